# Optimizing an MI355X kernel written in HIP

```python
import math
import jax, jax.numpy as jnp
from jax import lax
import numpy as np


D_MODEL = 1024
BATCH = 2
SEQ = 8192
DEPTH = 4

GRID_W = 64
CTX_LEN = 256
EPS = 1e-6

DN_H = 4
DN_DK = 128
DN_DV = 128
SHORT_CONV = 3
GLA_H = 4
GLA_DK = 64
GLA_DV = 128
GLA_RANK = 16
GLA_TAU = 16.0
CHUNK = 64
REC_SIZES = (DN_H * DN_DK, DN_H * DN_DK, DN_H * DN_DV, DN_H * DN_DV, 2 * DN_H, 2 * DN_H,
             GLA_H * GLA_DK, GLA_H * GLA_DK, GLA_H * GLA_DV, GLA_H * GLA_DV, 2 * GLA_RANK)
REC_IN = sum(REC_SIZES)
REC_MIX = DN_H * DN_DV + GLA_H * GLA_DV

ATT_H = 8
ATT_KVH = 2
ATT_G = ATT_H // ATT_KVH
ATT_HD = 128
ATT_QKV = (ATT_H + 2 * ATT_KVH) * ATT_HD
Q_BLOCK = 128
ROPE_THETA = 10000.0
ROPE_PAIRS = ATT_HD // 4

D_FF = 2816
FFN_CONV = 3

kernel_name = 'hybrid_deltanet_gla_gqa_dit'


def _rms(x):
    xf = x.astype(jnp.float32)
    return (xf * lax.rsqrt(jnp.mean(xf * xf, axis=-1, keepdims=True) + EPS)).astype(x.dtype)


def _l2n(x):
    return x * lax.rsqrt(jnp.sum(x * x, axis=-1, keepdims=True) + EPS)


def _modulate(h, shift, scale):
    return h * (1.0 + scale) + shift


def _ada(cond, w, b):
    m = (jax.nn.silu(cond) @ w + b)[:, None, :]
    return jnp.split(m, 6, axis=-1)


def _dwconv(x, w):
    K = w.shape[0]
    p = K // 2
    T = x.shape[1]
    xp = jnp.pad(x, ((0, 0), (p, p), (0, 0)))
    out = xp[:, 0:T] * w[0]
    for i in range(1, K):
        out = out + xp[:, i:i + T] * w[i]
    return out


def _heads(a, n_heads):
    B, T, _ = a.shape
    return jnp.swapaxes(a.reshape(B, T, n_heads, -1), 1, 2)


def _tokens(a):
    B, H, T, hd = a.shape
    return jnp.swapaxes(a, 1, 2).reshape(B, T, H * hd)


def _identity(a):
    return a


def _reverse(a):
    return jnp.flip(a, axis=2)


def _delta_chunked(q, k, v, g, beta, s0):
    B, H, T, _ = q.shape
    dv = v.shape[-1]
    n = T // CHUNK
    q, k, v = (a.reshape(B, H, n, CHUNK, a.shape[-1]) for a in (q, k, v))
    g, beta = (a.reshape(B, H, n, CHUNK) for a in (g, beta))
    G = jnp.cumsum(g, axis=-1)
    incl = jnp.tril(jnp.ones((CHUNK, CHUNK), bool))
    decay = jnp.exp(jnp.where(incl, G[..., :, None] - G[..., None, :], -jnp.inf))
    kb = k * beta[..., None]
    A = jnp.tril(jnp.einsum('bhnid,bhnjd->bhnij', kb, k) * decay, -1)
    eye = jnp.eye(CHUNK, dtype=q.dtype)
    tinv = lax.linalg.triangular_solve(eye + A, jnp.broadcast_to(eye, A.shape),
                                       left_side=True, lower=True, unit_diagonal=True)
    u = tinv @ (v * beta[..., None])
    w = tinv @ (kb * jnp.exp(G)[..., None])
    intra = jnp.einsum('bhnid,bhnjd->bhnij', q, k) * decay
    q_dec = q * jnp.exp(G)[..., None]
    k_dec = k * jnp.exp(G[..., -1:] - G)[..., None]
    g_last = jnp.exp(G[..., -1])

    def step(S, xs):
        qd, kd, w_c, u_c, a_c, gl = xs
        v_new = u_c - w_c @ S
        o = qd @ S + a_c @ v_new
        return S * gl[..., None, None] + jnp.swapaxes(kd, -1, -2) @ v_new, o

    xs = tuple(jnp.moveaxis(a, 2, 0) for a in (q_dec, k_dec, w, u, intra, g_last))
    S, o = lax.scan(step, s0, xs)
    return jnp.moveaxis(o, 0, 2).reshape(B, H, T, dv), S


def _gla_chunked(q, k, v, log_a, s0):
    B, H, T, _ = q.shape
    dv = v.shape[-1]
    n = T // CHUNK
    q, k, v, log_a = (a.reshape(B, H, n, CHUNK, a.shape[-1]) for a in (q, k, v, log_a))
    b = jnp.cumsum(log_a, axis=3)
    b_mid = b[:, :, :, CHUNK // 2:CHUNK // 2 + 1]
    att = jnp.tril(jnp.einsum('bhnid,bhnjd->bhnij', q * jnp.exp(b - b_mid), k * jnp.exp(b_mid - b)))
    o_intra = att @ v
    q_inter = q * jnp.exp(b)
    k_state = k * jnp.exp(b[..., -1:, :] - b)
    a_last = jnp.exp(b[..., -1, :])

    def step(S, xs):
        qd, kd, vc, al = xs
        o = qd @ S
        return S * al[..., :, None] + jnp.swapaxes(kd, -1, -2) @ vc, o

    xs = tuple(jnp.moveaxis(a, 2, 0) for a in (q_inter, k_state, v, a_last))
    S, o_inter = lax.scan(step, s0, xs)
    o = o_intra + jnp.moveaxis(o_inter, 0, 2)
    return o.reshape(B, H, T, dv), S


def _bidir_scan(scan_fn, shared_c, dir_c, shared_l, dir_l, state_shape):
    out_c = 0.0
    out_l = 0.0
    for d in range(2):
        f = _identity if d == 0 else _reverse
        args_c = [f(a) for a in shared_c] + [f(a[d]) for a in dir_c]
        args_l = [f(a) for a in shared_l] + [f(a[d]) for a in dir_l]
        o_c, s_c = scan_fn(*args_c, jnp.zeros(state_shape, jnp.float32))
        o_l, _ = scan_fn(*args_l, s_c)
        out_c = out_c + f(o_c)
        out_l = out_l + f(o_l)
    return out_c, out_l


def _recurrent_mixer(h_c, h_l, w_in, conv_w, a_log, dt_bias, dn_norm, gla_w2, gla_b2, gla_norm, w_out):
    offs = np.cumsum(REC_SIZES)[:-1].tolist()
    f32 = jnp.float32

    def prep(h):
        B, T, _ = h.shape
        dq, dk, dv, dz, da, db, gq, gk, gv, gr, gg = jnp.split(h @ w_in, offs, axis=-1)
        qkv = jax.nn.silu(_dwconv(jnp.concatenate([dq, dk, dv], axis=-1), conv_w)).astype(f32)
        dq, dk, dv = jnp.split(qkv, [DN_H * DN_DK, 2 * DN_H * DN_DK], axis=-1)
        dq = _l2n(_heads(dq, DN_H)) * DN_DK ** -0.5
        dk = _l2n(_heads(dk, DN_H))
        dv = _heads(dv, DN_H)
        g = -jnp.exp(a_log) * jax.nn.softplus(da.astype(f32).reshape(B, T, 2, DN_H) + dt_bias)
        beta = jax.nn.sigmoid(db.astype(f32).reshape(B, T, 2, DN_H))
        g = jnp.transpose(g, (2, 0, 3, 1))
        beta = jnp.transpose(beta, (2, 0, 3, 1))
        gq = _heads(gq.astype(f32), GLA_H) * GLA_DK ** -0.5
        gk = _heads(gk.astype(f32), GLA_H)
        gv = _heads(gv.astype(f32), GLA_H)
        la = jnp.einsum('btdr,drk->dbtk', gg.astype(f32).reshape(B, T, 2, GLA_RANK), gla_w2) + gla_b2[:, None, None, :]
        la = jax.nn.log_sigmoid(la) / GLA_TAU
        la = jnp.transpose(la.reshape(2, B, T, GLA_H, GLA_DK), (0, 1, 3, 2, 4))
        return (dq, dk, dv), (g, beta), (gq, gk, gv), (la,), _heads(dz, DN_H), _heads(gr, GLA_H)

    dn_sc, dn_dc, gla_sc, gla_dc, z_c, r_c = prep(h_c)
    dn_sl, dn_dl, gla_sl, gla_dl, z_l, r_l = prep(h_l)
    B = h_l.shape[0]
    dn_c, dn_l = _bidir_scan(_delta_chunked, dn_sc, dn_dc, dn_sl, dn_dl, (B, DN_H, DN_DK, DN_DV))
    gla_c, gla_l = _bidir_scan(_gla_chunked, gla_sc, gla_dc, gla_sl, gla_dl, (B, GLA_H, GLA_DK, GLA_DV))

    def merge(dn, gla, z, r, dtype):
        dn = _rms(dn) * dn_norm * jax.nn.silu(z)
        gla = _rms(gla) * gla_norm * jax.nn.silu(r)
        return jnp.concatenate([_tokens(dn), _tokens(gla)], axis=-1).astype(dtype) @ w_out

    return merge(dn_c, gla_c, z_c, r_c, h_c.dtype), merge(dn_l, gla_l, z_l, r_l, h_l.dtype)


def _rope_half(x, ang):
    x1, x2 = jnp.split(x.astype(jnp.float32), 2, axis=-1)
    cos = jnp.cos(ang)[:, None, :]
    sin = jnp.sin(ang)[:, None, :]
    return jnp.concatenate([x1 * cos - x2 * sin, x1 * sin + x2 * cos], axis=-1)


def _rope2d(x, ang_row, ang_col):
    xr, xc = jnp.split(x, 2, axis=-1)
    return jnp.concatenate([_rope_half(xr, ang_row), _rope_half(xc, ang_col)], axis=-1).astype(x.dtype)


def _attend(q, k, v):
    s = jnp.einsum('bqkgd,bskd->bkgqs', q.astype(jnp.float32), k.astype(jnp.float32)) * ATT_HD ** -0.5
    p = jax.nn.softmax(s, axis=-1)
    return jnp.einsum('bkgqs,bskd->bqkgd', p.astype(v.dtype), v)


def _attention_mixer(h_c, h_l, w_qkv, q_norm, k_norm, w_out, ang_row, ang_col, need_ctx):
    def prep(h, rotary):
        B, T, _ = h.shape
        q, k, v = jnp.split(h @ w_qkv, [ATT_H * ATT_HD, (ATT_H + ATT_KVH) * ATT_HD], axis=-1)
        q = _rms(q.reshape(B, T, ATT_H, ATT_HD)) * q_norm
        k = _rms(k.reshape(B, T, ATT_KVH, ATT_HD)) * k_norm
        if rotary:
            q = _rope2d(q, ang_row, ang_col)
            k = _rope2d(k, ang_row, ang_col)
        return q.reshape(B, T, ATT_KVH, ATT_G, ATT_HD), k, v.reshape(B, T, ATT_KVH, ATT_HD)

    qc, kc, vc = prep(h_c, False)
    ql, kl, vl = prep(h_l, True)
    keys = jnp.concatenate([kc, kl], axis=1)
    vals = jnp.concatenate([vc, vl], axis=1)
    B, T, _ = h_l.shape
    nb = T // Q_BLOCK
    qb = jnp.moveaxis(ql.reshape(B, nb, Q_BLOCK, ATT_KVH, ATT_G, ATT_HD), 1, 0)
    ol = lax.map(lambda qblk: _attend(qblk, keys, vals), qb)
    ol = jnp.moveaxis(ol, 0, 1).reshape(B, T, ATT_H * ATT_HD) @ w_out
    if need_ctx:
        oc = _attend(qc, kc, vc).reshape(B, h_c.shape[1], ATT_H * ATT_HD) @ w_out
    else:
        oc = None
    return oc, ol


def _conv_ffn(h, w_up, conv_w, w_down):
    gate, val = jnp.split(h @ w_up, 2, axis=-1)
    gate = _dwconv(gate, conv_w)
    return (jax.nn.silu(gate) * val) @ w_down


def setup_inputs(seed: int = 0) -> dict:
    key = jax.random.key(seed)
    ks = iter(jax.random.split(key, 32))
    f32 = jnp.float32

    def nrm(shape, scale):
        return jax.random.normal(next(ks), shape, f32) * scale

    def gain(shape):
        return 1.0 + nrm(shape, 0.02)

    NE = (DEPTH + 1) // 2
    NO = DEPTH // 2
    dt = jnp.exp(jax.random.uniform(next(ks), (NE, 2, DN_H), f32, math.log(1e-3), math.log(1e-1)))
    return {
        'x': nrm((BATCH, SEQ, D_MODEL), 1.0),
        'c': nrm((BATCH, D_MODEL), 1.0),
        'ctx': nrm((BATCH, CTX_LEN, D_MODEL), 1.0),
        'c_ctx': nrm((D_MODEL,), 1.0),
        'mod_w': nrm((DEPTH, D_MODEL, 6 * D_MODEL), 0.5 * D_MODEL ** -0.5),
        'mod_b': nrm((DEPTH, 6 * D_MODEL), 0.02),
        'rec_w_in': nrm((NE, D_MODEL, REC_IN), D_MODEL ** -0.5),
        'rec_conv': nrm((NE, SHORT_CONV, 2 * DN_H * DN_DK + DN_H * DN_DV), 0.5),
        'dn_a_log': jnp.log(jax.random.uniform(next(ks), (NE, 2, DN_H), f32, 1.0, 16.0)),
        'dn_dt_bias': dt + jnp.log(-jnp.expm1(-dt)),
        'dn_norm': gain((NE, DN_DV)),
        'gla_w2': nrm((NE, 2, GLA_RANK, GLA_H * GLA_DK), GLA_RANK ** -0.5),
        'gla_b2': nrm((NE, 2, GLA_H * GLA_DK), 0.1),
        'gla_norm': gain((NE, GLA_DV)),
        'rec_w_out': nrm((NE, REC_MIX, D_MODEL), REC_MIX ** -0.5),
        'att_w_qkv': nrm((NO, D_MODEL, ATT_QKV), D_MODEL ** -0.5),
        'att_q_norm': gain((NO, ATT_HD)),
        'att_k_norm': gain((NO, ATT_HD)),
        'att_w_out': nrm((NO, ATT_H * ATT_HD, D_MODEL), (ATT_H * ATT_HD) ** -0.5),
        'ffn_w_up': nrm((DEPTH, D_MODEL, 2 * D_FF), D_MODEL ** -0.5),
        'ffn_conv': nrm((DEPTH, FFN_CONV, D_FF), 0.5),
        'ffn_w_down': nrm((DEPTH, D_FF, D_MODEL), D_FF ** -0.5),
        'final_norm': gain((D_MODEL,)),
    }


def reference(x, c, ctx, c_ctx, mod_w, mod_b, rec_w_in, rec_conv, dn_a_log, dn_dt_bias, dn_norm,
              gla_w2, gla_b2, gla_norm, rec_w_out, att_w_qkv, att_q_norm, att_k_norm, att_w_out,
              ffn_w_up, ffn_conv, ffn_w_down, final_norm):
    f32 = jnp.float32
    n_lat = x.shape[1]
    ROWS = n_lat // GRID_W
    row = jnp.repeat(jnp.arange(ROWS, dtype=f32), GRID_W)
    col = jnp.tile(jnp.arange(GRID_W, dtype=f32), ROWS)
    inv_freq = ROPE_THETA ** (-jnp.arange(ROPE_PAIRS, dtype=f32) / ROPE_PAIRS)
    ang_row = row[:, None] * inv_freq
    ang_col = col[:, None] * inv_freq

    for i in range(DEPTH):
        last = i == DEPTH - 1
        ml = _ada(c, mod_w[i], mod_b[i])
        mc = _ada(c_ctx[None], mod_w[i], mod_b[i])
        h_l = _modulate(_rms(x), ml[0], ml[1])
        h_c = _modulate(_rms(ctx), mc[0], mc[1])
        if i % 2 == 0:
            e = i // 2
            mix_c, mix_l = _recurrent_mixer(h_c, h_l, rec_w_in[e], rec_conv[e], dn_a_log[e], dn_dt_bias[e],
                                            dn_norm[e], gla_w2[e], gla_b2[e], gla_norm[e], rec_w_out[e])
        else:
            o = i // 2
            mix_c, mix_l = _attention_mixer(h_c, h_l, att_w_qkv[o], att_q_norm[o], att_k_norm[o], att_w_out[o],
                                            ang_row, ang_col, not last)
        x = x + ml[2] * mix_l
        x = x + ml[5] * _conv_ffn(_modulate(_rms(x), ml[3], ml[4]), ffn_w_up[i], ffn_conv[i], ffn_w_down[i])
        if not last:
            ctx = ctx + mc[2] * mix_c
            ctx = ctx + mc[5] * _conv_ffn(_modulate(_rms(ctx), mc[3], mc[4]), ffn_w_up[i], ffn_conv[i], ffn_w_down[i])

    return _rms(x) * final_norm
```

```cpp
#include <hip/hip_runtime.h>
#include <hip/hip_cooperative_groups.h>
#include <cstdio>
#include <cstdint>
namespace cg = cooperative_groups;

#ifndef MK_COOP
#define MK_COOP 1
#endif

typedef unsigned short bf16_t;
typedef short bf16x8 __attribute__((ext_vector_type(8)));
typedef short s16x4 __attribute__((ext_vector_type(4)));
typedef float f32x16 __attribute__((ext_vector_type(16)));
typedef float f32x8 __attribute__((ext_vector_type(8)));
typedef float f32x4 __attribute__((ext_vector_type(4)));
typedef unsigned u32x4 __attribute__((ext_vector_type(4)));
#define DI __device__ __forceinline__
#define MFMA32(a, b, c) __builtin_amdgcn_mfma_f32_32x32x16_bf16((a), (b), (c), 0, 0, 0)

constexpr int DM = 1024, TB = 8448, CTXL = 256, LAT = 8192, MROWS = 2 * TB;
constexpr int NCH = 132;
constexpr int DFF = 2816;
constexpr int NREC = 3712;
constexpr float EPSF = 1e-6f;

constexpr size_t AL(size_t x) { return (x + 255) / 256 * 256; }
constexpr size_t OFF_XRES = 0;
constexpr size_t OFF_HBF = OFF_XRES + AL((size_t)MROWS * DM * 4);
constexpr size_t OFF_WC = OFF_HBF + AL((size_t)MROWS * DM * 2);
constexpr size_t WC_W2 = (size_t)5632 * 1024 * 2;
constexpr size_t OFF_MODS = OFF_WC + AL(WC_W2 + (size_t)1024 * 2816 * 2);
constexpr size_t OFF_SM = OFF_MODS + AL((size_t)4 * 3 * 6144 * 4);
constexpr size_t OFF_GB = OFF_SM + AL((size_t)MROWS * 64 * 4);
constexpr size_t OFF_SC = OFF_GB + AL((size_t)MROWS * 16 * 4);
constexpr size_t OFF_GL = OFF_SC + AL((size_t)16 * NCH * 64 * 2 * 4);
constexpr size_t OFF_D = OFF_GL + AL((size_t)16 * NCH * 4);
constexpr size_t D_P1 = 0;
constexpr size_t D_W = 0;
constexpr size_t D_INTRA = D_W + (size_t)16 * NCH * 64 * 128 * 2;
constexpr size_t D_P2 = D_P1 + (size_t)MROWS * 1536 * 2;
constexpr size_t D_QQ = D_P2 + (size_t)MROWS * 2048 * 2;
constexpr size_t D_QK = D_QQ + (size_t)MROWS * 512 * 2;
constexpr size_t D_QV = D_QK + (size_t)MROWS * 512 * 2;
constexpr size_t D_DNO = D_QK;
constexpr size_t D_KT = D_QV + (size_t)MROWS * 512 * 2;
constexpr size_t D_GLAO = D_KT + (size_t)MROWS * 512 * 2;
constexpr size_t D_END_E = D_GLAO + (size_t)2 * MROWS * 512 * 2;
constexpr size_t D_END_F = (size_t)MROWS * 5632 * 2;
constexpr size_t WS_NEED = OFF_D + (D_END_E > D_END_F ? D_END_E : D_END_F);
constexpr int LDS_BYTES = 112 * 1024;

struct P {
  const float *x, *c, *ctx, *c_ctx, *mod_w, *mod_b, *rec_w_in, *rec_conv, *dn_a_log, *dn_dt_bias, *dn_norm, *gla_w2, *gla_b2, *gla_norm,
      *rec_w_out, *att_w_qkv, *att_q_norm, *att_k_norm, *att_w_out, *ffn_w_up, *ffn_conv, *ffn_w_down, *final_norm;
  float* out;
  char* ws;
};

DI int TIDX() { int t = threadIdx.x; asm volatile("" : "+v"(t)); return t; }
DI int BIDX() { int t = blockIdx.x; asm volatile("" : "+s"(t)); return t; }
DI int GDIM() { int t = gridDim.x; asm volatile("" : "+s"(t)); return t; }
DI float bf2f(bf16_t v) { return __uint_as_float(((unsigned)v) << 16); }
DI bf16_t f2bf(float x) { unsigned u = __float_as_uint(x); u += 0x7fffu + ((u >> 16) & 1u); return (bf16_t)(u >> 16); }
DI unsigned cvtpk(float lo, float hi) { unsigned r; asm volatile("v_cvt_pk_bf16_f32 %0, %1, %2" : "=v"(r) : "v"(lo), "v"(hi)); return r; }
DI int crow(int r, int hi) { return (r & 3) + 8 * (r >> 2) + 4 * hi; }
DI float siluf(float x) { return x / (1.f + expf(-x)); }
DI float sigmf(float x) { return 1.f / (1.f + expf(-x)); }
DI float softplusf(float x) { return fmaxf(x, 0.f) + log1pf(expf(-fabsf(x))); }
DI float wave_sum(float v) {
#pragma unroll
  for (int o = 32; o > 0; o >>= 1) v += __shfl_xor(v, o);
  return v;
}
DI int modrow_of(int R) { const int b = R >= TB ? 1 : 0; const int pp = R - b * TB; return pp < CTXL ? 2 : b; }
template <int KS>
DI f32x16 mma_rows(const bf16_t* arow, const bf16_t* brow, f32x16 acc) {
#pragma unroll
  for (int ks = 0; ks < KS; ++ks) {
    const bf16x8 a = *reinterpret_cast<const bf16x8*>(arow + ks * 16);
    const bf16x8 b = *reinterpret_cast<const bf16x8*>(brow + ks * 16);
    acc = MFMA32(a, b, acc);
  }
  return acc;
}

__device__ __forceinline__ void ph_init(const P& p, char* lds) {
  const int tid = TIDX();
  float* sc = (float*)lds;
  float* red = sc + 3072;
  for (int i = tid; i < 3072; i += 512) { const int r = i >> 10, k = i & 1023; const float v = r < 2 ? p.c[r * 1024 + k] : p.c_ctx[k]; sc[i] = siluf(v); }
  __syncthreads();
  float* mods = (float*)(p.ws + OFF_MODS);
  for (int job = BIDX(); job < 192; job += GDIM()) {
    const int col = job * 128 + (tid & 127), kq = tid >> 7;
    const int L = col / 6144, cl = col - L * 6144;
    const float* w = p.mod_w + ((size_t)L * 1024 + kq * 256) * 6144 + cl;
    float a0 = 0.f, a1 = 0.f, a2 = 0.f;
#pragma unroll 8
    for (int k = 0; k < 256; ++k) { const float wv = w[(size_t)k * 6144]; const int kk = kq * 256 + k; a0 += sc[kk] * wv; a1 += sc[1024 + kk] * wv; a2 += sc[2048 + kk] * wv; }
    red[(kq * 3 + 0) * 128 + (tid & 127)] = a0; red[(kq * 3 + 1) * 128 + (tid & 127)] = a1; red[(kq * 3 + 2) * 128 + (tid & 127)] = a2;
    __syncthreads();
    if (tid < 384) { const int r = tid >> 7, cc = tid & 127; const int c2 = job * 128 + cc; const int L2 = c2 / 6144, cl2 = c2 - L2 * 6144;
      const float s = red[(0 * 3 + r) * 128 + cc] + red[(1 * 3 + r) * 128 + cc] + red[(2 * 3 + r) * 128 + cc] + red[(3 * 3 + r) * 128 + cc] + p.mod_b[L2 * 6144 + cl2];
      mods[((size_t)L2 * 3 + r) * 6144 + cl2] = s; }
    __syncthreads();
  }
  f32x4* xr = (f32x4*)(p.ws + OFF_XRES);
  for (size_t i = (size_t)BIDX() * 512 + tid; i < (size_t)MROWS * 256; i += (size_t)GDIM() * 512) {
    const int R = (int)(i >> 8), c4 = (int)(i & 255); const int b = R >= TB ? 1 : 0, pp = R - b * TB;
    const float* src = pp < CTXL ? p.ctx + ((size_t)b * CTXL + pp) * 1024 : p.x + ((size_t)b * LAT + (pp - CTXL)) * 1024;
    xr[i] = *(const f32x4*)(src + c4 * 4);
  }
}

DI int rec_src_col(int n) { if (n < 2048) return n; if (n < 3584) return n + 16; if (n < 3600) return 2048 + (n - 3584); if (n < 3632) return n; return -1; }
__device__ __forceinline__ void cvt_weight(const float* __restrict__ W, bf16_t* __restrict__ Wt, int K, int Nsrc, int Npad, bool perm) {
  const size_t items = (size_t)Npad * (K >> 3);
  for (size_t it = (size_t)BIDX() * 512 + TIDX(); it < items; it += (size_t)GDIM() * 512) {
    const int n = (int)(it % Npad), kb = (int)(it / Npad);
    const int s = perm ? rec_src_col(n) : n;
    float v[8];
#pragma unroll
    for (int j = 0; j < 8; ++j) v[j] = s >= 0 ? W[(size_t)(kb * 8 + j) * Nsrc + s] : 0.f;
    u32x4 w = {cvtpk(v[0], v[1]), cvtpk(v[2], v[3]), cvtpk(v[4], v[5]), cvtpk(v[6], v[7])};
    *(u32x4*)(Wt + (size_t)n * K + kb * 8) = w;
  }
}

__device__ __forceinline__ void ph_norm(const P& p, int L, int which) {
  const int tid = TIDX(), wid = tid >> 6, lane = tid & 63;
  const float* xr = (const float*)(p.ws + OFF_XRES);
  bf16_t* hb = (bf16_t*)(p.ws + OFF_HBF);
  const float* mods = (const float*)(p.ws + OFF_MODS) + (size_t)L * 3 * 6144;
  for (int R = BIDX() * 8 + wid; R < MROWS; R += GDIM() * 8) {
    const float* row = xr + (size_t)R * 1024;
    f32x4 v[4]; float ss = 0.f;
#pragma unroll
    for (int i = 0; i < 4; ++i) { v[i] = *(const f32x4*)(row + i * 256 + lane * 4); ss += v[i][0] * v[i][0] + v[i][1] * v[i][1] + v[i][2] * v[i][2] + v[i][3] * v[i][3]; }
    ss = wave_sum(ss);
    const float rs = rsqrtf(ss * (1.f / 1024.f) + EPSF);
    const float* mr = mods + (size_t)modrow_of(R) * 6144 + which * 3072;
#pragma unroll
    for (int i = 0; i < 4; ++i) { const int c0 = i * 256 + lane * 4; const f32x4 sh = *(const f32x4*)(mr + c0), scl = *(const f32x4*)(mr + 1024 + c0);
      float o[4];
#pragma unroll
      for (int j = 0; j < 4; ++j) o[j] = v[i][j] * rs * (1.f + scl[j]) + sh[j];
      uint2 w; w.x = cvtpk(o[0], o[1]); w.y = cvtpk(o[2], o[3]);
      *(uint2*)(hb + (size_t)R * 1024 + c0) = w; }
  }
}

struct EpiRec { bf16_t* P1; bf16_t* P2; float* SM;
  DI void operator()(int row, int col, float v) const {
    if (col < 1536) P1[(size_t)row * 1536 + col] = f2bf(v);
    else if (col < 3584) P2[(size_t)row * 2048 + (col - 1536)] = f2bf(v);
    else { const int lc = col - 3584; if (lc < 48) SM[(size_t)row * 64 + lc] = v; } } };
struct EpiBf { bf16_t* O; int ldc;
  DI void operator()(int row, int col, float v) const { O[(size_t)row * ldc + col] = f2bf(v); } };
struct EpiRes { float* X; const float* gate;
  DI void operator()(int row, int col, float v) const { float* q = X + (size_t)row * 1024 + col; *q = *q + gate[(size_t)modrow_of(row) * 6144 + col] * v; } };

template <class Epi>
__device__ __forceinline__ void gemm_phase(char* lds, const bf16_t* __restrict__ A, int lda, const bf16_t* __restrict__ Bt, int K, int nN, const Epi epi) {
  const int tid = TIDX(), wid = tid >> 6, lane = tid & 63, r32 = lane & 31, hi = lane >> 5;
  const int wm = wid >> 1, wn = wid & 1;
  const int nk = K >> 6;
  constexpr int RS = 144, ASZ = 256 * RS, BSZ = 128 * RS, STG = ASZ + BSZ;
  const int ntiles = (MROWS / 256) * nN;
  const int srow = tid >> 3, spc = tid & 7;
  for (int t = BIDX(); t < ntiles; t += GDIM()) {
    const int pm = t / nN, pn = t - pm * nN;
    const bf16_t* Ab = A + (size_t)(pm * 256 + srow) * lda + spc * 8;
    const bf16_t* Bb = Bt + (size_t)(pn * 128 + srow) * K + spc * 8;
    f32x16 acc00 = {}, acc01 = {}, acc10 = {}, acc11 = {};
    bf16x8 ra0, ra1, ra2, ra3, rb0, rb1;
#define GLOAD(kt) do { const int ko = (kt) * 64; ra0 = *(const bf16x8*)(Ab + ko); ra1 = *(const bf16x8*)(Ab + (size_t)64 * lda + ko); ra2 = *(const bf16x8*)(Ab + (size_t)128 * lda + ko); \
    ra3 = *(const bf16x8*)(Ab + (size_t)192 * lda + ko); rb0 = *(const bf16x8*)(Bb + ko); rb1 = *(const bf16x8*)(Bb + (size_t)64 * K + ko); } while (0)
#define SWRITE(buf) do { char* sb = lds + (buf) * STG + srow * RS + spc * 16; *(bf16x8*)(sb) = ra0; *(bf16x8*)(sb + 64 * RS) = ra1; *(bf16x8*)(sb + 128 * RS) = ra2; *(bf16x8*)(sb + 192 * RS) = ra3; \
    *(bf16x8*)(sb + ASZ) = rb0; *(bf16x8*)(sb + ASZ + 64 * RS) = rb1; } while (0)
    GLOAD(0); SWRITE(0); __syncthreads();
    for (int kt = 0; kt < nk; ++kt) {
      const int cur = kt & 1;
      if (kt + 1 < nk) GLOAD(kt + 1);
      const char* ab = lds + cur * STG + (64 * wm + r32) * RS + hi * 16;
      const char* bb = lds + cur * STG + ASZ + (64 * wn + r32) * RS + hi * 16;
#pragma unroll
      for (int ks = 0; ks < 4; ++ks) {
        const bf16x8 a0 = *(const bf16x8*)(ab + ks * 32), a1 = *(const bf16x8*)(ab + 32 * RS + ks * 32);
        const bf16x8 b0 = *(const bf16x8*)(bb + ks * 32), b1 = *(const bf16x8*)(bb + 32 * RS + ks * 32);
        acc00 = MFMA32(a0, b0, acc00); acc01 = MFMA32(a0, b1, acc01); acc10 = MFMA32(a1, b0, acc10); acc11 = MFMA32(a1, b1, acc11);
      }
      if (kt + 1 < nk) SWRITE(cur ^ 1);
      __syncthreads();
    }
#undef GLOAD
#undef SWRITE
    const int row0 = pm * 256 + 64 * wm, col0 = pn * 128 + 64 * wn + r32;
#pragma unroll
    for (int r = 0; r < 16; ++r) { const int rr = row0 + crow(r, hi);
      epi(rr, col0, acc00[r]); epi(rr, col0 + 32, acc01[r]); epi(rr + 32, col0, acc10[r]); epi(rr + 32, col0 + 32, acc11[r]); }
  }
}

__device__ __forceinline__ void ph_dnprep(const P& p, char* lds, int e) {
  const int tid = TIDX(), wid = tid >> 6, lane = tid & 63;
  const bf16_t* P1 = (const bf16_t*)(p.ws + OFF_D + D_P1);
  bf16_t* QQ = (bf16_t*)(p.ws + OFF_D + D_QQ); bf16_t* QK = (bf16_t*)(p.ws + OFF_D + D_QK); bf16_t* QV = (bf16_t*)(p.ws + OFF_D + D_QV);
  bf16_t* KT = (bf16_t*)(p.ws + OFF_D + D_KT);
  const float* SM = (const float*)(p.ws + OFF_SM); float* GB = (float*)(p.ws + OFF_GB);
  const float* cw = p.rec_conv + (size_t)e * 3 * 1536;
  bf16_t* kl = (bf16_t*)lds;
  for (int job = BIDX(); job < MROWS / 64; job += GDIM()) {
    const int R0 = job * 64;
    for (int tt = 0; tt < 8; ++tt) {
      const int tl = wid * 8 + tt, R = R0 + tl; const int b = R >= TB ? 1 : 0, pp = R - b * TB;
      const bool hasp = !(pp == 0 || pp == CTXL), hasn = !(pp == CTXL - 1 || pp == TB - 1);
#pragma unroll
      for (int part = 0; part < 3; ++part) {
        const int ch = part * 512 + lane * 8;
        const bf16x8 zc = *(const bf16x8*)(P1 + (size_t)R * 1536 + ch);
        bf16x8 zp = {}, zn = {};
        if (hasp) zp = *(const bf16x8*)(P1 + (size_t)(R - 1) * 1536 + ch);
        if (hasn) zn = *(const bf16x8*)(P1 + (size_t)(R + 1) * 1536 + ch);
        float o[8]; float ss = 0.f;
#pragma unroll
        for (int j = 0; j < 8; ++j) { const float a = bf2f((bf16_t)zp[j]) * cw[ch + j] + bf2f((bf16_t)zc[j]) * cw[1536 + ch + j] + bf2f((bf16_t)zn[j]) * cw[3072 + ch + j];
          o[j] = siluf(a); ss += o[j] * o[j]; }
        if (part < 2) {
          ss += __shfl_xor(ss, 1); ss += __shfl_xor(ss, 2); ss += __shfl_xor(ss, 4); ss += __shfl_xor(ss, 8);
          float sc = rsqrtf(ss + EPSF); if (part == 0) sc *= 0.08838834764831845f;
#pragma unroll
          for (int j = 0; j < 8; ++j) o[j] *= sc;
        }
        u32x4 w = {cvtpk(o[0], o[1]), cvtpk(o[2], o[3]), cvtpk(o[4], o[5]), cvtpk(o[6], o[7])};
        bf16_t* dst = part == 0 ? QQ : (part == 1 ? QK : QV);
        *(u32x4*)(dst + (size_t)R * 512 + lane * 8) = w;
        if (part == 1) *(u32x4*)(kl + tl * 512 + lane * 8) = w;
      }
      if (lane < 16) {
        const int q = lane & 7;
        if (lane < 8) { const float da = SM[(size_t)R * 64 + q]; GB[(size_t)R * 16 + q] = -expf(p.dn_a_log[e * 8 + q]) * softplusf(da + p.dn_dt_bias[e * 8 + q]); }
        else { const float db = SM[(size_t)R * 64 + 8 + q]; GB[(size_t)R * 16 + 8 + q] = sigmf(db); }
      }
    }
    __syncthreads();
    {
      const int b = R0 >= TB ? 1 : 0, c = (R0 - b * TB) / 64; const int h = tid >> 7, dk = tid & 127;
      bf16_t* dst = KT + ((((size_t)b * 4 + h) * NCH + c) * 128 + dk) * 64;
#pragma unroll
      for (int g8 = 0; g8 < 8; ++g8) { unsigned w[4];
#pragma unroll
        for (int j = 0; j < 4; ++j) { const unsigned lo = kl[(g8 * 8 + 2 * j) * 512 + tid], hi2 = kl[(g8 * 8 + 2 * j + 1) * 512 + tid]; w[j] = lo | (hi2 << 16); }
        *(u32x4*)(dst + g8 * 8) = (u32x4){w[0], w[1], w[2], w[3]}; }
    }
    __syncthreads();
  }
}

__device__ __forceinline__ void ph_dn_d1(const P& p, char* lds) {
  const int tid = TIDX(), wid = tid >> 6, lane = tid & 63, r32 = lane & 31, hi = lane >> 5;
  const bf16_t* QQ = (const bf16_t*)(p.ws + OFF_D + D_QQ); const bf16_t* QK = (const bf16_t*)(p.ws + OFF_D + D_QK); const bf16_t* QV = (const bf16_t*)(p.ws + OFF_D + D_QV);
  const float* GB = (const float*)(p.ws + OFF_GB);
  bf16_t* W_ = (bf16_t*)(p.ws + OFF_D + D_W); bf16_t* U_ = (bf16_t*)(p.ws + OFF_HBF); bf16_t* INTRA = (bf16_t*)(p.ws + OFF_D + D_INTRA);
  float* SC = (float*)(p.ws + OFF_SC); float* GLS = (float*)(p.ws + OFF_GL);
  float* KK = (float*)lds; float* QKm = KK + 64 * 65; float* Ad = QKm + 64 * 65; float* Gs = Ad + 2 * 4096; float* Bs = Gs + 128;
  for (int job = BIDX(); job < 8 * NCH; job += GDIM()) {
    const int b = job / (4 * NCH), h = (job / NCH) & 3, c = job % NCH;
    const size_t Rb = (size_t)b * TB + (size_t)c * 64;
    {
      const int w4 = wid & 3, mi = w4 & 1, ni = w4 >> 1;
      const bf16_t* As = wid < 4 ? QK : QQ;
      const bf16_t* arow = As + (Rb + 32 * mi + r32) * 512 + h * 128 + hi * 8;
      const bf16_t* brow = QK + (Rb + 32 * ni + r32) * 512 + h * 128 + hi * 8;
      f32x16 acc = {}; acc = mma_rows<8>(arow, brow, acc);
      float* dst = wid < 4 ? KK : QKm;
#pragma unroll
      for (int r = 0; r < 16; ++r) dst[(32 * mi + crow(r, hi)) * 65 + 32 * ni + r32] = acc[r];
    }
    if (tid < 128) { const int d = tid >> 6, ip = tid & 63, t = d ? 63 - ip : ip; Gs[tid] = GB[(Rb + t) * 16 + d * 4 + h]; Bs[tid] = GB[(Rb + t) * 16 + 8 + d * 4 + h]; }
    __syncthreads();
    if (tid == 0 || tid == 64) { float s = 0.f; for (int i = 0; i < 64; ++i) { s += Gs[tid + i]; Gs[tid + i] = s; } }
    __syncthreads();
    const int n0 = c, n1 = c < 4 ? 3 - c : 135 - c;
    const size_t cj0 = ((size_t)(0 * 2 + b) * 4 + h) * NCH + n0, cj1 = ((size_t)(1 * 2 + b) * 4 + h) * NCH + n1;
    for (int e2 = tid; e2 < 8192; e2 += 512) {
      const int d = e2 >> 12, ip = (e2 >> 6) & 63, jp = e2 & 63; const int i = d ? 63 - ip : ip, j = d ? 63 - jp : jp;
      const float dec = jp <= ip ? expf(Gs[d * 64 + ip] - Gs[d * 64 + jp]) : 0.f;
      Ad[d * 4096 + ip * 64 + jp] = jp < ip ? Bs[d * 64 + ip] * KK[i * 65 + j] * dec : 0.f;
      const size_t cj = d ? cj1 : cj0;
      INTRA[(cj * 64 + ip) * 64 + jp] = f2bf(QKm[i * 65 + j] * dec);
    }
    if (tid < 128) { const int d = tid >> 6, ip = tid & 63; const size_t cj = d ? cj1 : cj0; const float gi = Gs[tid], gl = Gs[d * 64 + 63];
      SC[(cj * 64 + ip) * 2] = expf(gi); SC[(cj * 64 + ip) * 2 + 1] = expf(gl - gi); if (ip == 0) GLS[cj] = expf(gl); }
    __syncthreads();
    {
      const int d = tid >> 8, cc = tid & 255; const size_t cj = d ? cj1 : cj0;
      int dofs = d * 64, aofs = d * 4096; asm volatile("" : "+v"(dofs), "+v"(aofs));
      float x[64];
      {
        const bf16_t* srcb = (cc < 128 ? QV + h * 128 + cc : QK + h * 128 + (cc - 128)) + (Rb + (d ? 63 : 0)) * 512;
        const long step = d ? -512 : 512;
#pragma unroll
        for (int g = 0; g < 8; ++g) {
#pragma unroll
          for (int q8 = 0; q8 < 8; ++q8) { const int ip = g * 8 + q8; x[ip] = bf2f(srcb[ip * step]); }
          asm volatile("" ::: "memory");
        }
        if (cc < 128) {
#pragma unroll
          for (int ip = 0; ip < 64; ++ip) x[ip] *= Bs[dofs + ip];
        } else {
#pragma unroll
          for (int ip = 0; ip < 64; ++ip) x[ip] *= Bs[dofs + ip] * expf(Gs[dofs + ip]);
        }
      }
      const float* Arow = Ad + aofs;
#pragma unroll
      for (int ip = 1; ip < 64; ++ip) {
        float s = 0.f;
#pragma unroll
        for (int j4 = 0; j4 < (ip + 3) / 4; ++j4) { const f32x4 a = *(const f32x4*)(Arow + ip * 64 + 4 * j4);
          s += a[0] * x[4 * j4] + a[1] * x[4 * j4 + 1] + a[2] * x[4 * j4 + 2] + a[3] * x[4 * j4 + 3]; }
        x[ip] -= s;
      }
      bf16_t* dst = cc < 128 ? U_ + cj * 64 * 128 + cc : W_ + cj * 64 * 128 + (cc - 128);
#pragma unroll
      for (int ip = 0; ip < 64; ++ip) dst[ip * 128] = f2bf(x[ip]);
    }
    __syncthreads();
  }
}

__device__ __forceinline__ void dn_scan(const P& p, char* lds, int job) {
  const int tid = TIDX(), wid = tid >> 6, lane = tid & 63, r32 = lane & 31, hi = lane >> 5;
  const int dir = job >> 5, b = (job >> 4) & 1, h = (job >> 2) & 3, n0 = (job & 3) * 32;
  const bf16_t* QQ = (const bf16_t*)(p.ws + OFF_D + D_QQ); const bf16_t* KT = (const bf16_t*)(p.ws + OFF_D + D_KT);
  const bf16_t* W_ = (const bf16_t*)(p.ws + OFF_D + D_W); const bf16_t* U_ = (const bf16_t*)(p.ws + OFF_HBF); const bf16_t* INTRA = (const bf16_t*)(p.ws + OFF_D + D_INTRA);
  const float* SC = (const float*)(p.ws + OFF_SC); const float* GLS = (const float*)(p.ws + OFF_GL);
  bf16_t* DNO = (bf16_t*)(p.ws + OFF_D + D_DNO);
  bf16_t* ST = (bf16_t*)lds; bf16_t* vTa = ST + 32 * 136; bf16_t* vTb = vTa + 32 * 72;
  for (int i = tid; i < 32 * 136; i += 512) ST[i] = 0;
  f32x16 accS = {};
  __syncthreads();
  const size_t seq = ((size_t)dir * 2 + b) * 4 + h;
  const int mi = wid & 1;
  for (int n = 0; n < NCH; ++n) {
    const int c = dir == 0 ? n : (n < 4 ? 3 - n : 135 - n);
    const size_t Rb = (size_t)b * TB + (size_t)c * 64;
    const size_t cj = seq * NCH + n;
    const bf16_t* Wc = W_ + cj * 64 * 128; const bf16_t* Uc = U_ + cj * 64 * 128; const bf16_t* Ic = INTRA + cj * 64 * 64;
    const float* scc = SC + cj * 128; const float gl = GLS[cj];
    const bf16_t* kTc = KT + (((size_t)b * 4 + h) * NCH + c) * 128 * 64;
    f32x16 acc = {};
    if (wid < 2) {
      acc = mma_rows<8>(Wc + (32 * mi + r32) * 128 + hi * 8, ST + r32 * 136 + hi * 8, acc);
#pragma unroll
      for (int r = 0; r < 16; ++r) { const int ip = 32 * mi + crow(r, hi); const float vn = bf2f(Uc[ip * 128 + n0 + r32]) - acc[r];
        vTa[r32 * 72 + ip] = f2bf(vn); const int to = dir ? 63 - ip : ip; vTb[r32 * 72 + to] = f2bf(vn * scc[ip * 2 + 1]); }
    } else if (wid < 4) {
      const int ipl = 32 * mi + r32, tl = dir ? 63 - ipl : ipl;
      acc = mma_rows<8>(QQ + (Rb + tl) * 512 + h * 128 + hi * 8, ST + r32 * 136 + hi * 8, acc);
#pragma unroll
      for (int r = 0; r < 16; ++r) acc[r] *= scc[(32 * mi + crow(r, hi)) * 2];
    }
    __syncthreads();
    if (wid >= 2 && wid < 4) {
      acc = mma_rows<4>(Ic + (32 * mi + r32) * 64 + hi * 8, vTa + r32 * 72 + hi * 8, acc);
#pragma unroll
      for (int r = 0; r < 16; ++r) { const int ip = 32 * mi + crow(r, hi), t = dir ? 63 - ip : ip;
        DNO[((size_t)dir * MROWS + Rb + t) * 512 + h * 128 + n0 + r32] = f2bf(acc[r]); }
    } else if (wid >= 4) {
      const int di = wid - 4;
#pragma unroll
      for (int r = 0; r < 16; ++r) accS[r] *= gl;
      accS = mma_rows<4>(kTc + (32 * di + r32) * 64 + hi * 8, vTb + r32 * 72 + hi * 8, accS);
#pragma unroll
      for (int r = 0; r < 16; ++r) ST[r32 * 136 + 32 * di + crow(r, hi)] = f2bf(accS[r]);
    }
    __syncthreads();
  }
}

__device__ __forceinline__ void gla_scan(const P& p, char* lds, int job, int e) {
  const int tid = TIDX(), wid = tid >> 6, lane = tid & 63, r32 = lane & 31, hi = lane >> 5;
  const int dir = job >> 5, b = (job >> 4) & 1, h = (job >> 2) & 3, n0 = (job & 3) * 32;
  const bf16_t* P2 = (const bf16_t*)(p.ws + OFF_D + D_P2); const float* SM = (const float*)(p.ws + OFF_SM);
  bf16_t* GLAO = (bf16_t*)(p.ws + OFF_D + D_GLAO);
  float* laS = (float*)lds; float* ggS = laS + 64 * 65; float* w2S = ggS + 1024; float* b2S = w2S + 1024; float* aL = b2S + 64;
  bf16_t* qe = (bf16_t*)(aL + 64); bf16_t* ke = qe + 64 * 72; bf16_t* qi = ke + 64 * 72; bf16_t* ksT = qi + 64 * 72; bf16_t* att = ksT + 64 * 72;
  bf16_t* vT = att + 64 * 72; bf16_t* ST = vT + 32 * 72;
  for (int i = tid; i < 1024; i += 512) { const int r = i >> 6, j = i & 63; w2S[i] = p.gla_w2[(((size_t)e * 2 + dir) * 16 + r) * 256 + h * 64 + j]; }
  if (tid < 64) b2S[tid] = p.gla_b2[((size_t)e * 2 + dir) * 256 + h * 64 + tid];
  for (int i = tid; i < 32 * 72; i += 512) ST[i] = 0;
  f32x16 accS = {};
  __syncthreads();
  const int mi = wid & 1;
  for (int n = 0; n < NCH; ++n) {
    const int c = dir == 0 ? n : (n < 4 ? 3 - n : 135 - n);
    const size_t Rb = (size_t)b * TB + (size_t)c * 64;
    for (int e2 = tid; e2 < 1024; e2 += 512) { const int ip = e2 >> 4, r = e2 & 15, t = dir ? 63 - ip : ip; ggS[e2] = SM[(Rb + t) * 64 + 16 + dir * 16 + r]; }
    __syncthreads();
    for (int e2 = tid; e2 < 4096; e2 += 512) { const int ip = e2 >> 6, j = e2 & 63; float s = b2S[j];
#pragma unroll
      for (int r = 0; r < 16; ++r) s += ggS[ip * 16 + r] * w2S[r * 64 + j];
      laS[ip * 65 + j] = (fminf(s, 0.f) - log1pf(expf(-fabsf(s)))) * 0.0625f; }
    __syncthreads();
    if (tid < 64) { float s = 0.f; for (int i = 0; i < 64; ++i) { s += laS[i * 65 + tid]; laS[i * 65 + tid] = s; } }
    __syncthreads();
    for (int e2 = tid; e2 < 4096; e2 += 512) { const int ip = e2 >> 6, j = e2 & 63, t = dir ? 63 - ip : ip;
      const float bb = laS[ip * 65 + j], bm = laS[32 * 65 + j], bl = laS[63 * 65 + j];
      const float q = bf2f(P2[(Rb + t) * 2048 + 512 + h * 64 + j]) * 0.125f, k = bf2f(P2[(Rb + t) * 2048 + 768 + h * 64 + j]);
      qe[ip * 72 + j] = f2bf(q * expf(bb - bm)); ke[ip * 72 + j] = f2bf(k * expf(bm - bb)); qi[ip * 72 + j] = f2bf(q * expf(bb)); ksT[j * 72 + ip] = f2bf(k * expf(bl - bb)); }
    for (int e2 = tid; e2 < 2048; e2 += 512) { const int ip = e2 >> 5, nn = e2 & 31, t = dir ? 63 - ip : ip; vT[nn * 72 + ip] = P2[(Rb + t) * 2048 + 1024 + h * 128 + n0 + nn]; }
    if (tid < 64) aL[tid] = expf(laS[63 * 65 + tid]);
    __syncthreads();
    f32x16 acc = {};
    if (wid < 4) {
      const int ni = wid >> 1;
      if (ni <= mi) acc = mma_rows<4>(qe + (32 * mi + r32) * 72 + hi * 8, ke + (32 * ni + r32) * 72 + hi * 8, acc);
#pragma unroll
      for (int r = 0; r < 16; ++r) { const int ip = 32 * mi + crow(r, hi), jp = 32 * ni + r32; att[ip * 72 + jp] = f2bf(jp <= ip ? acc[r] : 0.f); }
    } else if (wid < 6) {
      acc = mma_rows<4>(qi + (32 * mi + r32) * 72 + hi * 8, ST + r32 * 72 + hi * 8, acc);
    }
    __syncthreads();
    if (wid >= 4 && wid < 6) {
      acc = mma_rows<4>(att + (32 * mi + r32) * 72 + hi * 8, vT + r32 * 72 + hi * 8, acc);
#pragma unroll
      for (int r = 0; r < 16; ++r) { const int ip = 32 * mi + crow(r, hi), t = dir ? 63 - ip : ip;
        GLAO[((size_t)dir * MROWS + Rb + t) * 512 + h * 128 + n0 + r32] = f2bf(acc[r]); }
    } else if (wid >= 6) {
      const int di = wid - 6;
#pragma unroll
      for (int r = 0; r < 16; ++r) accS[r] *= aL[32 * di + crow(r, hi)];
      accS = mma_rows<4>(ksT + (32 * di + r32) * 72 + hi * 8, vT + r32 * 72 + hi * 8, accS);
#pragma unroll
      for (int r = 0; r < 16; ++r) ST[r32 * 72 + 32 * di + crow(r, hi)] = f2bf(accS[r]);
    }
    __syncthreads();
  }
}

__device__ __forceinline__ void ph_merge(const P& p, int e) {
  const int tid = TIDX(), wid = tid >> 6, lane = tid & 63;
  const bf16_t* DNO = (const bf16_t*)(p.ws + OFF_D + D_DNO); const bf16_t* GLAO = (const bf16_t*)(p.ws + OFF_D + D_GLAO);
  const bf16_t* P2 = (const bf16_t*)(p.ws + OFF_D + D_P2); bf16_t* hb = (bf16_t*)(p.ws + OFF_HBF);
  for (int R = BIDX() * 8 + wid; R < MROWS; R += GDIM() * 8) {
#pragma unroll
    for (int g = 0; g < 8; ++g) {
      const bf16_t* src = g < 4 ? DNO : GLAO; const int hc = (g & 3) * 128 + lane * 2;
      const unsigned a = *(const unsigned*)(src + (size_t)R * 512 + hc), bq = *(const unsigned*)(src + ((size_t)MROWS + R) * 512 + hc);
      const float v0 = bf2f((bf16_t)(a & 0xffff)) + bf2f((bf16_t)(bq & 0xffff)), v1 = bf2f((bf16_t)(a >> 16)) + bf2f((bf16_t)(bq >> 16));
      const float ss = wave_sum(v0 * v0 + v1 * v1);
      const float rs = rsqrtf(ss * (1.f / 128.f) + EPSF);
      const float* nw = g < 4 ? p.dn_norm + e * 128 : p.gla_norm + e * 128;
      const unsigned zz = *(const unsigned*)(P2 + (size_t)R * 2048 + (g < 4 ? 0 : 1536) + hc);
      const float z0 = bf2f((bf16_t)(zz & 0xffff)), z1 = bf2f((bf16_t)(zz >> 16));
      const float o0 = v0 * rs * nw[lane * 2] * siluf(z0), o1 = v1 * rs * nw[lane * 2 + 1] * siluf(z1);
      *(unsigned*)(hb + (size_t)R * 1024 + g * 128 + lane * 2) = cvtpk(o0, o1);
    }
  }
}

__device__ __forceinline__ void ph_ffnact(const P& p, int L) {
  bf16_t* U = (bf16_t*)(p.ws + OFF_D);
  const float* cw = p.ffn_conv + (size_t)L * 3 * DFF;
  const size_t items = (size_t)MROWS * 352;
  for (size_t it = (size_t)BIDX() * 512 + TIDX(); it < items; it += (size_t)GDIM() * 512) {
    const int R = (int)(it / 352), c0 = (int)(it % 352) * 8; const int b = R >= TB ? 1 : 0, pp = R - b * TB;
    const bool hasp = !(pp == 0 || pp == CTXL), hasn = !(pp == CTXL - 1 || pp == TB - 1);
    const bf16x8 zc = *(const bf16x8*)(U + (size_t)R * 5632 + c0); bf16x8 zp = {}, zn = {};
    if (hasp) zp = *(const bf16x8*)(U + (size_t)(R - 1) * 5632 + c0);
    if (hasn) zn = *(const bf16x8*)(U + (size_t)(R + 1) * 5632 + c0);
    const bf16x8 vv = *(const bf16x8*)(U + (size_t)R * 5632 + DFF + c0);
    float o[8];
#pragma unroll
    for (int j = 0; j < 8; ++j) { const float a = bf2f((bf16_t)zp[j]) * cw[c0 + j] + bf2f((bf16_t)zc[j]) * cw[DFF + c0 + j] + bf2f((bf16_t)zn[j]) * cw[2 * DFF + c0 + j];
      o[j] = siluf(a) * bf2f((bf16_t)vv[j]); }
    u32x4 w = {cvtpk(o[0], o[1]), cvtpk(o[2], o[3]), cvtpk(o[4], o[5]), cvtpk(o[6], o[7])};
    *(u32x4*)(U + (size_t)R * 5632 + DFF + c0) = w;
  }
}

__device__ __forceinline__ void ph_qknorm(const P& p, int o) {
  const int tid = TIDX(), wid = tid >> 6, lane = tid & 63;
  bf16_t* QKV = (bf16_t*)(p.ws + OFF_D);
  const float* qn = p.att_q_norm + o * 128; const float* kn = p.att_k_norm + o * 128;
  const float invf = powf(10000.f, -(float)(lane & 31) / 32.f);
  for (int R = BIDX() * 8 + wid; R < MROWS; R += GDIM() * 8) {
    const int b = R >= TB ? 1 : 0, pp = R - b * TB; const bool lat = pp >= CTXL; const int t = pp - CTXL;
    float cr = 1.f, sr = 0.f, cc = 1.f, sn = 0.f;
    if (lat) { const float ar = (float)(t >> 6) * invf, ac = (float)(t & 63) * invf; cr = cosf(ar); sr = sinf(ar); cc = cosf(ac); sn = sinf(ac); }
    for (int hd = 0; hd < 10; ++hd) {
      bf16_t* base = QKV + (size_t)R * 1536 + hd * 128; const float* nw = hd < 8 ? qn : kn;
      float v0 = bf2f(base[lane]), v1 = bf2f(base[64 + lane]);
      const float ss = wave_sum(v0 * v0 + v1 * v1); const float rs = rsqrtf(ss * (1.f / 128.f) + EPSF);
      v0 = v0 * rs * nw[lane]; v1 = v1 * rs * nw[64 + lane];
      const float p0 = __shfl_xor(v0, 32), p1 = __shfl_xor(v1, 32);
      float o0, o1;
      if (lane < 32) { o0 = v0 * cr - p0 * sr; o1 = v1 * cc - p1 * sn; } else { o0 = p0 * sr + v0 * cr; o1 = p1 * sn + v1 * cc; }
      base[lane] = f2bf(o0); base[64 + lane] = f2bf(o1);
    }
  }
}

namespace at {
constexpr int D = 128, NW = 8, QBLK = 32, KVBLK = 64;
constexpr float SCALE = 0.088388347648318440f, THR = 8.f;
constexpr int LDQ = 1536, LDK = 1536, LDO = 1024;
constexpr size_t SHM_V = KVBLK * D * 2, SHM_K = KVBLK * D * 2;
#define KSWZ(row, colB) ((row) * 256 + ((colB) ^ (((row) & 7) << 4)))
#define SBAR() __builtin_amdgcn_sched_barrier(0)
DI void partialSM(f32x16& p0, f32x16& p1, float& m_reg, float& mn, float& alpha) {
  constexpr float C = SCALE * 1.4426950408889634f;
  float pmax = p0[0]; for (int r = 1; r < 16; ++r) pmax = fmaxf(pmax, p0[r]); for (int r = 0; r < 16; ++r) pmax = fmaxf(pmax, p1[r]);
  { auto rr = __builtin_amdgcn_permlane32_swap(__float_as_uint(pmax), __float_as_uint(pmax), false, false);
    pmax = fmaxf(__uint_as_float(rr[0]), __uint_as_float(rr[1])); }
  if (__builtin_expect(__all(pmax - m_reg <= THR / SCALE), 1)) { mn = m_reg; alpha = 1.f; }
  else { mn = fmaxf(m_reg, pmax); alpha = __builtin_amdgcn_exp2f((m_reg - mn) * C); m_reg = mn; }
  float mnC = -mn * C;
  for (int r = 0; r < 16; ++r) p0[r] = fmaf(p0[r], C, mnC); for (int r = 0; r < 16; ++r) p1[r] = fmaf(p1[r], C, mnC);
  for (int r = 0; r < 16; ++r) p0[r] = __builtin_amdgcn_exp2f(p0[r]);
}
DI void finishSM(f32x16& p0, f32x16& p1, float alpha, float& l_reg, bf16x8& pa0, bf16x8& pa1, bf16x8& pa2, bf16x8& pa3) {
  for (int r = 0; r < 16; ++r) p1[r] = __builtin_amdgcn_exp2f(p1[r]);
  float ps = 0; for (int r = 0; r < 16; ++r) ps += p0[r]; for (int r = 0; r < 16; ++r) ps += p1[r];
  { auto rr = __builtin_amdgcn_permlane32_swap(__float_as_uint(ps), __float_as_uint(ps), false, false);
    ps = __uint_as_float(rr[0]) + __uint_as_float(rr[1]); }
  l_reg = l_reg * alpha + ps;
#define PK4(PP, BASE, OUT) do { unsigned a0 = cvtpk(PP[BASE + 0], PP[BASE + 1]), a1 = cvtpk(PP[BASE + 2], PP[BASE + 3]);   \
    unsigned b0 = cvtpk(PP[BASE + 4], PP[BASE + 5]), b1 = cvtpk(PP[BASE + 6], PP[BASE + 7]);                              \
    auto r0 = __builtin_amdgcn_permlane32_swap(a0, b0, false, false); auto r1 = __builtin_amdgcn_permlane32_swap(a1, b1, false, false); \
    u32x4 w = {r0[0], r1[0], r0[1], r1[1]}; OUT = *reinterpret_cast<bf16x8*>(&w); } while (0)
  PK4(p0, 0, pa0); PK4(p0, 8, pa1); PK4(p1, 0, pa2); PK4(p1, 8, pa3);
#undef PK4
}
DI void qkt(f32x16& p0, f32x16& p1, const bf16_t* Ks, const bf16x8* qr, int r32, int hi) {
  p0 = f32x16{}; p1 = f32x16{};
  for (int d0 = 0; d0 < 8; ++d0) { int cb = (d0 * 16 + hi * 8) * 2;
    bf16x8 b0 = *reinterpret_cast<const bf16x8*>((const char*)Ks + KSWZ(r32, cb));
    bf16x8 b1 = *reinterpret_cast<const bf16x8*>((const char*)Ks + KSWZ(32 + r32, cb));
    p0 = MFMA32(b0, qr[d0], p0);
    p1 = MFMA32(b1, qr[d0], p1); }
}
DI int v_st(int k, int c) { const int kk = (k & ~0xC) | ((k & 4) << 1) | ((k & 8) >> 1); return ((kk >> 3) * 4 + (c >> 5)) * 512 + ((kk & 7) * 32 + (c & 31)) * 2; }
DI int v_rd_base(int lane) { return ((lane & 3) << 3) | (((lane >> 2) & 3) << 6) | (((lane >> 4) & 1) << 5) | (((lane >> 5) & 1) << 8); }
constexpr int v_rd_off(int d0, int ks, int half) { return d0 * 512 + ks * 4096 + half * 2048; }
template <int OFF> DI s16x4 tr_read(int vb) {
  s16x4 r; asm volatile("ds_read_b64_tr_b16 %0, %1 offset:%2" : "=&v"(r) : "v"(vb), "i"(OFF) : "memory"); return r;
}
template <int D0> DI void pv_one(f32x16& od, int vb, bf16x8 pa0, bf16x8 pa1, bf16x8 pa2, bf16x8 pa3) {
  const s16x4 l0 = tr_read<v_rd_off(D0, 0, 0)>(vb), h0 = tr_read<v_rd_off(D0, 0, 1)>(vb), l1 = tr_read<v_rd_off(D0, 1, 0)>(vb), h1 = tr_read<v_rd_off(D0, 1, 1)>(vb);
  const s16x4 l2 = tr_read<v_rd_off(D0, 2, 0)>(vb), h2 = tr_read<v_rd_off(D0, 2, 1)>(vb), l3 = tr_read<v_rd_off(D0, 3, 0)>(vb), h3 = tr_read<v_rd_off(D0, 3, 1)>(vb);
  asm volatile("s_waitcnt lgkmcnt(0)" ::: "memory"); SBAR();
#define PK(Lx, Hx) (bf16x8){Lx[0], Lx[1], Lx[2], Lx[3], Hx[0], Hx[1], Hx[2], Hx[3]}
  od = MFMA32(pa0, PK(l0, h0), od);
  od = MFMA32(pa1, PK(l1, h1), od);
  od = MFMA32(pa2, PK(l2, h2), od);
  od = MFMA32(pa3, PK(l3, h3), od);
#undef PK
}
DI void pv_d0(f32x16* o, int vb, bf16x8 pa0, bf16x8 pa1, bf16x8 pa2, bf16x8 pa3) {
  pv_one<0>(o[0], vb, pa0, pa1, pa2, pa3); pv_one<1>(o[1], vb, pa0, pa1, pa2, pa3); pv_one<2>(o[2], vb, pa0, pa1, pa2, pa3); pv_one<3>(o[3], vb, pa0, pa1, pa2, pa3);
}
DI void attn_dense_body(const bf16_t* __restrict__ Qb, const bf16_t* __restrict__ Kh, const bf16_t* __restrict__ Vh, bf16_t* __restrict__ Ob, int seq, char* lds) {
  const int tid = TIDX(), wid = tid >> 6, lane = tid & 63, r32 = lane & 31, hi = lane >> 5;
  bf16_t* V_lds = (bf16_t*)lds; bf16_t* K_lds = (bf16_t*)(lds + 2 * SHM_V);
  float* ws = (float*)(lds + 2 * SHM_V + 2 * SHM_K) + wid * 64; float* li_l = ws; float* al_l = ws + 32;
  float m_reg = -1e30f, l_reg = 0; f32x16 o[4] = {}; bf16x8 qr[8];
  const bf16_t* Qw = Qb + (long)(wid * QBLK + r32) * LDQ + hi * 8;
#pragma unroll
  for (int d0 = 0; d0 < 8; ++d0) qr[d0] = *reinterpret_cast<const bf16x8*>(Qw + d0 * 16);
  const int sr = tid >> 4, sc = (tid & 15) * 8, vst0 = v_st(sr, sc), vst1 = v_st(32 + sr, sc);
  const int vb0 = (int)(uintptr_t)V_lds + v_rd_base(lane);
  struct { bf16x8 vs0, vs1, ks0, ks1; } sr_[2];
#define SLOAD(i, k0) do { sr_[i].vs0 = *(const bf16x8*)(&Vh[(long)((k0) + sr) * LDK + sc]); sr_[i].vs1 = *(const bf16x8*)(&Vh[(long)((k0) + 32 + sr) * LDK + sc]); \
    sr_[i].ks0 = *(const bf16x8*)(&Kh[(long)((k0) + sr) * LDK + sc]); sr_[i].ks1 = *(const bf16x8*)(&Kh[(long)((k0) + 32 + sr) * LDK + sc]); } while (0)
#define SWRITE(bq, i) do { *(bf16x8*)((char*)V_lds + (bq) * SHM_V + vst0) = sr_[i].vs0;          \
    *(bf16x8*)((char*)V_lds + (bq) * SHM_V + vst1) = sr_[i].vs1; int kc = sc * 2;               \
    *(bf16x8*)((char*)K_lds + (bq) * SHM_K + KSWZ(sr, kc)) = sr_[i].ks0;                       \
    *(bf16x8*)((char*)K_lds + (bq) * SHM_K + KSWZ(32 + sr, kc)) = sr_[i].ks1; } while (0)
#define SWAIT() asm volatile("s_waitcnt vmcnt(4)" ::: "memory")
#define RESC(a) do { if (__any((a) < 1.f)) { if (hi == 0) al_l[r32] = (a); asm volatile("s_waitcnt lgkmcnt(0)" ::: "memory"); \
    for (int d = 0; d < 4; ++d) for (int r = 0; r < 16; ++r) o[d][r] *= al_l[crow(r, hi)]; } } while (0)
  f32x16 pA0, pA1, pB0, pB1; float mnA, mnB, alA, alB; bf16x8 pa0, pa1, pa2, pa3; const int NT = seq / KVBLK;
  constexpr int SE = 0, SO = 1;
  SLOAD(SE, 0); asm volatile("s_waitcnt vmcnt(0)" ::: "memory"); SWRITE(0, SE); __syncthreads();
  qkt(pA0, pA1, K_lds, qr, r32, hi); partialSM(pA0, pA1, m_reg, mnA, alA);
  SLOAD(SO, KVBLK); if (2 < NT) SLOAD(SE, 2 * KVBLK);
  SWAIT(); SWRITE(1, SO); __syncthreads();
  for (int j = 1; j + 1 < NT; j += 2) {
    SBAR(); qkt(pB0, pB1, (bf16_t*)((char*)K_lds + SHM_K), qr, r32, hi);
    finishSM(pA0, pA1, alA, l_reg, pa0, pa1, pa2, pa3); SBAR();
    SLOAD(SO, (j + 2) * KVBLK); SBAR();
    pv_d0(o, vb0, pa0, pa1, pa2, pa3); partialSM(pB0, pB1, m_reg, mnB, alB);
    __syncthreads(); SWAIT(); SWRITE(0, SE);
    RESC(alB); __syncthreads();
    SBAR(); qkt(pA0, pA1, K_lds, qr, r32, hi);
    finishSM(pB0, pB1, alB, l_reg, pa0, pa1, pa2, pa3); SBAR();
    if (j + 3 < NT) SLOAD(SE, (j + 3) * KVBLK); SBAR();
    pv_d0(o, vb0 + (int)SHM_V, pa0, pa1, pa2, pa3); partialSM(pA0, pA1, m_reg, mnA, alA);
    __syncthreads(); SWAIT(); SWRITE(1, SO);
    RESC(alA); __syncthreads();
  }
  SBAR(); qkt(pB0, pB1, (bf16_t*)((char*)K_lds + SHM_K), qr, r32, hi);
  finishSM(pA0, pA1, alA, l_reg, pa0, pa1, pa2, pa3); SBAR();
  pv_d0(o, vb0, pa0, pa1, pa2, pa3); partialSM(pB0, pB1, m_reg, mnB, alB);
  __syncthreads(); RESC(alB);
  finishSM(pB0, pB1, alB, l_reg, pa0, pa1, pa2, pa3); SBAR();
  pv_d0(o, vb0 + (int)SHM_V, pa0, pa1, pa2, pa3);
  if (hi == 0) li_l[r32] = l_reg; asm volatile("s_waitcnt lgkmcnt(0)" ::: "memory");
  float rli[16];
#pragma unroll
  for (int r = 0; r < 16; ++r) rli[r] = __builtin_amdgcn_rcpf(li_l[crow(r, hi)]);
  bf16_t* Ow = Ob + (long)(wid * QBLK) * LDO;
#pragma unroll
  for (int r = 0; r < 16; ++r) { int orow = crow(r, hi);
    for (int d0 = 0; d0 < 4; ++d0) Ow[(long)orow * LDO + d0 * 32 + r32] = f2bf(o[d0][r] * rli[r]); }
#undef SLOAD
#undef SWRITE
#undef SWAIT
#undef RESC
}
}

__device__ __forceinline__ void ph_attn(const P& p, char* lds, bool need_ctx) {
  const bf16_t* QKV = (const bf16_t*)(p.ws + OFF_D); bf16_t* hb = (bf16_t*)(p.ws + OFF_HBF);
  const int nunits = need_ctx ? 528 : 512;
  for (int u = BIDX(); u < nunits; u += GDIM()) {
    int b, h, seq; size_t qrow;
    if (u < 512) { b = u >> 8; const int rem = u & 255; h = rem >> 5; qrow = (size_t)b * TB + CTXL + (size_t)(rem & 31) * 256; seq = TB; }
    else { const int uu = u - 512; b = uu >> 3; h = uu & 7; qrow = (size_t)b * TB; seq = CTXL; }
    const int kvh = h >> 2;
    const bf16_t* Kh = QKV + (size_t)b * TB * 1536 + 1024 + kvh * 128;
    const bf16_t* Vh = QKV + (size_t)b * TB * 1536 + 1280 + kvh * 128;
    at::attn_dense_body(QKV + qrow * 1536 + h * 128, Kh, Vh, hb + qrow * 1024 + h * 128, seq, lds);
    __syncthreads();
  }
}

__device__ __forceinline__ void ph_final(const P& p) {
  const int tid = TIDX(), wid = tid >> 6, lane = tid & 63;
  const float* xr = (const float*)(p.ws + OFF_XRES);
  for (int q = BIDX() * 8 + wid; q < 2 * LAT; q += GDIM() * 8) {
    const int b = q >> 13, t = q & (LAT - 1); const float* row = xr + ((size_t)b * TB + CTXL + t) * 1024;
    f32x4 v[4]; float ss = 0.f;
#pragma unroll
    for (int i = 0; i < 4; ++i) { v[i] = *(const f32x4*)(row + i * 256 + lane * 4); ss += v[i][0] * v[i][0] + v[i][1] * v[i][1] + v[i][2] * v[i][2] + v[i][3] * v[i][3]; }
    ss = wave_sum(ss); const float rs = rsqrtf(ss * (1.f / 1024.f) + EPSF);
#pragma unroll
    for (int i = 0; i < 4; ++i) { const int c0 = i * 256 + lane * 4; const f32x4 g = *(const f32x4*)(p.final_norm + c0); f32x4 o = v[i] * rs * g; *(f32x4*)(p.out + (size_t)q * 1024 + c0) = o; }
  }
}

constexpr int NPHASES = 42;
#ifndef ONLY_PH
#define ONLY_PH -1
#endif
#define EN(x) (ONLY_PH < 0 || ONLY_PH == (x))
__device__ __forceinline__ void run_phase(const P& p0, int ph, char* lds) {
  P p = p0; asm volatile("" : "+s"(p.ws));
  if (ph == 0) { if (EN(0)) ph_init(p, lds); return; }
  if (ph == NPHASES - 1) { if (EN(11)) ph_final(p); return; }
  const int q = ph - 1; int L, sub;
  if (q < 11) { L = 0; sub = q; } else if (q < 20) { L = 1; sub = q - 11; } else if (q < 31) { L = 2; sub = q - 20; } else { L = 3; sub = q - 31; }
  const bool even = (L & 1) == 0; const int e = L >> 1;
  bf16_t* W1 = (bf16_t*)(p.ws + OFF_WC); bf16_t* W2 = (bf16_t*)(p.ws + OFF_WC + WC_W2);
  bf16_t* hb = (bf16_t*)(p.ws + OFF_HBF); float* xr = (float*)(p.ws + OFF_XRES);
  const float* mods = (const float*)(p.ws + OFF_MODS) + (size_t)L * 3 * 6144;
  int fs = even ? sub - 7 : sub - 5;
  if (fs >= 0) {
    if (fs == 0) { if (EN(1)) { ph_norm(p, L, 1); cvt_weight(p.ffn_w_up + (size_t)L * 1024 * 5632, W1, 1024, 5632, 5632, false); cvt_weight(p.ffn_w_down + (size_t)L * DFF * 1024, W2, DFF, 1024, 1024, false); } }
    else if (fs == 1) { if (EN(2)) gemm_phase(lds, hb, 1024, W1, 1024, 44, EpiBf{(bf16_t*)(p.ws + OFF_D), 5632}); }
    else if (fs == 2) { if (EN(8)) ph_ffnact(p, L); }
    else { if (EN(2)) gemm_phase(lds, (const bf16_t*)(p.ws + OFF_D) + DFF, 5632, W2, DFF, 8, EpiRes{xr, mods + 5 * 1024}); }
    return;
  }
  if (even) {
    switch (sub) {
      case 0: if (EN(1)) { ph_norm(p, L, 0); cvt_weight(p.rec_w_in + (size_t)e * 1024 * 3632, W1, 1024, 3632, NREC, true); cvt_weight(p.rec_w_out + (size_t)e * 1024 * 1024, W2, 1024, 1024, 1024, false); } break;
      case 1: if (EN(2)) gemm_phase(lds, hb, 1024, W1, 1024, NREC / 128, EpiRec{(bf16_t*)(p.ws + OFF_D + D_P1), (bf16_t*)(p.ws + OFF_D + D_P2), (float*)(p.ws + OFF_SM)}); break;
      case 2: if (EN(3)) ph_dnprep(p, lds, e); break;
      case 3: if (EN(4)) ph_dn_d1(p, lds); break;
      case 4: if (BIDX() < 64) { if (EN(5)) dn_scan(p, lds, BIDX()); } else if (BIDX() < 128) { if (EN(6)) gla_scan(p, lds, BIDX() - 64, e); } break;
      case 5: if (EN(7)) ph_merge(p, e); break;
      case 6: if (EN(2)) gemm_phase(lds, hb, 1024, W2, 1024, 8, EpiRes{xr, mods + 2 * 1024}); break;
    }
  } else {
    const int o = L >> 1;
    switch (sub) {
      case 0: if (EN(1)) { ph_norm(p, L, 0); cvt_weight(p.att_w_qkv + (size_t)o * 1024 * 1536, W1, 1024, 1536, 1536, false); cvt_weight(p.att_w_out + (size_t)o * 1024 * 1024, W2, 1024, 1024, 1024, false); } break;
      case 1: if (EN(2)) gemm_phase(lds, hb, 1024, W1, 1024, 12, EpiBf{(bf16_t*)(p.ws + OFF_D), 1536}); break;
      case 2: if (EN(9)) ph_qknorm(p, o); break;
      case 3: if (EN(10)) ph_attn(p, lds, L != 3); break;
      case 4: if (EN(2)) gemm_phase(lds, hb, 1024, W2, 1024, 8, EpiRes{xr, mods + 2 * 1024}); break;
    }
  }
}

template <bool COOP>
__global__ void __launch_bounds__(512, 1) mk_kernel(P p, int ph0, int ph1) {
  extern __shared__ __attribute__((aligned(16))) char smem[];
  for (int ph = ph0; ph < ph1; ++ph) {
    run_phase(p, ph, smem);
    if constexpr (COOP) { if (ph + 1 < ph1) cg::this_grid().sync(); }
  }
}

extern "C" void kernel_launch(void* const* d_in, const int* in_sizes, int n_in, void* d_out, int out_size, void* d_ws, size_t ws_size, hipStream_t stream) {
  if (n_in != 23 || ws_size < WS_NEED) { fprintf(stderr, "kernel_launch: bad n_in %d or ws %zu < %zu\n", n_in, ws_size, (size_t)WS_NEED); return; }
  P p{};
  const float** f = (const float**)&p;
  for (int i = 0; i < 23; ++i) f[i] = (const float*)d_in[i];
  p.out = (float*)d_out; p.ws = (char*)d_ws;
  static int inited = 0, grid_blocks = 0;
  if (!inited) {
    hipFuncSetAttribute((const void*)mk_kernel<true>, hipFuncAttributeMaxDynamicSharedMemorySize, LDS_BYTES);
    hipFuncSetAttribute((const void*)mk_kernel<false>, hipFuncAttributeMaxDynamicSharedMemorySize, LDS_BYTES);
    int dev = 0, cus = 0, per_cu = 0;
    hipGetDevice(&dev); hipDeviceGetAttribute(&cus, hipDeviceAttributeMultiprocessorCount, dev);
    hipOccupancyMaxActiveBlocksPerMultiprocessor(&per_cu, mk_kernel<true>, 512, LDS_BYTES);
    if (per_cu > 1) per_cu = 1;
    grid_blocks = cus * per_cu; if (grid_blocks > 256) grid_blocks = 256; if (grid_blocks < 128) grid_blocks = 128;
    inited = 1;
  }
#if MK_COOP
  int ph0 = 0, ph1 = NPHASES;
  void* args[] = {&p, &ph0, &ph1};
  hipError_t er = hipLaunchCooperativeKernel((const void*)mk_kernel<true>, dim3(grid_blocks), dim3(512), args, LDS_BYTES, stream);
  if (er != hipSuccess) fprintf(stderr, "cooperative launch failed: %s (grid %d)\n", hipGetErrorString(er), grid_blocks);
#else
  for (int ph = 0; ph < NPHASES; ++ph) hipLaunchKernelGGL(mk_kernel<false>, dim3(256), dim3(512), LDS_BYTES, stream, p, ph, ph + 1);
#endif
}
```

```cpp
#include <hip/hip_runtime.h>
#include <hip/hip_cooperative_groups.h>
#include <cstdio>
#include <cstdint>
namespace cg = cooperative_groups;

#ifndef MK_COOP
#define MK_COOP 1
#endif

typedef unsigned short bf16_t;
typedef short bf16x8 __attribute__((ext_vector_type(8)));
typedef short s16x4 __attribute__((ext_vector_type(4)));
typedef float f32x16 __attribute__((ext_vector_type(16)));
typedef float f32x8 __attribute__((ext_vector_type(8)));
typedef float f32x4 __attribute__((ext_vector_type(4)));
typedef unsigned u32x4 __attribute__((ext_vector_type(4)));
#define DI __device__ __forceinline__
#define MFMA32(a, b, c) __builtin_amdgcn_mfma_f32_32x32x16_bf16((a), (b), (c), 0, 0, 0)

constexpr int DM = 1024, TB = 8448, CTXL = 256, LAT = 8192, MROWS = 2 * TB;
constexpr int NCH = 132;
constexpr int DFF = 2816;
constexpr int NREC = 3712;
constexpr float EPSF = 1e-6f;

constexpr size_t AL(size_t x) { return (x + 255) / 256 * 256; }
constexpr size_t OFF_XRES = 0;
constexpr size_t OFF_HBF = OFF_XRES + AL((size_t)MROWS * DM * 4);
constexpr size_t OFF_WC = OFF_HBF + AL((size_t)MROWS * DM * 2);
constexpr size_t WC_W2 = (size_t)5632 * 1024 * 2;
constexpr size_t OFF_MODS = OFF_WC + AL(WC_W2 + (size_t)1024 * 2816 * 2);
constexpr size_t OFF_SM = OFF_MODS + AL((size_t)4 * 3 * 6144 * 4);
constexpr size_t OFF_GB = OFF_SM + AL((size_t)MROWS * 64 * 4);
constexpr size_t OFF_SC = OFF_GB + AL((size_t)MROWS * 16 * 4);
constexpr size_t OFF_GL = OFF_SC + AL((size_t)16 * NCH * 64 * 2 * 4);
constexpr size_t OFF_D = OFF_GL + AL((size_t)16 * NCH * 4);
constexpr size_t D_P1 = 0;
constexpr size_t D_W = 0;
constexpr size_t D_INTRA = D_W + (size_t)16 * NCH * 64 * 128 * 2;
constexpr size_t D_P2 = D_P1 + (size_t)MROWS * 1536 * 2;
constexpr size_t D_QQ = D_P2 + (size_t)MROWS * 2048 * 2;
constexpr size_t D_QK = D_QQ + (size_t)MROWS * 512 * 2;
constexpr size_t D_QV = D_QK + (size_t)MROWS * 512 * 2;
constexpr size_t D_DNO = D_QK;
constexpr size_t D_KT = D_QV + (size_t)MROWS * 512 * 2;
constexpr size_t D_GLAO = D_KT + (size_t)MROWS * 512 * 2;
constexpr size_t D_END_E = D_GLAO + (size_t)2 * MROWS * 512 * 2;
constexpr size_t D_END_F = (size_t)MROWS * 5632 * 2;
constexpr size_t WS_NEED = OFF_D + (D_END_E > D_END_F ? D_END_E : D_END_F);
constexpr int LDS_BYTES = 112 * 1024;

struct P {
  const float *x, *c, *ctx, *c_ctx, *mod_w, *mod_b, *rec_w_in, *rec_conv, *dn_a_log, *dn_dt_bias, *dn_norm, *gla_w2, *gla_b2, *gla_norm,
      *rec_w_out, *att_w_qkv, *att_q_norm, *att_k_norm, *att_w_out, *ffn_w_up, *ffn_conv, *ffn_w_down, *final_norm;
  float* out;
  char* ws;
};

DI int TIDX() { int t = threadIdx.x; asm volatile("" : "+v"(t)); return t; }
DI int BIDX() { int t = blockIdx.x; asm volatile("" : "+s"(t)); return t; }
DI int GDIM() { int t = gridDim.x; asm volatile("" : "+s"(t)); return t; }
DI float bf2f(bf16_t v) { return __uint_as_float(((unsigned)v) << 16); }
DI bf16_t f2bf(float x) { unsigned u = __float_as_uint(x); u += 0x7fffu + ((u >> 16) & 1u); return (bf16_t)(u >> 16); }
DI unsigned cvtpk(float lo, float hi) { unsigned r; asm volatile("v_cvt_pk_bf16_f32 %0, %1, %2" : "=v"(r) : "v"(lo), "v"(hi)); return r; }
DI int crow(int r, int hi) { return (r & 3) + 8 * (r >> 2) + 4 * hi; }
DI float siluf(float x) { return x / (1.f + expf(-x)); }
DI float sigmf(float x) { return 1.f / (1.f + expf(-x)); }
DI float softplusf(float x) { return fmaxf(x, 0.f) + log1pf(expf(-fabsf(x))); }
DI float wave_sum(float v) {
#pragma unroll
  for (int o = 32; o > 0; o >>= 1) v += __shfl_xor(v, o);
  return v;
}
DI int modrow_of(int R) { const int b = R >= TB ? 1 : 0; const int pp = R - b * TB; return pp < CTXL ? 2 : b; }
template <int KS>
DI f32x16 mma_rows(const bf16_t* arow, const bf16_t* brow, f32x16 acc) {
#pragma unroll
  for (int ks = 0; ks < KS; ++ks) {
    const bf16x8 a = *reinterpret_cast<const bf16x8*>(arow + ks * 16);
    const bf16x8 b = *reinterpret_cast<const bf16x8*>(brow + ks * 16);
    acc = MFMA32(a, b, acc);
  }
  return acc;
}

__device__ __forceinline__ void ph_init(const P& p, char* lds) {
  const int tid = TIDX();
  float* sc = (float*)lds;
  float* red = sc + 3072;
  for (int i = tid; i < 3072; i += 512) { const int r = i >> 10, k = i & 1023; const float v = r < 2 ? p.c[r * 1024 + k] : p.c_ctx[k]; sc[i] = siluf(v); }
  __syncthreads();
  float* mods = (float*)(p.ws + OFF_MODS);
  for (int job = BIDX(); job < 192; job += GDIM()) {
    const int col = job * 128 + (tid & 127), kq = tid >> 7;
    const int L = col / 6144, cl = col - L * 6144;
    const float* w = p.mod_w + ((size_t)L * 1024 + kq * 256) * 6144 + cl;
    float a0 = 0.f, a1 = 0.f, a2 = 0.f;
#pragma unroll 8
    for (int k = 0; k < 256; ++k) { const float wv = w[(size_t)k * 6144]; const int kk = kq * 256 + k; a0 += sc[kk] * wv; a1 += sc[1024 + kk] * wv; a2 += sc[2048 + kk] * wv; }
    red[(kq * 3 + 0) * 128 + (tid & 127)] = a0; red[(kq * 3 + 1) * 128 + (tid & 127)] = a1; red[(kq * 3 + 2) * 128 + (tid & 127)] = a2;
    __syncthreads();
    if (tid < 384) { const int r = tid >> 7, cc = tid & 127; const int c2 = job * 128 + cc; const int L2 = c2 / 6144, cl2 = c2 - L2 * 6144;
      const float s = red[(0 * 3 + r) * 128 + cc] + red[(1 * 3 + r) * 128 + cc] + red[(2 * 3 + r) * 128 + cc] + red[(3 * 3 + r) * 128 + cc] + p.mod_b[L2 * 6144 + cl2];
      mods[((size_t)L2 * 3 + r) * 6144 + cl2] = s; }
    __syncthreads();
  }
  f32x4* xr = (f32x4*)(p.ws + OFF_XRES);
  for (size_t i = (size_t)BIDX() * 512 + tid; i < (size_t)MROWS * 256; i += (size_t)GDIM() * 512) {
    const int R = (int)(i >> 8), c4 = (int)(i & 255); const int b = R >= TB ? 1 : 0, pp = R - b * TB;
    const float* src = pp < CTXL ? p.ctx + ((size_t)b * CTXL + pp) * 1024 : p.x + ((size_t)b * LAT + (pp - CTXL)) * 1024;
    xr[i] = *(const f32x4*)(src + c4 * 4);
  }
}

DI int rec_src_col(int n) { if (n < 2048) return n; if (n < 3584) return n + 16; if (n < 3600) return 2048 + (n - 3584); if (n < 3632) return n; return -1; }
__device__ __forceinline__ void cvt_weight(const float* __restrict__ W, bf16_t* __restrict__ Wt, int K, int Nsrc, int Npad, bool perm) {
  const size_t items = (size_t)Npad * (K >> 3);
  for (size_t it = (size_t)BIDX() * 512 + TIDX(); it < items; it += (size_t)GDIM() * 512) {
    const int n = (int)(it % Npad), kb = (int)(it / Npad);
    const int s = perm ? rec_src_col(n) : n;
    float v[8];
#pragma unroll
    for (int j = 0; j < 8; ++j) v[j] = s >= 0 ? W[(size_t)(kb * 8 + j) * Nsrc + s] : 0.f;
    u32x4 w = {cvtpk(v[0], v[1]), cvtpk(v[2], v[3]), cvtpk(v[4], v[5]), cvtpk(v[6], v[7])};
    *(u32x4*)(Wt + (size_t)n * K + kb * 8) = w;
  }
}

__device__ __forceinline__ void ph_norm(const P& p, int L, int which) {
  const int tid = TIDX(), wid = tid >> 6, lane = tid & 63;
  const float* xr = (const float*)(p.ws + OFF_XRES);
  bf16_t* hb = (bf16_t*)(p.ws + OFF_HBF);
  const float* mods = (const float*)(p.ws + OFF_MODS) + (size_t)L * 3 * 6144;
  for (int R = BIDX() * 8 + wid; R < MROWS; R += GDIM() * 8) {
    const float* row = xr + (size_t)R * 1024;
    f32x4 v[4]; float ss = 0.f;
#pragma unroll
    for (int i = 0; i < 4; ++i) { v[i] = *(const f32x4*)(row + i * 256 + lane * 4); ss += v[i][0] * v[i][0] + v[i][1] * v[i][1] + v[i][2] * v[i][2] + v[i][3] * v[i][3]; }
    ss = wave_sum(ss);
    const float rs = rsqrtf(ss * (1.f / 1024.f) + EPSF);
    const float* mr = mods + (size_t)modrow_of(R) * 6144 + which * 3072;
#pragma unroll
    for (int i = 0; i < 4; ++i) { const int c0 = i * 256 + lane * 4; const f32x4 sh = *(const f32x4*)(mr + c0), scl = *(const f32x4*)(mr + 1024 + c0);
      float o[4];
#pragma unroll
      for (int j = 0; j < 4; ++j) o[j] = v[i][j] * rs * (1.f + scl[j]) + sh[j];
      uint2 w; w.x = cvtpk(o[0], o[1]); w.y = cvtpk(o[2], o[3]);
      *(uint2*)(hb + (size_t)R * 1024 + c0) = w; }
  }
}

struct EpiRec { bf16_t* P1; bf16_t* P2; float* SM;
  DI void operator()(int row, int col, float v) const {
    if (col < 1536) P1[(size_t)row * 1536 + col] = f2bf(v);
    else if (col < 3584) P2[(size_t)row * 2048 + (col - 1536)] = f2bf(v);
    else { const int lc = col - 3584; if (lc < 48) SM[(size_t)row * 64 + lc] = v; } } };
struct EpiBf { bf16_t* O; int ldc;
  DI void operator()(int row, int col, float v) const { O[(size_t)row * ldc + col] = f2bf(v); } };
struct EpiRes { float* X; const float* gate;
  DI void operator()(int row, int col, float v) const { float* q = X + (size_t)row * 1024 + col; *q = *q + gate[(size_t)modrow_of(row) * 6144 + col] * v; } };

template <class Epi>
__device__ __forceinline__ void gemm_phase(char* lds, const bf16_t* __restrict__ A, int lda, const bf16_t* __restrict__ Bt, int K, int nN, const Epi epi) {
  const int tid = TIDX(), wid = tid >> 6, lane = tid & 63, r32 = lane & 31, hi = lane >> 5;
  const int wm = wid >> 1, wn = wid & 1;
  const int nk = K >> 6;
  constexpr int RS = 144, ASZ = 256 * RS, BSZ = 128 * RS, STG = ASZ + BSZ;
  const int ntiles = (MROWS / 256) * nN;
  const int srow = tid >> 3, spc = tid & 7;
  for (int t = BIDX(); t < ntiles; t += GDIM()) {
    const int pm = t / nN, pn = t - pm * nN;
    const bf16_t* Ab = A + (size_t)(pm * 256 + srow) * lda + spc * 8;
    const bf16_t* Bb = Bt + (size_t)(pn * 128 + srow) * K + spc * 8;
    f32x16 acc00 = {}, acc01 = {}, acc10 = {}, acc11 = {};
    bf16x8 ra0, ra1, ra2, ra3, rb0, rb1;
#define GLOAD(kt) do { const int ko = (kt) * 64; ra0 = *(const bf16x8*)(Ab + ko); ra1 = *(const bf16x8*)(Ab + (size_t)64 * lda + ko); ra2 = *(const bf16x8*)(Ab + (size_t)128 * lda + ko); \
    ra3 = *(const bf16x8*)(Ab + (size_t)192 * lda + ko); rb0 = *(const bf16x8*)(Bb + ko); rb1 = *(const bf16x8*)(Bb + (size_t)64 * K + ko); } while (0)
#define SWRITE(buf) do { char* sb = lds + (buf) * STG + srow * RS + spc * 16; *(bf16x8*)(sb) = ra0; *(bf16x8*)(sb + 64 * RS) = ra1; *(bf16x8*)(sb + 128 * RS) = ra2; *(bf16x8*)(sb + 192 * RS) = ra3; \
    *(bf16x8*)(sb + ASZ) = rb0; *(bf16x8*)(sb + ASZ + 64 * RS) = rb1; } while (0)
    GLOAD(0); SWRITE(0); __syncthreads();
    for (int kt = 0; kt < nk; ++kt) {
      const int cur = kt & 1;
      if (kt + 1 < nk) GLOAD(kt + 1);
      const char* ab = lds + cur * STG + (64 * wm + r32) * RS + hi * 16;
      const char* bb = lds + cur * STG + ASZ + (64 * wn + r32) * RS + hi * 16;
#pragma unroll
      for (int ks = 0; ks < 4; ++ks) {
        const bf16x8 a0 = *(const bf16x8*)(ab + ks * 32), a1 = *(const bf16x8*)(ab + 32 * RS + ks * 32);
        const bf16x8 b0 = *(const bf16x8*)(bb + ks * 32), b1 = *(const bf16x8*)(bb + 32 * RS + ks * 32);
        acc00 = MFMA32(a0, b0, acc00); acc01 = MFMA32(a0, b1, acc01); acc10 = MFMA32(a1, b0, acc10); acc11 = MFMA32(a1, b1, acc11);
      }
      if (kt + 1 < nk) SWRITE(cur ^ 1);
      __syncthreads();
    }
#undef GLOAD
#undef SWRITE
    const int row0 = pm * 256 + 64 * wm, col0 = pn * 128 + 64 * wn + r32;
#pragma unroll
    for (int r = 0; r < 16; ++r) { const int rr = row0 + crow(r, hi);
      epi(rr, col0, acc00[r]); epi(rr, col0 + 32, acc01[r]); epi(rr + 32, col0, acc10[r]); epi(rr + 32, col0 + 32, acc11[r]); }
  }
}

__device__ __forceinline__ void ph_dnprep(const P& p, char* lds, int e) {
  const int tid = TIDX(), wid = tid >> 6, lane = tid & 63;
  const bf16_t* P1 = (const bf16_t*)(p.ws + OFF_D + D_P1);
  bf16_t* QQ = (bf16_t*)(p.ws + OFF_D + D_QQ); bf16_t* QK = (bf16_t*)(p.ws + OFF_D + D_QK); bf16_t* QV = (bf16_t*)(p.ws + OFF_D + D_QV);
  bf16_t* KT = (bf16_t*)(p.ws + OFF_D + D_KT);
  const float* SM = (const float*)(p.ws + OFF_SM); float* GB = (float*)(p.ws + OFF_GB);
  const float* cw = p.rec_conv + (size_t)e * 3 * 1536;
  bf16_t* kl = (bf16_t*)lds;
  for (int job = BIDX(); job < MROWS / 64; job += GDIM()) {
    const int R0 = job * 64;
    for (int tt = 0; tt < 8; ++tt) {
      const int tl = wid * 8 + tt, R = R0 + tl; const int b = R >= TB ? 1 : 0, pp = R - b * TB;
      const bool hasp = !(pp == 0 || pp == CTXL), hasn = !(pp == CTXL - 1 || pp == TB - 1);
#pragma unroll
      for (int part = 0; part < 3; ++part) {
        const int ch = part * 512 + lane * 8;
        const bf16x8 zc = *(const bf16x8*)(P1 + (size_t)R * 1536 + ch);
        bf16x8 zp = {}, zn = {};
        if (hasp) zp = *(const bf16x8*)(P1 + (size_t)(R - 1) * 1536 + ch);
        if (hasn) zn = *(const bf16x8*)(P1 + (size_t)(R + 1) * 1536 + ch);
        float o[8]; float ss = 0.f;
#pragma unroll
        for (int j = 0; j < 8; ++j) { const float a = bf2f((bf16_t)zp[j]) * cw[ch + j] + bf2f((bf16_t)zc[j]) * cw[1536 + ch + j] + bf2f((bf16_t)zn[j]) * cw[3072 + ch + j];
          o[j] = siluf(a); ss += o[j] * o[j]; }
        if (part < 2) {
          ss += __shfl_xor(ss, 1); ss += __shfl_xor(ss, 2); ss += __shfl_xor(ss, 4); ss += __shfl_xor(ss, 8);
          float sc = rsqrtf(ss + EPSF); if (part == 0) sc *= 0.08838834764831845f;
#pragma unroll
          for (int j = 0; j < 8; ++j) o[j] *= sc;
        }
        u32x4 w = {cvtpk(o[0], o[1]), cvtpk(o[2], o[3]), cvtpk(o[4], o[5]), cvtpk(o[6], o[7])};
        bf16_t* dst = part == 0 ? QQ : (part == 1 ? QK : QV);
        *(u32x4*)(dst + (size_t)R * 512 + lane * 8) = w;
        if (part == 1) *(u32x4*)(kl + tl * 512 + lane * 8) = w;
      }
      if (lane < 16) {
        const int q = lane & 7;
        if (lane < 8) { const float da = SM[(size_t)R * 64 + q]; GB[(size_t)R * 16 + q] = -expf(p.dn_a_log[e * 8 + q]) * softplusf(da + p.dn_dt_bias[e * 8 + q]); }
        else { const float db = SM[(size_t)R * 64 + 8 + q]; GB[(size_t)R * 16 + 8 + q] = sigmf(db); }
      }
    }
    __syncthreads();
    {
      const int b = R0 >= TB ? 1 : 0, c = (R0 - b * TB) / 64; const int h = tid >> 7, dk = tid & 127;
      bf16_t* dst = KT + ((((size_t)b * 4 + h) * NCH + c) * 128 + dk) * 64;
#pragma unroll
      for (int g8 = 0; g8 < 8; ++g8) { unsigned w[4];
#pragma unroll
        for (int j = 0; j < 4; ++j) { const unsigned lo = kl[(g8 * 8 + 2 * j) * 512 + tid], hi2 = kl[(g8 * 8 + 2 * j + 1) * 512 + tid]; w[j] = lo | (hi2 << 16); }
        *(u32x4*)(dst + g8 * 8) = (u32x4){w[0], w[1], w[2], w[3]}; }
    }
    __syncthreads();
  }
}

__device__ __forceinline__ void ph_dn_d1(const P& p, char* lds) {
  const int tid = TIDX(), wid = tid >> 6, lane = tid & 63, r32 = lane & 31, hi = lane >> 5;
  const bf16_t* QQ = (const bf16_t*)(p.ws + OFF_D + D_QQ); const bf16_t* QK = (const bf16_t*)(p.ws + OFF_D + D_QK); const bf16_t* QV = (const bf16_t*)(p.ws + OFF_D + D_QV);
  const float* GB = (const float*)(p.ws + OFF_GB);
  bf16_t* W_ = (bf16_t*)(p.ws + OFF_D + D_W); bf16_t* U_ = (bf16_t*)(p.ws + OFF_HBF); bf16_t* INTRA = (bf16_t*)(p.ws + OFF_D + D_INTRA);
  float* SC = (float*)(p.ws + OFF_SC); float* GLS = (float*)(p.ws + OFF_GL);
  float* KK = (float*)lds; float* QKm = KK + 64 * 65; float* Ad = QKm + 64 * 65; float* Gs = Ad + 2 * 4096; float* Bs = Gs + 128;
  for (int job = BIDX(); job < 8 * NCH; job += GDIM()) {
    const int b = job / (4 * NCH), h = (job / NCH) & 3, c = job % NCH;
    const size_t Rb = (size_t)b * TB + (size_t)c * 64;
    {
      const int w4 = wid & 3, mi = w4 & 1, ni = w4 >> 1;
      const bf16_t* As = wid < 4 ? QK : QQ;
      const bf16_t* arow = As + (Rb + 32 * mi + r32) * 512 + h * 128 + hi * 8;
      const bf16_t* brow = QK + (Rb + 32 * ni + r32) * 512 + h * 128 + hi * 8;
      f32x16 acc = {}; acc = mma_rows<8>(arow, brow, acc);
      float* dst = wid < 4 ? KK : QKm;
#pragma unroll
      for (int r = 0; r < 16; ++r) dst[(32 * mi + crow(r, hi)) * 65 + 32 * ni + r32] = acc[r];
    }
    if (tid < 128) { const int d = tid >> 6, ip = tid & 63, t = d ? 63 - ip : ip; Gs[tid] = GB[(Rb + t) * 16 + d * 4 + h]; Bs[tid] = GB[(Rb + t) * 16 + 8 + d * 4 + h]; }
    __syncthreads();
    if (tid == 0 || tid == 64) { float s = 0.f; for (int i = 0; i < 64; ++i) { s += Gs[tid + i]; Gs[tid + i] = s; } }
    __syncthreads();
    const int n0 = c, n1 = c < 4 ? 3 - c : 135 - c;
    const size_t cj0 = ((size_t)(0 * 2 + b) * 4 + h) * NCH + n0, cj1 = ((size_t)(1 * 2 + b) * 4 + h) * NCH + n1;
    for (int e2 = tid; e2 < 8192; e2 += 512) {
      const int d = e2 >> 12, ip = (e2 >> 6) & 63, jp = e2 & 63; const int i = d ? 63 - ip : ip, j = d ? 63 - jp : jp;
      const float dec = jp <= ip ? expf(Gs[d * 64 + ip] - Gs[d * 64 + jp]) : 0.f;
      Ad[d * 4096 + ip * 64 + jp] = jp < ip ? Bs[d * 64 + ip] * KK[i * 65 + j] * dec : 0.f;
      const size_t cj = d ? cj1 : cj0;
      INTRA[(cj * 64 + ip) * 64 + jp] = f2bf(QKm[i * 65 + j] * dec);
    }
    if (tid < 128) { const int d = tid >> 6, ip = tid & 63; const size_t cj = d ? cj1 : cj0; const float gi = Gs[tid], gl = Gs[d * 64 + 63];
      SC[(cj * 64 + ip) * 2] = expf(gi); SC[(cj * 64 + ip) * 2 + 1] = expf(gl - gi); if (ip == 0) GLS[cj] = expf(gl); }
    __syncthreads();
    {
      const int d = tid >> 8, cc = tid & 255; const size_t cj = d ? cj1 : cj0;
      int dofs = d * 64, aofs = d * 4096; asm volatile("" : "+v"(dofs), "+v"(aofs));
      float x[64];
      {
        const bf16_t* srcb = (cc < 128 ? QV + h * 128 + cc : QK + h * 128 + (cc - 128)) + (Rb + (d ? 63 : 0)) * 512;
        const long step = d ? -512 : 512;
#pragma unroll
        for (int g = 0; g < 8; ++g) {
#pragma unroll
          for (int q8 = 0; q8 < 8; ++q8) { const int ip = g * 8 + q8; x[ip] = bf2f(srcb[ip * step]); }
          asm volatile("" ::: "memory");
        }
        if (cc < 128) {
#pragma unroll
          for (int ip = 0; ip < 64; ++ip) x[ip] *= Bs[dofs + ip];
        } else {
#pragma unroll
          for (int ip = 0; ip < 64; ++ip) x[ip] *= Bs[dofs + ip] * expf(Gs[dofs + ip]);
        }
      }
      const float* Arow = Ad + aofs;
#pragma unroll
      for (int ip = 1; ip < 64; ++ip) {
        float s = 0.f;
#pragma unroll
        for (int j4 = 0; j4 < (ip + 3) / 4; ++j4) { const f32x4 a = *(const f32x4*)(Arow + ip * 64 + 4 * j4);
          s += a[0] * x[4 * j4] + a[1] * x[4 * j4 + 1] + a[2] * x[4 * j4 + 2] + a[3] * x[4 * j4 + 3]; }
        x[ip] -= s;
      }
      bf16_t* dst = cc < 128 ? U_ + cj * 64 * 128 + cc : W_ + cj * 64 * 128 + (cc - 128);
#pragma unroll
      for (int ip = 0; ip < 64; ++ip) dst[ip * 128] = f2bf(x[ip]);
    }
    __syncthreads();
  }
}

struct DnSet { bf16x8 fa[8]; };
__device__ __forceinline__ void dn_scan(const P& p, char* lds, int job) {
  const int tid = TIDX(), wid = tid >> 6, lane = tid & 63, r32 = lane & 31, hi = lane >> 5;
  const int dir = job >> 5, b = (job >> 4) & 1, h = (job >> 2) & 3, n0 = (job & 3) * 32;
  const bf16_t* QQ = (const bf16_t*)(p.ws + OFF_D + D_QQ); const bf16_t* KT = (const bf16_t*)(p.ws + OFF_D + D_KT);
  const bf16_t* W_ = (const bf16_t*)(p.ws + OFF_D + D_W); const bf16_t* U_ = (const bf16_t*)(p.ws + OFF_HBF); const bf16_t* INTRA = (const bf16_t*)(p.ws + OFF_D + D_INTRA);
  const float* SC = (const float*)(p.ws + OFF_SC); const float* GLS = (const float*)(p.ws + OFF_GL);
  bf16_t* DNO = (bf16_t*)(p.ws + OFF_D + D_DNO);
  bf16_t* ST = (bf16_t*)lds; bf16_t* vTa = ST + 32 * 136; bf16_t* vTb = vTa + 32 * 72;
  float* scS = (float*)(vTb + 32 * 72);
  bf16_t* uS = (bf16_t*)(scS + 256);
  bf16_t* inS = uS + 2 * 64 * 40;
  for (int i = tid; i < 32 * 136; i += 512) ST[i] = 0;
  f32x16 accS = {};
  const size_t seq = ((size_t)dir * 2 + b) * 4 + h;
  const int mi = wid & 1, di = wid - 4;
  const int role = wid < 2 ? 0 : (wid < 4 ? 1 : 2);
  const int tt = tid - 256;
  DnSet sA, sB;
  u32x4 stU, stI0, stI1; float stS = 0.f, glA = 0.f, glB = 0.f;
#define DN_CH(n_) const int n__ = (n_); const int c__ = dir == 0 ? n__ : (n__ < 4 ? 3 - n__ : 135 - n__); const size_t Rb__ = (size_t)b * TB + (size_t)c__ * 64; const size_t cj__ = seq * NCH + n__;
#define DN_LOAD(S, GL, n_) do { DN_CH(n_) \
    if (role == 0) { const bf16_t* Wc__ = W_ + cj__ * 8192 + (32 * mi + r32) * 128 + hi * 8; \
      _Pragma("unroll") for (int ks = 0; ks < 8; ++ks) S.fa[ks] = *(const bf16x8*)(Wc__ + ks * 16); } \
    else if (role == 1) { const int ipl = 32 * mi + r32, tl = dir ? 63 - ipl : ipl; const bf16_t* qrow = QQ + (Rb__ + tl) * 512 + h * 128 + hi * 8; \
      _Pragma("unroll") for (int ks = 0; ks < 8; ++ks) S.fa[ks] = *(const bf16x8*)(qrow + ks * 16); } \
    else { const bf16_t* kTc__ = KT + ((((size_t)b * 4 + h) * NCH + c__) * 128 + 32 * di + r32) * 64 + hi * 8; \
      _Pragma("unroll") for (int ks = 0; ks < 4; ++ks) S.fa[ks] = *(const bf16x8*)(kTc__ + ks * 16); GL = GLS[cj__]; } } while (0)
#define DN_STAGE_LD(n_) do { if (role == 2) { DN_CH(n_) (void)Rb__; \
      stU = *(const u32x4*)(U_ + cj__ * 8192 + (tt >> 2) * 128 + n0 + (tt & 3) * 8); \
      stI0 = *(const u32x4*)(INTRA + cj__ * 4096 + (tt >> 3) * 64 + (tt & 7) * 8); stI1 = *(const u32x4*)(INTRA + cj__ * 4096 + (32 + (tt >> 3)) * 64 + (tt & 7) * 8); \
      if (tt < 128) stS = SC[cj__ * 128 + tt]; } } while (0)
#define DN_STAGE_ST(bf_) do { if (role == 2) { *(u32x4*)(uS + (bf_) * 2560 + (tt >> 2) * 40 + (tt & 3) * 8) = stU; \
      *(u32x4*)(inS + (bf_) * 4608 + (tt >> 3) * 72 + (tt & 7) * 8) = stI0; *(u32x4*)(inS + (bf_) * 4608 + (32 + (tt >> 3)) * 72 + (tt & 7) * 8) = stI1; \
      if (tt < 128) scS[(bf_) * 128 + tt] = stS; } } while (0)
#define DN_STEP(S, GL, n_, bf_) do { DN_CH(n_) (void)cj__; \
    const float* sc__ = scS + (bf_) * 128; \
    f32x16 acc = {}; \
    if (role < 2) { const bf16_t* sb__ = ST + r32 * 136 + hi * 8; \
      _Pragma("unroll") for (int ks = 0; ks < 8; ++ks) acc = MFMA32(S.fa[ks], *(const bf16x8*)(sb__ + ks * 16), acc); \
      if (role == 0) { const bf16_t* us__ = uS + (bf_) * 2560 + r32; \
        _Pragma("unroll") for (int r = 0; r < 16; ++r) { const int ip = 32 * mi + crow(r, hi); const float vn = bf2f(us__[ip * 40]) - acc[r]; \
          vTa[r32 * 72 + ip] = f2bf(vn); const int to = dir ? 63 - ip : ip; vTb[r32 * 72 + to] = f2bf(vn * sc__[ip * 2 + 1]); } } \
      else { _Pragma("unroll") for (int r = 0; r < 16; ++r) acc[r] *= sc__[(32 * mi + crow(r, hi)) * 2]; } } \
    __syncthreads(); \
    if (role == 1) { const bf16_t* vb__ = vTa + r32 * 72 + hi * 8; const bf16_t* ib__ = inS + (bf_) * 4608 + (32 * mi + r32) * 72 + hi * 8; \
      _Pragma("unroll") for (int ks = 0; ks < 4; ++ks) acc = MFMA32(*(const bf16x8*)(ib__ + ks * 16), *(const bf16x8*)(vb__ + ks * 16), acc); \
      _Pragma("unroll") for (int r = 0; r < 16; ++r) { const int ip = 32 * mi + crow(r, hi), t = dir ? 63 - ip : ip; \
        DNO[((size_t)dir * MROWS + Rb__ + t) * 512 + h * 128 + n0 + r32] = f2bf(acc[r]); } } \
    else if (role == 2) { const bf16_t* vb__ = vTb + r32 * 72 + hi * 8; \
      _Pragma("unroll") for (int r = 0; r < 16; ++r) accS[r] *= GL; \
      _Pragma("unroll") for (int ks = 0; ks < 4; ++ks) accS = MFMA32(S.fa[ks], *(const bf16x8*)(vb__ + ks * 16), accS); \
      _Pragma("unroll") for (int r = 0; r < 16; ++r) ST[r32 * 136 + 32 * di + crow(r, hi)] = f2bf(accS[r]); } \
    DN_STAGE_ST((bf_) ^ 1); \
    __syncthreads(); } while (0)
  DN_STAGE_LD(0); DN_STAGE_ST(0);
  DN_LOAD(sA, glA, 0);
  __syncthreads();
  for (int n = 0; n < NCH; n += 2) {
    DN_LOAD(sB, glB, n + 1); DN_STAGE_LD(n + 1);
    DN_STEP(sA, glA, n, 0);
    if (n + 2 < NCH) { DN_LOAD(sA, glA, n + 2); DN_STAGE_LD(n + 2); }
    DN_STEP(sB, glB, n + 1, 1);
  }
#undef DN_CH
#undef DN_LOAD
#undef DN_STAGE_LD
#undef DN_STAGE_ST
#undef DN_STEP
}

DI float fast_logsig(float s) { return fminf(s, 0.f) - __logf(1.f + __expf(-fabsf(s))); }
struct GlaRegs { f32x4 g0, g1, g2, g3; bf16x8 qa, qb, ka, kb, v8; };
__device__ __forceinline__ void gla_scan(const P& p, char* lds, int job, int e) {
  const int tid = TIDX(), wid = tid >> 6, lane = tid & 63, r32 = lane & 31, hi = lane >> 5;
  const int dir = job >> 5, b = (job >> 4) & 1, h = (job >> 2) & 3, n0 = (job & 3) * 32;
  const bf16_t* P2 = (const bf16_t*)(p.ws + OFF_D + D_P2); const float* SM = (const float*)(p.ws + OFF_SM);
  bf16_t* GLAO = (bf16_t*)(p.ws + OFF_D + D_GLAO);
  float* w2S = (float*)lds; float* b2S = w2S + 1024; float* aLb = b2S + 64;
  bf16_t* ops = (bf16_t*)(aLb + 128);
  constexpr int OPB = (4 * 64 + 32) * 72;
  bf16_t* attp = ops + 2 * OPB;
  bf16_t* STb = attp + 2 * 32 * 72;
  for (int i = tid; i < 1024; i += 512) { const int r = i >> 6, j = i & 63; w2S[i] = p.gla_w2[(((size_t)e * 2 + dir) * 16 + r) * 256 + h * 64 + j]; }
  if (tid < 64) b2S[tid] = p.gla_b2[((size_t)e * 2 + dir) * 256 + h * 64 + tid];
  for (int i = tid; i < 2 * 32 * 72; i += 512) STb[i] = 0;
  f32x16 accS = {};
  __syncthreads();
  GlaRegs R;
#define GLA_LOAD(n_) do { const int n__ = (n_); const int c__ = dir == 0 ? n__ : (n__ < 4 ? 3 - n__ : 135 - n__); const size_t row__ = (size_t)b * TB + (size_t)c__ * 64 + (dir ? 63 - lane : lane); \
    const float* gp__ = SM + row__ * 64 + 16 + dir * 16; R.g0 = *(const f32x4*)(gp__); R.g1 = *(const f32x4*)(gp__ + 4); R.g2 = *(const f32x4*)(gp__ + 8); R.g3 = *(const f32x4*)(gp__ + 12); \
    const bf16_t* pr__ = P2 + row__ * 2048; R.qa = *(const bf16x8*)(pr__ + 512 + h * 64 + 16 * wid); R.qb = *(const bf16x8*)(pr__ + 512 + h * 64 + 16 * wid + 8); \
    R.ka = *(const bf16x8*)(pr__ + 768 + h * 64 + 16 * wid); R.kb = *(const bf16x8*)(pr__ + 768 + h * 64 + 16 * wid + 8); R.v8 = *(const bf16x8*)(pr__ + 1024 + h * 128 + n0 + 8 * wid); } while (0)
#define GLA_HALF(QV, KV, jb) do { float la[8]; \
    { f32x4 sa_ = *(const f32x4*)(b2S + (jb)), sb_ = *(const f32x4*)(b2S + (jb) + 4); \
      const float gg_[16] = {R.g0[0], R.g0[1], R.g0[2], R.g0[3], R.g1[0], R.g1[1], R.g1[2], R.g1[3], R.g2[0], R.g2[1], R.g2[2], R.g2[3], R.g3[0], R.g3[1], R.g3[2], R.g3[3]}; \
      _Pragma("unroll") for (int r_ = 0; r_ < 16; ++r_) { const f32x4 wa_ = *(const f32x4*)(w2S + r_ * 64 + (jb)), wb_ = *(const f32x4*)(w2S + r_ * 64 + (jb) + 4); sa_ += gg_[r_] * wa_; sb_ += gg_[r_] * wb_; } \
      _Pragma("unroll") for (int jj = 0; jj < 4; ++jj) { la[jj] = fast_logsig(sa_[jj]) * 0.0625f; la[4 + jj] = fast_logsig(sb_[jj]) * 0.0625f; } } \
    _Pragma("unroll") for (int o_ = 1; o_ < 64; o_ <<= 1) { _Pragma("unroll") for (int jj = 0; jj < 8; ++jj) { const float v_ = __shfl_up(la[jj], o_); if (lane >= o_) la[jj] += v_; } } \
    float eqe[8], eke[8], eqi[8]; \
    _Pragma("unroll") for (int jj = 0; jj < 8; ++jj) { const int j = (jb) + jj; const float bb = la[jj], bm = __shfl(bb, 32), bl = __shfl(bb, 63); \
      const float q_ = bf2f((bf16_t)QV[jj]) * 0.125f, k_ = bf2f((bf16_t)KV[jj]); \
      eqe[jj] = q_ * __expf(bb - bm); eke[jj] = k_ * __expf(bm - bb); eqi[jj] = q_ * __expf(bb); ksT_[j * 72 + lane] = f2bf(k_ * __expf(bl - bb)); if (lane == 63) aL_[j] = __expf(bl); } \
    *(u32x4*)(qe_ + lane * 72 + (jb)) = (u32x4){cvtpk(eqe[0], eqe[1]), cvtpk(eqe[2], eqe[3]), cvtpk(eqe[4], eqe[5]), cvtpk(eqe[6], eqe[7])}; \
    *(u32x4*)(ke_ + lane * 72 + (jb)) = (u32x4){cvtpk(eke[0], eke[1]), cvtpk(eke[2], eke[3]), cvtpk(eke[4], eke[5]), cvtpk(eke[6], eke[7])}; \
    *(u32x4*)(qi_ + lane * 72 + (jb)) = (u32x4){cvtpk(eqi[0], eqi[1]), cvtpk(eqi[2], eqi[3]), cvtpk(eqi[4], eqi[5]), cvtpk(eqi[6], eqi[7])}; } while (0)
#define GLA_PREP(bf_) do { bf16_t* qe_ = ops + (bf_) * OPB; bf16_t* ke_ = qe_ + 64 * 72; bf16_t* qi_ = ke_ + 64 * 72; bf16_t* ksT_ = qi_ + 64 * 72; bf16_t* vT_ = ksT_ + 64 * 72; float* aL_ = aLb + (bf_) * 64; \
    GLA_HALF(R.qa, R.ka, 16 * wid); GLA_HALF(R.qb, R.kb, 16 * wid + 8); \
    _Pragma("unroll") for (int q_ = 0; q_ < 8; ++q_) vT_[(8 * wid + q_) * 72 + lane] = (bf16_t)R.v8[q_]; } while (0)
  if (wid < 4) { GLA_LOAD(0); GLA_PREP(0); GLA_LOAD(1); }
  __syncthreads();
  for (int n = 0; n < NCH; ++n) {
    if (wid < 4) {
      if (n + 1 < NCH) { GLA_PREP((n + 1) & 1); if (n + 2 < NCH) GLA_LOAD(n + 2); }
    } else {
      const int bf = n & 1;
      const bf16_t* qe_ = ops + bf * OPB; const bf16_t* ke_ = qe_ + 64 * 72; const bf16_t* qi_ = ke_ + 64 * 72; const bf16_t* ksT_ = qi_ + 64 * 72; const bf16_t* vT_ = ksT_ + 64 * 72; const float* aL_ = aLb + bf * 64;
      const bf16_t* STr = STb + bf * 32 * 72; bf16_t* STw = STb + (bf ^ 1) * 32 * 72;
      if (wid < 6) {
        const int mi = wid - 4; bf16_t* attw = attp + mi * 32 * 72;
        const int c = dir == 0 ? n : (n < 4 ? 3 - n : 135 - n); const size_t Rb = (size_t)b * TB + (size_t)c * 64;
        f32x16 acc = {}; acc = mma_rows<4>(qi_ + (32 * mi + r32) * 72 + hi * 8, STr + r32 * 72 + hi * 8, acc);
        {
          f32x16 a0 = {}; a0 = mma_rows<4>(qe_ + (32 * mi + r32) * 72 + hi * 8, ke_ + r32 * 72 + hi * 8, a0);
#pragma unroll
          for (int r = 0; r < 16; ++r) { const int ipl = crow(r, hi); attw[ipl * 72 + r32] = f2bf((mi == 1 || r32 <= ipl) ? a0[r] : 0.f); }
          f32x16 a1 = {}; if (mi == 1) a1 = mma_rows<4>(qe_ + (32 + r32) * 72 + hi * 8, ke_ + (32 + r32) * 72 + hi * 8, a1);
#pragma unroll
          for (int r = 0; r < 16; ++r) { const int ipl = crow(r, hi); attw[ipl * 72 + 32 + r32] = f2bf((mi == 1 && r32 <= ipl) ? a1[r] : 0.f); }
        }
        asm volatile("s_waitcnt lgkmcnt(0)" ::: "memory");
        acc = mma_rows<4>(attw + r32 * 72 + hi * 8, vT_ + r32 * 72 + hi * 8, acc);
#pragma unroll
        for (int r = 0; r < 16; ++r) { const int ip = 32 * mi + crow(r, hi), t = dir ? 63 - ip : ip;
          GLAO[((size_t)dir * MROWS + Rb + t) * 512 + h * 128 + n0 + r32] = f2bf(acc[r]); }
      } else {
        const int di = wid - 6;
#pragma unroll
        for (int r = 0; r < 16; ++r) accS[r] *= aL_[32 * di + crow(r, hi)];
        accS = mma_rows<4>(ksT_ + (32 * di + r32) * 72 + hi * 8, vT_ + r32 * 72 + hi * 8, accS);
#pragma unroll
        for (int r = 0; r < 16; ++r) STw[r32 * 72 + 32 * di + crow(r, hi)] = f2bf(accS[r]);
      }
    }
    __syncthreads();
  }
#undef GLA_LOAD
#undef GLA_HALF
#undef GLA_PREP
}

__device__ __forceinline__ void ph_merge(const P& p, int e) {
  const int tid = TIDX(), wid = tid >> 6, lane = tid & 63;
  const bf16_t* DNO = (const bf16_t*)(p.ws + OFF_D + D_DNO); const bf16_t* GLAO = (const bf16_t*)(p.ws + OFF_D + D_GLAO);
  const bf16_t* P2 = (const bf16_t*)(p.ws + OFF_D + D_P2); bf16_t* hb = (bf16_t*)(p.ws + OFF_HBF);
  for (int R = BIDX() * 8 + wid; R < MROWS; R += GDIM() * 8) {
#pragma unroll
    for (int g = 0; g < 8; ++g) {
      const bf16_t* src = g < 4 ? DNO : GLAO; const int hc = (g & 3) * 128 + lane * 2;
      const unsigned a = *(const unsigned*)(src + (size_t)R * 512 + hc), bq = *(const unsigned*)(src + ((size_t)MROWS + R) * 512 + hc);
      const float v0 = bf2f((bf16_t)(a & 0xffff)) + bf2f((bf16_t)(bq & 0xffff)), v1 = bf2f((bf16_t)(a >> 16)) + bf2f((bf16_t)(bq >> 16));
      const float ss = wave_sum(v0 * v0 + v1 * v1);
      const float rs = rsqrtf(ss * (1.f / 128.f) + EPSF);
      const float* nw = g < 4 ? p.dn_norm + e * 128 : p.gla_norm + e * 128;
      const unsigned zz = *(const unsigned*)(P2 + (size_t)R * 2048 + (g < 4 ? 0 : 1536) + hc);
      const float z0 = bf2f((bf16_t)(zz & 0xffff)), z1 = bf2f((bf16_t)(zz >> 16));
      const float o0 = v0 * rs * nw[lane * 2] * siluf(z0), o1 = v1 * rs * nw[lane * 2 + 1] * siluf(z1);
      *(unsigned*)(hb + (size_t)R * 1024 + g * 128 + lane * 2) = cvtpk(o0, o1);
    }
  }
}

__device__ __forceinline__ void ph_ffnact(const P& p, int L) {
  bf16_t* U = (bf16_t*)(p.ws + OFF_D);
  const float* cw = p.ffn_conv + (size_t)L * 3 * DFF;
  const size_t items = (size_t)MROWS * 352;
  for (size_t it = (size_t)BIDX() * 512 + TIDX(); it < items; it += (size_t)GDIM() * 512) {
    const int R = (int)(it / 352), c0 = (int)(it % 352) * 8; const int b = R >= TB ? 1 : 0, pp = R - b * TB;
    const bool hasp = !(pp == 0 || pp == CTXL), hasn = !(pp == CTXL - 1 || pp == TB - 1);
    const bf16x8 zc = *(const bf16x8*)(U + (size_t)R * 5632 + c0); bf16x8 zp = {}, zn = {};
    if (hasp) zp = *(const bf16x8*)(U + (size_t)(R - 1) * 5632 + c0);
    if (hasn) zn = *(const bf16x8*)(U + (size_t)(R + 1) * 5632 + c0);
    const bf16x8 vv = *(const bf16x8*)(U + (size_t)R * 5632 + DFF + c0);
    float o[8];
#pragma unroll
    for (int j = 0; j < 8; ++j) { const float a = bf2f((bf16_t)zp[j]) * cw[c0 + j] + bf2f((bf16_t)zc[j]) * cw[DFF + c0 + j] + bf2f((bf16_t)zn[j]) * cw[2 * DFF + c0 + j];
      o[j] = siluf(a) * bf2f((bf16_t)vv[j]); }
    u32x4 w = {cvtpk(o[0], o[1]), cvtpk(o[2], o[3]), cvtpk(o[4], o[5]), cvtpk(o[6], o[7])};
    *(u32x4*)(U + (size_t)R * 5632 + DFF + c0) = w;
  }
}

__device__ __forceinline__ void ph_qknorm(const P& p, int o) {
  const int tid = TIDX(), wid = tid >> 6, lane = tid & 63;
  bf16_t* QKV = (bf16_t*)(p.ws + OFF_D);
  const float* qn = p.att_q_norm + o * 128; const float* kn = p.att_k_norm + o * 128;
  const float invf = powf(10000.f, -(float)(lane & 31) / 32.f);
  for (int R = BIDX() * 8 + wid; R < MROWS; R += GDIM() * 8) {
    const int b = R >= TB ? 1 : 0, pp = R - b * TB; const bool lat = pp >= CTXL; const int t = pp - CTXL;
    float cr = 1.f, sr = 0.f, cc = 1.f, sn = 0.f;
    if (lat) { const float ar = (float)(t >> 6) * invf, ac = (float)(t & 63) * invf; cr = cosf(ar); sr = sinf(ar); cc = cosf(ac); sn = sinf(ac); }
    for (int hd = 0; hd < 10; ++hd) {
      bf16_t* base = QKV + (size_t)R * 1536 + hd * 128; const float* nw = hd < 8 ? qn : kn;
      float v0 = bf2f(base[lane]), v1 = bf2f(base[64 + lane]);
      const float ss = wave_sum(v0 * v0 + v1 * v1); const float rs = rsqrtf(ss * (1.f / 128.f) + EPSF);
      v0 = v0 * rs * nw[lane]; v1 = v1 * rs * nw[64 + lane];
      const float p0 = __shfl_xor(v0, 32), p1 = __shfl_xor(v1, 32);
      float o0, o1;
      if (lane < 32) { o0 = v0 * cr - p0 * sr; o1 = v1 * cc - p1 * sn; } else { o0 = p0 * sr + v0 * cr; o1 = p1 * sn + v1 * cc; }
      base[lane] = f2bf(o0); base[64 + lane] = f2bf(o1);
    }
  }
}

namespace at {
constexpr int D = 128, NW = 8, QBLK = 32, KVBLK = 64;
constexpr float SCALE = 0.088388347648318440f, THR = 8.f;
constexpr int LDQ = 1536, LDK = 1536, LDO = 1024;
constexpr size_t SHM_V = KVBLK * D * 2, SHM_K = KVBLK * D * 2;
#define KSWZ(row, colB) ((row) * 256 + ((colB) ^ (((row) & 7) << 4)))
#define SBAR() __builtin_amdgcn_sched_barrier(0)
DI void partialSM(f32x16& p0, f32x16& p1, float& m_reg, float& mn, float& alpha) {
  constexpr float C = SCALE * 1.4426950408889634f;
  float pmax = p0[0]; for (int r = 1; r < 16; ++r) pmax = fmaxf(pmax, p0[r]); for (int r = 0; r < 16; ++r) pmax = fmaxf(pmax, p1[r]);
  { auto rr = __builtin_amdgcn_permlane32_swap(__float_as_uint(pmax), __float_as_uint(pmax), false, false);
    pmax = fmaxf(__uint_as_float(rr[0]), __uint_as_float(rr[1])); }
  if (__builtin_expect(__all(pmax - m_reg <= THR / SCALE), 1)) { mn = m_reg; alpha = 1.f; }
  else { mn = fmaxf(m_reg, pmax); alpha = __builtin_amdgcn_exp2f((m_reg - mn) * C); m_reg = mn; }
  float mnC = -mn * C;
  for (int r = 0; r < 16; ++r) p0[r] = fmaf(p0[r], C, mnC); for (int r = 0; r < 16; ++r) p1[r] = fmaf(p1[r], C, mnC);
  for (int r = 0; r < 16; ++r) p0[r] = __builtin_amdgcn_exp2f(p0[r]);
}
DI void finishSM(f32x16& p0, f32x16& p1, float alpha, float& l_reg, bf16x8& pa0, bf16x8& pa1, bf16x8& pa2, bf16x8& pa3) {
  for (int r = 0; r < 16; ++r) p1[r] = __builtin_amdgcn_exp2f(p1[r]);
  float ps = 0; for (int r = 0; r < 16; ++r) ps += p0[r]; for (int r = 0; r < 16; ++r) ps += p1[r];
  { auto rr = __builtin_amdgcn_permlane32_swap(__float_as_uint(ps), __float_as_uint(ps), false, false);
    ps = __uint_as_float(rr[0]) + __uint_as_float(rr[1]); }
  l_reg = l_reg * alpha + ps;
#define PK4(PP, BASE, OUT) do { unsigned a0 = cvtpk(PP[BASE + 0], PP[BASE + 1]), a1 = cvtpk(PP[BASE + 2], PP[BASE + 3]);   \
    unsigned b0 = cvtpk(PP[BASE + 4], PP[BASE + 5]), b1 = cvtpk(PP[BASE + 6], PP[BASE + 7]);                              \
    auto r0 = __builtin_amdgcn_permlane32_swap(a0, b0, false, false); auto r1 = __builtin_amdgcn_permlane32_swap(a1, b1, false, false); \
    u32x4 w = {r0[0], r1[0], r0[1], r1[1]}; OUT = *reinterpret_cast<bf16x8*>(&w); } while (0)
  PK4(p0, 0, pa0); PK4(p0, 8, pa1); PK4(p1, 0, pa2); PK4(p1, 8, pa3);
#undef PK4
}
DI void qkt(f32x16& p0, f32x16& p1, const bf16_t* Ks, const bf16x8* qr, int r32, int hi) {
  p0 = f32x16{}; p1 = f32x16{};
  for (int d0 = 0; d0 < 8; ++d0) { int cb = (d0 * 16 + hi * 8) * 2;
    bf16x8 b0 = *reinterpret_cast<const bf16x8*>((const char*)Ks + KSWZ(r32, cb));
    bf16x8 b1 = *reinterpret_cast<const bf16x8*>((const char*)Ks + KSWZ(32 + r32, cb));
    p0 = MFMA32(b0, qr[d0], p0);
    p1 = MFMA32(b1, qr[d0], p1); }
}
DI int v_st(int k, int c) { const int kk = (k & ~0xC) | ((k & 4) << 1) | ((k & 8) >> 1); return ((kk >> 3) * 4 + (c >> 5)) * 512 + ((kk & 7) * 32 + (c & 31)) * 2; }
DI int v_rd_base(int lane) { return ((lane & 3) << 3) | (((lane >> 2) & 3) << 6) | (((lane >> 4) & 1) << 5) | (((lane >> 5) & 1) << 8); }
constexpr int v_rd_off(int d0, int ks, int half) { return d0 * 512 + ks * 4096 + half * 2048; }
template <int OFF> DI s16x4 tr_read(int vb) {
  s16x4 r; asm volatile("ds_read_b64_tr_b16 %0, %1 offset:%2" : "=&v"(r) : "v"(vb), "i"(OFF) : "memory"); return r;
}
template <int D0> DI void pv_one(f32x16& od, int vb, bf16x8 pa0, bf16x8 pa1, bf16x8 pa2, bf16x8 pa3) {
  const s16x4 l0 = tr_read<v_rd_off(D0, 0, 0)>(vb), h0 = tr_read<v_rd_off(D0, 0, 1)>(vb), l1 = tr_read<v_rd_off(D0, 1, 0)>(vb), h1 = tr_read<v_rd_off(D0, 1, 1)>(vb);
  const s16x4 l2 = tr_read<v_rd_off(D0, 2, 0)>(vb), h2 = tr_read<v_rd_off(D0, 2, 1)>(vb), l3 = tr_read<v_rd_off(D0, 3, 0)>(vb), h3 = tr_read<v_rd_off(D0, 3, 1)>(vb);
  asm volatile("s_waitcnt lgkmcnt(0)" ::: "memory"); SBAR();
#define PK(Lx, Hx) (bf16x8){Lx[0], Lx[1], Lx[2], Lx[3], Hx[0], Hx[1], Hx[2], Hx[3]}
  od = MFMA32(pa0, PK(l0, h0), od);
  od = MFMA32(pa1, PK(l1, h1), od);
  od = MFMA32(pa2, PK(l2, h2), od);
  od = MFMA32(pa3, PK(l3, h3), od);
#undef PK
}
DI void pv_d0(f32x16* o, int vb, bf16x8 pa0, bf16x8 pa1, bf16x8 pa2, bf16x8 pa3) {
  pv_one<0>(o[0], vb, pa0, pa1, pa2, pa3); pv_one<1>(o[1], vb, pa0, pa1, pa2, pa3); pv_one<2>(o[2], vb, pa0, pa1, pa2, pa3); pv_one<3>(o[3], vb, pa0, pa1, pa2, pa3);
}
DI void attn_dense_body(const bf16_t* __restrict__ Qb, const bf16_t* __restrict__ Kh, const bf16_t* __restrict__ Vh, bf16_t* __restrict__ Ob, int seq, char* lds) {
  const int tid = TIDX(), wid = tid >> 6, lane = tid & 63, r32 = lane & 31, hi = lane >> 5;
  bf16_t* V_lds = (bf16_t*)lds; bf16_t* K_lds = (bf16_t*)(lds + 2 * SHM_V);
  float* ws = (float*)(lds + 2 * SHM_V + 2 * SHM_K) + wid * 64; float* li_l = ws; float* al_l = ws + 32;
  float m_reg = -1e30f, l_reg = 0; f32x16 o[4] = {}; bf16x8 qr[8];
  const bf16_t* Qw = Qb + (long)(wid * QBLK + r32) * LDQ + hi * 8;
#pragma unroll
  for (int d0 = 0; d0 < 8; ++d0) qr[d0] = *reinterpret_cast<const bf16x8*>(Qw + d0 * 16);
  const int sr = tid >> 4, sc = (tid & 15) * 8, vst0 = v_st(sr, sc), vst1 = v_st(32 + sr, sc);
  const int vb0 = (int)(uintptr_t)V_lds + v_rd_base(lane);
  struct { bf16x8 vs0, vs1, ks0, ks1; } sr_[2];
#define SLOAD(i, k0) do { sr_[i].vs0 = *(const bf16x8*)(&Vh[(long)((k0) + sr) * LDK + sc]); sr_[i].vs1 = *(const bf16x8*)(&Vh[(long)((k0) + 32 + sr) * LDK + sc]); \
    sr_[i].ks0 = *(const bf16x8*)(&Kh[(long)((k0) + sr) * LDK + sc]); sr_[i].ks1 = *(const bf16x8*)(&Kh[(long)((k0) + 32 + sr) * LDK + sc]); } while (0)
#define SWRITE(bq, i) do { *(bf16x8*)((char*)V_lds + (bq) * SHM_V + vst0) = sr_[i].vs0;          \
    *(bf16x8*)((char*)V_lds + (bq) * SHM_V + vst1) = sr_[i].vs1; int kc = sc * 2;               \
    *(bf16x8*)((char*)K_lds + (bq) * SHM_K + KSWZ(sr, kc)) = sr_[i].ks0;                       \
    *(bf16x8*)((char*)K_lds + (bq) * SHM_K + KSWZ(32 + sr, kc)) = sr_[i].ks1; } while (0)
#define SWAIT() asm volatile("s_waitcnt vmcnt(4)" ::: "memory")
#define RESC(a) do { if (__any((a) < 1.f)) { if (hi == 0) al_l[r32] = (a); asm volatile("s_waitcnt lgkmcnt(0)" ::: "memory"); \
    for (int d = 0; d < 4; ++d) for (int r = 0; r < 16; ++r) o[d][r] *= al_l[crow(r, hi)]; } } while (0)
  f32x16 pA0, pA1, pB0, pB1; float mnA, mnB, alA, alB; bf16x8 pa0, pa1, pa2, pa3; const int NT = seq / KVBLK;
  constexpr int SE = 0, SO = 1;
  SLOAD(SE, 0); asm volatile("s_waitcnt vmcnt(0)" ::: "memory"); SWRITE(0, SE); __syncthreads();
  qkt(pA0, pA1, K_lds, qr, r32, hi); partialSM(pA0, pA1, m_reg, mnA, alA);
  SLOAD(SO, KVBLK); if (2 < NT) SLOAD(SE, 2 * KVBLK);
  SWAIT(); SWRITE(1, SO); __syncthreads();
  for (int j = 1; j + 1 < NT; j += 2) {
    SBAR(); qkt(pB0, pB1, (bf16_t*)((char*)K_lds + SHM_K), qr, r32, hi);
    finishSM(pA0, pA1, alA, l_reg, pa0, pa1, pa2, pa3); SBAR();
    SLOAD(SO, (j + 2) * KVBLK); SBAR();
    pv_d0(o, vb0, pa0, pa1, pa2, pa3); partialSM(pB0, pB1, m_reg, mnB, alB);
    __syncthreads(); SWAIT(); SWRITE(0, SE);
    RESC(alB); __syncthreads();
    SBAR(); qkt(pA0, pA1, K_lds, qr, r32, hi);
    finishSM(pB0, pB1, alB, l_reg, pa0, pa1, pa2, pa3); SBAR();
    if (j + 3 < NT) SLOAD(SE, (j + 3) * KVBLK); SBAR();
    pv_d0(o, vb0 + (int)SHM_V, pa0, pa1, pa2, pa3); partialSM(pA0, pA1, m_reg, mnA, alA);
    __syncthreads(); SWAIT(); SWRITE(1, SO);
    RESC(alA); __syncthreads();
  }
  SBAR(); qkt(pB0, pB1, (bf16_t*)((char*)K_lds + SHM_K), qr, r32, hi);
  finishSM(pA0, pA1, alA, l_reg, pa0, pa1, pa2, pa3); SBAR();
  pv_d0(o, vb0, pa0, pa1, pa2, pa3); partialSM(pB0, pB1, m_reg, mnB, alB);
  __syncthreads(); RESC(alB);
  finishSM(pB0, pB1, alB, l_reg, pa0, pa1, pa2, pa3); SBAR();
  pv_d0(o, vb0 + (int)SHM_V, pa0, pa1, pa2, pa3);
  if (hi == 0) li_l[r32] = l_reg; asm volatile("s_waitcnt lgkmcnt(0)" ::: "memory");
  float rli[16];
#pragma unroll
  for (int r = 0; r < 16; ++r) rli[r] = __builtin_amdgcn_rcpf(li_l[crow(r, hi)]);
  bf16_t* Ow = Ob + (long)(wid * QBLK) * LDO;
#pragma unroll
  for (int r = 0; r < 16; ++r) { int orow = crow(r, hi);
    for (int d0 = 0; d0 < 4; ++d0) Ow[(long)orow * LDO + d0 * 32 + r32] = f2bf(o[d0][r] * rli[r]); }
#undef SLOAD
#undef SWRITE
#undef SWAIT
#undef RESC
}
}

__device__ __forceinline__ void ph_attn(const P& p, char* lds, bool need_ctx) {
  const bf16_t* QKV = (const bf16_t*)(p.ws + OFF_D); bf16_t* hb = (bf16_t*)(p.ws + OFF_HBF);
  const int nunits = need_ctx ? 528 : 512;
  for (int u = BIDX(); u < nunits; u += GDIM()) {
    int b, h, seq; size_t qrow;
    if (u < 512) { b = u >> 8; const int rem = u & 255; h = rem >> 5; qrow = (size_t)b * TB + CTXL + (size_t)(rem & 31) * 256; seq = TB; }
    else { const int uu = u - 512; b = uu >> 3; h = uu & 7; qrow = (size_t)b * TB; seq = CTXL; }
    const int kvh = h >> 2;
    const bf16_t* Kh = QKV + (size_t)b * TB * 1536 + 1024 + kvh * 128;
    const bf16_t* Vh = QKV + (size_t)b * TB * 1536 + 1280 + kvh * 128;
    at::attn_dense_body(QKV + qrow * 1536 + h * 128, Kh, Vh, hb + qrow * 1024 + h * 128, seq, lds);
    __syncthreads();
  }
}

__device__ __forceinline__ void ph_final(const P& p) {
  const int tid = TIDX(), wid = tid >> 6, lane = tid & 63;
  const float* xr = (const float*)(p.ws + OFF_XRES);
  for (int q = BIDX() * 8 + wid; q < 2 * LAT; q += GDIM() * 8) {
    const int b = q >> 13, t = q & (LAT - 1); const float* row = xr + ((size_t)b * TB + CTXL + t) * 1024;
    f32x4 v[4]; float ss = 0.f;
#pragma unroll
    for (int i = 0; i < 4; ++i) { v[i] = *(const f32x4*)(row + i * 256 + lane * 4); ss += v[i][0] * v[i][0] + v[i][1] * v[i][1] + v[i][2] * v[i][2] + v[i][3] * v[i][3]; }
    ss = wave_sum(ss); const float rs = rsqrtf(ss * (1.f / 1024.f) + EPSF);
#pragma unroll
    for (int i = 0; i < 4; ++i) { const int c0 = i * 256 + lane * 4; const f32x4 g = *(const f32x4*)(p.final_norm + c0); f32x4 o = v[i] * rs * g; *(f32x4*)(p.out + (size_t)q * 1024 + c0) = o; }
  }
}

constexpr int NPHASES = 42;
#ifndef ONLY_PH
#define ONLY_PH -1
#endif
#define EN(x) (ONLY_PH < 0 || ONLY_PH == (x))
#ifndef PROBE_REP
#define PROBE_REP -1
#endif
#define RUN(cls, ...) do { if (EN(cls)) { __VA_ARGS__; if (PROBE_REP == (cls)) { cg::this_grid().sync(); __VA_ARGS__; } } } while (0)
__device__ __forceinline__ void run_phase(const P& p0, int ph, char* lds) {
  P p = p0; asm volatile("" : "+s"(p.ws));
  if (ph == 0) { RUN(0, ph_init(p, lds)); return; }
  if (ph == NPHASES - 1) { if (EN(11)) ph_final(p); return; }
  const int q = ph - 1; int L, sub;
  if (q < 11) { L = 0; sub = q; } else if (q < 20) { L = 1; sub = q - 11; } else if (q < 31) { L = 2; sub = q - 20; } else { L = 3; sub = q - 31; }
  const bool even = (L & 1) == 0; const int e = L >> 1;
  bf16_t* W1 = (bf16_t*)(p.ws + OFF_WC); bf16_t* W2 = (bf16_t*)(p.ws + OFF_WC + WC_W2);
  bf16_t* hb = (bf16_t*)(p.ws + OFF_HBF); float* xr = (float*)(p.ws + OFF_XRES);
  const float* mods = (const float*)(p.ws + OFF_MODS) + (size_t)L * 3 * 6144;
  int fs = even ? sub - 7 : sub - 5;
  if (fs >= 0) {
    if (fs == 0) { RUN(1, ph_norm(p, L, 1); cvt_weight(p.ffn_w_up + (size_t)L * 1024 * 5632, W1, 1024, 5632, 5632, false); cvt_weight(p.ffn_w_down + (size_t)L * DFF * 1024, W2, DFF, 1024, 1024, false)); }
    else if (fs == 1) { RUN(2, gemm_phase(lds, hb, 1024, W1, 1024, 44, EpiBf{(bf16_t*)(p.ws + OFF_D), 5632})); }
    else if (fs == 2) { if (EN(8)) ph_ffnact(p, L); }
    else { if (EN(2)) gemm_phase(lds, (const bf16_t*)(p.ws + OFF_D) + DFF, 5632, W2, DFF, 8, EpiRes{xr, mods + 5 * 1024}); }
    return;
  }
  if (even) {
    switch (sub) {
      case 0: RUN(1, ph_norm(p, L, 0); cvt_weight(p.rec_w_in + (size_t)e * 1024 * 3632, W1, 1024, 3632, NREC, true); cvt_weight(p.rec_w_out + (size_t)e * 1024 * 1024, W2, 1024, 1024, 1024, false)); break;
      case 1: RUN(2, gemm_phase(lds, hb, 1024, W1, 1024, NREC / 128, EpiRec{(bf16_t*)(p.ws + OFF_D + D_P1), (bf16_t*)(p.ws + OFF_D + D_P2), (float*)(p.ws + OFF_SM)})); break;
      case 2: RUN(3, ph_dnprep(p, lds, e)); break;
      case 3: RUN(4, ph_dn_d1(p, lds)); break;
      case 4: RUN(5, if (BIDX() < 64) { dn_scan(p, lds, BIDX()); } else if (BIDX() < 128) { gla_scan(p, lds, BIDX() - 64, e); }); break;
      case 5: RUN(7, ph_merge(p, e)); break;
      case 6: if (EN(2)) gemm_phase(lds, hb, 1024, W2, 1024, 8, EpiRes{xr, mods + 2 * 1024}); break;
    }
  } else {
    const int o = L >> 1;
    switch (sub) {
      case 0: RUN(1, ph_norm(p, L, 0); cvt_weight(p.att_w_qkv + (size_t)o * 1024 * 1536, W1, 1024, 1536, 1536, false); cvt_weight(p.att_w_out + (size_t)o * 1024 * 1024, W2, 1024, 1024, 1024, false)); break;
      case 1: RUN(2, gemm_phase(lds, hb, 1024, W1, 1024, 12, EpiBf{(bf16_t*)(p.ws + OFF_D), 1536})); break;
      case 2: if (EN(9)) ph_qknorm(p, o); break;
      case 3: RUN(10, ph_attn(p, lds, L != 3)); break;
      case 4: if (EN(2)) gemm_phase(lds, hb, 1024, W2, 1024, 8, EpiRes{xr, mods + 2 * 1024}); break;
    }
  }
}

template <bool COOP>
__global__ void __launch_bounds__(512, 1) mk_kernel(P p, int ph0, int ph1) {
  extern __shared__ __attribute__((aligned(16))) char smem[];
  for (int ph = ph0; ph < ph1; ++ph) {
    run_phase(p, ph, smem);
    if constexpr (COOP) { if (ph + 1 < ph1) cg::this_grid().sync(); }
  }
}

extern "C" void kernel_launch(void* const* d_in, const int* in_sizes, int n_in, void* d_out, int out_size, void* d_ws, size_t ws_size, hipStream_t stream) {
  if (n_in != 23 || ws_size < WS_NEED) { fprintf(stderr, "kernel_launch: bad n_in %d or ws %zu < %zu\n", n_in, ws_size, (size_t)WS_NEED); return; }
  P p{};
  const float** f = (const float**)&p;
  for (int i = 0; i < 23; ++i) f[i] = (const float*)d_in[i];
  p.out = (float*)d_out; p.ws = (char*)d_ws;
  static int inited = 0, grid_blocks = 0;
  if (!inited) {
    hipFuncSetAttribute((const void*)mk_kernel<true>, hipFuncAttributeMaxDynamicSharedMemorySize, LDS_BYTES);
    hipFuncSetAttribute((const void*)mk_kernel<false>, hipFuncAttributeMaxDynamicSharedMemorySize, LDS_BYTES);
    int dev = 0, cus = 0, per_cu = 0;
    hipGetDevice(&dev); hipDeviceGetAttribute(&cus, hipDeviceAttributeMultiprocessorCount, dev);
    hipOccupancyMaxActiveBlocksPerMultiprocessor(&per_cu, mk_kernel<true>, 512, LDS_BYTES);
    if (per_cu > 1) per_cu = 1;
    grid_blocks = cus * per_cu; if (grid_blocks > 256) grid_blocks = 256; if (grid_blocks < 128) grid_blocks = 128;
    inited = 1;
  }
#if MK_COOP
  int ph0 = 0, ph1 = NPHASES;
  void* args[] = {&p, &ph0, &ph1};
  hipError_t er = hipLaunchCooperativeKernel((const void*)mk_kernel<true>, dim3(grid_blocks), dim3(512), args, LDS_BYTES, stream);
  if (er != hipSuccess) fprintf(stderr, "cooperative launch failed: %s (grid %d)\n", hipGetErrorString(er), grid_blocks);
#else
  for (int ph = 0; ph < NPHASES; ++ph) hipLaunchKernelGGL(mk_kernel<false>, dim3(256), dim3(512), LDS_BYTES, stream, p, ph, ph + 1);
#endif
}
```

```cpp
#include <hip/hip_runtime.h>
#include <hip/hip_cooperative_groups.h>
#include <cstdio>
#include <cstdint>
namespace cg = cooperative_groups;

#ifndef MK_COOP
#define MK_COOP 1
#endif

typedef unsigned short bf16_t;
typedef short bf16x8 __attribute__((ext_vector_type(8)));
typedef short s16x4 __attribute__((ext_vector_type(4)));
typedef float f32x16 __attribute__((ext_vector_type(16)));
typedef float f32x8 __attribute__((ext_vector_type(8)));
typedef float f32x4 __attribute__((ext_vector_type(4)));
typedef unsigned u32x4 __attribute__((ext_vector_type(4)));
#define DI __device__ __forceinline__
#define LBAR() do { asm volatile("s_waitcnt lgkmcnt(0)" ::: "memory"); __builtin_amdgcn_s_barrier(); asm volatile("" ::: "memory"); } while (0)
#define MFMA32(a, b, c) __builtin_amdgcn_mfma_f32_32x32x16_bf16((a), (b), (c), 0, 0, 0)

constexpr int DM = 1024, TB = 8448, CTXL = 256, LAT = 8192, MROWS = 2 * TB;
constexpr int NCH = 132;
constexpr int DFF = 2816;
constexpr int NREC = 3712;
constexpr float EPSF = 1e-6f;

constexpr size_t AL(size_t x) { return (x + 255) / 256 * 256; }
constexpr size_t OFF_XRES = 0;
constexpr size_t OFF_HBF = OFF_XRES + AL((size_t)MROWS * DM * 4);
constexpr size_t OFF_WC = OFF_HBF + AL((size_t)MROWS * DM * 2);
constexpr size_t WC_W2 = (size_t)5632 * 1024 * 2;
constexpr size_t OFF_MODS = OFF_WC + AL(WC_W2 + (size_t)1024 * 2816 * 2);
constexpr size_t OFF_SM = OFF_MODS + AL((size_t)4 * 3 * 6144 * 4);
constexpr size_t OFF_GB = OFF_SM + AL((size_t)MROWS * 64 * 4);
constexpr size_t OFF_SC = OFF_GB + AL((size_t)MROWS * 16 * 4);
constexpr size_t OFF_GL = OFF_SC + AL((size_t)16 * NCH * 64 * 2 * 4);
constexpr size_t OFF_D = OFF_GL + AL((size_t)16 * NCH * 4);
constexpr size_t D_P1 = 0;
constexpr size_t D_W = 0;
constexpr size_t D_INTRA = D_W + (size_t)16 * NCH * 64 * 128 * 2;
constexpr size_t D_P2 = D_P1 + (size_t)MROWS * 1536 * 2;
constexpr size_t D_QQ = D_P2 + (size_t)MROWS * 2048 * 2;
constexpr size_t D_QK = D_QQ + (size_t)MROWS * 512 * 2;
constexpr size_t D_QV = D_QK + (size_t)MROWS * 512 * 2;
constexpr size_t D_DNO = D_QK;
constexpr size_t D_KT = D_QV + (size_t)MROWS * 512 * 2;
constexpr size_t D_GLAO = D_KT + (size_t)MROWS * 512 * 2;
constexpr size_t D_END_E = D_GLAO + (size_t)2 * MROWS * 512 * 2;
constexpr size_t D_END_F = (size_t)MROWS * 5632 * 2;
constexpr size_t OFF_B16_1 = OFF_D + (D_END_E > D_END_F ? D_END_E : D_END_F);
constexpr size_t B16_BYTES = (size_t)8 * NCH * 64 * 64 * 2;
constexpr size_t WS_NEED = OFF_B16_1 + B16_BYTES;
constexpr int LDS_BYTES = 112 * 1024;

struct P {
  const float *x, *c, *ctx, *c_ctx, *mod_w, *mod_b, *rec_w_in, *rec_conv, *dn_a_log, *dn_dt_bias, *dn_norm, *gla_w2, *gla_b2, *gla_norm,
      *rec_w_out, *att_w_qkv, *att_q_norm, *att_k_norm, *att_w_out, *ffn_w_up, *ffn_conv, *ffn_w_down, *final_norm;
  float* out;
  char* ws;
};

DI int TIDX() { int t = threadIdx.x; asm volatile("" : "+v"(t)); return t; }
DI int BIDX() { int t = blockIdx.x; asm volatile("" : "+s"(t)); return t; }
DI int GDIM() { int t = gridDim.x; asm volatile("" : "+s"(t)); return t; }
DI float bf2f(bf16_t v) { return __uint_as_float(((unsigned)v) << 16); }
DI bf16_t f2bf(float x) { unsigned u = __float_as_uint(x); u += 0x7fffu + ((u >> 16) & 1u); return (bf16_t)(u >> 16); }
DI unsigned cvtpk(float lo, float hi) { unsigned r; asm volatile("v_cvt_pk_bf16_f32 %0, %1, %2" : "=v"(r) : "v"(lo), "v"(hi)); return r; }
DI int crow(int r, int hi) { return (r & 3) + 8 * (r >> 2) + 4 * hi; }
DI float siluf(float x) { return x / (1.f + expf(-x)); }
DI float sigmf(float x) { return 1.f / (1.f + expf(-x)); }
DI float softplusf(float x) { return fmaxf(x, 0.f) + log1pf(expf(-fabsf(x))); }
DI float wave_sum(float v) {
#pragma unroll
  for (int o = 32; o > 0; o >>= 1) v += __shfl_xor(v, o);
  return v;
}
DI int modrow_of(int R) { const int b = R >= TB ? 1 : 0; const int pp = R - b * TB; return pp < CTXL ? 2 : b; }
template <int KS>
DI f32x16 mma_rows(const bf16_t* arow, const bf16_t* brow, f32x16 acc) {
#pragma unroll
  for (int ks = 0; ks < KS; ++ks) {
    const bf16x8 a = *reinterpret_cast<const bf16x8*>(arow + ks * 16);
    const bf16x8 b = *reinterpret_cast<const bf16x8*>(brow + ks * 16);
    acc = MFMA32(a, b, acc);
  }
  return acc;
}

__device__ __forceinline__ void ph_init(const P& p, char* lds) {
  const int tid = TIDX();
  float* sc = (float*)lds;
  float* red = sc + 3072;
  for (int i = tid; i < 3072; i += 512) { const int r = i >> 10, k = i & 1023; const float v = r < 2 ? p.c[r * 1024 + k] : p.c_ctx[k]; sc[i] = siluf(v); }
  __syncthreads();
  float* mods = (float*)(p.ws + OFF_MODS);
  for (int job = BIDX(); job < 192; job += GDIM()) {
    const int col = job * 128 + (tid & 127), kq = tid >> 7;
    const int L = col / 6144, cl = col - L * 6144;
    const float* w = p.mod_w + ((size_t)L * 1024 + kq * 256) * 6144 + cl;
    float a0 = 0.f, a1 = 0.f, a2 = 0.f;
#pragma unroll 8
    for (int k = 0; k < 256; ++k) { const float wv = w[(size_t)k * 6144]; const int kk = kq * 256 + k; a0 += sc[kk] * wv; a1 += sc[1024 + kk] * wv; a2 += sc[2048 + kk] * wv; }
    red[(kq * 3 + 0) * 128 + (tid & 127)] = a0; red[(kq * 3 + 1) * 128 + (tid & 127)] = a1; red[(kq * 3 + 2) * 128 + (tid & 127)] = a2;
    __syncthreads();
    if (tid < 384) { const int r = tid >> 7, cc = tid & 127; const int c2 = job * 128 + cc; const int L2 = c2 / 6144, cl2 = c2 - L2 * 6144;
      const float s = red[(0 * 3 + r) * 128 + cc] + red[(1 * 3 + r) * 128 + cc] + red[(2 * 3 + r) * 128 + cc] + red[(3 * 3 + r) * 128 + cc] + p.mod_b[L2 * 6144 + cl2];
      mods[((size_t)L2 * 3 + r) * 6144 + cl2] = s; }
    __syncthreads();
  }
  f32x4* xr = (f32x4*)(p.ws + OFF_XRES);
  for (size_t i = (size_t)BIDX() * 512 + tid; i < (size_t)MROWS * 256; i += (size_t)GDIM() * 512) {
    const int R = (int)(i >> 8), c4 = (int)(i & 255); const int b = R >= TB ? 1 : 0, pp = R - b * TB;
    const float* src = pp < CTXL ? p.ctx + ((size_t)b * CTXL + pp) * 1024 : p.x + ((size_t)b * LAT + (pp - CTXL)) * 1024;
    xr[i] = *(const f32x4*)(src + c4 * 4);
  }
}

DI int rec_src_col(int n) { if (n < 2048) return n; if (n < 3584) return n + 16; if (n < 3600) return 2048 + (n - 3584); if (n < 3632) return n; return -1; }
__device__ __forceinline__ void cvt_weight(const float* __restrict__ W, bf16_t* __restrict__ Wt, int K, int Nsrc, int Npad, bool perm) {
  const size_t items = (size_t)Npad * (K >> 3);
  for (size_t it = (size_t)BIDX() * 512 + TIDX(); it < items; it += (size_t)GDIM() * 512) {
    const int n = (int)(it % Npad), kb = (int)(it / Npad);
    const int s = perm ? rec_src_col(n) : n;
    float v[8];
#pragma unroll
    for (int j = 0; j < 8; ++j) v[j] = s >= 0 ? W[(size_t)(kb * 8 + j) * Nsrc + s] : 0.f;
    u32x4 w = {cvtpk(v[0], v[1]), cvtpk(v[2], v[3]), cvtpk(v[4], v[5]), cvtpk(v[6], v[7])};
    *(u32x4*)(Wt + (size_t)n * K + kb * 8) = w;
  }
}

__device__ __forceinline__ void ph_norm(const P& p, int L, int which) {
  const int tid = TIDX(), wid = tid >> 6, lane = tid & 63;
  const float* xr = (const float*)(p.ws + OFF_XRES);
  bf16_t* hb = (bf16_t*)(p.ws + OFF_HBF);
  const float* mods = (const float*)(p.ws + OFF_MODS) + (size_t)L * 3 * 6144;
  for (int R = BIDX() * 8 + wid; R < MROWS; R += GDIM() * 8) {
    const float* row = xr + (size_t)R * 1024;
    f32x4 v[4]; float ss = 0.f;
#pragma unroll
    for (int i = 0; i < 4; ++i) { v[i] = *(const f32x4*)(row + i * 256 + lane * 4); ss += v[i][0] * v[i][0] + v[i][1] * v[i][1] + v[i][2] * v[i][2] + v[i][3] * v[i][3]; }
    ss = wave_sum(ss);
    const float rs = rsqrtf(ss * (1.f / 1024.f) + EPSF);
    const float* mr = mods + (size_t)modrow_of(R) * 6144 + which * 3072;
#pragma unroll
    for (int i = 0; i < 4; ++i) { const int c0 = i * 256 + lane * 4; const f32x4 sh = *(const f32x4*)(mr + c0), scl = *(const f32x4*)(mr + 1024 + c0);
      float o[4];
#pragma unroll
      for (int j = 0; j < 4; ++j) o[j] = v[i][j] * rs * (1.f + scl[j]) + sh[j];
      uint2 w; w.x = cvtpk(o[0], o[1]); w.y = cvtpk(o[2], o[3]);
      *(uint2*)(hb + (size_t)R * 1024 + c0) = w; }
  }
}

struct EpiRec { bf16_t* P1; bf16_t* P2; float* SM;
  DI void operator()(int row, int col, float v) const {
    if (col < 1536) P1[(size_t)row * 1536 + col] = f2bf(v);
    else if (col < 3584) P2[(size_t)row * 2048 + (col - 1536)] = f2bf(v);
    else { const int lc = col - 3584; if (lc < 48) SM[(size_t)row * 64 + lc] = v; } } };
struct EpiBf { bf16_t* O; int ldc;
  DI void operator()(int row, int col, float v) const { O[(size_t)row * ldc + col] = f2bf(v); } };
struct EpiRes { float* X; const float* gate;
  DI void operator()(int row, int col, float v) const { float* q = X + (size_t)row * 1024 + col; *q = *q + gate[(size_t)modrow_of(row) * 6144 + col] * v; } };

template <class Epi>
__device__ __forceinline__ void gemm_phase(char* lds, const bf16_t* __restrict__ A, int lda, const bf16_t* __restrict__ Bt, int K, int nN, const Epi epi) {
  const int tid = TIDX(), wid = tid >> 6, lane = tid & 63, r32 = lane & 31, hi = lane >> 5;
  const int wm = wid >> 1, wn = wid & 1;
  const int nk = K >> 6;
  constexpr int RS = 144, ASZ = 256 * RS, BSZ = 128 * RS, STG = ASZ + BSZ;
  const int ntiles = (MROWS / 256) * nN;
  const int srow = tid >> 3, spc = tid & 7;
  for (int t = BIDX(); t < ntiles; t += GDIM()) {
    const int pm = t / nN, pn = t - pm * nN;
    const bf16_t* Ab = A + (size_t)(pm * 256 + srow) * lda + spc * 8;
    const bf16_t* Bb = Bt + (size_t)(pn * 128 + srow) * K + spc * 8;
    f32x16 acc00 = {}, acc01 = {}, acc10 = {}, acc11 = {};
    bf16x8 ra0, ra1, ra2, ra3, rb0, rb1;
#define GLOAD(kt) do { const int ko = (kt) * 64; ra0 = *(const bf16x8*)(Ab + ko); ra1 = *(const bf16x8*)(Ab + (size_t)64 * lda + ko); ra2 = *(const bf16x8*)(Ab + (size_t)128 * lda + ko); \
    ra3 = *(const bf16x8*)(Ab + (size_t)192 * lda + ko); rb0 = *(const bf16x8*)(Bb + ko); rb1 = *(const bf16x8*)(Bb + (size_t)64 * K + ko); } while (0)
#define SWRITE(buf) do { char* sb = lds + (buf) * STG + srow * RS + spc * 16; *(bf16x8*)(sb) = ra0; *(bf16x8*)(sb + 64 * RS) = ra1; *(bf16x8*)(sb + 128 * RS) = ra2; *(bf16x8*)(sb + 192 * RS) = ra3; \
    *(bf16x8*)(sb + ASZ) = rb0; *(bf16x8*)(sb + ASZ + 64 * RS) = rb1; } while (0)
    GLOAD(0); SWRITE(0); __syncthreads();
    for (int kt = 0; kt < nk; ++kt) {
      const int cur = kt & 1;
      if (kt + 1 < nk) GLOAD(kt + 1);
      const char* ab = lds + cur * STG + (64 * wm + r32) * RS + hi * 16;
      const char* bb = lds + cur * STG + ASZ + (64 * wn + r32) * RS + hi * 16;
#pragma unroll
      for (int ks = 0; ks < 4; ++ks) {
        const bf16x8 a0 = *(const bf16x8*)(ab + ks * 32), a1 = *(const bf16x8*)(ab + 32 * RS + ks * 32);
        const bf16x8 b0 = *(const bf16x8*)(bb + ks * 32), b1 = *(const bf16x8*)(bb + 32 * RS + ks * 32);
        acc00 = MFMA32(a0, b0, acc00); acc01 = MFMA32(a0, b1, acc01); acc10 = MFMA32(a1, b0, acc10); acc11 = MFMA32(a1, b1, acc11);
      }
      if (kt + 1 < nk) SWRITE(cur ^ 1);
      __syncthreads();
    }
#undef GLOAD
#undef SWRITE
    const int row0 = pm * 256 + 64 * wm, col0 = pn * 128 + 64 * wn + r32;
#pragma unroll
    for (int r = 0; r < 16; ++r) { const int rr = row0 + crow(r, hi);
      epi(rr, col0, acc00[r]); epi(rr, col0 + 32, acc01[r]); epi(rr + 32, col0, acc10[r]); epi(rr + 32, col0 + 32, acc11[r]); }
  }
}

__device__ __forceinline__ void ph_dnprep(const P& p, char* lds, int e) {
  const int tid = TIDX(), wid = tid >> 6, lane = tid & 63;
  const bf16_t* P1 = (const bf16_t*)(p.ws + OFF_D + D_P1);
  bf16_t* QQ = (bf16_t*)(p.ws + OFF_D + D_QQ); bf16_t* QK = (bf16_t*)(p.ws + OFF_D + D_QK); bf16_t* QV = (bf16_t*)(p.ws + OFF_D + D_QV);
  bf16_t* KT = (bf16_t*)(p.ws + OFF_D + D_KT);
  const float* SM = (const float*)(p.ws + OFF_SM); float* GB = (float*)(p.ws + OFF_GB);
  const float* cw = p.rec_conv + (size_t)e * 3 * 1536;
  bf16_t* kl = (bf16_t*)lds;
  for (int job = BIDX(); job < MROWS / 64; job += GDIM()) {
    const int R0 = job * 64;
    for (int tt = 0; tt < 8; ++tt) {
      const int tl = wid * 8 + tt, R = R0 + tl; const int b = R >= TB ? 1 : 0, pp = R - b * TB;
      const bool hasp = !(pp == 0 || pp == CTXL), hasn = !(pp == CTXL - 1 || pp == TB - 1);
#pragma unroll
      for (int part = 0; part < 3; ++part) {
        const int ch = part * 512 + lane * 8;
        const bf16x8 zc = *(const bf16x8*)(P1 + (size_t)R * 1536 + ch);
        bf16x8 zp = {}, zn = {};
        if (hasp) zp = *(const bf16x8*)(P1 + (size_t)(R - 1) * 1536 + ch);
        if (hasn) zn = *(const bf16x8*)(P1 + (size_t)(R + 1) * 1536 + ch);
        float o[8]; float ss = 0.f;
#pragma unroll
        for (int j = 0; j < 8; ++j) { const float a = bf2f((bf16_t)zp[j]) * cw[ch + j] + bf2f((bf16_t)zc[j]) * cw[1536 + ch + j] + bf2f((bf16_t)zn[j]) * cw[3072 + ch + j];
          o[j] = siluf(a); ss += o[j] * o[j]; }
        if (part < 2) {
          ss += __shfl_xor(ss, 1); ss += __shfl_xor(ss, 2); ss += __shfl_xor(ss, 4); ss += __shfl_xor(ss, 8);
          float sc = rsqrtf(ss + EPSF); if (part == 0) sc *= 0.08838834764831845f;
#pragma unroll
          for (int j = 0; j < 8; ++j) o[j] *= sc;
        }
        u32x4 w = {cvtpk(o[0], o[1]), cvtpk(o[2], o[3]), cvtpk(o[4], o[5]), cvtpk(o[6], o[7])};
        bf16_t* dst = part == 0 ? QQ : (part == 1 ? QK : QV);
        *(u32x4*)(dst + (size_t)R * 512 + lane * 8) = w;
        if (part == 1) *(u32x4*)(kl + tl * 512 + lane * 8) = w;
      }
      if (lane < 16) {
        const int q = lane & 7;
        if (lane < 8) { const float da = SM[(size_t)R * 64 + q]; GB[(size_t)R * 16 + q] = -expf(p.dn_a_log[e * 8 + q]) * softplusf(da + p.dn_dt_bias[e * 8 + q]); }
        else { const float db = SM[(size_t)R * 64 + 8 + q]; GB[(size_t)R * 16 + 8 + q] = sigmf(db); }
      }
    }
    __syncthreads();
    {
      const int b = R0 >= TB ? 1 : 0, c = (R0 - b * TB) / 64; const int h = tid >> 7, dk = tid & 127;
      bf16_t* dst = KT + ((((size_t)b * 4 + h) * NCH + c) * 128 + dk) * 64;
#pragma unroll
      for (int g8 = 0; g8 < 8; ++g8) { unsigned w[4];
#pragma unroll
        for (int j = 0; j < 4; ++j) { const unsigned lo = kl[(g8 * 8 + 2 * j) * 512 + tid], hi2 = kl[(g8 * 8 + 2 * j + 1) * 512 + tid]; w[j] = lo | (hi2 << 16); }
        *(u32x4*)(dst + g8 * 8) = (u32x4){w[0], w[1], w[2], w[3]}; }
    }
    __syncthreads();
  }
}

__device__ __forceinline__ void ph_dn_d1(const P& p, char* lds) {
  const int tid = TIDX(), wid = tid >> 6, lane = tid & 63, r32 = lane & 31, hi = lane >> 5;
  const bf16_t* QQ = (const bf16_t*)(p.ws + OFF_D + D_QQ); const bf16_t* QK = (const bf16_t*)(p.ws + OFF_D + D_QK); const bf16_t* QV = (const bf16_t*)(p.ws + OFF_D + D_QV);
  const float* GB = (const float*)(p.ws + OFF_GB);
  bf16_t* W_ = (bf16_t*)(p.ws + OFF_D + D_W); bf16_t* U_ = (bf16_t*)(p.ws + OFF_HBF); bf16_t* INTRA = (bf16_t*)(p.ws + OFF_D + D_INTRA);
  float* SC = (float*)(p.ws + OFF_SC); float* GLS = (float*)(p.ws + OFF_GL);
  float* KK = (float*)lds; float* QKm = KK + 64 * 65; float* Ad = QKm + 64 * 65; float* Gs = Ad + 2 * 4096; float* Bs = Gs + 128;
  for (int job = BIDX(); job < 8 * NCH; job += GDIM()) {
    const int b = job / (4 * NCH), h = (job / NCH) & 3, c = job % NCH;
    const size_t Rb = (size_t)b * TB + (size_t)c * 64;
    {
      const int w4 = wid & 3, mi = w4 & 1, ni = w4 >> 1;
      const bf16_t* As = wid < 4 ? QK : QQ;
      const bf16_t* arow = As + (Rb + 32 * mi + r32) * 512 + h * 128 + hi * 8;
      const bf16_t* brow = QK + (Rb + 32 * ni + r32) * 512 + h * 128 + hi * 8;
      f32x16 acc = {}; acc = mma_rows<8>(arow, brow, acc);
      float* dst = wid < 4 ? KK : QKm;
#pragma unroll
      for (int r = 0; r < 16; ++r) dst[(32 * mi + crow(r, hi)) * 65 + 32 * ni + r32] = acc[r];
    }
    if (tid < 128) { const int d = tid >> 6, ip = tid & 63, t = d ? 63 - ip : ip; Gs[tid] = GB[(Rb + t) * 16 + d * 4 + h]; Bs[tid] = GB[(Rb + t) * 16 + 8 + d * 4 + h]; }
    __syncthreads();
    if (tid == 0 || tid == 64) { float s = 0.f; for (int i = 0; i < 64; ++i) { s += Gs[tid + i]; Gs[tid + i] = s; } }
    __syncthreads();
    const int n0 = c, n1 = c < 4 ? 3 - c : 135 - c;
    const size_t cj0 = ((size_t)(0 * 2 + b) * 4 + h) * NCH + n0, cj1 = ((size_t)(1 * 2 + b) * 4 + h) * NCH + n1;
    for (int e2 = tid; e2 < 8192; e2 += 512) {
      const int d = e2 >> 12, ip = (e2 >> 6) & 63, jp = e2 & 63; const int i = d ? 63 - ip : ip, j = d ? 63 - jp : jp;
      const float dec = jp <= ip ? expf(Gs[d * 64 + ip] - Gs[d * 64 + jp]) : 0.f;
      Ad[d * 4096 + ip * 64 + jp] = jp < ip ? Bs[d * 64 + ip] * KK[i * 65 + j] * dec : 0.f;
      const size_t cj = d ? cj1 : cj0;
      INTRA[(cj * 64 + ip) * 64 + jp] = f2bf(QKm[i * 65 + j] * dec);
    }
    if (tid < 128) { const int d = tid >> 6, ip = tid & 63; const size_t cj = d ? cj1 : cj0; const float gi = Gs[tid], gl = Gs[d * 64 + 63];
      SC[(cj * 64 + ip) * 2] = expf(gi); SC[(cj * 64 + ip) * 2 + 1] = expf(gl - gi); if (ip == 0) GLS[cj] = expf(gl); }
    __syncthreads();
    {
      const int d = tid >> 8, cc = tid & 255; const size_t cj = d ? cj1 : cj0;
      int dofs = d * 64, aofs = d * 4096; asm volatile("" : "+v"(dofs), "+v"(aofs));
      float x[64];
      {
        const bf16_t* srcb = (cc < 128 ? QV + h * 128 + cc : QK + h * 128 + (cc - 128)) + (Rb + (d ? 63 : 0)) * 512;
        const long step = d ? -512 : 512;
#pragma unroll
        for (int g = 0; g < 8; ++g) {
#pragma unroll
          for (int q8 = 0; q8 < 8; ++q8) { const int ip = g * 8 + q8; x[ip] = bf2f(srcb[ip * step]); }
          asm volatile("" ::: "memory");
        }
        if (cc < 128) {
#pragma unroll
          for (int ip = 0; ip < 64; ++ip) x[ip] *= Bs[dofs + ip];
        } else {
#pragma unroll
          for (int ip = 0; ip < 64; ++ip) x[ip] *= Bs[dofs + ip] * expf(Gs[dofs + ip]);
        }
      }
      const float* Arow = Ad + aofs;
#pragma unroll
      for (int ip = 1; ip < 64; ++ip) {
        float s = 0.f;
#pragma unroll
        for (int j4 = 0; j4 < (ip + 3) / 4; ++j4) { const f32x4 a = *(const f32x4*)(Arow + ip * 64 + 4 * j4);
          s += a[0] * x[4 * j4] + a[1] * x[4 * j4 + 1] + a[2] * x[4 * j4 + 2] + a[3] * x[4 * j4 + 3]; }
        x[ip] -= s;
      }
      bf16_t* dst = cc < 128 ? U_ + cj * 64 * 128 + cc : W_ + cj * 64 * 128 + (cc - 128);
#pragma unroll
      for (int ip = 0; ip < 64; ++ip) dst[ip * 128] = f2bf(x[ip]);
    }
    __syncthreads();
  }
}

typedef _Float16 h16x8 __attribute__((ext_vector_type(8)));
__device__ __forceinline__ void ph_gla_b(const P& p, char* lds, int e) {
  const int tid = TIDX(), wid = tid >> 6, lane = tid & 63;
  const float* SM = (const float*)(p.ws + OFF_SM);
  float* w2S = (float*)lds;
  float* b2S = w2S + 8192;
  for (int i = tid; i < 8192; i += 512) { const int d = i >> 12, hh = (i >> 10) & 3, r = (i >> 6) & 15, j = i & 63; w2S[i] = p.gla_w2[(((size_t)e * 2 + d) * 16 + r) * 256 + hh * 64 + j]; }
  if (tid < 512) b2S[tid] = p.gla_b2[(size_t)e * 512 + tid];
  __syncthreads();
  int jb = 8 * wid; asm volatile("" : "+v"(jb));
  for (int job = BIDX(); job < 16 * NCH; job += GDIM()) {
    const int n = job % NCH, sq = job / NCH; const int dir = sq >> 3, b = (sq >> 2) & 1, h = sq & 3;
    const int c = dir == 0 ? n : (n < 4 ? 3 - n : 135 - n);
    const size_t row = (size_t)b * TB + (size_t)c * 64 + (dir ? 63 - lane : lane);
    const float* gp = SM + row * 64 + 16 + dir * 16;
    const f32x4 g0 = *(const f32x4*)(gp), g1 = *(const f32x4*)(gp + 4), g2 = *(const f32x4*)(gp + 8), g3 = *(const f32x4*)(gp + 12);
    const float gg_[16] = {g0[0], g0[1], g0[2], g0[3], g1[0], g1[1], g1[2], g1[3], g2[0], g2[1], g2[2], g2[3], g3[0], g3[1], g3[2], g3[3]};
    const float* wb = w2S + (dir * 4 + h) * 1024 + jb; const float* bb2 = b2S + dir * 256 + h * 64 + jb;
    f32x4 sa = *(const f32x4*)(bb2), sb = *(const f32x4*)(bb2 + 4);
#pragma unroll
    for (int r = 0; r < 16; ++r) { const f32x4 wa = *(const f32x4*)(wb + r * 64), wq = *(const f32x4*)(wb + r * 64 + 4); sa += gg_[r] * wa; sb += gg_[r] * wq; }
    float la[8];
#pragma unroll
    for (int jj = 0; jj < 4; ++jj) { const float x0 = sa[jj], x1 = sb[jj];
      la[jj] = (fminf(x0, 0.f) - log1pf(expf(-fabsf(x0)))) * 0.0625f; la[4 + jj] = (fminf(x1, 0.f) - log1pf(expf(-fabsf(x1)))) * 0.0625f; }
#pragma unroll
    for (int o = 1; o < 64; o <<= 1) {
#pragma unroll
      for (int jj = 0; jj < 8; ++jj) { const float v = __shfl_up(la[jj], o); la[jj] += lane >= o ? v : 0.f; }
    }
    h16x8 hv;
#pragma unroll
    for (int jj = 0; jj < 8; ++jj) hv[jj] = (_Float16)la[jj];
    _Float16* dst = (_Float16*)(p.ws + (dir ? OFF_B16_1 : OFF_WC)) + ((((size_t)b * 4 + h) * NCH + n) * 64 + lane) * 64 + jb;
    *(h16x8*)dst = hv;
  }
}

struct DnSet { bf16x8 fa[8]; };
__device__ __forceinline__ void dn_scan(const P& p, char* lds, int job) {
  const int tid = TIDX(), wid = tid >> 6, lane = tid & 63, r32 = lane & 31, hi = lane >> 5;
  const int dir = job >> 5, b = (job >> 4) & 1, h = (job >> 2) & 3, n0 = (job & 3) * 32;
  const bf16_t* QQ = (const bf16_t*)(p.ws + OFF_D + D_QQ); const bf16_t* KT = (const bf16_t*)(p.ws + OFF_D + D_KT);
  const bf16_t* W_ = (const bf16_t*)(p.ws + OFF_D + D_W); const bf16_t* U_ = (const bf16_t*)(p.ws + OFF_HBF); const bf16_t* INTRA = (const bf16_t*)(p.ws + OFF_D + D_INTRA);
  const float* SC = (const float*)(p.ws + OFF_SC); const float* GLS = (const float*)(p.ws + OFF_GL);
  bf16_t* DNO = (bf16_t*)(p.ws + OFF_D + D_DNO);
  bf16_t* ST = (bf16_t*)lds; bf16_t* vTa = ST + 32 * 136; bf16_t* vTb = vTa + 32 * 72;
  float* scS = (float*)(vTb + 32 * 72);
  bf16_t* uS = (bf16_t*)(scS + 256);
  bf16_t* inS = uS + 2 * 64 * 40;
  for (int i = tid; i < 32 * 136; i += 512) ST[i] = 0;
  f32x16 accS = {};
  const size_t seq = ((size_t)dir * 2 + b) * 4 + h;
  const int mi = wid & 1, di = wid - 4;
  const int role = wid < 2 ? 0 : (wid < 4 ? 1 : 2);
  const int tt = tid - 256;
  DnSet sA, sB;
  u32x4 stU, stI0; float stS = 0.f, glA = 0.f, glB = 0.f;
#define DN_CH(n_) const int n__ = (n_); const int c__ = dir == 0 ? n__ : (n__ < 4 ? 3 - n__ : 135 - n__); const size_t Rb__ = (size_t)b * TB + (size_t)c__ * 64; const size_t cj__ = seq * NCH + n__;
#define DN_LOAD(S, GL, n_) do { DN_CH(n_) \
    const int ipl__ = 32 * mi + r32, tl__ = dir ? 63 - ipl__ : ipl__; \
    const bf16_t* b0__ = W_ + cj__ * 8192 + (32 * mi + r32) * 128 + hi * 8; \
    const bf16_t* b1__ = QQ + (Rb__ + tl__) * 512 + h * 128 + hi * 8; \
    const bf16_t* b2__ = KT + ((((size_t)b * 4 + h) * NCH + c__) * 128 + 32 * (wid & 3) + r32) * 64 + hi * 8; \
    const bf16_t* bs__ = role == 0 ? b0__ : (role == 1 ? b1__ : b2__); \
    _Pragma("unroll") for (int ks = 0; ks < 8; ++ks) S.fa[ks] = *(const bf16x8*)(bs__ + ks * 16); \
    GL = GLS[cj__]; } while (0)
#define DN_STAGE_LD(n_) do { DN_CH(n_) (void)Rb__; \
      stU = *(const u32x4*)(U_ + cj__ * 8192 + ((tid & 255) >> 2) * 128 + n0 + (tid & 3) * 8); \
      stI0 = *(const u32x4*)(INTRA + cj__ * 4096 + (tid >> 3) * 64 + (tid & 7) * 8); \
      stS = SC[cj__ * 128 + (tid & 127)]; } while (0)
#define DN_STAGE_ST(bf_) do { *(u32x4*)(inS + (bf_) * 4608 + (tid >> 3) * 72 + (tid & 7) * 8) = stI0; \
      if (tid < 256) *(u32x4*)(uS + (bf_) * 2560 + (tid >> 2) * 40 + (tid & 3) * 8) = stU; \
      if (tid < 128) scS[(bf_) * 128 + tid] = stS; } while (0)
#define DN_STEP(S, GL, n_, bf_) do { DN_CH(n_) (void)cj__; \
    const float* sc__ = scS + (bf_) * 128; \
    f32x16 acc = {}; \
    if (role < 2) { const bf16_t* sb__ = ST + r32 * 136 + hi * 8; \
      _Pragma("unroll") for (int ks = 0; ks < 8; ++ks) acc = MFMA32(S.fa[ks], *(const bf16x8*)(sb__ + ks * 16), acc); \
      if (role == 0) { const bf16_t* us__ = uS + (bf_) * 2560 + r32; \
        _Pragma("unroll") for (int r = 0; r < 16; ++r) { const int ip = 32 * mi + crow(r, hi); const float vn = bf2f(us__[ip * 40]) - acc[r]; \
          vTa[r32 * 72 + ip] = f2bf(vn); const int to = dir ? 63 - ip : ip; vTb[r32 * 72 + to] = f2bf(vn * sc__[ip * 2 + 1]); } } \
      else { _Pragma("unroll") for (int r = 0; r < 16; ++r) acc[r] *= sc__[(32 * mi + crow(r, hi)) * 2]; } } \
    LBAR(); \
    if (role == 1) { const bf16_t* vb__ = vTa + r32 * 72 + hi * 8; const bf16_t* ib__ = inS + (bf_) * 4608 + (32 * mi + r32) * 72 + hi * 8; \
      _Pragma("unroll") for (int ks = 0; ks < 4; ++ks) acc = MFMA32(*(const bf16x8*)(ib__ + ks * 16), *(const bf16x8*)(vb__ + ks * 16), acc); \
      _Pragma("unroll") for (int r = 0; r < 16; ++r) { const int ip = 32 * mi + crow(r, hi), t = dir ? 63 - ip : ip; \
        DNO[((size_t)dir * MROWS + Rb__ + t) * 512 + h * 128 + n0 + r32] = f2bf(acc[r]); } } \
    else if (role == 2) { const bf16_t* vb__ = vTb + r32 * 72 + hi * 8; \
      _Pragma("unroll") for (int r = 0; r < 16; ++r) accS[r] *= GL; \
      _Pragma("unroll") for (int ks = 0; ks < 4; ++ks) accS = MFMA32(S.fa[ks], *(const bf16x8*)(vb__ + ks * 16), accS); \
      _Pragma("unroll") for (int r = 0; r < 16; ++r) ST[r32 * 136 + 32 * di + crow(r, hi)] = f2bf(accS[r]); } \
    DN_STAGE_ST((bf_) ^ 1); \
    LBAR(); } while (0)
  DN_STAGE_LD(0); DN_STAGE_ST(0);
  DN_LOAD(sA, glA, 0);
  __syncthreads();
  for (int n = 0; n < NCH; n += 2) {
    DN_LOAD(sB, glB, n + 1); DN_STAGE_LD(n + 1);
    DN_STEP(sA, glA, n, 0);
    { const int n2 = n + 2 < NCH ? n + 2 : NCH - 1; DN_LOAD(sA, glA, n2); DN_STAGE_LD(n2); }
    DN_STEP(sB, glB, n + 1, 1);
  }
#undef DN_CH
#undef DN_LOAD
#undef DN_STAGE_LD
#undef DN_STAGE_ST
#undef DN_STEP
}

DI float fast_logsig(float s) { return fminf(s, 0.f) - __logf(1.f + __expf(-fabsf(s))); }
struct GlaRegs { h16x8 ba, bb; bf16x8 qa, qb, ka, kb, v8; };
__device__ __forceinline__ void gla_scan(const P& p, char* lds, int job, int e) {
  const int tid = TIDX(), wid = tid >> 6, lane = tid & 63, r32 = lane & 31, hi = lane >> 5;
  const int dir = job >> 5, b = (job >> 4) & 1, h = (job >> 2) & 3, n0 = (job & 3) * 32;
  const bf16_t* P2 = (const bf16_t*)(p.ws + OFF_D + D_P2); const float* SM = (const float*)(p.ws + OFF_SM);
  bf16_t* GLAO = (bf16_t*)(p.ws + OFF_D + D_GLAO);
  const _Float16* B16 = (const _Float16*)(p.ws + (dir ? OFF_B16_1 : OFF_WC));
  float* w2S = (float*)lds; float* b2S = w2S + 1024; float* aLb = b2S + 64;
  bf16_t* ops = (bf16_t*)(aLb + 128);
  constexpr int OPB = (4 * 64 + 32) * 72;
  bf16_t* attp = ops + 2 * OPB;
  bf16_t* STb = attp + 2 * 32 * 72;
  for (int i = tid; i < 2 * 32 * 72; i += 512) STb[i] = 0;
  f32x16 accS = {};
  __syncthreads();
  GlaRegs RA;
  int jb0 = 16 * (wid & 3); asm volatile("" : "+v"(jb0));
  int vtb0 = 8 * (wid & 3) * 72 + lane; asm volatile("" : "+v"(vtb0));
#define GLA_LOAD(R, n_) do { const int n__ = (n_) < NCH ? (n_) : NCH - 1; const int c__ = dir == 0 ? n__ : (n__ < 4 ? 3 - n__ : 135 - n__); const size_t row__ = (size_t)b * TB + (size_t)c__ * 64 + (dir ? 63 - lane : lane); \
    const _Float16* bp__ = B16 + ((((size_t)b * 4 + h) * NCH + n__) * 64 + lane) * 64 + 16 * (wid & 3); R.ba = *(const h16x8*)(bp__); R.bb = *(const h16x8*)(bp__ + 8); \
    const bf16_t* pr__ = P2 + row__ * 2048; R.qa = *(const bf16x8*)(pr__ + 512 + h * 64 + 16 * (wid & 3)); R.qb = *(const bf16x8*)(pr__ + 512 + h * 64 + 16 * (wid & 3) + 8); \
    R.ka = *(const bf16x8*)(pr__ + 768 + h * 64 + 16 * (wid & 3)); R.kb = *(const bf16x8*)(pr__ + 768 + h * 64 + 16 * (wid & 3) + 8); R.v8 = *(const bf16x8*)(pr__ + 1024 + h * 128 + n0 + 8 * (wid & 3)); } while (0)
#define GLA_HALF(R, BV, QV, KV, jb) do { \
    float eqe[8], eke[8], eqi[8]; \
    _Pragma("unroll") for (int jj = 0; jj < 8; ++jj) { const int j = (jb) + jj; const float bb = (float)BV[jj]; const float bm = __int_as_float(__builtin_amdgcn_readlane(__float_as_int(bb), 32)), bl = __int_as_float(__builtin_amdgcn_readlane(__float_as_int(bb), 63)); \
      const float q_ = bf2f((bf16_t)QV[jj]) * 0.125f, k_ = bf2f((bf16_t)KV[jj]); \
      eqe[jj] = q_ * __expf(bb - bm); eke[jj] = k_ * __expf(bm - bb); eqi[jj] = q_ * __expf(bb); ksT_[j * 72 + lane] = f2bf(k_ * __expf(bl - bb)); if (lane == 63) aL_[j] = __expf(bl); } \
    *(u32x4*)(qe_ + lane * 72 + (jb)) = (u32x4){cvtpk(eqe[0], eqe[1]), cvtpk(eqe[2], eqe[3]), cvtpk(eqe[4], eqe[5]), cvtpk(eqe[6], eqe[7])}; \
    *(u32x4*)(ke_ + lane * 72 + (jb)) = (u32x4){cvtpk(eke[0], eke[1]), cvtpk(eke[2], eke[3]), cvtpk(eke[4], eke[5]), cvtpk(eke[6], eke[7])}; \
    *(u32x4*)(qi_ + lane * 72 + (jb)) = (u32x4){cvtpk(eqi[0], eqi[1]), cvtpk(eqi[2], eqi[3]), cvtpk(eqi[4], eqi[5]), cvtpk(eqi[6], eqi[7])}; } while (0)
#define GLA_PREP(R, bf_) do { bf16_t* qe_ = ops + (bf_) * OPB; bf16_t* ke_ = qe_ + 64 * 72; bf16_t* qi_ = ke_ + 64 * 72; bf16_t* ksT_ = qi_ + 64 * 72; bf16_t* vT_ = ksT_ + 64 * 72; float* aL_ = aLb + (bf_) * 64; \
    GLA_HALF(R, R.ba, R.qa, R.ka, jb0); GLA_HALF(R, R.bb, R.qb, R.kb, jb0 + 8); \
    _Pragma("unroll") for (int q_ = 0; q_ < 8; ++q_) vT_[vtb0 + q_ * 72] = (bf16_t)R.v8[q_]; } while (0)
#define GLA_MMA(n_, bf_) do { const int nq__ = (n_); const int bf = (bf_); \
      const bf16_t* qe_ = ops + bf * OPB; const bf16_t* ke_ = qe_ + 64 * 72; const bf16_t* qi_ = ke_ + 64 * 72; const bf16_t* ksT_ = qi_ + 64 * 72; const bf16_t* vT_ = ksT_ + 64 * 72; const float* aL_ = aLb + bf * 64; \
      const bf16_t* STr = STb + bf * 32 * 72; bf16_t* STw = STb + (bf ^ 1) * 32 * 72; \
      if (wid < 6) { \
        const int mi = wid - 4; bf16_t* attw = attp + mi * 32 * 72; \
        const int c = dir == 0 ? nq__ : (nq__ < 4 ? 3 - nq__ : 135 - nq__); const size_t Rb = (size_t)b * TB + (size_t)c * 64; \
        f32x16 acc = {}; acc = mma_rows<4>(qi_ + (32 * mi + r32) * 72 + hi * 8, STr + r32 * 72 + hi * 8, acc); \
        { f32x16 a0 = {}; a0 = mma_rows<4>(qe_ + (32 * mi + r32) * 72 + hi * 8, ke_ + r32 * 72 + hi * 8, a0); \
          _Pragma("unroll") for (int r = 0; r < 16; ++r) { const int ipl = crow(r, hi); attw[ipl * 72 + r32] = f2bf((mi == 1 || r32 <= ipl) ? a0[r] : 0.f); } \
          f32x16 a1 = {}; if (mi == 1) a1 = mma_rows<4>(qe_ + (32 + r32) * 72 + hi * 8, ke_ + (32 + r32) * 72 + hi * 8, a1); \
          _Pragma("unroll") for (int r = 0; r < 16; ++r) { const int ipl = crow(r, hi); attw[ipl * 72 + 32 + r32] = f2bf((mi == 1 && r32 <= ipl) ? a1[r] : 0.f); } } \
        asm volatile("s_waitcnt lgkmcnt(0)" ::: "memory"); \
        acc = mma_rows<4>(attw + r32 * 72 + hi * 8, vT_ + r32 * 72 + hi * 8, acc); \
        _Pragma("unroll") for (int r = 0; r < 16; ++r) { const int ip = 32 * mi + crow(r, hi), t = dir ? 63 - ip : ip; \
          GLAO[((size_t)dir * MROWS + Rb + t) * 512 + h * 128 + n0 + r32] = f2bf(acc[r]); } \
      } else { \
        const int di = wid - 6; \
        _Pragma("unroll") for (int r = 0; r < 16; ++r) accS[r] *= aL_[32 * di + crow(r, hi)]; \
        accS = mma_rows<4>(ksT_ + (32 * di + r32) * 72 + hi * 8, vT_ + r32 * 72 + hi * 8, accS); \
        _Pragma("unroll") for (int r = 0; r < 16; ++r) STw[r32 * 72 + 32 * di + crow(r, hi)] = f2bf(accS[r]); \
      } } while (0)
  GLA_LOAD(RA, 0);
  if (wid < 4) { GLA_PREP(RA, 0); }
  GLA_LOAD(RA, 1);
  LBAR();
  for (int n = 0; n < NCH; n += 2) {
    if (wid < 4) { GLA_PREP(RA, 1); } else { GLA_MMA(n, 0); }
    GLA_LOAD(RA, n + 2);
    LBAR();
    if (wid < 4) { if (n + 2 < NCH) { GLA_PREP(RA, 0); } } else { GLA_MMA(n + 1, 1); }
    GLA_LOAD(RA, n + 3);
    LBAR();
  }
#undef GLA_MMA
#undef GLA_LOAD
#undef GLA_HALF
#undef GLA_PREP
}

__device__ __forceinline__ void ph_merge(const P& p, int e) {
  const int tid = TIDX(), wid = tid >> 6, lane = tid & 63;
  const bf16_t* DNO = (const bf16_t*)(p.ws + OFF_D + D_DNO); const bf16_t* GLAO = (const bf16_t*)(p.ws + OFF_D + D_GLAO);
  const bf16_t* P2 = (const bf16_t*)(p.ws + OFF_D + D_P2); bf16_t* hb = (bf16_t*)(p.ws + OFF_HBF);
  for (int R = BIDX() * 8 + wid; R < MROWS; R += GDIM() * 8) {
#pragma unroll
    for (int g = 0; g < 8; ++g) {
      const bf16_t* src = g < 4 ? DNO : GLAO; const int hc = (g & 3) * 128 + lane * 2;
      const unsigned a = *(const unsigned*)(src + (size_t)R * 512 + hc), bq = *(const unsigned*)(src + ((size_t)MROWS + R) * 512 + hc);
      const float v0 = bf2f((bf16_t)(a & 0xffff)) + bf2f((bf16_t)(bq & 0xffff)), v1 = bf2f((bf16_t)(a >> 16)) + bf2f((bf16_t)(bq >> 16));
      const float ss = wave_sum(v0 * v0 + v1 * v1);
      const float rs = rsqrtf(ss * (1.f / 128.f) + EPSF);
      const float* nw = g < 4 ? p.dn_norm + e * 128 : p.gla_norm + e * 128;
      const unsigned zz = *(const unsigned*)(P2 + (size_t)R * 2048 + (g < 4 ? 0 : 1536) + hc);
      const float z0 = bf2f((bf16_t)(zz & 0xffff)), z1 = bf2f((bf16_t)(zz >> 16));
      const float o0 = v0 * rs * nw[lane * 2] * siluf(z0), o1 = v1 * rs * nw[lane * 2 + 1] * siluf(z1);
      *(unsigned*)(hb + (size_t)R * 1024 + g * 128 + lane * 2) = cvtpk(o0, o1);
    }
  }
}

__device__ __forceinline__ void ph_ffnact(const P& p, int L) {
  bf16_t* U = (bf16_t*)(p.ws + OFF_D);
  const float* cw = p.ffn_conv + (size_t)L * 3 * DFF;
  const size_t items = (size_t)MROWS * 352;
  for (size_t it = (size_t)BIDX() * 512 + TIDX(); it < items; it += (size_t)GDIM() * 512) {
    const int R = (int)(it / 352), c0 = (int)(it % 352) * 8; const int b = R >= TB ? 1 : 0, pp = R - b * TB;
    const bool hasp = !(pp == 0 || pp == CTXL), hasn = !(pp == CTXL - 1 || pp == TB - 1);
    const bf16x8 zc = *(const bf16x8*)(U + (size_t)R * 5632 + c0); bf16x8 zp = {}, zn = {};
    if (hasp) zp = *(const bf16x8*)(U + (size_t)(R - 1) * 5632 + c0);
    if (hasn) zn = *(const bf16x8*)(U + (size_t)(R + 1) * 5632 + c0);
    const bf16x8 vv = *(const bf16x8*)(U + (size_t)R * 5632 + DFF + c0);
    float o[8];
#pragma unroll
    for (int j = 0; j < 8; ++j) { const float a = bf2f((bf16_t)zp[j]) * cw[c0 + j] + bf2f((bf16_t)zc[j]) * cw[DFF + c0 + j] + bf2f((bf16_t)zn[j]) * cw[2 * DFF + c0 + j];
      o[j] = siluf(a) * bf2f((bf16_t)vv[j]); }
    u32x4 w = {cvtpk(o[0], o[1]), cvtpk(o[2], o[3]), cvtpk(o[4], o[5]), cvtpk(o[6], o[7])};
    *(u32x4*)(U + (size_t)R * 5632 + DFF + c0) = w;
  }
}

__device__ __forceinline__ void ph_qknorm(const P& p, int o) {
  const int tid = TIDX(), wid = tid >> 6, lane = tid & 63;
  bf16_t* QKV = (bf16_t*)(p.ws + OFF_D);
  const float* qn = p.att_q_norm + o * 128; const float* kn = p.att_k_norm + o * 128;
  const float invf = powf(10000.f, -(float)(lane & 31) / 32.f);
  for (int R = BIDX() * 8 + wid; R < MROWS; R += GDIM() * 8) {
    const int b = R >= TB ? 1 : 0, pp = R - b * TB; const bool lat = pp >= CTXL; const int t = pp - CTXL;
    float cr = 1.f, sr = 0.f, cc = 1.f, sn = 0.f;
    if (lat) { const float ar = (float)(t >> 6) * invf, ac = (float)(t & 63) * invf; cr = cosf(ar); sr = sinf(ar); cc = cosf(ac); sn = sinf(ac); }
    for (int hd = 0; hd < 10; ++hd) {
      bf16_t* base = QKV + (size_t)R * 1536 + hd * 128; const float* nw = hd < 8 ? qn : kn;
      float v0 = bf2f(base[lane]), v1 = bf2f(base[64 + lane]);
      const float ss = wave_sum(v0 * v0 + v1 * v1); const float rs = rsqrtf(ss * (1.f / 128.f) + EPSF);
      v0 = v0 * rs * nw[lane]; v1 = v1 * rs * nw[64 + lane];
      const float p0 = __shfl_xor(v0, 32), p1 = __shfl_xor(v1, 32);
      float o0, o1;
      if (lane < 32) { o0 = v0 * cr - p0 * sr; o1 = v1 * cc - p1 * sn; } else { o0 = p0 * sr + v0 * cr; o1 = p1 * sn + v1 * cc; }
      base[lane] = f2bf(o0); base[64 + lane] = f2bf(o1);
    }
  }
}

namespace at {
constexpr int D = 128, NW = 8, QBLK = 32, KVBLK = 64;
constexpr float SCALE = 0.088388347648318440f, THR = 8.f;
constexpr int LDQ = 1536, LDK = 1536, LDO = 1024;
constexpr size_t SHM_V = KVBLK * D * 2, SHM_K = KVBLK * D * 2;
#define KSWZ(row, colB) ((row) * 256 + ((colB) ^ (((row) & 7) << 4)))
#define SBAR() __builtin_amdgcn_sched_barrier(0)
DI void partialSM(f32x16& p0, f32x16& p1, float& m_reg, float& mn, float& alpha) {
  constexpr float C = SCALE * 1.4426950408889634f;
  float pmax = p0[0]; for (int r = 1; r < 16; ++r) pmax = fmaxf(pmax, p0[r]); for (int r = 0; r < 16; ++r) pmax = fmaxf(pmax, p1[r]);
  { auto rr = __builtin_amdgcn_permlane32_swap(__float_as_uint(pmax), __float_as_uint(pmax), false, false);
    pmax = fmaxf(__uint_as_float(rr[0]), __uint_as_float(rr[1])); }
  if (__builtin_expect(__all(pmax - m_reg <= THR / SCALE), 1)) { mn = m_reg; alpha = 1.f; }
  else { mn = fmaxf(m_reg, pmax); alpha = __builtin_amdgcn_exp2f((m_reg - mn) * C); m_reg = mn; }
  float mnC = -mn * C;
  for (int r = 0; r < 16; ++r) p0[r] = fmaf(p0[r], C, mnC); for (int r = 0; r < 16; ++r) p1[r] = fmaf(p1[r], C, mnC);
  for (int r = 0; r < 16; ++r) p0[r] = __builtin_amdgcn_exp2f(p0[r]);
}
DI void finishSM(f32x16& p0, f32x16& p1, float alpha, float& l_reg, bf16x8& pa0, bf16x8& pa1, bf16x8& pa2, bf16x8& pa3) {
  for (int r = 0; r < 16; ++r) p1[r] = __builtin_amdgcn_exp2f(p1[r]);
  float ps = 0; for (int r = 0; r < 16; ++r) ps += p0[r]; for (int r = 0; r < 16; ++r) ps += p1[r];
  { auto rr = __builtin_amdgcn_permlane32_swap(__float_as_uint(ps), __float_as_uint(ps), false, false);
    ps = __uint_as_float(rr[0]) + __uint_as_float(rr[1]); }
  l_reg = l_reg * alpha + ps;
#define PK4(PP, BASE, OUT) do { unsigned a0 = cvtpk(PP[BASE + 0], PP[BASE + 1]), a1 = cvtpk(PP[BASE + 2], PP[BASE + 3]);   \
    unsigned b0 = cvtpk(PP[BASE + 4], PP[BASE + 5]), b1 = cvtpk(PP[BASE + 6], PP[BASE + 7]);                              \
    auto r0 = __builtin_amdgcn_permlane32_swap(a0, b0, false, false); auto r1 = __builtin_amdgcn_permlane32_swap(a1, b1, false, false); \
    u32x4 w = {r0[0], r1[0], r0[1], r1[1]}; OUT = *reinterpret_cast<bf16x8*>(&w); } while (0)
  PK4(p0, 0, pa0); PK4(p0, 8, pa1); PK4(p1, 0, pa2); PK4(p1, 8, pa3);
#undef PK4
}
DI void qkt(f32x16& p0, f32x16& p1, const bf16_t* Ks, const bf16x8* qr, int r32, int hi) {
  p0 = f32x16{}; p1 = f32x16{};
  for (int d0 = 0; d0 < 8; ++d0) { int cb = (d0 * 16 + hi * 8) * 2;
    bf16x8 b0 = *reinterpret_cast<const bf16x8*>((const char*)Ks + KSWZ(r32, cb));
    bf16x8 b1 = *reinterpret_cast<const bf16x8*>((const char*)Ks + KSWZ(32 + r32, cb));
    p0 = MFMA32(b0, qr[d0], p0);
    p1 = MFMA32(b1, qr[d0], p1); }
}
DI int v_st(int k, int c) { const int kk = (k & ~0xC) | ((k & 4) << 1) | ((k & 8) >> 1); return ((kk >> 3) * 4 + (c >> 5)) * 512 + ((kk & 7) * 32 + (c & 31)) * 2; }
DI int v_rd_base(int lane) { return ((lane & 3) << 3) | (((lane >> 2) & 3) << 6) | (((lane >> 4) & 1) << 5) | (((lane >> 5) & 1) << 8); }
constexpr int v_rd_off(int d0, int ks, int half) { return d0 * 512 + ks * 4096 + half * 2048; }
template <int OFF> DI s16x4 tr_read(int vb) {
  s16x4 r; asm volatile("ds_read_b64_tr_b16 %0, %1 offset:%2" : "=&v"(r) : "v"(vb), "i"(OFF) : "memory"); return r;
}
template <int D0> DI void pv_one(f32x16& od, int vb, bf16x8 pa0, bf16x8 pa1, bf16x8 pa2, bf16x8 pa3) {
  const s16x4 l0 = tr_read<v_rd_off(D0, 0, 0)>(vb), h0 = tr_read<v_rd_off(D0, 0, 1)>(vb), l1 = tr_read<v_rd_off(D0, 1, 0)>(vb), h1 = tr_read<v_rd_off(D0, 1, 1)>(vb);
  const s16x4 l2 = tr_read<v_rd_off(D0, 2, 0)>(vb), h2 = tr_read<v_rd_off(D0, 2, 1)>(vb), l3 = tr_read<v_rd_off(D0, 3, 0)>(vb), h3 = tr_read<v_rd_off(D0, 3, 1)>(vb);
  asm volatile("s_waitcnt lgkmcnt(0)" ::: "memory"); SBAR();
#define PK(Lx, Hx) (bf16x8){Lx[0], Lx[1], Lx[2], Lx[3], Hx[0], Hx[1], Hx[2], Hx[3]}
  od = MFMA32(pa0, PK(l0, h0), od);
  od = MFMA32(pa1, PK(l1, h1), od);
  od = MFMA32(pa2, PK(l2, h2), od);
  od = MFMA32(pa3, PK(l3, h3), od);
#undef PK
}
DI void pv_d0(f32x16* o, int vb, bf16x8 pa0, bf16x8 pa1, bf16x8 pa2, bf16x8 pa3) {
  pv_one<0>(o[0], vb, pa0, pa1, pa2, pa3); pv_one<1>(o[1], vb, pa0, pa1, pa2, pa3); pv_one<2>(o[2], vb, pa0, pa1, pa2, pa3); pv_one<3>(o[3], vb, pa0, pa1, pa2, pa3);
}
DI void attn_dense_body(const bf16_t* __restrict__ Qb, const bf16_t* __restrict__ Kh, const bf16_t* __restrict__ Vh, bf16_t* __restrict__ Ob, int seq, char* lds) {
  const int tid = TIDX(), wid = tid >> 6, lane = tid & 63, r32 = lane & 31, hi = lane >> 5;
  bf16_t* V_lds = (bf16_t*)lds; bf16_t* K_lds = (bf16_t*)(lds + 2 * SHM_V);
  float* ws = (float*)(lds + 2 * SHM_V + 2 * SHM_K) + wid * 64; float* li_l = ws; float* al_l = ws + 32;
  float m_reg = -1e30f, l_reg = 0; f32x16 o[4] = {}; bf16x8 qr[8];
  const bf16_t* Qw = Qb + (long)(wid * QBLK + r32) * LDQ + hi * 8;
#pragma unroll
  for (int d0 = 0; d0 < 8; ++d0) qr[d0] = *reinterpret_cast<const bf16x8*>(Qw + d0 * 16);
  const int sr = tid >> 4, sc = (tid & 15) * 8, vst0 = v_st(sr, sc), vst1 = v_st(32 + sr, sc);
  const int vb0 = (int)(uintptr_t)V_lds + v_rd_base(lane);
  struct { bf16x8 vs0, vs1, ks0, ks1; } sr_[2];
#define SLOAD(i, k0) do { sr_[i].vs0 = *(const bf16x8*)(&Vh[(long)((k0) + sr) * LDK + sc]); sr_[i].vs1 = *(const bf16x8*)(&Vh[(long)((k0) + 32 + sr) * LDK + sc]); \
    sr_[i].ks0 = *(const bf16x8*)(&Kh[(long)((k0) + sr) * LDK + sc]); sr_[i].ks1 = *(const bf16x8*)(&Kh[(long)((k0) + 32 + sr) * LDK + sc]); } while (0)
#define SWRITE(bq, i) do { *(bf16x8*)((char*)V_lds + (bq) * SHM_V + vst0) = sr_[i].vs0;          \
    *(bf16x8*)((char*)V_lds + (bq) * SHM_V + vst1) = sr_[i].vs1; int kc = sc * 2;               \
    *(bf16x8*)((char*)K_lds + (bq) * SHM_K + KSWZ(sr, kc)) = sr_[i].ks0;                       \
    *(bf16x8*)((char*)K_lds + (bq) * SHM_K + KSWZ(32 + sr, kc)) = sr_[i].ks1; } while (0)
#define SWAIT() asm volatile("s_waitcnt vmcnt(4)" ::: "memory")
#define RESC(a) do { if (__any((a) < 1.f)) { if (hi == 0) al_l[r32] = (a); asm volatile("s_waitcnt lgkmcnt(0)" ::: "memory"); \
    for (int d = 0; d < 4; ++d) for (int r = 0; r < 16; ++r) o[d][r] *= al_l[crow(r, hi)]; } } while (0)
  f32x16 pA0, pA1, pB0, pB1; float mnA, mnB, alA, alB; bf16x8 pa0, pa1, pa2, pa3; const int NT = seq / KVBLK;
  constexpr int SE = 0, SO = 1;
  SLOAD(SE, 0); asm volatile("s_waitcnt vmcnt(0)" ::: "memory"); SWRITE(0, SE); __syncthreads();
  qkt(pA0, pA1, K_lds, qr, r32, hi); partialSM(pA0, pA1, m_reg, mnA, alA);
  SLOAD(SO, KVBLK); if (2 < NT) SLOAD(SE, 2 * KVBLK);
  SWAIT(); SWRITE(1, SO); __syncthreads();
  for (int j = 1; j + 1 < NT; j += 2) {
    SBAR(); qkt(pB0, pB1, (bf16_t*)((char*)K_lds + SHM_K), qr, r32, hi);
    finishSM(pA0, pA1, alA, l_reg, pa0, pa1, pa2, pa3); SBAR();
    SLOAD(SO, (j + 2) * KVBLK); SBAR();
    pv_d0(o, vb0, pa0, pa1, pa2, pa3); partialSM(pB0, pB1, m_reg, mnB, alB);
    __syncthreads(); SWAIT(); SWRITE(0, SE);
    RESC(alB); __syncthreads();
    SBAR(); qkt(pA0, pA1, K_lds, qr, r32, hi);
    finishSM(pB0, pB1, alB, l_reg, pa0, pa1, pa2, pa3); SBAR();
    if (j + 3 < NT) SLOAD(SE, (j + 3) * KVBLK); SBAR();
    pv_d0(o, vb0 + (int)SHM_V, pa0, pa1, pa2, pa3); partialSM(pA0, pA1, m_reg, mnA, alA);
    __syncthreads(); SWAIT(); SWRITE(1, SO);
    RESC(alA); __syncthreads();
  }
  SBAR(); qkt(pB0, pB1, (bf16_t*)((char*)K_lds + SHM_K), qr, r32, hi);
  finishSM(pA0, pA1, alA, l_reg, pa0, pa1, pa2, pa3); SBAR();
  pv_d0(o, vb0, pa0, pa1, pa2, pa3); partialSM(pB0, pB1, m_reg, mnB, alB);
  __syncthreads(); RESC(alB);
  finishSM(pB0, pB1, alB, l_reg, pa0, pa1, pa2, pa3); SBAR();
  pv_d0(o, vb0 + (int)SHM_V, pa0, pa1, pa2, pa3);
  if (hi == 0) li_l[r32] = l_reg; asm volatile("s_waitcnt lgkmcnt(0)" ::: "memory");
  float rli[16];
#pragma unroll
  for (int r = 0; r < 16; ++r) rli[r] = __builtin_amdgcn_rcpf(li_l[crow(r, hi)]);
  bf16_t* Ow = Ob + (long)(wid * QBLK) * LDO;
#pragma unroll
  for (int r = 0; r < 16; ++r) { int orow = crow(r, hi);
    for (int d0 = 0; d0 < 4; ++d0) Ow[(long)orow * LDO + d0 * 32 + r32] = f2bf(o[d0][r] * rli[r]); }
#undef SLOAD
#undef SWRITE
#undef SWAIT
#undef RESC
}
}

__device__ __forceinline__ void ph_attn(const P& p, char* lds, bool need_ctx) {
  const bf16_t* QKV = (const bf16_t*)(p.ws + OFF_D); bf16_t* hb = (bf16_t*)(p.ws + OFF_HBF);
  const int nunits = need_ctx ? 528 : 512;
  for (int u = BIDX(); u < nunits; u += GDIM()) {
    int b, h, seq; size_t qrow;
    if (u < 512) { b = u >> 8; const int rem = u & 255; h = rem >> 5; qrow = (size_t)b * TB + CTXL + (size_t)(rem & 31) * 256; seq = TB; }
    else { const int uu = u - 512; b = uu >> 3; h = uu & 7; qrow = (size_t)b * TB; seq = CTXL; }
    const int kvh = h >> 2;
    const bf16_t* Kh = QKV + (size_t)b * TB * 1536 + 1024 + kvh * 128;
    const bf16_t* Vh = QKV + (size_t)b * TB * 1536 + 1280 + kvh * 128;
    at::attn_dense_body(QKV + qrow * 1536 + h * 128, Kh, Vh, hb + qrow * 1024 + h * 128, seq, lds);
    __syncthreads();
  }
}

__device__ __forceinline__ void ph_final(const P& p) {
  const int tid = TIDX(), wid = tid >> 6, lane = tid & 63;
  const float* xr = (const float*)(p.ws + OFF_XRES);
  for (int q = BIDX() * 8 + wid; q < 2 * LAT; q += GDIM() * 8) {
    const int b = q >> 13, t = q & (LAT - 1); const float* row = xr + ((size_t)b * TB + CTXL + t) * 1024;
    f32x4 v[4]; float ss = 0.f;
#pragma unroll
    for (int i = 0; i < 4; ++i) { v[i] = *(const f32x4*)(row + i * 256 + lane * 4); ss += v[i][0] * v[i][0] + v[i][1] * v[i][1] + v[i][2] * v[i][2] + v[i][3] * v[i][3]; }
    ss = wave_sum(ss); const float rs = rsqrtf(ss * (1.f / 1024.f) + EPSF);
#pragma unroll
    for (int i = 0; i < 4; ++i) { const int c0 = i * 256 + lane * 4; const f32x4 g = *(const f32x4*)(p.final_norm + c0); f32x4 o = v[i] * rs * g; *(f32x4*)(p.out + (size_t)q * 1024 + c0) = o; }
  }
}

constexpr int NPHASES = 42;
#ifndef ONLY_PH
#define ONLY_PH -1
#endif
#define EN(x) (ONLY_PH < 0 || ONLY_PH == (x))
#ifndef PROBE_REP
#define PROBE_REP -1
#endif
#define RUN(cls, ...) do { if (EN(cls)) { __VA_ARGS__; if (PROBE_REP == (cls)) { cg::this_grid().sync(); __VA_ARGS__; } } } while (0)
__device__ __forceinline__ void run_phase(const P& p0, int ph, char* lds) {
  P p = p0; asm volatile("" : "+s"(p.ws));
  if (ph == 0) { RUN(0, ph_init(p, lds)); return; }
  if (ph == NPHASES - 1) { if (EN(11)) ph_final(p); return; }
  const int q = ph - 1; int L, sub;
  if (q < 11) { L = 0; sub = q; } else if (q < 20) { L = 1; sub = q - 11; } else if (q < 31) { L = 2; sub = q - 20; } else { L = 3; sub = q - 31; }
  const bool even = (L & 1) == 0; const int e = L >> 1;
  bf16_t* W1 = (bf16_t*)(p.ws + OFF_WC); bf16_t* W2 = (bf16_t*)(p.ws + OFF_WC + WC_W2);
  bf16_t* hb = (bf16_t*)(p.ws + OFF_HBF); float* xr = (float*)(p.ws + OFF_XRES);
  const float* mods = (const float*)(p.ws + OFF_MODS) + (size_t)L * 3 * 6144;
  int fs = even ? sub - 7 : sub - 5;
  if (fs >= 0) {
    if (fs == 0) { RUN(1, ph_norm(p, L, 1); cvt_weight(p.ffn_w_up + (size_t)L * 1024 * 5632, W1, 1024, 5632, 5632, false); cvt_weight(p.ffn_w_down + (size_t)L * DFF * 1024, W2, DFF, 1024, 1024, false)); }
    else if (fs == 1) { RUN(2, gemm_phase(lds, hb, 1024, W1, 1024, 44, EpiBf{(bf16_t*)(p.ws + OFF_D), 5632})); }
    else if (fs == 2) { if (EN(8)) ph_ffnact(p, L); }
    else { if (EN(2)) gemm_phase(lds, (const bf16_t*)(p.ws + OFF_D) + DFF, 5632, W2, DFF, 8, EpiRes{xr, mods + 5 * 1024}); }
    return;
  }
  if (even) {
    switch (sub) {
      case 0: RUN(1, ph_norm(p, L, 0); cvt_weight(p.rec_w_in + (size_t)e * 1024 * 3632, W1, 1024, 3632, NREC, true); cvt_weight(p.rec_w_out + (size_t)e * 1024 * 1024, W2, 1024, 1024, 1024, false)); break;
      case 1: RUN(2, gemm_phase(lds, hb, 1024, W1, 1024, NREC / 128, EpiRec{(bf16_t*)(p.ws + OFF_D + D_P1), (bf16_t*)(p.ws + OFF_D + D_P2), (float*)(p.ws + OFF_SM)})); break;
      case 2: RUN(3, ph_dnprep(p, lds, e)); break;
      case 3: RUN(4, ph_dn_d1(p, lds); ph_gla_b(p, lds, e)); break;
      case 4: RUN(5, if (BIDX() < 64) { dn_scan(p, lds, BIDX()); } else if (BIDX() < 128) { gla_scan(p, lds, BIDX() - 64, e); });
        if (PROBE_REP == 55) { cg::this_grid().sync(); if (BIDX() < 64) { dn_scan(p, lds, BIDX()); } }
        if (PROBE_REP == 56) { cg::this_grid().sync(); if (BIDX() >= 64 && BIDX() < 128) { gla_scan(p, lds, BIDX() - 64, e); } }
        break;
      case 5: RUN(7, ph_merge(p, e)); break;
      case 6: if (EN(2)) gemm_phase(lds, hb, 1024, W2, 1024, 8, EpiRes{xr, mods + 2 * 1024}); break;
    }
  } else {
    const int o = L >> 1;
    switch (sub) {
      case 0: RUN(1, ph_norm(p, L, 0); cvt_weight(p.att_w_qkv + (size_t)o * 1024 * 1536, W1, 1024, 1536, 1536, false); cvt_weight(p.att_w_out + (size_t)o * 1024 * 1024, W2, 1024, 1024, 1024, false)); break;
      case 1: RUN(2, gemm_phase(lds, hb, 1024, W1, 1024, 12, EpiBf{(bf16_t*)(p.ws + OFF_D), 1536})); break;
      case 2: if (EN(9)) ph_qknorm(p, o); break;
      case 3: RUN(10, ph_attn(p, lds, L != 3)); break;
      case 4: if (EN(2)) gemm_phase(lds, hb, 1024, W2, 1024, 8, EpiRes{xr, mods + 2 * 1024}); break;
    }
  }
}

template <bool COOP>
__global__ void __launch_bounds__(512, 1) mk_kernel(P p, int ph0, int ph1) {
  extern __shared__ __attribute__((aligned(16))) char smem[];
  for (int ph = ph0; ph < ph1; ++ph) {
    run_phase(p, ph, smem);
    if constexpr (COOP) { if (ph + 1 < ph1) cg::this_grid().sync(); }
  }
}

extern "C" void kernel_launch(void* const* d_in, const int* in_sizes, int n_in, void* d_out, int out_size, void* d_ws, size_t ws_size, hipStream_t stream) {
  if (n_in != 23 || ws_size < WS_NEED) { fprintf(stderr, "kernel_launch: bad n_in %d or ws %zu < %zu\n", n_in, ws_size, (size_t)WS_NEED); return; }
  P p{};
  const float** f = (const float**)&p;
  for (int i = 0; i < 23; ++i) f[i] = (const float*)d_in[i];
  p.out = (float*)d_out; p.ws = (char*)d_ws;
  static int inited = 0, grid_blocks = 0;
  if (!inited) {
    hipFuncSetAttribute((const void*)mk_kernel<true>, hipFuncAttributeMaxDynamicSharedMemorySize, LDS_BYTES);
    hipFuncSetAttribute((const void*)mk_kernel<false>, hipFuncAttributeMaxDynamicSharedMemorySize, LDS_BYTES);
    int dev = 0, cus = 0, per_cu = 0;
    hipGetDevice(&dev); hipDeviceGetAttribute(&cus, hipDeviceAttributeMultiprocessorCount, dev);
    hipOccupancyMaxActiveBlocksPerMultiprocessor(&per_cu, mk_kernel<true>, 512, LDS_BYTES);
    if (per_cu > 1) per_cu = 1;
    grid_blocks = cus * per_cu; if (grid_blocks > 256) grid_blocks = 256; if (grid_blocks < 128) grid_blocks = 128;
    inited = 1;
  }
#if MK_COOP
  int ph0 = 0, ph1 = NPHASES;
  void* args[] = {&p, &ph0, &ph1};
  hipError_t er = hipLaunchCooperativeKernel((const void*)mk_kernel<true>, dim3(grid_blocks), dim3(512), args, LDS_BYTES, stream);
  if (er != hipSuccess) fprintf(stderr, "cooperative launch failed: %s (grid %d)\n", hipGetErrorString(er), grid_blocks);
#else
  for (int ph = 0; ph < NPHASES; ++ph) hipLaunchKernelGGL(mk_kernel<false>, dim3(256), dim3(512), LDS_BYTES, stream, p, ph, ph + 1);
#endif
}
```

```cpp
#include <hip/hip_runtime.h>
#include <hip/hip_cooperative_groups.h>
#include <cstdio>
#include <cstdint>
namespace cg = cooperative_groups;

#ifndef MK_COOP
#define MK_COOP 1
#endif

typedef unsigned short bf16_t;
typedef short bf16x8 __attribute__((ext_vector_type(8)));
typedef short s16x4 __attribute__((ext_vector_type(4)));
typedef float f32x16 __attribute__((ext_vector_type(16)));
typedef float f32x8 __attribute__((ext_vector_type(8)));
typedef float f32x4 __attribute__((ext_vector_type(4)));
typedef unsigned u32x4 __attribute__((ext_vector_type(4)));
#define DI __device__ __forceinline__
#define LBAR() do { asm volatile("s_waitcnt lgkmcnt(0)" ::: "memory"); __builtin_amdgcn_s_barrier(); asm volatile("" ::: "memory"); } while (0)
#define MFMA32(a, b, c) __builtin_amdgcn_mfma_f32_32x32x16_bf16((a), (b), (c), 0, 0, 0)

constexpr int DM = 1024, TB = 8448, CTXL = 256, LAT = 8192, MROWS = 2 * TB;
constexpr int NCH = 132;
constexpr int DFF = 2816;
constexpr int NREC = 3712;
constexpr float EPSF = 1e-6f;

constexpr size_t AL(size_t x) { return (x + 255) / 256 * 256; }
constexpr size_t OFF_XRES = 0;
constexpr size_t OFF_HBF = OFF_XRES + AL((size_t)MROWS * DM * 4);
constexpr size_t OFF_WC = OFF_HBF + AL((size_t)MROWS * DM * 2);
constexpr size_t WC_W2 = (size_t)5632 * 1024 * 2;
constexpr size_t OFF_MODS = OFF_WC + AL(WC_W2 + (size_t)1024 * 2816 * 2);
constexpr size_t OFF_SM = OFF_MODS + AL((size_t)4 * 3 * 6144 * 4);
constexpr size_t OFF_GB = OFF_SM + AL((size_t)MROWS * 64 * 4);
constexpr size_t OFF_SC = OFF_GB + AL((size_t)MROWS * 16 * 4);
constexpr size_t OFF_GL = OFF_SC + AL((size_t)16 * NCH * 64 * 2 * 4);
constexpr size_t OFF_D = OFF_GL + AL((size_t)16 * NCH * 4);
constexpr size_t D_P1 = 0;
constexpr size_t D_W = 0;
constexpr size_t D_INTRA = D_W + (size_t)16 * NCH * 64 * 128 * 2;
constexpr size_t D_P2 = D_P1 + (size_t)MROWS * 1536 * 2;
constexpr size_t D_QQ = D_P2 + (size_t)MROWS * 2048 * 2;
constexpr size_t D_QK = D_QQ + (size_t)MROWS * 512 * 2;
constexpr size_t D_QV = D_QK + (size_t)MROWS * 512 * 2;
constexpr size_t D_DNO = D_QK;
constexpr size_t D_KT = D_QV + (size_t)MROWS * 512 * 2;
constexpr size_t D_GLAO = D_KT + (size_t)MROWS * 512 * 2;
constexpr size_t D_END_E = D_GLAO + (size_t)2 * MROWS * 512 * 2;
constexpr size_t D_END_F = (size_t)MROWS * 5632 * 2;
constexpr size_t OFF_B16_1 = OFF_D + (D_END_E > D_END_F ? D_END_E : D_END_F);
constexpr size_t B16_BYTES = (size_t)8 * NCH * 64 * 64 * 2;
constexpr size_t OFF_BAR = OFF_B16_1 + AL(B16_BYTES);
constexpr size_t WS_NEED = OFF_BAR + 3456 * 4;
constexpr int LDS_BYTES = 112 * 1024;

struct P {
  const float *x, *c, *ctx, *c_ctx, *mod_w, *mod_b, *rec_w_in, *rec_conv, *dn_a_log, *dn_dt_bias, *dn_norm, *gla_w2, *gla_b2, *gla_norm,
      *rec_w_out, *att_w_qkv, *att_q_norm, *att_k_norm, *att_w_out, *ffn_w_up, *ffn_conv, *ffn_w_down, *final_norm;
  float* out;
  char* ws;
};

DI int TIDX() { int t = threadIdx.x; asm volatile("" : "+v"(t)); return t; }
DI int BIDX() { int t = blockIdx.x; asm volatile("" : "+s"(t)); return t; }
DI int GDIM() { int t = gridDim.x; asm volatile("" : "+s"(t)); return t; }
DI float bf2f(bf16_t v) { return __uint_as_float(((unsigned)v) << 16); }
DI bf16_t f2bf(float x) { unsigned u = __float_as_uint(x); u += 0x7fffu + ((u >> 16) & 1u); return (bf16_t)(u >> 16); }
DI unsigned cvtpk(float lo, float hi) { unsigned r; asm volatile("v_cvt_pk_bf16_f32 %0, %1, %2" : "=v"(r) : "v"(lo), "v"(hi)); return r; }
DI int crow(int r, int hi) { return (r & 3) + 8 * (r >> 2) + 4 * hi; }
DI float siluf(float x) { return x / (1.f + expf(-x)); }
DI float sigmf(float x) { return 1.f / (1.f + expf(-x)); }
DI float softplusf(float x) { return fmaxf(x, 0.f) + log1pf(expf(-fabsf(x))); }
DI float wave_sum(float v) {
#pragma unroll
  for (int o = 32; o > 0; o >>= 1) v += __shfl_xor(v, o);
  return v;
}
DI int modrow_of(int R) { const int b = R >= TB ? 1 : 0; const int pp = R - b * TB; return pp < CTXL ? 2 : b; }
template <int KS>
DI f32x16 mma_rows(const bf16_t* arow, const bf16_t* brow, f32x16 acc) {
#pragma unroll
  for (int ks = 0; ks < KS; ++ks) {
    const bf16x8 a = *reinterpret_cast<const bf16x8*>(arow + ks * 16);
    const bf16x8 b = *reinterpret_cast<const bf16x8*>(brow + ks * 16);
    acc = MFMA32(a, b, acc);
  }
  return acc;
}

#define XB_TMO      128
#define XB_XCNT(j)  (256  + 64 * (j))
#define XB_XSUB(j)  (1280 + 64 * (j))
#define XB_XGEN(j)  (2304 + 64 * (j))
#define XB_TOP      3328
#define XB_TOPGEN   3392
#define XCD_BAR_WORDS 3456
#define XB_SPIN_CAP (1u << 18)
#define LAS __attribute__((address_space(3)))
DI unsigned xb_ld(unsigned* p)              { return __hip_atomic_load(p, __ATOMIC_RELAXED, __HIP_MEMORY_SCOPE_AGENT); }
DI unsigned xb_add(unsigned* p, unsigned v) { return __hip_atomic_fetch_add(p, v, __ATOMIC_RELAXED, __HIP_MEMORY_SCOPE_AGENT); }
DI unsigned xb_xcc_id() { return (unsigned)__builtin_amdgcn_s_getreg((3 << 11) | 20) & 0xFu; }
#define XB_SPIN(cond, bar) do { unsigned _sp = 0; while (cond) { __builtin_amdgcn_s_sleep(1); \
    if ((++_sp & 255u) == 0u) { if (xb_ld(&(bar)[XB_TMO])) break; if (_sp > XB_SPIN_CAP) { atomicAdd(&(bar)[XB_TMO], 1u); break; } } } } while (0)
struct XcdBarrier { unsigned* bar; unsigned x; volatile LAS unsigned* st; };
DI XcdBarrier xcd_barrier_post(unsigned* bar, volatile LAS unsigned* st) {
    XcdBarrier b; b.bar = bar; b.x = xb_xcc_id(); b.st = st;
    if (threadIdx.x == 0) (void)xb_add(&bar[XB_XCNT(b.x)], 1u);
    return b;
}
DI void xcd_barrier_complete(unsigned* bar, unsigned x, unsigned& nloc, unsigned& nx) {
    const unsigned G = gridDim.x * gridDim.y * gridDim.z;
    unsigned sum, cnt, mine, sp = 0u;
    for (;;) {
        sum = 0u; cnt = 0u; mine = 0u;
#pragma unroll
        for (unsigned j = 0; j < 16; ++j) { const unsigned c = xb_ld(&bar[XB_XCNT(j)]); sum += c; cnt += (c > 0u) ? 1u : 0u; mine = (j == x) ? c : mine; }
        if (sum == G) break;
        __builtin_amdgcn_s_sleep(1);
        if ((++sp & 255u) == 0u) { if (xb_ld(&bar[XB_TMO])) break; if (sp > XB_SPIN_CAP) { atomicAdd(&bar[XB_TMO], 1u); break; } }
    }
    nloc = mine > 0u ? mine : 1u; nx = cnt > 0u ? cnt : 1u;
}
DI void xcd_barrier(const XcdBarrier& b) {
    asm volatile("s_waitcnt vmcnt(0)" ::: "memory");
    __syncthreads();
    if (threadIdx.x == 0) {
        unsigned* bar = b.bar;
        __builtin_amdgcn_s_waitcnt(0);
        unsigned nloc = b.st[0], nx = b.st[1];
        if (nloc == 0u) { xcd_barrier_complete(bar, b.x, nloc, nx); b.st[0] = nloc; b.st[1] = nx; }
        const unsigned old = xb_add(&bar[XB_XSUB(b.x)], 1u);
        const unsigned gen = old / nloc;
        if (old + 1u == (gen + 1u) * nloc) {
            __builtin_amdgcn_fence(__ATOMIC_RELEASE, "agent");
            asm volatile("s_waitcnt vmcnt(0)" ::: "memory");
            const unsigned og = xb_add(&bar[XB_TOP], 1u);
            const unsigned tg = og / nx;
            if (og + 1u == (tg + 1u) * nx) xb_add(&bar[XB_TOPGEN], 1u);
            else XB_SPIN(xb_ld(&bar[XB_TOPGEN]) == tg, bar);
            __builtin_amdgcn_fence(__ATOMIC_ACQUIRE, "agent");
            xb_add(&bar[XB_XGEN(b.x)], 1u);
            asm volatile("s_waitcnt vmcnt(0)" ::: "memory");
        } else {
            XB_SPIN(xb_ld(&bar[XB_XGEN(b.x)]) == gen, bar);
            __builtin_amdgcn_fence(__ATOMIC_ACQUIRE, "agent");
            asm volatile("s_waitcnt vmcnt(0)" ::: "memory");
        }
    }
    __syncthreads();
}

__device__ __forceinline__ void ph_init(const P& p, char* lds) {
  const int tid = TIDX();
  float* sc = (float*)lds;
  float* red = sc + 3072;
  for (int i = tid; i < 3072; i += 512) { const int r = i >> 10, k = i & 1023; const float v = r < 2 ? p.c[r * 1024 + k] : p.c_ctx[k]; sc[i] = siluf(v); }
  __syncthreads();
  float* mods = (float*)(p.ws + OFF_MODS);
  for (int job = BIDX(); job < 192; job += GDIM()) {
    const int col = job * 128 + (tid & 127), kq = tid >> 7;
    const int L = col / 6144, cl = col - L * 6144;
    const float* w = p.mod_w + ((size_t)L * 1024 + kq * 256) * 6144 + cl;
    float a0 = 0.f, a1 = 0.f, a2 = 0.f;
#pragma unroll 8
    for (int k = 0; k < 256; ++k) { const float wv = w[(size_t)k * 6144]; const int kk = kq * 256 + k; a0 += sc[kk] * wv; a1 += sc[1024 + kk] * wv; a2 += sc[2048 + kk] * wv; }
    red[(kq * 3 + 0) * 128 + (tid & 127)] = a0; red[(kq * 3 + 1) * 128 + (tid & 127)] = a1; red[(kq * 3 + 2) * 128 + (tid & 127)] = a2;
    __syncthreads();
    if (tid < 384) { const int r = tid >> 7, cc = tid & 127; const int c2 = job * 128 + cc; const int L2 = c2 / 6144, cl2 = c2 - L2 * 6144;
      const float s = red[(0 * 3 + r) * 128 + cc] + red[(1 * 3 + r) * 128 + cc] + red[(2 * 3 + r) * 128 + cc] + red[(3 * 3 + r) * 128 + cc] + p.mod_b[L2 * 6144 + cl2];
      mods[((size_t)L2 * 3 + r) * 6144 + cl2] = s; }
    __syncthreads();
  }
  f32x4* xr = (f32x4*)(p.ws + OFF_XRES);
  for (size_t i = (size_t)BIDX() * 512 + tid; i < (size_t)MROWS * 256; i += (size_t)GDIM() * 512) {
    const int R = (int)(i >> 8), c4 = (int)(i & 255); const int b = R >= TB ? 1 : 0, pp = R - b * TB;
    const float* src = pp < CTXL ? p.ctx + ((size_t)b * CTXL + pp) * 1024 : p.x + ((size_t)b * LAT + (pp - CTXL)) * 1024;
    xr[i] = *(const f32x4*)(src + c4 * 4);
  }
}

DI int rec_src_col(int n) { if (n < 2048) return n; if (n < 3584) return n + 16; if (n < 3600) return 2048 + (n - 3584); if (n < 3632) return n; return -1; }
__device__ __forceinline__ void cvt_weight(const float* __restrict__ W, bf16_t* __restrict__ Wt, int K, int Nsrc, int Npad, bool perm) {
  const size_t items = (size_t)Npad * (K >> 3);
  for (size_t it = (size_t)BIDX() * 512 + TIDX(); it < items; it += (size_t)GDIM() * 512) {
    const int n = (int)(it % Npad), kb = (int)(it / Npad);
    const int s = perm ? rec_src_col(n) : n;
    float v[8];
#pragma unroll
    for (int j = 0; j < 8; ++j) v[j] = s >= 0 ? W[(size_t)(kb * 8 + j) * Nsrc + s] : 0.f;
    u32x4 w = {cvtpk(v[0], v[1]), cvtpk(v[2], v[3]), cvtpk(v[4], v[5]), cvtpk(v[6], v[7])};
    *(u32x4*)(Wt + (size_t)n * K + kb * 8) = w;
  }
}

__device__ __forceinline__ void ph_norm(const P& p, int L, int which) {
  const int tid = TIDX(), wid = tid >> 6, lane = tid & 63;
  const float* xr = (const float*)(p.ws + OFF_XRES);
  bf16_t* hb = (bf16_t*)(p.ws + OFF_HBF);
  const float* mods = (const float*)(p.ws + OFF_MODS) + (size_t)L * 3 * 6144;
  for (int R = BIDX() * 8 + wid; R < MROWS; R += GDIM() * 8) {
    const float* row = xr + (size_t)R * 1024;
    f32x4 v[4]; float ss = 0.f;
#pragma unroll
    for (int i = 0; i < 4; ++i) { v[i] = *(const f32x4*)(row + i * 256 + lane * 4); ss += v[i][0] * v[i][0] + v[i][1] * v[i][1] + v[i][2] * v[i][2] + v[i][3] * v[i][3]; }
    ss = wave_sum(ss);
    const float rs = rsqrtf(ss * (1.f / 1024.f) + EPSF);
    const float* mr = mods + (size_t)modrow_of(R) * 6144 + which * 3072;
#pragma unroll
    for (int i = 0; i < 4; ++i) { const int c0 = i * 256 + lane * 4; const f32x4 sh = *(const f32x4*)(mr + c0), scl = *(const f32x4*)(mr + 1024 + c0);
      float o[4];
#pragma unroll
      for (int j = 0; j < 4; ++j) o[j] = v[i][j] * rs * (1.f + scl[j]) + sh[j];
      uint2 w; w.x = cvtpk(o[0], o[1]); w.y = cvtpk(o[2], o[3]);
      *(uint2*)(hb + (size_t)R * 1024 + c0) = w; }
  }
}

struct EpiRec { bf16_t* P1; bf16_t* P2; float* SM;
  DI void operator()(int row, int col, float v) const {
    if (col < 1536) P1[(size_t)row * 1536 + col] = f2bf(v);
    else if (col < 3584) P2[(size_t)row * 2048 + (col - 1536)] = f2bf(v);
    else { const int lc = col - 3584; if (lc < 48) SM[(size_t)row * 64 + lc] = v; } } };
struct EpiBf { bf16_t* O; int ldc;
  DI void operator()(int row, int col, float v) const { O[(size_t)row * ldc + col] = f2bf(v); } };
struct EpiRes { float* X; const float* gate;
  DI void operator()(int row, int col, float v) const { float* q = X + (size_t)row * 1024 + col; *q = *q + gate[(size_t)modrow_of(row) * 6144 + col] * v; } };

template <class Epi>
__device__ __forceinline__ void gemm_phase(char* lds, const bf16_t* __restrict__ A, int lda, const bf16_t* __restrict__ Bt, int K, int nN, const Epi epi) {
  const int tid = TIDX(), wid = tid >> 6, lane = tid & 63, r32 = lane & 31, hi = lane >> 5;
  const int wm = wid >> 1, wn = wid & 1;
  const int nk = K >> 6;
  constexpr int RS = 144, ASZ = 256 * RS, BSZ = 128 * RS, STG = ASZ + BSZ;
  const int ntiles = (MROWS / 256) * nN;
  const int srow = tid >> 3, spc = tid & 7;
  for (int t = BIDX(); t < ntiles; t += GDIM()) {
    const int pm = t / nN, pn = t - pm * nN;
    const bf16_t* Ab = A + (size_t)(pm * 256 + srow) * lda + spc * 8;
    const bf16_t* Bb = Bt + (size_t)(pn * 128 + srow) * K + spc * 8;
    f32x16 acc00 = {}, acc01 = {}, acc10 = {}, acc11 = {};
    bf16x8 ra0, ra1, ra2, ra3, rb0, rb1;
#define GLOAD(kt) do { const int ko = (kt) * 64; ra0 = *(const bf16x8*)(Ab + ko); ra1 = *(const bf16x8*)(Ab + (size_t)64 * lda + ko); ra2 = *(const bf16x8*)(Ab + (size_t)128 * lda + ko); \
    ra3 = *(const bf16x8*)(Ab + (size_t)192 * lda + ko); rb0 = *(const bf16x8*)(Bb + ko); rb1 = *(const bf16x8*)(Bb + (size_t)64 * K + ko); } while (0)
#define SWRITE(buf) do { char* sb = lds + (buf) * STG + srow * RS + spc * 16; *(bf16x8*)(sb) = ra0; *(bf16x8*)(sb + 64 * RS) = ra1; *(bf16x8*)(sb + 128 * RS) = ra2; *(bf16x8*)(sb + 192 * RS) = ra3; \
    *(bf16x8*)(sb + ASZ) = rb0; *(bf16x8*)(sb + ASZ + 64 * RS) = rb1; } while (0)
    GLOAD(0); SWRITE(0); __syncthreads();
    for (int kt = 0; kt < nk; ++kt) {
      const int cur = kt & 1;
      if (kt + 1 < nk) GLOAD(kt + 1);
      const char* ab = lds + cur * STG + (64 * wm + r32) * RS + hi * 16;
      const char* bb = lds + cur * STG + ASZ + (64 * wn + r32) * RS + hi * 16;
#pragma unroll
      for (int ks = 0; ks < 4; ++ks) {
        const bf16x8 a0 = *(const bf16x8*)(ab + ks * 32), a1 = *(const bf16x8*)(ab + 32 * RS + ks * 32);
        const bf16x8 b0 = *(const bf16x8*)(bb + ks * 32), b1 = *(const bf16x8*)(bb + 32 * RS + ks * 32);
        acc00 = MFMA32(a0, b0, acc00); acc01 = MFMA32(a0, b1, acc01); acc10 = MFMA32(a1, b0, acc10); acc11 = MFMA32(a1, b1, acc11);
      }
      if (kt + 1 < nk) SWRITE(cur ^ 1);
      __syncthreads();
    }
#undef GLOAD
#undef SWRITE
    const int row0 = pm * 256 + 64 * wm, col0 = pn * 128 + 64 * wn + r32;
#pragma unroll
    for (int r = 0; r < 16; ++r) { const int rr = row0 + crow(r, hi);
      epi(rr, col0, acc00[r]); epi(rr, col0 + 32, acc01[r]); epi(rr + 32, col0, acc10[r]); epi(rr + 32, col0 + 32, acc11[r]); }
  }
}

__device__ __forceinline__ void ph_dnprep(const P& p, char* lds, int e) {
  const int tid = TIDX(), wid = tid >> 6, lane = tid & 63;
  const bf16_t* P1 = (const bf16_t*)(p.ws + OFF_D + D_P1);
  bf16_t* QQ = (bf16_t*)(p.ws + OFF_D + D_QQ); bf16_t* QK = (bf16_t*)(p.ws + OFF_D + D_QK); bf16_t* QV = (bf16_t*)(p.ws + OFF_D + D_QV);
  bf16_t* KT = (bf16_t*)(p.ws + OFF_D + D_KT);
  const float* SM = (const float*)(p.ws + OFF_SM); float* GB = (float*)(p.ws + OFF_GB);
  const float* cw = p.rec_conv + (size_t)e * 3 * 1536;
  bf16_t* kl = (bf16_t*)lds;
  for (int job = BIDX(); job < MROWS / 64; job += GDIM()) {
    const int R0 = job * 64;
    for (int tt = 0; tt < 8; ++tt) {
      const int tl = wid * 8 + tt, R = R0 + tl; const int b = R >= TB ? 1 : 0, pp = R - b * TB;
      const bool hasp = !(pp == 0 || pp == CTXL), hasn = !(pp == CTXL - 1 || pp == TB - 1);
#pragma unroll
      for (int part = 0; part < 3; ++part) {
        const int ch = part * 512 + lane * 8;
        const bf16x8 zc = *(const bf16x8*)(P1 + (size_t)R * 1536 + ch);
        bf16x8 zp = {}, zn = {};
        if (hasp) zp = *(const bf16x8*)(P1 + (size_t)(R - 1) * 1536 + ch);
        if (hasn) zn = *(const bf16x8*)(P1 + (size_t)(R + 1) * 1536 + ch);
        float o[8]; float ss = 0.f;
#pragma unroll
        for (int j = 0; j < 8; ++j) { const float a = bf2f((bf16_t)zp[j]) * cw[ch + j] + bf2f((bf16_t)zc[j]) * cw[1536 + ch + j] + bf2f((bf16_t)zn[j]) * cw[3072 + ch + j];
          o[j] = siluf(a); ss += o[j] * o[j]; }
        if (part < 2) {
          ss += __shfl_xor(ss, 1); ss += __shfl_xor(ss, 2); ss += __shfl_xor(ss, 4); ss += __shfl_xor(ss, 8);
          float sc = rsqrtf(ss + EPSF); if (part == 0) sc *= 0.08838834764831845f;
#pragma unroll
          for (int j = 0; j < 8; ++j) o[j] *= sc;
        }
        u32x4 w = {cvtpk(o[0], o[1]), cvtpk(o[2], o[3]), cvtpk(o[4], o[5]), cvtpk(o[6], o[7])};
        bf16_t* dst = part == 0 ? QQ : (part == 1 ? QK : QV);
        *(u32x4*)(dst + (size_t)R * 512 + lane * 8) = w;
        if (part == 1) *(u32x4*)(kl + tl * 512 + lane * 8) = w;
      }
      if (lane < 16) {
        const int q = lane & 7;
        if (lane < 8) { const float da = SM[(size_t)R * 64 + q]; GB[(size_t)R * 16 + q] = -expf(p.dn_a_log[e * 8 + q]) * softplusf(da + p.dn_dt_bias[e * 8 + q]); }
        else { const float db = SM[(size_t)R * 64 + 8 + q]; GB[(size_t)R * 16 + 8 + q] = sigmf(db); }
      }
    }
    __syncthreads();
    {
      const int b = R0 >= TB ? 1 : 0, c = (R0 - b * TB) / 64; const int h = tid >> 7, dk = tid & 127;
      bf16_t* dst = KT + ((((size_t)b * 4 + h) * NCH + c) * 128 + dk) * 64;
#pragma unroll
      for (int g8 = 0; g8 < 8; ++g8) { unsigned w[4];
#pragma unroll
        for (int j = 0; j < 4; ++j) { const unsigned lo = kl[(g8 * 8 + 2 * j) * 512 + tid], hi2 = kl[(g8 * 8 + 2 * j + 1) * 512 + tid]; w[j] = lo | (hi2 << 16); }
        *(u32x4*)(dst + g8 * 8) = (u32x4){w[0], w[1], w[2], w[3]}; }
    }
    __syncthreads();
  }
}

__device__ __forceinline__ void ph_dn_d1(const P& p, char* lds) {
  const int tid = TIDX(), wid = tid >> 6, lane = tid & 63, r32 = lane & 31, hi = lane >> 5;
  const bf16_t* QQ = (const bf16_t*)(p.ws + OFF_D + D_QQ); const bf16_t* QK = (const bf16_t*)(p.ws + OFF_D + D_QK); const bf16_t* QV = (const bf16_t*)(p.ws + OFF_D + D_QV);
  const float* GB = (const float*)(p.ws + OFF_GB);
  bf16_t* W_ = (bf16_t*)(p.ws + OFF_D + D_W); bf16_t* U_ = (bf16_t*)(p.ws + OFF_HBF); bf16_t* INTRA = (bf16_t*)(p.ws + OFF_D + D_INTRA);
  float* SC = (float*)(p.ws + OFF_SC); float* GLS = (float*)(p.ws + OFF_GL);
  float* KK = (float*)lds; float* QKm = KK + 64 * 65; float* Ad = QKm + 64 * 65; float* Gs = Ad + 2 * 4096; float* Bs = Gs + 128;
  for (int job = BIDX(); job < 8 * NCH; job += GDIM()) {
    const int b = job / (4 * NCH), h = (job / NCH) & 3, c = job % NCH;
    const size_t Rb = (size_t)b * TB + (size_t)c * 64;
    {
      const int w4 = wid & 3, mi = w4 & 1, ni = w4 >> 1;
      const bf16_t* As = wid < 4 ? QK : QQ;
      const bf16_t* arow = As + (Rb + 32 * mi + r32) * 512 + h * 128 + hi * 8;
      const bf16_t* brow = QK + (Rb + 32 * ni + r32) * 512 + h * 128 + hi * 8;
      f32x16 acc = {}; acc = mma_rows<8>(arow, brow, acc);
      float* dst = wid < 4 ? KK : QKm;
#pragma unroll
      for (int r = 0; r < 16; ++r) dst[(32 * mi + crow(r, hi)) * 65 + 32 * ni + r32] = acc[r];
    }
    if (tid < 128) { const int d = tid >> 6, ip = tid & 63, t = d ? 63 - ip : ip; Gs[tid] = GB[(Rb + t) * 16 + d * 4 + h]; Bs[tid] = GB[(Rb + t) * 16 + 8 + d * 4 + h]; }
    __syncthreads();
    if (tid == 0 || tid == 64) { float s = 0.f; for (int i = 0; i < 64; ++i) { s += Gs[tid + i]; Gs[tid + i] = s; } }
    __syncthreads();
    const int n0 = c, n1 = c < 4 ? 3 - c : 135 - c;
    const size_t cj0 = ((size_t)(0 * 2 + b) * 4 + h) * NCH + n0, cj1 = ((size_t)(1 * 2 + b) * 4 + h) * NCH + n1;
    for (int e2 = tid; e2 < 8192; e2 += 512) {
      const int d = e2 >> 12, ip = (e2 >> 6) & 63, jp = e2 & 63; const int i = d ? 63 - ip : ip, j = d ? 63 - jp : jp;
      const float dec = jp <= ip ? expf(Gs[d * 64 + ip] - Gs[d * 64 + jp]) : 0.f;
      Ad[d * 4096 + ip * 64 + jp] = jp < ip ? Bs[d * 64 + ip] * KK[i * 65 + j] * dec : 0.f;
      const size_t cj = d ? cj1 : cj0;
      INTRA[(cj * 64 + ip) * 64 + jp] = f2bf(QKm[i * 65 + j] * dec);
    }
    if (tid < 128) { const int d = tid >> 6, ip = tid & 63; const size_t cj = d ? cj1 : cj0; const float gi = Gs[tid], gl = Gs[d * 64 + 63];
      SC[(cj * 64 + ip) * 2] = expf(gi); SC[(cj * 64 + ip) * 2 + 1] = expf(gl - gi); if (ip == 0) GLS[cj] = expf(gl); }
    __syncthreads();
    {
      const int d = tid >> 8, cc = tid & 255; const size_t cj = d ? cj1 : cj0;
      int dofs = d * 64, aofs = d * 4096; asm volatile("" : "+v"(dofs), "+v"(aofs));
      float x[64];
      {
        const bf16_t* srcb = (cc < 128 ? QV + h * 128 + cc : QK + h * 128 + (cc - 128)) + (Rb + (d ? 63 : 0)) * 512;
        const long step = d ? -512 : 512;
#pragma unroll
        for (int g = 0; g < 8; ++g) {
#pragma unroll
          for (int q8 = 0; q8 < 8; ++q8) { const int ip = g * 8 + q8; x[ip] = bf2f(srcb[ip * step]); }
          asm volatile("" ::: "memory");
        }
        if (cc < 128) {
#pragma unroll
          for (int ip = 0; ip < 64; ++ip) x[ip] *= Bs[dofs + ip];
        } else {
#pragma unroll
          for (int ip = 0; ip < 64; ++ip) x[ip] *= Bs[dofs + ip] * expf(Gs[dofs + ip]);
        }
      }
      const float* Arow = Ad + aofs;
#pragma unroll
      for (int ip = 1; ip < 64; ++ip) {
        float s = 0.f;
#pragma unroll
        for (int j4 = 0; j4 < (ip + 3) / 4; ++j4) { const f32x4 a = *(const f32x4*)(Arow + ip * 64 + 4 * j4);
          s += a[0] * x[4 * j4] + a[1] * x[4 * j4 + 1] + a[2] * x[4 * j4 + 2] + a[3] * x[4 * j4 + 3]; }
        x[ip] -= s;
      }
      bf16_t* dst = cc < 128 ? U_ + cj * 64 * 128 + cc : W_ + cj * 64 * 128 + (cc - 128);
#pragma unroll
      for (int ip = 0; ip < 64; ++ip) dst[ip * 128] = f2bf(x[ip]);
    }
    __syncthreads();
  }
}

typedef _Float16 h16x8 __attribute__((ext_vector_type(8)));
__device__ __forceinline__ void ph_gla_b(const P& p, char* lds, int e) {
  const int tid = TIDX(), wid = tid >> 6, lane = tid & 63;
  const float* SM = (const float*)(p.ws + OFF_SM);
  float* w2S = (float*)lds;
  float* b2S = w2S + 8192;
  for (int i = tid; i < 8192; i += 512) { const int d = i >> 12, hh = (i >> 10) & 3, r = (i >> 6) & 15, j = i & 63; w2S[i] = p.gla_w2[(((size_t)e * 2 + d) * 16 + r) * 256 + hh * 64 + j]; }
  if (tid < 512) b2S[tid] = p.gla_b2[(size_t)e * 512 + tid];
  __syncthreads();
  int jb = 8 * wid; asm volatile("" : "+v"(jb));
  for (int job = BIDX(); job < 16 * NCH; job += GDIM()) {
    const int n = job % NCH, sq = job / NCH; const int dir = sq >> 3, b = (sq >> 2) & 1, h = sq & 3;
    const int c = dir == 0 ? n : (n < 4 ? 3 - n : 135 - n);
    const size_t row = (size_t)b * TB + (size_t)c * 64 + (dir ? 63 - lane : lane);
    const float* gp = SM + row * 64 + 16 + dir * 16;
    const f32x4 g0 = *(const f32x4*)(gp), g1 = *(const f32x4*)(gp + 4), g2 = *(const f32x4*)(gp + 8), g3 = *(const f32x4*)(gp + 12);
    const float gg_[16] = {g0[0], g0[1], g0[2], g0[3], g1[0], g1[1], g1[2], g1[3], g2[0], g2[1], g2[2], g2[3], g3[0], g3[1], g3[2], g3[3]};
    const float* wb = w2S + (dir * 4 + h) * 1024 + jb; const float* bb2 = b2S + dir * 256 + h * 64 + jb;
    f32x4 sa = *(const f32x4*)(bb2), sb = *(const f32x4*)(bb2 + 4);
#pragma unroll
    for (int r = 0; r < 16; ++r) { const f32x4 wa = *(const f32x4*)(wb + r * 64), wq = *(const f32x4*)(wb + r * 64 + 4); sa += gg_[r] * wa; sb += gg_[r] * wq; }
    float la[8];
#pragma unroll
    for (int jj = 0; jj < 4; ++jj) { const float x0 = sa[jj], x1 = sb[jj];
      la[jj] = (fminf(x0, 0.f) - log1pf(expf(-fabsf(x0)))) * 0.0625f; la[4 + jj] = (fminf(x1, 0.f) - log1pf(expf(-fabsf(x1)))) * 0.0625f; }
#pragma unroll
    for (int o = 1; o < 64; o <<= 1) {
#pragma unroll
      for (int jj = 0; jj < 8; ++jj) { const float v = __shfl_up(la[jj], o); la[jj] += lane >= o ? v : 0.f; }
    }
    h16x8 hv;
#pragma unroll
    for (int jj = 0; jj < 8; ++jj) hv[jj] = (_Float16)la[jj];
    _Float16* dst = (_Float16*)(p.ws + (dir ? OFF_B16_1 : OFF_WC)) + ((((size_t)b * 4 + h) * NCH + n) * 64 + lane) * 64 + jb;
    *(h16x8*)dst = hv;
  }
}

struct DnSet { bf16x8 fa[8]; };
__device__ __forceinline__ void dn_scan(const P& p, char* lds, int job) {
  const int tid = TIDX(), wid = tid >> 6, lane = tid & 63, r32 = lane & 31, hi = lane >> 5;
  const int dir = job >> 5, b = (job >> 4) & 1, h = (job >> 2) & 3, n0 = (job & 3) * 32;
  const bf16_t* QQ = (const bf16_t*)(p.ws + OFF_D + D_QQ); const bf16_t* KT = (const bf16_t*)(p.ws + OFF_D + D_KT);
  const bf16_t* W_ = (const bf16_t*)(p.ws + OFF_D + D_W); const bf16_t* U_ = (const bf16_t*)(p.ws + OFF_HBF); const bf16_t* INTRA = (const bf16_t*)(p.ws + OFF_D + D_INTRA);
  const float* SC = (const float*)(p.ws + OFF_SC); const float* GLS = (const float*)(p.ws + OFF_GL);
  bf16_t* DNO = (bf16_t*)(p.ws + OFF_D + D_DNO);
  bf16_t* ST = (bf16_t*)lds; bf16_t* vTa = ST + 32 * 136; bf16_t* vTb = vTa + 32 * 72;
  float* scS = (float*)(vTb + 32 * 72);
  bf16_t* uS = (bf16_t*)(scS + 256);
  bf16_t* inS = uS + 2 * 64 * 40;
  for (int i = tid; i < 32 * 136; i += 512) ST[i] = 0;
  f32x16 accS = {};
  const size_t seq = ((size_t)dir * 2 + b) * 4 + h;
  const int mi = wid & 1, di = wid - 4;
  const int role = wid < 2 ? 0 : (wid < 4 ? 1 : 2);
  const int tt = tid - 256;
  DnSet sA, sB;
  u32x4 stU, stI0; float stS = 0.f, glA = 0.f, glB = 0.f;
#define DN_CH(n_) const int n__ = (n_); const int c__ = dir == 0 ? n__ : (n__ < 4 ? 3 - n__ : 135 - n__); const size_t Rb__ = (size_t)b * TB + (size_t)c__ * 64; const size_t cj__ = seq * NCH + n__;
#define DN_LOAD(S, GL, n_) do { DN_CH(n_) \
    const int ipl__ = 32 * mi + r32, tl__ = dir ? 63 - ipl__ : ipl__; \
    const bf16_t* b0__ = W_ + cj__ * 8192 + (32 * mi + r32) * 128 + hi * 8; \
    const bf16_t* b1__ = QQ + (Rb__ + tl__) * 512 + h * 128 + hi * 8; \
    const bf16_t* b2__ = KT + ((((size_t)b * 4 + h) * NCH + c__) * 128 + 32 * (wid & 3) + r32) * 64 + hi * 8; \
    const bf16_t* bs__ = role == 0 ? b0__ : (role == 1 ? b1__ : b2__); \
    _Pragma("unroll") for (int ks = 0; ks < 8; ++ks) S.fa[ks] = *(const bf16x8*)(bs__ + ks * 16); \
    GL = GLS[cj__]; } while (0)
#define DN_STAGE_LD(n_) do { DN_CH(n_) (void)Rb__; \
      stU = *(const u32x4*)(U_ + cj__ * 8192 + ((tid & 255) >> 2) * 128 + n0 + (tid & 3) * 8); \
      stI0 = *(const u32x4*)(INTRA + cj__ * 4096 + (tid >> 3) * 64 + (tid & 7) * 8); \
      stS = SC[cj__ * 128 + (tid & 127)]; } while (0)
#define DN_STAGE_ST(bf_) do { *(u32x4*)(inS + (bf_) * 4608 + (tid >> 3) * 72 + (tid & 7) * 8) = stI0; \
      if (tid < 256) *(u32x4*)(uS + (bf_) * 2560 + (tid >> 2) * 40 + (tid & 3) * 8) = stU; \
      if (tid < 128) scS[(bf_) * 128 + tid] = stS; } while (0)
#define DN_STEP(S, GL, n_, bf_) do { DN_CH(n_) (void)cj__; \
    const float* sc__ = scS + (bf_) * 128; \
    f32x16 acc = {}; \
    if (role < 2) { const bf16_t* sb__ = ST + r32 * 136 + hi * 8; \
      _Pragma("unroll") for (int ks = 0; ks < 8; ++ks) acc = MFMA32(S.fa[ks], *(const bf16x8*)(sb__ + ks * 16), acc); \
      if (role == 0) { const bf16_t* us__ = uS + (bf_) * 2560 + r32; \
        _Pragma("unroll") for (int r = 0; r < 16; ++r) { const int ip = 32 * mi + crow(r, hi); const float vn = bf2f(us__[ip * 40]) - acc[r]; \
          vTa[r32 * 72 + ip] = f2bf(vn); const int to = dir ? 63 - ip : ip; vTb[r32 * 72 + to] = f2bf(vn * sc__[ip * 2 + 1]); } } \
      else { _Pragma("unroll") for (int r = 0; r < 16; ++r) acc[r] *= sc__[(32 * mi + crow(r, hi)) * 2]; } } \
    LBAR(); \
    if (role == 1) { const bf16_t* vb__ = vTa + r32 * 72 + hi * 8; const bf16_t* ib__ = inS + (bf_) * 4608 + (32 * mi + r32) * 72 + hi * 8; \
      _Pragma("unroll") for (int ks = 0; ks < 4; ++ks) acc = MFMA32(*(const bf16x8*)(ib__ + ks * 16), *(const bf16x8*)(vb__ + ks * 16), acc); \
      _Pragma("unroll") for (int r = 0; r < 16; ++r) { const int ip = 32 * mi + crow(r, hi), t = dir ? 63 - ip : ip; \
        DNO[((size_t)dir * MROWS + Rb__ + t) * 512 + h * 128 + n0 + r32] = f2bf(acc[r]); } } \
    else if (role == 2) { const bf16_t* vb__ = vTb + r32 * 72 + hi * 8; \
      _Pragma("unroll") for (int r = 0; r < 16; ++r) accS[r] *= GL; \
      _Pragma("unroll") for (int ks = 0; ks < 4; ++ks) accS = MFMA32(S.fa[ks], *(const bf16x8*)(vb__ + ks * 16), accS); \
      _Pragma("unroll") for (int r = 0; r < 16; ++r) ST[r32 * 136 + 32 * di + crow(r, hi)] = f2bf(accS[r]); } \
    DN_STAGE_ST((bf_) ^ 1); \
    LBAR(); } while (0)
  DN_STAGE_LD(0); DN_STAGE_ST(0);
  DN_LOAD(sA, glA, 0);
  __syncthreads();
  for (int n = 0; n < NCH; n += 2) {
    DN_LOAD(sB, glB, n + 1); DN_STAGE_LD(n + 1);
    DN_STEP(sA, glA, n, 0);
    { const int n2 = n + 2 < NCH ? n + 2 : NCH - 1; DN_LOAD(sA, glA, n2); DN_STAGE_LD(n2); }
    DN_STEP(sB, glB, n + 1, 1);
  }
#undef DN_CH
#undef DN_LOAD
#undef DN_STAGE_LD
#undef DN_STAGE_ST
#undef DN_STEP
}

DI float fast_logsig(float s) { return fminf(s, 0.f) - __logf(1.f + __expf(-fabsf(s))); }
struct GlaRegs { h16x8 ba, bb; bf16x8 qa, qb, ka, kb, v8; };
__device__ __forceinline__ void gla_scan(const P& p, char* lds, int job, int e) {
  const int tid = TIDX(), wid = tid >> 6, lane = tid & 63, r32 = lane & 31, hi = lane >> 5;
  const int dir = job >> 5, b = (job >> 4) & 1, h = (job >> 2) & 3, n0 = (job & 3) * 32;
  const bf16_t* P2 = (const bf16_t*)(p.ws + OFF_D + D_P2); const float* SM = (const float*)(p.ws + OFF_SM);
  bf16_t* GLAO = (bf16_t*)(p.ws + OFF_D + D_GLAO);
  const _Float16* B16 = (const _Float16*)(p.ws + (dir ? OFF_B16_1 : OFF_WC));
  float* w2S = (float*)lds; float* b2S = w2S + 1024; float* aLb = b2S + 64;
  bf16_t* ops = (bf16_t*)(aLb + 128);
  constexpr int OPB = (4 * 64 + 32) * 72;
  bf16_t* attp = ops + 2 * OPB;
  bf16_t* STb = attp + 2 * 32 * 72;
  for (int i = tid; i < 2 * 32 * 72; i += 512) STb[i] = 0;
  f32x16 accS = {};
  __syncthreads();
  GlaRegs RA;
  int jb0 = 16 * (wid & 3); asm volatile("" : "+v"(jb0));
  int vtb0 = 8 * (wid & 3) * 72 + lane; asm volatile("" : "+v"(vtb0));
#define GLA_LOAD(R, n_) do { const int n__ = (n_) < NCH ? (n_) : NCH - 1; const int c__ = dir == 0 ? n__ : (n__ < 4 ? 3 - n__ : 135 - n__); const size_t row__ = (size_t)b * TB + (size_t)c__ * 64 + (dir ? 63 - lane : lane); \
    const _Float16* bp__ = B16 + ((((size_t)b * 4 + h) * NCH + n__) * 64 + lane) * 64 + 16 * (wid & 3); R.ba = *(const h16x8*)(bp__); R.bb = *(const h16x8*)(bp__ + 8); \
    const bf16_t* pr__ = P2 + row__ * 2048; R.qa = *(const bf16x8*)(pr__ + 512 + h * 64 + 16 * (wid & 3)); R.qb = *(const bf16x8*)(pr__ + 512 + h * 64 + 16 * (wid & 3) + 8); \
    R.ka = *(const bf16x8*)(pr__ + 768 + h * 64 + 16 * (wid & 3)); R.kb = *(const bf16x8*)(pr__ + 768 + h * 64 + 16 * (wid & 3) + 8); R.v8 = *(const bf16x8*)(pr__ + 1024 + h * 128 + n0 + 8 * (wid & 3)); } while (0)
#define GLA_HALF(R, BV, QV, KV, jb) do { \
    float eqe[8], eke[8], eqi[8]; \
    _Pragma("unroll") for (int jj = 0; jj < 8; ++jj) { const int j = (jb) + jj; const float bb = (float)BV[jj]; const float bm = __int_as_float(__builtin_amdgcn_readlane(__float_as_int(bb), 32)), bl = __int_as_float(__builtin_amdgcn_readlane(__float_as_int(bb), 63)); \
      const float q_ = bf2f((bf16_t)QV[jj]) * 0.125f, k_ = bf2f((bf16_t)KV[jj]); \
      eqe[jj] = q_ * __expf(bb - bm); eke[jj] = k_ * __expf(bm - bb); eqi[jj] = q_ * __expf(bb); ksT_[j * 72 + lane] = f2bf(k_ * __expf(bl - bb)); if (lane == 63) aL_[j] = __expf(bl); } \
    *(u32x4*)(qe_ + lane * 72 + (jb)) = (u32x4){cvtpk(eqe[0], eqe[1]), cvtpk(eqe[2], eqe[3]), cvtpk(eqe[4], eqe[5]), cvtpk(eqe[6], eqe[7])}; \
    *(u32x4*)(ke_ + lane * 72 + (jb)) = (u32x4){cvtpk(eke[0], eke[1]), cvtpk(eke[2], eke[3]), cvtpk(eke[4], eke[5]), cvtpk(eke[6], eke[7])}; \
    *(u32x4*)(qi_ + lane * 72 + (jb)) = (u32x4){cvtpk(eqi[0], eqi[1]), cvtpk(eqi[2], eqi[3]), cvtpk(eqi[4], eqi[5]), cvtpk(eqi[6], eqi[7])}; } while (0)
#define GLA_PREP(R, bf_) do { bf16_t* qe_ = ops + (bf_) * OPB; bf16_t* ke_ = qe_ + 64 * 72; bf16_t* qi_ = ke_ + 64 * 72; bf16_t* ksT_ = qi_ + 64 * 72; bf16_t* vT_ = ksT_ + 64 * 72; float* aL_ = aLb + (bf_) * 64; \
    GLA_HALF(R, R.ba, R.qa, R.ka, jb0); GLA_HALF(R, R.bb, R.qb, R.kb, jb0 + 8); \
    _Pragma("unroll") for (int q_ = 0; q_ < 8; ++q_) vT_[vtb0 + q_ * 72] = (bf16_t)R.v8[q_]; } while (0)
#define GLA_MMA(n_, bf_) do { const int nq__ = (n_); const int bf = (bf_); \
      const bf16_t* qe_ = ops + bf * OPB; const bf16_t* ke_ = qe_ + 64 * 72; const bf16_t* qi_ = ke_ + 64 * 72; const bf16_t* ksT_ = qi_ + 64 * 72; const bf16_t* vT_ = ksT_ + 64 * 72; const float* aL_ = aLb + bf * 64; \
      const bf16_t* STr = STb + bf * 32 * 72; bf16_t* STw = STb + (bf ^ 1) * 32 * 72; \
      if (wid < 6) { \
        const int mi = wid - 4; bf16_t* attw = attp + mi * 32 * 72; \
        const int c = dir == 0 ? nq__ : (nq__ < 4 ? 3 - nq__ : 135 - nq__); const size_t Rb = (size_t)b * TB + (size_t)c * 64; \
        f32x16 acc = {}; acc = mma_rows<4>(qi_ + (32 * mi + r32) * 72 + hi * 8, STr + r32 * 72 + hi * 8, acc); \
        { f32x16 a0 = {}; a0 = mma_rows<4>(qe_ + (32 * mi + r32) * 72 + hi * 8, ke_ + r32 * 72 + hi * 8, a0); \
          _Pragma("unroll") for (int r = 0; r < 16; ++r) { const int ipl = crow(r, hi); attw[ipl * 72 + r32] = f2bf((mi == 1 || r32 <= ipl) ? a0[r] : 0.f); } \
          f32x16 a1 = {}; if (mi == 1) a1 = mma_rows<4>(qe_ + (32 + r32) * 72 + hi * 8, ke_ + (32 + r32) * 72 + hi * 8, a1); \
          _Pragma("unroll") for (int r = 0; r < 16; ++r) { const int ipl = crow(r, hi); attw[ipl * 72 + 32 + r32] = f2bf((mi == 1 && r32 <= ipl) ? a1[r] : 0.f); } } \
        asm volatile("s_waitcnt lgkmcnt(0)" ::: "memory"); \
        acc = mma_rows<4>(attw + r32 * 72 + hi * 8, vT_ + r32 * 72 + hi * 8, acc); \
        _Pragma("unroll") for (int r = 0; r < 16; ++r) { const int ip = 32 * mi + crow(r, hi), t = dir ? 63 - ip : ip; \
          GLAO[((size_t)dir * MROWS + Rb + t) * 512 + h * 128 + n0 + r32] = f2bf(acc[r]); } \
      } else { \
        const int di = wid - 6; \
        _Pragma("unroll") for (int r = 0; r < 16; ++r) accS[r] *= aL_[32 * di + crow(r, hi)]; \
        accS = mma_rows<4>(ksT_ + (32 * di + r32) * 72 + hi * 8, vT_ + r32 * 72 + hi * 8, accS); \
        _Pragma("unroll") for (int r = 0; r < 16; ++r) STw[r32 * 72 + 32 * di + crow(r, hi)] = f2bf(accS[r]); \
      } } while (0)
  GLA_LOAD(RA, 0);
  if (wid < 4) { GLA_PREP(RA, 0); }
  GLA_LOAD(RA, 1);
  LBAR();
  for (int n = 0; n < NCH; n += 2) {
    if (wid < 4) { GLA_PREP(RA, 1); } else { GLA_MMA(n, 0); }
    GLA_LOAD(RA, n + 2);
    LBAR();
    if (wid < 4) { if (n + 2 < NCH) { GLA_PREP(RA, 0); } } else { GLA_MMA(n + 1, 1); }
    GLA_LOAD(RA, n + 3);
    LBAR();
  }
#undef GLA_MMA
#undef GLA_LOAD
#undef GLA_HALF
#undef GLA_PREP
}

__device__ __forceinline__ void ph_merge(const P& p, int e) {
  const int tid = TIDX(), wid = tid >> 6, lane = tid & 63;
  const bf16_t* DNO = (const bf16_t*)(p.ws + OFF_D + D_DNO); const bf16_t* GLAO = (const bf16_t*)(p.ws + OFF_D + D_GLAO);
  const bf16_t* P2 = (const bf16_t*)(p.ws + OFF_D + D_P2); bf16_t* hb = (bf16_t*)(p.ws + OFF_HBF);
  for (int R = BIDX() * 8 + wid; R < MROWS; R += GDIM() * 8) {
#pragma unroll
    for (int g = 0; g < 8; ++g) {
      const bf16_t* src = g < 4 ? DNO : GLAO; const int hc = (g & 3) * 128 + lane * 2;
      const unsigned a = *(const unsigned*)(src + (size_t)R * 512 + hc), bq = *(const unsigned*)(src + ((size_t)MROWS + R) * 512 + hc);
      const float v0 = bf2f((bf16_t)(a & 0xffff)) + bf2f((bf16_t)(bq & 0xffff)), v1 = bf2f((bf16_t)(a >> 16)) + bf2f((bf16_t)(bq >> 16));
      const float ss = wave_sum(v0 * v0 + v1 * v1);
      const float rs = rsqrtf(ss * (1.f / 128.f) + EPSF);
      const float* nw = g < 4 ? p.dn_norm + e * 128 : p.gla_norm + e * 128;
      const unsigned zz = *(const unsigned*)(P2 + (size_t)R * 2048 + (g < 4 ? 0 : 1536) + hc);
      const float z0 = bf2f((bf16_t)(zz & 0xffff)), z1 = bf2f((bf16_t)(zz >> 16));
      const float o0 = v0 * rs * nw[lane * 2] * siluf(z0), o1 = v1 * rs * nw[lane * 2 + 1] * siluf(z1);
      *(unsigned*)(hb + (size_t)R * 1024 + g * 128 + lane * 2) = cvtpk(o0, o1);
    }
  }
}

__device__ __forceinline__ void ph_ffnact(const P& p, int L) {
  bf16_t* U = (bf16_t*)(p.ws + OFF_D);
  const float* cw = p.ffn_conv + (size_t)L * 3 * DFF;
  const size_t items = (size_t)MROWS * 352;
  for (size_t it = (size_t)BIDX() * 512 + TIDX(); it < items; it += (size_t)GDIM() * 512) {
    const int R = (int)(it / 352), c0 = (int)(it % 352) * 8; const int b = R >= TB ? 1 : 0, pp = R - b * TB;
    const bool hasp = !(pp == 0 || pp == CTXL), hasn = !(pp == CTXL - 1 || pp == TB - 1);
    const bf16x8 zc = *(const bf16x8*)(U + (size_t)R * 5632 + c0); bf16x8 zp = {}, zn = {};
    if (hasp) zp = *(const bf16x8*)(U + (size_t)(R - 1) * 5632 + c0);
    if (hasn) zn = *(const bf16x8*)(U + (size_t)(R + 1) * 5632 + c0);
    const bf16x8 vv = *(const bf16x8*)(U + (size_t)R * 5632 + DFF + c0);
    float o[8];
#pragma unroll
    for (int j = 0; j < 8; ++j) { const float a = bf2f((bf16_t)zp[j]) * cw[c0 + j] + bf2f((bf16_t)zc[j]) * cw[DFF + c0 + j] + bf2f((bf16_t)zn[j]) * cw[2 * DFF + c0 + j];
      o[j] = siluf(a) * bf2f((bf16_t)vv[j]); }
    u32x4 w = {cvtpk(o[0], o[1]), cvtpk(o[2], o[3]), cvtpk(o[4], o[5]), cvtpk(o[6], o[7])};
    *(u32x4*)(U + (size_t)R * 5632 + DFF + c0) = w;
  }
}

__device__ __forceinline__ void ph_qknorm(const P& p, int o) {
  const int tid = TIDX(), wid = tid >> 6, lane = tid & 63;
  bf16_t* QKV = (bf16_t*)(p.ws + OFF_D);
  const float* qn = p.att_q_norm + o * 128; const float* kn = p.att_k_norm + o * 128;
  const float invf = powf(10000.f, -(float)(lane & 31) / 32.f);
  for (int R = BIDX() * 8 + wid; R < MROWS; R += GDIM() * 8) {
    const int b = R >= TB ? 1 : 0, pp = R - b * TB; const bool lat = pp >= CTXL; const int t = pp - CTXL;
    float cr = 1.f, sr = 0.f, cc = 1.f, sn = 0.f;
    if (lat) { const float ar = (float)(t >> 6) * invf, ac = (float)(t & 63) * invf; cr = cosf(ar); sr = sinf(ar); cc = cosf(ac); sn = sinf(ac); }
    for (int hd = 0; hd < 10; ++hd) {
      bf16_t* base = QKV + (size_t)R * 1536 + hd * 128; const float* nw = hd < 8 ? qn : kn;
      float v0 = bf2f(base[lane]), v1 = bf2f(base[64 + lane]);
      const float ss = wave_sum(v0 * v0 + v1 * v1); const float rs = rsqrtf(ss * (1.f / 128.f) + EPSF);
      v0 = v0 * rs * nw[lane]; v1 = v1 * rs * nw[64 + lane];
      const float p0 = __shfl_xor(v0, 32), p1 = __shfl_xor(v1, 32);
      float o0, o1;
      if (lane < 32) { o0 = v0 * cr - p0 * sr; o1 = v1 * cc - p1 * sn; } else { o0 = p0 * sr + v0 * cr; o1 = p1 * sn + v1 * cc; }
      base[lane] = f2bf(o0); base[64 + lane] = f2bf(o1);
    }
  }
}

namespace at {
constexpr int D = 128, NW = 8, QBLK = 32, KVBLK = 64;
constexpr float SCALE = 0.088388347648318440f, THR = 8.f;
constexpr int LDQ = 1536, LDK = 1536, LDO = 1024;
constexpr size_t SHM_V = KVBLK * D * 2, SHM_K = KVBLK * D * 2;
#define KSWZ(row, colB) ((row) * 256 + ((colB) ^ (((row) & 7) << 4)))
#define SBAR() __builtin_amdgcn_sched_barrier(0)
DI void partialSM(f32x16& p0, f32x16& p1, float& m_reg, float& mn, float& alpha) {
  constexpr float C = SCALE * 1.4426950408889634f;
  float pmax = p0[0]; for (int r = 1; r < 16; ++r) pmax = fmaxf(pmax, p0[r]); for (int r = 0; r < 16; ++r) pmax = fmaxf(pmax, p1[r]);
  { auto rr = __builtin_amdgcn_permlane32_swap(__float_as_uint(pmax), __float_as_uint(pmax), false, false);
    pmax = fmaxf(__uint_as_float(rr[0]), __uint_as_float(rr[1])); }
  if (__builtin_expect(__all(pmax - m_reg <= THR / SCALE), 1)) { mn = m_reg; alpha = 1.f; }
  else { mn = fmaxf(m_reg, pmax); alpha = __builtin_amdgcn_exp2f((m_reg - mn) * C); m_reg = mn; }
  float mnC = -mn * C;
  for (int r = 0; r < 16; ++r) p0[r] = fmaf(p0[r], C, mnC); for (int r = 0; r < 16; ++r) p1[r] = fmaf(p1[r], C, mnC);
  for (int r = 0; r < 16; ++r) p0[r] = __builtin_amdgcn_exp2f(p0[r]);
}
DI void finishSM(f32x16& p0, f32x16& p1, float alpha, float& l_reg, bf16x8& pa0, bf16x8& pa1, bf16x8& pa2, bf16x8& pa3) {
  for (int r = 0; r < 16; ++r) p1[r] = __builtin_amdgcn_exp2f(p1[r]);
  float ps = 0; for (int r = 0; r < 16; ++r) ps += p0[r]; for (int r = 0; r < 16; ++r) ps += p1[r];
  { auto rr = __builtin_amdgcn_permlane32_swap(__float_as_uint(ps), __float_as_uint(ps), false, false);
    ps = __uint_as_float(rr[0]) + __uint_as_float(rr[1]); }
  l_reg = l_reg * alpha + ps;
#define PK4(PP, BASE, OUT) do { unsigned a0 = cvtpk(PP[BASE + 0], PP[BASE + 1]), a1 = cvtpk(PP[BASE + 2], PP[BASE + 3]);   \
    unsigned b0 = cvtpk(PP[BASE + 4], PP[BASE + 5]), b1 = cvtpk(PP[BASE + 6], PP[BASE + 7]);                              \
    auto r0 = __builtin_amdgcn_permlane32_swap(a0, b0, false, false); auto r1 = __builtin_amdgcn_permlane32_swap(a1, b1, false, false); \
    u32x4 w = {r0[0], r1[0], r0[1], r1[1]}; OUT = *reinterpret_cast<bf16x8*>(&w); } while (0)
  PK4(p0, 0, pa0); PK4(p0, 8, pa1); PK4(p1, 0, pa2); PK4(p1, 8, pa3);
#undef PK4
}
DI void qkt(f32x16& p0, f32x16& p1, const bf16_t* Ks, const bf16x8* qr, int r32, int hi) {
  p0 = f32x16{}; p1 = f32x16{};
  for (int d0 = 0; d0 < 8; ++d0) { int cb = (d0 * 16 + hi * 8) * 2;
    bf16x8 b0 = *reinterpret_cast<const bf16x8*>((const char*)Ks + KSWZ(r32, cb));
    bf16x8 b1 = *reinterpret_cast<const bf16x8*>((const char*)Ks + KSWZ(32 + r32, cb));
    p0 = MFMA32(b0, qr[d0], p0);
    p1 = MFMA32(b1, qr[d0], p1); }
}
DI int v_st(int k, int c) { const int kk = (k & ~0xC) | ((k & 4) << 1) | ((k & 8) >> 1); return ((kk >> 3) * 4 + (c >> 5)) * 512 + ((kk & 7) * 32 + (c & 31)) * 2; }
DI int v_rd_base(int lane) { return ((lane & 3) << 3) | (((lane >> 2) & 3) << 6) | (((lane >> 4) & 1) << 5) | (((lane >> 5) & 1) << 8); }
constexpr int v_rd_off(int d0, int ks, int half) { return d0 * 512 + ks * 4096 + half * 2048; }
template <int OFF> DI s16x4 tr_read(int vb) {
  s16x4 r; asm volatile("ds_read_b64_tr_b16 %0, %1 offset:%2" : "=&v"(r) : "v"(vb), "i"(OFF) : "memory"); return r;
}
template <int D0> DI void pv_one(f32x16& od, int vb, bf16x8 pa0, bf16x8 pa1, bf16x8 pa2, bf16x8 pa3) {
  const s16x4 l0 = tr_read<v_rd_off(D0, 0, 0)>(vb), h0 = tr_read<v_rd_off(D0, 0, 1)>(vb), l1 = tr_read<v_rd_off(D0, 1, 0)>(vb), h1 = tr_read<v_rd_off(D0, 1, 1)>(vb);
  const s16x4 l2 = tr_read<v_rd_off(D0, 2, 0)>(vb), h2 = tr_read<v_rd_off(D0, 2, 1)>(vb), l3 = tr_read<v_rd_off(D0, 3, 0)>(vb), h3 = tr_read<v_rd_off(D0, 3, 1)>(vb);
  asm volatile("s_waitcnt lgkmcnt(0)" ::: "memory"); SBAR();
#define PK(Lx, Hx) (bf16x8){Lx[0], Lx[1], Lx[2], Lx[3], Hx[0], Hx[1], Hx[2], Hx[3]}
  od = MFMA32(pa0, PK(l0, h0), od);
  od = MFMA32(pa1, PK(l1, h1), od);
  od = MFMA32(pa2, PK(l2, h2), od);
  od = MFMA32(pa3, PK(l3, h3), od);
#undef PK
}
DI void pv_d0(f32x16* o, int vb, bf16x8 pa0, bf16x8 pa1, bf16x8 pa2, bf16x8 pa3) {
  pv_one<0>(o[0], vb, pa0, pa1, pa2, pa3); pv_one<1>(o[1], vb, pa0, pa1, pa2, pa3); pv_one<2>(o[2], vb, pa0, pa1, pa2, pa3); pv_one<3>(o[3], vb, pa0, pa1, pa2, pa3);
}
DI void attn_dense_body(const bf16_t* __restrict__ Qb, const bf16_t* __restrict__ Kh, const bf16_t* __restrict__ Vh, bf16_t* __restrict__ Ob, int seq, char* lds) {
  const int tid = TIDX(), wid = tid >> 6, lane = tid & 63, r32 = lane & 31, hi = lane >> 5;
  bf16_t* V_lds = (bf16_t*)lds; bf16_t* K_lds = (bf16_t*)(lds + 2 * SHM_V);
  float* ws = (float*)(lds + 2 * SHM_V + 2 * SHM_K) + wid * 64; float* li_l = ws; float* al_l = ws + 32;
  float m_reg = -1e30f, l_reg = 0; f32x16 o[4] = {}; bf16x8 qr[8];
  const bf16_t* Qw = Qb + (long)(wid * QBLK + r32) * LDQ + hi * 8;
#pragma unroll
  for (int d0 = 0; d0 < 8; ++d0) qr[d0] = *reinterpret_cast<const bf16x8*>(Qw + d0 * 16);
  const int sr = tid >> 4, sc = (tid & 15) * 8, vst0 = v_st(sr, sc), vst1 = v_st(32 + sr, sc);
  const int vb0 = (int)(uintptr_t)V_lds + v_rd_base(lane);
  struct { bf16x8 vs0, vs1, ks0, ks1; } sr_[2];
#define SLOAD(i, k0) do { sr_[i].vs0 = *(const bf16x8*)(&Vh[(long)((k0) + sr) * LDK + sc]); sr_[i].vs1 = *(const bf16x8*)(&Vh[(long)((k0) + 32 + sr) * LDK + sc]); \
    sr_[i].ks0 = *(const bf16x8*)(&Kh[(long)((k0) + sr) * LDK + sc]); sr_[i].ks1 = *(const bf16x8*)(&Kh[(long)((k0) + 32 + sr) * LDK + sc]); } while (0)
#define SWRITE(bq, i) do { *(bf16x8*)((char*)V_lds + (bq) * SHM_V + vst0) = sr_[i].vs0;          \
    *(bf16x8*)((char*)V_lds + (bq) * SHM_V + vst1) = sr_[i].vs1; int kc = sc * 2;               \
    *(bf16x8*)((char*)K_lds + (bq) * SHM_K + KSWZ(sr, kc)) = sr_[i].ks0;                       \
    *(bf16x8*)((char*)K_lds + (bq) * SHM_K + KSWZ(32 + sr, kc)) = sr_[i].ks1; } while (0)
#define SWAIT() asm volatile("s_waitcnt vmcnt(4)" ::: "memory")
#define RESC(a) do { if (__any((a) < 1.f)) { if (hi == 0) al_l[r32] = (a); asm volatile("s_waitcnt lgkmcnt(0)" ::: "memory"); \
    for (int d = 0; d < 4; ++d) for (int r = 0; r < 16; ++r) o[d][r] *= al_l[crow(r, hi)]; } } while (0)
  f32x16 pA0, pA1, pB0, pB1; float mnA, mnB, alA, alB; bf16x8 pa0, pa1, pa2, pa3; const int NT = seq / KVBLK;
  constexpr int SE = 0, SO = 1;
  SLOAD(SE, 0); asm volatile("s_waitcnt vmcnt(0)" ::: "memory"); SWRITE(0, SE); __syncthreads();
  qkt(pA0, pA1, K_lds, qr, r32, hi); partialSM(pA0, pA1, m_reg, mnA, alA);
  SLOAD(SO, KVBLK); if (2 < NT) SLOAD(SE, 2 * KVBLK);
  SWAIT(); SWRITE(1, SO); __syncthreads();
  for (int j = 1; j + 1 < NT; j += 2) {
    SBAR(); qkt(pB0, pB1, (bf16_t*)((char*)K_lds + SHM_K), qr, r32, hi);
    finishSM(pA0, pA1, alA, l_reg, pa0, pa1, pa2, pa3); SBAR();
    SLOAD(SO, (j + 2) * KVBLK); SBAR();
    pv_d0(o, vb0, pa0, pa1, pa2, pa3); partialSM(pB0, pB1, m_reg, mnB, alB);
    __syncthreads(); SWAIT(); SWRITE(0, SE);
    RESC(alB); __syncthreads();
    SBAR(); qkt(pA0, pA1, K_lds, qr, r32, hi);
    finishSM(pB0, pB1, alB, l_reg, pa0, pa1, pa2, pa3); SBAR();
    if (j + 3 < NT) SLOAD(SE, (j + 3) * KVBLK); SBAR();
    pv_d0(o, vb0 + (int)SHM_V, pa0, pa1, pa2, pa3); partialSM(pA0, pA1, m_reg, mnA, alA);
    __syncthreads(); SWAIT(); SWRITE(1, SO);
    RESC(alA); __syncthreads();
  }
  SBAR(); qkt(pB0, pB1, (bf16_t*)((char*)K_lds + SHM_K), qr, r32, hi);
  finishSM(pA0, pA1, alA, l_reg, pa0, pa1, pa2, pa3); SBAR();
  pv_d0(o, vb0, pa0, pa1, pa2, pa3); partialSM(pB0, pB1, m_reg, mnB, alB);
  __syncthreads(); RESC(alB);
  finishSM(pB0, pB1, alB, l_reg, pa0, pa1, pa2, pa3); SBAR();
  pv_d0(o, vb0 + (int)SHM_V, pa0, pa1, pa2, pa3);
  if (hi == 0) li_l[r32] = l_reg; asm volatile("s_waitcnt lgkmcnt(0)" ::: "memory");
  float rli[16];
#pragma unroll
  for (int r = 0; r < 16; ++r) rli[r] = __builtin_amdgcn_rcpf(li_l[crow(r, hi)]);
  bf16_t* Ow = Ob + (long)(wid * QBLK) * LDO;
#pragma unroll
  for (int r = 0; r < 16; ++r) { int orow = crow(r, hi);
    for (int d0 = 0; d0 < 4; ++d0) Ow[(long)orow * LDO + d0 * 32 + r32] = f2bf(o[d0][r] * rli[r]); }
#undef SLOAD
#undef SWRITE
#undef SWAIT
#undef RESC
}
}

__device__ __forceinline__ void ph_attn(const P& p, char* lds, bool need_ctx) {
  const bf16_t* QKV = (const bf16_t*)(p.ws + OFF_D); bf16_t* hb = (bf16_t*)(p.ws + OFF_HBF);
  const int nunits = need_ctx ? 528 : 512;
  for (int u = BIDX(); u < nunits; u += GDIM()) {
    int b, h, seq; size_t qrow;
    if (u < 512) { b = u >> 8; const int rem = u & 255; h = rem >> 5; qrow = (size_t)b * TB + CTXL + (size_t)(rem & 31) * 256; seq = TB; }
    else { const int uu = u - 512; b = uu >> 3; h = uu & 7; qrow = (size_t)b * TB; seq = CTXL; }
    const int kvh = h >> 2;
    const bf16_t* Kh = QKV + (size_t)b * TB * 1536 + 1024 + kvh * 128;
    const bf16_t* Vh = QKV + (size_t)b * TB * 1536 + 1280 + kvh * 128;
    at::attn_dense_body(QKV + qrow * 1536 + h * 128, Kh, Vh, hb + qrow * 1024 + h * 128, seq, lds);
    __syncthreads();
  }
}

__device__ __forceinline__ void ph_final(const P& p) {
  const int tid = TIDX(), wid = tid >> 6, lane = tid & 63;
  const float* xr = (const float*)(p.ws + OFF_XRES);
  for (int q = BIDX() * 8 + wid; q < 2 * LAT; q += GDIM() * 8) {
    const int b = q >> 13, t = q & (LAT - 1); const float* row = xr + ((size_t)b * TB + CTXL + t) * 1024;
    f32x4 v[4]; float ss = 0.f;
#pragma unroll
    for (int i = 0; i < 4; ++i) { v[i] = *(const f32x4*)(row + i * 256 + lane * 4); ss += v[i][0] * v[i][0] + v[i][1] * v[i][1] + v[i][2] * v[i][2] + v[i][3] * v[i][3]; }
    ss = wave_sum(ss); const float rs = rsqrtf(ss * (1.f / 1024.f) + EPSF);
#pragma unroll
    for (int i = 0; i < 4; ++i) { const int c0 = i * 256 + lane * 4; const f32x4 g = *(const f32x4*)(p.final_norm + c0); f32x4 o = v[i] * rs * g; *(f32x4*)(p.out + (size_t)q * 1024 + c0) = o; }
  }
}

constexpr int NPHASES = 42;
#ifndef ONLY_PH
#define ONLY_PH -1
#endif
#define EN(x) (ONLY_PH < 0 || ONLY_PH == (x))
#ifndef PROBE_REP
#define PROBE_REP -1
#endif
#define RUN(cls, ...) do { if (EN(cls)) { for (int rep_ = 0; rep_ < ((PROBE_REP == (cls)) ? 2 : 1); ++rep_) { if (rep_) xcd_barrier(*xbp); __VA_ARGS__; } } } while (0)
__device__ __forceinline__ void run_phase(const P& p0, int ph, char* lds, const XcdBarrier* xbp) {
  P p = p0; asm volatile("" : "+s"(p.ws));
  if (ph == 0) { RUN(0, ph_init(p, lds)); return; }
  if (ph == NPHASES - 1) { if (EN(11)) ph_final(p); return; }
  const int q = ph - 1; int L, sub;
  if (q < 11) { L = 0; sub = q; } else if (q < 20) { L = 1; sub = q - 11; } else if (q < 31) { L = 2; sub = q - 20; } else { L = 3; sub = q - 31; }
  const bool even = (L & 1) == 0; const int e = L >> 1;
  bf16_t* W1 = (bf16_t*)(p.ws + OFF_WC); bf16_t* W2 = (bf16_t*)(p.ws + OFF_WC + WC_W2);
  bf16_t* hb = (bf16_t*)(p.ws + OFF_HBF); float* xr = (float*)(p.ws + OFF_XRES);
  const float* mods = (const float*)(p.ws + OFF_MODS) + (size_t)L * 3 * 6144;
  int fs = even ? sub - 7 : sub - 5;
  if (fs >= 0) {
    if (fs == 0) { RUN(1, ph_norm(p, L, 1); cvt_weight(p.ffn_w_up + (size_t)L * 1024 * 5632, W1, 1024, 5632, 5632, false); cvt_weight(p.ffn_w_down + (size_t)L * DFF * 1024, W2, DFF, 1024, 1024, false)); }
    else if (fs == 1) { RUN(2, gemm_phase(lds, hb, 1024, W1, 1024, 44, EpiBf{(bf16_t*)(p.ws + OFF_D), 5632})); }
    else if (fs == 2) { if (EN(8)) ph_ffnact(p, L); }
    else { if (EN(2)) gemm_phase(lds, (const bf16_t*)(p.ws + OFF_D) + DFF, 5632, W2, DFF, 8, EpiRes{xr, mods + 5 * 1024}); }
    return;
  }
  if (even) {
    switch (sub) {
      case 0: RUN(1, ph_norm(p, L, 0); cvt_weight(p.rec_w_in + (size_t)e * 1024 * 3632, W1, 1024, 3632, NREC, true); cvt_weight(p.rec_w_out + (size_t)e * 1024 * 1024, W2, 1024, 1024, 1024, false)); break;
      case 1: RUN(2, gemm_phase(lds, hb, 1024, W1, 1024, NREC / 128, EpiRec{(bf16_t*)(p.ws + OFF_D + D_P1), (bf16_t*)(p.ws + OFF_D + D_P2), (float*)(p.ws + OFF_SM)})); break;
      case 2: RUN(3, ph_dnprep(p, lds, e)); break;
      case 3: RUN(4, ph_dn_d1(p, lds); ph_gla_b(p, lds, e)); break;
      case 4: RUN(5, if (BIDX() < 64) { dn_scan(p, lds, BIDX()); } else if (BIDX() < 128) { gla_scan(p, lds, BIDX() - 64, e); });
        if (PROBE_REP == 55) { xcd_barrier(*xbp); if (BIDX() < 64) { dn_scan(p, lds, BIDX()); } }
        if (PROBE_REP == 56) { xcd_barrier(*xbp); if (BIDX() >= 64 && BIDX() < 128) { gla_scan(p, lds, BIDX() - 64, e); } }
        break;
      case 5: RUN(7, ph_merge(p, e)); break;
      case 6: if (EN(2)) gemm_phase(lds, hb, 1024, W2, 1024, 8, EpiRes{xr, mods + 2 * 1024}); break;
    }
  } else {
    const int o = L >> 1;
    switch (sub) {
      case 0: RUN(1, ph_norm(p, L, 0); cvt_weight(p.att_w_qkv + (size_t)o * 1024 * 1536, W1, 1024, 1536, 1536, false); cvt_weight(p.att_w_out + (size_t)o * 1024 * 1024, W2, 1024, 1024, 1024, false)); break;
      case 1: RUN(2, gemm_phase(lds, hb, 1024, W1, 1024, 12, EpiBf{(bf16_t*)(p.ws + OFF_D), 1536})); break;
      case 2: if (EN(9)) ph_qknorm(p, o); break;
      case 3: RUN(10, ph_attn(p, lds, L != 3)); break;
      case 4: if (EN(2)) gemm_phase(lds, hb, 1024, W2, 1024, 8, EpiRes{xr, mods + 2 * 1024}); break;
    }
  }
}

template <bool COOP>
__global__ void __launch_bounds__(512, 1) mk_kernel(P p, int ph0, int ph1) {
  extern __shared__ __attribute__((aligned(16))) char smem[];
  if constexpr (COOP) {
    if (ph0 < 0) cg::this_grid().sync();
    volatile LAS unsigned* st = (volatile LAS unsigned*)(smem + LDS_BYTES);
    if (threadIdx.x < 4) st[threadIdx.x] = 0u;
    __syncthreads();
    XcdBarrier xb = xcd_barrier_post((unsigned*)(p.ws + OFF_BAR), st);
    for (int ph = ph0; ph < ph1; ++ph) {
      run_phase(p, ph, smem, &xb);
      if (ph + 1 < ph1) xcd_barrier(xb);
      if (PROBE_REP == 99 && ph == 0) { for (int q = 0; q < 20; ++q) xcd_barrier(xb); }
    }
  } else {
    for (int ph = ph0; ph < ph1; ++ph) run_phase(p, ph, smem, nullptr);
  }
}

extern "C" void kernel_launch(void* const* d_in, const int* in_sizes, int n_in, void* d_out, int out_size, void* d_ws, size_t ws_size, hipStream_t stream) {
  if (n_in != 23 || ws_size < WS_NEED) { fprintf(stderr, "kernel_launch: bad n_in %d or ws %zu < %zu\n", n_in, ws_size, (size_t)WS_NEED); return; }
  P p{};
  const float** f = (const float**)&p;
  for (int i = 0; i < 23; ++i) f[i] = (const float*)d_in[i];
  p.out = (float*)d_out; p.ws = (char*)d_ws;
  static int inited = 0, grid_blocks = 0;
  if (!inited) {
    hipFuncSetAttribute((const void*)mk_kernel<true>, hipFuncAttributeMaxDynamicSharedMemorySize, LDS_BYTES + 16);
    hipFuncSetAttribute((const void*)mk_kernel<false>, hipFuncAttributeMaxDynamicSharedMemorySize, LDS_BYTES);
    int dev = 0, cus = 0, per_cu = 0;
    hipGetDevice(&dev); hipDeviceGetAttribute(&cus, hipDeviceAttributeMultiprocessorCount, dev);
    hipOccupancyMaxActiveBlocksPerMultiprocessor(&per_cu, mk_kernel<true>, 512, LDS_BYTES + 16);
    if (per_cu > 1) per_cu = 1;
    grid_blocks = cus * per_cu; if (grid_blocks > 256) grid_blocks = 256; if (grid_blocks < 128) grid_blocks = 128;
    inited = 1;
  }
#if MK_COOP
  int ph0 = 0, ph1 = NPHASES;
  void* args[] = {&p, &ph0, &ph1};
  hipMemsetAsync((char*)d_ws + OFF_BAR, 0, 3456 * 4, stream);
  hipError_t er = hipLaunchCooperativeKernel((const void*)mk_kernel<true>, dim3(grid_blocks), dim3(512), args, LDS_BYTES + 16, stream);
  if (er != hipSuccess) fprintf(stderr, "cooperative launch failed: %s (grid %d)\n", hipGetErrorString(er), grid_blocks);
#else
  for (int ph = 0; ph < NPHASES; ++ph) hipLaunchKernelGGL(mk_kernel<false>, dim3(256), dim3(512), LDS_BYTES, stream, p, ph, ph + 1);
#endif
}
```

```cpp
#include <hip/hip_runtime.h>
#include <hip/hip_cooperative_groups.h>
#include <cstdio>
#include <cstdint>
namespace cg = cooperative_groups;

#ifndef MK_COOP
#define MK_COOP 1
#endif

typedef unsigned short bf16_t;
typedef short bf16x8 __attribute__((ext_vector_type(8)));
typedef short s16x4 __attribute__((ext_vector_type(4)));
typedef float f32x16 __attribute__((ext_vector_type(16)));
typedef float f32x8 __attribute__((ext_vector_type(8)));
typedef float f32x4 __attribute__((ext_vector_type(4)));
typedef unsigned u32x4 __attribute__((ext_vector_type(4)));
#define DI __device__ __forceinline__
#define LBAR() do { asm volatile("s_waitcnt lgkmcnt(0)" ::: "memory"); __builtin_amdgcn_s_barrier(); asm volatile("" ::: "memory"); } while (0)
#define MFMA32(a, b, c) __builtin_amdgcn_mfma_f32_32x32x16_bf16((a), (b), (c), 0, 0, 0)

constexpr int DM = 1024, TB = 8448, CTXL = 256, LAT = 8192, MROWS = 2 * TB;
constexpr int NCH = 132;
constexpr int DFF = 2816;
constexpr int NREC = 3840;
constexpr float EPSF = 1e-6f;

constexpr size_t AL(size_t x) { return (x + 255) / 256 * 256; }
constexpr size_t OFF_XRES = 0;
constexpr size_t OFF_HBF = OFF_XRES + AL((size_t)MROWS * DM * 4);
constexpr size_t OFF_WC = OFF_HBF + AL((size_t)MROWS * DM * 2);
constexpr size_t WC_W2 = (size_t)5632 * 1024 * 2;
constexpr size_t OFF_MODS = OFF_WC + AL(WC_W2 + (size_t)1024 * 2816 * 2);
constexpr size_t OFF_SM = OFF_MODS + AL((size_t)4 * 3 * 6144 * 4);
constexpr size_t OFF_GB = OFF_SM + AL((size_t)MROWS * 64 * 4);
constexpr size_t OFF_SC = OFF_GB + AL((size_t)MROWS * 16 * 4);
constexpr size_t OFF_GL = OFF_SC + AL((size_t)16 * NCH * 64 * 2 * 4);
constexpr size_t OFF_D = OFF_GL + AL((size_t)16 * NCH * 4);
constexpr size_t D_P1 = 0;
constexpr size_t D_W = 0;
constexpr size_t D_INTRA = D_W + (size_t)16 * NCH * 64 * 128 * 2;
constexpr size_t D_P2 = D_P1 + (size_t)MROWS * 1536 * 2;
constexpr size_t D_QQ = D_P2 + (size_t)MROWS * 2048 * 2;
constexpr size_t D_QK = D_QQ + (size_t)MROWS * 512 * 2;
constexpr size_t D_QV = D_QK + (size_t)MROWS * 512 * 2;
constexpr size_t D_DNO = D_QK;
constexpr size_t D_KT = D_QV + (size_t)MROWS * 512 * 2;
constexpr size_t D_GLAO = D_KT + (size_t)MROWS * 512 * 2;
constexpr size_t D_END_E = D_GLAO + (size_t)2 * MROWS * 512 * 2;
constexpr size_t D_END_F = (size_t)MROWS * 5632 * 2;
constexpr size_t OFF_B16_1 = OFF_D + (D_END_E > D_END_F ? D_END_E : D_END_F);
constexpr size_t B16_BYTES = (size_t)8 * NCH * 64 * 64 * 2;
constexpr size_t OFF_BAR = OFF_B16_1 + AL(B16_BYTES);
constexpr size_t WS_NEED = OFF_BAR + 3456 * 4;
constexpr int LDS_BYTES = 132 * 1024;

struct P {
  const float *x, *c, *ctx, *c_ctx, *mod_w, *mod_b, *rec_w_in, *rec_conv, *dn_a_log, *dn_dt_bias, *dn_norm, *gla_w2, *gla_b2, *gla_norm,
      *rec_w_out, *att_w_qkv, *att_q_norm, *att_k_norm, *att_w_out, *ffn_w_up, *ffn_conv, *ffn_w_down, *final_norm;
  float* out;
  char* ws;
};

DI int TIDX() { int t = threadIdx.x; asm volatile("" : "+v"(t)); return t; }
DI int BIDX() { int t = blockIdx.x; asm volatile("" : "+s"(t)); return t; }
DI int GDIM() { int t = gridDim.x; asm volatile("" : "+s"(t)); return t; }
DI float bf2f(bf16_t v) { return __uint_as_float(((unsigned)v) << 16); }
DI bf16_t f2bf(float x) { unsigned u = __float_as_uint(x); u += 0x7fffu + ((u >> 16) & 1u); return (bf16_t)(u >> 16); }
DI unsigned cvtpk(float lo, float hi) { unsigned r; asm volatile("v_cvt_pk_bf16_f32 %0, %1, %2" : "=v"(r) : "v"(lo), "v"(hi)); return r; }
DI int crow(int r, int hi) { return (r & 3) + 8 * (r >> 2) + 4 * hi; }
DI float siluf(float x) { return x / (1.f + expf(-x)); }
DI float sigmf(float x) { return 1.f / (1.f + expf(-x)); }
DI float softplusf(float x) { return fmaxf(x, 0.f) + log1pf(expf(-fabsf(x))); }
DI float wave_sum(float v) {
#pragma unroll
  for (int o = 32; o > 0; o >>= 1) v += __shfl_xor(v, o);
  return v;
}
DI int modrow_of(int R) { const int b = R >= TB ? 1 : 0; const int pp = R - b * TB; return pp < CTXL ? 2 : b; }
template <int KS>
DI f32x16 mma_rows(const bf16_t* arow, const bf16_t* brow, f32x16 acc) {
#pragma unroll
  for (int ks = 0; ks < KS; ++ks) {
    const bf16x8 a = *reinterpret_cast<const bf16x8*>(arow + ks * 16);
    const bf16x8 b = *reinterpret_cast<const bf16x8*>(brow + ks * 16);
    acc = MFMA32(a, b, acc);
  }
  return acc;
}

#define XB_TMO      128
#define XB_XCNT(j)  (256  + 64 * (j))
#define XB_XSUB(j)  (1280 + 64 * (j))
#define XB_XGEN(j)  (2304 + 64 * (j))
#define XB_TOP      3328
#define XB_TOPGEN   3392
#define XCD_BAR_WORDS 3456
#define XB_SPIN_CAP (1u << 18)
#define LAS __attribute__((address_space(3)))
DI unsigned xb_ld(unsigned* p)              { return __hip_atomic_load(p, __ATOMIC_RELAXED, __HIP_MEMORY_SCOPE_AGENT); }
DI unsigned xb_add(unsigned* p, unsigned v) { return __hip_atomic_fetch_add(p, v, __ATOMIC_RELAXED, __HIP_MEMORY_SCOPE_AGENT); }
DI unsigned xb_xcc_id() { return (unsigned)__builtin_amdgcn_s_getreg((3 << 11) | 20) & 0xFu; }
#define XB_SPIN(cond, bar) do { unsigned _sp = 0; while (cond) { __builtin_amdgcn_s_sleep(1); \
    if ((++_sp & 255u) == 0u) { if (xb_ld(&(bar)[XB_TMO])) break; if (_sp > XB_SPIN_CAP) { atomicAdd(&(bar)[XB_TMO], 1u); break; } } } } while (0)
struct XcdBarrier { unsigned* bar; unsigned x; volatile LAS unsigned* st; };
DI XcdBarrier xcd_barrier_post(unsigned* bar, volatile LAS unsigned* st) {
    XcdBarrier b; b.bar = bar; b.x = xb_xcc_id(); b.st = st;
    if (threadIdx.x == 0) (void)xb_add(&bar[XB_XCNT(b.x)], 1u);
    return b;
}
DI void xcd_barrier_complete(unsigned* bar, unsigned x, unsigned& nloc, unsigned& nx) {
    const unsigned G = gridDim.x * gridDim.y * gridDim.z;
    unsigned sum, cnt, mine, sp = 0u;
    for (;;) {
        sum = 0u; cnt = 0u; mine = 0u;
#pragma unroll
        for (unsigned j = 0; j < 16; ++j) { const unsigned c = xb_ld(&bar[XB_XCNT(j)]); sum += c; cnt += (c > 0u) ? 1u : 0u; mine = (j == x) ? c : mine; }
        if (sum == G) break;
        __builtin_amdgcn_s_sleep(1);
        if ((++sp & 255u) == 0u) { if (xb_ld(&bar[XB_TMO])) break; if (sp > XB_SPIN_CAP) { atomicAdd(&bar[XB_TMO], 1u); break; } }
    }
    nloc = mine > 0u ? mine : 1u; nx = cnt > 0u ? cnt : 1u;
}
DI void xcd_barrier(const XcdBarrier& b) {
    asm volatile("s_waitcnt vmcnt(0)" ::: "memory");
    __syncthreads();
    if (threadIdx.x == 0) {
        unsigned* bar = b.bar;
        __builtin_amdgcn_s_waitcnt(0);
        unsigned nloc = b.st[0], nx = b.st[1];
        if (nloc == 0u) { xcd_barrier_complete(bar, b.x, nloc, nx); b.st[0] = nloc; b.st[1] = nx; }
        const unsigned old = xb_add(&bar[XB_XSUB(b.x)], 1u);
        const unsigned gen = old / nloc;
        if (old + 1u == (gen + 1u) * nloc) {
            __builtin_amdgcn_fence(__ATOMIC_RELEASE, "agent");
            asm volatile("s_waitcnt vmcnt(0)" ::: "memory");
            const unsigned og = xb_add(&bar[XB_TOP], 1u);
            const unsigned tg = og / nx;
            if (og + 1u == (tg + 1u) * nx) xb_add(&bar[XB_TOPGEN], 1u);
            else XB_SPIN(xb_ld(&bar[XB_TOPGEN]) == tg, bar);
            __builtin_amdgcn_fence(__ATOMIC_ACQUIRE, "agent");
            xb_add(&bar[XB_XGEN(b.x)], 1u);
            asm volatile("s_waitcnt vmcnt(0)" ::: "memory");
        } else {
            XB_SPIN(xb_ld(&bar[XB_XGEN(b.x)]) == gen, bar);
            __builtin_amdgcn_fence(__ATOMIC_ACQUIRE, "agent");
            asm volatile("s_waitcnt vmcnt(0)" ::: "memory");
        }
    }
    __syncthreads();
}

__device__ __forceinline__ void ph_init(const P& p, char* lds) {
  const int tid = TIDX();
  float* sc = (float*)lds;
  float* red = sc + 3072;
  for (int i = tid; i < 3072; i += 512) { const int r = i >> 10, k = i & 1023; const float v = r < 2 ? p.c[r * 1024 + k] : p.c_ctx[k]; sc[i] = siluf(v); }
  __syncthreads();
  float* mods = (float*)(p.ws + OFF_MODS);
  for (int job = BIDX(); job < 192; job += GDIM()) {
    const int col = job * 128 + (tid & 127), kq = tid >> 7;
    const int L = col / 6144, cl = col - L * 6144;
    const float* w = p.mod_w + ((size_t)L * 1024 + kq * 256) * 6144 + cl;
    float a0 = 0.f, a1 = 0.f, a2 = 0.f;
#pragma unroll 8
    for (int k = 0; k < 256; ++k) { const float wv = w[(size_t)k * 6144]; const int kk = kq * 256 + k; a0 += sc[kk] * wv; a1 += sc[1024 + kk] * wv; a2 += sc[2048 + kk] * wv; }
    red[(kq * 3 + 0) * 128 + (tid & 127)] = a0; red[(kq * 3 + 1) * 128 + (tid & 127)] = a1; red[(kq * 3 + 2) * 128 + (tid & 127)] = a2;
    __syncthreads();
    if (tid < 384) { const int r = tid >> 7, cc = tid & 127; const int c2 = job * 128 + cc; const int L2 = c2 / 6144, cl2 = c2 - L2 * 6144;
      const float s = red[(0 * 3 + r) * 128 + cc] + red[(1 * 3 + r) * 128 + cc] + red[(2 * 3 + r) * 128 + cc] + red[(3 * 3 + r) * 128 + cc] + p.mod_b[L2 * 6144 + cl2];
      mods[((size_t)L2 * 3 + r) * 6144 + cl2] = s; }
    __syncthreads();
  }
  f32x4* xr = (f32x4*)(p.ws + OFF_XRES);
  for (size_t i = (size_t)BIDX() * 512 + tid; i < (size_t)MROWS * 256; i += (size_t)GDIM() * 512) {
    const int R = (int)(i >> 8), c4 = (int)(i & 255); const int b = R >= TB ? 1 : 0, pp = R - b * TB;
    const float* src = pp < CTXL ? p.ctx + ((size_t)b * CTXL + pp) * 1024 : p.x + ((size_t)b * LAT + (pp - CTXL)) * 1024;
    xr[i] = *(const f32x4*)(src + c4 * 4);
  }
}

DI int rec_src_col(int n) { if (n < 2048) return n; if (n < 3584) return n + 16; if (n < 3600) return 2048 + (n - 3584); if (n < 3632) return n; return -1; }
__device__ __forceinline__ void cvt_weight(const float* __restrict__ W, bf16_t* __restrict__ Wt, int K, int Nsrc, int Npad, bool perm) {
  const size_t items = (size_t)Npad * (K >> 3);
  for (size_t it = (size_t)BIDX() * 512 + TIDX(); it < items; it += (size_t)GDIM() * 512) {
    const int n = (int)(it % Npad), kb = (int)(it / Npad);
    const int s = perm ? rec_src_col(n) : n;
    float v[8];
#pragma unroll
    for (int j = 0; j < 8; ++j) v[j] = s >= 0 ? W[(size_t)(kb * 8 + j) * Nsrc + s] : 0.f;
    u32x4 w = {cvtpk(v[0], v[1]), cvtpk(v[2], v[3]), cvtpk(v[4], v[5]), cvtpk(v[6], v[7])};
    *(u32x4*)(Wt + (size_t)n * K + kb * 8) = w;
  }
}

__device__ __forceinline__ void ph_norm(const P& p, int L, int which) {
  const int tid = TIDX(), wid = tid >> 6, lane = tid & 63;
  const float* xr = (const float*)(p.ws + OFF_XRES);
  bf16_t* hb = (bf16_t*)(p.ws + OFF_HBF);
  const float* mods = (const float*)(p.ws + OFF_MODS) + (size_t)L * 3 * 6144;
  for (int R = BIDX() * 8 + wid; R < MROWS; R += GDIM() * 8) {
    const float* row = xr + (size_t)R * 1024;
    f32x4 v[4]; float ss = 0.f;
#pragma unroll
    for (int i = 0; i < 4; ++i) { v[i] = *(const f32x4*)(row + i * 256 + lane * 4); ss += v[i][0] * v[i][0] + v[i][1] * v[i][1] + v[i][2] * v[i][2] + v[i][3] * v[i][3]; }
    ss = wave_sum(ss);
    const float rs = rsqrtf(ss * (1.f / 1024.f) + EPSF);
    const float* mr = mods + (size_t)modrow_of(R) * 6144 + which * 3072;
#pragma unroll
    for (int i = 0; i < 4; ++i) { const int c0 = i * 256 + lane * 4; const f32x4 sh = *(const f32x4*)(mr + c0), scl = *(const f32x4*)(mr + 1024 + c0);
      float o[4];
#pragma unroll
      for (int j = 0; j < 4; ++j) o[j] = v[i][j] * rs * (1.f + scl[j]) + sh[j];
      uint2 w; w.x = cvtpk(o[0], o[1]); w.y = cvtpk(o[2], o[3]);
      *(uint2*)(hb + (size_t)R * 1024 + c0) = w; }
  }
}

struct EpiRec { bf16_t* P1; bf16_t* P2; float* SM;
  DI void operator()(int row, int col, float v) const {
    if (col < 1536) P1[(size_t)row * 1536 + col] = f2bf(v);
    else if (col < 3584) P2[(size_t)row * 2048 + (col - 1536)] = f2bf(v);
    else { const int lc = col - 3584; if (lc < 48) SM[(size_t)row * 64 + lc] = v; } } };
struct EpiBf { bf16_t* O; int ldc;
  DI void operator()(int row, int col, float v) const { O[(size_t)row * ldc + col] = f2bf(v); } };
struct EpiRes { float* X; const float* gate;
  DI void operator()(int row, int col, float v) const { float* q = X + (size_t)row * 1024 + col; *q = *q + gate[(size_t)modrow_of(row) * 6144 + col] * v; } };

template <class Epi>
__device__ __forceinline__ void gemm_phase(char* lds, const bf16_t* __restrict__ A, int lda, const bf16_t* __restrict__ Bt, int K, int nN, const Epi epi, bool skipctx = false) {
  const int tid = TIDX(), wid = tid >> 6, lane = tid & 63, r32 = lane & 31, hi = lane >> 5;
  const int wm = wid >> 1, wn = wid & 1;
  const int nk = K >> 6;
  constexpr int RS = 144, ASZ = 256 * RS, BSZ = 128 * RS, STG = ASZ + BSZ;
  const int ntiles = (skipctx ? 64 : MROWS / 256) * nN;
  const int srow = tid >> 3, spc = tid & 7;
  for (int t = BIDX(); t < ntiles; t += GDIM()) {
    int pm = t / nN; const int pn = t - pm * nN; if (skipctx) pm = pm + 1 + (pm >= 32 ? 1 : 0);
    const bf16_t* Ab = A + (size_t)(pm * 256 + srow) * lda + spc * 8;
    const bf16_t* Bb = Bt + (size_t)(pn * 128 + srow) * K + spc * 8;
    f32x16 acc00 = {}, acc01 = {}, acc10 = {}, acc11 = {};
    bf16x8 ra0, ra1, ra2, ra3, rb0, rb1;
#define GLOAD(kt) do { const int ko = (kt) * 64; ra0 = *(const bf16x8*)(Ab + ko); ra1 = *(const bf16x8*)(Ab + (size_t)64 * lda + ko); ra2 = *(const bf16x8*)(Ab + (size_t)128 * lda + ko); \
    ra3 = *(const bf16x8*)(Ab + (size_t)192 * lda + ko); rb0 = *(const bf16x8*)(Bb + ko); rb1 = *(const bf16x8*)(Bb + (size_t)64 * K + ko); } while (0)
#define SWRITE(buf) do { char* sb = lds + (buf) * STG + srow * RS + spc * 16; *(bf16x8*)(sb) = ra0; *(bf16x8*)(sb + 64 * RS) = ra1; *(bf16x8*)(sb + 128 * RS) = ra2; *(bf16x8*)(sb + 192 * RS) = ra3; \
    *(bf16x8*)(sb + ASZ) = rb0; *(bf16x8*)(sb + ASZ + 64 * RS) = rb1; } while (0)
    GLOAD(0); SWRITE(0); __syncthreads();
    for (int kt = 0; kt < nk; ++kt) {
      const int cur = kt & 1;
      if (kt + 1 < nk) GLOAD(kt + 1);
      const char* ab = lds + cur * STG + (64 * wm + r32) * RS + hi * 16;
      const char* bb = lds + cur * STG + ASZ + (64 * wn + r32) * RS + hi * 16;
#pragma unroll
      for (int ks = 0; ks < 4; ++ks) {
        const bf16x8 a0 = *(const bf16x8*)(ab + ks * 32), a1 = *(const bf16x8*)(ab + 32 * RS + ks * 32);
        const bf16x8 b0 = *(const bf16x8*)(bb + ks * 32), b1 = *(const bf16x8*)(bb + 32 * RS + ks * 32);
        acc00 = MFMA32(a0, b0, acc00); acc01 = MFMA32(a0, b1, acc01); acc10 = MFMA32(a1, b0, acc10); acc11 = MFMA32(a1, b1, acc11);
      }
      if (kt + 1 < nk) SWRITE(cur ^ 1);
      __syncthreads();
    }
#undef GLOAD
#undef SWRITE
    const int row0 = pm * 256 + 64 * wm, col0 = pn * 128 + 64 * wn + r32;
#pragma unroll
    for (int r = 0; r < 16; ++r) { const int rr = row0 + crow(r, hi);
      epi(rr, col0, acc00[r]); epi(rr, col0 + 32, acc01[r]); epi(rr + 32, col0, acc10[r]); epi(rr + 32, col0 + 32, acc11[r]); }
  }
}

namespace pg8 {
#define PG8_LAS __attribute__((address_space(3)))
constexpr int BM = 256, BK = 64, HALF = 128, HTB = HALF * BK * 2  , STAGE_BYTES = 8 * HTB, NXCD = 8, WGM = 8;

__host__ __device__ __forceinline__ int lds_byte(int r, int c) { const int st = (r >> 4) * 2 + (c >> 5), rr = r & 15, cc = c & 31, ob = rr * 64 + cc * 2; return st * 1024 + (ob ^ (((ob >> 9) & 1) << 5)); }
__host__ __device__ __forceinline__ void stage_rc(int b, int& R, int& C) { const int st = b / 1024, sb = b % 1024, swz = sb ^ (((sb >> 9) & 1) << 5); R = (st >> 1) * 16 + swz / 64; C = (st & 1) * 32 + (swz % 64) / 2; }
__host__ __device__ __forceinline__ int perm32(int rho) { const int n = rho >> 4, i = rho & 15; return 8 * (i >> 2) + 4 * n + (i & 3); }
struct Unit { int pm, pn; };
struct Gemm { const bf16_t* A; const bf16_t* Bt; int M, N, K, lda; };

struct StaticOrder {
    int nM, nN, nwg, G, c;
    __host__ __device__ void init(int M, int N, int G_, int c_) { nM = M / BM; nN = N / BM; nwg = nM * nN; G = G_; c = c_; }
    __host__ __device__ bool next(int i, Unit& u) const {
        const long L = (long)i * G + c; if (L >= nwg) return false;
        int wgid = (int)L; { const int q = nwg / NXCD, r = nwg % NXCD, xcd = wgid % NXCD, off = wgid / NXCD; wgid = (xcd < r ? xcd * (q + 1) : r * (q + 1) + (xcd - r) * q) + off; }
        const int nig = WGM * nN, gid = wgid / nig, fm = gid * WGM, gsz = (nM - fm) < WGM ? (nM - fm) : WGM;
        u.pm = fm + ((wgid % nig) % gsz); u.pn = (wgid % nig) / gsz; return true;
    }
    __device__ __forceinline__ void a_ready(const Unit&) const {}
    __device__ __forceinline__ void done(const Unit&) const {}
};
template <class Epi, class Sched, bool ALIGN_EPI = false, bool SP2 = false>
__device__ __forceinline__ void gemm_phase(PG8_LAS unsigned char* lds, const Gemm g, const Sched& S, const Epi& E) {
    const int tid = TIDX(), wid = __builtin_amdgcn_readfirstlane(tid >> 6), lane = tid & 63, wr = wid >> 2, wc = wid & 3, fr = lane & 15, fq = lane >> 4;
    const int K = g.K, nt = K / BK;
    unsigned voffA[2], voffB[2];
#pragma unroll
    for (int i = 0; i < 2; ++i) { int R, C; stage_rc(tid * 16 + i * 8192, R, C); const int Rb = Epi::PERM ? ((R & ~31) + perm32(R & 31)) : R;
        voffA[i] = (unsigned)(R * g.lda + C) * 2u; voffB[i] = (unsigned)(Rb * K + C) * 2u; }
    const size_t kstep = (size_t)(BK * 2);
    const size_t hstep = (size_t)HALF * K * 2;
    const size_t tstep = 2 * hstep; const size_t hstepA = (size_t)HALF * g.lda * 2, tstepA = 2 * hstepA;
    const unsigned ldsw = (unsigned)wid * 1024u;
    const int aoff = lds_byte(wr * 64 + fr, fq * 8), boff = lds_byte(wc * 32 + fr, fq * 8);
#define PG8_SA(b, h) (((b) * 2 + (h)) * HTB)
#define PG8_SB(b, h) ((4 + (b) * 2 + (h)) * HTB)
#define PG8_STAGE(bufoff, gbase, voff) do { _Pragma("unroll") for (int _i = 0; _i < 2; ++_i) \
        __builtin_amdgcn_global_load_lds((const unsigned*)((const char*)(gbase) + (voff)[_i]), (PG8_LAS unsigned*)(lds + (bufoff) + ldsw + _i * 8192), 16, 0, 0); } while (0)
#define PG8_LDA(dst, b, h) do { _Pragma("unroll") for (int m = 0; m < 4; ++m) _Pragma("unroll") for (int k = 0; k < 2; ++k) dst[m][k] = *(const PG8_LAS bf16x8*)(lds + PG8_SA(b, h) + aoff + m * 2048 + k * 1024); } while (0)
#define PG8_LDB(dst, b, h) do { _Pragma("unroll") for (int n = 0; n < 2; ++n) _Pragma("unroll") for (int k = 0; k < 2; ++k) dst[n][k] = *(const PG8_LAS bf16x8*)(lds + PG8_SB(b, h) + boff + n * 2048 + k * 1024); } while (0)
#define PG8_MMA(ai, bj, At, Bt) do { __builtin_amdgcn_s_setprio(1); _Pragma("unroll") for (int m = 0; m < 4; ++m) _Pragma("unroll") for (int n = 0; n < 2; ++n) _Pragma("unroll") for (int k = 0; k < 2; ++k) \
        acc[ai][bj][m][n] = __builtin_amdgcn_mfma_f32_16x16x32_bf16(Bt[n][k], At[m][k], acc[ai][bj][m][n], 0, 0, 0); __builtin_amdgcn_s_setprio(0); } while (0)
#define PG8_WAIT_V(n) asm volatile("s_waitcnt vmcnt(" #n ")" ::: "memory")
#define PG8_WAIT_L(n) asm volatile("s_waitcnt lgkmcnt(" #n ")" ::: "memory")
#define PG8_BAR __builtin_amdgcn_s_barrier()
#define PG8_SCHED __builtin_amdgcn_sched_barrier(0)
    Unit cur, nxt; int ui = 0;
    if (!S.next(0, cur)) return;
    f32x4 acc[2][2][4][2];
#pragma unroll
    for (int a = 0; a < 2; ++a)
#pragma unroll
        for (int b = 0; b < 2; ++b)
#pragma unroll
            for (int m = 0; m < 4; ++m)
#pragma unroll
                for (int n = 0; n < 2; ++n) acc[a][b][m][n] = (f32x4){0.f, 0.f, 0.f, 0.f};
    bf16x8 At[4][2], B0[2][2], B1[2][2];
    const char* cA = (const char*)g.A + (size_t)cur.pm * tstepA; const char* cB = (const char*)g.Bt + (size_t)cur.pn * tstep;
    S.a_ready(cur);
    if constexpr (SP2) {
        PG8_STAGE(PG8_SB(0, 0), cB, voffB); PG8_STAGE(PG8_SB(0, 1), cB + hstep, voffB); PG8_STAGE(PG8_SA(0, 0), cA, voffA); PG8_STAGE(PG8_SA(0, 1), cA + hstepA, voffA);
        if (wr == 1) PG8_BAR;
        PG8_WAIT_V(2); PG8_BAR;
        PG8_STAGE(PG8_SB(1, 0), cB + kstep, voffB); PG8_STAGE(PG8_SA(1, 0), cA + kstep, voffA); PG8_STAGE(PG8_SB(1, 1), cB + hstep + kstep, voffB);
        PG8_WAIT_V(6); PG8_BAR;
    } else {
        PG8_STAGE(PG8_SB(0, 0), cB, voffB); PG8_STAGE(PG8_SA(0, 0), cA, voffA); PG8_STAGE(PG8_SB(0, 1), cB + hstep, voffB); PG8_STAGE(PG8_SA(0, 1), cA + hstepA, voffA);
        if (wr == 1) PG8_BAR;
        PG8_WAIT_V(4); PG8_BAR;
        PG8_STAGE(PG8_SB(1, 0), cB + kstep, voffB); PG8_STAGE(PG8_SA(1, 0), cA + kstep, voffA); PG8_STAGE(PG8_SB(1, 1), cB + hstep + kstep, voffB);
        PG8_WAIT_V(6); PG8_BAR;
    }
    for (;;) {
        const bool has_next = S.next(ui + 1, nxt);
        const char* nA = has_next ? (const char*)g.A + (size_t)nxt.pm * tstepA : cA; const char* nB = has_next ? (const char*)g.Bt + (size_t)nxt.pn * tstep : cB;
        for (int t = 0; t < nt; t += 2) {
            const bool last = (t == nt - 2);
            const char* a1 = cA + (size_t)(t + 1) * kstep;
            const char* a2 = last ? nA : cA + (size_t)(t + 2) * kstep; const char* b2 = last ? nB : cB + (size_t)(t + 2) * kstep;
            const char* a3 = a2 + kstep; const char* b3 = b2 + kstep;
            if (last && has_next) S.a_ready(nxt);
            if constexpr (SP2) {
            PG8_LDB(B0, 0, 0); PG8_LDB(B1, 0, 1); PG8_SCHED; PG8_LDA(At, 0, 0); PG8_STAGE(PG8_SA(1, 1), a1 + hstepA, voffA);
            PG8_WAIT_V(8); PG8_WAIT_L(0); PG8_BAR; PG8_MMA(0, 0, At, B0); PG8_MMA(0, 1, At, B1); PG8_BAR; PG8_SCHED;
            PG8_LDA(At, 0, 1); PG8_STAGE(PG8_SB(0, 0), b2, voffB); PG8_STAGE(PG8_SB(0, 1), b2 + hstep, voffB); PG8_STAGE(PG8_SA(0, 0), a2, voffA);
            PG8_WAIT_V(8); PG8_WAIT_L(0); PG8_BAR; PG8_MMA(1, 0, At, B0); PG8_MMA(1, 1, At, B1); PG8_BAR; PG8_SCHED;
            PG8_LDB(B0, 1, 0); PG8_LDB(B1, 1, 1); PG8_SCHED; PG8_LDA(At, 1, 0); PG8_STAGE(PG8_SA(0, 1), a2 + hstepA, voffA);
            PG8_WAIT_V(8); PG8_WAIT_L(0); PG8_BAR; PG8_MMA(0, 0, At, B0); PG8_MMA(0, 1, At, B1); PG8_BAR; PG8_SCHED;
            PG8_LDA(At, 1, 1); PG8_STAGE(PG8_SB(1, 0), b3, voffB); PG8_STAGE(PG8_SB(1, 1), b3 + hstep, voffB); PG8_STAGE(PG8_SA(1, 0), a3, voffA);
            PG8_WAIT_V(8); PG8_WAIT_L(0); PG8_BAR; PG8_MMA(1, 0, At, B0); PG8_MMA(1, 1, At, B1); PG8_BAR; PG8_SCHED;
            } else {
            PG8_LDB(B0, 0, 0); PG8_SCHED; PG8_LDA(At, 0, 0); PG8_STAGE(PG8_SA(1, 1), a1 + hstepA, voffA);
            PG8_WAIT_L(8); PG8_BAR; PG8_WAIT_L(0); PG8_MMA(0, 0, At, B0); PG8_BAR; PG8_SCHED;
            PG8_LDB(B1, 0, 1); PG8_STAGE(PG8_SB(0, 0), b2, voffB);
            PG8_BAR; PG8_WAIT_L(0); PG8_MMA(0, 1, At, B1); PG8_BAR;
            PG8_LDA(At, 0, 1); PG8_STAGE(PG8_SA(0, 0), a2, voffA);
            PG8_BAR; PG8_WAIT_L(0); PG8_MMA(1, 0, At, B0); PG8_BAR; PG8_SCHED;
            PG8_STAGE(PG8_SB(0, 1), b2 + hstep, voffB);
            PG8_WAIT_V(6); PG8_BAR; PG8_MMA(1, 1, At, B1); PG8_BAR;
            PG8_LDB(B0, 1, 0); PG8_SCHED; PG8_LDA(At, 1, 0); PG8_STAGE(PG8_SA(0, 1), a2 + hstepA, voffA);
            PG8_WAIT_L(8); PG8_BAR; PG8_WAIT_L(0); PG8_MMA(0, 0, At, B0); PG8_BAR; PG8_SCHED;
            PG8_LDB(B1, 1, 1); PG8_STAGE(PG8_SB(1, 0), b3, voffB);
            PG8_BAR; PG8_WAIT_L(0); PG8_MMA(0, 1, At, B1); PG8_BAR;
            PG8_LDA(At, 1, 1); PG8_STAGE(PG8_SA(1, 0), a3, voffA);
            PG8_BAR; PG8_WAIT_L(0); PG8_MMA(1, 0, At, B0); PG8_BAR; PG8_SCHED;
            PG8_STAGE(PG8_SB(1, 1), b3 + hstep, voffB);
            PG8_WAIT_V(6); PG8_BAR; PG8_MMA(1, 1, At, B1); PG8_BAR;
            }
        }
        if constexpr (ALIGN_EPI) { if (wr == 0) PG8_BAR; }
        if constexpr (!Epi::AFTER_DRAIN) { E(acc, cur, wr, wc, fr, fq); S.done(cur); }
        if (!has_next) break;
#pragma unroll
        for (int a = 0; a < 2; ++a)
#pragma unroll
            for (int b = 0; b < 2; ++b)
#pragma unroll
                for (int m = 0; m < 4; ++m)
#pragma unroll
                    for (int n = 0; n < 2; ++n) acc[a][b][m][n] = (f32x4){0.f, 0.f, 0.f, 0.f};
        cur = nxt; cA = nA; cB = nB; ++ui;
        if constexpr (ALIGN_EPI) { if (wr == 1) PG8_BAR; }
    }
    PG8_WAIT_V(0);
    if constexpr (!ALIGN_EPI) { if (wr == 0) PG8_BAR; }
    PG8_BAR;
    if constexpr (Epi::AFTER_DRAIN) { E.fused(acc, cur, wr, wc, fr, fq, lds, wid, lane); S.done(cur); }
#undef PG8_SA
#undef PG8_SB
#undef PG8_STAGE
#undef PG8_LDA
#undef PG8_LDB
#undef PG8_MMA
#undef PG8_WAIT_V
#undef PG8_WAIT_L
#undef PG8_BAR
#undef PG8_SCHED
}
struct SchedX { StaticOrder so; bool skip;
  __device__ __forceinline__ bool next(int i, Unit& u) const { if (!so.next(i, u)) return false; if (skip) u.pm = u.pm + 1 + (u.pm >= 32 ? 1 : 0); return true; }
  __device__ __forceinline__ void a_ready(const Unit&) const {}
  __device__ __forceinline__ void done(const Unit&) const {} };
}
struct EpiRec8 { static constexpr bool PERM = false, AFTER_DRAIN = false; bf16_t* P1; bf16_t* P2; float* SM;
  DI void operator()(const f32x4 (&acc)[2][2][4][2], const pg8::Unit& u, int wr, int wc, int fr, int fq) const {
#pragma unroll
    for (int ai = 0; ai < 2; ++ai)
#pragma unroll
      for (int m = 0; m < 4; ++m) { const size_t row = (size_t)u.pm * 256 + ai * 128 + wr * 64 + m * 16 + fr;
#pragma unroll
        for (int bj = 0; bj < 2; ++bj)
#pragma unroll
          for (int n = 0; n < 2; ++n) { const int col = u.pn * 256 + bj * 128 + wc * 32 + n * 16 + fq * 4; const f32x4 v = acc[ai][bj][m][n];
            if (u.pn < 6) { uint2 w; w.x = cvtpk(v[0], v[1]); w.y = cvtpk(v[2], v[3]); *(uint2*)(P1 + row * 1536 + col) = w; }
            else if (u.pn < 14) { uint2 w; w.x = cvtpk(v[0], v[1]); w.y = cvtpk(v[2], v[3]); *(uint2*)(P2 + row * 2048 + (col - 1536)) = w; }
            else { const int lc = col - 3584; if (lc < 48) *(f32x4*)(SM + row * 64 + lc) = v; } } } } };
struct EpiBf8 { static constexpr bool PERM = false, AFTER_DRAIN = false; bf16_t* O; int ldc;
  DI void operator()(const f32x4 (&acc)[2][2][4][2], const pg8::Unit& u, int wr, int wc, int fr, int fq) const {
#pragma unroll
    for (int ai = 0; ai < 2; ++ai)
#pragma unroll
      for (int m = 0; m < 4; ++m) { const size_t row = (size_t)u.pm * 256 + ai * 128 + wr * 64 + m * 16 + fr;
#pragma unroll
        for (int bj = 0; bj < 2; ++bj)
#pragma unroll
          for (int n = 0; n < 2; ++n) { const int col = u.pn * 256 + bj * 128 + wc * 32 + n * 16 + fq * 4; const f32x4 v = acc[ai][bj][m][n];
            uint2 w; w.x = cvtpk(v[0], v[1]); w.y = cvtpk(v[2], v[3]); *(uint2*)(O + row * ldc + col) = w; } } } };
template <class Epi>
__device__ __forceinline__ void gemm8(char* lds, const bf16_t* A, int lda, const bf16_t* Bt, int K, int N, bool skipctx, const Epi& E) {
  pg8::Gemm g{A, Bt, skipctx ? 16384 : MROWS, N, K, lda};
  pg8::SchedX S; S.so.init(g.M, N, GDIM(), BIDX()); S.skip = skipctx;
  pg8::gemm_phase<Epi, pg8::SchedX, true, true>((PG8_LAS unsigned char*)lds, g, S, E);
}

__device__ __forceinline__ void ph_dnprep(const P& p, char* lds, int e) {
  const int tid = TIDX(), wid = tid >> 6, lane = tid & 63;
  const bf16_t* P1 = (const bf16_t*)(p.ws + OFF_D + D_P1);
  bf16_t* QQ = (bf16_t*)(p.ws + OFF_D + D_QQ); bf16_t* QK = (bf16_t*)(p.ws + OFF_D + D_QK); bf16_t* QV = (bf16_t*)(p.ws + OFF_D + D_QV);
  bf16_t* KT = (bf16_t*)(p.ws + OFF_D + D_KT);
  const float* SM = (const float*)(p.ws + OFF_SM); float* GB = (float*)(p.ws + OFF_GB);
  const float* cw = p.rec_conv + (size_t)e * 3 * 1536;
  bf16_t* kl = (bf16_t*)lds;
  for (int job = BIDX(); job < MROWS / 64; job += GDIM()) {
    const int R0 = job * 64;
    for (int tt = 0; tt < 8; ++tt) {
      const int tl = wid * 8 + tt, R = R0 + tl; const int b = R >= TB ? 1 : 0, pp = R - b * TB;
      const bool hasp = !(pp == 0 || pp == CTXL), hasn = !(pp == CTXL - 1 || pp == TB - 1);
#pragma unroll
      for (int part = 0; part < 3; ++part) {
        const int ch = part * 512 + lane * 8;
        const bf16x8 zc = *(const bf16x8*)(P1 + (size_t)R * 1536 + ch);
        bf16x8 zp = {}, zn = {};
        if (hasp) zp = *(const bf16x8*)(P1 + (size_t)(R - 1) * 1536 + ch);
        if (hasn) zn = *(const bf16x8*)(P1 + (size_t)(R + 1) * 1536 + ch);
        float o[8]; float ss = 0.f;
#pragma unroll
        for (int j = 0; j < 8; ++j) { const float a = bf2f((bf16_t)zp[j]) * cw[ch + j] + bf2f((bf16_t)zc[j]) * cw[1536 + ch + j] + bf2f((bf16_t)zn[j]) * cw[3072 + ch + j];
          o[j] = siluf(a); ss += o[j] * o[j]; }
        if (part < 2) {
          ss += __shfl_xor(ss, 1); ss += __shfl_xor(ss, 2); ss += __shfl_xor(ss, 4); ss += __shfl_xor(ss, 8);
          float sc = rsqrtf(ss + EPSF); if (part == 0) sc *= 0.08838834764831845f;
#pragma unroll
          for (int j = 0; j < 8; ++j) o[j] *= sc;
        }
        u32x4 w = {cvtpk(o[0], o[1]), cvtpk(o[2], o[3]), cvtpk(o[4], o[5]), cvtpk(o[6], o[7])};
        bf16_t* dst = part == 0 ? QQ : (part == 1 ? QK : QV);
        *(u32x4*)(dst + (size_t)R * 512 + lane * 8) = w;
        if (part == 1) *(u32x4*)(kl + tl * 512 + lane * 8) = w;
      }
      if (lane < 16) {
        const int q = lane & 7;
        if (lane < 8) { const float da = SM[(size_t)R * 64 + q]; GB[(size_t)R * 16 + q] = -expf(p.dn_a_log[e * 8 + q]) * softplusf(da + p.dn_dt_bias[e * 8 + q]); }
        else { const float db = SM[(size_t)R * 64 + 8 + q]; GB[(size_t)R * 16 + 8 + q] = sigmf(db); }
      }
    }
    __syncthreads();
    {
      const int b = R0 >= TB ? 1 : 0, c = (R0 - b * TB) / 64; const int h = tid >> 7, dk = tid & 127;
      bf16_t* dst = KT + ((((size_t)b * 4 + h) * NCH + c) * 128 + dk) * 64;
#pragma unroll
      for (int g8 = 0; g8 < 8; ++g8) { unsigned w[4];
#pragma unroll
        for (int j = 0; j < 4; ++j) { const unsigned lo = kl[(g8 * 8 + 2 * j) * 512 + tid], hi2 = kl[(g8 * 8 + 2 * j + 1) * 512 + tid]; w[j] = lo | (hi2 << 16); }
        *(u32x4*)(dst + g8 * 8) = (u32x4){w[0], w[1], w[2], w[3]}; }
    }
    __syncthreads();
  }
}

__device__ __forceinline__ void ph_dn_d1(const P& p, char* lds) {
  const int tid = TIDX(), wid = tid >> 6, lane = tid & 63, r32 = lane & 31, hi = lane >> 5;
  const bf16_t* QQ = (const bf16_t*)(p.ws + OFF_D + D_QQ); const bf16_t* QK = (const bf16_t*)(p.ws + OFF_D + D_QK); const bf16_t* QV = (const bf16_t*)(p.ws + OFF_D + D_QV);
  const float* GB = (const float*)(p.ws + OFF_GB);
  bf16_t* W_ = (bf16_t*)(p.ws + OFF_D + D_W); bf16_t* U_ = (bf16_t*)(p.ws + OFF_HBF); bf16_t* INTRA = (bf16_t*)(p.ws + OFF_D + D_INTRA);
  float* SC = (float*)(p.ws + OFF_SC); float* GLS = (float*)(p.ws + OFF_GL);
  float* KK = (float*)lds; float* QKm = KK + 64 * 65; float* Ad = QKm + 64 * 65; float* Gs = Ad + 2 * 4096; float* Bs = Gs + 128;
  for (int job = BIDX(); job < 8 * NCH; job += GDIM()) {
    const int b = job / (4 * NCH), h = (job / NCH) & 3, c = job % NCH;
    const size_t Rb = (size_t)b * TB + (size_t)c * 64;
    {
      const int w4 = wid & 3, mi = w4 & 1, ni = w4 >> 1;
      const bf16_t* As = wid < 4 ? QK : QQ;
      const bf16_t* arow = As + (Rb + 32 * mi + r32) * 512 + h * 128 + hi * 8;
      const bf16_t* brow = QK + (Rb + 32 * ni + r32) * 512 + h * 128 + hi * 8;
      f32x16 acc = {}; acc = mma_rows<8>(arow, brow, acc);
      float* dst = wid < 4 ? KK : QKm;
#pragma unroll
      for (int r = 0; r < 16; ++r) dst[(32 * mi + crow(r, hi)) * 65 + 32 * ni + r32] = acc[r];
    }
    if (tid < 128) { const int d = tid >> 6, ip = tid & 63, t = d ? 63 - ip : ip; Gs[tid] = GB[(Rb + t) * 16 + d * 4 + h]; Bs[tid] = GB[(Rb + t) * 16 + 8 + d * 4 + h]; }
    __syncthreads();
    if (tid == 0 || tid == 64) { float s = 0.f; for (int i = 0; i < 64; ++i) { s += Gs[tid + i]; Gs[tid + i] = s; } }
    __syncthreads();
    const int n0 = c, n1 = c < 4 ? 3 - c : 135 - c;
    const size_t cj0 = ((size_t)(0 * 2 + b) * 4 + h) * NCH + n0, cj1 = ((size_t)(1 * 2 + b) * 4 + h) * NCH + n1;
    for (int e2 = tid; e2 < 8192; e2 += 512) {
      const int d = e2 >> 12, ip = (e2 >> 6) & 63, jp = e2 & 63; const int i = d ? 63 - ip : ip, j = d ? 63 - jp : jp;
      const float dec = jp <= ip ? expf(Gs[d * 64 + ip] - Gs[d * 64 + jp]) : 0.f;
      Ad[d * 4096 + ip * 64 + jp] = jp < ip ? Bs[d * 64 + ip] * KK[i * 65 + j] * dec : 0.f;
      const size_t cj = d ? cj1 : cj0;
      INTRA[(cj * 64 + ip) * 64 + jp] = f2bf(QKm[i * 65 + j] * dec);
    }
    if (tid < 128) { const int d = tid >> 6, ip = tid & 63; const size_t cj = d ? cj1 : cj0; const float gi = Gs[tid], gl = Gs[d * 64 + 63];
      SC[(cj * 64 + ip) * 2] = expf(gi); SC[(cj * 64 + ip) * 2 + 1] = expf(gl - gi); if (ip == 0) GLS[cj] = expf(gl); }
    __syncthreads();
    {
      const int d = tid >> 8, cc = tid & 255; const size_t cj = d ? cj1 : cj0;
      int dofs = d * 64, aofs = d * 4096; asm volatile("" : "+v"(dofs), "+v"(aofs));
      float x[64];
      {
        const bf16_t* srcb = (cc < 128 ? QV + h * 128 + cc : QK + h * 128 + (cc - 128)) + (Rb + (d ? 63 : 0)) * 512;
        const long step = d ? -512 : 512;
#pragma unroll
        for (int g = 0; g < 8; ++g) {
#pragma unroll
          for (int q8 = 0; q8 < 8; ++q8) { const int ip = g * 8 + q8; x[ip] = bf2f(srcb[ip * step]); }
          asm volatile("" ::: "memory");
        }
        if (cc < 128) {
#pragma unroll
          for (int ip = 0; ip < 64; ++ip) x[ip] *= Bs[dofs + ip];
        } else {
#pragma unroll
          for (int ip = 0; ip < 64; ++ip) x[ip] *= Bs[dofs + ip] * expf(Gs[dofs + ip]);
        }
      }
      const float* Arow = Ad + aofs;
#pragma unroll
      for (int ip = 1; ip < 64; ++ip) {
        float s = 0.f;
#pragma unroll
        for (int j4 = 0; j4 < (ip + 3) / 4; ++j4) { const f32x4 a = *(const f32x4*)(Arow + ip * 64 + 4 * j4);
          s += a[0] * x[4 * j4] + a[1] * x[4 * j4 + 1] + a[2] * x[4 * j4 + 2] + a[3] * x[4 * j4 + 3]; }
        x[ip] -= s;
      }
      bf16_t* dst = cc < 128 ? U_ + cj * 64 * 128 + cc : W_ + cj * 64 * 128 + (cc - 128);
#pragma unroll
      for (int ip = 0; ip < 64; ++ip) dst[ip * 128] = f2bf(x[ip]);
    }
    __syncthreads();
  }
}

typedef _Float16 h16x8 __attribute__((ext_vector_type(8)));
__device__ __forceinline__ void ph_gla_b(const P& p, char* lds, int e) {
  const int tid = TIDX(), wid = tid >> 6, lane = tid & 63;
  const float* SM = (const float*)(p.ws + OFF_SM);
  float* w2S = (float*)lds;
  float* b2S = w2S + 8192;
  for (int i = tid; i < 8192; i += 512) { const int d = i >> 12, hh = (i >> 10) & 3, r = (i >> 6) & 15, j = i & 63; w2S[i] = p.gla_w2[(((size_t)e * 2 + d) * 16 + r) * 256 + hh * 64 + j]; }
  if (tid < 512) b2S[tid] = p.gla_b2[(size_t)e * 512 + tid];
  __syncthreads();
  int jb = 8 * wid; asm volatile("" : "+v"(jb));
  for (int job = BIDX(); job < 16 * NCH; job += GDIM()) {
    const int n = job % NCH, sq = job / NCH; const int dir = sq >> 3, b = (sq >> 2) & 1, h = sq & 3;
    const int c = dir == 0 ? n : (n < 4 ? 3 - n : 135 - n);
    const size_t row = (size_t)b * TB + (size_t)c * 64 + (dir ? 63 - lane : lane);
    const float* gp = SM + row * 64 + 16 + dir * 16;
    const f32x4 g0 = *(const f32x4*)(gp), g1 = *(const f32x4*)(gp + 4), g2 = *(const f32x4*)(gp + 8), g3 = *(const f32x4*)(gp + 12);
    const float gg_[16] = {g0[0], g0[1], g0[2], g0[3], g1[0], g1[1], g1[2], g1[3], g2[0], g2[1], g2[2], g2[3], g3[0], g3[1], g3[2], g3[3]};
    const float* wb = w2S + (dir * 4 + h) * 1024 + jb; const float* bb2 = b2S + dir * 256 + h * 64 + jb;
    f32x4 sa = *(const f32x4*)(bb2), sb = *(const f32x4*)(bb2 + 4);
#pragma unroll
    for (int r = 0; r < 16; ++r) { const f32x4 wa = *(const f32x4*)(wb + r * 64), wq = *(const f32x4*)(wb + r * 64 + 4); sa += gg_[r] * wa; sb += gg_[r] * wq; }
    float la[8];
#pragma unroll
    for (int jj = 0; jj < 4; ++jj) { const float x0 = sa[jj], x1 = sb[jj];
      la[jj] = (fminf(x0, 0.f) - log1pf(expf(-fabsf(x0)))) * 0.0625f; la[4 + jj] = (fminf(x1, 0.f) - log1pf(expf(-fabsf(x1)))) * 0.0625f; }
#pragma unroll
    for (int o = 1; o < 64; o <<= 1) {
#pragma unroll
      for (int jj = 0; jj < 8; ++jj) { const float v = __shfl_up(la[jj], o); la[jj] += lane >= o ? v : 0.f; }
    }
    h16x8 hv;
#pragma unroll
    for (int jj = 0; jj < 8; ++jj) hv[jj] = (_Float16)la[jj];
    _Float16* dst = (_Float16*)(p.ws + (dir ? OFF_B16_1 : OFF_WC)) + ((((size_t)b * 4 + h) * NCH + n) * 64 + lane) * 64 + jb;
    *(h16x8*)dst = hv;
  }
}

struct DnSet { bf16x8 fa[8]; };
__device__ __forceinline__ void dn_scan(const P& p, char* lds, int job) {
  const int tid = TIDX(), wid = tid >> 6, lane = tid & 63, r32 = lane & 31, hi = lane >> 5;
  const int dir = job >> 5, b = (job >> 4) & 1, h = (job >> 2) & 3, n0 = (job & 3) * 32;
  const bf16_t* QQ = (const bf16_t*)(p.ws + OFF_D + D_QQ); const bf16_t* KT = (const bf16_t*)(p.ws + OFF_D + D_KT);
  const bf16_t* W_ = (const bf16_t*)(p.ws + OFF_D + D_W); const bf16_t* U_ = (const bf16_t*)(p.ws + OFF_HBF); const bf16_t* INTRA = (const bf16_t*)(p.ws + OFF_D + D_INTRA);
  const float* SC = (const float*)(p.ws + OFF_SC); const float* GLS = (const float*)(p.ws + OFF_GL);
  bf16_t* DNO = (bf16_t*)(p.ws + OFF_D + D_DNO);
  bf16_t* ST = (bf16_t*)lds; bf16_t* vTa = ST + 32 * 136; bf16_t* vTb = vTa + 32 * 72;
  float* scS = (float*)(vTb + 32 * 72);
  bf16_t* uS = (bf16_t*)(scS + 256);
  bf16_t* inS = uS + 2 * 64 * 40;
  for (int i = tid; i < 32 * 136; i += 512) ST[i] = 0;
  f32x16 accS = {};
  const size_t seq = ((size_t)dir * 2 + b) * 4 + h;
  const int mi = wid & 1, di = wid - 4;
  const int role = wid < 2 ? 0 : (wid < 4 ? 1 : 2);
  const int tt = tid - 256;
  DnSet sA, sB;
  u32x4 stU, stI0; float stS = 0.f, glA = 0.f, glB = 0.f;
#define DN_CH(n_) const int n__ = (n_); const int c__ = dir == 0 ? n__ : (n__ < 4 ? 3 - n__ : 135 - n__); const size_t Rb__ = (size_t)b * TB + (size_t)c__ * 64; const size_t cj__ = seq * NCH + n__;
#define DN_LOAD(S, GL, n_) do { DN_CH(n_) \
    const int ipl__ = 32 * mi + r32, tl__ = dir ? 63 - ipl__ : ipl__; \
    const bf16_t* b0__ = W_ + cj__ * 8192 + (32 * mi + r32) * 128 + hi * 8; \
    const bf16_t* b1__ = QQ + (Rb__ + tl__) * 512 + h * 128 + hi * 8; \
    const bf16_t* b2__ = KT + ((((size_t)b * 4 + h) * NCH + c__) * 128 + 32 * (wid & 3) + r32) * 64 + hi * 8; \
    const bf16_t* bs__ = role == 0 ? b0__ : (role == 1 ? b1__ : b2__); \
    _Pragma("unroll") for (int ks = 0; ks < 8; ++ks) S.fa[ks] = *(const bf16x8*)(bs__ + ks * 16); \
    GL = GLS[cj__]; } while (0)
#define DN_STAGE_LD(n_) do { DN_CH(n_) (void)Rb__; \
      stU = *(const u32x4*)(U_ + cj__ * 8192 + ((tid & 255) >> 2) * 128 + n0 + (tid & 3) * 8); \
      stI0 = *(const u32x4*)(INTRA + cj__ * 4096 + (tid >> 3) * 64 + (tid & 7) * 8); \
      stS = SC[cj__ * 128 + (tid & 127)]; } while (0)
#define DN_STAGE_ST(bf_) do { *(u32x4*)(inS + (bf_) * 4608 + (tid >> 3) * 72 + (tid & 7) * 8) = stI0; \
      if (tid < 256) *(u32x4*)(uS + (bf_) * 2560 + (tid >> 2) * 40 + (tid & 3) * 8) = stU; \
      if (tid < 128) scS[(bf_) * 128 + tid] = stS; } while (0)
#define DN_STEP(S, GL, n_, bf_) do { DN_CH(n_) (void)cj__; \
    const float* sc__ = scS + (bf_) * 128; \
    f32x16 acc = {}; \
    if (role < 2) { const bf16_t* sb__ = ST + r32 * 136 + hi * 8; \
      _Pragma("unroll") for (int ks = 0; ks < 8; ++ks) acc = MFMA32(S.fa[ks], *(const bf16x8*)(sb__ + ks * 16), acc); \
      if (role == 0) { const bf16_t* us__ = uS + (bf_) * 2560 + r32; \
        _Pragma("unroll") for (int r = 0; r < 16; ++r) { const int ip = 32 * mi + crow(r, hi); const float vn = bf2f(us__[ip * 40]) - acc[r]; \
          vTa[r32 * 72 + ip] = f2bf(vn); const int to = dir ? 63 - ip : ip; vTb[r32 * 72 + to] = f2bf(vn * sc__[ip * 2 + 1]); } } \
      else { _Pragma("unroll") for (int r = 0; r < 16; ++r) acc[r] *= sc__[(32 * mi + crow(r, hi)) * 2]; } } \
    LBAR(); \
    if (role == 1) { const bf16_t* vb__ = vTa + r32 * 72 + hi * 8; const bf16_t* ib__ = inS + (bf_) * 4608 + (32 * mi + r32) * 72 + hi * 8; \
      _Pragma("unroll") for (int ks = 0; ks < 4; ++ks) acc = MFMA32(*(const bf16x8*)(ib__ + ks * 16), *(const bf16x8*)(vb__ + ks * 16), acc); \
      _Pragma("unroll") for (int r = 0; r < 16; ++r) { const int ip = 32 * mi + crow(r, hi), t = dir ? 63 - ip : ip; \
        DNO[((size_t)dir * MROWS + Rb__ + t) * 512 + h * 128 + n0 + r32] = f2bf(acc[r]); } } \
    else if (role == 2) { const bf16_t* vb__ = vTb + r32 * 72 + hi * 8; \
      _Pragma("unroll") for (int r = 0; r < 16; ++r) accS[r] *= GL; \
      _Pragma("unroll") for (int ks = 0; ks < 4; ++ks) accS = MFMA32(S.fa[ks], *(const bf16x8*)(vb__ + ks * 16), accS); \
      _Pragma("unroll") for (int r = 0; r < 16; ++r) ST[r32 * 136 + 32 * di + crow(r, hi)] = f2bf(accS[r]); } \
    DN_STAGE_ST((bf_) ^ 1); \
    LBAR(); } while (0)
  DN_STAGE_LD(0); DN_STAGE_ST(0);
  DN_LOAD(sA, glA, 0);
  __syncthreads();
  for (int n = 0; n < NCH; n += 2) {
    DN_LOAD(sB, glB, n + 1); DN_STAGE_LD(n + 1);
    DN_STEP(sA, glA, n, 0);
    { const int n2 = n + 2 < NCH ? n + 2 : NCH - 1; DN_LOAD(sA, glA, n2); DN_STAGE_LD(n2); }
    DN_STEP(sB, glB, n + 1, 1);
  }
#undef DN_CH
#undef DN_LOAD
#undef DN_STAGE_LD
#undef DN_STAGE_ST
#undef DN_STEP
}

DI float fast_logsig(float s) { return fminf(s, 0.f) - __logf(1.f + __expf(-fabsf(s))); }
struct GlaRegs { h16x8 ba, bb; bf16x8 qa, qb, ka, kb, v8; };
__device__ __forceinline__ void gla_scan(const P& p, char* lds, int job, int e) {
  const int tid = TIDX(), wid = tid >> 6, lane = tid & 63, r32 = lane & 31, hi = lane >> 5;
  const int dir = job >> 5, b = (job >> 4) & 1, h = (job >> 2) & 3, n0 = (job & 3) * 32;
  const bf16_t* P2 = (const bf16_t*)(p.ws + OFF_D + D_P2); const float* SM = (const float*)(p.ws + OFF_SM);
  bf16_t* GLAO = (bf16_t*)(p.ws + OFF_D + D_GLAO);
  const _Float16* B16 = (const _Float16*)(p.ws + (dir ? OFF_B16_1 : OFF_WC));
  float* w2S = (float*)lds; float* b2S = w2S + 1024; float* aLb = b2S + 64;
  bf16_t* ops = (bf16_t*)(aLb + 128);
  constexpr int OPB = (4 * 64 + 32) * 72;
  bf16_t* attp = ops + 2 * OPB;
  bf16_t* STb = attp + 2 * 32 * 72;
  for (int i = tid; i < 2 * 32 * 72; i += 512) STb[i] = 0;
  f32x16 accS = {};
  __syncthreads();
  GlaRegs RA;
  int jb0 = 16 * (wid & 3); asm volatile("" : "+v"(jb0));
  int vtb0 = 8 * (wid & 3) * 72 + lane; asm volatile("" : "+v"(vtb0));
#define GLA_LOAD(R, n_) do { const int n__ = (n_) < NCH ? (n_) : NCH - 1; const int c__ = dir == 0 ? n__ : (n__ < 4 ? 3 - n__ : 135 - n__); const size_t row__ = (size_t)b * TB + (size_t)c__ * 64 + (dir ? 63 - lane : lane); \
    const _Float16* bp__ = B16 + ((((size_t)b * 4 + h) * NCH + n__) * 64 + lane) * 64 + 16 * (wid & 3); R.ba = *(const h16x8*)(bp__); R.bb = *(const h16x8*)(bp__ + 8); \
    const bf16_t* pr__ = P2 + row__ * 2048; R.qa = *(const bf16x8*)(pr__ + 512 + h * 64 + 16 * (wid & 3)); R.qb = *(const bf16x8*)(pr__ + 512 + h * 64 + 16 * (wid & 3) + 8); \
    R.ka = *(const bf16x8*)(pr__ + 768 + h * 64 + 16 * (wid & 3)); R.kb = *(const bf16x8*)(pr__ + 768 + h * 64 + 16 * (wid & 3) + 8); R.v8 = *(const bf16x8*)(pr__ + 1024 + h * 128 + n0 + 8 * (wid & 3)); } while (0)
#define GLA_HALF(R, BV, QV, KV, jb) do { \
    float eqe[8], eke[8], eqi[8]; \
    _Pragma("unroll") for (int jj = 0; jj < 8; ++jj) { const int j = (jb) + jj; const float bb = (float)BV[jj]; const float bm = __int_as_float(__builtin_amdgcn_readlane(__float_as_int(bb), 32)), bl = __int_as_float(__builtin_amdgcn_readlane(__float_as_int(bb), 63)); \
      const float q_ = bf2f((bf16_t)QV[jj]) * 0.125f, k_ = bf2f((bf16_t)KV[jj]); \
      eqe[jj] = q_ * __expf(bb - bm); eke[jj] = k_ * __expf(bm - bb); eqi[jj] = q_ * __expf(bb); ksT_[j * 72 + lane] = f2bf(k_ * __expf(bl - bb)); if (lane == 63) aL_[j] = __expf(bl); } \
    *(u32x4*)(qe_ + lane * 72 + (jb)) = (u32x4){cvtpk(eqe[0], eqe[1]), cvtpk(eqe[2], eqe[3]), cvtpk(eqe[4], eqe[5]), cvtpk(eqe[6], eqe[7])}; \
    *(u32x4*)(ke_ + lane * 72 + (jb)) = (u32x4){cvtpk(eke[0], eke[1]), cvtpk(eke[2], eke[3]), cvtpk(eke[4], eke[5]), cvtpk(eke[6], eke[7])}; \
    *(u32x4*)(qi_ + lane * 72 + (jb)) = (u32x4){cvtpk(eqi[0], eqi[1]), cvtpk(eqi[2], eqi[3]), cvtpk(eqi[4], eqi[5]), cvtpk(eqi[6], eqi[7])}; } while (0)
#define GLA_PREP(R, bf_) do { bf16_t* qe_ = ops + (bf_) * OPB; bf16_t* ke_ = qe_ + 64 * 72; bf16_t* qi_ = ke_ + 64 * 72; bf16_t* ksT_ = qi_ + 64 * 72; bf16_t* vT_ = ksT_ + 64 * 72; float* aL_ = aLb + (bf_) * 64; \
    GLA_HALF(R, R.ba, R.qa, R.ka, jb0); GLA_HALF(R, R.bb, R.qb, R.kb, jb0 + 8); \
    _Pragma("unroll") for (int q_ = 0; q_ < 8; ++q_) vT_[vtb0 + q_ * 72] = (bf16_t)R.v8[q_]; } while (0)
#define GLA_MMA(n_, bf_) do { const int nq__ = (n_); const int bf = (bf_); \
      const bf16_t* qe_ = ops + bf * OPB; const bf16_t* ke_ = qe_ + 64 * 72; const bf16_t* qi_ = ke_ + 64 * 72; const bf16_t* ksT_ = qi_ + 64 * 72; const bf16_t* vT_ = ksT_ + 64 * 72; const float* aL_ = aLb + bf * 64; \
      const bf16_t* STr = STb + bf * 32 * 72; bf16_t* STw = STb + (bf ^ 1) * 32 * 72; \
      if (wid < 6) { \
        const int mi = wid - 4; bf16_t* attw = attp + mi * 32 * 72; \
        const int c = dir == 0 ? nq__ : (nq__ < 4 ? 3 - nq__ : 135 - nq__); const size_t Rb = (size_t)b * TB + (size_t)c * 64; \
        f32x16 acc = {}; acc = mma_rows<4>(qi_ + (32 * mi + r32) * 72 + hi * 8, STr + r32 * 72 + hi * 8, acc); \
        { f32x16 a0 = {}; a0 = mma_rows<4>(qe_ + (32 * mi + r32) * 72 + hi * 8, ke_ + r32 * 72 + hi * 8, a0); \
          _Pragma("unroll") for (int r = 0; r < 16; ++r) { const int ipl = crow(r, hi); attw[ipl * 72 + r32] = f2bf((mi == 1 || r32 <= ipl) ? a0[r] : 0.f); } \
          f32x16 a1 = {}; if (mi == 1) a1 = mma_rows<4>(qe_ + (32 + r32) * 72 + hi * 8, ke_ + (32 + r32) * 72 + hi * 8, a1); \
          _Pragma("unroll") for (int r = 0; r < 16; ++r) { const int ipl = crow(r, hi); attw[ipl * 72 + 32 + r32] = f2bf((mi == 1 && r32 <= ipl) ? a1[r] : 0.f); } } \
        asm volatile("s_waitcnt lgkmcnt(0)" ::: "memory"); \
        acc = mma_rows<4>(attw + r32 * 72 + hi * 8, vT_ + r32 * 72 + hi * 8, acc); \
        _Pragma("unroll") for (int r = 0; r < 16; ++r) { const int ip = 32 * mi + crow(r, hi), t = dir ? 63 - ip : ip; \
          GLAO[((size_t)dir * MROWS + Rb + t) * 512 + h * 128 + n0 + r32] = f2bf(acc[r]); } \
      } else { \
        const int di = wid - 6; \
        _Pragma("unroll") for (int r = 0; r < 16; ++r) accS[r] *= aL_[32 * di + crow(r, hi)]; \
        accS = mma_rows<4>(ksT_ + (32 * di + r32) * 72 + hi * 8, vT_ + r32 * 72 + hi * 8, accS); \
        _Pragma("unroll") for (int r = 0; r < 16; ++r) STw[r32 * 72 + 32 * di + crow(r, hi)] = f2bf(accS[r]); \
      } } while (0)
  GLA_LOAD(RA, 0);
  if (wid < 4) { GLA_PREP(RA, 0); }
  GLA_LOAD(RA, 1);
  LBAR();
  for (int n = 0; n < NCH; n += 2) {
    if (wid < 4) { GLA_PREP(RA, 1); } else { GLA_MMA(n, 0); }
    GLA_LOAD(RA, n + 2);
    LBAR();
    if (wid < 4) { if (n + 2 < NCH) { GLA_PREP(RA, 0); } } else { GLA_MMA(n + 1, 1); }
    GLA_LOAD(RA, n + 3);
    LBAR();
  }
#undef GLA_MMA
#undef GLA_LOAD
#undef GLA_HALF
#undef GLA_PREP
}

__device__ __forceinline__ void ph_merge(const P& p, int e) {
  const int tid = TIDX(), wid = tid >> 6, lane = tid & 63;
  const bf16_t* DNO = (const bf16_t*)(p.ws + OFF_D + D_DNO); const bf16_t* GLAO = (const bf16_t*)(p.ws + OFF_D + D_GLAO);
  const bf16_t* P2 = (const bf16_t*)(p.ws + OFF_D + D_P2); bf16_t* hb = (bf16_t*)(p.ws + OFF_HBF);
  for (int R = BIDX() * 8 + wid; R < MROWS; R += GDIM() * 8) {
#pragma unroll
    for (int g = 0; g < 8; ++g) {
      const bf16_t* src = g < 4 ? DNO : GLAO; const int hc = (g & 3) * 128 + lane * 2;
      const unsigned a = *(const unsigned*)(src + (size_t)R * 512 + hc), bq = *(const unsigned*)(src + ((size_t)MROWS + R) * 512 + hc);
      const float v0 = bf2f((bf16_t)(a & 0xffff)) + bf2f((bf16_t)(bq & 0xffff)), v1 = bf2f((bf16_t)(a >> 16)) + bf2f((bf16_t)(bq >> 16));
      const float ss = wave_sum(v0 * v0 + v1 * v1);
      const float rs = rsqrtf(ss * (1.f / 128.f) + EPSF);
      const float* nw = g < 4 ? p.dn_norm + e * 128 : p.gla_norm + e * 128;
      const unsigned zz = *(const unsigned*)(P2 + (size_t)R * 2048 + (g < 4 ? 0 : 1536) + hc);
      const float z0 = bf2f((bf16_t)(zz & 0xffff)), z1 = bf2f((bf16_t)(zz >> 16));
      const float o0 = v0 * rs * nw[lane * 2] * siluf(z0), o1 = v1 * rs * nw[lane * 2 + 1] * siluf(z1);
      *(unsigned*)(hb + (size_t)R * 1024 + g * 128 + lane * 2) = cvtpk(o0, o1);
    }
  }
}

__device__ __forceinline__ void ph_ffnact(const P& p, int L) {
  bf16_t* U = (bf16_t*)(p.ws + OFF_D);
  const float* cw = p.ffn_conv + (size_t)L * 3 * DFF;
  const size_t items = (size_t)MROWS * 352;
  for (size_t it = (size_t)BIDX() * 512 + TIDX(); it < items; it += (size_t)GDIM() * 512) {
    const int R = (int)(it / 352), c0 = (int)(it % 352) * 8; const int b = R >= TB ? 1 : 0, pp = R - b * TB;
    const bool hasp = !(pp == 0 || pp == CTXL), hasn = !(pp == CTXL - 1 || pp == TB - 1);
    const bf16x8 zc = *(const bf16x8*)(U + (size_t)R * 5632 + c0); bf16x8 zp = {}, zn = {};
    if (hasp) zp = *(const bf16x8*)(U + (size_t)(R - 1) * 5632 + c0);
    if (hasn) zn = *(const bf16x8*)(U + (size_t)(R + 1) * 5632 + c0);
    const bf16x8 vv = *(const bf16x8*)(U + (size_t)R * 5632 + DFF + c0);
    float o[8];
#pragma unroll
    for (int j = 0; j < 8; ++j) { const float a = bf2f((bf16_t)zp[j]) * cw[c0 + j] + bf2f((bf16_t)zc[j]) * cw[DFF + c0 + j] + bf2f((bf16_t)zn[j]) * cw[2 * DFF + c0 + j];
      o[j] = siluf(a) * bf2f((bf16_t)vv[j]); }
    u32x4 w = {cvtpk(o[0], o[1]), cvtpk(o[2], o[3]), cvtpk(o[4], o[5]), cvtpk(o[6], o[7])};
    *(u32x4*)(U + (size_t)R * 5632 + DFF + c0) = w;
  }
}

__device__ __forceinline__ void ph_qknorm(const P& p, int o) {
  const int tid = TIDX(), wid = tid >> 6, lane = tid & 63;
  bf16_t* QKV = (bf16_t*)(p.ws + OFF_D);
  const float* qn = p.att_q_norm + o * 128; const float* kn = p.att_k_norm + o * 128;
  const float invf = powf(10000.f, -(float)(lane & 31) / 32.f);
  for (int R = BIDX() * 8 + wid; R < MROWS; R += GDIM() * 8) {
    const int b = R >= TB ? 1 : 0, pp = R - b * TB; const bool lat = pp >= CTXL; const int t = pp - CTXL;
    float cr = 1.f, sr = 0.f, cc = 1.f, sn = 0.f;
    if (lat) { const float ar = (float)(t >> 6) * invf, ac = (float)(t & 63) * invf; cr = cosf(ar); sr = sinf(ar); cc = cosf(ac); sn = sinf(ac); }
    for (int hd = 0; hd < 10; ++hd) {
      bf16_t* base = QKV + (size_t)R * 1536 + hd * 128; const float* nw = hd < 8 ? qn : kn;
      float v0 = bf2f(base[lane]), v1 = bf2f(base[64 + lane]);
      const float ss = wave_sum(v0 * v0 + v1 * v1); const float rs = rsqrtf(ss * (1.f / 128.f) + EPSF);
      v0 = v0 * rs * nw[lane]; v1 = v1 * rs * nw[64 + lane];
      const float p0 = __shfl_xor(v0, 32), p1 = __shfl_xor(v1, 32);
      float o0, o1;
      if (lane < 32) { o0 = v0 * cr - p0 * sr; o1 = v1 * cc - p1 * sn; } else { o0 = p0 * sr + v0 * cr; o1 = p1 * sn + v1 * cc; }
      base[lane] = f2bf(o0); base[64 + lane] = f2bf(o1);
    }
  }
}

namespace at {
constexpr int D = 128, NW = 8, QBLK = 32, KVBLK = 64;
constexpr float SCALE = 0.088388347648318440f, THR = 8.f;
constexpr int LDQ = 1536, LDK = 1536, LDO = 1024;
constexpr size_t SHM_V = KVBLK * D * 2, SHM_K = KVBLK * D * 2;
#define KSWZ(row, colB) ((row) * 256 + ((colB) ^ (((row) & 7) << 4)))
#define SBAR() __builtin_amdgcn_sched_barrier(0)
DI void partialSM(f32x16& p0, f32x16& p1, float& m_reg, float& mn, float& alpha) {
  constexpr float C = SCALE * 1.4426950408889634f;
  float pmax = p0[0]; for (int r = 1; r < 16; ++r) pmax = fmaxf(pmax, p0[r]); for (int r = 0; r < 16; ++r) pmax = fmaxf(pmax, p1[r]);
  { auto rr = __builtin_amdgcn_permlane32_swap(__float_as_uint(pmax), __float_as_uint(pmax), false, false);
    pmax = fmaxf(__uint_as_float(rr[0]), __uint_as_float(rr[1])); }
  if (__builtin_expect(__all(pmax - m_reg <= THR / SCALE), 1)) { mn = m_reg; alpha = 1.f; }
  else { mn = fmaxf(m_reg, pmax); alpha = __builtin_amdgcn_exp2f((m_reg - mn) * C); m_reg = mn; }
  float mnC = -mn * C;
  for (int r = 0; r < 16; ++r) p0[r] = fmaf(p0[r], C, mnC); for (int r = 0; r < 16; ++r) p1[r] = fmaf(p1[r], C, mnC);
  for (int r = 0; r < 16; ++r) p0[r] = __builtin_amdgcn_exp2f(p0[r]);
}
DI void finishSM(f32x16& p0, f32x16& p1, float alpha, float& l_reg, bf16x8& pa0, bf16x8& pa1, bf16x8& pa2, bf16x8& pa3) {
  for (int r = 0; r < 16; ++r) p1[r] = __builtin_amdgcn_exp2f(p1[r]);
  float ps = 0; for (int r = 0; r < 16; ++r) ps += p0[r]; for (int r = 0; r < 16; ++r) ps += p1[r];
  { auto rr = __builtin_amdgcn_permlane32_swap(__float_as_uint(ps), __float_as_uint(ps), false, false);
    ps = __uint_as_float(rr[0]) + __uint_as_float(rr[1]); }
  l_reg = l_reg * alpha + ps;
#define PK4(PP, BASE, OUT) do { unsigned a0 = cvtpk(PP[BASE + 0], PP[BASE + 1]), a1 = cvtpk(PP[BASE + 2], PP[BASE + 3]);   \
    unsigned b0 = cvtpk(PP[BASE + 4], PP[BASE + 5]), b1 = cvtpk(PP[BASE + 6], PP[BASE + 7]);                              \
    auto r0 = __builtin_amdgcn_permlane32_swap(a0, b0, false, false); auto r1 = __builtin_amdgcn_permlane32_swap(a1, b1, false, false); \
    u32x4 w = {r0[0], r1[0], r0[1], r1[1]}; OUT = *reinterpret_cast<bf16x8*>(&w); } while (0)
  PK4(p0, 0, pa0); PK4(p0, 8, pa1); PK4(p1, 0, pa2); PK4(p1, 8, pa3);
#undef PK4
}
DI void qkt(f32x16& p0, f32x16& p1, const bf16_t* Ks, const bf16x8* qr, int r32, int hi) {
  p0 = f32x16{}; p1 = f32x16{};
  for (int d0 = 0; d0 < 8; ++d0) { int cb = (d0 * 16 + hi * 8) * 2;
    bf16x8 b0 = *reinterpret_cast<const bf16x8*>((const char*)Ks + KSWZ(r32, cb));
    bf16x8 b1 = *reinterpret_cast<const bf16x8*>((const char*)Ks + KSWZ(32 + r32, cb));
    p0 = MFMA32(b0, qr[d0], p0);
    p1 = MFMA32(b1, qr[d0], p1); }
}
DI int v_st(int k, int c) { const int kk = (k & ~0xC) | ((k & 4) << 1) | ((k & 8) >> 1); return ((kk >> 3) * 4 + (c >> 5)) * 512 + ((kk & 7) * 32 + (c & 31)) * 2; }
DI int v_rd_base(int lane) { return ((lane & 3) << 3) | (((lane >> 2) & 3) << 6) | (((lane >> 4) & 1) << 5) | (((lane >> 5) & 1) << 8); }
constexpr int v_rd_off(int d0, int ks, int half) { return d0 * 512 + ks * 4096 + half * 2048; }
template <int OFF> DI s16x4 tr_read(int vb) {
  s16x4 r; asm volatile("ds_read_b64_tr_b16 %0, %1 offset:%2" : "=&v"(r) : "v"(vb), "i"(OFF) : "memory"); return r;
}
template <int D0> DI void pv_one(f32x16& od, int vb, bf16x8 pa0, bf16x8 pa1, bf16x8 pa2, bf16x8 pa3) {
  const s16x4 l0 = tr_read<v_rd_off(D0, 0, 0)>(vb), h0 = tr_read<v_rd_off(D0, 0, 1)>(vb), l1 = tr_read<v_rd_off(D0, 1, 0)>(vb), h1 = tr_read<v_rd_off(D0, 1, 1)>(vb);
  const s16x4 l2 = tr_read<v_rd_off(D0, 2, 0)>(vb), h2 = tr_read<v_rd_off(D0, 2, 1)>(vb), l3 = tr_read<v_rd_off(D0, 3, 0)>(vb), h3 = tr_read<v_rd_off(D0, 3, 1)>(vb);
  asm volatile("s_waitcnt lgkmcnt(0)" ::: "memory"); SBAR();
#define PK(Lx, Hx) (bf16x8){Lx[0], Lx[1], Lx[2], Lx[3], Hx[0], Hx[1], Hx[2], Hx[3]}
  od = MFMA32(pa0, PK(l0, h0), od);
  od = MFMA32(pa1, PK(l1, h1), od);
  od = MFMA32(pa2, PK(l2, h2), od);
  od = MFMA32(pa3, PK(l3, h3), od);
#undef PK
}
DI void pv_d0(f32x16* o, int vb, bf16x8 pa0, bf16x8 pa1, bf16x8 pa2, bf16x8 pa3) {
  pv_one<0>(o[0], vb, pa0, pa1, pa2, pa3); pv_one<1>(o[1], vb, pa0, pa1, pa2, pa3); pv_one<2>(o[2], vb, pa0, pa1, pa2, pa3); pv_one<3>(o[3], vb, pa0, pa1, pa2, pa3);
}
DI void attn_dense_body(const bf16_t* __restrict__ Qb, const bf16_t* __restrict__ Kh, const bf16_t* __restrict__ Vh, bf16_t* __restrict__ Ob, int seq, char* lds) {
  const int tid = TIDX(), wid = tid >> 6, lane = tid & 63, r32 = lane & 31, hi = lane >> 5;
  bf16_t* V_lds = (bf16_t*)lds; bf16_t* K_lds = (bf16_t*)(lds + 2 * SHM_V);
  float* ws = (float*)(lds + 2 * SHM_V + 2 * SHM_K) + wid * 64; float* li_l = ws; float* al_l = ws + 32;
  float m_reg = -1e30f, l_reg = 0; f32x16 o[4] = {}; bf16x8 qr[8];
  const bf16_t* Qw = Qb + (long)(wid * QBLK + r32) * LDQ + hi * 8;
#pragma unroll
  for (int d0 = 0; d0 < 8; ++d0) qr[d0] = *reinterpret_cast<const bf16x8*>(Qw + d0 * 16);
  const int sr = tid >> 4, sc = (tid & 15) * 8, vst0 = v_st(sr, sc), vst1 = v_st(32 + sr, sc);
  const int vb0 = (int)(uintptr_t)V_lds + v_rd_base(lane);
  struct { bf16x8 vs0, vs1, ks0, ks1; } sr_[2];
#define SLOAD(i, k0) do { sr_[i].vs0 = *(const bf16x8*)(&Vh[(long)((k0) + sr) * LDK + sc]); sr_[i].vs1 = *(const bf16x8*)(&Vh[(long)((k0) + 32 + sr) * LDK + sc]); \
    sr_[i].ks0 = *(const bf16x8*)(&Kh[(long)((k0) + sr) * LDK + sc]); sr_[i].ks1 = *(const bf16x8*)(&Kh[(long)((k0) + 32 + sr) * LDK + sc]); } while (0)
#define SWRITE(bq, i) do { *(bf16x8*)((char*)V_lds + (bq) * SHM_V + vst0) = sr_[i].vs0;          \
    *(bf16x8*)((char*)V_lds + (bq) * SHM_V + vst1) = sr_[i].vs1; int kc = sc * 2;               \
    *(bf16x8*)((char*)K_lds + (bq) * SHM_K + KSWZ(sr, kc)) = sr_[i].ks0;                       \
    *(bf16x8*)((char*)K_lds + (bq) * SHM_K + KSWZ(32 + sr, kc)) = sr_[i].ks1; } while (0)
#define SWAIT() asm volatile("s_waitcnt vmcnt(4)" ::: "memory")
#define RESC(a) do { if (__any((a) < 1.f)) { if (hi == 0) al_l[r32] = (a); asm volatile("s_waitcnt lgkmcnt(0)" ::: "memory"); \
    for (int d = 0; d < 4; ++d) for (int r = 0; r < 16; ++r) o[d][r] *= al_l[crow(r, hi)]; } } while (0)
  f32x16 pA0, pA1, pB0, pB1; float mnA, mnB, alA, alB; bf16x8 pa0, pa1, pa2, pa3; const int NT = seq / KVBLK;
  constexpr int SE = 0, SO = 1;
  SLOAD(SE, 0); asm volatile("s_waitcnt vmcnt(0)" ::: "memory"); SWRITE(0, SE); __syncthreads();
  qkt(pA0, pA1, K_lds, qr, r32, hi); partialSM(pA0, pA1, m_reg, mnA, alA);
  SLOAD(SO, KVBLK); if (2 < NT) SLOAD(SE, 2 * KVBLK);
  SWAIT(); SWRITE(1, SO); __syncthreads();
  for (int j = 1; j + 1 < NT; j += 2) {
    SBAR(); qkt(pB0, pB1, (bf16_t*)((char*)K_lds + SHM_K), qr, r32, hi);
    finishSM(pA0, pA1, alA, l_reg, pa0, pa1, pa2, pa3); SBAR();
    SLOAD(SO, (j + 2) * KVBLK); SBAR();
    pv_d0(o, vb0, pa0, pa1, pa2, pa3); partialSM(pB0, pB1, m_reg, mnB, alB);
    __syncthreads(); SWAIT(); SWRITE(0, SE);
    RESC(alB); __syncthreads();
    SBAR(); qkt(pA0, pA1, K_lds, qr, r32, hi);
    finishSM(pB0, pB1, alB, l_reg, pa0, pa1, pa2, pa3); SBAR();
    if (j + 3 < NT) SLOAD(SE, (j + 3) * KVBLK); SBAR();
    pv_d0(o, vb0 + (int)SHM_V, pa0, pa1, pa2, pa3); partialSM(pA0, pA1, m_reg, mnA, alA);
    __syncthreads(); SWAIT(); SWRITE(1, SO);
    RESC(alA); __syncthreads();
  }
  SBAR(); qkt(pB0, pB1, (bf16_t*)((char*)K_lds + SHM_K), qr, r32, hi);
  finishSM(pA0, pA1, alA, l_reg, pa0, pa1, pa2, pa3); SBAR();
  pv_d0(o, vb0, pa0, pa1, pa2, pa3); partialSM(pB0, pB1, m_reg, mnB, alB);
  __syncthreads(); RESC(alB);
  finishSM(pB0, pB1, alB, l_reg, pa0, pa1, pa2, pa3); SBAR();
  pv_d0(o, vb0 + (int)SHM_V, pa0, pa1, pa2, pa3);
  if (hi == 0) li_l[r32] = l_reg; asm volatile("s_waitcnt lgkmcnt(0)" ::: "memory");
  float rli[16];
#pragma unroll
  for (int r = 0; r < 16; ++r) rli[r] = __builtin_amdgcn_rcpf(li_l[crow(r, hi)]);
  bf16_t* Ow = Ob + (long)(wid * QBLK) * LDO;
#pragma unroll
  for (int r = 0; r < 16; ++r) { int orow = crow(r, hi);
    for (int d0 = 0; d0 < 4; ++d0) Ow[(long)orow * LDO + d0 * 32 + r32] = f2bf(o[d0][r] * rli[r]); }
#undef SLOAD
#undef SWRITE
#undef SWAIT
#undef RESC
}
}

__device__ __forceinline__ void ph_attn(const P& p, char* lds, bool need_ctx) {
  const bf16_t* QKV = (const bf16_t*)(p.ws + OFF_D); bf16_t* hb = (bf16_t*)(p.ws + OFF_HBF);
  const int nunits = need_ctx ? 528 : 512;
  for (int u = BIDX(); u < nunits; u += GDIM()) {
    int b, h, seq; size_t qrow;
    if (u < 512) { b = u >> 8; const int rem = u & 255; h = rem >> 5; qrow = (size_t)b * TB + CTXL + (size_t)(rem & 31) * 256; seq = TB; }
    else { const int uu = u - 512; b = uu >> 3; h = uu & 7; qrow = (size_t)b * TB; seq = CTXL; }
    const int kvh = h >> 2;
    const bf16_t* Kh = QKV + (size_t)b * TB * 1536 + 1024 + kvh * 128;
    const bf16_t* Vh = QKV + (size_t)b * TB * 1536 + 1280 + kvh * 128;
    at::attn_dense_body(QKV + qrow * 1536 + h * 128, Kh, Vh, hb + qrow * 1024 + h * 128, seq, lds);
    __syncthreads();
  }
}

__device__ __forceinline__ void ph_final(const P& p) {
  const int tid = TIDX(), wid = tid >> 6, lane = tid & 63;
  const float* xr = (const float*)(p.ws + OFF_XRES);
  for (int q = BIDX() * 8 + wid; q < 2 * LAT; q += GDIM() * 8) {
    const int b = q >> 13, t = q & (LAT - 1); const float* row = xr + ((size_t)b * TB + CTXL + t) * 1024;
    f32x4 v[4]; float ss = 0.f;
#pragma unroll
    for (int i = 0; i < 4; ++i) { v[i] = *(const f32x4*)(row + i * 256 + lane * 4); ss += v[i][0] * v[i][0] + v[i][1] * v[i][1] + v[i][2] * v[i][2] + v[i][3] * v[i][3]; }
    ss = wave_sum(ss); const float rs = rsqrtf(ss * (1.f / 1024.f) + EPSF);
#pragma unroll
    for (int i = 0; i < 4; ++i) { const int c0 = i * 256 + lane * 4; const f32x4 g = *(const f32x4*)(p.final_norm + c0); f32x4 o = v[i] * rs * g; *(f32x4*)(p.out + (size_t)q * 1024 + c0) = o; }
  }
}

constexpr int NPHASES = 42;
#ifndef ONLY_PH
#define ONLY_PH -1
#endif
#define EN(x) (ONLY_PH < 0 || ONLY_PH == (x))
#ifndef PROBE_REP
#define PROBE_REP -1
#endif
#define RUN(cls, ...) do { if (EN(cls)) { for (int rep_ = 0; rep_ < ((PROBE_REP == (cls)) ? 2 : 1); ++rep_) { if (rep_) xcd_barrier(*xbp); __VA_ARGS__; } } } while (0)
__device__ __forceinline__ void run_phase(const P& p0, int ph, char* lds, const XcdBarrier* xbp) {
  P p = p0; asm volatile("" : "+s"(p.ws));
  if (ph == 0) { RUN(0, ph_init(p, lds)); return; }
  if (ph == NPHASES - 1) { if (EN(11)) ph_final(p); return; }
  const int q = ph - 1; int L, sub;
  if (q < 11) { L = 0; sub = q; } else if (q < 20) { L = 1; sub = q - 11; } else if (q < 31) { L = 2; sub = q - 20; } else { L = 3; sub = q - 31; }
  const bool even = (L & 1) == 0; const int e = L >> 1;
  bf16_t* W1 = (bf16_t*)(p.ws + OFF_WC); bf16_t* W2 = (bf16_t*)(p.ws + OFF_WC + WC_W2);
  bf16_t* hb = (bf16_t*)(p.ws + OFF_HBF); float* xr = (float*)(p.ws + OFF_XRES);
  const float* mods = (const float*)(p.ws + OFF_MODS) + (size_t)L * 3 * 6144;
  int fs = even ? sub - 7 : sub - 5;
  if (fs >= 0) {
    if (fs == 0) { RUN(1, ph_norm(p, L, 1); cvt_weight(p.ffn_w_up + (size_t)L * 1024 * 5632, W1, 1024, 5632, 5632, false); cvt_weight(p.ffn_w_down + (size_t)L * DFF * 1024, W2, DFF, 1024, 1024, false)); }
    else if (fs == 1) { RUN(2, gemm8(lds, hb, 1024, W1, 1024, 5632, L == 3, EpiBf8{(bf16_t*)(p.ws + OFF_D), 5632})); }
    else if (fs == 2) { if (EN(8)) ph_ffnact(p, L); }
    else { if (EN(2)) gemm_phase(lds, (const bf16_t*)(p.ws + OFF_D) + DFF, 5632, W2, DFF, 8, EpiRes{xr, mods + 5 * 1024}, L == 3); }
    return;
  }
  if (even) {
    switch (sub) {
      case 0: RUN(1, ph_norm(p, L, 0); cvt_weight(p.rec_w_in + (size_t)e * 1024 * 3632, W1, 1024, 3632, NREC, true); cvt_weight(p.rec_w_out + (size_t)e * 1024 * 1024, W2, 1024, 1024, 1024, false)); break;
      case 1: RUN(2, gemm8(lds, hb, 1024, W1, 1024, NREC, false, EpiRec8{(bf16_t*)(p.ws + OFF_D + D_P1), (bf16_t*)(p.ws + OFF_D + D_P2), (float*)(p.ws + OFF_SM)})); break;
      case 2: RUN(3, ph_dnprep(p, lds, e)); break;
      case 3: RUN(4, ph_dn_d1(p, lds); ph_gla_b(p, lds, e)); break;
      case 4: RUN(5, if (BIDX() < 64) { dn_scan(p, lds, BIDX()); } else if (BIDX() < 128) { gla_scan(p, lds, BIDX() - 64, e); });
        if (PROBE_REP == 55) { xcd_barrier(*xbp); if (BIDX() < 64) { dn_scan(p, lds, BIDX()); } }
        if (PROBE_REP == 56) { xcd_barrier(*xbp); if (BIDX() >= 64 && BIDX() < 128) { gla_scan(p, lds, BIDX() - 64, e); } }
        break;
      case 5: RUN(7, ph_merge(p, e)); break;
      case 6: if (EN(2)) gemm_phase(lds, hb, 1024, W2, 1024, 8, EpiRes{xr, mods + 2 * 1024}); break;
    }
  } else {
    const int o = L >> 1;
    switch (sub) {
      case 0: RUN(1, ph_norm(p, L, 0); cvt_weight(p.att_w_qkv + (size_t)o * 1024 * 1536, W1, 1024, 1536, 1536, false); cvt_weight(p.att_w_out + (size_t)o * 1024 * 1024, W2, 1024, 1024, 1024, false)); break;
      case 1: RUN(2, gemm8(lds, hb, 1024, W1, 1024, 1536, false, EpiBf8{(bf16_t*)(p.ws + OFF_D), 1536})); break;
      case 2: if (EN(9)) ph_qknorm(p, o); break;
      case 3: RUN(10, ph_attn(p, lds, L != 3)); break;
      case 4: if (EN(2)) gemm_phase(lds, hb, 1024, W2, 1024, 8, EpiRes{xr, mods + 2 * 1024}, L == 3); break;
    }
  }
}

template <bool COOP>
__global__ void __launch_bounds__(512, 1) mk_kernel(P p, int ph0, int ph1) {
  extern __shared__ __attribute__((aligned(16))) char smem[];
  if constexpr (COOP) {
    if (ph0 < 0) cg::this_grid().sync();
    volatile LAS unsigned* st = (volatile LAS unsigned*)(smem + LDS_BYTES);
    if (threadIdx.x < 4) st[threadIdx.x] = 0u;
    __syncthreads();
    XcdBarrier xb = xcd_barrier_post((unsigned*)(p.ws + OFF_BAR), st);
    for (int ph = ph0; ph < ph1; ++ph) {
      run_phase(p, ph, smem, &xb);
      if (ph + 1 < ph1) xcd_barrier(xb);
      if (PROBE_REP == 99 && ph == 0) { for (int q = 0; q < 20; ++q) xcd_barrier(xb); }
    }
  } else {
    for (int ph = ph0; ph < ph1; ++ph) run_phase(p, ph, smem, nullptr);
  }
}

extern "C" void kernel_launch(void* const* d_in, const int* in_sizes, int n_in, void* d_out, int out_size, void* d_ws, size_t ws_size, hipStream_t stream) {
  if (n_in != 23 || ws_size < WS_NEED) { fprintf(stderr, "kernel_launch: bad n_in %d or ws %zu < %zu\n", n_in, ws_size, (size_t)WS_NEED); return; }
  P p{};
  const float** f = (const float**)&p;
  for (int i = 0; i < 23; ++i) f[i] = (const float*)d_in[i];
  p.out = (float*)d_out; p.ws = (char*)d_ws;
  static int inited = 0, grid_blocks = 0;
  if (!inited) {
    hipFuncSetAttribute((const void*)mk_kernel<true>, hipFuncAttributeMaxDynamicSharedMemorySize, LDS_BYTES + 16);
    hipFuncSetAttribute((const void*)mk_kernel<false>, hipFuncAttributeMaxDynamicSharedMemorySize, LDS_BYTES);
    int dev = 0, cus = 0, per_cu = 0;
    hipGetDevice(&dev); hipDeviceGetAttribute(&cus, hipDeviceAttributeMultiprocessorCount, dev);
    hipOccupancyMaxActiveBlocksPerMultiprocessor(&per_cu, mk_kernel<true>, 512, LDS_BYTES + 16);
    if (per_cu > 1) per_cu = 1;
    grid_blocks = cus * per_cu; if (grid_blocks > 256) grid_blocks = 256; if (grid_blocks < 128) grid_blocks = 128;
    inited = 1;
  }
#if MK_COOP
  int ph0 = 0, ph1 = NPHASES;
  void* args[] = {&p, &ph0, &ph1};
  hipMemsetAsync((char*)d_ws + OFF_BAR, 0, 3456 * 4, stream);
  hipError_t er = hipLaunchCooperativeKernel((const void*)mk_kernel<true>, dim3(grid_blocks), dim3(512), args, LDS_BYTES + 16, stream);
  if (er != hipSuccess) fprintf(stderr, "cooperative launch failed: %s (grid %d)\n", hipGetErrorString(er), grid_blocks);
#else
  for (int ph = 0; ph < NPHASES; ++ph) hipLaunchKernelGGL(mk_kernel<false>, dim3(256), dim3(512), LDS_BYTES, stream, p, ph, ph + 1);
#endif
}
```

```cpp
#include <hip/hip_runtime.h>
#include <hip/hip_cooperative_groups.h>
#include <cstdio>
#include <cstdint>
namespace cg = cooperative_groups;

#ifndef MK_COOP
#define MK_COOP 1
#endif

typedef unsigned short bf16_t;
typedef short bf16x8 __attribute__((ext_vector_type(8)));
typedef short s16x4 __attribute__((ext_vector_type(4)));
typedef float f32x16 __attribute__((ext_vector_type(16)));
typedef float f32x8 __attribute__((ext_vector_type(8)));
typedef float f32x4 __attribute__((ext_vector_type(4)));
typedef unsigned u32x4 __attribute__((ext_vector_type(4)));
#define DI __device__ __forceinline__
#define LBAR() do { asm volatile("s_waitcnt lgkmcnt(0)" ::: "memory"); __builtin_amdgcn_s_barrier(); asm volatile("" ::: "memory"); } while (0)
#define MFMA32(a, b, c) __builtin_amdgcn_mfma_f32_32x32x16_bf16((a), (b), (c), 0, 0, 0)

constexpr int DM = 1024, TB = 8448, CTXL = 256, LAT = 8192, MROWS = 2 * TB;
constexpr int NCH = 132;
constexpr int DFF = 2816;
constexpr int NREC = 3840;
constexpr float EPSF = 1e-6f;

constexpr size_t AL(size_t x) { return (x + 255) / 256 * 256; }
constexpr size_t OFF_XRES = 0;
constexpr size_t OFF_HBF = OFF_XRES + AL((size_t)MROWS * DM * 4);
constexpr size_t OFF_WC = OFF_HBF + AL((size_t)MROWS * DM * 2);
constexpr size_t WC_W2 = (size_t)5632 * 1024 * 2;
constexpr size_t OFF_MODS = OFF_WC + AL(WC_W2 + (size_t)1024 * 2816 * 2);
constexpr size_t OFF_SM = OFF_MODS + AL((size_t)4 * 3 * 6144 * 4);
constexpr size_t OFF_GB = OFF_SM + AL((size_t)MROWS * 64 * 4);
constexpr size_t OFF_SC = OFF_GB + AL((size_t)MROWS * 16 * 4);
constexpr size_t OFF_GL = OFF_SC + AL((size_t)16 * NCH * 64 * 2 * 4);
constexpr size_t OFF_D = OFF_GL + AL((size_t)16 * NCH * 4);
constexpr size_t D_P1 = 0;
constexpr size_t D_W = 0;
constexpr size_t D_INTRA = D_W + (size_t)16 * NCH * 64 * 128 * 2;
constexpr size_t D_P2 = D_P1 + (size_t)MROWS * 1536 * 2;
constexpr size_t D_QQ = D_P2 + (size_t)MROWS * 2048 * 2;
constexpr size_t D_QK = D_QQ + (size_t)MROWS * 512 * 2;
constexpr size_t D_QV = D_QK + (size_t)MROWS * 512 * 2;
constexpr size_t D_DNO = D_QK;
constexpr size_t D_KT = D_QV + (size_t)MROWS * 512 * 2;
constexpr size_t D_GLAO = D_KT + (size_t)MROWS * 512 * 2;
constexpr size_t D_END_E = D_GLAO + (size_t)2 * MROWS * 512 * 2;
constexpr size_t D_END_F = (size_t)MROWS * 5632 * 2;
constexpr size_t OFF_B16_1 = OFF_D + (D_END_E > D_END_F ? D_END_E : D_END_F);
constexpr size_t B16_BYTES = (size_t)8 * NCH * 64 * 64 * 2;
constexpr size_t OFF_BAR = OFF_B16_1 + AL(B16_BYTES);
constexpr size_t WS_NEED = OFF_BAR + 3456 * 4;
constexpr int LDS_BYTES = 132 * 1024;

struct P {
  const float *x, *c, *ctx, *c_ctx, *mod_w, *mod_b, *rec_w_in, *rec_conv, *dn_a_log, *dn_dt_bias, *dn_norm, *gla_w2, *gla_b2, *gla_norm,
      *rec_w_out, *att_w_qkv, *att_q_norm, *att_k_norm, *att_w_out, *ffn_w_up, *ffn_conv, *ffn_w_down, *final_norm;
  float* out;
  char* ws;
};

DI int TIDX() { int t = threadIdx.x; asm volatile("" : "+v"(t)); return t; }
DI int BIDX() { int t = blockIdx.x; asm volatile("" : "+s"(t)); return t; }
DI int GDIM() { int t = gridDim.x; asm volatile("" : "+s"(t)); return t; }
DI float bf2f(bf16_t v) { return __uint_as_float(((unsigned)v) << 16); }
DI bf16_t f2bf(float x) { unsigned u = __float_as_uint(x); u += 0x7fffu + ((u >> 16) & 1u); return (bf16_t)(u >> 16); }
DI unsigned cvtpk(float lo, float hi) { unsigned r; asm volatile("v_cvt_pk_bf16_f32 %0, %1, %2" : "=v"(r) : "v"(lo), "v"(hi)); return r; }
DI int crow(int r, int hi) { return (r & 3) + 8 * (r >> 2) + 4 * hi; }
DI float siluf(float x) { return x / (1.f + expf(-x)); }
DI float sigmf(float x) { return 1.f / (1.f + expf(-x)); }
DI float softplusf(float x) { return fmaxf(x, 0.f) + log1pf(expf(-fabsf(x))); }
DI float wave_sum(float v) {
#pragma unroll
  for (int o = 32; o > 0; o >>= 1) v += __shfl_xor(v, o);
  return v;
}
DI int modrow_of(int R) { const int b = R >= TB ? 1 : 0; const int pp = R - b * TB; return pp < CTXL ? 2 : b; }
template <int KS>
DI f32x16 mma_rows(const bf16_t* arow, const bf16_t* brow, f32x16 acc) {
#pragma unroll
  for (int ks = 0; ks < KS; ++ks) {
    const bf16x8 a = *reinterpret_cast<const bf16x8*>(arow + ks * 16);
    const bf16x8 b = *reinterpret_cast<const bf16x8*>(brow + ks * 16);
    acc = MFMA32(a, b, acc);
  }
  return acc;
}

#define XB_TMO      128
#define XB_XCNT(j)  (256  + 64 * (j))
#define XB_XSUB(j)  (1280 + 64 * (j))
#define XB_XGEN(j)  (2304 + 64 * (j))
#define XB_TOP      3328
#define XB_TOPGEN   3392
#define XCD_BAR_WORDS 3456
#define XB_SPIN_CAP (1u << 18)
#define LAS __attribute__((address_space(3)))
DI unsigned xb_ld(unsigned* p)              { return __hip_atomic_load(p, __ATOMIC_RELAXED, __HIP_MEMORY_SCOPE_AGENT); }
DI unsigned xb_add(unsigned* p, unsigned v) { return __hip_atomic_fetch_add(p, v, __ATOMIC_RELAXED, __HIP_MEMORY_SCOPE_AGENT); }
DI unsigned xb_xcc_id() { return (unsigned)__builtin_amdgcn_s_getreg((3 << 11) | 20) & 0xFu; }
#define XB_SPIN(cond, bar) do { unsigned _sp = 0; while (cond) { __builtin_amdgcn_s_sleep(1); \
    if ((++_sp & 255u) == 0u) { if (xb_ld(&(bar)[XB_TMO])) break; if (_sp > XB_SPIN_CAP) { atomicAdd(&(bar)[XB_TMO], 1u); break; } } } } while (0)
struct XcdBarrier { unsigned* bar; unsigned x; volatile LAS unsigned* st; };
DI XcdBarrier xcd_barrier_post(unsigned* bar, volatile LAS unsigned* st) {
    XcdBarrier b; b.bar = bar; b.x = xb_xcc_id(); b.st = st;
    if (threadIdx.x == 0) (void)xb_add(&bar[XB_XCNT(b.x)], 1u);
    return b;
}
DI void xcd_barrier_complete(unsigned* bar, unsigned x, unsigned& nloc, unsigned& nx) {
    const unsigned G = gridDim.x * gridDim.y * gridDim.z;
    unsigned sum, cnt, mine, sp = 0u;
    for (;;) {
        sum = 0u; cnt = 0u; mine = 0u;
#pragma unroll
        for (unsigned j = 0; j < 16; ++j) { const unsigned c = xb_ld(&bar[XB_XCNT(j)]); sum += c; cnt += (c > 0u) ? 1u : 0u; mine = (j == x) ? c : mine; }
        if (sum == G) break;
        __builtin_amdgcn_s_sleep(1);
        if ((++sp & 255u) == 0u) { if (xb_ld(&bar[XB_TMO])) break; if (sp > XB_SPIN_CAP) { atomicAdd(&bar[XB_TMO], 1u); break; } }
    }
    nloc = mine > 0u ? mine : 1u; nx = cnt > 0u ? cnt : 1u;
}
DI void xcd_barrier(const XcdBarrier& b) {
    asm volatile("s_waitcnt vmcnt(0)" ::: "memory");
    __syncthreads();
    if (threadIdx.x == 0) {
        unsigned* bar = b.bar;
        __builtin_amdgcn_s_waitcnt(0);
        unsigned nloc = b.st[0], nx = b.st[1];
        if (nloc == 0u) { xcd_barrier_complete(bar, b.x, nloc, nx); b.st[0] = nloc; b.st[1] = nx; }
        const unsigned old = xb_add(&bar[XB_XSUB(b.x)], 1u);
        const unsigned gen = old / nloc;
        if (old + 1u == (gen + 1u) * nloc) {
            __builtin_amdgcn_fence(__ATOMIC_RELEASE, "agent");
            asm volatile("s_waitcnt vmcnt(0)" ::: "memory");
            const unsigned og = xb_add(&bar[XB_TOP], 1u);
            const unsigned tg = og / nx;
            if (og + 1u == (tg + 1u) * nx) xb_add(&bar[XB_TOPGEN], 1u);
            else XB_SPIN(xb_ld(&bar[XB_TOPGEN]) == tg, bar);
            __builtin_amdgcn_fence(__ATOMIC_ACQUIRE, "agent");
            xb_add(&bar[XB_XGEN(b.x)], 1u);
            asm volatile("s_waitcnt vmcnt(0)" ::: "memory");
        } else {
            XB_SPIN(xb_ld(&bar[XB_XGEN(b.x)]) == gen, bar);
            __builtin_amdgcn_fence(__ATOMIC_ACQUIRE, "agent");
            asm volatile("s_waitcnt vmcnt(0)" ::: "memory");
        }
    }
    __syncthreads();
}

__device__ __forceinline__ void ph_init(const P& p, char* lds) {
  const int tid = TIDX();
  float* sc = (float*)lds;
  float* red = sc + 3072;
  for (int i = tid; i < 3072; i += 512) { const int r = i >> 10, k = i & 1023; const float v = r < 2 ? p.c[r * 1024 + k] : p.c_ctx[k]; sc[i] = siluf(v); }
  __syncthreads();
  float* mods = (float*)(p.ws + OFF_MODS);
  for (int job = BIDX(); job < 192; job += GDIM()) {
    const int col = job * 128 + (tid & 127), kq = tid >> 7;
    const int L = col / 6144, cl = col - L * 6144;
    const float* w = p.mod_w + ((size_t)L * 1024 + kq * 256) * 6144 + cl;
    float a0 = 0.f, a1 = 0.f, a2 = 0.f;
#pragma unroll 8
    for (int k = 0; k < 256; ++k) { const float wv = w[(size_t)k * 6144]; const int kk = kq * 256 + k; a0 += sc[kk] * wv; a1 += sc[1024 + kk] * wv; a2 += sc[2048 + kk] * wv; }
    red[(kq * 3 + 0) * 128 + (tid & 127)] = a0; red[(kq * 3 + 1) * 128 + (tid & 127)] = a1; red[(kq * 3 + 2) * 128 + (tid & 127)] = a2;
    __syncthreads();
    if (tid < 384) { const int r = tid >> 7, cc = tid & 127; const int c2 = job * 128 + cc; const int L2 = c2 / 6144, cl2 = c2 - L2 * 6144;
      const float s = red[(0 * 3 + r) * 128 + cc] + red[(1 * 3 + r) * 128 + cc] + red[(2 * 3 + r) * 128 + cc] + red[(3 * 3 + r) * 128 + cc] + p.mod_b[L2 * 6144 + cl2];
      mods[((size_t)L2 * 3 + r) * 6144 + cl2] = s; }
    __syncthreads();
  }
  f32x4* xr = (f32x4*)(p.ws + OFF_XRES);
  for (size_t i = (size_t)BIDX() * 512 + tid; i < (size_t)MROWS * 256; i += (size_t)GDIM() * 512) {
    const int R = (int)(i >> 8), c4 = (int)(i & 255); const int b = R >= TB ? 1 : 0, pp = R - b * TB;
    const float* src = pp < CTXL ? p.ctx + ((size_t)b * CTXL + pp) * 1024 : p.x + ((size_t)b * LAT + (pp - CTXL)) * 1024;
    xr[i] = *(const f32x4*)(src + c4 * 4);
  }
}

DI int rec_src_col(int n) { if (n < 2048) return n; if (n < 3584) return n + 16; if (n < 3600) return 2048 + (n - 3584); if (n < 3632) return n; return -1; }
__device__ __forceinline__ void cvt_weight(const float* __restrict__ W, bf16_t* __restrict__ Wt, int K, int Nsrc, int Npad, bool perm) {
  const size_t items = (size_t)Npad * (K >> 3);
  for (size_t it = (size_t)BIDX() * 512 + TIDX(); it < items; it += (size_t)GDIM() * 512) {
    const int n = (int)(it % Npad), kb = (int)(it / Npad);
    const int s = perm ? rec_src_col(n) : n;
    float v[8];
#pragma unroll
    for (int j = 0; j < 8; ++j) v[j] = s >= 0 ? W[(size_t)(kb * 8 + j) * Nsrc + s] : 0.f;
    u32x4 w = {cvtpk(v[0], v[1]), cvtpk(v[2], v[3]), cvtpk(v[4], v[5]), cvtpk(v[6], v[7])};
    *(u32x4*)(Wt + (size_t)n * K + kb * 8) = w;
  }
}

__device__ __forceinline__ void ph_norm(const P& p, int L, int which) {
  const int tid = TIDX(), wid = tid >> 6, lane = tid & 63;
  const float* xr = (const float*)(p.ws + OFF_XRES);
  bf16_t* hb = (bf16_t*)(p.ws + OFF_HBF);
  const float* mods = (const float*)(p.ws + OFF_MODS) + (size_t)L * 3 * 6144;
  for (int R = BIDX() * 8 + wid; R < MROWS; R += GDIM() * 8) {
    const float* row = xr + (size_t)R * 1024;
    f32x4 v[4]; float ss = 0.f;
#pragma unroll
    for (int i = 0; i < 4; ++i) { v[i] = *(const f32x4*)(row + i * 256 + lane * 4); ss += v[i][0] * v[i][0] + v[i][1] * v[i][1] + v[i][2] * v[i][2] + v[i][3] * v[i][3]; }
    ss = wave_sum(ss);
    const float rs = rsqrtf(ss * (1.f / 1024.f) + EPSF);
    const float* mr = mods + (size_t)modrow_of(R) * 6144 + which * 3072;
#pragma unroll
    for (int i = 0; i < 4; ++i) { const int c0 = i * 256 + lane * 4; const f32x4 sh = *(const f32x4*)(mr + c0), scl = *(const f32x4*)(mr + 1024 + c0);
      float o[4];
#pragma unroll
      for (int j = 0; j < 4; ++j) o[j] = v[i][j] * rs * (1.f + scl[j]) + sh[j];
      uint2 w; w.x = cvtpk(o[0], o[1]); w.y = cvtpk(o[2], o[3]);
      *(uint2*)(hb + (size_t)R * 1024 + c0) = w; }
  }
}

struct EpiRec { bf16_t* P1; bf16_t* P2; float* SM;
  DI void operator()(int row, int col, float v) const {
    if (col < 1536) P1[(size_t)row * 1536 + col] = f2bf(v);
    else if (col < 3584) P2[(size_t)row * 2048 + (col - 1536)] = f2bf(v);
    else { const int lc = col - 3584; if (lc < 48) SM[(size_t)row * 64 + lc] = v; } } };
struct EpiBf { bf16_t* O; int ldc;
  DI void operator()(int row, int col, float v) const { O[(size_t)row * ldc + col] = f2bf(v); } };
struct EpiRes { float* X; const float* gate;
  DI void operator()(int row, int col, float v) const { float* q = X + (size_t)row * 1024 + col; *q = *q + gate[(size_t)modrow_of(row) * 6144 + col] * v; } };

template <class Epi>
__device__ __forceinline__ void gemm_phase(char* lds, const bf16_t* __restrict__ A, int lda, const bf16_t* __restrict__ Bt, int K, int nN, const Epi epi, bool skipctx = false) {
  const int tid = TIDX(), wid = tid >> 6, lane = tid & 63, r32 = lane & 31, hi = lane >> 5;
  const int wm = wid >> 1, wn = wid & 1;
  const int nk = K >> 6;
  constexpr int RS = 144, ASZ = 256 * RS, BSZ = 128 * RS, STG = ASZ + BSZ;
  const int ntiles = (skipctx ? 64 : MROWS / 256) * nN;
  const int srow = tid >> 3, spc = tid & 7;
  for (int t = BIDX(); t < ntiles; t += GDIM()) {
    int pm = t / nN; const int pn = t - pm * nN; if (skipctx) pm = pm + 1 + (pm >= 32 ? 1 : 0);
    const bf16_t* Ab = A + (size_t)(pm * 256 + srow) * lda + spc * 8;
    const bf16_t* Bb = Bt + (size_t)(pn * 128 + srow) * K + spc * 8;
    f32x16 acc00 = {}, acc01 = {}, acc10 = {}, acc11 = {};
    bf16x8 ra0, ra1, ra2, ra3, rb0, rb1;
#define GLOAD(kt) do { const int ko = (kt) * 64; ra0 = *(const bf16x8*)(Ab + ko); ra1 = *(const bf16x8*)(Ab + (size_t)64 * lda + ko); ra2 = *(const bf16x8*)(Ab + (size_t)128 * lda + ko); \
    ra3 = *(const bf16x8*)(Ab + (size_t)192 * lda + ko); rb0 = *(const bf16x8*)(Bb + ko); rb1 = *(const bf16x8*)(Bb + (size_t)64 * K + ko); } while (0)
#define SWRITE(buf) do { char* sb = lds + (buf) * STG + srow * RS + spc * 16; *(bf16x8*)(sb) = ra0; *(bf16x8*)(sb + 64 * RS) = ra1; *(bf16x8*)(sb + 128 * RS) = ra2; *(bf16x8*)(sb + 192 * RS) = ra3; \
    *(bf16x8*)(sb + ASZ) = rb0; *(bf16x8*)(sb + ASZ + 64 * RS) = rb1; } while (0)
    GLOAD(0); SWRITE(0); __syncthreads();
    for (int kt = 0; kt < nk; ++kt) {
      const int cur = kt & 1;
      if (kt + 1 < nk) GLOAD(kt + 1);
      const char* ab = lds + cur * STG + (64 * wm + r32) * RS + hi * 16;
      const char* bb = lds + cur * STG + ASZ + (64 * wn + r32) * RS + hi * 16;
#pragma unroll
      for (int ks = 0; ks < 4; ++ks) {
        const bf16x8 a0 = *(const bf16x8*)(ab + ks * 32), a1 = *(const bf16x8*)(ab + 32 * RS + ks * 32);
        const bf16x8 b0 = *(const bf16x8*)(bb + ks * 32), b1 = *(const bf16x8*)(bb + 32 * RS + ks * 32);
        acc00 = MFMA32(a0, b0, acc00); acc01 = MFMA32(a0, b1, acc01); acc10 = MFMA32(a1, b0, acc10); acc11 = MFMA32(a1, b1, acc11);
      }
      if (kt + 1 < nk) SWRITE(cur ^ 1);
      __syncthreads();
    }
#undef GLOAD
#undef SWRITE
    const int row0 = pm * 256 + 64 * wm, col0 = pn * 128 + 64 * wn + r32;
#pragma unroll
    for (int r = 0; r < 16; ++r) { const int rr = row0 + crow(r, hi);
      epi(rr, col0, acc00[r]); epi(rr, col0 + 32, acc01[r]); epi(rr + 32, col0, acc10[r]); epi(rr + 32, col0 + 32, acc11[r]); }
  }
}

namespace pg8 {
#define PG8_LAS __attribute__((address_space(3)))
constexpr int BM = 256, BK = 64, HALF = 128, HTB = HALF * BK * 2  , STAGE_BYTES = 8 * HTB, NXCD = 8, WGM = 8;

__host__ __device__ __forceinline__ int lds_byte(int r, int c) { const int st = (r >> 4) * 2 + (c >> 5), rr = r & 15, cc = c & 31, ob = rr * 64 + cc * 2; return st * 1024 + (ob ^ (((ob >> 9) & 1) << 5)); }
__host__ __device__ __forceinline__ void stage_rc(int b, int& R, int& C) { const int st = b / 1024, sb = b % 1024, swz = sb ^ (((sb >> 9) & 1) << 5); R = (st >> 1) * 16 + swz / 64; C = (st & 1) * 32 + (swz % 64) / 2; }
__host__ __device__ __forceinline__ int perm32(int rho) { const int n = rho >> 4, i = rho & 15; return 8 * (i >> 2) + 4 * n + (i & 3); }
struct Unit { int pm, pn; };
struct Gemm { const bf16_t* A; const bf16_t* Bt; int M, N, K, lda; };

struct StaticOrder {
    int nM, nN, nwg, G, c;
    __host__ __device__ void init(int M, int N, int G_, int c_) { nM = M / BM; nN = N / BM; nwg = nM * nN; G = G_; c = c_; }
    __host__ __device__ bool next(int i, Unit& u) const {
        const long L = (long)i * G + c; if (L >= nwg) return false;
        int wgid = (int)L; { const int q = nwg / NXCD, r = nwg % NXCD, xcd = wgid % NXCD, off = wgid / NXCD; wgid = (xcd < r ? xcd * (q + 1) : r * (q + 1) + (xcd - r) * q) + off; }
        const int nig = WGM * nN, gid = wgid / nig, fm = gid * WGM, gsz = (nM - fm) < WGM ? (nM - fm) : WGM;
        u.pm = fm + ((wgid % nig) % gsz); u.pn = (wgid % nig) / gsz; return true;
    }
    __device__ __forceinline__ void a_ready(const Unit&) const {}
    __device__ __forceinline__ void done(const Unit&) const {}
};
template <class Epi, class Sched, bool ALIGN_EPI = false, bool SP2 = false>
__device__ __forceinline__ void gemm_phase(PG8_LAS unsigned char* lds, const Gemm g, const Sched& S, const Epi& E) {
    const int tid = TIDX(), wid = __builtin_amdgcn_readfirstlane(tid >> 6), lane = tid & 63, wr = wid >> 2, wc = wid & 3, fr = lane & 15, fq = lane >> 4;
    const int K = g.K, nt = K / BK;
    unsigned voffA[2], voffB[2];
#pragma unroll
    for (int i = 0; i < 2; ++i) { int R, C; stage_rc(tid * 16 + i * 8192, R, C); const int Rb = Epi::PERM ? ((R & ~31) + perm32(R & 31)) : R;
        voffA[i] = (unsigned)(R * g.lda + C) * 2u; voffB[i] = (unsigned)(Rb * K + C) * 2u; }
    const size_t kstep = (size_t)(BK * 2);
    const size_t hstep = (size_t)HALF * K * 2;
    const size_t tstep = 2 * hstep; const size_t hstepA = (size_t)HALF * g.lda * 2, tstepA = 2 * hstepA;
    const unsigned ldsw = (unsigned)wid * 1024u;
    const int aoff = lds_byte(wr * 64 + fr, fq * 8), boff = lds_byte(wc * 32 + fr, fq * 8);
#define PG8_SA(b, h) (((b) * 2 + (h)) * HTB)
#define PG8_SB(b, h) ((4 + (b) * 2 + (h)) * HTB)
#define PG8_STAGE(bufoff, gbase, voff) do { _Pragma("unroll") for (int _i = 0; _i < 2; ++_i) \
        __builtin_amdgcn_global_load_lds((const unsigned*)((const char*)(gbase) + (voff)[_i]), (PG8_LAS unsigned*)(lds + (bufoff) + ldsw + _i * 8192), 16, 0, 0); } while (0)
#define PG8_LDA(dst, b, h) do { _Pragma("unroll") for (int m = 0; m < 4; ++m) _Pragma("unroll") for (int k = 0; k < 2; ++k) dst[m][k] = *(const PG8_LAS bf16x8*)(lds + PG8_SA(b, h) + aoff + m * 2048 + k * 1024); } while (0)
#define PG8_LDB(dst, b, h) do { _Pragma("unroll") for (int n = 0; n < 2; ++n) _Pragma("unroll") for (int k = 0; k < 2; ++k) dst[n][k] = *(const PG8_LAS bf16x8*)(lds + PG8_SB(b, h) + boff + n * 2048 + k * 1024); } while (0)
#define PG8_MMA(ai, bj, At, Bt) do { __builtin_amdgcn_s_setprio(1); _Pragma("unroll") for (int m = 0; m < 4; ++m) _Pragma("unroll") for (int n = 0; n < 2; ++n) _Pragma("unroll") for (int k = 0; k < 2; ++k) \
        acc[ai][bj][m][n] = __builtin_amdgcn_mfma_f32_16x16x32_bf16(Bt[n][k], At[m][k], acc[ai][bj][m][n], 0, 0, 0); __builtin_amdgcn_s_setprio(0); } while (0)
#define PG8_WAIT_V(n) asm volatile("s_waitcnt vmcnt(" #n ")" ::: "memory")
#define PG8_WAIT_L(n) asm volatile("s_waitcnt lgkmcnt(" #n ")" ::: "memory")
#define PG8_BAR __builtin_amdgcn_s_barrier()
#define PG8_SCHED __builtin_amdgcn_sched_barrier(0)
    Unit cur, nxt; int ui = 0;
    if (!S.next(0, cur)) return;
    f32x4 acc[2][2][4][2];
#pragma unroll
    for (int a = 0; a < 2; ++a)
#pragma unroll
        for (int b = 0; b < 2; ++b)
#pragma unroll
            for (int m = 0; m < 4; ++m)
#pragma unroll
                for (int n = 0; n < 2; ++n) acc[a][b][m][n] = (f32x4){0.f, 0.f, 0.f, 0.f};
    bf16x8 At[4][2], B0[2][2], B1[2][2];
    const char* cA = (const char*)g.A + (size_t)cur.pm * tstepA; const char* cB = (const char*)g.Bt + (size_t)cur.pn * tstep;
    S.a_ready(cur);
    if constexpr (SP2) {
        PG8_STAGE(PG8_SB(0, 0), cB, voffB); PG8_STAGE(PG8_SB(0, 1), cB + hstep, voffB); PG8_STAGE(PG8_SA(0, 0), cA, voffA); PG8_STAGE(PG8_SA(0, 1), cA + hstepA, voffA);
        if (wr == 1) PG8_BAR;
        PG8_WAIT_V(2); PG8_BAR;
        PG8_STAGE(PG8_SB(1, 0), cB + kstep, voffB); PG8_STAGE(PG8_SA(1, 0), cA + kstep, voffA); PG8_STAGE(PG8_SB(1, 1), cB + hstep + kstep, voffB);
        PG8_WAIT_V(6); PG8_BAR;
    } else {
        PG8_STAGE(PG8_SB(0, 0), cB, voffB); PG8_STAGE(PG8_SA(0, 0), cA, voffA); PG8_STAGE(PG8_SB(0, 1), cB + hstep, voffB); PG8_STAGE(PG8_SA(0, 1), cA + hstepA, voffA);
        if (wr == 1) PG8_BAR;
        PG8_WAIT_V(4); PG8_BAR;
        PG8_STAGE(PG8_SB(1, 0), cB + kstep, voffB); PG8_STAGE(PG8_SA(1, 0), cA + kstep, voffA); PG8_STAGE(PG8_SB(1, 1), cB + hstep + kstep, voffB);
        PG8_WAIT_V(6); PG8_BAR;
    }
    for (;;) {
        const bool has_next = S.next(ui + 1, nxt);
        const char* nA = has_next ? (const char*)g.A + (size_t)nxt.pm * tstepA : cA; const char* nB = has_next ? (const char*)g.Bt + (size_t)nxt.pn * tstep : cB;
        for (int t = 0; t < nt; t += 2) {
            const bool last = (t == nt - 2);
            const char* a1 = cA + (size_t)(t + 1) * kstep;
            const char* a2 = last ? nA : cA + (size_t)(t + 2) * kstep; const char* b2 = last ? nB : cB + (size_t)(t + 2) * kstep;
            const char* a3 = a2 + kstep; const char* b3 = b2 + kstep;
            if (last && has_next) S.a_ready(nxt);
            if constexpr (SP2) {
            PG8_LDB(B0, 0, 0); PG8_LDB(B1, 0, 1); PG8_SCHED; PG8_LDA(At, 0, 0); PG8_STAGE(PG8_SA(1, 1), a1 + hstepA, voffA);
            PG8_WAIT_V(8); PG8_WAIT_L(0); PG8_BAR; PG8_MMA(0, 0, At, B0); PG8_MMA(0, 1, At, B1); PG8_BAR; PG8_SCHED;
            PG8_LDA(At, 0, 1); PG8_STAGE(PG8_SB(0, 0), b2, voffB); PG8_STAGE(PG8_SB(0, 1), b2 + hstep, voffB); PG8_STAGE(PG8_SA(0, 0), a2, voffA);
            PG8_WAIT_V(8); PG8_WAIT_L(0); PG8_BAR; PG8_MMA(1, 0, At, B0); PG8_MMA(1, 1, At, B1); PG8_BAR; PG8_SCHED;
            PG8_LDB(B0, 1, 0); PG8_LDB(B1, 1, 1); PG8_SCHED; PG8_LDA(At, 1, 0); PG8_STAGE(PG8_SA(0, 1), a2 + hstepA, voffA);
            PG8_WAIT_V(8); PG8_WAIT_L(0); PG8_BAR; PG8_MMA(0, 0, At, B0); PG8_MMA(0, 1, At, B1); PG8_BAR; PG8_SCHED;
            PG8_LDA(At, 1, 1); PG8_STAGE(PG8_SB(1, 0), b3, voffB); PG8_STAGE(PG8_SB(1, 1), b3 + hstep, voffB); PG8_STAGE(PG8_SA(1, 0), a3, voffA);
            PG8_WAIT_V(8); PG8_WAIT_L(0); PG8_BAR; PG8_MMA(1, 0, At, B0); PG8_MMA(1, 1, At, B1); PG8_BAR; PG8_SCHED;
            } else {
            PG8_LDB(B0, 0, 0); PG8_SCHED; PG8_LDA(At, 0, 0); PG8_STAGE(PG8_SA(1, 1), a1 + hstepA, voffA);
            PG8_WAIT_L(8); PG8_BAR; PG8_WAIT_L(0); PG8_MMA(0, 0, At, B0); PG8_BAR; PG8_SCHED;
            PG8_LDB(B1, 0, 1); PG8_STAGE(PG8_SB(0, 0), b2, voffB);
            PG8_BAR; PG8_WAIT_L(0); PG8_MMA(0, 1, At, B1); PG8_BAR;
            PG8_LDA(At, 0, 1); PG8_STAGE(PG8_SA(0, 0), a2, voffA);
            PG8_BAR; PG8_WAIT_L(0); PG8_MMA(1, 0, At, B0); PG8_BAR; PG8_SCHED;
            PG8_STAGE(PG8_SB(0, 1), b2 + hstep, voffB);
            PG8_WAIT_V(6); PG8_BAR; PG8_MMA(1, 1, At, B1); PG8_BAR;
            PG8_LDB(B0, 1, 0); PG8_SCHED; PG8_LDA(At, 1, 0); PG8_STAGE(PG8_SA(0, 1), a2 + hstepA, voffA);
            PG8_WAIT_L(8); PG8_BAR; PG8_WAIT_L(0); PG8_MMA(0, 0, At, B0); PG8_BAR; PG8_SCHED;
            PG8_LDB(B1, 1, 1); PG8_STAGE(PG8_SB(1, 0), b3, voffB);
            PG8_BAR; PG8_WAIT_L(0); PG8_MMA(0, 1, At, B1); PG8_BAR;
            PG8_LDA(At, 1, 1); PG8_STAGE(PG8_SA(1, 0), a3, voffA);
            PG8_BAR; PG8_WAIT_L(0); PG8_MMA(1, 0, At, B0); PG8_BAR; PG8_SCHED;
            PG8_STAGE(PG8_SB(1, 1), b3 + hstep, voffB);
            PG8_WAIT_V(6); PG8_BAR; PG8_MMA(1, 1, At, B1); PG8_BAR;
            }
        }
        if constexpr (ALIGN_EPI) { if (wr == 0) PG8_BAR; }
        if constexpr (!Epi::AFTER_DRAIN) { E(acc, cur, wr, wc, fr, fq); S.done(cur); }
        if (!has_next) break;
#pragma unroll
        for (int a = 0; a < 2; ++a)
#pragma unroll
            for (int b = 0; b < 2; ++b)
#pragma unroll
                for (int m = 0; m < 4; ++m)
#pragma unroll
                    for (int n = 0; n < 2; ++n) acc[a][b][m][n] = (f32x4){0.f, 0.f, 0.f, 0.f};
        cur = nxt; cA = nA; cB = nB; ++ui;
        if constexpr (ALIGN_EPI) { if (wr == 1) PG8_BAR; }
    }
    PG8_WAIT_V(0);
    if constexpr (!ALIGN_EPI) { if (wr == 0) PG8_BAR; }
    PG8_BAR;
    if constexpr (Epi::AFTER_DRAIN) { E.fused(acc, cur, wr, wc, fr, fq, lds, wid, lane); S.done(cur); }
#undef PG8_SA
#undef PG8_SB
#undef PG8_STAGE
#undef PG8_LDA
#undef PG8_LDB
#undef PG8_MMA
#undef PG8_WAIT_V
#undef PG8_WAIT_L
#undef PG8_BAR
#undef PG8_SCHED
}
struct SchedX { StaticOrder so; bool skip;
  __device__ __forceinline__ bool next(int i, Unit& u) const { if (!so.next(i, u)) return false; if (skip) u.pm = u.pm + 1 + (u.pm >= 32 ? 1 : 0); return true; }
  __device__ __forceinline__ void a_ready(const Unit&) const {}
  __device__ __forceinline__ void done(const Unit&) const {} };
}
struct EpiRec8 { static constexpr bool PERM = false, AFTER_DRAIN = false; bf16_t* P1; bf16_t* P2; float* SM;
  DI void operator()(const f32x4 (&acc)[2][2][4][2], const pg8::Unit& u, int wr, int wc, int fr, int fq) const {
#pragma unroll
    for (int ai = 0; ai < 2; ++ai)
#pragma unroll
      for (int m = 0; m < 4; ++m) { const size_t row = (size_t)u.pm * 256 + ai * 128 + wr * 64 + m * 16 + fr;
#pragma unroll
        for (int bj = 0; bj < 2; ++bj)
#pragma unroll
          for (int n = 0; n < 2; ++n) { const int col = u.pn * 256 + bj * 128 + wc * 32 + n * 16 + fq * 4; const f32x4 v = acc[ai][bj][m][n];
            if (u.pn < 6) { uint2 w; w.x = cvtpk(v[0], v[1]); w.y = cvtpk(v[2], v[3]); *(uint2*)(P1 + row * 1536 + col) = w; }
            else if (u.pn < 14) { uint2 w; w.x = cvtpk(v[0], v[1]); w.y = cvtpk(v[2], v[3]); *(uint2*)(P2 + row * 2048 + (col - 1536)) = w; }
            else { const int lc = col - 3584; if (lc < 48) *(f32x4*)(SM + row * 64 + lc) = v; } } } } };
struct EpiBf8 { static constexpr bool PERM = false, AFTER_DRAIN = false; bf16_t* O; int ldc;
  DI void operator()(const f32x4 (&acc)[2][2][4][2], const pg8::Unit& u, int wr, int wc, int fr, int fq) const {
#pragma unroll
    for (int ai = 0; ai < 2; ++ai)
#pragma unroll
      for (int m = 0; m < 4; ++m) { const size_t row = (size_t)u.pm * 256 + ai * 128 + wr * 64 + m * 16 + fr;
#pragma unroll
        for (int bj = 0; bj < 2; ++bj)
#pragma unroll
          for (int n = 0; n < 2; ++n) { const int col = u.pn * 256 + bj * 128 + wc * 32 + n * 16 + fq * 4; const f32x4 v = acc[ai][bj][m][n];
            uint2 w; w.x = cvtpk(v[0], v[1]); w.y = cvtpk(v[2], v[3]); *(uint2*)(O + row * ldc + col) = w; } } } };
struct EpiRes8 { static constexpr bool PERM = false, AFTER_DRAIN = false; float* X; const float* gate;
  DI void operator()(const f32x4 (&acc)[2][2][4][2], const pg8::Unit& u, int wr, int wc, int fr, int fq) const {
    const float* gr = gate + (size_t)modrow_of(u.pm * 256) * 6144;
#pragma unroll
    for (int bj = 0; bj < 2; ++bj)
#pragma unroll
      for (int n = 0; n < 2; ++n) { const int col = u.pn * 256 + bj * 128 + wc * 32 + n * 16 + fq * 4; const f32x4 gv = *(const f32x4*)(gr + col);
#pragma unroll
        for (int ai = 0; ai < 2; ++ai)
#pragma unroll
          for (int m = 0; m < 4; ++m) { const size_t row = (size_t)u.pm * 256 + ai * 128 + wr * 64 + m * 16 + fr;
            f32x4* q = (f32x4*)(X + row * 1024 + col); *q = *q + gv * acc[ai][bj][m][n]; } } } };
template <class Epi>
__device__ __forceinline__ void gemm8(char* lds, const bf16_t* A, int lda, const bf16_t* Bt, int K, int N, bool skipctx, const Epi& E) {
  pg8::Gemm g{A, Bt, skipctx ? 16384 : MROWS, N, K, lda};
  pg8::SchedX S; S.so.init(g.M, N, GDIM(), BIDX()); S.skip = skipctx;
  pg8::gemm_phase<Epi, pg8::SchedX, true, true>((PG8_LAS unsigned char*)lds, g, S, E);
}

__device__ __forceinline__ void ph_dnprep(const P& p, char* lds, int e) {
  const int tid = TIDX(), wid = tid >> 6, lane = tid & 63;
  const bf16_t* P1 = (const bf16_t*)(p.ws + OFF_D + D_P1);
  bf16_t* QQ = (bf16_t*)(p.ws + OFF_D + D_QQ); bf16_t* QK = (bf16_t*)(p.ws + OFF_D + D_QK); bf16_t* QV = (bf16_t*)(p.ws + OFF_D + D_QV);
  bf16_t* KT = (bf16_t*)(p.ws + OFF_D + D_KT);
  const float* SM = (const float*)(p.ws + OFF_SM); float* GB = (float*)(p.ws + OFF_GB);
  const float* cw = p.rec_conv + (size_t)e * 3 * 1536;
  bf16_t* kl = (bf16_t*)lds;
  for (int job = BIDX(); job < MROWS / 64; job += GDIM()) {
    const int R0 = job * 64;
    for (int tt = 0; tt < 8; ++tt) {
      const int tl = wid * 8 + tt, R = R0 + tl; const int b = R >= TB ? 1 : 0, pp = R - b * TB;
      const bool hasp = !(pp == 0 || pp == CTXL), hasn = !(pp == CTXL - 1 || pp == TB - 1);
#pragma unroll
      for (int part = 0; part < 3; ++part) {
        const int ch = part * 512 + lane * 8;
        const bf16x8 zc = *(const bf16x8*)(P1 + (size_t)R * 1536 + ch);
        bf16x8 zp = {}, zn = {};
        if (hasp) zp = *(const bf16x8*)(P1 + (size_t)(R - 1) * 1536 + ch);
        if (hasn) zn = *(const bf16x8*)(P1 + (size_t)(R + 1) * 1536 + ch);
        float o[8]; float ss = 0.f;
#pragma unroll
        for (int j = 0; j < 8; ++j) { const float a = bf2f((bf16_t)zp[j]) * cw[ch + j] + bf2f((bf16_t)zc[j]) * cw[1536 + ch + j] + bf2f((bf16_t)zn[j]) * cw[3072 + ch + j];
          o[j] = siluf(a); ss += o[j] * o[j]; }
        if (part < 2) {
          ss += __shfl_xor(ss, 1); ss += __shfl_xor(ss, 2); ss += __shfl_xor(ss, 4); ss += __shfl_xor(ss, 8);
          float sc = rsqrtf(ss + EPSF); if (part == 0) sc *= 0.08838834764831845f;
#pragma unroll
          for (int j = 0; j < 8; ++j) o[j] *= sc;
        }
        u32x4 w = {cvtpk(o[0], o[1]), cvtpk(o[2], o[3]), cvtpk(o[4], o[5]), cvtpk(o[6], o[7])};
        bf16_t* dst = part == 0 ? QQ : (part == 1 ? QK : QV);
        *(u32x4*)(dst + (size_t)R * 512 + lane * 8) = w;
        if (part == 1) *(u32x4*)(kl + tl * 512 + lane * 8) = w;
      }
      if (lane < 16) {
        const int q = lane & 7;
        if (lane < 8) { const float da = SM[(size_t)R * 64 + q]; GB[(size_t)R * 16 + q] = -expf(p.dn_a_log[e * 8 + q]) * softplusf(da + p.dn_dt_bias[e * 8 + q]); }
        else { const float db = SM[(size_t)R * 64 + 8 + q]; GB[(size_t)R * 16 + 8 + q] = sigmf(db); }
      }
    }
    __syncthreads();
    {
      const int b = R0 >= TB ? 1 : 0, c = (R0 - b * TB) / 64; const int h = tid >> 7, dk = tid & 127;
      bf16_t* dst = KT + ((((size_t)b * 4 + h) * NCH + c) * 128 + dk) * 64;
#pragma unroll
      for (int g8 = 0; g8 < 8; ++g8) { unsigned w[4];
#pragma unroll
        for (int j = 0; j < 4; ++j) { const unsigned lo = kl[(g8 * 8 + 2 * j) * 512 + tid], hi2 = kl[(g8 * 8 + 2 * j + 1) * 512 + tid]; w[j] = lo | (hi2 << 16); }
        *(u32x4*)(dst + g8 * 8) = (u32x4){w[0], w[1], w[2], w[3]}; }
    }
    __syncthreads();
  }
}

__device__ __forceinline__ void ph_dn_d1(const P& p, char* lds) {
  const int tid = TIDX(), wid = tid >> 6, lane = tid & 63, r32 = lane & 31, hi = lane >> 5;
  const bf16_t* QQ = (const bf16_t*)(p.ws + OFF_D + D_QQ); const bf16_t* QK = (const bf16_t*)(p.ws + OFF_D + D_QK); const bf16_t* QV = (const bf16_t*)(p.ws + OFF_D + D_QV);
  const float* GB = (const float*)(p.ws + OFF_GB);
  bf16_t* W_ = (bf16_t*)(p.ws + OFF_D + D_W); bf16_t* U_ = (bf16_t*)(p.ws + OFF_HBF); bf16_t* INTRA = (bf16_t*)(p.ws + OFF_D + D_INTRA);
  float* SC = (float*)(p.ws + OFF_SC); float* GLS = (float*)(p.ws + OFF_GL);
  float* KK = (float*)lds; float* QKm = KK + 64 * 65; float* Ad = QKm + 64 * 65; float* Gs = Ad + 2 * 4096; float* Bs = Gs + 128;
  for (int job = BIDX(); job < 8 * NCH; job += GDIM()) {
    const int b = job / (4 * NCH), h = (job / NCH) & 3, c = job % NCH;
    const size_t Rb = (size_t)b * TB + (size_t)c * 64;
    {
      const int w4 = wid & 3, mi = w4 & 1, ni = w4 >> 1;
      const bf16_t* As = wid < 4 ? QK : QQ;
      const bf16_t* arow = As + (Rb + 32 * mi + r32) * 512 + h * 128 + hi * 8;
      const bf16_t* brow = QK + (Rb + 32 * ni + r32) * 512 + h * 128 + hi * 8;
      f32x16 acc = {}; acc = mma_rows<8>(arow, brow, acc);
      float* dst = wid < 4 ? KK : QKm;
#pragma unroll
      for (int r = 0; r < 16; ++r) dst[(32 * mi + crow(r, hi)) * 65 + 32 * ni + r32] = acc[r];
    }
    if (tid < 128) { const int d = tid >> 6, ip = tid & 63, t = d ? 63 - ip : ip; Gs[tid] = GB[(Rb + t) * 16 + d * 4 + h]; Bs[tid] = GB[(Rb + t) * 16 + 8 + d * 4 + h]; }
    __syncthreads();
    if (tid == 0 || tid == 64) { float s = 0.f; for (int i = 0; i < 64; ++i) { s += Gs[tid + i]; Gs[tid + i] = s; } }
    __syncthreads();
    const int n0 = c, n1 = c < 4 ? 3 - c : 135 - c;
    const size_t cj0 = ((size_t)(0 * 2 + b) * 4 + h) * NCH + n0, cj1 = ((size_t)(1 * 2 + b) * 4 + h) * NCH + n1;
    for (int e2 = tid; e2 < 8192; e2 += 512) {
      const int d = e2 >> 12, ip = (e2 >> 6) & 63, jp = e2 & 63; const int i = d ? 63 - ip : ip, j = d ? 63 - jp : jp;
      const float dec = jp <= ip ? expf(Gs[d * 64 + ip] - Gs[d * 64 + jp]) : 0.f;
      Ad[d * 4096 + ip * 64 + jp] = jp < ip ? Bs[d * 64 + ip] * KK[i * 65 + j] * dec : 0.f;
      const size_t cj = d ? cj1 : cj0;
      INTRA[(cj * 64 + ip) * 64 + jp] = f2bf(QKm[i * 65 + j] * dec);
    }
    if (tid < 128) { const int d = tid >> 6, ip = tid & 63; const size_t cj = d ? cj1 : cj0; const float gi = Gs[tid], gl = Gs[d * 64 + 63];
      SC[(cj * 64 + ip) * 2] = expf(gi); SC[(cj * 64 + ip) * 2 + 1] = expf(gl - gi); if (ip == 0) GLS[cj] = expf(gl); }
    __syncthreads();
    {
      const int d = tid >> 8, cc = tid & 255; const size_t cj = d ? cj1 : cj0;
      int dofs = d * 64, aofs = d * 4096; asm volatile("" : "+v"(dofs), "+v"(aofs));
      float x[64];
      {
        const bf16_t* srcb = (cc < 128 ? QV + h * 128 + cc : QK + h * 128 + (cc - 128)) + (Rb + (d ? 63 : 0)) * 512;
        const long step = d ? -512 : 512;
#pragma unroll
        for (int g = 0; g < 8; ++g) {
#pragma unroll
          for (int q8 = 0; q8 < 8; ++q8) { const int ip = g * 8 + q8; x[ip] = bf2f(srcb[ip * step]); }
          asm volatile("" ::: "memory");
        }
        if (cc < 128) {
#pragma unroll
          for (int ip = 0; ip < 64; ++ip) x[ip] *= Bs[dofs + ip];
        } else {
#pragma unroll
          for (int ip = 0; ip < 64; ++ip) x[ip] *= Bs[dofs + ip] * expf(Gs[dofs + ip]);
        }
      }
      const float* Arow = Ad + aofs;
#pragma unroll
      for (int ip = 1; ip < 64; ++ip) {
        float s = 0.f;
#pragma unroll
        for (int j4 = 0; j4 < (ip + 3) / 4; ++j4) { const f32x4 a = *(const f32x4*)(Arow + ip * 64 + 4 * j4);
          s += a[0] * x[4 * j4] + a[1] * x[4 * j4 + 1] + a[2] * x[4 * j4 + 2] + a[3] * x[4 * j4 + 3]; }
        x[ip] -= s;
      }
      bf16_t* dst = cc < 128 ? U_ + cj * 64 * 128 + cc : W_ + cj * 64 * 128 + (cc - 128);
#pragma unroll
      for (int ip = 0; ip < 64; ++ip) dst[ip * 128] = f2bf(x[ip]);
    }
    __syncthreads();
  }
}

typedef _Float16 h16x8 __attribute__((ext_vector_type(8)));
__device__ __forceinline__ void ph_gla_b(const P& p, char* lds, int e) {
  const int tid = TIDX(), wid = tid >> 6, lane = tid & 63;
  const float* SM = (const float*)(p.ws + OFF_SM);
  float* w2S = (float*)lds;
  float* b2S = w2S + 8192;
  for (int i = tid; i < 8192; i += 512) { const int d = i >> 12, hh = (i >> 10) & 3, r = (i >> 6) & 15, j = i & 63; w2S[i] = p.gla_w2[(((size_t)e * 2 + d) * 16 + r) * 256 + hh * 64 + j]; }
  if (tid < 512) b2S[tid] = p.gla_b2[(size_t)e * 512 + tid];
  __syncthreads();
  int jb = 8 * wid; asm volatile("" : "+v"(jb));
  for (int job = BIDX(); job < 16 * NCH; job += GDIM()) {
    const int n = job % NCH, sq = job / NCH; const int dir = sq >> 3, b = (sq >> 2) & 1, h = sq & 3;
    const int c = dir == 0 ? n : (n < 4 ? 3 - n : 135 - n);
    const size_t row = (size_t)b * TB + (size_t)c * 64 + (dir ? 63 - lane : lane);
    const float* gp = SM + row * 64 + 16 + dir * 16;
    const f32x4 g0 = *(const f32x4*)(gp), g1 = *(const f32x4*)(gp + 4), g2 = *(const f32x4*)(gp + 8), g3 = *(const f32x4*)(gp + 12);
    const float gg_[16] = {g0[0], g0[1], g0[2], g0[3], g1[0], g1[1], g1[2], g1[3], g2[0], g2[1], g2[2], g2[3], g3[0], g3[1], g3[2], g3[3]};
    const float* wb = w2S + (dir * 4 + h) * 1024 + jb; const float* bb2 = b2S + dir * 256 + h * 64 + jb;
    f32x4 sa = *(const f32x4*)(bb2), sb = *(const f32x4*)(bb2 + 4);
#pragma unroll
    for (int r = 0; r < 16; ++r) { const f32x4 wa = *(const f32x4*)(wb + r * 64), wq = *(const f32x4*)(wb + r * 64 + 4); sa += gg_[r] * wa; sb += gg_[r] * wq; }
    float la[8];
#pragma unroll
    for (int jj = 0; jj < 4; ++jj) { const float x0 = sa[jj], x1 = sb[jj];
      la[jj] = (fminf(x0, 0.f) - log1pf(expf(-fabsf(x0)))) * 0.0625f; la[4 + jj] = (fminf(x1, 0.f) - log1pf(expf(-fabsf(x1)))) * 0.0625f; }
#pragma unroll
    for (int o = 1; o < 64; o <<= 1) {
#pragma unroll
      for (int jj = 0; jj < 8; ++jj) { const float v = __shfl_up(la[jj], o); la[jj] += lane >= o ? v : 0.f; }
    }
    h16x8 hv;
#pragma unroll
    for (int jj = 0; jj < 8; ++jj) hv[jj] = (_Float16)la[jj];
    _Float16* dst = (_Float16*)(p.ws + (dir ? OFF_B16_1 : OFF_WC)) + ((((size_t)b * 4 + h) * NCH + n) * 64 + lane) * 64 + jb;
    *(h16x8*)dst = hv;
  }
}

struct DnSet { bf16x8 fa[8]; };
__device__ __forceinline__ void dn_scan(const P& p, char* lds, int job) {
  const int tid = TIDX(), wid = tid >> 6, lane = tid & 63, r32 = lane & 31, hi = lane >> 5;
  const int dir = job >> 5, b = (job >> 4) & 1, h = (job >> 2) & 3, n0 = (job & 3) * 32;
  const bf16_t* QQ = (const bf16_t*)(p.ws + OFF_D + D_QQ); const bf16_t* KT = (const bf16_t*)(p.ws + OFF_D + D_KT);
  const bf16_t* W_ = (const bf16_t*)(p.ws + OFF_D + D_W); const bf16_t* U_ = (const bf16_t*)(p.ws + OFF_HBF); const bf16_t* INTRA = (const bf16_t*)(p.ws + OFF_D + D_INTRA);
  const float* SC = (const float*)(p.ws + OFF_SC); const float* GLS = (const float*)(p.ws + OFF_GL);
  bf16_t* DNO = (bf16_t*)(p.ws + OFF_D + D_DNO);
  bf16_t* ST = (bf16_t*)lds; bf16_t* vTa = ST + 32 * 136; bf16_t* vTb = vTa + 32 * 72;
  float* scS = (float*)(vTb + 32 * 72);
  bf16_t* uS = (bf16_t*)(scS + 256);
  bf16_t* inS = uS + 2 * 64 * 40;
  for (int i = tid; i < 32 * 136; i += 512) ST[i] = 0;
  f32x16 accS = {};
  const size_t seq = ((size_t)dir * 2 + b) * 4 + h;
  const int mi = wid & 1, di = wid - 4;
  const int role = wid < 2 ? 0 : (wid < 4 ? 1 : 2);
  const int tt = tid - 256;
  DnSet sA, sB;
  u32x4 stU, stI0; float stS = 0.f, glA = 0.f, glB = 0.f;
#define DN_CH(n_) const int n__ = (n_); const int c__ = dir == 0 ? n__ : (n__ < 4 ? 3 - n__ : 135 - n__); const size_t Rb__ = (size_t)b * TB + (size_t)c__ * 64; const size_t cj__ = seq * NCH + n__;
#define DN_LOAD(S, GL, n_) do { DN_CH(n_) \
    const int ipl__ = 32 * mi + r32, tl__ = dir ? 63 - ipl__ : ipl__; \
    const bf16_t* b0__ = W_ + cj__ * 8192 + (32 * mi + r32) * 128 + hi * 8; \
    const bf16_t* b1__ = QQ + (Rb__ + tl__) * 512 + h * 128 + hi * 8; \
    const bf16_t* b2__ = KT + ((((size_t)b * 4 + h) * NCH + c__) * 128 + 32 * (wid & 3) + r32) * 64 + hi * 8; \
    const bf16_t* bs__ = role == 0 ? b0__ : (role == 1 ? b1__ : b2__); \
    _Pragma("unroll") for (int ks = 0; ks < 8; ++ks) S.fa[ks] = *(const bf16x8*)(bs__ + ks * 16); \
    GL = GLS[cj__]; } while (0)
#define DN_STAGE_LD(n_) do { DN_CH(n_) (void)Rb__; \
      stU = *(const u32x4*)(U_ + cj__ * 8192 + ((tid & 255) >> 2) * 128 + n0 + (tid & 3) * 8); \
      stI0 = *(const u32x4*)(INTRA + cj__ * 4096 + (tid >> 3) * 64 + (tid & 7) * 8); \
      stS = SC[cj__ * 128 + (tid & 127)]; } while (0)
#define DN_STAGE_ST(bf_) do { *(u32x4*)(inS + (bf_) * 4608 + (tid >> 3) * 72 + (tid & 7) * 8) = stI0; \
      if (tid < 256) *(u32x4*)(uS + (bf_) * 2560 + (tid >> 2) * 40 + (tid & 3) * 8) = stU; \
      if (tid < 128) scS[(bf_) * 128 + tid] = stS; } while (0)
#define DN_STEP(S, GL, n_, bf_) do { DN_CH(n_) (void)cj__; \
    const float* sc__ = scS + (bf_) * 128; \
    f32x16 acc = {}; \
    if (role < 2) { const bf16_t* sb__ = ST + r32 * 136 + hi * 8; \
      _Pragma("unroll") for (int ks = 0; ks < 8; ++ks) acc = MFMA32(S.fa[ks], *(const bf16x8*)(sb__ + ks * 16), acc); \
      if (role == 0) { const bf16_t* us__ = uS + (bf_) * 2560 + r32; \
        _Pragma("unroll") for (int r = 0; r < 16; ++r) { const int ip = 32 * mi + crow(r, hi); const float vn = bf2f(us__[ip * 40]) - acc[r]; \
          vTa[r32 * 72 + ip] = f2bf(vn); const int to = dir ? 63 - ip : ip; vTb[r32 * 72 + to] = f2bf(vn * sc__[ip * 2 + 1]); } } \
      else { _Pragma("unroll") for (int r = 0; r < 16; ++r) acc[r] *= sc__[(32 * mi + crow(r, hi)) * 2]; } } \
    LBAR(); \
    if (role == 1) { const bf16_t* vb__ = vTa + r32 * 72 + hi * 8; const bf16_t* ib__ = inS + (bf_) * 4608 + (32 * mi + r32) * 72 + hi * 8; \
      _Pragma("unroll") for (int ks = 0; ks < 4; ++ks) acc = MFMA32(*(const bf16x8*)(ib__ + ks * 16), *(const bf16x8*)(vb__ + ks * 16), acc); \
      _Pragma("unroll") for (int r = 0; r < 16; ++r) { const int ip = 32 * mi + crow(r, hi), t = dir ? 63 - ip : ip; \
        DNO[((size_t)dir * MROWS + Rb__ + t) * 512 + h * 128 + n0 + r32] = f2bf(acc[r]); } } \
    else if (role == 2) { const bf16_t* vb__ = vTb + r32 * 72 + hi * 8; \
      _Pragma("unroll") for (int r = 0; r < 16; ++r) accS[r] *= GL; \
      _Pragma("unroll") for (int ks = 0; ks < 4; ++ks) accS = MFMA32(S.fa[ks], *(const bf16x8*)(vb__ + ks * 16), accS); \
      _Pragma("unroll") for (int r = 0; r < 16; ++r) ST[r32 * 136 + 32 * di + crow(r, hi)] = f2bf(accS[r]); } \
    DN_STAGE_ST((bf_) ^ 1); \
    LBAR(); } while (0)
  DN_STAGE_LD(0); DN_STAGE_ST(0);
  DN_LOAD(sA, glA, 0);
  __syncthreads();
  for (int n = 0; n < NCH; n += 2) {
    DN_LOAD(sB, glB, n + 1); DN_STAGE_LD(n + 1);
    DN_STEP(sA, glA, n, 0);
    { const int n2 = n + 2 < NCH ? n + 2 : NCH - 1; DN_LOAD(sA, glA, n2); DN_STAGE_LD(n2); }
    DN_STEP(sB, glB, n + 1, 1);
  }
#undef DN_CH
#undef DN_LOAD
#undef DN_STAGE_LD
#undef DN_STAGE_ST
#undef DN_STEP
}

DI float fast_logsig(float s) { return fminf(s, 0.f) - __logf(1.f + __expf(-fabsf(s))); }
struct GlaRegs { h16x8 ba, bb; bf16x8 qa, qb, ka, kb, v8; };
__device__ __forceinline__ void gla_scan(const P& p, char* lds, int job, int e) {
  const int tid = TIDX(), wid = tid >> 6, lane = tid & 63, r32 = lane & 31, hi = lane >> 5;
  const int dir = job >> 5, b = (job >> 4) & 1, h = (job >> 2) & 3, n0 = (job & 3) * 32;
  const bf16_t* P2 = (const bf16_t*)(p.ws + OFF_D + D_P2); const float* SM = (const float*)(p.ws + OFF_SM);
  bf16_t* GLAO = (bf16_t*)(p.ws + OFF_D + D_GLAO);
  const _Float16* B16 = (const _Float16*)(p.ws + (dir ? OFF_B16_1 : OFF_WC));
  float* w2S = (float*)lds; float* b2S = w2S + 1024; float* aLb = b2S + 64;
  bf16_t* ops = (bf16_t*)(aLb + 128);
  constexpr int OPB = (4 * 64 + 32) * 72;
  bf16_t* attp = ops + 2 * OPB;
  bf16_t* STb = attp + 2 * 32 * 72;
  for (int i = tid; i < 2 * 32 * 72; i += 512) STb[i] = 0;
  f32x16 accS = {};
  __syncthreads();
  GlaRegs RA;
  int jb0 = 16 * (wid & 3); asm volatile("" : "+v"(jb0));
  int vtb0 = 8 * (wid & 3) * 72 + lane; asm volatile("" : "+v"(vtb0));
#define GLA_LOAD(R, n_) do { const int n__ = (n_) < NCH ? (n_) : NCH - 1; const int c__ = dir == 0 ? n__ : (n__ < 4 ? 3 - n__ : 135 - n__); const size_t row__ = (size_t)b * TB + (size_t)c__ * 64 + (dir ? 63 - lane : lane); \
    const _Float16* bp__ = B16 + ((((size_t)b * 4 + h) * NCH + n__) * 64 + lane) * 64 + 16 * (wid & 3); R.ba = *(const h16x8*)(bp__); R.bb = *(const h16x8*)(bp__ + 8); \
    const bf16_t* pr__ = P2 + row__ * 2048; R.qa = *(const bf16x8*)(pr__ + 512 + h * 64 + 16 * (wid & 3)); R.qb = *(const bf16x8*)(pr__ + 512 + h * 64 + 16 * (wid & 3) + 8); \
    R.ka = *(const bf16x8*)(pr__ + 768 + h * 64 + 16 * (wid & 3)); R.kb = *(const bf16x8*)(pr__ + 768 + h * 64 + 16 * (wid & 3) + 8); R.v8 = *(const bf16x8*)(pr__ + 1024 + h * 128 + n0 + 8 * (wid & 3)); } while (0)
#define GLA_HALF(R, BV, QV, KV, jb) do { \
    float eqe[8], eke[8], eqi[8]; \
    _Pragma("unroll") for (int jj = 0; jj < 8; ++jj) { const int j = (jb) + jj; const float bb = (float)BV[jj]; const float bm = __int_as_float(__builtin_amdgcn_readlane(__float_as_int(bb), 32)), bl = __int_as_float(__builtin_amdgcn_readlane(__float_as_int(bb), 63)); \
      const float q_ = bf2f((bf16_t)QV[jj]) * 0.125f, k_ = bf2f((bf16_t)KV[jj]); \
      eqe[jj] = q_ * __expf(bb - bm); eke[jj] = k_ * __expf(bm - bb); eqi[jj] = q_ * __expf(bb); ksT_[j * 72 + lane] = f2bf(k_ * __expf(bl - bb)); if (lane == 63) aL_[j] = __expf(bl); } \
    *(u32x4*)(qe_ + lane * 72 + (jb)) = (u32x4){cvtpk(eqe[0], eqe[1]), cvtpk(eqe[2], eqe[3]), cvtpk(eqe[4], eqe[5]), cvtpk(eqe[6], eqe[7])}; \
    *(u32x4*)(ke_ + lane * 72 + (jb)) = (u32x4){cvtpk(eke[0], eke[1]), cvtpk(eke[2], eke[3]), cvtpk(eke[4], eke[5]), cvtpk(eke[6], eke[7])}; \
    *(u32x4*)(qi_ + lane * 72 + (jb)) = (u32x4){cvtpk(eqi[0], eqi[1]), cvtpk(eqi[2], eqi[3]), cvtpk(eqi[4], eqi[5]), cvtpk(eqi[6], eqi[7])}; } while (0)
#define GLA_PREP(R, bf_) do { bf16_t* qe_ = ops + (bf_) * OPB; bf16_t* ke_ = qe_ + 64 * 72; bf16_t* qi_ = ke_ + 64 * 72; bf16_t* ksT_ = qi_ + 64 * 72; bf16_t* vT_ = ksT_ + 64 * 72; float* aL_ = aLb + (bf_) * 64; \
    GLA_HALF(R, R.ba, R.qa, R.ka, jb0); GLA_HALF(R, R.bb, R.qb, R.kb, jb0 + 8); \
    _Pragma("unroll") for (int q_ = 0; q_ < 8; ++q_) vT_[vtb0 + q_ * 72] = (bf16_t)R.v8[q_]; } while (0)
#define GLA_MMA(n_, bf_) do { const int nq__ = (n_); const int bf = (bf_); \
      const bf16_t* qe_ = ops + bf * OPB; const bf16_t* ke_ = qe_ + 64 * 72; const bf16_t* qi_ = ke_ + 64 * 72; const bf16_t* ksT_ = qi_ + 64 * 72; const bf16_t* vT_ = ksT_ + 64 * 72; const float* aL_ = aLb + bf * 64; \
      const bf16_t* STr = STb + bf * 32 * 72; bf16_t* STw = STb + (bf ^ 1) * 32 * 72; \
      if (wid < 6) { \
        const int mi = wid - 4; bf16_t* attw = attp + mi * 32 * 72; \
        const int c = dir == 0 ? nq__ : (nq__ < 4 ? 3 - nq__ : 135 - nq__); const size_t Rb = (size_t)b * TB + (size_t)c * 64; \
        f32x16 acc = {}; acc = mma_rows<4>(qi_ + (32 * mi + r32) * 72 + hi * 8, STr + r32 * 72 + hi * 8, acc); \
        { f32x16 a0 = {}; a0 = mma_rows<4>(qe_ + (32 * mi + r32) * 72 + hi * 8, ke_ + r32 * 72 + hi * 8, a0); \
          _Pragma("unroll") for (int r = 0; r < 16; ++r) { const int ipl = crow(r, hi); attw[ipl * 72 + r32] = f2bf((mi == 1 || r32 <= ipl) ? a0[r] : 0.f); } \
          f32x16 a1 = {}; if (mi == 1) a1 = mma_rows<4>(qe_ + (32 + r32) * 72 + hi * 8, ke_ + (32 + r32) * 72 + hi * 8, a1); \
          _Pragma("unroll") for (int r = 0; r < 16; ++r) { const int ipl = crow(r, hi); attw[ipl * 72 + 32 + r32] = f2bf((mi == 1 && r32 <= ipl) ? a1[r] : 0.f); } } \
        asm volatile("s_waitcnt lgkmcnt(0)" ::: "memory"); \
        acc = mma_rows<4>(attw + r32 * 72 + hi * 8, vT_ + r32 * 72 + hi * 8, acc); \
        _Pragma("unroll") for (int r = 0; r < 16; ++r) { const int ip = 32 * mi + crow(r, hi), t = dir ? 63 - ip : ip; \
          GLAO[((size_t)dir * MROWS + Rb + t) * 512 + h * 128 + n0 + r32] = f2bf(acc[r]); } \
      } else { \
        const int di = wid - 6; \
        _Pragma("unroll") for (int r = 0; r < 16; ++r) accS[r] *= aL_[32 * di + crow(r, hi)]; \
        accS = mma_rows<4>(ksT_ + (32 * di + r32) * 72 + hi * 8, vT_ + r32 * 72 + hi * 8, accS); \
        _Pragma("unroll") for (int r = 0; r < 16; ++r) STw[r32 * 72 + 32 * di + crow(r, hi)] = f2bf(accS[r]); \
      } } while (0)
  GLA_LOAD(RA, 0);
  if (wid < 4) { GLA_PREP(RA, 0); }
  GLA_LOAD(RA, 1);
  LBAR();
  for (int n = 0; n < NCH; n += 2) {
    if (wid < 4) { GLA_PREP(RA, 1); } else { GLA_MMA(n, 0); }
    GLA_LOAD(RA, n + 2);
    LBAR();
    if (wid < 4) { if (n + 2 < NCH) { GLA_PREP(RA, 0); } } else { GLA_MMA(n + 1, 1); }
    GLA_LOAD(RA, n + 3);
    LBAR();
  }
#undef GLA_MMA
#undef GLA_LOAD
#undef GLA_HALF
#undef GLA_PREP
}

__device__ __forceinline__ void ph_merge(const P& p, int e) {
  const int tid = TIDX(), wid = tid >> 6, lane = tid & 63;
  const bf16_t* DNO = (const bf16_t*)(p.ws + OFF_D + D_DNO); const bf16_t* GLAO = (const bf16_t*)(p.ws + OFF_D + D_GLAO);
  const bf16_t* P2 = (const bf16_t*)(p.ws + OFF_D + D_P2); bf16_t* hb = (bf16_t*)(p.ws + OFF_HBF);
  for (int R = BIDX() * 8 + wid; R < MROWS; R += GDIM() * 8) {
#pragma unroll
    for (int g = 0; g < 8; ++g) {
      const bf16_t* src = g < 4 ? DNO : GLAO; const int hc = (g & 3) * 128 + lane * 2;
      const unsigned a = *(const unsigned*)(src + (size_t)R * 512 + hc), bq = *(const unsigned*)(src + ((size_t)MROWS + R) * 512 + hc);
      const float v0 = bf2f((bf16_t)(a & 0xffff)) + bf2f((bf16_t)(bq & 0xffff)), v1 = bf2f((bf16_t)(a >> 16)) + bf2f((bf16_t)(bq >> 16));
      const float ss = wave_sum(v0 * v0 + v1 * v1);
      const float rs = rsqrtf(ss * (1.f / 128.f) + EPSF);
      const float* nw = g < 4 ? p.dn_norm + e * 128 : p.gla_norm + e * 128;
      const unsigned zz = *(const unsigned*)(P2 + (size_t)R * 2048 + (g < 4 ? 0 : 1536) + hc);
      const float z0 = bf2f((bf16_t)(zz & 0xffff)), z1 = bf2f((bf16_t)(zz >> 16));
      const float o0 = v0 * rs * nw[lane * 2] * siluf(z0), o1 = v1 * rs * nw[lane * 2 + 1] * siluf(z1);
      *(unsigned*)(hb + (size_t)R * 1024 + g * 128 + lane * 2) = cvtpk(o0, o1);
    }
  }
}

__device__ __forceinline__ void ph_ffnact(const P& p, int L) {
  bf16_t* U = (bf16_t*)(p.ws + OFF_D);
  const float* cw = p.ffn_conv + (size_t)L * 3 * DFF;
  const size_t items = (size_t)MROWS * 352;
  for (size_t it = (size_t)BIDX() * 512 + TIDX(); it < items; it += (size_t)GDIM() * 512) {
    const int R = (int)(it / 352), c0 = (int)(it % 352) * 8; const int b = R >= TB ? 1 : 0, pp = R - b * TB;
    const bool hasp = !(pp == 0 || pp == CTXL), hasn = !(pp == CTXL - 1 || pp == TB - 1);
    const bf16x8 zc = *(const bf16x8*)(U + (size_t)R * 5632 + c0); bf16x8 zp = {}, zn = {};
    if (hasp) zp = *(const bf16x8*)(U + (size_t)(R - 1) * 5632 + c0);
    if (hasn) zn = *(const bf16x8*)(U + (size_t)(R + 1) * 5632 + c0);
    const bf16x8 vv = *(const bf16x8*)(U + (size_t)R * 5632 + DFF + c0);
    float o[8];
#pragma unroll
    for (int j = 0; j < 8; ++j) { const float a = bf2f((bf16_t)zp[j]) * cw[c0 + j] + bf2f((bf16_t)zc[j]) * cw[DFF + c0 + j] + bf2f((bf16_t)zn[j]) * cw[2 * DFF + c0 + j];
      o[j] = siluf(a) * bf2f((bf16_t)vv[j]); }
    u32x4 w = {cvtpk(o[0], o[1]), cvtpk(o[2], o[3]), cvtpk(o[4], o[5]), cvtpk(o[6], o[7])};
    *(u32x4*)(U + (size_t)R * 5632 + DFF + c0) = w;
  }
}

__device__ __forceinline__ void ph_qknorm(const P& p, int o) {
  const int tid = TIDX(), wid = tid >> 6, lane = tid & 63;
  bf16_t* QKV = (bf16_t*)(p.ws + OFF_D);
  const float* qn = p.att_q_norm + o * 128; const float* kn = p.att_k_norm + o * 128;
  const float invf = powf(10000.f, -(float)(lane & 31) / 32.f);
  for (int R = BIDX() * 8 + wid; R < MROWS; R += GDIM() * 8) {
    const int b = R >= TB ? 1 : 0, pp = R - b * TB; const bool lat = pp >= CTXL; const int t = pp - CTXL;
    float cr = 1.f, sr = 0.f, cc = 1.f, sn = 0.f;
    if (lat) { const float ar = (float)(t >> 6) * invf, ac = (float)(t & 63) * invf; cr = cosf(ar); sr = sinf(ar); cc = cosf(ac); sn = sinf(ac); }
    for (int hd = 0; hd < 10; ++hd) {
      bf16_t* base = QKV + (size_t)R * 1536 + hd * 128; const float* nw = hd < 8 ? qn : kn;
      float v0 = bf2f(base[lane]), v1 = bf2f(base[64 + lane]);
      const float ss = wave_sum(v0 * v0 + v1 * v1); const float rs = rsqrtf(ss * (1.f / 128.f) + EPSF);
      v0 = v0 * rs * nw[lane]; v1 = v1 * rs * nw[64 + lane];
      const float p0 = __shfl_xor(v0, 32), p1 = __shfl_xor(v1, 32);
      float o0, o1;
      if (lane < 32) { o0 = v0 * cr - p0 * sr; o1 = v1 * cc - p1 * sn; } else { o0 = p0 * sr + v0 * cr; o1 = p1 * sn + v1 * cc; }
      base[lane] = f2bf(o0); base[64 + lane] = f2bf(o1);
    }
  }
}

namespace at {
constexpr int D = 128, NW = 8, QBLK = 32, KVBLK = 64;
constexpr float SCALE = 0.088388347648318440f, THR = 8.f;
constexpr int LDQ = 1536, LDK = 1536, LDO = 1024;
constexpr size_t SHM_V = KVBLK * D * 2, SHM_K = KVBLK * D * 2;
#define KSWZ(row, colB) ((row) * 256 + ((colB) ^ (((row) & 7) << 4)))
#define SBAR() __builtin_amdgcn_sched_barrier(0)
DI void partialSM(f32x16& p0, f32x16& p1, float& m_reg, float& mn, float& alpha) {
  constexpr float C = SCALE * 1.4426950408889634f;
  float pmax = p0[0]; for (int r = 1; r < 16; ++r) pmax = fmaxf(pmax, p0[r]); for (int r = 0; r < 16; ++r) pmax = fmaxf(pmax, p1[r]);
  { auto rr = __builtin_amdgcn_permlane32_swap(__float_as_uint(pmax), __float_as_uint(pmax), false, false);
    pmax = fmaxf(__uint_as_float(rr[0]), __uint_as_float(rr[1])); }
  if (__builtin_expect(__all(pmax - m_reg <= THR / SCALE), 1)) { mn = m_reg; alpha = 1.f; }
  else { mn = fmaxf(m_reg, pmax); alpha = __builtin_amdgcn_exp2f((m_reg - mn) * C); m_reg = mn; }
  float mnC = -mn * C;
  for (int r = 0; r < 16; ++r) p0[r] = fmaf(p0[r], C, mnC); for (int r = 0; r < 16; ++r) p1[r] = fmaf(p1[r], C, mnC);
  for (int r = 0; r < 16; ++r) p0[r] = __builtin_amdgcn_exp2f(p0[r]);
}
DI void finishSM(f32x16& p0, f32x16& p1, float alpha, float& l_reg, bf16x8& pa0, bf16x8& pa1, bf16x8& pa2, bf16x8& pa3) {
  for (int r = 0; r < 16; ++r) p1[r] = __builtin_amdgcn_exp2f(p1[r]);
  float ps = 0; for (int r = 0; r < 16; ++r) ps += p0[r]; for (int r = 0; r < 16; ++r) ps += p1[r];
  { auto rr = __builtin_amdgcn_permlane32_swap(__float_as_uint(ps), __float_as_uint(ps), false, false);
    ps = __uint_as_float(rr[0]) + __uint_as_float(rr[1]); }
  l_reg = l_reg * alpha + ps;
#define PK4(PP, BASE, OUT) do { unsigned a0 = cvtpk(PP[BASE + 0], PP[BASE + 1]), a1 = cvtpk(PP[BASE + 2], PP[BASE + 3]);   \
    unsigned b0 = cvtpk(PP[BASE + 4], PP[BASE + 5]), b1 = cvtpk(PP[BASE + 6], PP[BASE + 7]);                              \
    auto r0 = __builtin_amdgcn_permlane32_swap(a0, b0, false, false); auto r1 = __builtin_amdgcn_permlane32_swap(a1, b1, false, false); \
    u32x4 w = {r0[0], r1[0], r0[1], r1[1]}; OUT = *reinterpret_cast<bf16x8*>(&w); } while (0)
  PK4(p0, 0, pa0); PK4(p0, 8, pa1); PK4(p1, 0, pa2); PK4(p1, 8, pa3);
#undef PK4
}
DI void qkt(f32x16& p0, f32x16& p1, const bf16_t* Ks, const bf16x8* qr, int r32, int hi) {
  p0 = f32x16{}; p1 = f32x16{};
  for (int d0 = 0; d0 < 8; ++d0) { int cb = (d0 * 16 + hi * 8) * 2;
    bf16x8 b0 = *reinterpret_cast<const bf16x8*>((const char*)Ks + KSWZ(r32, cb));
    bf16x8 b1 = *reinterpret_cast<const bf16x8*>((const char*)Ks + KSWZ(32 + r32, cb));
    p0 = MFMA32(b0, qr[d0], p0);
    p1 = MFMA32(b1, qr[d0], p1); }
}
DI int v_st(int k, int c) { const int kk = (k & ~0xC) | ((k & 4) << 1) | ((k & 8) >> 1); return ((kk >> 3) * 4 + (c >> 5)) * 512 + ((kk & 7) * 32 + (c & 31)) * 2; }
DI int v_rd_base(int lane) { return ((lane & 3) << 3) | (((lane >> 2) & 3) << 6) | (((lane >> 4) & 1) << 5) | (((lane >> 5) & 1) << 8); }
constexpr int v_rd_off(int d0, int ks, int half) { return d0 * 512 + ks * 4096 + half * 2048; }
template <int OFF> DI s16x4 tr_read(int vb) {
  s16x4 r; asm volatile("ds_read_b64_tr_b16 %0, %1 offset:%2" : "=&v"(r) : "v"(vb), "i"(OFF) : "memory"); return r;
}
template <int D0> DI void pv_one(f32x16& od, int vb, bf16x8 pa0, bf16x8 pa1, bf16x8 pa2, bf16x8 pa3) {
  const s16x4 l0 = tr_read<v_rd_off(D0, 0, 0)>(vb), h0 = tr_read<v_rd_off(D0, 0, 1)>(vb), l1 = tr_read<v_rd_off(D0, 1, 0)>(vb), h1 = tr_read<v_rd_off(D0, 1, 1)>(vb);
  const s16x4 l2 = tr_read<v_rd_off(D0, 2, 0)>(vb), h2 = tr_read<v_rd_off(D0, 2, 1)>(vb), l3 = tr_read<v_rd_off(D0, 3, 0)>(vb), h3 = tr_read<v_rd_off(D0, 3, 1)>(vb);
  asm volatile("s_waitcnt lgkmcnt(0)" ::: "memory"); SBAR();
#define PK(Lx, Hx) (bf16x8){Lx[0], Lx[1], Lx[2], Lx[3], Hx[0], Hx[1], Hx[2], Hx[3]}
  od = MFMA32(pa0, PK(l0, h0), od);
  od = MFMA32(pa1, PK(l1, h1), od);
  od = MFMA32(pa2, PK(l2, h2), od);
  od = MFMA32(pa3, PK(l3, h3), od);
#undef PK
}
DI void pv_d0(f32x16* o, int vb, bf16x8 pa0, bf16x8 pa1, bf16x8 pa2, bf16x8 pa3) {
  pv_one<0>(o[0], vb, pa0, pa1, pa2, pa3); pv_one<1>(o[1], vb, pa0, pa1, pa2, pa3); pv_one<2>(o[2], vb, pa0, pa1, pa2, pa3); pv_one<3>(o[3], vb, pa0, pa1, pa2, pa3);
}
DI void attn_dense_body(const bf16_t* __restrict__ Qb, const bf16_t* __restrict__ Kh, const bf16_t* __restrict__ Vh, bf16_t* __restrict__ Ob, int seq, char* lds) {
  const int tid = TIDX(), wid = tid >> 6, lane = tid & 63, r32 = lane & 31, hi = lane >> 5;
  bf16_t* V_lds = (bf16_t*)lds; bf16_t* K_lds = (bf16_t*)(lds + 2 * SHM_V);
  float* ws = (float*)(lds + 2 * SHM_V + 2 * SHM_K) + wid * 64; float* li_l = ws; float* al_l = ws + 32;
  float m_reg = -1e30f, l_reg = 0; f32x16 o[4] = {}; bf16x8 qr[8];
  const bf16_t* Qw = Qb + (long)(wid * QBLK + r32) * LDQ + hi * 8;
#pragma unroll
  for (int d0 = 0; d0 < 8; ++d0) qr[d0] = *reinterpret_cast<const bf16x8*>(Qw + d0 * 16);
  const int sr = tid >> 4, sc = (tid & 15) * 8, vst0 = v_st(sr, sc), vst1 = v_st(32 + sr, sc);
  const int vb0 = (int)(uintptr_t)V_lds + v_rd_base(lane);
  struct { bf16x8 vs0, vs1, ks0, ks1; } sr_[2];
#define SLOAD(i, k0) do { sr_[i].vs0 = *(const bf16x8*)(&Vh[(long)((k0) + sr) * LDK + sc]); sr_[i].vs1 = *(const bf16x8*)(&Vh[(long)((k0) + 32 + sr) * LDK + sc]); \
    sr_[i].ks0 = *(const bf16x8*)(&Kh[(long)((k0) + sr) * LDK + sc]); sr_[i].ks1 = *(const bf16x8*)(&Kh[(long)((k0) + 32 + sr) * LDK + sc]); } while (0)
#define SWRITE(bq, i) do { *(bf16x8*)((char*)V_lds + (bq) * SHM_V + vst0) = sr_[i].vs0;          \
    *(bf16x8*)((char*)V_lds + (bq) * SHM_V + vst1) = sr_[i].vs1; int kc = sc * 2;               \
    *(bf16x8*)((char*)K_lds + (bq) * SHM_K + KSWZ(sr, kc)) = sr_[i].ks0;                       \
    *(bf16x8*)((char*)K_lds + (bq) * SHM_K + KSWZ(32 + sr, kc)) = sr_[i].ks1; } while (0)
#define SWAIT() asm volatile("s_waitcnt vmcnt(4)" ::: "memory")
#define RESC(a) do { if (__any((a) < 1.f)) { if (hi == 0) al_l[r32] = (a); asm volatile("s_waitcnt lgkmcnt(0)" ::: "memory"); \
    for (int d = 0; d < 4; ++d) for (int r = 0; r < 16; ++r) o[d][r] *= al_l[crow(r, hi)]; } } while (0)
  f32x16 pA0, pA1, pB0, pB1; float mnA, mnB, alA, alB; bf16x8 pa0, pa1, pa2, pa3; const int NT = seq / KVBLK;
  constexpr int SE = 0, SO = 1;
  SLOAD(SE, 0); asm volatile("s_waitcnt vmcnt(0)" ::: "memory"); SWRITE(0, SE); __syncthreads();
  qkt(pA0, pA1, K_lds, qr, r32, hi); partialSM(pA0, pA1, m_reg, mnA, alA);
  SLOAD(SO, KVBLK); if (2 < NT) SLOAD(SE, 2 * KVBLK);
  SWAIT(); SWRITE(1, SO); __syncthreads();
  for (int j = 1; j + 1 < NT; j += 2) {
    SBAR(); qkt(pB0, pB1, (bf16_t*)((char*)K_lds + SHM_K), qr, r32, hi);
    finishSM(pA0, pA1, alA, l_reg, pa0, pa1, pa2, pa3); SBAR();
    SLOAD(SO, (j + 2) * KVBLK); SBAR();
    pv_d0(o, vb0, pa0, pa1, pa2, pa3); partialSM(pB0, pB1, m_reg, mnB, alB);
    __syncthreads(); SWAIT(); SWRITE(0, SE);
    RESC(alB); __syncthreads();
    SBAR(); qkt(pA0, pA1, K_lds, qr, r32, hi);
    finishSM(pB0, pB1, alB, l_reg, pa0, pa1, pa2, pa3); SBAR();
    if (j + 3 < NT) SLOAD(SE, (j + 3) * KVBLK); SBAR();
    pv_d0(o, vb0 + (int)SHM_V, pa0, pa1, pa2, pa3); partialSM(pA0, pA1, m_reg, mnA, alA);
    __syncthreads(); SWAIT(); SWRITE(1, SO);
    RESC(alA); __syncthreads();
  }
  SBAR(); qkt(pB0, pB1, (bf16_t*)((char*)K_lds + SHM_K), qr, r32, hi);
  finishSM(pA0, pA1, alA, l_reg, pa0, pa1, pa2, pa3); SBAR();
  pv_d0(o, vb0, pa0, pa1, pa2, pa3); partialSM(pB0, pB1, m_reg, mnB, alB);
  __syncthreads(); RESC(alB);
  finishSM(pB0, pB1, alB, l_reg, pa0, pa1, pa2, pa3); SBAR();
  pv_d0(o, vb0 + (int)SHM_V, pa0, pa1, pa2, pa3);
  if (hi == 0) li_l[r32] = l_reg; asm volatile("s_waitcnt lgkmcnt(0)" ::: "memory");
  float rli[16];
#pragma unroll
  for (int r = 0; r < 16; ++r) rli[r] = __builtin_amdgcn_rcpf(li_l[crow(r, hi)]);
  bf16_t* Ow = Ob + (long)(wid * QBLK) * LDO;
#pragma unroll
  for (int r = 0; r < 16; ++r) { int orow = crow(r, hi);
    for (int d0 = 0; d0 < 4; ++d0) Ow[(long)orow * LDO + d0 * 32 + r32] = f2bf(o[d0][r] * rli[r]); }
#undef SLOAD
#undef SWRITE
#undef SWAIT
#undef RESC
}
}

__device__ __forceinline__ void ph_attn(const P& p, char* lds, bool need_ctx) {
  const bf16_t* QKV = (const bf16_t*)(p.ws + OFF_D); bf16_t* hb = (bf16_t*)(p.ws + OFF_HBF);
  const int nunits = need_ctx ? 528 : 512;
  for (int u = BIDX(); u < nunits; u += GDIM()) {
    int b, h, seq; size_t qrow;
    if (u < 512) { b = u >> 8; const int rem = u & 255; h = rem >> 5; qrow = (size_t)b * TB + CTXL + (size_t)(rem & 31) * 256; seq = TB; }
    else { const int uu = u - 512; b = uu >> 3; h = uu & 7; qrow = (size_t)b * TB; seq = CTXL; }
    const int kvh = h >> 2;
    const bf16_t* Kh = QKV + (size_t)b * TB * 1536 + 1024 + kvh * 128;
    const bf16_t* Vh = QKV + (size_t)b * TB * 1536 + 1280 + kvh * 128;
    at::attn_dense_body(QKV + qrow * 1536 + h * 128, Kh, Vh, hb + qrow * 1024 + h * 128, seq, lds);
    __syncthreads();
  }
}

__device__ __forceinline__ void ph_final(const P& p) {
  const int tid = TIDX(), wid = tid >> 6, lane = tid & 63;
  const float* xr = (const float*)(p.ws + OFF_XRES);
  for (int q = BIDX() * 8 + wid; q < 2 * LAT; q += GDIM() * 8) {
    const int b = q >> 13, t = q & (LAT - 1); const float* row = xr + ((size_t)b * TB + CTXL + t) * 1024;
    f32x4 v[4]; float ss = 0.f;
#pragma unroll
    for (int i = 0; i < 4; ++i) { v[i] = *(const f32x4*)(row + i * 256 + lane * 4); ss += v[i][0] * v[i][0] + v[i][1] * v[i][1] + v[i][2] * v[i][2] + v[i][3] * v[i][3]; }
    ss = wave_sum(ss); const float rs = rsqrtf(ss * (1.f / 1024.f) + EPSF);
#pragma unroll
    for (int i = 0; i < 4; ++i) { const int c0 = i * 256 + lane * 4; const f32x4 g = *(const f32x4*)(p.final_norm + c0); f32x4 o = v[i] * rs * g; *(f32x4*)(p.out + (size_t)q * 1024 + c0) = o; }
  }
}

constexpr int NPHASES = 42;
#ifndef ONLY_PH
#define ONLY_PH -1
#endif
#define EN(x) (ONLY_PH < 0 || ONLY_PH == (x))
#ifndef PROBE_REP
#define PROBE_REP -1
#endif
#define RUN(cls, ...) do { if (EN(cls)) { for (int rep_ = 0; rep_ < ((PROBE_REP == (cls)) ? 2 : 1); ++rep_) { if (rep_) xcd_barrier(*xbp); __VA_ARGS__; } } } while (0)
__device__ __forceinline__ void run_phase(const P& p0, int ph, char* lds, const XcdBarrier* xbp) {
  P p = p0; asm volatile("" : "+s"(p.ws));
  if (ph == 0) { RUN(0, ph_init(p, lds)); return; }
  if (ph == NPHASES - 1) { if (EN(11)) ph_final(p); return; }
  const int q = ph - 1; int L, sub;
  if (q < 11) { L = 0; sub = q; } else if (q < 20) { L = 1; sub = q - 11; } else if (q < 31) { L = 2; sub = q - 20; } else { L = 3; sub = q - 31; }
  const bool even = (L & 1) == 0; const int e = L >> 1;
  bf16_t* W1 = (bf16_t*)(p.ws + OFF_WC); bf16_t* W2 = (bf16_t*)(p.ws + OFF_WC + WC_W2);
  bf16_t* hb = (bf16_t*)(p.ws + OFF_HBF); float* xr = (float*)(p.ws + OFF_XRES);
  const float* mods = (const float*)(p.ws + OFF_MODS) + (size_t)L * 3 * 6144;
  int fs = even ? sub - 7 : sub - 5;
  if (fs >= 0) {
    if (fs == 0) { RUN(1, ph_norm(p, L, 1); cvt_weight(p.ffn_w_up + (size_t)L * 1024 * 5632, W1, 1024, 5632, 5632, false); cvt_weight(p.ffn_w_down + (size_t)L * DFF * 1024, W2, DFF, 1024, 1024, false)); }
    else if (fs == 1) { RUN(2, gemm8(lds, hb, 1024, W1, 1024, 5632, L == 3, EpiBf8{(bf16_t*)(p.ws + OFF_D), 5632})); }
    else if (fs == 2) { if (EN(8)) ph_ffnact(p, L); }
    else { if (EN(2)) gemm8(lds, (const bf16_t*)(p.ws + OFF_D) + DFF, 5632, W2, DFF, 1024, L == 3, EpiRes8{xr, mods + 5 * 1024}); }
    return;
  }
  if (even) {
    switch (sub) {
      case 0: RUN(1, ph_norm(p, L, 0); cvt_weight(p.rec_w_in + (size_t)e * 1024 * 3632, W1, 1024, 3632, NREC, true); cvt_weight(p.rec_w_out + (size_t)e * 1024 * 1024, W2, 1024, 1024, 1024, false)); break;
      case 1: RUN(2, gemm8(lds, hb, 1024, W1, 1024, NREC, false, EpiRec8{(bf16_t*)(p.ws + OFF_D + D_P1), (bf16_t*)(p.ws + OFF_D + D_P2), (float*)(p.ws + OFF_SM)})); break;
      case 2: RUN(3, ph_dnprep(p, lds, e)); break;
      case 3: RUN(4, ph_dn_d1(p, lds); ph_gla_b(p, lds, e)); break;
      case 4: RUN(5, if (BIDX() < 64) { dn_scan(p, lds, BIDX()); } else if (BIDX() < 128) { gla_scan(p, lds, BIDX() - 64, e); });
        if (PROBE_REP == 55) { xcd_barrier(*xbp); if (BIDX() < 64) { dn_scan(p, lds, BIDX()); } }
        if (PROBE_REP == 56) { xcd_barrier(*xbp); if (BIDX() >= 64 && BIDX() < 128) { gla_scan(p, lds, BIDX() - 64, e); } }
        break;
      case 5: RUN(7, ph_merge(p, e)); break;
      case 6: if (EN(2)) gemm8(lds, hb, 1024, W2, 1024, 1024, false, EpiRes8{xr, mods + 2 * 1024}); break;
    }
  } else {
    const int o = L >> 1;
    switch (sub) {
      case 0: RUN(1, ph_norm(p, L, 0); cvt_weight(p.att_w_qkv + (size_t)o * 1024 * 1536, W1, 1024, 1536, 1536, false); cvt_weight(p.att_w_out + (size_t)o * 1024 * 1024, W2, 1024, 1024, 1024, false)); break;
      case 1: RUN(2, gemm8(lds, hb, 1024, W1, 1024, 1536, false, EpiBf8{(bf16_t*)(p.ws + OFF_D), 1536})); break;
      case 2: if (EN(9)) ph_qknorm(p, o); break;
      case 3: RUN(10, ph_attn(p, lds, L != 3)); break;
      case 4: if (EN(2)) gemm8(lds, hb, 1024, W2, 1024, 1024, L == 3, EpiRes8{xr, mods + 2 * 1024}); break;
    }
  }
}

template <bool COOP>
__global__ void __launch_bounds__(512, 1) mk_kernel(P p, int ph0, int ph1) {
  extern __shared__ __attribute__((aligned(16))) char smem[];
  if constexpr (COOP) {
    if (ph0 < 0) cg::this_grid().sync();
    volatile LAS unsigned* st = (volatile LAS unsigned*)(smem + LDS_BYTES);
    if (threadIdx.x < 4) st[threadIdx.x] = 0u;
    __syncthreads();
    XcdBarrier xb = xcd_barrier_post((unsigned*)(p.ws + OFF_BAR), st);
    for (int ph = ph0; ph < ph1; ++ph) {
      run_phase(p, ph, smem, &xb);
      if (ph + 1 < ph1) xcd_barrier(xb);
      if (PROBE_REP == 99 && ph == 0) { for (int q = 0; q < 20; ++q) xcd_barrier(xb); }
    }
  } else {
    for (int ph = ph0; ph < ph1; ++ph) run_phase(p, ph, smem, nullptr);
  }
}

extern "C" void kernel_launch(void* const* d_in, const int* in_sizes, int n_in, void* d_out, int out_size, void* d_ws, size_t ws_size, hipStream_t stream) {
  if (n_in != 23 || ws_size < WS_NEED) { fprintf(stderr, "kernel_launch: bad n_in %d or ws %zu < %zu\n", n_in, ws_size, (size_t)WS_NEED); return; }
  P p{};
  const float** f = (const float**)&p;
  for (int i = 0; i < 23; ++i) f[i] = (const float*)d_in[i];
  p.out = (float*)d_out; p.ws = (char*)d_ws;
  static int inited = 0, grid_blocks = 0;
  if (!inited) {
    hipFuncSetAttribute((const void*)mk_kernel<true>, hipFuncAttributeMaxDynamicSharedMemorySize, LDS_BYTES + 16);
    hipFuncSetAttribute((const void*)mk_kernel<false>, hipFuncAttributeMaxDynamicSharedMemorySize, LDS_BYTES);
    int dev = 0, cus = 0, per_cu = 0;
    hipGetDevice(&dev); hipDeviceGetAttribute(&cus, hipDeviceAttributeMultiprocessorCount, dev);
    hipOccupancyMaxActiveBlocksPerMultiprocessor(&per_cu, mk_kernel<true>, 512, LDS_BYTES + 16);
    if (per_cu > 1) per_cu = 1;
    grid_blocks = cus * per_cu; if (grid_blocks > 256) grid_blocks = 256; if (grid_blocks < 128) grid_blocks = 128;
    inited = 1;
  }
#if MK_COOP
  int ph0 = 0, ph1 = NPHASES;
  void* args[] = {&p, &ph0, &ph1};
  hipMemsetAsync((char*)d_ws + OFF_BAR, 0, 3456 * 4, stream);
  hipError_t er = hipLaunchCooperativeKernel((const void*)mk_kernel<true>, dim3(grid_blocks), dim3(512), args, LDS_BYTES + 16, stream);
  if (er != hipSuccess) fprintf(stderr, "cooperative launch failed: %s (grid %d)\n", hipGetErrorString(er), grid_blocks);
#else
  for (int ph = 0; ph < NPHASES; ++ph) hipLaunchKernelGGL(mk_kernel<false>, dim3(256), dim3(512), LDS_BYTES, stream, p, ph, ph + 1);
#endif
}
```

```cpp
#include <hip/hip_runtime.h>
#include <hip/hip_cooperative_groups.h>
#include <cstdio>
#include <cstdint>
namespace cg = cooperative_groups;

#ifndef MK_COOP
#define MK_COOP 1
#endif

typedef unsigned short bf16_t;
typedef short bf16x8 __attribute__((ext_vector_type(8)));
typedef short s16x4 __attribute__((ext_vector_type(4)));
typedef float f32x16 __attribute__((ext_vector_type(16)));
typedef float f32x8 __attribute__((ext_vector_type(8)));
typedef float f32x4 __attribute__((ext_vector_type(4)));
typedef unsigned u32x4 __attribute__((ext_vector_type(4)));
#define DI __device__ __forceinline__
#define LBAR() do { asm volatile("s_waitcnt lgkmcnt(0)" ::: "memory"); __builtin_amdgcn_s_barrier(); asm volatile("" ::: "memory"); } while (0)
#define MFMA32(a, b, c) __builtin_amdgcn_mfma_f32_32x32x16_bf16((a), (b), (c), 0, 0, 0)

constexpr int DM = 1024, TB = 8448, CTXL = 256, LAT = 8192, MROWS = 2 * TB;
constexpr int NCH = 132;
constexpr int DFF = 2816;
constexpr int NREC = 3840;
constexpr float EPSF = 1e-6f;

constexpr size_t AL(size_t x) { return (x + 255) / 256 * 256; }
constexpr size_t OFF_XRES = 0;
constexpr size_t OFF_HBF = OFF_XRES + AL((size_t)MROWS * DM * 4);
constexpr size_t OFF_WC = OFF_HBF + AL((size_t)MROWS * DM * 2);
constexpr size_t WC_W2 = (size_t)5632 * 1024 * 2;
constexpr size_t OFF_MODS = OFF_WC + AL(WC_W2 + (size_t)1024 * 2816 * 2);
constexpr size_t OFF_SM = OFF_MODS + AL((size_t)4 * 3 * 6144 * 4);
constexpr size_t OFF_GB = OFF_SM + AL((size_t)MROWS * 64 * 4);
constexpr size_t OFF_SC = OFF_GB + AL((size_t)MROWS * 16 * 4);
constexpr size_t OFF_GL = OFF_SC + AL((size_t)16 * NCH * 64 * 2 * 4);
constexpr size_t OFF_D = OFF_GL + AL((size_t)16 * NCH * 4);
constexpr size_t D_P1 = 0;
constexpr size_t D_W = 0;
constexpr size_t D_INTRA = D_W + (size_t)16 * NCH * 64 * 128 * 2;
constexpr size_t D_P2 = D_P1 + (size_t)MROWS * 1536 * 2;
constexpr size_t D_QQ = D_P2 + (size_t)MROWS * 2048 * 2;
constexpr size_t D_QK = D_QQ + (size_t)MROWS * 512 * 2;
constexpr size_t D_QV = D_QK + (size_t)MROWS * 512 * 2;
constexpr size_t D_DNO = D_QK;
constexpr size_t D_KT = D_QV + (size_t)MROWS * 512 * 2;
constexpr size_t D_GLAO = D_KT + (size_t)MROWS * 512 * 2;
constexpr size_t D_END_E = D_GLAO + (size_t)2 * MROWS * 512 * 2;
constexpr size_t D_END_F = (size_t)MROWS * 5632 * 2;
constexpr size_t OFF_B16_1 = OFF_D + (D_END_E > D_END_F ? D_END_E : D_END_F);
constexpr size_t B16_BYTES = (size_t)8 * NCH * 64 * 64 * 2;
constexpr size_t OFF_BAR = OFF_B16_1 + AL(B16_BYTES);
constexpr size_t OFF_W3 = OFF_BAR + AL(3456 * 4);
constexpr size_t WS_NEED = OFF_W3 + (size_t)1024 * 1024 * 2;
constexpr int LDS_BYTES = 132 * 1024;

struct P {
  const float *x, *c, *ctx, *c_ctx, *mod_w, *mod_b, *rec_w_in, *rec_conv, *dn_a_log, *dn_dt_bias, *dn_norm, *gla_w2, *gla_b2, *gla_norm,
      *rec_w_out, *att_w_qkv, *att_q_norm, *att_k_norm, *att_w_out, *ffn_w_up, *ffn_conv, *ffn_w_down, *final_norm;
  float* out;
  char* ws;
};

DI int TIDX() { int t = threadIdx.x; asm volatile("" : "+v"(t)); return t; }
DI int BIDX() { int t = blockIdx.x; asm volatile("" : "+s"(t)); return t; }
DI int GDIM() { int t = gridDim.x; asm volatile("" : "+s"(t)); return t; }
DI float bf2f(bf16_t v) { return __uint_as_float(((unsigned)v) << 16); }
DI bf16_t f2bf(float x) { unsigned u = __float_as_uint(x); u += 0x7fffu + ((u >> 16) & 1u); return (bf16_t)(u >> 16); }
DI unsigned cvtpk(float lo, float hi) { unsigned r; asm volatile("v_cvt_pk_bf16_f32 %0, %1, %2" : "=v"(r) : "v"(lo), "v"(hi)); return r; }
DI int crow(int r, int hi) { return (r & 3) + 8 * (r >> 2) + 4 * hi; }
DI float siluf(float x) { return x / (1.f + expf(-x)); }
DI float sigmf(float x) { return 1.f / (1.f + expf(-x)); }
DI float softplusf(float x) { return fmaxf(x, 0.f) + log1pf(expf(-fabsf(x))); }
DI float wave_sum(float v) {
#pragma unroll
  for (int o = 32; o > 0; o >>= 1) v += __shfl_xor(v, o);
  return v;
}
DI int modrow_of(int R) { const int b = R >= TB ? 1 : 0; const int pp = R - b * TB; return pp < CTXL ? 2 : b; }
template <int KS>
DI f32x16 mma_rows(const bf16_t* arow, const bf16_t* brow, f32x16 acc) {
#pragma unroll
  for (int ks = 0; ks < KS; ++ks) {
    const bf16x8 a = *reinterpret_cast<const bf16x8*>(arow + ks * 16);
    const bf16x8 b = *reinterpret_cast<const bf16x8*>(brow + ks * 16);
    acc = MFMA32(a, b, acc);
  }
  return acc;
}

#define XB_TMO      128
#define XB_XCNT(j)  (256  + 64 * (j))
#define XB_XSUB(j)  (1280 + 64 * (j))
#define XB_XGEN(j)  (2304 + 64 * (j))
#define XB_TOP      3328
#define XB_TOPGEN   3392
#define XCD_BAR_WORDS 3456
#define XB_SPIN_CAP (1u << 18)
#define LAS __attribute__((address_space(3)))
DI unsigned xb_ld(unsigned* p)              { return __hip_atomic_load(p, __ATOMIC_RELAXED, __HIP_MEMORY_SCOPE_AGENT); }
DI unsigned xb_add(unsigned* p, unsigned v) { return __hip_atomic_fetch_add(p, v, __ATOMIC_RELAXED, __HIP_MEMORY_SCOPE_AGENT); }
DI unsigned xb_xcc_id() { return (unsigned)__builtin_amdgcn_s_getreg((3 << 11) | 20) & 0xFu; }
#define XB_SPIN(cond, bar) do { unsigned _sp = 0; while (cond) { __builtin_amdgcn_s_sleep(1); \
    if ((++_sp & 255u) == 0u) { if (xb_ld(&(bar)[XB_TMO])) break; if (_sp > XB_SPIN_CAP) { atomicAdd(&(bar)[XB_TMO], 1u); break; } } } } while (0)
struct XcdBarrier { unsigned* bar; unsigned x; volatile LAS unsigned* st; };
DI XcdBarrier xcd_barrier_post(unsigned* bar, volatile LAS unsigned* st) {
    XcdBarrier b; b.bar = bar; b.x = xb_xcc_id(); b.st = st;
    if (threadIdx.x == 0) (void)xb_add(&bar[XB_XCNT(b.x)], 1u);
    return b;
}
DI void xcd_barrier_complete(unsigned* bar, unsigned x, unsigned& nloc, unsigned& nx) {
    const unsigned G = gridDim.x * gridDim.y * gridDim.z;
    unsigned sum, cnt, mine, sp = 0u;
    for (;;) {
        sum = 0u; cnt = 0u; mine = 0u;
#pragma unroll
        for (unsigned j = 0; j < 16; ++j) { const unsigned c = xb_ld(&bar[XB_XCNT(j)]); sum += c; cnt += (c > 0u) ? 1u : 0u; mine = (j == x) ? c : mine; }
        if (sum == G) break;
        __builtin_amdgcn_s_sleep(1);
        if ((++sp & 255u) == 0u) { if (xb_ld(&bar[XB_TMO])) break; if (sp > XB_SPIN_CAP) { atomicAdd(&bar[XB_TMO], 1u); break; } }
    }
    nloc = mine > 0u ? mine : 1u; nx = cnt > 0u ? cnt : 1u;
}
DI void xcd_barrier(const XcdBarrier& b) {
    asm volatile("s_waitcnt vmcnt(0)" ::: "memory");
    __syncthreads();
    if (threadIdx.x == 0) {
        unsigned* bar = b.bar;
        __builtin_amdgcn_s_waitcnt(0);
        unsigned nloc = b.st[0], nx = b.st[1];
        if (nloc == 0u) { xcd_barrier_complete(bar, b.x, nloc, nx); b.st[0] = nloc; b.st[1] = nx; }
        const unsigned old = xb_add(&bar[XB_XSUB(b.x)], 1u);
        const unsigned gen = old / nloc;
        if (old + 1u == (gen + 1u) * nloc) {
            __builtin_amdgcn_fence(__ATOMIC_RELEASE, "agent");
            asm volatile("s_waitcnt vmcnt(0)" ::: "memory");
            const unsigned og = xb_add(&bar[XB_TOP], 1u);
            const unsigned tg = og / nx;
            if (og + 1u == (tg + 1u) * nx) xb_add(&bar[XB_TOPGEN], 1u);
            else XB_SPIN(xb_ld(&bar[XB_TOPGEN]) == tg, bar);
            __builtin_amdgcn_fence(__ATOMIC_ACQUIRE, "agent");
            xb_add(&bar[XB_XGEN(b.x)], 1u);
            asm volatile("s_waitcnt vmcnt(0)" ::: "memory");
        } else {
            XB_SPIN(xb_ld(&bar[XB_XGEN(b.x)]) == gen, bar);
            __builtin_amdgcn_fence(__ATOMIC_ACQUIRE, "agent");
            asm volatile("s_waitcnt vmcnt(0)" ::: "memory");
        }
    }
    __syncthreads();
}

__device__ __forceinline__ void ph_init(const P& p, char* lds) {
  const int tid = TIDX();
  float* sc = (float*)lds;
  float* red = sc + 3072;
  for (int i = tid; i < 3072; i += 512) { const int r = i >> 10, k = i & 1023; const float v = r < 2 ? p.c[r * 1024 + k] : p.c_ctx[k]; sc[i] = siluf(v); }
  __syncthreads();
  float* mods = (float*)(p.ws + OFF_MODS);
  for (int job = BIDX(); job < 192; job += GDIM()) {
    const int col = job * 128 + (tid & 127), kq = tid >> 7;
    const int L = col / 6144, cl = col - L * 6144;
    const float* w = p.mod_w + ((size_t)L * 1024 + kq * 256) * 6144 + cl;
    float a0 = 0.f, a1 = 0.f, a2 = 0.f;
#pragma unroll 8
    for (int k = 0; k < 256; ++k) { const float wv = w[(size_t)k * 6144]; const int kk = kq * 256 + k; a0 += sc[kk] * wv; a1 += sc[1024 + kk] * wv; a2 += sc[2048 + kk] * wv; }
    red[(kq * 3 + 0) * 128 + (tid & 127)] = a0; red[(kq * 3 + 1) * 128 + (tid & 127)] = a1; red[(kq * 3 + 2) * 128 + (tid & 127)] = a2;
    __syncthreads();
    if (tid < 384) { const int r = tid >> 7, cc = tid & 127; const int c2 = job * 128 + cc; const int L2 = c2 / 6144, cl2 = c2 - L2 * 6144;
      const float s = red[(0 * 3 + r) * 128 + cc] + red[(1 * 3 + r) * 128 + cc] + red[(2 * 3 + r) * 128 + cc] + red[(3 * 3 + r) * 128 + cc] + p.mod_b[L2 * 6144 + cl2];
      mods[((size_t)L2 * 3 + r) * 6144 + cl2] = s; }
    __syncthreads();
  }
  f32x4* xr = (f32x4*)(p.ws + OFF_XRES);
  for (size_t i = (size_t)BIDX() * 512 + tid; i < (size_t)MROWS * 256; i += (size_t)GDIM() * 512) {
    const int R = (int)(i >> 8), c4 = (int)(i & 255); const int b = R >= TB ? 1 : 0, pp = R - b * TB;
    const float* src = pp < CTXL ? p.ctx + ((size_t)b * CTXL + pp) * 1024 : p.x + ((size_t)b * LAT + (pp - CTXL)) * 1024;
    xr[i] = *(const f32x4*)(src + c4 * 4);
  }
}

DI int rec_src_col(int n) { if (n < 2048) return n; if (n < 3584) return n + 16; if (n < 3600) return 2048 + (n - 3584); if (n < 3632) return n; return -1; }
__device__ __forceinline__ void cvt_weight(const float* __restrict__ W, bf16_t* __restrict__ Wt, int K, int Nsrc, int Npad, bool perm, int skipb) {
  const size_t items = (size_t)Npad * (K >> 3);
  const int bid = BIDX() - skipb, nb = GDIM() - skipb;
  if (bid < 0) return;
  for (size_t it = (size_t)bid * 512 + TIDX(); it < items; it += (size_t)nb * 512) {
    const int n = (int)(it % Npad), kb = (int)(it / Npad);
    const int s = perm ? rec_src_col(n) : n;
    float v[8];
#pragma unroll
    for (int j = 0; j < 8; ++j) v[j] = s >= 0 ? W[(size_t)(kb * 8 + j) * Nsrc + s] : 0.f;
    u32x4 w = {cvtpk(v[0], v[1]), cvtpk(v[2], v[3]), cvtpk(v[4], v[5]), cvtpk(v[6], v[7])};
    *(u32x4*)(Wt + (size_t)n * K + kb * 8) = w;
  }
}

__device__ __forceinline__ void ph_norm(const P& p, int L, int which) {
  const int tid = TIDX(), wid = tid >> 6, lane = tid & 63, l16 = lane & 15, sub = lane >> 4;
  const float* xr = (const float*)(p.ws + OFF_XRES);
  bf16_t* hb = (bf16_t*)(p.ws + OFF_HBF);
  const float* mods = (const float*)(p.ws + OFF_MODS) + (size_t)L * 3 * 6144;
  for (int R4 = (BIDX() * 8 + wid) * 4; R4 < MROWS; R4 += GDIM() * 32) {
    const int R = R4 + sub;
    const float* row = xr + (size_t)R * 1024 + l16 * 4;
    f32x4 v[16]; float ss = 0.f;
#pragma unroll
    for (int i = 0; i < 16; ++i) v[i] = *(const f32x4*)(row + i * 64);
#pragma unroll
    for (int i = 0; i < 16; ++i) ss += v[i][0] * v[i][0] + v[i][1] * v[i][1] + v[i][2] * v[i][2] + v[i][3] * v[i][3];
    ss += __shfl_xor(ss, 1); ss += __shfl_xor(ss, 2); ss += __shfl_xor(ss, 4); ss += __shfl_xor(ss, 8);
    const float rs = rsqrtf(ss * (1.f / 1024.f) + EPSF);
    const float* mr = mods + (size_t)modrow_of(R) * 6144 + which * 3072 + l16 * 4;
    bf16_t* dst = hb + (size_t)R * 1024 + l16 * 4;
#pragma unroll
    for (int i = 0; i < 16; ++i) { const f32x4 sh = *(const f32x4*)(mr + i * 64), scl = *(const f32x4*)(mr + 1024 + i * 64);
      float o[4];
#pragma unroll
      for (int j = 0; j < 4; ++j) o[j] = v[i][j] * rs * (1.f + scl[j]) + sh[j];
      uint2 w; w.x = cvtpk(o[0], o[1]); w.y = cvtpk(o[2], o[3]);
      *(uint2*)(dst + i * 64) = w; }
  }
}

struct EpiRec { bf16_t* P1; bf16_t* P2; float* SM;
  DI void operator()(int row, int col, float v) const {
    if (col < 1536) P1[(size_t)row * 1536 + col] = f2bf(v);
    else if (col < 3584) P2[(size_t)row * 2048 + (col - 1536)] = f2bf(v);
    else { const int lc = col - 3584; if (lc < 48) SM[(size_t)row * 64 + lc] = v; } } };
struct EpiBf { bf16_t* O; int ldc;
  DI void operator()(int row, int col, float v) const { O[(size_t)row * ldc + col] = f2bf(v); } };
struct EpiRes { float* X; const float* gate;
  DI void operator()(int row, int col, float v) const { float* q = X + (size_t)row * 1024 + col; *q = *q + gate[(size_t)modrow_of(row) * 6144 + col] * v; } };

template <class Epi>
__device__ __forceinline__ void gemm_phase(char* lds, const bf16_t* __restrict__ A, int lda, const bf16_t* __restrict__ Bt, int K, int nN, const Epi epi, bool skipctx = false) {
  const int tid = TIDX(), wid = tid >> 6, lane = tid & 63, r32 = lane & 31, hi = lane >> 5;
  const int wm = wid >> 1, wn = wid & 1;
  const int nk = K >> 6;
  constexpr int RS = 144, ASZ = 256 * RS, BSZ = 128 * RS, STG = ASZ + BSZ;
  const int ntiles = (skipctx ? 64 : MROWS / 256) * nN;
  const int srow = tid >> 3, spc = tid & 7;
  for (int t = BIDX(); t < ntiles; t += GDIM()) {
    int pm = t / nN; const int pn = t - pm * nN; if (skipctx) pm = pm + 1 + (pm >= 32 ? 1 : 0);
    const bf16_t* Ab = A + (size_t)(pm * 256 + srow) * lda + spc * 8;
    const bf16_t* Bb = Bt + (size_t)(pn * 128 + srow) * K + spc * 8;
    f32x16 acc00 = {}, acc01 = {}, acc10 = {}, acc11 = {};
    bf16x8 ra0, ra1, ra2, ra3, rb0, rb1;
#define GLOAD(kt) do { const int ko = (kt) * 64; ra0 = *(const bf16x8*)(Ab + ko); ra1 = *(const bf16x8*)(Ab + (size_t)64 * lda + ko); ra2 = *(const bf16x8*)(Ab + (size_t)128 * lda + ko); \
    ra3 = *(const bf16x8*)(Ab + (size_t)192 * lda + ko); rb0 = *(const bf16x8*)(Bb + ko); rb1 = *(const bf16x8*)(Bb + (size_t)64 * K + ko); } while (0)
#define SWRITE(buf) do { char* sb = lds + (buf) * STG + srow * RS + spc * 16; *(bf16x8*)(sb) = ra0; *(bf16x8*)(sb + 64 * RS) = ra1; *(bf16x8*)(sb + 128 * RS) = ra2; *(bf16x8*)(sb + 192 * RS) = ra3; \
    *(bf16x8*)(sb + ASZ) = rb0; *(bf16x8*)(sb + ASZ + 64 * RS) = rb1; } while (0)
    GLOAD(0); SWRITE(0); __syncthreads();
    for (int kt = 0; kt < nk; ++kt) {
      const int cur = kt & 1;
      if (kt + 1 < nk) GLOAD(kt + 1);
      const char* ab = lds + cur * STG + (64 * wm + r32) * RS + hi * 16;
      const char* bb = lds + cur * STG + ASZ + (64 * wn + r32) * RS + hi * 16;
#pragma unroll
      for (int ks = 0; ks < 4; ++ks) {
        const bf16x8 a0 = *(const bf16x8*)(ab + ks * 32), a1 = *(const bf16x8*)(ab + 32 * RS + ks * 32);
        const bf16x8 b0 = *(const bf16x8*)(bb + ks * 32), b1 = *(const bf16x8*)(bb + 32 * RS + ks * 32);
        acc00 = MFMA32(a0, b0, acc00); acc01 = MFMA32(a0, b1, acc01); acc10 = MFMA32(a1, b0, acc10); acc11 = MFMA32(a1, b1, acc11);
      }
      if (kt + 1 < nk) SWRITE(cur ^ 1);
      __syncthreads();
    }
#undef GLOAD
#undef SWRITE
    const int row0 = pm * 256 + 64 * wm, col0 = pn * 128 + 64 * wn + r32;
#pragma unroll
    for (int r = 0; r < 16; ++r) { const int rr = row0 + crow(r, hi);
      epi(rr, col0, acc00[r]); epi(rr, col0 + 32, acc01[r]); epi(rr + 32, col0, acc10[r]); epi(rr + 32, col0 + 32, acc11[r]); }
  }
}

namespace pg8 {
#define PG8_LAS __attribute__((address_space(3)))
constexpr int BM = 256, BK = 64, HALF = 128, HTB = HALF * BK * 2  , STAGE_BYTES = 8 * HTB, NXCD = 8, WGM = 8;

__host__ __device__ __forceinline__ int lds_byte(int r, int c) { const int st = (r >> 4) * 2 + (c >> 5), rr = r & 15, cc = c & 31, ob = rr * 64 + cc * 2; return st * 1024 + (ob ^ (((ob >> 9) & 1) << 5)); }
__host__ __device__ __forceinline__ void stage_rc(int b, int& R, int& C) { const int st = b / 1024, sb = b % 1024, swz = sb ^ (((sb >> 9) & 1) << 5); R = (st >> 1) * 16 + swz / 64; C = (st & 1) * 32 + (swz % 64) / 2; }
__host__ __device__ __forceinline__ int perm32(int rho) { const int n = rho >> 4, i = rho & 15; return 8 * (i >> 2) + 4 * n + (i & 3); }
struct Unit { int pm, pn; };
struct Gemm { const bf16_t* A; const bf16_t* Bt; int M, N, K, lda; };

struct StaticOrder {
    int nM, nN, nwg, G, c;
    __host__ __device__ void init(int M, int N, int G_, int c_) { nM = M / BM; nN = N / BM; nwg = nM * nN; G = G_; c = c_; }
    __host__ __device__ bool next(int i, Unit& u) const {
        const long L = (long)i * G + c; if (L >= nwg) return false;
        int wgid = (int)L; { const int q = nwg / NXCD, r = nwg % NXCD, xcd = wgid % NXCD, off = wgid / NXCD; wgid = (xcd < r ? xcd * (q + 1) : r * (q + 1) + (xcd - r) * q) + off; }
        const int nig = WGM * nN, gid = wgid / nig, fm = gid * WGM, gsz = (nM - fm) < WGM ? (nM - fm) : WGM;
        u.pm = fm + ((wgid % nig) % gsz); u.pn = (wgid % nig) / gsz; return true;
    }
    __device__ __forceinline__ void a_ready(const Unit&) const {}
    __device__ __forceinline__ void done(const Unit&) const {}
};
template <class Epi, class Sched, bool ALIGN_EPI = false, bool SP2 = false>
__device__ __forceinline__ void gemm_phase(PG8_LAS unsigned char* lds, const Gemm g, const Sched& S, const Epi& E) {
    const int tid = TIDX(), wid = __builtin_amdgcn_readfirstlane(tid >> 6), lane = tid & 63, wr = wid >> 2, wc = wid & 3, fr = lane & 15, fq = lane >> 4;
    const int K = g.K, nt = K / BK;
    unsigned voffA[2], voffB[2];
#pragma unroll
    for (int i = 0; i < 2; ++i) { int R, C; stage_rc(tid * 16 + i * 8192, R, C); const int Rb = Epi::PERM ? ((R & ~31) + perm32(R & 31)) : R;
        voffA[i] = (unsigned)(R * g.lda + C) * 2u; voffB[i] = (unsigned)(Rb * K + C) * 2u; }
    const size_t kstep = (size_t)(BK * 2);
    const size_t hstep = (size_t)HALF * K * 2;
    const size_t tstep = 2 * hstep; const size_t hstepA = (size_t)HALF * g.lda * 2, tstepA = 2 * hstepA;
    const unsigned ldsw = (unsigned)wid * 1024u;
    const int aoff = lds_byte(wr * 64 + fr, fq * 8), boff = lds_byte(wc * 32 + fr, fq * 8);
#define PG8_SA(b, h) (((b) * 2 + (h)) * HTB)
#define PG8_SB(b, h) ((4 + (b) * 2 + (h)) * HTB)
#define PG8_STAGE(bufoff, gbase, voff) do { _Pragma("unroll") for (int _i = 0; _i < 2; ++_i) \
        __builtin_amdgcn_global_load_lds((const unsigned*)((const char*)(gbase) + (voff)[_i]), (PG8_LAS unsigned*)(lds + (bufoff) + ldsw + _i * 8192), 16, 0, 0); } while (0)
#define PG8_LDA(dst, b, h) do { _Pragma("unroll") for (int m = 0; m < 4; ++m) _Pragma("unroll") for (int k = 0; k < 2; ++k) dst[m][k] = *(const PG8_LAS bf16x8*)(lds + PG8_SA(b, h) + aoff + m * 2048 + k * 1024); } while (0)
#define PG8_LDB(dst, b, h) do { _Pragma("unroll") for (int n = 0; n < 2; ++n) _Pragma("unroll") for (int k = 0; k < 2; ++k) dst[n][k] = *(const PG8_LAS bf16x8*)(lds + PG8_SB(b, h) + boff + n * 2048 + k * 1024); } while (0)
#define PG8_MMA(ai, bj, At, Bt) do { __builtin_amdgcn_s_setprio(1); _Pragma("unroll") for (int m = 0; m < 4; ++m) _Pragma("unroll") for (int n = 0; n < 2; ++n) _Pragma("unroll") for (int k = 0; k < 2; ++k) \
        acc[ai][bj][m][n] = __builtin_amdgcn_mfma_f32_16x16x32_bf16(Bt[n][k], At[m][k], acc[ai][bj][m][n], 0, 0, 0); __builtin_amdgcn_s_setprio(0); } while (0)
#define PG8_WAIT_V(n) asm volatile("s_waitcnt vmcnt(" #n ")" ::: "memory")
#define PG8_WAIT_L(n) asm volatile("s_waitcnt lgkmcnt(" #n ")" ::: "memory")
#define PG8_BAR __builtin_amdgcn_s_barrier()
#define PG8_SCHED __builtin_amdgcn_sched_barrier(0)
    Unit cur, nxt; int ui = 0;
    if (!S.next(0, cur)) return;
    f32x4 acc[2][2][4][2];
#pragma unroll
    for (int a = 0; a < 2; ++a)
#pragma unroll
        for (int b = 0; b < 2; ++b)
#pragma unroll
            for (int m = 0; m < 4; ++m)
#pragma unroll
                for (int n = 0; n < 2; ++n) acc[a][b][m][n] = (f32x4){0.f, 0.f, 0.f, 0.f};
    bf16x8 At[4][2], B0[2][2], B1[2][2];
    const char* cA = (const char*)g.A + (size_t)cur.pm * tstepA; const char* cB = (const char*)g.Bt + (size_t)cur.pn * tstep;
    S.a_ready(cur);
    if constexpr (SP2) {
        PG8_STAGE(PG8_SB(0, 0), cB, voffB); PG8_STAGE(PG8_SB(0, 1), cB + hstep, voffB); PG8_STAGE(PG8_SA(0, 0), cA, voffA); PG8_STAGE(PG8_SA(0, 1), cA + hstepA, voffA);
        if (wr == 1) PG8_BAR;
        PG8_WAIT_V(2); PG8_BAR;
        PG8_STAGE(PG8_SB(1, 0), cB + kstep, voffB); PG8_STAGE(PG8_SA(1, 0), cA + kstep, voffA); PG8_STAGE(PG8_SB(1, 1), cB + hstep + kstep, voffB);
        PG8_WAIT_V(6); PG8_BAR;
    } else {
        PG8_STAGE(PG8_SB(0, 0), cB, voffB); PG8_STAGE(PG8_SA(0, 0), cA, voffA); PG8_STAGE(PG8_SB(0, 1), cB + hstep, voffB); PG8_STAGE(PG8_SA(0, 1), cA + hstepA, voffA);
        if (wr == 1) PG8_BAR;
        PG8_WAIT_V(4); PG8_BAR;
        PG8_STAGE(PG8_SB(1, 0), cB + kstep, voffB); PG8_STAGE(PG8_SA(1, 0), cA + kstep, voffA); PG8_STAGE(PG8_SB(1, 1), cB + hstep + kstep, voffB);
        PG8_WAIT_V(6); PG8_BAR;
    }
    for (;;) {
        const bool has_next = S.next(ui + 1, nxt);
        const char* nA = has_next ? (const char*)g.A + (size_t)nxt.pm * tstepA : cA; const char* nB = has_next ? (const char*)g.Bt + (size_t)nxt.pn * tstep : cB;
        for (int t = 0; t < nt; t += 2) {
            const bool last = (t == nt - 2);
            const char* a1 = cA + (size_t)(t + 1) * kstep;
            const char* a2 = last ? nA : cA + (size_t)(t + 2) * kstep; const char* b2 = last ? nB : cB + (size_t)(t + 2) * kstep;
            const char* a3 = a2 + kstep; const char* b3 = b2 + kstep;
            if (last && has_next) S.a_ready(nxt);
            if constexpr (SP2) {
            PG8_LDB(B0, 0, 0); PG8_LDB(B1, 0, 1); PG8_SCHED; PG8_LDA(At, 0, 0); PG8_STAGE(PG8_SA(1, 1), a1 + hstepA, voffA);
            PG8_WAIT_V(8); PG8_WAIT_L(0); PG8_BAR; PG8_MMA(0, 0, At, B0); PG8_MMA(0, 1, At, B1); PG8_BAR; PG8_SCHED;
            PG8_LDA(At, 0, 1); PG8_STAGE(PG8_SB(0, 0), b2, voffB); PG8_STAGE(PG8_SB(0, 1), b2 + hstep, voffB); PG8_STAGE(PG8_SA(0, 0), a2, voffA);
            PG8_WAIT_V(8); PG8_WAIT_L(0); PG8_BAR; PG8_MMA(1, 0, At, B0); PG8_MMA(1, 1, At, B1); PG8_BAR; PG8_SCHED;
            PG8_LDB(B0, 1, 0); PG8_LDB(B1, 1, 1); PG8_SCHED; PG8_LDA(At, 1, 0); PG8_STAGE(PG8_SA(0, 1), a2 + hstepA, voffA);
            PG8_WAIT_V(8); PG8_WAIT_L(0); PG8_BAR; PG8_MMA(0, 0, At, B0); PG8_MMA(0, 1, At, B1); PG8_BAR; PG8_SCHED;
            PG8_LDA(At, 1, 1); PG8_STAGE(PG8_SB(1, 0), b3, voffB); PG8_STAGE(PG8_SB(1, 1), b3 + hstep, voffB); PG8_STAGE(PG8_SA(1, 0), a3, voffA);
            PG8_WAIT_V(8); PG8_WAIT_L(0); PG8_BAR; PG8_MMA(1, 0, At, B0); PG8_MMA(1, 1, At, B1); PG8_BAR; PG8_SCHED;
            } else {
            PG8_LDB(B0, 0, 0); PG8_SCHED; PG8_LDA(At, 0, 0); PG8_STAGE(PG8_SA(1, 1), a1 + hstepA, voffA);
            PG8_WAIT_L(8); PG8_BAR; PG8_WAIT_L(0); PG8_MMA(0, 0, At, B0); PG8_BAR; PG8_SCHED;
            PG8_LDB(B1, 0, 1); PG8_STAGE(PG8_SB(0, 0), b2, voffB);
            PG8_BAR; PG8_WAIT_L(0); PG8_MMA(0, 1, At, B1); PG8_BAR;
            PG8_LDA(At, 0, 1); PG8_STAGE(PG8_SA(0, 0), a2, voffA);
            PG8_BAR; PG8_WAIT_L(0); PG8_MMA(1, 0, At, B0); PG8_BAR; PG8_SCHED;
            PG8_STAGE(PG8_SB(0, 1), b2 + hstep, voffB);
            PG8_WAIT_V(6); PG8_BAR; PG8_MMA(1, 1, At, B1); PG8_BAR;
            PG8_LDB(B0, 1, 0); PG8_SCHED; PG8_LDA(At, 1, 0); PG8_STAGE(PG8_SA(0, 1), a2 + hstepA, voffA);
            PG8_WAIT_L(8); PG8_BAR; PG8_WAIT_L(0); PG8_MMA(0, 0, At, B0); PG8_BAR; PG8_SCHED;
            PG8_LDB(B1, 1, 1); PG8_STAGE(PG8_SB(1, 0), b3, voffB);
            PG8_BAR; PG8_WAIT_L(0); PG8_MMA(0, 1, At, B1); PG8_BAR;
            PG8_LDA(At, 1, 1); PG8_STAGE(PG8_SA(1, 0), a3, voffA);
            PG8_BAR; PG8_WAIT_L(0); PG8_MMA(1, 0, At, B0); PG8_BAR; PG8_SCHED;
            PG8_STAGE(PG8_SB(1, 1), b3 + hstep, voffB);
            PG8_WAIT_V(6); PG8_BAR; PG8_MMA(1, 1, At, B1); PG8_BAR;
            }
        }
        if constexpr (ALIGN_EPI) { if (wr == 0) PG8_BAR; }
        if constexpr (!Epi::AFTER_DRAIN) { E(acc, cur, wr, wc, fr, fq); S.done(cur); }
        if (!has_next) break;
#pragma unroll
        for (int a = 0; a < 2; ++a)
#pragma unroll
            for (int b = 0; b < 2; ++b)
#pragma unroll
                for (int m = 0; m < 4; ++m)
#pragma unroll
                    for (int n = 0; n < 2; ++n) acc[a][b][m][n] = (f32x4){0.f, 0.f, 0.f, 0.f};
        cur = nxt; cA = nA; cB = nB; ++ui;
        if constexpr (ALIGN_EPI) { if (wr == 1) PG8_BAR; }
    }
    PG8_WAIT_V(0);
    if constexpr (!ALIGN_EPI) { if (wr == 0) PG8_BAR; }
    PG8_BAR;
    if constexpr (Epi::AFTER_DRAIN) { E.fused(acc, cur, wr, wc, fr, fq, lds, wid, lane); S.done(cur); }
#undef PG8_SA
#undef PG8_SB
#undef PG8_STAGE
#undef PG8_LDA
#undef PG8_LDB
#undef PG8_MMA
#undef PG8_WAIT_V
#undef PG8_WAIT_L
#undef PG8_BAR
#undef PG8_SCHED
}
struct SchedX { StaticOrder so; bool skip;
  __device__ __forceinline__ bool next(int i, Unit& u) const { if (!so.next(i, u)) return false; if (skip) u.pm = u.pm + 1 + (u.pm >= 32 ? 1 : 0); return true; }
  __device__ __forceinline__ void a_ready(const Unit&) const {}
  __device__ __forceinline__ void done(const Unit&) const {} };
}
struct EpiRec8 { static constexpr bool PERM = false, AFTER_DRAIN = false; bf16_t* P1; bf16_t* P2; float* SM;
  DI void operator()(const f32x4 (&acc)[2][2][4][2], const pg8::Unit& u, int wr, int wc, int fr, int fq) const {
#pragma unroll
    for (int ai = 0; ai < 2; ++ai)
#pragma unroll
      for (int m = 0; m < 4; ++m) { const size_t row = (size_t)u.pm * 256 + ai * 128 + wr * 64 + m * 16 + fr;
#pragma unroll
        for (int bj = 0; bj < 2; ++bj)
#pragma unroll
          for (int n = 0; n < 2; ++n) { const int col = u.pn * 256 + bj * 128 + wc * 32 + n * 16 + fq * 4; const f32x4 v = acc[ai][bj][m][n];
            if (u.pn < 6) { uint2 w; w.x = cvtpk(v[0], v[1]); w.y = cvtpk(v[2], v[3]); *(uint2*)(P1 + row * 1536 + col) = w; }
            else if (u.pn < 14) { uint2 w; w.x = cvtpk(v[0], v[1]); w.y = cvtpk(v[2], v[3]); *(uint2*)(P2 + row * 2048 + (col - 1536)) = w; }
            else { const int lc = col - 3584; if (lc < 48) *(f32x4*)(SM + row * 64 + lc) = v; } } } } };
struct EpiBf8 { static constexpr bool PERM = false, AFTER_DRAIN = false; bf16_t* O; int ldc;
  DI void operator()(const f32x4 (&acc)[2][2][4][2], const pg8::Unit& u, int wr, int wc, int fr, int fq) const {
#pragma unroll
    for (int ai = 0; ai < 2; ++ai)
#pragma unroll
      for (int m = 0; m < 4; ++m) { const size_t row = (size_t)u.pm * 256 + ai * 128 + wr * 64 + m * 16 + fr;
#pragma unroll
        for (int bj = 0; bj < 2; ++bj)
#pragma unroll
          for (int n = 0; n < 2; ++n) { const int col = u.pn * 256 + bj * 128 + wc * 32 + n * 16 + fq * 4; const f32x4 v = acc[ai][bj][m][n];
            uint2 w; w.x = cvtpk(v[0], v[1]); w.y = cvtpk(v[2], v[3]); *(uint2*)(O + row * ldc + col) = w; } } } };
struct EpiRes8 { static constexpr bool PERM = false, AFTER_DRAIN = false; float* X; const float* gate;
  DI void operator()(const f32x4 (&acc)[2][2][4][2], const pg8::Unit& u, int wr, int wc, int fr, int fq) const {
    const float* gr = gate + (size_t)modrow_of(u.pm * 256) * 6144;
#pragma unroll
    for (int bj = 0; bj < 2; ++bj)
#pragma unroll
      for (int n = 0; n < 2; ++n) { const int col = u.pn * 256 + bj * 128 + wc * 32 + n * 16 + fq * 4; const f32x4 gv = *(const f32x4*)(gr + col);
#pragma unroll
        for (int ai = 0; ai < 2; ++ai)
#pragma unroll
          for (int m = 0; m < 4; ++m) { const size_t row = (size_t)u.pm * 256 + ai * 128 + wr * 64 + m * 16 + fr;
            f32x4* q = (f32x4*)(X + row * 1024 + col); *q = *q + gv * acc[ai][bj][m][n]; } } } };
template <class Epi>
__device__ __forceinline__ void gemm8(char* lds, const bf16_t* A, int lda, const bf16_t* Bt, int K, int N, bool skipctx, const Epi& E) {
  pg8::Gemm g{A, Bt, skipctx ? 16384 : MROWS, N, K, lda};
  pg8::SchedX S; S.so.init(g.M, N, GDIM(), BIDX()); S.skip = skipctx;
  pg8::gemm_phase<Epi, pg8::SchedX, true, true>((PG8_LAS unsigned char*)lds, g, S, E);
}

__device__ __forceinline__ void ph_dnprep(const P& p, char* lds, int e) {
  const int tid = TIDX(), wid = tid >> 6, lane = tid & 63;
  const bf16_t* P1 = (const bf16_t*)(p.ws + OFF_D + D_P1);
  bf16_t* QQ = (bf16_t*)(p.ws + OFF_D + D_QQ); bf16_t* QK = (bf16_t*)(p.ws + OFF_D + D_QK); bf16_t* QV = (bf16_t*)(p.ws + OFF_D + D_QV);
  bf16_t* KT = (bf16_t*)(p.ws + OFF_D + D_KT);
  const float* SM = (const float*)(p.ws + OFF_SM); float* GB = (float*)(p.ws + OFF_GB);
  const float* cw = p.rec_conv + (size_t)e * 3 * 1536;
  bf16_t* kl = (bf16_t*)lds;
  for (int job = BIDX(); job < MROWS / 64; job += GDIM()) {
    const int R0 = job * 64;
    for (int tt = 0; tt < 8; ++tt) {
      const int tl = wid * 8 + tt, R = R0 + tl; const int b = R >= TB ? 1 : 0, pp = R - b * TB;
      const bool hasp = !(pp == 0 || pp == CTXL), hasn = !(pp == CTXL - 1 || pp == TB - 1);
#pragma unroll
      for (int part = 0; part < 3; ++part) {
        const int ch = part * 512 + lane * 8;
        const bf16x8 zc = *(const bf16x8*)(P1 + (size_t)R * 1536 + ch);
        bf16x8 zp = {}, zn = {};
        if (hasp) zp = *(const bf16x8*)(P1 + (size_t)(R - 1) * 1536 + ch);
        if (hasn) zn = *(const bf16x8*)(P1 + (size_t)(R + 1) * 1536 + ch);
        float o[8]; float ss = 0.f;
#pragma unroll
        for (int j = 0; j < 8; ++j) { const float a = bf2f((bf16_t)zp[j]) * cw[ch + j] + bf2f((bf16_t)zc[j]) * cw[1536 + ch + j] + bf2f((bf16_t)zn[j]) * cw[3072 + ch + j];
          o[j] = siluf(a); ss += o[j] * o[j]; }
        if (part < 2) {
          ss += __shfl_xor(ss, 1); ss += __shfl_xor(ss, 2); ss += __shfl_xor(ss, 4); ss += __shfl_xor(ss, 8);
          float sc = rsqrtf(ss + EPSF); if (part == 0) sc *= 0.08838834764831845f;
#pragma unroll
          for (int j = 0; j < 8; ++j) o[j] *= sc;
        }
        u32x4 w = {cvtpk(o[0], o[1]), cvtpk(o[2], o[3]), cvtpk(o[4], o[5]), cvtpk(o[6], o[7])};
        bf16_t* dst = part == 0 ? QQ : (part == 1 ? QK : QV);
        *(u32x4*)(dst + (size_t)R * 512 + lane * 8) = w;
        if (part == 1) *(u32x4*)(kl + tl * 512 + lane * 8) = w;
      }
      if (lane < 16) {
        const int q = lane & 7;
        if (lane < 8) { const float da = SM[(size_t)R * 64 + q]; GB[(size_t)R * 16 + q] = -expf(p.dn_a_log[e * 8 + q]) * softplusf(da + p.dn_dt_bias[e * 8 + q]); }
        else { const float db = SM[(size_t)R * 64 + 8 + q]; GB[(size_t)R * 16 + 8 + q] = sigmf(db); }
      }
    }
    __syncthreads();
    {
      const int b = R0 >= TB ? 1 : 0, c = (R0 - b * TB) / 64; const int h = tid >> 7, dk = tid & 127;
      bf16_t* dst = KT + ((((size_t)b * 4 + h) * NCH + c) * 128 + dk) * 64;
#pragma unroll
      for (int g8 = 0; g8 < 8; ++g8) { unsigned w[4];
#pragma unroll
        for (int j = 0; j < 4; ++j) { const unsigned lo = kl[(g8 * 8 + 2 * j) * 512 + tid], hi2 = kl[(g8 * 8 + 2 * j + 1) * 512 + tid]; w[j] = lo | (hi2 << 16); }
        *(u32x4*)(dst + g8 * 8) = (u32x4){w[0], w[1], w[2], w[3]}; }
    }
    __syncthreads();
  }
}

__device__ __forceinline__ void ph_dn_d1(const P& p, char* lds) {
  const int tid = TIDX(), wid = tid >> 6, lane = tid & 63, r32 = lane & 31, hi = lane >> 5;
  const bf16_t* QQ = (const bf16_t*)(p.ws + OFF_D + D_QQ); const bf16_t* QK = (const bf16_t*)(p.ws + OFF_D + D_QK); const bf16_t* QV = (const bf16_t*)(p.ws + OFF_D + D_QV);
  const float* GB = (const float*)(p.ws + OFF_GB);
  bf16_t* W_ = (bf16_t*)(p.ws + OFF_D + D_W); bf16_t* U_ = (bf16_t*)(p.ws + OFF_HBF); bf16_t* INTRA = (bf16_t*)(p.ws + OFF_D + D_INTRA);
  float* SC = (float*)(p.ws + OFF_SC); float* GLS = (float*)(p.ws + OFF_GL);
  float* KK = (float*)lds; float* QKm = KK + 64 * 65; float* Ad = QKm + 64 * 65; float* Gs = Ad + 2 * 4096; float* Bs = Gs + 128;
  for (int job = BIDX(); job < 8 * NCH; job += GDIM()) {
    const int b = job / (4 * NCH), h = (job / NCH) & 3, c = job % NCH;
    const size_t Rb = (size_t)b * TB + (size_t)c * 64;
    {
      const int w4 = wid & 3, mi = w4 & 1, ni = w4 >> 1;
      const bf16_t* As = wid < 4 ? QK : QQ;
      const bf16_t* arow = As + (Rb + 32 * mi + r32) * 512 + h * 128 + hi * 8;
      const bf16_t* brow = QK + (Rb + 32 * ni + r32) * 512 + h * 128 + hi * 8;
      f32x16 acc = {}; acc = mma_rows<8>(arow, brow, acc);
      float* dst = wid < 4 ? KK : QKm;
#pragma unroll
      for (int r = 0; r < 16; ++r) dst[(32 * mi + crow(r, hi)) * 65 + 32 * ni + r32] = acc[r];
    }
    if (tid < 128) { const int d = tid >> 6, ip = tid & 63, t = d ? 63 - ip : ip; Gs[tid] = GB[(Rb + t) * 16 + d * 4 + h]; Bs[tid] = GB[(Rb + t) * 16 + 8 + d * 4 + h]; }
    __syncthreads();
    if (tid == 0 || tid == 64) { float s = 0.f; for (int i = 0; i < 64; ++i) { s += Gs[tid + i]; Gs[tid + i] = s; } }
    __syncthreads();
    const int n0 = c, n1 = c < 4 ? 3 - c : 135 - c;
    const size_t cj0 = ((size_t)(0 * 2 + b) * 4 + h) * NCH + n0, cj1 = ((size_t)(1 * 2 + b) * 4 + h) * NCH + n1;
    for (int e2 = tid; e2 < 8192; e2 += 512) {
      const int d = e2 >> 12, ip = (e2 >> 6) & 63, jp = e2 & 63; const int i = d ? 63 - ip : ip, j = d ? 63 - jp : jp;
      const float dec = jp <= ip ? expf(Gs[d * 64 + ip] - Gs[d * 64 + jp]) : 0.f;
      Ad[d * 4096 + ip * 64 + jp] = jp < ip ? Bs[d * 64 + ip] * KK[i * 65 + j] * dec : 0.f;
      const size_t cj = d ? cj1 : cj0;
      INTRA[(cj * 64 + ip) * 64 + jp] = f2bf(QKm[i * 65 + j] * dec);
    }
    if (tid < 128) { const int d = tid >> 6, ip = tid & 63; const size_t cj = d ? cj1 : cj0; const float gi = Gs[tid], gl = Gs[d * 64 + 63];
      SC[(cj * 64 + ip) * 2] = expf(gi); SC[(cj * 64 + ip) * 2 + 1] = expf(gl - gi); if (ip == 0) GLS[cj] = expf(gl); }
    __syncthreads();
    {
      const int d = tid >> 8, cc = tid & 255; const size_t cj = d ? cj1 : cj0;
      int dofs = d * 64, aofs = d * 4096; asm volatile("" : "+v"(dofs), "+v"(aofs));
      float x[64];
      {
        const bf16_t* srcb = (cc < 128 ? QV + h * 128 + cc : QK + h * 128 + (cc - 128)) + (Rb + (d ? 63 : 0)) * 512;
        const long step = d ? -512 : 512;
#pragma unroll
        for (int g = 0; g < 8; ++g) {
#pragma unroll
          for (int q8 = 0; q8 < 8; ++q8) { const int ip = g * 8 + q8; x[ip] = bf2f(srcb[ip * step]); }
          asm volatile("" ::: "memory");
        }
        if (cc < 128) {
#pragma unroll
          for (int ip = 0; ip < 64; ++ip) x[ip] *= Bs[dofs + ip];
        } else {
#pragma unroll
          for (int ip = 0; ip < 64; ++ip) x[ip] *= Bs[dofs + ip] * expf(Gs[dofs + ip]);
        }
      }
      const float* Arow = Ad + aofs;
#pragma unroll
      for (int ip = 1; ip < 64; ++ip) {
        float s = 0.f;
#pragma unroll
        for (int j4 = 0; j4 < (ip + 3) / 4; ++j4) { const f32x4 a = *(const f32x4*)(Arow + ip * 64 + 4 * j4);
          s += a[0] * x[4 * j4] + a[1] * x[4 * j4 + 1] + a[2] * x[4 * j4 + 2] + a[3] * x[4 * j4 + 3]; }
        x[ip] -= s;
      }
      bf16_t* dst = cc < 128 ? U_ + cj * 64 * 128 + cc : W_ + cj * 64 * 128 + (cc - 128);
#pragma unroll
      for (int ip = 0; ip < 64; ++ip) dst[ip * 128] = f2bf(x[ip]);
    }
    __syncthreads();
  }
}

typedef _Float16 h16x8 __attribute__((ext_vector_type(8)));
__device__ __forceinline__ void ph_gla_b(const P& p, char* lds, int e) {
  const int tid = TIDX(), wid = tid >> 6, lane = tid & 63;
  const float* SM = (const float*)(p.ws + OFF_SM);
  float* w2S = (float*)lds;
  float* b2S = w2S + 8192;
  for (int i = tid; i < 8192; i += 512) { const int d = i >> 12, hh = (i >> 10) & 3, r = (i >> 6) & 15, j = i & 63; w2S[i] = p.gla_w2[(((size_t)e * 2 + d) * 16 + r) * 256 + hh * 64 + j]; }
  if (tid < 512) b2S[tid] = p.gla_b2[(size_t)e * 512 + tid];
  __syncthreads();
  int jb = 8 * wid; asm volatile("" : "+v"(jb));
  for (int job = BIDX(); job < 16 * NCH; job += GDIM()) {
    const int n = job % NCH, sq = job / NCH; const int dir = sq >> 3, b = (sq >> 2) & 1, h = sq & 3;
    const int c = dir == 0 ? n : (n < 4 ? 3 - n : 135 - n);
    const size_t row = (size_t)b * TB + (size_t)c * 64 + (dir ? 63 - lane : lane);
    const float* gp = SM + row * 64 + 16 + dir * 16;
    const f32x4 g0 = *(const f32x4*)(gp), g1 = *(const f32x4*)(gp + 4), g2 = *(const f32x4*)(gp + 8), g3 = *(const f32x4*)(gp + 12);
    const float gg_[16] = {g0[0], g0[1], g0[2], g0[3], g1[0], g1[1], g1[2], g1[3], g2[0], g2[1], g2[2], g2[3], g3[0], g3[1], g3[2], g3[3]};
    const float* wb = w2S + (dir * 4 + h) * 1024 + jb; const float* bb2 = b2S + dir * 256 + h * 64 + jb;
    f32x4 sa = *(const f32x4*)(bb2), sb = *(const f32x4*)(bb2 + 4);
#pragma unroll
    for (int r = 0; r < 16; ++r) { const f32x4 wa = *(const f32x4*)(wb + r * 64), wq = *(const f32x4*)(wb + r * 64 + 4); sa += gg_[r] * wa; sb += gg_[r] * wq; }
    float la[8];
#pragma unroll
    for (int jj = 0; jj < 4; ++jj) { const float x0 = sa[jj], x1 = sb[jj];
      la[jj] = (fminf(x0, 0.f) - log1pf(expf(-fabsf(x0)))) * 0.0625f; la[4 + jj] = (fminf(x1, 0.f) - log1pf(expf(-fabsf(x1)))) * 0.0625f; }
#pragma unroll
    for (int o = 1; o < 64; o <<= 1) {
#pragma unroll
      for (int jj = 0; jj < 8; ++jj) { const float v = __shfl_up(la[jj], o); la[jj] += lane >= o ? v : 0.f; }
    }
    h16x8 hv;
#pragma unroll
    for (int jj = 0; jj < 8; ++jj) hv[jj] = (_Float16)la[jj];
    _Float16* dst = (_Float16*)(p.ws + (dir ? OFF_B16_1 : OFF_WC)) + ((((size_t)b * 4 + h) * NCH + n) * 64 + lane) * 64 + jb;
    *(h16x8*)dst = hv;
  }
}

struct DnSet { bf16x8 fa[8]; };
__device__ __forceinline__ void dn_scan(const P& p, char* lds, int job) {
  const int tid = TIDX(), wid = tid >> 6, lane = tid & 63, r32 = lane & 31, hi = lane >> 5;
  const int dir = job >> 5, b = (job >> 4) & 1, h = (job >> 2) & 3, n0 = (job & 3) * 32;
  const bf16_t* QQ = (const bf16_t*)(p.ws + OFF_D + D_QQ); const bf16_t* KT = (const bf16_t*)(p.ws + OFF_D + D_KT);
  const bf16_t* W_ = (const bf16_t*)(p.ws + OFF_D + D_W); const bf16_t* U_ = (const bf16_t*)(p.ws + OFF_HBF); const bf16_t* INTRA = (const bf16_t*)(p.ws + OFF_D + D_INTRA);
  const float* SC = (const float*)(p.ws + OFF_SC); const float* GLS = (const float*)(p.ws + OFF_GL);
  bf16_t* DNO = (bf16_t*)(p.ws + OFF_D + D_DNO);
  bf16_t* ST = (bf16_t*)lds; bf16_t* vTa = ST + 32 * 136; bf16_t* vTb = vTa + 32 * 72;
  float* scS = (float*)(vTb + 32 * 72);
  bf16_t* uS = (bf16_t*)(scS + 256);
  bf16_t* inS = uS + 2 * 64 * 40;
  for (int i = tid; i < 32 * 136; i += 512) ST[i] = 0;
  f32x16 accS = {};
  const size_t seq = ((size_t)dir * 2 + b) * 4 + h;
  const int mi = wid & 1, di = wid - 4;
  const int role = wid < 2 ? 0 : (wid < 4 ? 1 : 2);
  const int tt = tid - 256;
  DnSet sA, sB;
  u32x4 stU, stI0; float stS = 0.f, glA = 0.f, glB = 0.f;
#define DN_CH(n_) const int n__ = (n_); const int c__ = dir == 0 ? n__ : (n__ < 4 ? 3 - n__ : 135 - n__); const size_t Rb__ = (size_t)b * TB + (size_t)c__ * 64; const size_t cj__ = seq * NCH + n__;
#define DN_LOAD(S, GL, n_) do { DN_CH(n_) \
    const int ipl__ = 32 * mi + r32, tl__ = dir ? 63 - ipl__ : ipl__; \
    const bf16_t* b0__ = W_ + cj__ * 8192 + (32 * mi + r32) * 128 + hi * 8; \
    const bf16_t* b1__ = QQ + (Rb__ + tl__) * 512 + h * 128 + hi * 8; \
    const bf16_t* b2__ = KT + ((((size_t)b * 4 + h) * NCH + c__) * 128 + 32 * (wid & 3) + r32) * 64 + hi * 8; \
    const bf16_t* bs__ = role == 0 ? b0__ : (role == 1 ? b1__ : b2__); \
    _Pragma("unroll") for (int ks = 0; ks < 8; ++ks) S.fa[ks] = *(const bf16x8*)(bs__ + ks * 16); \
    GL = GLS[cj__]; } while (0)
#define DN_STAGE_LD(n_) do { DN_CH(n_) (void)Rb__; \
      stU = *(const u32x4*)(U_ + cj__ * 8192 + ((tid & 255) >> 2) * 128 + n0 + (tid & 3) * 8); \
      stI0 = *(const u32x4*)(INTRA + cj__ * 4096 + (tid >> 3) * 64 + (tid & 7) * 8); \
      stS = SC[cj__ * 128 + (tid & 127)]; } while (0)
#define DN_STAGE_ST(bf_) do { *(u32x4*)(inS + (bf_) * 4608 + (tid >> 3) * 72 + (tid & 7) * 8) = stI0; \
      if (tid < 256) *(u32x4*)(uS + (bf_) * 2560 + (tid >> 2) * 40 + (tid & 3) * 8) = stU; \
      if (tid < 128) scS[(bf_) * 128 + tid] = stS; } while (0)
#define DN_STEP(S, GL, n_, bf_) do { DN_CH(n_) (void)cj__; \
    const float* sc__ = scS + (bf_) * 128; \
    f32x16 acc = {}; \
    if (role < 2) { const bf16_t* sb__ = ST + r32 * 136 + hi * 8; \
      _Pragma("unroll") for (int ks = 0; ks < 8; ++ks) acc = MFMA32(S.fa[ks], *(const bf16x8*)(sb__ + ks * 16), acc); \
      if (role == 0) { const bf16_t* us__ = uS + (bf_) * 2560 + r32; \
        _Pragma("unroll") for (int r = 0; r < 16; ++r) { const int ip = 32 * mi + crow(r, hi); const float vn = bf2f(us__[ip * 40]) - acc[r]; \
          vTa[r32 * 72 + ip] = f2bf(vn); const int to = dir ? 63 - ip : ip; vTb[r32 * 72 + to] = f2bf(vn * sc__[ip * 2 + 1]); } } \
      else { _Pragma("unroll") for (int r = 0; r < 16; ++r) acc[r] *= sc__[(32 * mi + crow(r, hi)) * 2]; } } \
    LBAR(); \
    if (role == 1) { const bf16_t* vb__ = vTa + r32 * 72 + hi * 8; const bf16_t* ib__ = inS + (bf_) * 4608 + (32 * mi + r32) * 72 + hi * 8; \
      _Pragma("unroll") for (int ks = 0; ks < 4; ++ks) acc = MFMA32(*(const bf16x8*)(ib__ + ks * 16), *(const bf16x8*)(vb__ + ks * 16), acc); \
      _Pragma("unroll") for (int r = 0; r < 16; ++r) { const int ip = 32 * mi + crow(r, hi), t = dir ? 63 - ip : ip; \
        DNO[((size_t)dir * MROWS + Rb__ + t) * 512 + h * 128 + n0 + r32] = f2bf(acc[r]); } } \
    else if (role == 2) { const bf16_t* vb__ = vTb + r32 * 72 + hi * 8; \
      _Pragma("unroll") for (int r = 0; r < 16; ++r) accS[r] *= GL; \
      _Pragma("unroll") for (int ks = 0; ks < 4; ++ks) accS = MFMA32(S.fa[ks], *(const bf16x8*)(vb__ + ks * 16), accS); \
      _Pragma("unroll") for (int r = 0; r < 16; ++r) ST[r32 * 136 + 32 * di + crow(r, hi)] = f2bf(accS[r]); } \
    DN_STAGE_ST((bf_) ^ 1); \
    LBAR(); } while (0)
  DN_STAGE_LD(0); DN_STAGE_ST(0);
  DN_LOAD(sA, glA, 0);
  __syncthreads();
  for (int n = 0; n < NCH; n += 2) {
    DN_LOAD(sB, glB, n + 1); DN_STAGE_LD(n + 1);
    DN_STEP(sA, glA, n, 0);
    { const int n2 = n + 2 < NCH ? n + 2 : NCH - 1; DN_LOAD(sA, glA, n2); DN_STAGE_LD(n2); }
    DN_STEP(sB, glB, n + 1, 1);
  }
#undef DN_CH
#undef DN_LOAD
#undef DN_STAGE_LD
#undef DN_STAGE_ST
#undef DN_STEP
}

DI float fast_logsig(float s) { return fminf(s, 0.f) - __logf(1.f + __expf(-fabsf(s))); }
struct GlaRegs { h16x8 ba, bb; bf16x8 qa, qb, ka, kb, v8; };
__device__ __forceinline__ void gla_scan(const P& p, char* lds, int job, int e) {
  const int tid = TIDX(), wid = tid >> 6, lane = tid & 63, r32 = lane & 31, hi = lane >> 5;
  const int dir = job >> 5, b = (job >> 4) & 1, h = (job >> 2) & 3, n0 = (job & 3) * 32;
  const bf16_t* P2 = (const bf16_t*)(p.ws + OFF_D + D_P2); const float* SM = (const float*)(p.ws + OFF_SM);
  bf16_t* GLAO = (bf16_t*)(p.ws + OFF_D + D_GLAO);
  const _Float16* B16 = (const _Float16*)(p.ws + (dir ? OFF_B16_1 : OFF_WC));
  float* w2S = (float*)lds; float* b2S = w2S + 1024; float* aLb = b2S + 64;
  bf16_t* ops = (bf16_t*)(aLb + 128);
  constexpr int OPB = (4 * 64 + 32) * 72;
  bf16_t* attp = ops + 2 * OPB;
  bf16_t* STb = attp + 2 * 32 * 72;
  for (int i = tid; i < 2 * 32 * 72; i += 512) STb[i] = 0;
  f32x16 accS = {};
  __syncthreads();
  GlaRegs RA;
  int jb0 = 16 * (wid & 3); asm volatile("" : "+v"(jb0));
  int vtb0 = 8 * (wid & 3) * 72 + lane; asm volatile("" : "+v"(vtb0));
#define GLA_LOAD(R, n_) do { const int n__ = (n_) < NCH ? (n_) : NCH - 1; const int c__ = dir == 0 ? n__ : (n__ < 4 ? 3 - n__ : 135 - n__); const size_t row__ = (size_t)b * TB + (size_t)c__ * 64 + (dir ? 63 - lane : lane); \
    const _Float16* bp__ = B16 + ((((size_t)b * 4 + h) * NCH + n__) * 64 + lane) * 64 + 16 * (wid & 3); R.ba = *(const h16x8*)(bp__); R.bb = *(const h16x8*)(bp__ + 8); \
    const bf16_t* pr__ = P2 + row__ * 2048; R.qa = *(const bf16x8*)(pr__ + 512 + h * 64 + 16 * (wid & 3)); R.qb = *(const bf16x8*)(pr__ + 512 + h * 64 + 16 * (wid & 3) + 8); \
    R.ka = *(const bf16x8*)(pr__ + 768 + h * 64 + 16 * (wid & 3)); R.kb = *(const bf16x8*)(pr__ + 768 + h * 64 + 16 * (wid & 3) + 8); R.v8 = *(const bf16x8*)(pr__ + 1024 + h * 128 + n0 + 8 * (wid & 3)); } while (0)
#define GLA_HALF(R, BV, QV, KV, jb) do { \
    float eqe[8], eke[8], eqi[8]; \
    _Pragma("unroll") for (int jj = 0; jj < 8; ++jj) { const int j = (jb) + jj; const float bb = (float)BV[jj]; const float bm = __int_as_float(__builtin_amdgcn_readlane(__float_as_int(bb), 32)), bl = __int_as_float(__builtin_amdgcn_readlane(__float_as_int(bb), 63)); \
      const float q_ = bf2f((bf16_t)QV[jj]) * 0.125f, k_ = bf2f((bf16_t)KV[jj]); \
      eqe[jj] = q_ * __expf(bb - bm); eke[jj] = k_ * __expf(bm - bb); eqi[jj] = q_ * __expf(bb); ksT_[j * 72 + lane] = f2bf(k_ * __expf(bl - bb)); if (lane == 63) aL_[j] = __expf(bl); } \
    *(u32x4*)(qe_ + lane * 72 + (jb)) = (u32x4){cvtpk(eqe[0], eqe[1]), cvtpk(eqe[2], eqe[3]), cvtpk(eqe[4], eqe[5]), cvtpk(eqe[6], eqe[7])}; \
    *(u32x4*)(ke_ + lane * 72 + (jb)) = (u32x4){cvtpk(eke[0], eke[1]), cvtpk(eke[2], eke[3]), cvtpk(eke[4], eke[5]), cvtpk(eke[6], eke[7])}; \
    *(u32x4*)(qi_ + lane * 72 + (jb)) = (u32x4){cvtpk(eqi[0], eqi[1]), cvtpk(eqi[2], eqi[3]), cvtpk(eqi[4], eqi[5]), cvtpk(eqi[6], eqi[7])}; } while (0)
#define GLA_PREP(R, bf_) do { bf16_t* qe_ = ops + (bf_) * OPB; bf16_t* ke_ = qe_ + 64 * 72; bf16_t* qi_ = ke_ + 64 * 72; bf16_t* ksT_ = qi_ + 64 * 72; bf16_t* vT_ = ksT_ + 64 * 72; float* aL_ = aLb + (bf_) * 64; \
    GLA_HALF(R, R.ba, R.qa, R.ka, jb0); GLA_HALF(R, R.bb, R.qb, R.kb, jb0 + 8); \
    _Pragma("unroll") for (int q_ = 0; q_ < 8; ++q_) vT_[vtb0 + q_ * 72] = (bf16_t)R.v8[q_]; } while (0)
#define GLA_MMA(n_, bf_) do { const int nq__ = (n_); const int bf = (bf_); \
      const bf16_t* qe_ = ops + bf * OPB; const bf16_t* ke_ = qe_ + 64 * 72; const bf16_t* qi_ = ke_ + 64 * 72; const bf16_t* ksT_ = qi_ + 64 * 72; const bf16_t* vT_ = ksT_ + 64 * 72; const float* aL_ = aLb + bf * 64; \
      const bf16_t* STr = STb + bf * 32 * 72; bf16_t* STw = STb + (bf ^ 1) * 32 * 72; \
      if (wid < 6) { \
        const int mi = wid - 4; bf16_t* attw = attp + mi * 32 * 72; \
        const int c = dir == 0 ? nq__ : (nq__ < 4 ? 3 - nq__ : 135 - nq__); const size_t Rb = (size_t)b * TB + (size_t)c * 64; \
        f32x16 acc = {}; acc = mma_rows<4>(qi_ + (32 * mi + r32) * 72 + hi * 8, STr + r32 * 72 + hi * 8, acc); \
        { f32x16 a0 = {}; a0 = mma_rows<4>(qe_ + (32 * mi + r32) * 72 + hi * 8, ke_ + r32 * 72 + hi * 8, a0); \
          _Pragma("unroll") for (int r = 0; r < 16; ++r) { const int ipl = crow(r, hi); attw[ipl * 72 + r32] = f2bf((mi == 1 || r32 <= ipl) ? a0[r] : 0.f); } \
          f32x16 a1 = {}; if (mi == 1) a1 = mma_rows<4>(qe_ + (32 + r32) * 72 + hi * 8, ke_ + (32 + r32) * 72 + hi * 8, a1); \
          _Pragma("unroll") for (int r = 0; r < 16; ++r) { const int ipl = crow(r, hi); attw[ipl * 72 + 32 + r32] = f2bf((mi == 1 && r32 <= ipl) ? a1[r] : 0.f); } } \
        asm volatile("s_waitcnt lgkmcnt(0)" ::: "memory"); \
        acc = mma_rows<4>(attw + r32 * 72 + hi * 8, vT_ + r32 * 72 + hi * 8, acc); \
        _Pragma("unroll") for (int r = 0; r < 16; ++r) { const int ip = 32 * mi + crow(r, hi), t = dir ? 63 - ip : ip; \
          GLAO[((size_t)dir * MROWS + Rb + t) * 512 + h * 128 + n0 + r32] = f2bf(acc[r]); } \
      } else { \
        const int di = wid - 6; \
        _Pragma("unroll") for (int r = 0; r < 16; ++r) accS[r] *= aL_[32 * di + crow(r, hi)]; \
        accS = mma_rows<4>(ksT_ + (32 * di + r32) * 72 + hi * 8, vT_ + r32 * 72 + hi * 8, accS); \
        _Pragma("unroll") for (int r = 0; r < 16; ++r) STw[r32 * 72 + 32 * di + crow(r, hi)] = f2bf(accS[r]); \
      } } while (0)
  GLA_LOAD(RA, 0);
  if (wid < 4) { GLA_PREP(RA, 0); }
  GLA_LOAD(RA, 1);
  LBAR();
  for (int n = 0; n < NCH; n += 2) {
    if (wid < 4) { GLA_PREP(RA, 1); } else { GLA_MMA(n, 0); }
    GLA_LOAD(RA, n + 2);
    LBAR();
    if (wid < 4) { if (n + 2 < NCH) { GLA_PREP(RA, 0); } } else { GLA_MMA(n + 1, 1); }
    GLA_LOAD(RA, n + 3);
    LBAR();
  }
#undef GLA_MMA
#undef GLA_LOAD
#undef GLA_HALF
#undef GLA_PREP
}

__device__ __forceinline__ void ph_merge(const P& p, int e) {
  const int tid = TIDX(), wid = tid >> 6, lane = tid & 63, l16 = lane & 15, sub = lane >> 4;
  const bf16_t* DNO = (const bf16_t*)(p.ws + OFF_D + D_DNO); const bf16_t* GLAO = (const bf16_t*)(p.ws + OFF_D + D_GLAO);
  const bf16_t* P2 = (const bf16_t*)(p.ws + OFF_D + D_P2); bf16_t* hb = (bf16_t*)(p.ws + OFF_HBF);
  f32x8 nwd = *(const f32x8*)(p.dn_norm + e * 128 + l16 * 8), nwg = *(const f32x8*)(p.gla_norm + e * 128 + l16 * 8);
  for (int R4 = (BIDX() * 8 + wid) * 4; R4 < MROWS; R4 += GDIM() * 32) {
    const size_t R = R4 + sub;
    bf16x8 a[8], bq[8], zz[8];
#pragma unroll
    for (int g = 0; g < 8; ++g) { const bf16_t* src = g < 4 ? DNO : GLAO; const int hc = (g & 3) * 128 + l16 * 8;
      a[g] = *(const bf16x8*)(src + R * 512 + hc); bq[g] = *(const bf16x8*)(src + ((size_t)MROWS + R) * 512 + hc);
      zz[g] = *(const bf16x8*)(P2 + R * 2048 + (g < 4 ? 0 : 1536) + hc); }
#pragma unroll
    for (int g = 0; g < 8; ++g) {
      float v[8]; float ss = 0.f;
#pragma unroll
      for (int j = 0; j < 8; ++j) { v[j] = bf2f((bf16_t)a[g][j]) + bf2f((bf16_t)bq[g][j]); ss += v[j] * v[j]; }
      ss += __shfl_xor(ss, 1); ss += __shfl_xor(ss, 2); ss += __shfl_xor(ss, 4); ss += __shfl_xor(ss, 8);
      const float rs = rsqrtf(ss * (1.f / 128.f) + EPSF);
      float o[8];
#pragma unroll
      for (int j = 0; j < 8; ++j) o[j] = v[j] * rs * (g < 4 ? nwd[j] : nwg[j]) * siluf(bf2f((bf16_t)zz[g][j]));
      *(u32x4*)(hb + R * 1024 + g * 128 + l16 * 8) = (u32x4){cvtpk(o[0], o[1]), cvtpk(o[2], o[3]), cvtpk(o[4], o[5]), cvtpk(o[6], o[7])};
    }
  }
}

__device__ __forceinline__ void ph_ffnact(const P& p, int L) {
  bf16_t* U = (bf16_t*)(p.ws + OFF_D);
  const float* cw = p.ffn_conv + (size_t)L * 3 * DFF;
  const size_t items = (size_t)MROWS * 352;
  for (size_t it = (size_t)BIDX() * 512 + TIDX(); it < items; it += (size_t)GDIM() * 512) {
    const int R = (int)(it / 352), c0 = (int)(it % 352) * 8; const int b = R >= TB ? 1 : 0, pp = R - b * TB;
    const bool hasp = !(pp == 0 || pp == CTXL), hasn = !(pp == CTXL - 1 || pp == TB - 1);
    const bf16x8 zc = *(const bf16x8*)(U + (size_t)R * 5632 + c0); bf16x8 zp = {}, zn = {};
    if (hasp) zp = *(const bf16x8*)(U + (size_t)(R - 1) * 5632 + c0);
    if (hasn) zn = *(const bf16x8*)(U + (size_t)(R + 1) * 5632 + c0);
    const bf16x8 vv = *(const bf16x8*)(U + (size_t)R * 5632 + DFF + c0);
    float o[8];
#pragma unroll
    for (int j = 0; j < 8; ++j) { const float a = bf2f((bf16_t)zp[j]) * cw[c0 + j] + bf2f((bf16_t)zc[j]) * cw[DFF + c0 + j] + bf2f((bf16_t)zn[j]) * cw[2 * DFF + c0 + j];
      o[j] = siluf(a) * bf2f((bf16_t)vv[j]); }
    u32x4 w = {cvtpk(o[0], o[1]), cvtpk(o[2], o[3]), cvtpk(o[4], o[5]), cvtpk(o[6], o[7])};
    *(u32x4*)(U + (size_t)R * 5632 + DFF + c0) = w;
  }
}

__device__ __forceinline__ void ph_qknorm(const P& p, char* lds, int o) {
  const int tid = TIDX(), wid = tid >> 6, lane = tid & 63, l16 = lane & 15, sub = lane >> 4;
  bf16_t* QKV = (bf16_t*)(p.ws + OFF_D);
  float* tab = (float*)lds;
  for (int i = tid; i < 4096; i += 512) { const int pos = i >> 5, f = i & 31; const float ang = (float)pos * powf(10000.f, -(float)f / 32.f); tab[2 * i] = cosf(ang); tab[2 * i + 1] = sinf(ang); }
  __syncthreads();
  const f32x8 qn = *(const f32x8*)(p.att_q_norm + o * 128 + l16 * 8), kn = *(const f32x8*)(p.att_k_norm + o * 128 + l16 * 8);
  const int f0 = (l16 & 3) * 8;
  for (int R4 = (BIDX() * 8 + wid) * 4; R4 < MROWS; R4 += GDIM() * 32) {
    const int R = R4 + sub; const int b = R >= TB ? 1 : 0, pp = R - b * TB; const bool lat = pp >= CTXL; const int t = lat ? pp - CTXL : 0;
    const int pos = (l16 < 8) ? (t >> 6) : (t & 63);
    bf16_t* base = QKV + (size_t)R * 1536 + l16 * 8;
    bf16x8 x[10];
#pragma unroll
    for (int hd = 0; hd < 10; ++hd) x[hd] = *(const bf16x8*)(base + hd * 128);
    float cs[8], sn[8];
#pragma unroll
    for (int j = 0; j < 8; ++j) { const float2 t2 = *(const float2*)(tab + 2 * (pos * 32 + f0 + j)); cs[j] = lat ? t2.x : 1.f; sn[j] = lat ? t2.y : 0.f; }
#pragma unroll
    for (int hd = 0; hd < 10; ++hd) {
      float v[8]; float ss = 0.f;
#pragma unroll
      for (int j = 0; j < 8; ++j) { v[j] = bf2f((bf16_t)x[hd][j]); ss += v[j] * v[j]; }
      ss += __shfl_xor(ss, 1); ss += __shfl_xor(ss, 2); ss += __shfl_xor(ss, 4); ss += __shfl_xor(ss, 8);
      const float rs = rsqrtf(ss * (1.f / 128.f) + EPSF);
      float ov[8];
#pragma unroll
      for (int j = 0; j < 8; ++j) { v[j] = v[j] * rs * (hd < 8 ? qn[j] : kn[j]); const float pr = __shfl_xor(v[j], 4);
        ov[j] = (l16 & 4) ? (pr * sn[j] + v[j] * cs[j]) : (v[j] * cs[j] - pr * sn[j]); }
      *(u32x4*)(base + hd * 128) = (u32x4){cvtpk(ov[0], ov[1]), cvtpk(ov[2], ov[3]), cvtpk(ov[4], ov[5]), cvtpk(ov[6], ov[7])};
    }
  }
}

namespace at {
constexpr int D = 128, NW = 8, QBLK = 32, KVBLK = 64;
constexpr float SCALE = 0.088388347648318440f, THR = 8.f;
constexpr int LDQ = 1536, LDK = 1536, LDO = 1024;
constexpr size_t SHM_V = KVBLK * D * 2, SHM_K = KVBLK * D * 2;
#define KSWZ(row, colB) ((row) * 256 + ((colB) ^ (((row) & 7) << 4)))
#define SBAR() __builtin_amdgcn_sched_barrier(0)
DI void partialSM(f32x16& p0, f32x16& p1, float& m_reg, float& mn, float& alpha) {
  constexpr float C = SCALE * 1.4426950408889634f;
  float pmax = p0[0]; for (int r = 1; r < 16; ++r) pmax = fmaxf(pmax, p0[r]); for (int r = 0; r < 16; ++r) pmax = fmaxf(pmax, p1[r]);
  { auto rr = __builtin_amdgcn_permlane32_swap(__float_as_uint(pmax), __float_as_uint(pmax), false, false);
    pmax = fmaxf(__uint_as_float(rr[0]), __uint_as_float(rr[1])); }
  if (__builtin_expect(__all(pmax - m_reg <= THR / SCALE), 1)) { mn = m_reg; alpha = 1.f; }
  else { mn = fmaxf(m_reg, pmax); alpha = __builtin_amdgcn_exp2f((m_reg - mn) * C); m_reg = mn; }
  float mnC = -mn * C;
  for (int r = 0; r < 16; ++r) p0[r] = fmaf(p0[r], C, mnC); for (int r = 0; r < 16; ++r) p1[r] = fmaf(p1[r], C, mnC);
  for (int r = 0; r < 16; ++r) p0[r] = __builtin_amdgcn_exp2f(p0[r]);
}
DI void finishSM(f32x16& p0, f32x16& p1, float alpha, float& l_reg, bf16x8& pa0, bf16x8& pa1, bf16x8& pa2, bf16x8& pa3) {
  for (int r = 0; r < 16; ++r) p1[r] = __builtin_amdgcn_exp2f(p1[r]);
  float ps = 0; for (int r = 0; r < 16; ++r) ps += p0[r]; for (int r = 0; r < 16; ++r) ps += p1[r];
  { auto rr = __builtin_amdgcn_permlane32_swap(__float_as_uint(ps), __float_as_uint(ps), false, false);
    ps = __uint_as_float(rr[0]) + __uint_as_float(rr[1]); }
  l_reg = l_reg * alpha + ps;
#define PK4(PP, BASE, OUT) do { unsigned a0 = cvtpk(PP[BASE + 0], PP[BASE + 1]), a1 = cvtpk(PP[BASE + 2], PP[BASE + 3]);   \
    unsigned b0 = cvtpk(PP[BASE + 4], PP[BASE + 5]), b1 = cvtpk(PP[BASE + 6], PP[BASE + 7]);                              \
    auto r0 = __builtin_amdgcn_permlane32_swap(a0, b0, false, false); auto r1 = __builtin_amdgcn_permlane32_swap(a1, b1, false, false); \
    u32x4 w = {r0[0], r1[0], r0[1], r1[1]}; OUT = *reinterpret_cast<bf16x8*>(&w); } while (0)
  PK4(p0, 0, pa0); PK4(p0, 8, pa1); PK4(p1, 0, pa2); PK4(p1, 8, pa3);
#undef PK4
}
DI void qkt(f32x16& p0, f32x16& p1, const bf16_t* Ks, const bf16x8* qr, int r32, int hi) {
  p0 = f32x16{}; p1 = f32x16{};
  for (int d0 = 0; d0 < 8; ++d0) { int cb = (d0 * 16 + hi * 8) * 2;
    bf16x8 b0 = *reinterpret_cast<const bf16x8*>((const char*)Ks + KSWZ(r32, cb));
    bf16x8 b1 = *reinterpret_cast<const bf16x8*>((const char*)Ks + KSWZ(32 + r32, cb));
    p0 = MFMA32(b0, qr[d0], p0);
    p1 = MFMA32(b1, qr[d0], p1); }
}
DI int v_st(int k, int c) { const int kk = (k & ~0xC) | ((k & 4) << 1) | ((k & 8) >> 1); return ((kk >> 3) * 4 + (c >> 5)) * 512 + ((kk & 7) * 32 + (c & 31)) * 2; }
DI int v_rd_base(int lane) { return ((lane & 3) << 3) | (((lane >> 2) & 3) << 6) | (((lane >> 4) & 1) << 5) | (((lane >> 5) & 1) << 8); }
constexpr int v_rd_off(int d0, int ks, int half) { return d0 * 512 + ks * 4096 + half * 2048; }
template <int OFF> DI s16x4 tr_read(int vb) {
  s16x4 r; asm volatile("ds_read_b64_tr_b16 %0, %1 offset:%2" : "=&v"(r) : "v"(vb), "i"(OFF) : "memory"); return r;
}
template <int D0> DI void pv_one(f32x16& od, int vb, bf16x8 pa0, bf16x8 pa1, bf16x8 pa2, bf16x8 pa3) {
  const s16x4 l0 = tr_read<v_rd_off(D0, 0, 0)>(vb), h0 = tr_read<v_rd_off(D0, 0, 1)>(vb), l1 = tr_read<v_rd_off(D0, 1, 0)>(vb), h1 = tr_read<v_rd_off(D0, 1, 1)>(vb);
  const s16x4 l2 = tr_read<v_rd_off(D0, 2, 0)>(vb), h2 = tr_read<v_rd_off(D0, 2, 1)>(vb), l3 = tr_read<v_rd_off(D0, 3, 0)>(vb), h3 = tr_read<v_rd_off(D0, 3, 1)>(vb);
  asm volatile("s_waitcnt lgkmcnt(0)" ::: "memory"); SBAR();
#define PK(Lx, Hx) (bf16x8){Lx[0], Lx[1], Lx[2], Lx[3], Hx[0], Hx[1], Hx[2], Hx[3]}
  od = MFMA32(pa0, PK(l0, h0), od);
  od = MFMA32(pa1, PK(l1, h1), od);
  od = MFMA32(pa2, PK(l2, h2), od);
  od = MFMA32(pa3, PK(l3, h3), od);
#undef PK
}
DI void pv_d0(f32x16* o, int vb, bf16x8 pa0, bf16x8 pa1, bf16x8 pa2, bf16x8 pa3) {
  pv_one<0>(o[0], vb, pa0, pa1, pa2, pa3); pv_one<1>(o[1], vb, pa0, pa1, pa2, pa3); pv_one<2>(o[2], vb, pa0, pa1, pa2, pa3); pv_one<3>(o[3], vb, pa0, pa1, pa2, pa3);
}
DI void attn_dense_body(const bf16_t* __restrict__ Qb, const bf16_t* __restrict__ Kh, const bf16_t* __restrict__ Vh, bf16_t* __restrict__ Ob, int seq, char* lds) {
  const int tid = TIDX(), wid = tid >> 6, lane = tid & 63, r32 = lane & 31, hi = lane >> 5;
  bf16_t* V_lds = (bf16_t*)lds; bf16_t* K_lds = (bf16_t*)(lds + 2 * SHM_V);
  float* ws = (float*)(lds + 2 * SHM_V + 2 * SHM_K) + wid * 64; float* li_l = ws; float* al_l = ws + 32;
  float m_reg = -1e30f, l_reg = 0; f32x16 o[4] = {}; bf16x8 qr[8];
  const bf16_t* Qw = Qb + (long)(wid * QBLK + r32) * LDQ + hi * 8;
#pragma unroll
  for (int d0 = 0; d0 < 8; ++d0) qr[d0] = *reinterpret_cast<const bf16x8*>(Qw + d0 * 16);
  const int sr = tid >> 4, sc = (tid & 15) * 8, vst0 = v_st(sr, sc), vst1 = v_st(32 + sr, sc);
  const int vb0 = (int)(uintptr_t)V_lds + v_rd_base(lane);
  struct { bf16x8 vs0, vs1, ks0, ks1; } sr_[2];
#define SLOAD(i, k0) do { sr_[i].vs0 = *(const bf16x8*)(&Vh[(long)((k0) + sr) * LDK + sc]); sr_[i].vs1 = *(const bf16x8*)(&Vh[(long)((k0) + 32 + sr) * LDK + sc]); \
    sr_[i].ks0 = *(const bf16x8*)(&Kh[(long)((k0) + sr) * LDK + sc]); sr_[i].ks1 = *(const bf16x8*)(&Kh[(long)((k0) + 32 + sr) * LDK + sc]); } while (0)
#define SWRITE(bq, i) do { *(bf16x8*)((char*)V_lds + (bq) * SHM_V + vst0) = sr_[i].vs0;          \
    *(bf16x8*)((char*)V_lds + (bq) * SHM_V + vst1) = sr_[i].vs1; int kc = sc * 2;               \
    *(bf16x8*)((char*)K_lds + (bq) * SHM_K + KSWZ(sr, kc)) = sr_[i].ks0;                       \
    *(bf16x8*)((char*)K_lds + (bq) * SHM_K + KSWZ(32 + sr, kc)) = sr_[i].ks1; } while (0)
#define SWAIT() asm volatile("s_waitcnt vmcnt(4)" ::: "memory")
#define RESC(a) do { if (__any((a) < 1.f)) { if (hi == 0) al_l[r32] = (a); asm volatile("s_waitcnt lgkmcnt(0)" ::: "memory"); \
    for (int d = 0; d < 4; ++d) for (int r = 0; r < 16; ++r) o[d][r] *= al_l[crow(r, hi)]; } } while (0)
  f32x16 pA0, pA1, pB0, pB1; float mnA, mnB, alA, alB; bf16x8 pa0, pa1, pa2, pa3; const int NT = seq / KVBLK;
  constexpr int SE = 0, SO = 1;
  SLOAD(SE, 0); asm volatile("s_waitcnt vmcnt(0)" ::: "memory"); SWRITE(0, SE); __syncthreads();
  qkt(pA0, pA1, K_lds, qr, r32, hi); partialSM(pA0, pA1, m_reg, mnA, alA);
  SLOAD(SO, KVBLK); if (2 < NT) SLOAD(SE, 2 * KVBLK);
  SWAIT(); SWRITE(1, SO); __syncthreads();
  for (int j = 1; j + 1 < NT; j += 2) {
    SBAR(); qkt(pB0, pB1, (bf16_t*)((char*)K_lds + SHM_K), qr, r32, hi);
    finishSM(pA0, pA1, alA, l_reg, pa0, pa1, pa2, pa3); SBAR();
    SLOAD(SO, (j + 2) * KVBLK); SBAR();
    pv_d0(o, vb0, pa0, pa1, pa2, pa3); partialSM(pB0, pB1, m_reg, mnB, alB);
    __syncthreads(); SWAIT(); SWRITE(0, SE);
    RESC(alB); __syncthreads();
    SBAR(); qkt(pA0, pA1, K_lds, qr, r32, hi);
    finishSM(pB0, pB1, alB, l_reg, pa0, pa1, pa2, pa3); SBAR();
    if (j + 3 < NT) SLOAD(SE, (j + 3) * KVBLK); SBAR();
    pv_d0(o, vb0 + (int)SHM_V, pa0, pa1, pa2, pa3); partialSM(pA0, pA1, m_reg, mnA, alA);
    __syncthreads(); SWAIT(); SWRITE(1, SO);
    RESC(alA); __syncthreads();
  }
  SBAR(); qkt(pB0, pB1, (bf16_t*)((char*)K_lds + SHM_K), qr, r32, hi);
  finishSM(pA0, pA1, alA, l_reg, pa0, pa1, pa2, pa3); SBAR();
  pv_d0(o, vb0, pa0, pa1, pa2, pa3); partialSM(pB0, pB1, m_reg, mnB, alB);
  __syncthreads(); RESC(alB);
  finishSM(pB0, pB1, alB, l_reg, pa0, pa1, pa2, pa3); SBAR();
  pv_d0(o, vb0 + (int)SHM_V, pa0, pa1, pa2, pa3);
  if (hi == 0) li_l[r32] = l_reg; asm volatile("s_waitcnt lgkmcnt(0)" ::: "memory");
  float rli[16];
#pragma unroll
  for (int r = 0; r < 16; ++r) rli[r] = __builtin_amdgcn_rcpf(li_l[crow(r, hi)]);
  bf16_t* Ow = Ob + (long)(wid * QBLK) * LDO;
#pragma unroll
  for (int r = 0; r < 16; ++r) { int orow = crow(r, hi);
    for (int d0 = 0; d0 < 4; ++d0) Ow[(long)orow * LDO + d0 * 32 + r32] = f2bf(o[d0][r] * rli[r]); }
#undef SLOAD
#undef SWRITE
#undef SWAIT
#undef RESC
}
}

__device__ __forceinline__ void ph_attn(const P& p, char* lds, bool need_ctx) {
  const bf16_t* QKV = (const bf16_t*)(p.ws + OFF_D); bf16_t* hb = (bf16_t*)(p.ws + OFF_HBF);
  const int nunits = need_ctx ? 528 : 512;
  for (int u = BIDX(); u < nunits; u += GDIM()) {
    int b, h, seq; size_t qrow;
    if (u < 512) { b = u >> 8; const int rem = u & 255; h = rem >> 5; qrow = (size_t)b * TB + CTXL + (size_t)(rem & 31) * 256; seq = TB; }
    else { const int uu = u - 512; b = uu >> 3; h = uu & 7; qrow = (size_t)b * TB; seq = CTXL; }
    const int kvh = h >> 2;
    const bf16_t* Kh = QKV + (size_t)b * TB * 1536 + 1024 + kvh * 128;
    const bf16_t* Vh = QKV + (size_t)b * TB * 1536 + 1280 + kvh * 128;
    at::attn_dense_body(QKV + qrow * 1536 + h * 128, Kh, Vh, hb + qrow * 1024 + h * 128, seq, lds);
    __syncthreads();
  }
}

__device__ __forceinline__ void ph_final(const P& p) {
  const int tid = TIDX(), wid = tid >> 6, lane = tid & 63;
  const float* xr = (const float*)(p.ws + OFF_XRES);
  for (int q = BIDX() * 8 + wid; q < 2 * LAT; q += GDIM() * 8) {
    const int b = q >> 13, t = q & (LAT - 1); const float* row = xr + ((size_t)b * TB + CTXL + t) * 1024;
    f32x4 v[4]; float ss = 0.f;
#pragma unroll
    for (int i = 0; i < 4; ++i) { v[i] = *(const f32x4*)(row + i * 256 + lane * 4); ss += v[i][0] * v[i][0] + v[i][1] * v[i][1] + v[i][2] * v[i][2] + v[i][3] * v[i][3]; }
    ss = wave_sum(ss); const float rs = rsqrtf(ss * (1.f / 1024.f) + EPSF);
#pragma unroll
    for (int i = 0; i < 4; ++i) { const int c0 = i * 256 + lane * 4; const f32x4 g = *(const f32x4*)(p.final_norm + c0); f32x4 o = v[i] * rs * g; *(f32x4*)(p.out + (size_t)q * 1024 + c0) = o; }
  }
}

constexpr int NPHASES = 42;
#ifndef ONLY_PH
#define ONLY_PH -1
#endif
#define EN(x) (ONLY_PH < 0 || ONLY_PH == (x))
#ifndef PROBE_REP
#define PROBE_REP -1
#endif
#define RUN(cls, ...) do { if (EN(cls)) { for (int rep_ = 0; rep_ < ((PROBE_REP == (cls)) ? 2 : 1); ++rep_) { if (rep_) xcd_barrier(*xbp); __VA_ARGS__; } } } while (0)
__device__ __forceinline__ void run_phase(const P& p0, int ph, char* lds, const XcdBarrier* xbp) {
  P p = p0; asm volatile("" : "+s"(p.ws));
  if (ph == NPHASES - 1) { if (EN(11)) ph_final(p); return; }
  const int q = ph - 1; int L, sub;
  if (q < 11) { L = 0; sub = q; } else if (q < 20) { L = 1; sub = q - 11; } else if (q < 31) { L = 2; sub = q - 20; } else { L = 3; sub = q - 31; }
  const bool even = (L & 1) == 0; const int e = L >> 1;
  bf16_t* W1 = (bf16_t*)(p.ws + OFF_WC); bf16_t* W2 = (bf16_t*)(p.ws + OFF_WC + WC_W2);
  bf16_t* hb = (bf16_t*)(p.ws + OFF_HBF); float* xr = (float*)(p.ws + OFF_XRES);
  const float* mods = (const float*)(p.ws + OFF_MODS) + (size_t)L * 3 * 6144;
  bf16_t* W3 = (bf16_t*)(p.ws + OFF_W3);
#define CVT_MIX(LL, skipb) do { const int L_ = (LL); if ((L_ & 1) == 0) { cvt_weight(p.rec_w_in + (size_t)(L_ >> 1) * 1024 * 3632, W1, 1024, 3632, NREC, true, skipb); cvt_weight(p.rec_w_out + (size_t)(L_ >> 1) * 1024 * 1024, W3, 1024, 1024, 1024, false, skipb); } \
    else { cvt_weight(p.att_w_qkv + (size_t)(L_ >> 1) * 1024 * 1536, W1, 1024, 1536, 1536, false, skipb); cvt_weight(p.att_w_out + (size_t)(L_ >> 1) * 1024 * 1024, W3, 1024, 1024, 1024, false, skipb); } } while (0)
#define CVT_FFN(LL, skipb) do { const int L_ = (LL); cvt_weight(p.ffn_w_up + (size_t)L_ * 1024 * 5632, W1, 1024, 5632, 5632, false, skipb); cvt_weight(p.ffn_w_down + (size_t)L_ * DFF * 1024, W2, DFF, 1024, 1024, false, skipb); } while (0)
  if (ph == 0) { RUN(0, ph_init(p, lds); CVT_MIX(0, 0)); return; }
  int fs = even ? sub - 7 : sub - 5;
  if (fs >= 0) {
    if (fs == 0) { RUN(1, ph_norm(p, L, 1)); }
    else if (fs == 1) { RUN(2, gemm8(lds, hb, 1024, W1, 1024, 5632, L == 3, EpiBf8{(bf16_t*)(p.ws + OFF_D), 5632})); }
    else if (fs == 2) { if (EN(8)) ph_ffnact(p, L); }
    else { if (EN(2)) { gemm8(lds, (const bf16_t*)(p.ws + OFF_D) + DFF, 5632, W2, DFF, 1024, L == 3, EpiRes8{xr, mods + 5 * 1024}); if (L < 3) CVT_MIX(L + 1, 8); } }
    return;
  }
  if (even) {
    switch (sub) {
      case 0: RUN(1, ph_norm(p, L, 0)); break;
      case 1: RUN(2, gemm8(lds, hb, 1024, W1, 1024, NREC, false, EpiRec8{(bf16_t*)(p.ws + OFF_D + D_P1), (bf16_t*)(p.ws + OFF_D + D_P2), (float*)(p.ws + OFF_SM)})); break;
      case 2: RUN(3, ph_dnprep(p, lds, e)); break;
      case 3: RUN(4, ph_dn_d1(p, lds); ph_gla_b(p, lds, e)); break;
      case 4: RUN(5, if (BIDX() < 64) { dn_scan(p, lds, BIDX()); } else if (BIDX() < 128) { gla_scan(p, lds, BIDX() - 64, e); });
        if (PROBE_REP == 55) { xcd_barrier(*xbp); if (BIDX() < 64) { dn_scan(p, lds, BIDX()); } }
        if (PROBE_REP == 56) { xcd_barrier(*xbp); if (BIDX() >= 64 && BIDX() < 128) { gla_scan(p, lds, BIDX() - 64, e); } }
        break;
      case 5: RUN(7, ph_merge(p, e)); break;
      case 6: if (EN(2)) { gemm8(lds, hb, 1024, W3, 1024, 1024, false, EpiRes8{xr, mods + 2 * 1024}); CVT_FFN(L, 8); } break;
    }
  } else {
    const int o = L >> 1;
    switch (sub) {
      case 0: RUN(1, ph_norm(p, L, 0)); break;
      case 1: RUN(2, gemm8(lds, hb, 1024, W1, 1024, 1536, false, EpiBf8{(bf16_t*)(p.ws + OFF_D), 1536})); break;
      case 2: if (EN(9)) ph_qknorm(p, lds, o); break;
      case 3: RUN(10, ph_attn(p, lds, L != 3)); break;
      case 4: if (EN(2)) { gemm8(lds, hb, 1024, W3, 1024, 1024, L == 3, EpiRes8{xr, mods + 2 * 1024}); CVT_FFN(L, L == 3 ? 0 : 8); } break;
    }
  }
}

template <bool COOP>
__global__ void __launch_bounds__(512, 1) mk_kernel(P p, int ph0, int ph1) {
  extern __shared__ __attribute__((aligned(16))) char smem[];
  if constexpr (COOP) {
    if (ph0 < 0) cg::this_grid().sync();
    volatile LAS unsigned* st = (volatile LAS unsigned*)(smem + LDS_BYTES);
    if (threadIdx.x < 4) st[threadIdx.x] = 0u;
    __syncthreads();
    XcdBarrier xb = xcd_barrier_post((unsigned*)(p.ws + OFF_BAR), st);
    for (int ph = ph0; ph < ph1; ++ph) {
      run_phase(p, ph, smem, &xb);
      if (ph + 1 < ph1) xcd_barrier(xb);
      if (PROBE_REP == 99 && ph == 0) { for (int q = 0; q < 20; ++q) xcd_barrier(xb); }
    }
  } else {
    for (int ph = ph0; ph < ph1; ++ph) run_phase(p, ph, smem, nullptr);
  }
}

extern "C" void kernel_launch(void* const* d_in, const int* in_sizes, int n_in, void* d_out, int out_size, void* d_ws, size_t ws_size, hipStream_t stream) {
  if (n_in != 23 || ws_size < WS_NEED) { fprintf(stderr, "kernel_launch: bad n_in %d or ws %zu < %zu\n", n_in, ws_size, (size_t)WS_NEED); return; }
  P p{};
  const float** f = (const float**)&p;
  for (int i = 0; i < 23; ++i) f[i] = (const float*)d_in[i];
  p.out = (float*)d_out; p.ws = (char*)d_ws;
  static int inited = 0, grid_blocks = 0;
  if (!inited) {
    hipFuncSetAttribute((const void*)mk_kernel<true>, hipFuncAttributeMaxDynamicSharedMemorySize, LDS_BYTES + 16);
    hipFuncSetAttribute((const void*)mk_kernel<false>, hipFuncAttributeMaxDynamicSharedMemorySize, LDS_BYTES);
    int dev = 0, cus = 0, per_cu = 0;
    hipGetDevice(&dev); hipDeviceGetAttribute(&cus, hipDeviceAttributeMultiprocessorCount, dev);
    hipOccupancyMaxActiveBlocksPerMultiprocessor(&per_cu, mk_kernel<true>, 512, LDS_BYTES + 16);
    if (per_cu > 1) per_cu = 1;
    grid_blocks = cus * per_cu; if (grid_blocks > 256) grid_blocks = 256; if (grid_blocks < 128) grid_blocks = 128;
    inited = 1;
  }
#if MK_COOP
  int ph0 = 0, ph1 = NPHASES;
  void* args[] = {&p, &ph0, &ph1};
  hipMemsetAsync((char*)d_ws + OFF_BAR, 0, 3456 * 4, stream);
  hipError_t er = hipLaunchCooperativeKernel((const void*)mk_kernel<true>, dim3(grid_blocks), dim3(512), args, LDS_BYTES + 16, stream);
  if (er != hipSuccess) fprintf(stderr, "cooperative launch failed: %s (grid %d)\n", hipGetErrorString(er), grid_blocks);
#else
  for (int ph = 0; ph < NPHASES; ++ph) hipLaunchKernelGGL(mk_kernel<false>, dim3(256), dim3(512), LDS_BYTES, stream, p, ph, ph + 1);
#endif
}
```

```cpp
#include <hip/hip_runtime.h>
#include <hip/hip_cooperative_groups.h>
#include <cstdio>
#include <cstdint>
namespace cg = cooperative_groups;

#ifndef MK_COOP
#define MK_COOP 1
#endif

typedef unsigned short bf16_t;
typedef short bf16x8 __attribute__((ext_vector_type(8)));
typedef short s16x4 __attribute__((ext_vector_type(4)));
typedef float f32x16 __attribute__((ext_vector_type(16)));
typedef float f32x8 __attribute__((ext_vector_type(8)));
typedef float f32x4 __attribute__((ext_vector_type(4)));
typedef unsigned u32x4 __attribute__((ext_vector_type(4)));
#define DI __device__ __forceinline__
#define LBAR() do { asm volatile("s_waitcnt lgkmcnt(0)" ::: "memory"); __builtin_amdgcn_s_barrier(); asm volatile("" ::: "memory"); } while (0)
#define MFMA32(a, b, c) __builtin_amdgcn_mfma_f32_32x32x16_bf16((a), (b), (c), 0, 0, 0)

constexpr int DM = 1024, TB = 8448, CTXL = 256, LAT = 8192, MROWS = 2 * TB;
constexpr int NCH = 132;
constexpr int DFF = 2816;
constexpr int NREC = 3840;
constexpr float EPSF = 1e-6f;

constexpr size_t AL(size_t x) { return (x + 255) / 256 * 256; }
constexpr size_t OFF_XRES = 0;
constexpr size_t OFF_HBF = OFF_XRES + AL((size_t)MROWS * DM * 4);
constexpr size_t OFF_WC = OFF_HBF + AL((size_t)MROWS * DM * 2);
constexpr size_t WC_W2 = (size_t)5632 * 1024 * 2;
constexpr size_t OFF_MODS = OFF_WC + AL(WC_W2 + (size_t)1024 * 2816 * 2);
constexpr size_t OFF_SM = OFF_MODS + AL((size_t)4 * 3 * 6144 * 4);
constexpr size_t OFF_GB = OFF_SM + AL((size_t)MROWS * 64 * 4);
constexpr size_t OFF_SC = OFF_GB + AL((size_t)MROWS * 16 * 4);
constexpr size_t OFF_GL = OFF_SC + AL((size_t)16 * NCH * 64 * 2 * 4);
constexpr size_t OFF_D = OFF_GL + AL((size_t)16 * NCH * 4);
constexpr size_t D_P1 = 0;
constexpr size_t D_W = 0;
constexpr size_t D_INTRA = D_W + (size_t)16 * NCH * 64 * 128 * 2;
constexpr size_t D_P2 = D_P1 + (size_t)MROWS * 1536 * 2;
constexpr size_t D_QQ = D_P2 + (size_t)MROWS * 2048 * 2;
constexpr size_t D_QK = D_QQ + (size_t)MROWS * 512 * 2;
constexpr size_t D_QV = D_QK + (size_t)MROWS * 512 * 2;
constexpr size_t D_DNO = D_QK;
constexpr size_t D_KT = D_QV + (size_t)MROWS * 512 * 2;
constexpr size_t D_GLAO = D_KT + (size_t)MROWS * 512 * 2;
constexpr size_t D_END_E = D_GLAO + (size_t)2 * MROWS * 512 * 2;
constexpr size_t D_END_F = (size_t)MROWS * 5632 * 2;
constexpr size_t OFF_B16_1 = OFF_D + (D_END_E > D_END_F ? D_END_E : D_END_F);
constexpr size_t B16_BYTES = (size_t)8 * NCH * 64 * 64 * 2;
constexpr size_t OFF_BAR = OFF_B16_1 + AL(B16_BYTES);
constexpr size_t OFF_W3 = OFF_BAR + AL(3456 * 4);
constexpr size_t WS_NEED = OFF_W3 + (size_t)1024 * 1024 * 2;
constexpr int LDS_BYTES = 132 * 1024;

struct P {
  const float *x, *c, *ctx, *c_ctx, *mod_w, *mod_b, *rec_w_in, *rec_conv, *dn_a_log, *dn_dt_bias, *dn_norm, *gla_w2, *gla_b2, *gla_norm,
      *rec_w_out, *att_w_qkv, *att_q_norm, *att_k_norm, *att_w_out, *ffn_w_up, *ffn_conv, *ffn_w_down, *final_norm;
  float* out;
  char* ws;
};

DI int TIDX() { int t = threadIdx.x; asm volatile("" : "+v"(t)); return t; }
DI int BIDX() { int t = blockIdx.x; asm volatile("" : "+s"(t)); return t; }
DI int GDIM() { int t = gridDim.x; asm volatile("" : "+s"(t)); return t; }
DI float bf2f(bf16_t v) { return __uint_as_float(((unsigned)v) << 16); }
DI bf16_t f2bf(float x) { unsigned u = __float_as_uint(x); u += 0x7fffu + ((u >> 16) & 1u); return (bf16_t)(u >> 16); }
DI unsigned cvtpk(float lo, float hi) { unsigned r; asm volatile("v_cvt_pk_bf16_f32 %0, %1, %2" : "=v"(r) : "v"(lo), "v"(hi)); return r; }
DI int crow(int r, int hi) { return (r & 3) + 8 * (r >> 2) + 4 * hi; }
DI float siluf(float x) { return x / (1.f + expf(-x)); }
DI float sigmf(float x) { return 1.f / (1.f + expf(-x)); }
DI float softplusf(float x) { return fmaxf(x, 0.f) + log1pf(expf(-fabsf(x))); }
DI float wave_sum(float v) {
#pragma unroll
  for (int o = 32; o > 0; o >>= 1) v += __shfl_xor(v, o);
  return v;
}
DI int modrow_of(int R) { const int b = R >= TB ? 1 : 0; const int pp = R - b * TB; return pp < CTXL ? 2 : b; }
template <int KS>
DI f32x16 mma_rows(const bf16_t* arow, const bf16_t* brow, f32x16 acc) {
#pragma unroll
  for (int ks = 0; ks < KS; ++ks) {
    const bf16x8 a = *reinterpret_cast<const bf16x8*>(arow + ks * 16);
    const bf16x8 b = *reinterpret_cast<const bf16x8*>(brow + ks * 16);
    acc = MFMA32(a, b, acc);
  }
  return acc;
}

#define XB_TMO      128
#define XB_XCNT(j)  (256  + 64 * (j))
#define XB_XSUB(j)  (1280 + 64 * (j))
#define XB_XGEN(j)  (2304 + 64 * (j))
#define XB_TOP      3328
#define XB_TOPGEN   3392
#define XCD_BAR_WORDS 3456
#define XB_SPIN_CAP (1u << 18)
#define LAS __attribute__((address_space(3)))
DI unsigned xb_ld(unsigned* p)              { return __hip_atomic_load(p, __ATOMIC_RELAXED, __HIP_MEMORY_SCOPE_AGENT); }
DI unsigned xb_add(unsigned* p, unsigned v) { return __hip_atomic_fetch_add(p, v, __ATOMIC_RELAXED, __HIP_MEMORY_SCOPE_AGENT); }
DI unsigned xb_xcc_id() { return (unsigned)__builtin_amdgcn_s_getreg((3 << 11) | 20) & 0xFu; }
#define XB_SPIN(cond, bar) do { unsigned _sp = 0; while (cond) { __builtin_amdgcn_s_sleep(1); \
    if ((++_sp & 255u) == 0u) { if (xb_ld(&(bar)[XB_TMO])) break; if (_sp > XB_SPIN_CAP) { atomicAdd(&(bar)[XB_TMO], 1u); break; } } } } while (0)
struct XcdBarrier { unsigned* bar; unsigned x; volatile LAS unsigned* st; };
DI XcdBarrier xcd_barrier_post(unsigned* bar, volatile LAS unsigned* st) {
    XcdBarrier b; b.bar = bar; b.x = xb_xcc_id(); b.st = st;
    if (threadIdx.x == 0) (void)xb_add(&bar[XB_XCNT(b.x)], 1u);
    return b;
}
DI void xcd_barrier_complete(unsigned* bar, unsigned x, unsigned& nloc, unsigned& nx) {
    const unsigned G = gridDim.x * gridDim.y * gridDim.z;
    unsigned sum, cnt, mine, sp = 0u;
    for (;;) {
        sum = 0u; cnt = 0u; mine = 0u;
#pragma unroll
        for (unsigned j = 0; j < 16; ++j) { const unsigned c = xb_ld(&bar[XB_XCNT(j)]); sum += c; cnt += (c > 0u) ? 1u : 0u; mine = (j == x) ? c : mine; }
        if (sum == G) break;
        __builtin_amdgcn_s_sleep(1);
        if ((++sp & 255u) == 0u) { if (xb_ld(&bar[XB_TMO])) break; if (sp > XB_SPIN_CAP) { atomicAdd(&bar[XB_TMO], 1u); break; } }
    }
    nloc = mine > 0u ? mine : 1u; nx = cnt > 0u ? cnt : 1u;
}
DI void xcd_barrier(const XcdBarrier& b) {
    asm volatile("s_waitcnt vmcnt(0)" ::: "memory");
    __syncthreads();
    if (threadIdx.x == 0) {
        unsigned* bar = b.bar;
        __builtin_amdgcn_s_waitcnt(0);
        unsigned nloc = b.st[0], nx = b.st[1];
        if (nloc == 0u) { xcd_barrier_complete(bar, b.x, nloc, nx); b.st[0] = nloc; b.st[1] = nx; }
        const unsigned old = xb_add(&bar[XB_XSUB(b.x)], 1u);
        const unsigned gen = old / nloc;
        if (old + 1u == (gen + 1u) * nloc) {
            __builtin_amdgcn_fence(__ATOMIC_RELEASE, "agent");
            asm volatile("s_waitcnt vmcnt(0)" ::: "memory");
            const unsigned og = xb_add(&bar[XB_TOP], 1u);
            const unsigned tg = og / nx;
            if (og + 1u == (tg + 1u) * nx) xb_add(&bar[XB_TOPGEN], 1u);
            else XB_SPIN(xb_ld(&bar[XB_TOPGEN]) == tg, bar);
            __builtin_amdgcn_fence(__ATOMIC_ACQUIRE, "agent");
            xb_add(&bar[XB_XGEN(b.x)], 1u);
            asm volatile("s_waitcnt vmcnt(0)" ::: "memory");
        } else {
            XB_SPIN(xb_ld(&bar[XB_XGEN(b.x)]) == gen, bar);
            __builtin_amdgcn_fence(__ATOMIC_ACQUIRE, "agent");
            asm volatile("s_waitcnt vmcnt(0)" ::: "memory");
        }
    }
    __syncthreads();
}

__device__ __forceinline__ void ph_init(const P& p, char* lds) {
  const int tid = TIDX();
  float* sc = (float*)lds;
  float* red = sc + 3072;
  for (int i = tid; i < 3072; i += 512) { const int r = i >> 10, k = i & 1023; const float v = r < 2 ? p.c[r * 1024 + k] : p.c_ctx[k]; sc[i] = siluf(v); }
  __syncthreads();
  float* mods = (float*)(p.ws + OFF_MODS);
  for (int job = BIDX(); job < 192; job += GDIM()) {
    const int col = job * 128 + (tid & 127), kq = tid >> 7;
    const int L = col / 6144, cl = col - L * 6144;
    const float* w = p.mod_w + ((size_t)L * 1024 + kq * 256) * 6144 + cl;
    float a0 = 0.f, a1 = 0.f, a2 = 0.f;
#pragma unroll 8
    for (int k = 0; k < 256; ++k) { const float wv = w[(size_t)k * 6144]; const int kk = kq * 256 + k; a0 += sc[kk] * wv; a1 += sc[1024 + kk] * wv; a2 += sc[2048 + kk] * wv; }
    red[(kq * 3 + 0) * 128 + (tid & 127)] = a0; red[(kq * 3 + 1) * 128 + (tid & 127)] = a1; red[(kq * 3 + 2) * 128 + (tid & 127)] = a2;
    __syncthreads();
    if (tid < 384) { const int r = tid >> 7, cc = tid & 127; const int c2 = job * 128 + cc; const int L2 = c2 / 6144, cl2 = c2 - L2 * 6144;
      const float s = red[(0 * 3 + r) * 128 + cc] + red[(1 * 3 + r) * 128 + cc] + red[(2 * 3 + r) * 128 + cc] + red[(3 * 3 + r) * 128 + cc] + p.mod_b[L2 * 6144 + cl2];
      mods[((size_t)L2 * 3 + r) * 6144 + cl2] = s; }
    __syncthreads();
  }
  f32x4* xr = (f32x4*)(p.ws + OFF_XRES);
  for (size_t i = (size_t)BIDX() * 512 + tid; i < (size_t)MROWS * 256; i += (size_t)GDIM() * 512) {
    const int R = (int)(i >> 8), c4 = (int)(i & 255); const int b = R >= TB ? 1 : 0, pp = R - b * TB;
    const float* src = pp < CTXL ? p.ctx + ((size_t)b * CTXL + pp) * 1024 : p.x + ((size_t)b * LAT + (pp - CTXL)) * 1024;
    xr[i] = *(const f32x4*)(src + c4 * 4);
  }
}

DI int rec_src_col(int n) { if (n < 2048) return n; if (n < 3584) return n + 16; if (n < 3600) return 2048 + (n - 3584); if (n < 3632) return n; return -1; }
__device__ __forceinline__ void cvt_weight(const float* __restrict__ W, bf16_t* __restrict__ Wt, int K, int Nsrc, int Npad, bool perm, int skipb) {
  const size_t items = (size_t)Npad * (K >> 3);
  const int bid = BIDX() - skipb, nb = GDIM() - skipb;
  if (bid < 0) return;
  for (size_t it = (size_t)bid * 512 + TIDX(); it < items; it += (size_t)nb * 512) {
    const int n = (int)(it % Npad), kb = (int)(it / Npad);
    const int s = perm ? rec_src_col(n) : n;
    float v[8];
#pragma unroll
    for (int j = 0; j < 8; ++j) v[j] = s >= 0 ? W[(size_t)(kb * 8 + j) * Nsrc + s] : 0.f;
    u32x4 w = {cvtpk(v[0], v[1]), cvtpk(v[2], v[3]), cvtpk(v[4], v[5]), cvtpk(v[6], v[7])};
    *(u32x4*)(Wt + (size_t)n * K + kb * 8) = w;
  }
}

__device__ __forceinline__ void ph_norm(const P& p, int L, int which) {
  const int tid = TIDX(), wid = tid >> 6, lane = tid & 63, l16 = lane & 15, sub = lane >> 4;
  const float* xr = (const float*)(p.ws + OFF_XRES);
  bf16_t* hb = (bf16_t*)(p.ws + OFF_HBF);
  const float* mods = (const float*)(p.ws + OFF_MODS) + (size_t)L * 3 * 6144;
  for (int R4 = (BIDX() * 8 + wid) * 4; R4 < MROWS; R4 += GDIM() * 32) {
    const int R = R4 + sub;
    const float* row = xr + (size_t)R * 1024 + l16 * 4;
    f32x4 v[16]; float ss = 0.f;
#pragma unroll
    for (int i = 0; i < 16; ++i) v[i] = *(const f32x4*)(row + i * 64);
#pragma unroll
    for (int i = 0; i < 16; ++i) ss += v[i][0] * v[i][0] + v[i][1] * v[i][1] + v[i][2] * v[i][2] + v[i][3] * v[i][3];
    ss += __shfl_xor(ss, 1); ss += __shfl_xor(ss, 2); ss += __shfl_xor(ss, 4); ss += __shfl_xor(ss, 8);
    const float rs = rsqrtf(ss * (1.f / 1024.f) + EPSF);
    const float* mr = mods + (size_t)modrow_of(R) * 6144 + which * 3072 + l16 * 4;
    bf16_t* dst = hb + (size_t)R * 1024 + l16 * 4;
#pragma unroll
    for (int i = 0; i < 16; ++i) { const f32x4 sh = *(const f32x4*)(mr + i * 64), scl = *(const f32x4*)(mr + 1024 + i * 64);
      float o[4];
#pragma unroll
      for (int j = 0; j < 4; ++j) o[j] = v[i][j] * rs * (1.f + scl[j]) + sh[j];
      uint2 w; w.x = cvtpk(o[0], o[1]); w.y = cvtpk(o[2], o[3]);
      *(uint2*)(dst + i * 64) = w; }
  }
}

struct EpiRec { bf16_t* P1; bf16_t* P2; float* SM;
  DI void operator()(int row, int col, float v) const {
    if (col < 1536) P1[(size_t)row * 1536 + col] = f2bf(v);
    else if (col < 3584) P2[(size_t)row * 2048 + (col - 1536)] = f2bf(v);
    else { const int lc = col - 3584; if (lc < 48) SM[(size_t)row * 64 + lc] = v; } } };
struct EpiBf { bf16_t* O; int ldc;
  DI void operator()(int row, int col, float v) const { O[(size_t)row * ldc + col] = f2bf(v); } };
struct EpiRes { float* X; const float* gate;
  DI void operator()(int row, int col, float v) const { float* q = X + (size_t)row * 1024 + col; *q = *q + gate[(size_t)modrow_of(row) * 6144 + col] * v; } };

template <class Epi>
__device__ __forceinline__ void gemm_phase(char* lds, const bf16_t* __restrict__ A, int lda, const bf16_t* __restrict__ Bt, int K, int nN, const Epi epi, bool skipctx = false) {
  const int tid = TIDX(), wid = tid >> 6, lane = tid & 63, r32 = lane & 31, hi = lane >> 5;
  const int wm = wid >> 1, wn = wid & 1;
  const int nk = K >> 6;
  constexpr int RS = 144, ASZ = 256 * RS, BSZ = 128 * RS, STG = ASZ + BSZ;
  const int ntiles = (skipctx ? 64 : MROWS / 256) * nN;
  const int srow = tid >> 3, spc = tid & 7;
  for (int t = BIDX(); t < ntiles; t += GDIM()) {
    int pm = t / nN; const int pn = t - pm * nN; if (skipctx) pm = pm + 1 + (pm >= 32 ? 1 : 0);
    const bf16_t* Ab = A + (size_t)(pm * 256 + srow) * lda + spc * 8;
    const bf16_t* Bb = Bt + (size_t)(pn * 128 + srow) * K + spc * 8;
    f32x16 acc00 = {}, acc01 = {}, acc10 = {}, acc11 = {};
    bf16x8 ra0, ra1, ra2, ra3, rb0, rb1;
#define GLOAD(kt) do { const int ko = (kt) * 64; ra0 = *(const bf16x8*)(Ab + ko); ra1 = *(const bf16x8*)(Ab + (size_t)64 * lda + ko); ra2 = *(const bf16x8*)(Ab + (size_t)128 * lda + ko); \
    ra3 = *(const bf16x8*)(Ab + (size_t)192 * lda + ko); rb0 = *(const bf16x8*)(Bb + ko); rb1 = *(const bf16x8*)(Bb + (size_t)64 * K + ko); } while (0)
#define SWRITE(buf) do { char* sb = lds + (buf) * STG + srow * RS + spc * 16; *(bf16x8*)(sb) = ra0; *(bf16x8*)(sb + 64 * RS) = ra1; *(bf16x8*)(sb + 128 * RS) = ra2; *(bf16x8*)(sb + 192 * RS) = ra3; \
    *(bf16x8*)(sb + ASZ) = rb0; *(bf16x8*)(sb + ASZ + 64 * RS) = rb1; } while (0)
    GLOAD(0); SWRITE(0); __syncthreads();
    for (int kt = 0; kt < nk; ++kt) {
      const int cur = kt & 1;
      if (kt + 1 < nk) GLOAD(kt + 1);
      const char* ab = lds + cur * STG + (64 * wm + r32) * RS + hi * 16;
      const char* bb = lds + cur * STG + ASZ + (64 * wn + r32) * RS + hi * 16;
#pragma unroll
      for (int ks = 0; ks < 4; ++ks) {
        const bf16x8 a0 = *(const bf16x8*)(ab + ks * 32), a1 = *(const bf16x8*)(ab + 32 * RS + ks * 32);
        const bf16x8 b0 = *(const bf16x8*)(bb + ks * 32), b1 = *(const bf16x8*)(bb + 32 * RS + ks * 32);
        acc00 = MFMA32(a0, b0, acc00); acc01 = MFMA32(a0, b1, acc01); acc10 = MFMA32(a1, b0, acc10); acc11 = MFMA32(a1, b1, acc11);
      }
      if (kt + 1 < nk) SWRITE(cur ^ 1);
      __syncthreads();
    }
#undef GLOAD
#undef SWRITE
    const int row0 = pm * 256 + 64 * wm, col0 = pn * 128 + 64 * wn + r32;
#pragma unroll
    for (int r = 0; r < 16; ++r) { const int rr = row0 + crow(r, hi);
      epi(rr, col0, acc00[r]); epi(rr, col0 + 32, acc01[r]); epi(rr + 32, col0, acc10[r]); epi(rr + 32, col0 + 32, acc11[r]); }
  }
}

namespace pg8 {
#define PG8_LAS __attribute__((address_space(3)))
constexpr int BM = 256, BK = 64, HALF = 128, HTB = HALF * BK * 2  , STAGE_BYTES = 8 * HTB, NXCD = 8, WGM = 8;

__host__ __device__ __forceinline__ int lds_byte(int r, int c) { const int st = (r >> 4) * 2 + (c >> 5), rr = r & 15, cc = c & 31, ob = rr * 64 + cc * 2; return st * 1024 + (ob ^ (((ob >> 9) & 1) << 5)); }
__host__ __device__ __forceinline__ void stage_rc(int b, int& R, int& C) { const int st = b / 1024, sb = b % 1024, swz = sb ^ (((sb >> 9) & 1) << 5); R = (st >> 1) * 16 + swz / 64; C = (st & 1) * 32 + (swz % 64) / 2; }
__host__ __device__ __forceinline__ int perm32(int rho) { const int n = rho >> 4, i = rho & 15; return 8 * (i >> 2) + 4 * n + (i & 3); }
struct Unit { int pm, pn; };
struct Gemm { const bf16_t* A; const bf16_t* Bt; int M, N, K, lda; };

struct StaticOrder {
    int nM, nN, nwg, G, c;
    __host__ __device__ void init(int M, int N, int G_, int c_) { nM = M / BM; nN = N / BM; nwg = nM * nN; G = G_; c = c_; }
    __host__ __device__ bool next(int i, Unit& u) const {
        const long L = (long)i * G + c; if (L >= nwg) return false;
        int wgid = (int)L; { const int q = nwg / NXCD, r = nwg % NXCD, xcd = wgid % NXCD, off = wgid / NXCD; wgid = (xcd < r ? xcd * (q + 1) : r * (q + 1) + (xcd - r) * q) + off; }
        const int nig = WGM * nN, gid = wgid / nig, fm = gid * WGM, gsz = (nM - fm) < WGM ? (nM - fm) : WGM;
        u.pm = fm + ((wgid % nig) % gsz); u.pn = (wgid % nig) / gsz; return true;
    }
    __device__ __forceinline__ void a_ready(const Unit&) const {}
    __device__ __forceinline__ void done(const Unit&) const {}
};
template <class Epi, class Sched, bool ALIGN_EPI = false, bool SP2 = false>
__device__ __forceinline__ void gemm_phase(PG8_LAS unsigned char* lds, const Gemm g, const Sched& S, const Epi& E) {
    const int tid = TIDX(), wid = __builtin_amdgcn_readfirstlane(tid >> 6), lane = tid & 63, wr = wid >> 2, wc = wid & 3, fr = lane & 15, fq = lane >> 4;
    const int K = g.K, nt = K / BK;
    unsigned voffA[2], voffB[2];
#pragma unroll
    for (int i = 0; i < 2; ++i) { int R, C; stage_rc(tid * 16 + i * 8192, R, C); const int Rb = Epi::PERM ? ((R & ~31) + perm32(R & 31)) : R;
        voffA[i] = (unsigned)(R * g.lda + C) * 2u; voffB[i] = (unsigned)(Rb * K + C) * 2u; }
    const size_t kstep = (size_t)(BK * 2);
    const size_t hstep = (size_t)HALF * K * 2;
    const size_t tstep = 2 * hstep; const size_t hstepA = (size_t)HALF * g.lda * 2, tstepA = 2 * hstepA;
    const unsigned ldsw = (unsigned)wid * 1024u;
    const int aoff = lds_byte(wr * 64 + fr, fq * 8), boff = lds_byte(wc * 32 + fr, fq * 8);
#define PG8_SA(b, h) (((b) * 2 + (h)) * HTB)
#define PG8_SB(b, h) ((4 + (b) * 2 + (h)) * HTB)
#define PG8_STAGE(bufoff, gbase, voff) do { _Pragma("unroll") for (int _i = 0; _i < 2; ++_i) \
        __builtin_amdgcn_global_load_lds((const unsigned*)((const char*)(gbase) + (voff)[_i]), (PG8_LAS unsigned*)(lds + (bufoff) + ldsw + _i * 8192), 16, 0, 0); } while (0)
#define PG8_LDA(dst, b, h) do { _Pragma("unroll") for (int m = 0; m < 4; ++m) _Pragma("unroll") for (int k = 0; k < 2; ++k) dst[m][k] = *(const PG8_LAS bf16x8*)(lds + PG8_SA(b, h) + aoff + m * 2048 + k * 1024); } while (0)
#define PG8_LDB(dst, b, h) do { _Pragma("unroll") for (int n = 0; n < 2; ++n) _Pragma("unroll") for (int k = 0; k < 2; ++k) dst[n][k] = *(const PG8_LAS bf16x8*)(lds + PG8_SB(b, h) + boff + n * 2048 + k * 1024); } while (0)
#define PG8_MMA(ai, bj, At, Bt) do { __builtin_amdgcn_s_setprio(1); _Pragma("unroll") for (int m = 0; m < 4; ++m) _Pragma("unroll") for (int n = 0; n < 2; ++n) _Pragma("unroll") for (int k = 0; k < 2; ++k) \
        acc[ai][bj][m][n] = __builtin_amdgcn_mfma_f32_16x16x32_bf16(Bt[n][k], At[m][k], acc[ai][bj][m][n], 0, 0, 0); __builtin_amdgcn_s_setprio(0); } while (0)
#define PG8_WAIT_V(n) asm volatile("s_waitcnt vmcnt(" #n ")" ::: "memory")
#define PG8_WAIT_L(n) asm volatile("s_waitcnt lgkmcnt(" #n ")" ::: "memory")
#define PG8_BAR __builtin_amdgcn_s_barrier()
#define PG8_SCHED __builtin_amdgcn_sched_barrier(0)
    Unit cur, nxt; int ui = 0;
    if (!S.next(0, cur)) return;
    f32x4 acc[2][2][4][2];
#pragma unroll
    for (int a = 0; a < 2; ++a)
#pragma unroll
        for (int b = 0; b < 2; ++b)
#pragma unroll
            for (int m = 0; m < 4; ++m)
#pragma unroll
                for (int n = 0; n < 2; ++n) acc[a][b][m][n] = (f32x4){0.f, 0.f, 0.f, 0.f};
    bf16x8 At[4][2], B0[2][2], B1[2][2];
    const char* cA = (const char*)g.A + (size_t)cur.pm * tstepA; const char* cB = (const char*)g.Bt + (size_t)cur.pn * tstep;
    S.a_ready(cur);
    if constexpr (SP2) {
        PG8_STAGE(PG8_SB(0, 0), cB, voffB); PG8_STAGE(PG8_SB(0, 1), cB + hstep, voffB); PG8_STAGE(PG8_SA(0, 0), cA, voffA); PG8_STAGE(PG8_SA(0, 1), cA + hstepA, voffA);
        if (wr == 1) PG8_BAR;
        PG8_WAIT_V(2); PG8_BAR;
        PG8_STAGE(PG8_SB(1, 0), cB + kstep, voffB); PG8_STAGE(PG8_SA(1, 0), cA + kstep, voffA); PG8_STAGE(PG8_SB(1, 1), cB + hstep + kstep, voffB);
        PG8_WAIT_V(6); PG8_BAR;
    } else {
        PG8_STAGE(PG8_SB(0, 0), cB, voffB); PG8_STAGE(PG8_SA(0, 0), cA, voffA); PG8_STAGE(PG8_SB(0, 1), cB + hstep, voffB); PG8_STAGE(PG8_SA(0, 1), cA + hstepA, voffA);
        if (wr == 1) PG8_BAR;
        PG8_WAIT_V(4); PG8_BAR;
        PG8_STAGE(PG8_SB(1, 0), cB + kstep, voffB); PG8_STAGE(PG8_SA(1, 0), cA + kstep, voffA); PG8_STAGE(PG8_SB(1, 1), cB + hstep + kstep, voffB);
        PG8_WAIT_V(6); PG8_BAR;
    }
    for (;;) {
        const bool has_next = S.next(ui + 1, nxt);
        const char* nA = has_next ? (const char*)g.A + (size_t)nxt.pm * tstepA : cA; const char* nB = has_next ? (const char*)g.Bt + (size_t)nxt.pn * tstep : cB;
        for (int t = 0; t < nt; t += 2) {
            const bool last = (t == nt - 2);
            const char* a1 = cA + (size_t)(t + 1) * kstep;
            const char* a2 = last ? nA : cA + (size_t)(t + 2) * kstep; const char* b2 = last ? nB : cB + (size_t)(t + 2) * kstep;
            const char* a3 = a2 + kstep; const char* b3 = b2 + kstep;
            if (last && has_next) S.a_ready(nxt);
            if constexpr (SP2) {
            PG8_LDB(B0, 0, 0); PG8_LDB(B1, 0, 1); PG8_SCHED; PG8_LDA(At, 0, 0); PG8_STAGE(PG8_SA(1, 1), a1 + hstepA, voffA);
            PG8_WAIT_V(8); PG8_WAIT_L(0); PG8_BAR; PG8_MMA(0, 0, At, B0); PG8_MMA(0, 1, At, B1); PG8_BAR; PG8_SCHED;
            PG8_LDA(At, 0, 1); PG8_STAGE(PG8_SB(0, 0), b2, voffB); PG8_STAGE(PG8_SB(0, 1), b2 + hstep, voffB); PG8_STAGE(PG8_SA(0, 0), a2, voffA);
            PG8_WAIT_V(8); PG8_WAIT_L(0); PG8_BAR; PG8_MMA(1, 0, At, B0); PG8_MMA(1, 1, At, B1); PG8_BAR; PG8_SCHED;
            PG8_LDB(B0, 1, 0); PG8_LDB(B1, 1, 1); PG8_SCHED; PG8_LDA(At, 1, 0); PG8_STAGE(PG8_SA(0, 1), a2 + hstepA, voffA);
            PG8_WAIT_V(8); PG8_WAIT_L(0); PG8_BAR; PG8_MMA(0, 0, At, B0); PG8_MMA(0, 1, At, B1); PG8_BAR; PG8_SCHED;
            PG8_LDA(At, 1, 1); PG8_STAGE(PG8_SB(1, 0), b3, voffB); PG8_STAGE(PG8_SB(1, 1), b3 + hstep, voffB); PG8_STAGE(PG8_SA(1, 0), a3, voffA);
            PG8_WAIT_V(8); PG8_WAIT_L(0); PG8_BAR; PG8_MMA(1, 0, At, B0); PG8_MMA(1, 1, At, B1); PG8_BAR; PG8_SCHED;
            } else {
            PG8_LDB(B0, 0, 0); PG8_SCHED; PG8_LDA(At, 0, 0); PG8_STAGE(PG8_SA(1, 1), a1 + hstepA, voffA);
            PG8_WAIT_L(8); PG8_BAR; PG8_WAIT_L(0); PG8_MMA(0, 0, At, B0); PG8_BAR; PG8_SCHED;
            PG8_LDB(B1, 0, 1); PG8_STAGE(PG8_SB(0, 0), b2, voffB);
            PG8_BAR; PG8_WAIT_L(0); PG8_MMA(0, 1, At, B1); PG8_BAR;
            PG8_LDA(At, 0, 1); PG8_STAGE(PG8_SA(0, 0), a2, voffA);
            PG8_BAR; PG8_WAIT_L(0); PG8_MMA(1, 0, At, B0); PG8_BAR; PG8_SCHED;
            PG8_STAGE(PG8_SB(0, 1), b2 + hstep, voffB);
            PG8_WAIT_V(6); PG8_BAR; PG8_MMA(1, 1, At, B1); PG8_BAR;
            PG8_LDB(B0, 1, 0); PG8_SCHED; PG8_LDA(At, 1, 0); PG8_STAGE(PG8_SA(0, 1), a2 + hstepA, voffA);
            PG8_WAIT_L(8); PG8_BAR; PG8_WAIT_L(0); PG8_MMA(0, 0, At, B0); PG8_BAR; PG8_SCHED;
            PG8_LDB(B1, 1, 1); PG8_STAGE(PG8_SB(1, 0), b3, voffB);
            PG8_BAR; PG8_WAIT_L(0); PG8_MMA(0, 1, At, B1); PG8_BAR;
            PG8_LDA(At, 1, 1); PG8_STAGE(PG8_SA(1, 0), a3, voffA);
            PG8_BAR; PG8_WAIT_L(0); PG8_MMA(1, 0, At, B0); PG8_BAR; PG8_SCHED;
            PG8_STAGE(PG8_SB(1, 1), b3 + hstep, voffB);
            PG8_WAIT_V(6); PG8_BAR; PG8_MMA(1, 1, At, B1); PG8_BAR;
            }
        }
        if constexpr (ALIGN_EPI) { if (wr == 0) PG8_BAR; }
        if constexpr (!Epi::AFTER_DRAIN) { E(acc, cur, wr, wc, fr, fq); S.done(cur); }
        if (!has_next) break;
#pragma unroll
        for (int a = 0; a < 2; ++a)
#pragma unroll
            for (int b = 0; b < 2; ++b)
#pragma unroll
                for (int m = 0; m < 4; ++m)
#pragma unroll
                    for (int n = 0; n < 2; ++n) acc[a][b][m][n] = (f32x4){0.f, 0.f, 0.f, 0.f};
        cur = nxt; cA = nA; cB = nB; ++ui;
        if constexpr (ALIGN_EPI) { if (wr == 1) PG8_BAR; }
    }
    PG8_WAIT_V(0);
    if constexpr (!ALIGN_EPI) { if (wr == 0) PG8_BAR; }
    PG8_BAR;
    if constexpr (Epi::AFTER_DRAIN) { E.fused(acc, cur, wr, wc, fr, fq, lds, wid, lane); S.done(cur); }
#undef PG8_SA
#undef PG8_SB
#undef PG8_STAGE
#undef PG8_LDA
#undef PG8_LDB
#undef PG8_MMA
#undef PG8_WAIT_V
#undef PG8_WAIT_L
#undef PG8_BAR
#undef PG8_SCHED
}
struct SchedX { StaticOrder so; bool skip;
  __device__ __forceinline__ bool next(int i, Unit& u) const { if (!so.next(i, u)) return false; if (skip) u.pm = u.pm + 1 + (u.pm >= 32 ? 1 : 0); return true; }
  __device__ __forceinline__ void a_ready(const Unit&) const {}
  __device__ __forceinline__ void done(const Unit&) const {} };
}
struct EpiRec8 { static constexpr bool PERM = false, AFTER_DRAIN = false; bf16_t* P1; bf16_t* P2; float* SM;
  DI void operator()(const f32x4 (&acc)[2][2][4][2], const pg8::Unit& u, int wr, int wc, int fr, int fq) const {
#pragma unroll
    for (int ai = 0; ai < 2; ++ai)
#pragma unroll
      for (int m = 0; m < 4; ++m) { const size_t row = (size_t)u.pm * 256 + ai * 128 + wr * 64 + m * 16 + fr;
#pragma unroll
        for (int bj = 0; bj < 2; ++bj)
#pragma unroll
          for (int n = 0; n < 2; ++n) { const int col = u.pn * 256 + bj * 128 + wc * 32 + n * 16 + fq * 4; const f32x4 v = acc[ai][bj][m][n];
            if (u.pn < 6) { uint2 w; w.x = cvtpk(v[0], v[1]); w.y = cvtpk(v[2], v[3]); *(uint2*)(P1 + row * 1536 + col) = w; }
            else if (u.pn < 14) { uint2 w; w.x = cvtpk(v[0], v[1]); w.y = cvtpk(v[2], v[3]); *(uint2*)(P2 + row * 2048 + (col - 1536)) = w; }
            else { const int lc = col - 3584; if (lc < 48) *(f32x4*)(SM + row * 64 + lc) = v; } } } } };
struct EpiBf8 { static constexpr bool PERM = false, AFTER_DRAIN = false; bf16_t* O; int ldc;
  DI void operator()(const f32x4 (&acc)[2][2][4][2], const pg8::Unit& u, int wr, int wc, int fr, int fq) const {
#pragma unroll
    for (int ai = 0; ai < 2; ++ai)
#pragma unroll
      for (int m = 0; m < 4; ++m) { const size_t row = (size_t)u.pm * 256 + ai * 128 + wr * 64 + m * 16 + fr;
#pragma unroll
        for (int bj = 0; bj < 2; ++bj)
#pragma unroll
          for (int n = 0; n < 2; ++n) { const int col = u.pn * 256 + bj * 128 + wc * 32 + n * 16 + fq * 4; const f32x4 v = acc[ai][bj][m][n];
            uint2 w; w.x = cvtpk(v[0], v[1]); w.y = cvtpk(v[2], v[3]); *(uint2*)(O + row * ldc + col) = w; } } } };
struct EpiRes8 { static constexpr bool PERM = false, AFTER_DRAIN = false; float* X; const float* gate;
  DI void operator()(const f32x4 (&acc)[2][2][4][2], const pg8::Unit& u, int wr, int wc, int fr, int fq) const {
    const float* gr = gate + (size_t)modrow_of(u.pm * 256) * 6144;
#pragma unroll
    for (int bj = 0; bj < 2; ++bj)
#pragma unroll
      for (int n = 0; n < 2; ++n) { const int col = u.pn * 256 + bj * 128 + wc * 32 + n * 16 + fq * 4; const f32x4 gv = *(const f32x4*)(gr + col);
#pragma unroll
        for (int ai = 0; ai < 2; ++ai)
#pragma unroll
          for (int m = 0; m < 4; ++m) { const size_t row = (size_t)u.pm * 256 + ai * 128 + wr * 64 + m * 16 + fr;
            f32x4* q = (f32x4*)(X + row * 1024 + col); *q = *q + gv * acc[ai][bj][m][n]; } } } };
template <class Epi>
__device__ __forceinline__ void gemm8(char* lds, const bf16_t* A, int lda, const bf16_t* Bt, int K, int N, bool skipctx, const Epi& E) {
  pg8::Gemm g{A, Bt, skipctx ? 16384 : MROWS, N, K, lda};
  pg8::SchedX S; S.so.init(g.M, N, GDIM(), BIDX()); S.skip = skipctx;
  pg8::gemm_phase<Epi, pg8::SchedX, true, true>((PG8_LAS unsigned char*)lds, g, S, E);
}

__device__ __forceinline__ void ph_dnprep(const P& p, char* lds, int e) {
  const int tid = TIDX(), wid = tid >> 6, lane = tid & 63;
  const bf16_t* P1 = (const bf16_t*)(p.ws + OFF_D + D_P1);
  bf16_t* QQ = (bf16_t*)(p.ws + OFF_D + D_QQ); bf16_t* QK = (bf16_t*)(p.ws + OFF_D + D_QK); bf16_t* QV = (bf16_t*)(p.ws + OFF_D + D_QV);
  bf16_t* KT = (bf16_t*)(p.ws + OFF_D + D_KT);
  const float* SM = (const float*)(p.ws + OFF_SM); float* GB = (float*)(p.ws + OFF_GB);
  const float* cw = p.rec_conv + (size_t)e * 3 * 1536;
  bf16_t* kl = (bf16_t*)lds;
  for (int job = BIDX(); job < MROWS / 64; job += GDIM()) {
    const int R0 = job * 64;
    for (int tt = 0; tt < 8; ++tt) {
      const int tl = wid * 8 + tt, R = R0 + tl; const int b = R >= TB ? 1 : 0, pp = R - b * TB;
      const bool hasp = !(pp == 0 || pp == CTXL), hasn = !(pp == CTXL - 1 || pp == TB - 1);
#pragma unroll
      for (int part = 0; part < 3; ++part) {
        const int ch = part * 512 + lane * 8;
        const bf16x8 zc = *(const bf16x8*)(P1 + (size_t)R * 1536 + ch);
        bf16x8 zp = {}, zn = {};
        if (hasp) zp = *(const bf16x8*)(P1 + (size_t)(R - 1) * 1536 + ch);
        if (hasn) zn = *(const bf16x8*)(P1 + (size_t)(R + 1) * 1536 + ch);
        float o[8]; float ss = 0.f;
#pragma unroll
        for (int j = 0; j < 8; ++j) { const float a = bf2f((bf16_t)zp[j]) * cw[ch + j] + bf2f((bf16_t)zc[j]) * cw[1536 + ch + j] + bf2f((bf16_t)zn[j]) * cw[3072 + ch + j];
          o[j] = siluf(a); ss += o[j] * o[j]; }
        if (part < 2) {
          ss += __shfl_xor(ss, 1); ss += __shfl_xor(ss, 2); ss += __shfl_xor(ss, 4); ss += __shfl_xor(ss, 8);
          float sc = rsqrtf(ss + EPSF); if (part == 0) sc *= 0.08838834764831845f;
#pragma unroll
          for (int j = 0; j < 8; ++j) o[j] *= sc;
        }
        u32x4 w = {cvtpk(o[0], o[1]), cvtpk(o[2], o[3]), cvtpk(o[4], o[5]), cvtpk(o[6], o[7])};
        bf16_t* dst = part == 0 ? QQ : (part == 1 ? QK : QV);
        *(u32x4*)(dst + (size_t)R * 512 + lane * 8) = w;
        if (part == 1) *(u32x4*)(kl + tl * 512 + lane * 8) = w;
      }
      if (lane < 16) {
        const int q = lane & 7;
        if (lane < 8) { const float da = SM[(size_t)R * 64 + q]; GB[(size_t)R * 16 + q] = -expf(p.dn_a_log[e * 8 + q]) * softplusf(da + p.dn_dt_bias[e * 8 + q]); }
        else { const float db = SM[(size_t)R * 64 + 8 + q]; GB[(size_t)R * 16 + 8 + q] = sigmf(db); }
      }
    }
    __syncthreads();
    {
      const int b = R0 >= TB ? 1 : 0, c = (R0 - b * TB) / 64; const int h = tid >> 7, dk = tid & 127;
      bf16_t* dst = KT + ((((size_t)b * 4 + h) * NCH + c) * 128 + dk) * 64;
#pragma unroll
      for (int g8 = 0; g8 < 8; ++g8) { unsigned w[4];
#pragma unroll
        for (int j = 0; j < 4; ++j) { const unsigned lo = kl[(g8 * 8 + 2 * j) * 512 + tid], hi2 = kl[(g8 * 8 + 2 * j + 1) * 512 + tid]; w[j] = lo | (hi2 << 16); }
        *(u32x4*)(dst + g8 * 8) = (u32x4){w[0], w[1], w[2], w[3]}; }
    }
    __syncthreads();
  }
}

__device__ __forceinline__ void ph_dn_d1(const P& p, char* lds) {
  const int tid = TIDX(), wid = tid >> 6, lane = tid & 63, r32 = lane & 31, hi = lane >> 5;
  const bf16_t* QQ = (const bf16_t*)(p.ws + OFF_D + D_QQ); const bf16_t* QK = (const bf16_t*)(p.ws + OFF_D + D_QK); const bf16_t* QV = (const bf16_t*)(p.ws + OFF_D + D_QV);
  const float* GB = (const float*)(p.ws + OFF_GB);
  bf16_t* W_ = (bf16_t*)(p.ws + OFF_D + D_W); bf16_t* U_ = (bf16_t*)(p.ws + OFF_HBF); bf16_t* INTRA = (bf16_t*)(p.ws + OFF_D + D_INTRA);
  float* SC = (float*)(p.ws + OFF_SC); float* GLS = (float*)(p.ws + OFF_GL);
  float* KK = (float*)lds; float* QKm = KK + 64 * 65; float* Ad = QKm + 64 * 65; float* Gs = Ad + 2 * 4096; float* Bs = Gs + 128;
  for (int job = BIDX(); job < 8 * NCH; job += GDIM()) {
    const int b = job / (4 * NCH), h = (job / NCH) & 3, c = job % NCH;
    const size_t Rb = (size_t)b * TB + (size_t)c * 64;
    {
      const int w4 = wid & 3, mi = w4 & 1, ni = w4 >> 1;
      const bf16_t* As = wid < 4 ? QK : QQ;
      const bf16_t* arow = As + (Rb + 32 * mi + r32) * 512 + h * 128 + hi * 8;
      const bf16_t* brow = QK + (Rb + 32 * ni + r32) * 512 + h * 128 + hi * 8;
      f32x16 acc = {}; acc = mma_rows<8>(arow, brow, acc);
      float* dst = wid < 4 ? KK : QKm;
#pragma unroll
      for (int r = 0; r < 16; ++r) dst[(32 * mi + crow(r, hi)) * 65 + 32 * ni + r32] = acc[r];
    }
    if (tid < 128) { const int d = tid >> 6, ip = tid & 63, t = d ? 63 - ip : ip; Gs[tid] = GB[(Rb + t) * 16 + d * 4 + h]; Bs[tid] = GB[(Rb + t) * 16 + 8 + d * 4 + h]; }
    __syncthreads();
    if (tid == 0 || tid == 64) { float s = 0.f; for (int i = 0; i < 64; ++i) { s += Gs[tid + i]; Gs[tid + i] = s; } }
    __syncthreads();
    const int n0 = c, n1 = c < 4 ? 3 - c : 135 - c;
    const size_t cj0 = ((size_t)(0 * 2 + b) * 4 + h) * NCH + n0, cj1 = ((size_t)(1 * 2 + b) * 4 + h) * NCH + n1;
    for (int e2 = tid; e2 < 8192; e2 += 512) {
      const int d = e2 >> 12, ip = (e2 >> 6) & 63, jp = e2 & 63; const int i = d ? 63 - ip : ip, j = d ? 63 - jp : jp;
      const float dec = jp <= ip ? expf(Gs[d * 64 + ip] - Gs[d * 64 + jp]) : 0.f;
      Ad[d * 4096 + ip * 64 + jp] = jp < ip ? Bs[d * 64 + ip] * KK[i * 65 + j] * dec : 0.f;
      const size_t cj = d ? cj1 : cj0;
      INTRA[(cj * 64 + ip) * 64 + jp] = f2bf(QKm[i * 65 + j] * dec);
    }
    if (tid < 128) { const int d = tid >> 6, ip = tid & 63; const size_t cj = d ? cj1 : cj0; const float gi = Gs[tid], gl = Gs[d * 64 + 63];
      SC[(cj * 64 + ip) * 2] = expf(gi); SC[(cj * 64 + ip) * 2 + 1] = expf(gl - gi); if (ip == 0) GLS[cj] = expf(gl); }
    __syncthreads();
    {
      const int d = tid >> 8, cc = tid & 255; const size_t cj = d ? cj1 : cj0;
      int dofs = d * 64, aofs = d * 4096; asm volatile("" : "+v"(dofs), "+v"(aofs));
      float x[64];
      {
        const bf16_t* srcb = (cc < 128 ? QV + h * 128 + cc : QK + h * 128 + (cc - 128)) + (Rb + (d ? 63 : 0)) * 512;
        const long step = d ? -512 : 512;
#pragma unroll
        for (int g = 0; g < 8; ++g) {
#pragma unroll
          for (int q8 = 0; q8 < 8; ++q8) { const int ip = g * 8 + q8; x[ip] = bf2f(srcb[ip * step]); }
          asm volatile("" ::: "memory");
        }
        if (cc < 128) {
#pragma unroll
          for (int ip = 0; ip < 64; ++ip) x[ip] *= Bs[dofs + ip];
        } else {
#pragma unroll
          for (int ip = 0; ip < 64; ++ip) x[ip] *= Bs[dofs + ip] * expf(Gs[dofs + ip]);
        }
      }
      const float* Arow = Ad + aofs;
#pragma unroll
      for (int ip = 1; ip < 64; ++ip) {
        float s = 0.f;
#pragma unroll
        for (int j4 = 0; j4 < (ip + 3) / 4; ++j4) { const f32x4 a = *(const f32x4*)(Arow + ip * 64 + 4 * j4);
          s += a[0] * x[4 * j4] + a[1] * x[4 * j4 + 1] + a[2] * x[4 * j4 + 2] + a[3] * x[4 * j4 + 3]; }
        x[ip] -= s;
      }
      bf16_t* dst = cc < 128 ? U_ + cj * 64 * 128 + cc : W_ + cj * 64 * 128 + (cc - 128);
#pragma unroll
      for (int ip = 0; ip < 64; ++ip) dst[ip * 128] = f2bf(x[ip]);
    }
    __syncthreads();
  }
}

typedef _Float16 h16x8 __attribute__((ext_vector_type(8)));
__device__ __forceinline__ void ph_gla_b(const P& p, char* lds, int e) {
  const int tid = TIDX(), wid = tid >> 6, lane = tid & 63;
  const float* SM = (const float*)(p.ws + OFF_SM);
  float* w2S = (float*)lds;
  float* b2S = w2S + 8192;
  for (int i = tid; i < 8192; i += 512) { const int d = i >> 12, hh = (i >> 10) & 3, r = (i >> 6) & 15, j = i & 63; w2S[i] = p.gla_w2[(((size_t)e * 2 + d) * 16 + r) * 256 + hh * 64 + j]; }
  if (tid < 512) b2S[tid] = p.gla_b2[(size_t)e * 512 + tid];
  __syncthreads();
  int jb = 8 * wid; asm volatile("" : "+v"(jb));
  for (int job = BIDX(); job < 16 * NCH; job += GDIM()) {
    const int n = job % NCH, sq = job / NCH; const int dir = sq >> 3, b = (sq >> 2) & 1, h = sq & 3;
    const int c = dir == 0 ? n : (n < 4 ? 3 - n : 135 - n);
    const size_t row = (size_t)b * TB + (size_t)c * 64 + (dir ? 63 - lane : lane);
    const float* gp = SM + row * 64 + 16 + dir * 16;
    const f32x4 g0 = *(const f32x4*)(gp), g1 = *(const f32x4*)(gp + 4), g2 = *(const f32x4*)(gp + 8), g3 = *(const f32x4*)(gp + 12);
    const float gg_[16] = {g0[0], g0[1], g0[2], g0[3], g1[0], g1[1], g1[2], g1[3], g2[0], g2[1], g2[2], g2[3], g3[0], g3[1], g3[2], g3[3]};
    const float* wb = w2S + (dir * 4 + h) * 1024 + jb; const float* bb2 = b2S + dir * 256 + h * 64 + jb;
    f32x4 sa = *(const f32x4*)(bb2), sb = *(const f32x4*)(bb2 + 4);
#pragma unroll
    for (int r = 0; r < 16; ++r) { const f32x4 wa = *(const f32x4*)(wb + r * 64), wq = *(const f32x4*)(wb + r * 64 + 4); sa += gg_[r] * wa; sb += gg_[r] * wq; }
    float la[8];
#pragma unroll
    for (int jj = 0; jj < 4; ++jj) { const float x0 = sa[jj], x1 = sb[jj];
      la[jj] = (fminf(x0, 0.f) - log1pf(expf(-fabsf(x0)))) * 0.0625f; la[4 + jj] = (fminf(x1, 0.f) - log1pf(expf(-fabsf(x1)))) * 0.0625f; }
#pragma unroll
    for (int o = 1; o < 64; o <<= 1) {
#pragma unroll
      for (int jj = 0; jj < 8; ++jj) { const float v = __shfl_up(la[jj], o); la[jj] += lane >= o ? v : 0.f; }
    }
    h16x8 hv;
#pragma unroll
    for (int jj = 0; jj < 8; ++jj) hv[jj] = (_Float16)la[jj];
    _Float16* dst = (_Float16*)(p.ws + (dir ? OFF_B16_1 : OFF_WC)) + ((((size_t)b * 4 + h) * NCH + n) * 64 + lane) * 64 + jb;
    *(h16x8*)dst = hv;
  }
}

struct DnSet { bf16x8 fa[8]; };
__device__ __forceinline__ void dn_scan(const P& p, char* lds, int job) {
  const int tid = TIDX(), wid = tid >> 6, lane = tid & 63, r32 = lane & 31, hi = lane >> 5;
  const int dir = job >> 5, b = (job >> 4) & 1, h = (job >> 2) & 3, n0 = (job & 3) * 32;
  const bf16_t* QQ = (const bf16_t*)(p.ws + OFF_D + D_QQ); const bf16_t* KT = (const bf16_t*)(p.ws + OFF_D + D_KT);
  const bf16_t* W_ = (const bf16_t*)(p.ws + OFF_D + D_W); const bf16_t* U_ = (const bf16_t*)(p.ws + OFF_HBF); const bf16_t* INTRA = (const bf16_t*)(p.ws + OFF_D + D_INTRA);
  const float* SC = (const float*)(p.ws + OFF_SC); const float* GLS = (const float*)(p.ws + OFF_GL);
  bf16_t* DNO = (bf16_t*)(p.ws + OFF_D + D_DNO);
  bf16_t* ST = (bf16_t*)lds; bf16_t* vTa = ST + 32 * 136; bf16_t* vTb = vTa + 32 * 72;
  float* scS = (float*)(vTb + 32 * 72);
  bf16_t* uS = (bf16_t*)(scS + 256);
  bf16_t* inS = uS + 2 * 64 * 40;
  for (int i = tid; i < 32 * 136; i += 512) ST[i] = 0;
  f32x16 accS = {};
  const size_t seq = ((size_t)dir * 2 + b) * 4 + h;
  const int mi = wid & 1, di = wid - 4;
  const int role = wid < 2 ? 0 : (wid < 4 ? 1 : 2);
  const int tt = tid - 256;
  DnSet fs[3]; float gls[3] = {0.f, 0.f, 0.f};
  u32x4 stU[2], stI0[2]; float stS[2] = {0.f, 0.f};
#define DN_CH(n_) const int n__ = (n_); const int c__ = dir == 0 ? n__ : (n__ < 4 ? 3 - n__ : 135 - n__); const size_t Rb__ = (size_t)b * TB + (size_t)c__ * 64; const size_t cj__ = seq * NCH + n__;
#define DN_LOAD(S, GL, n_) do { DN_CH(n_) \
    const int ipl__ = 32 * mi + r32, tl__ = dir ? 63 - ipl__ : ipl__; \
    const bf16_t* b0__ = W_ + cj__ * 8192 + (32 * mi + r32) * 128 + hi * 8; \
    const bf16_t* b1__ = QQ + (Rb__ + tl__) * 512 + h * 128 + hi * 8; \
    const bf16_t* b2__ = KT + ((((size_t)b * 4 + h) * NCH + c__) * 128 + 32 * (wid & 3) + r32) * 64 + hi * 8; \
    const bf16_t* bs__ = role == 0 ? b0__ : (role == 1 ? b1__ : b2__); \
    _Pragma("unroll") for (int ks = 0; ks < 8; ++ks) S.fa[ks] = *(const bf16x8*)(bs__ + ks * 16); \
    GL = GLS[cj__]; } while (0)
#define DN_STAGE_LD(q_, n_) do { DN_CH(n_) (void)Rb__; \
      stU[q_] = *(const u32x4*)(U_ + cj__ * 8192 + ((tid & 255) >> 2) * 128 + n0 + (tid & 3) * 8); \
      stI0[q_] = *(const u32x4*)(INTRA + cj__ * 4096 + (tid >> 3) * 64 + (tid & 7) * 8); \
      stS[q_] = SC[cj__ * 128 + (tid & 127)]; } while (0)
#define DN_STAGE_ST(q_, bf_) do { *(u32x4*)(inS + (bf_) * 4608 + (tid >> 3) * 72 + (tid & 7) * 8) = stI0[q_]; \
      if (tid < 256) *(u32x4*)(uS + (bf_) * 2560 + (tid >> 2) * 40 + (tid & 3) * 8) = stU[q_]; \
      if (tid < 128) scS[(bf_) * 128 + tid] = stS[q_]; } while (0)
#define DN_STEP(S, GL, n_, bf_) do { DN_CH(n_) (void)cj__; \
    const float* sc__ = scS + (bf_) * 128; \
    if (role < 2) { _Pragma("unroll") for (int r = 0; r < 16; ++r) accS[r] = 0.f; } \
    if (role < 2) { const bf16_t* sb__ = ST + r32 * 136 + hi * 8; \
      _Pragma("unroll") for (int ks = 0; ks < 8; ++ks) accS = MFMA32(S.fa[ks], *(const bf16x8*)(sb__ + ks * 16), accS); \
      if (role == 0) { const bf16_t* us__ = uS + (bf_) * 2560 + r32; \
        _Pragma("unroll") for (int r = 0; r < 16; ++r) { const int ip = 32 * mi + crow(r, hi); const float vn = bf2f(us__[ip * 40]) - accS[r]; \
          vTa[r32 * 72 + ip] = f2bf(vn); const int to = dir ? 63 - ip : ip; vTb[r32 * 72 + to] = f2bf(vn * sc__[ip * 2 + 1]); } } \
      else { _Pragma("unroll") for (int r = 0; r < 16; ++r) accS[r] *= sc__[(32 * mi + crow(r, hi)) * 2]; } } \
    LBAR(); \
    if (role == 1) { const bf16_t* vb__ = vTa + r32 * 72 + hi * 8; const bf16_t* ib__ = inS + (bf_) * 4608 + (32 * mi + r32) * 72 + hi * 8; \
      _Pragma("unroll") for (int ks = 0; ks < 4; ++ks) accS = MFMA32(*(const bf16x8*)(ib__ + ks * 16), *(const bf16x8*)(vb__ + ks * 16), accS); \
      _Pragma("unroll") for (int r = 0; r < 16; ++r) { const int ip = 32 * mi + crow(r, hi), t = dir ? 63 - ip : ip; \
        DNO[((size_t)dir * MROWS + Rb__ + t) * 512 + h * 128 + n0 + r32] = f2bf(accS[r]); } } \
    else if (role == 2) { const bf16_t* vb__ = vTb + r32 * 72 + hi * 8; \
      _Pragma("unroll") for (int r = 0; r < 16; ++r) accS[r] *= GL; \
      _Pragma("unroll") for (int ks = 0; ks < 4; ++ks) accS = MFMA32(S.fa[ks], *(const bf16x8*)(vb__ + ks * 16), accS); \
      _Pragma("unroll") for (int r = 0; r < 16; ++r) ST[r32 * 136 + 32 * di + crow(r, hi)] = f2bf(accS[r]); } \
    LBAR(); } while (0)
  DN_STAGE_LD(0, 0); DN_STAGE_ST(0, 0); DN_STAGE_LD(1, 1);
  DN_LOAD(fs[0], gls[0], 0); DN_LOAD(fs[1], gls[1], 1);
  __syncthreads();
  for (int nb6 = 0; nb6 < NCH; nb6 += 6) {
#pragma unroll
    for (int k = 0; k < 6; ++k) {
      const int n = nb6 + k; const int n2 = n + 2 < NCH ? n + 2 : NCH - 1;
      DN_STAGE_ST((k + 1) & 1, (k + 1) & 1);
      DN_LOAD(fs[(k + 2) % 3], gls[(k + 2) % 3], n2); DN_STAGE_LD(k & 1, n2);
      DN_STEP(fs[k % 3], gls[k % 3], n, k & 1);
    }
  }
#undef DN_CH
#undef DN_LOAD
#undef DN_STAGE_LD
#undef DN_STAGE_ST
#undef DN_STEP
}

DI float fast_logsig(float s) { return fminf(s, 0.f) - __logf(1.f + __expf(-fabsf(s))); }
struct GlaRegs { h16x8 ba, bb; bf16x8 qa, qb, ka, kb, v8; };
__device__ __forceinline__ void gla_scan(const P& p, char* lds, int job, int e) {
  const int tid = TIDX(), wid = tid >> 6, lane = tid & 63, r32 = lane & 31, hi = lane >> 5;
  const int dir = job >> 5, b = (job >> 4) & 1, h = (job >> 2) & 3, n0 = (job & 3) * 32;
  const bf16_t* P2 = (const bf16_t*)(p.ws + OFF_D + D_P2); const float* SM = (const float*)(p.ws + OFF_SM);
  bf16_t* GLAO = (bf16_t*)(p.ws + OFF_D + D_GLAO);
  const _Float16* B16 = (const _Float16*)(p.ws + (dir ? OFF_B16_1 : OFF_WC));
  float* w2S = (float*)lds; float* b2S = w2S + 1024; float* aLb = b2S + 64;
  bf16_t* ops = (bf16_t*)(aLb + 128);
  constexpr int OPB = (4 * 64 + 32) * 72;
  bf16_t* attp = ops + 2 * OPB;
  bf16_t* STb = attp + 2 * 32 * 72;
  for (int i = tid; i < 2 * 32 * 72; i += 512) STb[i] = 0;
  f32x16 accS = {};
  __syncthreads();
  GlaRegs RG[3];
  int jb0 = 16 * (wid & 3); asm volatile("" : "+v"(jb0));
  int vtb0 = 8 * (wid & 3) * 72 + lane; asm volatile("" : "+v"(vtb0));
#define GLA_LOAD(R, n_) do { const int n__ = (n_) < NCH ? (n_) : NCH - 1; const int c__ = dir == 0 ? n__ : (n__ < 4 ? 3 - n__ : 135 - n__); const size_t row__ = (size_t)b * TB + (size_t)c__ * 64 + (dir ? 63 - lane : lane); \
    const _Float16* bp__ = B16 + ((((size_t)b * 4 + h) * NCH + n__) * 64 + lane) * 64 + 16 * (wid & 3); R.ba = *(const h16x8*)(bp__); R.bb = *(const h16x8*)(bp__ + 8); \
    const bf16_t* pr__ = P2 + row__ * 2048; R.qa = *(const bf16x8*)(pr__ + 512 + h * 64 + 16 * (wid & 3)); R.qb = *(const bf16x8*)(pr__ + 512 + h * 64 + 16 * (wid & 3) + 8); \
    R.ka = *(const bf16x8*)(pr__ + 768 + h * 64 + 16 * (wid & 3)); R.kb = *(const bf16x8*)(pr__ + 768 + h * 64 + 16 * (wid & 3) + 8); R.v8 = *(const bf16x8*)(pr__ + 1024 + h * 128 + n0 + 8 * (wid & 3)); } while (0)
#define GLA_HALF(R, BV, QV, KV, jb) do { \
    float eqe[8], eke[8], eqi[8]; \
    _Pragma("unroll") for (int jj = 0; jj < 8; ++jj) { const int j = (jb) + jj; const float bb = (float)BV[jj]; const float bm = __int_as_float(__builtin_amdgcn_readlane(__float_as_int(bb), 32)), bl = __int_as_float(__builtin_amdgcn_readlane(__float_as_int(bb), 63)); \
      const float q_ = bf2f((bf16_t)QV[jj]) * 0.125f, k_ = bf2f((bf16_t)KV[jj]); \
      eqe[jj] = q_ * __expf(bb - bm); eke[jj] = k_ * __expf(bm - bb); eqi[jj] = q_ * __expf(bb); ksT_[j * 72 + lane] = f2bf(k_ * __expf(bl - bb)); if (lane == 63) aL_[j] = __expf(bl); } \
    *(u32x4*)(qe_ + lane * 72 + (jb)) = (u32x4){cvtpk(eqe[0], eqe[1]), cvtpk(eqe[2], eqe[3]), cvtpk(eqe[4], eqe[5]), cvtpk(eqe[6], eqe[7])}; \
    *(u32x4*)(ke_ + lane * 72 + (jb)) = (u32x4){cvtpk(eke[0], eke[1]), cvtpk(eke[2], eke[3]), cvtpk(eke[4], eke[5]), cvtpk(eke[6], eke[7])}; \
    *(u32x4*)(qi_ + lane * 72 + (jb)) = (u32x4){cvtpk(eqi[0], eqi[1]), cvtpk(eqi[2], eqi[3]), cvtpk(eqi[4], eqi[5]), cvtpk(eqi[6], eqi[7])}; } while (0)
#define GLA_PREP(R, bf_) do { bf16_t* qe_ = ops + (bf_) * OPB; bf16_t* ke_ = qe_ + 64 * 72; bf16_t* qi_ = ke_ + 64 * 72; bf16_t* ksT_ = qi_ + 64 * 72; bf16_t* vT_ = ksT_ + 64 * 72; float* aL_ = aLb + (bf_) * 64; \
    GLA_HALF(R, R.ba, R.qa, R.ka, jb0); GLA_HALF(R, R.bb, R.qb, R.kb, jb0 + 8); \
    _Pragma("unroll") for (int q_ = 0; q_ < 8; ++q_) vT_[vtb0 + q_ * 72] = (bf16_t)R.v8[q_]; } while (0)
#define GLA_MMA(n_, bf_) do { const int nq__ = (n_); const int bf = (bf_); \
      const bf16_t* qe_ = ops + bf * OPB; const bf16_t* ke_ = qe_ + 64 * 72; const bf16_t* qi_ = ke_ + 64 * 72; const bf16_t* ksT_ = qi_ + 64 * 72; const bf16_t* vT_ = ksT_ + 64 * 72; const float* aL_ = aLb + bf * 64; \
      const bf16_t* STr = STb + bf * 32 * 72; bf16_t* STw = STb + (bf ^ 1) * 32 * 72; \
      if (wid < 6) { \
        const int mi = wid - 4; bf16_t* attw = attp + mi * 32 * 72; \
        const int c = dir == 0 ? nq__ : (nq__ < 4 ? 3 - nq__ : 135 - nq__); const size_t Rb = (size_t)b * TB + (size_t)c * 64; \
        f32x16 acc = {}; acc = mma_rows<4>(qi_ + (32 * mi + r32) * 72 + hi * 8, STr + r32 * 72 + hi * 8, acc); \
        { f32x16 a0 = {}; a0 = mma_rows<4>(qe_ + (32 * mi + r32) * 72 + hi * 8, ke_ + r32 * 72 + hi * 8, a0); \
          _Pragma("unroll") for (int r = 0; r < 16; ++r) { const int ipl = crow(r, hi); attw[ipl * 72 + r32] = f2bf((mi == 1 || r32 <= ipl) ? a0[r] : 0.f); } \
          f32x16 a1 = {}; if (mi == 1) a1 = mma_rows<4>(qe_ + (32 + r32) * 72 + hi * 8, ke_ + (32 + r32) * 72 + hi * 8, a1); \
          _Pragma("unroll") for (int r = 0; r < 16; ++r) { const int ipl = crow(r, hi); attw[ipl * 72 + 32 + r32] = f2bf((mi == 1 && r32 <= ipl) ? a1[r] : 0.f); } } \
        asm volatile("s_waitcnt lgkmcnt(0)" ::: "memory"); \
        acc = mma_rows<4>(attw + r32 * 72 + hi * 8, vT_ + r32 * 72 + hi * 8, acc); \
        _Pragma("unroll") for (int r = 0; r < 16; ++r) { const int ip = 32 * mi + crow(r, hi), t = dir ? 63 - ip : ip; \
          GLAO[((size_t)dir * MROWS + Rb + t) * 512 + h * 128 + n0 + r32] = f2bf(acc[r]); } \
      } else { \
        const int di = wid - 6; \
        _Pragma("unroll") for (int r = 0; r < 16; ++r) accS[r] *= aL_[32 * di + crow(r, hi)]; \
        accS = mma_rows<4>(ksT_ + (32 * di + r32) * 72 + hi * 8, vT_ + r32 * 72 + hi * 8, accS); \
        _Pragma("unroll") for (int r = 0; r < 16; ++r) STw[r32 * 72 + 32 * di + crow(r, hi)] = f2bf(accS[r]); \
      } } while (0)
  GLA_LOAD(RG[0], 0);
  if (wid < 4) { GLA_PREP(RG[0], 0); }
  GLA_LOAD(RG[1], 1); GLA_LOAD(RG[2], 2); GLA_LOAD(RG[0], 3);
  LBAR();
  for (int nb6 = 0; nb6 < NCH; nb6 += 6) {
#pragma unroll
    for (int k = 0; k < 6; ++k) {
      const int n = nb6 + k;
      if (wid < 4) { if (n + 1 < NCH) { GLA_PREP(RG[(k + 1) % 3], (k + 1) & 1); } } else { GLA_MMA(n, k & 1); }
      GLA_LOAD(RG[(k + 1) % 3], n + 4);
      LBAR();
    }
  }
#undef GLA_MMA
#undef GLA_LOAD
#undef GLA_HALF
#undef GLA_PREP
}

__device__ __forceinline__ void ph_merge(const P& p, int e) {
  const int tid = TIDX(), wid = tid >> 6, lane = tid & 63, l16 = lane & 15, sub = lane >> 4;
  const bf16_t* DNO = (const bf16_t*)(p.ws + OFF_D + D_DNO); const bf16_t* GLAO = (const bf16_t*)(p.ws + OFF_D + D_GLAO);
  const bf16_t* P2 = (const bf16_t*)(p.ws + OFF_D + D_P2); bf16_t* hb = (bf16_t*)(p.ws + OFF_HBF);
  f32x8 nwd = *(const f32x8*)(p.dn_norm + e * 128 + l16 * 8), nwg = *(const f32x8*)(p.gla_norm + e * 128 + l16 * 8);
  for (int R4 = (BIDX() * 8 + wid) * 4; R4 < MROWS; R4 += GDIM() * 32) {
    const size_t R = R4 + sub;
    bf16x8 a[8], bq[8], zz[8];
#pragma unroll
    for (int g = 0; g < 8; ++g) { const bf16_t* src = g < 4 ? DNO : GLAO; const int hc = (g & 3) * 128 + l16 * 8;
      a[g] = *(const bf16x8*)(src + R * 512 + hc); bq[g] = *(const bf16x8*)(src + ((size_t)MROWS + R) * 512 + hc);
      zz[g] = *(const bf16x8*)(P2 + R * 2048 + (g < 4 ? 0 : 1536) + hc); }
#pragma unroll
    for (int g = 0; g < 8; ++g) {
      float v[8]; float ss = 0.f;
#pragma unroll
      for (int j = 0; j < 8; ++j) { v[j] = bf2f((bf16_t)a[g][j]) + bf2f((bf16_t)bq[g][j]); ss += v[j] * v[j]; }
      ss += __shfl_xor(ss, 1); ss += __shfl_xor(ss, 2); ss += __shfl_xor(ss, 4); ss += __shfl_xor(ss, 8);
      const float rs = rsqrtf(ss * (1.f / 128.f) + EPSF);
      float o[8];
#pragma unroll
      for (int j = 0; j < 8; ++j) o[j] = v[j] * rs * (g < 4 ? nwd[j] : nwg[j]) * siluf(bf2f((bf16_t)zz[g][j]));
      *(u32x4*)(hb + R * 1024 + g * 128 + l16 * 8) = (u32x4){cvtpk(o[0], o[1]), cvtpk(o[2], o[3]), cvtpk(o[4], o[5]), cvtpk(o[6], o[7])};
    }
  }
}

__device__ __forceinline__ void ph_ffnact(const P& p, int L) {
  bf16_t* U = (bf16_t*)(p.ws + OFF_D);
  const float* cw = p.ffn_conv + (size_t)L * 3 * DFF;
  const size_t items = (size_t)MROWS * 352;
  for (size_t it = (size_t)BIDX() * 512 + TIDX(); it < items; it += (size_t)GDIM() * 512) {
    const int R = (int)(it / 352), c0 = (int)(it % 352) * 8; const int b = R >= TB ? 1 : 0, pp = R - b * TB;
    const bool hasp = !(pp == 0 || pp == CTXL), hasn = !(pp == CTXL - 1 || pp == TB - 1);
    const bf16x8 zc = *(const bf16x8*)(U + (size_t)R * 5632 + c0); bf16x8 zp = {}, zn = {};
    if (hasp) zp = *(const bf16x8*)(U + (size_t)(R - 1) * 5632 + c0);
    if (hasn) zn = *(const bf16x8*)(U + (size_t)(R + 1) * 5632 + c0);
    const bf16x8 vv = *(const bf16x8*)(U + (size_t)R * 5632 + DFF + c0);
    float o[8];
#pragma unroll
    for (int j = 0; j < 8; ++j) { const float a = bf2f((bf16_t)zp[j]) * cw[c0 + j] + bf2f((bf16_t)zc[j]) * cw[DFF + c0 + j] + bf2f((bf16_t)zn[j]) * cw[2 * DFF + c0 + j];
      o[j] = siluf(a) * bf2f((bf16_t)vv[j]); }
    u32x4 w = {cvtpk(o[0], o[1]), cvtpk(o[2], o[3]), cvtpk(o[4], o[5]), cvtpk(o[6], o[7])};
    *(u32x4*)(U + (size_t)R * 5632 + DFF + c0) = w;
  }
}

__device__ __forceinline__ void ph_qknorm(const P& p, char* lds, int o) {
  const int tid = TIDX(), wid = tid >> 6, lane = tid & 63, l16 = lane & 15, sub = lane >> 4;
  bf16_t* QKV = (bf16_t*)(p.ws + OFF_D);
  float* tab = (float*)lds;
  for (int i = tid; i < 4096; i += 512) { const int pos = i >> 5, f = i & 31; const float ang = (float)pos * powf(10000.f, -(float)f / 32.f); tab[2 * i] = cosf(ang); tab[2 * i + 1] = sinf(ang); }
  __syncthreads();
  const f32x8 qn = *(const f32x8*)(p.att_q_norm + o * 128 + l16 * 8), kn = *(const f32x8*)(p.att_k_norm + o * 128 + l16 * 8);
  const int f0 = (l16 & 3) * 8;
  for (int R4 = (BIDX() * 8 + wid) * 4; R4 < MROWS; R4 += GDIM() * 32) {
    const int R = R4 + sub; const int b = R >= TB ? 1 : 0, pp = R - b * TB; const bool lat = pp >= CTXL; const int t = lat ? pp - CTXL : 0;
    const int pos = (l16 < 8) ? (t >> 6) : (t & 63);
    bf16_t* base = QKV + (size_t)R * 1536 + l16 * 8;
    bf16x8 x[10];
#pragma unroll
    for (int hd = 0; hd < 10; ++hd) x[hd] = *(const bf16x8*)(base + hd * 128);
    float cs[8], sn[8];
#pragma unroll
    for (int j = 0; j < 8; ++j) { const float2 t2 = *(const float2*)(tab + 2 * (pos * 32 + f0 + j)); cs[j] = lat ? t2.x : 1.f; sn[j] = lat ? t2.y : 0.f; }
#pragma unroll
    for (int hd = 0; hd < 10; ++hd) {
      float v[8]; float ss = 0.f;
#pragma unroll
      for (int j = 0; j < 8; ++j) { v[j] = bf2f((bf16_t)x[hd][j]); ss += v[j] * v[j]; }
      ss += __shfl_xor(ss, 1); ss += __shfl_xor(ss, 2); ss += __shfl_xor(ss, 4); ss += __shfl_xor(ss, 8);
      const float rs = rsqrtf(ss * (1.f / 128.f) + EPSF);
      float ov[8];
#pragma unroll
      for (int j = 0; j < 8; ++j) { v[j] = v[j] * rs * (hd < 8 ? qn[j] : kn[j]); const float pr = __shfl_xor(v[j], 4);
        ov[j] = (l16 & 4) ? (pr * sn[j] + v[j] * cs[j]) : (v[j] * cs[j] - pr * sn[j]); }
      *(u32x4*)(base + hd * 128) = (u32x4){cvtpk(ov[0], ov[1]), cvtpk(ov[2], ov[3]), cvtpk(ov[4], ov[5]), cvtpk(ov[6], ov[7])};
    }
  }
}

namespace at {
constexpr int D = 128, NW = 8, QBLK = 32, KVBLK = 64;
constexpr float SCALE = 0.088388347648318440f, THR = 8.f;
constexpr int LDQ = 1536, LDK = 1536, LDO = 1024;
constexpr size_t SHM_V = KVBLK * D * 2, SHM_K = KVBLK * D * 2;
#define KSWZ(row, colB) ((row) * 256 + ((colB) ^ (((row) & 7) << 4)))
#define SBAR() __builtin_amdgcn_sched_barrier(0)
DI void partialSM(f32x16& p0, f32x16& p1, float& m_reg, float& mn, float& alpha) {
  constexpr float C = SCALE * 1.4426950408889634f;
  float pmax = p0[0]; for (int r = 1; r < 16; ++r) pmax = fmaxf(pmax, p0[r]); for (int r = 0; r < 16; ++r) pmax = fmaxf(pmax, p1[r]);
  { auto rr = __builtin_amdgcn_permlane32_swap(__float_as_uint(pmax), __float_as_uint(pmax), false, false);
    pmax = fmaxf(__uint_as_float(rr[0]), __uint_as_float(rr[1])); }
  if (__builtin_expect(__all(pmax - m_reg <= THR / SCALE), 1)) { mn = m_reg; alpha = 1.f; }
  else { mn = fmaxf(m_reg, pmax); alpha = __builtin_amdgcn_exp2f((m_reg - mn) * C); m_reg = mn; }
  float mnC = -mn * C;
  for (int r = 0; r < 16; ++r) p0[r] = fmaf(p0[r], C, mnC); for (int r = 0; r < 16; ++r) p1[r] = fmaf(p1[r], C, mnC);
  for (int r = 0; r < 16; ++r) p0[r] = __builtin_amdgcn_exp2f(p0[r]);
}
DI void finishSM(f32x16& p0, f32x16& p1, float alpha, float& l_reg, bf16x8& pa0, bf16x8& pa1, bf16x8& pa2, bf16x8& pa3) {
  for (int r = 0; r < 16; ++r) p1[r] = __builtin_amdgcn_exp2f(p1[r]);
  float ps = 0; for (int r = 0; r < 16; ++r) ps += p0[r]; for (int r = 0; r < 16; ++r) ps += p1[r];
  { auto rr = __builtin_amdgcn_permlane32_swap(__float_as_uint(ps), __float_as_uint(ps), false, false);
    ps = __uint_as_float(rr[0]) + __uint_as_float(rr[1]); }
  l_reg = l_reg * alpha + ps;
#define PK4(PP, BASE, OUT) do { unsigned a0 = cvtpk(PP[BASE + 0], PP[BASE + 1]), a1 = cvtpk(PP[BASE + 2], PP[BASE + 3]);   \
    unsigned b0 = cvtpk(PP[BASE + 4], PP[BASE + 5]), b1 = cvtpk(PP[BASE + 6], PP[BASE + 7]);                              \
    auto r0 = __builtin_amdgcn_permlane32_swap(a0, b0, false, false); auto r1 = __builtin_amdgcn_permlane32_swap(a1, b1, false, false); \
    u32x4 w = {r0[0], r1[0], r0[1], r1[1]}; OUT = *reinterpret_cast<bf16x8*>(&w); } while (0)
  PK4(p0, 0, pa0); PK4(p0, 8, pa1); PK4(p1, 0, pa2); PK4(p1, 8, pa3);
#undef PK4
}
DI void qkt(f32x16& p0, f32x16& p1, const bf16_t* Ks, const bf16x8* qr, int r32, int hi) {
  p0 = f32x16{}; p1 = f32x16{};
  for (int d0 = 0; d0 < 8; ++d0) { int cb = (d0 * 16 + hi * 8) * 2;
    bf16x8 b0 = *reinterpret_cast<const bf16x8*>((const char*)Ks + KSWZ(r32, cb));
    bf16x8 b1 = *reinterpret_cast<const bf16x8*>((const char*)Ks + KSWZ(32 + r32, cb));
    p0 = MFMA32(b0, qr[d0], p0);
    p1 = MFMA32(b1, qr[d0], p1); }
}
DI int v_st(int k, int c) { const int kk = (k & ~0xC) | ((k & 4) << 1) | ((k & 8) >> 1); return ((kk >> 3) * 4 + (c >> 5)) * 512 + ((kk & 7) * 32 + (c & 31)) * 2; }
DI int v_rd_base(int lane) { return ((lane & 3) << 3) | (((lane >> 2) & 3) << 6) | (((lane >> 4) & 1) << 5) | (((lane >> 5) & 1) << 8); }
constexpr int v_rd_off(int d0, int ks, int half) { return d0 * 512 + ks * 4096 + half * 2048; }
template <int OFF> DI s16x4 tr_read(int vb) {
  s16x4 r; asm volatile("ds_read_b64_tr_b16 %0, %1 offset:%2" : "=&v"(r) : "v"(vb), "i"(OFF) : "memory"); return r;
}
template <int D0> DI void pv_one(f32x16& od, int vb, bf16x8 pa0, bf16x8 pa1, bf16x8 pa2, bf16x8 pa3) {
  const s16x4 l0 = tr_read<v_rd_off(D0, 0, 0)>(vb), h0 = tr_read<v_rd_off(D0, 0, 1)>(vb), l1 = tr_read<v_rd_off(D0, 1, 0)>(vb), h1 = tr_read<v_rd_off(D0, 1, 1)>(vb);
  const s16x4 l2 = tr_read<v_rd_off(D0, 2, 0)>(vb), h2 = tr_read<v_rd_off(D0, 2, 1)>(vb), l3 = tr_read<v_rd_off(D0, 3, 0)>(vb), h3 = tr_read<v_rd_off(D0, 3, 1)>(vb);
  asm volatile("s_waitcnt lgkmcnt(0)" ::: "memory"); SBAR();
#define PK(Lx, Hx) (bf16x8){Lx[0], Lx[1], Lx[2], Lx[3], Hx[0], Hx[1], Hx[2], Hx[3]}
  od = MFMA32(pa0, PK(l0, h0), od);
  od = MFMA32(pa1, PK(l1, h1), od);
  od = MFMA32(pa2, PK(l2, h2), od);
  od = MFMA32(pa3, PK(l3, h3), od);
#undef PK
}
DI void pv_d0(f32x16* o, int vb, bf16x8 pa0, bf16x8 pa1, bf16x8 pa2, bf16x8 pa3) {
  pv_one<0>(o[0], vb, pa0, pa1, pa2, pa3); pv_one<1>(o[1], vb, pa0, pa1, pa2, pa3); pv_one<2>(o[2], vb, pa0, pa1, pa2, pa3); pv_one<3>(o[3], vb, pa0, pa1, pa2, pa3);
}
DI void attn_dense_body(const bf16_t* __restrict__ Qb, const bf16_t* __restrict__ Kh, const bf16_t* __restrict__ Vh, bf16_t* __restrict__ Ob, int seq, char* lds) {
  const int tid = TIDX(), wid = tid >> 6, lane = tid & 63, r32 = lane & 31, hi = lane >> 5;
  bf16_t* V_lds = (bf16_t*)lds; bf16_t* K_lds = (bf16_t*)(lds + 2 * SHM_V);
  float* ws = (float*)(lds + 2 * SHM_V + 2 * SHM_K) + wid * 64; float* li_l = ws; float* al_l = ws + 32;
  float m_reg = -1e30f, l_reg = 0; f32x16 o[4] = {}; bf16x8 qr[8];
  const bf16_t* Qw = Qb + (long)(wid * QBLK + r32) * LDQ + hi * 8;
#pragma unroll
  for (int d0 = 0; d0 < 8; ++d0) qr[d0] = *reinterpret_cast<const bf16x8*>(Qw + d0 * 16);
  const int sr = tid >> 4, sc = (tid & 15) * 8, vst0 = v_st(sr, sc), vst1 = v_st(32 + sr, sc);
  const int vb0 = (int)(uintptr_t)V_lds + v_rd_base(lane);
  struct { bf16x8 vs0, vs1, ks0, ks1; } sr_[2];
#define SLOAD(i, k0) do { sr_[i].vs0 = *(const bf16x8*)(&Vh[(long)((k0) + sr) * LDK + sc]); sr_[i].vs1 = *(const bf16x8*)(&Vh[(long)((k0) + 32 + sr) * LDK + sc]); \
    sr_[i].ks0 = *(const bf16x8*)(&Kh[(long)((k0) + sr) * LDK + sc]); sr_[i].ks1 = *(const bf16x8*)(&Kh[(long)((k0) + 32 + sr) * LDK + sc]); } while (0)
#define SWRITE(bq, i) do { *(bf16x8*)((char*)V_lds + (bq) * SHM_V + vst0) = sr_[i].vs0;          \
    *(bf16x8*)((char*)V_lds + (bq) * SHM_V + vst1) = sr_[i].vs1; int kc = sc * 2;               \
    *(bf16x8*)((char*)K_lds + (bq) * SHM_K + KSWZ(sr, kc)) = sr_[i].ks0;                       \
    *(bf16x8*)((char*)K_lds + (bq) * SHM_K + KSWZ(32 + sr, kc)) = sr_[i].ks1; } while (0)
#define SWAIT() asm volatile("s_waitcnt vmcnt(4)" ::: "memory")
#define RESC(a) do { if (__any((a) < 1.f)) { if (hi == 0) al_l[r32] = (a); asm volatile("s_waitcnt lgkmcnt(0)" ::: "memory"); \
    for (int d = 0; d < 4; ++d) for (int r = 0; r < 16; ++r) o[d][r] *= al_l[crow(r, hi)]; } } while (0)
  f32x16 pA0, pA1, pB0, pB1; float mnA, mnB, alA, alB; bf16x8 pa0, pa1, pa2, pa3; const int NT = seq / KVBLK;
  constexpr int SE = 0, SO = 1;
  SLOAD(SE, 0); asm volatile("s_waitcnt vmcnt(0)" ::: "memory"); SWRITE(0, SE); __syncthreads();
  qkt(pA0, pA1, K_lds, qr, r32, hi); partialSM(pA0, pA1, m_reg, mnA, alA);
  SLOAD(SO, KVBLK); if (2 < NT) SLOAD(SE, 2 * KVBLK);
  SWAIT(); SWRITE(1, SO); __syncthreads();
  for (int j = 1; j + 1 < NT; j += 2) {
    SBAR(); qkt(pB0, pB1, (bf16_t*)((char*)K_lds + SHM_K), qr, r32, hi);
    finishSM(pA0, pA1, alA, l_reg, pa0, pa1, pa2, pa3); SBAR();
    SLOAD(SO, (j + 2) * KVBLK); SBAR();
    pv_d0(o, vb0, pa0, pa1, pa2, pa3); partialSM(pB0, pB1, m_reg, mnB, alB);
    __syncthreads(); SWAIT(); SWRITE(0, SE);
    RESC(alB); __syncthreads();
    SBAR(); qkt(pA0, pA1, K_lds, qr, r32, hi);
    finishSM(pB0, pB1, alB, l_reg, pa0, pa1, pa2, pa3); SBAR();
    if (j + 3 < NT) SLOAD(SE, (j + 3) * KVBLK); SBAR();
    pv_d0(o, vb0 + (int)SHM_V, pa0, pa1, pa2, pa3); partialSM(pA0, pA1, m_reg, mnA, alA);
    __syncthreads(); SWAIT(); SWRITE(1, SO);
    RESC(alA); __syncthreads();
  }
  SBAR(); qkt(pB0, pB1, (bf16_t*)((char*)K_lds + SHM_K), qr, r32, hi);
  finishSM(pA0, pA1, alA, l_reg, pa0, pa1, pa2, pa3); SBAR();
  pv_d0(o, vb0, pa0, pa1, pa2, pa3); partialSM(pB0, pB1, m_reg, mnB, alB);
  __syncthreads(); RESC(alB);
  finishSM(pB0, pB1, alB, l_reg, pa0, pa1, pa2, pa3); SBAR();
  pv_d0(o, vb0 + (int)SHM_V, pa0, pa1, pa2, pa3);
  if (hi == 0) li_l[r32] = l_reg; asm volatile("s_waitcnt lgkmcnt(0)" ::: "memory");
  float rli[16];
#pragma unroll
  for (int r = 0; r < 16; ++r) rli[r] = __builtin_amdgcn_rcpf(li_l[crow(r, hi)]);
  bf16_t* Ow = Ob + (long)(wid * QBLK) * LDO;
#pragma unroll
  for (int r = 0; r < 16; ++r) { int orow = crow(r, hi);
    for (int d0 = 0; d0 < 4; ++d0) Ow[(long)orow * LDO + d0 * 32 + r32] = f2bf(o[d0][r] * rli[r]); }
#undef SLOAD
#undef SWRITE
#undef SWAIT
#undef RESC
}
}

__device__ __forceinline__ void ph_attn(const P& p, char* lds, bool need_ctx) {
  const bf16_t* QKV = (const bf16_t*)(p.ws + OFF_D); bf16_t* hb = (bf16_t*)(p.ws + OFF_HBF);
  const int nunits = need_ctx ? 528 : 512;
  for (int u = BIDX(); u < nunits; u += GDIM()) {
    int b, h, seq; size_t qrow;
    if (u < 512) { b = u >> 8; const int rem = u & 255; h = rem >> 5; qrow = (size_t)b * TB + CTXL + (size_t)(rem & 31) * 256; seq = TB; }
    else { const int uu = u - 512; b = uu >> 3; h = uu & 7; qrow = (size_t)b * TB; seq = CTXL; }
    const int kvh = h >> 2;
    const bf16_t* Kh = QKV + (size_t)b * TB * 1536 + 1024 + kvh * 128;
    const bf16_t* Vh = QKV + (size_t)b * TB * 1536 + 1280 + kvh * 128;
    at::attn_dense_body(QKV + qrow * 1536 + h * 128, Kh, Vh, hb + qrow * 1024 + h * 128, seq, lds);
    __syncthreads();
  }
}

__device__ __forceinline__ void ph_final(const P& p) {
  const int tid = TIDX(), wid = tid >> 6, lane = tid & 63;
  const float* xr = (const float*)(p.ws + OFF_XRES);
  for (int q = BIDX() * 8 + wid; q < 2 * LAT; q += GDIM() * 8) {
    const int b = q >> 13, t = q & (LAT - 1); const float* row = xr + ((size_t)b * TB + CTXL + t) * 1024;
    f32x4 v[4]; float ss = 0.f;
#pragma unroll
    for (int i = 0; i < 4; ++i) { v[i] = *(const f32x4*)(row + i * 256 + lane * 4); ss += v[i][0] * v[i][0] + v[i][1] * v[i][1] + v[i][2] * v[i][2] + v[i][3] * v[i][3]; }
    ss = wave_sum(ss); const float rs = rsqrtf(ss * (1.f / 1024.f) + EPSF);
#pragma unroll
    for (int i = 0; i < 4; ++i) { const int c0 = i * 256 + lane * 4; const f32x4 g = *(const f32x4*)(p.final_norm + c0); f32x4 o = v[i] * rs * g; *(f32x4*)(p.out + (size_t)q * 1024 + c0) = o; }
  }
}

constexpr int NPHASES = 42;
#ifndef ONLY_PH
#define ONLY_PH -1
#endif
#define EN(x) (ONLY_PH < 0 || ONLY_PH == (x))
#ifndef PROBE_REP
#define PROBE_REP -1
#endif
#define RUN(cls, ...) do { if (EN(cls)) { for (int rep_ = 0; rep_ < ((PROBE_REP == (cls)) ? 2 : 1); ++rep_) { if (rep_) xcd_barrier(*xbp); __VA_ARGS__; } } } while (0)
__device__ __forceinline__ void run_phase(const P& p0, int ph, char* lds, const XcdBarrier* xbp) {
  P p = p0; asm volatile("" : "+s"(p.ws));
  if (ph == NPHASES - 1) { if (EN(11)) ph_final(p); return; }
  const int q = ph - 1; int L, sub;
  if (q < 11) { L = 0; sub = q; } else if (q < 20) { L = 1; sub = q - 11; } else if (q < 31) { L = 2; sub = q - 20; } else { L = 3; sub = q - 31; }
  const bool even = (L & 1) == 0; const int e = L >> 1;
  bf16_t* W1 = (bf16_t*)(p.ws + OFF_WC); bf16_t* W2 = (bf16_t*)(p.ws + OFF_WC + WC_W2);
  bf16_t* hb = (bf16_t*)(p.ws + OFF_HBF); float* xr = (float*)(p.ws + OFF_XRES);
  const float* mods = (const float*)(p.ws + OFF_MODS) + (size_t)L * 3 * 6144;
  bf16_t* W3 = (bf16_t*)(p.ws + OFF_W3);
#define CVT_MIX(LL, skipb) do { const int L_ = (LL); if ((L_ & 1) == 0) { cvt_weight(p.rec_w_in + (size_t)(L_ >> 1) * 1024 * 3632, W1, 1024, 3632, NREC, true, skipb); cvt_weight(p.rec_w_out + (size_t)(L_ >> 1) * 1024 * 1024, W3, 1024, 1024, 1024, false, skipb); } \
    else { cvt_weight(p.att_w_qkv + (size_t)(L_ >> 1) * 1024 * 1536, W1, 1024, 1536, 1536, false, skipb); cvt_weight(p.att_w_out + (size_t)(L_ >> 1) * 1024 * 1024, W3, 1024, 1024, 1024, false, skipb); } } while (0)
#define CVT_FFN(LL, skipb) do { const int L_ = (LL); cvt_weight(p.ffn_w_up + (size_t)L_ * 1024 * 5632, W1, 1024, 5632, 5632, false, skipb); cvt_weight(p.ffn_w_down + (size_t)L_ * DFF * 1024, W2, DFF, 1024, 1024, false, skipb); } while (0)
  if (ph == 0) { RUN(0, ph_init(p, lds); CVT_MIX(0, 0)); return; }
  int fs = even ? sub - 7 : sub - 5;
  if (fs >= 0) {
    if (fs == 0) { RUN(1, ph_norm(p, L, 1)); }
    else if (fs == 1) { RUN(2, gemm8(lds, hb, 1024, W1, 1024, 5632, L == 3, EpiBf8{(bf16_t*)(p.ws + OFF_D), 5632})); }
    else if (fs == 2) { if (EN(8)) ph_ffnact(p, L); }
    else { if (EN(2)) { gemm8(lds, (const bf16_t*)(p.ws + OFF_D) + DFF, 5632, W2, DFF, 1024, L == 3, EpiRes8{xr, mods + 5 * 1024}); if (L < 3) CVT_MIX(L + 1, 8); } }
    return;
  }
  if (even) {
    switch (sub) {
      case 0: RUN(1, ph_norm(p, L, 0)); break;
      case 1: RUN(2, gemm8(lds, hb, 1024, W1, 1024, NREC, false, EpiRec8{(bf16_t*)(p.ws + OFF_D + D_P1), (bf16_t*)(p.ws + OFF_D + D_P2), (float*)(p.ws + OFF_SM)})); break;
      case 2: RUN(3, ph_dnprep(p, lds, e)); break;
      case 3: RUN(4, ph_dn_d1(p, lds); ph_gla_b(p, lds, e)); break;
      case 4: RUN(5, if (BIDX() < 64) { dn_scan(p, lds, BIDX()); } else if (BIDX() < 128) { gla_scan(p, lds, BIDX() - 64, e); });
        if (PROBE_REP == 55) { xcd_barrier(*xbp); if (BIDX() < 64) { dn_scan(p, lds, BIDX()); } }
        if (PROBE_REP == 56) { xcd_barrier(*xbp); if (BIDX() >= 64 && BIDX() < 128) { gla_scan(p, lds, BIDX() - 64, e); } }
        break;
      case 5: RUN(7, ph_merge(p, e)); break;
      case 6: if (EN(2)) { gemm8(lds, hb, 1024, W3, 1024, 1024, false, EpiRes8{xr, mods + 2 * 1024}); CVT_FFN(L, 8); } break;
    }
  } else {
    const int o = L >> 1;
    switch (sub) {
      case 0: RUN(1, ph_norm(p, L, 0)); break;
      case 1: RUN(2, gemm8(lds, hb, 1024, W1, 1024, 1536, false, EpiBf8{(bf16_t*)(p.ws + OFF_D), 1536})); break;
      case 2: if (EN(9)) ph_qknorm(p, lds, o); break;
      case 3: RUN(10, ph_attn(p, lds, L != 3)); break;
      case 4: if (EN(2)) { gemm8(lds, hb, 1024, W3, 1024, 1024, L == 3, EpiRes8{xr, mods + 2 * 1024}); CVT_FFN(L, L == 3 ? 0 : 8); } break;
    }
  }
}

template <bool COOP>
__global__ void __launch_bounds__(512, 1) mk_kernel(P p, int ph0, int ph1) {
  extern __shared__ __attribute__((aligned(16))) char smem[];
  if constexpr (COOP) {
    if (ph0 < 0) cg::this_grid().sync();
    volatile LAS unsigned* st = (volatile LAS unsigned*)(smem + LDS_BYTES);
    if (threadIdx.x < 4) st[threadIdx.x] = 0u;
    __syncthreads();
    XcdBarrier xb = xcd_barrier_post((unsigned*)(p.ws + OFF_BAR), st);
    for (int ph = ph0; ph < ph1; ++ph) {
      run_phase(p, ph, smem, &xb);
      if (ph + 1 < ph1) xcd_barrier(xb);
      if (PROBE_REP == 99 && ph == 0) { for (int q = 0; q < 20; ++q) xcd_barrier(xb); }
    }
  } else {
    for (int ph = ph0; ph < ph1; ++ph) run_phase(p, ph, smem, nullptr);
  }
}

extern "C" void kernel_launch(void* const* d_in, const int* in_sizes, int n_in, void* d_out, int out_size, void* d_ws, size_t ws_size, hipStream_t stream) {
  if (n_in != 23 || ws_size < WS_NEED) { fprintf(stderr, "kernel_launch: bad n_in %d or ws %zu < %zu\n", n_in, ws_size, (size_t)WS_NEED); return; }
  P p{};
  const float** f = (const float**)&p;
  for (int i = 0; i < 23; ++i) f[i] = (const float*)d_in[i];
  p.out = (float*)d_out; p.ws = (char*)d_ws;
  static int inited = 0, grid_blocks = 0;
  if (!inited) {
    hipFuncSetAttribute((const void*)mk_kernel<true>, hipFuncAttributeMaxDynamicSharedMemorySize, LDS_BYTES + 16);
    hipFuncSetAttribute((const void*)mk_kernel<false>, hipFuncAttributeMaxDynamicSharedMemorySize, LDS_BYTES);
    int dev = 0, cus = 0, per_cu = 0;
    hipGetDevice(&dev); hipDeviceGetAttribute(&cus, hipDeviceAttributeMultiprocessorCount, dev);
    hipOccupancyMaxActiveBlocksPerMultiprocessor(&per_cu, mk_kernel<true>, 512, LDS_BYTES + 16);
    if (per_cu > 1) per_cu = 1;
    grid_blocks = cus * per_cu; if (grid_blocks > 256) grid_blocks = 256; if (grid_blocks < 128) grid_blocks = 128;
    inited = 1;
  }
#if MK_COOP
  int ph0 = 0, ph1 = NPHASES;
  void* args[] = {&p, &ph0, &ph1};
  hipMemsetAsync((char*)d_ws + OFF_BAR, 0, 3456 * 4, stream);
  hipError_t er = hipLaunchCooperativeKernel((const void*)mk_kernel<true>, dim3(grid_blocks), dim3(512), args, LDS_BYTES + 16, stream);
  if (er != hipSuccess) fprintf(stderr, "cooperative launch failed: %s (grid %d)\n", hipGetErrorString(er), grid_blocks);
#else
  for (int ph = 0; ph < NPHASES; ++ph) hipLaunchKernelGGL(mk_kernel<false>, dim3(256), dim3(512), LDS_BYTES, stream, p, ph, ph + 1);
#endif
}
```

```cpp
#include <hip/hip_runtime.h>
#include <hip/hip_cooperative_groups.h>
#include <cstdio>
#include <cstdint>
namespace cg = cooperative_groups;

#ifndef MK_COOP
#define MK_COOP 1
#endif

typedef unsigned short bf16_t;
typedef short bf16x8 __attribute__((ext_vector_type(8)));
typedef short s16x4 __attribute__((ext_vector_type(4)));
typedef float f32x16 __attribute__((ext_vector_type(16)));
typedef float f32x8 __attribute__((ext_vector_type(8)));
typedef float f32x4 __attribute__((ext_vector_type(4)));
typedef unsigned u32x4 __attribute__((ext_vector_type(4)));
#define DI __device__ __forceinline__
#define LBAR() do { asm volatile("s_waitcnt lgkmcnt(0)" ::: "memory"); __builtin_amdgcn_s_barrier(); asm volatile("" ::: "memory"); } while (0)
#define MFMA32(a, b, c) __builtin_amdgcn_mfma_f32_32x32x16_bf16((a), (b), (c), 0, 0, 0)

constexpr int DM = 1024, TB = 8448, CTXL = 256, LAT = 8192, MROWS = 2 * TB;
constexpr int NCH = 132;
constexpr int DFF = 2816;
constexpr int NREC = 3840;
constexpr float EPSF = 1e-6f;

constexpr size_t AL(size_t x) { return (x + 255) / 256 * 256; }
constexpr size_t OFF_XRES = 0;
constexpr size_t OFF_HBF = OFF_XRES + AL((size_t)MROWS * DM * 4);
constexpr size_t OFF_WC = OFF_HBF + AL((size_t)MROWS * DM * 2);
constexpr size_t WC_W2 = (size_t)5632 * 1024 * 2;
constexpr size_t OFF_MODS = OFF_WC + AL(WC_W2 + (size_t)1024 * 2816 * 2);
constexpr size_t OFF_SM = OFF_MODS + AL((size_t)4 * 3 * 6144 * 4);
constexpr size_t OFF_GB = OFF_SM + AL((size_t)MROWS * 64 * 4);
constexpr size_t OFF_SC = OFF_GB + AL((size_t)MROWS * 16 * 4);
constexpr size_t OFF_GL = OFF_SC + AL((size_t)16 * NCH * 64 * 2 * 4);
constexpr size_t OFF_D = OFF_GL + AL((size_t)16 * NCH * 4);
constexpr size_t D_P1 = 0;
constexpr size_t D_W = 0;
constexpr size_t D_INTRA = D_W + (size_t)16 * NCH * 64 * 128 * 2;
constexpr size_t D_P2 = D_P1 + (size_t)MROWS * 1536 * 2;
constexpr size_t D_QQ = D_P2 + (size_t)MROWS * 2048 * 2;
constexpr size_t D_QK = D_QQ + (size_t)MROWS * 512 * 2;
constexpr size_t D_QV = D_QK + (size_t)MROWS * 512 * 2;
constexpr size_t D_DNO = D_QK;
constexpr size_t D_KT = D_QV + (size_t)MROWS * 512 * 2;
constexpr size_t D_GLAO = D_KT + (size_t)MROWS * 512 * 2;
constexpr size_t D_END_E = D_GLAO + (size_t)2 * MROWS * 512 * 2;
constexpr size_t D_END_F = (size_t)MROWS * 5632 * 2;
constexpr size_t OFF_B16_1 = OFF_D + (D_END_E > D_END_F ? D_END_E : D_END_F);
constexpr size_t B16_BYTES = (size_t)8 * NCH * 64 * 64 * 2;
constexpr size_t OFF_BAR = OFF_B16_1 + AL(B16_BYTES);
constexpr size_t OFF_W3 = OFF_BAR + AL(3456 * 4);
constexpr size_t WS_NEED = OFF_W3 + (size_t)1024 * 1024 * 2;
constexpr int LDS_BYTES = 132 * 1024;

struct P {
  const float *x, *c, *ctx, *c_ctx, *mod_w, *mod_b, *rec_w_in, *rec_conv, *dn_a_log, *dn_dt_bias, *dn_norm, *gla_w2, *gla_b2, *gla_norm,
      *rec_w_out, *att_w_qkv, *att_q_norm, *att_k_norm, *att_w_out, *ffn_w_up, *ffn_conv, *ffn_w_down, *final_norm;
  float* out;
  char* ws;
};

DI int TIDX() { int t = threadIdx.x; asm volatile("" : "+v"(t)); return t; }
DI int BIDX() { int t = blockIdx.x; asm volatile("" : "+s"(t)); return t; }
DI int GDIM() { int t = gridDim.x; asm volatile("" : "+s"(t)); return t; }
DI float bf2f(bf16_t v) { return __uint_as_float(((unsigned)v) << 16); }
DI bf16_t f2bf(float x) { unsigned u = __float_as_uint(x); u += 0x7fffu + ((u >> 16) & 1u); return (bf16_t)(u >> 16); }
DI unsigned cvtpk(float lo, float hi) { unsigned r; asm volatile("v_cvt_pk_bf16_f32 %0, %1, %2" : "=v"(r) : "v"(lo), "v"(hi)); return r; }
DI int crow(int r, int hi) { return (r & 3) + 8 * (r >> 2) + 4 * hi; }
DI float siluf(float x) { return x / (1.f + expf(-x)); }
DI float sigmf(float x) { return 1.f / (1.f + expf(-x)); }
DI float softplusf(float x) { return fmaxf(x, 0.f) + log1pf(expf(-fabsf(x))); }
DI float wave_sum(float v) {
#pragma unroll
  for (int o = 32; o > 0; o >>= 1) v += __shfl_xor(v, o);
  return v;
}
DI int modrow_of(int R) { const int b = R >= TB ? 1 : 0; const int pp = R - b * TB; return pp < CTXL ? 2 : b; }
template <int KS>
DI f32x16 mma_rows(const bf16_t* arow, const bf16_t* brow, f32x16 acc) {
#pragma unroll
  for (int ks = 0; ks < KS; ++ks) {
    const bf16x8 a = *reinterpret_cast<const bf16x8*>(arow + ks * 16);
    const bf16x8 b = *reinterpret_cast<const bf16x8*>(brow + ks * 16);
    acc = MFMA32(a, b, acc);
  }
  return acc;
}

#define XB_TMO      128
#define XB_XCNT(j)  (256  + 64 * (j))
#define XB_XSUB(j)  (1280 + 64 * (j))
#define XB_XGEN(j)  (2304 + 64 * (j))
#define XB_TOP      3328
#define XB_TOPGEN   3392
#define XCD_BAR_WORDS 3456
#define XB_SPIN_CAP (1u << 18)
#define LAS __attribute__((address_space(3)))
DI unsigned xb_ld(unsigned* p)              { return __hip_atomic_load(p, __ATOMIC_RELAXED, __HIP_MEMORY_SCOPE_AGENT); }
DI unsigned xb_add(unsigned* p, unsigned v) { return __hip_atomic_fetch_add(p, v, __ATOMIC_RELAXED, __HIP_MEMORY_SCOPE_AGENT); }
DI unsigned xb_xcc_id() { return (unsigned)__builtin_amdgcn_s_getreg((3 << 11) | 20) & 0xFu; }
#define XB_SPIN(cond, bar) do { unsigned _sp = 0; while (cond) { __builtin_amdgcn_s_sleep(1); \
    if ((++_sp & 255u) == 0u) { if (xb_ld(&(bar)[XB_TMO])) break; if (_sp > XB_SPIN_CAP) { atomicAdd(&(bar)[XB_TMO], 1u); break; } } } } while (0)
struct XcdBarrier { unsigned* bar; unsigned x; volatile LAS unsigned* st; };
DI XcdBarrier xcd_barrier_post(unsigned* bar, volatile LAS unsigned* st) {
    XcdBarrier b; b.bar = bar; b.x = xb_xcc_id(); b.st = st;
    if (threadIdx.x == 0) (void)xb_add(&bar[XB_XCNT(b.x)], 1u);
    return b;
}
DI void xcd_barrier_complete(unsigned* bar, unsigned x, unsigned& nloc, unsigned& nx) {
    const unsigned G = gridDim.x * gridDim.y * gridDim.z;
    unsigned sum, cnt, mine, sp = 0u;
    for (;;) {
        sum = 0u; cnt = 0u; mine = 0u;
#pragma unroll
        for (unsigned j = 0; j < 16; ++j) { const unsigned c = xb_ld(&bar[XB_XCNT(j)]); sum += c; cnt += (c > 0u) ? 1u : 0u; mine = (j == x) ? c : mine; }
        if (sum == G) break;
        __builtin_amdgcn_s_sleep(1);
        if ((++sp & 255u) == 0u) { if (xb_ld(&bar[XB_TMO])) break; if (sp > XB_SPIN_CAP) { atomicAdd(&bar[XB_TMO], 1u); break; } }
    }
    nloc = mine > 0u ? mine : 1u; nx = cnt > 0u ? cnt : 1u;
}
DI void xcd_barrier(const XcdBarrier& b) {
    asm volatile("s_waitcnt vmcnt(0)" ::: "memory");
    __syncthreads();
    if (threadIdx.x == 0) {
        unsigned* bar = b.bar;
        __builtin_amdgcn_s_waitcnt(0);
        unsigned nloc = b.st[0], nx = b.st[1];
        if (nloc == 0u) { xcd_barrier_complete(bar, b.x, nloc, nx); b.st[0] = nloc; b.st[1] = nx; }
        const unsigned old = xb_add(&bar[XB_XSUB(b.x)], 1u);
        const unsigned gen = old / nloc;
        if (old + 1u == (gen + 1u) * nloc) {
            __builtin_amdgcn_fence(__ATOMIC_RELEASE, "agent");
            asm volatile("s_waitcnt vmcnt(0)" ::: "memory");
            const unsigned og = xb_add(&bar[XB_TOP], 1u);
            const unsigned tg = og / nx;
            if (og + 1u == (tg + 1u) * nx) xb_add(&bar[XB_TOPGEN], 1u);
            else XB_SPIN(xb_ld(&bar[XB_TOPGEN]) == tg, bar);
            __builtin_amdgcn_fence(__ATOMIC_ACQUIRE, "agent");
            xb_add(&bar[XB_XGEN(b.x)], 1u);
            asm volatile("s_waitcnt vmcnt(0)" ::: "memory");
        } else {
            XB_SPIN(xb_ld(&bar[XB_XGEN(b.x)]) == gen, bar);
            __builtin_amdgcn_fence(__ATOMIC_ACQUIRE, "agent");
            asm volatile("s_waitcnt vmcnt(0)" ::: "memory");
        }
    }
    __syncthreads();
}

__device__ __forceinline__ void ph_init(const P& p, char* lds) {
  const int tid = TIDX();
  float* sc = (float*)lds;
  float* red = sc + 3072;
  for (int i = tid; i < 3072; i += 512) { const int r = i >> 10, k = i & 1023; const float v = r < 2 ? p.c[r * 1024 + k] : p.c_ctx[k]; sc[i] = siluf(v); }
  __syncthreads();
  float* mods = (float*)(p.ws + OFF_MODS);
  for (int job = BIDX(); job < 192; job += GDIM()) {
    const int col = job * 128 + (tid & 127), kq = tid >> 7;
    const int L = col / 6144, cl = col - L * 6144;
    const float* w = p.mod_w + ((size_t)L * 1024 + kq * 256) * 6144 + cl;
    float a0 = 0.f, a1 = 0.f, a2 = 0.f;
#pragma unroll 8
    for (int k = 0; k < 256; ++k) { const float wv = w[(size_t)k * 6144]; const int kk = kq * 256 + k; a0 += sc[kk] * wv; a1 += sc[1024 + kk] * wv; a2 += sc[2048 + kk] * wv; }
    red[(kq * 3 + 0) * 128 + (tid & 127)] = a0; red[(kq * 3 + 1) * 128 + (tid & 127)] = a1; red[(kq * 3 + 2) * 128 + (tid & 127)] = a2;
    __syncthreads();
    if (tid < 384) { const int r = tid >> 7, cc = tid & 127; const int c2 = job * 128 + cc; const int L2 = c2 / 6144, cl2 = c2 - L2 * 6144;
      const float s = red[(0 * 3 + r) * 128 + cc] + red[(1 * 3 + r) * 128 + cc] + red[(2 * 3 + r) * 128 + cc] + red[(3 * 3 + r) * 128 + cc] + p.mod_b[L2 * 6144 + cl2];
      mods[((size_t)L2 * 3 + r) * 6144 + cl2] = s; }
    __syncthreads();
  }
  f32x4* xr = (f32x4*)(p.ws + OFF_XRES);
  for (size_t i = (size_t)BIDX() * 512 + tid; i < (size_t)MROWS * 256; i += (size_t)GDIM() * 512) {
    const int R = (int)(i >> 8), c4 = (int)(i & 255); const int b = R >= TB ? 1 : 0, pp = R - b * TB;
    const float* src = pp < CTXL ? p.ctx + ((size_t)b * CTXL + pp) * 1024 : p.x + ((size_t)b * LAT + (pp - CTXL)) * 1024;
    xr[i] = *(const f32x4*)(src + c4 * 4);
  }
}

DI int rec_src_col(int n) { if (n < 2048) return n; if (n < 3584) return n + 16; if (n < 3600) return 2048 + (n - 3584); if (n < 3632) return n; return -1; }
__device__ __forceinline__ void cvt_weight(const float* __restrict__ W, bf16_t* __restrict__ Wt, int K, int Nsrc, int Npad, bool perm, int skipb) {
  const size_t items = (size_t)Npad * (K >> 3);
  const int bid = BIDX() - skipb, nb = GDIM() - skipb;
  if (bid < 0) return;
  for (size_t it = (size_t)bid * 512 + TIDX(); it < items; it += (size_t)nb * 512) {
    const int n = (int)(it % Npad), kb = (int)(it / Npad);
    const int s = perm ? rec_src_col(n) : n;
    float v[8];
#pragma unroll
    for (int j = 0; j < 8; ++j) v[j] = s >= 0 ? W[(size_t)(kb * 8 + j) * Nsrc + s] : 0.f;
    u32x4 w = {cvtpk(v[0], v[1]), cvtpk(v[2], v[3]), cvtpk(v[4], v[5]), cvtpk(v[6], v[7])};
    *(u32x4*)(Wt + (size_t)n * K + kb * 8) = w;
  }
}

__device__ __forceinline__ void ph_norm(const P& p, int L, int which) {
  const int tid = TIDX(), wid = tid >> 6, lane = tid & 63, l16 = lane & 15, sub = lane >> 4;
  const float* xr = (const float*)(p.ws + OFF_XRES);
  bf16_t* hb = (bf16_t*)(p.ws + OFF_HBF);
  const float* mods = (const float*)(p.ws + OFF_MODS) + (size_t)L * 3 * 6144;
  for (int R4 = (BIDX() * 8 + wid) * 4; R4 < MROWS; R4 += GDIM() * 32) {
    const int R = R4 + sub;
    const float* row = xr + (size_t)R * 1024 + l16 * 4;
    f32x4 v[16]; float ss = 0.f;
#pragma unroll
    for (int i = 0; i < 16; ++i) v[i] = *(const f32x4*)(row + i * 64);
#pragma unroll
    for (int i = 0; i < 16; ++i) ss += v[i][0] * v[i][0] + v[i][1] * v[i][1] + v[i][2] * v[i][2] + v[i][3] * v[i][3];
    ss += __shfl_xor(ss, 1); ss += __shfl_xor(ss, 2); ss += __shfl_xor(ss, 4); ss += __shfl_xor(ss, 8);
    const float rs = rsqrtf(ss * (1.f / 1024.f) + EPSF);
    const float* mr = mods + (size_t)modrow_of(R) * 6144 + which * 3072 + l16 * 4;
    bf16_t* dst = hb + (size_t)R * 1024 + l16 * 4;
#pragma unroll
    for (int i = 0; i < 16; ++i) { const f32x4 sh = *(const f32x4*)(mr + i * 64), scl = *(const f32x4*)(mr + 1024 + i * 64);
      float o[4];
#pragma unroll
      for (int j = 0; j < 4; ++j) o[j] = v[i][j] * rs * (1.f + scl[j]) + sh[j];
      uint2 w; w.x = cvtpk(o[0], o[1]); w.y = cvtpk(o[2], o[3]);
      *(uint2*)(dst + i * 64) = w; }
  }
}

struct EpiRec { bf16_t* P1; bf16_t* P2; float* SM;
  DI void operator()(int row, int col, float v) const {
    if (col < 1536) P1[(size_t)row * 1536 + col] = f2bf(v);
    else if (col < 3584) P2[(size_t)row * 2048 + (col - 1536)] = f2bf(v);
    else { const int lc = col - 3584; if (lc < 48) SM[(size_t)row * 64 + lc] = v; } } };
struct EpiBf { bf16_t* O; int ldc;
  DI void operator()(int row, int col, float v) const { O[(size_t)row * ldc + col] = f2bf(v); } };
struct EpiRes { float* X; const float* gate;
  DI void operator()(int row, int col, float v) const { float* q = X + (size_t)row * 1024 + col; *q = *q + gate[(size_t)modrow_of(row) * 6144 + col] * v; } };

template <class Epi>
__device__ __forceinline__ void gemm_phase(char* lds, const bf16_t* __restrict__ A, int lda, const bf16_t* __restrict__ Bt, int K, int nN, const Epi epi, bool skipctx = false) {
  const int tid = TIDX(), wid = tid >> 6, lane = tid & 63, r32 = lane & 31, hi = lane >> 5;
  const int wm = wid >> 1, wn = wid & 1;
  const int nk = K >> 6;
  constexpr int RS = 144, ASZ = 256 * RS, BSZ = 128 * RS, STG = ASZ + BSZ;
  const int ntiles = (skipctx ? 64 : MROWS / 256) * nN;
  const int srow = tid >> 3, spc = tid & 7;
  for (int t = BIDX(); t < ntiles; t += GDIM()) {
    int pm = t / nN; const int pn = t - pm * nN; if (skipctx) pm = pm + 1 + (pm >= 32 ? 1 : 0);
    const bf16_t* Ab = A + (size_t)(pm * 256 + srow) * lda + spc * 8;
    const bf16_t* Bb = Bt + (size_t)(pn * 128 + srow) * K + spc * 8;
    f32x16 acc00 = {}, acc01 = {}, acc10 = {}, acc11 = {};
    bf16x8 ra0, ra1, ra2, ra3, rb0, rb1;
#define GLOAD(kt) do { const int ko = (kt) * 64; ra0 = *(const bf16x8*)(Ab + ko); ra1 = *(const bf16x8*)(Ab + (size_t)64 * lda + ko); ra2 = *(const bf16x8*)(Ab + (size_t)128 * lda + ko); \
    ra3 = *(const bf16x8*)(Ab + (size_t)192 * lda + ko); rb0 = *(const bf16x8*)(Bb + ko); rb1 = *(const bf16x8*)(Bb + (size_t)64 * K + ko); } while (0)
#define SWRITE(buf) do { char* sb = lds + (buf) * STG + srow * RS + spc * 16; *(bf16x8*)(sb) = ra0; *(bf16x8*)(sb + 64 * RS) = ra1; *(bf16x8*)(sb + 128 * RS) = ra2; *(bf16x8*)(sb + 192 * RS) = ra3; \
    *(bf16x8*)(sb + ASZ) = rb0; *(bf16x8*)(sb + ASZ + 64 * RS) = rb1; } while (0)
    GLOAD(0); SWRITE(0); __syncthreads();
    for (int kt = 0; kt < nk; ++kt) {
      const int cur = kt & 1;
      if (kt + 1 < nk) GLOAD(kt + 1);
      const char* ab = lds + cur * STG + (64 * wm + r32) * RS + hi * 16;
      const char* bb = lds + cur * STG + ASZ + (64 * wn + r32) * RS + hi * 16;
#pragma unroll
      for (int ks = 0; ks < 4; ++ks) {
        const bf16x8 a0 = *(const bf16x8*)(ab + ks * 32), a1 = *(const bf16x8*)(ab + 32 * RS + ks * 32);
        const bf16x8 b0 = *(const bf16x8*)(bb + ks * 32), b1 = *(const bf16x8*)(bb + 32 * RS + ks * 32);
        acc00 = MFMA32(a0, b0, acc00); acc01 = MFMA32(a0, b1, acc01); acc10 = MFMA32(a1, b0, acc10); acc11 = MFMA32(a1, b1, acc11);
      }
      if (kt + 1 < nk) SWRITE(cur ^ 1);
      __syncthreads();
    }
#undef GLOAD
#undef SWRITE
    const int row0 = pm * 256 + 64 * wm, col0 = pn * 128 + 64 * wn + r32;
#pragma unroll
    for (int r = 0; r < 16; ++r) { const int rr = row0 + crow(r, hi);
      epi(rr, col0, acc00[r]); epi(rr, col0 + 32, acc01[r]); epi(rr + 32, col0, acc10[r]); epi(rr + 32, col0 + 32, acc11[r]); }
  }
}

namespace pg8 {
#define PG8_LAS __attribute__((address_space(3)))
constexpr int BM = 256, BK = 64, HALF = 128, HTB = HALF * BK * 2  , STAGE_BYTES = 8 * HTB, NXCD = 8, WGM = 8;

__host__ __device__ __forceinline__ int lds_byte(int r, int c) { const int st = (r >> 4) * 2 + (c >> 5), rr = r & 15, cc = c & 31, ob = rr * 64 + cc * 2; return st * 1024 + (ob ^ (((ob >> 9) & 1) << 5)); }
__host__ __device__ __forceinline__ void stage_rc(int b, int& R, int& C) { const int st = b / 1024, sb = b % 1024, swz = sb ^ (((sb >> 9) & 1) << 5); R = (st >> 1) * 16 + swz / 64; C = (st & 1) * 32 + (swz % 64) / 2; }
__host__ __device__ __forceinline__ int perm32(int rho) { const int n = rho >> 4, i = rho & 15; return 8 * (i >> 2) + 4 * n + (i & 3); }
struct Unit { int pm, pn; };
struct Gemm { const bf16_t* A; const bf16_t* Bt; int M, N, K, lda; };

struct StaticOrder {
    int nM, nN, nwg, G, c;
    __host__ __device__ void init(int M, int N, int G_, int c_) { nM = M / BM; nN = N / BM; nwg = nM * nN; G = G_; c = c_; }
    __host__ __device__ bool next(int i, Unit& u) const {
        const long L = (long)i * G + c; if (L >= nwg) return false;
        int wgid = (int)L; { const int q = nwg / NXCD, r = nwg % NXCD, xcd = wgid % NXCD, off = wgid / NXCD; wgid = (xcd < r ? xcd * (q + 1) : r * (q + 1) + (xcd - r) * q) + off; }
        const int nig = WGM * nN, gid = wgid / nig, fm = gid * WGM, gsz = (nM - fm) < WGM ? (nM - fm) : WGM;
        u.pm = fm + ((wgid % nig) % gsz); u.pn = (wgid % nig) / gsz; return true;
    }
    __device__ __forceinline__ void a_ready(const Unit&) const {}
    __device__ __forceinline__ void done(const Unit&) const {}
};
template <class Epi, class Sched, bool ALIGN_EPI = false, bool SP2 = false>
__device__ __forceinline__ void gemm_phase(PG8_LAS unsigned char* lds, const Gemm g, const Sched& S, const Epi& E) {
    const int tid = TIDX(), wid = __builtin_amdgcn_readfirstlane(tid >> 6), lane = tid & 63, wr = wid >> 2, wc = wid & 3, fr = lane & 15, fq = lane >> 4;
    const int K = g.K, nt = K / BK;
    unsigned voffA[2], voffB[2];
#pragma unroll
    for (int i = 0; i < 2; ++i) { int R, C; stage_rc(tid * 16 + i * 8192, R, C); const int Rb = Epi::PERM ? ((R & ~31) + perm32(R & 31)) : R;
        voffA[i] = (unsigned)(R * g.lda + C) * 2u; voffB[i] = (unsigned)(Rb * K + C) * 2u; }
    const size_t kstep = (size_t)(BK * 2);
    const size_t hstep = (size_t)HALF * K * 2;
    const size_t tstep = 2 * hstep; const size_t hstepA = (size_t)HALF * g.lda * 2, tstepA = 2 * hstepA;
    const unsigned ldsw = (unsigned)wid * 1024u;
    const int aoff = lds_byte(wr * 64 + fr, fq * 8), boff = lds_byte(wc * 32 + fr, fq * 8);
#define PG8_SA(b, h) (((b) * 2 + (h)) * HTB)
#define PG8_SB(b, h) ((4 + (b) * 2 + (h)) * HTB)
#define PG8_STAGE(bufoff, gbase, voff) do { _Pragma("unroll") for (int _i = 0; _i < 2; ++_i) \
        __builtin_amdgcn_global_load_lds((const unsigned*)((const char*)(gbase) + (voff)[_i]), (PG8_LAS unsigned*)(lds + (bufoff) + ldsw + _i * 8192), 16, 0, 0); } while (0)
#define PG8_LDA(dst, b, h) do { _Pragma("unroll") for (int m = 0; m < 4; ++m) _Pragma("unroll") for (int k = 0; k < 2; ++k) dst[m][k] = *(const PG8_LAS bf16x8*)(lds + PG8_SA(b, h) + aoff + m * 2048 + k * 1024); } while (0)
#define PG8_LDB(dst, b, h) do { _Pragma("unroll") for (int n = 0; n < 2; ++n) _Pragma("unroll") for (int k = 0; k < 2; ++k) dst[n][k] = *(const PG8_LAS bf16x8*)(lds + PG8_SB(b, h) + boff + n * 2048 + k * 1024); } while (0)
#define PG8_MMA(ai, bj, At, Bt) do { __builtin_amdgcn_s_setprio(1); _Pragma("unroll") for (int m = 0; m < 4; ++m) _Pragma("unroll") for (int n = 0; n < 2; ++n) _Pragma("unroll") for (int k = 0; k < 2; ++k) \
        acc[ai][bj][m][n] = __builtin_amdgcn_mfma_f32_16x16x32_bf16(Bt[n][k], At[m][k], acc[ai][bj][m][n], 0, 0, 0); __builtin_amdgcn_s_setprio(0); } while (0)
#define PG8_WAIT_V(n) asm volatile("s_waitcnt vmcnt(" #n ")" ::: "memory")
#define PG8_WAIT_L(n) asm volatile("s_waitcnt lgkmcnt(" #n ")" ::: "memory")
#define PG8_BAR __builtin_amdgcn_s_barrier()
#define PG8_SCHED __builtin_amdgcn_sched_barrier(0)
    Unit cur, nxt; int ui = 0;
    if (!S.next(0, cur)) return;
    f32x4 acc[2][2][4][2];
#pragma unroll
    for (int a = 0; a < 2; ++a)
#pragma unroll
        for (int b = 0; b < 2; ++b)
#pragma unroll
            for (int m = 0; m < 4; ++m)
#pragma unroll
                for (int n = 0; n < 2; ++n) acc[a][b][m][n] = (f32x4){0.f, 0.f, 0.f, 0.f};
    bf16x8 At[4][2], B0[2][2], B1[2][2];
    const char* cA = (const char*)g.A + (size_t)cur.pm * tstepA; const char* cB = (const char*)g.Bt + (size_t)cur.pn * tstep;
    S.a_ready(cur);
    if constexpr (SP2) {
        PG8_STAGE(PG8_SB(0, 0), cB, voffB); PG8_STAGE(PG8_SB(0, 1), cB + hstep, voffB); PG8_STAGE(PG8_SA(0, 0), cA, voffA); PG8_STAGE(PG8_SA(0, 1), cA + hstepA, voffA);
        if (wr == 1) PG8_BAR;
        PG8_WAIT_V(2); PG8_BAR;
        PG8_STAGE(PG8_SB(1, 0), cB + kstep, voffB); PG8_STAGE(PG8_SA(1, 0), cA + kstep, voffA); PG8_STAGE(PG8_SB(1, 1), cB + hstep + kstep, voffB);
        PG8_WAIT_V(6); PG8_BAR;
    } else {
        PG8_STAGE(PG8_SB(0, 0), cB, voffB); PG8_STAGE(PG8_SA(0, 0), cA, voffA); PG8_STAGE(PG8_SB(0, 1), cB + hstep, voffB); PG8_STAGE(PG8_SA(0, 1), cA + hstepA, voffA);
        if (wr == 1) PG8_BAR;
        PG8_WAIT_V(4); PG8_BAR;
        PG8_STAGE(PG8_SB(1, 0), cB + kstep, voffB); PG8_STAGE(PG8_SA(1, 0), cA + kstep, voffA); PG8_STAGE(PG8_SB(1, 1), cB + hstep + kstep, voffB);
        PG8_WAIT_V(6); PG8_BAR;
    }
    for (;;) {
        const bool has_next = S.next(ui + 1, nxt);
        const char* nA = has_next ? (const char*)g.A + (size_t)nxt.pm * tstepA : cA; const char* nB = has_next ? (const char*)g.Bt + (size_t)nxt.pn * tstep : cB;
        for (int t = 0; t < nt; t += 2) {
            const bool last = (t == nt - 2);
            const char* a1 = cA + (size_t)(t + 1) * kstep;
            const char* a2 = last ? nA : cA + (size_t)(t + 2) * kstep; const char* b2 = last ? nB : cB + (size_t)(t + 2) * kstep;
            const char* a3 = a2 + kstep; const char* b3 = b2 + kstep;
            if (last && has_next) S.a_ready(nxt);
            if constexpr (SP2) {
            PG8_LDB(B0, 0, 0); PG8_LDB(B1, 0, 1); PG8_SCHED; PG8_LDA(At, 0, 0); PG8_STAGE(PG8_SA(1, 1), a1 + hstepA, voffA);
            PG8_WAIT_V(8); PG8_WAIT_L(0); PG8_BAR; PG8_MMA(0, 0, At, B0); PG8_MMA(0, 1, At, B1); PG8_BAR; PG8_SCHED;
            PG8_LDA(At, 0, 1); PG8_STAGE(PG8_SB(0, 0), b2, voffB); PG8_STAGE(PG8_SB(0, 1), b2 + hstep, voffB); PG8_STAGE(PG8_SA(0, 0), a2, voffA);
            PG8_WAIT_V(8); PG8_WAIT_L(0); PG8_BAR; PG8_MMA(1, 0, At, B0); PG8_MMA(1, 1, At, B1); PG8_BAR; PG8_SCHED;
            PG8_LDB(B0, 1, 0); PG8_LDB(B1, 1, 1); PG8_SCHED; PG8_LDA(At, 1, 0); PG8_STAGE(PG8_SA(0, 1), a2 + hstepA, voffA);
            PG8_WAIT_V(8); PG8_WAIT_L(0); PG8_BAR; PG8_MMA(0, 0, At, B0); PG8_MMA(0, 1, At, B1); PG8_BAR; PG8_SCHED;
            PG8_LDA(At, 1, 1); PG8_STAGE(PG8_SB(1, 0), b3, voffB); PG8_STAGE(PG8_SB(1, 1), b3 + hstep, voffB); PG8_STAGE(PG8_SA(1, 0), a3, voffA);
            PG8_WAIT_V(8); PG8_WAIT_L(0); PG8_BAR; PG8_MMA(1, 0, At, B0); PG8_MMA(1, 1, At, B1); PG8_BAR; PG8_SCHED;
            } else {
            PG8_LDB(B0, 0, 0); PG8_SCHED; PG8_LDA(At, 0, 0); PG8_STAGE(PG8_SA(1, 1), a1 + hstepA, voffA);
            PG8_WAIT_L(8); PG8_BAR; PG8_WAIT_L(0); PG8_MMA(0, 0, At, B0); PG8_BAR; PG8_SCHED;
            PG8_LDB(B1, 0, 1); PG8_STAGE(PG8_SB(0, 0), b2, voffB);
            PG8_BAR; PG8_WAIT_L(0); PG8_MMA(0, 1, At, B1); PG8_BAR;
            PG8_LDA(At, 0, 1); PG8_STAGE(PG8_SA(0, 0), a2, voffA);
            PG8_BAR; PG8_WAIT_L(0); PG8_MMA(1, 0, At, B0); PG8_BAR; PG8_SCHED;
            PG8_STAGE(PG8_SB(0, 1), b2 + hstep, voffB);
            PG8_WAIT_V(6); PG8_BAR; PG8_MMA(1, 1, At, B1); PG8_BAR;
            PG8_LDB(B0, 1, 0); PG8_SCHED; PG8_LDA(At, 1, 0); PG8_STAGE(PG8_SA(0, 1), a2 + hstepA, voffA);
            PG8_WAIT_L(8); PG8_BAR; PG8_WAIT_L(0); PG8_MMA(0, 0, At, B0); PG8_BAR; PG8_SCHED;
            PG8_LDB(B1, 1, 1); PG8_STAGE(PG8_SB(1, 0), b3, voffB);
            PG8_BAR; PG8_WAIT_L(0); PG8_MMA(0, 1, At, B1); PG8_BAR;
            PG8_LDA(At, 1, 1); PG8_STAGE(PG8_SA(1, 0), a3, voffA);
            PG8_BAR; PG8_WAIT_L(0); PG8_MMA(1, 0, At, B0); PG8_BAR; PG8_SCHED;
            PG8_STAGE(PG8_SB(1, 1), b3 + hstep, voffB);
            PG8_WAIT_V(6); PG8_BAR; PG8_MMA(1, 1, At, B1); PG8_BAR;
            }
        }
        if constexpr (ALIGN_EPI) { if (wr == 0) PG8_BAR; }
        if constexpr (!Epi::AFTER_DRAIN) { E(acc, cur, wr, wc, fr, fq); S.done(cur); }
        if (!has_next) break;
#pragma unroll
        for (int a = 0; a < 2; ++a)
#pragma unroll
            for (int b = 0; b < 2; ++b)
#pragma unroll
                for (int m = 0; m < 4; ++m)
#pragma unroll
                    for (int n = 0; n < 2; ++n) acc[a][b][m][n] = (f32x4){0.f, 0.f, 0.f, 0.f};
        cur = nxt; cA = nA; cB = nB; ++ui;
        if constexpr (ALIGN_EPI) { if (wr == 1) PG8_BAR; }
    }
    PG8_WAIT_V(0);
    if constexpr (!ALIGN_EPI) { if (wr == 0) PG8_BAR; }
    PG8_BAR;
    if constexpr (Epi::AFTER_DRAIN) { E.fused(acc, cur, wr, wc, fr, fq, lds, wid, lane); S.done(cur); }
#undef PG8_SA
#undef PG8_SB
#undef PG8_STAGE
#undef PG8_LDA
#undef PG8_LDB
#undef PG8_MMA
#undef PG8_WAIT_V
#undef PG8_WAIT_L
#undef PG8_BAR
#undef PG8_SCHED
}
struct SchedX { StaticOrder so; bool skip;
  __device__ __forceinline__ bool next(int i, Unit& u) const { if (!so.next(i, u)) return false; if (skip) u.pm = u.pm + 1 + (u.pm >= 32 ? 1 : 0); return true; }
  __device__ __forceinline__ void a_ready(const Unit&) const {}
  __device__ __forceinline__ void done(const Unit&) const {} };
}
struct EpiRec8 { static constexpr bool PERM = false, AFTER_DRAIN = false; bf16_t* P1; bf16_t* P2; float* SM;
  DI void operator()(const f32x4 (&acc)[2][2][4][2], const pg8::Unit& u, int wr, int wc, int fr, int fq) const {
#pragma unroll
    for (int ai = 0; ai < 2; ++ai)
#pragma unroll
      for (int m = 0; m < 4; ++m) { const size_t row = (size_t)u.pm * 256 + ai * 128 + wr * 64 + m * 16 + fr;
#pragma unroll
        for (int bj = 0; bj < 2; ++bj)
#pragma unroll
          for (int n = 0; n < 2; ++n) { const int col = u.pn * 256 + bj * 128 + wc * 32 + n * 16 + fq * 4; const f32x4 v = acc[ai][bj][m][n];
            if (u.pn < 6) { uint2 w; w.x = cvtpk(v[0], v[1]); w.y = cvtpk(v[2], v[3]); *(uint2*)(P1 + row * 1536 + col) = w; }
            else if (u.pn < 14) { uint2 w; w.x = cvtpk(v[0], v[1]); w.y = cvtpk(v[2], v[3]); *(uint2*)(P2 + row * 2048 + (col - 1536)) = w; }
            else { const int lc = col - 3584; if (lc < 48) *(f32x4*)(SM + row * 64 + lc) = v; } } } } };
struct EpiBf8 { static constexpr bool PERM = false, AFTER_DRAIN = false; bf16_t* O; int ldc;
  DI void operator()(const f32x4 (&acc)[2][2][4][2], const pg8::Unit& u, int wr, int wc, int fr, int fq) const {
#pragma unroll
    for (int ai = 0; ai < 2; ++ai)
#pragma unroll
      for (int m = 0; m < 4; ++m) { const size_t row = (size_t)u.pm * 256 + ai * 128 + wr * 64 + m * 16 + fr;
#pragma unroll
        for (int bj = 0; bj < 2; ++bj)
#pragma unroll
          for (int n = 0; n < 2; ++n) { const int col = u.pn * 256 + bj * 128 + wc * 32 + n * 16 + fq * 4; const f32x4 v = acc[ai][bj][m][n];
            uint2 w; w.x = cvtpk(v[0], v[1]); w.y = cvtpk(v[2], v[3]); *(uint2*)(O + row * ldc + col) = w; } } } };
struct EpiRes8 { static constexpr bool PERM = false, AFTER_DRAIN = false; float* X; const float* gate;
  DI void operator()(const f32x4 (&acc)[2][2][4][2], const pg8::Unit& u, int wr, int wc, int fr, int fq) const {
    const float* gr = gate + (size_t)modrow_of(u.pm * 256) * 6144;
#pragma unroll
    for (int bj = 0; bj < 2; ++bj)
#pragma unroll
      for (int n = 0; n < 2; ++n) { const int col = u.pn * 256 + bj * 128 + wc * 32 + n * 16 + fq * 4; const f32x4 gv = *(const f32x4*)(gr + col);
#pragma unroll
        for (int ai = 0; ai < 2; ++ai)
#pragma unroll
          for (int m = 0; m < 4; ++m) { const size_t row = (size_t)u.pm * 256 + ai * 128 + wr * 64 + m * 16 + fr;
            f32x4* q = (f32x4*)(X + row * 1024 + col); *q = *q + gv * acc[ai][bj][m][n]; } } } };
template <class Epi>
__device__ __forceinline__ void gemm8(char* lds, const bf16_t* A, int lda, const bf16_t* Bt, int K, int N, bool skipctx, const Epi& E) {
  pg8::Gemm g{A, Bt, skipctx ? 16384 : MROWS, N, K, lda};
  pg8::SchedX S; S.so.init(g.M, N, GDIM(), BIDX()); S.skip = skipctx;
  pg8::gemm_phase<Epi, pg8::SchedX, true, true>((PG8_LAS unsigned char*)lds, g, S, E);
}

__device__ __forceinline__ void ph_dnprep(const P& p, char* lds, int e) {
  const int tid = TIDX(), wid = tid >> 6, lane = tid & 63;
  const bf16_t* P1 = (const bf16_t*)(p.ws + OFF_D + D_P1);
  bf16_t* QQ = (bf16_t*)(p.ws + OFF_D + D_QQ); bf16_t* QK = (bf16_t*)(p.ws + OFF_D + D_QK); bf16_t* QV = (bf16_t*)(p.ws + OFF_D + D_QV);
  bf16_t* KT = (bf16_t*)(p.ws + OFF_D + D_KT);
  const float* SM = (const float*)(p.ws + OFF_SM); float* GB = (float*)(p.ws + OFF_GB);
  const float* cw = p.rec_conv + (size_t)e * 3 * 1536;
  bf16_t* kl = (bf16_t*)lds;
  for (int job = BIDX(); job < MROWS / 64; job += GDIM()) {
    const int R0 = job * 64;
    for (int tt = 0; tt < 8; ++tt) {
      const int tl = wid * 8 + tt, R = R0 + tl; const int b = R >= TB ? 1 : 0, pp = R - b * TB;
      const bool hasp = !(pp == 0 || pp == CTXL), hasn = !(pp == CTXL - 1 || pp == TB - 1);
#pragma unroll
      for (int part = 0; part < 3; ++part) {
        const int ch = part * 512 + lane * 8;
        const bf16x8 zc = *(const bf16x8*)(P1 + (size_t)R * 1536 + ch);
        bf16x8 zp = {}, zn = {};
        if (hasp) zp = *(const bf16x8*)(P1 + (size_t)(R - 1) * 1536 + ch);
        if (hasn) zn = *(const bf16x8*)(P1 + (size_t)(R + 1) * 1536 + ch);
        float o[8]; float ss = 0.f;
#pragma unroll
        for (int j = 0; j < 8; ++j) { const float a = bf2f((bf16_t)zp[j]) * cw[ch + j] + bf2f((bf16_t)zc[j]) * cw[1536 + ch + j] + bf2f((bf16_t)zn[j]) * cw[3072 + ch + j];
          o[j] = siluf(a); ss += o[j] * o[j]; }
        if (part < 2) {
          ss += __shfl_xor(ss, 1); ss += __shfl_xor(ss, 2); ss += __shfl_xor(ss, 4); ss += __shfl_xor(ss, 8);
          float sc = rsqrtf(ss + EPSF); if (part == 0) sc *= 0.08838834764831845f;
#pragma unroll
          for (int j = 0; j < 8; ++j) o[j] *= sc;
        }
        u32x4 w = {cvtpk(o[0], o[1]), cvtpk(o[2], o[3]), cvtpk(o[4], o[5]), cvtpk(o[6], o[7])};
        bf16_t* dst = part == 0 ? QQ : (part == 1 ? QK : QV);
        *(u32x4*)(dst + (size_t)R * 512 + lane * 8) = w;
        if (part == 1) *(u32x4*)(kl + tl * 512 + lane * 8) = w;
      }
      if (lane < 16) {
        const int q = lane & 7;
        if (lane < 8) { const float da = SM[(size_t)R * 64 + q]; GB[(size_t)R * 16 + q] = -expf(p.dn_a_log[e * 8 + q]) * softplusf(da + p.dn_dt_bias[e * 8 + q]); }
        else { const float db = SM[(size_t)R * 64 + 8 + q]; GB[(size_t)R * 16 + 8 + q] = sigmf(db); }
      }
    }
    __syncthreads();
    {
      const int b = R0 >= TB ? 1 : 0, c = (R0 - b * TB) / 64; const int h = tid >> 7, dk = tid & 127;
      bf16_t* dst = KT + ((((size_t)b * 4 + h) * NCH + c) * 128 + dk) * 64;
#pragma unroll
      for (int g8 = 0; g8 < 8; ++g8) { unsigned w[4];
#pragma unroll
        for (int j = 0; j < 4; ++j) { const unsigned lo = kl[(g8 * 8 + 2 * j) * 512 + tid], hi2 = kl[(g8 * 8 + 2 * j + 1) * 512 + tid]; w[j] = lo | (hi2 << 16); }
        *(u32x4*)(dst + g8 * 8) = (u32x4){w[0], w[1], w[2], w[3]}; }
    }
    __syncthreads();
  }
}

__device__ __forceinline__ void ph_dn_d1(const P& p, char* lds) {
  const int tid = TIDX(), wid = tid >> 6, lane = tid & 63, r32 = lane & 31, hi = lane >> 5;
  const bf16_t* QQ = (const bf16_t*)(p.ws + OFF_D + D_QQ); const bf16_t* QK = (const bf16_t*)(p.ws + OFF_D + D_QK); const bf16_t* QV = (const bf16_t*)(p.ws + OFF_D + D_QV);
  const float* GB = (const float*)(p.ws + OFF_GB);
  bf16_t* W_ = (bf16_t*)(p.ws + OFF_D + D_W); bf16_t* U_ = (bf16_t*)(p.ws + OFF_HBF); bf16_t* INTRA = (bf16_t*)(p.ws + OFF_D + D_INTRA);
  float* SC = (float*)(p.ws + OFF_SC); float* GLS = (float*)(p.ws + OFF_GL);
  float* KK = (float*)lds; float* QKm = KK + 64 * 65; float* Ad = QKm + 64 * 65; float* Gs = Ad + 2 * 4096; float* Bs = Gs + 128;
  for (int job = BIDX(); job < 8 * NCH; job += GDIM()) {
    const int b = job / (4 * NCH), h = (job / NCH) & 3, c = job % NCH;
    const size_t Rb = (size_t)b * TB + (size_t)c * 64;
    {
      const int w4 = wid & 3, mi = w4 & 1, ni = w4 >> 1;
      const bf16_t* As = wid < 4 ? QK : QQ;
      const bf16_t* arow = As + (Rb + 32 * mi + r32) * 512 + h * 128 + hi * 8;
      const bf16_t* brow = QK + (Rb + 32 * ni + r32) * 512 + h * 128 + hi * 8;
      f32x16 acc = {}; acc = mma_rows<8>(arow, brow, acc);
      float* dst = wid < 4 ? KK : QKm;
#pragma unroll
      for (int r = 0; r < 16; ++r) dst[(32 * mi + crow(r, hi)) * 65 + 32 * ni + r32] = acc[r];
    }
    if (tid < 128) { const int d = tid >> 6, ip = tid & 63, t = d ? 63 - ip : ip; Gs[tid] = GB[(Rb + t) * 16 + d * 4 + h]; Bs[tid] = GB[(Rb + t) * 16 + 8 + d * 4 + h]; }
    __syncthreads();
    if (tid == 0 || tid == 64) { float s = 0.f; for (int i = 0; i < 64; ++i) { s += Gs[tid + i]; Gs[tid + i] = s; } }
    __syncthreads();
    const int n0 = c, n1 = c < 4 ? 3 - c : 135 - c;
    const size_t cj0 = ((size_t)(0 * 2 + b) * 4 + h) * NCH + n0, cj1 = ((size_t)(1 * 2 + b) * 4 + h) * NCH + n1;
    for (int e2 = tid; e2 < 8192; e2 += 512) {
      const int d = e2 >> 12, ip = (e2 >> 6) & 63, jp = e2 & 63; const int i = d ? 63 - ip : ip, j = d ? 63 - jp : jp;
      const float dec = jp <= ip ? expf(Gs[d * 64 + ip] - Gs[d * 64 + jp]) : 0.f;
      Ad[d * 4096 + ip * 64 + jp] = jp < ip ? Bs[d * 64 + ip] * KK[i * 65 + j] * dec : 0.f;
      const size_t cj = d ? cj1 : cj0;
      INTRA[(cj * 64 + ip) * 64 + jp] = f2bf(QKm[i * 65 + j] * dec);
    }
    if (tid < 128) { const int d = tid >> 6, ip = tid & 63; const size_t cj = d ? cj1 : cj0; const float gi = Gs[tid], gl = Gs[d * 64 + 63];
      SC[(cj * 64 + ip) * 2] = expf(gi); SC[(cj * 64 + ip) * 2 + 1] = expf(gl - gi); if (ip == 0) GLS[cj] = expf(gl); }
    __syncthreads();
    {
      const int d = tid >> 8, cc = tid & 255; const size_t cj = d ? cj1 : cj0;
      int dofs = d * 64, aofs = d * 4096; asm volatile("" : "+v"(dofs), "+v"(aofs));
      float x[64];
      {
        const bf16_t* srcb = (cc < 128 ? QV + h * 128 + cc : QK + h * 128 + (cc - 128)) + (Rb + (d ? 63 : 0)) * 512;
        const long step = d ? -512 : 512;
#pragma unroll
        for (int g = 0; g < 8; ++g) {
#pragma unroll
          for (int q8 = 0; q8 < 8; ++q8) { const int ip = g * 8 + q8; x[ip] = bf2f(srcb[ip * step]); }
          asm volatile("" ::: "memory");
        }
        if (cc < 128) {
#pragma unroll
          for (int ip = 0; ip < 64; ++ip) x[ip] *= Bs[dofs + ip];
        } else {
#pragma unroll
          for (int ip = 0; ip < 64; ++ip) x[ip] *= Bs[dofs + ip] * expf(Gs[dofs + ip]);
        }
      }
      const float* Arow = Ad + aofs;
#pragma unroll
      for (int ip = 1; ip < 64; ++ip) {
        float s = 0.f;
#pragma unroll
        for (int j4 = 0; j4 < (ip + 3) / 4; ++j4) { const f32x4 a = *(const f32x4*)(Arow + ip * 64 + 4 * j4);
          s += a[0] * x[4 * j4] + a[1] * x[4 * j4 + 1] + a[2] * x[4 * j4 + 2] + a[3] * x[4 * j4 + 3]; }
        x[ip] -= s;
      }
      bf16_t* dst = cc < 128 ? U_ + cj * 64 * 128 + cc : W_ + cj * 64 * 128 + (cc - 128);
#pragma unroll
      for (int ip = 0; ip < 64; ++ip) dst[ip * 128] = f2bf(x[ip]);
    }
    __syncthreads();
  }
}

typedef _Float16 h16x8 __attribute__((ext_vector_type(8)));
__device__ __forceinline__ void ph_gla_b(const P& p, char* lds, int e) {
  const int tid = TIDX(), wid = tid >> 6, lane = tid & 63;
  const float* SM = (const float*)(p.ws + OFF_SM);
  float* w2S = (float*)lds;
  float* b2S = w2S + 8192;
  for (int i = tid; i < 8192; i += 512) { const int d = i >> 12, hh = (i >> 10) & 3, r = (i >> 6) & 15, j = i & 63; w2S[i] = p.gla_w2[(((size_t)e * 2 + d) * 16 + r) * 256 + hh * 64 + j]; }
  if (tid < 512) b2S[tid] = p.gla_b2[(size_t)e * 512 + tid];
  __syncthreads();
  int jb = 8 * wid; asm volatile("" : "+v"(jb));
  for (int job = BIDX(); job < 16 * NCH; job += GDIM()) {
    const int n = job % NCH, sq = job / NCH; const int dir = sq >> 3, b = (sq >> 2) & 1, h = sq & 3;
    const int c = dir == 0 ? n : (n < 4 ? 3 - n : 135 - n);
    const size_t row = (size_t)b * TB + (size_t)c * 64 + (dir ? 63 - lane : lane);
    const float* gp = SM + row * 64 + 16 + dir * 16;
    const f32x4 g0 = *(const f32x4*)(gp), g1 = *(const f32x4*)(gp + 4), g2 = *(const f32x4*)(gp + 8), g3 = *(const f32x4*)(gp + 12);
    const float gg_[16] = {g0[0], g0[1], g0[2], g0[3], g1[0], g1[1], g1[2], g1[3], g2[0], g2[1], g2[2], g2[3], g3[0], g3[1], g3[2], g3[3]};
    const float* wb = w2S + (dir * 4 + h) * 1024 + jb; const float* bb2 = b2S + dir * 256 + h * 64 + jb;
    f32x4 sa = *(const f32x4*)(bb2), sb = *(const f32x4*)(bb2 + 4);
#pragma unroll
    for (int r = 0; r < 16; ++r) { const f32x4 wa = *(const f32x4*)(wb + r * 64), wq = *(const f32x4*)(wb + r * 64 + 4); sa += gg_[r] * wa; sb += gg_[r] * wq; }
    float la[8];
#pragma unroll
    for (int jj = 0; jj < 4; ++jj) { const float x0 = sa[jj], x1 = sb[jj];
      la[jj] = (fminf(x0, 0.f) - log1pf(expf(-fabsf(x0)))) * 0.0625f; la[4 + jj] = (fminf(x1, 0.f) - log1pf(expf(-fabsf(x1)))) * 0.0625f; }
#pragma unroll
    for (int o = 1; o < 64; o <<= 1) {
#pragma unroll
      for (int jj = 0; jj < 8; ++jj) { const float v = __shfl_up(la[jj], o); la[jj] += lane >= o ? v : 0.f; }
    }
    h16x8 hv;
#pragma unroll
    for (int jj = 0; jj < 8; ++jj) hv[jj] = (_Float16)la[jj];
    _Float16* dst = (_Float16*)(p.ws + (dir ? OFF_B16_1 : OFF_WC)) + ((((size_t)b * 4 + h) * NCH + n) * 64 + lane) * 64 + jb;
    *(h16x8*)dst = hv;
  }
}

struct DnSet { bf16x8 fa[8]; };
__device__ __forceinline__ void dn_scan(const P& p, char* lds, int job) {
  const int tid = TIDX(), wid = tid >> 6, lane = tid & 63, r32 = lane & 31, hi = lane >> 5;
  const int dir = job >> 5, b = (job >> 4) & 1, h = (job >> 2) & 3, n0 = (job & 3) * 32;
  const bf16_t* QQ = (const bf16_t*)(p.ws + OFF_D + D_QQ); const bf16_t* KT = (const bf16_t*)(p.ws + OFF_D + D_KT);
  const bf16_t* W_ = (const bf16_t*)(p.ws + OFF_D + D_W); const bf16_t* U_ = (const bf16_t*)(p.ws + OFF_HBF); const bf16_t* INTRA = (const bf16_t*)(p.ws + OFF_D + D_INTRA);
  const float* SC = (const float*)(p.ws + OFF_SC); const float* GLS = (const float*)(p.ws + OFF_GL);
  bf16_t* DNO = (bf16_t*)(p.ws + OFF_D + D_DNO);
  bf16_t* ST = (bf16_t*)lds; bf16_t* vTa = ST + 32 * 136; bf16_t* vTb = vTa + 32 * 72;
  float* scS = (float*)(vTb + 32 * 72);
  bf16_t* uS = (bf16_t*)(scS + 256);
  bf16_t* inS = uS + 2 * 64 * 40;
  for (int i = tid; i < 32 * 136; i += 512) ST[i] = 0;
  f32x16 accS = {};
  const size_t seq = ((size_t)dir * 2 + b) * 4 + h;
  const int mi = wid & 1, di = wid - 4;
  const int role = wid < 2 ? 0 : (wid < 4 ? 1 : 2);
  const int tt = tid - 256;
  DnSet fs[3]; float gls[3] = {0.f, 0.f, 0.f};
  u32x4 stU[2], stI0[2]; float stS[2] = {0.f, 0.f};
#define DN_CH(n_) const int n__ = (n_); const int c__ = dir == 0 ? n__ : (n__ < 4 ? 3 - n__ : 135 - n__); const size_t Rb__ = (size_t)b * TB + (size_t)c__ * 64; const size_t cj__ = seq * NCH + n__;
#define DN_LOAD(S, GL, n_) do { DN_CH(n_) \
    const int ipl__ = 32 * mi + r32, tl__ = dir ? 63 - ipl__ : ipl__; \
    const bf16_t* b0__ = W_ + cj__ * 8192 + (32 * mi + r32) * 128 + hi * 8; \
    const bf16_t* b1__ = QQ + (Rb__ + tl__) * 512 + h * 128 + hi * 8; \
    const bf16_t* b2__ = KT + ((((size_t)b * 4 + h) * NCH + c__) * 128 + 32 * (wid & 3) + r32) * 64 + hi * 8; \
    const bf16_t* bs__ = role == 0 ? b0__ : (role == 1 ? b1__ : b2__); \
    _Pragma("unroll") for (int ks = 0; ks < 8; ++ks) S.fa[ks] = *(const bf16x8*)(bs__ + ks * 16); \
    GL = GLS[cj__]; } while (0)
#define DN_STAGE_LD(q_, n_) do { DN_CH(n_) (void)Rb__; \
      stU[q_] = *(const u32x4*)(U_ + cj__ * 8192 + ((tid & 255) >> 2) * 128 + n0 + (tid & 3) * 8); \
      stI0[q_] = *(const u32x4*)(INTRA + cj__ * 4096 + (tid >> 3) * 64 + (tid & 7) * 8); \
      stS[q_] = SC[cj__ * 128 + (tid & 127)]; } while (0)
#define DN_STAGE_ST(q_, bf_) do { *(u32x4*)(inS + (bf_) * 4608 + (tid >> 3) * 72 + (tid & 7) * 8) = stI0[q_]; \
      if (tid < 256) *(u32x4*)(uS + (bf_) * 2560 + (tid >> 2) * 40 + (tid & 3) * 8) = stU[q_]; \
      if (tid < 128) scS[(bf_) * 128 + tid] = stS[q_]; } while (0)
#define DN_STEP(S, GL, n_, bf_) do { DN_CH(n_) (void)cj__; \
    const float* sc__ = scS + (bf_) * 128; \
    if (role < 2) { _Pragma("unroll") for (int r = 0; r < 16; ++r) accS[r] = 0.f; } \
    if (role < 2) { const bf16_t* sb__ = ST + r32 * 136 + hi * 8; \
      _Pragma("unroll") for (int ks = 0; ks < 8; ++ks) accS = MFMA32(S.fa[ks], *(const bf16x8*)(sb__ + ks * 16), accS); \
      if (role == 0) { const bf16_t* us__ = uS + (bf_) * 2560 + r32; \
        _Pragma("unroll") for (int r = 0; r < 16; ++r) { const int ip = 32 * mi + crow(r, hi); const float vn = bf2f(us__[ip * 40]) - accS[r]; \
          vTa[r32 * 72 + ip] = f2bf(vn); const int to = dir ? 63 - ip : ip; vTb[r32 * 72 + to] = f2bf(vn * sc__[ip * 2 + 1]); } } \
      else { _Pragma("unroll") for (int r = 0; r < 16; ++r) accS[r] *= sc__[(32 * mi + crow(r, hi)) * 2]; } } \
    LBAR(); \
    if (role == 1) { const bf16_t* vb__ = vTa + r32 * 72 + hi * 8; const bf16_t* ib__ = inS + (bf_) * 4608 + (32 * mi + r32) * 72 + hi * 8; \
      _Pragma("unroll") for (int ks = 0; ks < 4; ++ks) accS = MFMA32(*(const bf16x8*)(ib__ + ks * 16), *(const bf16x8*)(vb__ + ks * 16), accS); \
      _Pragma("unroll") for (int r = 0; r < 16; ++r) { const int ip = 32 * mi + crow(r, hi), t = dir ? 63 - ip : ip; \
        DNO[((size_t)dir * MROWS + Rb__ + t) * 512 + h * 128 + n0 + r32] = f2bf(accS[r]); } } \
    else if (role == 2) { const bf16_t* vb__ = vTb + r32 * 72 + hi * 8; \
      _Pragma("unroll") for (int r = 0; r < 16; ++r) accS[r] *= GL; \
      _Pragma("unroll") for (int ks = 0; ks < 4; ++ks) accS = MFMA32(S.fa[ks], *(const bf16x8*)(vb__ + ks * 16), accS); \
      _Pragma("unroll") for (int r = 0; r < 16; ++r) ST[r32 * 136 + 32 * di + crow(r, hi)] = f2bf(accS[r]); } \
    LBAR(); } while (0)
  DN_STAGE_LD(0, 0); DN_STAGE_ST(0, 0); DN_STAGE_LD(1, 1);
  DN_LOAD(fs[0], gls[0], 0); DN_LOAD(fs[1], gls[1], 1);
  __syncthreads();
  for (int nb6 = 0; nb6 < NCH; nb6 += 6) {
#pragma unroll
    for (int k = 0; k < 6; ++k) {
      const int n = nb6 + k; const int n2 = n + 2 < NCH ? n + 2 : NCH - 1;
      DN_STAGE_ST((k + 1) & 1, (k + 1) & 1);
      DN_LOAD(fs[(k + 2) % 3], gls[(k + 2) % 3], n2); DN_STAGE_LD(k & 1, n2);
      DN_STEP(fs[k % 3], gls[k % 3], n, k & 1);
    }
  }
#undef DN_CH
#undef DN_LOAD
#undef DN_STAGE_LD
#undef DN_STAGE_ST
#undef DN_STEP
}

DI float fast_logsig(float s) { return fminf(s, 0.f) - __logf(1.f + __expf(-fabsf(s))); }
struct GlaRegs { h16x8 ba, bb; bf16x8 qa, qb, ka, kb, v8; };
__device__ __forceinline__ void gla_scan(const P& p, char* lds, int job, int e) {
  const int tid = TIDX(), wid = tid >> 6, lane = tid & 63, r32 = lane & 31, hi = lane >> 5;
  const int dir = job >> 5, b = (job >> 4) & 1, h = (job >> 2) & 3, n0 = (job & 3) * 32;
  const bf16_t* P2 = (const bf16_t*)(p.ws + OFF_D + D_P2); const float* SM = (const float*)(p.ws + OFF_SM);
  bf16_t* GLAO = (bf16_t*)(p.ws + OFF_D + D_GLAO);
  const _Float16* B16 = (const _Float16*)(p.ws + (dir ? OFF_B16_1 : OFF_WC));
  float* w2S = (float*)lds; float* b2S = w2S + 1024; float* aLb = b2S + 64;
  bf16_t* ops = (bf16_t*)(aLb + 128);
  constexpr int OPB = (4 * 64 + 32) * 72;
  bf16_t* attp = ops + 2 * OPB;
  bf16_t* STb = attp + 2 * 32 * 72;
  for (int i = tid; i < 2 * 32 * 72; i += 512) STb[i] = 0;
  f32x16 accS = {};
  __syncthreads();
  GlaRegs RG[3];
  int jb0 = 16 * (wid & 3); asm volatile("" : "+v"(jb0));
  int vtb0 = 8 * (wid & 3) * 72 + lane; asm volatile("" : "+v"(vtb0));
#define GLA_LOAD(R, n_) do { const int n__ = (n_) < NCH ? (n_) : NCH - 1; const int c__ = dir == 0 ? n__ : (n__ < 4 ? 3 - n__ : 135 - n__); const size_t row__ = (size_t)b * TB + (size_t)c__ * 64 + (dir ? 63 - lane : lane); \
    const _Float16* bp__ = B16 + ((((size_t)b * 4 + h) * NCH + n__) * 64 + lane) * 64 + 16 * (wid & 3); R.ba = *(const h16x8*)(bp__); R.bb = *(const h16x8*)(bp__ + 8); \
    const bf16_t* pr__ = P2 + row__ * 2048; R.qa = *(const bf16x8*)(pr__ + 512 + h * 64 + 16 * (wid & 3)); R.qb = *(const bf16x8*)(pr__ + 512 + h * 64 + 16 * (wid & 3) + 8); \
    R.ka = *(const bf16x8*)(pr__ + 768 + h * 64 + 16 * (wid & 3)); R.kb = *(const bf16x8*)(pr__ + 768 + h * 64 + 16 * (wid & 3) + 8); R.v8 = *(const bf16x8*)(pr__ + 1024 + h * 128 + n0 + 8 * (wid & 3)); } while (0)
#define GLA_HALF(R, BV, QV, KV, jb) do { \
    float eqe[8], eke[8], eqi[8]; \
    _Pragma("unroll") for (int jj = 0; jj < 8; ++jj) { const int j = (jb) + jj; const float bb = (float)BV[jj]; const float bm = __int_as_float(__builtin_amdgcn_readlane(__float_as_int(bb), 32)), bl = __int_as_float(__builtin_amdgcn_readlane(__float_as_int(bb), 63)); \
      const float q_ = bf2f((bf16_t)QV[jj]) * 0.125f, k_ = bf2f((bf16_t)KV[jj]); \
      eqe[jj] = q_ * __expf(bb - bm); eke[jj] = k_ * __expf(bm - bb); eqi[jj] = q_ * __expf(bb); ksT_[j * 72 + lane] = f2bf(k_ * __expf(bl - bb)); if (lane == 63) aL_[j] = __expf(bl); } \
    *(u32x4*)(qe_ + lane * 72 + (jb)) = (u32x4){cvtpk(eqe[0], eqe[1]), cvtpk(eqe[2], eqe[3]), cvtpk(eqe[4], eqe[5]), cvtpk(eqe[6], eqe[7])}; \
    *(u32x4*)(ke_ + lane * 72 + (jb)) = (u32x4){cvtpk(eke[0], eke[1]), cvtpk(eke[2], eke[3]), cvtpk(eke[4], eke[5]), cvtpk(eke[6], eke[7])}; \
    *(u32x4*)(qi_ + lane * 72 + (jb)) = (u32x4){cvtpk(eqi[0], eqi[1]), cvtpk(eqi[2], eqi[3]), cvtpk(eqi[4], eqi[5]), cvtpk(eqi[6], eqi[7])}; } while (0)
#define GLA_PREP(R, bf_) do { bf16_t* qe_ = ops + (bf_) * OPB; bf16_t* ke_ = qe_ + 64 * 72; bf16_t* qi_ = ke_ + 64 * 72; bf16_t* ksT_ = qi_ + 64 * 72; bf16_t* vT_ = ksT_ + 64 * 72; float* aL_ = aLb + (bf_) * 64; \
    GLA_HALF(R, R.ba, R.qa, R.ka, jb0); GLA_HALF(R, R.bb, R.qb, R.kb, jb0 + 8); \
    _Pragma("unroll") for (int q_ = 0; q_ < 8; ++q_) vT_[vtb0 + q_ * 72] = (bf16_t)R.v8[q_]; } while (0)
#define GLA_MMA(n_, bf_) do { const int nq__ = (n_); const int bf = (bf_); \
      const bf16_t* qe_ = ops + bf * OPB; const bf16_t* ke_ = qe_ + 64 * 72; const bf16_t* qi_ = ke_ + 64 * 72; const bf16_t* ksT_ = qi_ + 64 * 72; const bf16_t* vT_ = ksT_ + 64 * 72; const float* aL_ = aLb + bf * 64; \
      const bf16_t* STr = STb + bf * 32 * 72; bf16_t* STw = STb + (bf ^ 1) * 32 * 72; \
      if (wid < 6) { \
        const int mi = wid - 4; bf16_t* attw = attp + mi * 32 * 72; \
        const int c = dir == 0 ? nq__ : (nq__ < 4 ? 3 - nq__ : 135 - nq__); const size_t Rb = (size_t)b * TB + (size_t)c * 64; \
        f32x16 acc = {}; acc = mma_rows<4>(qi_ + (32 * mi + r32) * 72 + hi * 8, STr + r32 * 72 + hi * 8, acc); \
        { f32x16 a0 = {}; a0 = mma_rows<4>(qe_ + (32 * mi + r32) * 72 + hi * 8, ke_ + r32 * 72 + hi * 8, a0); \
          _Pragma("unroll") for (int r = 0; r < 16; ++r) { const int ipl = crow(r, hi); attw[ipl * 72 + r32] = f2bf((mi == 1 || r32 <= ipl) ? a0[r] : 0.f); } \
          f32x16 a1 = {}; if (mi == 1) a1 = mma_rows<4>(qe_ + (32 + r32) * 72 + hi * 8, ke_ + (32 + r32) * 72 + hi * 8, a1); \
          _Pragma("unroll") for (int r = 0; r < 16; ++r) { const int ipl = crow(r, hi); attw[ipl * 72 + 32 + r32] = f2bf((mi == 1 && r32 <= ipl) ? a1[r] : 0.f); } } \
        asm volatile("s_waitcnt lgkmcnt(0)" ::: "memory"); \
        acc = mma_rows<4>(attw + r32 * 72 + hi * 8, vT_ + r32 * 72 + hi * 8, acc); \
        _Pragma("unroll") for (int r = 0; r < 16; ++r) { const int ip = 32 * mi + crow(r, hi), t = dir ? 63 - ip : ip; \
          GLAO[((size_t)dir * MROWS + Rb + t) * 512 + h * 128 + n0 + r32] = f2bf(acc[r]); } \
      } else { \
        const int di = wid - 6; \
        _Pragma("unroll") for (int r = 0; r < 16; ++r) accS[r] *= aL_[32 * di + crow(r, hi)]; \
        accS = mma_rows<4>(ksT_ + (32 * di + r32) * 72 + hi * 8, vT_ + r32 * 72 + hi * 8, accS); \
        _Pragma("unroll") for (int r = 0; r < 16; ++r) STw[r32 * 72 + 32 * di + crow(r, hi)] = f2bf(accS[r]); \
      } } while (0)
  GLA_LOAD(RG[0], 0);
  if (wid < 4) { GLA_PREP(RG[0], 0); }
  GLA_LOAD(RG[1], 1); GLA_LOAD(RG[2], 2); GLA_LOAD(RG[0], 3);
  LBAR();
  for (int nb6 = 0; nb6 < NCH; nb6 += 6) {
#pragma unroll
    for (int k = 0; k < 6; ++k) {
      const int n = nb6 + k;
      if (wid < 4) { if (n + 1 < NCH) { GLA_PREP(RG[(k + 1) % 3], (k + 1) & 1); } } else { GLA_MMA(n, k & 1); }
      GLA_LOAD(RG[(k + 1) % 3], n + 4);
      LBAR();
    }
  }
#undef GLA_MMA
#undef GLA_LOAD
#undef GLA_HALF
#undef GLA_PREP
}

__device__ __forceinline__ void ph_merge(const P& p, int e) {
  const int tid = TIDX(), wid = tid >> 6, lane = tid & 63, l16 = lane & 15, sub = lane >> 4;
  const bf16_t* DNO = (const bf16_t*)(p.ws + OFF_D + D_DNO); const bf16_t* GLAO = (const bf16_t*)(p.ws + OFF_D + D_GLAO);
  const bf16_t* P2 = (const bf16_t*)(p.ws + OFF_D + D_P2); bf16_t* hb = (bf16_t*)(p.ws + OFF_HBF);
  f32x8 nwd = *(const f32x8*)(p.dn_norm + e * 128 + l16 * 8), nwg = *(const f32x8*)(p.gla_norm + e * 128 + l16 * 8);
  for (int R4 = (BIDX() * 8 + wid) * 4; R4 < MROWS; R4 += GDIM() * 32) {
    const size_t R = R4 + sub;
    bf16x8 a[8], bq[8], zz[8];
#pragma unroll
    for (int g = 0; g < 8; ++g) { const bf16_t* src = g < 4 ? DNO : GLAO; const int hc = (g & 3) * 128 + l16 * 8;
      a[g] = *(const bf16x8*)(src + R * 512 + hc); bq[g] = *(const bf16x8*)(src + ((size_t)MROWS + R) * 512 + hc);
      zz[g] = *(const bf16x8*)(P2 + R * 2048 + (g < 4 ? 0 : 1536) + hc); }
#pragma unroll
    for (int g = 0; g < 8; ++g) {
      float v[8]; float ss = 0.f;
#pragma unroll
      for (int j = 0; j < 8; ++j) { v[j] = bf2f((bf16_t)a[g][j]) + bf2f((bf16_t)bq[g][j]); ss += v[j] * v[j]; }
      ss += __shfl_xor(ss, 1); ss += __shfl_xor(ss, 2); ss += __shfl_xor(ss, 4); ss += __shfl_xor(ss, 8);
      const float rs = rsqrtf(ss * (1.f / 128.f) + EPSF);
      float o[8];
#pragma unroll
      for (int j = 0; j < 8; ++j) o[j] = v[j] * rs * (g < 4 ? nwd[j] : nwg[j]) * siluf(bf2f((bf16_t)zz[g][j]));
      *(u32x4*)(hb + R * 1024 + g * 128 + l16 * 8) = (u32x4){cvtpk(o[0], o[1]), cvtpk(o[2], o[3]), cvtpk(o[4], o[5]), cvtpk(o[6], o[7])};
    }
  }
}

DI float silu_fast(float x) { return x / (1.f + __expf(-x)); }
__device__ __forceinline__ void ph_ffnact(const P& p, int L) {
  bf16_t* U = (bf16_t*)(p.ws + OFF_D);
  const float* cw = p.ffn_conv + (size_t)L * 3 * DFF;
  const size_t items = (size_t)MROWS * 352, stride = (size_t)GDIM() * 512;
  for (size_t it0 = (size_t)BIDX() * 512 + TIDX(); it0 < items; it0 += 2 * stride) {
    bf16x8 zc[2], zp[2], zn[2], vv[2]; int Rr[2], cc[2]; bool ok[2];
#pragma unroll
    for (int q = 0; q < 2; ++q) {
      size_t it = it0 + q * stride; ok[q] = it < items; if (!ok[q]) it = it0;
      const int R = (int)(it / 352), c0 = (int)(it % 352) * 8; const int b = R >= TB ? 1 : 0, pp = R - b * TB;
      const bool hasp = !(pp == 0 || pp == CTXL), hasn = !(pp == CTXL - 1 || pp == TB - 1);
      Rr[q] = R; cc[q] = c0;
      zc[q] = *(const bf16x8*)(U + (size_t)R * 5632 + c0);
      zp[q] = *(const bf16x8*)(U + (size_t)(hasp ? R - 1 : R) * 5632 + c0);
      zn[q] = *(const bf16x8*)(U + (size_t)(hasn ? R + 1 : R) * 5632 + c0);
      vv[q] = *(const bf16x8*)(U + (size_t)R * 5632 + DFF + c0);
      if (!hasp) zp[q] = (bf16x8){0, 0, 0, 0, 0, 0, 0, 0};
      if (!hasn) zn[q] = (bf16x8){0, 0, 0, 0, 0, 0, 0, 0};
    }
#pragma unroll
    for (int q = 0; q < 2; ++q) {
      const int c0 = cc[q];
      const f32x8 w0 = *(const f32x8*)(cw + c0), w1 = *(const f32x8*)(cw + DFF + c0), w2 = *(const f32x8*)(cw + 2 * DFF + c0);
      float o[8];
#pragma unroll
      for (int j = 0; j < 8; ++j) { const float a = bf2f((bf16_t)zp[q][j]) * w0[j] + bf2f((bf16_t)zc[q][j]) * w1[j] + bf2f((bf16_t)zn[q][j]) * w2[j];
        o[j] = silu_fast(a) * bf2f((bf16_t)vv[q][j]); }
      if (ok[q]) *(u32x4*)(U + (size_t)Rr[q] * 5632 + DFF + c0) = (u32x4){cvtpk(o[0], o[1]), cvtpk(o[2], o[3]), cvtpk(o[4], o[5]), cvtpk(o[6], o[7])};
    }
  }
}

__device__ __forceinline__ void ph_qknorm(const P& p, char* lds, int o) {
  const int tid = TIDX(), wid = tid >> 6, lane = tid & 63, l16 = lane & 15, sub = lane >> 4;
  bf16_t* QKV = (bf16_t*)(p.ws + OFF_D);
  float* tab = (float*)lds;
  for (int i = tid; i < 4096; i += 512) { const int pos = i >> 5, f = i & 31; const float ang = (float)pos * powf(10000.f, -(float)f / 32.f); tab[2 * i] = cosf(ang); tab[2 * i + 1] = sinf(ang); }
  __syncthreads();
  const f32x8 qn = *(const f32x8*)(p.att_q_norm + o * 128 + l16 * 8), kn = *(const f32x8*)(p.att_k_norm + o * 128 + l16 * 8);
  const int f0 = (l16 & 3) * 8;
  for (int R4 = (BIDX() * 8 + wid) * 4; R4 < MROWS; R4 += GDIM() * 32) {
    const int R = R4 + sub; const int b = R >= TB ? 1 : 0, pp = R - b * TB; const bool lat = pp >= CTXL; const int t = lat ? pp - CTXL : 0;
    const int pos = (l16 < 8) ? (t >> 6) : (t & 63);
    bf16_t* base = QKV + (size_t)R * 1536 + l16 * 8;
    bf16x8 x[10];
#pragma unroll
    for (int hd = 0; hd < 10; ++hd) x[hd] = *(const bf16x8*)(base + hd * 128);
    float cs[8], sn[8];
#pragma unroll
    for (int j = 0; j < 8; ++j) { const float2 t2 = *(const float2*)(tab + 2 * (pos * 32 + f0 + j)); cs[j] = lat ? t2.x : 1.f; sn[j] = lat ? t2.y : 0.f; }
#pragma unroll
    for (int hd = 0; hd < 10; ++hd) {
      float v[8]; float ss = 0.f;
#pragma unroll
      for (int j = 0; j < 8; ++j) { v[j] = bf2f((bf16_t)x[hd][j]); ss += v[j] * v[j]; }
      ss += __shfl_xor(ss, 1); ss += __shfl_xor(ss, 2); ss += __shfl_xor(ss, 4); ss += __shfl_xor(ss, 8);
      const float rs = rsqrtf(ss * (1.f / 128.f) + EPSF);
      float ov[8];
#pragma unroll
      for (int j = 0; j < 8; ++j) { v[j] = v[j] * rs * (hd < 8 ? qn[j] : kn[j]); const float pr = __shfl_xor(v[j], 4);
        ov[j] = (l16 & 4) ? (pr * sn[j] + v[j] * cs[j]) : (v[j] * cs[j] - pr * sn[j]); }
      *(u32x4*)(base + hd * 128) = (u32x4){cvtpk(ov[0], ov[1]), cvtpk(ov[2], ov[3]), cvtpk(ov[4], ov[5]), cvtpk(ov[6], ov[7])};
    }
  }
}

namespace at {
constexpr int D = 128, NW = 8, QBLK = 32, KVBLK = 64;
constexpr float SCALE = 0.088388347648318440f, THR = 8.f;
constexpr int LDQ = 1536, LDK = 1536, LDO = 1024;
constexpr size_t SHM_V = KVBLK * D * 2, SHM_K = KVBLK * D * 2;
#define KSWZ(row, colB) ((row) * 256 + ((colB) ^ (((row) & 7) << 4)))
#define SBAR() __builtin_amdgcn_sched_barrier(0)
DI void partialSM(f32x16& p0, f32x16& p1, float& m_reg, float& mn, float& alpha) {
  constexpr float C = SCALE * 1.4426950408889634f;
  float pmax = p0[0]; for (int r = 1; r < 16; ++r) pmax = fmaxf(pmax, p0[r]); for (int r = 0; r < 16; ++r) pmax = fmaxf(pmax, p1[r]);
  { auto rr = __builtin_amdgcn_permlane32_swap(__float_as_uint(pmax), __float_as_uint(pmax), false, false);
    pmax = fmaxf(__uint_as_float(rr[0]), __uint_as_float(rr[1])); }
  if (__builtin_expect(__all(pmax - m_reg <= THR / SCALE), 1)) { mn = m_reg; alpha = 1.f; }
  else { mn = fmaxf(m_reg, pmax); alpha = __builtin_amdgcn_exp2f((m_reg - mn) * C); m_reg = mn; }
  float mnC = -mn * C;
  for (int r = 0; r < 16; ++r) p0[r] = fmaf(p0[r], C, mnC); for (int r = 0; r < 16; ++r) p1[r] = fmaf(p1[r], C, mnC);
  for (int r = 0; r < 16; ++r) p0[r] = __builtin_amdgcn_exp2f(p0[r]);
}
DI void finishSM(f32x16& p0, f32x16& p1, float alpha, float& l_reg, bf16x8& pa0, bf16x8& pa1, bf16x8& pa2, bf16x8& pa3) {
  for (int r = 0; r < 16; ++r) p1[r] = __builtin_amdgcn_exp2f(p1[r]);
  float ps = 0; for (int r = 0; r < 16; ++r) ps += p0[r]; for (int r = 0; r < 16; ++r) ps += p1[r];
  { auto rr = __builtin_amdgcn_permlane32_swap(__float_as_uint(ps), __float_as_uint(ps), false, false);
    ps = __uint_as_float(rr[0]) + __uint_as_float(rr[1]); }
  l_reg = l_reg * alpha + ps;
#define PK4(PP, BASE, OUT) do { unsigned a0 = cvtpk(PP[BASE + 0], PP[BASE + 1]), a1 = cvtpk(PP[BASE + 2], PP[BASE + 3]);   \
    unsigned b0 = cvtpk(PP[BASE + 4], PP[BASE + 5]), b1 = cvtpk(PP[BASE + 6], PP[BASE + 7]);                              \
    auto r0 = __builtin_amdgcn_permlane32_swap(a0, b0, false, false); auto r1 = __builtin_amdgcn_permlane32_swap(a1, b1, false, false); \
    u32x4 w = {r0[0], r1[0], r0[1], r1[1]}; OUT = *reinterpret_cast<bf16x8*>(&w); } while (0)
  PK4(p0, 0, pa0); PK4(p0, 8, pa1); PK4(p1, 0, pa2); PK4(p1, 8, pa3);
#undef PK4
}
DI void qkt(f32x16& p0, f32x16& p1, const bf16_t* Ks, const bf16x8* qr, int r32, int hi) {
  p0 = f32x16{}; p1 = f32x16{};
  for (int d0 = 0; d0 < 8; ++d0) { int cb = (d0 * 16 + hi * 8) * 2;
    bf16x8 b0 = *reinterpret_cast<const bf16x8*>((const char*)Ks + KSWZ(r32, cb));
    bf16x8 b1 = *reinterpret_cast<const bf16x8*>((const char*)Ks + KSWZ(32 + r32, cb));
    p0 = MFMA32(b0, qr[d0], p0);
    p1 = MFMA32(b1, qr[d0], p1); }
}
DI int v_st(int k, int c) { const int kk = (k & ~0xC) | ((k & 4) << 1) | ((k & 8) >> 1); return ((kk >> 3) * 4 + (c >> 5)) * 512 + ((kk & 7) * 32 + (c & 31)) * 2; }
DI int v_rd_base(int lane) { return ((lane & 3) << 3) | (((lane >> 2) & 3) << 6) | (((lane >> 4) & 1) << 5) | (((lane >> 5) & 1) << 8); }
constexpr int v_rd_off(int d0, int ks, int half) { return d0 * 512 + ks * 4096 + half * 2048; }
template <int OFF> DI s16x4 tr_read(int vb) {
  s16x4 r; asm volatile("ds_read_b64_tr_b16 %0, %1 offset:%2" : "=&v"(r) : "v"(vb), "i"(OFF) : "memory"); return r;
}
template <int D0> DI void pv_one(f32x16& od, int vb, bf16x8 pa0, bf16x8 pa1, bf16x8 pa2, bf16x8 pa3) {
  const s16x4 l0 = tr_read<v_rd_off(D0, 0, 0)>(vb), h0 = tr_read<v_rd_off(D0, 0, 1)>(vb), l1 = tr_read<v_rd_off(D0, 1, 0)>(vb), h1 = tr_read<v_rd_off(D0, 1, 1)>(vb);
  const s16x4 l2 = tr_read<v_rd_off(D0, 2, 0)>(vb), h2 = tr_read<v_rd_off(D0, 2, 1)>(vb), l3 = tr_read<v_rd_off(D0, 3, 0)>(vb), h3 = tr_read<v_rd_off(D0, 3, 1)>(vb);
  asm volatile("s_waitcnt lgkmcnt(0)" ::: "memory"); SBAR();
#define PK(Lx, Hx) (bf16x8){Lx[0], Lx[1], Lx[2], Lx[3], Hx[0], Hx[1], Hx[2], Hx[3]}
  od = MFMA32(pa0, PK(l0, h0), od);
  od = MFMA32(pa1, PK(l1, h1), od);
  od = MFMA32(pa2, PK(l2, h2), od);
  od = MFMA32(pa3, PK(l3, h3), od);
#undef PK
}
DI void pv_d0(f32x16* o, int vb, bf16x8 pa0, bf16x8 pa1, bf16x8 pa2, bf16x8 pa3) {
  pv_one<0>(o[0], vb, pa0, pa1, pa2, pa3); pv_one<1>(o[1], vb, pa0, pa1, pa2, pa3); pv_one<2>(o[2], vb, pa0, pa1, pa2, pa3); pv_one<3>(o[3], vb, pa0, pa1, pa2, pa3);
}
DI void attn_dense_body(const bf16_t* __restrict__ Qb, const bf16_t* __restrict__ Kh, const bf16_t* __restrict__ Vh, bf16_t* __restrict__ Ob, int seq, char* lds) {
  const int tid = TIDX(), wid = tid >> 6, lane = tid & 63, r32 = lane & 31, hi = lane >> 5;
  bf16_t* V_lds = (bf16_t*)lds; bf16_t* K_lds = (bf16_t*)(lds + 2 * SHM_V);
  float* ws = (float*)(lds + 2 * SHM_V + 2 * SHM_K) + wid * 64; float* li_l = ws; float* al_l = ws + 32;
  float m_reg = -1e30f, l_reg = 0; f32x16 o[4] = {}; bf16x8 qr[8];
  const bf16_t* Qw = Qb + (long)(wid * QBLK + r32) * LDQ + hi * 8;
#pragma unroll
  for (int d0 = 0; d0 < 8; ++d0) qr[d0] = *reinterpret_cast<const bf16x8*>(Qw + d0 * 16);
  const int sr = tid >> 4, sc = (tid & 15) * 8, vst0 = v_st(sr, sc), vst1 = v_st(32 + sr, sc);
  const int vb0 = (int)(uintptr_t)V_lds + v_rd_base(lane);
  struct { bf16x8 vs0, vs1, ks0, ks1; } sr_[2];
#define SLOAD(i, k0) do { sr_[i].vs0 = *(const bf16x8*)(&Vh[(long)((k0) + sr) * LDK + sc]); sr_[i].vs1 = *(const bf16x8*)(&Vh[(long)((k0) + 32 + sr) * LDK + sc]); \
    sr_[i].ks0 = *(const bf16x8*)(&Kh[(long)((k0) + sr) * LDK + sc]); sr_[i].ks1 = *(const bf16x8*)(&Kh[(long)((k0) + 32 + sr) * LDK + sc]); } while (0)
#define SWRITE(bq, i) do { *(bf16x8*)((char*)V_lds + (bq) * SHM_V + vst0) = sr_[i].vs0;          \
    *(bf16x8*)((char*)V_lds + (bq) * SHM_V + vst1) = sr_[i].vs1; int kc = sc * 2;               \
    *(bf16x8*)((char*)K_lds + (bq) * SHM_K + KSWZ(sr, kc)) = sr_[i].ks0;                       \
    *(bf16x8*)((char*)K_lds + (bq) * SHM_K + KSWZ(32 + sr, kc)) = sr_[i].ks1; } while (0)
#define SWAIT() asm volatile("s_waitcnt vmcnt(4)" ::: "memory")
#define RESC(a) do { if (__any((a) < 1.f)) { if (hi == 0) al_l[r32] = (a); asm volatile("s_waitcnt lgkmcnt(0)" ::: "memory"); \
    for (int d = 0; d < 4; ++d) for (int r = 0; r < 16; ++r) o[d][r] *= al_l[crow(r, hi)]; } } while (0)
  f32x16 pA0, pA1, pB0, pB1; float mnA, mnB, alA, alB; bf16x8 pa0, pa1, pa2, pa3; const int NT = seq / KVBLK;
  constexpr int SE = 0, SO = 1;
  SLOAD(SE, 0); asm volatile("s_waitcnt vmcnt(0)" ::: "memory"); SWRITE(0, SE); __syncthreads();
  qkt(pA0, pA1, K_lds, qr, r32, hi); partialSM(pA0, pA1, m_reg, mnA, alA);
  SLOAD(SO, KVBLK); if (2 < NT) SLOAD(SE, 2 * KVBLK);
  SWAIT(); SWRITE(1, SO); __syncthreads();
  for (int j = 1; j + 1 < NT; j += 2) {
    SBAR(); qkt(pB0, pB1, (bf16_t*)((char*)K_lds + SHM_K), qr, r32, hi);
    finishSM(pA0, pA1, alA, l_reg, pa0, pa1, pa2, pa3); SBAR();
    SLOAD(SO, (j + 2) * KVBLK); SBAR();
    pv_d0(o, vb0, pa0, pa1, pa2, pa3); partialSM(pB0, pB1, m_reg, mnB, alB);
    __syncthreads(); SWAIT(); SWRITE(0, SE);
    RESC(alB); __syncthreads();
    SBAR(); qkt(pA0, pA1, K_lds, qr, r32, hi);
    finishSM(pB0, pB1, alB, l_reg, pa0, pa1, pa2, pa3); SBAR();
    if (j + 3 < NT) SLOAD(SE, (j + 3) * KVBLK); SBAR();
    pv_d0(o, vb0 + (int)SHM_V, pa0, pa1, pa2, pa3); partialSM(pA0, pA1, m_reg, mnA, alA);
    __syncthreads(); SWAIT(); SWRITE(1, SO);
    RESC(alA); __syncthreads();
  }
  SBAR(); qkt(pB0, pB1, (bf16_t*)((char*)K_lds + SHM_K), qr, r32, hi);
  finishSM(pA0, pA1, alA, l_reg, pa0, pa1, pa2, pa3); SBAR();
  pv_d0(o, vb0, pa0, pa1, pa2, pa3); partialSM(pB0, pB1, m_reg, mnB, alB);
  __syncthreads(); RESC(alB);
  finishSM(pB0, pB1, alB, l_reg, pa0, pa1, pa2, pa3); SBAR();
  pv_d0(o, vb0 + (int)SHM_V, pa0, pa1, pa2, pa3);
  if (hi == 0) li_l[r32] = l_reg; asm volatile("s_waitcnt lgkmcnt(0)" ::: "memory");
  float rli[16];
#pragma unroll
  for (int r = 0; r < 16; ++r) rli[r] = __builtin_amdgcn_rcpf(li_l[crow(r, hi)]);
  bf16_t* Ow = Ob + (long)(wid * QBLK) * LDO;
#pragma unroll
  for (int r = 0; r < 16; ++r) { int orow = crow(r, hi);
    for (int d0 = 0; d0 < 4; ++d0) Ow[(long)orow * LDO + d0 * 32 + r32] = f2bf(o[d0][r] * rli[r]); }
#undef SLOAD
#undef SWRITE
#undef SWAIT
#undef RESC
}
}

__device__ __forceinline__ void ph_attn(const P& p, char* lds, bool need_ctx) {
  const bf16_t* QKV = (const bf16_t*)(p.ws + OFF_D); bf16_t* hb = (bf16_t*)(p.ws + OFF_HBF);
  const int nunits = need_ctx ? 528 : 512;
  for (int u = BIDX(); u < nunits; u += GDIM()) {
    int b, h, seq; size_t qrow;
    if (u < 512) { b = u >> 8; const int rem = u & 255; h = rem >> 5; qrow = (size_t)b * TB + CTXL + (size_t)(rem & 31) * 256; seq = TB; }
    else { const int uu = u - 512; b = uu >> 3; h = uu & 7; qrow = (size_t)b * TB; seq = CTXL; }
    const int kvh = h >> 2;
    const bf16_t* Kh = QKV + (size_t)b * TB * 1536 + 1024 + kvh * 128;
    const bf16_t* Vh = QKV + (size_t)b * TB * 1536 + 1280 + kvh * 128;
    at::attn_dense_body(QKV + qrow * 1536 + h * 128, Kh, Vh, hb + qrow * 1024 + h * 128, seq, lds);
    __syncthreads();
  }
}

__device__ __forceinline__ void ph_final(const P& p) {
  const int tid = TIDX(), wid = tid >> 6, lane = tid & 63;
  const float* xr = (const float*)(p.ws + OFF_XRES);
  for (int q = BIDX() * 8 + wid; q < 2 * LAT; q += GDIM() * 8) {
    const int b = q >> 13, t = q & (LAT - 1); const float* row = xr + ((size_t)b * TB + CTXL + t) * 1024;
    f32x4 v[4]; float ss = 0.f;
#pragma unroll
    for (int i = 0; i < 4; ++i) { v[i] = *(const f32x4*)(row + i * 256 + lane * 4); ss += v[i][0] * v[i][0] + v[i][1] * v[i][1] + v[i][2] * v[i][2] + v[i][3] * v[i][3]; }
    ss = wave_sum(ss); const float rs = rsqrtf(ss * (1.f / 1024.f) + EPSF);
#pragma unroll
    for (int i = 0; i < 4; ++i) { const int c0 = i * 256 + lane * 4; const f32x4 g = *(const f32x4*)(p.final_norm + c0); f32x4 o = v[i] * rs * g; *(f32x4*)(p.out + (size_t)q * 1024 + c0) = o; }
  }
}

constexpr int NPHASES = 42;
#ifndef ONLY_PH
#define ONLY_PH -1
#endif
#define EN(x) (ONLY_PH < 0 || ONLY_PH == (x))
#ifndef PROBE_REP
#define PROBE_REP -1
#endif
#define RUN(cls, ...) do { if (EN(cls)) { for (int rep_ = 0; rep_ < ((PROBE_REP == (cls)) ? 2 : 1); ++rep_) { if (rep_) xcd_barrier(*xbp); __VA_ARGS__; } } } while (0)
__device__ __forceinline__ void run_phase(const P& p0, int ph, char* lds, const XcdBarrier* xbp) {
  P p = p0; asm volatile("" : "+s"(p.ws));
  if (ph == NPHASES - 1) { if (EN(11)) ph_final(p); return; }
  const int q = ph - 1; int L, sub;
  if (q < 11) { L = 0; sub = q; } else if (q < 20) { L = 1; sub = q - 11; } else if (q < 31) { L = 2; sub = q - 20; } else { L = 3; sub = q - 31; }
  const bool even = (L & 1) == 0; const int e = L >> 1;
  bf16_t* W1 = (bf16_t*)(p.ws + OFF_WC); bf16_t* W2 = (bf16_t*)(p.ws + OFF_WC + WC_W2);
  bf16_t* hb = (bf16_t*)(p.ws + OFF_HBF); float* xr = (float*)(p.ws + OFF_XRES);
  const float* mods = (const float*)(p.ws + OFF_MODS) + (size_t)L * 3 * 6144;
  bf16_t* W3 = (bf16_t*)(p.ws + OFF_W3);
#define CVT_MIX(LL, skipb) do { const int L_ = (LL); if ((L_ & 1) == 0) { cvt_weight(p.rec_w_in + (size_t)(L_ >> 1) * 1024 * 3632, W1, 1024, 3632, NREC, true, skipb); cvt_weight(p.rec_w_out + (size_t)(L_ >> 1) * 1024 * 1024, W3, 1024, 1024, 1024, false, skipb); } \
    else { cvt_weight(p.att_w_qkv + (size_t)(L_ >> 1) * 1024 * 1536, W1, 1024, 1536, 1536, false, skipb); cvt_weight(p.att_w_out + (size_t)(L_ >> 1) * 1024 * 1024, W3, 1024, 1024, 1024, false, skipb); } } while (0)
#define CVT_FFN(LL, skipb) do { const int L_ = (LL); cvt_weight(p.ffn_w_up + (size_t)L_ * 1024 * 5632, W1, 1024, 5632, 5632, false, skipb); cvt_weight(p.ffn_w_down + (size_t)L_ * DFF * 1024, W2, DFF, 1024, 1024, false, skipb); } while (0)
  if (ph == 0) { RUN(0, ph_init(p, lds); CVT_MIX(0, 0)); return; }
  int fs = even ? sub - 7 : sub - 5;
  if (fs >= 0) {
    if (fs == 0) { RUN(1, ph_norm(p, L, 1)); }
    else if (fs == 1) { RUN(2, gemm8(lds, hb, 1024, W1, 1024, 5632, L == 3, EpiBf8{(bf16_t*)(p.ws + OFF_D), 5632})); }
    else if (fs == 2) { if (EN(8)) ph_ffnact(p, L); }
    else { if (EN(2)) { gemm8(lds, (const bf16_t*)(p.ws + OFF_D) + DFF, 5632, W2, DFF, 1024, L == 3, EpiRes8{xr, mods + 5 * 1024}); if (L < 3) CVT_MIX(L + 1, 8); } }
    return;
  }
  if (even) {
    switch (sub) {
      case 0: RUN(1, ph_norm(p, L, 0)); break;
      case 1: RUN(2, gemm8(lds, hb, 1024, W1, 1024, NREC, false, EpiRec8{(bf16_t*)(p.ws + OFF_D + D_P1), (bf16_t*)(p.ws + OFF_D + D_P2), (float*)(p.ws + OFF_SM)})); break;
      case 2: RUN(3, ph_dnprep(p, lds, e)); break;
      case 3: RUN(4, ph_dn_d1(p, lds); ph_gla_b(p, lds, e)); break;
      case 4: RUN(5, if (BIDX() < 64) { dn_scan(p, lds, BIDX()); } else if (BIDX() < 128) { gla_scan(p, lds, BIDX() - 64, e); });
        if (PROBE_REP == 55) { xcd_barrier(*xbp); if (BIDX() < 64) { dn_scan(p, lds, BIDX()); } }
        if (PROBE_REP == 56) { xcd_barrier(*xbp); if (BIDX() >= 64 && BIDX() < 128) { gla_scan(p, lds, BIDX() - 64, e); } }
        break;
      case 5: RUN(7, ph_merge(p, e)); break;
      case 6: if (EN(2)) { gemm8(lds, hb, 1024, W3, 1024, 1024, false, EpiRes8{xr, mods + 2 * 1024}); CVT_FFN(L, 8); } break;
    }
  } else {
    const int o = L >> 1;
    switch (sub) {
      case 0: RUN(1, ph_norm(p, L, 0)); break;
      case 1: RUN(2, gemm8(lds, hb, 1024, W1, 1024, 1536, false, EpiBf8{(bf16_t*)(p.ws + OFF_D), 1536})); break;
      case 2: if (EN(9)) ph_qknorm(p, lds, o); break;
      case 3: RUN(10, ph_attn(p, lds, L != 3)); break;
      case 4: if (EN(2)) { gemm8(lds, hb, 1024, W3, 1024, 1024, L == 3, EpiRes8{xr, mods + 2 * 1024}); CVT_FFN(L, L == 3 ? 0 : 8); } break;
    }
  }
}

template <bool COOP>
__global__ void __launch_bounds__(512, 1) mk_kernel(P p, int ph0, int ph1) {
  extern __shared__ __attribute__((aligned(16))) char smem[];
  if constexpr (COOP) {
    if (ph0 < 0) cg::this_grid().sync();
    volatile LAS unsigned* st = (volatile LAS unsigned*)(smem + LDS_BYTES);
    if (threadIdx.x < 4) st[threadIdx.x] = 0u;
    __syncthreads();
    XcdBarrier xb = xcd_barrier_post((unsigned*)(p.ws + OFF_BAR), st);
    for (int ph = ph0; ph < ph1; ++ph) {
      run_phase(p, ph, smem, &xb);
      if (ph + 1 < ph1) xcd_barrier(xb);
      if (PROBE_REP == 99 && ph == 0) { for (int q = 0; q < 20; ++q) xcd_barrier(xb); }
    }
  } else {
    for (int ph = ph0; ph < ph1; ++ph) run_phase(p, ph, smem, nullptr);
  }
}

extern "C" void kernel_launch(void* const* d_in, const int* in_sizes, int n_in, void* d_out, int out_size, void* d_ws, size_t ws_size, hipStream_t stream) {
  if (n_in != 23 || ws_size < WS_NEED) { fprintf(stderr, "kernel_launch: bad n_in %d or ws %zu < %zu\n", n_in, ws_size, (size_t)WS_NEED); return; }
  P p{};
  const float** f = (const float**)&p;
  for (int i = 0; i < 23; ++i) f[i] = (const float*)d_in[i];
  p.out = (float*)d_out; p.ws = (char*)d_ws;
  static int inited = 0, grid_blocks = 0;
  if (!inited) {
    hipFuncSetAttribute((const void*)mk_kernel<true>, hipFuncAttributeMaxDynamicSharedMemorySize, LDS_BYTES + 16);
    hipFuncSetAttribute((const void*)mk_kernel<false>, hipFuncAttributeMaxDynamicSharedMemorySize, LDS_BYTES);
    int dev = 0, cus = 0, per_cu = 0;
    hipGetDevice(&dev); hipDeviceGetAttribute(&cus, hipDeviceAttributeMultiprocessorCount, dev);
    hipOccupancyMaxActiveBlocksPerMultiprocessor(&per_cu, mk_kernel<true>, 512, LDS_BYTES + 16);
    if (per_cu > 1) per_cu = 1;
    grid_blocks = cus * per_cu; if (grid_blocks > 256) grid_blocks = 256; if (grid_blocks < 128) grid_blocks = 128;
    inited = 1;
  }
#if MK_COOP
  int ph0 = 0, ph1 = NPHASES;
  void* args[] = {&p, &ph0, &ph1};
  hipMemsetAsync((char*)d_ws + OFF_BAR, 0, 3456 * 4, stream);
  hipError_t er = hipLaunchCooperativeKernel((const void*)mk_kernel<true>, dim3(grid_blocks), dim3(512), args, LDS_BYTES + 16, stream);
  if (er != hipSuccess) fprintf(stderr, "cooperative launch failed: %s (grid %d)\n", hipGetErrorString(er), grid_blocks);
#else
  for (int ph = 0; ph < NPHASES; ++ph) hipLaunchKernelGGL(mk_kernel<false>, dim3(256), dim3(512), LDS_BYTES, stream, p, ph, ph + 1);
#endif
}
```

```cpp
#include <hip/hip_runtime.h>
#include <hip/hip_cooperative_groups.h>
#include <cstdio>
#include <cstdint>
namespace cg = cooperative_groups;

#ifndef MK_COOP
#define MK_COOP 1
#endif

typedef unsigned short bf16_t;
typedef short bf16x8 __attribute__((ext_vector_type(8)));
typedef short s16x4 __attribute__((ext_vector_type(4)));
typedef float f32x16 __attribute__((ext_vector_type(16)));
typedef float f32x8 __attribute__((ext_vector_type(8)));
typedef float f32x4 __attribute__((ext_vector_type(4)));
typedef unsigned u32x4 __attribute__((ext_vector_type(4)));
#define DI __device__ __forceinline__
#define LBAR() do { asm volatile("s_waitcnt lgkmcnt(0)" ::: "memory"); __builtin_amdgcn_s_barrier(); asm volatile("" ::: "memory"); } while (0)
#define MFMA32(a, b, c) __builtin_amdgcn_mfma_f32_32x32x16_bf16((a), (b), (c), 0, 0, 0)

constexpr int DM = 1024, TB = 8448, CTXL = 256, LAT = 8192, MROWS = 2 * TB;
constexpr int NCH = 132;
constexpr int DFF = 2816;
constexpr int NREC = 3840;
constexpr float EPSF = 1e-6f;

constexpr size_t AL(size_t x) { return (x + 255) / 256 * 256; }
constexpr size_t OFF_XRES = 0;
constexpr size_t OFF_HBF = OFF_XRES + AL((size_t)MROWS * DM * 4);
constexpr size_t OFF_WC = OFF_HBF + AL((size_t)MROWS * DM * 2);
constexpr size_t WC_W2 = (size_t)5632 * 1024 * 2;
constexpr size_t OFF_MODS = OFF_WC + AL(WC_W2 + (size_t)1024 * 2816 * 2);
constexpr size_t OFF_SM = OFF_MODS + AL((size_t)4 * 3 * 6144 * 4);
constexpr size_t OFF_GB = OFF_SM + AL((size_t)MROWS * 64 * 4);
constexpr size_t OFF_SC = OFF_GB + AL((size_t)MROWS * 16 * 4);
constexpr size_t OFF_GL = OFF_SC + AL((size_t)16 * NCH * 64 * 2 * 4);
constexpr size_t OFF_D = OFF_GL + AL((size_t)16 * NCH * 4);
constexpr size_t D_P1 = 0;
constexpr size_t D_W = 0;
constexpr size_t D_INTRA = D_W + (size_t)16 * NCH * 64 * 128 * 2;
constexpr size_t D_P2 = D_P1 + (size_t)MROWS * 1536 * 2;
constexpr size_t D_QQ = D_P2 + (size_t)MROWS * 2048 * 2;
constexpr size_t D_QK = D_QQ + (size_t)MROWS * 512 * 2;
constexpr size_t D_QV = D_QK + (size_t)MROWS * 512 * 2;
constexpr size_t D_DNO = D_QK;
constexpr size_t D_KT = D_QV + (size_t)MROWS * 512 * 2;
constexpr size_t D_GLAO = D_KT + (size_t)MROWS * 512 * 2;
constexpr size_t D_END_E = D_GLAO + (size_t)2 * MROWS * 512 * 2;
constexpr size_t D_END_F = (size_t)MROWS * 5632 * 2;
constexpr size_t OFF_B16_1 = OFF_D + (D_END_E > D_END_F ? D_END_E : D_END_F);
constexpr size_t B16_BYTES = (size_t)8 * NCH * 64 * 64 * 2;
constexpr size_t OFF_BAR = OFF_B16_1 + AL(B16_BYTES);
constexpr size_t OFF_W3 = OFF_BAR + AL(3456 * 4);
constexpr size_t WS_NEED = OFF_W3 + (size_t)1024 * 1024 * 2;
constexpr int LDS_BYTES = 132 * 1024;

struct P {
  const float *x, *c, *ctx, *c_ctx, *mod_w, *mod_b, *rec_w_in, *rec_conv, *dn_a_log, *dn_dt_bias, *dn_norm, *gla_w2, *gla_b2, *gla_norm,
      *rec_w_out, *att_w_qkv, *att_q_norm, *att_k_norm, *att_w_out, *ffn_w_up, *ffn_conv, *ffn_w_down, *final_norm;
  float* out;
  char* ws;
};

DI int TIDX() { int t = threadIdx.x; asm volatile("" : "+v"(t)); return t; }
DI int BIDX() { int t = blockIdx.x; asm volatile("" : "+s"(t)); return t; }
DI int GDIM() { int t = gridDim.x; asm volatile("" : "+s"(t)); return t; }
DI float bf2f(bf16_t v) { return __uint_as_float(((unsigned)v) << 16); }
DI bf16_t f2bf(float x) { unsigned u = __float_as_uint(x); u += 0x7fffu + ((u >> 16) & 1u); return (bf16_t)(u >> 16); }
DI unsigned cvtpk(float lo, float hi) { unsigned r; asm volatile("v_cvt_pk_bf16_f32 %0, %1, %2" : "=v"(r) : "v"(lo), "v"(hi)); return r; }
DI int crow(int r, int hi) { return (r & 3) + 8 * (r >> 2) + 4 * hi; }
DI float siluf(float x) { return x / (1.f + expf(-x)); }
DI float sigmf(float x) { return 1.f / (1.f + expf(-x)); }
DI float softplusf(float x) { return fmaxf(x, 0.f) + log1pf(expf(-fabsf(x))); }
DI float wave_sum(float v) {
#pragma unroll
  for (int o = 32; o > 0; o >>= 1) v += __shfl_xor(v, o);
  return v;
}
DI int modrow_of(int R) { const int b = R >= TB ? 1 : 0; const int pp = R - b * TB; return pp < CTXL ? 2 : b; }
template <int KS>
DI f32x16 mma_rows(const bf16_t* arow, const bf16_t* brow, f32x16 acc) {
#pragma unroll
  for (int ks = 0; ks < KS; ++ks) {
    const bf16x8 a = *reinterpret_cast<const bf16x8*>(arow + ks * 16);
    const bf16x8 b = *reinterpret_cast<const bf16x8*>(brow + ks * 16);
    acc = MFMA32(a, b, acc);
  }
  return acc;
}

#define XB_TMO      128
#define XB_XCNT(j)  (256  + 64 * (j))
#define XB_XSUB(j)  (1280 + 64 * (j))
#define XB_XGEN(j)  (2304 + 64 * (j))
#define XB_TOP      3328
#define XB_TOPGEN   3392
#define XCD_BAR_WORDS 3456
#define XB_SPIN_CAP (1u << 18)
#define LAS __attribute__((address_space(3)))
DI unsigned xb_ld(unsigned* p)              { return __hip_atomic_load(p, __ATOMIC_RELAXED, __HIP_MEMORY_SCOPE_AGENT); }
DI unsigned xb_add(unsigned* p, unsigned v) { return __hip_atomic_fetch_add(p, v, __ATOMIC_RELAXED, __HIP_MEMORY_SCOPE_AGENT); }
DI unsigned xb_xcc_id() { return (unsigned)__builtin_amdgcn_s_getreg((3 << 11) | 20) & 0xFu; }
#define XB_SPIN(cond, bar) do { unsigned _sp = 0; while (cond) { __builtin_amdgcn_s_sleep(1); \
    if ((++_sp & 255u) == 0u) { if (xb_ld(&(bar)[XB_TMO])) break; if (_sp > XB_SPIN_CAP) { atomicAdd(&(bar)[XB_TMO], 1u); break; } } } } while (0)
struct XcdBarrier { unsigned* bar; unsigned x; volatile LAS unsigned* st; };
DI XcdBarrier xcd_barrier_post(unsigned* bar, volatile LAS unsigned* st) {
    XcdBarrier b; b.bar = bar; b.x = xb_xcc_id(); b.st = st;
    if (threadIdx.x == 0) (void)xb_add(&bar[XB_XCNT(b.x)], 1u);
    return b;
}
DI void xcd_barrier_complete(unsigned* bar, unsigned x, unsigned& nloc, unsigned& nx) {
    const unsigned G = gridDim.x * gridDim.y * gridDim.z;
    unsigned sum, cnt, mine, sp = 0u;
    for (;;) {
        sum = 0u; cnt = 0u; mine = 0u;
#pragma unroll
        for (unsigned j = 0; j < 16; ++j) { const unsigned c = xb_ld(&bar[XB_XCNT(j)]); sum += c; cnt += (c > 0u) ? 1u : 0u; mine = (j == x) ? c : mine; }
        if (sum == G) break;
        __builtin_amdgcn_s_sleep(1);
        if ((++sp & 255u) == 0u) { if (xb_ld(&bar[XB_TMO])) break; if (sp > XB_SPIN_CAP) { atomicAdd(&bar[XB_TMO], 1u); break; } }
    }
    nloc = mine > 0u ? mine : 1u; nx = cnt > 0u ? cnt : 1u;
}
DI void xcd_barrier(const XcdBarrier& b) {
    asm volatile("s_waitcnt vmcnt(0)" ::: "memory");
    __syncthreads();
    if (threadIdx.x == 0) {
        unsigned* bar = b.bar;
        __builtin_amdgcn_s_waitcnt(0);
        unsigned nloc = b.st[0], nx = b.st[1];
        if (nloc == 0u) { xcd_barrier_complete(bar, b.x, nloc, nx); b.st[0] = nloc; b.st[1] = nx; }
        const unsigned old = xb_add(&bar[XB_XSUB(b.x)], 1u);
        const unsigned gen = old / nloc;
        if (old + 1u == (gen + 1u) * nloc) {
            __builtin_amdgcn_fence(__ATOMIC_RELEASE, "agent");
            asm volatile("s_waitcnt vmcnt(0)" ::: "memory");
            const unsigned og = xb_add(&bar[XB_TOP], 1u);
            const unsigned tg = og / nx;
            if (og + 1u == (tg + 1u) * nx) xb_add(&bar[XB_TOPGEN], 1u);
            else XB_SPIN(xb_ld(&bar[XB_TOPGEN]) == tg, bar);
            __builtin_amdgcn_fence(__ATOMIC_ACQUIRE, "agent");
            xb_add(&bar[XB_XGEN(b.x)], 1u);
            asm volatile("s_waitcnt vmcnt(0)" ::: "memory");
        } else {
            XB_SPIN(xb_ld(&bar[XB_XGEN(b.x)]) == gen, bar);
            __builtin_amdgcn_fence(__ATOMIC_ACQUIRE, "agent");
            asm volatile("s_waitcnt vmcnt(0)" ::: "memory");
        }
    }
    __syncthreads();
}

__device__ __forceinline__ void ph_init(const P& p, char* lds) {
  const int tid = TIDX();
  float* sc = (float*)lds;
  float* red = sc + 3072;
  for (int i = tid; i < 3072; i += 512) { const int r = i >> 10, k = i & 1023; const float v = r < 2 ? p.c[r * 1024 + k] : p.c_ctx[k]; sc[i] = siluf(v); }
  __syncthreads();
  float* mods = (float*)(p.ws + OFF_MODS);
  for (int job = BIDX(); job < 192; job += GDIM()) {
    const int col = job * 128 + (tid & 127), kq = tid >> 7;
    const int L = col / 6144, cl = col - L * 6144;
    const float* w = p.mod_w + ((size_t)L * 1024 + kq * 256) * 6144 + cl;
    float a0 = 0.f, a1 = 0.f, a2 = 0.f;
#pragma unroll 8
    for (int k = 0; k < 256; ++k) { const float wv = w[(size_t)k * 6144]; const int kk = kq * 256 + k; a0 += sc[kk] * wv; a1 += sc[1024 + kk] * wv; a2 += sc[2048 + kk] * wv; }
    red[(kq * 3 + 0) * 128 + (tid & 127)] = a0; red[(kq * 3 + 1) * 128 + (tid & 127)] = a1; red[(kq * 3 + 2) * 128 + (tid & 127)] = a2;
    __syncthreads();
    if (tid < 384) { const int r = tid >> 7, cc = tid & 127; const int c2 = job * 128 + cc; const int L2 = c2 / 6144, cl2 = c2 - L2 * 6144;
      const float s = red[(0 * 3 + r) * 128 + cc] + red[(1 * 3 + r) * 128 + cc] + red[(2 * 3 + r) * 128 + cc] + red[(3 * 3 + r) * 128 + cc] + p.mod_b[L2 * 6144 + cl2];
      mods[((size_t)L2 * 3 + r) * 6144 + cl2] = s; }
    __syncthreads();
  }
  f32x4* xr = (f32x4*)(p.ws + OFF_XRES);
  for (size_t i = (size_t)BIDX() * 512 + tid; i < (size_t)MROWS * 256; i += (size_t)GDIM() * 512) {
    const int R = (int)(i >> 8), c4 = (int)(i & 255); const int b = R >= TB ? 1 : 0, pp = R - b * TB;
    const float* src = pp < CTXL ? p.ctx + ((size_t)b * CTXL + pp) * 1024 : p.x + ((size_t)b * LAT + (pp - CTXL)) * 1024;
    xr[i] = *(const f32x4*)(src + c4 * 4);
  }
}

DI int rec_src_col(int n) { if (n < 2048) return n; if (n < 3584) return n + 16; if (n < 3600) return 2048 + (n - 3584); if (n < 3632) return n; return -1; }
__device__ __forceinline__ void cvt_weight(const float* __restrict__ W, bf16_t* __restrict__ Wt, int K, int Nsrc, int Npad, bool perm, int skipb) {
  const size_t items = (size_t)Npad * (K >> 3);
  const int bid = BIDX() - skipb, nb = GDIM() - skipb;
  if (bid < 0) return;
  for (size_t it = (size_t)bid * 512 + TIDX(); it < items; it += (size_t)nb * 512) {
    const int n = (int)(it % Npad), kb = (int)(it / Npad);
    const int s = perm ? rec_src_col(n) : n;
    float v[8];
#pragma unroll
    for (int j = 0; j < 8; ++j) v[j] = s >= 0 ? W[(size_t)(kb * 8 + j) * Nsrc + s] : 0.f;
    u32x4 w = {cvtpk(v[0], v[1]), cvtpk(v[2], v[3]), cvtpk(v[4], v[5]), cvtpk(v[6], v[7])};
    *(u32x4*)(Wt + (size_t)n * K + kb * 8) = w;
  }
}

__device__ __forceinline__ void ph_norm(const P& p, int L, int which) {
  const int tid = TIDX(), wid = tid >> 6, lane = tid & 63, l16 = lane & 15, sub = lane >> 4;
  const float* xr = (const float*)(p.ws + OFF_XRES);
  bf16_t* hb = (bf16_t*)(p.ws + OFF_HBF);
  const float* mods = (const float*)(p.ws + OFF_MODS) + (size_t)L * 3 * 6144;
  for (int R4 = (BIDX() * 8 + wid) * 4; R4 < MROWS; R4 += GDIM() * 32) {
    const int R = R4 + sub;
    const float* row = xr + (size_t)R * 1024 + l16 * 4;
    f32x4 v[16]; float ss = 0.f;
#pragma unroll
    for (int i = 0; i < 16; ++i) v[i] = *(const f32x4*)(row + i * 64);
#pragma unroll
    for (int i = 0; i < 16; ++i) ss += v[i][0] * v[i][0] + v[i][1] * v[i][1] + v[i][2] * v[i][2] + v[i][3] * v[i][3];
    ss += __shfl_xor(ss, 1); ss += __shfl_xor(ss, 2); ss += __shfl_xor(ss, 4); ss += __shfl_xor(ss, 8);
    const float rs = rsqrtf(ss * (1.f / 1024.f) + EPSF);
    const float* mr = mods + (size_t)modrow_of(R) * 6144 + which * 3072 + l16 * 4;
    bf16_t* dst = hb + (size_t)R * 1024 + l16 * 4;
#pragma unroll
    for (int i = 0; i < 16; ++i) { const f32x4 sh = *(const f32x4*)(mr + i * 64), scl = *(const f32x4*)(mr + 1024 + i * 64);
      float o[4];
#pragma unroll
      for (int j = 0; j < 4; ++j) o[j] = v[i][j] * rs * (1.f + scl[j]) + sh[j];
      uint2 w; w.x = cvtpk(o[0], o[1]); w.y = cvtpk(o[2], o[3]);
      *(uint2*)(dst + i * 64) = w; }
  }
}

struct EpiRec { bf16_t* P1; bf16_t* P2; float* SM;
  DI void operator()(int row, int col, float v) const {
    if (col < 1536) P1[(size_t)row * 1536 + col] = f2bf(v);
    else if (col < 3584) P2[(size_t)row * 2048 + (col - 1536)] = f2bf(v);
    else { const int lc = col - 3584; if (lc < 48) SM[(size_t)row * 64 + lc] = v; } } };
struct EpiBf { bf16_t* O; int ldc;
  DI void operator()(int row, int col, float v) const { O[(size_t)row * ldc + col] = f2bf(v); } };
struct EpiRes { float* X; const float* gate;
  DI void operator()(int row, int col, float v) const { float* q = X + (size_t)row * 1024 + col; *q = *q + gate[(size_t)modrow_of(row) * 6144 + col] * v; } };

template <class Epi>
__device__ __forceinline__ void gemm_phase(char* lds, const bf16_t* __restrict__ A, int lda, const bf16_t* __restrict__ Bt, int K, int nN, const Epi epi, bool skipctx = false) {
  const int tid = TIDX(), wid = tid >> 6, lane = tid & 63, r32 = lane & 31, hi = lane >> 5;
  const int wm = wid >> 1, wn = wid & 1;
  const int nk = K >> 6;
  constexpr int RS = 144, ASZ = 256 * RS, BSZ = 128 * RS, STG = ASZ + BSZ;
  const int ntiles = (skipctx ? 64 : MROWS / 256) * nN;
  const int srow = tid >> 3, spc = tid & 7;
  for (int t = BIDX(); t < ntiles; t += GDIM()) {
    int pm = t / nN; const int pn = t - pm * nN; if (skipctx) pm = pm + 1 + (pm >= 32 ? 1 : 0);
    const bf16_t* Ab = A + (size_t)(pm * 256 + srow) * lda + spc * 8;
    const bf16_t* Bb = Bt + (size_t)(pn * 128 + srow) * K + spc * 8;
    f32x16 acc00 = {}, acc01 = {}, acc10 = {}, acc11 = {};
    bf16x8 ra0, ra1, ra2, ra3, rb0, rb1;
#define GLOAD(kt) do { const int ko = (kt) * 64; ra0 = *(const bf16x8*)(Ab + ko); ra1 = *(const bf16x8*)(Ab + (size_t)64 * lda + ko); ra2 = *(const bf16x8*)(Ab + (size_t)128 * lda + ko); \
    ra3 = *(const bf16x8*)(Ab + (size_t)192 * lda + ko); rb0 = *(const bf16x8*)(Bb + ko); rb1 = *(const bf16x8*)(Bb + (size_t)64 * K + ko); } while (0)
#define SWRITE(buf) do { char* sb = lds + (buf) * STG + srow * RS + spc * 16; *(bf16x8*)(sb) = ra0; *(bf16x8*)(sb + 64 * RS) = ra1; *(bf16x8*)(sb + 128 * RS) = ra2; *(bf16x8*)(sb + 192 * RS) = ra3; \
    *(bf16x8*)(sb + ASZ) = rb0; *(bf16x8*)(sb + ASZ + 64 * RS) = rb1; } while (0)
    GLOAD(0); SWRITE(0); __syncthreads();
    for (int kt = 0; kt < nk; ++kt) {
      const int cur = kt & 1;
      if (kt + 1 < nk) GLOAD(kt + 1);
      const char* ab = lds + cur * STG + (64 * wm + r32) * RS + hi * 16;
      const char* bb = lds + cur * STG + ASZ + (64 * wn + r32) * RS + hi * 16;
#pragma unroll
      for (int ks = 0; ks < 4; ++ks) {
        const bf16x8 a0 = *(const bf16x8*)(ab + ks * 32), a1 = *(const bf16x8*)(ab + 32 * RS + ks * 32);
        const bf16x8 b0 = *(const bf16x8*)(bb + ks * 32), b1 = *(const bf16x8*)(bb + 32 * RS + ks * 32);
        acc00 = MFMA32(a0, b0, acc00); acc01 = MFMA32(a0, b1, acc01); acc10 = MFMA32(a1, b0, acc10); acc11 = MFMA32(a1, b1, acc11);
      }
      if (kt + 1 < nk) SWRITE(cur ^ 1);
      __syncthreads();
    }
#undef GLOAD
#undef SWRITE
    const int row0 = pm * 256 + 64 * wm, col0 = pn * 128 + 64 * wn + r32;
#pragma unroll
    for (int r = 0; r < 16; ++r) { const int rr = row0 + crow(r, hi);
      epi(rr, col0, acc00[r]); epi(rr, col0 + 32, acc01[r]); epi(rr + 32, col0, acc10[r]); epi(rr + 32, col0 + 32, acc11[r]); }
  }
}

namespace pg8 {
#define PG8_LAS __attribute__((address_space(3)))
constexpr int BM = 256, BK = 64, HALF = 128, HTB = HALF * BK * 2  , STAGE_BYTES = 8 * HTB, NXCD = 8, WGM = 8;

__host__ __device__ __forceinline__ int lds_byte(int r, int c) { const int st = (r >> 4) * 2 + (c >> 5), rr = r & 15, cc = c & 31, ob = rr * 64 + cc * 2; return st * 1024 + (ob ^ (((ob >> 9) & 1) << 5)); }
__host__ __device__ __forceinline__ void stage_rc(int b, int& R, int& C) { const int st = b / 1024, sb = b % 1024, swz = sb ^ (((sb >> 9) & 1) << 5); R = (st >> 1) * 16 + swz / 64; C = (st & 1) * 32 + (swz % 64) / 2; }
__host__ __device__ __forceinline__ int perm32(int rho) { const int n = rho >> 4, i = rho & 15; return 8 * (i >> 2) + 4 * n + (i & 3); }
struct Unit { int pm, pn; };
struct Gemm { const bf16_t* A; const bf16_t* Bt; int M, N, K, lda; };

struct StaticOrder {
    int nM, nN, nwg, G, c;
    __host__ __device__ void init(int M, int N, int G_, int c_) { nM = M / BM; nN = N / BM; nwg = nM * nN; G = G_; c = c_; }
    __host__ __device__ bool next(int i, Unit& u) const {
        const long L = (long)i * G + c; if (L >= nwg) return false;
        int wgid = (int)L; { const int q = nwg / NXCD, r = nwg % NXCD, xcd = wgid % NXCD, off = wgid / NXCD; wgid = (xcd < r ? xcd * (q + 1) : r * (q + 1) + (xcd - r) * q) + off; }
        const int nig = WGM * nN, gid = wgid / nig, fm = gid * WGM, gsz = (nM - fm) < WGM ? (nM - fm) : WGM;
        u.pm = fm + ((wgid % nig) % gsz); u.pn = (wgid % nig) / gsz; return true;
    }
    __device__ __forceinline__ void a_ready(const Unit&) const {}
    __device__ __forceinline__ void done(const Unit&) const {}
};
template <class Epi, class Sched, bool ALIGN_EPI = false, bool SP2 = false>
__device__ __forceinline__ void gemm_phase(PG8_LAS unsigned char* lds, const Gemm g, const Sched& S, const Epi& E) {
    const int tid = TIDX(), wid = __builtin_amdgcn_readfirstlane(tid >> 6), lane = tid & 63, wr = wid >> 2, wc = wid & 3, fr = lane & 15, fq = lane >> 4;
    const int K = g.K, nt = K / BK;
    unsigned voffA[2], voffB[2];
#pragma unroll
    for (int i = 0; i < 2; ++i) { int R, C; stage_rc(tid * 16 + i * 8192, R, C); const int Rb = Epi::PERM ? ((R & ~31) + perm32(R & 31)) : R;
        voffA[i] = (unsigned)(R * g.lda + C) * 2u; voffB[i] = (unsigned)(Rb * K + C) * 2u; }
    const size_t kstep = (size_t)(BK * 2);
    const size_t hstep = (size_t)HALF * K * 2;
    const size_t tstep = 2 * hstep; const size_t hstepA = (size_t)HALF * g.lda * 2, tstepA = 2 * hstepA;
    const unsigned ldsw = (unsigned)wid * 1024u;
    const int aoff = lds_byte(wr * 64 + fr, fq * 8), boff = lds_byte(wc * 32 + fr, fq * 8);
#define PG8_SA(b, h) (((b) * 2 + (h)) * HTB)
#define PG8_SB(b, h) ((4 + (b) * 2 + (h)) * HTB)
#define PG8_STAGE(bufoff, gbase, voff) do { _Pragma("unroll") for (int _i = 0; _i < 2; ++_i) \
        __builtin_amdgcn_global_load_lds((const unsigned*)((const char*)(gbase) + (voff)[_i]), (PG8_LAS unsigned*)(lds + (bufoff) + ldsw + _i * 8192), 16, 0, 0); } while (0)
#define PG8_LDA(dst, b, h) do { _Pragma("unroll") for (int m = 0; m < 4; ++m) _Pragma("unroll") for (int k = 0; k < 2; ++k) dst[m][k] = *(const PG8_LAS bf16x8*)(lds + PG8_SA(b, h) + aoff + m * 2048 + k * 1024); } while (0)
#define PG8_LDB(dst, b, h) do { _Pragma("unroll") for (int n = 0; n < 2; ++n) _Pragma("unroll") for (int k = 0; k < 2; ++k) dst[n][k] = *(const PG8_LAS bf16x8*)(lds + PG8_SB(b, h) + boff + n * 2048 + k * 1024); } while (0)
#define PG8_MMA(ai, bj, At, Bt) do { __builtin_amdgcn_s_setprio(1); _Pragma("unroll") for (int m = 0; m < 4; ++m) _Pragma("unroll") for (int n = 0; n < 2; ++n) _Pragma("unroll") for (int k = 0; k < 2; ++k) \
        acc[ai][bj][m][n] = __builtin_amdgcn_mfma_f32_16x16x32_bf16(Bt[n][k], At[m][k], acc[ai][bj][m][n], 0, 0, 0); __builtin_amdgcn_s_setprio(0); } while (0)
#define PG8_WAIT_V(n) asm volatile("s_waitcnt vmcnt(" #n ")" ::: "memory")
#define PG8_WAIT_L(n) asm volatile("s_waitcnt lgkmcnt(" #n ")" ::: "memory")
#define PG8_BAR __builtin_amdgcn_s_barrier()
#define PG8_SCHED __builtin_amdgcn_sched_barrier(0)
    Unit cur, nxt; int ui = 0;
    if (!S.next(0, cur)) return;
    f32x4 acc[2][2][4][2];
#pragma unroll
    for (int a = 0; a < 2; ++a)
#pragma unroll
        for (int b = 0; b < 2; ++b)
#pragma unroll
            for (int m = 0; m < 4; ++m)
#pragma unroll
                for (int n = 0; n < 2; ++n) acc[a][b][m][n] = (f32x4){0.f, 0.f, 0.f, 0.f};
    bf16x8 At[4][2], B0[2][2], B1[2][2];
    const char* cA = (const char*)g.A + (size_t)cur.pm * tstepA; const char* cB = (const char*)g.Bt + (size_t)cur.pn * tstep;
    S.a_ready(cur);
    if constexpr (SP2) {
        PG8_STAGE(PG8_SB(0, 0), cB, voffB); PG8_STAGE(PG8_SB(0, 1), cB + hstep, voffB); PG8_STAGE(PG8_SA(0, 0), cA, voffA); PG8_STAGE(PG8_SA(0, 1), cA + hstepA, voffA);
        if (wr == 1) PG8_BAR;
        PG8_WAIT_V(2); PG8_BAR;
        PG8_STAGE(PG8_SB(1, 0), cB + kstep, voffB); PG8_STAGE(PG8_SA(1, 0), cA + kstep, voffA); PG8_STAGE(PG8_SB(1, 1), cB + hstep + kstep, voffB);
        PG8_WAIT_V(6); PG8_BAR;
    } else {
        PG8_STAGE(PG8_SB(0, 0), cB, voffB); PG8_STAGE(PG8_SA(0, 0), cA, voffA); PG8_STAGE(PG8_SB(0, 1), cB + hstep, voffB); PG8_STAGE(PG8_SA(0, 1), cA + hstepA, voffA);
        if (wr == 1) PG8_BAR;
        PG8_WAIT_V(4); PG8_BAR;
        PG8_STAGE(PG8_SB(1, 0), cB + kstep, voffB); PG8_STAGE(PG8_SA(1, 0), cA + kstep, voffA); PG8_STAGE(PG8_SB(1, 1), cB + hstep + kstep, voffB);
        PG8_WAIT_V(6); PG8_BAR;
    }
    for (;;) {
        const bool has_next = S.next(ui + 1, nxt);
        const char* nA = has_next ? (const char*)g.A + (size_t)nxt.pm * tstepA : cA; const char* nB = has_next ? (const char*)g.Bt + (size_t)nxt.pn * tstep : cB;
        for (int t = 0; t < nt; t += 2) {
            const bool last = (t == nt - 2);
            const char* a1 = cA + (size_t)(t + 1) * kstep;
            const char* a2 = last ? nA : cA + (size_t)(t + 2) * kstep; const char* b2 = last ? nB : cB + (size_t)(t + 2) * kstep;
            const char* a3 = a2 + kstep; const char* b3 = b2 + kstep;
            if (last && has_next) S.a_ready(nxt);
            if constexpr (SP2) {
            PG8_LDB(B0, 0, 0); PG8_LDB(B1, 0, 1); PG8_SCHED; PG8_LDA(At, 0, 0); PG8_STAGE(PG8_SA(1, 1), a1 + hstepA, voffA);
            PG8_WAIT_V(8); PG8_WAIT_L(0); PG8_BAR; PG8_MMA(0, 0, At, B0); PG8_MMA(0, 1, At, B1); PG8_BAR; PG8_SCHED;
            PG8_LDA(At, 0, 1); PG8_STAGE(PG8_SB(0, 0), b2, voffB); PG8_STAGE(PG8_SB(0, 1), b2 + hstep, voffB); PG8_STAGE(PG8_SA(0, 0), a2, voffA);
            PG8_WAIT_V(8); PG8_WAIT_L(0); PG8_BAR; PG8_MMA(1, 0, At, B0); PG8_MMA(1, 1, At, B1); PG8_BAR; PG8_SCHED;
            PG8_LDB(B0, 1, 0); PG8_LDB(B1, 1, 1); PG8_SCHED; PG8_LDA(At, 1, 0); PG8_STAGE(PG8_SA(0, 1), a2 + hstepA, voffA);
            PG8_WAIT_V(8); PG8_WAIT_L(0); PG8_BAR; PG8_MMA(0, 0, At, B0); PG8_MMA(0, 1, At, B1); PG8_BAR; PG8_SCHED;
            PG8_LDA(At, 1, 1); PG8_STAGE(PG8_SB(1, 0), b3, voffB); PG8_STAGE(PG8_SB(1, 1), b3 + hstep, voffB); PG8_STAGE(PG8_SA(1, 0), a3, voffA);
            PG8_WAIT_V(8); PG8_WAIT_L(0); PG8_BAR; PG8_MMA(1, 0, At, B0); PG8_MMA(1, 1, At, B1); PG8_BAR; PG8_SCHED;
            } else {
            PG8_LDB(B0, 0, 0); PG8_SCHED; PG8_LDA(At, 0, 0); PG8_STAGE(PG8_SA(1, 1), a1 + hstepA, voffA);
            PG8_WAIT_L(8); PG8_BAR; PG8_WAIT_L(0); PG8_MMA(0, 0, At, B0); PG8_BAR; PG8_SCHED;
            PG8_LDB(B1, 0, 1); PG8_STAGE(PG8_SB(0, 0), b2, voffB);
            PG8_BAR; PG8_WAIT_L(0); PG8_MMA(0, 1, At, B1); PG8_BAR;
            PG8_LDA(At, 0, 1); PG8_STAGE(PG8_SA(0, 0), a2, voffA);
            PG8_BAR; PG8_WAIT_L(0); PG8_MMA(1, 0, At, B0); PG8_BAR; PG8_SCHED;
            PG8_STAGE(PG8_SB(0, 1), b2 + hstep, voffB);
            PG8_WAIT_V(6); PG8_BAR; PG8_MMA(1, 1, At, B1); PG8_BAR;
            PG8_LDB(B0, 1, 0); PG8_SCHED; PG8_LDA(At, 1, 0); PG8_STAGE(PG8_SA(0, 1), a2 + hstepA, voffA);
            PG8_WAIT_L(8); PG8_BAR; PG8_WAIT_L(0); PG8_MMA(0, 0, At, B0); PG8_BAR; PG8_SCHED;
            PG8_LDB(B1, 1, 1); PG8_STAGE(PG8_SB(1, 0), b3, voffB);
            PG8_BAR; PG8_WAIT_L(0); PG8_MMA(0, 1, At, B1); PG8_BAR;
            PG8_LDA(At, 1, 1); PG8_STAGE(PG8_SA(1, 0), a3, voffA);
            PG8_BAR; PG8_WAIT_L(0); PG8_MMA(1, 0, At, B0); PG8_BAR; PG8_SCHED;
            PG8_STAGE(PG8_SB(1, 1), b3 + hstep, voffB);
            PG8_WAIT_V(6); PG8_BAR; PG8_MMA(1, 1, At, B1); PG8_BAR;
            }
        }
        if constexpr (ALIGN_EPI) { if (wr == 0) PG8_BAR; }
        if constexpr (!Epi::AFTER_DRAIN) { E(acc, cur, wr, wc, fr, fq); S.done(cur); }
        if (!has_next) break;
#pragma unroll
        for (int a = 0; a < 2; ++a)
#pragma unroll
            for (int b = 0; b < 2; ++b)
#pragma unroll
                for (int m = 0; m < 4; ++m)
#pragma unroll
                    for (int n = 0; n < 2; ++n) acc[a][b][m][n] = (f32x4){0.f, 0.f, 0.f, 0.f};
        cur = nxt; cA = nA; cB = nB; ++ui;
        if constexpr (ALIGN_EPI) { if (wr == 1) PG8_BAR; }
    }
    PG8_WAIT_V(0);
    if constexpr (!ALIGN_EPI) { if (wr == 0) PG8_BAR; }
    PG8_BAR;
    if constexpr (Epi::AFTER_DRAIN) { E.fused(acc, cur, wr, wc, fr, fq, lds, wid, lane); S.done(cur); }
#undef PG8_SA
#undef PG8_SB
#undef PG8_STAGE
#undef PG8_LDA
#undef PG8_LDB
#undef PG8_MMA
#undef PG8_WAIT_V
#undef PG8_WAIT_L
#undef PG8_BAR
#undef PG8_SCHED
}
struct SchedX { StaticOrder so; bool skip;
  __device__ __forceinline__ bool next(int i, Unit& u) const { if (!so.next(i, u)) return false; if (skip) u.pm = u.pm + 1 + (u.pm >= 32 ? 1 : 0); return true; }
  __device__ __forceinline__ void a_ready(const Unit&) const {}
  __device__ __forceinline__ void done(const Unit&) const {} };
}
struct EpiRec8 { static constexpr bool PERM = false, AFTER_DRAIN = false; bf16_t* P1; bf16_t* P2; float* SM;
  DI void operator()(const f32x4 (&acc)[2][2][4][2], const pg8::Unit& u, int wr, int wc, int fr, int fq) const {
#pragma unroll
    for (int ai = 0; ai < 2; ++ai)
#pragma unroll
      for (int m = 0; m < 4; ++m) { const size_t row = (size_t)u.pm * 256 + ai * 128 + wr * 64 + m * 16 + fr;
#pragma unroll
        for (int bj = 0; bj < 2; ++bj)
#pragma unroll
          for (int n = 0; n < 2; ++n) { const int col = u.pn * 256 + bj * 128 + wc * 32 + n * 16 + fq * 4; const f32x4 v = acc[ai][bj][m][n];
            if (u.pn < 6) { uint2 w; w.x = cvtpk(v[0], v[1]); w.y = cvtpk(v[2], v[3]); *(uint2*)(P1 + row * 1536 + col) = w; }
            else if (u.pn < 14) { uint2 w; w.x = cvtpk(v[0], v[1]); w.y = cvtpk(v[2], v[3]); *(uint2*)(P2 + row * 2048 + (col - 1536)) = w; }
            else { const int lc = col - 3584; if (lc < 48) *(f32x4*)(SM + row * 64 + lc) = v; } } } } };
struct EpiBf8 { static constexpr bool PERM = false, AFTER_DRAIN = false; bf16_t* O; int ldc;
  DI void operator()(const f32x4 (&acc)[2][2][4][2], const pg8::Unit& u, int wr, int wc, int fr, int fq) const {
#pragma unroll
    for (int ai = 0; ai < 2; ++ai)
#pragma unroll
      for (int m = 0; m < 4; ++m) { const size_t row = (size_t)u.pm * 256 + ai * 128 + wr * 64 + m * 16 + fr;
#pragma unroll
        for (int bj = 0; bj < 2; ++bj)
#pragma unroll
          for (int n = 0; n < 2; ++n) { const int col = u.pn * 256 + bj * 128 + wc * 32 + n * 16 + fq * 4; const f32x4 v = acc[ai][bj][m][n];
            uint2 w; w.x = cvtpk(v[0], v[1]); w.y = cvtpk(v[2], v[3]); *(uint2*)(O + row * ldc + col) = w; } } } };
struct EpiRes8 { static constexpr bool PERM = false, AFTER_DRAIN = false; float* X; const float* gate;
  DI void operator()(const f32x4 (&acc)[2][2][4][2], const pg8::Unit& u, int wr, int wc, int fr, int fq) const {
    const float* gr = gate + (size_t)modrow_of(u.pm * 256) * 6144;
#pragma unroll
    for (int bj = 0; bj < 2; ++bj)
#pragma unroll
      for (int n = 0; n < 2; ++n) { const int col = u.pn * 256 + bj * 128 + wc * 32 + n * 16 + fq * 4; const f32x4 gv = *(const f32x4*)(gr + col);
#pragma unroll
        for (int ai = 0; ai < 2; ++ai)
#pragma unroll
          for (int m = 0; m < 4; ++m) { const size_t row = (size_t)u.pm * 256 + ai * 128 + wr * 64 + m * 16 + fr;
            f32x4* q = (f32x4*)(X + row * 1024 + col); *q = *q + gv * acc[ai][bj][m][n]; } } } };
template <class Epi>
__device__ __forceinline__ void gemm8(char* lds, const bf16_t* A, int lda, const bf16_t* Bt, int K, int N, bool skipctx, const Epi& E) {
  pg8::Gemm g{A, Bt, skipctx ? 16384 : MROWS, N, K, lda};
  pg8::SchedX S; S.so.init(g.M, N, GDIM(), BIDX()); S.skip = skipctx;
  pg8::gemm_phase<Epi, pg8::SchedX, true, true>((PG8_LAS unsigned char*)lds, g, S, E);
}

__device__ __forceinline__ void ph_dnprep(const P& p, char* lds, int e) {
  const int tid = TIDX(), wid = tid >> 6, lane = tid & 63;
  const bf16_t* P1 = (const bf16_t*)(p.ws + OFF_D + D_P1);
  bf16_t* QQ = (bf16_t*)(p.ws + OFF_D + D_QQ); bf16_t* QK = (bf16_t*)(p.ws + OFF_D + D_QK); bf16_t* QV = (bf16_t*)(p.ws + OFF_D + D_QV);
  bf16_t* KT = (bf16_t*)(p.ws + OFF_D + D_KT);
  const float* SM = (const float*)(p.ws + OFF_SM); float* GB = (float*)(p.ws + OFF_GB);
  const float* cw = p.rec_conv + (size_t)e * 3 * 1536;
  bf16_t* kl = (bf16_t*)lds;
  for (int job = BIDX(); job < MROWS / 64; job += GDIM()) {
    const int R0 = job * 64;
    for (int tt = 0; tt < 8; ++tt) {
      const int tl = wid * 8 + tt, R = R0 + tl; const int b = R >= TB ? 1 : 0, pp = R - b * TB;
      const bool hasp = !(pp == 0 || pp == CTXL), hasn = !(pp == CTXL - 1 || pp == TB - 1);
#pragma unroll
      for (int part = 0; part < 3; ++part) {
        const int ch = part * 512 + lane * 8;
        const bf16x8 zc = *(const bf16x8*)(P1 + (size_t)R * 1536 + ch);
        bf16x8 zp = {}, zn = {};
        if (hasp) zp = *(const bf16x8*)(P1 + (size_t)(R - 1) * 1536 + ch);
        if (hasn) zn = *(const bf16x8*)(P1 + (size_t)(R + 1) * 1536 + ch);
        float o[8]; float ss = 0.f;
#pragma unroll
        for (int j = 0; j < 8; ++j) { const float a = bf2f((bf16_t)zp[j]) * cw[ch + j] + bf2f((bf16_t)zc[j]) * cw[1536 + ch + j] + bf2f((bf16_t)zn[j]) * cw[3072 + ch + j];
          o[j] = siluf(a); ss += o[j] * o[j]; }
        if (part < 2) {
          ss += __shfl_xor(ss, 1); ss += __shfl_xor(ss, 2); ss += __shfl_xor(ss, 4); ss += __shfl_xor(ss, 8);
          float sc = rsqrtf(ss + EPSF); if (part == 0) sc *= 0.08838834764831845f;
#pragma unroll
          for (int j = 0; j < 8; ++j) o[j] *= sc;
        }
        u32x4 w = {cvtpk(o[0], o[1]), cvtpk(o[2], o[3]), cvtpk(o[4], o[5]), cvtpk(o[6], o[7])};
        bf16_t* dst = part == 0 ? QQ : (part == 1 ? QK : QV);
        *(u32x4*)(dst + (size_t)R * 512 + lane * 8) = w;
        if (part == 1) *(u32x4*)(kl + tl * 512 + lane * 8) = w;
      }
      if (lane < 16) {
        const int q = lane & 7;
        if (lane < 8) { const float da = SM[(size_t)R * 64 + q]; GB[(size_t)R * 16 + q] = -expf(p.dn_a_log[e * 8 + q]) * softplusf(da + p.dn_dt_bias[e * 8 + q]); }
        else { const float db = SM[(size_t)R * 64 + 8 + q]; GB[(size_t)R * 16 + 8 + q] = sigmf(db); }
      }
    }
    __syncthreads();
    {
      const int b = R0 >= TB ? 1 : 0, c = (R0 - b * TB) / 64; const int h = tid >> 7, dk = tid & 127;
      bf16_t* dst = KT + ((((size_t)b * 4 + h) * NCH + c) * 128 + dk) * 64;
#pragma unroll
      for (int g8 = 0; g8 < 8; ++g8) { unsigned w[4];
#pragma unroll
        for (int j = 0; j < 4; ++j) { const unsigned lo = kl[(g8 * 8 + 2 * j) * 512 + tid], hi2 = kl[(g8 * 8 + 2 * j + 1) * 512 + tid]; w[j] = lo | (hi2 << 16); }
        *(u32x4*)(dst + g8 * 8) = (u32x4){w[0], w[1], w[2], w[3]}; }
    }
    __syncthreads();
  }
}

__device__ __forceinline__ void ph_dn_d1(const P& p, char* lds) {
  const int tid = TIDX(), wid = tid >> 6, lane = tid & 63, r32 = lane & 31, hi = lane >> 5;
  const bf16_t* QQ = (const bf16_t*)(p.ws + OFF_D + D_QQ); const bf16_t* QK = (const bf16_t*)(p.ws + OFF_D + D_QK); const bf16_t* QV = (const bf16_t*)(p.ws + OFF_D + D_QV);
  const float* GB = (const float*)(p.ws + OFF_GB);
  bf16_t* W_ = (bf16_t*)(p.ws + OFF_D + D_W); bf16_t* U_ = (bf16_t*)(p.ws + OFF_HBF); bf16_t* INTRA = (bf16_t*)(p.ws + OFF_D + D_INTRA);
  float* SC = (float*)(p.ws + OFF_SC); float* GLS = (float*)(p.ws + OFF_GL);
  float* KK = (float*)lds; float* QKm = KK + 64 * 65; float* Ad = QKm + 64 * 65; float* Gs = Ad + 2 * 4096; float* Bs = Gs + 128;
  bf16_t* Vs = (bf16_t*)(Bs + 128); bf16_t* Ks = Vs + 64 * 128;
  for (int job = BIDX(); job < 8 * NCH; job += GDIM()) {
    const int b = job / (4 * NCH), h = (job / NCH) & 3, c = job % NCH;
    const size_t Rb = (size_t)b * TB + (size_t)c * 64;
    {
      const int srow = tid >> 4, spc = (tid & 15) * 8;
      const u32x4 v0 = *(const u32x4*)(QV + (Rb + srow) * 512 + h * 128 + spc), v1 = *(const u32x4*)(QV + (Rb + 32 + srow) * 512 + h * 128 + spc);
      const u32x4 k0 = *(const u32x4*)(QK + (Rb + srow) * 512 + h * 128 + spc), k1 = *(const u32x4*)(QK + (Rb + 32 + srow) * 512 + h * 128 + spc);
      *(u32x4*)(Vs + srow * 128 + spc) = v0; *(u32x4*)(Vs + (32 + srow) * 128 + spc) = v1;
      *(u32x4*)(Ks + srow * 128 + spc) = k0; *(u32x4*)(Ks + (32 + srow) * 128 + spc) = k1;
    }
    {
      const int w4 = wid & 3, mi = w4 & 1, ni = w4 >> 1;
      const bf16_t* As = wid < 4 ? QK : QQ;
      const bf16_t* arow = As + (Rb + 32 * mi + r32) * 512 + h * 128 + hi * 8;
      const bf16_t* brow = QK + (Rb + 32 * ni + r32) * 512 + h * 128 + hi * 8;
      f32x16 acc = {}; acc = mma_rows<8>(arow, brow, acc);
      float* dst = wid < 4 ? KK : QKm;
#pragma unroll
      for (int r = 0; r < 16; ++r) dst[(32 * mi + crow(r, hi)) * 65 + 32 * ni + r32] = acc[r];
    }
    if (tid < 128) { const int d = tid >> 6, ip = tid & 63, t = d ? 63 - ip : ip; float g = GB[(Rb + t) * 16 + d * 4 + h]; Bs[tid] = GB[(Rb + t) * 16 + 8 + d * 4 + h];
#pragma unroll
      for (int o = 1; o < 64; o <<= 1) { const float v = __shfl_up(g, o); g += ip >= o ? v : 0.f; }
      Gs[tid] = g; }
    __syncthreads();
    const int n0 = c, n1 = c < 4 ? 3 - c : 135 - c;
    const size_t cj0 = ((size_t)(0 * 2 + b) * 4 + h) * NCH + n0, cj1 = ((size_t)(1 * 2 + b) * 4 + h) * NCH + n1;
    for (int e2 = tid; e2 < 8192; e2 += 512) {
      const int d = e2 >> 12, ip = (e2 >> 6) & 63, jp = e2 & 63; const int i = d ? 63 - ip : ip, j = d ? 63 - jp : jp;
      const float dec = jp <= ip ? __expf(Gs[d * 64 + ip] - Gs[d * 64 + jp]) : 0.f;
      Ad[d * 4096 + ip * 64 + jp] = jp < ip ? Bs[d * 64 + ip] * KK[i * 65 + j] * dec : 0.f;
      const size_t cj = d ? cj1 : cj0;
      INTRA[(cj * 64 + ip) * 64 + jp] = f2bf(QKm[i * 65 + j] * dec);
    }
    if (tid < 128) { const int d = tid >> 6, ip = tid & 63; const size_t cj = d ? cj1 : cj0; const float gi = Gs[tid], gl = Gs[d * 64 + 63];
      SC[(cj * 64 + ip) * 2] = __expf(gi); SC[(cj * 64 + ip) * 2 + 1] = __expf(gl - gi); if (ip == 0) GLS[cj] = __expf(gl); }
    __syncthreads();
    {
      const int d = tid >> 8, cc = tid & 255; const size_t cj = d ? cj1 : cj0;
      int dofs = d * 64, aofs = d * 4096; asm volatile("" : "+v"(dofs), "+v"(aofs));
      float x[64];
      {
        int vofs = cc < 128 ? cc : 64 * 128 + (cc - 128); asm volatile("" : "+v"(vofs));
#pragma unroll
        for (int ip = 0; ip < 64; ++ip) x[ip] = bf2f(Vs[vofs + ip * 128]);
#pragma unroll
        for (int ip = 0; ip < 32; ++ip) { const float a_ = x[ip], b_ = x[63 - ip]; x[ip] = d ? b_ : a_; x[63 - ip] = d ? a_ : b_; }
        if (cc < 128) {
#pragma unroll
          for (int ip = 0; ip < 64; ++ip) x[ip] *= Bs[dofs + ip];
        } else {
#pragma unroll
          for (int ip = 0; ip < 64; ++ip) x[ip] *= Bs[dofs + ip] * __expf(Gs[dofs + ip]);
        }
      }
      const float* Arow = Ad + aofs;
#pragma unroll
      for (int ip = 1; ip < 64; ++ip) {
        float s = 0.f;
#pragma unroll
        for (int j4 = 0; j4 < (ip + 3) / 4; ++j4) { const f32x4 a = *(const f32x4*)(Arow + ip * 64 + 4 * j4);
          s += a[0] * x[4 * j4] + a[1] * x[4 * j4 + 1] + a[2] * x[4 * j4 + 2] + a[3] * x[4 * j4 + 3]; }
        x[ip] -= s;
      }
      bf16_t* dst = cc < 128 ? U_ + cj * 64 * 128 + cc : W_ + cj * 64 * 128 + (cc - 128);
#pragma unroll
      for (int ip = 0; ip < 64; ++ip) dst[ip * 128] = f2bf(x[ip]);
    }
    __syncthreads();
  }
}

typedef _Float16 h16x8 __attribute__((ext_vector_type(8)));
__device__ __forceinline__ void ph_gla_b(const P& p, char* lds, int e) {
  const int tid = TIDX(), wid = tid >> 6, lane = tid & 63;
  const float* SM = (const float*)(p.ws + OFF_SM);
  float* w2S = (float*)lds;
  float* b2S = w2S + 8192;
  for (int i = tid; i < 8192; i += 512) { const int d = i >> 12, hh = (i >> 10) & 3, r = (i >> 6) & 15, j = i & 63; w2S[i] = p.gla_w2[(((size_t)e * 2 + d) * 16 + r) * 256 + hh * 64 + j]; }
  if (tid < 512) b2S[tid] = p.gla_b2[(size_t)e * 512 + tid];
  __syncthreads();
  int jb = 8 * wid; asm volatile("" : "+v"(jb));
  for (int job = BIDX(); job < 16 * NCH; job += GDIM()) {
    const int n = job % NCH, sq = job / NCH; const int dir = sq >> 3, b = (sq >> 2) & 1, h = sq & 3;
    const int c = dir == 0 ? n : (n < 4 ? 3 - n : 135 - n);
    const size_t row = (size_t)b * TB + (size_t)c * 64 + (dir ? 63 - lane : lane);
    const float* gp = SM + row * 64 + 16 + dir * 16;
    const f32x4 g0 = *(const f32x4*)(gp), g1 = *(const f32x4*)(gp + 4), g2 = *(const f32x4*)(gp + 8), g3 = *(const f32x4*)(gp + 12);
    const float gg_[16] = {g0[0], g0[1], g0[2], g0[3], g1[0], g1[1], g1[2], g1[3], g2[0], g2[1], g2[2], g2[3], g3[0], g3[1], g3[2], g3[3]};
    const float* wb = w2S + (dir * 4 + h) * 1024 + jb; const float* bb2 = b2S + dir * 256 + h * 64 + jb;
    f32x4 sa = *(const f32x4*)(bb2), sb = *(const f32x4*)(bb2 + 4);
#pragma unroll
    for (int r = 0; r < 16; ++r) { const f32x4 wa = *(const f32x4*)(wb + r * 64), wq = *(const f32x4*)(wb + r * 64 + 4); sa += gg_[r] * wa; sb += gg_[r] * wq; }
    float la[8];
#pragma unroll
    for (int jj = 0; jj < 4; ++jj) { const float x0 = sa[jj], x1 = sb[jj];
      la[jj] = (fminf(x0, 0.f) - log1pf(expf(-fabsf(x0)))) * 0.0625f; la[4 + jj] = (fminf(x1, 0.f) - log1pf(expf(-fabsf(x1)))) * 0.0625f; }
#pragma unroll
    for (int o = 1; o < 64; o <<= 1) {
#pragma unroll
      for (int jj = 0; jj < 8; ++jj) { const float v = __shfl_up(la[jj], o); la[jj] += lane >= o ? v : 0.f; }
    }
    h16x8 hv;
#pragma unroll
    for (int jj = 0; jj < 8; ++jj) hv[jj] = (_Float16)la[jj];
    _Float16* dst = (_Float16*)(p.ws + (dir ? OFF_B16_1 : OFF_WC)) + ((((size_t)b * 4 + h) * NCH + n) * 64 + lane) * 64 + jb;
    *(h16x8*)dst = hv;
  }
}

struct DnSet { bf16x8 fa[8]; };
template <int ROLE>
__device__ __forceinline__ void dn_scan_t(const P& p, char* lds, int job) {
  const int tid = TIDX(), wid = tid >> 6, lane = tid & 63, r32 = lane & 31, hi = lane >> 5;
  const int dir = job >> 5, b = (job >> 4) & 1, h = (job >> 2) & 3, n0 = (job & 3) * 32;
  const bf16_t* QQ = (const bf16_t*)(p.ws + OFF_D + D_QQ); const bf16_t* KT = (const bf16_t*)(p.ws + OFF_D + D_KT);
  const bf16_t* W_ = (const bf16_t*)(p.ws + OFF_D + D_W); const bf16_t* U_ = (const bf16_t*)(p.ws + OFF_HBF); const bf16_t* INTRA = (const bf16_t*)(p.ws + OFF_D + D_INTRA);
  const float* SC = (const float*)(p.ws + OFF_SC); const float* GLS = (const float*)(p.ws + OFF_GL);
  bf16_t* DNO = (bf16_t*)(p.ws + OFF_D + D_DNO);
  bf16_t* ST = (bf16_t*)lds; bf16_t* vTa = ST + 32 * 136; bf16_t* vTb = vTa + 32 * 72;
  float* scS = (float*)(vTb + 32 * 72);
  bf16_t* uS = (bf16_t*)(scS + 256);
  bf16_t* inS = uS + 2 * 64 * 40;
  for (int i = tid; i < 32 * 136; i += 512) ST[i] = 0;
  f32x16 accS = {};
  const size_t seq = ((size_t)dir * 2 + b) * 4 + h;
  const int mi = wid & 1, di = wid - 4;
  constexpr int role = ROLE;
  const int tt = tid - 256;
  DnSet fs[3]; float gls[3] = {0.f, 0.f, 0.f};
  u32x4 stU[3], stI0[3]; float stS[3] = {0.f, 0.f, 0.f};
#define DN_CH(n_) const int n__ = (n_); const int c__ = dir == 0 ? n__ : (n__ < 4 ? 3 - n__ : 135 - n__); const size_t Rb__ = (size_t)b * TB + (size_t)c__ * 64; const size_t cj__ = seq * NCH + n__;
#define DN_LOAD(S, GL, n_) do { DN_CH(n_) \
    const int ipl__ = 32 * mi + r32, tl__ = dir ? 63 - ipl__ : ipl__; \
    const bf16_t* b0__ = W_ + cj__ * 8192 + (32 * mi + r32) * 128 + hi * 8; \
    const bf16_t* b1__ = QQ + (Rb__ + tl__) * 512 + h * 128 + hi * 8; \
    const bf16_t* b2__ = KT + ((((size_t)b * 4 + h) * NCH + c__) * 128 + 32 * (wid & 3) + r32) * 64 + hi * 8; \
    const bf16_t* bs__ = role == 0 ? b0__ : (role == 1 ? b1__ : b2__); \
    _Pragma("unroll") for (int ks = 0; ks < 8; ++ks) S.fa[ks] = *(const bf16x8*)(bs__ + ks * 16); \
    GL = GLS[cj__]; } while (0)
#define DN_STAGE_LD(q_, n_) do { DN_CH(n_) (void)Rb__; \
      stU[q_] = *(const u32x4*)(U_ + cj__ * 8192 + ((tid & 255) >> 2) * 128 + n0 + (tid & 3) * 8); \
      stI0[q_] = *(const u32x4*)(INTRA + cj__ * 4096 + (tid >> 3) * 64 + (tid & 7) * 8); \
      stS[q_] = SC[cj__ * 128 + (tid & 127)]; } while (0)
#define DN_STAGE_ST(q_, bf_) do { *(u32x4*)(inS + (bf_) * 4608 + (tid >> 3) * 72 + (tid & 7) * 8) = stI0[q_]; \
      if (ROLE < 2) *(u32x4*)(uS + (bf_) * 2560 + (tid >> 2) * 40 + (tid & 3) * 8) = stU[q_]; \
      if (ROLE == 0) scS[(bf_) * 128 + tid] = stS[q_]; } while (0)
#define DN_STEP(S, GL, n_, bf_) do { DN_CH(n_) (void)cj__; \
    const float* sc__ = scS + (bf_) * 128; \
    if (role < 2) { _Pragma("unroll") for (int r = 0; r < 16; ++r) accS[r] = 0.f; } \
    if (role < 2) { const bf16_t* sb__ = ST + r32 * 136 + hi * 8; \
      _Pragma("unroll") for (int ks = 0; ks < 8; ++ks) accS = MFMA32(S.fa[ks], *(const bf16x8*)(sb__ + ks * 16), accS); \
      if (role == 0) { const bf16_t* us__ = uS + (bf_) * 2560 + r32; \
        _Pragma("unroll") for (int r = 0; r < 16; ++r) { const int ip = 32 * mi + crow(r, hi); const float vn = bf2f(us__[ip * 40]) - accS[r]; \
          vTa[r32 * 72 + ip] = f2bf(vn); const int to = dir ? 63 - ip : ip; vTb[r32 * 72 + to] = f2bf(vn * sc__[ip * 2 + 1]); } } \
      else { _Pragma("unroll") for (int r = 0; r < 16; ++r) accS[r] *= sc__[(32 * mi + crow(r, hi)) * 2]; } } \
    LBAR(); \
    if (role == 1) { const bf16_t* vb__ = vTa + r32 * 72 + hi * 8; const bf16_t* ib__ = inS + (bf_) * 4608 + (32 * mi + r32) * 72 + hi * 8; \
      _Pragma("unroll") for (int ks = 0; ks < 4; ++ks) accS = MFMA32(*(const bf16x8*)(ib__ + ks * 16), *(const bf16x8*)(vb__ + ks * 16), accS); \
      _Pragma("unroll") for (int r = 0; r < 16; ++r) { const int ip = 32 * mi + crow(r, hi), t = dir ? 63 - ip : ip; \
        DNO[((size_t)dir * MROWS + Rb__ + t) * 512 + h * 128 + n0 + r32] = f2bf(accS[r]); } } \
    else if (role == 2) { const bf16_t* vb__ = vTb + r32 * 72 + hi * 8; \
      _Pragma("unroll") for (int r = 0; r < 16; ++r) accS[r] *= GL; \
      _Pragma("unroll") for (int ks = 0; ks < 4; ++ks) accS = MFMA32(S.fa[ks], *(const bf16x8*)(vb__ + ks * 16), accS); \
      _Pragma("unroll") for (int r = 0; r < 16; ++r) ST[r32 * 136 + 32 * di + crow(r, hi)] = f2bf(accS[r]); } \
    LBAR(); } while (0)
  DN_STAGE_LD(0, 0); DN_STAGE_ST(0, 0); DN_STAGE_LD(1, 1); DN_STAGE_LD(2, 2);
  DN_LOAD(fs[0], gls[0], 0); DN_LOAD(fs[1], gls[1], 1);
  __syncthreads();
  for (int nb6 = 0; nb6 < NCH; nb6 += 6) {
#pragma unroll
    for (int k = 0; k < 6; ++k) {
      const int n = nb6 + k; const int n2 = n + 2 < NCH ? n + 2 : NCH - 1; const int n3 = n + 3 < NCH ? n + 3 : NCH - 1;
      DN_STAGE_ST((k + 1) % 3, (k + 1) & 1);
      DN_STAGE_LD(k % 3, n3);
      DN_LOAD(fs[(k + 2) % 3], gls[(k + 2) % 3], n2);
      DN_STEP(fs[k % 3], gls[k % 3], n, k & 1);
    }
  }
#undef DN_CH
#undef DN_LOAD
#undef DN_STAGE_LD
#undef DN_STAGE_ST
#undef DN_STEP
}

__device__ __forceinline__ void dn_scan(const P& p, char* lds, int job) {
  const int wid = TIDX() >> 6;
  if (wid < 2) dn_scan_t<0>(p, lds, job); else if (wid < 4) dn_scan_t<1>(p, lds, job); else dn_scan_t<2>(p, lds, job);
}

DI float fast_logsig(float s) { return fminf(s, 0.f) - __logf(1.f + __expf(-fabsf(s))); }
struct GlaRegs { h16x8 ba, bb; bf16x8 qa, qb, ka, kb, v8; };
template <int ROLE>
__device__ __forceinline__ void gla_scan_t(const P& p, char* lds, int job, int e) {
  const int tid = TIDX(), wid = tid >> 6, lane = tid & 63, r32 = lane & 31, hi = lane >> 5;
  const int dir = job >> 5, b = (job >> 4) & 1, h = (job >> 2) & 3, n0 = (job & 3) * 32;
  const bf16_t* P2 = (const bf16_t*)(p.ws + OFF_D + D_P2); const float* SM = (const float*)(p.ws + OFF_SM);
  bf16_t* GLAO = (bf16_t*)(p.ws + OFF_D + D_GLAO);
  const _Float16* B16 = (const _Float16*)(p.ws + (dir ? OFF_B16_1 : OFF_WC));
  float* w2S = (float*)lds; float* b2S = w2S + 1024; float* aLb = b2S + 64;
  bf16_t* ops = (bf16_t*)(aLb + 128);
  constexpr int OPB = (4 * 64 + 32) * 72;
  bf16_t* attp = ops + 2 * OPB;
  bf16_t* STb = attp + 2 * 32 * 72;
  for (int i = tid; i < 2 * 32 * 72; i += 512) STb[i] = 0;
  f32x16 accS = {};
  __syncthreads();
  GlaRegs RG[3];
  int jb0 = 16 * (wid & 3); asm volatile("" : "+v"(jb0));
  int vtb0 = 8 * (wid & 3) * 72 + lane; asm volatile("" : "+v"(vtb0));
#define GLA_LOAD(R, n_) do { const int n__ = (n_) < NCH ? (n_) : NCH - 1; const int c__ = dir == 0 ? n__ : (n__ < 4 ? 3 - n__ : 135 - n__); const size_t row__ = (size_t)b * TB + (size_t)c__ * 64 + (dir ? 63 - lane : lane); \
    const _Float16* bp__ = B16 + ((((size_t)b * 4 + h) * NCH + n__) * 64 + lane) * 64 + 16 * (wid & 3); R.ba = *(const h16x8*)(bp__); R.bb = *(const h16x8*)(bp__ + 8); \
    const bf16_t* pr__ = P2 + row__ * 2048; R.qa = *(const bf16x8*)(pr__ + 512 + h * 64 + 16 * (wid & 3)); R.qb = *(const bf16x8*)(pr__ + 512 + h * 64 + 16 * (wid & 3) + 8); \
    R.ka = *(const bf16x8*)(pr__ + 768 + h * 64 + 16 * (wid & 3)); R.kb = *(const bf16x8*)(pr__ + 768 + h * 64 + 16 * (wid & 3) + 8); R.v8 = *(const bf16x8*)(pr__ + 1024 + h * 128 + n0 + 8 * (wid & 3)); } while (0)
#define GLA_HALF(R, BV, QV, KV, jb) do { \
    float eqe[8], eke[8], eqi[8]; \
    _Pragma("unroll") for (int jj = 0; jj < 8; ++jj) { const int j = (jb) + jj; const float bb = (float)BV[jj]; const float bm = __int_as_float(__builtin_amdgcn_readlane(__float_as_int(bb), 32)), bl = __int_as_float(__builtin_amdgcn_readlane(__float_as_int(bb), 63)); \
      const float q_ = bf2f((bf16_t)QV[jj]) * 0.125f, k_ = bf2f((bf16_t)KV[jj]); \
      eqe[jj] = q_ * __expf(bb - bm); eke[jj] = k_ * __expf(bm - bb); eqi[jj] = q_ * __expf(bb); ksT_[j * 72 + lane] = f2bf(k_ * __expf(bl - bb)); if (lane == 63) aL_[j] = __expf(bl); } \
    *(u32x4*)(qe_ + lane * 72 + (jb)) = (u32x4){cvtpk(eqe[0], eqe[1]), cvtpk(eqe[2], eqe[3]), cvtpk(eqe[4], eqe[5]), cvtpk(eqe[6], eqe[7])}; \
    *(u32x4*)(ke_ + lane * 72 + (jb)) = (u32x4){cvtpk(eke[0], eke[1]), cvtpk(eke[2], eke[3]), cvtpk(eke[4], eke[5]), cvtpk(eke[6], eke[7])}; \
    *(u32x4*)(qi_ + lane * 72 + (jb)) = (u32x4){cvtpk(eqi[0], eqi[1]), cvtpk(eqi[2], eqi[3]), cvtpk(eqi[4], eqi[5]), cvtpk(eqi[6], eqi[7])}; } while (0)
#define GLA_PREP(R, bf_) do { bf16_t* qe_ = ops + (bf_) * OPB; bf16_t* ke_ = qe_ + 64 * 72; bf16_t* qi_ = ke_ + 64 * 72; bf16_t* ksT_ = qi_ + 64 * 72; bf16_t* vT_ = ksT_ + 64 * 72; float* aL_ = aLb + (bf_) * 64; \
    GLA_HALF(R, R.ba, R.qa, R.ka, jb0); GLA_HALF(R, R.bb, R.qb, R.kb, jb0 + 8); \
    _Pragma("unroll") for (int q_ = 0; q_ < 8; ++q_) vT_[vtb0 + q_ * 72] = (bf16_t)R.v8[q_]; } while (0)
#define GLA_MMA(n_, bf_) do { const int nq__ = (n_); const int bf = (bf_); \
      const bf16_t* qe_ = ops + bf * OPB; const bf16_t* ke_ = qe_ + 64 * 72; const bf16_t* qi_ = ke_ + 64 * 72; const bf16_t* ksT_ = qi_ + 64 * 72; const bf16_t* vT_ = ksT_ + 64 * 72; const float* aL_ = aLb + bf * 64; \
      const bf16_t* STr = STb + bf * 32 * 72; bf16_t* STw = STb + (bf ^ 1) * 32 * 72; \
      if (ROLE == 1) { \
        const int mi = wid - 4; bf16_t* attw = attp + mi * 32 * 72; \
        const int c = dir == 0 ? nq__ : (nq__ < 4 ? 3 - nq__ : 135 - nq__); const size_t Rb = (size_t)b * TB + (size_t)c * 64; \
        f32x16 acc = {}; acc = mma_rows<4>(qi_ + (32 * mi + r32) * 72 + hi * 8, STr + r32 * 72 + hi * 8, acc); \
        { f32x16 a0 = {}; a0 = mma_rows<4>(qe_ + (32 * mi + r32) * 72 + hi * 8, ke_ + r32 * 72 + hi * 8, a0); \
          _Pragma("unroll") for (int r = 0; r < 16; ++r) { const int ipl = crow(r, hi); attw[ipl * 72 + r32] = f2bf((mi == 1 || r32 <= ipl) ? a0[r] : 0.f); } \
          f32x16 a1 = {}; if (mi == 1) a1 = mma_rows<4>(qe_ + (32 + r32) * 72 + hi * 8, ke_ + (32 + r32) * 72 + hi * 8, a1); \
          _Pragma("unroll") for (int r = 0; r < 16; ++r) { const int ipl = crow(r, hi); attw[ipl * 72 + 32 + r32] = f2bf((mi == 1 && r32 <= ipl) ? a1[r] : 0.f); } } \
        asm volatile("s_waitcnt lgkmcnt(0)" ::: "memory"); \
        acc = mma_rows<4>(attw + r32 * 72 + hi * 8, vT_ + r32 * 72 + hi * 8, acc); \
        _Pragma("unroll") for (int r = 0; r < 16; ++r) { const int ip = 32 * mi + crow(r, hi), t = dir ? 63 - ip : ip; \
          GLAO[((size_t)dir * MROWS + Rb + t) * 512 + h * 128 + n0 + r32] = f2bf(acc[r]); } \
      } else { \
        const int di = wid - 6; \
        _Pragma("unroll") for (int r = 0; r < 16; ++r) accS[r] *= aL_[32 * di + crow(r, hi)]; \
        accS = mma_rows<4>(ksT_ + (32 * di + r32) * 72 + hi * 8, vT_ + r32 * 72 + hi * 8, accS); \
        _Pragma("unroll") for (int r = 0; r < 16; ++r) STw[r32 * 72 + 32 * di + crow(r, hi)] = f2bf(accS[r]); \
      } } while (0)
  GLA_LOAD(RG[0], 0);
  if (ROLE == 0) { GLA_PREP(RG[0], 0); }
  GLA_LOAD(RG[1], 1); GLA_LOAD(RG[2], 2); GLA_LOAD(RG[0], 3);
  LBAR();
  for (int nb6 = 0; nb6 < NCH; nb6 += 6) {
#pragma unroll
    for (int k = 0; k < 6; ++k) {
      const int n = nb6 + k;
      if (ROLE == 0) { if (n + 1 < NCH) { GLA_PREP(RG[(k + 1) % 3], (k + 1) & 1); } } else { GLA_MMA(n, k & 1); }
      GLA_LOAD(RG[(k + 1) % 3], n + 4);
      LBAR();
    }
  }
#undef GLA_MMA
#undef GLA_LOAD
#undef GLA_HALF
#undef GLA_PREP
}

__device__ __forceinline__ void gla_scan(const P& p, char* lds, int job, int e) {
  const int wid = TIDX() >> 6;
  if (wid < 4) gla_scan_t<0>(p, lds, job, e); else if (wid < 6) gla_scan_t<1>(p, lds, job, e); else gla_scan_t<2>(p, lds, job, e);
}

__device__ __forceinline__ void ph_merge(const P& p, int e) {
  const int tid = TIDX(), wid = tid >> 6, lane = tid & 63, l16 = lane & 15, sub = lane >> 4;
  const bf16_t* DNO = (const bf16_t*)(p.ws + OFF_D + D_DNO); const bf16_t* GLAO = (const bf16_t*)(p.ws + OFF_D + D_GLAO);
  const bf16_t* P2 = (const bf16_t*)(p.ws + OFF_D + D_P2); bf16_t* hb = (bf16_t*)(p.ws + OFF_HBF);
  f32x8 nwd = *(const f32x8*)(p.dn_norm + e * 128 + l16 * 8), nwg = *(const f32x8*)(p.gla_norm + e * 128 + l16 * 8);
  for (int R4 = (BIDX() * 8 + wid) * 4; R4 < MROWS; R4 += GDIM() * 32) {
    const size_t R = R4 + sub;
    bf16x8 a[8], bq[8], zz[8];
#pragma unroll
    for (int g = 0; g < 8; ++g) { const bf16_t* src = g < 4 ? DNO : GLAO; const int hc = (g & 3) * 128 + l16 * 8;
      a[g] = *(const bf16x8*)(src + R * 512 + hc); bq[g] = *(const bf16x8*)(src + ((size_t)MROWS + R) * 512 + hc);
      zz[g] = *(const bf16x8*)(P2 + R * 2048 + (g < 4 ? 0 : 1536) + hc); }
#pragma unroll
    for (int g = 0; g < 8; ++g) {
      float v[8]; float ss = 0.f;
#pragma unroll
      for (int j = 0; j < 8; ++j) { v[j] = bf2f((bf16_t)a[g][j]) + bf2f((bf16_t)bq[g][j]); ss += v[j] * v[j]; }
      ss += __shfl_xor(ss, 1); ss += __shfl_xor(ss, 2); ss += __shfl_xor(ss, 4); ss += __shfl_xor(ss, 8);
      const float rs = rsqrtf(ss * (1.f / 128.f) + EPSF);
      float o[8];
#pragma unroll
      for (int j = 0; j < 8; ++j) o[j] = v[j] * rs * (g < 4 ? nwd[j] : nwg[j]) * siluf(bf2f((bf16_t)zz[g][j]));
      *(u32x4*)(hb + R * 1024 + g * 128 + l16 * 8) = (u32x4){cvtpk(o[0], o[1]), cvtpk(o[2], o[3]), cvtpk(o[4], o[5]), cvtpk(o[6], o[7])};
    }
  }
}

DI float silu_fast(float x) { return x / (1.f + __expf(-x)); }
__device__ __forceinline__ void ph_ffnact(const P& p, int L) {
  bf16_t* U = (bf16_t*)(p.ws + OFF_D);
  const float* cw = p.ffn_conv + (size_t)L * 3 * DFF;
  const size_t items = (size_t)MROWS * 352, stride = (size_t)GDIM() * 512;
  for (size_t it0 = (size_t)BIDX() * 512 + TIDX(); it0 < items; it0 += 2 * stride) {
    bf16x8 zc[2], zp[2], zn[2], vv[2]; int Rr[2], cc[2]; bool ok[2];
#pragma unroll
    for (int q = 0; q < 2; ++q) {
      size_t it = it0 + q * stride; ok[q] = it < items; if (!ok[q]) it = it0;
      const int R = (int)(it / 352), c0 = (int)(it % 352) * 8; const int b = R >= TB ? 1 : 0, pp = R - b * TB;
      const bool hasp = !(pp == 0 || pp == CTXL), hasn = !(pp == CTXL - 1 || pp == TB - 1);
      Rr[q] = R; cc[q] = c0;
      zc[q] = *(const bf16x8*)(U + (size_t)R * 5632 + c0);
      zp[q] = *(const bf16x8*)(U + (size_t)(hasp ? R - 1 : R) * 5632 + c0);
      zn[q] = *(const bf16x8*)(U + (size_t)(hasn ? R + 1 : R) * 5632 + c0);
      vv[q] = *(const bf16x8*)(U + (size_t)R * 5632 + DFF + c0);
      if (!hasp) zp[q] = (bf16x8){0, 0, 0, 0, 0, 0, 0, 0};
      if (!hasn) zn[q] = (bf16x8){0, 0, 0, 0, 0, 0, 0, 0};
    }
#pragma unroll
    for (int q = 0; q < 2; ++q) {
      const int c0 = cc[q];
      const f32x8 w0 = *(const f32x8*)(cw + c0), w1 = *(const f32x8*)(cw + DFF + c0), w2 = *(const f32x8*)(cw + 2 * DFF + c0);
      float o[8];
#pragma unroll
      for (int j = 0; j < 8; ++j) { const float a = bf2f((bf16_t)zp[q][j]) * w0[j] + bf2f((bf16_t)zc[q][j]) * w1[j] + bf2f((bf16_t)zn[q][j]) * w2[j];
        o[j] = silu_fast(a) * bf2f((bf16_t)vv[q][j]); }
      if (ok[q]) *(u32x4*)(U + (size_t)Rr[q] * 5632 + DFF + c0) = (u32x4){cvtpk(o[0], o[1]), cvtpk(o[2], o[3]), cvtpk(o[4], o[5]), cvtpk(o[6], o[7])};
    }
  }
}

__device__ __forceinline__ void ph_qknorm(const P& p, char* lds, int o) {
  const int tid = TIDX(), wid = tid >> 6, lane = tid & 63, l16 = lane & 15, sub = lane >> 4;
  bf16_t* QKV = (bf16_t*)(p.ws + OFF_D);
  float* tab = (float*)lds;
  for (int i = tid; i < 4096; i += 512) { const int pos = i >> 5, f = i & 31; const float ang = (float)pos * powf(10000.f, -(float)f / 32.f); tab[2 * i] = cosf(ang); tab[2 * i + 1] = sinf(ang); }
  __syncthreads();
  const f32x8 qn = *(const f32x8*)(p.att_q_norm + o * 128 + l16 * 8), kn = *(const f32x8*)(p.att_k_norm + o * 128 + l16 * 8);
  const int f0 = (l16 & 3) * 8;
  for (int R4 = (BIDX() * 8 + wid) * 4; R4 < MROWS; R4 += GDIM() * 32) {
    const int R = R4 + sub; const int b = R >= TB ? 1 : 0, pp = R - b * TB; const bool lat = pp >= CTXL; const int t = lat ? pp - CTXL : 0;
    const int pos = (l16 < 8) ? (t >> 6) : (t & 63);
    bf16_t* base = QKV + (size_t)R * 1536 + l16 * 8;
    bf16x8 x[10];
#pragma unroll
    for (int hd = 0; hd < 10; ++hd) x[hd] = *(const bf16x8*)(base + hd * 128);
    float cs[8], sn[8];
#pragma unroll
    for (int j = 0; j < 8; ++j) { const float2 t2 = *(const float2*)(tab + 2 * (pos * 32 + f0 + j)); cs[j] = lat ? t2.x : 1.f; sn[j] = lat ? t2.y : 0.f; }
#pragma unroll
    for (int hd = 0; hd < 10; ++hd) {
      float v[8]; float ss = 0.f;
#pragma unroll
      for (int j = 0; j < 8; ++j) { v[j] = bf2f((bf16_t)x[hd][j]); ss += v[j] * v[j]; }
      ss += __shfl_xor(ss, 1); ss += __shfl_xor(ss, 2); ss += __shfl_xor(ss, 4); ss += __shfl_xor(ss, 8);
      const float rs = rsqrtf(ss * (1.f / 128.f) + EPSF);
      float ov[8];
#pragma unroll
      for (int j = 0; j < 8; ++j) { v[j] = v[j] * rs * (hd < 8 ? qn[j] : kn[j]); const float pr = __shfl_xor(v[j], 4);
        ov[j] = (l16 & 4) ? (pr * sn[j] + v[j] * cs[j]) : (v[j] * cs[j] - pr * sn[j]); }
      *(u32x4*)(base + hd * 128) = (u32x4){cvtpk(ov[0], ov[1]), cvtpk(ov[2], ov[3]), cvtpk(ov[4], ov[5]), cvtpk(ov[6], ov[7])};
    }
  }
}

namespace at {
constexpr int D = 128, NW = 8, QBLK = 32, KVBLK = 64;
constexpr float SCALE = 0.088388347648318440f, THR = 8.f;
constexpr int LDQ = 1536, LDK = 1536, LDO = 1024;
constexpr size_t SHM_V = KVBLK * D * 2, SHM_K = KVBLK * D * 2;
#define KSWZ(row, colB) ((row) * 256 + ((colB) ^ (((row) & 7) << 4)))
#define SBAR() __builtin_amdgcn_sched_barrier(0)
DI void partialSM(f32x16& p0, f32x16& p1, float& m_reg, float& mn, float& alpha) {
  constexpr float C = SCALE * 1.4426950408889634f;
  float pmax = p0[0]; for (int r = 1; r < 16; ++r) pmax = fmaxf(pmax, p0[r]); for (int r = 0; r < 16; ++r) pmax = fmaxf(pmax, p1[r]);
  { auto rr = __builtin_amdgcn_permlane32_swap(__float_as_uint(pmax), __float_as_uint(pmax), false, false);
    pmax = fmaxf(__uint_as_float(rr[0]), __uint_as_float(rr[1])); }
  if (__builtin_expect(__all(pmax - m_reg <= THR / SCALE), 1)) { mn = m_reg; alpha = 1.f; }
  else { mn = fmaxf(m_reg, pmax); alpha = __builtin_amdgcn_exp2f((m_reg - mn) * C); m_reg = mn; }
  float mnC = -mn * C;
  for (int r = 0; r < 16; ++r) p0[r] = fmaf(p0[r], C, mnC); for (int r = 0; r < 16; ++r) p1[r] = fmaf(p1[r], C, mnC);
  for (int r = 0; r < 16; ++r) p0[r] = __builtin_amdgcn_exp2f(p0[r]);
}
DI void finishSM(f32x16& p0, f32x16& p1, float alpha, float& l_reg, bf16x8& pa0, bf16x8& pa1, bf16x8& pa2, bf16x8& pa3) {
  for (int r = 0; r < 16; ++r) p1[r] = __builtin_amdgcn_exp2f(p1[r]);
  float ps = 0; for (int r = 0; r < 16; ++r) ps += p0[r]; for (int r = 0; r < 16; ++r) ps += p1[r];
  { auto rr = __builtin_amdgcn_permlane32_swap(__float_as_uint(ps), __float_as_uint(ps), false, false);
    ps = __uint_as_float(rr[0]) + __uint_as_float(rr[1]); }
  l_reg = l_reg * alpha + ps;
#define PK4(PP, BASE, OUT) do { unsigned a0 = cvtpk(PP[BASE + 0], PP[BASE + 1]), a1 = cvtpk(PP[BASE + 2], PP[BASE + 3]);   \
    unsigned b0 = cvtpk(PP[BASE + 4], PP[BASE + 5]), b1 = cvtpk(PP[BASE + 6], PP[BASE + 7]);                              \
    auto r0 = __builtin_amdgcn_permlane32_swap(a0, b0, false, false); auto r1 = __builtin_amdgcn_permlane32_swap(a1, b1, false, false); \
    u32x4 w = {r0[0], r1[0], r0[1], r1[1]}; OUT = *reinterpret_cast<bf16x8*>(&w); } while (0)
  PK4(p0, 0, pa0); PK4(p0, 8, pa1); PK4(p1, 0, pa2); PK4(p1, 8, pa3);
#undef PK4
}
DI void qkt(f32x16& p0, f32x16& p1, const bf16_t* Ks, const bf16x8* qr, int r32, int hi) {
  p0 = f32x16{}; p1 = f32x16{};
  for (int d0 = 0; d0 < 8; ++d0) { int cb = (d0 * 16 + hi * 8) * 2;
    bf16x8 b0 = *reinterpret_cast<const bf16x8*>((const char*)Ks + KSWZ(r32, cb));
    bf16x8 b1 = *reinterpret_cast<const bf16x8*>((const char*)Ks + KSWZ(32 + r32, cb));
    p0 = MFMA32(b0, qr[d0], p0);
    p1 = MFMA32(b1, qr[d0], p1); }
}
DI int v_st(int k, int c) { const int kk = (k & ~0xC) | ((k & 4) << 1) | ((k & 8) >> 1); return ((kk >> 3) * 4 + (c >> 5)) * 512 + ((kk & 7) * 32 + (c & 31)) * 2; }
DI int v_rd_base(int lane) { return ((lane & 3) << 3) | (((lane >> 2) & 3) << 6) | (((lane >> 4) & 1) << 5) | (((lane >> 5) & 1) << 8); }
constexpr int v_rd_off(int d0, int ks, int half) { return d0 * 512 + ks * 4096 + half * 2048; }
template <int OFF> DI s16x4 tr_read(int vb) {
  s16x4 r; asm volatile("ds_read_b64_tr_b16 %0, %1 offset:%2" : "=&v"(r) : "v"(vb), "i"(OFF) : "memory"); return r;
}
template <int D0> DI void pv_one(f32x16& od, int vb, bf16x8 pa0, bf16x8 pa1, bf16x8 pa2, bf16x8 pa3) {
  const s16x4 l0 = tr_read<v_rd_off(D0, 0, 0)>(vb), h0 = tr_read<v_rd_off(D0, 0, 1)>(vb), l1 = tr_read<v_rd_off(D0, 1, 0)>(vb), h1 = tr_read<v_rd_off(D0, 1, 1)>(vb);
  const s16x4 l2 = tr_read<v_rd_off(D0, 2, 0)>(vb), h2 = tr_read<v_rd_off(D0, 2, 1)>(vb), l3 = tr_read<v_rd_off(D0, 3, 0)>(vb), h3 = tr_read<v_rd_off(D0, 3, 1)>(vb);
  asm volatile("s_waitcnt lgkmcnt(0)" ::: "memory"); SBAR();
#define PK(Lx, Hx) (bf16x8){Lx[0], Lx[1], Lx[2], Lx[3], Hx[0], Hx[1], Hx[2], Hx[3]}
  od = MFMA32(pa0, PK(l0, h0), od);
  od = MFMA32(pa1, PK(l1, h1), od);
  od = MFMA32(pa2, PK(l2, h2), od);
  od = MFMA32(pa3, PK(l3, h3), od);
#undef PK
}
DI void pv_d0(f32x16* o, int vb, bf16x8 pa0, bf16x8 pa1, bf16x8 pa2, bf16x8 pa3) {
  pv_one<0>(o[0], vb, pa0, pa1, pa2, pa3); pv_one<1>(o[1], vb, pa0, pa1, pa2, pa3); pv_one<2>(o[2], vb, pa0, pa1, pa2, pa3); pv_one<3>(o[3], vb, pa0, pa1, pa2, pa3);
}
DI void attn_dense_body(const bf16_t* __restrict__ Qb, const bf16_t* __restrict__ Kh, const bf16_t* __restrict__ Vh, bf16_t* __restrict__ Ob, int seq, char* lds) {
  const int tid = TIDX(), wid = tid >> 6, lane = tid & 63, r32 = lane & 31, hi = lane >> 5;
  bf16_t* V_lds = (bf16_t*)lds; bf16_t* K_lds = (bf16_t*)(lds + 2 * SHM_V);
  float* ws = (float*)(lds + 2 * SHM_V + 2 * SHM_K) + wid * 64; float* li_l = ws; float* al_l = ws + 32;
  float m_reg = -1e30f, l_reg = 0; f32x16 o[4] = {}; bf16x8 qr[8];
  const bf16_t* Qw = Qb + (long)(wid * QBLK + r32) * LDQ + hi * 8;
#pragma unroll
  for (int d0 = 0; d0 < 8; ++d0) qr[d0] = *reinterpret_cast<const bf16x8*>(Qw + d0 * 16);
  const int sr = tid >> 4, sc = (tid & 15) * 8, vst0 = v_st(sr, sc), vst1 = v_st(32 + sr, sc);
  const int vb0 = (int)(uintptr_t)V_lds + v_rd_base(lane);
  struct { bf16x8 vs0, vs1, ks0, ks1; } sr_[2];
#define SLOAD(i, k0) do { sr_[i].vs0 = *(const bf16x8*)(&Vh[(long)((k0) + sr) * LDK + sc]); sr_[i].vs1 = *(const bf16x8*)(&Vh[(long)((k0) + 32 + sr) * LDK + sc]); \
    sr_[i].ks0 = *(const bf16x8*)(&Kh[(long)((k0) + sr) * LDK + sc]); sr_[i].ks1 = *(const bf16x8*)(&Kh[(long)((k0) + 32 + sr) * LDK + sc]); } while (0)
#define SWRITE(bq, i) do { *(bf16x8*)((char*)V_lds + (bq) * SHM_V + vst0) = sr_[i].vs0;          \
    *(bf16x8*)((char*)V_lds + (bq) * SHM_V + vst1) = sr_[i].vs1; int kc = sc * 2;               \
    *(bf16x8*)((char*)K_lds + (bq) * SHM_K + KSWZ(sr, kc)) = sr_[i].ks0;                       \
    *(bf16x8*)((char*)K_lds + (bq) * SHM_K + KSWZ(32 + sr, kc)) = sr_[i].ks1; } while (0)
#define SWAIT() asm volatile("s_waitcnt vmcnt(4)" ::: "memory")
#define RESC(a) do { if (__any((a) < 1.f)) { if (hi == 0) al_l[r32] = (a); asm volatile("s_waitcnt lgkmcnt(0)" ::: "memory"); \
    for (int d = 0; d < 4; ++d) for (int r = 0; r < 16; ++r) o[d][r] *= al_l[crow(r, hi)]; } } while (0)
  f32x16 pA0, pA1, pB0, pB1; float mnA, mnB, alA, alB; bf16x8 pa0, pa1, pa2, pa3; const int NT = seq / KVBLK;
  constexpr int SE = 0, SO = 1;
  SLOAD(SE, 0); asm volatile("s_waitcnt vmcnt(0)" ::: "memory"); SWRITE(0, SE); __syncthreads();
  qkt(pA0, pA1, K_lds, qr, r32, hi); partialSM(pA0, pA1, m_reg, mnA, alA);
  SLOAD(SO, KVBLK); if (2 < NT) SLOAD(SE, 2 * KVBLK);
  SWAIT(); SWRITE(1, SO); __syncthreads();
  for (int j = 1; j + 1 < NT; j += 2) {
    SBAR(); qkt(pB0, pB1, (bf16_t*)((char*)K_lds + SHM_K), qr, r32, hi);
    finishSM(pA0, pA1, alA, l_reg, pa0, pa1, pa2, pa3); SBAR();
    SLOAD(SO, (j + 2) * KVBLK); SBAR();
    pv_d0(o, vb0, pa0, pa1, pa2, pa3); partialSM(pB0, pB1, m_reg, mnB, alB);
    __syncthreads(); SWAIT(); SWRITE(0, SE);
    RESC(alB); __syncthreads();
    SBAR(); qkt(pA0, pA1, K_lds, qr, r32, hi);
    finishSM(pB0, pB1, alB, l_reg, pa0, pa1, pa2, pa3); SBAR();
    if (j + 3 < NT) SLOAD(SE, (j + 3) * KVBLK); SBAR();
    pv_d0(o, vb0 + (int)SHM_V, pa0, pa1, pa2, pa3); partialSM(pA0, pA1, m_reg, mnA, alA);
    __syncthreads(); SWAIT(); SWRITE(1, SO);
    RESC(alA); __syncthreads();
  }
  SBAR(); qkt(pB0, pB1, (bf16_t*)((char*)K_lds + SHM_K), qr, r32, hi);
  finishSM(pA0, pA1, alA, l_reg, pa0, pa1, pa2, pa3); SBAR();
  pv_d0(o, vb0, pa0, pa1, pa2, pa3); partialSM(pB0, pB1, m_reg, mnB, alB);
  __syncthreads(); RESC(alB);
  finishSM(pB0, pB1, alB, l_reg, pa0, pa1, pa2, pa3); SBAR();
  pv_d0(o, vb0 + (int)SHM_V, pa0, pa1, pa2, pa3);
  if (hi == 0) li_l[r32] = l_reg; asm volatile("s_waitcnt lgkmcnt(0)" ::: "memory");
  float rli[16];
#pragma unroll
  for (int r = 0; r < 16; ++r) rli[r] = __builtin_amdgcn_rcpf(li_l[crow(r, hi)]);
  bf16_t* Ow = Ob + (long)(wid * QBLK) * LDO;
#pragma unroll
  for (int r = 0; r < 16; ++r) { int orow = crow(r, hi);
    for (int d0 = 0; d0 < 4; ++d0) Ow[(long)orow * LDO + d0 * 32 + r32] = f2bf(o[d0][r] * rli[r]); }
#undef SLOAD
#undef SWRITE
#undef SWAIT
#undef RESC
}
}

__device__ __forceinline__ void ph_attn(const P& p, char* lds, bool need_ctx) {
  const bf16_t* QKV = (const bf16_t*)(p.ws + OFF_D); bf16_t* hb = (bf16_t*)(p.ws + OFF_HBF);
  const int nunits = need_ctx ? 528 : 512;
  for (int u = BIDX(); u < nunits; u += GDIM()) {
    int b, h, seq; size_t qrow;
    if (u < 512) { b = u >> 8; const int rem = u & 255; h = rem >> 5; qrow = (size_t)b * TB + CTXL + (size_t)(rem & 31) * 256; seq = TB; }
    else { const int uu = u - 512; b = uu >> 3; h = uu & 7; qrow = (size_t)b * TB; seq = CTXL; }
    const int kvh = h >> 2;
    const bf16_t* Kh = QKV + (size_t)b * TB * 1536 + 1024 + kvh * 128;
    const bf16_t* Vh = QKV + (size_t)b * TB * 1536 + 1280 + kvh * 128;
    at::attn_dense_body(QKV + qrow * 1536 + h * 128, Kh, Vh, hb + qrow * 1024 + h * 128, seq, lds);
    __syncthreads();
  }
}

__device__ __forceinline__ void ph_final(const P& p) {
  const int tid = TIDX(), wid = tid >> 6, lane = tid & 63;
  const float* xr = (const float*)(p.ws + OFF_XRES);
  for (int q = BIDX() * 8 + wid; q < 2 * LAT; q += GDIM() * 8) {
    const int b = q >> 13, t = q & (LAT - 1); const float* row = xr + ((size_t)b * TB + CTXL + t) * 1024;
    f32x4 v[4]; float ss = 0.f;
#pragma unroll
    for (int i = 0; i < 4; ++i) { v[i] = *(const f32x4*)(row + i * 256 + lane * 4); ss += v[i][0] * v[i][0] + v[i][1] * v[i][1] + v[i][2] * v[i][2] + v[i][3] * v[i][3]; }
    ss = wave_sum(ss); const float rs = rsqrtf(ss * (1.f / 1024.f) + EPSF);
#pragma unroll
    for (int i = 0; i < 4; ++i) { const int c0 = i * 256 + lane * 4; const f32x4 g = *(const f32x4*)(p.final_norm + c0); f32x4 o = v[i] * rs * g; *(f32x4*)(p.out + (size_t)q * 1024 + c0) = o; }
  }
}

constexpr int NPHASES = 42;
#ifndef ONLY_PH
#define ONLY_PH -1
#endif
#define EN(x) (ONLY_PH < 0 || ONLY_PH == (x))
#ifndef PROBE_REP
#define PROBE_REP -1
#endif
#define RUN(cls, ...) do { if (EN(cls)) { for (int rep_ = 0; rep_ < ((PROBE_REP == (cls)) ? 2 : 1); ++rep_) { if (rep_) xcd_barrier(*xbp); __VA_ARGS__; } } } while (0)
__device__ __forceinline__ void run_phase(const P& p0, int ph, char* lds, const XcdBarrier* xbp) {
  P p = p0; { size_t zoff = 0; asm volatile("" : "+s"(zoff)); p.ws = p0.ws + zoff; }
  if (ph == NPHASES - 1) { if (EN(11)) ph_final(p); return; }
  const int q = ph - 1; int L, sub;
  if (q < 11) { L = 0; sub = q; } else if (q < 20) { L = 1; sub = q - 11; } else if (q < 31) { L = 2; sub = q - 20; } else { L = 3; sub = q - 31; }
  const bool even = (L & 1) == 0; const int e = L >> 1;
  bf16_t* W1 = (bf16_t*)(p.ws + OFF_WC); bf16_t* W2 = (bf16_t*)(p.ws + OFF_WC + WC_W2);
  bf16_t* hb = (bf16_t*)(p.ws + OFF_HBF); float* xr = (float*)(p.ws + OFF_XRES);
  const float* mods = (const float*)(p.ws + OFF_MODS) + (size_t)L * 3 * 6144;
  bf16_t* W3 = (bf16_t*)(p.ws + OFF_W3);
#define CVT_MIX(LL, skipb) do { const int L_ = (LL); if ((L_ & 1) == 0) { cvt_weight(p.rec_w_in + (size_t)(L_ >> 1) * 1024 * 3632, W1, 1024, 3632, NREC, true, skipb); cvt_weight(p.rec_w_out + (size_t)(L_ >> 1) * 1024 * 1024, W3, 1024, 1024, 1024, false, skipb); } \
    else { cvt_weight(p.att_w_qkv + (size_t)(L_ >> 1) * 1024 * 1536, W1, 1024, 1536, 1536, false, skipb); cvt_weight(p.att_w_out + (size_t)(L_ >> 1) * 1024 * 1024, W3, 1024, 1024, 1024, false, skipb); } } while (0)
#define CVT_FFN(LL, skipb) do { const int L_ = (LL); cvt_weight(p.ffn_w_up + (size_t)L_ * 1024 * 5632, W1, 1024, 5632, 5632, false, skipb); cvt_weight(p.ffn_w_down + (size_t)L_ * DFF * 1024, W2, DFF, 1024, 1024, false, skipb); } while (0)
  if (ph == 0) { RUN(0, ph_init(p, lds); CVT_MIX(0, 0)); return; }
  int fs = even ? sub - 7 : sub - 5;
  if (fs >= 0) {
    if (fs == 0) { RUN(1, ph_norm(p, L, 1)); }
    else if (fs == 1) { RUN(2, gemm8(lds, hb, 1024, W1, 1024, 5632, L == 3, EpiBf8{(bf16_t*)(p.ws + OFF_D), 5632})); }
    else if (fs == 2) { if (EN(8)) ph_ffnact(p, L); }
    else { if (EN(2)) { gemm8(lds, (const bf16_t*)(p.ws + OFF_D) + DFF, 5632, W2, DFF, 1024, L == 3, EpiRes8{xr, mods + 5 * 1024}); if (L < 3) CVT_MIX(L + 1, 8); } }
    return;
  }
  if (even) {
    switch (sub) {
      case 0: RUN(1, ph_norm(p, L, 0)); break;
      case 1: RUN(2, gemm8(lds, hb, 1024, W1, 1024, NREC, false, EpiRec8{(bf16_t*)(p.ws + OFF_D + D_P1), (bf16_t*)(p.ws + OFF_D + D_P2), (float*)(p.ws + OFF_SM)})); break;
      case 2: RUN(3, ph_dnprep(p, lds, e)); break;
      case 3: RUN(4, ph_dn_d1(p, lds); ph_gla_b(p, lds, e)); break;
      case 4: RUN(5, if (BIDX() < 64) { dn_scan(p, lds, BIDX()); } else if (BIDX() < 128) { gla_scan(p, lds, BIDX() - 64, e); });
        if (PROBE_REP == 55) { xcd_barrier(*xbp); if (BIDX() < 64) { dn_scan(p, lds, BIDX()); } }
        if (PROBE_REP == 56) { xcd_barrier(*xbp); if (BIDX() >= 64 && BIDX() < 128) { gla_scan(p, lds, BIDX() - 64, e); } }
        break;
      case 5: RUN(7, ph_merge(p, e)); break;
      case 6: if (EN(2)) { gemm8(lds, hb, 1024, W3, 1024, 1024, false, EpiRes8{xr, mods + 2 * 1024}); CVT_FFN(L, 8); } break;
    }
  } else {
    const int o = L >> 1;
    switch (sub) {
      case 0: RUN(1, ph_norm(p, L, 0)); break;
      case 1: RUN(2, gemm8(lds, hb, 1024, W1, 1024, 1536, false, EpiBf8{(bf16_t*)(p.ws + OFF_D), 1536})); break;
      case 2: if (EN(9)) ph_qknorm(p, lds, o); break;
      case 3: RUN(10, ph_attn(p, lds, L != 3)); break;
      case 4: if (EN(2)) { gemm8(lds, hb, 1024, W3, 1024, 1024, L == 3, EpiRes8{xr, mods + 2 * 1024}); CVT_FFN(L, L == 3 ? 0 : 8); } break;
    }
  }
}

template <bool COOP>
__global__ void __launch_bounds__(512, 1) mk_kernel(P p, int ph0, int ph1) {
  extern __shared__ __attribute__((aligned(16))) char smem[];
  if constexpr (COOP) {
    if (ph0 < 0) cg::this_grid().sync();
    volatile LAS unsigned* st = (volatile LAS unsigned*)(smem + LDS_BYTES);
    if (threadIdx.x < 4) st[threadIdx.x] = 0u;
    __syncthreads();
    XcdBarrier xb = xcd_barrier_post((unsigned*)(p.ws + OFF_BAR), st);
    for (int ph = ph0; ph < ph1; ++ph) {
      run_phase(p, ph, smem, &xb);
      if (ph + 1 < ph1) xcd_barrier(xb);
      if (PROBE_REP == 99 && ph == 0) { for (int q = 0; q < 20; ++q) xcd_barrier(xb); }
    }
  } else {
    for (int ph = ph0; ph < ph1; ++ph) run_phase(p, ph, smem, nullptr);
  }
}

extern "C" void kernel_launch(void* const* d_in, const int* in_sizes, int n_in, void* d_out, int out_size, void* d_ws, size_t ws_size, hipStream_t stream) {
  if (n_in != 23 || ws_size < WS_NEED) { fprintf(stderr, "kernel_launch: bad n_in %d or ws %zu < %zu\n", n_in, ws_size, (size_t)WS_NEED); return; }
  P p{};
  const float** f = (const float**)&p;
  for (int i = 0; i < 23; ++i) f[i] = (const float*)d_in[i];
  p.out = (float*)d_out; p.ws = (char*)d_ws;
  static int inited = 0, grid_blocks = 0;
  if (!inited) {
    hipFuncSetAttribute((const void*)mk_kernel<true>, hipFuncAttributeMaxDynamicSharedMemorySize, LDS_BYTES + 16);
    hipFuncSetAttribute((const void*)mk_kernel<false>, hipFuncAttributeMaxDynamicSharedMemorySize, LDS_BYTES);
    int dev = 0, cus = 0, per_cu = 0;
    hipGetDevice(&dev); hipDeviceGetAttribute(&cus, hipDeviceAttributeMultiprocessorCount, dev);
    hipOccupancyMaxActiveBlocksPerMultiprocessor(&per_cu, mk_kernel<true>, 512, LDS_BYTES + 16);
    if (per_cu > 1) per_cu = 1;
    grid_blocks = cus * per_cu; if (grid_blocks > 256) grid_blocks = 256; if (grid_blocks < 128) grid_blocks = 128;
    inited = 1;
  }
#if MK_COOP
  int ph0 = 0, ph1 = NPHASES;
  void* args[] = {&p, &ph0, &ph1};
  hipMemsetAsync((char*)d_ws + OFF_BAR, 0, 3456 * 4, stream);
  hipError_t er = hipLaunchCooperativeKernel((const void*)mk_kernel<true>, dim3(grid_blocks), dim3(512), args, LDS_BYTES + 16, stream);
  if (er != hipSuccess) fprintf(stderr, "cooperative launch failed: %s (grid %d)\n", hipGetErrorString(er), grid_blocks);
#else
  for (int ph = 0; ph < NPHASES; ++ph) hipLaunchKernelGGL(mk_kernel<false>, dim3(256), dim3(512), LDS_BYTES, stream, p, ph, ph + 1);
#endif
}
```

```cpp
#include <hip/hip_runtime.h>
#include <hip/hip_cooperative_groups.h>
#include <cstdio>
#include <cstdint>
namespace cg = cooperative_groups;

#ifndef MK_COOP
#define MK_COOP 1
#endif

typedef unsigned short bf16_t;
typedef short bf16x8 __attribute__((ext_vector_type(8)));
typedef short s16x4 __attribute__((ext_vector_type(4)));
typedef float f32x16 __attribute__((ext_vector_type(16)));
typedef float f32x8 __attribute__((ext_vector_type(8)));
typedef float f32x4 __attribute__((ext_vector_type(4)));
typedef unsigned u32x4 __attribute__((ext_vector_type(4)));
#define DI __device__ __forceinline__
#define LBAR() do { asm volatile("s_waitcnt lgkmcnt(0)" ::: "memory"); __builtin_amdgcn_s_barrier(); asm volatile("" ::: "memory"); } while (0)
#define MFMA32(a, b, c) __builtin_amdgcn_mfma_f32_32x32x16_bf16((a), (b), (c), 0, 0, 0)

constexpr int DM = 1024, TB = 8448, CTXL = 256, LAT = 8192, MROWS = 2 * TB;
constexpr int NCH = 132;
constexpr int DFF = 2816;
constexpr int NREC = 3840;
constexpr float EPSF = 1e-6f;

constexpr size_t AL(size_t x) { return (x + 255) / 256 * 256; }
constexpr size_t OFF_XRES = 0;
constexpr size_t OFF_HBF = OFF_XRES + AL((size_t)MROWS * DM * 4);
constexpr size_t OFF_WC = OFF_HBF + AL((size_t)MROWS * DM * 2);
constexpr size_t WC_W2 = (size_t)5632 * 1024 * 2;
constexpr size_t OFF_MODS = OFF_WC + AL(WC_W2 + (size_t)1024 * 2816 * 2);
constexpr size_t OFF_SM = OFF_MODS + AL((size_t)4 * 3 * 6144 * 4);
constexpr size_t OFF_GB = OFF_SM + AL((size_t)MROWS * 64 * 4);
constexpr size_t OFF_SC = OFF_GB + AL((size_t)MROWS * 16 * 4);
constexpr size_t OFF_GL = OFF_SC + AL((size_t)16 * NCH * 64 * 2 * 4);
constexpr size_t OFF_D = OFF_GL + AL((size_t)16 * NCH * 4);
constexpr size_t D_P1 = 0;
constexpr size_t D_W = 0;
constexpr size_t D_INTRA = D_W + (size_t)16 * NCH * 64 * 128 * 2;
constexpr size_t D_P2 = D_P1 + (size_t)MROWS * 1536 * 2;
constexpr size_t D_QQ = D_P2 + (size_t)MROWS * 2048 * 2;
constexpr size_t D_QK = D_QQ + (size_t)MROWS * 512 * 2;
constexpr size_t D_QV = D_QK + (size_t)MROWS * 512 * 2;
constexpr size_t D_DNO = D_QK;
constexpr size_t D_KT = D_QV + (size_t)MROWS * 512 * 2;
constexpr size_t D_GLAO = D_KT + (size_t)MROWS * 512 * 2;
constexpr size_t D_END_E = D_GLAO + (size_t)2 * MROWS * 512 * 2;
constexpr size_t D_END_F = (size_t)MROWS * 5632 * 2;
constexpr size_t OFF_B16_1 = OFF_D + (D_END_E > D_END_F ? D_END_E : D_END_F);
constexpr size_t B16_BYTES = (size_t)8 * NCH * 64 * 64 * 2;
constexpr size_t OFF_BAR = OFF_B16_1 + AL(B16_BYTES);
constexpr size_t OFF_W3 = OFF_BAR + AL(3456 * 4);
constexpr size_t WS_NEED = OFF_W3 + (size_t)1024 * 1024 * 2;
constexpr int LDS_BYTES = 132 * 1024;

struct P {
  const float *x, *c, *ctx, *c_ctx, *mod_w, *mod_b, *rec_w_in, *rec_conv, *dn_a_log, *dn_dt_bias, *dn_norm, *gla_w2, *gla_b2, *gla_norm,
      *rec_w_out, *att_w_qkv, *att_q_norm, *att_k_norm, *att_w_out, *ffn_w_up, *ffn_conv, *ffn_w_down, *final_norm;
  float* out;
  char* ws;
};

DI int TIDX() { int t = threadIdx.x; asm volatile("" : "+v"(t)); return t; }
DI int BIDX() { int t = blockIdx.x; asm volatile("" : "+s"(t)); return t; }
DI int GDIM() { int t = gridDim.x; asm volatile("" : "+s"(t)); return t; }
DI float bf2f(bf16_t v) { return __uint_as_float(((unsigned)v) << 16); }
DI bf16_t f2bf(float x) { unsigned u = __float_as_uint(x); u += 0x7fffu + ((u >> 16) & 1u); return (bf16_t)(u >> 16); }
DI unsigned cvtpk(float lo, float hi) { unsigned r; asm volatile("v_cvt_pk_bf16_f32 %0, %1, %2" : "=v"(r) : "v"(lo), "v"(hi)); return r; }
DI int crow(int r, int hi) { return (r & 3) + 8 * (r >> 2) + 4 * hi; }
DI float siluf(float x) { return x / (1.f + expf(-x)); }
DI float sigmf(float x) { return 1.f / (1.f + expf(-x)); }
DI float softplusf(float x) { return fmaxf(x, 0.f) + log1pf(expf(-fabsf(x))); }
DI float wave_sum(float v) {
#pragma unroll
  for (int o = 32; o > 0; o >>= 1) v += __shfl_xor(v, o);
  return v;
}
DI int modrow_of(int R) { const int b = R >= TB ? 1 : 0; const int pp = R - b * TB; return pp < CTXL ? 2 : b; }
template <int KS>
DI f32x16 mma_rows(const bf16_t* arow, const bf16_t* brow, f32x16 acc) {
#pragma unroll
  for (int ks = 0; ks < KS; ++ks) {
    const bf16x8 a = *reinterpret_cast<const bf16x8*>(arow + ks * 16);
    const bf16x8 b = *reinterpret_cast<const bf16x8*>(brow + ks * 16);
    acc = MFMA32(a, b, acc);
  }
  return acc;
}

#define XB_TMO      128
#define XB_XCNT(j)  (256  + 64 * (j))
#define XB_XSUB(j)  (1280 + 64 * (j))
#define XB_XGEN(j)  (2304 + 64 * (j))
#define XB_TOP      3328
#define XB_TOPGEN   3392
#define XCD_BAR_WORDS 3456
#define XB_SPIN_CAP (1u << 18)
#define LAS __attribute__((address_space(3)))
DI unsigned xb_ld(unsigned* p)              { return __hip_atomic_load(p, __ATOMIC_RELAXED, __HIP_MEMORY_SCOPE_AGENT); }
DI unsigned xb_add(unsigned* p, unsigned v) { return __hip_atomic_fetch_add(p, v, __ATOMIC_RELAXED, __HIP_MEMORY_SCOPE_AGENT); }
DI unsigned xb_xcc_id() { return (unsigned)__builtin_amdgcn_s_getreg((3 << 11) | 20) & 0xFu; }
#define XB_SPIN(cond, bar) do { unsigned _sp = 0; while (cond) { __builtin_amdgcn_s_sleep(1); \
    if ((++_sp & 255u) == 0u) { if (xb_ld(&(bar)[XB_TMO])) break; if (_sp > XB_SPIN_CAP) { atomicAdd(&(bar)[XB_TMO], 1u); break; } } } } while (0)
struct XcdBarrier { unsigned* bar; unsigned x; volatile LAS unsigned* st; };
DI XcdBarrier xcd_barrier_post(unsigned* bar, volatile LAS unsigned* st) {
    XcdBarrier b; b.bar = bar; b.x = xb_xcc_id(); b.st = st;
    if (threadIdx.x == 0) (void)xb_add(&bar[XB_XCNT(b.x)], 1u);
    return b;
}
DI void xcd_barrier_complete(unsigned* bar, unsigned x, unsigned& nloc, unsigned& nx) {
    const unsigned G = gridDim.x * gridDim.y * gridDim.z;
    unsigned sum, cnt, mine, sp = 0u;
    for (;;) {
        sum = 0u; cnt = 0u; mine = 0u;
#pragma unroll
        for (unsigned j = 0; j < 16; ++j) { const unsigned c = xb_ld(&bar[XB_XCNT(j)]); sum += c; cnt += (c > 0u) ? 1u : 0u; mine = (j == x) ? c : mine; }
        if (sum == G) break;
        __builtin_amdgcn_s_sleep(1);
        if ((++sp & 255u) == 0u) { if (xb_ld(&bar[XB_TMO])) break; if (sp > XB_SPIN_CAP) { atomicAdd(&bar[XB_TMO], 1u); break; } }
    }
    nloc = mine > 0u ? mine : 1u; nx = cnt > 0u ? cnt : 1u;
}
DI void xcd_barrier(const XcdBarrier& b) {
    asm volatile("s_waitcnt vmcnt(0)" ::: "memory");
    __syncthreads();
    if (threadIdx.x == 0) {
        unsigned* bar = b.bar;
        __builtin_amdgcn_s_waitcnt(0);
        unsigned nloc = b.st[0], nx = b.st[1];
        if (nloc == 0u) { xcd_barrier_complete(bar, b.x, nloc, nx); b.st[0] = nloc; b.st[1] = nx; }
        const unsigned old = xb_add(&bar[XB_XSUB(b.x)], 1u);
        const unsigned gen = old / nloc;
        if (old + 1u == (gen + 1u) * nloc) {
            __builtin_amdgcn_fence(__ATOMIC_RELEASE, "agent");
            asm volatile("s_waitcnt vmcnt(0)" ::: "memory");
            const unsigned og = xb_add(&bar[XB_TOP], 1u);
            const unsigned tg = og / nx;
            if (og + 1u == (tg + 1u) * nx) xb_add(&bar[XB_TOPGEN], 1u);
            else XB_SPIN(xb_ld(&bar[XB_TOPGEN]) == tg, bar);
            __builtin_amdgcn_fence(__ATOMIC_ACQUIRE, "agent");
            xb_add(&bar[XB_XGEN(b.x)], 1u);
            asm volatile("s_waitcnt vmcnt(0)" ::: "memory");
        } else {
            XB_SPIN(xb_ld(&bar[XB_XGEN(b.x)]) == gen, bar);
            __builtin_amdgcn_fence(__ATOMIC_ACQUIRE, "agent");
            asm volatile("s_waitcnt vmcnt(0)" ::: "memory");
        }
    }
    __syncthreads();
}

__device__ __forceinline__ void ph_init(const P& p, char* lds) {
  const int tid = TIDX();
  float* sc = (float*)lds;
  float* red = sc + 3072;
  for (int i = tid; i < 3072; i += 512) { const int r = i >> 10, k = i & 1023; const float v = r < 2 ? p.c[r * 1024 + k] : p.c_ctx[k]; sc[i] = siluf(v); }
  __syncthreads();
  float* mods = (float*)(p.ws + OFF_MODS);
  for (int job = BIDX(); job < 192; job += GDIM()) {
    const int col = job * 128 + (tid & 127), kq = tid >> 7;
    const int L = col / 6144, cl = col - L * 6144;
    const float* w = p.mod_w + ((size_t)L * 1024 + kq * 256) * 6144 + cl;
    float a0 = 0.f, a1 = 0.f, a2 = 0.f;
#pragma unroll 8
    for (int k = 0; k < 256; ++k) { const float wv = w[(size_t)k * 6144]; const int kk = kq * 256 + k; a0 += sc[kk] * wv; a1 += sc[1024 + kk] * wv; a2 += sc[2048 + kk] * wv; }
    red[(kq * 3 + 0) * 128 + (tid & 127)] = a0; red[(kq * 3 + 1) * 128 + (tid & 127)] = a1; red[(kq * 3 + 2) * 128 + (tid & 127)] = a2;
    __syncthreads();
    if (tid < 384) { const int r = tid >> 7, cc = tid & 127; const int c2 = job * 128 + cc; const int L2 = c2 / 6144, cl2 = c2 - L2 * 6144;
      const float s = red[(0 * 3 + r) * 128 + cc] + red[(1 * 3 + r) * 128 + cc] + red[(2 * 3 + r) * 128 + cc] + red[(3 * 3 + r) * 128 + cc] + p.mod_b[L2 * 6144 + cl2];
      mods[((size_t)L2 * 3 + r) * 6144 + cl2] = s; }
    __syncthreads();
  }
  f32x4* xr = (f32x4*)(p.ws + OFF_XRES);
  for (size_t i = (size_t)BIDX() * 512 + tid; i < (size_t)MROWS * 256; i += (size_t)GDIM() * 512) {
    const int R = (int)(i >> 8), c4 = (int)(i & 255); const int b = R >= TB ? 1 : 0, pp = R - b * TB;
    const float* src = pp < CTXL ? p.ctx + ((size_t)b * CTXL + pp) * 1024 : p.x + ((size_t)b * LAT + (pp - CTXL)) * 1024;
    xr[i] = *(const f32x4*)(src + c4 * 4);
  }
}

DI int rec_src_col(int n) { if (n < 2048) return n; if (n < 3584) return n + 16; if (n < 3600) return 2048 + (n - 3584); if (n < 3632) return n; return -1; }
__device__ __forceinline__ void cvt_weight(const float* __restrict__ W, bf16_t* __restrict__ Wt, int K, int Nsrc, int Npad, bool perm, int skipb) {
  const size_t items = (size_t)Npad * (K >> 3);
  const int bid = BIDX() - skipb, nb = GDIM() - skipb;
  if (bid < 0) return;
  for (size_t it = (size_t)bid * 512 + TIDX(); it < items; it += (size_t)nb * 512) {
    const int n = (int)(it % Npad), kb = (int)(it / Npad);
    const int s = perm ? rec_src_col(n) : n;
    float v[8];
#pragma unroll
    for (int j = 0; j < 8; ++j) v[j] = s >= 0 ? W[(size_t)(kb * 8 + j) * Nsrc + s] : 0.f;
    u32x4 w = {cvtpk(v[0], v[1]), cvtpk(v[2], v[3]), cvtpk(v[4], v[5]), cvtpk(v[6], v[7])};
    *(u32x4*)(Wt + (size_t)n * K + kb * 8) = w;
  }
}

__device__ __forceinline__ void ph_norm(const P& p, int L, int which, int mode, int skipb) {
  const int tid = TIDX(), wid = tid >> 6, lane = tid & 63, l16 = lane & 15, sub = lane >> 4;
  const float* xr = (const float*)(p.ws + OFF_XRES);
  bf16_t* hb = (bf16_t*)(p.ws + OFF_HBF);
  const float* mods = (const float*)(p.ws + OFF_MODS) + (size_t)L * 3 * 6144;
  const int bid = BIDX() - skipb, nb = GDIM() - skipb;
  if (bid < 0) return;
  const int nquads = mode == 0 ? MROWS / 4 : (mode == 1 ? 2 * LAT / 4 : 2 * CTXL / 4);
  for (int q = bid * 8 + wid; q < nquads; q += nb * 8) {
    int R4;
    if (mode == 0) R4 = q * 4; else if (mode == 1) R4 = q < LAT / 4 ? CTXL + q * 4 : TB + CTXL + (q - LAT / 4) * 4; else R4 = q < CTXL / 4 ? q * 4 : TB + (q - CTXL / 4) * 4;
    const int R = R4 + sub;
    const float* row = xr + (size_t)R * 1024 + l16 * 4;
    f32x4 v[16]; float ss = 0.f;
#pragma unroll
    for (int i = 0; i < 16; ++i) v[i] = *(const f32x4*)(row + i * 64);
#pragma unroll
    for (int i = 0; i < 16; ++i) ss += v[i][0] * v[i][0] + v[i][1] * v[i][1] + v[i][2] * v[i][2] + v[i][3] * v[i][3];
    ss += __shfl_xor(ss, 1); ss += __shfl_xor(ss, 2); ss += __shfl_xor(ss, 4); ss += __shfl_xor(ss, 8);
    const float rs = rsqrtf(ss * (1.f / 1024.f) + EPSF);
    const float* mr = mods + (size_t)modrow_of(R) * 6144 + which * 3072 + l16 * 4;
    bf16_t* dst = hb + (size_t)R * 1024 + l16 * 4;
#pragma unroll
    for (int i = 0; i < 16; ++i) { const f32x4 sh = *(const f32x4*)(mr + i * 64), scl = *(const f32x4*)(mr + 1024 + i * 64);
      float o[4];
#pragma unroll
      for (int j = 0; j < 4; ++j) o[j] = v[i][j] * rs * (1.f + scl[j]) + sh[j];
      uint2 w; w.x = cvtpk(o[0], o[1]); w.y = cvtpk(o[2], o[3]);
      *(uint2*)(dst + i * 64) = w; }
  }
}

struct EpiRec { bf16_t* P1; bf16_t* P2; float* SM;
  DI void operator()(int row, int col, float v) const {
    if (col < 1536) P1[(size_t)row * 1536 + col] = f2bf(v);
    else if (col < 3584) P2[(size_t)row * 2048 + (col - 1536)] = f2bf(v);
    else { const int lc = col - 3584; if (lc < 48) SM[(size_t)row * 64 + lc] = v; } } };
struct EpiBf { bf16_t* O; int ldc;
  DI void operator()(int row, int col, float v) const { O[(size_t)row * ldc + col] = f2bf(v); } };
struct EpiRes { float* X; const float* gate;
  DI void operator()(int row, int col, float v) const { float* q = X + (size_t)row * 1024 + col; *q = *q + gate[(size_t)modrow_of(row) * 6144 + col] * v; } };

template <class Epi>
__device__ __forceinline__ void gemm_phase(char* lds, const bf16_t* __restrict__ A, int lda, const bf16_t* __restrict__ Bt, int K, int nN, const Epi epi, bool skipctx = false) {
  const int tid = TIDX(), wid = tid >> 6, lane = tid & 63, r32 = lane & 31, hi = lane >> 5;
  const int wm = wid >> 1, wn = wid & 1;
  const int nk = K >> 6;
  constexpr int RS = 144, ASZ = 256 * RS, BSZ = 128 * RS, STG = ASZ + BSZ;
  const int ntiles = (skipctx ? 64 : MROWS / 256) * nN;
  const int srow = tid >> 3, spc = tid & 7;
  for (int t = BIDX(); t < ntiles; t += GDIM()) {
    int pm = t / nN; const int pn = t - pm * nN; if (skipctx) pm = pm + 1 + (pm >= 32 ? 1 : 0);
    const bf16_t* Ab = A + (size_t)(pm * 256 + srow) * lda + spc * 8;
    const bf16_t* Bb = Bt + (size_t)(pn * 128 + srow) * K + spc * 8;
    f32x16 acc00 = {}, acc01 = {}, acc10 = {}, acc11 = {};
    bf16x8 ra0, ra1, ra2, ra3, rb0, rb1;
#define GLOAD(kt) do { const int ko = (kt) * 64; ra0 = *(const bf16x8*)(Ab + ko); ra1 = *(const bf16x8*)(Ab + (size_t)64 * lda + ko); ra2 = *(const bf16x8*)(Ab + (size_t)128 * lda + ko); \
    ra3 = *(const bf16x8*)(Ab + (size_t)192 * lda + ko); rb0 = *(const bf16x8*)(Bb + ko); rb1 = *(const bf16x8*)(Bb + (size_t)64 * K + ko); } while (0)
#define SWRITE(buf) do { char* sb = lds + (buf) * STG + srow * RS + spc * 16; *(bf16x8*)(sb) = ra0; *(bf16x8*)(sb + 64 * RS) = ra1; *(bf16x8*)(sb + 128 * RS) = ra2; *(bf16x8*)(sb + 192 * RS) = ra3; \
    *(bf16x8*)(sb + ASZ) = rb0; *(bf16x8*)(sb + ASZ + 64 * RS) = rb1; } while (0)
    GLOAD(0); SWRITE(0); __syncthreads();
    for (int kt = 0; kt < nk; ++kt) {
      const int cur = kt & 1;
      if (kt + 1 < nk) GLOAD(kt + 1);
      const char* ab = lds + cur * STG + (64 * wm + r32) * RS + hi * 16;
      const char* bb = lds + cur * STG + ASZ + (64 * wn + r32) * RS + hi * 16;
#pragma unroll
      for (int ks = 0; ks < 4; ++ks) {
        const bf16x8 a0 = *(const bf16x8*)(ab + ks * 32), a1 = *(const bf16x8*)(ab + 32 * RS + ks * 32);
        const bf16x8 b0 = *(const bf16x8*)(bb + ks * 32), b1 = *(const bf16x8*)(bb + 32 * RS + ks * 32);
        acc00 = MFMA32(a0, b0, acc00); acc01 = MFMA32(a0, b1, acc01); acc10 = MFMA32(a1, b0, acc10); acc11 = MFMA32(a1, b1, acc11);
      }
      if (kt + 1 < nk) SWRITE(cur ^ 1);
      __syncthreads();
    }
#undef GLOAD
#undef SWRITE
    const int row0 = pm * 256 + 64 * wm, col0 = pn * 128 + 64 * wn + r32;
#pragma unroll
    for (int r = 0; r < 16; ++r) { const int rr = row0 + crow(r, hi);
      epi(rr, col0, acc00[r]); epi(rr, col0 + 32, acc01[r]); epi(rr + 32, col0, acc10[r]); epi(rr + 32, col0 + 32, acc11[r]); }
  }
}

namespace pg8 {
#define PG8_LAS __attribute__((address_space(3)))
constexpr int BM = 256, BK = 64, HALF = 128, HTB = HALF * BK * 2  , STAGE_BYTES = 8 * HTB, NXCD = 8, WGM = 8;

__host__ __device__ __forceinline__ int lds_byte(int r, int c) { const int st = (r >> 4) * 2 + (c >> 5), rr = r & 15, cc = c & 31, ob = rr * 64 + cc * 2; return st * 1024 + (ob ^ (((ob >> 9) & 1) << 5)); }
__host__ __device__ __forceinline__ void stage_rc(int b, int& R, int& C) { const int st = b / 1024, sb = b % 1024, swz = sb ^ (((sb >> 9) & 1) << 5); R = (st >> 1) * 16 + swz / 64; C = (st & 1) * 32 + (swz % 64) / 2; }
__host__ __device__ __forceinline__ int perm32(int rho) { const int n = rho >> 4, i = rho & 15; return 8 * (i >> 2) + 4 * n + (i & 3); }
struct Unit { int pm, pn; };
struct Gemm { const bf16_t* A; const bf16_t* Bt; int M, N, K, lda; };

struct StaticOrder {
    int nM, nN, nwg, G, c;
    __host__ __device__ void init(int M, int N, int G_, int c_) { nM = M / BM; nN = N / BM; nwg = nM * nN; G = G_; c = c_; }
    __host__ __device__ bool next(int i, Unit& u) const {
        const long L = (long)i * G + c; if (L >= nwg) return false;
        int wgid = (int)L; { const int q = nwg / NXCD, r = nwg % NXCD, xcd = wgid % NXCD, off = wgid / NXCD; wgid = (xcd < r ? xcd * (q + 1) : r * (q + 1) + (xcd - r) * q) + off; }
        const int nig = WGM * nN, gid = wgid / nig, fm = gid * WGM, gsz = (nM - fm) < WGM ? (nM - fm) : WGM;
        u.pm = fm + ((wgid % nig) % gsz); u.pn = (wgid % nig) / gsz; return true;
    }
    __device__ __forceinline__ void a_ready(const Unit&) const {}
    __device__ __forceinline__ void done(const Unit&) const {}
};
template <class Epi, class Sched, bool ALIGN_EPI = false, bool SP2 = false>
__device__ __forceinline__ void gemm_phase(PG8_LAS unsigned char* lds, const Gemm g, const Sched& S, const Epi& E) {
    const int tid = TIDX(), wid = __builtin_amdgcn_readfirstlane(tid >> 6), lane = tid & 63, wr = wid >> 2, wc = wid & 3, fr = lane & 15, fq = lane >> 4;
    const int K = g.K, nt = K / BK;
    unsigned voffA[2], voffB[2];
#pragma unroll
    for (int i = 0; i < 2; ++i) { int R, C; stage_rc(tid * 16 + i * 8192, R, C); const int Rb = Epi::PERM ? ((R & ~31) + perm32(R & 31)) : R;
        voffA[i] = (unsigned)(R * g.lda + C) * 2u; voffB[i] = (unsigned)(Rb * K + C) * 2u; }
    const size_t kstep = (size_t)(BK * 2);
    const size_t hstep = (size_t)HALF * K * 2;
    const size_t tstep = 2 * hstep; const size_t hstepA = (size_t)HALF * g.lda * 2, tstepA = 2 * hstepA;
    const unsigned ldsw = (unsigned)wid * 1024u;
    const int aoff = lds_byte(wr * 64 + fr, fq * 8), boff = lds_byte(wc * 32 + fr, fq * 8);
#define PG8_SA(b, h) (((b) * 2 + (h)) * HTB)
#define PG8_SB(b, h) ((4 + (b) * 2 + (h)) * HTB)
#define PG8_STAGE(bufoff, gbase, voff) do { _Pragma("unroll") for (int _i = 0; _i < 2; ++_i) \
        __builtin_amdgcn_global_load_lds((const unsigned*)((const char*)(gbase) + (voff)[_i]), (PG8_LAS unsigned*)(lds + (bufoff) + ldsw + _i * 8192), 16, 0, 0); } while (0)
#define PG8_LDA(dst, b, h) do { _Pragma("unroll") for (int m = 0; m < 4; ++m) _Pragma("unroll") for (int k = 0; k < 2; ++k) dst[m][k] = *(const PG8_LAS bf16x8*)(lds + PG8_SA(b, h) + aoff + m * 2048 + k * 1024); } while (0)
#define PG8_LDB(dst, b, h) do { _Pragma("unroll") for (int n = 0; n < 2; ++n) _Pragma("unroll") for (int k = 0; k < 2; ++k) dst[n][k] = *(const PG8_LAS bf16x8*)(lds + PG8_SB(b, h) + boff + n * 2048 + k * 1024); } while (0)
#define PG8_MMA(ai, bj, At, Bt) do { __builtin_amdgcn_s_setprio(1); _Pragma("unroll") for (int m = 0; m < 4; ++m) _Pragma("unroll") for (int n = 0; n < 2; ++n) _Pragma("unroll") for (int k = 0; k < 2; ++k) \
        acc[ai][bj][m][n] = __builtin_amdgcn_mfma_f32_16x16x32_bf16(Bt[n][k], At[m][k], acc[ai][bj][m][n], 0, 0, 0); __builtin_amdgcn_s_setprio(0); } while (0)
#define PG8_WAIT_V(n) asm volatile("s_waitcnt vmcnt(" #n ")" ::: "memory")
#define PG8_WAIT_L(n) asm volatile("s_waitcnt lgkmcnt(" #n ")" ::: "memory")
#define PG8_BAR __builtin_amdgcn_s_barrier()
#define PG8_SCHED __builtin_amdgcn_sched_barrier(0)
    Unit cur, nxt; int ui = 0;
    if (!S.next(0, cur)) return;
    f32x4 acc[2][2][4][2];
#pragma unroll
    for (int a = 0; a < 2; ++a)
#pragma unroll
        for (int b = 0; b < 2; ++b)
#pragma unroll
            for (int m = 0; m < 4; ++m)
#pragma unroll
                for (int n = 0; n < 2; ++n) acc[a][b][m][n] = (f32x4){0.f, 0.f, 0.f, 0.f};
    bf16x8 At[4][2], B0[2][2], B1[2][2];
    const char* cA = (const char*)g.A + (size_t)cur.pm * tstepA; const char* cB = (const char*)g.Bt + (size_t)cur.pn * tstep;
    S.a_ready(cur);
    if constexpr (SP2) {
        PG8_STAGE(PG8_SB(0, 0), cB, voffB); PG8_STAGE(PG8_SB(0, 1), cB + hstep, voffB); PG8_STAGE(PG8_SA(0, 0), cA, voffA); PG8_STAGE(PG8_SA(0, 1), cA + hstepA, voffA);
        if (wr == 1) PG8_BAR;
        PG8_WAIT_V(2); PG8_BAR;
        PG8_STAGE(PG8_SB(1, 0), cB + kstep, voffB); PG8_STAGE(PG8_SA(1, 0), cA + kstep, voffA); PG8_STAGE(PG8_SB(1, 1), cB + hstep + kstep, voffB);
        PG8_WAIT_V(6); PG8_BAR;
    } else {
        PG8_STAGE(PG8_SB(0, 0), cB, voffB); PG8_STAGE(PG8_SA(0, 0), cA, voffA); PG8_STAGE(PG8_SB(0, 1), cB + hstep, voffB); PG8_STAGE(PG8_SA(0, 1), cA + hstepA, voffA);
        if (wr == 1) PG8_BAR;
        PG8_WAIT_V(4); PG8_BAR;
        PG8_STAGE(PG8_SB(1, 0), cB + kstep, voffB); PG8_STAGE(PG8_SA(1, 0), cA + kstep, voffA); PG8_STAGE(PG8_SB(1, 1), cB + hstep + kstep, voffB);
        PG8_WAIT_V(6); PG8_BAR;
    }
    for (;;) {
        const bool has_next = S.next(ui + 1, nxt);
        const char* nA = has_next ? (const char*)g.A + (size_t)nxt.pm * tstepA : cA; const char* nB = has_next ? (const char*)g.Bt + (size_t)nxt.pn * tstep : cB;
        for (int t = 0; t < nt; t += 2) {
            const bool last = (t == nt - 2);
            const char* a1 = cA + (size_t)(t + 1) * kstep;
            const char* a2 = last ? nA : cA + (size_t)(t + 2) * kstep; const char* b2 = last ? nB : cB + (size_t)(t + 2) * kstep;
            const char* a3 = a2 + kstep; const char* b3 = b2 + kstep;
            if (last && has_next) S.a_ready(nxt);
            if constexpr (SP2) {
            PG8_LDB(B0, 0, 0); PG8_LDB(B1, 0, 1); PG8_SCHED; PG8_LDA(At, 0, 0); PG8_STAGE(PG8_SA(1, 1), a1 + hstepA, voffA);
            PG8_WAIT_V(8); PG8_WAIT_L(0); PG8_BAR; PG8_MMA(0, 0, At, B0); PG8_MMA(0, 1, At, B1); PG8_BAR; PG8_SCHED;
            PG8_LDA(At, 0, 1); PG8_STAGE(PG8_SB(0, 0), b2, voffB); PG8_STAGE(PG8_SB(0, 1), b2 + hstep, voffB); PG8_STAGE(PG8_SA(0, 0), a2, voffA);
            PG8_WAIT_V(8); PG8_WAIT_L(0); PG8_BAR; PG8_MMA(1, 0, At, B0); PG8_MMA(1, 1, At, B1); PG8_BAR; PG8_SCHED;
            PG8_LDB(B0, 1, 0); PG8_LDB(B1, 1, 1); PG8_SCHED; PG8_LDA(At, 1, 0); PG8_STAGE(PG8_SA(0, 1), a2 + hstepA, voffA);
            PG8_WAIT_V(8); PG8_WAIT_L(0); PG8_BAR; PG8_MMA(0, 0, At, B0); PG8_MMA(0, 1, At, B1); PG8_BAR; PG8_SCHED;
            PG8_LDA(At, 1, 1); PG8_STAGE(PG8_SB(1, 0), b3, voffB); PG8_STAGE(PG8_SB(1, 1), b3 + hstep, voffB); PG8_STAGE(PG8_SA(1, 0), a3, voffA);
            PG8_WAIT_V(8); PG8_WAIT_L(0); PG8_BAR; PG8_MMA(1, 0, At, B0); PG8_MMA(1, 1, At, B1); PG8_BAR; PG8_SCHED;
            } else {
            PG8_LDB(B0, 0, 0); PG8_SCHED; PG8_LDA(At, 0, 0); PG8_STAGE(PG8_SA(1, 1), a1 + hstepA, voffA);
            PG8_WAIT_L(8); PG8_BAR; PG8_WAIT_L(0); PG8_MMA(0, 0, At, B0); PG8_BAR; PG8_SCHED;
            PG8_LDB(B1, 0, 1); PG8_STAGE(PG8_SB(0, 0), b2, voffB);
            PG8_BAR; PG8_WAIT_L(0); PG8_MMA(0, 1, At, B1); PG8_BAR;
            PG8_LDA(At, 0, 1); PG8_STAGE(PG8_SA(0, 0), a2, voffA);
            PG8_BAR; PG8_WAIT_L(0); PG8_MMA(1, 0, At, B0); PG8_BAR; PG8_SCHED;
            PG8_STAGE(PG8_SB(0, 1), b2 + hstep, voffB);
            PG8_WAIT_V(6); PG8_BAR; PG8_MMA(1, 1, At, B1); PG8_BAR;
            PG8_LDB(B0, 1, 0); PG8_SCHED; PG8_LDA(At, 1, 0); PG8_STAGE(PG8_SA(0, 1), a2 + hstepA, voffA);
            PG8_WAIT_L(8); PG8_BAR; PG8_WAIT_L(0); PG8_MMA(0, 0, At, B0); PG8_BAR; PG8_SCHED;
            PG8_LDB(B1, 1, 1); PG8_STAGE(PG8_SB(1, 0), b3, voffB);
            PG8_BAR; PG8_WAIT_L(0); PG8_MMA(0, 1, At, B1); PG8_BAR;
            PG8_LDA(At, 1, 1); PG8_STAGE(PG8_SA(1, 0), a3, voffA);
            PG8_BAR; PG8_WAIT_L(0); PG8_MMA(1, 0, At, B0); PG8_BAR; PG8_SCHED;
            PG8_STAGE(PG8_SB(1, 1), b3 + hstep, voffB);
            PG8_WAIT_V(6); PG8_BAR; PG8_MMA(1, 1, At, B1); PG8_BAR;
            }
        }
        if constexpr (ALIGN_EPI) { if (wr == 0) PG8_BAR; }
        if constexpr (!Epi::AFTER_DRAIN) { E(acc, cur, wr, wc, fr, fq); S.done(cur); }
        if (!has_next) break;
#pragma unroll
        for (int a = 0; a < 2; ++a)
#pragma unroll
            for (int b = 0; b < 2; ++b)
#pragma unroll
                for (int m = 0; m < 4; ++m)
#pragma unroll
                    for (int n = 0; n < 2; ++n) acc[a][b][m][n] = (f32x4){0.f, 0.f, 0.f, 0.f};
        cur = nxt; cA = nA; cB = nB; ++ui;
        if constexpr (ALIGN_EPI) { if (wr == 1) PG8_BAR; }
    }
    PG8_WAIT_V(0);
    if constexpr (!ALIGN_EPI) { if (wr == 0) PG8_BAR; }
    PG8_BAR;
    if constexpr (Epi::AFTER_DRAIN) { E.fused(acc, cur, wr, wc, fr, fq, lds, wid, lane); S.done(cur); }
#undef PG8_SA
#undef PG8_SB
#undef PG8_STAGE
#undef PG8_LDA
#undef PG8_LDB
#undef PG8_MMA
#undef PG8_WAIT_V
#undef PG8_WAIT_L
#undef PG8_BAR
#undef PG8_SCHED
}
struct SchedX { StaticOrder so; int mode;
  __device__ __forceinline__ bool next(int i, Unit& u) const {
    if (mode == 2) { if (i != 0 || so.c >= 8) return false; u.pm = (so.c >> 2) ? 33 : 0; u.pn = so.c & 3; return true; }
    if (!so.next(i, u)) return false; if (mode == 1) u.pm = u.pm + 1 + (u.pm >= 32 ? 1 : 0); return true; }
  __device__ __forceinline__ void a_ready(const Unit&) const {}
  __device__ __forceinline__ void done(const Unit&) const {} };
}
struct EpiRec8 { static constexpr bool PERM = false, AFTER_DRAIN = false; bf16_t* P1; bf16_t* P2; float* SM;
  DI void operator()(const f32x4 (&acc)[2][2][4][2], const pg8::Unit& u, int wr, int wc, int fr, int fq) const {
#pragma unroll
    for (int ai = 0; ai < 2; ++ai)
#pragma unroll
      for (int m = 0; m < 4; ++m) { const size_t row = (size_t)u.pm * 256 + ai * 128 + wr * 64 + m * 16 + fr;
#pragma unroll
        for (int bj = 0; bj < 2; ++bj)
#pragma unroll
          for (int n = 0; n < 2; ++n) { const int col = u.pn * 256 + bj * 128 + wc * 32 + n * 16 + fq * 4; const f32x4 v = acc[ai][bj][m][n];
            if (u.pn < 6) { uint2 w; w.x = cvtpk(v[0], v[1]); w.y = cvtpk(v[2], v[3]); *(uint2*)(P1 + row * 1536 + col) = w; }
            else if (u.pn < 14) { uint2 w; w.x = cvtpk(v[0], v[1]); w.y = cvtpk(v[2], v[3]); *(uint2*)(P2 + row * 2048 + (col - 1536)) = w; }
            else { const int lc = col - 3584; if (lc < 48) *(f32x4*)(SM + row * 64 + lc) = v; } } } } };
struct EpiBf8 { static constexpr bool PERM = false, AFTER_DRAIN = false; bf16_t* O; int ldc;
  DI void operator()(const f32x4 (&acc)[2][2][4][2], const pg8::Unit& u, int wr, int wc, int fr, int fq) const {
#pragma unroll
    for (int ai = 0; ai < 2; ++ai)
#pragma unroll
      for (int m = 0; m < 4; ++m) { const size_t row = (size_t)u.pm * 256 + ai * 128 + wr * 64 + m * 16 + fr;
#pragma unroll
        for (int bj = 0; bj < 2; ++bj)
#pragma unroll
          for (int n = 0; n < 2; ++n) { const int col = u.pn * 256 + bj * 128 + wc * 32 + n * 16 + fq * 4; const f32x4 v = acc[ai][bj][m][n];
            uint2 w; w.x = cvtpk(v[0], v[1]); w.y = cvtpk(v[2], v[3]); *(uint2*)(O + row * ldc + col) = w; } } } };
struct EpiRes8 { static constexpr bool PERM = false, AFTER_DRAIN = false; float* X; const float* gate;
  DI void operator()(const f32x4 (&acc)[2][2][4][2], const pg8::Unit& u, int wr, int wc, int fr, int fq) const {
    const float* gr = gate + (size_t)modrow_of(u.pm * 256) * 6144;
#pragma unroll
    for (int bj = 0; bj < 2; ++bj)
#pragma unroll
      for (int n = 0; n < 2; ++n) { const int col = u.pn * 256 + bj * 128 + wc * 32 + n * 16 + fq * 4; const f32x4 gv = *(const f32x4*)(gr + col);
#pragma unroll
        for (int ai = 0; ai < 2; ++ai)
#pragma unroll
          for (int m = 0; m < 4; ++m) { const size_t row = (size_t)u.pm * 256 + ai * 128 + wr * 64 + m * 16 + fr;
            f32x4* q = (f32x4*)(X + row * 1024 + col); *q = *q + gv * acc[ai][bj][m][n]; } } } };
template <class Epi>
__device__ __forceinline__ void gemm8(char* lds, const bf16_t* A, int lda, const bf16_t* Bt, int K, int N, int mode, const Epi& E) {
  pg8::Gemm g{A, Bt, mode == 1 ? 16384 : MROWS, N, K, lda};
  pg8::SchedX S; S.so.init(g.M, N, GDIM(), BIDX()); S.mode = mode;
  pg8::gemm_phase<Epi, pg8::SchedX, true, true>((PG8_LAS unsigned char*)lds, g, S, E);
}

__device__ __forceinline__ void ph_dnprep(const P& p, char* lds, int e) {
  const int tid = TIDX(), wid = tid >> 6, lane = tid & 63;
  const bf16_t* P1 = (const bf16_t*)(p.ws + OFF_D + D_P1);
  bf16_t* QQ = (bf16_t*)(p.ws + OFF_D + D_QQ); bf16_t* QK = (bf16_t*)(p.ws + OFF_D + D_QK); bf16_t* QV = (bf16_t*)(p.ws + OFF_D + D_QV);
  bf16_t* KT = (bf16_t*)(p.ws + OFF_D + D_KT);
  const float* SM = (const float*)(p.ws + OFF_SM); float* GB = (float*)(p.ws + OFF_GB);
  const float* cw = p.rec_conv + (size_t)e * 3 * 1536;
  bf16_t* kl = (bf16_t*)lds;
  for (int job = BIDX(); job < MROWS / 64; job += GDIM()) {
    const int R0 = job * 64;
    for (int tt = 0; tt < 8; ++tt) {
      const int tl = wid * 8 + tt, R = R0 + tl; const int b = R >= TB ? 1 : 0, pp = R - b * TB;
      const bool hasp = !(pp == 0 || pp == CTXL), hasn = !(pp == CTXL - 1 || pp == TB - 1);
#pragma unroll
      for (int part = 0; part < 3; ++part) {
        const int ch = part * 512 + lane * 8;
        const bf16x8 zc = *(const bf16x8*)(P1 + (size_t)R * 1536 + ch);
        bf16x8 zp = {}, zn = {};
        if (hasp) zp = *(const bf16x8*)(P1 + (size_t)(R - 1) * 1536 + ch);
        if (hasn) zn = *(const bf16x8*)(P1 + (size_t)(R + 1) * 1536 + ch);
        float o[8]; float ss = 0.f;
#pragma unroll
        for (int j = 0; j < 8; ++j) { const float a = bf2f((bf16_t)zp[j]) * cw[ch + j] + bf2f((bf16_t)zc[j]) * cw[1536 + ch + j] + bf2f((bf16_t)zn[j]) * cw[3072 + ch + j];
          o[j] = siluf(a); ss += o[j] * o[j]; }
        if (part < 2) {
          ss += __shfl_xor(ss, 1); ss += __shfl_xor(ss, 2); ss += __shfl_xor(ss, 4); ss += __shfl_xor(ss, 8);
          float sc = rsqrtf(ss + EPSF); if (part == 0) sc *= 0.08838834764831845f;
#pragma unroll
          for (int j = 0; j < 8; ++j) o[j] *= sc;
        }
        u32x4 w = {cvtpk(o[0], o[1]), cvtpk(o[2], o[3]), cvtpk(o[4], o[5]), cvtpk(o[6], o[7])};
        bf16_t* dst = part == 0 ? QQ : (part == 1 ? QK : QV);
        *(u32x4*)(dst + (size_t)R * 512 + lane * 8) = w;
        if (part == 1) *(u32x4*)(kl + tl * 512 + lane * 8) = w;
      }
      if (lane < 16) {
        const int q = lane & 7;
        if (lane < 8) { const float da = SM[(size_t)R * 64 + q]; GB[(size_t)R * 16 + q] = -expf(p.dn_a_log[e * 8 + q]) * softplusf(da + p.dn_dt_bias[e * 8 + q]); }
        else { const float db = SM[(size_t)R * 64 + 8 + q]; GB[(size_t)R * 16 + 8 + q] = sigmf(db); }
      }
    }
    __syncthreads();
    {
      const int b = R0 >= TB ? 1 : 0, c = (R0 - b * TB) / 64; const int h = tid >> 7, dk = tid & 127;
      bf16_t* dst = KT + ((((size_t)b * 4 + h) * NCH + c) * 128 + dk) * 64;
#pragma unroll
      for (int g8 = 0; g8 < 8; ++g8) { unsigned w[4];
#pragma unroll
        for (int j = 0; j < 4; ++j) { const unsigned lo = kl[(g8 * 8 + 2 * j) * 512 + tid], hi2 = kl[(g8 * 8 + 2 * j + 1) * 512 + tid]; w[j] = lo | (hi2 << 16); }
        *(u32x4*)(dst + g8 * 8) = (u32x4){w[0], w[1], w[2], w[3]}; }
    }
    __syncthreads();
  }
}

__device__ __forceinline__ void ph_dn_d1(const P& p, char* lds) {
  const int tid = TIDX(), wid = tid >> 6, lane = tid & 63, r32 = lane & 31, hi = lane >> 5;
  const bf16_t* QQ = (const bf16_t*)(p.ws + OFF_D + D_QQ); const bf16_t* QK = (const bf16_t*)(p.ws + OFF_D + D_QK); const bf16_t* QV = (const bf16_t*)(p.ws + OFF_D + D_QV);
  const float* GB = (const float*)(p.ws + OFF_GB);
  bf16_t* W_ = (bf16_t*)(p.ws + OFF_D + D_W); bf16_t* U_ = (bf16_t*)(p.ws + OFF_HBF); bf16_t* INTRA = (bf16_t*)(p.ws + OFF_D + D_INTRA);
  float* SC = (float*)(p.ws + OFF_SC); float* GLS = (float*)(p.ws + OFF_GL);
  float* KK = (float*)lds; float* QKm = KK + 64 * 65; float* Ad = QKm + 64 * 65; float* Gs = Ad + 2 * 4096; float* Bs = Gs + 128;
  bf16_t* Vs = (bf16_t*)(Bs + 128); bf16_t* Ks = Vs + 64 * 128;
  for (int job = BIDX(); job < 8 * NCH; job += GDIM()) {
    const int b = job / (4 * NCH), h = (job / NCH) & 3, c = job % NCH;
    const size_t Rb = (size_t)b * TB + (size_t)c * 64;
    {
      const int srow = tid >> 4, spc = (tid & 15) * 8;
      const u32x4 v0 = *(const u32x4*)(QV + (Rb + srow) * 512 + h * 128 + spc), v1 = *(const u32x4*)(QV + (Rb + 32 + srow) * 512 + h * 128 + spc);
      const u32x4 k0 = *(const u32x4*)(QK + (Rb + srow) * 512 + h * 128 + spc), k1 = *(const u32x4*)(QK + (Rb + 32 + srow) * 512 + h * 128 + spc);
      *(u32x4*)(Vs + srow * 128 + spc) = v0; *(u32x4*)(Vs + (32 + srow) * 128 + spc) = v1;
      *(u32x4*)(Ks + srow * 128 + spc) = k0; *(u32x4*)(Ks + (32 + srow) * 128 + spc) = k1;
    }
    {
      const int w4 = wid & 3, mi = w4 & 1, ni = w4 >> 1;
      const bf16_t* As = wid < 4 ? QK : QQ;
      const bf16_t* arow = As + (Rb + 32 * mi + r32) * 512 + h * 128 + hi * 8;
      const bf16_t* brow = QK + (Rb + 32 * ni + r32) * 512 + h * 128 + hi * 8;
      f32x16 acc = {}; acc = mma_rows<8>(arow, brow, acc);
      float* dst = wid < 4 ? KK : QKm;
#pragma unroll
      for (int r = 0; r < 16; ++r) dst[(32 * mi + crow(r, hi)) * 65 + 32 * ni + r32] = acc[r];
    }
    if (tid < 128) { const int d = tid >> 6, ip = tid & 63, t = d ? 63 - ip : ip; float g = GB[(Rb + t) * 16 + d * 4 + h]; Bs[tid] = GB[(Rb + t) * 16 + 8 + d * 4 + h];
#pragma unroll
      for (int o = 1; o < 64; o <<= 1) { const float v = __shfl_up(g, o); g += ip >= o ? v : 0.f; }
      Gs[tid] = g; }
    __syncthreads();
    const int n0 = c, n1 = c < 4 ? 3 - c : 135 - c;
    const size_t cj0 = ((size_t)(0 * 2 + b) * 4 + h) * NCH + n0, cj1 = ((size_t)(1 * 2 + b) * 4 + h) * NCH + n1;
    for (int e2 = tid; e2 < 8192; e2 += 512) {
      const int d = e2 >> 12, ip = (e2 >> 6) & 63, jp = e2 & 63; const int i = d ? 63 - ip : ip, j = d ? 63 - jp : jp;
      const float dec = jp <= ip ? __expf(Gs[d * 64 + ip] - Gs[d * 64 + jp]) : 0.f;
      Ad[d * 4096 + ip * 64 + jp] = jp < ip ? Bs[d * 64 + ip] * KK[i * 65 + j] * dec : 0.f;
      const size_t cj = d ? cj1 : cj0;
      INTRA[(cj * 64 + ip) * 64 + jp] = f2bf(QKm[i * 65 + j] * dec);
    }
    if (tid < 128) { const int d = tid >> 6, ip = tid & 63; const size_t cj = d ? cj1 : cj0; const float gi = Gs[tid], gl = Gs[d * 64 + 63];
      SC[(cj * 64 + ip) * 2] = __expf(gi); SC[(cj * 64 + ip) * 2 + 1] = __expf(gl - gi); if (ip == 0) GLS[cj] = __expf(gl); }
    __syncthreads();
    {
      const int d = tid >> 8, cc = tid & 255; const size_t cj = d ? cj1 : cj0;
      int dofs = d * 64, aofs = d * 4096; asm volatile("" : "+v"(dofs), "+v"(aofs));
      float x[64];
      {
        int vofs = cc < 128 ? cc : 64 * 128 + (cc - 128); asm volatile("" : "+v"(vofs));
#pragma unroll
        for (int ip = 0; ip < 64; ++ip) x[ip] = bf2f(Vs[vofs + ip * 128]);
#pragma unroll
        for (int ip = 0; ip < 32; ++ip) { const float a_ = x[ip], b_ = x[63 - ip]; x[ip] = d ? b_ : a_; x[63 - ip] = d ? a_ : b_; }
        if (cc < 128) {
#pragma unroll
          for (int ip = 0; ip < 64; ++ip) x[ip] *= Bs[dofs + ip];
        } else {
#pragma unroll
          for (int ip = 0; ip < 64; ++ip) x[ip] *= Bs[dofs + ip] * __expf(Gs[dofs + ip]);
        }
      }
      const float* Arow = Ad + aofs;
#pragma unroll
      for (int ip = 1; ip < 64; ++ip) {
        float s = 0.f;
#pragma unroll
        for (int j4 = 0; j4 < (ip + 3) / 4; ++j4) { const f32x4 a = *(const f32x4*)(Arow + ip * 64 + 4 * j4);
          s += a[0] * x[4 * j4] + a[1] * x[4 * j4 + 1] + a[2] * x[4 * j4 + 2] + a[3] * x[4 * j4 + 3]; }
        x[ip] -= s;
      }
      bf16_t* dst = cc < 128 ? U_ + cj * 64 * 128 + cc : W_ + cj * 64 * 128 + (cc - 128);
#pragma unroll
      for (int ip = 0; ip < 64; ++ip) dst[ip * 128] = f2bf(x[ip]);
    }
    __syncthreads();
  }
}

typedef _Float16 h16x8 __attribute__((ext_vector_type(8)));
__device__ __forceinline__ void ph_gla_b(const P& p, char* lds, int e) {
  const int tid = TIDX(), wid = tid >> 6, lane = tid & 63;
  const float* SM = (const float*)(p.ws + OFF_SM);
  float* w2S = (float*)lds;
  float* b2S = w2S + 8192;
  for (int i = tid; i < 8192; i += 512) { const int d = i >> 12, hh = (i >> 10) & 3, r = (i >> 6) & 15, j = i & 63; w2S[i] = p.gla_w2[(((size_t)e * 2 + d) * 16 + r) * 256 + hh * 64 + j]; }
  if (tid < 512) b2S[tid] = p.gla_b2[(size_t)e * 512 + tid];
  __syncthreads();
  int jb = 8 * wid; asm volatile("" : "+v"(jb));
  for (int job = BIDX(); job < 16 * NCH; job += GDIM()) {
    const int n = job % NCH, sq = job / NCH; const int dir = sq >> 3, b = (sq >> 2) & 1, h = sq & 3;
    const int c = dir == 0 ? n : (n < 4 ? 3 - n : 135 - n);
    const size_t row = (size_t)b * TB + (size_t)c * 64 + (dir ? 63 - lane : lane);
    const float* gp = SM + row * 64 + 16 + dir * 16;
    const f32x4 g0 = *(const f32x4*)(gp), g1 = *(const f32x4*)(gp + 4), g2 = *(const f32x4*)(gp + 8), g3 = *(const f32x4*)(gp + 12);
    const float gg_[16] = {g0[0], g0[1], g0[2], g0[3], g1[0], g1[1], g1[2], g1[3], g2[0], g2[1], g2[2], g2[3], g3[0], g3[1], g3[2], g3[3]};
    const float* wb = w2S + (dir * 4 + h) * 1024 + jb; const float* bb2 = b2S + dir * 256 + h * 64 + jb;
    f32x4 sa = *(const f32x4*)(bb2), sb = *(const f32x4*)(bb2 + 4);
#pragma unroll
    for (int r = 0; r < 16; ++r) { const f32x4 wa = *(const f32x4*)(wb + r * 64), wq = *(const f32x4*)(wb + r * 64 + 4); sa += gg_[r] * wa; sb += gg_[r] * wq; }
    float la[8];
#pragma unroll
    for (int jj = 0; jj < 4; ++jj) { const float x0 = sa[jj], x1 = sb[jj];
      la[jj] = (fminf(x0, 0.f) - log1pf(expf(-fabsf(x0)))) * 0.0625f; la[4 + jj] = (fminf(x1, 0.f) - log1pf(expf(-fabsf(x1)))) * 0.0625f; }
#pragma unroll
    for (int o = 1; o < 64; o <<= 1) {
#pragma unroll
      for (int jj = 0; jj < 8; ++jj) { const float v = __shfl_up(la[jj], o); la[jj] += lane >= o ? v : 0.f; }
    }
    h16x8 hv;
#pragma unroll
    for (int jj = 0; jj < 8; ++jj) hv[jj] = (_Float16)la[jj];
    _Float16* dst = (_Float16*)(p.ws + (dir ? OFF_B16_1 : OFF_WC)) + ((((size_t)b * 4 + h) * NCH + n) * 64 + lane) * 64 + jb;
    *(h16x8*)dst = hv;
  }
}

struct DnSet { bf16x8 fa[8]; };
template <int ROLE>
__device__ __forceinline__ void dn_scan_t(const P& p, char* lds, int job) {
  const int tid = TIDX(), wid = tid >> 6, lane = tid & 63, r32 = lane & 31, hi = lane >> 5;
  const int dir = job >> 5, b = (job >> 4) & 1, h = (job >> 2) & 3, n0 = (job & 3) * 32;
  const bf16_t* QQ = (const bf16_t*)(p.ws + OFF_D + D_QQ); const bf16_t* KT = (const bf16_t*)(p.ws + OFF_D + D_KT);
  const bf16_t* W_ = (const bf16_t*)(p.ws + OFF_D + D_W); const bf16_t* U_ = (const bf16_t*)(p.ws + OFF_HBF); const bf16_t* INTRA = (const bf16_t*)(p.ws + OFF_D + D_INTRA);
  const float* SC = (const float*)(p.ws + OFF_SC); const float* GLS = (const float*)(p.ws + OFF_GL);
  bf16_t* DNO = (bf16_t*)(p.ws + OFF_D + D_DNO);
  bf16_t* ST = (bf16_t*)lds; bf16_t* vTa = ST + 32 * 136; bf16_t* vTb = vTa + 32 * 72;
  float* scS = (float*)(vTb + 32 * 72);
  bf16_t* uS = (bf16_t*)(scS + 256);
  bf16_t* inS = uS + 2 * 64 * 40;
  for (int i = tid; i < 32 * 136; i += 512) ST[i] = 0;
  f32x16 accS = {};
  const size_t seq = ((size_t)dir * 2 + b) * 4 + h;
  const int mi = wid & 1, di = wid - 4;
  constexpr int role = ROLE;
  const int tt = tid - 256;
  DnSet fs[3]; float gls[3] = {0.f, 0.f, 0.f};
  u32x4 stU[3], stI0[3]; float stS[3] = {0.f, 0.f, 0.f};
#define DN_CH(n_) const int n__ = (n_); const int c__ = dir == 0 ? n__ : (n__ < 4 ? 3 - n__ : 135 - n__); const size_t Rb__ = (size_t)b * TB + (size_t)c__ * 64; const size_t cj__ = seq * NCH + n__;
#define DN_LOAD(S, GL, n_) do { DN_CH(n_) \
    const int ipl__ = 32 * mi + r32, tl__ = dir ? 63 - ipl__ : ipl__; \
    const bf16_t* b0__ = W_ + cj__ * 8192 + (32 * mi + r32) * 128 + hi * 8; \
    const bf16_t* b1__ = QQ + (Rb__ + tl__) * 512 + h * 128 + hi * 8; \
    const bf16_t* b2__ = KT + ((((size_t)b * 4 + h) * NCH + c__) * 128 + 32 * (wid & 3) + r32) * 64 + hi * 8; \
    const bf16_t* bs__ = role == 0 ? b0__ : (role == 1 ? b1__ : b2__); \
    _Pragma("unroll") for (int ks = 0; ks < 8; ++ks) S.fa[ks] = *(const bf16x8*)(bs__ + ks * 16); \
    GL = GLS[cj__]; } while (0)
#define DN_STAGE_LD(q_, n_) do { DN_CH(n_) (void)Rb__; \
      stU[q_] = *(const u32x4*)(U_ + cj__ * 8192 + ((tid & 255) >> 2) * 128 + n0 + (tid & 3) * 8); \
      stI0[q_] = *(const u32x4*)(INTRA + cj__ * 4096 + (tid >> 3) * 64 + (tid & 7) * 8); \
      stS[q_] = SC[cj__ * 128 + (tid & 127)]; } while (0)
#define DN_STAGE_ST(q_, bf_) do { *(u32x4*)(inS + (bf_) * 4608 + (tid >> 3) * 72 + (tid & 7) * 8) = stI0[q_]; \
      if (ROLE < 2) *(u32x4*)(uS + (bf_) * 2560 + (tid >> 2) * 40 + (tid & 3) * 8) = stU[q_]; \
      if (ROLE == 0) scS[(bf_) * 128 + tid] = stS[q_]; } while (0)
#define DN_STEP(S, GL, n_, bf_) do { DN_CH(n_) (void)cj__; \
    const float* sc__ = scS + (bf_) * 128; \
    if (role < 2) { _Pragma("unroll") for (int r = 0; r < 16; ++r) accS[r] = 0.f; } \
    if (role < 2) { const bf16_t* sb__ = ST + r32 * 136 + hi * 8; \
      _Pragma("unroll") for (int ks = 0; ks < 8; ++ks) accS = MFMA32(S.fa[ks], *(const bf16x8*)(sb__ + ks * 16), accS); \
      if (role == 0) { const bf16_t* us__ = uS + (bf_) * 2560 + r32; \
        _Pragma("unroll") for (int r = 0; r < 16; ++r) { const int ip = 32 * mi + crow(r, hi); const float vn = bf2f(us__[ip * 40]) - accS[r]; \
          vTa[r32 * 72 + ip] = f2bf(vn); const int to = dir ? 63 - ip : ip; vTb[r32 * 72 + to] = f2bf(vn * sc__[ip * 2 + 1]); } } \
      else { _Pragma("unroll") for (int r = 0; r < 16; ++r) accS[r] *= sc__[(32 * mi + crow(r, hi)) * 2]; } } \
    LBAR(); \
    if (role == 1) { const bf16_t* vb__ = vTa + r32 * 72 + hi * 8; const bf16_t* ib__ = inS + (bf_) * 4608 + (32 * mi + r32) * 72 + hi * 8; \
      _Pragma("unroll") for (int ks = 0; ks < 4; ++ks) accS = MFMA32(*(const bf16x8*)(ib__ + ks * 16), *(const bf16x8*)(vb__ + ks * 16), accS); \
      _Pragma("unroll") for (int r = 0; r < 16; ++r) { const int ip = 32 * mi + crow(r, hi), t = dir ? 63 - ip : ip; \
        DNO[((size_t)dir * MROWS + Rb__ + t) * 512 + h * 128 + n0 + r32] = f2bf(accS[r]); } } \
    else if (role == 2) { const bf16_t* vb__ = vTb + r32 * 72 + hi * 8; \
      _Pragma("unroll") for (int r = 0; r < 16; ++r) accS[r] *= GL; \
      _Pragma("unroll") for (int ks = 0; ks < 4; ++ks) accS = MFMA32(S.fa[ks], *(const bf16x8*)(vb__ + ks * 16), accS); \
      _Pragma("unroll") for (int r = 0; r < 16; ++r) ST[r32 * 136 + 32 * di + crow(r, hi)] = f2bf(accS[r]); } \
    LBAR(); } while (0)
  DN_STAGE_LD(0, 0); DN_STAGE_ST(0, 0); DN_STAGE_LD(1, 1); DN_STAGE_LD(2, 2);
  DN_LOAD(fs[0], gls[0], 0); DN_LOAD(fs[1], gls[1], 1);
  __syncthreads();
  for (int nb6 = 0; nb6 < NCH; nb6 += 6) {
#pragma unroll
    for (int k = 0; k < 6; ++k) {
      const int n = nb6 + k; const int n2 = n + 2 < NCH ? n + 2 : NCH - 1; const int n3 = n + 3 < NCH ? n + 3 : NCH - 1;
      DN_STAGE_ST((k + 1) % 3, (k + 1) & 1);
      DN_STAGE_LD(k % 3, n3);
      DN_LOAD(fs[(k + 2) % 3], gls[(k + 2) % 3], n2);
      DN_STEP(fs[k % 3], gls[k % 3], n, k & 1);
    }
  }
#undef DN_CH
#undef DN_LOAD
#undef DN_STAGE_LD
#undef DN_STAGE_ST
#undef DN_STEP
}

__device__ __forceinline__ void dn_scan(const P& p, char* lds, int job) {
  const int wid = TIDX() >> 6;
  if (wid < 2) dn_scan_t<0>(p, lds, job); else if (wid < 4) dn_scan_t<1>(p, lds, job); else dn_scan_t<2>(p, lds, job);
}

DI float fast_logsig(float s) { return fminf(s, 0.f) - __logf(1.f + __expf(-fabsf(s))); }
struct GlaRegs { h16x8 ba, bb; bf16x8 qa, qb, ka, kb, v8; };
template <int ROLE>
__device__ __forceinline__ void gla_scan_t(const P& p, char* lds, int job, int e) {
  const int tid = TIDX(), wid = tid >> 6, lane = tid & 63, r32 = lane & 31, hi = lane >> 5;
  const int dir = job >> 5, b = (job >> 4) & 1, h = (job >> 2) & 3, n0 = (job & 3) * 32;
  const bf16_t* P2 = (const bf16_t*)(p.ws + OFF_D + D_P2); const float* SM = (const float*)(p.ws + OFF_SM);
  bf16_t* GLAO = (bf16_t*)(p.ws + OFF_D + D_GLAO);
  const _Float16* B16 = (const _Float16*)(p.ws + (dir ? OFF_B16_1 : OFF_WC));
  float* w2S = (float*)lds; float* b2S = w2S + 1024; float* aLb = b2S + 64;
  bf16_t* ops = (bf16_t*)(aLb + 128);
  constexpr int OPB = (4 * 64 + 32) * 72;
  bf16_t* attp = ops + 2 * OPB;
  bf16_t* STb = attp + 2 * 32 * 72;
  for (int i = tid; i < 2 * 32 * 72; i += 512) STb[i] = 0;
  f32x16 accS = {};
  __syncthreads();
  GlaRegs RG[3];
  int jb0 = 16 * (wid & 3); asm volatile("" : "+v"(jb0));
  int vtb0 = 8 * (wid & 3) * 72 + lane; asm volatile("" : "+v"(vtb0));
#define GLA_LOAD(R, n_) do { const int n__ = (n_) < NCH ? (n_) : NCH - 1; const int c__ = dir == 0 ? n__ : (n__ < 4 ? 3 - n__ : 135 - n__); const size_t row__ = (size_t)b * TB + (size_t)c__ * 64 + (dir ? 63 - lane : lane); \
    const _Float16* bp__ = B16 + ((((size_t)b * 4 + h) * NCH + n__) * 64 + lane) * 64 + 16 * (wid & 3); R.ba = *(const h16x8*)(bp__); R.bb = *(const h16x8*)(bp__ + 8); \
    const bf16_t* pr__ = P2 + row__ * 2048; R.qa = *(const bf16x8*)(pr__ + 512 + h * 64 + 16 * (wid & 3)); R.qb = *(const bf16x8*)(pr__ + 512 + h * 64 + 16 * (wid & 3) + 8); \
    R.ka = *(const bf16x8*)(pr__ + 768 + h * 64 + 16 * (wid & 3)); R.kb = *(const bf16x8*)(pr__ + 768 + h * 64 + 16 * (wid & 3) + 8); R.v8 = *(const bf16x8*)(pr__ + 1024 + h * 128 + n0 + 8 * (wid & 3)); } while (0)
#define GLA_HALF(R, BV, QV, KV, jb) do { \
    float eqe[8], eke[8], eqi[8]; \
    _Pragma("unroll") for (int jj = 0; jj < 8; ++jj) { const int j = (jb) + jj; const float bb = (float)BV[jj]; const float bm = __int_as_float(__builtin_amdgcn_readlane(__float_as_int(bb), 32)), bl = __int_as_float(__builtin_amdgcn_readlane(__float_as_int(bb), 63)); \
      const float q_ = bf2f((bf16_t)QV[jj]) * 0.125f, k_ = bf2f((bf16_t)KV[jj]); \
      eqe[jj] = q_ * __expf(bb - bm); eke[jj] = k_ * __expf(bm - bb); eqi[jj] = q_ * __expf(bb); ksT_[j * 72 + lane] = f2bf(k_ * __expf(bl - bb)); if (lane == 63) aL_[j] = __expf(bl); } \
    *(u32x4*)(qe_ + lane * 72 + (jb)) = (u32x4){cvtpk(eqe[0], eqe[1]), cvtpk(eqe[2], eqe[3]), cvtpk(eqe[4], eqe[5]), cvtpk(eqe[6], eqe[7])}; \
    *(u32x4*)(ke_ + lane * 72 + (jb)) = (u32x4){cvtpk(eke[0], eke[1]), cvtpk(eke[2], eke[3]), cvtpk(eke[4], eke[5]), cvtpk(eke[6], eke[7])}; \
    *(u32x4*)(qi_ + lane * 72 + (jb)) = (u32x4){cvtpk(eqi[0], eqi[1]), cvtpk(eqi[2], eqi[3]), cvtpk(eqi[4], eqi[5]), cvtpk(eqi[6], eqi[7])}; } while (0)
#define GLA_PREP(R, bf_) do { bf16_t* qe_ = ops + (bf_) * OPB; bf16_t* ke_ = qe_ + 64 * 72; bf16_t* qi_ = ke_ + 64 * 72; bf16_t* ksT_ = qi_ + 64 * 72; bf16_t* vT_ = ksT_ + 64 * 72; float* aL_ = aLb + (bf_) * 64; \
    GLA_HALF(R, R.ba, R.qa, R.ka, jb0); GLA_HALF(R, R.bb, R.qb, R.kb, jb0 + 8); \
    _Pragma("unroll") for (int q_ = 0; q_ < 8; ++q_) vT_[vtb0 + q_ * 72] = (bf16_t)R.v8[q_]; } while (0)
#define GLA_MMA(n_, bf_) do { const int nq__ = (n_); const int bf = (bf_); \
      const bf16_t* qe_ = ops + bf * OPB; const bf16_t* ke_ = qe_ + 64 * 72; const bf16_t* qi_ = ke_ + 64 * 72; const bf16_t* ksT_ = qi_ + 64 * 72; const bf16_t* vT_ = ksT_ + 64 * 72; const float* aL_ = aLb + bf * 64; \
      const bf16_t* STr = STb + bf * 32 * 72; bf16_t* STw = STb + (bf ^ 1) * 32 * 72; \
      if (ROLE == 1) { \
        const int mi = wid - 4; bf16_t* attw = attp + mi * 32 * 72; \
        const int c = dir == 0 ? nq__ : (nq__ < 4 ? 3 - nq__ : 135 - nq__); const size_t Rb = (size_t)b * TB + (size_t)c * 64; \
        f32x16 acc = {}; acc = mma_rows<4>(qi_ + (32 * mi + r32) * 72 + hi * 8, STr + r32 * 72 + hi * 8, acc); \
        { f32x16 a0 = {}; a0 = mma_rows<4>(qe_ + (32 * mi + r32) * 72 + hi * 8, ke_ + r32 * 72 + hi * 8, a0); \
          _Pragma("unroll") for (int r = 0; r < 16; ++r) { const int ipl = crow(r, hi); attw[ipl * 72 + r32] = f2bf((mi == 1 || r32 <= ipl) ? a0[r] : 0.f); } \
          f32x16 a1 = {}; if (mi == 1) a1 = mma_rows<4>(qe_ + (32 + r32) * 72 + hi * 8, ke_ + (32 + r32) * 72 + hi * 8, a1); \
          _Pragma("unroll") for (int r = 0; r < 16; ++r) { const int ipl = crow(r, hi); attw[ipl * 72 + 32 + r32] = f2bf((mi == 1 && r32 <= ipl) ? a1[r] : 0.f); } } \
        asm volatile("s_waitcnt lgkmcnt(0)" ::: "memory"); \
        acc = mma_rows<4>(attw + r32 * 72 + hi * 8, vT_ + r32 * 72 + hi * 8, acc); \
        _Pragma("unroll") for (int r = 0; r < 16; ++r) { const int ip = 32 * mi + crow(r, hi), t = dir ? 63 - ip : ip; \
          GLAO[((size_t)dir * MROWS + Rb + t) * 512 + h * 128 + n0 + r32] = f2bf(acc[r]); } \
      } else { \
        const int di = wid - 6; \
        _Pragma("unroll") for (int r = 0; r < 16; ++r) accS[r] *= aL_[32 * di + crow(r, hi)]; \
        accS = mma_rows<4>(ksT_ + (32 * di + r32) * 72 + hi * 8, vT_ + r32 * 72 + hi * 8, accS); \
        _Pragma("unroll") for (int r = 0; r < 16; ++r) STw[r32 * 72 + 32 * di + crow(r, hi)] = f2bf(accS[r]); \
      } } while (0)
  GLA_LOAD(RG[0], 0);
  if (ROLE == 0) { GLA_PREP(RG[0], 0); }
  GLA_LOAD(RG[1], 1); GLA_LOAD(RG[2], 2); GLA_LOAD(RG[0], 3);
  LBAR();
  for (int nb6 = 0; nb6 < NCH; nb6 += 6) {
#pragma unroll
    for (int k = 0; k < 6; ++k) {
      const int n = nb6 + k;
      if (ROLE == 0) { if (n + 1 < NCH) { GLA_PREP(RG[(k + 1) % 3], (k + 1) & 1); } } else { GLA_MMA(n, k & 1); }
      GLA_LOAD(RG[(k + 1) % 3], n + 4);
      LBAR();
    }
  }
#undef GLA_MMA
#undef GLA_LOAD
#undef GLA_HALF
#undef GLA_PREP
}

__device__ __forceinline__ void gla_scan(const P& p, char* lds, int job, int e) {
  const int wid = TIDX() >> 6;
  if (wid < 4) gla_scan_t<0>(p, lds, job, e); else if (wid < 6) gla_scan_t<1>(p, lds, job, e); else gla_scan_t<2>(p, lds, job, e);
}

__device__ __forceinline__ void ph_merge(const P& p, int e) {
  const int tid = TIDX(), wid = tid >> 6, lane = tid & 63, l16 = lane & 15, sub = lane >> 4;
  const bf16_t* DNO = (const bf16_t*)(p.ws + OFF_D + D_DNO); const bf16_t* GLAO = (const bf16_t*)(p.ws + OFF_D + D_GLAO);
  const bf16_t* P2 = (const bf16_t*)(p.ws + OFF_D + D_P2); bf16_t* hb = (bf16_t*)(p.ws + OFF_HBF);
  f32x8 nwd = *(const f32x8*)(p.dn_norm + e * 128 + l16 * 8), nwg = *(const f32x8*)(p.gla_norm + e * 128 + l16 * 8);
  for (int R4 = (BIDX() * 8 + wid) * 4; R4 < MROWS; R4 += GDIM() * 32) {
    const size_t R = R4 + sub;
    bf16x8 a[8], bq[8], zz[8];
#pragma unroll
    for (int g = 0; g < 8; ++g) { const bf16_t* src = g < 4 ? DNO : GLAO; const int hc = (g & 3) * 128 + l16 * 8;
      a[g] = *(const bf16x8*)(src + R * 512 + hc); bq[g] = *(const bf16x8*)(src + ((size_t)MROWS + R) * 512 + hc);
      zz[g] = *(const bf16x8*)(P2 + R * 2048 + (g < 4 ? 0 : 1536) + hc); }
#pragma unroll
    for (int g = 0; g < 8; ++g) {
      float v[8]; float ss = 0.f;
#pragma unroll
      for (int j = 0; j < 8; ++j) { v[j] = bf2f((bf16_t)a[g][j]) + bf2f((bf16_t)bq[g][j]); ss += v[j] * v[j]; }
      ss += __shfl_xor(ss, 1); ss += __shfl_xor(ss, 2); ss += __shfl_xor(ss, 4); ss += __shfl_xor(ss, 8);
      const float rs = rsqrtf(ss * (1.f / 128.f) + EPSF);
      float o[8];
#pragma unroll
      for (int j = 0; j < 8; ++j) o[j] = v[j] * rs * (g < 4 ? nwd[j] : nwg[j]) * siluf(bf2f((bf16_t)zz[g][j]));
      *(u32x4*)(hb + R * 1024 + g * 128 + l16 * 8) = (u32x4){cvtpk(o[0], o[1]), cvtpk(o[2], o[3]), cvtpk(o[4], o[5]), cvtpk(o[6], o[7])};
    }
  }
}

DI float silu_fast(float x) { return x / (1.f + __expf(-x)); }
__device__ __forceinline__ void ph_ffnact(const P& p, int L) {
  bf16_t* U = (bf16_t*)(p.ws + OFF_D);
  const float* cw = p.ffn_conv + (size_t)L * 3 * DFF;
  const size_t items = (size_t)MROWS * 352, stride = (size_t)GDIM() * 512;
  for (size_t it0 = (size_t)BIDX() * 512 + TIDX(); it0 < items; it0 += 2 * stride) {
    bf16x8 zc[2], zp[2], zn[2], vv[2]; int Rr[2], cc[2]; bool ok[2];
#pragma unroll
    for (int q = 0; q < 2; ++q) {
      size_t it = it0 + q * stride; ok[q] = it < items; if (!ok[q]) it = it0;
      const int R = (int)(it / 352), c0 = (int)(it % 352) * 8; const int b = R >= TB ? 1 : 0, pp = R - b * TB;
      const bool hasp = !(pp == 0 || pp == CTXL), hasn = !(pp == CTXL - 1 || pp == TB - 1);
      Rr[q] = R; cc[q] = c0;
      zc[q] = *(const bf16x8*)(U + (size_t)R * 5632 + c0);
      zp[q] = *(const bf16x8*)(U + (size_t)(hasp ? R - 1 : R) * 5632 + c0);
      zn[q] = *(const bf16x8*)(U + (size_t)(hasn ? R + 1 : R) * 5632 + c0);
      vv[q] = *(const bf16x8*)(U + (size_t)R * 5632 + DFF + c0);
      if (!hasp) zp[q] = (bf16x8){0, 0, 0, 0, 0, 0, 0, 0};
      if (!hasn) zn[q] = (bf16x8){0, 0, 0, 0, 0, 0, 0, 0};
    }
#pragma unroll
    for (int q = 0; q < 2; ++q) {
      const int c0 = cc[q];
      const f32x8 w0 = *(const f32x8*)(cw + c0), w1 = *(const f32x8*)(cw + DFF + c0), w2 = *(const f32x8*)(cw + 2 * DFF + c0);
      float o[8];
#pragma unroll
      for (int j = 0; j < 8; ++j) { const float a = bf2f((bf16_t)zp[q][j]) * w0[j] + bf2f((bf16_t)zc[q][j]) * w1[j] + bf2f((bf16_t)zn[q][j]) * w2[j];
        o[j] = silu_fast(a) * bf2f((bf16_t)vv[q][j]); }
      if (ok[q]) *(u32x4*)(U + (size_t)Rr[q] * 5632 + DFF + c0) = (u32x4){cvtpk(o[0], o[1]), cvtpk(o[2], o[3]), cvtpk(o[4], o[5]), cvtpk(o[6], o[7])};
    }
  }
}

__device__ __forceinline__ void ph_qknorm(const P& p, char* lds, int o) {
  const int tid = TIDX(), wid = tid >> 6, lane = tid & 63, l16 = lane & 15, sub = lane >> 4;
  bf16_t* QKV = (bf16_t*)(p.ws + OFF_D);
  float* tab = (float*)lds;
  for (int i = tid; i < 4096; i += 512) { const int pos = i >> 5, f = i & 31; const float ang = (float)pos * powf(10000.f, -(float)f / 32.f); tab[2 * i] = cosf(ang); tab[2 * i + 1] = sinf(ang); }
  __syncthreads();
  const f32x8 qn = *(const f32x8*)(p.att_q_norm + o * 128 + l16 * 8), kn = *(const f32x8*)(p.att_k_norm + o * 128 + l16 * 8);
  const int f0 = (l16 & 3) * 8;
  for (int R4 = (BIDX() * 8 + wid) * 4; R4 < MROWS; R4 += GDIM() * 32) {
    const int R = R4 + sub; const int b = R >= TB ? 1 : 0, pp = R - b * TB; const bool lat = pp >= CTXL; const int t = lat ? pp - CTXL : 0;
    const int pos = (l16 < 8) ? (t >> 6) : (t & 63);
    bf16_t* base = QKV + (size_t)R * 1536 + l16 * 8;
    bf16x8 x[10];
#pragma unroll
    for (int hd = 0; hd < 10; ++hd) x[hd] = *(const bf16x8*)(base + hd * 128);
    float cs[8], sn[8];
#pragma unroll
    for (int j = 0; j < 8; ++j) { const float2 t2 = *(const float2*)(tab + 2 * (pos * 32 + f0 + j)); cs[j] = lat ? t2.x : 1.f; sn[j] = lat ? t2.y : 0.f; }
#pragma unroll
    for (int hd = 0; hd < 10; ++hd) {
      float v[8]; float ss = 0.f;
#pragma unroll
      for (int j = 0; j < 8; ++j) { v[j] = bf2f((bf16_t)x[hd][j]); ss += v[j] * v[j]; }
      ss += __shfl_xor(ss, 1); ss += __shfl_xor(ss, 2); ss += __shfl_xor(ss, 4); ss += __shfl_xor(ss, 8);
      const float rs = rsqrtf(ss * (1.f / 128.f) + EPSF);
      float ov[8];
#pragma unroll
      for (int j = 0; j < 8; ++j) { v[j] = v[j] * rs * (hd < 8 ? qn[j] : kn[j]); const float pr = __shfl_xor(v[j], 4);
        ov[j] = (l16 & 4) ? (pr * sn[j] + v[j] * cs[j]) : (v[j] * cs[j] - pr * sn[j]); }
      *(u32x4*)(base + hd * 128) = (u32x4){cvtpk(ov[0], ov[1]), cvtpk(ov[2], ov[3]), cvtpk(ov[4], ov[5]), cvtpk(ov[6], ov[7])};
    }
  }
}

namespace at {
constexpr int D = 128, NW = 8, QBLK = 32, KVBLK = 64;
constexpr float SCALE = 0.088388347648318440f, THR = 8.f;
constexpr int LDQ = 1536, LDK = 1536, LDO = 1024;
constexpr size_t SHM_V = KVBLK * D * 2, SHM_K = KVBLK * D * 2;
#define KSWZ(row, colB) ((row) * 256 + ((colB) ^ (((row) & 7) << 4)))
#define SBAR() __builtin_amdgcn_sched_barrier(0)
DI void partialSM(f32x16& p0, f32x16& p1, float& m_reg, float& mn, float& alpha) {
  constexpr float C = SCALE * 1.4426950408889634f;
  float pmax = p0[0]; for (int r = 1; r < 16; ++r) pmax = fmaxf(pmax, p0[r]); for (int r = 0; r < 16; ++r) pmax = fmaxf(pmax, p1[r]);
  { auto rr = __builtin_amdgcn_permlane32_swap(__float_as_uint(pmax), __float_as_uint(pmax), false, false);
    pmax = fmaxf(__uint_as_float(rr[0]), __uint_as_float(rr[1])); }
  if (__builtin_expect(__all(pmax - m_reg <= THR / SCALE), 1)) { mn = m_reg; alpha = 1.f; }
  else { mn = fmaxf(m_reg, pmax); alpha = __builtin_amdgcn_exp2f((m_reg - mn) * C); m_reg = mn; }
  float mnC = -mn * C;
  for (int r = 0; r < 16; ++r) p0[r] = fmaf(p0[r], C, mnC); for (int r = 0; r < 16; ++r) p1[r] = fmaf(p1[r], C, mnC);
  for (int r = 0; r < 16; ++r) p0[r] = __builtin_amdgcn_exp2f(p0[r]);
}
DI void finishSM(f32x16& p0, f32x16& p1, float alpha, float& l_reg, bf16x8& pa0, bf16x8& pa1, bf16x8& pa2, bf16x8& pa3) {
  for (int r = 0; r < 16; ++r) p1[r] = __builtin_amdgcn_exp2f(p1[r]);
  float ps = 0; for (int r = 0; r < 16; ++r) ps += p0[r]; for (int r = 0; r < 16; ++r) ps += p1[r];
  { auto rr = __builtin_amdgcn_permlane32_swap(__float_as_uint(ps), __float_as_uint(ps), false, false);
    ps = __uint_as_float(rr[0]) + __uint_as_float(rr[1]); }
  l_reg = l_reg * alpha + ps;
#define PK4(PP, BASE, OUT) do { unsigned a0 = cvtpk(PP[BASE + 0], PP[BASE + 1]), a1 = cvtpk(PP[BASE + 2], PP[BASE + 3]);   \
    unsigned b0 = cvtpk(PP[BASE + 4], PP[BASE + 5]), b1 = cvtpk(PP[BASE + 6], PP[BASE + 7]);                              \
    auto r0 = __builtin_amdgcn_permlane32_swap(a0, b0, false, false); auto r1 = __builtin_amdgcn_permlane32_swap(a1, b1, false, false); \
    u32x4 w = {r0[0], r1[0], r0[1], r1[1]}; OUT = *reinterpret_cast<bf16x8*>(&w); } while (0)
  PK4(p0, 0, pa0); PK4(p0, 8, pa1); PK4(p1, 0, pa2); PK4(p1, 8, pa3);
#undef PK4
}
DI void qkt(f32x16& p0, f32x16& p1, const bf16_t* Ks, const bf16x8* qr, int r32, int hi) {
  p0 = f32x16{}; p1 = f32x16{};
  for (int d0 = 0; d0 < 8; ++d0) { int cb = (d0 * 16 + hi * 8) * 2;
    bf16x8 b0 = *reinterpret_cast<const bf16x8*>((const char*)Ks + KSWZ(r32, cb));
    bf16x8 b1 = *reinterpret_cast<const bf16x8*>((const char*)Ks + KSWZ(32 + r32, cb));
    p0 = MFMA32(b0, qr[d0], p0);
    p1 = MFMA32(b1, qr[d0], p1); }
}
DI int v_st(int k, int c) { const int kk = (k & ~0xC) | ((k & 4) << 1) | ((k & 8) >> 1); return ((kk >> 3) * 4 + (c >> 5)) * 512 + ((kk & 7) * 32 + (c & 31)) * 2; }
DI int v_rd_base(int lane) { return ((lane & 3) << 3) | (((lane >> 2) & 3) << 6) | (((lane >> 4) & 1) << 5) | (((lane >> 5) & 1) << 8); }
constexpr int v_rd_off(int d0, int ks, int half) { return d0 * 512 + ks * 4096 + half * 2048; }
template <int OFF> DI s16x4 tr_read(int vb) {
  s16x4 r; asm volatile("ds_read_b64_tr_b16 %0, %1 offset:%2" : "=&v"(r) : "v"(vb), "i"(OFF) : "memory"); return r;
}
template <int D0> DI void pv_one(f32x16& od, int vb, bf16x8 pa0, bf16x8 pa1, bf16x8 pa2, bf16x8 pa3) {
  const s16x4 l0 = tr_read<v_rd_off(D0, 0, 0)>(vb), h0 = tr_read<v_rd_off(D0, 0, 1)>(vb), l1 = tr_read<v_rd_off(D0, 1, 0)>(vb), h1 = tr_read<v_rd_off(D0, 1, 1)>(vb);
  const s16x4 l2 = tr_read<v_rd_off(D0, 2, 0)>(vb), h2 = tr_read<v_rd_off(D0, 2, 1)>(vb), l3 = tr_read<v_rd_off(D0, 3, 0)>(vb), h3 = tr_read<v_rd_off(D0, 3, 1)>(vb);
  asm volatile("s_waitcnt lgkmcnt(0)" ::: "memory"); SBAR();
#define PK(Lx, Hx) (bf16x8){Lx[0], Lx[1], Lx[2], Lx[3], Hx[0], Hx[1], Hx[2], Hx[3]}
  od = MFMA32(pa0, PK(l0, h0), od);
  od = MFMA32(pa1, PK(l1, h1), od);
  od = MFMA32(pa2, PK(l2, h2), od);
  od = MFMA32(pa3, PK(l3, h3), od);
#undef PK
}
DI void pv_d0(f32x16* o, int vb, bf16x8 pa0, bf16x8 pa1, bf16x8 pa2, bf16x8 pa3) {
  pv_one<0>(o[0], vb, pa0, pa1, pa2, pa3); pv_one<1>(o[1], vb, pa0, pa1, pa2, pa3); pv_one<2>(o[2], vb, pa0, pa1, pa2, pa3); pv_one<3>(o[3], vb, pa0, pa1, pa2, pa3);
}
DI void attn_dense_body(const bf16_t* __restrict__ Qb, const bf16_t* __restrict__ Kh, const bf16_t* __restrict__ Vh, bf16_t* __restrict__ Ob, int seq, char* lds) {
  const int tid = TIDX(), wid = tid >> 6, lane = tid & 63, r32 = lane & 31, hi = lane >> 5;
  bf16_t* V_lds = (bf16_t*)lds; bf16_t* K_lds = (bf16_t*)(lds + 2 * SHM_V);
  float* ws = (float*)(lds + 2 * SHM_V + 2 * SHM_K) + wid * 64; float* li_l = ws; float* al_l = ws + 32;
  float m_reg = -1e30f, l_reg = 0; f32x16 o[4] = {}; bf16x8 qr[8];
  const bf16_t* Qw = Qb + (long)(wid * QBLK + r32) * LDQ + hi * 8;
#pragma unroll
  for (int d0 = 0; d0 < 8; ++d0) qr[d0] = *reinterpret_cast<const bf16x8*>(Qw + d0 * 16);
  const int sr = tid >> 4, sc = (tid & 15) * 8, vst0 = v_st(sr, sc), vst1 = v_st(32 + sr, sc);
  const int vb0 = (int)(uintptr_t)V_lds + v_rd_base(lane);
  struct { bf16x8 vs0, vs1, ks0, ks1; } sr_[2];
#define SLOAD(i, k0) do { sr_[i].vs0 = *(const bf16x8*)(&Vh[(long)((k0) + sr) * LDK + sc]); sr_[i].vs1 = *(const bf16x8*)(&Vh[(long)((k0) + 32 + sr) * LDK + sc]); \
    sr_[i].ks0 = *(const bf16x8*)(&Kh[(long)((k0) + sr) * LDK + sc]); sr_[i].ks1 = *(const bf16x8*)(&Kh[(long)((k0) + 32 + sr) * LDK + sc]); } while (0)
#define SWRITE(bq, i) do { *(bf16x8*)((char*)V_lds + (bq) * SHM_V + vst0) = sr_[i].vs0;          \
    *(bf16x8*)((char*)V_lds + (bq) * SHM_V + vst1) = sr_[i].vs1; int kc = sc * 2;               \
    *(bf16x8*)((char*)K_lds + (bq) * SHM_K + KSWZ(sr, kc)) = sr_[i].ks0;                       \
    *(bf16x8*)((char*)K_lds + (bq) * SHM_K + KSWZ(32 + sr, kc)) = sr_[i].ks1; } while (0)
#define SWAIT() asm volatile("s_waitcnt vmcnt(4)" ::: "memory")
#define RESC(a) do { if (__any((a) < 1.f)) { if (hi == 0) al_l[r32] = (a); asm volatile("s_waitcnt lgkmcnt(0)" ::: "memory"); \
    for (int d = 0; d < 4; ++d) for (int r = 0; r < 16; ++r) o[d][r] *= al_l[crow(r, hi)]; } } while (0)
  f32x16 pA0, pA1, pB0, pB1; float mnA, mnB, alA, alB; bf16x8 pa0, pa1, pa2, pa3; const int NT = seq / KVBLK;
  constexpr int SE = 0, SO = 1;
  SLOAD(SE, 0); asm volatile("s_waitcnt vmcnt(0)" ::: "memory"); SWRITE(0, SE); __syncthreads();
  qkt(pA0, pA1, K_lds, qr, r32, hi); partialSM(pA0, pA1, m_reg, mnA, alA);
  SLOAD(SO, KVBLK); if (2 < NT) SLOAD(SE, 2 * KVBLK);
  SWAIT(); SWRITE(1, SO); __syncthreads();
  for (int j = 1; j + 1 < NT; j += 2) {
    SBAR(); qkt(pB0, pB1, (bf16_t*)((char*)K_lds + SHM_K), qr, r32, hi);
    finishSM(pA0, pA1, alA, l_reg, pa0, pa1, pa2, pa3); SBAR();
    SLOAD(SO, (j + 2) * KVBLK); SBAR();
    pv_d0(o, vb0, pa0, pa1, pa2, pa3); partialSM(pB0, pB1, m_reg, mnB, alB);
    __syncthreads(); SWAIT(); SWRITE(0, SE);
    RESC(alB); __syncthreads();
    SBAR(); qkt(pA0, pA1, K_lds, qr, r32, hi);
    finishSM(pB0, pB1, alB, l_reg, pa0, pa1, pa2, pa3); SBAR();
    if (j + 3 < NT) SLOAD(SE, (j + 3) * KVBLK); SBAR();
    pv_d0(o, vb0 + (int)SHM_V, pa0, pa1, pa2, pa3); partialSM(pA0, pA1, m_reg, mnA, alA);
    __syncthreads(); SWAIT(); SWRITE(1, SO);
    RESC(alA); __syncthreads();
  }
  SBAR(); qkt(pB0, pB1, (bf16_t*)((char*)K_lds + SHM_K), qr, r32, hi);
  finishSM(pA0, pA1, alA, l_reg, pa0, pa1, pa2, pa3); SBAR();
  pv_d0(o, vb0, pa0, pa1, pa2, pa3); partialSM(pB0, pB1, m_reg, mnB, alB);
  __syncthreads(); RESC(alB);
  finishSM(pB0, pB1, alB, l_reg, pa0, pa1, pa2, pa3); SBAR();
  pv_d0(o, vb0 + (int)SHM_V, pa0, pa1, pa2, pa3);
  if (hi == 0) li_l[r32] = l_reg; asm volatile("s_waitcnt lgkmcnt(0)" ::: "memory");
  float rli[16];
#pragma unroll
  for (int r = 0; r < 16; ++r) rli[r] = __builtin_amdgcn_rcpf(li_l[crow(r, hi)]);
  bf16_t* Ow = Ob + (long)(wid * QBLK) * LDO;
#pragma unroll
  for (int r = 0; r < 16; ++r) { int orow = crow(r, hi);
    for (int d0 = 0; d0 < 4; ++d0) Ow[(long)orow * LDO + d0 * 32 + r32] = f2bf(o[d0][r] * rli[r]); }
#undef SLOAD
#undef SWRITE
#undef SWAIT
#undef RESC
}
}

__device__ __forceinline__ void ph_attn(const P& p, char* lds, bool need_ctx) {
  const bf16_t* QKV = (const bf16_t*)(p.ws + OFF_D); bf16_t* hb = (bf16_t*)(p.ws + OFF_HBF);
  const int nunits = need_ctx ? 528 : 512;
  for (int u = BIDX(); u < nunits; u += GDIM()) {
    int b, h, seq; size_t qrow;
    if (u < 512) { b = u >> 8; const int rem = u & 255; h = rem >> 5; qrow = (size_t)b * TB + CTXL + (size_t)(rem & 31) * 256; seq = TB; }
    else { const int uu = u - 512; b = uu >> 3; h = uu & 7; qrow = (size_t)b * TB; seq = CTXL; }
    const int kvh = h >> 2;
    const bf16_t* Kh = QKV + (size_t)b * TB * 1536 + 1024 + kvh * 128;
    const bf16_t* Vh = QKV + (size_t)b * TB * 1536 + 1280 + kvh * 128;
    at::attn_dense_body(QKV + qrow * 1536 + h * 128, Kh, Vh, hb + qrow * 1024 + h * 128, seq, lds);
    __syncthreads();
  }
}

__device__ __forceinline__ void ph_final(const P& p) {
  const int tid = TIDX(), wid = tid >> 6, lane = tid & 63;
  const float* xr = (const float*)(p.ws + OFF_XRES);
  for (int q = BIDX() * 8 + wid; q < 2 * LAT; q += GDIM() * 8) {
    const int b = q >> 13, t = q & (LAT - 1); const float* row = xr + ((size_t)b * TB + CTXL + t) * 1024;
    f32x4 v[4]; float ss = 0.f;
#pragma unroll
    for (int i = 0; i < 4; ++i) { v[i] = *(const f32x4*)(row + i * 256 + lane * 4); ss += v[i][0] * v[i][0] + v[i][1] * v[i][1] + v[i][2] * v[i][2] + v[i][3] * v[i][3]; }
    ss = wave_sum(ss); const float rs = rsqrtf(ss * (1.f / 1024.f) + EPSF);
#pragma unroll
    for (int i = 0; i < 4; ++i) { const int c0 = i * 256 + lane * 4; const f32x4 g = *(const f32x4*)(p.final_norm + c0); f32x4 o = v[i] * rs * g; *(f32x4*)(p.out + (size_t)q * 1024 + c0) = o; }
  }
}

#ifndef ONLY_PH
#define ONLY_PH -1
#endif
#define EN(x) (ONLY_PH < 0 || ONLY_PH == (x))
#ifndef PROBE_REP
#define PROBE_REP -1
#endif
#define RUN(cls, ...) do { if (EN(cls)) { for (int rep_ = 0; rep_ < ((PROBE_REP == (cls)) ? 2 : 1); ++rep_) { if (rep_) xcd_barrier(*xbp); __VA_ARGS__; } } } while (0)
enum { OP_INIT, OP_N1FULL, OP_IN, OP_PREP, OP_D1, OP_SCAN, OP_MERGE, OP_OUTLAT, OP_OUTCTX_N2LAT, OP_N2CTX, OP_UP, OP_ACT, OP_DOWNLAT, OP_DOWNCTX_N1LAT, OP_N1CTX,
       OP_QKV, OP_QKNORM, OP_ATTN, OP_N2FULL, OP_FINAL };
constexpr int NPHASES = 48;
__device__ __forceinline__ void decode_phase(int ph, int& op, int& L) {
  if (ph == 0) { op = OP_INIT; L = 0; return; }
  if (ph == NPHASES - 1) { op = OP_FINAL; L = 3; return; }
  int q = ph - 1;
  if (q < 14) { L = 0; if (q == 0) { op = OP_N1FULL; return; } q -= 1; }
  else if (q < 25) { L = 1; q -= 14; }
  else if (q < 38) { L = 2; q -= 25; }
  else { L = 3; q -= 38; }
  if ((L & 1) == 0) {
    if (q < 5) { op = OP_IN + q; return; }
    q -= 5;
  } else {
    if (q < 3) { op = OP_QKV + q; return; }
    q -= 3;
  }
  if (L < 3) { const int t[8] = {OP_OUTLAT, OP_OUTCTX_N2LAT, OP_N2CTX, OP_UP, OP_ACT, OP_DOWNLAT, OP_DOWNCTX_N1LAT, OP_N1CTX}; op = t[q]; }
  else { const int t[5] = {OP_OUTLAT, OP_N2FULL, OP_UP, OP_ACT, OP_DOWNLAT}; op = t[q]; }
}
__device__ __forceinline__ void run_phase(const P& p0, int ph, char* lds, const XcdBarrier* xbp) {
  P p = p0; { size_t zoff = 0; asm volatile("" : "+s"(zoff)); p.ws = p0.ws + zoff; }
  int op, L; decode_phase(ph, op, L);
  const int e = L >> 1, o = L >> 1;
  bf16_t* W1 = (bf16_t*)(p.ws + OFF_WC); bf16_t* W2 = (bf16_t*)(p.ws + OFF_WC + WC_W2); bf16_t* W3 = (bf16_t*)(p.ws + OFF_W3);
  bf16_t* hb = (bf16_t*)(p.ws + OFF_HBF); float* xr = (float*)(p.ws + OFF_XRES);
  const float* mods = (const float*)(p.ws + OFF_MODS) + (size_t)L * 3 * 6144;
#define CVT_MIX(LL, skipb) do { const int L_ = (LL); if ((L_ & 1) == 0) { cvt_weight(p.rec_w_in + (size_t)(L_ >> 1) * 1024 * 3632, W1, 1024, 3632, NREC, true, skipb); cvt_weight(p.rec_w_out + (size_t)(L_ >> 1) * 1024 * 1024, W3, 1024, 1024, 1024, false, skipb); } \
    else { cvt_weight(p.att_w_qkv + (size_t)(L_ >> 1) * 1024 * 1536, W1, 1024, 1536, 1536, false, skipb); cvt_weight(p.att_w_out + (size_t)(L_ >> 1) * 1024 * 1024, W3, 1024, 1024, 1024, false, skipb); } } while (0)
#define CVT_FFN(LL, skipb) do { const int L_ = (LL); cvt_weight(p.ffn_w_up + (size_t)L_ * 1024 * 5632, W1, 1024, 5632, 5632, false, skipb); cvt_weight(p.ffn_w_down + (size_t)L_ * DFF * 1024, W2, DFF, 1024, 1024, false, skipb); } while (0)
  switch (op) {
    case OP_INIT: RUN(0, ph_init(p, lds); CVT_MIX(0, 0)); break;
    case OP_N1FULL: RUN(1, ph_norm(p, L, 0, 0, 0)); break;
    case OP_IN: RUN(2, gemm8(lds, hb, 1024, W1, 1024, NREC, 0, EpiRec8{(bf16_t*)(p.ws + OFF_D + D_P1), (bf16_t*)(p.ws + OFF_D + D_P2), (float*)(p.ws + OFF_SM)})); break;
    case OP_PREP: RUN(3, ph_dnprep(p, lds, e)); break;
    case OP_D1: RUN(4, ph_dn_d1(p, lds); ph_gla_b(p, lds, e)); break;
    case OP_SCAN: RUN(5, if (BIDX() < 64) { dn_scan(p, lds, BIDX()); } else if (BIDX() < 128) { gla_scan(p, lds, BIDX() - 64, e); });
        if (PROBE_REP == 55) { xcd_barrier(*xbp); if (BIDX() < 64) { dn_scan(p, lds, BIDX()); } }
        if (PROBE_REP == 56) { xcd_barrier(*xbp); if (BIDX() >= 64 && BIDX() < 128) { gla_scan(p, lds, BIDX() - 64, e); } }
        break;
    case OP_MERGE: RUN(7, ph_merge(p, e)); break;
    case OP_QKV: RUN(2, gemm8(lds, hb, 1024, W1, 1024, 1536, 0, EpiBf8{(bf16_t*)(p.ws + OFF_D), 1536})); break;
    case OP_QKNORM: if (EN(9)) ph_qknorm(p, lds, o); break;
    case OP_ATTN: RUN(10, ph_attn(p, lds, L != 3)); break;
    case OP_OUTLAT: if (EN(2)) { gemm8(lds, hb, 1024, W3, 1024, 1024, 1, EpiRes8{xr, mods + 2 * 1024}); if (L == 3) CVT_FFN(L, 0); } break;
    case OP_OUTCTX_N2LAT: if (EN(2)) { if (BIDX() < 8) gemm8(lds, hb, 1024, W3, 1024, 1024, 2, EpiRes8{xr, mods + 2 * 1024}); else ph_norm(p, L, 1, 1, 8); CVT_FFN(L, 8); } break;
    case OP_N2CTX: if (EN(1)) ph_norm(p, L, 1, 2, 0); break;
    case OP_N2FULL: if (EN(1)) ph_norm(p, L, 1, 0, 0); break;
    case OP_UP: RUN(2, gemm8(lds, hb, 1024, W1, 1024, 5632, L == 3 ? 1 : 0, EpiBf8{(bf16_t*)(p.ws + OFF_D), 5632})); break;
    case OP_ACT: if (EN(8)) ph_ffnact(p, L); break;
    case OP_DOWNLAT: if (EN(2)) gemm8(lds, (const bf16_t*)(p.ws + OFF_D) + DFF, 5632, W2, DFF, 1024, 1, EpiRes8{xr, mods + 5 * 1024}); break;
    case OP_DOWNCTX_N1LAT: if (EN(2)) { if (BIDX() < 8) gemm8(lds, (const bf16_t*)(p.ws + OFF_D) + DFF, 5632, W2, DFF, 1024, 2, EpiRes8{xr, mods + 5 * 1024}); else ph_norm(p, L + 1, 0, 1, 8); CVT_MIX(L + 1, 8); } break;
    case OP_N1CTX: if (EN(1)) ph_norm(p, L + 1, 0, 2, 0); break;
    case OP_FINAL: if (EN(11)) ph_final(p); break;
  }
#undef CVT_MIX
#undef CVT_FFN
}

template <bool COOP>
__global__ void __launch_bounds__(512, 1) mk_kernel(P p, int ph0, int ph1) {
  extern __shared__ __attribute__((aligned(16))) char smem[];
  if constexpr (COOP) {
    if (ph0 < 0) cg::this_grid().sync();
    volatile LAS unsigned* st = (volatile LAS unsigned*)(smem + LDS_BYTES);
    if (threadIdx.x < 4) st[threadIdx.x] = 0u;
    __syncthreads();
    XcdBarrier xb = xcd_barrier_post((unsigned*)(p.ws + OFF_BAR), st);
    for (int ph = ph0; ph < ph1; ++ph) {
      run_phase(p, ph, smem, &xb);
      if (ph + 1 < ph1) xcd_barrier(xb);
      if (PROBE_REP == 99 && ph == 0) { for (int q = 0; q < 20; ++q) xcd_barrier(xb); }
    }
  } else {
    for (int ph = ph0; ph < ph1; ++ph) run_phase(p, ph, smem, nullptr);
  }
}

extern "C" void kernel_launch(void* const* d_in, const int* in_sizes, int n_in, void* d_out, int out_size, void* d_ws, size_t ws_size, hipStream_t stream) {
  if (n_in != 23 || ws_size < WS_NEED) { fprintf(stderr, "kernel_launch: bad n_in %d or ws %zu < %zu\n", n_in, ws_size, (size_t)WS_NEED); return; }
  P p{};
  const float** f = (const float**)&p;
  for (int i = 0; i < 23; ++i) f[i] = (const float*)d_in[i];
  p.out = (float*)d_out; p.ws = (char*)d_ws;
  static int inited = 0, grid_blocks = 0;
  if (!inited) {
    hipFuncSetAttribute((const void*)mk_kernel<true>, hipFuncAttributeMaxDynamicSharedMemorySize, LDS_BYTES + 16);
    hipFuncSetAttribute((const void*)mk_kernel<false>, hipFuncAttributeMaxDynamicSharedMemorySize, LDS_BYTES);
    int dev = 0, cus = 0, per_cu = 0;
    hipGetDevice(&dev); hipDeviceGetAttribute(&cus, hipDeviceAttributeMultiprocessorCount, dev);
    hipOccupancyMaxActiveBlocksPerMultiprocessor(&per_cu, mk_kernel<true>, 512, LDS_BYTES + 16);
    if (per_cu > 1) per_cu = 1;
    grid_blocks = cus * per_cu; if (grid_blocks > 256) grid_blocks = 256; if (grid_blocks < 128) grid_blocks = 128;
    inited = 1;
  }
#if MK_COOP
  int ph0 = 0, ph1 = NPHASES;
  void* args[] = {&p, &ph0, &ph1};
  hipMemsetAsync((char*)d_ws + OFF_BAR, 0, 3456 * 4, stream);
  hipError_t er = hipLaunchCooperativeKernel((const void*)mk_kernel<true>, dim3(grid_blocks), dim3(512), args, LDS_BYTES + 16, stream);
  if (er != hipSuccess) fprintf(stderr, "cooperative launch failed: %s (grid %d)\n", hipGetErrorString(er), grid_blocks);
#else
  for (int ph = 0; ph < NPHASES; ++ph) hipLaunchKernelGGL(mk_kernel<false>, dim3(256), dim3(512), LDS_BYTES, stream, p, ph, ph + 1);
#endif
}
```

```cpp
#include <hip/hip_runtime.h>
#include <hip/hip_cooperative_groups.h>
#include <cstdio>
#include <cstdint>
namespace cg = cooperative_groups;

#ifndef MK_COOP
#define MK_COOP 1
#endif

typedef unsigned short bf16_t;
typedef short bf16x8 __attribute__((ext_vector_type(8)));
typedef short s16x4 __attribute__((ext_vector_type(4)));
typedef float f32x16 __attribute__((ext_vector_type(16)));
typedef float f32x8 __attribute__((ext_vector_type(8)));
typedef float f32x4 __attribute__((ext_vector_type(4)));
typedef unsigned u32x4 __attribute__((ext_vector_type(4)));
#define DI __device__ __forceinline__
#define LBAR() do { asm volatile("s_waitcnt lgkmcnt(0)" ::: "memory"); __builtin_amdgcn_s_barrier(); asm volatile("" ::: "memory"); } while (0)
#define MFMA32(a, b, c) __builtin_amdgcn_mfma_f32_32x32x16_bf16((a), (b), (c), 0, 0, 0)

constexpr int DM = 1024, TB = 8448, CTXL = 256, LAT = 8192, MROWS = 2 * TB;
constexpr int NCH = 132;
constexpr int DFF = 2816;
constexpr int NREC = 3840;
constexpr float EPSF = 1e-6f;

constexpr size_t AL(size_t x) { return (x + 255) / 256 * 256; }
constexpr size_t OFF_XRES = 0;
constexpr size_t OFF_HBF = OFF_XRES + AL((size_t)MROWS * DM * 4);
constexpr size_t OFF_WC = OFF_HBF + AL((size_t)MROWS * DM * 2);
constexpr size_t WC_W2 = (size_t)5632 * 1024 * 2;
constexpr size_t OFF_MODS = OFF_WC + AL(WC_W2 + (size_t)1024 * 2816 * 2);
constexpr size_t OFF_SM = OFF_MODS + AL((size_t)4 * 3 * 6144 * 4);
constexpr size_t OFF_GB = OFF_SM + AL((size_t)MROWS * 64 * 4);
constexpr size_t OFF_SC = OFF_GB + AL((size_t)MROWS * 16 * 4);
constexpr size_t OFF_GL = OFF_SC + AL((size_t)16 * NCH * 64 * 2 * 4);
constexpr size_t OFF_D = OFF_GL + AL((size_t)16 * NCH * 4);
constexpr size_t D_P1 = 0;
constexpr size_t D_W = 0;
constexpr size_t D_INTRA = D_W + (size_t)16 * NCH * 64 * 128 * 2;
constexpr size_t D_P2 = D_P1 + (size_t)MROWS * 1536 * 2;
constexpr size_t D_QQ = D_P2 + (size_t)MROWS * 2048 * 2;
constexpr size_t D_QK = D_QQ + (size_t)MROWS * 512 * 2;
constexpr size_t D_QV = D_QK + (size_t)MROWS * 512 * 2;
constexpr size_t D_DNO = D_QK;
constexpr size_t D_KT = D_QV + (size_t)MROWS * 512 * 2;
constexpr size_t D_GLAO = D_KT + (size_t)MROWS * 512 * 2;
constexpr size_t D_END_E = D_GLAO + (size_t)2 * MROWS * 512 * 2;
constexpr size_t D_END_F = (size_t)MROWS * 5632 * 2;
constexpr size_t OFF_B16_1 = OFF_D + (D_END_E > D_END_F ? D_END_E : D_END_F);
constexpr size_t B16_BYTES = (size_t)8 * NCH * 64 * 64 * 2;
constexpr size_t OFF_BAR = OFF_B16_1 + AL(B16_BYTES);
constexpr size_t OFF_W3 = OFF_BAR + AL(3456 * 4);
constexpr size_t WS_NEED = OFF_W3 + (size_t)1024 * 1024 * 2;
constexpr int LDS_BYTES = 132 * 1024;

struct P {
  const float *x, *c, *ctx, *c_ctx, *mod_w, *mod_b, *rec_w_in, *rec_conv, *dn_a_log, *dn_dt_bias, *dn_norm, *gla_w2, *gla_b2, *gla_norm,
      *rec_w_out, *att_w_qkv, *att_q_norm, *att_k_norm, *att_w_out, *ffn_w_up, *ffn_conv, *ffn_w_down, *final_norm;
  float* out;
  char* ws;
};

DI int TIDX() { int t = threadIdx.x; asm volatile("" : "+v"(t)); return t; }
DI int BIDX() { int t = blockIdx.x; asm volatile("" : "+s"(t)); return t; }
DI int GDIM() { int t = gridDim.x; asm volatile("" : "+s"(t)); return t; }
DI float bf2f(bf16_t v) { return __uint_as_float(((unsigned)v) << 16); }
DI bf16_t f2bf(float x) { unsigned u = __float_as_uint(x); u += 0x7fffu + ((u >> 16) & 1u); return (bf16_t)(u >> 16); }
DI unsigned cvtpk(float lo, float hi) { unsigned r; asm volatile("v_cvt_pk_bf16_f32 %0, %1, %2" : "=v"(r) : "v"(lo), "v"(hi)); return r; }
DI int crow(int r, int hi) { return (r & 3) + 8 * (r >> 2) + 4 * hi; }
DI float siluf(float x) { return x / (1.f + expf(-x)); }
DI float sigmf(float x) { return 1.f / (1.f + expf(-x)); }
DI float softplusf(float x) { return fmaxf(x, 0.f) + log1pf(expf(-fabsf(x))); }
DI float wave_sum(float v) {
#pragma unroll
  for (int o = 32; o > 0; o >>= 1) v += __shfl_xor(v, o);
  return v;
}
DI int modrow_of(int R) { const int b = R >= TB ? 1 : 0; const int pp = R - b * TB; return pp < CTXL ? 2 : b; }
template <int KS>
DI f32x16 mma_rows(const bf16_t* arow, const bf16_t* brow, f32x16 acc) {
#pragma unroll
  for (int ks = 0; ks < KS; ++ks) {
    const bf16x8 a = *reinterpret_cast<const bf16x8*>(arow + ks * 16);
    const bf16x8 b = *reinterpret_cast<const bf16x8*>(brow + ks * 16);
    acc = MFMA32(a, b, acc);
  }
  return acc;
}

#define XB_TMO      128
#define XB_XCNT(j)  (256  + 64 * (j))
#define XB_XSUB(j)  (1280 + 64 * (j))
#define XB_XGEN(j)  (2304 + 64 * (j))
#define XB_TOP      3328
#define XB_TOPGEN   3392
#define XCD_BAR_WORDS 3456
#define XB_SPIN_CAP (1u << 18)
#define LAS __attribute__((address_space(3)))
DI unsigned xb_ld(unsigned* p)              { return __hip_atomic_load(p, __ATOMIC_RELAXED, __HIP_MEMORY_SCOPE_AGENT); }
DI unsigned xb_add(unsigned* p, unsigned v) { return __hip_atomic_fetch_add(p, v, __ATOMIC_RELAXED, __HIP_MEMORY_SCOPE_AGENT); }
DI unsigned xb_xcc_id() { return (unsigned)__builtin_amdgcn_s_getreg((3 << 11) | 20) & 0xFu; }
#define XB_SPIN(cond, bar) do { unsigned _sp = 0; while (cond) { __builtin_amdgcn_s_sleep(1); \
    if ((++_sp & 255u) == 0u) { if (xb_ld(&(bar)[XB_TMO])) break; if (_sp > XB_SPIN_CAP) { atomicAdd(&(bar)[XB_TMO], 1u); break; } } } } while (0)
struct XcdBarrier { unsigned* bar; unsigned x; volatile LAS unsigned* st; };
DI XcdBarrier xcd_barrier_post(unsigned* bar, volatile LAS unsigned* st) {
    XcdBarrier b; b.bar = bar; b.x = xb_xcc_id(); b.st = st;
    if (threadIdx.x == 0) (void)xb_add(&bar[XB_XCNT(b.x)], 1u);
    return b;
}
DI void xcd_barrier_complete(unsigned* bar, unsigned x, unsigned& nloc, unsigned& nx) {
    const unsigned G = gridDim.x * gridDim.y * gridDim.z;
    unsigned sum, cnt, mine, sp = 0u;
    for (;;) {
        sum = 0u; cnt = 0u; mine = 0u;
#pragma unroll
        for (unsigned j = 0; j < 16; ++j) { const unsigned c = xb_ld(&bar[XB_XCNT(j)]); sum += c; cnt += (c > 0u) ? 1u : 0u; mine = (j == x) ? c : mine; }
        if (sum == G) break;
        __builtin_amdgcn_s_sleep(1);
        if ((++sp & 255u) == 0u) { if (xb_ld(&bar[XB_TMO])) break; if (sp > XB_SPIN_CAP) { atomicAdd(&bar[XB_TMO], 1u); break; } }
    }
    nloc = mine > 0u ? mine : 1u; nx = cnt > 0u ? cnt : 1u;
}
DI void xcd_barrier(const XcdBarrier& b) {
    asm volatile("s_waitcnt vmcnt(0)" ::: "memory");
    __syncthreads();
    if (threadIdx.x == 0) {
        unsigned* bar = b.bar;
        __builtin_amdgcn_s_waitcnt(0);
        unsigned nloc = b.st[0], nx = b.st[1];
        if (nloc == 0u) { xcd_barrier_complete(bar, b.x, nloc, nx); b.st[0] = nloc; b.st[1] = nx; }
        const unsigned old = xb_add(&bar[XB_XSUB(b.x)], 1u);
        const unsigned gen = old / nloc;
        if (old + 1u == (gen + 1u) * nloc) {
            __builtin_amdgcn_fence(__ATOMIC_RELEASE, "agent");
            asm volatile("s_waitcnt vmcnt(0)" ::: "memory");
            const unsigned og = xb_add(&bar[XB_TOP], 1u);
            const unsigned tg = og / nx;
            if (og + 1u == (tg + 1u) * nx) xb_add(&bar[XB_TOPGEN], 1u);
            else XB_SPIN(xb_ld(&bar[XB_TOPGEN]) == tg, bar);
            __builtin_amdgcn_fence(__ATOMIC_ACQUIRE, "agent");
            xb_add(&bar[XB_XGEN(b.x)], 1u);
            asm volatile("s_waitcnt vmcnt(0)" ::: "memory");
        } else {
            XB_SPIN(xb_ld(&bar[XB_XGEN(b.x)]) == gen, bar);
            __builtin_amdgcn_fence(__ATOMIC_ACQUIRE, "agent");
            asm volatile("s_waitcnt vmcnt(0)" ::: "memory");
        }
    }
    __syncthreads();
}

__device__ __forceinline__ void ph_init(const P& p, char* lds) {
  const int tid = TIDX();
  float* sc = (float*)lds;
  float* red = sc + 3072;
  for (int i = tid; i < 3072; i += 512) { const int r = i >> 10, k = i & 1023; const float v = r < 2 ? p.c[r * 1024 + k] : p.c_ctx[k]; sc[i] = siluf(v); }
  __syncthreads();
  float* mods = (float*)(p.ws + OFF_MODS);
  for (int job = BIDX(); job < 192; job += GDIM()) {
    const int col = job * 128 + (tid & 127), kq = tid >> 7;
    const int L = col / 6144, cl = col - L * 6144;
    const float* w = p.mod_w + ((size_t)L * 1024 + kq * 256) * 6144 + cl;
    float a0 = 0.f, a1 = 0.f, a2 = 0.f;
#pragma unroll 8
    for (int k = 0; k < 256; ++k) { const float wv = w[(size_t)k * 6144]; const int kk = kq * 256 + k; a0 += sc[kk] * wv; a1 += sc[1024 + kk] * wv; a2 += sc[2048 + kk] * wv; }
    red[(kq * 3 + 0) * 128 + (tid & 127)] = a0; red[(kq * 3 + 1) * 128 + (tid & 127)] = a1; red[(kq * 3 + 2) * 128 + (tid & 127)] = a2;
    __syncthreads();
    if (tid < 384) { const int r = tid >> 7, cc = tid & 127; const int c2 = job * 128 + cc; const int L2 = c2 / 6144, cl2 = c2 - L2 * 6144;
      const float s = red[(0 * 3 + r) * 128 + cc] + red[(1 * 3 + r) * 128 + cc] + red[(2 * 3 + r) * 128 + cc] + red[(3 * 3 + r) * 128 + cc] + p.mod_b[L2 * 6144 + cl2];
      mods[((size_t)L2 * 3 + r) * 6144 + cl2] = s; }
    __syncthreads();
  }
  f32x4* xr = (f32x4*)(p.ws + OFF_XRES);
  for (size_t i = (size_t)BIDX() * 512 + tid; i < (size_t)MROWS * 256; i += (size_t)GDIM() * 512) {
    const int R = (int)(i >> 8), c4 = (int)(i & 255); const int b = R >= TB ? 1 : 0, pp = R - b * TB;
    const float* src = pp < CTXL ? p.ctx + ((size_t)b * CTXL + pp) * 1024 : p.x + ((size_t)b * LAT + (pp - CTXL)) * 1024;
    xr[i] = *(const f32x4*)(src + c4 * 4);
  }
}

DI int rec_src_col(int n) { if (n < 2048) return n; if (n < 3584) return n + 16; if (n < 3600) return 2048 + (n - 3584); if (n < 3632) return n; return -1; }
__device__ __forceinline__ void cvt_weight(const float* __restrict__ W, bf16_t* __restrict__ Wt, int K, int Nsrc, int Npad, bool perm, int skipb) {
  const size_t items = (size_t)Npad * (K >> 3);
  const int bid = BIDX() - skipb, nb = GDIM() - skipb;
  if (bid < 0) return;
  for (size_t it = (size_t)bid * 512 + TIDX(); it < items; it += (size_t)nb * 512) {
    const int n = (int)(it % Npad), kb = (int)(it / Npad);
    const int s = perm ? rec_src_col(n) : n;
    float v[8];
#pragma unroll
    for (int j = 0; j < 8; ++j) v[j] = s >= 0 ? W[(size_t)(kb * 8 + j) * Nsrc + s] : 0.f;
    u32x4 w = {cvtpk(v[0], v[1]), cvtpk(v[2], v[3]), cvtpk(v[4], v[5]), cvtpk(v[6], v[7])};
    *(u32x4*)(Wt + (size_t)n * K + kb * 8) = w;
  }
}

__device__ __forceinline__ void gemm_ctx_split(char* lds, const bf16_t* __restrict__ A, int lda, const bf16_t* __restrict__ Bt, int ldb, int Ks, float* __restrict__ PART) {
  const int tid = TIDX(), wid = tid >> 6, lane = tid & 63, r32 = lane & 31, hi = lane >> 5;
  const int wm = wid >> 1, wn = wid & 1;
  const int nk = Ks >> 6;
  constexpr int RS = 144, ASZ = 256 * RS, BSZ = 128 * RS, STG = ASZ + BSZ;
  const int srow = tid >> 3, spc = tid & 7;
  const int w = BIDX(); const int ks = w >> 4, j = w & 15; const int pm = (j >> 3) ? 33 : 0, pn = j & 7;
  const bf16_t* Ab = A + (size_t)(pm * 256 + srow) * lda + (size_t)ks * Ks + spc * 8;
  const bf16_t* Bb = Bt + (size_t)(pn * 128 + srow) * ldb + (size_t)ks * Ks + spc * 8;
  f32x16 acc00 = {}, acc01 = {}, acc10 = {}, acc11 = {};
  bf16x8 ra0, ra1, ra2, ra3, rb0, rb1;
#define GLOAD(kt) do { const int ko = (kt) * 64; ra0 = *(const bf16x8*)(Ab + ko); ra1 = *(const bf16x8*)(Ab + (size_t)64 * lda + ko); ra2 = *(const bf16x8*)(Ab + (size_t)128 * lda + ko); \
    ra3 = *(const bf16x8*)(Ab + (size_t)192 * lda + ko); rb0 = *(const bf16x8*)(Bb + ko); rb1 = *(const bf16x8*)(Bb + (size_t)64 * ldb + ko); } while (0)
#define SWRITE(buf) do { char* sb = lds + (buf) * STG + srow * RS + spc * 16; *(bf16x8*)(sb) = ra0; *(bf16x8*)(sb + 64 * RS) = ra1; *(bf16x8*)(sb + 128 * RS) = ra2; *(bf16x8*)(sb + 192 * RS) = ra3; \
    *(bf16x8*)(sb + ASZ) = rb0; *(bf16x8*)(sb + ASZ + 64 * RS) = rb1; } while (0)
  GLOAD(0); SWRITE(0); __syncthreads();
  for (int kt = 0; kt < nk; ++kt) {
    const int cur = kt & 1;
    if (kt + 1 < nk) GLOAD(kt + 1);
    const char* ab = lds + cur * STG + (64 * wm + r32) * RS + hi * 16;
    const char* bb = lds + cur * STG + ASZ + (64 * wn + r32) * RS + hi * 16;
#pragma unroll
    for (int k4 = 0; k4 < 4; ++k4) {
      const bf16x8 a0 = *(const bf16x8*)(ab + k4 * 32), a1 = *(const bf16x8*)(ab + 32 * RS + k4 * 32);
      const bf16x8 b0 = *(const bf16x8*)(bb + k4 * 32), b1 = *(const bf16x8*)(bb + 32 * RS + k4 * 32);
      acc00 = MFMA32(a0, b0, acc00); acc01 = MFMA32(a0, b1, acc01); acc10 = MFMA32(a1, b0, acc10); acc11 = MFMA32(a1, b1, acc11);
    }
    if (kt + 1 < nk) SWRITE(cur ^ 1);
    __syncthreads();
  }
#undef GLOAD
#undef SWRITE
  float* pb = PART + ((size_t)ks * 512 + (pm ? 256 : 0) + 64 * wm) * 1024 + pn * 128 + 64 * wn + r32;
#pragma unroll
  for (int r = 0; r < 16; ++r) { float* q = pb + (size_t)crow(r, hi) * 1024;
    q[0] = acc00[r]; q[32] = acc01[r]; q[32 * 1024] = acc10[r]; q[32 * 1024 + 32] = acc11[r]; }
}

__device__ __forceinline__ void ph_ctx_fold_norm(const P& p, int L, int which, const float* __restrict__ part, int nsplit, const float* __restrict__ gate) {
  const int tid = TIDX(), wid = tid >> 6, lane = tid & 63;
  float* xr = (float*)(p.ws + OFF_XRES); bf16_t* hb = (bf16_t*)(p.ws + OFF_HBF);
  const float* mods = (const float*)(p.ws + OFF_MODS) + (size_t)L * 3 * 6144;
  for (int cr = BIDX() * 8 + wid; cr < 2 * CTXL; cr += GDIM() * 8) {
    const int R = cr < CTXL ? cr : TB + (cr - CTXL);
    float* row = xr + (size_t)R * 1024 + lane * 4;
    const float* pr = part + (size_t)cr * 1024 + lane * 4;
    f32x4 v[4], a[4];
#pragma unroll
    for (int i = 0; i < 4; ++i) { v[i] = *(const f32x4*)(row + i * 256); a[i] = *(const f32x4*)(pr + i * 256); }
    for (int sp = 1; sp < nsplit; ++sp) {
#pragma unroll
      for (int i = 0; i < 4; ++i) a[i] += *(const f32x4*)(pr + (size_t)sp * 512 * 1024 + i * 256);
    }
    float ss = 0.f;
#pragma unroll
    for (int i = 0; i < 4; ++i) { v[i] += *(const f32x4*)(gate + 2 * 6144 + i * 256 + lane * 4) * a[i]; *(f32x4*)(row + i * 256) = v[i];
      ss += v[i][0] * v[i][0] + v[i][1] * v[i][1] + v[i][2] * v[i][2] + v[i][3] * v[i][3]; }
    ss = wave_sum(ss);
    const float rs = rsqrtf(ss * (1.f / 1024.f) + EPSF);
    const float* mr = mods + (size_t)2 * 6144 + which * 3072 + lane * 4;
#pragma unroll
    for (int i = 0; i < 4; ++i) { const f32x4 sh = *(const f32x4*)(mr + i * 256), scl = *(const f32x4*)(mr + 1024 + i * 256);
      float o[4];
#pragma unroll
      for (int j = 0; j < 4; ++j) o[j] = v[i][j] * rs * (1.f + scl[j]) + sh[j];
      uint2 w; w.x = cvtpk(o[0], o[1]); w.y = cvtpk(o[2], o[3]);
      *(uint2*)(hb + (size_t)R * 1024 + i * 256 + lane * 4) = w; }
  }
}

__device__ __forceinline__ void ph_norm(const P& p, int L, int which, int mode, int skipb) {
  const int tid = TIDX(), wid = tid >> 6, lane = tid & 63, l16 = lane & 15, sub = lane >> 4;
  const float* xr = (const float*)(p.ws + OFF_XRES);
  bf16_t* hb = (bf16_t*)(p.ws + OFF_HBF);
  const float* mods = (const float*)(p.ws + OFF_MODS) + (size_t)L * 3 * 6144;
  const int bid = BIDX() - skipb, nb = GDIM() - skipb;
  if (bid < 0) return;
  const int nquads = mode == 0 ? MROWS / 4 : (mode == 1 ? 2 * LAT / 4 : 2 * CTXL / 4);
  for (int q = bid * 8 + wid; q < nquads; q += nb * 8) {
    int R4;
    if (mode == 0) R4 = q * 4; else if (mode == 1) R4 = q < LAT / 4 ? CTXL + q * 4 : TB + CTXL + (q - LAT / 4) * 4; else R4 = q < CTXL / 4 ? q * 4 : TB + (q - CTXL / 4) * 4;
    const int R = R4 + sub;
    const float* row = xr + (size_t)R * 1024 + l16 * 4;
    f32x4 v[16]; float ss = 0.f;
#pragma unroll
    for (int i = 0; i < 16; ++i) v[i] = *(const f32x4*)(row + i * 64);
#pragma unroll
    for (int i = 0; i < 16; ++i) ss += v[i][0] * v[i][0] + v[i][1] * v[i][1] + v[i][2] * v[i][2] + v[i][3] * v[i][3];
    ss += __shfl_xor(ss, 1); ss += __shfl_xor(ss, 2); ss += __shfl_xor(ss, 4); ss += __shfl_xor(ss, 8);
    const float rs = rsqrtf(ss * (1.f / 1024.f) + EPSF);
    const float* mr = mods + (size_t)modrow_of(R) * 6144 + which * 3072 + l16 * 4;
    bf16_t* dst = hb + (size_t)R * 1024 + l16 * 4;
#pragma unroll
    for (int i = 0; i < 16; ++i) { const f32x4 sh = *(const f32x4*)(mr + i * 64), scl = *(const f32x4*)(mr + 1024 + i * 64);
      float o[4];
#pragma unroll
      for (int j = 0; j < 4; ++j) o[j] = v[i][j] * rs * (1.f + scl[j]) + sh[j];
      uint2 w; w.x = cvtpk(o[0], o[1]); w.y = cvtpk(o[2], o[3]);
      *(uint2*)(dst + i * 64) = w; }
  }
}

struct EpiRec { bf16_t* P1; bf16_t* P2; float* SM;
  DI void operator()(int row, int col, float v) const {
    if (col < 1536) P1[(size_t)row * 1536 + col] = f2bf(v);
    else if (col < 3584) P2[(size_t)row * 2048 + (col - 1536)] = f2bf(v);
    else { const int lc = col - 3584; if (lc < 48) SM[(size_t)row * 64 + lc] = v; } } };
struct EpiBf { bf16_t* O; int ldc;
  DI void operator()(int row, int col, float v) const { O[(size_t)row * ldc + col] = f2bf(v); } };
struct EpiRes { float* X; const float* gate;
  DI void operator()(int row, int col, float v) const { float* q = X + (size_t)row * 1024 + col; *q = *q + gate[(size_t)modrow_of(row) * 6144 + col] * v; } };

template <class Epi>
__device__ __forceinline__ void gemm_phase(char* lds, const bf16_t* __restrict__ A, int lda, const bf16_t* __restrict__ Bt, int K, int nN, const Epi epi, bool skipctx = false) {
  const int tid = TIDX(), wid = tid >> 6, lane = tid & 63, r32 = lane & 31, hi = lane >> 5;
  const int wm = wid >> 1, wn = wid & 1;
  const int nk = K >> 6;
  constexpr int RS = 144, ASZ = 256 * RS, BSZ = 128 * RS, STG = ASZ + BSZ;
  const int ntiles = (skipctx ? 64 : MROWS / 256) * nN;
  const int srow = tid >> 3, spc = tid & 7;
  for (int t = BIDX(); t < ntiles; t += GDIM()) {
    int pm = t / nN; const int pn = t - pm * nN; if (skipctx) pm = pm + 1 + (pm >= 32 ? 1 : 0);
    const bf16_t* Ab = A + (size_t)(pm * 256 + srow) * lda + spc * 8;
    const bf16_t* Bb = Bt + (size_t)(pn * 128 + srow) * K + spc * 8;
    f32x16 acc00 = {}, acc01 = {}, acc10 = {}, acc11 = {};
    bf16x8 ra0, ra1, ra2, ra3, rb0, rb1;
#define GLOAD(kt) do { const int ko = (kt) * 64; ra0 = *(const bf16x8*)(Ab + ko); ra1 = *(const bf16x8*)(Ab + (size_t)64 * lda + ko); ra2 = *(const bf16x8*)(Ab + (size_t)128 * lda + ko); \
    ra3 = *(const bf16x8*)(Ab + (size_t)192 * lda + ko); rb0 = *(const bf16x8*)(Bb + ko); rb1 = *(const bf16x8*)(Bb + (size_t)64 * K + ko); } while (0)
#define SWRITE(buf) do { char* sb = lds + (buf) * STG + srow * RS + spc * 16; *(bf16x8*)(sb) = ra0; *(bf16x8*)(sb + 64 * RS) = ra1; *(bf16x8*)(sb + 128 * RS) = ra2; *(bf16x8*)(sb + 192 * RS) = ra3; \
    *(bf16x8*)(sb + ASZ) = rb0; *(bf16x8*)(sb + ASZ + 64 * RS) = rb1; } while (0)
    GLOAD(0); SWRITE(0); __syncthreads();
    for (int kt = 0; kt < nk; ++kt) {
      const int cur = kt & 1;
      if (kt + 1 < nk) GLOAD(kt + 1);
      const char* ab = lds + cur * STG + (64 * wm + r32) * RS + hi * 16;
      const char* bb = lds + cur * STG + ASZ + (64 * wn + r32) * RS + hi * 16;
#pragma unroll
      for (int ks = 0; ks < 4; ++ks) {
        const bf16x8 a0 = *(const bf16x8*)(ab + ks * 32), a1 = *(const bf16x8*)(ab + 32 * RS + ks * 32);
        const bf16x8 b0 = *(const bf16x8*)(bb + ks * 32), b1 = *(const bf16x8*)(bb + 32 * RS + ks * 32);
        acc00 = MFMA32(a0, b0, acc00); acc01 = MFMA32(a0, b1, acc01); acc10 = MFMA32(a1, b0, acc10); acc11 = MFMA32(a1, b1, acc11);
      }
      if (kt + 1 < nk) SWRITE(cur ^ 1);
      __syncthreads();
    }
#undef GLOAD
#undef SWRITE
    const int row0 = pm * 256 + 64 * wm, col0 = pn * 128 + 64 * wn + r32;
#pragma unroll
    for (int r = 0; r < 16; ++r) { const int rr = row0 + crow(r, hi);
      epi(rr, col0, acc00[r]); epi(rr, col0 + 32, acc01[r]); epi(rr + 32, col0, acc10[r]); epi(rr + 32, col0 + 32, acc11[r]); }
  }
}

namespace pg8 {
#define PG8_LAS __attribute__((address_space(3)))
constexpr int BM = 256, BK = 64, HALF = 128, HTB = HALF * BK * 2  , STAGE_BYTES = 8 * HTB, NXCD = 8, WGM = 8;

__host__ __device__ __forceinline__ int lds_byte(int r, int c) { const int st = (r >> 4) * 2 + (c >> 5), rr = r & 15, cc = c & 31, ob = rr * 64 + cc * 2; return st * 1024 + (ob ^ (((ob >> 9) & 1) << 5)); }
__host__ __device__ __forceinline__ void stage_rc(int b, int& R, int& C) { const int st = b / 1024, sb = b % 1024, swz = sb ^ (((sb >> 9) & 1) << 5); R = (st >> 1) * 16 + swz / 64; C = (st & 1) * 32 + (swz % 64) / 2; }
__host__ __device__ __forceinline__ int perm32(int rho) { const int n = rho >> 4, i = rho & 15; return 8 * (i >> 2) + 4 * n + (i & 3); }
struct Unit { int pm, pn; };
struct Gemm { const bf16_t* A; const bf16_t* Bt; int M, N, K, lda; };

struct StaticOrder {
    int nM, nN, nwg, G, c;
    __host__ __device__ void init(int M, int N, int G_, int c_) { nM = M / BM; nN = N / BM; nwg = nM * nN; G = G_; c = c_; }
    __host__ __device__ bool next(int i, Unit& u) const {
        const long L = (long)i * G + c; if (L >= nwg) return false;
        int wgid = (int)L; { const int q = nwg / NXCD, r = nwg % NXCD, xcd = wgid % NXCD, off = wgid / NXCD; wgid = (xcd < r ? xcd * (q + 1) : r * (q + 1) + (xcd - r) * q) + off; }
        const int nig = WGM * nN, gid = wgid / nig, fm = gid * WGM, gsz = (nM - fm) < WGM ? (nM - fm) : WGM;
        u.pm = fm + ((wgid % nig) % gsz); u.pn = (wgid % nig) / gsz; return true;
    }
    __device__ __forceinline__ void a_ready(const Unit&) const {}
    __device__ __forceinline__ void done(const Unit&) const {}
};
template <class Epi, class Sched, bool ALIGN_EPI = false, bool SP2 = false>
__device__ __forceinline__ void gemm_phase(PG8_LAS unsigned char* lds, const Gemm g, const Sched& S, const Epi& E) {
    const int tid = TIDX(), wid = __builtin_amdgcn_readfirstlane(tid >> 6), lane = tid & 63, wr = wid >> 2, wc = wid & 3, fr = lane & 15, fq = lane >> 4;
    const int K = g.K, nt = K / BK;
    unsigned voffA[2], voffB[2];
#pragma unroll
    for (int i = 0; i < 2; ++i) { int R, C; stage_rc(tid * 16 + i * 8192, R, C); const int Rb = Epi::PERM ? ((R & ~31) + perm32(R & 31)) : R;
        voffA[i] = (unsigned)(R * g.lda + C) * 2u; voffB[i] = (unsigned)(Rb * K + C) * 2u; }
    const size_t kstep = (size_t)(BK * 2);
    const size_t hstep = (size_t)HALF * K * 2;
    const size_t tstep = 2 * hstep; const size_t hstepA = (size_t)HALF * g.lda * 2, tstepA = 2 * hstepA;
    const unsigned ldsw = (unsigned)wid * 1024u;
    const int aoff = lds_byte(wr * 64 + fr, fq * 8), boff = lds_byte(wc * 32 + fr, fq * 8);
#define PG8_SA(b, h) (((b) * 2 + (h)) * HTB)
#define PG8_SB(b, h) ((4 + (b) * 2 + (h)) * HTB)
#define PG8_STAGE(bufoff, gbase, voff) do { _Pragma("unroll") for (int _i = 0; _i < 2; ++_i) \
        __builtin_amdgcn_global_load_lds((const unsigned*)((const char*)(gbase) + (voff)[_i]), (PG8_LAS unsigned*)(lds + (bufoff) + ldsw + _i * 8192), 16, 0, 0); } while (0)
#define PG8_LDA(dst, b, h) do { _Pragma("unroll") for (int m = 0; m < 4; ++m) _Pragma("unroll") for (int k = 0; k < 2; ++k) dst[m][k] = *(const PG8_LAS bf16x8*)(lds + PG8_SA(b, h) + aoff + m * 2048 + k * 1024); } while (0)
#define PG8_LDB(dst, b, h) do { _Pragma("unroll") for (int n = 0; n < 2; ++n) _Pragma("unroll") for (int k = 0; k < 2; ++k) dst[n][k] = *(const PG8_LAS bf16x8*)(lds + PG8_SB(b, h) + boff + n * 2048 + k * 1024); } while (0)
#define PG8_MMA(ai, bj, At, Bt) do { __builtin_amdgcn_s_setprio(1); _Pragma("unroll") for (int m = 0; m < 4; ++m) _Pragma("unroll") for (int n = 0; n < 2; ++n) _Pragma("unroll") for (int k = 0; k < 2; ++k) \
        acc[ai][bj][m][n] = __builtin_amdgcn_mfma_f32_16x16x32_bf16(Bt[n][k], At[m][k], acc[ai][bj][m][n], 0, 0, 0); __builtin_amdgcn_s_setprio(0); } while (0)
#define PG8_WAIT_V(n) asm volatile("s_waitcnt vmcnt(" #n ")" ::: "memory")
#define PG8_WAIT_L(n) asm volatile("s_waitcnt lgkmcnt(" #n ")" ::: "memory")
#define PG8_BAR __builtin_amdgcn_s_barrier()
#define PG8_SCHED __builtin_amdgcn_sched_barrier(0)
    Unit cur, nxt; int ui = 0;
    if (!S.next(0, cur)) return;
    f32x4 acc[2][2][4][2];
#pragma unroll
    for (int a = 0; a < 2; ++a)
#pragma unroll
        for (int b = 0; b < 2; ++b)
#pragma unroll
            for (int m = 0; m < 4; ++m)
#pragma unroll
                for (int n = 0; n < 2; ++n) acc[a][b][m][n] = (f32x4){0.f, 0.f, 0.f, 0.f};
    bf16x8 At[4][2], B0[2][2], B1[2][2];
    const char* cA = (const char*)g.A + (size_t)cur.pm * tstepA; const char* cB = (const char*)g.Bt + (size_t)cur.pn * tstep;
    S.a_ready(cur);
    if constexpr (SP2) {
        PG8_STAGE(PG8_SB(0, 0), cB, voffB); PG8_STAGE(PG8_SB(0, 1), cB + hstep, voffB); PG8_STAGE(PG8_SA(0, 0), cA, voffA); PG8_STAGE(PG8_SA(0, 1), cA + hstepA, voffA);
        if (wr == 1) PG8_BAR;
        PG8_WAIT_V(2); PG8_BAR;
        PG8_STAGE(PG8_SB(1, 0), cB + kstep, voffB); PG8_STAGE(PG8_SA(1, 0), cA + kstep, voffA); PG8_STAGE(PG8_SB(1, 1), cB + hstep + kstep, voffB);
        PG8_WAIT_V(6); PG8_BAR;
    } else {
        PG8_STAGE(PG8_SB(0, 0), cB, voffB); PG8_STAGE(PG8_SA(0, 0), cA, voffA); PG8_STAGE(PG8_SB(0, 1), cB + hstep, voffB); PG8_STAGE(PG8_SA(0, 1), cA + hstepA, voffA);
        if (wr == 1) PG8_BAR;
        PG8_WAIT_V(4); PG8_BAR;
        PG8_STAGE(PG8_SB(1, 0), cB + kstep, voffB); PG8_STAGE(PG8_SA(1, 0), cA + kstep, voffA); PG8_STAGE(PG8_SB(1, 1), cB + hstep + kstep, voffB);
        PG8_WAIT_V(6); PG8_BAR;
    }
    for (;;) {
        const bool has_next = S.next(ui + 1, nxt);
        const char* nA = has_next ? (const char*)g.A + (size_t)nxt.pm * tstepA : cA; const char* nB = has_next ? (const char*)g.Bt + (size_t)nxt.pn * tstep : cB;
        for (int t = 0; t < nt; t += 2) {
            const bool last = (t == nt - 2);
            const char* a1 = cA + (size_t)(t + 1) * kstep;
            const char* a2 = last ? nA : cA + (size_t)(t + 2) * kstep; const char* b2 = last ? nB : cB + (size_t)(t + 2) * kstep;
            const char* a3 = a2 + kstep; const char* b3 = b2 + kstep;
            if (last && has_next) S.a_ready(nxt);
            if constexpr (SP2) {
            PG8_LDB(B0, 0, 0); PG8_LDB(B1, 0, 1); PG8_SCHED; PG8_LDA(At, 0, 0); PG8_STAGE(PG8_SA(1, 1), a1 + hstepA, voffA);
            PG8_WAIT_V(8); PG8_WAIT_L(0); PG8_BAR; PG8_MMA(0, 0, At, B0); PG8_MMA(0, 1, At, B1); PG8_BAR; PG8_SCHED;
            PG8_LDA(At, 0, 1); PG8_STAGE(PG8_SB(0, 0), b2, voffB); PG8_STAGE(PG8_SB(0, 1), b2 + hstep, voffB); PG8_STAGE(PG8_SA(0, 0), a2, voffA);
            PG8_WAIT_V(8); PG8_WAIT_L(0); PG8_BAR; PG8_MMA(1, 0, At, B0); PG8_MMA(1, 1, At, B1); PG8_BAR; PG8_SCHED;
            PG8_LDB(B0, 1, 0); PG8_LDB(B1, 1, 1); PG8_SCHED; PG8_LDA(At, 1, 0); PG8_STAGE(PG8_SA(0, 1), a2 + hstepA, voffA);
            PG8_WAIT_V(8); PG8_WAIT_L(0); PG8_BAR; PG8_MMA(0, 0, At, B0); PG8_MMA(0, 1, At, B1); PG8_BAR; PG8_SCHED;
            PG8_LDA(At, 1, 1); PG8_STAGE(PG8_SB(1, 0), b3, voffB); PG8_STAGE(PG8_SB(1, 1), b3 + hstep, voffB); PG8_STAGE(PG8_SA(1, 0), a3, voffA);
            PG8_WAIT_V(8); PG8_WAIT_L(0); PG8_BAR; PG8_MMA(1, 0, At, B0); PG8_MMA(1, 1, At, B1); PG8_BAR; PG8_SCHED;
            } else {
            PG8_LDB(B0, 0, 0); PG8_SCHED; PG8_LDA(At, 0, 0); PG8_STAGE(PG8_SA(1, 1), a1 + hstepA, voffA);
            PG8_WAIT_L(8); PG8_BAR; PG8_WAIT_L(0); PG8_MMA(0, 0, At, B0); PG8_BAR; PG8_SCHED;
            PG8_LDB(B1, 0, 1); PG8_STAGE(PG8_SB(0, 0), b2, voffB);
            PG8_BAR; PG8_WAIT_L(0); PG8_MMA(0, 1, At, B1); PG8_BAR;
            PG8_LDA(At, 0, 1); PG8_STAGE(PG8_SA(0, 0), a2, voffA);
            PG8_BAR; PG8_WAIT_L(0); PG8_MMA(1, 0, At, B0); PG8_BAR; PG8_SCHED;
            PG8_STAGE(PG8_SB(0, 1), b2 + hstep, voffB);
            PG8_WAIT_V(6); PG8_BAR; PG8_MMA(1, 1, At, B1); PG8_BAR;
            PG8_LDB(B0, 1, 0); PG8_SCHED; PG8_LDA(At, 1, 0); PG8_STAGE(PG8_SA(0, 1), a2 + hstepA, voffA);
            PG8_WAIT_L(8); PG8_BAR; PG8_WAIT_L(0); PG8_MMA(0, 0, At, B0); PG8_BAR; PG8_SCHED;
            PG8_LDB(B1, 1, 1); PG8_STAGE(PG8_SB(1, 0), b3, voffB);
            PG8_BAR; PG8_WAIT_L(0); PG8_MMA(0, 1, At, B1); PG8_BAR;
            PG8_LDA(At, 1, 1); PG8_STAGE(PG8_SA(1, 0), a3, voffA);
            PG8_BAR; PG8_WAIT_L(0); PG8_MMA(1, 0, At, B0); PG8_BAR; PG8_SCHED;
            PG8_STAGE(PG8_SB(1, 1), b3 + hstep, voffB);
            PG8_WAIT_V(6); PG8_BAR; PG8_MMA(1, 1, At, B1); PG8_BAR;
            }
        }
        if constexpr (ALIGN_EPI) { if (wr == 0) PG8_BAR; }
        if constexpr (!Epi::AFTER_DRAIN) { E(acc, cur, wr, wc, fr, fq); S.done(cur); }
        if (!has_next) break;
#pragma unroll
        for (int a = 0; a < 2; ++a)
#pragma unroll
            for (int b = 0; b < 2; ++b)
#pragma unroll
                for (int m = 0; m < 4; ++m)
#pragma unroll
                    for (int n = 0; n < 2; ++n) acc[a][b][m][n] = (f32x4){0.f, 0.f, 0.f, 0.f};
        cur = nxt; cA = nA; cB = nB; ++ui;
        if constexpr (ALIGN_EPI) { if (wr == 1) PG8_BAR; }
    }
    PG8_WAIT_V(0);
    if constexpr (!ALIGN_EPI) { if (wr == 0) PG8_BAR; }
    PG8_BAR;
    if constexpr (Epi::AFTER_DRAIN) { E.fused(acc, cur, wr, wc, fr, fq, lds, wid, lane); S.done(cur); }
#undef PG8_SA
#undef PG8_SB
#undef PG8_STAGE
#undef PG8_LDA
#undef PG8_LDB
#undef PG8_MMA
#undef PG8_WAIT_V
#undef PG8_WAIT_L
#undef PG8_BAR
#undef PG8_SCHED
}
struct SchedX { StaticOrder so; int mode;
  __device__ __forceinline__ bool next(int i, Unit& u) const {
    if (mode == 2) { if (i != 0 || so.c >= 8) return false; u.pm = (so.c >> 2) ? 33 : 0; u.pn = so.c & 3; return true; }
    if (!so.next(i, u)) return false; if (mode == 1) u.pm = u.pm + 1 + (u.pm >= 32 ? 1 : 0); return true; }
  __device__ __forceinline__ void a_ready(const Unit&) const {}
  __device__ __forceinline__ void done(const Unit&) const {} };
}
struct EpiRec8 { static constexpr bool PERM = false, AFTER_DRAIN = false; bf16_t* P1; bf16_t* P2; float* SM;
  DI void operator()(const f32x4 (&acc)[2][2][4][2], const pg8::Unit& u, int wr, int wc, int fr, int fq) const {
#pragma unroll
    for (int ai = 0; ai < 2; ++ai)
#pragma unroll
      for (int m = 0; m < 4; ++m) { const size_t row = (size_t)u.pm * 256 + ai * 128 + wr * 64 + m * 16 + fr;
#pragma unroll
        for (int bj = 0; bj < 2; ++bj)
#pragma unroll
          for (int n = 0; n < 2; ++n) { const int col = u.pn * 256 + bj * 128 + wc * 32 + n * 16 + fq * 4; const f32x4 v = acc[ai][bj][m][n];
            if (u.pn < 6) { uint2 w; w.x = cvtpk(v[0], v[1]); w.y = cvtpk(v[2], v[3]); *(uint2*)(P1 + row * 1536 + col) = w; }
            else if (u.pn < 14) { uint2 w; w.x = cvtpk(v[0], v[1]); w.y = cvtpk(v[2], v[3]); *(uint2*)(P2 + row * 2048 + (col - 1536)) = w; }
            else { const int lc = col - 3584; if (lc < 48) *(f32x4*)(SM + row * 64 + lc) = v; } } } } };
struct EpiBf8 { static constexpr bool PERM = false, AFTER_DRAIN = false; bf16_t* O; int ldc;
  DI void operator()(const f32x4 (&acc)[2][2][4][2], const pg8::Unit& u, int wr, int wc, int fr, int fq) const {
#pragma unroll
    for (int ai = 0; ai < 2; ++ai)
#pragma unroll
      for (int m = 0; m < 4; ++m) { const size_t row = (size_t)u.pm * 256 + ai * 128 + wr * 64 + m * 16 + fr;
#pragma unroll
        for (int bj = 0; bj < 2; ++bj)
#pragma unroll
          for (int n = 0; n < 2; ++n) { const int col = u.pn * 256 + bj * 128 + wc * 32 + n * 16 + fq * 4; const f32x4 v = acc[ai][bj][m][n];
            uint2 w; w.x = cvtpk(v[0], v[1]); w.y = cvtpk(v[2], v[3]); *(uint2*)(O + row * ldc + col) = w; } } } };
struct EpiRes8 { static constexpr bool PERM = false, AFTER_DRAIN = false; float* X; const float* gate;
  DI void operator()(const f32x4 (&acc)[2][2][4][2], const pg8::Unit& u, int wr, int wc, int fr, int fq) const {
    const float* gr = gate + (size_t)modrow_of(u.pm * 256) * 6144;
#pragma unroll
    for (int bj = 0; bj < 2; ++bj)
#pragma unroll
      for (int n = 0; n < 2; ++n) { const int col = u.pn * 256 + bj * 128 + wc * 32 + n * 16 + fq * 4; const f32x4 gv = *(const f32x4*)(gr + col);
#pragma unroll
        for (int ai = 0; ai < 2; ++ai)
#pragma unroll
          for (int m = 0; m < 4; ++m) { const size_t row = (size_t)u.pm * 256 + ai * 128 + wr * 64 + m * 16 + fr;
            f32x4* q = (f32x4*)(X + row * 1024 + col); *q = *q + gv * acc[ai][bj][m][n]; } } } };
template <class Epi>
__device__ __forceinline__ void gemm8(char* lds, const bf16_t* A, int lda, const bf16_t* Bt, int K, int N, int mode, const Epi& E) {
  pg8::Gemm g{A, Bt, mode == 1 ? 16384 : MROWS, N, K, lda};
  pg8::SchedX S; S.so.init(g.M, N, GDIM(), BIDX()); S.mode = mode;
  pg8::gemm_phase<Epi, pg8::SchedX, true, true>((PG8_LAS unsigned char*)lds, g, S, E);
}

__device__ __forceinline__ void ph_dnprep(const P& p, char* lds, int e) {
  const int tid = TIDX(), wid = tid >> 6, lane = tid & 63;
  const bf16_t* P1 = (const bf16_t*)(p.ws + OFF_D + D_P1);
  bf16_t* QQ = (bf16_t*)(p.ws + OFF_D + D_QQ); bf16_t* QK = (bf16_t*)(p.ws + OFF_D + D_QK); bf16_t* QV = (bf16_t*)(p.ws + OFF_D + D_QV);
  bf16_t* KT = (bf16_t*)(p.ws + OFF_D + D_KT);
  const float* SM = (const float*)(p.ws + OFF_SM); float* GB = (float*)(p.ws + OFF_GB);
  const float* cw = p.rec_conv + (size_t)e * 3 * 1536;
  bf16_t* kl = (bf16_t*)lds;
  for (int job = BIDX(); job < MROWS / 64; job += GDIM()) {
    const int R0 = job * 64;
    for (int tt = 0; tt < 8; ++tt) {
      const int tl = wid * 8 + tt, R = R0 + tl; const int b = R >= TB ? 1 : 0, pp = R - b * TB;
      const bool hasp = !(pp == 0 || pp == CTXL), hasn = !(pp == CTXL - 1 || pp == TB - 1);
#pragma unroll
      for (int part = 0; part < 3; ++part) {
        const int ch = part * 512 + lane * 8;
        const bf16x8 zc = *(const bf16x8*)(P1 + (size_t)R * 1536 + ch);
        bf16x8 zp = {}, zn = {};
        if (hasp) zp = *(const bf16x8*)(P1 + (size_t)(R - 1) * 1536 + ch);
        if (hasn) zn = *(const bf16x8*)(P1 + (size_t)(R + 1) * 1536 + ch);
        float o[8]; float ss = 0.f;
#pragma unroll
        for (int j = 0; j < 8; ++j) { const float a = bf2f((bf16_t)zp[j]) * cw[ch + j] + bf2f((bf16_t)zc[j]) * cw[1536 + ch + j] + bf2f((bf16_t)zn[j]) * cw[3072 + ch + j];
          o[j] = siluf(a); ss += o[j] * o[j]; }
        if (part < 2) {
          ss += __shfl_xor(ss, 1); ss += __shfl_xor(ss, 2); ss += __shfl_xor(ss, 4); ss += __shfl_xor(ss, 8);
          float sc = rsqrtf(ss + EPSF); if (part == 0) sc *= 0.08838834764831845f;
#pragma unroll
          for (int j = 0; j < 8; ++j) o[j] *= sc;
        }
        u32x4 w = {cvtpk(o[0], o[1]), cvtpk(o[2], o[3]), cvtpk(o[4], o[5]), cvtpk(o[6], o[7])};
        bf16_t* dst = part == 0 ? QQ : (part == 1 ? QK : QV);
        *(u32x4*)(dst + (size_t)R * 512 + lane * 8) = w;
        if (part == 1) *(u32x4*)(kl + tl * 512 + lane * 8) = w;
      }
      if (lane < 16) {
        const int q = lane & 7;
        if (lane < 8) { const float da = SM[(size_t)R * 64 + q]; GB[(size_t)R * 16 + q] = -expf(p.dn_a_log[e * 8 + q]) * softplusf(da + p.dn_dt_bias[e * 8 + q]); }
        else { const float db = SM[(size_t)R * 64 + 8 + q]; GB[(size_t)R * 16 + 8 + q] = sigmf(db); }
      }
    }
    __syncthreads();
    {
      const int b = R0 >= TB ? 1 : 0, c = (R0 - b * TB) / 64; const int h = tid >> 7, dk = tid & 127;
      bf16_t* dst = KT + ((((size_t)b * 4 + h) * NCH + c) * 128 + dk) * 64;
#pragma unroll
      for (int g8 = 0; g8 < 8; ++g8) { unsigned w[4];
#pragma unroll
        for (int j = 0; j < 4; ++j) { const unsigned lo = kl[(g8 * 8 + 2 * j) * 512 + tid], hi2 = kl[(g8 * 8 + 2 * j + 1) * 512 + tid]; w[j] = lo | (hi2 << 16); }
        *(u32x4*)(dst + g8 * 8) = (u32x4){w[0], w[1], w[2], w[3]}; }
    }
    __syncthreads();
  }
}

__device__ __forceinline__ void ph_dn_d1(const P& p, char* lds) {
  const int tid = TIDX(), wid = tid >> 6, lane = tid & 63, r32 = lane & 31, hi = lane >> 5;
  const bf16_t* QQ = (const bf16_t*)(p.ws + OFF_D + D_QQ); const bf16_t* QK = (const bf16_t*)(p.ws + OFF_D + D_QK); const bf16_t* QV = (const bf16_t*)(p.ws + OFF_D + D_QV);
  const float* GB = (const float*)(p.ws + OFF_GB);
  bf16_t* W_ = (bf16_t*)(p.ws + OFF_D + D_W); bf16_t* U_ = (bf16_t*)(p.ws + OFF_HBF); bf16_t* INTRA = (bf16_t*)(p.ws + OFF_D + D_INTRA);
  float* SC = (float*)(p.ws + OFF_SC); float* GLS = (float*)(p.ws + OFF_GL);
  float* KK = (float*)lds; float* QKm = KK + 64 * 65; float* Ad = QKm + 64 * 65; float* Gs = Ad + 2 * 4096; float* Bs = Gs + 128;
  bf16_t* Vs = (bf16_t*)(Bs + 128); bf16_t* Ks = Vs + 64 * 128;
  for (int job = BIDX(); job < 8 * NCH; job += GDIM()) {
    const int b = job / (4 * NCH), h = (job / NCH) & 3, c = job % NCH;
    const size_t Rb = (size_t)b * TB + (size_t)c * 64;
    {
      const int srow = tid >> 4, spc = (tid & 15) * 8;
      const u32x4 v0 = *(const u32x4*)(QV + (Rb + srow) * 512 + h * 128 + spc), v1 = *(const u32x4*)(QV + (Rb + 32 + srow) * 512 + h * 128 + spc);
      const u32x4 k0 = *(const u32x4*)(QK + (Rb + srow) * 512 + h * 128 + spc), k1 = *(const u32x4*)(QK + (Rb + 32 + srow) * 512 + h * 128 + spc);
      *(u32x4*)(Vs + srow * 128 + spc) = v0; *(u32x4*)(Vs + (32 + srow) * 128 + spc) = v1;
      *(u32x4*)(Ks + srow * 128 + spc) = k0; *(u32x4*)(Ks + (32 + srow) * 128 + spc) = k1;
    }
    {
      const int w4 = wid & 3, mi = w4 & 1, ni = w4 >> 1;
      const bf16_t* As = wid < 4 ? QK : QQ;
      const bf16_t* arow = As + (Rb + 32 * mi + r32) * 512 + h * 128 + hi * 8;
      const bf16_t* brow = QK + (Rb + 32 * ni + r32) * 512 + h * 128 + hi * 8;
      f32x16 acc = {}; acc = mma_rows<8>(arow, brow, acc);
      float* dst = wid < 4 ? KK : QKm;
#pragma unroll
      for (int r = 0; r < 16; ++r) dst[(32 * mi + crow(r, hi)) * 65 + 32 * ni + r32] = acc[r];
    }
    if (tid < 128) { const int d = tid >> 6, ip = tid & 63, t = d ? 63 - ip : ip; float g = GB[(Rb + t) * 16 + d * 4 + h]; Bs[tid] = GB[(Rb + t) * 16 + 8 + d * 4 + h];
#pragma unroll
      for (int o = 1; o < 64; o <<= 1) { const float v = __shfl_up(g, o); g += ip >= o ? v : 0.f; }
      Gs[tid] = g; }
    __syncthreads();
    const int n0 = c, n1 = c < 4 ? 3 - c : 135 - c;
    const size_t cj0 = ((size_t)(0 * 2 + b) * 4 + h) * NCH + n0, cj1 = ((size_t)(1 * 2 + b) * 4 + h) * NCH + n1;
    for (int e2 = tid; e2 < 8192; e2 += 512) {
      const int d = e2 >> 12, ip = (e2 >> 6) & 63, jp = e2 & 63; const int i = d ? 63 - ip : ip, j = d ? 63 - jp : jp;
      const float dec = jp <= ip ? __expf(Gs[d * 64 + ip] - Gs[d * 64 + jp]) : 0.f;
      Ad[d * 4096 + ip * 64 + jp] = jp < ip ? Bs[d * 64 + ip] * KK[i * 65 + j] * dec : 0.f;
      const size_t cj = d ? cj1 : cj0;
      INTRA[(cj * 64 + ip) * 64 + jp] = f2bf(QKm[i * 65 + j] * dec);
    }
    if (tid < 128) { const int d = tid >> 6, ip = tid & 63; const size_t cj = d ? cj1 : cj0; const float gi = Gs[tid], gl = Gs[d * 64 + 63];
      SC[(cj * 64 + ip) * 2] = __expf(gi); SC[(cj * 64 + ip) * 2 + 1] = __expf(gl - gi); if (ip == 0) GLS[cj] = __expf(gl); }
    __syncthreads();
    {
      const int d = tid >> 8, cc = tid & 255; const size_t cj = d ? cj1 : cj0;
      int dofs = d * 64, aofs = d * 4096; asm volatile("" : "+v"(dofs), "+v"(aofs));
      float x[64];
      {
        int vofs = cc < 128 ? cc : 64 * 128 + (cc - 128); asm volatile("" : "+v"(vofs));
#pragma unroll
        for (int ip = 0; ip < 64; ++ip) x[ip] = bf2f(Vs[vofs + ip * 128]);
#pragma unroll
        for (int ip = 0; ip < 32; ++ip) { const float a_ = x[ip], b_ = x[63 - ip]; x[ip] = d ? b_ : a_; x[63 - ip] = d ? a_ : b_; }
        if (cc < 128) {
#pragma unroll
          for (int ip = 0; ip < 64; ++ip) x[ip] *= Bs[dofs + ip];
        } else {
#pragma unroll
          for (int ip = 0; ip < 64; ++ip) x[ip] *= Bs[dofs + ip] * __expf(Gs[dofs + ip]);
        }
      }
      const float* Arow = Ad + aofs;
#pragma unroll
      for (int ip = 1; ip < 64; ++ip) {
        float s = 0.f;
#pragma unroll
        for (int j4 = 0; j4 < (ip + 3) / 4; ++j4) { const f32x4 a = *(const f32x4*)(Arow + ip * 64 + 4 * j4);
          s += a[0] * x[4 * j4] + a[1] * x[4 * j4 + 1] + a[2] * x[4 * j4 + 2] + a[3] * x[4 * j4 + 3]; }
        x[ip] -= s;
      }
      bf16_t* dst = cc < 128 ? U_ + cj * 64 * 128 + cc : W_ + cj * 64 * 128 + (cc - 128);
#pragma unroll
      for (int ip = 0; ip < 64; ++ip) dst[ip * 128] = f2bf(x[ip]);
    }
    __syncthreads();
  }
}

typedef _Float16 h16x8 __attribute__((ext_vector_type(8)));
__device__ __forceinline__ void ph_gla_b(const P& p, char* lds, int e) {
  const int tid = TIDX(), wid = tid >> 6, lane = tid & 63;
  const float* SM = (const float*)(p.ws + OFF_SM);
  float* w2S = (float*)lds;
  float* b2S = w2S + 8192;
  for (int i = tid; i < 8192; i += 512) { const int d = i >> 12, hh = (i >> 10) & 3, r = (i >> 6) & 15, j = i & 63; w2S[i] = p.gla_w2[(((size_t)e * 2 + d) * 16 + r) * 256 + hh * 64 + j]; }
  if (tid < 512) b2S[tid] = p.gla_b2[(size_t)e * 512 + tid];
  __syncthreads();
  int jb = 8 * wid; asm volatile("" : "+v"(jb));
  for (int job = BIDX(); job < 16 * NCH; job += GDIM()) {
    const int n = job % NCH, sq = job / NCH; const int dir = sq >> 3, b = (sq >> 2) & 1, h = sq & 3;
    const int c = dir == 0 ? n : (n < 4 ? 3 - n : 135 - n);
    const size_t row = (size_t)b * TB + (size_t)c * 64 + (dir ? 63 - lane : lane);
    const float* gp = SM + row * 64 + 16 + dir * 16;
    const f32x4 g0 = *(const f32x4*)(gp), g1 = *(const f32x4*)(gp + 4), g2 = *(const f32x4*)(gp + 8), g3 = *(const f32x4*)(gp + 12);
    const float gg_[16] = {g0[0], g0[1], g0[2], g0[3], g1[0], g1[1], g1[2], g1[3], g2[0], g2[1], g2[2], g2[3], g3[0], g3[1], g3[2], g3[3]};
    const float* wb = w2S + (dir * 4 + h) * 1024 + jb; const float* bb2 = b2S + dir * 256 + h * 64 + jb;
    f32x4 sa = *(const f32x4*)(bb2), sb = *(const f32x4*)(bb2 + 4);
#pragma unroll
    for (int r = 0; r < 16; ++r) { const f32x4 wa = *(const f32x4*)(wb + r * 64), wq = *(const f32x4*)(wb + r * 64 + 4); sa += gg_[r] * wa; sb += gg_[r] * wq; }
    float la[8];
#pragma unroll
    for (int jj = 0; jj < 4; ++jj) { const float x0 = sa[jj], x1 = sb[jj];
      la[jj] = (fminf(x0, 0.f) - log1pf(expf(-fabsf(x0)))) * 0.0625f; la[4 + jj] = (fminf(x1, 0.f) - log1pf(expf(-fabsf(x1)))) * 0.0625f; }
#pragma unroll
    for (int o = 1; o < 64; o <<= 1) {
#pragma unroll
      for (int jj = 0; jj < 8; ++jj) { const float v = __shfl_up(la[jj], o); la[jj] += lane >= o ? v : 0.f; }
    }
    h16x8 hv;
#pragma unroll
    for (int jj = 0; jj < 8; ++jj) hv[jj] = (_Float16)la[jj];
    _Float16* dst = (_Float16*)(p.ws + (dir ? OFF_B16_1 : OFF_WC)) + ((((size_t)b * 4 + h) * NCH + n) * 64 + lane) * 64 + jb;
    *(h16x8*)dst = hv;
  }
}

struct DnSet { bf16x8 fa[8]; };
template <int ROLE>
__device__ __forceinline__ void dn_scan_t(const P& p, char* lds, int job) {
  const int tid = TIDX(), wid = tid >> 6, lane = tid & 63, r32 = lane & 31, hi = lane >> 5;
  const int dir = job >> 5, b = (job >> 4) & 1, h = (job >> 2) & 3, n0 = (job & 3) * 32;
  const bf16_t* QQ = (const bf16_t*)(p.ws + OFF_D + D_QQ); const bf16_t* KT = (const bf16_t*)(p.ws + OFF_D + D_KT);
  const bf16_t* W_ = (const bf16_t*)(p.ws + OFF_D + D_W); const bf16_t* U_ = (const bf16_t*)(p.ws + OFF_HBF); const bf16_t* INTRA = (const bf16_t*)(p.ws + OFF_D + D_INTRA);
  const float* SC = (const float*)(p.ws + OFF_SC); const float* GLS = (const float*)(p.ws + OFF_GL);
  bf16_t* DNO = (bf16_t*)(p.ws + OFF_D + D_DNO);
  bf16_t* ST = (bf16_t*)lds; bf16_t* vTa = ST + 32 * 136; bf16_t* vTb = vTa + 32 * 72;
  float* scS = (float*)(vTb + 32 * 72);
  bf16_t* uS = (bf16_t*)(scS + 256);
  bf16_t* inS = uS + 2 * 64 * 40;
  for (int i = tid; i < 32 * 136; i += 512) ST[i] = 0;
  f32x16 accS = {};
  const size_t seq = ((size_t)dir * 2 + b) * 4 + h;
  const int mi = wid & 1, di = wid - 4;
  constexpr int role = ROLE;
  const int tt = tid - 256;
  DnSet fs[3]; float gls[3] = {0.f, 0.f, 0.f};
  u32x4 stU[3], stI0[3]; float stS[3] = {0.f, 0.f, 0.f};
#define DN_CH(n_) const int n__ = (n_); const int c__ = dir == 0 ? n__ : (n__ < 4 ? 3 - n__ : 135 - n__); const size_t Rb__ = (size_t)b * TB + (size_t)c__ * 64; const size_t cj__ = seq * NCH + n__;
#define DN_LOAD(S, GL, n_) do { DN_CH(n_) \
    const int ipl__ = 32 * mi + r32, tl__ = dir ? 63 - ipl__ : ipl__; \
    const bf16_t* b0__ = W_ + cj__ * 8192 + (32 * mi + r32) * 128 + hi * 8; \
    const bf16_t* b1__ = QQ + (Rb__ + tl__) * 512 + h * 128 + hi * 8; \
    const bf16_t* b2__ = KT + ((((size_t)b * 4 + h) * NCH + c__) * 128 + 32 * (wid & 3) + r32) * 64 + hi * 8; \
    const bf16_t* bs__ = role == 0 ? b0__ : (role == 1 ? b1__ : b2__); \
    _Pragma("unroll") for (int ks = 0; ks < 8; ++ks) S.fa[ks] = *(const bf16x8*)(bs__ + ks * 16); \
    GL = GLS[cj__]; } while (0)
#define DN_STAGE_LD(q_, n_) do { DN_CH(n_) (void)Rb__; \
      stU[q_] = *(const u32x4*)(U_ + cj__ * 8192 + ((tid & 255) >> 2) * 128 + n0 + (tid & 3) * 8); \
      stI0[q_] = *(const u32x4*)(INTRA + cj__ * 4096 + (tid >> 3) * 64 + (tid & 7) * 8); \
      stS[q_] = SC[cj__ * 128 + (tid & 127)]; } while (0)
#define DN_STAGE_ST(q_, bf_) do { *(u32x4*)(inS + (bf_) * 4608 + (tid >> 3) * 72 + (tid & 7) * 8) = stI0[q_]; \
      if (ROLE < 2) *(u32x4*)(uS + (bf_) * 2560 + (tid >> 2) * 40 + (tid & 3) * 8) = stU[q_]; \
      if (ROLE == 0) scS[(bf_) * 128 + tid] = stS[q_]; } while (0)
#define DN_STEP(S, GL, n_, bf_) do { DN_CH(n_) (void)cj__; \
    const float* sc__ = scS + (bf_) * 128; \
    if (role < 2) { _Pragma("unroll") for (int r = 0; r < 16; ++r) accS[r] = 0.f; } \
    if (role < 2) { const bf16_t* sb__ = ST + r32 * 136 + hi * 8; \
      _Pragma("unroll") for (int ks = 0; ks < 8; ++ks) accS = MFMA32(S.fa[ks], *(const bf16x8*)(sb__ + ks * 16), accS); \
      if (role == 0) { const bf16_t* us__ = uS + (bf_) * 2560 + r32; \
        _Pragma("unroll") for (int r = 0; r < 16; ++r) { const int ip = 32 * mi + crow(r, hi); const float vn = bf2f(us__[ip * 40]) - accS[r]; \
          vTa[r32 * 72 + ip] = f2bf(vn); const int to = dir ? 63 - ip : ip; vTb[r32 * 72 + to] = f2bf(vn * sc__[ip * 2 + 1]); } } \
      else { _Pragma("unroll") for (int r = 0; r < 16; ++r) accS[r] *= sc__[(32 * mi + crow(r, hi)) * 2]; } } \
    LBAR(); \
    if (role == 1) { const bf16_t* vb__ = vTa + r32 * 72 + hi * 8; const bf16_t* ib__ = inS + (bf_) * 4608 + (32 * mi + r32) * 72 + hi * 8; \
      _Pragma("unroll") for (int ks = 0; ks < 4; ++ks) accS = MFMA32(*(const bf16x8*)(ib__ + ks * 16), *(const bf16x8*)(vb__ + ks * 16), accS); \
      _Pragma("unroll") for (int r = 0; r < 16; ++r) { const int ip = 32 * mi + crow(r, hi), t = dir ? 63 - ip : ip; \
        DNO[((size_t)dir * MROWS + Rb__ + t) * 512 + h * 128 + n0 + r32] = f2bf(accS[r]); } } \
    else if (role == 2) { const bf16_t* vb__ = vTb + r32 * 72 + hi * 8; \
      _Pragma("unroll") for (int r = 0; r < 16; ++r) accS[r] *= GL; \
      _Pragma("unroll") for (int ks = 0; ks < 4; ++ks) accS = MFMA32(S.fa[ks], *(const bf16x8*)(vb__ + ks * 16), accS); \
      _Pragma("unroll") for (int r = 0; r < 16; ++r) ST[r32 * 136 + 32 * di + crow(r, hi)] = f2bf(accS[r]); } \
    LBAR(); } while (0)
  DN_STAGE_LD(0, 0); DN_STAGE_ST(0, 0); DN_STAGE_LD(1, 1); DN_STAGE_LD(2, 2);
  DN_LOAD(fs[0], gls[0], 0); DN_LOAD(fs[1], gls[1], 1);
  __syncthreads();
  for (int nb6 = 0; nb6 < NCH; nb6 += 6) {
#pragma unroll
    for (int k = 0; k < 6; ++k) {
      const int n = nb6 + k; const int n2 = n + 2 < NCH ? n + 2 : NCH - 1; const int n3 = n + 3 < NCH ? n + 3 : NCH - 1;
      DN_STAGE_ST((k + 1) % 3, (k + 1) & 1);
      DN_STAGE_LD(k % 3, n3);
      DN_LOAD(fs[(k + 2) % 3], gls[(k + 2) % 3], n2);
      DN_STEP(fs[k % 3], gls[k % 3], n, k & 1);
    }
  }
#undef DN_CH
#undef DN_LOAD
#undef DN_STAGE_LD
#undef DN_STAGE_ST
#undef DN_STEP
}

__device__ __forceinline__ void dn_scan(const P& p, char* lds, int job) {
  const int wid = TIDX() >> 6;
  if (wid < 2) dn_scan_t<0>(p, lds, job); else if (wid < 4) dn_scan_t<1>(p, lds, job); else dn_scan_t<2>(p, lds, job);
}

DI float fast_logsig(float s) { return fminf(s, 0.f) - __logf(1.f + __expf(-fabsf(s))); }
struct GlaRegs { h16x8 ba, bb; bf16x8 qa, qb, ka, kb, v8; };
template <int ROLE>
__device__ __forceinline__ void gla_scan_t(const P& p, char* lds, int job, int e) {
  const int tid = TIDX(), wid = tid >> 6, lane = tid & 63, r32 = lane & 31, hi = lane >> 5;
  const int dir = job >> 5, b = (job >> 4) & 1, h = (job >> 2) & 3, n0 = (job & 3) * 32;
  const bf16_t* P2 = (const bf16_t*)(p.ws + OFF_D + D_P2); const float* SM = (const float*)(p.ws + OFF_SM);
  bf16_t* GLAO = (bf16_t*)(p.ws + OFF_D + D_GLAO);
  const _Float16* B16 = (const _Float16*)(p.ws + (dir ? OFF_B16_1 : OFF_WC));
  float* w2S = (float*)lds; float* b2S = w2S + 1024; float* aLb = b2S + 64;
  bf16_t* ops = (bf16_t*)(aLb + 128);
  constexpr int OPB = (4 * 64 + 32) * 72;
  bf16_t* attp = ops + 2 * OPB;
  bf16_t* STb = attp + 2 * 32 * 72;
  for (int i = tid; i < 2 * 32 * 72; i += 512) STb[i] = 0;
  f32x16 accS = {};
  __syncthreads();
  GlaRegs RG[3];
  int jb0 = 16 * (wid & 3); asm volatile("" : "+v"(jb0));
  int vtb0 = 8 * (wid & 3) * 72 + lane; asm volatile("" : "+v"(vtb0));
#define GLA_LOAD(R, n_) do { const int n__ = (n_) < NCH ? (n_) : NCH - 1; const int c__ = dir == 0 ? n__ : (n__ < 4 ? 3 - n__ : 135 - n__); const size_t row__ = (size_t)b * TB + (size_t)c__ * 64 + (dir ? 63 - lane : lane); \
    const _Float16* bp__ = B16 + ((((size_t)b * 4 + h) * NCH + n__) * 64 + lane) * 64 + 16 * (wid & 3); R.ba = *(const h16x8*)(bp__); R.bb = *(const h16x8*)(bp__ + 8); \
    const bf16_t* pr__ = P2 + row__ * 2048; R.qa = *(const bf16x8*)(pr__ + 512 + h * 64 + 16 * (wid & 3)); R.qb = *(const bf16x8*)(pr__ + 512 + h * 64 + 16 * (wid & 3) + 8); \
    R.ka = *(const bf16x8*)(pr__ + 768 + h * 64 + 16 * (wid & 3)); R.kb = *(const bf16x8*)(pr__ + 768 + h * 64 + 16 * (wid & 3) + 8); R.v8 = *(const bf16x8*)(pr__ + 1024 + h * 128 + n0 + 8 * (wid & 3)); } while (0)
#define GLA_HALF(R, BV, QV, KV, jb) do { \
    float eqe[8], eke[8], eqi[8]; \
    _Pragma("unroll") for (int jj = 0; jj < 8; ++jj) { const int j = (jb) + jj; const float bb = (float)BV[jj]; const float bm = __int_as_float(__builtin_amdgcn_readlane(__float_as_int(bb), 32)), bl = __int_as_float(__builtin_amdgcn_readlane(__float_as_int(bb), 63)); \
      const float q_ = bf2f((bf16_t)QV[jj]) * 0.125f, k_ = bf2f((bf16_t)KV[jj]); \
      eqe[jj] = q_ * __expf(bb - bm); eke[jj] = k_ * __expf(bm - bb); eqi[jj] = q_ * __expf(bb); ksT_[j * 72 + lane] = f2bf(k_ * __expf(bl - bb)); if (lane == 63) aL_[j] = __expf(bl); } \
    *(u32x4*)(qe_ + lane * 72 + (jb)) = (u32x4){cvtpk(eqe[0], eqe[1]), cvtpk(eqe[2], eqe[3]), cvtpk(eqe[4], eqe[5]), cvtpk(eqe[6], eqe[7])}; \
    *(u32x4*)(ke_ + lane * 72 + (jb)) = (u32x4){cvtpk(eke[0], eke[1]), cvtpk(eke[2], eke[3]), cvtpk(eke[4], eke[5]), cvtpk(eke[6], eke[7])}; \
    *(u32x4*)(qi_ + lane * 72 + (jb)) = (u32x4){cvtpk(eqi[0], eqi[1]), cvtpk(eqi[2], eqi[3]), cvtpk(eqi[4], eqi[5]), cvtpk(eqi[6], eqi[7])}; } while (0)
#define GLA_PREP(R, bf_) do { bf16_t* qe_ = ops + (bf_) * OPB; bf16_t* ke_ = qe_ + 64 * 72; bf16_t* qi_ = ke_ + 64 * 72; bf16_t* ksT_ = qi_ + 64 * 72; bf16_t* vT_ = ksT_ + 64 * 72; float* aL_ = aLb + (bf_) * 64; \
    GLA_HALF(R, R.ba, R.qa, R.ka, jb0); GLA_HALF(R, R.bb, R.qb, R.kb, jb0 + 8); \
    _Pragma("unroll") for (int q_ = 0; q_ < 8; ++q_) vT_[vtb0 + q_ * 72] = (bf16_t)R.v8[q_]; } while (0)
#define GLA_MMA(n_, bf_) do { const int nq__ = (n_); const int bf = (bf_); \
      const bf16_t* qe_ = ops + bf * OPB; const bf16_t* ke_ = qe_ + 64 * 72; const bf16_t* qi_ = ke_ + 64 * 72; const bf16_t* ksT_ = qi_ + 64 * 72; const bf16_t* vT_ = ksT_ + 64 * 72; const float* aL_ = aLb + bf * 64; \
      const bf16_t* STr = STb + bf * 32 * 72; bf16_t* STw = STb + (bf ^ 1) * 32 * 72; \
      if (ROLE == 1) { \
        const int mi = wid - 4; bf16_t* attw = attp + mi * 32 * 72; \
        const int c = dir == 0 ? nq__ : (nq__ < 4 ? 3 - nq__ : 135 - nq__); const size_t Rb = (size_t)b * TB + (size_t)c * 64; \
        f32x16 acc = {}; acc = mma_rows<4>(qi_ + (32 * mi + r32) * 72 + hi * 8, STr + r32 * 72 + hi * 8, acc); \
        { f32x16 a0 = {}; a0 = mma_rows<4>(qe_ + (32 * mi + r32) * 72 + hi * 8, ke_ + r32 * 72 + hi * 8, a0); \
          _Pragma("unroll") for (int r = 0; r < 16; ++r) { const int ipl = crow(r, hi); attw[ipl * 72 + r32] = f2bf((mi == 1 || r32 <= ipl) ? a0[r] : 0.f); } \
          f32x16 a1 = {}; if (mi == 1) a1 = mma_rows<4>(qe_ + (32 + r32) * 72 + hi * 8, ke_ + (32 + r32) * 72 + hi * 8, a1); \
          _Pragma("unroll") for (int r = 0; r < 16; ++r) { const int ipl = crow(r, hi); attw[ipl * 72 + 32 + r32] = f2bf((mi == 1 && r32 <= ipl) ? a1[r] : 0.f); } } \
        asm volatile("s_waitcnt lgkmcnt(0)" ::: "memory"); \
        acc = mma_rows<4>(attw + r32 * 72 + hi * 8, vT_ + r32 * 72 + hi * 8, acc); \
        _Pragma("unroll") for (int r = 0; r < 16; ++r) { const int ip = 32 * mi + crow(r, hi), t = dir ? 63 - ip : ip; \
          GLAO[((size_t)dir * MROWS + Rb + t) * 512 + h * 128 + n0 + r32] = f2bf(acc[r]); } \
      } else { \
        const int di = wid - 6; \
        _Pragma("unroll") for (int r = 0; r < 16; ++r) accS[r] *= aL_[32 * di + crow(r, hi)]; \
        accS = mma_rows<4>(ksT_ + (32 * di + r32) * 72 + hi * 8, vT_ + r32 * 72 + hi * 8, accS); \
        _Pragma("unroll") for (int r = 0; r < 16; ++r) STw[r32 * 72 + 32 * di + crow(r, hi)] = f2bf(accS[r]); \
      } } while (0)
  GLA_LOAD(RG[0], 0);
  if (ROLE == 0) { GLA_PREP(RG[0], 0); }
  GLA_LOAD(RG[1], 1); GLA_LOAD(RG[2], 2); GLA_LOAD(RG[0], 3);
  LBAR();
  for (int nb6 = 0; nb6 < NCH; nb6 += 6) {
#pragma unroll
    for (int k = 0; k < 6; ++k) {
      const int n = nb6 + k;
      if (ROLE == 0) { if (n + 1 < NCH) { GLA_PREP(RG[(k + 1) % 3], (k + 1) & 1); } } else { GLA_MMA(n, k & 1); }
      GLA_LOAD(RG[(k + 1) % 3], n + 4);
      LBAR();
    }
  }
#undef GLA_MMA
#undef GLA_LOAD
#undef GLA_HALF
#undef GLA_PREP
}

__device__ __forceinline__ void gla_scan(const P& p, char* lds, int job, int e) {
  const int wid = TIDX() >> 6;
  if (wid < 4) gla_scan_t<0>(p, lds, job, e); else if (wid < 6) gla_scan_t<1>(p, lds, job, e); else gla_scan_t<2>(p, lds, job, e);
}

__device__ __forceinline__ void ph_merge(const P& p, int e) {
  const int tid = TIDX(), wid = tid >> 6, lane = tid & 63, l16 = lane & 15, sub = lane >> 4;
  const bf16_t* DNO = (const bf16_t*)(p.ws + OFF_D + D_DNO); const bf16_t* GLAO = (const bf16_t*)(p.ws + OFF_D + D_GLAO);
  const bf16_t* P2 = (const bf16_t*)(p.ws + OFF_D + D_P2); bf16_t* hb = (bf16_t*)(p.ws + OFF_HBF);
  f32x8 nwd = *(const f32x8*)(p.dn_norm + e * 128 + l16 * 8), nwg = *(const f32x8*)(p.gla_norm + e * 128 + l16 * 8);
  for (int R4 = (BIDX() * 8 + wid) * 4; R4 < MROWS; R4 += GDIM() * 32) {
    const size_t R = R4 + sub;
    bf16x8 a[8], bq[8], zz[8];
#pragma unroll
    for (int g = 0; g < 8; ++g) { const bf16_t* src = g < 4 ? DNO : GLAO; const int hc = (g & 3) * 128 + l16 * 8;
      a[g] = *(const bf16x8*)(src + R * 512 + hc); bq[g] = *(const bf16x8*)(src + ((size_t)MROWS + R) * 512 + hc);
      zz[g] = *(const bf16x8*)(P2 + R * 2048 + (g < 4 ? 0 : 1536) + hc); }
#pragma unroll
    for (int g = 0; g < 8; ++g) {
      float v[8]; float ss = 0.f;
#pragma unroll
      for (int j = 0; j < 8; ++j) { v[j] = bf2f((bf16_t)a[g][j]) + bf2f((bf16_t)bq[g][j]); ss += v[j] * v[j]; }
      ss += __shfl_xor(ss, 1); ss += __shfl_xor(ss, 2); ss += __shfl_xor(ss, 4); ss += __shfl_xor(ss, 8);
      const float rs = rsqrtf(ss * (1.f / 128.f) + EPSF);
      float o[8];
#pragma unroll
      for (int j = 0; j < 8; ++j) o[j] = v[j] * rs * (g < 4 ? nwd[j] : nwg[j]) * siluf(bf2f((bf16_t)zz[g][j]));
      *(u32x4*)(hb + R * 1024 + g * 128 + l16 * 8) = (u32x4){cvtpk(o[0], o[1]), cvtpk(o[2], o[3]), cvtpk(o[4], o[5]), cvtpk(o[6], o[7])};
    }
  }
}

DI float silu_fast(float x) { return x / (1.f + __expf(-x)); }
__device__ __forceinline__ void ph_ffnact(const P& p, int L) {
  bf16_t* U = (bf16_t*)(p.ws + OFF_D);
  const float* cw = p.ffn_conv + (size_t)L * 3 * DFF;
  const size_t items = (size_t)MROWS * 352, stride = (size_t)GDIM() * 512;
  for (size_t it0 = (size_t)BIDX() * 512 + TIDX(); it0 < items; it0 += 2 * stride) {
    bf16x8 zc[2], zp[2], zn[2], vv[2]; int Rr[2], cc[2]; bool ok[2];
#pragma unroll
    for (int q = 0; q < 2; ++q) {
      size_t it = it0 + q * stride; ok[q] = it < items; if (!ok[q]) it = it0;
      const int R = (int)(it / 352), c0 = (int)(it % 352) * 8; const int b = R >= TB ? 1 : 0, pp = R - b * TB;
      const bool hasp = !(pp == 0 || pp == CTXL), hasn = !(pp == CTXL - 1 || pp == TB - 1);
      Rr[q] = R; cc[q] = c0;
      zc[q] = *(const bf16x8*)(U + (size_t)R * 5632 + c0);
      zp[q] = *(const bf16x8*)(U + (size_t)(hasp ? R - 1 : R) * 5632 + c0);
      zn[q] = *(const bf16x8*)(U + (size_t)(hasn ? R + 1 : R) * 5632 + c0);
      vv[q] = *(const bf16x8*)(U + (size_t)R * 5632 + DFF + c0);
      if (!hasp) zp[q] = (bf16x8){0, 0, 0, 0, 0, 0, 0, 0};
      if (!hasn) zn[q] = (bf16x8){0, 0, 0, 0, 0, 0, 0, 0};
    }
#pragma unroll
    for (int q = 0; q < 2; ++q) {
      const int c0 = cc[q];
      const f32x8 w0 = *(const f32x8*)(cw + c0), w1 = *(const f32x8*)(cw + DFF + c0), w2 = *(const f32x8*)(cw + 2 * DFF + c0);
      float o[8];
#pragma unroll
      for (int j = 0; j < 8; ++j) { const float a = bf2f((bf16_t)zp[q][j]) * w0[j] + bf2f((bf16_t)zc[q][j]) * w1[j] + bf2f((bf16_t)zn[q][j]) * w2[j];
        o[j] = silu_fast(a) * bf2f((bf16_t)vv[q][j]); }
      if (ok[q]) *(u32x4*)(U + (size_t)Rr[q] * 5632 + DFF + c0) = (u32x4){cvtpk(o[0], o[1]), cvtpk(o[2], o[3]), cvtpk(o[4], o[5]), cvtpk(o[6], o[7])};
    }
  }
}

__device__ __forceinline__ void ph_qknorm(const P& p, char* lds, int o) {
  const int tid = TIDX(), wid = tid >> 6, lane = tid & 63, l16 = lane & 15, sub = lane >> 4;
  bf16_t* QKV = (bf16_t*)(p.ws + OFF_D);
  float* tab = (float*)lds;
  for (int i = tid; i < 4096; i += 512) { const int pos = i >> 5, f = i & 31; const float ang = (float)pos * powf(10000.f, -(float)f / 32.f); tab[2 * i] = cosf(ang); tab[2 * i + 1] = sinf(ang); }
  __syncthreads();
  const f32x8 qn = *(const f32x8*)(p.att_q_norm + o * 128 + l16 * 8), kn = *(const f32x8*)(p.att_k_norm + o * 128 + l16 * 8);
  const int f0 = (l16 & 3) * 8;
  for (int R4 = (BIDX() * 8 + wid) * 4; R4 < MROWS; R4 += GDIM() * 32) {
    const int R = R4 + sub; const int b = R >= TB ? 1 : 0, pp = R - b * TB; const bool lat = pp >= CTXL; const int t = lat ? pp - CTXL : 0;
    const int pos = (l16 < 8) ? (t >> 6) : (t & 63);
    bf16_t* base = QKV + (size_t)R * 1536 + l16 * 8;
    bf16x8 x[10];
#pragma unroll
    for (int hd = 0; hd < 10; ++hd) x[hd] = *(const bf16x8*)(base + hd * 128);
    float cs[8], sn[8];
#pragma unroll
    for (int j = 0; j < 8; ++j) { const float2 t2 = *(const float2*)(tab + 2 * (pos * 32 + f0 + j)); cs[j] = lat ? t2.x : 1.f; sn[j] = lat ? t2.y : 0.f; }
#pragma unroll
    for (int hd = 0; hd < 10; ++hd) {
      float v[8]; float ss = 0.f;
#pragma unroll
      for (int j = 0; j < 8; ++j) { v[j] = bf2f((bf16_t)x[hd][j]); ss += v[j] * v[j]; }
      ss += __shfl_xor(ss, 1); ss += __shfl_xor(ss, 2); ss += __shfl_xor(ss, 4); ss += __shfl_xor(ss, 8);
      const float rs = rsqrtf(ss * (1.f / 128.f) + EPSF);
      float ov[8];
#pragma unroll
      for (int j = 0; j < 8; ++j) { v[j] = v[j] * rs * (hd < 8 ? qn[j] : kn[j]); const float pr = __shfl_xor(v[j], 4);
        ov[j] = (l16 & 4) ? (pr * sn[j] + v[j] * cs[j]) : (v[j] * cs[j] - pr * sn[j]); }
      *(u32x4*)(base + hd * 128) = (u32x4){cvtpk(ov[0], ov[1]), cvtpk(ov[2], ov[3]), cvtpk(ov[4], ov[5]), cvtpk(ov[6], ov[7])};
    }
  }
}

namespace at {
constexpr int D = 128, NW = 8, QBLK = 32, KVBLK = 64;
constexpr float SCALE = 0.088388347648318440f, THR = 8.f;
constexpr int LDQ = 1536, LDK = 1536, LDO = 1024;
constexpr size_t SHM_V = KVBLK * D * 2, SHM_K = KVBLK * D * 2;
#define KSWZ(row, colB) ((row) * 256 + ((colB) ^ (((row) & 7) << 4)))
#define SBAR() __builtin_amdgcn_sched_barrier(0)
DI void partialSM(f32x16& p0, f32x16& p1, float& m_reg, float& mn, float& alpha) {
  constexpr float C = SCALE * 1.4426950408889634f;
  float pmax = p0[0]; for (int r = 1; r < 16; ++r) pmax = fmaxf(pmax, p0[r]); for (int r = 0; r < 16; ++r) pmax = fmaxf(pmax, p1[r]);
  { auto rr = __builtin_amdgcn_permlane32_swap(__float_as_uint(pmax), __float_as_uint(pmax), false, false);
    pmax = fmaxf(__uint_as_float(rr[0]), __uint_as_float(rr[1])); }
  if (__builtin_expect(__all(pmax - m_reg <= THR / SCALE), 1)) { mn = m_reg; alpha = 1.f; }
  else { mn = fmaxf(m_reg, pmax); alpha = __builtin_amdgcn_exp2f((m_reg - mn) * C); m_reg = mn; }
  float mnC = -mn * C;
  for (int r = 0; r < 16; ++r) p0[r] = fmaf(p0[r], C, mnC); for (int r = 0; r < 16; ++r) p1[r] = fmaf(p1[r], C, mnC);
  for (int r = 0; r < 16; ++r) p0[r] = __builtin_amdgcn_exp2f(p0[r]);
}
DI void finishSM(f32x16& p0, f32x16& p1, float alpha, float& l_reg, bf16x8& pa0, bf16x8& pa1, bf16x8& pa2, bf16x8& pa3) {
  for (int r = 0; r < 16; ++r) p1[r] = __builtin_amdgcn_exp2f(p1[r]);
  float ps = 0; for (int r = 0; r < 16; ++r) ps += p0[r]; for (int r = 0; r < 16; ++r) ps += p1[r];
  { auto rr = __builtin_amdgcn_permlane32_swap(__float_as_uint(ps), __float_as_uint(ps), false, false);
    ps = __uint_as_float(rr[0]) + __uint_as_float(rr[1]); }
  l_reg = l_reg * alpha + ps;
#define PK4(PP, BASE, OUT) do { unsigned a0 = cvtpk(PP[BASE + 0], PP[BASE + 1]), a1 = cvtpk(PP[BASE + 2], PP[BASE + 3]);   \
    unsigned b0 = cvtpk(PP[BASE + 4], PP[BASE + 5]), b1 = cvtpk(PP[BASE + 6], PP[BASE + 7]);                              \
    auto r0 = __builtin_amdgcn_permlane32_swap(a0, b0, false, false); auto r1 = __builtin_amdgcn_permlane32_swap(a1, b1, false, false); \
    u32x4 w = {r0[0], r1[0], r0[1], r1[1]}; OUT = *reinterpret_cast<bf16x8*>(&w); } while (0)
  PK4(p0, 0, pa0); PK4(p0, 8, pa1); PK4(p1, 0, pa2); PK4(p1, 8, pa3);
#undef PK4
}
DI void qkt(f32x16& p0, f32x16& p1, const bf16_t* Ks, const bf16x8* qr, int r32, int hi) {
  p0 = f32x16{}; p1 = f32x16{};
  for (int d0 = 0; d0 < 8; ++d0) { int cb = (d0 * 16 + hi * 8) * 2;
    bf16x8 b0 = *reinterpret_cast<const bf16x8*>((const char*)Ks + KSWZ(r32, cb));
    bf16x8 b1 = *reinterpret_cast<const bf16x8*>((const char*)Ks + KSWZ(32 + r32, cb));
    p0 = MFMA32(b0, qr[d0], p0);
    p1 = MFMA32(b1, qr[d0], p1); }
}
DI int v_st(int k, int c) { const int kk = (k & ~0xC) | ((k & 4) << 1) | ((k & 8) >> 1); return ((kk >> 3) * 4 + (c >> 5)) * 512 + ((kk & 7) * 32 + (c & 31)) * 2; }
DI int v_rd_base(int lane) { return ((lane & 3) << 3) | (((lane >> 2) & 3) << 6) | (((lane >> 4) & 1) << 5) | (((lane >> 5) & 1) << 8); }
constexpr int v_rd_off(int d0, int ks, int half) { return d0 * 512 + ks * 4096 + half * 2048; }
template <int OFF> DI s16x4 tr_read(int vb) {
  s16x4 r; asm volatile("ds_read_b64_tr_b16 %0, %1 offset:%2" : "=&v"(r) : "v"(vb), "i"(OFF) : "memory"); return r;
}
template <int D0> DI void pv_one(f32x16& od, int vb, bf16x8 pa0, bf16x8 pa1, bf16x8 pa2, bf16x8 pa3) {
  const s16x4 l0 = tr_read<v_rd_off(D0, 0, 0)>(vb), h0 = tr_read<v_rd_off(D0, 0, 1)>(vb), l1 = tr_read<v_rd_off(D0, 1, 0)>(vb), h1 = tr_read<v_rd_off(D0, 1, 1)>(vb);
  const s16x4 l2 = tr_read<v_rd_off(D0, 2, 0)>(vb), h2 = tr_read<v_rd_off(D0, 2, 1)>(vb), l3 = tr_read<v_rd_off(D0, 3, 0)>(vb), h3 = tr_read<v_rd_off(D0, 3, 1)>(vb);
  asm volatile("s_waitcnt lgkmcnt(0)" ::: "memory"); SBAR();
#define PK(Lx, Hx) (bf16x8){Lx[0], Lx[1], Lx[2], Lx[3], Hx[0], Hx[1], Hx[2], Hx[3]}
  od = MFMA32(pa0, PK(l0, h0), od);
  od = MFMA32(pa1, PK(l1, h1), od);
  od = MFMA32(pa2, PK(l2, h2), od);
  od = MFMA32(pa3, PK(l3, h3), od);
#undef PK
}
DI void pv_d0(f32x16* o, int vb, bf16x8 pa0, bf16x8 pa1, bf16x8 pa2, bf16x8 pa3) {
  pv_one<0>(o[0], vb, pa0, pa1, pa2, pa3); pv_one<1>(o[1], vb, pa0, pa1, pa2, pa3); pv_one<2>(o[2], vb, pa0, pa1, pa2, pa3); pv_one<3>(o[3], vb, pa0, pa1, pa2, pa3);
}
DI void attn_dense_body(const bf16_t* __restrict__ Qb, const bf16_t* __restrict__ Kh, const bf16_t* __restrict__ Vh, bf16_t* __restrict__ Ob, int seq, char* lds) {
  const int tid = TIDX(), wid = tid >> 6, lane = tid & 63, r32 = lane & 31, hi = lane >> 5;
  bf16_t* V_lds = (bf16_t*)lds; bf16_t* K_lds = (bf16_t*)(lds + 2 * SHM_V);
  float* ws = (float*)(lds + 2 * SHM_V + 2 * SHM_K) + wid * 64; float* li_l = ws; float* al_l = ws + 32;
  float m_reg = -1e30f, l_reg = 0; f32x16 o[4] = {}; bf16x8 qr[8];
  const bf16_t* Qw = Qb + (long)(wid * QBLK + r32) * LDQ + hi * 8;
#pragma unroll
  for (int d0 = 0; d0 < 8; ++d0) qr[d0] = *reinterpret_cast<const bf16x8*>(Qw + d0 * 16);
  const int sr = tid >> 4, sc = (tid & 15) * 8, vst0 = v_st(sr, sc), vst1 = v_st(32 + sr, sc);
  const int vb0 = (int)(uintptr_t)V_lds + v_rd_base(lane);
  struct { bf16x8 vs0, vs1, ks0, ks1; } sr_[2];
#define SLOAD(i, k0) do { sr_[i].vs0 = *(const bf16x8*)(&Vh[(long)((k0) + sr) * LDK + sc]); sr_[i].vs1 = *(const bf16x8*)(&Vh[(long)((k0) + 32 + sr) * LDK + sc]); \
    sr_[i].ks0 = *(const bf16x8*)(&Kh[(long)((k0) + sr) * LDK + sc]); sr_[i].ks1 = *(const bf16x8*)(&Kh[(long)((k0) + 32 + sr) * LDK + sc]); } while (0)
#define SWRITE(bq, i) do { *(bf16x8*)((char*)V_lds + (bq) * SHM_V + vst0) = sr_[i].vs0;          \
    *(bf16x8*)((char*)V_lds + (bq) * SHM_V + vst1) = sr_[i].vs1; int kc = sc * 2;               \
    *(bf16x8*)((char*)K_lds + (bq) * SHM_K + KSWZ(sr, kc)) = sr_[i].ks0;                       \
    *(bf16x8*)((char*)K_lds + (bq) * SHM_K + KSWZ(32 + sr, kc)) = sr_[i].ks1; } while (0)
#define SWAIT() asm volatile("s_waitcnt vmcnt(4)" ::: "memory")
#define RESC(a) do { if (__any((a) < 1.f)) { if (hi == 0) al_l[r32] = (a); asm volatile("s_waitcnt lgkmcnt(0)" ::: "memory"); \
    for (int d = 0; d < 4; ++d) for (int r = 0; r < 16; ++r) o[d][r] *= al_l[crow(r, hi)]; } } while (0)
  f32x16 pA0, pA1, pB0, pB1; float mnA, mnB, alA, alB; bf16x8 pa0, pa1, pa2, pa3; const int NT = seq / KVBLK;
  constexpr int SE = 0, SO = 1;
  SLOAD(SE, 0); asm volatile("s_waitcnt vmcnt(0)" ::: "memory"); SWRITE(0, SE); __syncthreads();
  qkt(pA0, pA1, K_lds, qr, r32, hi); partialSM(pA0, pA1, m_reg, mnA, alA);
  SLOAD(SO, KVBLK); if (2 < NT) SLOAD(SE, 2 * KVBLK);
  SWAIT(); SWRITE(1, SO); __syncthreads();
  for (int j = 1; j + 1 < NT; j += 2) {
    SBAR(); qkt(pB0, pB1, (bf16_t*)((char*)K_lds + SHM_K), qr, r32, hi);
    finishSM(pA0, pA1, alA, l_reg, pa0, pa1, pa2, pa3); SBAR();
    SLOAD(SO, (j + 2) * KVBLK); SBAR();
    pv_d0(o, vb0, pa0, pa1, pa2, pa3); partialSM(pB0, pB1, m_reg, mnB, alB);
    __syncthreads(); SWAIT(); SWRITE(0, SE);
    RESC(alB); __syncthreads();
    SBAR(); qkt(pA0, pA1, K_lds, qr, r32, hi);
    finishSM(pB0, pB1, alB, l_reg, pa0, pa1, pa2, pa3); SBAR();
    if (j + 3 < NT) SLOAD(SE, (j + 3) * KVBLK); SBAR();
    pv_d0(o, vb0 + (int)SHM_V, pa0, pa1, pa2, pa3); partialSM(pA0, pA1, m_reg, mnA, alA);
    __syncthreads(); SWAIT(); SWRITE(1, SO);
    RESC(alA); __syncthreads();
  }
  SBAR(); qkt(pB0, pB1, (bf16_t*)((char*)K_lds + SHM_K), qr, r32, hi);
  finishSM(pA0, pA1, alA, l_reg, pa0, pa1, pa2, pa3); SBAR();
  pv_d0(o, vb0, pa0, pa1, pa2, pa3); partialSM(pB0, pB1, m_reg, mnB, alB);
  __syncthreads(); RESC(alB);
  finishSM(pB0, pB1, alB, l_reg, pa0, pa1, pa2, pa3); SBAR();
  pv_d0(o, vb0 + (int)SHM_V, pa0, pa1, pa2, pa3);
  if (hi == 0) li_l[r32] = l_reg; asm volatile("s_waitcnt lgkmcnt(0)" ::: "memory");
  float rli[16];
#pragma unroll
  for (int r = 0; r < 16; ++r) rli[r] = __builtin_amdgcn_rcpf(li_l[crow(r, hi)]);
  bf16_t* Ow = Ob + (long)(wid * QBLK) * LDO;
#pragma unroll
  for (int r = 0; r < 16; ++r) { int orow = crow(r, hi);
    for (int d0 = 0; d0 < 4; ++d0) Ow[(long)orow * LDO + d0 * 32 + r32] = f2bf(o[d0][r] * rli[r]); }
#undef SLOAD
#undef SWRITE
#undef SWAIT
#undef RESC
}
}

__device__ __forceinline__ void ph_attn(const P& p, char* lds, bool need_ctx) {
  const bf16_t* QKV = (const bf16_t*)(p.ws + OFF_D); bf16_t* hb = (bf16_t*)(p.ws + OFF_HBF);
  const int nunits = need_ctx ? 528 : 512;
  for (int u = BIDX(); u < nunits; u += GDIM()) {
    int b, h, seq; size_t qrow;
    if (u < 512) { b = u >> 8; const int rem = u & 255; h = rem >> 5; qrow = (size_t)b * TB + CTXL + (size_t)(rem & 31) * 256; seq = TB; }
    else { const int uu = u - 512; b = uu >> 3; h = uu & 7; qrow = (size_t)b * TB; seq = CTXL; }
    const int kvh = h >> 2;
    const bf16_t* Kh = QKV + (size_t)b * TB * 1536 + 1024 + kvh * 128;
    const bf16_t* Vh = QKV + (size_t)b * TB * 1536 + 1280 + kvh * 128;
    at::attn_dense_body(QKV + qrow * 1536 + h * 128, Kh, Vh, hb + qrow * 1024 + h * 128, seq, lds);
    __syncthreads();
  }
}

__device__ __forceinline__ void ph_final(const P& p) {
  const int tid = TIDX(), wid = tid >> 6, lane = tid & 63;
  const float* xr = (const float*)(p.ws + OFF_XRES);
  for (int q = BIDX() * 8 + wid; q < 2 * LAT; q += GDIM() * 8) {
    const int b = q >> 13, t = q & (LAT - 1); const float* row = xr + ((size_t)b * TB + CTXL + t) * 1024;
    f32x4 v[4]; float ss = 0.f;
#pragma unroll
    for (int i = 0; i < 4; ++i) { v[i] = *(const f32x4*)(row + i * 256 + lane * 4); ss += v[i][0] * v[i][0] + v[i][1] * v[i][1] + v[i][2] * v[i][2] + v[i][3] * v[i][3]; }
    ss = wave_sum(ss); const float rs = rsqrtf(ss * (1.f / 1024.f) + EPSF);
#pragma unroll
    for (int i = 0; i < 4; ++i) { const int c0 = i * 256 + lane * 4; const f32x4 g = *(const f32x4*)(p.final_norm + c0); f32x4 o = v[i] * rs * g; *(f32x4*)(p.out + (size_t)q * 1024 + c0) = o; }
  }
}

#ifndef ONLY_PH
#define ONLY_PH -1
#endif
#define EN(x) (ONLY_PH < 0 || ONLY_PH == (x))
#ifndef PROBE_REP
#define PROBE_REP -1
#endif
#define RUN(cls, ...) do { if (EN(cls)) { for (int rep_ = 0; rep_ < ((PROBE_REP == (cls)) ? 2 : 1); ++rep_) { if (rep_) xcd_barrier(*xbp); __VA_ARGS__; } } } while (0)
enum { OP_INIT, OP_N1FULL, OP_IN, OP_PREP, OP_D1, OP_SCAN, OP_MERGE, OP_OUTLAT, OP_OUTCTX_N2LAT, OP_N2CTX, OP_UP, OP_ACT, OP_DOWNLAT, OP_DOWNCTX_N1LAT, OP_N1CTX,
       OP_QKV, OP_QKNORM, OP_ATTN, OP_N2FULL, OP_FINAL };
constexpr int NPHASES = 48;
__device__ __forceinline__ void decode_phase(int ph, int& op, int& L) {
  if (ph == 0) { op = OP_INIT; L = 0; return; }
  if (ph == NPHASES - 1) { op = OP_FINAL; L = 3; return; }
  int q = ph - 1;
  if (q < 14) { L = 0; if (q == 0) { op = OP_N1FULL; return; } q -= 1; }
  else if (q < 25) { L = 1; q -= 14; }
  else if (q < 38) { L = 2; q -= 25; }
  else { L = 3; q -= 38; }
  if ((L & 1) == 0) {
    if (q < 5) { op = OP_IN + q; return; }
    q -= 5;
  } else {
    if (q < 3) { op = OP_QKV + q; return; }
    q -= 3;
  }
  if (L < 3) { const int t[8] = {OP_OUTLAT, OP_OUTCTX_N2LAT, OP_N2CTX, OP_UP, OP_ACT, OP_DOWNLAT, OP_DOWNCTX_N1LAT, OP_N1CTX}; op = t[q]; }
  else { const int t[5] = {OP_OUTLAT, OP_N2FULL, OP_UP, OP_ACT, OP_DOWNLAT}; op = t[q]; }
}
__device__ __forceinline__ void run_phase(const P& p0, int ph, char* lds, const XcdBarrier* xbp) {
  P p = p0; { typedef __attribute__((address_space(1))) char gchar_t; size_t wi = (size_t)p0.ws; asm volatile("" : "+s"(wi)); p.ws = (char*)(gchar_t*)wi; }
  int op, L; decode_phase(ph, op, L);
  const int e = L >> 1, o = L >> 1;
  bf16_t* W1 = (bf16_t*)(p.ws + OFF_WC); bf16_t* W2 = (bf16_t*)(p.ws + OFF_WC + WC_W2); bf16_t* W3 = (bf16_t*)(p.ws + OFF_W3);
  bf16_t* hb = (bf16_t*)(p.ws + OFF_HBF); float* xr = (float*)(p.ws + OFF_XRES);
  const float* mods = (const float*)(p.ws + OFF_MODS) + (size_t)L * 3 * 6144;
  float* PART = (float*)(p.ws + OFF_D + D_END_F);
#define CVT_MIX(LL, skipb) do { const int L_ = (LL); if ((L_ & 1) == 0) { cvt_weight(p.rec_w_in + (size_t)(L_ >> 1) * 1024 * 3632, W1, 1024, 3632, NREC, true, skipb); cvt_weight(p.rec_w_out + (size_t)(L_ >> 1) * 1024 * 1024, W3, 1024, 1024, 1024, false, skipb); } \
    else { cvt_weight(p.att_w_qkv + (size_t)(L_ >> 1) * 1024 * 1536, W1, 1024, 1536, 1536, false, skipb); cvt_weight(p.att_w_out + (size_t)(L_ >> 1) * 1024 * 1024, W3, 1024, 1024, 1024, false, skipb); } } while (0)
#define CVT_FFN(LL, skipb) do { const int L_ = (LL); cvt_weight(p.ffn_w_up + (size_t)L_ * 1024 * 5632, W1, 1024, 5632, 5632, false, skipb); cvt_weight(p.ffn_w_down + (size_t)L_ * DFF * 1024, W2, DFF, 1024, 1024, false, skipb); } while (0)
  switch (op) {
    case OP_INIT: RUN(0, ph_init(p, lds); CVT_MIX(0, 0)); break;
    case OP_N1FULL: RUN(1, ph_norm(p, L, 0, 0, 0)); break;
    case OP_IN: RUN(2, gemm8(lds, hb, 1024, W1, 1024, NREC, 0, EpiRec8{(bf16_t*)(p.ws + OFF_D + D_P1), (bf16_t*)(p.ws + OFF_D + D_P2), (float*)(p.ws + OFF_SM)})); break;
    case OP_PREP: RUN(3, ph_dnprep(p, lds, e)); break;
    case OP_D1: RUN(4, ph_dn_d1(p, lds); ph_gla_b(p, lds, e)); break;
    case OP_SCAN: RUN(5, if (BIDX() < 64) { dn_scan(p, lds, BIDX()); } else if (BIDX() < 128) { gla_scan(p, lds, BIDX() - 64, e); });
        if (PROBE_REP == 55) { xcd_barrier(*xbp); if (BIDX() < 64) { dn_scan(p, lds, BIDX()); } }
        if (PROBE_REP == 56) { xcd_barrier(*xbp); if (BIDX() >= 64 && BIDX() < 128) { gla_scan(p, lds, BIDX() - 64, e); } }
        break;
    case OP_MERGE: RUN(7, ph_merge(p, e)); break;
    case OP_QKV: RUN(2, gemm8(lds, hb, 1024, W1, 1024, 1536, 0, EpiBf8{(bf16_t*)(p.ws + OFF_D), 1536})); break;
    case OP_QKNORM: if (EN(9)) ph_qknorm(p, lds, o); break;
    case OP_ATTN: RUN(10, ph_attn(p, lds, L != 3)); break;
    case OP_OUTLAT: if (EN(2)) { gemm8(lds, hb, 1024, W3, 1024, 1024, 1, EpiRes8{xr, mods + 2 * 1024}); if (L == 3) CVT_FFN(L, 0); } break;
    case OP_OUTCTX_N2LAT: if (EN(2)) { if (BIDX() < 128) gemm_ctx_split(lds, hb, 1024, W3, 1024, 128, PART); ph_norm(p, L, 1, 1, 0); CVT_FFN(L, 0); } break;
    case OP_N2CTX: if (EN(1)) ph_ctx_fold_norm(p, L, 1, PART, 8, mods + 2 * 1024); break;
    case OP_N2FULL: if (EN(1)) ph_norm(p, L, 1, 0, 0); break;
    case OP_UP: RUN(2, gemm8(lds, hb, 1024, W1, 1024, 5632, L == 3 ? 1 : 0, EpiBf8{(bf16_t*)(p.ws + OFF_D), 5632})); break;
    case OP_ACT: if (EN(8)) ph_ffnact(p, L); break;
    case OP_DOWNLAT: if (EN(2)) gemm8(lds, (const bf16_t*)(p.ws + OFF_D) + DFF, 5632, W2, DFF, 1024, 1, EpiRes8{xr, mods + 5 * 1024}); break;
    case OP_DOWNCTX_N1LAT: if (EN(2)) { if (BIDX() < 176) gemm_ctx_split(lds, (const bf16_t*)(p.ws + OFF_D) + DFF, 5632, W2, DFF, 256, PART); ph_norm(p, L + 1, 0, 1, 0); CVT_MIX(L + 1, 0); } break;
    case OP_N1CTX: if (EN(1)) ph_ctx_fold_norm(p, L + 1, 0, PART, 11, mods + 5 * 1024); break;
    case OP_FINAL: if (EN(11)) ph_final(p); break;
  }
#undef CVT_MIX
#undef CVT_FFN
}

template <bool COOP>
__global__ void __launch_bounds__(512, 1) mk_kernel(P p, int ph0, int ph1) {
  extern __shared__ __attribute__((aligned(16))) char smem[];
  if constexpr (COOP) {
    if (ph0 < 0) cg::this_grid().sync();
    volatile LAS unsigned* st = (volatile LAS unsigned*)(smem + LDS_BYTES);
    if (threadIdx.x < 4) st[threadIdx.x] = 0u;
    __syncthreads();
    XcdBarrier xb = xcd_barrier_post((unsigned*)(p.ws + OFF_BAR), st);
    for (int ph = ph0; ph < ph1; ++ph) {
      run_phase(p, ph, smem, &xb);
      if (ph + 1 < ph1) xcd_barrier(xb);
      if (PROBE_REP == 99 && ph == 0) { for (int q = 0; q < 20; ++q) xcd_barrier(xb); }
    }
  } else {
    for (int ph = ph0; ph < ph1; ++ph) run_phase(p, ph, smem, nullptr);
  }
}

extern "C" void kernel_launch(void* const* d_in, const int* in_sizes, int n_in, void* d_out, int out_size, void* d_ws, size_t ws_size, hipStream_t stream) {
  if (n_in != 23 || ws_size < WS_NEED) { fprintf(stderr, "kernel_launch: bad n_in %d or ws %zu < %zu\n", n_in, ws_size, (size_t)WS_NEED); return; }
  P p{};
  const float** f = (const float**)&p;
  for (int i = 0; i < 23; ++i) f[i] = (const float*)d_in[i];
  p.out = (float*)d_out; p.ws = (char*)d_ws;
  static int inited = 0, grid_blocks = 0;
  if (!inited) {
    hipFuncSetAttribute((const void*)mk_kernel<true>, hipFuncAttributeMaxDynamicSharedMemorySize, LDS_BYTES + 16);
#if !MK_COOP
    hipFuncSetAttribute((const void*)mk_kernel<false>, hipFuncAttributeMaxDynamicSharedMemorySize, LDS_BYTES);
#endif
    int dev = 0, cus = 0, per_cu = 0;
    hipGetDevice(&dev); hipDeviceGetAttribute(&cus, hipDeviceAttributeMultiprocessorCount, dev);
    hipOccupancyMaxActiveBlocksPerMultiprocessor(&per_cu, mk_kernel<true>, 512, LDS_BYTES + 16);
    if (per_cu > 1) per_cu = 1;
    grid_blocks = cus * per_cu; if (grid_blocks > 256) grid_blocks = 256; if (grid_blocks < 128) grid_blocks = 128;
    inited = 1;
  }
#if MK_COOP
  int ph0 = 0, ph1 = NPHASES;
  void* args[] = {&p, &ph0, &ph1};
  hipMemsetAsync((char*)d_ws + OFF_BAR, 0, 3456 * 4, stream);
  hipError_t er = hipLaunchCooperativeKernel((const void*)mk_kernel<true>, dim3(grid_blocks), dim3(512), args, LDS_BYTES + 16, stream);
  if (er != hipSuccess) fprintf(stderr, "cooperative launch failed: %s (grid %d)\n", hipGetErrorString(er), grid_blocks);
#else
  for (int ph = 0; ph < NPHASES; ++ph) hipLaunchKernelGGL(mk_kernel<false>, dim3(256), dim3(512), LDS_BYTES, stream, p, ph, ph + 1);
#endif
}
```

```cpp
#include <hip/hip_runtime.h>
#include <hip/hip_cooperative_groups.h>
#include <cstdio>
#include <cstdint>
namespace cg = cooperative_groups;

#ifndef MK_COOP
#define MK_COOP 1
#endif

typedef unsigned short bf16_t;
typedef short bf16x8 __attribute__((ext_vector_type(8)));
typedef short s16x4 __attribute__((ext_vector_type(4)));
typedef float f32x16 __attribute__((ext_vector_type(16)));
typedef float f32x8 __attribute__((ext_vector_type(8)));
typedef float f32x4 __attribute__((ext_vector_type(4)));
typedef unsigned u32x4 __attribute__((ext_vector_type(4)));
#define DI __device__ __forceinline__
#define LBAR() do { asm volatile("s_waitcnt lgkmcnt(0)" ::: "memory"); __builtin_amdgcn_s_barrier(); asm volatile("" ::: "memory"); } while (0)
#define MFMA32(a, b, c) __builtin_amdgcn_mfma_f32_32x32x16_bf16((a), (b), (c), 0, 0, 0)

constexpr int DM = 1024, TB = 8448, CTXL = 256, LAT = 8192, MROWS = 2 * TB;
constexpr int NCH = 132;
constexpr int DFF = 2816;
constexpr int NREC = 3840;
constexpr float EPSF = 1e-6f;

constexpr size_t AL(size_t x) { return (x + 255) / 256 * 256; }
constexpr size_t OFF_XRES = 0;
constexpr size_t OFF_HBF = OFF_XRES + AL((size_t)MROWS * DM * 4);
constexpr size_t OFF_WC = OFF_HBF + AL((size_t)MROWS * DM * 2);
constexpr size_t WC_W2 = (size_t)5632 * 1024 * 2;
constexpr size_t OFF_MODS = OFF_WC + AL(WC_W2 + (size_t)1024 * 2816 * 2);
constexpr size_t OFF_SM = OFF_MODS + AL((size_t)4 * 3 * 6144 * 4);
constexpr size_t OFF_GB = OFF_SM + AL((size_t)MROWS * 64 * 4);
constexpr size_t OFF_SC = OFF_GB + AL((size_t)MROWS * 16 * 4);
constexpr size_t OFF_GL = OFF_SC + AL((size_t)16 * NCH * 64 * 2 * 4);
constexpr size_t OFF_D = OFF_GL + AL((size_t)16 * NCH * 4);
constexpr size_t D_P1 = 0;
constexpr size_t D_W = 0;
constexpr size_t D_INTRA = D_W + (size_t)16 * NCH * 64 * 128 * 2;
constexpr size_t D_P2 = D_P1 + (size_t)MROWS * 1536 * 2;
constexpr size_t D_QQ = D_P2 + (size_t)MROWS * 2048 * 2;
constexpr size_t D_QK = D_QQ + (size_t)MROWS * 512 * 2;
constexpr size_t D_QV = D_QK + (size_t)MROWS * 512 * 2;
constexpr size_t D_DNO = D_QK;
constexpr size_t D_KT = D_QV + (size_t)MROWS * 512 * 2;
constexpr size_t D_GLAO = D_KT + (size_t)MROWS * 512 * 2;
constexpr size_t D_END_E = D_GLAO + (size_t)2 * MROWS * 512 * 2;
constexpr size_t D_END_F = (size_t)MROWS * 5632 * 2;
constexpr size_t OFF_B16_1 = OFF_D + (D_END_E > D_END_F ? D_END_E : D_END_F);
constexpr size_t B16_BYTES = (size_t)8 * NCH * 64 * 64 * 2;
constexpr size_t OFF_BAR = OFF_B16_1 + AL(B16_BYTES);
constexpr size_t OFF_W3 = OFF_BAR + AL(3456 * 4);
constexpr size_t WS_NEED = OFF_W3 + (size_t)1024 * 1024 * 2;
constexpr int LDS_BYTES = 132 * 1024;

struct P {
  const float *x, *c, *ctx, *c_ctx, *mod_w, *mod_b, *rec_w_in, *rec_conv, *dn_a_log, *dn_dt_bias, *dn_norm, *gla_w2, *gla_b2, *gla_norm,
      *rec_w_out, *att_w_qkv, *att_q_norm, *att_k_norm, *att_w_out, *ffn_w_up, *ffn_conv, *ffn_w_down, *final_norm;
  float* out;
  char* ws;
};

DI int TIDX() { int t = threadIdx.x; asm volatile("" : "+v"(t)); return t; }
DI int BIDX() { int t = blockIdx.x; asm volatile("" : "+s"(t)); return t; }
DI int GDIM() { int t = gridDim.x; asm volatile("" : "+s"(t)); return t; }
DI float bf2f(bf16_t v) { return __uint_as_float(((unsigned)v) << 16); }
DI bf16_t f2bf(float x) { unsigned u = __float_as_uint(x); u += 0x7fffu + ((u >> 16) & 1u); return (bf16_t)(u >> 16); }
DI unsigned cvtpk(float lo, float hi) { unsigned r; asm volatile("v_cvt_pk_bf16_f32 %0, %1, %2" : "=v"(r) : "v"(lo), "v"(hi)); return r; }
DI int crow(int r, int hi) { return (r & 3) + 8 * (r >> 2) + 4 * hi; }
DI float siluf(float x) { return x / (1.f + expf(-x)); }
DI float sigmf(float x) { return 1.f / (1.f + expf(-x)); }
DI float softplusf(float x) { return fmaxf(x, 0.f) + log1pf(expf(-fabsf(x))); }
DI float wave_sum(float v) {
#pragma unroll
  for (int o = 32; o > 0; o >>= 1) v += __shfl_xor(v, o);
  return v;
}
DI int modrow_of(int R) { const int b = R >= TB ? 1 : 0; const int pp = R - b * TB; return pp < CTXL ? 2 : b; }
template <int KS>
DI f32x16 mma_rows(const bf16_t* arow, const bf16_t* brow, f32x16 acc) {
#pragma unroll
  for (int ks = 0; ks < KS; ++ks) {
    const bf16x8 a = *reinterpret_cast<const bf16x8*>(arow + ks * 16);
    const bf16x8 b = *reinterpret_cast<const bf16x8*>(brow + ks * 16);
    acc = MFMA32(a, b, acc);
  }
  return acc;
}

#define XB_TMO      128
#define XB_XCNT(j)  (256  + 64 * (j))
#define XB_XSUB(j)  (1280 + 64 * (j))
#define XB_XGEN(j)  (2304 + 64 * (j))
#define XB_TOP      3328
#define XB_TOPGEN   3392
#define XCD_BAR_WORDS 3456
#define XB_SPIN_CAP (1u << 18)
#define LAS __attribute__((address_space(3)))
DI unsigned xb_ld(unsigned* p)              { return __hip_atomic_load(p, __ATOMIC_RELAXED, __HIP_MEMORY_SCOPE_AGENT); }
DI unsigned xb_add(unsigned* p, unsigned v) { return __hip_atomic_fetch_add(p, v, __ATOMIC_RELAXED, __HIP_MEMORY_SCOPE_AGENT); }
DI unsigned xb_xcc_id() { return (unsigned)__builtin_amdgcn_s_getreg((3 << 11) | 20) & 0xFu; }
#define XB_SPIN(cond, bar) do { unsigned _sp = 0; while (cond) { __builtin_amdgcn_s_sleep(1); \
    if ((++_sp & 255u) == 0u) { if (xb_ld(&(bar)[XB_TMO])) break; if (_sp > XB_SPIN_CAP) { atomicAdd(&(bar)[XB_TMO], 1u); break; } } } } while (0)
struct XcdBarrier { unsigned* bar; unsigned x; volatile LAS unsigned* st; };
DI XcdBarrier xcd_barrier_post(unsigned* bar, volatile LAS unsigned* st) {
    XcdBarrier b; b.bar = bar; b.x = xb_xcc_id(); b.st = st;
    if (threadIdx.x == 0) (void)xb_add(&bar[XB_XCNT(b.x)], 1u);
    return b;
}
DI void xcd_barrier_complete(unsigned* bar, unsigned x, unsigned& nloc, unsigned& nx) {
    const unsigned G = gridDim.x * gridDim.y * gridDim.z;
    unsigned sum, cnt, mine, sp = 0u;
    for (;;) {
        sum = 0u; cnt = 0u; mine = 0u;
#pragma unroll
        for (unsigned j = 0; j < 16; ++j) { const unsigned c = xb_ld(&bar[XB_XCNT(j)]); sum += c; cnt += (c > 0u) ? 1u : 0u; mine = (j == x) ? c : mine; }
        if (sum == G) break;
        __builtin_amdgcn_s_sleep(1);
        if ((++sp & 255u) == 0u) { if (xb_ld(&bar[XB_TMO])) break; if (sp > XB_SPIN_CAP) { atomicAdd(&bar[XB_TMO], 1u); break; } }
    }
    nloc = mine > 0u ? mine : 1u; nx = cnt > 0u ? cnt : 1u;
}
DI void xcd_barrier(const XcdBarrier& b) {
    asm volatile("s_waitcnt vmcnt(0)" ::: "memory");
    __syncthreads();
    if (threadIdx.x == 0) {
        unsigned* bar = b.bar;
        __builtin_amdgcn_s_waitcnt(0);
        unsigned nloc = b.st[0], nx = b.st[1];
        if (nloc == 0u) { xcd_barrier_complete(bar, b.x, nloc, nx); b.st[0] = nloc; b.st[1] = nx; }
        const unsigned old = xb_add(&bar[XB_XSUB(b.x)], 1u);
        const unsigned gen = old / nloc;
        if (old + 1u == (gen + 1u) * nloc) {
            __builtin_amdgcn_fence(__ATOMIC_RELEASE, "agent");
            asm volatile("s_waitcnt vmcnt(0)" ::: "memory");
            const unsigned og = xb_add(&bar[XB_TOP], 1u);
            const unsigned tg = og / nx;
            if (og + 1u == (tg + 1u) * nx) xb_add(&bar[XB_TOPGEN], 1u);
            else XB_SPIN(xb_ld(&bar[XB_TOPGEN]) == tg, bar);
            __builtin_amdgcn_fence(__ATOMIC_ACQUIRE, "agent");
            xb_add(&bar[XB_XGEN(b.x)], 1u);
            asm volatile("s_waitcnt vmcnt(0)" ::: "memory");
        } else {
            XB_SPIN(xb_ld(&bar[XB_XGEN(b.x)]) == gen, bar);
            __builtin_amdgcn_fence(__ATOMIC_ACQUIRE, "agent");
            asm volatile("s_waitcnt vmcnt(0)" ::: "memory");
        }
    }
    __syncthreads();
}

__device__ __forceinline__ void ph_init(const P& p, char* lds) {
  const int tid = TIDX();
  float* sc = (float*)lds;
  float* red = sc + 3072;
  for (int i = tid; i < 3072; i += 512) { const int r = i >> 10, k = i & 1023; const float v = r < 2 ? p.c[r * 1024 + k] : p.c_ctx[k]; sc[i] = siluf(v); }
  __syncthreads();
  float* mods = (float*)(p.ws + OFF_MODS);
  for (int job = BIDX(); job < 192; job += GDIM()) {
    const int col = job * 128 + (tid & 127), kq = tid >> 7;
    const int L = col / 6144, cl = col - L * 6144;
    const float* w = p.mod_w + ((size_t)L * 1024 + kq * 256) * 6144 + cl;
    float a0 = 0.f, a1 = 0.f, a2 = 0.f;
#pragma unroll 8
    for (int k = 0; k < 256; ++k) { const float wv = w[(size_t)k * 6144]; const int kk = kq * 256 + k; a0 += sc[kk] * wv; a1 += sc[1024 + kk] * wv; a2 += sc[2048 + kk] * wv; }
    red[(kq * 3 + 0) * 128 + (tid & 127)] = a0; red[(kq * 3 + 1) * 128 + (tid & 127)] = a1; red[(kq * 3 + 2) * 128 + (tid & 127)] = a2;
    __syncthreads();
    if (tid < 384) { const int r = tid >> 7, cc = tid & 127; const int c2 = job * 128 + cc; const int L2 = c2 / 6144, cl2 = c2 - L2 * 6144;
      const float s = red[(0 * 3 + r) * 128 + cc] + red[(1 * 3 + r) * 128 + cc] + red[(2 * 3 + r) * 128 + cc] + red[(3 * 3 + r) * 128 + cc] + p.mod_b[L2 * 6144 + cl2];
      mods[((size_t)L2 * 3 + r) * 6144 + cl2] = s; }
    __syncthreads();
  }
  f32x4* xr = (f32x4*)(p.ws + OFF_XRES);
  for (size_t i = (size_t)BIDX() * 512 + tid; i < (size_t)MROWS * 256; i += (size_t)GDIM() * 512) {
    const int R = (int)(i >> 8), c4 = (int)(i & 255); const int b = R >= TB ? 1 : 0, pp = R - b * TB;
    const float* src = pp < CTXL ? p.ctx + ((size_t)b * CTXL + pp) * 1024 : p.x + ((size_t)b * LAT + (pp - CTXL)) * 1024;
    xr[i] = *(const f32x4*)(src + c4 * 4);
  }
}

DI int rec_src_col(int n) { if (n < 2048) return n; if (n < 3584) return n + 16; if (n < 3600) return 2048 + (n - 3584); if (n < 3632) return n; return -1; }
__device__ __forceinline__ void cvt_weight(const float* __restrict__ W, bf16_t* __restrict__ Wt, int K, int Nsrc, int Npad, bool perm, int skipb) {
  const size_t items = (size_t)Npad * (K >> 3);
  const int bid = BIDX() - skipb, nb = GDIM() - skipb;
  if (bid < 0) return;
  for (size_t it = (size_t)bid * 512 + TIDX(); it < items; it += (size_t)nb * 512) {
    const int n = (int)(it % Npad), kb = (int)(it / Npad);
    const int s = perm ? rec_src_col(n) : n;
    float v[8];
#pragma unroll
    for (int j = 0; j < 8; ++j) v[j] = s >= 0 ? W[(size_t)(kb * 8 + j) * Nsrc + s] : 0.f;
    u32x4 w = {cvtpk(v[0], v[1]), cvtpk(v[2], v[3]), cvtpk(v[4], v[5]), cvtpk(v[6], v[7])};
    *(u32x4*)(Wt + (size_t)n * K + kb * 8) = w;
  }
}

__device__ __forceinline__ void gemm_ctx_split(char* lds, const bf16_t* __restrict__ A, int lda, const bf16_t* __restrict__ Bt, int ldb, int Ks, float* __restrict__ PART) {
  const int tid = TIDX(), wid = tid >> 6, lane = tid & 63, r32 = lane & 31, hi = lane >> 5;
  const int wm = wid >> 1, wn = wid & 1;
  const int nk = Ks >> 6;
  constexpr int RS = 144, ASZ = 256 * RS, BSZ = 128 * RS, STG = ASZ + BSZ;
  const int srow = tid >> 3, spc = tid & 7;
  const int w = BIDX(); const int ks = w >> 4, j = w & 15; const int pm = (j >> 3) ? 33 : 0, pn = j & 7;
  const bf16_t* Ab = A + (size_t)(pm * 256 + srow) * lda + (size_t)ks * Ks + spc * 8;
  const bf16_t* Bb = Bt + (size_t)(pn * 128 + srow) * ldb + (size_t)ks * Ks + spc * 8;
  f32x16 acc00 = {}, acc01 = {}, acc10 = {}, acc11 = {};
  bf16x8 ra0, ra1, ra2, ra3, rb0, rb1;
#define GLOAD(kt) do { const int ko = (kt) * 64; ra0 = *(const bf16x8*)(Ab + ko); ra1 = *(const bf16x8*)(Ab + (size_t)64 * lda + ko); ra2 = *(const bf16x8*)(Ab + (size_t)128 * lda + ko); \
    ra3 = *(const bf16x8*)(Ab + (size_t)192 * lda + ko); rb0 = *(const bf16x8*)(Bb + ko); rb1 = *(const bf16x8*)(Bb + (size_t)64 * ldb + ko); } while (0)
#define SWRITE(buf) do { char* sb = lds + (buf) * STG + srow * RS + spc * 16; *(bf16x8*)(sb) = ra0; *(bf16x8*)(sb + 64 * RS) = ra1; *(bf16x8*)(sb + 128 * RS) = ra2; *(bf16x8*)(sb + 192 * RS) = ra3; \
    *(bf16x8*)(sb + ASZ) = rb0; *(bf16x8*)(sb + ASZ + 64 * RS) = rb1; } while (0)
  GLOAD(0); SWRITE(0); __syncthreads();
  for (int kt = 0; kt < nk; ++kt) {
    const int cur = kt & 1;
    if (kt + 1 < nk) GLOAD(kt + 1);
    const char* ab = lds + cur * STG + (64 * wm + r32) * RS + hi * 16;
    const char* bb = lds + cur * STG + ASZ + (64 * wn + r32) * RS + hi * 16;
#pragma unroll
    for (int k4 = 0; k4 < 4; ++k4) {
      const bf16x8 a0 = *(const bf16x8*)(ab + k4 * 32), a1 = *(const bf16x8*)(ab + 32 * RS + k4 * 32);
      const bf16x8 b0 = *(const bf16x8*)(bb + k4 * 32), b1 = *(const bf16x8*)(bb + 32 * RS + k4 * 32);
      acc00 = MFMA32(a0, b0, acc00); acc01 = MFMA32(a0, b1, acc01); acc10 = MFMA32(a1, b0, acc10); acc11 = MFMA32(a1, b1, acc11);
    }
    if (kt + 1 < nk) SWRITE(cur ^ 1);
    __syncthreads();
  }
#undef GLOAD
#undef SWRITE
  float* pb = PART + ((size_t)ks * 512 + (pm ? 256 : 0) + 64 * wm) * 1024 + pn * 128 + 64 * wn + r32;
#pragma unroll
  for (int r = 0; r < 16; ++r) { float* q = pb + (size_t)crow(r, hi) * 1024;
    q[0] = acc00[r]; q[32] = acc01[r]; q[32 * 1024] = acc10[r]; q[32 * 1024 + 32] = acc11[r]; }
}

__device__ __forceinline__ void ph_ctx_fold_norm(const P& p, int L, int which, const float* __restrict__ part, int nsplit, const float* __restrict__ gate) {
  const int tid = TIDX(), wid = tid >> 6, lane = tid & 63;
  float* xr = (float*)(p.ws + OFF_XRES); bf16_t* hb = (bf16_t*)(p.ws + OFF_HBF);
  const float* mods = (const float*)(p.ws + OFF_MODS) + (size_t)L * 3 * 6144;
  for (int cr = BIDX() * 8 + wid; cr < 2 * CTXL; cr += GDIM() * 8) {
    const int R = cr < CTXL ? cr : TB + (cr - CTXL);
    float* row = xr + (size_t)R * 1024 + lane * 4;
    const float* pr = part + (size_t)cr * 1024 + lane * 4;
    f32x4 v[4], a[4];
#pragma unroll
    for (int i = 0; i < 4; ++i) { v[i] = *(const f32x4*)(row + i * 256); a[i] = *(const f32x4*)(pr + i * 256); }
    for (int sp = 1; sp < nsplit; ++sp) {
#pragma unroll
      for (int i = 0; i < 4; ++i) a[i] += *(const f32x4*)(pr + (size_t)sp * 512 * 1024 + i * 256);
    }
    float ss = 0.f;
#pragma unroll
    for (int i = 0; i < 4; ++i) { v[i] += *(const f32x4*)(gate + 2 * 6144 + i * 256 + lane * 4) * a[i]; *(f32x4*)(row + i * 256) = v[i];
      ss += v[i][0] * v[i][0] + v[i][1] * v[i][1] + v[i][2] * v[i][2] + v[i][3] * v[i][3]; }
    ss = wave_sum(ss);
    const float rs = rsqrtf(ss * (1.f / 1024.f) + EPSF);
    const float* mr = mods + (size_t)2 * 6144 + which * 3072 + lane * 4;
#pragma unroll
    for (int i = 0; i < 4; ++i) { const f32x4 sh = *(const f32x4*)(mr + i * 256), scl = *(const f32x4*)(mr + 1024 + i * 256);
      float o[4];
#pragma unroll
      for (int j = 0; j < 4; ++j) o[j] = v[i][j] * rs * (1.f + scl[j]) + sh[j];
      uint2 w; w.x = cvtpk(o[0], o[1]); w.y = cvtpk(o[2], o[3]);
      *(uint2*)(hb + (size_t)R * 1024 + i * 256 + lane * 4) = w; }
  }
}

__device__ __forceinline__ void ph_norm(const P& p, int L, int which, int mode, int skipb) {
  const int tid = TIDX(), wid = tid >> 6, lane = tid & 63, l16 = lane & 15, sub = lane >> 4;
  const float* xr = (const float*)(p.ws + OFF_XRES);
  bf16_t* hb = (bf16_t*)(p.ws + OFF_HBF);
  const float* mods = (const float*)(p.ws + OFF_MODS) + (size_t)L * 3 * 6144;
  const int bid = BIDX() - skipb, nb = GDIM() - skipb;
  if (bid < 0) return;
  const int nquads = mode == 0 ? MROWS / 4 : (mode == 1 ? 2 * LAT / 4 : 2 * CTXL / 4);
  for (int q = bid * 8 + wid; q < nquads; q += nb * 8) {
    int R4;
    if (mode == 0) R4 = q * 4; else if (mode == 1) R4 = q < LAT / 4 ? CTXL + q * 4 : TB + CTXL + (q - LAT / 4) * 4; else R4 = q < CTXL / 4 ? q * 4 : TB + (q - CTXL / 4) * 4;
    const int R = R4 + sub;
    const float* row = xr + (size_t)R * 1024 + l16 * 4;
    f32x4 v[16]; float ss = 0.f;
#pragma unroll
    for (int i = 0; i < 16; ++i) v[i] = *(const f32x4*)(row + i * 64);
#pragma unroll
    for (int i = 0; i < 16; ++i) ss += v[i][0] * v[i][0] + v[i][1] * v[i][1] + v[i][2] * v[i][2] + v[i][3] * v[i][3];
    ss += __shfl_xor(ss, 1); ss += __shfl_xor(ss, 2); ss += __shfl_xor(ss, 4); ss += __shfl_xor(ss, 8);
    const float rs = rsqrtf(ss * (1.f / 1024.f) + EPSF);
    const float* mr = mods + (size_t)modrow_of(R) * 6144 + which * 3072 + l16 * 4;
    bf16_t* dst = hb + (size_t)R * 1024 + l16 * 4;
#pragma unroll
    for (int i = 0; i < 16; ++i) { const f32x4 sh = *(const f32x4*)(mr + i * 64), scl = *(const f32x4*)(mr + 1024 + i * 64);
      float o[4];
#pragma unroll
      for (int j = 0; j < 4; ++j) o[j] = v[i][j] * rs * (1.f + scl[j]) + sh[j];
      uint2 w; w.x = cvtpk(o[0], o[1]); w.y = cvtpk(o[2], o[3]);
      *(uint2*)(dst + i * 64) = w; }
  }
}

struct EpiRec { bf16_t* P1; bf16_t* P2; float* SM;
  DI void operator()(int row, int col, float v) const {
    if (col < 1536) P1[(size_t)row * 1536 + col] = f2bf(v);
    else if (col < 3584) P2[(size_t)row * 2048 + (col - 1536)] = f2bf(v);
    else { const int lc = col - 3584; if (lc < 48) SM[(size_t)row * 64 + lc] = v; } } };
struct EpiBf { bf16_t* O; int ldc;
  DI void operator()(int row, int col, float v) const { O[(size_t)row * ldc + col] = f2bf(v); } };
struct EpiRes { float* X; const float* gate;
  DI void operator()(int row, int col, float v) const { float* q = X + (size_t)row * 1024 + col; *q = *q + gate[(size_t)modrow_of(row) * 6144 + col] * v; } };

template <class Epi>
__device__ __forceinline__ void gemm_phase(char* lds, const bf16_t* __restrict__ A, int lda, const bf16_t* __restrict__ Bt, int K, int nN, const Epi epi, bool skipctx = false) {
  const int tid = TIDX(), wid = tid >> 6, lane = tid & 63, r32 = lane & 31, hi = lane >> 5;
  const int wm = wid >> 1, wn = wid & 1;
  const int nk = K >> 6;
  constexpr int RS = 144, ASZ = 256 * RS, BSZ = 128 * RS, STG = ASZ + BSZ;
  const int ntiles = (skipctx ? 64 : MROWS / 256) * nN;
  const int srow = tid >> 3, spc = tid & 7;
  for (int t = BIDX(); t < ntiles; t += GDIM()) {
    int pm = t / nN; const int pn = t - pm * nN; if (skipctx) pm = pm + 1 + (pm >= 32 ? 1 : 0);
    const bf16_t* Ab = A + (size_t)(pm * 256 + srow) * lda + spc * 8;
    const bf16_t* Bb = Bt + (size_t)(pn * 128 + srow) * K + spc * 8;
    f32x16 acc00 = {}, acc01 = {}, acc10 = {}, acc11 = {};
    bf16x8 ra0, ra1, ra2, ra3, rb0, rb1;
#define GLOAD(kt) do { const int ko = (kt) * 64; ra0 = *(const bf16x8*)(Ab + ko); ra1 = *(const bf16x8*)(Ab + (size_t)64 * lda + ko); ra2 = *(const bf16x8*)(Ab + (size_t)128 * lda + ko); \
    ra3 = *(const bf16x8*)(Ab + (size_t)192 * lda + ko); rb0 = *(const bf16x8*)(Bb + ko); rb1 = *(const bf16x8*)(Bb + (size_t)64 * K + ko); } while (0)
#define SWRITE(buf) do { char* sb = lds + (buf) * STG + srow * RS + spc * 16; *(bf16x8*)(sb) = ra0; *(bf16x8*)(sb + 64 * RS) = ra1; *(bf16x8*)(sb + 128 * RS) = ra2; *(bf16x8*)(sb + 192 * RS) = ra3; \
    *(bf16x8*)(sb + ASZ) = rb0; *(bf16x8*)(sb + ASZ + 64 * RS) = rb1; } while (0)
    GLOAD(0); SWRITE(0); __syncthreads();
    for (int kt = 0; kt < nk; ++kt) {
      const int cur = kt & 1;
      if (kt + 1 < nk) GLOAD(kt + 1);
      const char* ab = lds + cur * STG + (64 * wm + r32) * RS + hi * 16;
      const char* bb = lds + cur * STG + ASZ + (64 * wn + r32) * RS + hi * 16;
#pragma unroll
      for (int ks = 0; ks < 4; ++ks) {
        const bf16x8 a0 = *(const bf16x8*)(ab + ks * 32), a1 = *(const bf16x8*)(ab + 32 * RS + ks * 32);
        const bf16x8 b0 = *(const bf16x8*)(bb + ks * 32), b1 = *(const bf16x8*)(bb + 32 * RS + ks * 32);
        acc00 = MFMA32(a0, b0, acc00); acc01 = MFMA32(a0, b1, acc01); acc10 = MFMA32(a1, b0, acc10); acc11 = MFMA32(a1, b1, acc11);
      }
      if (kt + 1 < nk) SWRITE(cur ^ 1);
      __syncthreads();
    }
#undef GLOAD
#undef SWRITE
    const int row0 = pm * 256 + 64 * wm, col0 = pn * 128 + 64 * wn + r32;
#pragma unroll
    for (int r = 0; r < 16; ++r) { const int rr = row0 + crow(r, hi);
      epi(rr, col0, acc00[r]); epi(rr, col0 + 32, acc01[r]); epi(rr + 32, col0, acc10[r]); epi(rr + 32, col0 + 32, acc11[r]); }
  }
}

namespace pg8 {
#define PG8_LAS __attribute__((address_space(3)))
constexpr int BM = 256, BK = 64, HALF = 128, HTB = HALF * BK * 2  , STAGE_BYTES = 8 * HTB, NXCD = 8, WGM = 8;

__host__ __device__ __forceinline__ int lds_byte(int r, int c) { const int st = (r >> 4) * 2 + (c >> 5), rr = r & 15, cc = c & 31, ob = rr * 64 + cc * 2; return st * 1024 + (ob ^ (((ob >> 9) & 1) << 5)); }
__host__ __device__ __forceinline__ void stage_rc(int b, int& R, int& C) { const int st = b / 1024, sb = b % 1024, swz = sb ^ (((sb >> 9) & 1) << 5); R = (st >> 1) * 16 + swz / 64; C = (st & 1) * 32 + (swz % 64) / 2; }
__host__ __device__ __forceinline__ int perm32(int rho) { const int n = rho >> 4, i = rho & 15; return 8 * (i >> 2) + 4 * n + (i & 3); }
struct Unit { int pm, pn; };
struct Gemm { const bf16_t* A; const bf16_t* Bt; int M, N, K, lda; };

struct StaticOrder {
    int nM, nN, nwg, G, c;
    __host__ __device__ void init(int M, int N, int G_, int c_) { nM = M / BM; nN = N / BM; nwg = nM * nN; G = G_; c = c_; }
    __host__ __device__ bool next(int i, Unit& u) const {
        const long L = (long)i * G + c; if (L >= nwg) return false;
        int wgid = (int)L; { const int q = nwg / NXCD, r = nwg % NXCD, xcd = wgid % NXCD, off = wgid / NXCD; wgid = (xcd < r ? xcd * (q + 1) : r * (q + 1) + (xcd - r) * q) + off; }
        const int nig = WGM * nN, gid = wgid / nig, fm = gid * WGM, gsz = (nM - fm) < WGM ? (nM - fm) : WGM;
        u.pm = fm + ((wgid % nig) % gsz); u.pn = (wgid % nig) / gsz; return true;
    }
    __device__ __forceinline__ void a_ready(const Unit&) const {}
    __device__ __forceinline__ void done(const Unit&) const {}
};
template <class Epi, class Sched, bool ALIGN_EPI = false, bool SP2 = false>
__device__ __forceinline__ void gemm_phase(PG8_LAS unsigned char* lds, const Gemm g, const Sched& S, const Epi& E) {
    const int tid = TIDX(), wid = __builtin_amdgcn_readfirstlane(tid >> 6), lane = tid & 63, wr = wid >> 2, wc = wid & 3, fr = lane & 15, fq = lane >> 4;
    const int K = g.K, nt = K / BK;
    unsigned voffA[2], voffB[2];
#pragma unroll
    for (int i = 0; i < 2; ++i) { int R, C; stage_rc(tid * 16 + i * 8192, R, C); const int Rb = Epi::PERM ? ((R & ~31) + perm32(R & 31)) : R;
        voffA[i] = (unsigned)(R * g.lda + C) * 2u; voffB[i] = (unsigned)(Rb * K + C) * 2u; }
    const size_t kstep = (size_t)(BK * 2);
    const size_t hstep = (size_t)HALF * K * 2;
    const size_t tstep = 2 * hstep; const size_t hstepA = (size_t)HALF * g.lda * 2, tstepA = 2 * hstepA;
    const unsigned ldsw = (unsigned)wid * 1024u;
    const int aoff = lds_byte(wr * 64 + fr, fq * 8), boff = lds_byte(wc * 32 + fr, fq * 8);
#define PG8_SA(b, h) (((b) * 2 + (h)) * HTB)
#define PG8_SB(b, h) ((4 + (b) * 2 + (h)) * HTB)
#define PG8_STAGE(bufoff, gbase, voff) do { _Pragma("unroll") for (int _i = 0; _i < 2; ++_i) \
        __builtin_amdgcn_global_load_lds((const unsigned*)((const char*)(gbase) + (voff)[_i]), (PG8_LAS unsigned*)(lds + (bufoff) + ldsw + _i * 8192), 16, 0, 0); } while (0)
#define PG8_LDA(dst, b, h) do { _Pragma("unroll") for (int m = 0; m < 4; ++m) _Pragma("unroll") for (int k = 0; k < 2; ++k) dst[m][k] = *(const PG8_LAS bf16x8*)(lds + PG8_SA(b, h) + aoff + m * 2048 + k * 1024); } while (0)
#define PG8_LDB(dst, b, h) do { _Pragma("unroll") for (int n = 0; n < 2; ++n) _Pragma("unroll") for (int k = 0; k < 2; ++k) dst[n][k] = *(const PG8_LAS bf16x8*)(lds + PG8_SB(b, h) + boff + n * 2048 + k * 1024); } while (0)
#define PG8_MMA(ai, bj, At, Bt) do { __builtin_amdgcn_s_setprio(1); _Pragma("unroll") for (int m = 0; m < 4; ++m) _Pragma("unroll") for (int n = 0; n < 2; ++n) _Pragma("unroll") for (int k = 0; k < 2; ++k) \
        acc[ai][bj][m][n] = __builtin_amdgcn_mfma_f32_16x16x32_bf16(Bt[n][k], At[m][k], acc[ai][bj][m][n], 0, 0, 0); __builtin_amdgcn_s_setprio(0); } while (0)
#define PG8_WAIT_V(n) asm volatile("s_waitcnt vmcnt(" #n ")" ::: "memory")
#define PG8_WAIT_L(n) asm volatile("s_waitcnt lgkmcnt(" #n ")" ::: "memory")
#define PG8_BAR __builtin_amdgcn_s_barrier()
#define PG8_SCHED __builtin_amdgcn_sched_barrier(0)
    Unit cur, nxt; int ui = 0;
    if (!S.next(0, cur)) return;
    f32x4 acc[2][2][4][2];
#pragma unroll
    for (int a = 0; a < 2; ++a)
#pragma unroll
        for (int b = 0; b < 2; ++b)
#pragma unroll
            for (int m = 0; m < 4; ++m)
#pragma unroll
                for (int n = 0; n < 2; ++n) acc[a][b][m][n] = (f32x4){0.f, 0.f, 0.f, 0.f};
    bf16x8 At[4][2], B0[2][2], B1[2][2];
    const char* cA = (const char*)g.A + (size_t)cur.pm * tstepA; const char* cB = (const char*)g.Bt + (size_t)cur.pn * tstep;
    S.a_ready(cur);
    if constexpr (SP2) {
        PG8_STAGE(PG8_SB(0, 0), cB, voffB); PG8_STAGE(PG8_SB(0, 1), cB + hstep, voffB); PG8_STAGE(PG8_SA(0, 0), cA, voffA); PG8_STAGE(PG8_SA(0, 1), cA + hstepA, voffA);
        if (wr == 1) PG8_BAR;
        PG8_WAIT_V(2); PG8_BAR;
        PG8_STAGE(PG8_SB(1, 0), cB + kstep, voffB); PG8_STAGE(PG8_SA(1, 0), cA + kstep, voffA); PG8_STAGE(PG8_SB(1, 1), cB + hstep + kstep, voffB);
        PG8_WAIT_V(6); PG8_BAR;
    } else {
        PG8_STAGE(PG8_SB(0, 0), cB, voffB); PG8_STAGE(PG8_SA(0, 0), cA, voffA); PG8_STAGE(PG8_SB(0, 1), cB + hstep, voffB); PG8_STAGE(PG8_SA(0, 1), cA + hstepA, voffA);
        if (wr == 1) PG8_BAR;
        PG8_WAIT_V(4); PG8_BAR;
        PG8_STAGE(PG8_SB(1, 0), cB + kstep, voffB); PG8_STAGE(PG8_SA(1, 0), cA + kstep, voffA); PG8_STAGE(PG8_SB(1, 1), cB + hstep + kstep, voffB);
        PG8_WAIT_V(6); PG8_BAR;
    }
    for (;;) {
        const bool has_next = S.next(ui + 1, nxt);
        const char* nA = has_next ? (const char*)g.A + (size_t)nxt.pm * tstepA : cA; const char* nB = has_next ? (const char*)g.Bt + (size_t)nxt.pn * tstep : cB;
        for (int t = 0; t < nt; t += 2) {
            const bool last = (t == nt - 2);
            const char* a1 = cA + (size_t)(t + 1) * kstep;
            const char* a2 = last ? nA : cA + (size_t)(t + 2) * kstep; const char* b2 = last ? nB : cB + (size_t)(t + 2) * kstep;
            const char* a3 = a2 + kstep; const char* b3 = b2 + kstep;
            if (last && has_next) S.a_ready(nxt);
            if constexpr (SP2) {
            PG8_LDB(B0, 0, 0); PG8_LDB(B1, 0, 1); PG8_SCHED; PG8_LDA(At, 0, 0); PG8_STAGE(PG8_SA(1, 1), a1 + hstepA, voffA);
            PG8_WAIT_V(8); PG8_WAIT_L(0); PG8_BAR; PG8_MMA(0, 0, At, B0); PG8_MMA(0, 1, At, B1); PG8_BAR; PG8_SCHED;
            PG8_LDA(At, 0, 1); PG8_STAGE(PG8_SB(0, 0), b2, voffB); PG8_STAGE(PG8_SB(0, 1), b2 + hstep, voffB); PG8_STAGE(PG8_SA(0, 0), a2, voffA);
            PG8_WAIT_V(8); PG8_WAIT_L(0); PG8_BAR; PG8_MMA(1, 0, At, B0); PG8_MMA(1, 1, At, B1); PG8_BAR; PG8_SCHED;
            PG8_LDB(B0, 1, 0); PG8_LDB(B1, 1, 1); PG8_SCHED; PG8_LDA(At, 1, 0); PG8_STAGE(PG8_SA(0, 1), a2 + hstepA, voffA);
            PG8_WAIT_V(8); PG8_WAIT_L(0); PG8_BAR; PG8_MMA(0, 0, At, B0); PG8_MMA(0, 1, At, B1); PG8_BAR; PG8_SCHED;
            PG8_LDA(At, 1, 1); PG8_STAGE(PG8_SB(1, 0), b3, voffB); PG8_STAGE(PG8_SB(1, 1), b3 + hstep, voffB); PG8_STAGE(PG8_SA(1, 0), a3, voffA);
            PG8_WAIT_V(8); PG8_WAIT_L(0); PG8_BAR; PG8_MMA(1, 0, At, B0); PG8_MMA(1, 1, At, B1); PG8_BAR; PG8_SCHED;
            } else {
            PG8_LDB(B0, 0, 0); PG8_SCHED; PG8_LDA(At, 0, 0); PG8_STAGE(PG8_SA(1, 1), a1 + hstepA, voffA);
            PG8_WAIT_L(8); PG8_BAR; PG8_WAIT_L(0); PG8_MMA(0, 0, At, B0); PG8_BAR; PG8_SCHED;
            PG8_LDB(B1, 0, 1); PG8_STAGE(PG8_SB(0, 0), b2, voffB);
            PG8_BAR; PG8_WAIT_L(0); PG8_MMA(0, 1, At, B1); PG8_BAR;
            PG8_LDA(At, 0, 1); PG8_STAGE(PG8_SA(0, 0), a2, voffA);
            PG8_BAR; PG8_WAIT_L(0); PG8_MMA(1, 0, At, B0); PG8_BAR; PG8_SCHED;
            PG8_STAGE(PG8_SB(0, 1), b2 + hstep, voffB);
            PG8_WAIT_V(6); PG8_BAR; PG8_MMA(1, 1, At, B1); PG8_BAR;
            PG8_LDB(B0, 1, 0); PG8_SCHED; PG8_LDA(At, 1, 0); PG8_STAGE(PG8_SA(0, 1), a2 + hstepA, voffA);
            PG8_WAIT_L(8); PG8_BAR; PG8_WAIT_L(0); PG8_MMA(0, 0, At, B0); PG8_BAR; PG8_SCHED;
            PG8_LDB(B1, 1, 1); PG8_STAGE(PG8_SB(1, 0), b3, voffB);
            PG8_BAR; PG8_WAIT_L(0); PG8_MMA(0, 1, At, B1); PG8_BAR;
            PG8_LDA(At, 1, 1); PG8_STAGE(PG8_SA(1, 0), a3, voffA);
            PG8_BAR; PG8_WAIT_L(0); PG8_MMA(1, 0, At, B0); PG8_BAR; PG8_SCHED;
            PG8_STAGE(PG8_SB(1, 1), b3 + hstep, voffB);
            PG8_WAIT_V(6); PG8_BAR; PG8_MMA(1, 1, At, B1); PG8_BAR;
            }
        }
        if constexpr (ALIGN_EPI) { if (wr == 0) PG8_BAR; }
        if constexpr (!Epi::AFTER_DRAIN) { E(acc, cur, wr, wc, fr, fq); S.done(cur); }
        if (!has_next) break;
#pragma unroll
        for (int a = 0; a < 2; ++a)
#pragma unroll
            for (int b = 0; b < 2; ++b)
#pragma unroll
                for (int m = 0; m < 4; ++m)
#pragma unroll
                    for (int n = 0; n < 2; ++n) acc[a][b][m][n] = (f32x4){0.f, 0.f, 0.f, 0.f};
        cur = nxt; cA = nA; cB = nB; ++ui;
        if constexpr (ALIGN_EPI) { if (wr == 1) PG8_BAR; }
    }
    PG8_WAIT_V(0);
    if constexpr (!ALIGN_EPI) { if (wr == 0) PG8_BAR; }
    PG8_BAR;
    if constexpr (Epi::AFTER_DRAIN) { E.fused(acc, cur, wr, wc, fr, fq, lds, wid, lane); S.done(cur); }
#undef PG8_SA
#undef PG8_SB
#undef PG8_STAGE
#undef PG8_LDA
#undef PG8_LDB
#undef PG8_MMA
#undef PG8_WAIT_V
#undef PG8_WAIT_L
#undef PG8_BAR
#undef PG8_SCHED
}
struct SchedX { StaticOrder so; int mode;
  __device__ __forceinline__ bool next(int i, Unit& u) const {
    if (mode == 2) { if (i != 0 || so.c >= 8) return false; u.pm = (so.c >> 2) ? 33 : 0; u.pn = so.c & 3; return true; }
    if (!so.next(i, u)) return false; if (mode == 1) u.pm = u.pm + 1 + (u.pm >= 32 ? 1 : 0); return true; }
  __device__ __forceinline__ void a_ready(const Unit&) const {}
  __device__ __forceinline__ void done(const Unit&) const {} };
}
struct EpiRec8 { static constexpr bool PERM = false, AFTER_DRAIN = false; bf16_t* P1; bf16_t* P2; float* SM;
  DI void operator()(const f32x4 (&acc)[2][2][4][2], const pg8::Unit& u, int wr, int wc, int fr, int fq) const {
#pragma unroll
    for (int ai = 0; ai < 2; ++ai)
#pragma unroll
      for (int m = 0; m < 4; ++m) { const size_t row = (size_t)u.pm * 256 + ai * 128 + wr * 64 + m * 16 + fr;
#pragma unroll
        for (int bj = 0; bj < 2; ++bj)
#pragma unroll
          for (int n = 0; n < 2; ++n) { const int col = u.pn * 256 + bj * 128 + wc * 32 + n * 16 + fq * 4; const f32x4 v = acc[ai][bj][m][n];
            if (u.pn < 6) { uint2 w; w.x = cvtpk(v[0], v[1]); w.y = cvtpk(v[2], v[3]); *(uint2*)(P1 + row * 1536 + col) = w; }
            else if (u.pn < 14) { uint2 w; w.x = cvtpk(v[0], v[1]); w.y = cvtpk(v[2], v[3]); *(uint2*)(P2 + row * 2048 + (col - 1536)) = w; }
            else { const int lc = col - 3584; if (lc < 48) *(f32x4*)(SM + row * 64 + lc) = v; } } } } };
struct EpiBf8 { static constexpr bool PERM = false, AFTER_DRAIN = false; bf16_t* O; int ldc;
  DI void operator()(const f32x4 (&acc)[2][2][4][2], const pg8::Unit& u, int wr, int wc, int fr, int fq) const {
#pragma unroll
    for (int ai = 0; ai < 2; ++ai)
#pragma unroll
      for (int m = 0; m < 4; ++m) { const size_t row = (size_t)u.pm * 256 + ai * 128 + wr * 64 + m * 16 + fr;
#pragma unroll
        for (int bj = 0; bj < 2; ++bj)
#pragma unroll
          for (int n = 0; n < 2; ++n) { const int col = u.pn * 256 + bj * 128 + wc * 32 + n * 16 + fq * 4; const f32x4 v = acc[ai][bj][m][n];
            uint2 w; w.x = cvtpk(v[0], v[1]); w.y = cvtpk(v[2], v[3]); *(uint2*)(O + row * ldc + col) = w; } } } };
struct EpiRes8 { static constexpr bool PERM = false, AFTER_DRAIN = false; float* X; const float* gate;
  DI void operator()(const f32x4 (&acc)[2][2][4][2], const pg8::Unit& u, int wr, int wc, int fr, int fq) const {
    const float* gr = gate + (size_t)modrow_of(u.pm * 256) * 6144;
#pragma unroll
    for (int bj = 0; bj < 2; ++bj)
#pragma unroll
      for (int n = 0; n < 2; ++n) { const int col = u.pn * 256 + bj * 128 + wc * 32 + n * 16 + fq * 4; const f32x4 gv = *(const f32x4*)(gr + col);
#pragma unroll
        for (int ai = 0; ai < 2; ++ai)
#pragma unroll
          for (int m = 0; m < 4; ++m) { const size_t row = (size_t)u.pm * 256 + ai * 128 + wr * 64 + m * 16 + fr;
            f32x4* q = (f32x4*)(X + row * 1024 + col); *q = *q + gv * acc[ai][bj][m][n]; } } } };
template <class Epi>
__device__ __forceinline__ void gemm8(char* lds, const bf16_t* A, int lda, const bf16_t* Bt, int K, int N, int mode, const Epi& E) {
  pg8::Gemm g{A, Bt, mode == 1 ? 16384 : MROWS, N, K, lda};
  pg8::SchedX S; S.so.init(g.M, N, GDIM(), BIDX()); S.mode = mode;
  pg8::gemm_phase<Epi, pg8::SchedX, true, true>((PG8_LAS unsigned char*)lds, g, S, E);
}

__device__ __forceinline__ void ph_dnprep(const P& p, char* lds, int e) {
  const int tid = TIDX(), wid = tid >> 6, lane = tid & 63;
  const bf16_t* P1 = (const bf16_t*)(p.ws + OFF_D + D_P1);
  bf16_t* QQ = (bf16_t*)(p.ws + OFF_D + D_QQ); bf16_t* QK = (bf16_t*)(p.ws + OFF_D + D_QK); bf16_t* QV = (bf16_t*)(p.ws + OFF_D + D_QV);
  bf16_t* KT = (bf16_t*)(p.ws + OFF_D + D_KT);
  const float* SM = (const float*)(p.ws + OFF_SM); float* GB = (float*)(p.ws + OFF_GB);
  const float* cw = p.rec_conv + (size_t)e * 3 * 1536;
  bf16_t* kl = (bf16_t*)lds;
  for (int job = BIDX(); job < MROWS / 32; job += GDIM()) {
    const int R0 = job * 32;
    for (int tt = 0; tt < 4; ++tt) {
      const int tl = wid * 4 + tt, R = R0 + tl; const int b = R >= TB ? 1 : 0, pp = R - b * TB;
      const bool hasp = !(pp == 0 || pp == CTXL), hasn = !(pp == CTXL - 1 || pp == TB - 1);
#pragma unroll
      for (int part = 0; part < 3; ++part) {
        const int ch = part * 512 + lane * 8;
        const bf16x8 zc = *(const bf16x8*)(P1 + (size_t)R * 1536 + ch);
        bf16x8 zp = {}, zn = {};
        if (hasp) zp = *(const bf16x8*)(P1 + (size_t)(R - 1) * 1536 + ch);
        if (hasn) zn = *(const bf16x8*)(P1 + (size_t)(R + 1) * 1536 + ch);
        float o[8]; float ss = 0.f;
#pragma unroll
        for (int j = 0; j < 8; ++j) { const float a = bf2f((bf16_t)zp[j]) * cw[ch + j] + bf2f((bf16_t)zc[j]) * cw[1536 + ch + j] + bf2f((bf16_t)zn[j]) * cw[3072 + ch + j];
          o[j] = siluf(a); ss += o[j] * o[j]; }
        if (part < 2) {
          ss += __shfl_xor(ss, 1); ss += __shfl_xor(ss, 2); ss += __shfl_xor(ss, 4); ss += __shfl_xor(ss, 8);
          float sc = rsqrtf(ss + EPSF); if (part == 0) sc *= 0.08838834764831845f;
#pragma unroll
          for (int j = 0; j < 8; ++j) o[j] *= sc;
        }
        u32x4 w = {cvtpk(o[0], o[1]), cvtpk(o[2], o[3]), cvtpk(o[4], o[5]), cvtpk(o[6], o[7])};
        bf16_t* dst = part == 0 ? QQ : (part == 1 ? QK : QV);
        *(u32x4*)(dst + (size_t)R * 512 + lane * 8) = w;
        if (part == 1) *(u32x4*)(kl + tl * 512 + lane * 8) = w;
      }
      if (lane < 16) {
        const int q = lane & 7;
        if (lane < 8) { const float da = SM[(size_t)R * 64 + q]; GB[(size_t)R * 16 + q] = -expf(p.dn_a_log[e * 8 + q]) * softplusf(da + p.dn_dt_bias[e * 8 + q]); }
        else { const float db = SM[(size_t)R * 64 + 8 + q]; GB[(size_t)R * 16 + 8 + q] = sigmf(db); }
      }
    }
    __syncthreads();
    {
      const int b = R0 >= TB ? 1 : 0, c = (R0 - b * TB) / 64, half = ((R0 - b * TB) >> 5) & 1; const int h = tid >> 7, dk = tid & 127;
      bf16_t* dst = KT + ((((size_t)b * 4 + h) * NCH + c) * 128 + dk) * 64 + half * 32;
#pragma unroll
      for (int g8 = 0; g8 < 4; ++g8) { unsigned w[4];
#pragma unroll
        for (int j = 0; j < 4; ++j) { const unsigned lo = kl[(g8 * 8 + 2 * j) * 512 + tid], hi2 = kl[(g8 * 8 + 2 * j + 1) * 512 + tid]; w[j] = lo | (hi2 << 16); }
        *(u32x4*)(dst + g8 * 8) = (u32x4){w[0], w[1], w[2], w[3]}; }
    }
    __syncthreads();
  }
}

__device__ __forceinline__ void ph_dn_d1(const P& p, char* lds) {
  const int tid = TIDX(), wid = tid >> 6, lane = tid & 63, r32 = lane & 31, hi = lane >> 5;
  const bf16_t* QQ = (const bf16_t*)(p.ws + OFF_D + D_QQ); const bf16_t* QK = (const bf16_t*)(p.ws + OFF_D + D_QK); const bf16_t* QV = (const bf16_t*)(p.ws + OFF_D + D_QV);
  const float* GB = (const float*)(p.ws + OFF_GB);
  bf16_t* W_ = (bf16_t*)(p.ws + OFF_D + D_W); bf16_t* U_ = (bf16_t*)(p.ws + OFF_HBF); bf16_t* INTRA = (bf16_t*)(p.ws + OFF_D + D_INTRA);
  float* SC = (float*)(p.ws + OFF_SC); float* GLS = (float*)(p.ws + OFF_GL);
  float* KK = (float*)lds; float* QKm = KK + 64 * 65; float* Ad = QKm + 64 * 65; float* Gs = Ad + 2 * 4096; float* Bs = Gs + 128;
  bf16_t* Vs = (bf16_t*)(Bs + 128); bf16_t* Ks = Vs + 64 * 128;
  for (int job = BIDX(); job < 8 * NCH; job += GDIM()) {
    const int b = job / (4 * NCH), h = (job / NCH) & 3, c = job % NCH;
    const size_t Rb = (size_t)b * TB + (size_t)c * 64;
    {
      const int srow = tid >> 4, spc = (tid & 15) * 8;
      const u32x4 v0 = *(const u32x4*)(QV + (Rb + srow) * 512 + h * 128 + spc), v1 = *(const u32x4*)(QV + (Rb + 32 + srow) * 512 + h * 128 + spc);
      const u32x4 k0 = *(const u32x4*)(QK + (Rb + srow) * 512 + h * 128 + spc), k1 = *(const u32x4*)(QK + (Rb + 32 + srow) * 512 + h * 128 + spc);
      *(u32x4*)(Vs + srow * 128 + spc) = v0; *(u32x4*)(Vs + (32 + srow) * 128 + spc) = v1;
      *(u32x4*)(Ks + srow * 128 + spc) = k0; *(u32x4*)(Ks + (32 + srow) * 128 + spc) = k1;
    }
    {
      const int w4 = wid & 3, mi = w4 & 1, ni = w4 >> 1;
      const bf16_t* As = wid < 4 ? QK : QQ;
      const bf16_t* arow = As + (Rb + 32 * mi + r32) * 512 + h * 128 + hi * 8;
      const bf16_t* brow = QK + (Rb + 32 * ni + r32) * 512 + h * 128 + hi * 8;
      f32x16 acc = {}; acc = mma_rows<8>(arow, brow, acc);
      float* dst = wid < 4 ? KK : QKm;
#pragma unroll
      for (int r = 0; r < 16; ++r) dst[(32 * mi + crow(r, hi)) * 65 + 32 * ni + r32] = acc[r];
    }
    if (tid < 128) { const int d = tid >> 6, ip = tid & 63, t = d ? 63 - ip : ip; float g = GB[(Rb + t) * 16 + d * 4 + h]; Bs[tid] = GB[(Rb + t) * 16 + 8 + d * 4 + h];
#pragma unroll
      for (int o = 1; o < 64; o <<= 1) { const float v = __shfl_up(g, o); g += ip >= o ? v : 0.f; }
      Gs[tid] = g; }
    __syncthreads();
    const int n0 = c, n1 = c < 4 ? 3 - c : 135 - c;
    const size_t cj0 = ((size_t)(0 * 2 + b) * 4 + h) * NCH + n0, cj1 = ((size_t)(1 * 2 + b) * 4 + h) * NCH + n1;
    for (int e2 = tid; e2 < 8192; e2 += 512) {
      const int d = e2 >> 12, ip = (e2 >> 6) & 63, jp = e2 & 63; const int i = d ? 63 - ip : ip, j = d ? 63 - jp : jp;
      const float dec = jp <= ip ? __expf(Gs[d * 64 + ip] - Gs[d * 64 + jp]) : 0.f;
      Ad[d * 4096 + ip * 64 + jp] = jp < ip ? Bs[d * 64 + ip] * KK[i * 65 + j] * dec : 0.f;
      const size_t cj = d ? cj1 : cj0;
      INTRA[(cj * 64 + ip) * 64 + jp] = f2bf(QKm[i * 65 + j] * dec);
    }
    if (tid < 128) { const int d = tid >> 6, ip = tid & 63; const size_t cj = d ? cj1 : cj0; const float gi = Gs[tid], gl = Gs[d * 64 + 63];
      SC[(cj * 64 + ip) * 2] = __expf(gi); SC[(cj * 64 + ip) * 2 + 1] = __expf(gl - gi); if (ip == 0) GLS[cj] = __expf(gl); }
    __syncthreads();
    {
      const int d = tid >> 8, cc = tid & 255; const size_t cj = d ? cj1 : cj0;
      int dofs = d * 64, aofs = d * 4096; asm volatile("" : "+v"(dofs), "+v"(aofs));
      float x[64];
      {
        int vofs = cc < 128 ? cc : 64 * 128 + (cc - 128); asm volatile("" : "+v"(vofs));
#pragma unroll
        for (int ip = 0; ip < 64; ++ip) x[ip] = bf2f(Vs[vofs + ip * 128]);
#pragma unroll
        for (int ip = 0; ip < 32; ++ip) { const float a_ = x[ip], b_ = x[63 - ip]; x[ip] = d ? b_ : a_; x[63 - ip] = d ? a_ : b_; }
        if (cc < 128) {
#pragma unroll
          for (int ip = 0; ip < 64; ++ip) x[ip] *= Bs[dofs + ip];
        } else {
#pragma unroll
          for (int ip = 0; ip < 64; ++ip) x[ip] *= Bs[dofs + ip] * __expf(Gs[dofs + ip]);
        }
      }
      const float* Arow = Ad + aofs;
#pragma unroll
      for (int ip = 1; ip < 64; ++ip) {
        float s = 0.f;
#pragma unroll
        for (int j4 = 0; j4 < (ip + 3) / 4; ++j4) { const f32x4 a = *(const f32x4*)(Arow + ip * 64 + 4 * j4);
          s += a[0] * x[4 * j4] + a[1] * x[4 * j4 + 1] + a[2] * x[4 * j4 + 2] + a[3] * x[4 * j4 + 3]; }
        x[ip] -= s;
      }
      bf16_t* dst = cc < 128 ? U_ + cj * 64 * 128 + cc : W_ + cj * 64 * 128 + (cc - 128);
#pragma unroll
      for (int ip = 0; ip < 64; ++ip) dst[ip * 128] = f2bf(x[ip]);
    }
    __syncthreads();
  }
}

typedef _Float16 h16x8 __attribute__((ext_vector_type(8)));
__device__ __forceinline__ void ph_gla_b(const P& p, char* lds, int e) {
  const int tid = TIDX(), wid = tid >> 6, lane = tid & 63;
  const float* SM = (const float*)(p.ws + OFF_SM);
  float* w2S = (float*)lds;
  float* b2S = w2S + 8192;
  for (int i = tid; i < 8192; i += 512) { const int d = i >> 12, hh = (i >> 10) & 3, r = (i >> 6) & 15, j = i & 63; w2S[i] = p.gla_w2[(((size_t)e * 2 + d) * 16 + r) * 256 + hh * 64 + j]; }
  if (tid < 512) b2S[tid] = p.gla_b2[(size_t)e * 512 + tid];
  __syncthreads();
  int jb = 8 * wid; asm volatile("" : "+v"(jb));
  for (int job = GDIM() - 1 - BIDX(); job < 16 * NCH; job += GDIM()) {
    const int n = job % NCH, sq = job / NCH; const int dir = sq >> 3, b = (sq >> 2) & 1, h = sq & 3;
    const int c = dir == 0 ? n : (n < 4 ? 3 - n : 135 - n);
    const size_t row = (size_t)b * TB + (size_t)c * 64 + (dir ? 63 - lane : lane);
    const float* gp = SM + row * 64 + 16 + dir * 16;
    const f32x4 g0 = *(const f32x4*)(gp), g1 = *(const f32x4*)(gp + 4), g2 = *(const f32x4*)(gp + 8), g3 = *(const f32x4*)(gp + 12);
    const float gg_[16] = {g0[0], g0[1], g0[2], g0[3], g1[0], g1[1], g1[2], g1[3], g2[0], g2[1], g2[2], g2[3], g3[0], g3[1], g3[2], g3[3]};
    const float* wb = w2S + (dir * 4 + h) * 1024 + jb; const float* bb2 = b2S + dir * 256 + h * 64 + jb;
    f32x4 sa = *(const f32x4*)(bb2), sb = *(const f32x4*)(bb2 + 4);
#pragma unroll
    for (int r = 0; r < 16; ++r) { const f32x4 wa = *(const f32x4*)(wb + r * 64), wq = *(const f32x4*)(wb + r * 64 + 4); sa += gg_[r] * wa; sb += gg_[r] * wq; }
    float la[8];
#pragma unroll
    for (int jj = 0; jj < 4; ++jj) { const float x0 = sa[jj], x1 = sb[jj];
      la[jj] = (fminf(x0, 0.f) - log1pf(expf(-fabsf(x0)))) * 0.0625f; la[4 + jj] = (fminf(x1, 0.f) - log1pf(expf(-fabsf(x1)))) * 0.0625f; }
#pragma unroll
    for (int o = 1; o < 64; o <<= 1) {
#pragma unroll
      for (int jj = 0; jj < 8; ++jj) { const float v = __shfl_up(la[jj], o); la[jj] += lane >= o ? v : 0.f; }
    }
    h16x8 hv;
#pragma unroll
    for (int jj = 0; jj < 8; ++jj) hv[jj] = (_Float16)la[jj];
    _Float16* dst = (_Float16*)(p.ws + (dir ? OFF_B16_1 : OFF_WC)) + ((((size_t)b * 4 + h) * NCH + n) * 64 + lane) * 64 + jb;
    *(h16x8*)dst = hv;
  }
}

struct DnSet { bf16x8 fa[8]; };
template <int ROLE>
__device__ __forceinline__ void dn_scan_t(const P& p, char* lds, int job) {
  const int tid = TIDX(), wid = tid >> 6, lane = tid & 63, r32 = lane & 31, hi = lane >> 5;
  const int dir = job >> 5, b = (job >> 4) & 1, h = (job >> 2) & 3, n0 = (job & 3) * 32;
  const bf16_t* QQ = (const bf16_t*)(p.ws + OFF_D + D_QQ); const bf16_t* KT = (const bf16_t*)(p.ws + OFF_D + D_KT);
  const bf16_t* W_ = (const bf16_t*)(p.ws + OFF_D + D_W); const bf16_t* U_ = (const bf16_t*)(p.ws + OFF_HBF); const bf16_t* INTRA = (const bf16_t*)(p.ws + OFF_D + D_INTRA);
  const float* SC = (const float*)(p.ws + OFF_SC); const float* GLS = (const float*)(p.ws + OFF_GL);
  bf16_t* DNO = (bf16_t*)(p.ws + OFF_D + D_DNO);
  bf16_t* ST = (bf16_t*)lds; bf16_t* vTa = ST + 32 * 136; bf16_t* vTb = vTa + 32 * 72;
  float* scS = (float*)(vTb + 32 * 72);
  bf16_t* uS = (bf16_t*)(scS + 256);
  bf16_t* inS = uS + 2 * 64 * 40;
  for (int i = tid; i < 32 * 136; i += 512) ST[i] = 0;
  f32x16 accS = {};
  const size_t seq = ((size_t)dir * 2 + b) * 4 + h;
  const int mi = wid & 1, di = wid - 4;
  constexpr int role = ROLE;
  const int tt = tid - 256;
  DnSet fs[3]; float gls[3] = {0.f, 0.f, 0.f};
  u32x4 stU[3], stI0[3]; float stS[3] = {0.f, 0.f, 0.f};
#define DN_CH(n_) const int n__ = (n_); const int c__ = dir == 0 ? n__ : (n__ < 4 ? 3 - n__ : 135 - n__); const size_t Rb__ = (size_t)b * TB + (size_t)c__ * 64; const size_t cj__ = seq * NCH + n__;
#define DN_LOAD(S, GL, n_) do { DN_CH(n_) \
    const int ipl__ = 32 * mi + r32, tl__ = dir ? 63 - ipl__ : ipl__; \
    const bf16_t* b0__ = W_ + cj__ * 8192 + (32 * mi + r32) * 128 + hi * 8; \
    const bf16_t* b1__ = QQ + (Rb__ + tl__) * 512 + h * 128 + hi * 8; \
    const bf16_t* b2__ = KT + ((((size_t)b * 4 + h) * NCH + c__) * 128 + 32 * (wid & 3) + r32) * 64 + hi * 8; \
    const bf16_t* bs__ = role == 0 ? b0__ : (role == 1 ? b1__ : b2__); \
    _Pragma("unroll") for (int ks = 0; ks < 8; ++ks) S.fa[ks] = *(const bf16x8*)(bs__ + ks * 16); \
    GL = GLS[cj__]; } while (0)
#define DN_STAGE_LD(q_, n_) do { DN_CH(n_) (void)Rb__; \
      stU[q_] = *(const u32x4*)(U_ + cj__ * 8192 + ((tid & 255) >> 2) * 128 + n0 + (tid & 3) * 8); \
      stI0[q_] = *(const u32x4*)(INTRA + cj__ * 4096 + (tid >> 3) * 64 + (tid & 7) * 8); \
      stS[q_] = SC[cj__ * 128 + (tid & 127)]; } while (0)
#define DN_STAGE_ST(q_, bf_) do { *(u32x4*)(inS + (bf_) * 4608 + (tid >> 3) * 72 + (tid & 7) * 8) = stI0[q_]; \
      if (ROLE < 2) *(u32x4*)(uS + (bf_) * 2560 + (tid >> 2) * 40 + (tid & 3) * 8) = stU[q_]; \
      if (ROLE == 0) scS[(bf_) * 128 + tid] = stS[q_]; } while (0)
#define DN_STEP(S, GL, n_, bf_) do { DN_CH(n_) (void)cj__; \
    const float* sc__ = scS + (bf_) * 128; \
    if (role < 2) { _Pragma("unroll") for (int r = 0; r < 16; ++r) accS[r] = 0.f; } \
    if (role < 2) { const bf16_t* sb__ = ST + r32 * 136 + hi * 8; \
      _Pragma("unroll") for (int ks = 0; ks < 8; ++ks) accS = MFMA32(S.fa[ks], *(const bf16x8*)(sb__ + ks * 16), accS); \
      if (role == 0) { const bf16_t* us__ = uS + (bf_) * 2560 + r32; \
        _Pragma("unroll") for (int r = 0; r < 16; ++r) { const int ip = 32 * mi + crow(r, hi); const float vn = bf2f(us__[ip * 40]) - accS[r]; \
          vTa[r32 * 72 + ip] = f2bf(vn); const int to = dir ? 63 - ip : ip; vTb[r32 * 72 + to] = f2bf(vn * sc__[ip * 2 + 1]); } } \
      else { _Pragma("unroll") for (int r = 0; r < 16; ++r) accS[r] *= sc__[(32 * mi + crow(r, hi)) * 2]; } } \
    LBAR(); \
    if (role == 1) { const bf16_t* vb__ = vTa + r32 * 72 + hi * 8; const bf16_t* ib__ = inS + (bf_) * 4608 + (32 * mi + r32) * 72 + hi * 8; \
      _Pragma("unroll") for (int ks = 0; ks < 4; ++ks) accS = MFMA32(*(const bf16x8*)(ib__ + ks * 16), *(const bf16x8*)(vb__ + ks * 16), accS); \
      _Pragma("unroll") for (int r = 0; r < 16; ++r) { const int ip = 32 * mi + crow(r, hi), t = dir ? 63 - ip : ip; \
        DNO[((size_t)dir * MROWS + Rb__ + t) * 512 + h * 128 + n0 + r32] = f2bf(accS[r]); } } \
    else if (role == 2) { const bf16_t* vb__ = vTb + r32 * 72 + hi * 8; \
      _Pragma("unroll") for (int r = 0; r < 16; ++r) accS[r] *= GL; \
      _Pragma("unroll") for (int ks = 0; ks < 4; ++ks) accS = MFMA32(S.fa[ks], *(const bf16x8*)(vb__ + ks * 16), accS); \
      _Pragma("unroll") for (int r = 0; r < 16; ++r) ST[r32 * 136 + 32 * di + crow(r, hi)] = f2bf(accS[r]); } \
    LBAR(); } while (0)
  DN_STAGE_LD(0, 0); DN_STAGE_ST(0, 0); DN_STAGE_LD(1, 1); DN_STAGE_LD(2, 2);
  DN_LOAD(fs[0], gls[0], 0); DN_LOAD(fs[1], gls[1], 1);
  __syncthreads();
  for (int nb6 = 0; nb6 < NCH; nb6 += 6) {
#pragma unroll
    for (int k = 0; k < 6; ++k) {
      const int n = nb6 + k; const int n2 = n + 2 < NCH ? n + 2 : NCH - 1; const int n3 = n + 3 < NCH ? n + 3 : NCH - 1;
      DN_STAGE_ST((k + 1) % 3, (k + 1) & 1);
      DN_STAGE_LD(k % 3, n3);
      DN_LOAD(fs[(k + 2) % 3], gls[(k + 2) % 3], n2);
      DN_STEP(fs[k % 3], gls[k % 3], n, k & 1);
    }
  }
#undef DN_CH
#undef DN_LOAD
#undef DN_STAGE_LD
#undef DN_STAGE_ST
#undef DN_STEP
}

__device__ __forceinline__ void dn_scan(const P& p, char* lds, int job) {
  const int wid = TIDX() >> 6;
  if (wid < 2) dn_scan_t<0>(p, lds, job); else if (wid < 4) dn_scan_t<1>(p, lds, job); else dn_scan_t<2>(p, lds, job);
}

DI float fast_logsig(float s) { return fminf(s, 0.f) - __logf(1.f + __expf(-fabsf(s))); }
struct GlaRegs { h16x8 ba, bb; bf16x8 qa, qb, ka, kb, v8; };
template <int ROLE>
__device__ __forceinline__ void gla_scan_t(const P& p, char* lds, int job, int e) {
  const int tid = TIDX(), wid = tid >> 6, lane = tid & 63, r32 = lane & 31, hi = lane >> 5;
  const int dir = job >> 5, b = (job >> 4) & 1, h = (job >> 2) & 3, n0 = (job & 3) * 32;
  const bf16_t* P2 = (const bf16_t*)(p.ws + OFF_D + D_P2); const float* SM = (const float*)(p.ws + OFF_SM);
  bf16_t* GLAO = (bf16_t*)(p.ws + OFF_D + D_GLAO);
  const _Float16* B16 = (const _Float16*)(p.ws + (dir ? OFF_B16_1 : OFF_WC));
  float* w2S = (float*)lds; float* b2S = w2S + 1024; float* aLb = b2S + 64;
  bf16_t* ops = (bf16_t*)(aLb + 128);
  constexpr int OPB = (4 * 64 + 32) * 72;
  bf16_t* attp = ops + 2 * OPB;
  bf16_t* STb = attp + 2 * 32 * 72;
  for (int i = tid; i < 2 * 32 * 72; i += 512) STb[i] = 0;
  f32x16 accS = {};
  __syncthreads();
  GlaRegs RG[3];
  int jb0 = 16 * (wid & 3); asm volatile("" : "+v"(jb0));
  int vtb0 = 8 * (wid & 3) * 72 + lane; asm volatile("" : "+v"(vtb0));
#define GLA_LOAD(R, n_) do { const int n__ = (n_) < NCH ? (n_) : NCH - 1; const int c__ = dir == 0 ? n__ : (n__ < 4 ? 3 - n__ : 135 - n__); const size_t row__ = (size_t)b * TB + (size_t)c__ * 64 + (dir ? 63 - lane : lane); \
    const _Float16* bp__ = B16 + ((((size_t)b * 4 + h) * NCH + n__) * 64 + lane) * 64 + 16 * (wid & 3); R.ba = *(const h16x8*)(bp__); R.bb = *(const h16x8*)(bp__ + 8); \
    const bf16_t* pr__ = P2 + row__ * 2048; R.qa = *(const bf16x8*)(pr__ + 512 + h * 64 + 16 * (wid & 3)); R.qb = *(const bf16x8*)(pr__ + 512 + h * 64 + 16 * (wid & 3) + 8); \
    R.ka = *(const bf16x8*)(pr__ + 768 + h * 64 + 16 * (wid & 3)); R.kb = *(const bf16x8*)(pr__ + 768 + h * 64 + 16 * (wid & 3) + 8); R.v8 = *(const bf16x8*)(pr__ + 1024 + h * 128 + n0 + 8 * (wid & 3)); } while (0)
#define GLA_HALF(R, BV, QV, KV, jb) do { \
    float eqe[8], eke[8], eqi[8]; \
    _Pragma("unroll") for (int jj = 0; jj < 8; ++jj) { const int j = (jb) + jj; const float bb = (float)BV[jj]; const float bm = __int_as_float(__builtin_amdgcn_readlane(__float_as_int(bb), 32)), bl = __int_as_float(__builtin_amdgcn_readlane(__float_as_int(bb), 63)); \
      const float q_ = bf2f((bf16_t)QV[jj]) * 0.125f, k_ = bf2f((bf16_t)KV[jj]); \
      eqe[jj] = q_ * __expf(bb - bm); eke[jj] = k_ * __expf(bm - bb); eqi[jj] = q_ * __expf(bb); ksT_[j * 72 + lane] = f2bf(k_ * __expf(bl - bb)); if (lane == 63) aL_[j] = __expf(bl); } \
    *(u32x4*)(qe_ + lane * 72 + (jb)) = (u32x4){cvtpk(eqe[0], eqe[1]), cvtpk(eqe[2], eqe[3]), cvtpk(eqe[4], eqe[5]), cvtpk(eqe[6], eqe[7])}; \
    *(u32x4*)(ke_ + lane * 72 + (jb)) = (u32x4){cvtpk(eke[0], eke[1]), cvtpk(eke[2], eke[3]), cvtpk(eke[4], eke[5]), cvtpk(eke[6], eke[7])}; \
    *(u32x4*)(qi_ + lane * 72 + (jb)) = (u32x4){cvtpk(eqi[0], eqi[1]), cvtpk(eqi[2], eqi[3]), cvtpk(eqi[4], eqi[5]), cvtpk(eqi[6], eqi[7])}; } while (0)
#define GLA_PREP(R, bf_) do { bf16_t* qe_ = ops + (bf_) * OPB; bf16_t* ke_ = qe_ + 64 * 72; bf16_t* qi_ = ke_ + 64 * 72; bf16_t* ksT_ = qi_ + 64 * 72; bf16_t* vT_ = ksT_ + 64 * 72; float* aL_ = aLb + (bf_) * 64; \
    GLA_HALF(R, R.ba, R.qa, R.ka, jb0); GLA_HALF(R, R.bb, R.qb, R.kb, jb0 + 8); \
    _Pragma("unroll") for (int q_ = 0; q_ < 8; ++q_) vT_[vtb0 + q_ * 72] = (bf16_t)R.v8[q_]; } while (0)
#define GLA_MMA(n_, bf_) do { const int nq__ = (n_); const int bf = (bf_); \
      const bf16_t* qe_ = ops + bf * OPB; const bf16_t* ke_ = qe_ + 64 * 72; const bf16_t* qi_ = ke_ + 64 * 72; const bf16_t* ksT_ = qi_ + 64 * 72; const bf16_t* vT_ = ksT_ + 64 * 72; const float* aL_ = aLb + bf * 64; \
      const bf16_t* STr = STb + bf * 32 * 72; bf16_t* STw = STb + (bf ^ 1) * 32 * 72; \
      if (ROLE == 1) { \
        const int mi = wid - 4; bf16_t* attw = attp + mi * 32 * 72; \
        const int c = dir == 0 ? nq__ : (nq__ < 4 ? 3 - nq__ : 135 - nq__); const size_t Rb = (size_t)b * TB + (size_t)c * 64; \
        f32x16 acc = {}; acc = mma_rows<4>(qi_ + (32 * mi + r32) * 72 + hi * 8, STr + r32 * 72 + hi * 8, acc); \
        { f32x16 a0 = {}; a0 = mma_rows<4>(qe_ + (32 * mi + r32) * 72 + hi * 8, ke_ + r32 * 72 + hi * 8, a0); \
          _Pragma("unroll") for (int r = 0; r < 16; ++r) { const int ipl = crow(r, hi); attw[ipl * 72 + r32] = f2bf((mi == 1 || r32 <= ipl) ? a0[r] : 0.f); } \
          f32x16 a1 = {}; if (mi == 1) a1 = mma_rows<4>(qe_ + (32 + r32) * 72 + hi * 8, ke_ + (32 + r32) * 72 + hi * 8, a1); \
          _Pragma("unroll") for (int r = 0; r < 16; ++r) { const int ipl = crow(r, hi); attw[ipl * 72 + 32 + r32] = f2bf((mi == 1 && r32 <= ipl) ? a1[r] : 0.f); } } \
        asm volatile("s_waitcnt lgkmcnt(0)" ::: "memory"); \
        acc = mma_rows<4>(attw + r32 * 72 + hi * 8, vT_ + r32 * 72 + hi * 8, acc); \
        _Pragma("unroll") for (int r = 0; r < 16; ++r) { const int ip = 32 * mi + crow(r, hi), t = dir ? 63 - ip : ip; \
          GLAO[((size_t)dir * MROWS + Rb + t) * 512 + h * 128 + n0 + r32] = f2bf(acc[r]); } \
      } else { \
        const int di = wid - 6; \
        _Pragma("unroll") for (int r = 0; r < 16; ++r) accS[r] *= aL_[32 * di + crow(r, hi)]; \
        accS = mma_rows<4>(ksT_ + (32 * di + r32) * 72 + hi * 8, vT_ + r32 * 72 + hi * 8, accS); \
        _Pragma("unroll") for (int r = 0; r < 16; ++r) STw[r32 * 72 + 32 * di + crow(r, hi)] = f2bf(accS[r]); \
      } } while (0)
  GLA_LOAD(RG[0], 0);
  if (ROLE == 0) { GLA_PREP(RG[0], 0); }
  GLA_LOAD(RG[1], 1); GLA_LOAD(RG[2], 2); GLA_LOAD(RG[0], 3);
  LBAR();
  for (int nb6 = 0; nb6 < NCH; nb6 += 6) {
#pragma unroll
    for (int k = 0; k < 6; ++k) {
      const int n = nb6 + k;
      if (ROLE == 0) { if (n + 1 < NCH) { GLA_PREP(RG[(k + 1) % 3], (k + 1) & 1); } } else { GLA_MMA(n, k & 1); }
      GLA_LOAD(RG[(k + 1) % 3], n + 4);
      LBAR();
    }
  }
#undef GLA_MMA
#undef GLA_LOAD
#undef GLA_HALF
#undef GLA_PREP
}

__device__ __forceinline__ void gla_scan(const P& p, char* lds, int job, int e) {
  const int wid = TIDX() >> 6;
  if (wid < 4) gla_scan_t<0>(p, lds, job, e); else if (wid < 6) gla_scan_t<1>(p, lds, job, e); else gla_scan_t<2>(p, lds, job, e);
}

__device__ __forceinline__ void ph_merge(const P& p, int e) {
  const int tid = TIDX(), wid = tid >> 6, lane = tid & 63, l16 = lane & 15, sub = lane >> 4;
  const bf16_t* DNO = (const bf16_t*)(p.ws + OFF_D + D_DNO); const bf16_t* GLAO = (const bf16_t*)(p.ws + OFF_D + D_GLAO);
  const bf16_t* P2 = (const bf16_t*)(p.ws + OFF_D + D_P2); bf16_t* hb = (bf16_t*)(p.ws + OFF_HBF);
  f32x8 nwd = *(const f32x8*)(p.dn_norm + e * 128 + l16 * 8), nwg = *(const f32x8*)(p.gla_norm + e * 128 + l16 * 8);
  for (int R4 = (BIDX() * 8 + wid) * 4; R4 < MROWS; R4 += GDIM() * 32) {
    const size_t R = R4 + sub;
    bf16x8 a[8], bq[8], zz[8];
#pragma unroll
    for (int g = 0; g < 8; ++g) { const bf16_t* src = g < 4 ? DNO : GLAO; const int hc = (g & 3) * 128 + l16 * 8;
      a[g] = *(const bf16x8*)(src + R * 512 + hc); bq[g] = *(const bf16x8*)(src + ((size_t)MROWS + R) * 512 + hc);
      zz[g] = *(const bf16x8*)(P2 + R * 2048 + (g < 4 ? 0 : 1536) + hc); }
#pragma unroll
    for (int g = 0; g < 8; ++g) {
      float v[8]; float ss = 0.f;
#pragma unroll
      for (int j = 0; j < 8; ++j) { v[j] = bf2f((bf16_t)a[g][j]) + bf2f((bf16_t)bq[g][j]); ss += v[j] * v[j]; }
      ss += __shfl_xor(ss, 1); ss += __shfl_xor(ss, 2); ss += __shfl_xor(ss, 4); ss += __shfl_xor(ss, 8);
      const float rs = rsqrtf(ss * (1.f / 128.f) + EPSF);
      float o[8];
#pragma unroll
      for (int j = 0; j < 8; ++j) o[j] = v[j] * rs * (g < 4 ? nwd[j] : nwg[j]) * siluf(bf2f((bf16_t)zz[g][j]));
      *(u32x4*)(hb + R * 1024 + g * 128 + l16 * 8) = (u32x4){cvtpk(o[0], o[1]), cvtpk(o[2], o[3]), cvtpk(o[4], o[5]), cvtpk(o[6], o[7])};
    }
  }
}

DI float silu_fast(float x) { return x / (1.f + __expf(-x)); }
__device__ __forceinline__ void ph_ffnact(const P& p, int L) {
  bf16_t* U = (bf16_t*)(p.ws + OFF_D);
  const float* cw = p.ffn_conv + (size_t)L * 3 * DFF;
  const size_t items = (size_t)MROWS * 352, stride = (size_t)GDIM() * 512;
  for (size_t it0 = (size_t)BIDX() * 512 + TIDX(); it0 < items; it0 += 2 * stride) {
    bf16x8 zc[2], zp[2], zn[2], vv[2]; int Rr[2], cc[2]; bool ok[2];
#pragma unroll
    for (int q = 0; q < 2; ++q) {
      size_t it = it0 + q * stride; ok[q] = it < items; if (!ok[q]) it = it0;
      const int R = (int)(it / 352), c0 = (int)(it % 352) * 8; const int b = R >= TB ? 1 : 0, pp = R - b * TB;
      const bool hasp = !(pp == 0 || pp == CTXL), hasn = !(pp == CTXL - 1 || pp == TB - 1);
      Rr[q] = R; cc[q] = c0;
      zc[q] = *(const bf16x8*)(U + (size_t)R * 5632 + c0);
      zp[q] = *(const bf16x8*)(U + (size_t)(hasp ? R - 1 : R) * 5632 + c0);
      zn[q] = *(const bf16x8*)(U + (size_t)(hasn ? R + 1 : R) * 5632 + c0);
      vv[q] = *(const bf16x8*)(U + (size_t)R * 5632 + DFF + c0);
      if (!hasp) zp[q] = (bf16x8){0, 0, 0, 0, 0, 0, 0, 0};
      if (!hasn) zn[q] = (bf16x8){0, 0, 0, 0, 0, 0, 0, 0};
    }
#pragma unroll
    for (int q = 0; q < 2; ++q) {
      const int c0 = cc[q];
      const f32x8 w0 = *(const f32x8*)(cw + c0), w1 = *(const f32x8*)(cw + DFF + c0), w2 = *(const f32x8*)(cw + 2 * DFF + c0);
      float o[8];
#pragma unroll
      for (int j = 0; j < 8; ++j) { const float a = bf2f((bf16_t)zp[q][j]) * w0[j] + bf2f((bf16_t)zc[q][j]) * w1[j] + bf2f((bf16_t)zn[q][j]) * w2[j];
        o[j] = silu_fast(a) * bf2f((bf16_t)vv[q][j]); }
      if (ok[q]) *(u32x4*)(U + (size_t)Rr[q] * 5632 + DFF + c0) = (u32x4){cvtpk(o[0], o[1]), cvtpk(o[2], o[3]), cvtpk(o[4], o[5]), cvtpk(o[6], o[7])};
    }
  }
}

__device__ __forceinline__ void ph_qknorm(const P& p, char* lds, int o) {
  const int tid = TIDX(), wid = tid >> 6, lane = tid & 63, l16 = lane & 15, sub = lane >> 4;
  bf16_t* QKV = (bf16_t*)(p.ws + OFF_D);
  float* tab = (float*)lds;
  for (int i = tid; i < 4096; i += 512) { const int pos = i >> 5, f = i & 31; const float ang = (float)pos * powf(10000.f, -(float)f / 32.f); tab[2 * i] = cosf(ang); tab[2 * i + 1] = sinf(ang); }
  __syncthreads();
  const f32x8 qn = *(const f32x8*)(p.att_q_norm + o * 128 + l16 * 8), kn = *(const f32x8*)(p.att_k_norm + o * 128 + l16 * 8);
  const int f0 = (l16 & 3) * 8;
  for (int R4 = (BIDX() * 8 + wid) * 4; R4 < MROWS; R4 += GDIM() * 32) {
    const int R = R4 + sub; const int b = R >= TB ? 1 : 0, pp = R - b * TB; const bool lat = pp >= CTXL; const int t = lat ? pp - CTXL : 0;
    const int pos = (l16 < 8) ? (t >> 6) : (t & 63);
    bf16_t* base = QKV + (size_t)R * 1536 + l16 * 8;
    bf16x8 x[10];
#pragma unroll
    for (int hd = 0; hd < 10; ++hd) x[hd] = *(const bf16x8*)(base + hd * 128);
    float cs[8], sn[8];
#pragma unroll
    for (int j = 0; j < 8; ++j) { const float2 t2 = *(const float2*)(tab + 2 * (pos * 32 + f0 + j)); cs[j] = lat ? t2.x : 1.f; sn[j] = lat ? t2.y : 0.f; }
#pragma unroll
    for (int hd = 0; hd < 10; ++hd) {
      float v[8]; float ss = 0.f;
#pragma unroll
      for (int j = 0; j < 8; ++j) { v[j] = bf2f((bf16_t)x[hd][j]); ss += v[j] * v[j]; }
      ss += __shfl_xor(ss, 1); ss += __shfl_xor(ss, 2); ss += __shfl_xor(ss, 4); ss += __shfl_xor(ss, 8);
      const float rs = rsqrtf(ss * (1.f / 128.f) + EPSF);
      float ov[8];
#pragma unroll
      for (int j = 0; j < 8; ++j) { v[j] = v[j] * rs * (hd < 8 ? qn[j] : kn[j]); const float pr = __shfl_xor(v[j], 4);
        ov[j] = (l16 & 4) ? (pr * sn[j] + v[j] * cs[j]) : (v[j] * cs[j] - pr * sn[j]); }
      *(u32x4*)(base + hd * 128) = (u32x4){cvtpk(ov[0], ov[1]), cvtpk(ov[2], ov[3]), cvtpk(ov[4], ov[5]), cvtpk(ov[6], ov[7])};
    }
  }
}

namespace at {
constexpr int D = 128, NW = 8, QBLK = 32, KVBLK = 64;
constexpr float SCALE = 0.088388347648318440f, THR = 8.f;
constexpr int LDQ = 1536, LDK = 1536, LDO = 1024;
constexpr size_t SHM_V = KVBLK * D * 2, SHM_K = KVBLK * D * 2;
#define KSWZ(row, colB) ((row) * 256 + ((colB) ^ (((row) & 7) << 4)))
#define SBAR() __builtin_amdgcn_sched_barrier(0)
DI void partialSM(f32x16& p0, f32x16& p1, float& m_reg, float& mn, float& alpha) {
  constexpr float C = SCALE * 1.4426950408889634f;
  float pmax = p0[0]; for (int r = 1; r < 16; ++r) pmax = fmaxf(pmax, p0[r]); for (int r = 0; r < 16; ++r) pmax = fmaxf(pmax, p1[r]);
  { auto rr = __builtin_amdgcn_permlane32_swap(__float_as_uint(pmax), __float_as_uint(pmax), false, false);
    pmax = fmaxf(__uint_as_float(rr[0]), __uint_as_float(rr[1])); }
  if (__builtin_expect(__all(pmax - m_reg <= THR / SCALE), 1)) { mn = m_reg; alpha = 1.f; }
  else { mn = fmaxf(m_reg, pmax); alpha = __builtin_amdgcn_exp2f((m_reg - mn) * C); m_reg = mn; }
  float mnC = -mn * C;
  for (int r = 0; r < 16; ++r) p0[r] = fmaf(p0[r], C, mnC); for (int r = 0; r < 16; ++r) p1[r] = fmaf(p1[r], C, mnC);
  for (int r = 0; r < 16; ++r) p0[r] = __builtin_amdgcn_exp2f(p0[r]);
}
DI void finishSM(f32x16& p0, f32x16& p1, float alpha, float& l_reg, bf16x8& pa0, bf16x8& pa1, bf16x8& pa2, bf16x8& pa3) {
  for (int r = 0; r < 16; ++r) p1[r] = __builtin_amdgcn_exp2f(p1[r]);
  float ps = 0; for (int r = 0; r < 16; ++r) ps += p0[r]; for (int r = 0; r < 16; ++r) ps += p1[r];
  { auto rr = __builtin_amdgcn_permlane32_swap(__float_as_uint(ps), __float_as_uint(ps), false, false);
    ps = __uint_as_float(rr[0]) + __uint_as_float(rr[1]); }
  l_reg = l_reg * alpha + ps;
#define PK4(PP, BASE, OUT) do { unsigned a0 = cvtpk(PP[BASE + 0], PP[BASE + 1]), a1 = cvtpk(PP[BASE + 2], PP[BASE + 3]);   \
    unsigned b0 = cvtpk(PP[BASE + 4], PP[BASE + 5]), b1 = cvtpk(PP[BASE + 6], PP[BASE + 7]);                              \
    auto r0 = __builtin_amdgcn_permlane32_swap(a0, b0, false, false); auto r1 = __builtin_amdgcn_permlane32_swap(a1, b1, false, false); \
    u32x4 w = {r0[0], r1[0], r0[1], r1[1]}; OUT = *reinterpret_cast<bf16x8*>(&w); } while (0)
  PK4(p0, 0, pa0); PK4(p0, 8, pa1); PK4(p1, 0, pa2); PK4(p1, 8, pa3);
#undef PK4
}
DI void qkt(f32x16& p0, f32x16& p1, const bf16_t* Ks, const bf16x8* qr, int r32, int hi) {
  p0 = f32x16{}; p1 = f32x16{};
  for (int d0 = 0; d0 < 8; ++d0) { int cb = (d0 * 16 + hi * 8) * 2;
    bf16x8 b0 = *reinterpret_cast<const bf16x8*>((const char*)Ks + KSWZ(r32, cb));
    bf16x8 b1 = *reinterpret_cast<const bf16x8*>((const char*)Ks + KSWZ(32 + r32, cb));
    p0 = MFMA32(b0, qr[d0], p0);
    p1 = MFMA32(b1, qr[d0], p1); }
}
DI int v_st(int k, int c) { const int kk = (k & ~0xC) | ((k & 4) << 1) | ((k & 8) >> 1); return ((kk >> 3) * 4 + (c >> 5)) * 512 + ((kk & 7) * 32 + (c & 31)) * 2; }
DI int v_rd_base(int lane) { return ((lane & 3) << 3) | (((lane >> 2) & 3) << 6) | (((lane >> 4) & 1) << 5) | (((lane >> 5) & 1) << 8); }
constexpr int v_rd_off(int d0, int ks, int half) { return d0 * 512 + ks * 4096 + half * 2048; }
template <int OFF> DI s16x4 tr_read(int vb) {
  s16x4 r; asm volatile("ds_read_b64_tr_b16 %0, %1 offset:%2" : "=&v"(r) : "v"(vb), "i"(OFF) : "memory"); return r;
}
template <int D0> DI void pv_one(f32x16& od, int vb, bf16x8 pa0, bf16x8 pa1, bf16x8 pa2, bf16x8 pa3) {
  const s16x4 l0 = tr_read<v_rd_off(D0, 0, 0)>(vb), h0 = tr_read<v_rd_off(D0, 0, 1)>(vb), l1 = tr_read<v_rd_off(D0, 1, 0)>(vb), h1 = tr_read<v_rd_off(D0, 1, 1)>(vb);
  const s16x4 l2 = tr_read<v_rd_off(D0, 2, 0)>(vb), h2 = tr_read<v_rd_off(D0, 2, 1)>(vb), l3 = tr_read<v_rd_off(D0, 3, 0)>(vb), h3 = tr_read<v_rd_off(D0, 3, 1)>(vb);
  asm volatile("s_waitcnt lgkmcnt(0)" ::: "memory"); SBAR();
#define PK(Lx, Hx) (bf16x8){Lx[0], Lx[1], Lx[2], Lx[3], Hx[0], Hx[1], Hx[2], Hx[3]}
  od = MFMA32(pa0, PK(l0, h0), od);
  od = MFMA32(pa1, PK(l1, h1), od);
  od = MFMA32(pa2, PK(l2, h2), od);
  od = MFMA32(pa3, PK(l3, h3), od);
#undef PK
}
DI void pv_d0(f32x16* o, int vb, bf16x8 pa0, bf16x8 pa1, bf16x8 pa2, bf16x8 pa3) {
  pv_one<0>(o[0], vb, pa0, pa1, pa2, pa3); pv_one<1>(o[1], vb, pa0, pa1, pa2, pa3); pv_one<2>(o[2], vb, pa0, pa1, pa2, pa3); pv_one<3>(o[3], vb, pa0, pa1, pa2, pa3);
}
DI void attn_dense_body(const bf16_t* __restrict__ Qb, const bf16_t* __restrict__ Kh, const bf16_t* __restrict__ Vh, bf16_t* __restrict__ Ob, int seq, char* lds) {
  const int tid = TIDX(), wid = tid >> 6, lane = tid & 63, r32 = lane & 31, hi = lane >> 5;
  bf16_t* V_lds = (bf16_t*)lds; bf16_t* K_lds = (bf16_t*)(lds + 2 * SHM_V);
  float* ws = (float*)(lds + 2 * SHM_V + 2 * SHM_K) + wid * 64; float* li_l = ws; float* al_l = ws + 32;
  float m_reg = -1e30f, l_reg = 0; f32x16 o[4] = {}; bf16x8 qr[8];
  const bf16_t* Qw = Qb + (long)(wid * QBLK + r32) * LDQ + hi * 8;
#pragma unroll
  for (int d0 = 0; d0 < 8; ++d0) qr[d0] = *reinterpret_cast<const bf16x8*>(Qw + d0 * 16);
  const int sr = tid >> 4, sc = (tid & 15) * 8, vst0 = v_st(sr, sc), vst1 = v_st(32 + sr, sc);
  const int vb0 = (int)(uintptr_t)V_lds + v_rd_base(lane);
  struct { bf16x8 vs0, vs1, ks0, ks1; } sr_[2];
#define SLOAD(i, k0) do { sr_[i].vs0 = *(const bf16x8*)(&Vh[(long)((k0) + sr) * LDK + sc]); sr_[i].vs1 = *(const bf16x8*)(&Vh[(long)((k0) + 32 + sr) * LDK + sc]); \
    sr_[i].ks0 = *(const bf16x8*)(&Kh[(long)((k0) + sr) * LDK + sc]); sr_[i].ks1 = *(const bf16x8*)(&Kh[(long)((k0) + 32 + sr) * LDK + sc]); } while (0)
#define SWRITE(bq, i) do { *(bf16x8*)((char*)V_lds + (bq) * SHM_V + vst0) = sr_[i].vs0;          \
    *(bf16x8*)((char*)V_lds + (bq) * SHM_V + vst1) = sr_[i].vs1; int kc = sc * 2;               \
    *(bf16x8*)((char*)K_lds + (bq) * SHM_K + KSWZ(sr, kc)) = sr_[i].ks0;                       \
    *(bf16x8*)((char*)K_lds + (bq) * SHM_K + KSWZ(32 + sr, kc)) = sr_[i].ks1; } while (0)
#define SWAIT() asm volatile("s_waitcnt vmcnt(4)" ::: "memory")
#define RESC(a) do { if (__any((a) < 1.f)) { if (hi == 0) al_l[r32] = (a); asm volatile("s_waitcnt lgkmcnt(0)" ::: "memory"); \
    for (int d = 0; d < 4; ++d) for (int r = 0; r < 16; ++r) o[d][r] *= al_l[crow(r, hi)]; } } while (0)
  f32x16 pA0, pA1, pB0, pB1; float mnA, mnB, alA, alB; bf16x8 pa0, pa1, pa2, pa3; const int NT = seq / KVBLK;
  constexpr int SE = 0, SO = 1;
  SLOAD(SE, 0); asm volatile("s_waitcnt vmcnt(0)" ::: "memory"); SWRITE(0, SE); __syncthreads();
  qkt(pA0, pA1, K_lds, qr, r32, hi); partialSM(pA0, pA1, m_reg, mnA, alA);
  SLOAD(SO, KVBLK); if (2 < NT) SLOAD(SE, 2 * KVBLK);
  SWAIT(); SWRITE(1, SO); __syncthreads();
  for (int j = 1; j + 1 < NT; j += 2) {
    SBAR(); qkt(pB0, pB1, (bf16_t*)((char*)K_lds + SHM_K), qr, r32, hi);
    finishSM(pA0, pA1, alA, l_reg, pa0, pa1, pa2, pa3); SBAR();
    SLOAD(SO, (j + 2) * KVBLK); SBAR();
    pv_d0(o, vb0, pa0, pa1, pa2, pa3); partialSM(pB0, pB1, m_reg, mnB, alB);
    __syncthreads(); SWAIT(); SWRITE(0, SE);
    RESC(alB); __syncthreads();
    SBAR(); qkt(pA0, pA1, K_lds, qr, r32, hi);
    finishSM(pB0, pB1, alB, l_reg, pa0, pa1, pa2, pa3); SBAR();
    if (j + 3 < NT) SLOAD(SE, (j + 3) * KVBLK); SBAR();
    pv_d0(o, vb0 + (int)SHM_V, pa0, pa1, pa2, pa3); partialSM(pA0, pA1, m_reg, mnA, alA);
    __syncthreads(); SWAIT(); SWRITE(1, SO);
    RESC(alA); __syncthreads();
  }
  SBAR(); qkt(pB0, pB1, (bf16_t*)((char*)K_lds + SHM_K), qr, r32, hi);
  finishSM(pA0, pA1, alA, l_reg, pa0, pa1, pa2, pa3); SBAR();
  pv_d0(o, vb0, pa0, pa1, pa2, pa3); partialSM(pB0, pB1, m_reg, mnB, alB);
  __syncthreads(); RESC(alB);
  finishSM(pB0, pB1, alB, l_reg, pa0, pa1, pa2, pa3); SBAR();
  pv_d0(o, vb0 + (int)SHM_V, pa0, pa1, pa2, pa3);
  if (hi == 0) li_l[r32] = l_reg; asm volatile("s_waitcnt lgkmcnt(0)" ::: "memory");
  float rli[16];
#pragma unroll
  for (int r = 0; r < 16; ++r) rli[r] = __builtin_amdgcn_rcpf(li_l[crow(r, hi)]);
  bf16_t* Ow = Ob + (long)(wid * QBLK) * LDO;
#pragma unroll
  for (int r = 0; r < 16; ++r) { int orow = crow(r, hi);
    for (int d0 = 0; d0 < 4; ++d0) Ow[(long)orow * LDO + d0 * 32 + r32] = f2bf(o[d0][r] * rli[r]); }
#undef SLOAD
#undef SWRITE
#undef SWAIT
#undef RESC
}
}

__device__ __forceinline__ void ph_attn(const P& p, char* lds, bool need_ctx) {
  const bf16_t* QKV = (const bf16_t*)(p.ws + OFF_D); bf16_t* hb = (bf16_t*)(p.ws + OFF_HBF);
  const int nunits = need_ctx ? 528 : 512;
  for (int u = BIDX(); u < nunits; u += GDIM()) {
    int b, h, seq; size_t qrow;
    if (u < 512) { b = u >> 8; const int rem = u & 255; h = rem >> 5; qrow = (size_t)b * TB + CTXL + (size_t)(rem & 31) * 256; seq = TB; }
    else { const int uu = u - 512; b = uu >> 3; h = uu & 7; qrow = (size_t)b * TB; seq = CTXL; }
    const int kvh = h >> 2;
    const bf16_t* Kh = QKV + (size_t)b * TB * 1536 + 1024 + kvh * 128;
    const bf16_t* Vh = QKV + (size_t)b * TB * 1536 + 1280 + kvh * 128;
    at::attn_dense_body(QKV + qrow * 1536 + h * 128, Kh, Vh, hb + qrow * 1024 + h * 128, seq, lds);
    __syncthreads();
  }
}

__device__ __forceinline__ void ph_final(const P& p) {
  const int tid = TIDX(), wid = tid >> 6, lane = tid & 63;
  const float* xr = (const float*)(p.ws + OFF_XRES);
  for (int q = BIDX() * 8 + wid; q < 2 * LAT; q += GDIM() * 8) {
    const int b = q >> 13, t = q & (LAT - 1); const float* row = xr + ((size_t)b * TB + CTXL + t) * 1024;
    f32x4 v[4]; float ss = 0.f;
#pragma unroll
    for (int i = 0; i < 4; ++i) { v[i] = *(const f32x4*)(row + i * 256 + lane * 4); ss += v[i][0] * v[i][0] + v[i][1] * v[i][1] + v[i][2] * v[i][2] + v[i][3] * v[i][3]; }
    ss = wave_sum(ss); const float rs = rsqrtf(ss * (1.f / 1024.f) + EPSF);
#pragma unroll
    for (int i = 0; i < 4; ++i) { const int c0 = i * 256 + lane * 4; const f32x4 g = *(const f32x4*)(p.final_norm + c0); f32x4 o = v[i] * rs * g; *(f32x4*)(p.out + (size_t)q * 1024 + c0) = o; }
  }
}

#ifndef ONLY_PH
#define ONLY_PH -1
#endif
#define EN(x) (ONLY_PH < 0 || ONLY_PH == (x))
#ifndef PROBE_REP
#define PROBE_REP -1
#endif
#define RUN(cls, ...) do { if (EN(cls)) { for (int rep_ = 0; rep_ < ((PROBE_REP == (cls)) ? 2 : 1); ++rep_) { if (rep_) xcd_barrier(*xbp); __VA_ARGS__; } } } while (0)
enum { OP_INIT, OP_N1FULL, OP_IN, OP_PREP, OP_D1, OP_SCAN, OP_MERGE, OP_OUTLAT, OP_OUTCTX_N2LAT, OP_N2CTX, OP_UP, OP_ACT, OP_DOWNLAT, OP_DOWNCTX_N1LAT, OP_N1CTX,
       OP_QKV, OP_QKNORM, OP_ATTN, OP_N2FULL, OP_FINAL };
constexpr int NPHASES = 48;
__device__ __forceinline__ void decode_phase(int ph, int& op, int& L) {
  if (ph == 0) { op = OP_INIT; L = 0; return; }
  if (ph == NPHASES - 1) { op = OP_FINAL; L = 3; return; }
  int q = ph - 1;
  if (q < 14) { L = 0; if (q == 0) { op = OP_N1FULL; return; } q -= 1; }
  else if (q < 25) { L = 1; q -= 14; }
  else if (q < 38) { L = 2; q -= 25; }
  else { L = 3; q -= 38; }
  if ((L & 1) == 0) {
    if (q < 5) { op = OP_IN + q; return; }
    q -= 5;
  } else {
    if (q < 3) { op = OP_QKV + q; return; }
    q -= 3;
  }
  if (L < 3) { const int t[8] = {OP_OUTLAT, OP_OUTCTX_N2LAT, OP_N2CTX, OP_UP, OP_ACT, OP_DOWNLAT, OP_DOWNCTX_N1LAT, OP_N1CTX}; op = t[q]; }
  else { const int t[5] = {OP_OUTLAT, OP_N2FULL, OP_UP, OP_ACT, OP_DOWNLAT}; op = t[q]; }
}
__device__ __forceinline__ void run_phase(const P& p0, int ph, char* lds, const XcdBarrier* xbp) {
  P p = p0; { typedef __attribute__((address_space(1))) char gchar_t; size_t wi = (size_t)p0.ws; asm volatile("" : "+s"(wi)); p.ws = (char*)(gchar_t*)wi; }
  int op, L; decode_phase(ph, op, L);
  const int e = L >> 1, o = L >> 1;
  bf16_t* W1 = (bf16_t*)(p.ws + OFF_WC); bf16_t* W2 = (bf16_t*)(p.ws + OFF_WC + WC_W2); bf16_t* W3 = (bf16_t*)(p.ws + OFF_W3);
  bf16_t* hb = (bf16_t*)(p.ws + OFF_HBF); float* xr = (float*)(p.ws + OFF_XRES);
  const float* mods = (const float*)(p.ws + OFF_MODS) + (size_t)L * 3 * 6144;
  float* PART = (float*)(p.ws + OFF_D + D_END_F);
#define CVT_MIX(LL, skipb) do { const int L_ = (LL); if ((L_ & 1) == 0) { cvt_weight(p.rec_w_in + (size_t)(L_ >> 1) * 1024 * 3632, W1, 1024, 3632, NREC, true, skipb); cvt_weight(p.rec_w_out + (size_t)(L_ >> 1) * 1024 * 1024, W3, 1024, 1024, 1024, false, skipb); } \
    else { cvt_weight(p.att_w_qkv + (size_t)(L_ >> 1) * 1024 * 1536, W1, 1024, 1536, 1536, false, skipb); cvt_weight(p.att_w_out + (size_t)(L_ >> 1) * 1024 * 1024, W3, 1024, 1024, 1024, false, skipb); } } while (0)
#define CVT_FFN(LL, skipb) do { const int L_ = (LL); cvt_weight(p.ffn_w_up + (size_t)L_ * 1024 * 5632, W1, 1024, 5632, 5632, false, skipb); cvt_weight(p.ffn_w_down + (size_t)L_ * DFF * 1024, W2, DFF, 1024, 1024, false, skipb); } while (0)
  switch (op) {
    case OP_INIT: RUN(0, ph_init(p, lds); CVT_MIX(0, 0)); break;
    case OP_N1FULL: RUN(1, ph_norm(p, L, 0, 0, 0)); break;
    case OP_IN: RUN(2, gemm8(lds, hb, 1024, W1, 1024, NREC, 0, EpiRec8{(bf16_t*)(p.ws + OFF_D + D_P1), (bf16_t*)(p.ws + OFF_D + D_P2), (float*)(p.ws + OFF_SM)})); break;
    case OP_PREP: RUN(3, ph_dnprep(p, lds, e)); break;
    case OP_D1: RUN(4, ph_dn_d1(p, lds); ph_gla_b(p, lds, e)); break;
    case OP_SCAN: RUN(5, if (BIDX() < 64) { dn_scan(p, lds, BIDX()); } else if (BIDX() < 128) { gla_scan(p, lds, BIDX() - 64, e); });
        if (PROBE_REP == 55) { xcd_barrier(*xbp); if (BIDX() < 64) { dn_scan(p, lds, BIDX()); } }
        if (PROBE_REP == 56) { xcd_barrier(*xbp); if (BIDX() >= 64 && BIDX() < 128) { gla_scan(p, lds, BIDX() - 64, e); } }
        break;
    case OP_MERGE: RUN(7, ph_merge(p, e)); break;
    case OP_QKV: RUN(2, gemm8(lds, hb, 1024, W1, 1024, 1536, 0, EpiBf8{(bf16_t*)(p.ws + OFF_D), 1536})); break;
    case OP_QKNORM: if (EN(9)) ph_qknorm(p, lds, o); break;
    case OP_ATTN: RUN(10, ph_attn(p, lds, L != 3)); break;
    case OP_OUTLAT: if (EN(2)) { gemm8(lds, hb, 1024, W3, 1024, 1024, 1, EpiRes8{xr, mods + 2 * 1024}); if (L == 3) CVT_FFN(L, 0); } break;
    case OP_OUTCTX_N2LAT: if (EN(2)) { if (BIDX() < 128) gemm_ctx_split(lds, hb, 1024, W3, 1024, 128, PART); ph_norm(p, L, 1, 1, 0); CVT_FFN(L, 0); } break;
    case OP_N2CTX: if (EN(1)) ph_ctx_fold_norm(p, L, 1, PART, 8, mods + 2 * 1024); break;
    case OP_N2FULL: if (EN(1)) ph_norm(p, L, 1, 0, 0); break;
    case OP_UP: RUN(2, gemm8(lds, hb, 1024, W1, 1024, 5632, L == 3 ? 1 : 0, EpiBf8{(bf16_t*)(p.ws + OFF_D), 5632})); break;
    case OP_ACT: if (EN(8)) ph_ffnact(p, L); break;
    case OP_DOWNLAT: if (EN(2)) gemm8(lds, (const bf16_t*)(p.ws + OFF_D) + DFF, 5632, W2, DFF, 1024, 1, EpiRes8{xr, mods + 5 * 1024}); break;
    case OP_DOWNCTX_N1LAT: if (EN(2)) { if (BIDX() < 176) gemm_ctx_split(lds, (const bf16_t*)(p.ws + OFF_D) + DFF, 5632, W2, DFF, 256, PART); ph_norm(p, L + 1, 0, 1, 0); CVT_MIX(L + 1, 0); } break;
    case OP_N1CTX: if (EN(1)) ph_ctx_fold_norm(p, L + 1, 0, PART, 11, mods + 5 * 1024); break;
    case OP_FINAL: if (EN(11)) ph_final(p); break;
  }
#undef CVT_MIX
#undef CVT_FFN
}

template <bool COOP>
__global__ void __launch_bounds__(512, 1) mk_kernel(P p, int ph0, int ph1) {
  extern __shared__ __attribute__((aligned(16))) char smem[];
  if constexpr (COOP) {
    if (ph0 < 0) cg::this_grid().sync();
    volatile LAS unsigned* st = (volatile LAS unsigned*)(smem + LDS_BYTES);
    if (threadIdx.x < 4) st[threadIdx.x] = 0u;
    __syncthreads();
    XcdBarrier xb = xcd_barrier_post((unsigned*)(p.ws + OFF_BAR), st);
    for (int ph = ph0; ph < ph1; ++ph) {
      run_phase(p, ph, smem, &xb);
      if (ph + 1 < ph1) xcd_barrier(xb);
      if (PROBE_REP == 99 && ph == 0) { for (int q = 0; q < 20; ++q) xcd_barrier(xb); }
    }
  } else {
    for (int ph = ph0; ph < ph1; ++ph) run_phase(p, ph, smem, nullptr);
  }
}

extern "C" void kernel_launch(void* const* d_in, const int* in_sizes, int n_in, void* d_out, int out_size, void* d_ws, size_t ws_size, hipStream_t stream) {
  if (n_in != 23 || ws_size < WS_NEED) { fprintf(stderr, "kernel_launch: bad n_in %d or ws %zu < %zu\n", n_in, ws_size, (size_t)WS_NEED); return; }
  P p{};
  const float** f = (const float**)&p;
  for (int i = 0; i < 23; ++i) f[i] = (const float*)d_in[i];
  p.out = (float*)d_out; p.ws = (char*)d_ws;
  static int inited = 0, grid_blocks = 0;
  if (!inited) {
    hipFuncSetAttribute((const void*)mk_kernel<true>, hipFuncAttributeMaxDynamicSharedMemorySize, LDS_BYTES + 16);
#if !MK_COOP
    hipFuncSetAttribute((const void*)mk_kernel<false>, hipFuncAttributeMaxDynamicSharedMemorySize, LDS_BYTES);
#endif
    int dev = 0, cus = 0, per_cu = 0;
    hipGetDevice(&dev); hipDeviceGetAttribute(&cus, hipDeviceAttributeMultiprocessorCount, dev);
    hipOccupancyMaxActiveBlocksPerMultiprocessor(&per_cu, mk_kernel<true>, 512, LDS_BYTES + 16);
    if (per_cu > 1) per_cu = 1;
    grid_blocks = cus * per_cu; if (grid_blocks > 256) grid_blocks = 256; if (grid_blocks < 128) grid_blocks = 128;
    inited = 1;
  }
#if MK_COOP
  int ph0 = 0, ph1 = NPHASES;
  void* args[] = {&p, &ph0, &ph1};
  hipMemsetAsync((char*)d_ws + OFF_BAR, 0, 3456 * 4, stream);
  hipError_t er = hipLaunchCooperativeKernel((const void*)mk_kernel<true>, dim3(grid_blocks), dim3(512), args, LDS_BYTES + 16, stream);
  if (er != hipSuccess) fprintf(stderr, "cooperative launch failed: %s (grid %d)\n", hipGetErrorString(er), grid_blocks);
#else
  for (int ph = 0; ph < NPHASES; ++ph) hipLaunchKernelGGL(mk_kernel<false>, dim3(256), dim3(512), LDS_BYTES, stream, p, ph, ph + 1);
#endif
}
```

```cpp
#include <hip/hip_runtime.h>
#include <hip/hip_cooperative_groups.h>
#include <cstdio>
#include <cstdint>
namespace cg = cooperative_groups;

#ifndef MK_COOP
#define MK_COOP 1
#endif

typedef unsigned short bf16_t;
typedef short bf16x8 __attribute__((ext_vector_type(8)));
typedef short s16x4 __attribute__((ext_vector_type(4)));
typedef float f32x16 __attribute__((ext_vector_type(16)));
typedef float f32x8 __attribute__((ext_vector_type(8)));
typedef float f32x4 __attribute__((ext_vector_type(4)));
typedef unsigned u32x4 __attribute__((ext_vector_type(4)));
#define DI __device__ __forceinline__
#define LBAR() do { asm volatile("s_waitcnt lgkmcnt(0)" ::: "memory"); __builtin_amdgcn_s_barrier(); asm volatile("" ::: "memory"); } while (0)
#define MFMA32(a, b, c) __builtin_amdgcn_mfma_f32_32x32x16_bf16((a), (b), (c), 0, 0, 0)

constexpr int DM = 1024, TB = 8448, CTXL = 256, LAT = 8192, MROWS = 2 * TB;
constexpr int NCH = 132;
constexpr int DFF = 2816;
constexpr int NREC = 3840;
constexpr float EPSF = 1e-6f;

constexpr size_t AL(size_t x) { return (x + 255) / 256 * 256; }
constexpr size_t OFF_XRES = 0;
constexpr size_t OFF_HBF = OFF_XRES + AL((size_t)MROWS * DM * 4);
constexpr size_t OFF_WC = OFF_HBF + AL((size_t)MROWS * DM * 2);
constexpr size_t WC_W2 = (size_t)5632 * 1024 * 2;
constexpr size_t OFF_MODS = OFF_WC + AL(WC_W2 + (size_t)1024 * 2816 * 2);
constexpr size_t OFF_SM = OFF_MODS + AL((size_t)4 * 3 * 6144 * 4);
constexpr size_t OFF_GB = OFF_SM + AL((size_t)MROWS * 64 * 4);
constexpr size_t OFF_SC = OFF_GB + AL((size_t)MROWS * 16 * 4);
constexpr size_t OFF_GL = OFF_SC + AL((size_t)16 * NCH * 64 * 2 * 4);
constexpr size_t OFF_D = OFF_GL + AL((size_t)16 * NCH * 4);
constexpr size_t D_P1 = 0;
constexpr size_t D_W = 0;
constexpr size_t D_INTRA = D_W + (size_t)16 * NCH * 64 * 128 * 2;
constexpr size_t D_P2 = D_P1 + (size_t)MROWS * 1536 * 2;
constexpr size_t D_QQ = D_P2 + (size_t)MROWS * 2048 * 2;
constexpr size_t D_QK = D_QQ + (size_t)MROWS * 512 * 2;
constexpr size_t D_QV = D_QK + (size_t)MROWS * 512 * 2;
constexpr size_t D_DNO = D_QK;
constexpr size_t D_KT = D_QV + (size_t)MROWS * 512 * 2;
constexpr size_t D_GLAO = D_KT + (size_t)MROWS * 512 * 2;
constexpr size_t D_END_E = D_GLAO + (size_t)2 * MROWS * 512 * 2;
constexpr size_t D_END_F = (size_t)MROWS * 5632 * 2;
constexpr size_t OFF_B16_1 = OFF_D + (D_END_E > D_END_F ? D_END_E : D_END_F);
constexpr size_t B16_BYTES = (size_t)8 * NCH * 64 * 64 * 2;
constexpr size_t OFF_BAR = OFF_B16_1 + AL(B16_BYTES);
constexpr size_t OFF_W3 = OFF_BAR + AL(3456 * 4);
constexpr size_t WS_NEED = OFF_W3 + (size_t)1024 * 1024 * 2;
constexpr int LDS_BYTES = 132 * 1024;

struct P {
  const float *x, *c, *ctx, *c_ctx, *mod_w, *mod_b, *rec_w_in, *rec_conv, *dn_a_log, *dn_dt_bias, *dn_norm, *gla_w2, *gla_b2, *gla_norm,
      *rec_w_out, *att_w_qkv, *att_q_norm, *att_k_norm, *att_w_out, *ffn_w_up, *ffn_conv, *ffn_w_down, *final_norm;
  float* out;
  char* ws;
};

DI int TIDX() { int t = threadIdx.x; asm volatile("" : "+v"(t)); return t; }
DI int BIDX() { int t = blockIdx.x; asm volatile("" : "+s"(t)); return t; }
DI int GDIM() { int t = gridDim.x; asm volatile("" : "+s"(t)); return t; }
DI float bf2f(bf16_t v) { return __uint_as_float(((unsigned)v) << 16); }
DI bf16_t f2bf(float x) { unsigned u = __float_as_uint(x); u += 0x7fffu + ((u >> 16) & 1u); return (bf16_t)(u >> 16); }
typedef __bf16 bf16n2 __attribute__((ext_vector_type(2)));
DI unsigned cvtpk(float lo, float hi) { const bf16n2 v = {(__bf16)lo, (__bf16)hi}; return __builtin_bit_cast(unsigned, v); }
DI int crow(int r, int hi) { return (r & 3) + 8 * (r >> 2) + 4 * hi; }
DI float siluf(float x) { return x / (1.f + expf(-x)); }
DI float sigmf(float x) { return 1.f / (1.f + expf(-x)); }
DI float softplusf(float x) { return fmaxf(x, 0.f) + log1pf(expf(-fabsf(x))); }
DI float wave_sum(float v) {
#pragma unroll
  for (int o = 32; o > 0; o >>= 1) v += __shfl_xor(v, o);
  return v;
}
DI int modrow_of(int R) { const int b = R >= TB ? 1 : 0; const int pp = R - b * TB; return pp < CTXL ? 2 : b; }
template <int KS>
DI f32x16 mma_rows(const bf16_t* arow, const bf16_t* brow, f32x16 acc) {
#pragma unroll
  for (int ks = 0; ks < KS; ++ks) {
    const bf16x8 a = *reinterpret_cast<const bf16x8*>(arow + ks * 16);
    const bf16x8 b = *reinterpret_cast<const bf16x8*>(brow + ks * 16);
    acc = MFMA32(a, b, acc);
  }
  return acc;
}

#define XB_TMO      128
#define XB_XCNT(j)  (256  + 64 * (j))
#define XB_XSUB(j)  (1280 + 64 * (j))
#define XB_XGEN(j)  (2304 + 64 * (j))
#define XB_TOP      3328
#define XB_TOPGEN   3392
#define XCD_BAR_WORDS 3456
#define XB_SPIN_CAP (1u << 18)
#define LAS __attribute__((address_space(3)))
DI unsigned xb_ld(unsigned* p)              { return __hip_atomic_load(p, __ATOMIC_RELAXED, __HIP_MEMORY_SCOPE_AGENT); }
DI unsigned xb_add(unsigned* p, unsigned v) { return __hip_atomic_fetch_add(p, v, __ATOMIC_RELAXED, __HIP_MEMORY_SCOPE_AGENT); }
DI unsigned xb_xcc_id() { return (unsigned)__builtin_amdgcn_s_getreg((3 << 11) | 20) & 0xFu; }
#define XB_SPIN(cond, bar) do { unsigned _sp = 0; while (cond) { __builtin_amdgcn_s_sleep(1); \
    if ((++_sp & 255u) == 0u) { if (xb_ld(&(bar)[XB_TMO])) break; if (_sp > XB_SPIN_CAP) { atomicAdd(&(bar)[XB_TMO], 1u); break; } } } } while (0)
struct XcdBarrier { unsigned* bar; unsigned x; volatile LAS unsigned* st; };
DI XcdBarrier xcd_barrier_post(unsigned* bar, volatile LAS unsigned* st) {
    XcdBarrier b; b.bar = bar; b.x = xb_xcc_id(); b.st = st;
    if (threadIdx.x == 0) (void)xb_add(&bar[XB_XCNT(b.x)], 1u);
    return b;
}
DI void xcd_barrier_complete(unsigned* bar, unsigned x, unsigned& nloc, unsigned& nx) {
    const unsigned G = gridDim.x * gridDim.y * gridDim.z;
    unsigned sum, cnt, mine, sp = 0u;
    for (;;) {
        sum = 0u; cnt = 0u; mine = 0u;
#pragma unroll
        for (unsigned j = 0; j < 16; ++j) { const unsigned c = xb_ld(&bar[XB_XCNT(j)]); sum += c; cnt += (c > 0u) ? 1u : 0u; mine = (j == x) ? c : mine; }
        if (sum == G) break;
        __builtin_amdgcn_s_sleep(1);
        if ((++sp & 255u) == 0u) { if (xb_ld(&bar[XB_TMO])) break; if (sp > XB_SPIN_CAP) { atomicAdd(&bar[XB_TMO], 1u); break; } }
    }
    nloc = mine > 0u ? mine : 1u; nx = cnt > 0u ? cnt : 1u;
}
DI void xcd_barrier(const XcdBarrier& b) {
    asm volatile("s_waitcnt vmcnt(0)" ::: "memory");
    __syncthreads();
    if (threadIdx.x == 0) {
        unsigned* bar = b.bar;
        __builtin_amdgcn_s_waitcnt(0);
        unsigned nloc = b.st[0], nx = b.st[1];
        if (nloc == 0u) { xcd_barrier_complete(bar, b.x, nloc, nx); b.st[0] = nloc; b.st[1] = nx; }
        const unsigned old = xb_add(&bar[XB_XSUB(b.x)], 1u);
        const unsigned gen = old / nloc;
        if (old + 1u == (gen + 1u) * nloc) {
            __builtin_amdgcn_fence(__ATOMIC_RELEASE, "agent");
            asm volatile("s_waitcnt vmcnt(0)" ::: "memory");
            const unsigned og = xb_add(&bar[XB_TOP], 1u);
            const unsigned tg = og / nx;
            if (og + 1u == (tg + 1u) * nx) xb_add(&bar[XB_TOPGEN], 1u);
            else XB_SPIN(xb_ld(&bar[XB_TOPGEN]) == tg, bar);
            __builtin_amdgcn_fence(__ATOMIC_ACQUIRE, "agent");
            xb_add(&bar[XB_XGEN(b.x)], 1u);
            asm volatile("s_waitcnt vmcnt(0)" ::: "memory");
        } else {
            XB_SPIN(xb_ld(&bar[XB_XGEN(b.x)]) == gen, bar);
            __builtin_amdgcn_fence(__ATOMIC_ACQUIRE, "agent");
            asm volatile("s_waitcnt vmcnt(0)" ::: "memory");
        }
    }
    __syncthreads();
}

__device__ __forceinline__ void ph_init(const P& p, char* lds) {
  const int tid = TIDX();
  float* sc = (float*)lds;
  float* red = sc + 3072;
  for (int i = tid; i < 3072; i += 512) { const int r = i >> 10, k = i & 1023; const float v = r < 2 ? p.c[r * 1024 + k] : p.c_ctx[k]; sc[i] = siluf(v); }
  __syncthreads();
  float* mods = (float*)(p.ws + OFF_MODS);
  for (int job = BIDX(); job < 192; job += GDIM()) {
    const int col = job * 128 + (tid & 127), kq = tid >> 7;
    const int L = col / 6144, cl = col - L * 6144;
    const float* w = p.mod_w + ((size_t)L * 1024 + kq * 256) * 6144 + cl;
    float a0 = 0.f, a1 = 0.f, a2 = 0.f;
#pragma unroll 8
    for (int k = 0; k < 256; ++k) { const float wv = w[(size_t)k * 6144]; const int kk = kq * 256 + k; a0 += sc[kk] * wv; a1 += sc[1024 + kk] * wv; a2 += sc[2048 + kk] * wv; }
    red[(kq * 3 + 0) * 128 + (tid & 127)] = a0; red[(kq * 3 + 1) * 128 + (tid & 127)] = a1; red[(kq * 3 + 2) * 128 + (tid & 127)] = a2;
    __syncthreads();
    if (tid < 384) { const int r = tid >> 7, cc = tid & 127; const int c2 = job * 128 + cc; const int L2 = c2 / 6144, cl2 = c2 - L2 * 6144;
      const float s = red[(0 * 3 + r) * 128 + cc] + red[(1 * 3 + r) * 128 + cc] + red[(2 * 3 + r) * 128 + cc] + red[(3 * 3 + r) * 128 + cc] + p.mod_b[L2 * 6144 + cl2];
      mods[((size_t)L2 * 3 + r) * 6144 + cl2] = s; }
    __syncthreads();
  }
  f32x4* xr = (f32x4*)(p.ws + OFF_XRES);
  for (size_t i = (size_t)BIDX() * 512 + tid; i < (size_t)MROWS * 256; i += (size_t)GDIM() * 512) {
    const int R = (int)(i >> 8), c4 = (int)(i & 255); const int b = R >= TB ? 1 : 0, pp = R - b * TB;
    const float* src = pp < CTXL ? p.ctx + ((size_t)b * CTXL + pp) * 1024 : p.x + ((size_t)b * LAT + (pp - CTXL)) * 1024;
    xr[i] = *(const f32x4*)(src + c4 * 4);
  }
}

DI int rec_src_col(int n) { if (n < 2048) return n; if (n < 3584) return n + 16; if (n < 3600) return 2048 + (n - 3584); if (n < 3632) return n; return -1; }
__device__ __forceinline__ void cvt_weight(const float* __restrict__ W, bf16_t* __restrict__ Wt, int K, int Nsrc, int Npad, bool perm, int skipb) {
  const size_t items = (size_t)Npad * (K >> 3);
  const int bid = BIDX() - skipb, nb = GDIM() - skipb;
  if (bid < 0) return;
  for (size_t it = (size_t)bid * 512 + TIDX(); it < items; it += (size_t)nb * 512) {
    const int n = (int)(it % Npad), kb = (int)(it / Npad);
    const int s = perm ? rec_src_col(n) : n;
    float v[8];
#pragma unroll
    for (int j = 0; j < 8; ++j) v[j] = s >= 0 ? W[(size_t)(kb * 8 + j) * Nsrc + s] : 0.f;
    u32x4 w = {cvtpk(v[0], v[1]), cvtpk(v[2], v[3]), cvtpk(v[4], v[5]), cvtpk(v[6], v[7])};
    *(u32x4*)(Wt + (size_t)n * K + kb * 8) = w;
  }
}

__device__ __forceinline__ void gemm_ctx_split(char* lds, const bf16_t* __restrict__ A, int lda, const bf16_t* __restrict__ Bt, int ldb, int Ks, float* __restrict__ PART) {
  const int tid = TIDX(), wid = tid >> 6, lane = tid & 63, r32 = lane & 31, hi = lane >> 5;
  const int wm = wid >> 1, wn = wid & 1;
  const int nk = Ks >> 6;
  constexpr int RS = 144, ASZ = 256 * RS, BSZ = 128 * RS, STG = ASZ + BSZ;
  const int srow = tid >> 3, spc = tid & 7;
  const int w = BIDX(); const int ks = w >> 4, j = w & 15; const int pm = (j >> 3) ? 33 : 0, pn = j & 7;
  const bf16_t* Ab = A + (size_t)(pm * 256 + srow) * lda + (size_t)ks * Ks + spc * 8;
  const bf16_t* Bb = Bt + (size_t)(pn * 128 + srow) * ldb + (size_t)ks * Ks + spc * 8;
  f32x16 acc00 = {}, acc01 = {}, acc10 = {}, acc11 = {};
  bf16x8 ra0, ra1, ra2, ra3, rb0, rb1;
#define GLOAD(kt) do { const int ko = (kt) * 64; ra0 = *(const bf16x8*)(Ab + ko); ra1 = *(const bf16x8*)(Ab + (size_t)64 * lda + ko); ra2 = *(const bf16x8*)(Ab + (size_t)128 * lda + ko); \
    ra3 = *(const bf16x8*)(Ab + (size_t)192 * lda + ko); rb0 = *(const bf16x8*)(Bb + ko); rb1 = *(const bf16x8*)(Bb + (size_t)64 * ldb + ko); } while (0)
#define SWRITE(buf) do { char* sb = lds + (buf) * STG + srow * RS + spc * 16; *(bf16x8*)(sb) = ra0; *(bf16x8*)(sb + 64 * RS) = ra1; *(bf16x8*)(sb + 128 * RS) = ra2; *(bf16x8*)(sb + 192 * RS) = ra3; \
    *(bf16x8*)(sb + ASZ) = rb0; *(bf16x8*)(sb + ASZ + 64 * RS) = rb1; } while (0)
  GLOAD(0); SWRITE(0); __syncthreads();
  for (int kt = 0; kt < nk; ++kt) {
    const int cur = kt & 1;
    if (kt + 1 < nk) GLOAD(kt + 1);
    const char* ab = lds + cur * STG + (64 * wm + r32) * RS + hi * 16;
    const char* bb = lds + cur * STG + ASZ + (64 * wn + r32) * RS + hi * 16;
#pragma unroll
    for (int k4 = 0; k4 < 4; ++k4) {
      const bf16x8 a0 = *(const bf16x8*)(ab + k4 * 32), a1 = *(const bf16x8*)(ab + 32 * RS + k4 * 32);
      const bf16x8 b0 = *(const bf16x8*)(bb + k4 * 32), b1 = *(const bf16x8*)(bb + 32 * RS + k4 * 32);
      acc00 = MFMA32(a0, b0, acc00); acc01 = MFMA32(a0, b1, acc01); acc10 = MFMA32(a1, b0, acc10); acc11 = MFMA32(a1, b1, acc11);
    }
    if (kt + 1 < nk) SWRITE(cur ^ 1);
    __syncthreads();
  }
#undef GLOAD
#undef SWRITE
  float* pb = PART + ((size_t)ks * 512 + (pm ? 256 : 0) + 64 * wm) * 1024 + pn * 128 + 64 * wn + r32;
#pragma unroll
  for (int r = 0; r < 16; ++r) { float* q = pb + (size_t)crow(r, hi) * 1024;
    q[0] = acc00[r]; q[32] = acc01[r]; q[32 * 1024] = acc10[r]; q[32 * 1024 + 32] = acc11[r]; }
}

__device__ __forceinline__ void ph_ctx_fold_norm(const P& p, int L, int which, const float* __restrict__ part, int nsplit, const float* __restrict__ gate) {
  const int tid = TIDX(), wid = tid >> 6, lane = tid & 63;
  float* xr = (float*)(p.ws + OFF_XRES); bf16_t* hb = (bf16_t*)(p.ws + OFF_HBF);
  const float* mods = (const float*)(p.ws + OFF_MODS) + (size_t)L * 3 * 6144;
  for (int cr = BIDX() * 8 + wid; cr < 2 * CTXL; cr += GDIM() * 8) {
    const int R = cr < CTXL ? cr : TB + (cr - CTXL);
    float* row = xr + (size_t)R * 1024 + lane * 4;
    const float* pr = part + (size_t)cr * 1024 + lane * 4;
    f32x4 v[4], a[4];
#pragma unroll
    for (int i = 0; i < 4; ++i) { v[i] = *(const f32x4*)(row + i * 256); a[i] = *(const f32x4*)(pr + i * 256); }
    for (int sp = 1; sp < nsplit; ++sp) {
#pragma unroll
      for (int i = 0; i < 4; ++i) a[i] += *(const f32x4*)(pr + (size_t)sp * 512 * 1024 + i * 256);
    }
    float ss = 0.f;
#pragma unroll
    for (int i = 0; i < 4; ++i) { v[i] += *(const f32x4*)(gate + 2 * 6144 + i * 256 + lane * 4) * a[i]; *(f32x4*)(row + i * 256) = v[i];
      ss += v[i][0] * v[i][0] + v[i][1] * v[i][1] + v[i][2] * v[i][2] + v[i][3] * v[i][3]; }
    ss = wave_sum(ss);
    const float rs = rsqrtf(ss * (1.f / 1024.f) + EPSF);
    const float* mr = mods + (size_t)2 * 6144 + which * 3072 + lane * 4;
#pragma unroll
    for (int i = 0; i < 4; ++i) { const f32x4 sh = *(const f32x4*)(mr + i * 256), scl = *(const f32x4*)(mr + 1024 + i * 256);
      float o[4];
#pragma unroll
      for (int j = 0; j < 4; ++j) o[j] = v[i][j] * rs * (1.f + scl[j]) + sh[j];
      uint2 w; w.x = cvtpk(o[0], o[1]); w.y = cvtpk(o[2], o[3]);
      *(uint2*)(hb + (size_t)R * 1024 + i * 256 + lane * 4) = w; }
  }
}

__device__ __forceinline__ void ph_norm(const P& p, int L, int which, int mode, int skipb) {
  const int tid = TIDX(), wid = tid >> 6, lane = tid & 63, l16 = lane & 15, sub = lane >> 4;
  const float* xr = (const float*)(p.ws + OFF_XRES);
  bf16_t* hb = (bf16_t*)(p.ws + OFF_HBF);
  const float* mods = (const float*)(p.ws + OFF_MODS) + (size_t)L * 3 * 6144;
  const int bid = BIDX() - skipb, nb = GDIM() - skipb;
  if (bid < 0) return;
  const int nquads = mode == 0 ? MROWS / 4 : (mode == 1 ? 2 * LAT / 4 : 2 * CTXL / 4);
  for (int q = bid * 8 + wid; q < nquads; q += nb * 8) {
    int R4;
    if (mode == 0) R4 = q * 4; else if (mode == 1) R4 = q < LAT / 4 ? CTXL + q * 4 : TB + CTXL + (q - LAT / 4) * 4; else R4 = q < CTXL / 4 ? q * 4 : TB + (q - CTXL / 4) * 4;
    const int R = R4 + sub;
    const float* row = xr + (size_t)R * 1024 + l16 * 4;
    f32x4 v[16]; float ss = 0.f;
#pragma unroll
    for (int i = 0; i < 16; ++i) v[i] = *(const f32x4*)(row + i * 64);
#pragma unroll
    for (int i = 0; i < 16; ++i) ss += v[i][0] * v[i][0] + v[i][1] * v[i][1] + v[i][2] * v[i][2] + v[i][3] * v[i][3];
    ss += __shfl_xor(ss, 1); ss += __shfl_xor(ss, 2); ss += __shfl_xor(ss, 4); ss += __shfl_xor(ss, 8);
    const float rs = rsqrtf(ss * (1.f / 1024.f) + EPSF);
    const float* mr = mods + (size_t)modrow_of(R) * 6144 + which * 3072 + l16 * 4;
    bf16_t* dst = hb + (size_t)R * 1024 + l16 * 4;
#pragma unroll
    for (int i = 0; i < 16; ++i) { const f32x4 sh = *(const f32x4*)(mr + i * 64), scl = *(const f32x4*)(mr + 1024 + i * 64);
      float o[4];
#pragma unroll
      for (int j = 0; j < 4; ++j) o[j] = v[i][j] * rs * (1.f + scl[j]) + sh[j];
      uint2 w; w.x = cvtpk(o[0], o[1]); w.y = cvtpk(o[2], o[3]);
      *(uint2*)(dst + i * 64) = w; }
  }
}

struct EpiRec { bf16_t* P1; bf16_t* P2; float* SM;
  DI void operator()(int row, int col, float v) const {
    if (col < 1536) P1[(size_t)row * 1536 + col] = f2bf(v);
    else if (col < 3584) P2[(size_t)row * 2048 + (col - 1536)] = f2bf(v);
    else { const int lc = col - 3584; if (lc < 48) SM[(size_t)row * 64 + lc] = v; } } };
struct EpiBf { bf16_t* O; int ldc;
  DI void operator()(int row, int col, float v) const { O[(size_t)row * ldc + col] = f2bf(v); } };
struct EpiRes { float* X; const float* gate;
  DI void operator()(int row, int col, float v) const { float* q = X + (size_t)row * 1024 + col; *q = *q + gate[(size_t)modrow_of(row) * 6144 + col] * v; } };

template <class Epi>
__device__ __forceinline__ void gemm_phase(char* lds, const bf16_t* __restrict__ A, int lda, const bf16_t* __restrict__ Bt, int K, int nN, const Epi epi, bool skipctx = false) {
  const int tid = TIDX(), wid = tid >> 6, lane = tid & 63, r32 = lane & 31, hi = lane >> 5;
  const int wm = wid >> 1, wn = wid & 1;
  const int nk = K >> 6;
  constexpr int RS = 144, ASZ = 256 * RS, BSZ = 128 * RS, STG = ASZ + BSZ;
  const int ntiles = (skipctx ? 64 : MROWS / 256) * nN;
  const int srow = tid >> 3, spc = tid & 7;
  for (int t = BIDX(); t < ntiles; t += GDIM()) {
    int pm = t / nN; const int pn = t - pm * nN; if (skipctx) pm = pm + 1 + (pm >= 32 ? 1 : 0);
    const bf16_t* Ab = A + (size_t)(pm * 256 + srow) * lda + spc * 8;
    const bf16_t* Bb = Bt + (size_t)(pn * 128 + srow) * K + spc * 8;
    f32x16 acc00 = {}, acc01 = {}, acc10 = {}, acc11 = {};
    bf16x8 ra0, ra1, ra2, ra3, rb0, rb1;
#define GLOAD(kt) do { const int ko = (kt) * 64; ra0 = *(const bf16x8*)(Ab + ko); ra1 = *(const bf16x8*)(Ab + (size_t)64 * lda + ko); ra2 = *(const bf16x8*)(Ab + (size_t)128 * lda + ko); \
    ra3 = *(const bf16x8*)(Ab + (size_t)192 * lda + ko); rb0 = *(const bf16x8*)(Bb + ko); rb1 = *(const bf16x8*)(Bb + (size_t)64 * K + ko); } while (0)
#define SWRITE(buf) do { char* sb = lds + (buf) * STG + srow * RS + spc * 16; *(bf16x8*)(sb) = ra0; *(bf16x8*)(sb + 64 * RS) = ra1; *(bf16x8*)(sb + 128 * RS) = ra2; *(bf16x8*)(sb + 192 * RS) = ra3; \
    *(bf16x8*)(sb + ASZ) = rb0; *(bf16x8*)(sb + ASZ + 64 * RS) = rb1; } while (0)
    GLOAD(0); SWRITE(0); __syncthreads();
    for (int kt = 0; kt < nk; ++kt) {
      const int cur = kt & 1;
      if (kt + 1 < nk) GLOAD(kt + 1);
      const char* ab = lds + cur * STG + (64 * wm + r32) * RS + hi * 16;
      const char* bb = lds + cur * STG + ASZ + (64 * wn + r32) * RS + hi * 16;
#pragma unroll
      for (int ks = 0; ks < 4; ++ks) {
        const bf16x8 a0 = *(const bf16x8*)(ab + ks * 32), a1 = *(const bf16x8*)(ab + 32 * RS + ks * 32);
        const bf16x8 b0 = *(const bf16x8*)(bb + ks * 32), b1 = *(const bf16x8*)(bb + 32 * RS + ks * 32);
        acc00 = MFMA32(a0, b0, acc00); acc01 = MFMA32(a0, b1, acc01); acc10 = MFMA32(a1, b0, acc10); acc11 = MFMA32(a1, b1, acc11);
      }
      if (kt + 1 < nk) SWRITE(cur ^ 1);
      __syncthreads();
    }
#undef GLOAD
#undef SWRITE
    const int row0 = pm * 256 + 64 * wm, col0 = pn * 128 + 64 * wn + r32;
#pragma unroll
    for (int r = 0; r < 16; ++r) { const int rr = row0 + crow(r, hi);
      epi(rr, col0, acc00[r]); epi(rr, col0 + 32, acc01[r]); epi(rr + 32, col0, acc10[r]); epi(rr + 32, col0 + 32, acc11[r]); }
  }
}

namespace pg8 {
#define PG8_LAS __attribute__((address_space(3)))
constexpr int BM = 256, BK = 64, HALF = 128, HTB = HALF * BK * 2  , STAGE_BYTES = 8 * HTB, NXCD = 8, WGM = 8;

__host__ __device__ __forceinline__ int lds_byte(int r, int c) { const int st = (r >> 4) * 2 + (c >> 5), rr = r & 15, cc = c & 31, ob = rr * 64 + cc * 2; return st * 1024 + (ob ^ (((ob >> 9) & 1) << 5)); }
__host__ __device__ __forceinline__ void stage_rc(int b, int& R, int& C) { const int st = b / 1024, sb = b % 1024, swz = sb ^ (((sb >> 9) & 1) << 5); R = (st >> 1) * 16 + swz / 64; C = (st & 1) * 32 + (swz % 64) / 2; }
__host__ __device__ __forceinline__ int perm32(int rho) { const int n = rho >> 4, i = rho & 15; return 8 * (i >> 2) + 4 * n + (i & 3); }
struct Unit { int pm, pn; };
struct Gemm { const bf16_t* A; const bf16_t* Bt; int M, N, K, lda; };

struct StaticOrder {
    int nM, nN, nwg, G, c;
    __host__ __device__ void init(int M, int N, int G_, int c_) { nM = M / BM; nN = N / BM; nwg = nM * nN; G = G_; c = c_; }
    __host__ __device__ bool next(int i, Unit& u) const {
        const long L = (long)i * G + c; if (L >= nwg) return false;
        int wgid = (int)L; { const int q = nwg / NXCD, r = nwg % NXCD, xcd = wgid % NXCD, off = wgid / NXCD; wgid = (xcd < r ? xcd * (q + 1) : r * (q + 1) + (xcd - r) * q) + off; }
        const int nig = WGM * nN, gid = wgid / nig, fm = gid * WGM, gsz = (nM - fm) < WGM ? (nM - fm) : WGM;
        u.pm = fm + ((wgid % nig) % gsz); u.pn = (wgid % nig) / gsz; return true;
    }
    __device__ __forceinline__ void a_ready(const Unit&) const {}
    __device__ __forceinline__ void done(const Unit&) const {}
};
template <class Epi, class Sched, bool ALIGN_EPI = false, bool SP2 = false>
__device__ __forceinline__ void gemm_phase(PG8_LAS unsigned char* lds, const Gemm g, const Sched& S, const Epi& E) {
    const int tid = TIDX(), wid = __builtin_amdgcn_readfirstlane(tid >> 6), lane = tid & 63, wr = wid >> 2, wc = wid & 3, fr = lane & 15, fq = lane >> 4;
    const int K = g.K, nt = K / BK;
    unsigned voffA[2], voffB[2];
#pragma unroll
    for (int i = 0; i < 2; ++i) { int R, C; stage_rc(tid * 16 + i * 8192, R, C); const int Rb = Epi::PERM ? ((R & ~31) + perm32(R & 31)) : R;
        voffA[i] = (unsigned)(R * g.lda + C) * 2u; voffB[i] = (unsigned)(Rb * K + C) * 2u; }
    const size_t kstep = (size_t)(BK * 2);
    const size_t hstep = (size_t)HALF * K * 2;
    const size_t tstep = 2 * hstep; const size_t hstepA = (size_t)HALF * g.lda * 2, tstepA = 2 * hstepA;
    const unsigned ldsw = (unsigned)wid * 1024u;
    const int aoff = lds_byte(wr * 64 + fr, fq * 8), boff = lds_byte(wc * 32 + fr, fq * 8);
#define PG8_SA(b, h) (((b) * 2 + (h)) * HTB)
#define PG8_SB(b, h) ((4 + (b) * 2 + (h)) * HTB)
#define PG8_STAGE(bufoff, gbase, voff) do { _Pragma("unroll") for (int _i = 0; _i < 2; ++_i) \
        __builtin_amdgcn_global_load_lds((const unsigned*)((const char*)(gbase) + (voff)[_i]), (PG8_LAS unsigned*)(lds + (bufoff) + ldsw + _i * 8192), 16, 0, 0); } while (0)
#define PG8_LDA(dst, b, h) do { _Pragma("unroll") for (int m = 0; m < 4; ++m) _Pragma("unroll") for (int k = 0; k < 2; ++k) dst[m][k] = *(const PG8_LAS bf16x8*)(lds + PG8_SA(b, h) + aoff + m * 2048 + k * 1024); } while (0)
#define PG8_LDB(dst, b, h) do { _Pragma("unroll") for (int n = 0; n < 2; ++n) _Pragma("unroll") for (int k = 0; k < 2; ++k) dst[n][k] = *(const PG8_LAS bf16x8*)(lds + PG8_SB(b, h) + boff + n * 2048 + k * 1024); } while (0)
#define PG8_MMA(ai, bj, At, Bt) do { __builtin_amdgcn_s_setprio(1); _Pragma("unroll") for (int m = 0; m < 4; ++m) _Pragma("unroll") for (int n = 0; n < 2; ++n) _Pragma("unroll") for (int k = 0; k < 2; ++k) \
        acc[ai][bj][m][n] = __builtin_amdgcn_mfma_f32_16x16x32_bf16(Bt[n][k], At[m][k], acc[ai][bj][m][n], 0, 0, 0); __builtin_amdgcn_s_setprio(0); } while (0)
#define PG8_WAIT_V(n) asm volatile("s_waitcnt vmcnt(" #n ")" ::: "memory")
#define PG8_WAIT_L(n) asm volatile("s_waitcnt lgkmcnt(" #n ")" ::: "memory")
#define PG8_BAR __builtin_amdgcn_s_barrier()
#define PG8_SCHED __builtin_amdgcn_sched_barrier(0)
    Unit cur, nxt; int ui = 0;
    if (!S.next(0, cur)) return;
    f32x4 acc[2][2][4][2];
#pragma unroll
    for (int a = 0; a < 2; ++a)
#pragma unroll
        for (int b = 0; b < 2; ++b)
#pragma unroll
            for (int m = 0; m < 4; ++m)
#pragma unroll
                for (int n = 0; n < 2; ++n) acc[a][b][m][n] = (f32x4){0.f, 0.f, 0.f, 0.f};
    bf16x8 At[4][2], B0[2][2], B1[2][2];
    const char* cA = (const char*)g.A + (size_t)cur.pm * tstepA; const char* cB = (const char*)g.Bt + (size_t)cur.pn * tstep;
    S.a_ready(cur);
    if constexpr (SP2) {
        PG8_STAGE(PG8_SB(0, 0), cB, voffB); PG8_STAGE(PG8_SB(0, 1), cB + hstep, voffB); PG8_STAGE(PG8_SA(0, 0), cA, voffA); PG8_STAGE(PG8_SA(0, 1), cA + hstepA, voffA);
        if (wr == 1) PG8_BAR;
        PG8_WAIT_V(2); PG8_BAR;
        PG8_STAGE(PG8_SB(1, 0), cB + kstep, voffB); PG8_STAGE(PG8_SA(1, 0), cA + kstep, voffA); PG8_STAGE(PG8_SB(1, 1), cB + hstep + kstep, voffB);
        PG8_WAIT_V(6); PG8_BAR;
    } else {
        PG8_STAGE(PG8_SB(0, 0), cB, voffB); PG8_STAGE(PG8_SA(0, 0), cA, voffA); PG8_STAGE(PG8_SB(0, 1), cB + hstep, voffB); PG8_STAGE(PG8_SA(0, 1), cA + hstepA, voffA);
        if (wr == 1) PG8_BAR;
        PG8_WAIT_V(4); PG8_BAR;
        PG8_STAGE(PG8_SB(1, 0), cB + kstep, voffB); PG8_STAGE(PG8_SA(1, 0), cA + kstep, voffA); PG8_STAGE(PG8_SB(1, 1), cB + hstep + kstep, voffB);
        PG8_WAIT_V(6); PG8_BAR;
    }
    for (;;) {
        const bool has_next = S.next(ui + 1, nxt);
        const char* nA = has_next ? (const char*)g.A + (size_t)nxt.pm * tstepA : cA; const char* nB = has_next ? (const char*)g.Bt + (size_t)nxt.pn * tstep : cB;
        for (int t = 0; t < nt; t += 2) {
            const bool last = (t == nt - 2);
            const char* a1 = cA + (size_t)(t + 1) * kstep;
            const char* a2 = last ? nA : cA + (size_t)(t + 2) * kstep; const char* b2 = last ? nB : cB + (size_t)(t + 2) * kstep;
            const char* a3 = a2 + kstep; const char* b3 = b2 + kstep;
            if (last && has_next) S.a_ready(nxt);
            if constexpr (SP2) {
            PG8_LDB(B0, 0, 0); PG8_LDB(B1, 0, 1); PG8_SCHED; PG8_LDA(At, 0, 0); PG8_STAGE(PG8_SA(1, 1), a1 + hstepA, voffA);
            PG8_WAIT_V(8); PG8_WAIT_L(0); PG8_BAR; PG8_MMA(0, 0, At, B0); PG8_MMA(0, 1, At, B1); PG8_BAR; PG8_SCHED;
            PG8_LDA(At, 0, 1); PG8_STAGE(PG8_SB(0, 0), b2, voffB); PG8_STAGE(PG8_SB(0, 1), b2 + hstep, voffB); PG8_STAGE(PG8_SA(0, 0), a2, voffA);
            PG8_WAIT_V(8); PG8_WAIT_L(0); PG8_BAR; PG8_MMA(1, 0, At, B0); PG8_MMA(1, 1, At, B1); PG8_BAR; PG8_SCHED;
            PG8_LDB(B0, 1, 0); PG8_LDB(B1, 1, 1); PG8_SCHED; PG8_LDA(At, 1, 0); PG8_STAGE(PG8_SA(0, 1), a2 + hstepA, voffA);
            PG8_WAIT_V(8); PG8_WAIT_L(0); PG8_BAR; PG8_MMA(0, 0, At, B0); PG8_MMA(0, 1, At, B1); PG8_BAR; PG8_SCHED;
            PG8_LDA(At, 1, 1); PG8_STAGE(PG8_SB(1, 0), b3, voffB); PG8_STAGE(PG8_SB(1, 1), b3 + hstep, voffB); PG8_STAGE(PG8_SA(1, 0), a3, voffA);
            PG8_WAIT_V(8); PG8_WAIT_L(0); PG8_BAR; PG8_MMA(1, 0, At, B0); PG8_MMA(1, 1, At, B1); PG8_BAR; PG8_SCHED;
            } else {
            PG8_LDB(B0, 0, 0); PG8_SCHED; PG8_LDA(At, 0, 0); PG8_STAGE(PG8_SA(1, 1), a1 + hstepA, voffA);
            PG8_WAIT_L(8); PG8_BAR; PG8_WAIT_L(0); PG8_MMA(0, 0, At, B0); PG8_BAR; PG8_SCHED;
            PG8_LDB(B1, 0, 1); PG8_STAGE(PG8_SB(0, 0), b2, voffB);
            PG8_BAR; PG8_WAIT_L(0); PG8_MMA(0, 1, At, B1); PG8_BAR;
            PG8_LDA(At, 0, 1); PG8_STAGE(PG8_SA(0, 0), a2, voffA);
            PG8_BAR; PG8_WAIT_L(0); PG8_MMA(1, 0, At, B0); PG8_BAR; PG8_SCHED;
            PG8_STAGE(PG8_SB(0, 1), b2 + hstep, voffB);
            PG8_WAIT_V(6); PG8_BAR; PG8_MMA(1, 1, At, B1); PG8_BAR;
            PG8_LDB(B0, 1, 0); PG8_SCHED; PG8_LDA(At, 1, 0); PG8_STAGE(PG8_SA(0, 1), a2 + hstepA, voffA);
            PG8_WAIT_L(8); PG8_BAR; PG8_WAIT_L(0); PG8_MMA(0, 0, At, B0); PG8_BAR; PG8_SCHED;
            PG8_LDB(B1, 1, 1); PG8_STAGE(PG8_SB(1, 0), b3, voffB);
            PG8_BAR; PG8_WAIT_L(0); PG8_MMA(0, 1, At, B1); PG8_BAR;
            PG8_LDA(At, 1, 1); PG8_STAGE(PG8_SA(1, 0), a3, voffA);
            PG8_BAR; PG8_WAIT_L(0); PG8_MMA(1, 0, At, B0); PG8_BAR; PG8_SCHED;
            PG8_STAGE(PG8_SB(1, 1), b3 + hstep, voffB);
            PG8_WAIT_V(6); PG8_BAR; PG8_MMA(1, 1, At, B1); PG8_BAR;
            }
        }
        if constexpr (ALIGN_EPI) { if (wr == 0) PG8_BAR; }
        if constexpr (!Epi::AFTER_DRAIN) { E(acc, cur, wr, wc, fr, fq); S.done(cur); }
        if (!has_next) break;
#pragma unroll
        for (int a = 0; a < 2; ++a)
#pragma unroll
            for (int b = 0; b < 2; ++b)
#pragma unroll
                for (int m = 0; m < 4; ++m)
#pragma unroll
                    for (int n = 0; n < 2; ++n) acc[a][b][m][n] = (f32x4){0.f, 0.f, 0.f, 0.f};
        cur = nxt; cA = nA; cB = nB; ++ui;
        if constexpr (ALIGN_EPI) { if (wr == 1) PG8_BAR; }
    }
    PG8_WAIT_V(0);
    if constexpr (!ALIGN_EPI) { if (wr == 0) PG8_BAR; }
    PG8_BAR;
    if constexpr (Epi::AFTER_DRAIN) { E.fused(acc, cur, wr, wc, fr, fq, lds, wid, lane); S.done(cur); }
#undef PG8_SA
#undef PG8_SB
#undef PG8_STAGE
#undef PG8_LDA
#undef PG8_LDB
#undef PG8_MMA
#undef PG8_WAIT_V
#undef PG8_WAIT_L
#undef PG8_BAR
#undef PG8_SCHED
}
struct SchedX { StaticOrder so; int mode;
  __device__ __forceinline__ bool next(int i, Unit& u) const {
    if (mode == 2) { if (i != 0 || so.c >= 8) return false; u.pm = (so.c >> 2) ? 33 : 0; u.pn = so.c & 3; return true; }
    if (!so.next(i, u)) return false; if (mode == 1) u.pm = u.pm + 1 + (u.pm >= 32 ? 1 : 0); return true; }
  __device__ __forceinline__ void a_ready(const Unit&) const {}
  __device__ __forceinline__ void done(const Unit&) const {} };
}
struct EpiRec8 { static constexpr bool PERM = false, AFTER_DRAIN = false; bf16_t* P1; bf16_t* P2; float* SM;
  DI void operator()(const f32x4 (&acc)[2][2][4][2], const pg8::Unit& u, int wr, int wc, int fr, int fq) const {
#pragma unroll
    for (int ai = 0; ai < 2; ++ai)
#pragma unroll
      for (int m = 0; m < 4; ++m) { const size_t row = (size_t)u.pm * 256 + ai * 128 + wr * 64 + m * 16 + fr;
#pragma unroll
        for (int bj = 0; bj < 2; ++bj)
#pragma unroll
          for (int n = 0; n < 2; ++n) { const int col = u.pn * 256 + bj * 128 + wc * 32 + n * 16 + fq * 4; const f32x4 v = acc[ai][bj][m][n];
            if (u.pn < 6) { uint2 w; w.x = cvtpk(v[0], v[1]); w.y = cvtpk(v[2], v[3]); *(uint2*)(P1 + row * 1536 + col) = w; }
            else if (u.pn < 14) { uint2 w; w.x = cvtpk(v[0], v[1]); w.y = cvtpk(v[2], v[3]); *(uint2*)(P2 + row * 2048 + (col - 1536)) = w; }
            else { const int lc = col - 3584; if (lc < 48) *(f32x4*)(SM + row * 64 + lc) = v; } } } } };
struct EpiBf8 { static constexpr bool PERM = false, AFTER_DRAIN = false; bf16_t* O; int ldc;
  DI void operator()(const f32x4 (&acc)[2][2][4][2], const pg8::Unit& u, int wr, int wc, int fr, int fq) const {
#pragma unroll
    for (int ai = 0; ai < 2; ++ai)
#pragma unroll
      for (int m = 0; m < 4; ++m) { const size_t row = (size_t)u.pm * 256 + ai * 128 + wr * 64 + m * 16 + fr;
#pragma unroll
        for (int bj = 0; bj < 2; ++bj)
#pragma unroll
          for (int n = 0; n < 2; ++n) { const int col = u.pn * 256 + bj * 128 + wc * 32 + n * 16 + fq * 4; const f32x4 v = acc[ai][bj][m][n];
            uint2 w; w.x = cvtpk(v[0], v[1]); w.y = cvtpk(v[2], v[3]); *(uint2*)(O + row * ldc + col) = w; } } } };
struct EpiRes8 { static constexpr bool PERM = false, AFTER_DRAIN = false; float* X; const float* gate;
  DI void operator()(const f32x4 (&acc)[2][2][4][2], const pg8::Unit& u, int wr, int wc, int fr, int fq) const {
    const float* gr = gate + (size_t)modrow_of(u.pm * 256) * 6144;
#pragma unroll
    for (int bj = 0; bj < 2; ++bj)
#pragma unroll
      for (int n = 0; n < 2; ++n) { const int col = u.pn * 256 + bj * 128 + wc * 32 + n * 16 + fq * 4; const f32x4 gv = *(const f32x4*)(gr + col);
#pragma unroll
        for (int ai = 0; ai < 2; ++ai)
#pragma unroll
          for (int m = 0; m < 4; ++m) { const size_t row = (size_t)u.pm * 256 + ai * 128 + wr * 64 + m * 16 + fr;
            f32x4* q = (f32x4*)(X + row * 1024 + col); *q = *q + gv * acc[ai][bj][m][n]; } } } };
template <class Epi>
__device__ __forceinline__ void gemm8(char* lds, const bf16_t* A, int lda, const bf16_t* Bt, int K, int N, int mode, const Epi& E) {
  pg8::Gemm g{A, Bt, mode == 1 ? 16384 : MROWS, N, K, lda};
  pg8::SchedX S; S.so.init(g.M, N, GDIM(), BIDX()); S.mode = mode;
  pg8::gemm_phase<Epi, pg8::SchedX, true, true>((PG8_LAS unsigned char*)lds, g, S, E);
}

__device__ __forceinline__ void ph_dnprep(const P& p, char* lds, int e) {
  const int tid = TIDX(), wid = tid >> 6, lane = tid & 63;
  const bf16_t* P1 = (const bf16_t*)(p.ws + OFF_D + D_P1);
  bf16_t* QQ = (bf16_t*)(p.ws + OFF_D + D_QQ); bf16_t* QK = (bf16_t*)(p.ws + OFF_D + D_QK); bf16_t* QV = (bf16_t*)(p.ws + OFF_D + D_QV);
  bf16_t* KT = (bf16_t*)(p.ws + OFF_D + D_KT);
  const float* SM = (const float*)(p.ws + OFF_SM); float* GB = (float*)(p.ws + OFF_GB);
  const float* cw = p.rec_conv + (size_t)e * 3 * 1536;
  bf16_t* kl = (bf16_t*)lds;
  for (int job = BIDX(); job < MROWS / 32; job += GDIM()) {
    const int R0 = job * 32;
    for (int tt = 0; tt < 4; ++tt) {
      const int tl = wid * 4 + tt, R = R0 + tl; const int b = R >= TB ? 1 : 0, pp = R - b * TB;
      const bool hasp = !(pp == 0 || pp == CTXL), hasn = !(pp == CTXL - 1 || pp == TB - 1);
#pragma unroll
      for (int part = 0; part < 3; ++part) {
        const int ch = part * 512 + lane * 8;
        const bf16x8 zc = *(const bf16x8*)(P1 + (size_t)R * 1536 + ch);
        bf16x8 zp = {}, zn = {};
        if (hasp) zp = *(const bf16x8*)(P1 + (size_t)(R - 1) * 1536 + ch);
        if (hasn) zn = *(const bf16x8*)(P1 + (size_t)(R + 1) * 1536 + ch);
        float o[8]; float ss = 0.f;
#pragma unroll
        for (int j = 0; j < 8; ++j) { const float a = bf2f((bf16_t)zp[j]) * cw[ch + j] + bf2f((bf16_t)zc[j]) * cw[1536 + ch + j] + bf2f((bf16_t)zn[j]) * cw[3072 + ch + j];
          o[j] = siluf(a); ss += o[j] * o[j]; }
        if (part < 2) {
          ss += __shfl_xor(ss, 1); ss += __shfl_xor(ss, 2); ss += __shfl_xor(ss, 4); ss += __shfl_xor(ss, 8);
          float sc = rsqrtf(ss + EPSF); if (part == 0) sc *= 0.08838834764831845f;
#pragma unroll
          for (int j = 0; j < 8; ++j) o[j] *= sc;
        }
        u32x4 w = {cvtpk(o[0], o[1]), cvtpk(o[2], o[3]), cvtpk(o[4], o[5]), cvtpk(o[6], o[7])};
        bf16_t* dst = part == 0 ? QQ : (part == 1 ? QK : QV);
        *(u32x4*)(dst + (size_t)R * 512 + lane * 8) = w;
        if (part == 1) *(u32x4*)(kl + tl * 512 + lane * 8) = w;
      }
      if (lane < 16) {
        const int q = lane & 7;
        if (lane < 8) { const float da = SM[(size_t)R * 64 + q]; GB[(size_t)R * 16 + q] = -expf(p.dn_a_log[e * 8 + q]) * softplusf(da + p.dn_dt_bias[e * 8 + q]); }
        else { const float db = SM[(size_t)R * 64 + 8 + q]; GB[(size_t)R * 16 + 8 + q] = sigmf(db); }
      }
    }
    __syncthreads();
    {
      const int b = R0 >= TB ? 1 : 0, c = (R0 - b * TB) / 64, half = ((R0 - b * TB) >> 5) & 1; const int h = tid >> 7, dk = tid & 127;
      bf16_t* dst = KT + ((((size_t)b * 4 + h) * NCH + c) * 128 + dk) * 64 + half * 32;
#pragma unroll
      for (int g8 = 0; g8 < 4; ++g8) { unsigned w[4];
#pragma unroll
        for (int j = 0; j < 4; ++j) { const unsigned lo = kl[(g8 * 8 + 2 * j) * 512 + tid], hi2 = kl[(g8 * 8 + 2 * j + 1) * 512 + tid]; w[j] = lo | (hi2 << 16); }
        *(u32x4*)(dst + g8 * 8) = (u32x4){w[0], w[1], w[2], w[3]}; }
    }
    __syncthreads();
  }
}

__device__ __forceinline__ void ph_dn_d1(const P& p, char* lds) {
  const int tid = TIDX(), wid = tid >> 6, lane = tid & 63, r32 = lane & 31, hi = lane >> 5;
  const bf16_t* QQ = (const bf16_t*)(p.ws + OFF_D + D_QQ); const bf16_t* QK = (const bf16_t*)(p.ws + OFF_D + D_QK); const bf16_t* QV = (const bf16_t*)(p.ws + OFF_D + D_QV);
  const float* GB = (const float*)(p.ws + OFF_GB);
  bf16_t* W_ = (bf16_t*)(p.ws + OFF_D + D_W); bf16_t* U_ = (bf16_t*)(p.ws + OFF_HBF); bf16_t* INTRA = (bf16_t*)(p.ws + OFF_D + D_INTRA);
  float* SC = (float*)(p.ws + OFF_SC); float* GLS = (float*)(p.ws + OFF_GL);
  float* KK = (float*)lds; float* QKm = KK + 64 * 65; float* Ad = QKm + 64 * 65; float* Gs = Ad + 2 * 4096; float* Bs = Gs + 128;
  bf16_t* Vs = (bf16_t*)(Bs + 128); bf16_t* Ks = Vs + 64 * 128;
  for (int job = BIDX(); job < 8 * NCH; job += GDIM()) {
    const int b = job / (4 * NCH), h = (job / NCH) & 3, c = job % NCH;
    const size_t Rb = (size_t)b * TB + (size_t)c * 64;
    {
      const int srow = tid >> 4, spc = (tid & 15) * 8;
      const u32x4 v0 = *(const u32x4*)(QV + (Rb + srow) * 512 + h * 128 + spc), v1 = *(const u32x4*)(QV + (Rb + 32 + srow) * 512 + h * 128 + spc);
      const u32x4 k0 = *(const u32x4*)(QK + (Rb + srow) * 512 + h * 128 + spc), k1 = *(const u32x4*)(QK + (Rb + 32 + srow) * 512 + h * 128 + spc);
      *(u32x4*)(Vs + srow * 128 + spc) = v0; *(u32x4*)(Vs + (32 + srow) * 128 + spc) = v1;
      *(u32x4*)(Ks + srow * 128 + spc) = k0; *(u32x4*)(Ks + (32 + srow) * 128 + spc) = k1;
    }
    {
      const int w4 = wid & 3, mi = w4 & 1, ni = w4 >> 1;
      const bf16_t* As = wid < 4 ? QK : QQ;
      const bf16_t* arow = As + (Rb + 32 * mi + r32) * 512 + h * 128 + hi * 8;
      const bf16_t* brow = QK + (Rb + 32 * ni + r32) * 512 + h * 128 + hi * 8;
      f32x16 acc = {}; acc = mma_rows<8>(arow, brow, acc);
      float* dst = wid < 4 ? KK : QKm;
#pragma unroll
      for (int r = 0; r < 16; ++r) dst[(32 * mi + crow(r, hi)) * 65 + 32 * ni + r32] = acc[r];
    }
    if (tid < 128) { const int d = tid >> 6, ip = tid & 63, t = d ? 63 - ip : ip; float g = GB[(Rb + t) * 16 + d * 4 + h]; Bs[tid] = GB[(Rb + t) * 16 + 8 + d * 4 + h];
#pragma unroll
      for (int o = 1; o < 64; o <<= 1) { const float v = __shfl_up(g, o); g += ip >= o ? v : 0.f; }
      Gs[tid] = g; }
    __syncthreads();
    const int n0 = c, n1 = c < 4 ? 3 - c : 135 - c;
    const size_t cj0 = ((size_t)(0 * 2 + b) * 4 + h) * NCH + n0, cj1 = ((size_t)(1 * 2 + b) * 4 + h) * NCH + n1;
    for (int e2 = tid; e2 < 8192; e2 += 512) {
      const int d = e2 >> 12, ip = (e2 >> 6) & 63, jp = e2 & 63; const int i = d ? 63 - ip : ip, j = d ? 63 - jp : jp;
      const float dec = jp <= ip ? __expf(Gs[d * 64 + ip] - Gs[d * 64 + jp]) : 0.f;
      Ad[d * 4096 + ip * 64 + jp] = jp < ip ? Bs[d * 64 + ip] * KK[i * 65 + j] * dec : 0.f;
      const size_t cj = d ? cj1 : cj0;
      INTRA[(cj * 64 + ip) * 64 + jp] = f2bf(QKm[i * 65 + j] * dec);
    }
    if (tid < 128) { const int d = tid >> 6, ip = tid & 63; const size_t cj = d ? cj1 : cj0; const float gi = Gs[tid], gl = Gs[d * 64 + 63];
      SC[(cj * 64 + ip) * 2] = __expf(gi); SC[(cj * 64 + ip) * 2 + 1] = __expf(gl - gi); if (ip == 0) GLS[cj] = __expf(gl); }
    __syncthreads();
    {
      const int d = tid >> 8, cc = tid & 255; const size_t cj = d ? cj1 : cj0;
      int dofs = d * 64, aofs = d * 4096; asm volatile("" : "+v"(dofs), "+v"(aofs));
      float x[64];
      {
        int vofs = cc < 128 ? cc : 64 * 128 + (cc - 128); asm volatile("" : "+v"(vofs));
#pragma unroll
        for (int ip = 0; ip < 64; ++ip) x[ip] = bf2f(Vs[vofs + ip * 128]);
#pragma unroll
        for (int ip = 0; ip < 32; ++ip) { const float a_ = x[ip], b_ = x[63 - ip]; x[ip] = d ? b_ : a_; x[63 - ip] = d ? a_ : b_; }
        if (cc < 128) {
#pragma unroll
          for (int ip = 0; ip < 64; ++ip) x[ip] *= Bs[dofs + ip];
        } else {
#pragma unroll
          for (int ip = 0; ip < 64; ++ip) x[ip] *= Bs[dofs + ip] * __expf(Gs[dofs + ip]);
        }
      }
      const float* Arow = Ad + aofs;
#pragma unroll
      for (int ip = 1; ip < 64; ++ip) {
        float s = 0.f;
#pragma unroll
        for (int j4 = 0; j4 < (ip + 3) / 4; ++j4) { const f32x4 a = *(const f32x4*)(Arow + ip * 64 + 4 * j4);
          s += a[0] * x[4 * j4] + a[1] * x[4 * j4 + 1] + a[2] * x[4 * j4 + 2] + a[3] * x[4 * j4 + 3]; }
        x[ip] -= s;
      }
      bf16_t* dst = cc < 128 ? U_ + cj * 64 * 128 + cc : W_ + cj * 64 * 128 + (cc - 128);
#pragma unroll
      for (int ip = 0; ip < 64; ++ip) dst[ip * 128] = f2bf(x[ip]);
    }
    __syncthreads();
  }
}

typedef _Float16 h16x8 __attribute__((ext_vector_type(8)));
__device__ __forceinline__ void ph_gla_b(const P& p, char* lds, int e) {
  const int tid = TIDX(), wid = tid >> 6, lane = tid & 63;
  const float* SM = (const float*)(p.ws + OFF_SM);
  float* w2S = (float*)lds;
  float* b2S = w2S + 8192;
  for (int i = tid; i < 8192; i += 512) { const int d = i >> 12, hh = (i >> 10) & 3, r = (i >> 6) & 15, j = i & 63; w2S[i] = p.gla_w2[(((size_t)e * 2 + d) * 16 + r) * 256 + hh * 64 + j]; }
  if (tid < 512) b2S[tid] = p.gla_b2[(size_t)e * 512 + tid];
  __syncthreads();
  int jb = 8 * wid; asm volatile("" : "+v"(jb));
  for (int job = GDIM() - 1 - BIDX(); job < 16 * NCH; job += GDIM()) {
    const int n = job % NCH, sq = job / NCH; const int dir = sq >> 3, b = (sq >> 2) & 1, h = sq & 3;
    const int c = dir == 0 ? n : (n < 4 ? 3 - n : 135 - n);
    const size_t row = (size_t)b * TB + (size_t)c * 64 + (dir ? 63 - lane : lane);
    const float* gp = SM + row * 64 + 16 + dir * 16;
    const f32x4 g0 = *(const f32x4*)(gp), g1 = *(const f32x4*)(gp + 4), g2 = *(const f32x4*)(gp + 8), g3 = *(const f32x4*)(gp + 12);
    const float gg_[16] = {g0[0], g0[1], g0[2], g0[3], g1[0], g1[1], g1[2], g1[3], g2[0], g2[1], g2[2], g2[3], g3[0], g3[1], g3[2], g3[3]};
    const float* wb = w2S + (dir * 4 + h) * 1024 + jb; const float* bb2 = b2S + dir * 256 + h * 64 + jb;
    f32x4 sa = *(const f32x4*)(bb2), sb = *(const f32x4*)(bb2 + 4);
#pragma unroll
    for (int r = 0; r < 16; ++r) { const f32x4 wa = *(const f32x4*)(wb + r * 64), wq = *(const f32x4*)(wb + r * 64 + 4); sa += gg_[r] * wa; sb += gg_[r] * wq; }
    float la[8];
#pragma unroll
    for (int jj = 0; jj < 4; ++jj) { const float x0 = sa[jj], x1 = sb[jj];
      la[jj] = (fminf(x0, 0.f) - log1pf(expf(-fabsf(x0)))) * 0.0625f; la[4 + jj] = (fminf(x1, 0.f) - log1pf(expf(-fabsf(x1)))) * 0.0625f; }
#pragma unroll
    for (int o = 1; o < 64; o <<= 1) {
#pragma unroll
      for (int jj = 0; jj < 8; ++jj) { const float v = __shfl_up(la[jj], o); la[jj] += lane >= o ? v : 0.f; }
    }
    h16x8 hv;
#pragma unroll
    for (int jj = 0; jj < 8; ++jj) hv[jj] = (_Float16)la[jj];
    _Float16* dst = (_Float16*)(p.ws + (dir ? OFF_B16_1 : OFF_WC)) + ((((size_t)b * 4 + h) * NCH + n) * 64 + lane) * 64 + jb;
    *(h16x8*)dst = hv;
  }
}

struct DnSet { bf16x8 fa[8]; };
template <int ROLE>
__device__ __forceinline__ void dn_scan_t(const P& p, char* lds, int job) {
  const int tid = TIDX(), wid = tid >> 6, lane = tid & 63, r32 = lane & 31, hi = lane >> 5;
  const int dir = job >> 5, b = (job >> 4) & 1, h = (job >> 2) & 3, n0 = (job & 3) * 32;
  const bf16_t* QQ = (const bf16_t*)(p.ws + OFF_D + D_QQ); const bf16_t* KT = (const bf16_t*)(p.ws + OFF_D + D_KT);
  const bf16_t* W_ = (const bf16_t*)(p.ws + OFF_D + D_W); const bf16_t* U_ = (const bf16_t*)(p.ws + OFF_HBF); const bf16_t* INTRA = (const bf16_t*)(p.ws + OFF_D + D_INTRA);
  const float* SC = (const float*)(p.ws + OFF_SC); const float* GLS = (const float*)(p.ws + OFF_GL);
  bf16_t* DNO = (bf16_t*)(p.ws + OFF_D + D_DNO);
  bf16_t* ST = (bf16_t*)lds; bf16_t* vTa = ST + 32 * 136; bf16_t* vTb = vTa + 32 * 72;
  float* scS = (float*)(vTb + 32 * 72);
  bf16_t* uS = (bf16_t*)(scS + 256);
  bf16_t* inS = uS + 2 * 64 * 40;
  for (int i = tid; i < 32 * 136; i += 512) ST[i] = 0;
  f32x16 accS = {};
  const size_t seq = ((size_t)dir * 2 + b) * 4 + h;
  const int mi = wid & 1, di = wid - 4;
  constexpr int role = ROLE;
  const int tt = tid - 256;
  DnSet fs[3]; float gls[3] = {0.f, 0.f, 0.f};
  u32x4 stU[3], stI0[3]; float stS[3] = {0.f, 0.f, 0.f};
#define DN_CH(n_) const int n__ = (n_); const int c__ = dir == 0 ? n__ : (n__ < 4 ? 3 - n__ : 135 - n__); const size_t Rb__ = (size_t)b * TB + (size_t)c__ * 64; const size_t cj__ = seq * NCH + n__;
#define DN_LOAD(S, GL, n_) do { DN_CH(n_) \
    const int ipl__ = 32 * mi + r32, tl__ = dir ? 63 - ipl__ : ipl__; \
    const bf16_t* b0__ = W_ + cj__ * 8192 + (32 * mi + r32) * 128 + hi * 8; \
    const bf16_t* b1__ = QQ + (Rb__ + tl__) * 512 + h * 128 + hi * 8; \
    const bf16_t* b2__ = KT + ((((size_t)b * 4 + h) * NCH + c__) * 128 + 32 * (wid & 3) + r32) * 64 + hi * 8; \
    const bf16_t* bs__ = role == 0 ? b0__ : (role == 1 ? b1__ : b2__); \
    _Pragma("unroll") for (int ks = 0; ks < 8; ++ks) S.fa[ks] = *(const bf16x8*)(bs__ + ks * 16); \
    GL = GLS[cj__]; } while (0)
#define DN_STAGE_LD(q_, n_) do { DN_CH(n_) (void)Rb__; \
      stU[q_] = *(const u32x4*)(U_ + cj__ * 8192 + ((tid & 255) >> 2) * 128 + n0 + (tid & 3) * 8); \
      stI0[q_] = *(const u32x4*)(INTRA + cj__ * 4096 + (tid >> 3) * 64 + (tid & 7) * 8); \
      stS[q_] = SC[cj__ * 128 + (tid & 127)]; } while (0)
#define DN_STAGE_ST(q_, bf_) do { *(u32x4*)(inS + (bf_) * 4608 + (tid >> 3) * 72 + (tid & 7) * 8) = stI0[q_]; \
      if (ROLE < 2) *(u32x4*)(uS + (bf_) * 2560 + (tid >> 2) * 40 + (tid & 3) * 8) = stU[q_]; \
      if (ROLE == 0) scS[(bf_) * 128 + tid] = stS[q_]; } while (0)
#define DN_STEP(S, GL, n_, bf_) do { DN_CH(n_) (void)cj__; \
    const float* sc__ = scS + (bf_) * 128; \
    if (role < 2) { _Pragma("unroll") for (int r = 0; r < 16; ++r) accS[r] = 0.f; } \
    if (role < 2) { const bf16_t* sb__ = ST + r32 * 136 + hi * 8; \
      _Pragma("unroll") for (int ks = 0; ks < 8; ++ks) accS = MFMA32(S.fa[ks], *(const bf16x8*)(sb__ + ks * 16), accS); \
      if (role == 0) { const bf16_t* us__ = uS + (bf_) * 2560 + r32; \
        _Pragma("unroll") for (int r = 0; r < 16; ++r) { const int ip = 32 * mi + crow(r, hi); const float vn = bf2f(us__[ip * 40]) - accS[r]; \
          vTa[r32 * 72 + ip] = f2bf(vn); const int to = dir ? 63 - ip : ip; vTb[r32 * 72 + to] = f2bf(vn * sc__[ip * 2 + 1]); } } \
      else { _Pragma("unroll") for (int r = 0; r < 16; ++r) accS[r] *= sc__[(32 * mi + crow(r, hi)) * 2]; } } \
    LBAR(); \
    if (role == 1) { const bf16_t* vb__ = vTa + r32 * 72 + hi * 8; const bf16_t* ib__ = inS + (bf_) * 4608 + (32 * mi + r32) * 72 + hi * 8; \
      _Pragma("unroll") for (int ks = 0; ks < 4; ++ks) accS = MFMA32(*(const bf16x8*)(ib__ + ks * 16), *(const bf16x8*)(vb__ + ks * 16), accS); \
      _Pragma("unroll") for (int r = 0; r < 16; ++r) { const int ip = 32 * mi + crow(r, hi), t = dir ? 63 - ip : ip; \
        DNO[((size_t)dir * MROWS + Rb__ + t) * 512 + h * 128 + n0 + r32] = f2bf(accS[r]); } } \
    else if (role == 2) { const bf16_t* vb__ = vTb + r32 * 72 + hi * 8; \
      _Pragma("unroll") for (int r = 0; r < 16; ++r) accS[r] *= GL; \
      _Pragma("unroll") for (int ks = 0; ks < 4; ++ks) accS = MFMA32(S.fa[ks], *(const bf16x8*)(vb__ + ks * 16), accS); \
      _Pragma("unroll") for (int r = 0; r < 16; ++r) ST[r32 * 136 + 32 * di + crow(r, hi)] = f2bf(accS[r]); } \
    LBAR(); } while (0)
  DN_STAGE_LD(0, 0); DN_STAGE_ST(0, 0); DN_STAGE_LD(1, 1); DN_STAGE_LD(2, 2);
  DN_LOAD(fs[0], gls[0], 0); DN_LOAD(fs[1], gls[1], 1);
  __syncthreads();
  for (int nb6 = 0; nb6 < NCH; nb6 += 6) {
#pragma unroll
    for (int k = 0; k < 6; ++k) {
      const int n = nb6 + k; const int n2 = n + 2 < NCH ? n + 2 : NCH - 1; const int n3 = n + 3 < NCH ? n + 3 : NCH - 1;
      DN_STAGE_ST((k + 1) % 3, (k + 1) & 1);
      DN_STAGE_LD(k % 3, n3);
      DN_LOAD(fs[(k + 2) % 3], gls[(k + 2) % 3], n2);
      DN_STEP(fs[k % 3], gls[k % 3], n, k & 1);
    }
  }
#undef DN_CH
#undef DN_LOAD
#undef DN_STAGE_LD
#undef DN_STAGE_ST
#undef DN_STEP
}

__device__ __forceinline__ void dn_scan(const P& p, char* lds, int job) {
  const int wid = TIDX() >> 6;
  if (wid < 2) dn_scan_t<0>(p, lds, job); else if (wid < 4) dn_scan_t<1>(p, lds, job); else dn_scan_t<2>(p, lds, job);
}

DI float fast_logsig(float s) { return fminf(s, 0.f) - __logf(1.f + __expf(-fabsf(s))); }
struct GlaRegs { h16x8 ba, bb; bf16x8 qa, qb, ka, kb, v8; };
template <int ROLE>
__device__ __forceinline__ void gla_scan_t(const P& p, char* lds, int job, int e) {
  const int tid = TIDX(), wid = tid >> 6, lane = tid & 63, r32 = lane & 31, hi = lane >> 5;
  const int dir = job >> 5, b = (job >> 4) & 1, h = (job >> 2) & 3, n0 = (job & 3) * 32;
  const bf16_t* P2 = (const bf16_t*)(p.ws + OFF_D + D_P2); const float* SM = (const float*)(p.ws + OFF_SM);
  bf16_t* GLAO = (bf16_t*)(p.ws + OFF_D + D_GLAO);
  const _Float16* B16 = (const _Float16*)(p.ws + (dir ? OFF_B16_1 : OFF_WC));
  float* w2S = (float*)lds; float* b2S = w2S + 1024; float* aLb = b2S + 64;
  bf16_t* ops = (bf16_t*)(aLb + 128);
  constexpr int OPB = (4 * 64 + 32) * 72;
  bf16_t* attp = ops + 2 * OPB;
  bf16_t* STb = attp + 2 * 32 * 72;
  for (int i = tid; i < 2 * 32 * 72; i += 512) STb[i] = 0;
  f32x16 accS = {};
  __syncthreads();
  GlaRegs RG[3];
  int jb0 = 16 * (wid & 3); asm volatile("" : "+v"(jb0));
  int vtb0 = 8 * (wid & 3) * 72 + lane; asm volatile("" : "+v"(vtb0));
#define GLA_LOAD(R, n_) do { const int n__ = (n_) < NCH ? (n_) : NCH - 1; const int c__ = dir == 0 ? n__ : (n__ < 4 ? 3 - n__ : 135 - n__); const size_t row__ = (size_t)b * TB + (size_t)c__ * 64 + (dir ? 63 - lane : lane); \
    const _Float16* bp__ = B16 + ((((size_t)b * 4 + h) * NCH + n__) * 64 + lane) * 64 + 16 * (wid & 3); R.ba = *(const h16x8*)(bp__); R.bb = *(const h16x8*)(bp__ + 8); \
    const bf16_t* pr__ = P2 + row__ * 2048; R.qa = *(const bf16x8*)(pr__ + 512 + h * 64 + 16 * (wid & 3)); R.qb = *(const bf16x8*)(pr__ + 512 + h * 64 + 16 * (wid & 3) + 8); \
    R.ka = *(const bf16x8*)(pr__ + 768 + h * 64 + 16 * (wid & 3)); R.kb = *(const bf16x8*)(pr__ + 768 + h * 64 + 16 * (wid & 3) + 8); R.v8 = *(const bf16x8*)(pr__ + 1024 + h * 128 + n0 + 8 * (wid & 3)); } while (0)
#define GLA_HALF(R, BV, QV, KV, jb) do { \
    float eqe[8], eke[8], eqi[8]; \
    _Pragma("unroll") for (int jj = 0; jj < 8; ++jj) { const int j = (jb) + jj; const float bb = (float)BV[jj]; const float bm = __int_as_float(__builtin_amdgcn_readlane(__float_as_int(bb), 32)), bl = __int_as_float(__builtin_amdgcn_readlane(__float_as_int(bb), 63)); \
      const float q_ = bf2f((bf16_t)QV[jj]) * 0.125f, k_ = bf2f((bf16_t)KV[jj]); \
      eqe[jj] = q_ * __expf(bb - bm); eke[jj] = k_ * __expf(bm - bb); eqi[jj] = q_ * __expf(bb); ksT_[j * 72 + lane] = f2bf(k_ * __expf(bl - bb)); if (lane == 63) aL_[j] = __expf(bl); } \
    *(u32x4*)(qe_ + lane * 72 + (jb)) = (u32x4){cvtpk(eqe[0], eqe[1]), cvtpk(eqe[2], eqe[3]), cvtpk(eqe[4], eqe[5]), cvtpk(eqe[6], eqe[7])}; \
    *(u32x4*)(ke_ + lane * 72 + (jb)) = (u32x4){cvtpk(eke[0], eke[1]), cvtpk(eke[2], eke[3]), cvtpk(eke[4], eke[5]), cvtpk(eke[6], eke[7])}; \
    *(u32x4*)(qi_ + lane * 72 + (jb)) = (u32x4){cvtpk(eqi[0], eqi[1]), cvtpk(eqi[2], eqi[3]), cvtpk(eqi[4], eqi[5]), cvtpk(eqi[6], eqi[7])}; } while (0)
#define GLA_PREP(R, bf_) do { bf16_t* qe_ = ops + (bf_) * OPB; bf16_t* ke_ = qe_ + 64 * 72; bf16_t* qi_ = ke_ + 64 * 72; bf16_t* ksT_ = qi_ + 64 * 72; bf16_t* vT_ = ksT_ + 64 * 72; float* aL_ = aLb + (bf_) * 64; \
    GLA_HALF(R, R.ba, R.qa, R.ka, jb0); GLA_HALF(R, R.bb, R.qb, R.kb, jb0 + 8); \
    _Pragma("unroll") for (int q_ = 0; q_ < 8; ++q_) vT_[vtb0 + q_ * 72] = (bf16_t)R.v8[q_]; } while (0)
#define GLA_MMA(n_, bf_) do { const int nq__ = (n_); const int bf = (bf_); \
      const bf16_t* qe_ = ops + bf * OPB; const bf16_t* ke_ = qe_ + 64 * 72; const bf16_t* qi_ = ke_ + 64 * 72; const bf16_t* ksT_ = qi_ + 64 * 72; const bf16_t* vT_ = ksT_ + 64 * 72; const float* aL_ = aLb + bf * 64; \
      const bf16_t* STr = STb + bf * 32 * 72; bf16_t* STw = STb + (bf ^ 1) * 32 * 72; \
      if (ROLE == 1) { \
        const int mi = wid - 4; bf16_t* attw = attp + mi * 32 * 72; \
        const int c = dir == 0 ? nq__ : (nq__ < 4 ? 3 - nq__ : 135 - nq__); const size_t Rb = (size_t)b * TB + (size_t)c * 64; \
        f32x16 acc = {}; acc = mma_rows<4>(qi_ + (32 * mi + r32) * 72 + hi * 8, STr + r32 * 72 + hi * 8, acc); \
        { f32x16 a0 = {}; a0 = mma_rows<4>(qe_ + (32 * mi + r32) * 72 + hi * 8, ke_ + r32 * 72 + hi * 8, a0); \
          _Pragma("unroll") for (int r = 0; r < 16; ++r) { const int ipl = crow(r, hi); attw[ipl * 72 + r32] = f2bf((mi == 1 || r32 <= ipl) ? a0[r] : 0.f); } \
          f32x16 a1 = {}; if (mi == 1) a1 = mma_rows<4>(qe_ + (32 + r32) * 72 + hi * 8, ke_ + (32 + r32) * 72 + hi * 8, a1); \
          _Pragma("unroll") for (int r = 0; r < 16; ++r) { const int ipl = crow(r, hi); attw[ipl * 72 + 32 + r32] = f2bf((mi == 1 && r32 <= ipl) ? a1[r] : 0.f); } } \
        asm volatile("s_waitcnt lgkmcnt(0)" ::: "memory"); \
        acc = mma_rows<4>(attw + r32 * 72 + hi * 8, vT_ + r32 * 72 + hi * 8, acc); \
        _Pragma("unroll") for (int r = 0; r < 16; ++r) { const int ip = 32 * mi + crow(r, hi), t = dir ? 63 - ip : ip; \
          GLAO[((size_t)dir * MROWS + Rb + t) * 512 + h * 128 + n0 + r32] = f2bf(acc[r]); } \
      } else { \
        const int di = wid - 6; \
        _Pragma("unroll") for (int r = 0; r < 16; ++r) accS[r] *= aL_[32 * di + crow(r, hi)]; \
        accS = mma_rows<4>(ksT_ + (32 * di + r32) * 72 + hi * 8, vT_ + r32 * 72 + hi * 8, accS); \
        _Pragma("unroll") for (int r = 0; r < 16; ++r) STw[r32 * 72 + 32 * di + crow(r, hi)] = f2bf(accS[r]); \
      } } while (0)
  GLA_LOAD(RG[0], 0);
  if (ROLE == 0) { GLA_PREP(RG[0], 0); }
  GLA_LOAD(RG[1], 1); GLA_LOAD(RG[2], 2); GLA_LOAD(RG[0], 3);
  LBAR();
  for (int nb6 = 0; nb6 < NCH; nb6 += 6) {
#pragma unroll
    for (int k = 0; k < 6; ++k) {
      const int n = nb6 + k;
      if (ROLE == 0) { if (n + 1 < NCH) { GLA_PREP(RG[(k + 1) % 3], (k + 1) & 1); } } else { GLA_MMA(n, k & 1); }
      GLA_LOAD(RG[(k + 1) % 3], n + 4);
      LBAR();
    }
  }
#undef GLA_MMA
#undef GLA_LOAD
#undef GLA_HALF
#undef GLA_PREP
}

__device__ __forceinline__ void gla_scan(const P& p, char* lds, int job, int e) {
  const int wid = TIDX() >> 6;
  if (wid < 4) gla_scan_t<0>(p, lds, job, e); else if (wid < 6) gla_scan_t<1>(p, lds, job, e); else gla_scan_t<2>(p, lds, job, e);
}

__device__ __forceinline__ void ph_merge(const P& p, int e) {
  const int tid = TIDX(), wid = tid >> 6, lane = tid & 63, l16 = lane & 15, sub = lane >> 4;
  const bf16_t* DNO = (const bf16_t*)(p.ws + OFF_D + D_DNO); const bf16_t* GLAO = (const bf16_t*)(p.ws + OFF_D + D_GLAO);
  const bf16_t* P2 = (const bf16_t*)(p.ws + OFF_D + D_P2); bf16_t* hb = (bf16_t*)(p.ws + OFF_HBF);
  f32x8 nwd = *(const f32x8*)(p.dn_norm + e * 128 + l16 * 8), nwg = *(const f32x8*)(p.gla_norm + e * 128 + l16 * 8);
  for (int R4 = (BIDX() * 8 + wid) * 4; R4 < MROWS; R4 += GDIM() * 32) {
    const size_t R = R4 + sub;
    bf16x8 a[8], bq[8], zz[8];
#pragma unroll
    for (int g = 0; g < 8; ++g) { const bf16_t* src = g < 4 ? DNO : GLAO; const int hc = (g & 3) * 128 + l16 * 8;
      a[g] = *(const bf16x8*)(src + R * 512 + hc); bq[g] = *(const bf16x8*)(src + ((size_t)MROWS + R) * 512 + hc);
      zz[g] = *(const bf16x8*)(P2 + R * 2048 + (g < 4 ? 0 : 1536) + hc); }
#pragma unroll
    for (int g = 0; g < 8; ++g) {
      float v[8]; float ss = 0.f;
#pragma unroll
      for (int j = 0; j < 8; ++j) { v[j] = bf2f((bf16_t)a[g][j]) + bf2f((bf16_t)bq[g][j]); ss += v[j] * v[j]; }
      ss += __shfl_xor(ss, 1); ss += __shfl_xor(ss, 2); ss += __shfl_xor(ss, 4); ss += __shfl_xor(ss, 8);
      const float rs = rsqrtf(ss * (1.f / 128.f) + EPSF);
      float o[8];
#pragma unroll
      for (int j = 0; j < 8; ++j) o[j] = v[j] * rs * (g < 4 ? nwd[j] : nwg[j]) * siluf(bf2f((bf16_t)zz[g][j]));
      *(u32x4*)(hb + R * 1024 + g * 128 + l16 * 8) = (u32x4){cvtpk(o[0], o[1]), cvtpk(o[2], o[3]), cvtpk(o[4], o[5]), cvtpk(o[6], o[7])};
    }
  }
}

DI float silu_fast(float x) { return x / (1.f + __expf(-x)); }
__device__ __forceinline__ void ph_ffnact(const P& p, int L) {
  bf16_t* U = (bf16_t*)(p.ws + OFF_D);
  const float* cw = p.ffn_conv + (size_t)L * 3 * DFF;
  const size_t items = (size_t)MROWS * 352, stride = (size_t)GDIM() * 512;
  for (size_t it0 = (size_t)BIDX() * 512 + TIDX(); it0 < items; it0 += 2 * stride) {
    bf16x8 zc[2], zp[2], zn[2], vv[2]; int Rr[2], cc[2]; bool ok[2];
#pragma unroll
    for (int q = 0; q < 2; ++q) {
      size_t it = it0 + q * stride; ok[q] = it < items; if (!ok[q]) it = it0;
      const int R = (int)(it / 352), c0 = (int)(it % 352) * 8; const int b = R >= TB ? 1 : 0, pp = R - b * TB;
      const bool hasp = !(pp == 0 || pp == CTXL), hasn = !(pp == CTXL - 1 || pp == TB - 1);
      Rr[q] = R; cc[q] = c0;
      zc[q] = *(const bf16x8*)(U + (size_t)R * 5632 + c0);
      zp[q] = *(const bf16x8*)(U + (size_t)(hasp ? R - 1 : R) * 5632 + c0);
      zn[q] = *(const bf16x8*)(U + (size_t)(hasn ? R + 1 : R) * 5632 + c0);
      vv[q] = *(const bf16x8*)(U + (size_t)R * 5632 + DFF + c0);
      if (!hasp) zp[q] = (bf16x8){0, 0, 0, 0, 0, 0, 0, 0};
      if (!hasn) zn[q] = (bf16x8){0, 0, 0, 0, 0, 0, 0, 0};
    }
#pragma unroll
    for (int q = 0; q < 2; ++q) {
      const int c0 = cc[q];
      const f32x8 w0 = *(const f32x8*)(cw + c0), w1 = *(const f32x8*)(cw + DFF + c0), w2 = *(const f32x8*)(cw + 2 * DFF + c0);
      float o[8];
#pragma unroll
      for (int j = 0; j < 8; ++j) { const float a = bf2f((bf16_t)zp[q][j]) * w0[j] + bf2f((bf16_t)zc[q][j]) * w1[j] + bf2f((bf16_t)zn[q][j]) * w2[j];
        o[j] = silu_fast(a) * bf2f((bf16_t)vv[q][j]); }
      if (ok[q]) *(u32x4*)(U + (size_t)Rr[q] * 5632 + DFF + c0) = (u32x4){cvtpk(o[0], o[1]), cvtpk(o[2], o[3]), cvtpk(o[4], o[5]), cvtpk(o[6], o[7])};
    }
  }
}

__device__ __forceinline__ void ph_qknorm(const P& p, char* lds, int o) {
  const int tid = TIDX(), wid = tid >> 6, lane = tid & 63, l16 = lane & 15, sub = lane >> 4;
  bf16_t* QKV = (bf16_t*)(p.ws + OFF_D);
  float* tab = (float*)lds;
  for (int i = tid; i < 4096; i += 512) { const int pos = i >> 5, f = i & 31; const float ang = (float)pos * powf(10000.f, -(float)f / 32.f); tab[2 * i] = cosf(ang); tab[2 * i + 1] = sinf(ang); }
  __syncthreads();
  const f32x8 qn = *(const f32x8*)(p.att_q_norm + o * 128 + l16 * 8), kn = *(const f32x8*)(p.att_k_norm + o * 128 + l16 * 8);
  const int f0 = (l16 & 3) * 8;
  for (int R4 = (BIDX() * 8 + wid) * 4; R4 < MROWS; R4 += GDIM() * 32) {
    const int R = R4 + sub; const int b = R >= TB ? 1 : 0, pp = R - b * TB; const bool lat = pp >= CTXL; const int t = lat ? pp - CTXL : 0;
    const int pos = (l16 < 8) ? (t >> 6) : (t & 63);
    bf16_t* base = QKV + (size_t)R * 1536 + l16 * 8;
    bf16x8 x[10];
#pragma unroll
    for (int hd = 0; hd < 10; ++hd) x[hd] = *(const bf16x8*)(base + hd * 128);
    float cs[8], sn[8];
#pragma unroll
    for (int j = 0; j < 8; ++j) { const float2 t2 = *(const float2*)(tab + 2 * (pos * 32 + f0 + j)); cs[j] = lat ? t2.x : 1.f; sn[j] = lat ? t2.y : 0.f; }
#pragma unroll
    for (int hd = 0; hd < 10; ++hd) {
      float v[8]; float ss = 0.f;
#pragma unroll
      for (int j = 0; j < 8; ++j) { v[j] = bf2f((bf16_t)x[hd][j]); ss += v[j] * v[j]; }
      ss += __shfl_xor(ss, 1); ss += __shfl_xor(ss, 2); ss += __shfl_xor(ss, 4); ss += __shfl_xor(ss, 8);
      const float rs = rsqrtf(ss * (1.f / 128.f) + EPSF);
      float ov[8];
#pragma unroll
      for (int j = 0; j < 8; ++j) { v[j] = v[j] * rs * (hd < 8 ? qn[j] : kn[j]); const float pr = __shfl_xor(v[j], 4);
        ov[j] = (l16 & 4) ? (pr * sn[j] + v[j] * cs[j]) : (v[j] * cs[j] - pr * sn[j]); }
      *(u32x4*)(base + hd * 128) = (u32x4){cvtpk(ov[0], ov[1]), cvtpk(ov[2], ov[3]), cvtpk(ov[4], ov[5]), cvtpk(ov[6], ov[7])};
    }
  }
}

namespace at {
constexpr int D = 128, NW = 8, QBLK = 32, KVBLK = 64;
constexpr float SCALE = 0.088388347648318440f, THR = 8.f;
constexpr int LDQ = 1536, LDK = 1536, LDO = 1024;
constexpr size_t SHM_V = KVBLK * D * 2, SHM_K = KVBLK * D * 2;
#define KSWZ(row, colB) ((row) * 256 + ((colB) ^ (((row) & 7) << 4)))
#define SBAR() __builtin_amdgcn_sched_barrier(0)
DI void partialSM(f32x16& p0, f32x16& p1, float& m_reg, float& mn, float& alpha) {
  constexpr float C = SCALE * 1.4426950408889634f;
  float pmax = p0[0]; for (int r = 1; r < 16; ++r) pmax = fmaxf(pmax, p0[r]); for (int r = 0; r < 16; ++r) pmax = fmaxf(pmax, p1[r]);
  { auto rr = __builtin_amdgcn_permlane32_swap(__float_as_uint(pmax), __float_as_uint(pmax), false, false);
    pmax = fmaxf(__uint_as_float(rr[0]), __uint_as_float(rr[1])); }
  if (__builtin_expect(__all(pmax - m_reg <= THR / SCALE), 1)) { mn = m_reg; alpha = 1.f; }
  else { mn = fmaxf(m_reg, pmax); alpha = __builtin_amdgcn_exp2f((m_reg - mn) * C); m_reg = mn; }
  float mnC = -mn * C;
  for (int r = 0; r < 16; ++r) p0[r] = fmaf(p0[r], C, mnC); for (int r = 0; r < 16; ++r) p1[r] = fmaf(p1[r], C, mnC);
  for (int r = 0; r < 16; ++r) p0[r] = __builtin_amdgcn_exp2f(p0[r]);
}
DI void finishSM(f32x16& p0, f32x16& p1, float alpha, float& l_reg, bf16x8& pa0, bf16x8& pa1, bf16x8& pa2, bf16x8& pa3) {
  for (int r = 0; r < 16; ++r) p1[r] = __builtin_amdgcn_exp2f(p1[r]);
  float ps = 0; for (int r = 0; r < 16; ++r) ps += p0[r]; for (int r = 0; r < 16; ++r) ps += p1[r];
  { auto rr = __builtin_amdgcn_permlane32_swap(__float_as_uint(ps), __float_as_uint(ps), false, false);
    ps = __uint_as_float(rr[0]) + __uint_as_float(rr[1]); }
  l_reg = l_reg * alpha + ps;
#define PK4(PP, BASE, OUT) do { unsigned a0 = cvtpk(PP[BASE + 0], PP[BASE + 1]), a1 = cvtpk(PP[BASE + 2], PP[BASE + 3]);   \
    unsigned b0 = cvtpk(PP[BASE + 4], PP[BASE + 5]), b1 = cvtpk(PP[BASE + 6], PP[BASE + 7]);                              \
    auto r0 = __builtin_amdgcn_permlane32_swap(a0, b0, false, false); auto r1 = __builtin_amdgcn_permlane32_swap(a1, b1, false, false); \
    u32x4 w = {r0[0], r1[0], r0[1], r1[1]}; OUT = *reinterpret_cast<bf16x8*>(&w); } while (0)
  PK4(p0, 0, pa0); PK4(p0, 8, pa1); PK4(p1, 0, pa2); PK4(p1, 8, pa3);
#undef PK4
}
DI void qkt(f32x16& p0, f32x16& p1, const bf16_t* Ks, const bf16x8* qr, int r32, int hi) {
  p0 = f32x16{}; p1 = f32x16{};
  for (int d0 = 0; d0 < 8; ++d0) { int cb = (d0 * 16 + hi * 8) * 2;
    bf16x8 b0 = *reinterpret_cast<const bf16x8*>((const char*)Ks + KSWZ(r32, cb));
    bf16x8 b1 = *reinterpret_cast<const bf16x8*>((const char*)Ks + KSWZ(32 + r32, cb));
    p0 = MFMA32(b0, qr[d0], p0);
    p1 = MFMA32(b1, qr[d0], p1); }
}
DI int v_st(int k, int c) { const int kk = (k & ~0xC) | ((k & 4) << 1) | ((k & 8) >> 1); return ((kk >> 3) * 4 + (c >> 5)) * 512 + ((kk & 7) * 32 + (c & 31)) * 2; }
DI int v_rd_base(int lane) { return ((lane & 3) << 3) | (((lane >> 2) & 3) << 6) | (((lane >> 4) & 1) << 5) | (((lane >> 5) & 1) << 8); }
constexpr int v_rd_off(int d0, int ks, int half) { return d0 * 512 + ks * 4096 + half * 2048; }
template <int OFF> DI s16x4 tr_read(int vb) {
  s16x4 r; asm volatile("ds_read_b64_tr_b16 %0, %1 offset:%2" : "=&v"(r) : "v"(vb), "i"(OFF) : "memory"); return r;
}
template <int D0> DI void pv_one(f32x16& od, int vb, bf16x8 pa0, bf16x8 pa1, bf16x8 pa2, bf16x8 pa3) {
  const s16x4 l0 = tr_read<v_rd_off(D0, 0, 0)>(vb), h0 = tr_read<v_rd_off(D0, 0, 1)>(vb), l1 = tr_read<v_rd_off(D0, 1, 0)>(vb), h1 = tr_read<v_rd_off(D0, 1, 1)>(vb);
  const s16x4 l2 = tr_read<v_rd_off(D0, 2, 0)>(vb), h2 = tr_read<v_rd_off(D0, 2, 1)>(vb), l3 = tr_read<v_rd_off(D0, 3, 0)>(vb), h3 = tr_read<v_rd_off(D0, 3, 1)>(vb);
  asm volatile("s_waitcnt lgkmcnt(0)" ::: "memory"); SBAR();
#define PK(Lx, Hx) (bf16x8){Lx[0], Lx[1], Lx[2], Lx[3], Hx[0], Hx[1], Hx[2], Hx[3]}
  od = MFMA32(pa0, PK(l0, h0), od);
  od = MFMA32(pa1, PK(l1, h1), od);
  od = MFMA32(pa2, PK(l2, h2), od);
  od = MFMA32(pa3, PK(l3, h3), od);
#undef PK
}
DI void pv_d0(f32x16* o, int vb, bf16x8 pa0, bf16x8 pa1, bf16x8 pa2, bf16x8 pa3) {
  pv_one<0>(o[0], vb, pa0, pa1, pa2, pa3); pv_one<1>(o[1], vb, pa0, pa1, pa2, pa3); pv_one<2>(o[2], vb, pa0, pa1, pa2, pa3); pv_one<3>(o[3], vb, pa0, pa1, pa2, pa3);
}
DI void attn_dense_body(const bf16_t* __restrict__ Qb, const bf16_t* __restrict__ Kh, const bf16_t* __restrict__ Vh, bf16_t* __restrict__ Ob, int seq, char* lds) {
  const int tid = TIDX(), wid = tid >> 6, lane = tid & 63, r32 = lane & 31, hi = lane >> 5;
  bf16_t* V_lds = (bf16_t*)lds; bf16_t* K_lds = (bf16_t*)(lds + 2 * SHM_V);
  float* ws = (float*)(lds + 2 * SHM_V + 2 * SHM_K) + wid * 64; float* li_l = ws; float* al_l = ws + 32;
  float m_reg = -1e30f, l_reg = 0; f32x16 o[4] = {}; bf16x8 qr[8];
  const bf16_t* Qw = Qb + (long)(wid * QBLK + r32) * LDQ + hi * 8;
#pragma unroll
  for (int d0 = 0; d0 < 8; ++d0) qr[d0] = *reinterpret_cast<const bf16x8*>(Qw + d0 * 16);
  const int sr = tid >> 4, sc = (tid & 15) * 8, vst0 = v_st(sr, sc), vst1 = v_st(32 + sr, sc);
  const int vb0 = (int)(uintptr_t)V_lds + v_rd_base(lane);
  struct { bf16x8 vs0, vs1, ks0, ks1; } sr_[2];
#define SLOAD(i, k0) do { sr_[i].vs0 = *(const bf16x8*)(&Vh[(long)((k0) + sr) * LDK + sc]); sr_[i].vs1 = *(const bf16x8*)(&Vh[(long)((k0) + 32 + sr) * LDK + sc]); \
    sr_[i].ks0 = *(const bf16x8*)(&Kh[(long)((k0) + sr) * LDK + sc]); sr_[i].ks1 = *(const bf16x8*)(&Kh[(long)((k0) + 32 + sr) * LDK + sc]); } while (0)
#define SWRITE(bq, i) do { *(bf16x8*)((char*)V_lds + (bq) * SHM_V + vst0) = sr_[i].vs0;          \
    *(bf16x8*)((char*)V_lds + (bq) * SHM_V + vst1) = sr_[i].vs1; int kc = sc * 2;               \
    *(bf16x8*)((char*)K_lds + (bq) * SHM_K + KSWZ(sr, kc)) = sr_[i].ks0;                       \
    *(bf16x8*)((char*)K_lds + (bq) * SHM_K + KSWZ(32 + sr, kc)) = sr_[i].ks1; } while (0)
#define SWAIT() asm volatile("s_waitcnt vmcnt(4)" ::: "memory")
#define RESC(a) do { if (__any((a) < 1.f)) { if (hi == 0) al_l[r32] = (a); asm volatile("s_waitcnt lgkmcnt(0)" ::: "memory"); \
    for (int d = 0; d < 4; ++d) for (int r = 0; r < 16; ++r) o[d][r] *= al_l[crow(r, hi)]; } } while (0)
  f32x16 pA0, pA1, pB0, pB1; float mnA, mnB, alA, alB; bf16x8 pa0, pa1, pa2, pa3; const int NT = seq / KVBLK;
  constexpr int SE = 0, SO = 1;
  SLOAD(SE, 0); asm volatile("s_waitcnt vmcnt(0)" ::: "memory"); SWRITE(0, SE); __syncthreads();
  qkt(pA0, pA1, K_lds, qr, r32, hi); partialSM(pA0, pA1, m_reg, mnA, alA);
  SLOAD(SO, KVBLK); if (2 < NT) SLOAD(SE, 2 * KVBLK);
  SWAIT(); SWRITE(1, SO); __syncthreads();
  for (int j = 1; j + 1 < NT; j += 2) {
    SBAR(); qkt(pB0, pB1, (bf16_t*)((char*)K_lds + SHM_K), qr, r32, hi);
    finishSM(pA0, pA1, alA, l_reg, pa0, pa1, pa2, pa3); SBAR();
    SLOAD(SO, (j + 2) * KVBLK); SBAR();
    pv_d0(o, vb0, pa0, pa1, pa2, pa3); partialSM(pB0, pB1, m_reg, mnB, alB);
    __syncthreads(); SWAIT(); SWRITE(0, SE);
    RESC(alB); __syncthreads();
    SBAR(); qkt(pA0, pA1, K_lds, qr, r32, hi);
    finishSM(pB0, pB1, alB, l_reg, pa0, pa1, pa2, pa3); SBAR();
    if (j + 3 < NT) SLOAD(SE, (j + 3) * KVBLK); SBAR();
    pv_d0(o, vb0 + (int)SHM_V, pa0, pa1, pa2, pa3); partialSM(pA0, pA1, m_reg, mnA, alA);
    __syncthreads(); SWAIT(); SWRITE(1, SO);
    RESC(alA); __syncthreads();
  }
  SBAR(); qkt(pB0, pB1, (bf16_t*)((char*)K_lds + SHM_K), qr, r32, hi);
  finishSM(pA0, pA1, alA, l_reg, pa0, pa1, pa2, pa3); SBAR();
  pv_d0(o, vb0, pa0, pa1, pa2, pa3); partialSM(pB0, pB1, m_reg, mnB, alB);
  __syncthreads(); RESC(alB);
  finishSM(pB0, pB1, alB, l_reg, pa0, pa1, pa2, pa3); SBAR();
  pv_d0(o, vb0 + (int)SHM_V, pa0, pa1, pa2, pa3);
  if (hi == 0) li_l[r32] = l_reg; asm volatile("s_waitcnt lgkmcnt(0)" ::: "memory");
  float rli[16];
#pragma unroll
  for (int r = 0; r < 16; ++r) rli[r] = __builtin_amdgcn_rcpf(li_l[crow(r, hi)]);
  bf16_t* Ow = Ob + (long)(wid * QBLK) * LDO;
#pragma unroll
  for (int r = 0; r < 16; ++r) { int orow = crow(r, hi);
    for (int d0 = 0; d0 < 4; ++d0) Ow[(long)orow * LDO + d0 * 32 + r32] = f2bf(o[d0][r] * rli[r]); }
#undef SLOAD
#undef SWRITE
#undef SWAIT
#undef RESC
}
}

__device__ __forceinline__ void ph_attn(const P& p, char* lds, bool need_ctx) {
  const bf16_t* QKV = (const bf16_t*)(p.ws + OFF_D); bf16_t* hb = (bf16_t*)(p.ws + OFF_HBF);
  const int nunits = need_ctx ? 528 : 512;
  for (int u = BIDX(); u < nunits; u += GDIM()) {
    int b, h, seq; size_t qrow;
    if (u < 512) { b = u >> 8; const int rem = u & 255; h = rem >> 5; qrow = (size_t)b * TB + CTXL + (size_t)(rem & 31) * 256; seq = TB; }
    else { const int uu = u - 512; b = uu >> 3; h = uu & 7; qrow = (size_t)b * TB; seq = CTXL; }
    const int kvh = h >> 2;
    const bf16_t* Kh = QKV + (size_t)b * TB * 1536 + 1024 + kvh * 128;
    const bf16_t* Vh = QKV + (size_t)b * TB * 1536 + 1280 + kvh * 128;
    at::attn_dense_body(QKV + qrow * 1536 + h * 128, Kh, Vh, hb + qrow * 1024 + h * 128, seq, lds);
    __syncthreads();
  }
}

__device__ __forceinline__ void ph_final(const P& p) {
  const int tid = TIDX(), wid = tid >> 6, lane = tid & 63;
  const float* xr = (const float*)(p.ws + OFF_XRES);
  for (int q = BIDX() * 8 + wid; q < 2 * LAT; q += GDIM() * 8) {
    const int b = q >> 13, t = q & (LAT - 1); const float* row = xr + ((size_t)b * TB + CTXL + t) * 1024;
    f32x4 v[4]; float ss = 0.f;
#pragma unroll
    for (int i = 0; i < 4; ++i) { v[i] = *(const f32x4*)(row + i * 256 + lane * 4); ss += v[i][0] * v[i][0] + v[i][1] * v[i][1] + v[i][2] * v[i][2] + v[i][3] * v[i][3]; }
    ss = wave_sum(ss); const float rs = rsqrtf(ss * (1.f / 1024.f) + EPSF);
#pragma unroll
    for (int i = 0; i < 4; ++i) { const int c0 = i * 256 + lane * 4; const f32x4 g = *(const f32x4*)(p.final_norm + c0); f32x4 o = v[i] * rs * g; *(f32x4*)(p.out + (size_t)q * 1024 + c0) = o; }
  }
}

#ifndef ONLY_PH
#define ONLY_PH -1
#endif
#define EN(x) (ONLY_PH < 0 || ONLY_PH == (x))
#ifndef PROBE_REP
#define PROBE_REP -1
#endif
#define RUN(cls, ...) do { if (EN(cls)) { for (int rep_ = 0; rep_ < ((PROBE_REP == (cls)) ? 2 : 1); ++rep_) { if (rep_) xcd_barrier(*xbp); __VA_ARGS__; } } } while (0)
enum { OP_INIT, OP_N1FULL, OP_IN, OP_PREP, OP_D1, OP_SCAN, OP_MERGE, OP_OUTLAT, OP_OUTCTX_N2LAT, OP_N2CTX, OP_UP, OP_ACT, OP_DOWNLAT, OP_DOWNCTX_N1LAT, OP_N1CTX,
       OP_QKV, OP_QKNORM, OP_ATTN, OP_N2FULL, OP_FINAL };
constexpr int NPHASES = 48;
__device__ __forceinline__ void decode_phase(int ph, int& op, int& L) {
  if (ph == 0) { op = OP_INIT; L = 0; return; }
  if (ph == NPHASES - 1) { op = OP_FINAL; L = 3; return; }
  int q = ph - 1;
  if (q < 14) { L = 0; if (q == 0) { op = OP_N1FULL; return; } q -= 1; }
  else if (q < 25) { L = 1; q -= 14; }
  else if (q < 38) { L = 2; q -= 25; }
  else { L = 3; q -= 38; }
  if ((L & 1) == 0) {
    if (q < 5) { op = OP_IN + q; return; }
    q -= 5;
  } else {
    if (q < 3) { op = OP_QKV + q; return; }
    q -= 3;
  }
  if (L < 3) { const int t[8] = {OP_OUTLAT, OP_OUTCTX_N2LAT, OP_N2CTX, OP_UP, OP_ACT, OP_DOWNLAT, OP_DOWNCTX_N1LAT, OP_N1CTX}; op = t[q]; }
  else { const int t[5] = {OP_OUTLAT, OP_N2FULL, OP_UP, OP_ACT, OP_DOWNLAT}; op = t[q]; }
}
__device__ __forceinline__ void run_phase(const P& p0, int ph, char* lds, const XcdBarrier* xbp) {
  P p = p0; { typedef __attribute__((address_space(1))) char gchar_t; size_t wi = (size_t)p0.ws; asm volatile("" : "+s"(wi)); p.ws = (char*)(gchar_t*)wi; }
  int op, L; decode_phase(ph, op, L);
  const int e = L >> 1, o = L >> 1;
  bf16_t* W1 = (bf16_t*)(p.ws + OFF_WC); bf16_t* W2 = (bf16_t*)(p.ws + OFF_WC + WC_W2); bf16_t* W3 = (bf16_t*)(p.ws + OFF_W3);
  bf16_t* hb = (bf16_t*)(p.ws + OFF_HBF); float* xr = (float*)(p.ws + OFF_XRES);
  const float* mods = (const float*)(p.ws + OFF_MODS) + (size_t)L * 3 * 6144;
  float* PART = (float*)(p.ws + OFF_D + D_END_F);
#define CVT_MIX(LL, skipb) do { const int L_ = (LL); if ((L_ & 1) == 0) { cvt_weight(p.rec_w_in + (size_t)(L_ >> 1) * 1024 * 3632, W1, 1024, 3632, NREC, true, skipb); cvt_weight(p.rec_w_out + (size_t)(L_ >> 1) * 1024 * 1024, W3, 1024, 1024, 1024, false, skipb); } \
    else { cvt_weight(p.att_w_qkv + (size_t)(L_ >> 1) * 1024 * 1536, W1, 1024, 1536, 1536, false, skipb); cvt_weight(p.att_w_out + (size_t)(L_ >> 1) * 1024 * 1024, W3, 1024, 1024, 1024, false, skipb); } } while (0)
#define CVT_FFN(LL, skipb) do { const int L_ = (LL); cvt_weight(p.ffn_w_up + (size_t)L_ * 1024 * 5632, W1, 1024, 5632, 5632, false, skipb); cvt_weight(p.ffn_w_down + (size_t)L_ * DFF * 1024, W2, DFF, 1024, 1024, false, skipb); } while (0)
  switch (op) {
    case OP_INIT: RUN(0, ph_init(p, lds); CVT_MIX(0, 0)); break;
    case OP_N1FULL: RUN(1, ph_norm(p, L, 0, 0, 0)); break;
    case OP_IN: RUN(2, gemm8(lds, hb, 1024, W1, 1024, NREC, 0, EpiRec8{(bf16_t*)(p.ws + OFF_D + D_P1), (bf16_t*)(p.ws + OFF_D + D_P2), (float*)(p.ws + OFF_SM)})); break;
    case OP_PREP: RUN(3, ph_dnprep(p, lds, e)); break;
    case OP_D1: RUN(4, ph_dn_d1(p, lds); ph_gla_b(p, lds, e)); break;
    case OP_SCAN: RUN(5, if (BIDX() < 64) { dn_scan(p, lds, BIDX()); } else if (BIDX() < 128) { gla_scan(p, lds, BIDX() - 64, e); });
        if (PROBE_REP == 55) { xcd_barrier(*xbp); if (BIDX() < 64) { dn_scan(p, lds, BIDX()); } }
        if (PROBE_REP == 56) { xcd_barrier(*xbp); if (BIDX() >= 64 && BIDX() < 128) { gla_scan(p, lds, BIDX() - 64, e); } }
        break;
    case OP_MERGE: RUN(7, ph_merge(p, e)); break;
    case OP_QKV: RUN(2, gemm8(lds, hb, 1024, W1, 1024, 1536, 0, EpiBf8{(bf16_t*)(p.ws + OFF_D), 1536})); break;
    case OP_QKNORM: if (EN(9)) ph_qknorm(p, lds, o); break;
    case OP_ATTN: RUN(10, ph_attn(p, lds, L != 3)); break;
    case OP_OUTLAT: if (EN(2)) { gemm8(lds, hb, 1024, W3, 1024, 1024, 1, EpiRes8{xr, mods + 2 * 1024}); if (L == 3) CVT_FFN(L, 0); } break;
    case OP_OUTCTX_N2LAT: if (EN(2)) { if (BIDX() < 128) gemm_ctx_split(lds, hb, 1024, W3, 1024, 128, PART); ph_norm(p, L, 1, 1, 0); CVT_FFN(L, 0); } break;
    case OP_N2CTX: if (EN(1)) ph_ctx_fold_norm(p, L, 1, PART, 8, mods + 2 * 1024); break;
    case OP_N2FULL: if (EN(1)) ph_norm(p, L, 1, 0, 0); break;
    case OP_UP: RUN(2, gemm8(lds, hb, 1024, W1, 1024, 5632, L == 3 ? 1 : 0, EpiBf8{(bf16_t*)(p.ws + OFF_D), 5632})); break;
    case OP_ACT: if (EN(8)) ph_ffnact(p, L); break;
    case OP_DOWNLAT: if (EN(2)) gemm8(lds, (const bf16_t*)(p.ws + OFF_D) + DFF, 5632, W2, DFF, 1024, 1, EpiRes8{xr, mods + 5 * 1024}); break;
    case OP_DOWNCTX_N1LAT: if (EN(2)) { if (BIDX() < 176) gemm_ctx_split(lds, (const bf16_t*)(p.ws + OFF_D) + DFF, 5632, W2, DFF, 256, PART); ph_norm(p, L + 1, 0, 1, 0); CVT_MIX(L + 1, 0); } break;
    case OP_N1CTX: if (EN(1)) ph_ctx_fold_norm(p, L + 1, 0, PART, 11, mods + 5 * 1024); break;
    case OP_FINAL: if (EN(11)) ph_final(p); break;
  }
#undef CVT_MIX
#undef CVT_FFN
}

template <bool COOP>
__global__ void __launch_bounds__(512, 1) mk_kernel(P p, int ph0, int ph1) {
  extern __shared__ __attribute__((aligned(16))) char smem[];
  if constexpr (COOP) {
    if (ph0 < 0) cg::this_grid().sync();
    volatile LAS unsigned* st = (volatile LAS unsigned*)(smem + LDS_BYTES);
    if (threadIdx.x < 4) st[threadIdx.x] = 0u;
    __syncthreads();
    XcdBarrier xb = xcd_barrier_post((unsigned*)(p.ws + OFF_BAR), st);
    for (int ph = ph0; ph < ph1; ++ph) {
      run_phase(p, ph, smem, &xb);
      if (ph + 1 < ph1) xcd_barrier(xb);
      if (PROBE_REP == 99 && ph == 0) { for (int q = 0; q < 20; ++q) xcd_barrier(xb); }
    }
  } else {
    for (int ph = ph0; ph < ph1; ++ph) run_phase(p, ph, smem, nullptr);
  }
}

extern "C" void kernel_launch(void* const* d_in, const int* in_sizes, int n_in, void* d_out, int out_size, void* d_ws, size_t ws_size, hipStream_t stream) {
  if (n_in != 23 || ws_size < WS_NEED) { fprintf(stderr, "kernel_launch: bad n_in %d or ws %zu < %zu\n", n_in, ws_size, (size_t)WS_NEED); return; }
  P p{};
  const float** f = (const float**)&p;
  for (int i = 0; i < 23; ++i) f[i] = (const float*)d_in[i];
  p.out = (float*)d_out; p.ws = (char*)d_ws;
  static int inited = 0, grid_blocks = 0;
  if (!inited) {
    hipFuncSetAttribute((const void*)mk_kernel<true>, hipFuncAttributeMaxDynamicSharedMemorySize, LDS_BYTES + 16);
#if !MK_COOP
    hipFuncSetAttribute((const void*)mk_kernel<false>, hipFuncAttributeMaxDynamicSharedMemorySize, LDS_BYTES);
#endif
    int dev = 0, cus = 0, per_cu = 0;
    hipGetDevice(&dev); hipDeviceGetAttribute(&cus, hipDeviceAttributeMultiprocessorCount, dev);
    hipOccupancyMaxActiveBlocksPerMultiprocessor(&per_cu, mk_kernel<true>, 512, LDS_BYTES + 16);
    if (per_cu > 1) per_cu = 1;
    grid_blocks = cus * per_cu; if (grid_blocks > 256) grid_blocks = 256; if (grid_blocks < 128) grid_blocks = 128;
    inited = 1;
  }
#if MK_COOP
  int ph0 = 0, ph1 = NPHASES;
  void* args[] = {&p, &ph0, &ph1};
  hipMemsetAsync((char*)d_ws + OFF_BAR, 0, 3456 * 4, stream);
  hipError_t er = hipLaunchCooperativeKernel((const void*)mk_kernel<true>, dim3(grid_blocks), dim3(512), args, LDS_BYTES + 16, stream);
  if (er != hipSuccess) fprintf(stderr, "cooperative launch failed: %s (grid %d)\n", hipGetErrorString(er), grid_blocks);
#else
  for (int ph = 0; ph < NPHASES; ++ph) hipLaunchKernelGGL(mk_kernel<false>, dim3(256), dim3(512), LDS_BYTES, stream, p, ph, ph + 1);
#endif
}
```

```cpp
#include <hip/hip_runtime.h>
#include <hip/hip_cooperative_groups.h>
#include <cstdio>
#include <cstdint>
namespace cg = cooperative_groups;

#ifndef MK_COOP
#define MK_COOP 1
#endif

typedef unsigned short bf16_t;
typedef short bf16x8 __attribute__((ext_vector_type(8)));
typedef short s16x4 __attribute__((ext_vector_type(4)));
typedef float f32x16 __attribute__((ext_vector_type(16)));
typedef float f32x8 __attribute__((ext_vector_type(8)));
typedef float f32x4 __attribute__((ext_vector_type(4)));
typedef unsigned u32x4 __attribute__((ext_vector_type(4)));
#define DI __device__ __forceinline__
#define LBAR() do { asm volatile("s_waitcnt lgkmcnt(0)" ::: "memory"); __builtin_amdgcn_s_barrier(); asm volatile("" ::: "memory"); } while (0)
#define MFMA32(a, b, c) __builtin_amdgcn_mfma_f32_32x32x16_bf16((a), (b), (c), 0, 0, 0)

constexpr int DM = 1024, TB = 8448, CTXL = 256, LAT = 8192, MROWS = 2 * TB;
constexpr int NCH = 132;
constexpr int DFF = 2816;
constexpr int NREC = 3840;
constexpr float EPSF = 1e-6f;

constexpr size_t AL(size_t x) { return (x + 255) / 256 * 256; }
constexpr size_t OFF_XRES = 0;
constexpr size_t OFF_HBF = OFF_XRES + AL((size_t)MROWS * DM * 4);
constexpr size_t OFF_WC = OFF_HBF + AL((size_t)MROWS * DM * 2);
constexpr size_t WC_W2 = (size_t)5632 * 1024 * 2;
constexpr size_t OFF_MODS = OFF_WC + AL(WC_W2 + (size_t)1024 * 2816 * 2);
constexpr size_t OFF_SM = OFF_MODS + AL((size_t)4 * 3 * 6144 * 4);
constexpr size_t OFF_GB = OFF_SM + AL((size_t)MROWS * 64 * 4);
constexpr size_t OFF_SC = OFF_GB + AL((size_t)MROWS * 16 * 4);
constexpr size_t OFF_GL = OFF_SC + AL((size_t)16 * NCH * 64 * 2 * 4);
constexpr size_t OFF_D = OFF_GL + AL((size_t)16 * NCH * 4);
constexpr size_t D_P1 = 0;
constexpr size_t D_W = 0;
constexpr size_t D_INTRA = D_W + (size_t)16 * NCH * 64 * 128 * 2;
constexpr size_t D_P2 = D_P1 + (size_t)MROWS * 1536 * 2;
constexpr size_t D_QQ = D_P2 + (size_t)MROWS * 2048 * 2;
constexpr size_t D_QK = D_QQ + (size_t)MROWS * 512 * 2;
constexpr size_t D_QV = D_QK + (size_t)MROWS * 512 * 2;
constexpr size_t D_DNO = D_QK;
constexpr size_t D_KT = D_QV + (size_t)MROWS * 512 * 2;
constexpr size_t D_GLAO = D_KT + (size_t)MROWS * 512 * 2;
constexpr size_t D_END_E = D_GLAO + (size_t)2 * MROWS * 512 * 2;
constexpr size_t D_END_F = (size_t)MROWS * 5632 * 2;
constexpr size_t OFF_B16_1 = OFF_D + (D_END_E > D_END_F ? D_END_E : D_END_F);
constexpr size_t B16_BYTES = (size_t)8 * NCH * 64 * 64 * 2;
constexpr size_t OFF_BAR = OFF_B16_1 + AL(B16_BYTES);
constexpr size_t OFF_W3 = OFF_BAR + AL(3456 * 4);
constexpr size_t WS_NEED = OFF_W3 + (size_t)1024 * 1024 * 2;
constexpr int LDS_BYTES = 132 * 1024;

struct P {
  const float *x, *c, *ctx, *c_ctx, *mod_w, *mod_b, *rec_w_in, *rec_conv, *dn_a_log, *dn_dt_bias, *dn_norm, *gla_w2, *gla_b2, *gla_norm,
      *rec_w_out, *att_w_qkv, *att_q_norm, *att_k_norm, *att_w_out, *ffn_w_up, *ffn_conv, *ffn_w_down, *final_norm;
  float* out;
  char* ws;
};

DI int TIDX() { int t = threadIdx.x; asm volatile("" : "+v"(t)); return t; }
DI int BIDX() { int t = blockIdx.x; asm volatile("" : "+s"(t)); return t; }
DI int GDIM() { int t = gridDim.x; asm volatile("" : "+s"(t)); return t; }
DI float bf2f(bf16_t v) { return __uint_as_float(((unsigned)v) << 16); }
DI bf16_t f2bf(float x) { unsigned u = __float_as_uint(x); u += 0x7fffu + ((u >> 16) & 1u); return (bf16_t)(u >> 16); }
typedef __bf16 bf16n2 __attribute__((ext_vector_type(2)));
DI unsigned cvtpk(float lo, float hi) { const bf16n2 v = {(__bf16)lo, (__bf16)hi}; return __builtin_bit_cast(unsigned, v); }
DI int crow(int r, int hi) { return (r & 3) + 8 * (r >> 2) + 4 * hi; }
DI float siluf(float x) { return x / (1.f + expf(-x)); }
DI float sigmf(float x) { return 1.f / (1.f + expf(-x)); }
DI float softplusf(float x) { return fmaxf(x, 0.f) + log1pf(expf(-fabsf(x))); }
DI float wave_sum(float v) {
#pragma unroll
  for (int o = 32; o > 0; o >>= 1) v += __shfl_xor(v, o);
  return v;
}
DI int modrow_of(int R) { const int b = R >= TB ? 1 : 0; const int pp = R - b * TB; return pp < CTXL ? 2 : b; }
template <int KS>
DI f32x16 mma_rows(const bf16_t* arow, const bf16_t* brow, f32x16 acc) {
#pragma unroll
  for (int ks = 0; ks < KS; ++ks) {
    const bf16x8 a = *reinterpret_cast<const bf16x8*>(arow + ks * 16);
    const bf16x8 b = *reinterpret_cast<const bf16x8*>(brow + ks * 16);
    acc = MFMA32(a, b, acc);
  }
  return acc;
}

#define XB_TMO      128
#define XB_XCNT(j)  (256  + 64 * (j))
#define XB_XSUB(j)  (1280 + 64 * (j))
#define XB_XGEN(j)  (2304 + 64 * (j))
#define XB_TOP      3328
#define XB_TOPGEN   3392
#define XCD_BAR_WORDS 3456
#define XB_SPIN_CAP (1u << 18)
#define LAS __attribute__((address_space(3)))
DI unsigned xb_ld(unsigned* p)              { return __hip_atomic_load(p, __ATOMIC_RELAXED, __HIP_MEMORY_SCOPE_AGENT); }
DI unsigned xb_add(unsigned* p, unsigned v) { return __hip_atomic_fetch_add(p, v, __ATOMIC_RELAXED, __HIP_MEMORY_SCOPE_AGENT); }
DI unsigned xb_xcc_id() { return (unsigned)__builtin_amdgcn_s_getreg((3 << 11) | 20) & 0xFu; }
#define XB_SPIN(cond, bar) do { unsigned _sp = 0; while (cond) { __builtin_amdgcn_s_sleep(1); \
    if ((++_sp & 255u) == 0u) { if (xb_ld(&(bar)[XB_TMO])) break; if (_sp > XB_SPIN_CAP) { atomicAdd(&(bar)[XB_TMO], 1u); break; } } } } while (0)
struct XcdBarrier { unsigned* bar; unsigned x; volatile LAS unsigned* st; };
DI XcdBarrier xcd_barrier_post(unsigned* bar, volatile LAS unsigned* st) {
    XcdBarrier b; b.bar = bar; b.x = xb_xcc_id(); b.st = st;
    if (threadIdx.x == 0) (void)xb_add(&bar[XB_XCNT(b.x)], 1u);
    return b;
}
DI void xcd_barrier_complete(unsigned* bar, unsigned x, unsigned& nloc, unsigned& nx) {
    const unsigned G = gridDim.x * gridDim.y * gridDim.z;
    unsigned sum, cnt, mine, sp = 0u;
    for (;;) {
        sum = 0u; cnt = 0u; mine = 0u;
#pragma unroll
        for (unsigned j = 0; j < 16; ++j) { const unsigned c = xb_ld(&bar[XB_XCNT(j)]); sum += c; cnt += (c > 0u) ? 1u : 0u; mine = (j == x) ? c : mine; }
        if (sum == G) break;
        __builtin_amdgcn_s_sleep(1);
        if ((++sp & 255u) == 0u) { if (xb_ld(&bar[XB_TMO])) break; if (sp > XB_SPIN_CAP) { atomicAdd(&bar[XB_TMO], 1u); break; } }
    }
    nloc = mine > 0u ? mine : 1u; nx = cnt > 0u ? cnt : 1u;
}
DI void xcd_barrier(const XcdBarrier& b) {
    asm volatile("s_waitcnt vmcnt(0)" ::: "memory");
    __syncthreads();
    if (threadIdx.x == 0) {
        unsigned* bar = b.bar;
        __builtin_amdgcn_s_waitcnt(0);
        unsigned nloc = b.st[0], nx = b.st[1];
        if (nloc == 0u) { xcd_barrier_complete(bar, b.x, nloc, nx); b.st[0] = nloc; b.st[1] = nx; }
        const unsigned old = xb_add(&bar[XB_XSUB(b.x)], 1u);
        const unsigned gen = old / nloc;
        if (old + 1u == (gen + 1u) * nloc) {
            __builtin_amdgcn_fence(__ATOMIC_RELEASE, "agent");
            asm volatile("s_waitcnt vmcnt(0)" ::: "memory");
            const unsigned og = xb_add(&bar[XB_TOP], 1u);
            const unsigned tg = og / nx;
            if (og + 1u == (tg + 1u) * nx) xb_add(&bar[XB_TOPGEN], 1u);
            else XB_SPIN(xb_ld(&bar[XB_TOPGEN]) == tg, bar);
            __builtin_amdgcn_fence(__ATOMIC_ACQUIRE, "agent");
            xb_add(&bar[XB_XGEN(b.x)], 1u);
            asm volatile("s_waitcnt vmcnt(0)" ::: "memory");
        } else {
            XB_SPIN(xb_ld(&bar[XB_XGEN(b.x)]) == gen, bar);
            __builtin_amdgcn_fence(__ATOMIC_ACQUIRE, "agent");
            asm volatile("s_waitcnt vmcnt(0)" ::: "memory");
        }
    }
    __syncthreads();
}

__device__ __forceinline__ void ph_init(const P& p, char* lds) {
  const int tid = TIDX();
  float* sc = (float*)lds;
  float* red = sc + 3072;
  for (int i = tid; i < 3072; i += 512) { const int r = i >> 10, k = i & 1023; const float v = r < 2 ? p.c[r * 1024 + k] : p.c_ctx[k]; sc[i] = siluf(v); }
  __syncthreads();
  float* mods = (float*)(p.ws + OFF_MODS);
  for (int job = BIDX(); job < 192; job += GDIM()) {
    const int col = job * 128 + (tid & 127), kq = tid >> 7;
    const int L = col / 6144, cl = col - L * 6144;
    const float* w = p.mod_w + ((size_t)L * 1024 + kq * 256) * 6144 + cl;
    float a0 = 0.f, a1 = 0.f, a2 = 0.f;
#pragma unroll 8
    for (int k = 0; k < 256; ++k) { const float wv = w[(size_t)k * 6144]; const int kk = kq * 256 + k; a0 += sc[kk] * wv; a1 += sc[1024 + kk] * wv; a2 += sc[2048 + kk] * wv; }
    red[(kq * 3 + 0) * 128 + (tid & 127)] = a0; red[(kq * 3 + 1) * 128 + (tid & 127)] = a1; red[(kq * 3 + 2) * 128 + (tid & 127)] = a2;
    __syncthreads();
    if (tid < 384) { const int r = tid >> 7, cc = tid & 127; const int c2 = job * 128 + cc; const int L2 = c2 / 6144, cl2 = c2 - L2 * 6144;
      const float s = red[(0 * 3 + r) * 128 + cc] + red[(1 * 3 + r) * 128 + cc] + red[(2 * 3 + r) * 128 + cc] + red[(3 * 3 + r) * 128 + cc] + p.mod_b[L2 * 6144 + cl2];
      mods[((size_t)L2 * 3 + r) * 6144 + cl2] = s; }
    __syncthreads();
  }
  f32x4* xr = (f32x4*)(p.ws + OFF_XRES);
  for (size_t i = (size_t)BIDX() * 512 + tid; i < (size_t)MROWS * 256; i += (size_t)GDIM() * 512) {
    const int R = (int)(i >> 8), c4 = (int)(i & 255); const int b = R >= TB ? 1 : 0, pp = R - b * TB;
    const float* src = pp < CTXL ? p.ctx + ((size_t)b * CTXL + pp) * 1024 : p.x + ((size_t)b * LAT + (pp - CTXL)) * 1024;
    xr[i] = *(const f32x4*)(src + c4 * 4);
  }
}

DI int rec_src_col(int n) { if (n < 2048) return n; if (n < 3584) return n + 16; if (n < 3600) return 2048 + (n - 3584); if (n < 3632) return n; return -1; }
__device__ __forceinline__ void cvt_weight(const float* __restrict__ W, bf16_t* __restrict__ Wt, int K, int Nsrc, int Npad, bool perm, int skipb) {
  const size_t items = (size_t)Npad * (K >> 3);
  const int bid = BIDX() - skipb, nb = GDIM() - skipb;
  if (bid < 0) return;
  for (size_t it = (size_t)bid * 512 + TIDX(); it < items; it += (size_t)nb * 512) {
    const int n = (int)(it % Npad), kb = (int)(it / Npad);
    const int s = perm ? rec_src_col(n) : n;
    float v[8];
#pragma unroll
    for (int j = 0; j < 8; ++j) v[j] = s >= 0 ? W[(size_t)(kb * 8 + j) * Nsrc + s] : 0.f;
    u32x4 w = {cvtpk(v[0], v[1]), cvtpk(v[2], v[3]), cvtpk(v[4], v[5]), cvtpk(v[6], v[7])};
    *(u32x4*)(Wt + (size_t)n * K + kb * 8) = w;
  }
}

__device__ __forceinline__ void gemm_ctx_split(char* lds, const bf16_t* __restrict__ A, int lda, const bf16_t* __restrict__ Bt, int ldb, int Ks, float* __restrict__ PART) {
  const int tid = TIDX(), wid = tid >> 6, lane = tid & 63, r32 = lane & 31, hi = lane >> 5;
  const int wm = wid >> 1, wn = wid & 1;
  const int nk = Ks >> 6;
  constexpr int RS = 144, ASZ = 256 * RS, BSZ = 128 * RS, STG = ASZ + BSZ;
  const int srow = tid >> 3, spc = tid & 7;
  const int w = BIDX(); const int ks = w >> 4, j = w & 15; const int pm = (j >> 3) ? 33 : 0, pn = j & 7;
  const bf16_t* Ab = A + (size_t)(pm * 256 + srow) * lda + (size_t)ks * Ks + spc * 8;
  const bf16_t* Bb = Bt + (size_t)(pn * 128 + srow) * ldb + (size_t)ks * Ks + spc * 8;
  f32x16 acc00 = {}, acc01 = {}, acc10 = {}, acc11 = {};
  bf16x8 ra0, ra1, ra2, ra3, rb0, rb1;
#define GLOAD(kt) do { const int ko = (kt) * 64; ra0 = *(const bf16x8*)(Ab + ko); ra1 = *(const bf16x8*)(Ab + (size_t)64 * lda + ko); ra2 = *(const bf16x8*)(Ab + (size_t)128 * lda + ko); \
    ra3 = *(const bf16x8*)(Ab + (size_t)192 * lda + ko); rb0 = *(const bf16x8*)(Bb + ko); rb1 = *(const bf16x8*)(Bb + (size_t)64 * ldb + ko); } while (0)
#define SWRITE(buf) do { char* sb = lds + (buf) * STG + srow * RS + spc * 16; *(bf16x8*)(sb) = ra0; *(bf16x8*)(sb + 64 * RS) = ra1; *(bf16x8*)(sb + 128 * RS) = ra2; *(bf16x8*)(sb + 192 * RS) = ra3; \
    *(bf16x8*)(sb + ASZ) = rb0; *(bf16x8*)(sb + ASZ + 64 * RS) = rb1; } while (0)
  GLOAD(0); SWRITE(0); __syncthreads();
  for (int kt = 0; kt < nk; ++kt) {
    const int cur = kt & 1;
    if (kt + 1 < nk) GLOAD(kt + 1);
    const char* ab = lds + cur * STG + (64 * wm + r32) * RS + hi * 16;
    const char* bb = lds + cur * STG + ASZ + (64 * wn + r32) * RS + hi * 16;
#pragma unroll
    for (int k4 = 0; k4 < 4; ++k4) {
      const bf16x8 a0 = *(const bf16x8*)(ab + k4 * 32), a1 = *(const bf16x8*)(ab + 32 * RS + k4 * 32);
      const bf16x8 b0 = *(const bf16x8*)(bb + k4 * 32), b1 = *(const bf16x8*)(bb + 32 * RS + k4 * 32);
      acc00 = MFMA32(a0, b0, acc00); acc01 = MFMA32(a0, b1, acc01); acc10 = MFMA32(a1, b0, acc10); acc11 = MFMA32(a1, b1, acc11);
    }
    if (kt + 1 < nk) SWRITE(cur ^ 1);
    __syncthreads();
  }
#undef GLOAD
#undef SWRITE
  float* pb = PART + ((size_t)ks * 512 + (pm ? 256 : 0) + 64 * wm) * 1024 + pn * 128 + 64 * wn + r32;
#pragma unroll
  for (int r = 0; r < 16; ++r) { float* q = pb + (size_t)crow(r, hi) * 1024;
    q[0] = acc00[r]; q[32] = acc01[r]; q[32 * 1024] = acc10[r]; q[32 * 1024 + 32] = acc11[r]; }
}

__device__ __forceinline__ void ph_ctx_fold_norm(const P& p, int L, int which, const float* __restrict__ part, int nsplit, const float* __restrict__ gate) {
  const int tid = TIDX(), wid = tid >> 6, lane = tid & 63;
  float* xr = (float*)(p.ws + OFF_XRES); bf16_t* hb = (bf16_t*)(p.ws + OFF_HBF);
  const float* mods = (const float*)(p.ws + OFF_MODS) + (size_t)L * 3 * 6144;
  for (int cr = BIDX() * 8 + wid; cr < 2 * CTXL; cr += GDIM() * 8) {
    const int R = cr < CTXL ? cr : TB + (cr - CTXL);
    float* row = xr + (size_t)R * 1024 + lane * 4;
    const float* pr = part + (size_t)cr * 1024 + lane * 4;
    f32x4 v[4], a[4];
#pragma unroll
    for (int i = 0; i < 4; ++i) { v[i] = *(const f32x4*)(row + i * 256); a[i] = *(const f32x4*)(pr + i * 256); }
    for (int sp = 1; sp < nsplit; ++sp) {
#pragma unroll
      for (int i = 0; i < 4; ++i) a[i] += *(const f32x4*)(pr + (size_t)sp * 512 * 1024 + i * 256);
    }
    float ss = 0.f;
#pragma unroll
    for (int i = 0; i < 4; ++i) { v[i] += *(const f32x4*)(gate + 2 * 6144 + i * 256 + lane * 4) * a[i]; *(f32x4*)(row + i * 256) = v[i];
      ss += v[i][0] * v[i][0] + v[i][1] * v[i][1] + v[i][2] * v[i][2] + v[i][3] * v[i][3]; }
    ss = wave_sum(ss);
    const float rs = rsqrtf(ss * (1.f / 1024.f) + EPSF);
    const float* mr = mods + (size_t)2 * 6144 + which * 3072 + lane * 4;
#pragma unroll
    for (int i = 0; i < 4; ++i) { const f32x4 sh = *(const f32x4*)(mr + i * 256), scl = *(const f32x4*)(mr + 1024 + i * 256);
      float o[4];
#pragma unroll
      for (int j = 0; j < 4; ++j) o[j] = v[i][j] * rs * (1.f + scl[j]) + sh[j];
      uint2 w; w.x = cvtpk(o[0], o[1]); w.y = cvtpk(o[2], o[3]);
      *(uint2*)(hb + (size_t)R * 1024 + i * 256 + lane * 4) = w; }
  }
}

__device__ __forceinline__ void ph_norm(const P& p, int L, int which, int mode, int skipb) {
  const int tid = TIDX(), wid = tid >> 6, lane = tid & 63, l16 = lane & 15, sub = lane >> 4;
  const float* xr = (const float*)(p.ws + OFF_XRES);
  bf16_t* hb = (bf16_t*)(p.ws + OFF_HBF);
  const float* mods = (const float*)(p.ws + OFF_MODS) + (size_t)L * 3 * 6144;
  const int bid = BIDX() - skipb, nb = GDIM() - skipb;
  if (bid < 0) return;
  const int nquads = mode == 0 ? MROWS / 4 : (mode == 1 ? 2 * LAT / 4 : 2 * CTXL / 4);
  for (int q = bid * 8 + wid; q < nquads; q += nb * 8) {
    int R4;
    if (mode == 0) R4 = q * 4; else if (mode == 1) R4 = q < LAT / 4 ? CTXL + q * 4 : TB + CTXL + (q - LAT / 4) * 4; else R4 = q < CTXL / 4 ? q * 4 : TB + (q - CTXL / 4) * 4;
    const int R = R4 + sub;
    const float* row = xr + (size_t)R * 1024 + l16 * 4;
    f32x4 v[16]; float ss = 0.f;
#pragma unroll
    for (int i = 0; i < 16; ++i) v[i] = *(const f32x4*)(row + i * 64);
#pragma unroll
    for (int i = 0; i < 16; ++i) ss += v[i][0] * v[i][0] + v[i][1] * v[i][1] + v[i][2] * v[i][2] + v[i][3] * v[i][3];
    ss += __shfl_xor(ss, 1); ss += __shfl_xor(ss, 2); ss += __shfl_xor(ss, 4); ss += __shfl_xor(ss, 8);
    const float rs = rsqrtf(ss * (1.f / 1024.f) + EPSF);
    const float* mr = mods + (size_t)modrow_of(R) * 6144 + which * 3072 + l16 * 4;
    bf16_t* dst = hb + (size_t)R * 1024 + l16 * 4;
#pragma unroll
    for (int i = 0; i < 16; ++i) { const f32x4 sh = *(const f32x4*)(mr + i * 64), scl = *(const f32x4*)(mr + 1024 + i * 64);
      float o[4];
#pragma unroll
      for (int j = 0; j < 4; ++j) o[j] = v[i][j] * rs * (1.f + scl[j]) + sh[j];
      uint2 w; w.x = cvtpk(o[0], o[1]); w.y = cvtpk(o[2], o[3]);
      *(uint2*)(dst + i * 64) = w; }
  }
}

struct EpiRec { bf16_t* P1; bf16_t* P2; float* SM;
  DI void operator()(int row, int col, float v) const {
    if (col < 1536) P1[(size_t)row * 1536 + col] = f2bf(v);
    else if (col < 3584) P2[(size_t)row * 2048 + (col - 1536)] = f2bf(v);
    else { const int lc = col - 3584; if (lc < 48) SM[(size_t)row * 64 + lc] = v; } } };
struct EpiBf { bf16_t* O; int ldc;
  DI void operator()(int row, int col, float v) const { O[(size_t)row * ldc + col] = f2bf(v); } };
struct EpiRes { float* X; const float* gate;
  DI void operator()(int row, int col, float v) const { float* q = X + (size_t)row * 1024 + col; *q = *q + gate[(size_t)modrow_of(row) * 6144 + col] * v; } };

template <class Epi>
__device__ __forceinline__ void gemm_phase(char* lds, const bf16_t* __restrict__ A, int lda, const bf16_t* __restrict__ Bt, int K, int nN, const Epi epi, bool skipctx = false) {
  const int tid = TIDX(), wid = tid >> 6, lane = tid & 63, r32 = lane & 31, hi = lane >> 5;
  const int wm = wid >> 1, wn = wid & 1;
  const int nk = K >> 6;
  constexpr int RS = 144, ASZ = 256 * RS, BSZ = 128 * RS, STG = ASZ + BSZ;
  const int ntiles = (skipctx ? 64 : MROWS / 256) * nN;
  const int srow = tid >> 3, spc = tid & 7;
  for (int t = BIDX(); t < ntiles; t += GDIM()) {
    int pm = t / nN; const int pn = t - pm * nN; if (skipctx) pm = pm + 1 + (pm >= 32 ? 1 : 0);
    const bf16_t* Ab = A + (size_t)(pm * 256 + srow) * lda + spc * 8;
    const bf16_t* Bb = Bt + (size_t)(pn * 128 + srow) * K + spc * 8;
    f32x16 acc00 = {}, acc01 = {}, acc10 = {}, acc11 = {};
    bf16x8 ra0, ra1, ra2, ra3, rb0, rb1;
#define GLOAD(kt) do { const int ko = (kt) * 64; ra0 = *(const bf16x8*)(Ab + ko); ra1 = *(const bf16x8*)(Ab + (size_t)64 * lda + ko); ra2 = *(const bf16x8*)(Ab + (size_t)128 * lda + ko); \
    ra3 = *(const bf16x8*)(Ab + (size_t)192 * lda + ko); rb0 = *(const bf16x8*)(Bb + ko); rb1 = *(const bf16x8*)(Bb + (size_t)64 * K + ko); } while (0)
#define SWRITE(buf) do { char* sb = lds + (buf) * STG + srow * RS + spc * 16; *(bf16x8*)(sb) = ra0; *(bf16x8*)(sb + 64 * RS) = ra1; *(bf16x8*)(sb + 128 * RS) = ra2; *(bf16x8*)(sb + 192 * RS) = ra3; \
    *(bf16x8*)(sb + ASZ) = rb0; *(bf16x8*)(sb + ASZ + 64 * RS) = rb1; } while (0)
    GLOAD(0); SWRITE(0); __syncthreads();
    for (int kt = 0; kt < nk; ++kt) {
      const int cur = kt & 1;
      if (kt + 1 < nk) GLOAD(kt + 1);
      const char* ab = lds + cur * STG + (64 * wm + r32) * RS + hi * 16;
      const char* bb = lds + cur * STG + ASZ + (64 * wn + r32) * RS + hi * 16;
#pragma unroll
      for (int ks = 0; ks < 4; ++ks) {
        const bf16x8 a0 = *(const bf16x8*)(ab + ks * 32), a1 = *(const bf16x8*)(ab + 32 * RS + ks * 32);
        const bf16x8 b0 = *(const bf16x8*)(bb + ks * 32), b1 = *(const bf16x8*)(bb + 32 * RS + ks * 32);
        acc00 = MFMA32(a0, b0, acc00); acc01 = MFMA32(a0, b1, acc01); acc10 = MFMA32(a1, b0, acc10); acc11 = MFMA32(a1, b1, acc11);
      }
      if (kt + 1 < nk) SWRITE(cur ^ 1);
      __syncthreads();
    }
#undef GLOAD
#undef SWRITE
    const int row0 = pm * 256 + 64 * wm, col0 = pn * 128 + 64 * wn + r32;
#pragma unroll
    for (int r = 0; r < 16; ++r) { const int rr = row0 + crow(r, hi);
      epi(rr, col0, acc00[r]); epi(rr, col0 + 32, acc01[r]); epi(rr + 32, col0, acc10[r]); epi(rr + 32, col0 + 32, acc11[r]); }
  }
}

namespace pg8 {
#define PG8_LAS __attribute__((address_space(3)))
constexpr int BM = 256, BK = 64, HALF = 128, HTB = HALF * BK * 2  , STAGE_BYTES = 8 * HTB, NXCD = 8, WGM = 8;

__host__ __device__ __forceinline__ int lds_byte(int r, int c) { const int st = (r >> 4) * 2 + (c >> 5), rr = r & 15, cc = c & 31, ob = rr * 64 + cc * 2; return st * 1024 + (ob ^ (((ob >> 9) & 1) << 5)); }
__host__ __device__ __forceinline__ void stage_rc(int b, int& R, int& C) { const int st = b / 1024, sb = b % 1024, swz = sb ^ (((sb >> 9) & 1) << 5); R = (st >> 1) * 16 + swz / 64; C = (st & 1) * 32 + (swz % 64) / 2; }
__host__ __device__ __forceinline__ int perm32(int rho) { const int n = rho >> 4, i = rho & 15; return 8 * (i >> 2) + 4 * n + (i & 3); }
struct Unit { int pm, pn; };
struct Gemm { const bf16_t* A; const bf16_t* Bt; int M, N, K, lda; };

struct StaticOrder {
    int nM, nN, nwg, G, c;
    __host__ __device__ void init(int M, int N, int G_, int c_) { nM = M / BM; nN = N / BM; nwg = nM * nN; G = G_; c = c_; }
    __host__ __device__ bool next(int i, Unit& u) const {
        const long L = (long)i * G + c; if (L >= nwg) return false;
        int wgid = (int)L; { const int q = nwg / NXCD, r = nwg % NXCD, xcd = wgid % NXCD, off = wgid / NXCD; wgid = (xcd < r ? xcd * (q + 1) : r * (q + 1) + (xcd - r) * q) + off; }
        const int nig = WGM * nN, gid = wgid / nig, fm = gid * WGM, gsz = (nM - fm) < WGM ? (nM - fm) : WGM;
        u.pm = fm + ((wgid % nig) % gsz); u.pn = (wgid % nig) / gsz; return true;
    }
    __device__ __forceinline__ void a_ready(const Unit&) const {}
    __device__ __forceinline__ void done(const Unit&) const {}
};
template <class Epi, class Sched, bool ALIGN_EPI = false, bool SP2 = false>
__device__ __forceinline__ void gemm_phase(PG8_LAS unsigned char* lds, const Gemm g, const Sched& S, const Epi& E) {
    const int tid = TIDX(), wid = __builtin_amdgcn_readfirstlane(tid >> 6), lane = tid & 63, wr = wid >> 2, wc = wid & 3, fr = lane & 15, fq = lane >> 4;
    const int K = g.K, nt = K / BK;
    unsigned voffA[2], voffB[2];
#pragma unroll
    for (int i = 0; i < 2; ++i) { int R, C; stage_rc(tid * 16 + i * 8192, R, C); const int Rb = Epi::PERM ? ((R & ~31) + perm32(R & 31)) : R;
        voffA[i] = (unsigned)(R * g.lda + C) * 2u; voffB[i] = (unsigned)(Rb * K + C) * 2u; }
    const size_t kstep = (size_t)(BK * 2);
    const size_t hstep = (size_t)HALF * K * 2;
    const size_t tstep = 2 * hstep; const size_t hstepA = (size_t)HALF * g.lda * 2, tstepA = 2 * hstepA;
    const unsigned ldsw = (unsigned)wid * 1024u;
    const int aoff = lds_byte(wr * 64 + fr, fq * 8), boff = lds_byte(wc * 32 + fr, fq * 8);
#define PG8_SA(b, h) (((b) * 2 + (h)) * HTB)
#define PG8_SB(b, h) ((4 + (b) * 2 + (h)) * HTB)
#define PG8_STAGE(bufoff, gbase, voff) do { _Pragma("unroll") for (int _i = 0; _i < 2; ++_i) \
        __builtin_amdgcn_global_load_lds((const unsigned*)((const char*)(gbase) + (voff)[_i]), (PG8_LAS unsigned*)(lds + (bufoff) + ldsw + _i * 8192), 16, 0, 0); } while (0)
#define PG8_LDA(dst, b, h) do { _Pragma("unroll") for (int m = 0; m < 4; ++m) _Pragma("unroll") for (int k = 0; k < 2; ++k) dst[m][k] = *(const PG8_LAS bf16x8*)(lds + PG8_SA(b, h) + aoff + m * 2048 + k * 1024); } while (0)
#define PG8_LDB(dst, b, h) do { _Pragma("unroll") for (int n = 0; n < 2; ++n) _Pragma("unroll") for (int k = 0; k < 2; ++k) dst[n][k] = *(const PG8_LAS bf16x8*)(lds + PG8_SB(b, h) + boff + n * 2048 + k * 1024); } while (0)
#define PG8_MMA(ai, bj, At, Bt) do { __builtin_amdgcn_s_setprio(1); _Pragma("unroll") for (int m = 0; m < 4; ++m) _Pragma("unroll") for (int n = 0; n < 2; ++n) _Pragma("unroll") for (int k = 0; k < 2; ++k) \
        acc[ai][bj][m][n] = __builtin_amdgcn_mfma_f32_16x16x32_bf16(Bt[n][k], At[m][k], acc[ai][bj][m][n], 0, 0, 0); __builtin_amdgcn_s_setprio(0); } while (0)
#define PG8_WAIT_V(n) asm volatile("s_waitcnt vmcnt(" #n ")" ::: "memory")
#define PG8_WAIT_L(n) asm volatile("s_waitcnt lgkmcnt(" #n ")" ::: "memory")
#define PG8_BAR __builtin_amdgcn_s_barrier()
#define PG8_SCHED __builtin_amdgcn_sched_barrier(0)
    Unit cur, nxt; int ui = 0;
    if (!S.next(0, cur)) return;
    f32x4 acc[2][2][4][2];
#pragma unroll
    for (int a = 0; a < 2; ++a)
#pragma unroll
        for (int b = 0; b < 2; ++b)
#pragma unroll
            for (int m = 0; m < 4; ++m)
#pragma unroll
                for (int n = 0; n < 2; ++n) acc[a][b][m][n] = (f32x4){0.f, 0.f, 0.f, 0.f};
    bf16x8 At[4][2], B0[2][2], B1[2][2];
    const char* cA = (const char*)g.A + (size_t)cur.pm * tstepA; const char* cB = (const char*)g.Bt + (size_t)cur.pn * tstep;
    S.a_ready(cur);
    if constexpr (SP2) {
        PG8_STAGE(PG8_SB(0, 0), cB, voffB); PG8_STAGE(PG8_SB(0, 1), cB + hstep, voffB); PG8_STAGE(PG8_SA(0, 0), cA, voffA); PG8_STAGE(PG8_SA(0, 1), cA + hstepA, voffA);
        if (wr == 1) PG8_BAR;
        PG8_WAIT_V(2); PG8_BAR;
        PG8_STAGE(PG8_SB(1, 0), cB + kstep, voffB); PG8_STAGE(PG8_SA(1, 0), cA + kstep, voffA); PG8_STAGE(PG8_SB(1, 1), cB + hstep + kstep, voffB);
        PG8_WAIT_V(6); PG8_BAR;
    } else {
        PG8_STAGE(PG8_SB(0, 0), cB, voffB); PG8_STAGE(PG8_SA(0, 0), cA, voffA); PG8_STAGE(PG8_SB(0, 1), cB + hstep, voffB); PG8_STAGE(PG8_SA(0, 1), cA + hstepA, voffA);
        if (wr == 1) PG8_BAR;
        PG8_WAIT_V(4); PG8_BAR;
        PG8_STAGE(PG8_SB(1, 0), cB + kstep, voffB); PG8_STAGE(PG8_SA(1, 0), cA + kstep, voffA); PG8_STAGE(PG8_SB(1, 1), cB + hstep + kstep, voffB);
        PG8_WAIT_V(6); PG8_BAR;
    }
    for (;;) {
        const bool has_next = S.next(ui + 1, nxt);
        const char* nA = has_next ? (const char*)g.A + (size_t)nxt.pm * tstepA : cA; const char* nB = has_next ? (const char*)g.Bt + (size_t)nxt.pn * tstep : cB;
        for (int t = 0; t < nt; t += 2) {
            const bool last = (t == nt - 2);
            const char* a1 = cA + (size_t)(t + 1) * kstep;
            const char* a2 = last ? nA : cA + (size_t)(t + 2) * kstep; const char* b2 = last ? nB : cB + (size_t)(t + 2) * kstep;
            const char* a3 = a2 + kstep; const char* b3 = b2 + kstep;
            if (last && has_next) S.a_ready(nxt);
            if constexpr (SP2) {
            PG8_LDB(B0, 0, 0); PG8_LDB(B1, 0, 1); PG8_SCHED; PG8_LDA(At, 0, 0); PG8_STAGE(PG8_SA(1, 1), a1 + hstepA, voffA);
            PG8_WAIT_V(8); PG8_WAIT_L(0); PG8_BAR; PG8_MMA(0, 0, At, B0); PG8_MMA(0, 1, At, B1); PG8_BAR; PG8_SCHED;
            PG8_LDA(At, 0, 1); PG8_STAGE(PG8_SB(0, 0), b2, voffB); PG8_STAGE(PG8_SB(0, 1), b2 + hstep, voffB); PG8_STAGE(PG8_SA(0, 0), a2, voffA);
            PG8_WAIT_V(8); PG8_WAIT_L(0); PG8_BAR; PG8_MMA(1, 0, At, B0); PG8_MMA(1, 1, At, B1); PG8_BAR; PG8_SCHED;
            PG8_LDB(B0, 1, 0); PG8_LDB(B1, 1, 1); PG8_SCHED; PG8_LDA(At, 1, 0); PG8_STAGE(PG8_SA(0, 1), a2 + hstepA, voffA);
            PG8_WAIT_V(8); PG8_WAIT_L(0); PG8_BAR; PG8_MMA(0, 0, At, B0); PG8_MMA(0, 1, At, B1); PG8_BAR; PG8_SCHED;
            PG8_LDA(At, 1, 1); PG8_STAGE(PG8_SB(1, 0), b3, voffB); PG8_STAGE(PG8_SB(1, 1), b3 + hstep, voffB); PG8_STAGE(PG8_SA(1, 0), a3, voffA);
            PG8_WAIT_V(8); PG8_WAIT_L(0); PG8_BAR; PG8_MMA(1, 0, At, B0); PG8_MMA(1, 1, At, B1); PG8_BAR; PG8_SCHED;
            } else {
            PG8_LDB(B0, 0, 0); PG8_SCHED; PG8_LDA(At, 0, 0); PG8_STAGE(PG8_SA(1, 1), a1 + hstepA, voffA);
            PG8_WAIT_L(8); PG8_BAR; PG8_WAIT_L(0); PG8_MMA(0, 0, At, B0); PG8_BAR; PG8_SCHED;
            PG8_LDB(B1, 0, 1); PG8_STAGE(PG8_SB(0, 0), b2, voffB);
            PG8_BAR; PG8_WAIT_L(0); PG8_MMA(0, 1, At, B1); PG8_BAR;
            PG8_LDA(At, 0, 1); PG8_STAGE(PG8_SA(0, 0), a2, voffA);
            PG8_BAR; PG8_WAIT_L(0); PG8_MMA(1, 0, At, B0); PG8_BAR; PG8_SCHED;
            PG8_STAGE(PG8_SB(0, 1), b2 + hstep, voffB);
            PG8_WAIT_V(6); PG8_BAR; PG8_MMA(1, 1, At, B1); PG8_BAR;
            PG8_LDB(B0, 1, 0); PG8_SCHED; PG8_LDA(At, 1, 0); PG8_STAGE(PG8_SA(0, 1), a2 + hstepA, voffA);
            PG8_WAIT_L(8); PG8_BAR; PG8_WAIT_L(0); PG8_MMA(0, 0, At, B0); PG8_BAR; PG8_SCHED;
            PG8_LDB(B1, 1, 1); PG8_STAGE(PG8_SB(1, 0), b3, voffB);
            PG8_BAR; PG8_WAIT_L(0); PG8_MMA(0, 1, At, B1); PG8_BAR;
            PG8_LDA(At, 1, 1); PG8_STAGE(PG8_SA(1, 0), a3, voffA);
            PG8_BAR; PG8_WAIT_L(0); PG8_MMA(1, 0, At, B0); PG8_BAR; PG8_SCHED;
            PG8_STAGE(PG8_SB(1, 1), b3 + hstep, voffB);
            PG8_WAIT_V(6); PG8_BAR; PG8_MMA(1, 1, At, B1); PG8_BAR;
            }
        }
        if constexpr (ALIGN_EPI) { if (wr == 0) PG8_BAR; }
        if constexpr (!Epi::AFTER_DRAIN) { E(acc, cur, wr, wc, fr, fq); S.done(cur); }
        if (!has_next) break;
#pragma unroll
        for (int a = 0; a < 2; ++a)
#pragma unroll
            for (int b = 0; b < 2; ++b)
#pragma unroll
                for (int m = 0; m < 4; ++m)
#pragma unroll
                    for (int n = 0; n < 2; ++n) acc[a][b][m][n] = (f32x4){0.f, 0.f, 0.f, 0.f};
        cur = nxt; cA = nA; cB = nB; ++ui;
        if constexpr (ALIGN_EPI) { if (wr == 1) PG8_BAR; }
    }
    PG8_WAIT_V(0);
    if constexpr (!ALIGN_EPI) { if (wr == 0) PG8_BAR; }
    PG8_BAR;
    if constexpr (Epi::AFTER_DRAIN) { E.fused(acc, cur, wr, wc, fr, fq, lds, wid, lane); S.done(cur); }
#undef PG8_SA
#undef PG8_SB
#undef PG8_STAGE
#undef PG8_LDA
#undef PG8_LDB
#undef PG8_MMA
#undef PG8_WAIT_V
#undef PG8_WAIT_L
#undef PG8_BAR
#undef PG8_SCHED
}
struct SchedX { StaticOrder so; int mode;
  __device__ __forceinline__ bool next(int i, Unit& u) const {
    if (mode == 2) { if (i != 0 || so.c >= 8) return false; u.pm = (so.c >> 2) ? 33 : 0; u.pn = so.c & 3; return true; }
    if (!so.next(i, u)) return false; if (mode == 1) u.pm = u.pm + 1 + (u.pm >= 32 ? 1 : 0); return true; }
  __device__ __forceinline__ void a_ready(const Unit&) const {}
  __device__ __forceinline__ void done(const Unit&) const {} };
}
struct EpiRec8 { static constexpr bool PERM = false, AFTER_DRAIN = false; bf16_t* P1; bf16_t* P2; float* SM;
  DI void operator()(const f32x4 (&acc)[2][2][4][2], const pg8::Unit& u, int wr, int wc, int fr, int fq) const {
#pragma unroll
    for (int ai = 0; ai < 2; ++ai)
#pragma unroll
      for (int m = 0; m < 4; ++m) { const size_t row = (size_t)u.pm * 256 + ai * 128 + wr * 64 + m * 16 + fr;
#pragma unroll
        for (int bj = 0; bj < 2; ++bj)
#pragma unroll
          for (int n = 0; n < 2; ++n) { const int col = u.pn * 256 + bj * 128 + wc * 32 + n * 16 + fq * 4; const f32x4 v = acc[ai][bj][m][n];
            if (u.pn < 6) { uint2 w; w.x = cvtpk(v[0], v[1]); w.y = cvtpk(v[2], v[3]); *(uint2*)(P1 + row * 1536 + col) = w; }
            else if (u.pn < 14) { uint2 w; w.x = cvtpk(v[0], v[1]); w.y = cvtpk(v[2], v[3]); *(uint2*)(P2 + row * 2048 + (col - 1536)) = w; }
            else { const int lc = col - 3584; if (lc < 48) *(f32x4*)(SM + row * 64 + lc) = v; } } } } };
struct EpiBf8 { static constexpr bool PERM = false, AFTER_DRAIN = false; bf16_t* O; int ldc;
  DI void operator()(const f32x4 (&acc)[2][2][4][2], const pg8::Unit& u, int wr, int wc, int fr, int fq) const {
#pragma unroll
    for (int ai = 0; ai < 2; ++ai)
#pragma unroll
      for (int m = 0; m < 4; ++m) { const size_t row = (size_t)u.pm * 256 + ai * 128 + wr * 64 + m * 16 + fr;
#pragma unroll
        for (int bj = 0; bj < 2; ++bj)
#pragma unroll
          for (int n = 0; n < 2; ++n) { const int col = u.pn * 256 + bj * 128 + wc * 32 + n * 16 + fq * 4; const f32x4 v = acc[ai][bj][m][n];
            uint2 w; w.x = cvtpk(v[0], v[1]); w.y = cvtpk(v[2], v[3]); *(uint2*)(O + row * ldc + col) = w; } } } };
struct EpiRes8 { static constexpr bool PERM = false, AFTER_DRAIN = false; float* X; const float* gate;
  DI void operator()(const f32x4 (&acc)[2][2][4][2], const pg8::Unit& u, int wr, int wc, int fr, int fq) const {
    const float* gr = gate + (size_t)modrow_of(u.pm * 256) * 6144;
#pragma unroll
    for (int bj = 0; bj < 2; ++bj)
#pragma unroll
      for (int n = 0; n < 2; ++n) { const int col = u.pn * 256 + bj * 128 + wc * 32 + n * 16 + fq * 4; const f32x4 gv = *(const f32x4*)(gr + col);
#pragma unroll
        for (int ai = 0; ai < 2; ++ai)
#pragma unroll
          for (int m = 0; m < 4; ++m) { const size_t row = (size_t)u.pm * 256 + ai * 128 + wr * 64 + m * 16 + fr;
            f32x4* q = (f32x4*)(X + row * 1024 + col); *q = *q + gv * acc[ai][bj][m][n]; } } } };
template <class Epi>
__device__ __forceinline__ void gemm8(char* lds, const bf16_t* A, int lda, const bf16_t* Bt, int K, int N, int mode, const Epi& E) {
  pg8::Gemm g{A, Bt, mode == 1 ? 16384 : MROWS, N, K, lda};
  pg8::SchedX S; S.so.init(g.M, N, GDIM(), BIDX()); S.mode = mode;
  pg8::gemm_phase<Epi, pg8::SchedX, true, true>((PG8_LAS unsigned char*)lds, g, S, E);
}

__device__ __forceinline__ void ph_dnprep(const P& p, char* lds, int e) {
  const int tid = TIDX(), wid = tid >> 6, lane = tid & 63;
  const bf16_t* P1 = (const bf16_t*)(p.ws + OFF_D + D_P1);
  bf16_t* QQ = (bf16_t*)(p.ws + OFF_D + D_QQ); bf16_t* QK = (bf16_t*)(p.ws + OFF_D + D_QK); bf16_t* QV = (bf16_t*)(p.ws + OFF_D + D_QV);
  bf16_t* KT = (bf16_t*)(p.ws + OFF_D + D_KT);
  const float* SM = (const float*)(p.ws + OFF_SM); float* GB = (float*)(p.ws + OFF_GB);
  const float* cw = p.rec_conv + (size_t)e * 3 * 1536;
  bf16_t* kl = (bf16_t*)lds;
  for (int job = BIDX(); job < MROWS / 32; job += GDIM()) {
    const int R0 = job * 32;
    for (int tt = 0; tt < 4; ++tt) {
      const int tl = wid * 4 + tt, R = R0 + tl; const int b = R >= TB ? 1 : 0, pp = R - b * TB;
      const bool hasp = !(pp == 0 || pp == CTXL), hasn = !(pp == CTXL - 1 || pp == TB - 1);
#pragma unroll
      for (int part = 0; part < 3; ++part) {
        const int ch = part * 512 + lane * 8;
        const bf16x8 zc = *(const bf16x8*)(P1 + (size_t)R * 1536 + ch);
        bf16x8 zp = {}, zn = {};
        if (hasp) zp = *(const bf16x8*)(P1 + (size_t)(R - 1) * 1536 + ch);
        if (hasn) zn = *(const bf16x8*)(P1 + (size_t)(R + 1) * 1536 + ch);
        float o[8]; float ss = 0.f;
#pragma unroll
        for (int j = 0; j < 8; ++j) { const float a = bf2f((bf16_t)zp[j]) * cw[ch + j] + bf2f((bf16_t)zc[j]) * cw[1536 + ch + j] + bf2f((bf16_t)zn[j]) * cw[3072 + ch + j];
          o[j] = siluf(a); ss += o[j] * o[j]; }
        if (part < 2) {
          ss += __shfl_xor(ss, 1); ss += __shfl_xor(ss, 2); ss += __shfl_xor(ss, 4); ss += __shfl_xor(ss, 8);
          float sc = rsqrtf(ss + EPSF); if (part == 0) sc *= 0.08838834764831845f;
#pragma unroll
          for (int j = 0; j < 8; ++j) o[j] *= sc;
        }
        u32x4 w = {cvtpk(o[0], o[1]), cvtpk(o[2], o[3]), cvtpk(o[4], o[5]), cvtpk(o[6], o[7])};
        bf16_t* dst = part == 0 ? QQ : (part == 1 ? QK : QV);
        *(u32x4*)(dst + (size_t)R * 512 + lane * 8) = w;
        if (part == 1) *(u32x4*)(kl + tl * 512 + lane * 8) = w;
      }
      if (lane < 16) {
        const int q = lane & 7;
        if (lane < 8) { const float da = SM[(size_t)R * 64 + q]; GB[(size_t)R * 16 + q] = -expf(p.dn_a_log[e * 8 + q]) * softplusf(da + p.dn_dt_bias[e * 8 + q]); }
        else { const float db = SM[(size_t)R * 64 + 8 + q]; GB[(size_t)R * 16 + 8 + q] = sigmf(db); }
      }
    }
    __syncthreads();
    {
      const int b = R0 >= TB ? 1 : 0, c = (R0 - b * TB) / 64, half = ((R0 - b * TB) >> 5) & 1; const int h = tid >> 7, dk = tid & 127;
      bf16_t* dst = KT + ((((size_t)b * 4 + h) * NCH + c) * 128 + dk) * 64 + half * 32;
#pragma unroll
      for (int g8 = 0; g8 < 4; ++g8) { unsigned w[4];
#pragma unroll
        for (int j = 0; j < 4; ++j) { const unsigned lo = kl[(g8 * 8 + 2 * j) * 512 + tid], hi2 = kl[(g8 * 8 + 2 * j + 1) * 512 + tid]; w[j] = lo | (hi2 << 16); }
        *(u32x4*)(dst + g8 * 8) = (u32x4){w[0], w[1], w[2], w[3]}; }
    }
    __syncthreads();
  }
}

__device__ __forceinline__ void ph_dn_d1(const P& p, char* lds) {
  const int tid = TIDX(), wid = tid >> 6, lane = tid & 63, r32 = lane & 31, hi = lane >> 5;
  const bf16_t* QQ = (const bf16_t*)(p.ws + OFF_D + D_QQ); const bf16_t* QK = (const bf16_t*)(p.ws + OFF_D + D_QK); const bf16_t* QV = (const bf16_t*)(p.ws + OFF_D + D_QV);
  const float* GB = (const float*)(p.ws + OFF_GB);
  bf16_t* W_ = (bf16_t*)(p.ws + OFF_D + D_W); bf16_t* U_ = (bf16_t*)(p.ws + OFF_HBF); bf16_t* INTRA = (bf16_t*)(p.ws + OFF_D + D_INTRA);
  float* SC = (float*)(p.ws + OFF_SC); float* GLS = (float*)(p.ws + OFF_GL);
  float* KK = (float*)lds; float* QKm = KK + 64 * 65; float* Ad = QKm + 64 * 65; float* Gs = Ad + 2 * 4096; float* Bs = Gs + 128;
  bf16_t* Vs = (bf16_t*)(Bs + 128); bf16_t* Ks = Vs + 64 * 128;
  for (int job = BIDX(); job < 8 * NCH; job += GDIM()) {
    const int b = job / (4 * NCH), h = (job / NCH) & 3, c = job % NCH;
    const size_t Rb = (size_t)b * TB + (size_t)c * 64;
    {
      const int srow = tid >> 4, spc = (tid & 15) * 8;
      const u32x4 v0 = *(const u32x4*)(QV + (Rb + srow) * 512 + h * 128 + spc), v1 = *(const u32x4*)(QV + (Rb + 32 + srow) * 512 + h * 128 + spc);
      const u32x4 k0 = *(const u32x4*)(QK + (Rb + srow) * 512 + h * 128 + spc), k1 = *(const u32x4*)(QK + (Rb + 32 + srow) * 512 + h * 128 + spc);
      *(u32x4*)(Vs + srow * 128 + spc) = v0; *(u32x4*)(Vs + (32 + srow) * 128 + spc) = v1;
      *(u32x4*)(Ks + srow * 128 + spc) = k0; *(u32x4*)(Ks + (32 + srow) * 128 + spc) = k1;
    }
    {
      const int w4 = wid & 3, mi = w4 & 1, ni = w4 >> 1;
      const bf16_t* As = wid < 4 ? QK : QQ;
      const bf16_t* arow = As + (Rb + 32 * mi + r32) * 512 + h * 128 + hi * 8;
      const bf16_t* brow = QK + (Rb + 32 * ni + r32) * 512 + h * 128 + hi * 8;
      f32x16 acc = {}; acc = mma_rows<8>(arow, brow, acc);
      float* dst = wid < 4 ? KK : QKm;
#pragma unroll
      for (int r = 0; r < 16; ++r) dst[(32 * mi + crow(r, hi)) * 65 + 32 * ni + r32] = acc[r];
    }
    if (tid < 128) { const int d = tid >> 6, ip = tid & 63, t = d ? 63 - ip : ip; float g = GB[(Rb + t) * 16 + d * 4 + h]; Bs[tid] = GB[(Rb + t) * 16 + 8 + d * 4 + h];
#pragma unroll
      for (int o = 1; o < 64; o <<= 1) { const float v = __shfl_up(g, o); g += ip >= o ? v : 0.f; }
      Gs[tid] = g; }
    __syncthreads();
    const int n0 = c, n1 = c < 4 ? 3 - c : 135 - c;
    const size_t cj0 = ((size_t)(0 * 2 + b) * 4 + h) * NCH + n0, cj1 = ((size_t)(1 * 2 + b) * 4 + h) * NCH + n1;
    for (int e2 = tid; e2 < 8192; e2 += 512) {
      const int d = e2 >> 12, ip = (e2 >> 6) & 63, jp = e2 & 63; const int i = d ? 63 - ip : ip, j = d ? 63 - jp : jp;
      const float dec = jp <= ip ? __expf(Gs[d * 64 + ip] - Gs[d * 64 + jp]) : 0.f;
      Ad[d * 4096 + ip * 64 + jp] = jp < ip ? Bs[d * 64 + ip] * KK[i * 65 + j] * dec : 0.f;
      const size_t cj = d ? cj1 : cj0;
      INTRA[(cj * 64 + ip) * 64 + jp] = f2bf(QKm[i * 65 + j] * dec);
    }
    if (tid < 128) { const int d = tid >> 6, ip = tid & 63; const size_t cj = d ? cj1 : cj0; const float gi = Gs[tid], gl = Gs[d * 64 + 63];
      SC[(cj * 64 + ip) * 2] = __expf(gi); SC[(cj * 64 + ip) * 2 + 1] = __expf(gl - gi); if (ip == 0) GLS[cj] = __expf(gl); }
    __syncthreads();
    {
      const int d = tid >> 8, cc = tid & 255; const size_t cj = d ? cj1 : cj0;
      int dofs = d * 64, aofs = d * 4096; asm volatile("" : "+v"(dofs), "+v"(aofs));
      float x[64];
      {
        int vofs = cc < 128 ? cc : 64 * 128 + (cc - 128); asm volatile("" : "+v"(vofs));
#pragma unroll
        for (int ip = 0; ip < 64; ++ip) x[ip] = bf2f(Vs[vofs + ip * 128]);
#pragma unroll
        for (int ip = 0; ip < 32; ++ip) { const float a_ = x[ip], b_ = x[63 - ip]; x[ip] = d ? b_ : a_; x[63 - ip] = d ? a_ : b_; }
        if (cc < 128) {
#pragma unroll
          for (int ip = 0; ip < 64; ++ip) x[ip] *= Bs[dofs + ip];
        } else {
#pragma unroll
          for (int ip = 0; ip < 64; ++ip) x[ip] *= Bs[dofs + ip] * __expf(Gs[dofs + ip]);
        }
      }
      const float* Arow = Ad + aofs;
#pragma unroll
      for (int ip = 1; ip < 64; ++ip) {
        float s = 0.f;
#pragma unroll
        for (int j4 = 0; j4 < (ip + 3) / 4; ++j4) { const f32x4 a = *(const f32x4*)(Arow + ip * 64 + 4 * j4);
          s += a[0] * x[4 * j4] + a[1] * x[4 * j4 + 1] + a[2] * x[4 * j4 + 2] + a[3] * x[4 * j4 + 3]; }
        x[ip] -= s;
      }
      bf16_t* dst = cc < 128 ? U_ + cj * 64 * 128 + cc : W_ + cj * 64 * 128 + (cc - 128);
#pragma unroll
      for (int ip = 0; ip < 64; ++ip) dst[ip * 128] = f2bf(x[ip]);
    }
    __syncthreads();
  }
}

typedef _Float16 h16x8 __attribute__((ext_vector_type(8)));
__device__ __forceinline__ void ph_gla_b(const P& p, char* lds, int e) {
  const int tid = TIDX(), wid = tid >> 6, lane = tid & 63;
  const float* SM = (const float*)(p.ws + OFF_SM);
  float* w2S = (float*)lds;
  float* b2S = w2S + 8192;
  for (int i = tid; i < 8192; i += 512) { const int d = i >> 12, hh = (i >> 10) & 3, r = (i >> 6) & 15, j = i & 63; w2S[i] = p.gla_w2[(((size_t)e * 2 + d) * 16 + r) * 256 + hh * 64 + j]; }
  if (tid < 512) b2S[tid] = p.gla_b2[(size_t)e * 512 + tid];
  __syncthreads();
  int jb = 8 * wid; asm volatile("" : "+v"(jb));
  for (int job = GDIM() - 1 - BIDX(); job < 16 * NCH; job += GDIM()) {
    const int n = job % NCH, sq = job / NCH; const int dir = sq >> 3, b = (sq >> 2) & 1, h = sq & 3;
    const int c = dir == 0 ? n : (n < 4 ? 3 - n : 135 - n);
    const size_t row = (size_t)b * TB + (size_t)c * 64 + (dir ? 63 - lane : lane);
    const float* gp = SM + row * 64 + 16 + dir * 16;
    const f32x4 g0 = *(const f32x4*)(gp), g1 = *(const f32x4*)(gp + 4), g2 = *(const f32x4*)(gp + 8), g3 = *(const f32x4*)(gp + 12);
    const float gg_[16] = {g0[0], g0[1], g0[2], g0[3], g1[0], g1[1], g1[2], g1[3], g2[0], g2[1], g2[2], g2[3], g3[0], g3[1], g3[2], g3[3]};
    const float* wb = w2S + (dir * 4 + h) * 1024 + jb; const float* bb2 = b2S + dir * 256 + h * 64 + jb;
    f32x4 sa = *(const f32x4*)(bb2), sb = *(const f32x4*)(bb2 + 4);
#pragma unroll
    for (int r = 0; r < 16; ++r) { const f32x4 wa = *(const f32x4*)(wb + r * 64), wq = *(const f32x4*)(wb + r * 64 + 4); sa += gg_[r] * wa; sb += gg_[r] * wq; }
    float la[8];
#pragma unroll
    for (int jj = 0; jj < 4; ++jj) { const float x0 = sa[jj], x1 = sb[jj];
      la[jj] = (fminf(x0, 0.f) - log1pf(expf(-fabsf(x0)))) * 0.0625f; la[4 + jj] = (fminf(x1, 0.f) - log1pf(expf(-fabsf(x1)))) * 0.0625f; }
#pragma unroll
    for (int o = 1; o < 64; o <<= 1) {
#pragma unroll
      for (int jj = 0; jj < 8; ++jj) { const float v = __shfl_up(la[jj], o); la[jj] += lane >= o ? v : 0.f; }
    }
    h16x8 hv;
#pragma unroll
    for (int jj = 0; jj < 8; ++jj) hv[jj] = (_Float16)la[jj];
    _Float16* dst = (_Float16*)(p.ws + (dir ? OFF_B16_1 : OFF_WC)) + ((((size_t)b * 4 + h) * NCH + n) * 64 + lane) * 64 + jb;
    *(h16x8*)dst = hv;
  }
}

struct DnSet { bf16x8 fa[8]; };
template <int ROLE>
__device__ __forceinline__ void dn_scan_t(const P& p, char* lds, int job) {
  const int tid = TIDX(), wid = tid >> 6, lane = tid & 63, r32 = lane & 31, hi = lane >> 5;
  const int dir = job >> 5, b = (job >> 4) & 1, h = (job >> 2) & 3, n0 = (job & 3) * 32;
  const bf16_t* QQ = (const bf16_t*)(p.ws + OFF_D + D_QQ); const bf16_t* KT = (const bf16_t*)(p.ws + OFF_D + D_KT);
  const bf16_t* W_ = (const bf16_t*)(p.ws + OFF_D + D_W); const bf16_t* U_ = (const bf16_t*)(p.ws + OFF_HBF); const bf16_t* INTRA = (const bf16_t*)(p.ws + OFF_D + D_INTRA);
  const float* SC = (const float*)(p.ws + OFF_SC); const float* GLS = (const float*)(p.ws + OFF_GL);
  bf16_t* DNO = (bf16_t*)(p.ws + OFF_D + D_DNO);
  bf16_t* ST = (bf16_t*)lds; bf16_t* vTa = ST + 32 * 136; bf16_t* vTb = vTa + 32 * 72;
  float* scS = (float*)(vTb + 32 * 72);
  bf16_t* uS = (bf16_t*)(scS + 256);
  bf16_t* inS = uS + 2 * 64 * 40;
  for (int i = tid; i < 32 * 136; i += 512) ST[i] = 0;
  f32x16 accS = {};
  const size_t seq = ((size_t)dir * 2 + b) * 4 + h;
  const int mi = wid & 1, di = wid - 4;
  constexpr int role = ROLE;
  const int tt = tid - 256;
  DnSet fs[3]; float gls[3] = {0.f, 0.f, 0.f};
  u32x4 stU[3], stI0[3]; float stS[3] = {0.f, 0.f, 0.f};
#define DN_CH(n_) const int n__ = (n_); const int c__ = dir == 0 ? n__ : (n__ < 4 ? 3 - n__ : 135 - n__); const size_t Rb__ = (size_t)b * TB + (size_t)c__ * 64; const size_t cj__ = seq * NCH + n__;
#define DN_LOAD(S, GL, n_) do { DN_CH(n_) \
    const int ipl__ = 32 * mi + r32, tl__ = dir ? 63 - ipl__ : ipl__; \
    const bf16_t* b0__ = W_ + cj__ * 8192 + (32 * mi + r32) * 128 + hi * 8; \
    const bf16_t* b1__ = QQ + (Rb__ + tl__) * 512 + h * 128 + hi * 8; \
    const bf16_t* b2__ = KT + ((((size_t)b * 4 + h) * NCH + c__) * 128 + 32 * (wid & 3) + r32) * 64 + hi * 8; \
    const bf16_t* bs__ = role == 0 ? b0__ : (role == 1 ? b1__ : b2__); \
    _Pragma("unroll") for (int ks = 0; ks < 8; ++ks) S.fa[ks] = *(const bf16x8*)(bs__ + ks * 16); \
    GL = GLS[cj__]; } while (0)
#define DN_STAGE_LD(q_, n_) do { DN_CH(n_) (void)Rb__; \
      stU[q_] = *(const u32x4*)(U_ + cj__ * 8192 + ((tid & 255) >> 2) * 128 + n0 + (tid & 3) * 8); \
      stI0[q_] = *(const u32x4*)(INTRA + cj__ * 4096 + (tid >> 3) * 64 + (tid & 7) * 8); \
      stS[q_] = SC[cj__ * 128 + (tid & 127)]; } while (0)
#define DN_STAGE_ST(q_, bf_) do { *(u32x4*)(inS + (bf_) * 4608 + (tid >> 3) * 72 + (tid & 7) * 8) = stI0[q_]; \
      if (ROLE < 2) *(u32x4*)(uS + (bf_) * 2560 + (tid >> 2) * 40 + (tid & 3) * 8) = stU[q_]; \
      if (ROLE == 0) scS[(bf_) * 128 + tid] = stS[q_]; } while (0)
#define DN_STEP(S, GL, n_, bf_) do { DN_CH(n_) (void)cj__; \
    const float* sc__ = scS + (bf_) * 128; \
    if (role < 2) { _Pragma("unroll") for (int r = 0; r < 16; ++r) accS[r] = 0.f; } \
    if (role < 2) { const bf16_t* sb__ = ST + r32 * 136 + hi * 8; \
      _Pragma("unroll") for (int ks = 0; ks < 8; ++ks) accS = MFMA32(S.fa[ks], *(const bf16x8*)(sb__ + ks * 16), accS); \
      if (role == 0) { const bf16_t* us__ = uS + (bf_) * 2560 + r32; \
        _Pragma("unroll") for (int r = 0; r < 16; ++r) { const int ip = 32 * mi + crow(r, hi); const float vn = bf2f(us__[ip * 40]) - accS[r]; \
          vTa[r32 * 72 + ip] = f2bf(vn); const int to = dir ? 63 - ip : ip; vTb[r32 * 72 + to] = f2bf(vn * sc__[ip * 2 + 1]); } } \
      else { _Pragma("unroll") for (int r = 0; r < 16; ++r) accS[r] *= sc__[(32 * mi + crow(r, hi)) * 2]; } } \
    LBAR(); \
    if (role == 1) { const bf16_t* vb__ = vTa + r32 * 72 + hi * 8; const bf16_t* ib__ = inS + (bf_) * 4608 + (32 * mi + r32) * 72 + hi * 8; \
      _Pragma("unroll") for (int ks = 0; ks < 4; ++ks) accS = MFMA32(*(const bf16x8*)(ib__ + ks * 16), *(const bf16x8*)(vb__ + ks * 16), accS); \
      _Pragma("unroll") for (int r = 0; r < 16; ++r) { const int ip = 32 * mi + crow(r, hi), t = dir ? 63 - ip : ip; \
        DNO[((size_t)dir * MROWS + Rb__ + t) * 512 + h * 128 + n0 + r32] = f2bf(accS[r]); } } \
    else if (role == 2) { const bf16_t* vb__ = vTb + r32 * 72 + hi * 8; \
      _Pragma("unroll") for (int r = 0; r < 16; ++r) accS[r] *= GL; \
      _Pragma("unroll") for (int ks = 0; ks < 4; ++ks) accS = MFMA32(S.fa[ks], *(const bf16x8*)(vb__ + ks * 16), accS); \
      _Pragma("unroll") for (int r = 0; r < 16; ++r) ST[r32 * 136 + 32 * di + crow(r, hi)] = f2bf(accS[r]); } \
    LBAR(); } while (0)
  DN_STAGE_LD(0, 0); DN_STAGE_ST(0, 0); DN_STAGE_LD(1, 1); DN_STAGE_LD(2, 2);
  DN_LOAD(fs[0], gls[0], 0); DN_LOAD(fs[1], gls[1], 1);
  __syncthreads();
  for (int nb6 = 0; nb6 < NCH; nb6 += 6) {
#pragma unroll
    for (int k = 0; k < 6; ++k) {
      const int n = nb6 + k; const int n2 = n + 2 < NCH ? n + 2 : NCH - 1; const int n3 = n + 3 < NCH ? n + 3 : NCH - 1;
      DN_STAGE_ST((k + 1) % 3, (k + 1) & 1);
      DN_STAGE_LD(k % 3, n3);
      DN_LOAD(fs[(k + 2) % 3], gls[(k + 2) % 3], n2);
      DN_STEP(fs[k % 3], gls[k % 3], n, k & 1);
    }
  }
#undef DN_CH
#undef DN_LOAD
#undef DN_STAGE_LD
#undef DN_STAGE_ST
#undef DN_STEP
}

__device__ __forceinline__ void dn_scan(const P& p, char* lds, int job) {
  const int wid = TIDX() >> 6;
  if (wid < 2) dn_scan_t<0>(p, lds, job); else if (wid < 4) dn_scan_t<1>(p, lds, job); else dn_scan_t<2>(p, lds, job);
}

DI float fast_logsig(float s) { return fminf(s, 0.f) - __logf(1.f + __expf(-fabsf(s))); }
struct GlaRegs { h16x8 ba, bb; bf16x8 qa, qb, ka, kb, v8; };
template <int ROLE>
__device__ __forceinline__ void gla_scan_t(const P& p, char* lds, int job, int e) {
  const int tid = TIDX(), wid = tid >> 6, lane = tid & 63, r32 = lane & 31, hi = lane >> 5;
  const int dir = job >> 5, b = (job >> 4) & 1, h = (job >> 2) & 3, n0 = (job & 3) * 32;
  const bf16_t* P2 = (const bf16_t*)(p.ws + OFF_D + D_P2); const float* SM = (const float*)(p.ws + OFF_SM);
  bf16_t* GLAO = (bf16_t*)(p.ws + OFF_D + D_GLAO);
  const _Float16* B16 = (const _Float16*)(p.ws + (dir ? OFF_B16_1 : OFF_WC));
  float* w2S = (float*)lds; float* b2S = w2S + 1024; float* aLb = b2S + 64;
  bf16_t* ops = (bf16_t*)(aLb + 128);
  constexpr int OPB = (4 * 64 + 32) * 72;
  bf16_t* attp = ops + 2 * OPB;
  bf16_t* STb = attp + 2 * 32 * 72;
  for (int i = tid; i < 2 * 32 * 72; i += 512) STb[i] = 0;
  f32x16 accS = {};
  __syncthreads();
  GlaRegs RG[3];
  int jb0 = 16 * (wid & 3); asm volatile("" : "+v"(jb0));
  int vtb0 = 8 * (wid & 3) * 72 + lane; asm volatile("" : "+v"(vtb0));
#define GLA_LOAD(R, n_) do { const int n__ = (n_) < NCH ? (n_) : NCH - 1; const int c__ = dir == 0 ? n__ : (n__ < 4 ? 3 - n__ : 135 - n__); const size_t row__ = (size_t)b * TB + (size_t)c__ * 64 + (dir ? 63 - lane : lane); \
    const _Float16* bp__ = B16 + ((((size_t)b * 4 + h) * NCH + n__) * 64 + lane) * 64 + 16 * (wid & 3); R.ba = *(const h16x8*)(bp__); R.bb = *(const h16x8*)(bp__ + 8); \
    const bf16_t* pr__ = P2 + row__ * 2048; R.qa = *(const bf16x8*)(pr__ + 512 + h * 64 + 16 * (wid & 3)); R.qb = *(const bf16x8*)(pr__ + 512 + h * 64 + 16 * (wid & 3) + 8); \
    R.ka = *(const bf16x8*)(pr__ + 768 + h * 64 + 16 * (wid & 3)); R.kb = *(const bf16x8*)(pr__ + 768 + h * 64 + 16 * (wid & 3) + 8); R.v8 = *(const bf16x8*)(pr__ + 1024 + h * 128 + n0 + 8 * (wid & 3)); } while (0)
#define GLA_HALF(R, BV, QV, KV, jb) do { \
    float eqe[8], eke[8], eqi[8]; \
    _Pragma("unroll") for (int jj = 0; jj < 8; ++jj) { const int j = (jb) + jj; const float bb = (float)BV[jj]; const float bm = __int_as_float(__builtin_amdgcn_readlane(__float_as_int(bb), 32)), bl = __int_as_float(__builtin_amdgcn_readlane(__float_as_int(bb), 63)); \
      const float q_ = bf2f((bf16_t)QV[jj]) * 0.125f, k_ = bf2f((bf16_t)KV[jj]); \
      eqe[jj] = q_ * __expf(bb - bm); eke[jj] = k_ * __expf(bm - bb); eqi[jj] = q_ * __expf(bb); ksT_[j * 72 + lane] = f2bf(k_ * __expf(bl - bb)); if (lane == 63) aL_[j] = __expf(bl); } \
    *(u32x4*)(qe_ + lane * 72 + (jb)) = (u32x4){cvtpk(eqe[0], eqe[1]), cvtpk(eqe[2], eqe[3]), cvtpk(eqe[4], eqe[5]), cvtpk(eqe[6], eqe[7])}; \
    *(u32x4*)(ke_ + lane * 72 + (jb)) = (u32x4){cvtpk(eke[0], eke[1]), cvtpk(eke[2], eke[3]), cvtpk(eke[4], eke[5]), cvtpk(eke[6], eke[7])}; \
    *(u32x4*)(qi_ + lane * 72 + (jb)) = (u32x4){cvtpk(eqi[0], eqi[1]), cvtpk(eqi[2], eqi[3]), cvtpk(eqi[4], eqi[5]), cvtpk(eqi[6], eqi[7])}; } while (0)
#define GLA_PREP(R, bf_) do { bf16_t* qe_ = ops + (bf_) * OPB; bf16_t* ke_ = qe_ + 64 * 72; bf16_t* qi_ = ke_ + 64 * 72; bf16_t* ksT_ = qi_ + 64 * 72; bf16_t* vT_ = ksT_ + 64 * 72; float* aL_ = aLb + (bf_) * 64; \
    GLA_HALF(R, R.ba, R.qa, R.ka, jb0); GLA_HALF(R, R.bb, R.qb, R.kb, jb0 + 8); \
    _Pragma("unroll") for (int q_ = 0; q_ < 8; ++q_) vT_[vtb0 + q_ * 72] = (bf16_t)R.v8[q_]; } while (0)
#define GLA_MMA(n_, bf_) do { const int nq__ = (n_); const int bf = (bf_); \
      const bf16_t* qe_ = ops + bf * OPB; const bf16_t* ke_ = qe_ + 64 * 72; const bf16_t* qi_ = ke_ + 64 * 72; const bf16_t* ksT_ = qi_ + 64 * 72; const bf16_t* vT_ = ksT_ + 64 * 72; const float* aL_ = aLb + bf * 64; \
      const bf16_t* STr = STb + bf * 32 * 72; bf16_t* STw = STb + (bf ^ 1) * 32 * 72; \
      if (ROLE == 1) { \
        const int mi = wid - 4; bf16_t* attw = attp + mi * 32 * 72; \
        const int c = dir == 0 ? nq__ : (nq__ < 4 ? 3 - nq__ : 135 - nq__); const size_t Rb = (size_t)b * TB + (size_t)c * 64; \
        f32x16 acc = {}; acc = mma_rows<4>(qi_ + (32 * mi + r32) * 72 + hi * 8, STr + r32 * 72 + hi * 8, acc); \
        { f32x16 a0 = {}; a0 = mma_rows<4>(qe_ + (32 * mi + r32) * 72 + hi * 8, ke_ + r32 * 72 + hi * 8, a0); \
          _Pragma("unroll") for (int r = 0; r < 16; ++r) { const int ipl = crow(r, hi); attw[ipl * 72 + r32] = f2bf((mi == 1 || r32 <= ipl) ? a0[r] : 0.f); } \
          f32x16 a1 = {}; if (mi == 1) a1 = mma_rows<4>(qe_ + (32 + r32) * 72 + hi * 8, ke_ + (32 + r32) * 72 + hi * 8, a1); \
          _Pragma("unroll") for (int r = 0; r < 16; ++r) { const int ipl = crow(r, hi); attw[ipl * 72 + 32 + r32] = f2bf((mi == 1 && r32 <= ipl) ? a1[r] : 0.f); } } \
        asm volatile("s_waitcnt lgkmcnt(0)" ::: "memory"); \
        acc = mma_rows<4>(attw + r32 * 72 + hi * 8, vT_ + r32 * 72 + hi * 8, acc); \
        _Pragma("unroll") for (int r = 0; r < 16; ++r) { const int ip = 32 * mi + crow(r, hi), t = dir ? 63 - ip : ip; \
          GLAO[((size_t)dir * MROWS + Rb + t) * 512 + h * 128 + n0 + r32] = f2bf(acc[r]); } \
      } else { \
        const int di = wid - 6; \
        _Pragma("unroll") for (int r = 0; r < 16; ++r) accS[r] *= aL_[32 * di + crow(r, hi)]; \
        accS = mma_rows<4>(ksT_ + (32 * di + r32) * 72 + hi * 8, vT_ + r32 * 72 + hi * 8, accS); \
        _Pragma("unroll") for (int r = 0; r < 16; ++r) STw[r32 * 72 + 32 * di + crow(r, hi)] = f2bf(accS[r]); \
      } } while (0)
  GLA_LOAD(RG[0], 0);
  if (ROLE == 0) { GLA_PREP(RG[0], 0); }
  GLA_LOAD(RG[1], 1); GLA_LOAD(RG[2], 2); GLA_LOAD(RG[0], 3);
  LBAR();
  for (int nb6 = 0; nb6 < NCH; nb6 += 6) {
#pragma unroll
    for (int k = 0; k < 6; ++k) {
      const int n = nb6 + k;
      if (ROLE == 0) { if (n + 1 < NCH) { GLA_PREP(RG[(k + 1) % 3], (k + 1) & 1); } } else { GLA_MMA(n, k & 1); }
      GLA_LOAD(RG[(k + 1) % 3], n + 4);
      LBAR();
    }
  }
#undef GLA_MMA
#undef GLA_LOAD
#undef GLA_HALF
#undef GLA_PREP
}

__device__ __forceinline__ void gla_scan(const P& p, char* lds, int job, int e) {
  const int wid = TIDX() >> 6;
  if (wid < 4) gla_scan_t<0>(p, lds, job, e); else if (wid < 6) gla_scan_t<1>(p, lds, job, e); else gla_scan_t<2>(p, lds, job, e);
}

__device__ __forceinline__ void ph_merge(const P& p, int e) {
  const int tid = TIDX(), wid = tid >> 6, lane = tid & 63, l16 = lane & 15, sub = lane >> 4;
  const bf16_t* DNO = (const bf16_t*)(p.ws + OFF_D + D_DNO); const bf16_t* GLAO = (const bf16_t*)(p.ws + OFF_D + D_GLAO);
  const bf16_t* P2 = (const bf16_t*)(p.ws + OFF_D + D_P2); bf16_t* hb = (bf16_t*)(p.ws + OFF_HBF);
  f32x8 nwd = *(const f32x8*)(p.dn_norm + e * 128 + l16 * 8), nwg = *(const f32x8*)(p.gla_norm + e * 128 + l16 * 8);
  for (int R4 = (BIDX() * 8 + wid) * 4; R4 < MROWS; R4 += GDIM() * 32) {
    const size_t R = R4 + sub;
    bf16x8 a[8], bq[8], zz[8];
#pragma unroll
    for (int g = 0; g < 8; ++g) { const bf16_t* src = g < 4 ? DNO : GLAO; const int hc = (g & 3) * 128 + l16 * 8;
      a[g] = *(const bf16x8*)(src + R * 512 + hc); bq[g] = *(const bf16x8*)(src + ((size_t)MROWS + R) * 512 + hc);
      zz[g] = *(const bf16x8*)(P2 + R * 2048 + (g < 4 ? 0 : 1536) + hc); }
#pragma unroll
    for (int g = 0; g < 8; ++g) {
      float v[8]; float ss = 0.f;
#pragma unroll
      for (int j = 0; j < 8; ++j) { v[j] = bf2f((bf16_t)a[g][j]) + bf2f((bf16_t)bq[g][j]); ss += v[j] * v[j]; }
      ss += __shfl_xor(ss, 1); ss += __shfl_xor(ss, 2); ss += __shfl_xor(ss, 4); ss += __shfl_xor(ss, 8);
      const float rs = rsqrtf(ss * (1.f / 128.f) + EPSF);
      float o[8];
#pragma unroll
      for (int j = 0; j < 8; ++j) o[j] = v[j] * rs * (g < 4 ? nwd[j] : nwg[j]) * siluf(bf2f((bf16_t)zz[g][j]));
      *(u32x4*)(hb + R * 1024 + g * 128 + l16 * 8) = (u32x4){cvtpk(o[0], o[1]), cvtpk(o[2], o[3]), cvtpk(o[4], o[5]), cvtpk(o[6], o[7])};
    }
  }
}

DI float silu_fast(float x) { return x / (1.f + __expf(-x)); }
__device__ __forceinline__ void ph_ffnact(const P& p, int L) {
  bf16_t* U = (bf16_t*)(p.ws + OFF_D);
  const float* cw = p.ffn_conv + (size_t)L * 3 * DFF;
  const size_t items = (size_t)MROWS * 352, stride = (size_t)GDIM() * 512;
  for (size_t it0 = (size_t)BIDX() * 512 + TIDX(); it0 < items; it0 += 2 * stride) {
    bf16x8 zc[2], zp[2], zn[2], vv[2]; int Rr[2], cc[2]; bool ok[2];
#pragma unroll
    for (int q = 0; q < 2; ++q) {
      size_t it = it0 + q * stride; ok[q] = it < items; if (!ok[q]) it = it0;
      const int R = (int)(it / 352), c0 = (int)(it % 352) * 8; const int b = R >= TB ? 1 : 0, pp = R - b * TB;
      const bool hasp = !(pp == 0 || pp == CTXL), hasn = !(pp == CTXL - 1 || pp == TB - 1);
      Rr[q] = R; cc[q] = c0;
      zc[q] = *(const bf16x8*)(U + (size_t)R * 5632 + c0);
      zp[q] = *(const bf16x8*)(U + (size_t)(hasp ? R - 1 : R) * 5632 + c0);
      zn[q] = *(const bf16x8*)(U + (size_t)(hasn ? R + 1 : R) * 5632 + c0);
      vv[q] = *(const bf16x8*)(U + (size_t)R * 5632 + DFF + c0);
      if (!hasp) zp[q] = (bf16x8){0, 0, 0, 0, 0, 0, 0, 0};
      if (!hasn) zn[q] = (bf16x8){0, 0, 0, 0, 0, 0, 0, 0};
    }
#pragma unroll
    for (int q = 0; q < 2; ++q) {
      const int c0 = cc[q];
      const f32x8 w0 = *(const f32x8*)(cw + c0), w1 = *(const f32x8*)(cw + DFF + c0), w2 = *(const f32x8*)(cw + 2 * DFF + c0);
      float o[8];
#pragma unroll
      for (int j = 0; j < 8; ++j) { const float a = bf2f((bf16_t)zp[q][j]) * w0[j] + bf2f((bf16_t)zc[q][j]) * w1[j] + bf2f((bf16_t)zn[q][j]) * w2[j];
        o[j] = silu_fast(a) * bf2f((bf16_t)vv[q][j]); }
      if (ok[q]) *(u32x4*)(U + (size_t)Rr[q] * 5632 + DFF + c0) = (u32x4){cvtpk(o[0], o[1]), cvtpk(o[2], o[3]), cvtpk(o[4], o[5]), cvtpk(o[6], o[7])};
    }
  }
}

__device__ __forceinline__ void ph_qknorm(const P& p, char* lds, int o) {
  const int tid = TIDX(), wid = tid >> 6, lane = tid & 63, l16 = lane & 15, sub = lane >> 4;
  bf16_t* QKV = (bf16_t*)(p.ws + OFF_D);
  float* tab = (float*)lds;
  for (int i = tid; i < 4096; i += 512) { const int pos = i >> 5, f = i & 31; const float ang = (float)pos * powf(10000.f, -(float)f / 32.f); tab[2 * i] = cosf(ang); tab[2 * i + 1] = sinf(ang); }
  __syncthreads();
  const f32x8 qn = *(const f32x8*)(p.att_q_norm + o * 128 + l16 * 8), kn = *(const f32x8*)(p.att_k_norm + o * 128 + l16 * 8);
  const int f0 = (l16 & 3) * 8;
  for (int R4 = (BIDX() * 8 + wid) * 4; R4 < MROWS; R4 += GDIM() * 32) {
    const int R = R4 + sub; const int b = R >= TB ? 1 : 0, pp = R - b * TB; const bool lat = pp >= CTXL; const int t = lat ? pp - CTXL : 0;
    const int pos = (l16 < 8) ? (t >> 6) : (t & 63);
    bf16_t* base = QKV + (size_t)R * 1536 + l16 * 8;
    bf16x8 x[10];
#pragma unroll
    for (int hd = 0; hd < 10; ++hd) x[hd] = *(const bf16x8*)(base + hd * 128);
    float cs[8], sn[8];
#pragma unroll
    for (int j = 0; j < 8; ++j) { const float2 t2 = *(const float2*)(tab + 2 * (pos * 32 + f0 + j)); cs[j] = lat ? t2.x : 1.f; sn[j] = lat ? t2.y : 0.f; }
#pragma unroll
    for (int hd = 0; hd < 10; ++hd) {
      float v[8]; float ss = 0.f;
#pragma unroll
      for (int j = 0; j < 8; ++j) { v[j] = bf2f((bf16_t)x[hd][j]); ss += v[j] * v[j]; }
      ss += __shfl_xor(ss, 1); ss += __shfl_xor(ss, 2); ss += __shfl_xor(ss, 4); ss += __shfl_xor(ss, 8);
      const float rs = rsqrtf(ss * (1.f / 128.f) + EPSF);
      float ov[8];
#pragma unroll
      for (int j = 0; j < 8; ++j) { v[j] = v[j] * rs * (hd < 8 ? qn[j] : kn[j]); const float pr = __shfl_xor(v[j], 4);
        ov[j] = (l16 & 4) ? (pr * sn[j] + v[j] * cs[j]) : (v[j] * cs[j] - pr * sn[j]); }
      *(u32x4*)(base + hd * 128) = (u32x4){cvtpk(ov[0], ov[1]), cvtpk(ov[2], ov[3]), cvtpk(ov[4], ov[5]), cvtpk(ov[6], ov[7])};
    }
  }
}

__device__ __forceinline__ void qk_fused(const P& p, char* lds, int o) {
  const int tid = TIDX(), l16 = tid & 15, grp = tid >> 4;
  bf16_t* QKV = (bf16_t*)(p.ws + OFF_D);
  float* tab = (float*)lds;
  for (int i = tid; i < 4096; i += 512) { const int pos = i >> 5, f = i & 31; const float ang = (float)pos * powf(10000.f, -(float)f / 32.f); tab[2 * i] = cosf(ang); tab[2 * i + 1] = sinf(ang); }
  asm volatile("s_waitcnt vmcnt(0)" ::: "memory");
  __syncthreads();
  const int f0 = (l16 & 3) * 8;
  pg8::SchedX S; S.so.init(MROWS, 1536, GDIM(), BIDX()); S.mode = 0;
  pg8::Unit u;
  for (int ui = 0; S.next(ui, u); ++ui) {
    if (u.pn >= 5) continue;
    const f32x8 nw = *(const f32x8*)((u.pn < 4 ? p.att_q_norm : p.att_k_norm) + o * 128 + l16 * 8);
    for (int it0 = grp; it0 < 512; it0 += 128) {
      bf16x8 x[4]; bf16_t* base[4]; int pos[4]; bool lat[4];
#pragma unroll
      for (int q = 0; q < 4; ++q) { const int it = it0 + q * 32;
        const int R = u.pm * 256 + (it >> 1); const int b = R >= TB ? 1 : 0, pp = R - b * TB; lat[q] = pp >= CTXL; const int t = lat[q] ? pp - CTXL : 0;
        pos[q] = (l16 < 8) ? (t >> 6) : (t & 63);
        base[q] = QKV + (size_t)R * 1536 + u.pn * 256 + (it & 1) * 128 + l16 * 8; x[q] = *(const bf16x8*)base[q]; }
#pragma unroll
      for (int q = 0; q < 4; ++q) {
        float v[8]; float ss = 0.f;
#pragma unroll
        for (int j = 0; j < 8; ++j) { v[j] = bf2f((bf16_t)x[q][j]); ss += v[j] * v[j]; }
        ss += __shfl_xor(ss, 1); ss += __shfl_xor(ss, 2); ss += __shfl_xor(ss, 4); ss += __shfl_xor(ss, 8);
        const float rs = rsqrtf(ss * (1.f / 128.f) + EPSF);
        float ov[8];
#pragma unroll
        for (int j = 0; j < 8; ++j) { const float2 t2 = *(const float2*)(tab + 2 * (pos[q] * 32 + f0 + j)); const float cs = lat[q] ? t2.x : 1.f, sn = lat[q] ? t2.y : 0.f;
          v[j] = v[j] * rs * nw[j]; const float pr = __shfl_xor(v[j], 4);
          ov[j] = (l16 & 4) ? (pr * sn + v[j] * cs) : (v[j] * cs - pr * sn); }
        *(u32x4*)base[q] = (u32x4){cvtpk(ov[0], ov[1]), cvtpk(ov[2], ov[3]), cvtpk(ov[4], ov[5]), cvtpk(ov[6], ov[7])};
      }
    }
  }
}

namespace at {
constexpr int D = 128, NW = 8, QBLK = 32, KVBLK = 64;
constexpr float SCALE = 0.088388347648318440f, THR = 8.f;
constexpr int LDQ = 1536, LDK = 1536, LDO = 1024;
constexpr size_t SHM_V = KVBLK * D * 2, SHM_K = KVBLK * D * 2;
#define KSWZ(row, colB) ((row) * 256 + ((colB) ^ (((row) & 7) << 4)))
#define SBAR() __builtin_amdgcn_sched_barrier(0)
DI void partialSM(f32x16& p0, f32x16& p1, float& m_reg, float& mn, float& alpha) {
  constexpr float C = SCALE * 1.4426950408889634f;
  float pmax = p0[0]; for (int r = 1; r < 16; ++r) pmax = fmaxf(pmax, p0[r]); for (int r = 0; r < 16; ++r) pmax = fmaxf(pmax, p1[r]);
  { auto rr = __builtin_amdgcn_permlane32_swap(__float_as_uint(pmax), __float_as_uint(pmax), false, false);
    pmax = fmaxf(__uint_as_float(rr[0]), __uint_as_float(rr[1])); }
  if (__builtin_expect(__all(pmax - m_reg <= THR / SCALE), 1)) { mn = m_reg; alpha = 1.f; }
  else { mn = fmaxf(m_reg, pmax); alpha = __builtin_amdgcn_exp2f((m_reg - mn) * C); m_reg = mn; }
  float mnC = -mn * C;
  for (int r = 0; r < 16; ++r) p0[r] = fmaf(p0[r], C, mnC); for (int r = 0; r < 16; ++r) p1[r] = fmaf(p1[r], C, mnC);
  for (int r = 0; r < 16; ++r) p0[r] = __builtin_amdgcn_exp2f(p0[r]);
}
DI void finishSM(f32x16& p0, f32x16& p1, float alpha, float& l_reg, bf16x8& pa0, bf16x8& pa1, bf16x8& pa2, bf16x8& pa3) {
  for (int r = 0; r < 16; ++r) p1[r] = __builtin_amdgcn_exp2f(p1[r]);
  float ps = 0; for (int r = 0; r < 16; ++r) ps += p0[r]; for (int r = 0; r < 16; ++r) ps += p1[r];
  { auto rr = __builtin_amdgcn_permlane32_swap(__float_as_uint(ps), __float_as_uint(ps), false, false);
    ps = __uint_as_float(rr[0]) + __uint_as_float(rr[1]); }
  l_reg = l_reg * alpha + ps;
#define PK4(PP, BASE, OUT) do { unsigned a0 = cvtpk(PP[BASE + 0], PP[BASE + 1]), a1 = cvtpk(PP[BASE + 2], PP[BASE + 3]);   \
    unsigned b0 = cvtpk(PP[BASE + 4], PP[BASE + 5]), b1 = cvtpk(PP[BASE + 6], PP[BASE + 7]);                              \
    auto r0 = __builtin_amdgcn_permlane32_swap(a0, b0, false, false); auto r1 = __builtin_amdgcn_permlane32_swap(a1, b1, false, false); \
    u32x4 w = {r0[0], r1[0], r0[1], r1[1]}; OUT = *reinterpret_cast<bf16x8*>(&w); } while (0)
  PK4(p0, 0, pa0); PK4(p0, 8, pa1); PK4(p1, 0, pa2); PK4(p1, 8, pa3);
#undef PK4
}
DI void qkt(f32x16& p0, f32x16& p1, const bf16_t* Ks, const bf16x8* qr, int r32, int hi) {
  p0 = f32x16{}; p1 = f32x16{};
  for (int d0 = 0; d0 < 8; ++d0) { int cb = (d0 * 16 + hi * 8) * 2;
    bf16x8 b0 = *reinterpret_cast<const bf16x8*>((const char*)Ks + KSWZ(r32, cb));
    bf16x8 b1 = *reinterpret_cast<const bf16x8*>((const char*)Ks + KSWZ(32 + r32, cb));
    p0 = MFMA32(b0, qr[d0], p0);
    p1 = MFMA32(b1, qr[d0], p1); }
}
DI int v_st(int k, int c) { const int kk = (k & ~0xC) | ((k & 4) << 1) | ((k & 8) >> 1); return ((kk >> 3) * 4 + (c >> 5)) * 512 + ((kk & 7) * 32 + (c & 31)) * 2; }
DI int v_rd_base(int lane) { return ((lane & 3) << 3) | (((lane >> 2) & 3) << 6) | (((lane >> 4) & 1) << 5) | (((lane >> 5) & 1) << 8); }
constexpr int v_rd_off(int d0, int ks, int half) { return d0 * 512 + ks * 4096 + half * 2048; }
template <int OFF> DI s16x4 tr_read(int vb) {
  s16x4 r; asm volatile("ds_read_b64_tr_b16 %0, %1 offset:%2" : "=&v"(r) : "v"(vb), "i"(OFF) : "memory"); return r;
}
template <int D0> DI void pv_one(f32x16& od, int vb, bf16x8 pa0, bf16x8 pa1, bf16x8 pa2, bf16x8 pa3) {
  const s16x4 l0 = tr_read<v_rd_off(D0, 0, 0)>(vb), h0 = tr_read<v_rd_off(D0, 0, 1)>(vb), l1 = tr_read<v_rd_off(D0, 1, 0)>(vb), h1 = tr_read<v_rd_off(D0, 1, 1)>(vb);
  const s16x4 l2 = tr_read<v_rd_off(D0, 2, 0)>(vb), h2 = tr_read<v_rd_off(D0, 2, 1)>(vb), l3 = tr_read<v_rd_off(D0, 3, 0)>(vb), h3 = tr_read<v_rd_off(D0, 3, 1)>(vb);
  asm volatile("s_waitcnt lgkmcnt(0)" ::: "memory"); SBAR();
#define PK(Lx, Hx) (bf16x8){Lx[0], Lx[1], Lx[2], Lx[3], Hx[0], Hx[1], Hx[2], Hx[3]}
  od = MFMA32(pa0, PK(l0, h0), od);
  od = MFMA32(pa1, PK(l1, h1), od);
  od = MFMA32(pa2, PK(l2, h2), od);
  od = MFMA32(pa3, PK(l3, h3), od);
#undef PK
}
DI void pv_d0(f32x16* o, int vb, bf16x8 pa0, bf16x8 pa1, bf16x8 pa2, bf16x8 pa3) {
  pv_one<0>(o[0], vb, pa0, pa1, pa2, pa3); pv_one<1>(o[1], vb, pa0, pa1, pa2, pa3); pv_one<2>(o[2], vb, pa0, pa1, pa2, pa3); pv_one<3>(o[3], vb, pa0, pa1, pa2, pa3);
}
DI void attn_dense_body(const bf16_t* __restrict__ Qb, const bf16_t* __restrict__ Kh, const bf16_t* __restrict__ Vh, bf16_t* __restrict__ Ob, int seq, char* lds) {
  const int tid = TIDX(), wid = tid >> 6, lane = tid & 63, r32 = lane & 31, hi = lane >> 5;
  bf16_t* V_lds = (bf16_t*)lds; bf16_t* K_lds = (bf16_t*)(lds + 2 * SHM_V);
  float* ws = (float*)(lds + 2 * SHM_V + 2 * SHM_K) + wid * 64; float* li_l = ws; float* al_l = ws + 32;
  float m_reg = -1e30f, l_reg = 0; f32x16 o[4] = {}; bf16x8 qr[8];
  const bf16_t* Qw = Qb + (long)(wid * QBLK + r32) * LDQ + hi * 8;
#pragma unroll
  for (int d0 = 0; d0 < 8; ++d0) qr[d0] = *reinterpret_cast<const bf16x8*>(Qw + d0 * 16);
  const int sr = tid >> 4, sc = (tid & 15) * 8, vst0 = v_st(sr, sc), vst1 = v_st(32 + sr, sc);
  const int vb0 = (int)(uintptr_t)V_lds + v_rd_base(lane);
  struct { bf16x8 vs0, vs1, ks0, ks1; } sr_[2];
#define SLOAD(i, k0) do { sr_[i].vs0 = *(const bf16x8*)(&Vh[(long)((k0) + sr) * LDK + sc]); sr_[i].vs1 = *(const bf16x8*)(&Vh[(long)((k0) + 32 + sr) * LDK + sc]); \
    sr_[i].ks0 = *(const bf16x8*)(&Kh[(long)((k0) + sr) * LDK + sc]); sr_[i].ks1 = *(const bf16x8*)(&Kh[(long)((k0) + 32 + sr) * LDK + sc]); } while (0)
#define SWRITE(bq, i) do { *(bf16x8*)((char*)V_lds + (bq) * SHM_V + vst0) = sr_[i].vs0;          \
    *(bf16x8*)((char*)V_lds + (bq) * SHM_V + vst1) = sr_[i].vs1; int kc = sc * 2;               \
    *(bf16x8*)((char*)K_lds + (bq) * SHM_K + KSWZ(sr, kc)) = sr_[i].ks0;                       \
    *(bf16x8*)((char*)K_lds + (bq) * SHM_K + KSWZ(32 + sr, kc)) = sr_[i].ks1; } while (0)
#define SWAIT() asm volatile("s_waitcnt vmcnt(4)" ::: "memory")
#define RESC(a) do { if (__any((a) < 1.f)) { if (hi == 0) al_l[r32] = (a); asm volatile("s_waitcnt lgkmcnt(0)" ::: "memory"); \
    for (int d = 0; d < 4; ++d) for (int r = 0; r < 16; ++r) o[d][r] *= al_l[crow(r, hi)]; } } while (0)
  f32x16 pA0, pA1, pB0, pB1; float mnA, mnB, alA, alB; bf16x8 pa0, pa1, pa2, pa3; const int NT = seq / KVBLK;
  constexpr int SE = 0, SO = 1;
  SLOAD(SE, 0); asm volatile("s_waitcnt vmcnt(0)" ::: "memory"); SWRITE(0, SE); __syncthreads();
  qkt(pA0, pA1, K_lds, qr, r32, hi); partialSM(pA0, pA1, m_reg, mnA, alA);
  SLOAD(SO, KVBLK); if (2 < NT) SLOAD(SE, 2 * KVBLK);
  SWAIT(); SWRITE(1, SO); __syncthreads();
  for (int j = 1; j + 1 < NT; j += 2) {
    SBAR(); qkt(pB0, pB1, (bf16_t*)((char*)K_lds + SHM_K), qr, r32, hi);
    finishSM(pA0, pA1, alA, l_reg, pa0, pa1, pa2, pa3); SBAR();
    SLOAD(SO, (j + 2) * KVBLK); SBAR();
    pv_d0(o, vb0, pa0, pa1, pa2, pa3); partialSM(pB0, pB1, m_reg, mnB, alB);
    __syncthreads(); SWAIT(); SWRITE(0, SE);
    RESC(alB); __syncthreads();
    SBAR(); qkt(pA0, pA1, K_lds, qr, r32, hi);
    finishSM(pB0, pB1, alB, l_reg, pa0, pa1, pa2, pa3); SBAR();
    if (j + 3 < NT) SLOAD(SE, (j + 3) * KVBLK); SBAR();
    pv_d0(o, vb0 + (int)SHM_V, pa0, pa1, pa2, pa3); partialSM(pA0, pA1, m_reg, mnA, alA);
    __syncthreads(); SWAIT(); SWRITE(1, SO);
    RESC(alA); __syncthreads();
  }
  SBAR(); qkt(pB0, pB1, (bf16_t*)((char*)K_lds + SHM_K), qr, r32, hi);
  finishSM(pA0, pA1, alA, l_reg, pa0, pa1, pa2, pa3); SBAR();
  pv_d0(o, vb0, pa0, pa1, pa2, pa3); partialSM(pB0, pB1, m_reg, mnB, alB);
  __syncthreads(); RESC(alB);
  finishSM(pB0, pB1, alB, l_reg, pa0, pa1, pa2, pa3); SBAR();
  pv_d0(o, vb0 + (int)SHM_V, pa0, pa1, pa2, pa3);
  if (hi == 0) li_l[r32] = l_reg; asm volatile("s_waitcnt lgkmcnt(0)" ::: "memory");
  float rli[16];
#pragma unroll
  for (int r = 0; r < 16; ++r) rli[r] = __builtin_amdgcn_rcpf(li_l[crow(r, hi)]);
  bf16_t* Ow = Ob + (long)(wid * QBLK) * LDO;
#pragma unroll
  for (int r = 0; r < 16; ++r) { int orow = crow(r, hi);
    for (int d0 = 0; d0 < 4; ++d0) Ow[(long)orow * LDO + d0 * 32 + r32] = f2bf(o[d0][r] * rli[r]); }
#undef SLOAD
#undef SWRITE
#undef SWAIT
#undef RESC
}
}

__device__ __forceinline__ void ph_attn(const P& p, char* lds, bool need_ctx) {
  const bf16_t* QKV = (const bf16_t*)(p.ws + OFF_D); bf16_t* hb = (bf16_t*)(p.ws + OFF_HBF);
  const int nunits = need_ctx ? 528 : 512;
  for (int u = BIDX(); u < nunits; u += GDIM()) {
    int b, h, seq; size_t qrow;
    if (u < 512) { b = u >> 8; const int rem = u & 255; h = rem >> 5; qrow = (size_t)b * TB + CTXL + (size_t)(rem & 31) * 256; seq = TB; }
    else { const int uu = u - 512; b = uu >> 3; h = uu & 7; qrow = (size_t)b * TB; seq = CTXL; }
    const int kvh = h >> 2;
    const bf16_t* Kh = QKV + (size_t)b * TB * 1536 + 1024 + kvh * 128;
    const bf16_t* Vh = QKV + (size_t)b * TB * 1536 + 1280 + kvh * 128;
    at::attn_dense_body(QKV + qrow * 1536 + h * 128, Kh, Vh, hb + qrow * 1024 + h * 128, seq, lds);
    __syncthreads();
  }
}

__device__ __forceinline__ void ph_final(const P& p) {
  const int tid = TIDX(), wid = tid >> 6, lane = tid & 63;
  const float* xr = (const float*)(p.ws + OFF_XRES);
  for (int q = BIDX() * 8 + wid; q < 2 * LAT; q += GDIM() * 8) {
    const int b = q >> 13, t = q & (LAT - 1); const float* row = xr + ((size_t)b * TB + CTXL + t) * 1024;
    f32x4 v[4]; float ss = 0.f;
#pragma unroll
    for (int i = 0; i < 4; ++i) { v[i] = *(const f32x4*)(row + i * 256 + lane * 4); ss += v[i][0] * v[i][0] + v[i][1] * v[i][1] + v[i][2] * v[i][2] + v[i][3] * v[i][3]; }
    ss = wave_sum(ss); const float rs = rsqrtf(ss * (1.f / 1024.f) + EPSF);
#pragma unroll
    for (int i = 0; i < 4; ++i) { const int c0 = i * 256 + lane * 4; const f32x4 g = *(const f32x4*)(p.final_norm + c0); f32x4 o = v[i] * rs * g; *(f32x4*)(p.out + (size_t)q * 1024 + c0) = o; }
  }
}

#ifndef ONLY_PH
#define ONLY_PH -1
#endif
#define EN(x) (ONLY_PH < 0 || ONLY_PH == (x))
#ifndef PROBE_REP
#define PROBE_REP -1
#endif
#define RUN(cls, ...) do { if (EN(cls)) { for (int rep_ = 0; rep_ < ((PROBE_REP == (cls)) ? 2 : 1); ++rep_) { if (rep_) xcd_barrier(*xbp); __VA_ARGS__; } } } while (0)
enum { OP_INIT, OP_N1FULL, OP_IN, OP_PREP, OP_D1, OP_SCAN, OP_MERGE, OP_OUTLAT, OP_OUTCTX_N2LAT, OP_N2CTX, OP_UP, OP_ACT, OP_DOWNLAT, OP_DOWNCTX_N1LAT, OP_N1CTX,
       OP_QKV, OP_QKNORM, OP_ATTN, OP_N2FULL, OP_FINAL };
constexpr int NPHASES = 46;
__device__ __forceinline__ void decode_phase(int ph, int& op, int& L) {
  if (ph == 0) { op = OP_INIT; L = 0; return; }
  if (ph == NPHASES - 1) { op = OP_FINAL; L = 3; return; }
  int q = ph - 1;
  if (q < 14) { L = 0; if (q == 0) { op = OP_N1FULL; return; } q -= 1; }
  else if (q < 24) { L = 1; q -= 14; }
  else if (q < 37) { L = 2; q -= 24; }
  else { L = 3; q -= 37; }
  if ((L & 1) == 0) {
    if (q < 5) { op = OP_IN + q; return; }
    q -= 5;
  } else {
    if (q < 2) { op = q == 0 ? OP_QKV : OP_ATTN; return; }
    q -= 2;
  }
  if (L < 3) { const int t[8] = {OP_OUTLAT, OP_OUTCTX_N2LAT, OP_N2CTX, OP_UP, OP_ACT, OP_DOWNLAT, OP_DOWNCTX_N1LAT, OP_N1CTX}; op = t[q]; }
  else { const int t[5] = {OP_OUTLAT, OP_N2FULL, OP_UP, OP_ACT, OP_DOWNLAT}; op = t[q]; }
}
__device__ __forceinline__ void run_phase(const P& p0, int ph, char* lds, const XcdBarrier* xbp) {
  P p = p0; { typedef __attribute__((address_space(1))) char gchar_t; size_t wi = (size_t)p0.ws; asm volatile("" : "+s"(wi)); p.ws = (char*)(gchar_t*)wi; }
  int op, L; decode_phase(ph, op, L);
  const int e = L >> 1, o = L >> 1;
  bf16_t* W1 = (bf16_t*)(p.ws + OFF_WC); bf16_t* W2 = (bf16_t*)(p.ws + OFF_WC + WC_W2); bf16_t* W3 = (bf16_t*)(p.ws + OFF_W3);
  bf16_t* hb = (bf16_t*)(p.ws + OFF_HBF); float* xr = (float*)(p.ws + OFF_XRES);
  const float* mods = (const float*)(p.ws + OFF_MODS) + (size_t)L * 3 * 6144;
  float* PART = (float*)(p.ws + OFF_D + D_END_F);
#define CVT_MIX(LL, skipb) do { const int L_ = (LL); if ((L_ & 1) == 0) { cvt_weight(p.rec_w_in + (size_t)(L_ >> 1) * 1024 * 3632, W1, 1024, 3632, NREC, true, skipb); cvt_weight(p.rec_w_out + (size_t)(L_ >> 1) * 1024 * 1024, W3, 1024, 1024, 1024, false, skipb); } \
    else { cvt_weight(p.att_w_qkv + (size_t)(L_ >> 1) * 1024 * 1536, W1, 1024, 1536, 1536, false, skipb); cvt_weight(p.att_w_out + (size_t)(L_ >> 1) * 1024 * 1024, W3, 1024, 1024, 1024, false, skipb); } } while (0)
#define CVT_FFN(LL, skipb) do { const int L_ = (LL); cvt_weight(p.ffn_w_up + (size_t)L_ * 1024 * 5632, W1, 1024, 5632, 5632, false, skipb); cvt_weight(p.ffn_w_down + (size_t)L_ * DFF * 1024, W2, DFF, 1024, 1024, false, skipb); } while (0)
  switch (op) {
    case OP_INIT: RUN(0, ph_init(p, lds); CVT_MIX(0, 0)); break;
    case OP_N1FULL: RUN(1, ph_norm(p, L, 0, 0, 0)); break;
    case OP_IN: RUN(2, gemm8(lds, hb, 1024, W1, 1024, NREC, 0, EpiRec8{(bf16_t*)(p.ws + OFF_D + D_P1), (bf16_t*)(p.ws + OFF_D + D_P2), (float*)(p.ws + OFF_SM)})); break;
    case OP_PREP: RUN(3, ph_dnprep(p, lds, e)); break;
    case OP_D1: RUN(4, ph_dn_d1(p, lds); ph_gla_b(p, lds, e)); break;
    case OP_SCAN: RUN(5, if (BIDX() < 64) { dn_scan(p, lds, BIDX()); } else if (BIDX() < 128) { gla_scan(p, lds, BIDX() - 64, e); });
        if (PROBE_REP == 55) { xcd_barrier(*xbp); if (BIDX() < 64) { dn_scan(p, lds, BIDX()); } }
        if (PROBE_REP == 56) { xcd_barrier(*xbp); if (BIDX() >= 64 && BIDX() < 128) { gla_scan(p, lds, BIDX() - 64, e); } }
        break;
    case OP_MERGE: RUN(7, ph_merge(p, e)); break;
    case OP_QKV: if (EN(2)) { gemm8(lds, hb, 1024, W1, 1024, 1536, 0, EpiBf8{(bf16_t*)(p.ws + OFF_D), 1536}); qk_fused(p, lds, o); } break;
    case OP_ATTN: RUN(10, ph_attn(p, lds, L != 3)); break;
    case OP_OUTLAT: if (EN(2)) { gemm8(lds, hb, 1024, W3, 1024, 1024, 1, EpiRes8{xr, mods + 2 * 1024}); if (L == 3) CVT_FFN(L, 0); } break;
    case OP_OUTCTX_N2LAT: if (EN(2)) { if (BIDX() < 128) gemm_ctx_split(lds, hb, 1024, W3, 1024, 128, PART); ph_norm(p, L, 1, 1, 0); CVT_FFN(L, 0); } break;
    case OP_N2CTX: if (EN(1)) ph_ctx_fold_norm(p, L, 1, PART, 8, mods + 2 * 1024); break;
    case OP_N2FULL: if (EN(1)) ph_norm(p, L, 1, 0, 0); break;
    case OP_UP: RUN(2, gemm8(lds, hb, 1024, W1, 1024, 5632, L == 3 ? 1 : 0, EpiBf8{(bf16_t*)(p.ws + OFF_D), 5632})); break;
    case OP_ACT: if (EN(8)) ph_ffnact(p, L); break;
    case OP_DOWNLAT: if (EN(2)) gemm8(lds, (const bf16_t*)(p.ws + OFF_D) + DFF, 5632, W2, DFF, 1024, 1, EpiRes8{xr, mods + 5 * 1024}); break;
    case OP_DOWNCTX_N1LAT: if (EN(2)) { if (BIDX() < 176) gemm_ctx_split(lds, (const bf16_t*)(p.ws + OFF_D) + DFF, 5632, W2, DFF, 256, PART); ph_norm(p, L + 1, 0, 1, 0); CVT_MIX(L + 1, 0); } break;
    case OP_N1CTX: if (EN(1)) ph_ctx_fold_norm(p, L + 1, 0, PART, 11, mods + 5 * 1024); break;
    case OP_FINAL: if (EN(11)) ph_final(p); break;
  }
#undef CVT_MIX
#undef CVT_FFN
}

template <bool COOP>
__global__ void __launch_bounds__(512, 1) mk_kernel(P p, int ph0, int ph1) {
  extern __shared__ __attribute__((aligned(16))) char smem[];
  if constexpr (COOP) {
    if (ph0 < 0) cg::this_grid().sync();
    volatile LAS unsigned* st = (volatile LAS unsigned*)(smem + LDS_BYTES);
    if (threadIdx.x < 4) st[threadIdx.x] = 0u;
    __syncthreads();
    XcdBarrier xb = xcd_barrier_post((unsigned*)(p.ws + OFF_BAR), st);
    for (int ph = ph0; ph < ph1; ++ph) {
      run_phase(p, ph, smem, &xb);
      if (ph + 1 < ph1) xcd_barrier(xb);
      if (PROBE_REP == 99 && ph == 0) { for (int q = 0; q < 20; ++q) xcd_barrier(xb); }
    }
  } else {
    for (int ph = ph0; ph < ph1; ++ph) run_phase(p, ph, smem, nullptr);
  }
}

extern "C" void kernel_launch(void* const* d_in, const int* in_sizes, int n_in, void* d_out, int out_size, void* d_ws, size_t ws_size, hipStream_t stream) {
  if (n_in != 23 || ws_size < WS_NEED) { fprintf(stderr, "kernel_launch: bad n_in %d or ws %zu < %zu\n", n_in, ws_size, (size_t)WS_NEED); return; }
  P p{};
  const float** f = (const float**)&p;
  for (int i = 0; i < 23; ++i) f[i] = (const float*)d_in[i];
  p.out = (float*)d_out; p.ws = (char*)d_ws;
  static int inited = 0, grid_blocks = 0;
  if (!inited) {
    hipFuncSetAttribute((const void*)mk_kernel<true>, hipFuncAttributeMaxDynamicSharedMemorySize, LDS_BYTES + 16);
#if !MK_COOP
    hipFuncSetAttribute((const void*)mk_kernel<false>, hipFuncAttributeMaxDynamicSharedMemorySize, LDS_BYTES);
#endif
    int dev = 0, cus = 0, per_cu = 0;
    hipGetDevice(&dev); hipDeviceGetAttribute(&cus, hipDeviceAttributeMultiprocessorCount, dev);
    hipOccupancyMaxActiveBlocksPerMultiprocessor(&per_cu, mk_kernel<true>, 512, LDS_BYTES + 16);
    if (per_cu > 1) per_cu = 1;
    grid_blocks = cus * per_cu; if (grid_blocks > 256) grid_blocks = 256; if (grid_blocks < 128) grid_blocks = 128;
    inited = 1;
  }
#if MK_COOP
  int ph0 = 0, ph1 = NPHASES;
  void* args[] = {&p, &ph0, &ph1};
  hipMemsetAsync((char*)d_ws + OFF_BAR, 0, 3456 * 4, stream);
  hipError_t er = hipLaunchCooperativeKernel((const void*)mk_kernel<true>, dim3(grid_blocks), dim3(512), args, LDS_BYTES + 16, stream);
  if (er != hipSuccess) fprintf(stderr, "cooperative launch failed: %s (grid %d)\n", hipGetErrorString(er), grid_blocks);
#else
  for (int ph = 0; ph < NPHASES; ++ph) hipLaunchKernelGGL(mk_kernel<false>, dim3(256), dim3(512), LDS_BYTES, stream, p, ph, ph + 1);
#endif
}
```

```cpp
#include <hip/hip_runtime.h>
#include <hip/hip_cooperative_groups.h>
#include <cstdio>
#include <cstdint>
namespace cg = cooperative_groups;

#ifndef MK_COOP
#define MK_COOP 1
#endif

typedef unsigned short bf16_t;
typedef short bf16x8 __attribute__((ext_vector_type(8)));
typedef short s16x4 __attribute__((ext_vector_type(4)));
typedef float f32x16 __attribute__((ext_vector_type(16)));
typedef float f32x8 __attribute__((ext_vector_type(8)));
typedef float f32x4 __attribute__((ext_vector_type(4)));
typedef unsigned u32x4 __attribute__((ext_vector_type(4)));
#define DI __device__ __forceinline__
#define LBAR() do { asm volatile("s_waitcnt lgkmcnt(0)" ::: "memory"); __builtin_amdgcn_s_barrier(); asm volatile("" ::: "memory"); } while (0)
#define MFMA32(a, b, c) __builtin_amdgcn_mfma_f32_32x32x16_bf16((a), (b), (c), 0, 0, 0)

constexpr int DM = 1024, TB = 8448, CTXL = 256, LAT = 8192, MROWS = 2 * TB;
constexpr int NCH = 132;
constexpr int DFF = 2816;
constexpr int NREC = 3840;
constexpr float EPSF = 1e-6f;

constexpr size_t AL(size_t x) { return (x + 255) / 256 * 256; }
constexpr size_t OFF_XRES = 0;
constexpr size_t OFF_HBF = OFF_XRES + AL((size_t)MROWS * DM * 4);
constexpr size_t OFF_WC = OFF_HBF + AL((size_t)MROWS * DM * 2);
constexpr size_t WC_W2 = (size_t)5632 * 1024 * 2;
constexpr size_t OFF_MODS = OFF_WC + AL(WC_W2 + (size_t)1024 * 2816 * 2);
constexpr size_t OFF_SM = OFF_MODS + AL((size_t)4 * 3 * 6144 * 4);
constexpr size_t OFF_GB = OFF_SM + AL((size_t)MROWS * 64 * 4);
constexpr size_t OFF_SC = OFF_GB + AL((size_t)MROWS * 16 * 4);
constexpr size_t OFF_GL = OFF_SC + AL((size_t)16 * NCH * 64 * 2 * 4);
constexpr size_t OFF_D = OFF_GL + AL((size_t)16 * NCH * 4);
constexpr size_t D_P1 = 0;
constexpr size_t D_W = 0;
constexpr size_t D_INTRA = D_W + (size_t)16 * NCH * 64 * 128 * 2;
constexpr size_t D_P2 = D_P1 + (size_t)MROWS * 1536 * 2;
constexpr size_t D_QQ = D_P2 + (size_t)MROWS * 2048 * 2;
constexpr size_t D_QK = D_QQ + (size_t)MROWS * 512 * 2;
constexpr size_t D_QV = D_QK + (size_t)MROWS * 512 * 2;
constexpr size_t D_DNO = D_QK;
constexpr size_t D_KT = D_QV + (size_t)MROWS * 512 * 2;
constexpr size_t D_GLAO = D_KT + (size_t)MROWS * 512 * 2;
constexpr size_t D_END_E = D_GLAO + (size_t)2 * MROWS * 512 * 2;
constexpr size_t D_END_F = (size_t)MROWS * 5632 * 2;
constexpr size_t OFF_B16_1 = OFF_D + (D_END_E > D_END_F ? D_END_E : D_END_F);
constexpr size_t B16_BYTES = (size_t)8 * NCH * 64 * 64 * 2;
constexpr size_t OFF_BAR = OFF_B16_1 + AL(B16_BYTES);
constexpr size_t OFF_W3 = OFF_BAR + AL(3456 * 4);
constexpr size_t WS_NEED = OFF_W3 + (size_t)1024 * 1024 * 2;
constexpr int LDS_BYTES = 132 * 1024;

struct P {
  const float *x, *c, *ctx, *c_ctx, *mod_w, *mod_b, *rec_w_in, *rec_conv, *dn_a_log, *dn_dt_bias, *dn_norm, *gla_w2, *gla_b2, *gla_norm,
      *rec_w_out, *att_w_qkv, *att_q_norm, *att_k_norm, *att_w_out, *ffn_w_up, *ffn_conv, *ffn_w_down, *final_norm;
  float* out;
  char* ws;
};

DI int TIDX() { int t = threadIdx.x; asm volatile("" : "+v"(t)); return t; }
DI int BIDX() { int t = blockIdx.x; asm volatile("" : "+s"(t)); return t; }
DI int GDIM() { int t = gridDim.x; asm volatile("" : "+s"(t)); return t; }
DI float bf2f(bf16_t v) { return __uint_as_float(((unsigned)v) << 16); }
DI bf16_t f2bf(float x) { unsigned u = __float_as_uint(x); u += 0x7fffu + ((u >> 16) & 1u); return (bf16_t)(u >> 16); }
typedef __bf16 bf16n2 __attribute__((ext_vector_type(2)));
DI unsigned cvtpk(float lo, float hi) { const bf16n2 v = {(__bf16)lo, (__bf16)hi}; return __builtin_bit_cast(unsigned, v); }
DI int crow(int r, int hi) { return (r & 3) + 8 * (r >> 2) + 4 * hi; }
DI float siluf(float x) { return x / (1.f + expf(-x)); }
DI float sigmf(float x) { return 1.f / (1.f + expf(-x)); }
DI float softplusf(float x) { return fmaxf(x, 0.f) + log1pf(expf(-fabsf(x))); }
DI float wave_sum(float v) {
#pragma unroll
  for (int o = 32; o > 0; o >>= 1) v += __shfl_xor(v, o);
  return v;
}
DI int modrow_of(int R) { const int b = R >= TB ? 1 : 0; const int pp = R - b * TB; return pp < CTXL ? 2 : b; }
template <int KS>
DI f32x16 mma_rows(const bf16_t* arow, const bf16_t* brow, f32x16 acc) {
#pragma unroll
  for (int ks = 0; ks < KS; ++ks) {
    const bf16x8 a = *reinterpret_cast<const bf16x8*>(arow + ks * 16);
    const bf16x8 b = *reinterpret_cast<const bf16x8*>(brow + ks * 16);
    acc = MFMA32(a, b, acc);
  }
  return acc;
}

#define XB_TMO      128
#define XB_XCNT(j)  (256  + 64 * (j))
#define XB_XSUB(j)  (1280 + 64 * (j))
#define XB_XGEN(j)  (2304 + 64 * (j))
#define XB_TOP      3328
#define XB_TOPGEN   3392
#define XCD_BAR_WORDS 3456
#define XB_SPIN_CAP (1u << 18)
#define LAS __attribute__((address_space(3)))
DI unsigned xb_ld(unsigned* p)              { return __hip_atomic_load(p, __ATOMIC_RELAXED, __HIP_MEMORY_SCOPE_AGENT); }
DI unsigned xb_add(unsigned* p, unsigned v) { return __hip_atomic_fetch_add(p, v, __ATOMIC_RELAXED, __HIP_MEMORY_SCOPE_AGENT); }
DI unsigned xb_xcc_id() { return (unsigned)__builtin_amdgcn_s_getreg((3 << 11) | 20) & 0xFu; }
#define XB_SPIN(cond, bar) do { unsigned _sp = 0; while (cond) { __builtin_amdgcn_s_sleep(1); \
    if ((++_sp & 255u) == 0u) { if (xb_ld(&(bar)[XB_TMO])) break; if (_sp > XB_SPIN_CAP) { atomicAdd(&(bar)[XB_TMO], 1u); break; } } } } while (0)
struct XcdBarrier { unsigned* bar; unsigned x; volatile LAS unsigned* st; };
DI XcdBarrier xcd_barrier_post(unsigned* bar, volatile LAS unsigned* st) {
    XcdBarrier b; b.bar = bar; b.x = xb_xcc_id(); b.st = st;
    if (threadIdx.x == 0) (void)xb_add(&bar[XB_XCNT(b.x)], 1u);
    return b;
}
DI void xcd_barrier_complete(unsigned* bar, unsigned x, unsigned& nloc, unsigned& nx) {
    const unsigned G = gridDim.x * gridDim.y * gridDim.z;
    unsigned sum, cnt, mine, sp = 0u;
    for (;;) {
        sum = 0u; cnt = 0u; mine = 0u;
#pragma unroll
        for (unsigned j = 0; j < 16; ++j) { const unsigned c = xb_ld(&bar[XB_XCNT(j)]); sum += c; cnt += (c > 0u) ? 1u : 0u; mine = (j == x) ? c : mine; }
        if (sum == G) break;
        __builtin_amdgcn_s_sleep(1);
        if ((++sp & 255u) == 0u) { if (xb_ld(&bar[XB_TMO])) break; if (sp > XB_SPIN_CAP) { atomicAdd(&bar[XB_TMO], 1u); break; } }
    }
    nloc = mine > 0u ? mine : 1u; nx = cnt > 0u ? cnt : 1u;
}
DI void xcd_barrier(const XcdBarrier& b) {
    asm volatile("s_waitcnt vmcnt(0)" ::: "memory");
    __syncthreads();
    if (threadIdx.x == 0) {
        unsigned* bar = b.bar;
        __builtin_amdgcn_s_waitcnt(0);
        unsigned nloc = b.st[0], nx = b.st[1];
        if (nloc == 0u) { xcd_barrier_complete(bar, b.x, nloc, nx); b.st[0] = nloc; b.st[1] = nx; }
        const unsigned old = xb_add(&bar[XB_XSUB(b.x)], 1u);
        const unsigned gen = old / nloc;
        if (old + 1u == (gen + 1u) * nloc) {
            __builtin_amdgcn_fence(__ATOMIC_RELEASE, "agent");
            asm volatile("s_waitcnt vmcnt(0)" ::: "memory");
            const unsigned og = xb_add(&bar[XB_TOP], 1u);
            const unsigned tg = og / nx;
            if (og + 1u == (tg + 1u) * nx) xb_add(&bar[XB_TOPGEN], 1u);
            else XB_SPIN(xb_ld(&bar[XB_TOPGEN]) == tg, bar);
            __builtin_amdgcn_fence(__ATOMIC_ACQUIRE, "agent");
            xb_add(&bar[XB_XGEN(b.x)], 1u);
            asm volatile("s_waitcnt vmcnt(0)" ::: "memory");
        } else {
            XB_SPIN(xb_ld(&bar[XB_XGEN(b.x)]) == gen, bar);
            __builtin_amdgcn_fence(__ATOMIC_ACQUIRE, "agent");
            asm volatile("s_waitcnt vmcnt(0)" ::: "memory");
        }
    }
    __syncthreads();
}

__device__ __forceinline__ void ph_init(const P& p, char* lds) {
  const int tid = TIDX();
  float* sc = (float*)lds;
  float* red = sc + 3072;
  for (int i = tid; i < 3072; i += 512) { const int r = i >> 10, k = i & 1023; const float v = r < 2 ? p.c[r * 1024 + k] : p.c_ctx[k]; sc[i] = siluf(v); }
  __syncthreads();
  float* mods = (float*)(p.ws + OFF_MODS);
  for (int job = BIDX(); job < 192; job += GDIM()) {
    const int col = job * 128 + (tid & 127), kq = tid >> 7;
    const int L = col / 6144, cl = col - L * 6144;
    const float* w = p.mod_w + ((size_t)L * 1024 + kq * 256) * 6144 + cl;
    float a0 = 0.f, a1 = 0.f, a2 = 0.f;
#pragma unroll 8
    for (int k = 0; k < 256; ++k) { const float wv = w[(size_t)k * 6144]; const int kk = kq * 256 + k; a0 += sc[kk] * wv; a1 += sc[1024 + kk] * wv; a2 += sc[2048 + kk] * wv; }
    red[(kq * 3 + 0) * 128 + (tid & 127)] = a0; red[(kq * 3 + 1) * 128 + (tid & 127)] = a1; red[(kq * 3 + 2) * 128 + (tid & 127)] = a2;
    __syncthreads();
    if (tid < 384) { const int r = tid >> 7, cc = tid & 127; const int c2 = job * 128 + cc; const int L2 = c2 / 6144, cl2 = c2 - L2 * 6144;
      const float s = red[(0 * 3 + r) * 128 + cc] + red[(1 * 3 + r) * 128 + cc] + red[(2 * 3 + r) * 128 + cc] + red[(3 * 3 + r) * 128 + cc] + p.mod_b[L2 * 6144 + cl2];
      mods[((size_t)L2 * 3 + r) * 6144 + cl2] = s; }
    __syncthreads();
  }
  f32x4* xr = (f32x4*)(p.ws + OFF_XRES);
  for (size_t i = (size_t)BIDX() * 512 + tid; i < (size_t)MROWS * 256; i += (size_t)GDIM() * 512) {
    const int R = (int)(i >> 8), c4 = (int)(i & 255); const int b = R >= TB ? 1 : 0, pp = R - b * TB;
    const float* src = pp < CTXL ? p.ctx + ((size_t)b * CTXL + pp) * 1024 : p.x + ((size_t)b * LAT + (pp - CTXL)) * 1024;
    xr[i] = *(const f32x4*)(src + c4 * 4);
  }
}

DI int rec_src_col(int n) { if (n < 2048) return n; if (n < 3584) return n + 16; if (n < 3600) return 2048 + (n - 3584); if (n < 3632) return n; return -1; }
__device__ __forceinline__ void cvt_weight(const float* __restrict__ W, bf16_t* __restrict__ Wt, int K, int Nsrc, int Npad, bool perm, int skipb) {
  const size_t items = (size_t)Npad * (K >> 3);
  const int bid = BIDX() - skipb, nb = GDIM() - skipb;
  if (bid < 0) return;
  for (size_t it = (size_t)bid * 512 + TIDX(); it < items; it += (size_t)nb * 512) {
    const int n = (int)(it % Npad), kb = (int)(it / Npad);
    const int s = perm ? rec_src_col(n) : n;
    float v[8];
#pragma unroll
    for (int j = 0; j < 8; ++j) v[j] = s >= 0 ? W[(size_t)(kb * 8 + j) * Nsrc + s] : 0.f;
    u32x4 w = {cvtpk(v[0], v[1]), cvtpk(v[2], v[3]), cvtpk(v[4], v[5]), cvtpk(v[6], v[7])};
    *(u32x4*)(Wt + (size_t)n * K + kb * 8) = w;
  }
}

__device__ __forceinline__ void gemm_ctx_split(char* lds, const bf16_t* __restrict__ A, int lda, const bf16_t* __restrict__ Bt, int ldb, int Ks, float* __restrict__ PART) {
  const int tid = TIDX(), wid = tid >> 6, lane = tid & 63, r32 = lane & 31, hi = lane >> 5;
  const int wm = wid >> 1, wn = wid & 1;
  const int nk = Ks >> 6;
  constexpr int RS = 144, ASZ = 256 * RS, BSZ = 128 * RS, STG = ASZ + BSZ;
  const int srow = tid >> 3, spc = tid & 7;
  const int w = BIDX(); const int ks = w >> 4, j = w & 15; const int pm = (j >> 3) ? 33 : 0, pn = j & 7;
  const bf16_t* Ab = A + (size_t)(pm * 256 + srow) * lda + (size_t)ks * Ks + spc * 8;
  const bf16_t* Bb = Bt + (size_t)(pn * 128 + srow) * ldb + (size_t)ks * Ks + spc * 8;
  f32x16 acc00 = {}, acc01 = {}, acc10 = {}, acc11 = {};
  bf16x8 ra0, ra1, ra2, ra3, rb0, rb1;
#define GLOAD(kt) do { const int ko = (kt) * 64; ra0 = *(const bf16x8*)(Ab + ko); ra1 = *(const bf16x8*)(Ab + (size_t)64 * lda + ko); ra2 = *(const bf16x8*)(Ab + (size_t)128 * lda + ko); \
    ra3 = *(const bf16x8*)(Ab + (size_t)192 * lda + ko); rb0 = *(const bf16x8*)(Bb + ko); rb1 = *(const bf16x8*)(Bb + (size_t)64 * ldb + ko); } while (0)
#define SWRITE(buf) do { char* sb = lds + (buf) * STG + srow * RS + spc * 16; *(bf16x8*)(sb) = ra0; *(bf16x8*)(sb + 64 * RS) = ra1; *(bf16x8*)(sb + 128 * RS) = ra2; *(bf16x8*)(sb + 192 * RS) = ra3; \
    *(bf16x8*)(sb + ASZ) = rb0; *(bf16x8*)(sb + ASZ + 64 * RS) = rb1; } while (0)
  GLOAD(0); SWRITE(0); __syncthreads();
  for (int kt = 0; kt < nk; ++kt) {
    const int cur = kt & 1;
    if (kt + 1 < nk) GLOAD(kt + 1);
    const char* ab = lds + cur * STG + (64 * wm + r32) * RS + hi * 16;
    const char* bb = lds + cur * STG + ASZ + (64 * wn + r32) * RS + hi * 16;
#pragma unroll
    for (int k4 = 0; k4 < 4; ++k4) {
      const bf16x8 a0 = *(const bf16x8*)(ab + k4 * 32), a1 = *(const bf16x8*)(ab + 32 * RS + k4 * 32);
      const bf16x8 b0 = *(const bf16x8*)(bb + k4 * 32), b1 = *(const bf16x8*)(bb + 32 * RS + k4 * 32);
      acc00 = MFMA32(a0, b0, acc00); acc01 = MFMA32(a0, b1, acc01); acc10 = MFMA32(a1, b0, acc10); acc11 = MFMA32(a1, b1, acc11);
    }
    if (kt + 1 < nk) SWRITE(cur ^ 1);
    __syncthreads();
  }
#undef GLOAD
#undef SWRITE
  float* pb = PART + ((size_t)ks * 512 + (pm ? 256 : 0) + 64 * wm) * 1024 + pn * 128 + 64 * wn + r32;
#pragma unroll
  for (int r = 0; r < 16; ++r) { float* q = pb + (size_t)crow(r, hi) * 1024;
    q[0] = acc00[r]; q[32] = acc01[r]; q[32 * 1024] = acc10[r]; q[32 * 1024 + 32] = acc11[r]; }
}

__device__ __forceinline__ void ph_ctx_fold_norm(const P& p, int L, int which, const float* __restrict__ part, int nsplit, const float* __restrict__ gate) {
  const int tid = TIDX(), wid = tid >> 6, lane = tid & 63;
  float* xr = (float*)(p.ws + OFF_XRES); bf16_t* hb = (bf16_t*)(p.ws + OFF_HBF);
  const float* mods = (const float*)(p.ws + OFF_MODS) + (size_t)L * 3 * 6144;
  for (int cr = BIDX() * 8 + wid; cr < 2 * CTXL; cr += GDIM() * 8) {
    const int R = cr < CTXL ? cr : TB + (cr - CTXL);
    float* row = xr + (size_t)R * 1024 + lane * 4;
    const float* pr = part + (size_t)cr * 1024 + lane * 4;
    f32x4 v[4], a[4];
#pragma unroll
    for (int i = 0; i < 4; ++i) { v[i] = *(const f32x4*)(row + i * 256); a[i] = *(const f32x4*)(pr + i * 256); }
    for (int sp = 1; sp < nsplit; ++sp) {
#pragma unroll
      for (int i = 0; i < 4; ++i) a[i] += *(const f32x4*)(pr + (size_t)sp * 512 * 1024 + i * 256);
    }
    float ss = 0.f;
#pragma unroll
    for (int i = 0; i < 4; ++i) { v[i] += *(const f32x4*)(gate + 2 * 6144 + i * 256 + lane * 4) * a[i]; *(f32x4*)(row + i * 256) = v[i];
      ss += v[i][0] * v[i][0] + v[i][1] * v[i][1] + v[i][2] * v[i][2] + v[i][3] * v[i][3]; }
    ss = wave_sum(ss);
    const float rs = rsqrtf(ss * (1.f / 1024.f) + EPSF);
    const float* mr = mods + (size_t)2 * 6144 + which * 3072 + lane * 4;
#pragma unroll
    for (int i = 0; i < 4; ++i) { const f32x4 sh = *(const f32x4*)(mr + i * 256), scl = *(const f32x4*)(mr + 1024 + i * 256);
      float o[4];
#pragma unroll
      for (int j = 0; j < 4; ++j) o[j] = v[i][j] * rs * (1.f + scl[j]) + sh[j];
      uint2 w; w.x = cvtpk(o[0], o[1]); w.y = cvtpk(o[2], o[3]);
      *(uint2*)(hb + (size_t)R * 1024 + i * 256 + lane * 4) = w; }
  }
}

__device__ __forceinline__ void ph_norm(const P& p, int L, int which, int mode, int skipb) {
  const int tid = TIDX(), wid = tid >> 6, lane = tid & 63, l16 = lane & 15, sub = lane >> 4;
  const float* xr = (const float*)(p.ws + OFF_XRES);
  bf16_t* hb = (bf16_t*)(p.ws + OFF_HBF);
  const float* mods = (const float*)(p.ws + OFF_MODS) + (size_t)L * 3 * 6144;
  const int bid = BIDX() - skipb, nb = GDIM() - skipb;
  if (bid < 0) return;
  const int nquads = mode == 0 ? MROWS / 4 : (mode == 1 ? 2 * LAT / 4 : 2 * CTXL / 4);
  for (int q = bid * 8 + wid; q < nquads; q += nb * 8) {
    int R4;
    if (mode == 0) R4 = q * 4; else if (mode == 1) R4 = q < LAT / 4 ? CTXL + q * 4 : TB + CTXL + (q - LAT / 4) * 4; else R4 = q < CTXL / 4 ? q * 4 : TB + (q - CTXL / 4) * 4;
    const int R = R4 + sub;
    const float* row = xr + (size_t)R * 1024 + l16 * 4;
    f32x4 v[16]; float ss = 0.f;
#pragma unroll
    for (int i = 0; i < 16; ++i) v[i] = *(const f32x4*)(row + i * 64);
#pragma unroll
    for (int i = 0; i < 16; ++i) ss += v[i][0] * v[i][0] + v[i][1] * v[i][1] + v[i][2] * v[i][2] + v[i][3] * v[i][3];
    ss += __shfl_xor(ss, 1); ss += __shfl_xor(ss, 2); ss += __shfl_xor(ss, 4); ss += __shfl_xor(ss, 8);
    const float rs = rsqrtf(ss * (1.f / 1024.f) + EPSF);
    const float* mr = mods + (size_t)modrow_of(R) * 6144 + which * 3072 + l16 * 4;
    bf16_t* dst = hb + (size_t)R * 1024 + l16 * 4;
#pragma unroll
    for (int i = 0; i < 16; ++i) { const f32x4 sh = *(const f32x4*)(mr + i * 64), scl = *(const f32x4*)(mr + 1024 + i * 64);
      float o[4];
#pragma unroll
      for (int j = 0; j < 4; ++j) o[j] = v[i][j] * rs * (1.f + scl[j]) + sh[j];
      uint2 w; w.x = cvtpk(o[0], o[1]); w.y = cvtpk(o[2], o[3]);
      *(uint2*)(dst + i * 64) = w; }
  }
}

struct EpiRec { bf16_t* P1; bf16_t* P2; float* SM;
  DI void operator()(int row, int col, float v) const {
    if (col < 1536) P1[(size_t)row * 1536 + col] = f2bf(v);
    else if (col < 3584) P2[(size_t)row * 2048 + (col - 1536)] = f2bf(v);
    else { const int lc = col - 3584; if (lc < 48) SM[(size_t)row * 64 + lc] = v; } } };
struct EpiBf { bf16_t* O; int ldc;
  DI void operator()(int row, int col, float v) const { O[(size_t)row * ldc + col] = f2bf(v); } };
struct EpiRes { float* X; const float* gate;
  DI void operator()(int row, int col, float v) const { float* q = X + (size_t)row * 1024 + col; *q = *q + gate[(size_t)modrow_of(row) * 6144 + col] * v; } };

template <class Epi>
__device__ __forceinline__ void gemm_phase(char* lds, const bf16_t* __restrict__ A, int lda, const bf16_t* __restrict__ Bt, int K, int nN, const Epi epi, bool skipctx = false) {
  const int tid = TIDX(), wid = tid >> 6, lane = tid & 63, r32 = lane & 31, hi = lane >> 5;
  const int wm = wid >> 1, wn = wid & 1;
  const int nk = K >> 6;
  constexpr int RS = 144, ASZ = 256 * RS, BSZ = 128 * RS, STG = ASZ + BSZ;
  const int ntiles = (skipctx ? 64 : MROWS / 256) * nN;
  const int srow = tid >> 3, spc = tid & 7;
  for (int t = BIDX(); t < ntiles; t += GDIM()) {
    int pm = t / nN; const int pn = t - pm * nN; if (skipctx) pm = pm + 1 + (pm >= 32 ? 1 : 0);
    const bf16_t* Ab = A + (size_t)(pm * 256 + srow) * lda + spc * 8;
    const bf16_t* Bb = Bt + (size_t)(pn * 128 + srow) * K + spc * 8;
    f32x16 acc00 = {}, acc01 = {}, acc10 = {}, acc11 = {};
    bf16x8 ra0, ra1, ra2, ra3, rb0, rb1;
#define GLOAD(kt) do { const int ko = (kt) * 64; ra0 = *(const bf16x8*)(Ab + ko); ra1 = *(const bf16x8*)(Ab + (size_t)64 * lda + ko); ra2 = *(const bf16x8*)(Ab + (size_t)128 * lda + ko); \
    ra3 = *(const bf16x8*)(Ab + (size_t)192 * lda + ko); rb0 = *(const bf16x8*)(Bb + ko); rb1 = *(const bf16x8*)(Bb + (size_t)64 * K + ko); } while (0)
#define SWRITE(buf) do { char* sb = lds + (buf) * STG + srow * RS + spc * 16; *(bf16x8*)(sb) = ra0; *(bf16x8*)(sb + 64 * RS) = ra1; *(bf16x8*)(sb + 128 * RS) = ra2; *(bf16x8*)(sb + 192 * RS) = ra3; \
    *(bf16x8*)(sb + ASZ) = rb0; *(bf16x8*)(sb + ASZ + 64 * RS) = rb1; } while (0)
    GLOAD(0); SWRITE(0); __syncthreads();
    for (int kt = 0; kt < nk; ++kt) {
      const int cur = kt & 1;
      if (kt + 1 < nk) GLOAD(kt + 1);
      const char* ab = lds + cur * STG + (64 * wm + r32) * RS + hi * 16;
      const char* bb = lds + cur * STG + ASZ + (64 * wn + r32) * RS + hi * 16;
#pragma unroll
      for (int ks = 0; ks < 4; ++ks) {
        const bf16x8 a0 = *(const bf16x8*)(ab + ks * 32), a1 = *(const bf16x8*)(ab + 32 * RS + ks * 32);
        const bf16x8 b0 = *(const bf16x8*)(bb + ks * 32), b1 = *(const bf16x8*)(bb + 32 * RS + ks * 32);
        acc00 = MFMA32(a0, b0, acc00); acc01 = MFMA32(a0, b1, acc01); acc10 = MFMA32(a1, b0, acc10); acc11 = MFMA32(a1, b1, acc11);
      }
      if (kt + 1 < nk) SWRITE(cur ^ 1);
      __syncthreads();
    }
#undef GLOAD
#undef SWRITE
    const int row0 = pm * 256 + 64 * wm, col0 = pn * 128 + 64 * wn + r32;
#pragma unroll
    for (int r = 0; r < 16; ++r) { const int rr = row0 + crow(r, hi);
      epi(rr, col0, acc00[r]); epi(rr, col0 + 32, acc01[r]); epi(rr + 32, col0, acc10[r]); epi(rr + 32, col0 + 32, acc11[r]); }
  }
}

namespace pg8 {
#define PG8_LAS __attribute__((address_space(3)))
constexpr int BM = 256, BK = 64, HALF = 128, HTB = HALF * BK * 2  , STAGE_BYTES = 8 * HTB, NXCD = 8, WGM = 8;

__host__ __device__ __forceinline__ int lds_byte(int r, int c) { const int st = (r >> 4) * 2 + (c >> 5), rr = r & 15, cc = c & 31, ob = rr * 64 + cc * 2; return st * 1024 + (ob ^ (((ob >> 9) & 1) << 5)); }
__host__ __device__ __forceinline__ void stage_rc(int b, int& R, int& C) { const int st = b / 1024, sb = b % 1024, swz = sb ^ (((sb >> 9) & 1) << 5); R = (st >> 1) * 16 + swz / 64; C = (st & 1) * 32 + (swz % 64) / 2; }
__host__ __device__ __forceinline__ int perm32(int rho) { const int n = rho >> 4, i = rho & 15; return 8 * (i >> 2) + 4 * n + (i & 3); }
struct Unit { int pm, pn; };
struct Gemm { const bf16_t* A; const bf16_t* Bt; int M, N, K, lda; };

struct StaticOrder {
    int nM, nN, nwg, G, c;
    __host__ __device__ void init(int M, int N, int G_, int c_) { nM = M / BM; nN = N / BM; nwg = nM * nN; G = G_; c = c_; }
    __host__ __device__ bool next(int i, Unit& u) const {
        const long L = (long)i * G + c; if (L >= nwg) return false;
        int wgid = (int)L; { const int q = nwg / NXCD, r = nwg % NXCD, xcd = wgid % NXCD, off = wgid / NXCD; wgid = (xcd < r ? xcd * (q + 1) : r * (q + 1) + (xcd - r) * q) + off; }
        const int nig = WGM * nN, gid = wgid / nig, fm = gid * WGM, gsz = (nM - fm) < WGM ? (nM - fm) : WGM;
        u.pm = fm + ((wgid % nig) % gsz); u.pn = (wgid % nig) / gsz; return true;
    }
    __device__ __forceinline__ void a_ready(const Unit&) const {}
    __device__ __forceinline__ void done(const Unit&) const {}
};
template <class Epi, class Sched, bool ALIGN_EPI = false, bool SP2 = false>
__device__ __forceinline__ void gemm_phase(PG8_LAS unsigned char* lds, const Gemm g, const Sched& S, const Epi& E) {
    const int tid = TIDX(), wid = __builtin_amdgcn_readfirstlane(tid >> 6), lane = tid & 63, wr = wid >> 2, wc = wid & 3, fr = lane & 15, fq = lane >> 4;
    const int K = g.K, nt = K / BK;
    unsigned voffA[2], voffB[2];
#pragma unroll
    for (int i = 0; i < 2; ++i) { int R, C; stage_rc(tid * 16 + i * 8192, R, C); const int Rb = Epi::PERM ? ((R & ~31) + perm32(R & 31)) : R;
        voffA[i] = (unsigned)(R * g.lda + C) * 2u; voffB[i] = (unsigned)(Rb * K + C) * 2u; }
    const size_t kstep = (size_t)(BK * 2);
    const size_t hstep = (size_t)HALF * K * 2;
    const size_t tstep = 2 * hstep; const size_t hstepA = (size_t)HALF * g.lda * 2, tstepA = 2 * hstepA;
    const unsigned ldsw = (unsigned)wid * 1024u;
    const int aoff = lds_byte(wr * 64 + fr, fq * 8), boff = lds_byte(wc * 32 + fr, fq * 8);
#define PG8_SA(b, h) (((b) * 2 + (h)) * HTB)
#define PG8_SB(b, h) ((4 + (b) * 2 + (h)) * HTB)
#define PG8_STAGE(bufoff, gbase, voff) do { _Pragma("unroll") for (int _i = 0; _i < 2; ++_i) \
        __builtin_amdgcn_global_load_lds((const unsigned*)((const char*)(gbase) + (voff)[_i]), (PG8_LAS unsigned*)(lds + (bufoff) + ldsw + _i * 8192), 16, 0, 0); } while (0)
#define PG8_LDA(dst, b, h) do { _Pragma("unroll") for (int m = 0; m < 4; ++m) _Pragma("unroll") for (int k = 0; k < 2; ++k) dst[m][k] = *(const PG8_LAS bf16x8*)(lds + PG8_SA(b, h) + aoff + m * 2048 + k * 1024); } while (0)
#define PG8_LDB(dst, b, h) do { _Pragma("unroll") for (int n = 0; n < 2; ++n) _Pragma("unroll") for (int k = 0; k < 2; ++k) dst[n][k] = *(const PG8_LAS bf16x8*)(lds + PG8_SB(b, h) + boff + n * 2048 + k * 1024); } while (0)
#define PG8_MMA(ai, bj, At, Bt) do { __builtin_amdgcn_s_setprio(1); _Pragma("unroll") for (int m = 0; m < 4; ++m) _Pragma("unroll") for (int n = 0; n < 2; ++n) _Pragma("unroll") for (int k = 0; k < 2; ++k) \
        acc[ai][bj][m][n] = __builtin_amdgcn_mfma_f32_16x16x32_bf16(Bt[n][k], At[m][k], acc[ai][bj][m][n], 0, 0, 0); __builtin_amdgcn_s_setprio(0); } while (0)
#define PG8_WAIT_V(n) asm volatile("s_waitcnt vmcnt(" #n ")" ::: "memory")
#define PG8_WAIT_L(n) asm volatile("s_waitcnt lgkmcnt(" #n ")" ::: "memory")
#define PG8_BAR __builtin_amdgcn_s_barrier()
#define PG8_SCHED __builtin_amdgcn_sched_barrier(0)
    Unit cur, nxt; int ui = 0;
    if (!S.next(0, cur)) return;
    f32x4 acc[2][2][4][2];
#pragma unroll
    for (int a = 0; a < 2; ++a)
#pragma unroll
        for (int b = 0; b < 2; ++b)
#pragma unroll
            for (int m = 0; m < 4; ++m)
#pragma unroll
                for (int n = 0; n < 2; ++n) acc[a][b][m][n] = (f32x4){0.f, 0.f, 0.f, 0.f};
    bf16x8 At[4][2], B0[2][2], B1[2][2];
    const char* cA = (const char*)g.A + (size_t)cur.pm * tstepA; const char* cB = (const char*)g.Bt + (size_t)cur.pn * tstep;
    S.a_ready(cur);
    if constexpr (SP2) {
        PG8_STAGE(PG8_SB(0, 0), cB, voffB); PG8_STAGE(PG8_SB(0, 1), cB + hstep, voffB); PG8_STAGE(PG8_SA(0, 0), cA, voffA); PG8_STAGE(PG8_SA(0, 1), cA + hstepA, voffA);
        if (wr == 1) PG8_BAR;
        PG8_WAIT_V(2); PG8_BAR;
        PG8_STAGE(PG8_SB(1, 0), cB + kstep, voffB); PG8_STAGE(PG8_SA(1, 0), cA + kstep, voffA); PG8_STAGE(PG8_SB(1, 1), cB + hstep + kstep, voffB);
        PG8_WAIT_V(6); PG8_BAR;
    } else {
        PG8_STAGE(PG8_SB(0, 0), cB, voffB); PG8_STAGE(PG8_SA(0, 0), cA, voffA); PG8_STAGE(PG8_SB(0, 1), cB + hstep, voffB); PG8_STAGE(PG8_SA(0, 1), cA + hstepA, voffA);
        if (wr == 1) PG8_BAR;
        PG8_WAIT_V(4); PG8_BAR;
        PG8_STAGE(PG8_SB(1, 0), cB + kstep, voffB); PG8_STAGE(PG8_SA(1, 0), cA + kstep, voffA); PG8_STAGE(PG8_SB(1, 1), cB + hstep + kstep, voffB);
        PG8_WAIT_V(6); PG8_BAR;
    }
    for (;;) {
        const bool has_next = S.next(ui + 1, nxt);
        const char* nA = has_next ? (const char*)g.A + (size_t)nxt.pm * tstepA : cA; const char* nB = has_next ? (const char*)g.Bt + (size_t)nxt.pn * tstep : cB;
        for (int t = 0; t < nt; t += 2) {
            const bool last = (t == nt - 2);
            const char* a1 = cA + (size_t)(t + 1) * kstep;
            const char* a2 = last ? nA : cA + (size_t)(t + 2) * kstep; const char* b2 = last ? nB : cB + (size_t)(t + 2) * kstep;
            const char* a3 = a2 + kstep; const char* b3 = b2 + kstep;
            if (last && has_next) S.a_ready(nxt);
            if constexpr (SP2) {
            PG8_LDB(B0, 0, 0); PG8_LDB(B1, 0, 1); PG8_SCHED; PG8_LDA(At, 0, 0); PG8_STAGE(PG8_SA(1, 1), a1 + hstepA, voffA);
            PG8_WAIT_V(8); PG8_WAIT_L(0); PG8_BAR; PG8_MMA(0, 0, At, B0); PG8_MMA(0, 1, At, B1); PG8_BAR; PG8_SCHED;
            PG8_LDA(At, 0, 1); PG8_STAGE(PG8_SB(0, 0), b2, voffB); PG8_STAGE(PG8_SB(0, 1), b2 + hstep, voffB); PG8_STAGE(PG8_SA(0, 0), a2, voffA);
            PG8_WAIT_V(8); PG8_WAIT_L(0); PG8_BAR; PG8_MMA(1, 0, At, B0); PG8_MMA(1, 1, At, B1); PG8_BAR; PG8_SCHED;
            PG8_LDB(B0, 1, 0); PG8_LDB(B1, 1, 1); PG8_SCHED; PG8_LDA(At, 1, 0); PG8_STAGE(PG8_SA(0, 1), a2 + hstepA, voffA);
            PG8_WAIT_V(8); PG8_WAIT_L(0); PG8_BAR; PG8_MMA(0, 0, At, B0); PG8_MMA(0, 1, At, B1); PG8_BAR; PG8_SCHED;
            PG8_LDA(At, 1, 1); PG8_STAGE(PG8_SB(1, 0), b3, voffB); PG8_STAGE(PG8_SB(1, 1), b3 + hstep, voffB); PG8_STAGE(PG8_SA(1, 0), a3, voffA);
            PG8_WAIT_V(8); PG8_WAIT_L(0); PG8_BAR; PG8_MMA(1, 0, At, B0); PG8_MMA(1, 1, At, B1); PG8_BAR; PG8_SCHED;
            } else {
            PG8_LDB(B0, 0, 0); PG8_SCHED; PG8_LDA(At, 0, 0); PG8_STAGE(PG8_SA(1, 1), a1 + hstepA, voffA);
            PG8_WAIT_L(8); PG8_BAR; PG8_WAIT_L(0); PG8_MMA(0, 0, At, B0); PG8_BAR; PG8_SCHED;
            PG8_LDB(B1, 0, 1); PG8_STAGE(PG8_SB(0, 0), b2, voffB);
            PG8_BAR; PG8_WAIT_L(0); PG8_MMA(0, 1, At, B1); PG8_BAR;
            PG8_LDA(At, 0, 1); PG8_STAGE(PG8_SA(0, 0), a2, voffA);
            PG8_BAR; PG8_WAIT_L(0); PG8_MMA(1, 0, At, B0); PG8_BAR; PG8_SCHED;
            PG8_STAGE(PG8_SB(0, 1), b2 + hstep, voffB);
            PG8_WAIT_V(6); PG8_BAR; PG8_MMA(1, 1, At, B1); PG8_BAR;
            PG8_LDB(B0, 1, 0); PG8_SCHED; PG8_LDA(At, 1, 0); PG8_STAGE(PG8_SA(0, 1), a2 + hstepA, voffA);
            PG8_WAIT_L(8); PG8_BAR; PG8_WAIT_L(0); PG8_MMA(0, 0, At, B0); PG8_BAR; PG8_SCHED;
            PG8_LDB(B1, 1, 1); PG8_STAGE(PG8_SB(1, 0), b3, voffB);
            PG8_BAR; PG8_WAIT_L(0); PG8_MMA(0, 1, At, B1); PG8_BAR;
            PG8_LDA(At, 1, 1); PG8_STAGE(PG8_SA(1, 0), a3, voffA);
            PG8_BAR; PG8_WAIT_L(0); PG8_MMA(1, 0, At, B0); PG8_BAR; PG8_SCHED;
            PG8_STAGE(PG8_SB(1, 1), b3 + hstep, voffB);
            PG8_WAIT_V(6); PG8_BAR; PG8_MMA(1, 1, At, B1); PG8_BAR;
            }
        }
        if constexpr (ALIGN_EPI) { if (wr == 0) PG8_BAR; }
        if constexpr (!Epi::AFTER_DRAIN) { E(acc, cur, wr, wc, fr, fq); S.done(cur); }
        if (!has_next) break;
#pragma unroll
        for (int a = 0; a < 2; ++a)
#pragma unroll
            for (int b = 0; b < 2; ++b)
#pragma unroll
                for (int m = 0; m < 4; ++m)
#pragma unroll
                    for (int n = 0; n < 2; ++n) acc[a][b][m][n] = (f32x4){0.f, 0.f, 0.f, 0.f};
        cur = nxt; cA = nA; cB = nB; ++ui;
        if constexpr (ALIGN_EPI) { if (wr == 1) PG8_BAR; }
    }
    PG8_WAIT_V(0);
    if constexpr (!ALIGN_EPI) { if (wr == 0) PG8_BAR; }
    PG8_BAR;
    if constexpr (Epi::AFTER_DRAIN) { E.fused(acc, cur, wr, wc, fr, fq, lds, wid, lane); S.done(cur); }
#undef PG8_SA
#undef PG8_SB
#undef PG8_STAGE
#undef PG8_LDA
#undef PG8_LDB
#undef PG8_MMA
#undef PG8_WAIT_V
#undef PG8_WAIT_L
#undef PG8_BAR
#undef PG8_SCHED
}
struct SchedX { StaticOrder so; int mode;
  __device__ __forceinline__ bool next(int i, Unit& u) const {
    if (mode == 2) { if (i != 0 || so.c >= 8) return false; u.pm = (so.c >> 2) ? 33 : 0; u.pn = so.c & 3; return true; }
    if (!so.next(i, u)) return false; if (mode == 1) u.pm = u.pm + 1 + (u.pm >= 32 ? 1 : 0); return true; }
  __device__ __forceinline__ void a_ready(const Unit&) const {}
  __device__ __forceinline__ void done(const Unit&) const {} };
}
struct EpiRec8 { static constexpr bool PERM = true, AFTER_DRAIN = false; bf16_t* P1; bf16_t* P2; float* SM;
  DI void operator()(const f32x4 (&acc)[2][2][4][2], const pg8::Unit& u, int wr, int wc, int fr, int fq) const {
#pragma unroll
    for (int ai = 0; ai < 2; ++ai)
#pragma unroll
      for (int m = 0; m < 4; ++m) { const size_t row = (size_t)u.pm * 256 + ai * 128 + wr * 64 + m * 16 + fr;
#pragma unroll
        for (int bj = 0; bj < 2; ++bj) { const int col = u.pn * 256 + bj * 128 + wc * 32 + fq * 8; const f32x4 v0 = acc[ai][bj][m][0], v1 = acc[ai][bj][m][1];
          if (u.pn < 14) { const u32x4 w = {cvtpk(v0[0], v0[1]), cvtpk(v0[2], v0[3]), cvtpk(v1[0], v1[1]), cvtpk(v1[2], v1[3])};
            if (u.pn < 6) *(u32x4*)(P1 + row * 1536 + col) = w; else *(u32x4*)(P2 + row * 2048 + (col - 1536)) = w; }
          else { const int lc = col - 3584; if (lc < 48) { *(f32x4*)(SM + row * 64 + lc) = v0; *(f32x4*)(SM + row * 64 + lc + 4) = v1; } } } } } };
struct EpiBf8 { static constexpr bool PERM = true, AFTER_DRAIN = false; bf16_t* O; int ldc;
  DI void operator()(const f32x4 (&acc)[2][2][4][2], const pg8::Unit& u, int wr, int wc, int fr, int fq) const {
#pragma unroll
    for (int ai = 0; ai < 2; ++ai)
#pragma unroll
      for (int m = 0; m < 4; ++m) { const size_t row = (size_t)u.pm * 256 + ai * 128 + wr * 64 + m * 16 + fr;
#pragma unroll
        for (int bj = 0; bj < 2; ++bj) { const int col = u.pn * 256 + bj * 128 + wc * 32 + fq * 8; const f32x4 v0 = acc[ai][bj][m][0], v1 = acc[ai][bj][m][1];
          const u32x4 w = {cvtpk(v0[0], v0[1]), cvtpk(v0[2], v0[3]), cvtpk(v1[0], v1[1]), cvtpk(v1[2], v1[3])};
          *(u32x4*)(O + row * ldc + col) = w; } } } };
struct EpiRes8 { static constexpr bool PERM = false, AFTER_DRAIN = false; float* X; const float* gate;
  DI void operator()(const f32x4 (&acc)[2][2][4][2], const pg8::Unit& u, int wr, int wc, int fr, int fq) const {
    const float* gr = gate + (size_t)modrow_of(u.pm * 256) * 6144;
#pragma unroll
    for (int bj = 0; bj < 2; ++bj)
#pragma unroll
      for (int n = 0; n < 2; ++n) { const int col = u.pn * 256 + bj * 128 + wc * 32 + n * 16 + fq * 4; const f32x4 gv = *(const f32x4*)(gr + col);
#pragma unroll
        for (int ai = 0; ai < 2; ++ai)
#pragma unroll
          for (int m = 0; m < 4; ++m) { const size_t row = (size_t)u.pm * 256 + ai * 128 + wr * 64 + m * 16 + fr;
            f32x4* q = (f32x4*)(X + row * 1024 + col); *q = *q + gv * acc[ai][bj][m][n]; } } } };
template <class Epi>
__device__ __forceinline__ void gemm8(char* lds, const bf16_t* A, int lda, const bf16_t* Bt, int K, int N, int mode, const Epi& E) {
  pg8::Gemm g{A, Bt, mode == 1 ? 16384 : MROWS, N, K, lda};
  pg8::SchedX S; S.so.init(g.M, N, GDIM(), BIDX()); S.mode = mode;
  pg8::gemm_phase<Epi, pg8::SchedX, true, true>((PG8_LAS unsigned char*)lds, g, S, E);
}

__device__ __forceinline__ void ph_dnprep(const P& p, char* lds, int e) {
  const int tid = TIDX(), wid = tid >> 6, lane = tid & 63;
  const bf16_t* P1 = (const bf16_t*)(p.ws + OFF_D + D_P1);
  bf16_t* QQ = (bf16_t*)(p.ws + OFF_D + D_QQ); bf16_t* QK = (bf16_t*)(p.ws + OFF_D + D_QK); bf16_t* QV = (bf16_t*)(p.ws + OFF_D + D_QV);
  bf16_t* KT = (bf16_t*)(p.ws + OFF_D + D_KT);
  const float* SM = (const float*)(p.ws + OFF_SM); float* GB = (float*)(p.ws + OFF_GB);
  const float* cw = p.rec_conv + (size_t)e * 3 * 1536;
  bf16_t* kl = (bf16_t*)lds;
  for (int job = BIDX(); job < MROWS / 32; job += GDIM()) {
    const int R0 = job * 32;
    for (int tt = 0; tt < 4; ++tt) {
      const int tl = wid * 4 + tt, R = R0 + tl; const int b = R >= TB ? 1 : 0, pp = R - b * TB;
      const bool hasp = !(pp == 0 || pp == CTXL), hasn = !(pp == CTXL - 1 || pp == TB - 1);
#pragma unroll
      for (int part = 0; part < 3; ++part) {
        const int ch = part * 512 + lane * 8;
        const bf16x8 zc = *(const bf16x8*)(P1 + (size_t)R * 1536 + ch);
        bf16x8 zp = {}, zn = {};
        if (hasp) zp = *(const bf16x8*)(P1 + (size_t)(R - 1) * 1536 + ch);
        if (hasn) zn = *(const bf16x8*)(P1 + (size_t)(R + 1) * 1536 + ch);
        float o[8]; float ss = 0.f;
#pragma unroll
        for (int j = 0; j < 8; ++j) { const float a = bf2f((bf16_t)zp[j]) * cw[ch + j] + bf2f((bf16_t)zc[j]) * cw[1536 + ch + j] + bf2f((bf16_t)zn[j]) * cw[3072 + ch + j];
          o[j] = siluf(a); ss += o[j] * o[j]; }
        if (part < 2) {
          ss += __shfl_xor(ss, 1); ss += __shfl_xor(ss, 2); ss += __shfl_xor(ss, 4); ss += __shfl_xor(ss, 8);
          float sc = rsqrtf(ss + EPSF); if (part == 0) sc *= 0.08838834764831845f;
#pragma unroll
          for (int j = 0; j < 8; ++j) o[j] *= sc;
        }
        u32x4 w = {cvtpk(o[0], o[1]), cvtpk(o[2], o[3]), cvtpk(o[4], o[5]), cvtpk(o[6], o[7])};
        bf16_t* dst = part == 0 ? QQ : (part == 1 ? QK : QV);
        *(u32x4*)(dst + (size_t)R * 512 + lane * 8) = w;
        if (part == 1) *(u32x4*)(kl + tl * 512 + lane * 8) = w;
      }
      if (lane < 16) {
        const int q = lane & 7;
        if (lane < 8) { const float da = SM[(size_t)R * 64 + q]; GB[(size_t)R * 16 + q] = -expf(p.dn_a_log[e * 8 + q]) * softplusf(da + p.dn_dt_bias[e * 8 + q]); }
        else { const float db = SM[(size_t)R * 64 + 8 + q]; GB[(size_t)R * 16 + 8 + q] = sigmf(db); }
      }
    }
    __syncthreads();
    {
      const int b = R0 >= TB ? 1 : 0, c = (R0 - b * TB) / 64, half = ((R0 - b * TB) >> 5) & 1; const int h = tid >> 7, dk = tid & 127;
      bf16_t* dst = KT + ((((size_t)b * 4 + h) * NCH + c) * 128 + dk) * 64 + half * 32;
#pragma unroll
      for (int g8 = 0; g8 < 4; ++g8) { unsigned w[4];
#pragma unroll
        for (int j = 0; j < 4; ++j) { const unsigned lo = kl[(g8 * 8 + 2 * j) * 512 + tid], hi2 = kl[(g8 * 8 + 2 * j + 1) * 512 + tid]; w[j] = lo | (hi2 << 16); }
        *(u32x4*)(dst + g8 * 8) = (u32x4){w[0], w[1], w[2], w[3]}; }
    }
    __syncthreads();
  }
}

__device__ __forceinline__ void ph_dn_d1(const P& p, char* lds) {
  const int tid = TIDX(), wid = tid >> 6, lane = tid & 63, r32 = lane & 31, hi = lane >> 5;
  const bf16_t* QQ = (const bf16_t*)(p.ws + OFF_D + D_QQ); const bf16_t* QK = (const bf16_t*)(p.ws + OFF_D + D_QK); const bf16_t* QV = (const bf16_t*)(p.ws + OFF_D + D_QV);
  const float* GB = (const float*)(p.ws + OFF_GB);
  bf16_t* W_ = (bf16_t*)(p.ws + OFF_D + D_W); bf16_t* U_ = (bf16_t*)(p.ws + OFF_HBF); bf16_t* INTRA = (bf16_t*)(p.ws + OFF_D + D_INTRA);
  float* SC = (float*)(p.ws + OFF_SC); float* GLS = (float*)(p.ws + OFF_GL);
  float* KK = (float*)lds; float* QKm = KK + 64 * 65; float* Ad = QKm + 64 * 65; float* Gs = Ad + 2 * 4096; float* Bs = Gs + 128;
  bf16_t* Vs = (bf16_t*)(Bs + 128); bf16_t* Ks = Vs + 64 * 128;
  for (int job = BIDX(); job < 8 * NCH; job += GDIM()) {
    const int b = job / (4 * NCH), h = (job / NCH) & 3, c = job % NCH;
    const size_t Rb = (size_t)b * TB + (size_t)c * 64;
    {
      const int srow = tid >> 4, spc = (tid & 15) * 8;
      const u32x4 v0 = *(const u32x4*)(QV + (Rb + srow) * 512 + h * 128 + spc), v1 = *(const u32x4*)(QV + (Rb + 32 + srow) * 512 + h * 128 + spc);
      const u32x4 k0 = *(const u32x4*)(QK + (Rb + srow) * 512 + h * 128 + spc), k1 = *(const u32x4*)(QK + (Rb + 32 + srow) * 512 + h * 128 + spc);
      *(u32x4*)(Vs + srow * 128 + spc) = v0; *(u32x4*)(Vs + (32 + srow) * 128 + spc) = v1;
      *(u32x4*)(Ks + srow * 128 + spc) = k0; *(u32x4*)(Ks + (32 + srow) * 128 + spc) = k1;
    }
    {
      const int w4 = wid & 3, mi = w4 & 1, ni = w4 >> 1;
      const bf16_t* As = wid < 4 ? QK : QQ;
      const bf16_t* arow = As + (Rb + 32 * mi + r32) * 512 + h * 128 + hi * 8;
      const bf16_t* brow = QK + (Rb + 32 * ni + r32) * 512 + h * 128 + hi * 8;
      f32x16 acc = {}; acc = mma_rows<8>(arow, brow, acc);
      float* dst = wid < 4 ? KK : QKm;
#pragma unroll
      for (int r = 0; r < 16; ++r) dst[(32 * mi + crow(r, hi)) * 65 + 32 * ni + r32] = acc[r];
    }
    if (tid < 128) { const int d = tid >> 6, ip = tid & 63, t = d ? 63 - ip : ip; float g = GB[(Rb + t) * 16 + d * 4 + h]; Bs[tid] = GB[(Rb + t) * 16 + 8 + d * 4 + h];
#pragma unroll
      for (int o = 1; o < 64; o <<= 1) { const float v = __shfl_up(g, o); g += ip >= o ? v : 0.f; }
      Gs[tid] = g; }
    __syncthreads();
    const int n0 = c, n1 = c < 4 ? 3 - c : 135 - c;
    const size_t cj0 = ((size_t)(0 * 2 + b) * 4 + h) * NCH + n0, cj1 = ((size_t)(1 * 2 + b) * 4 + h) * NCH + n1;
    for (int e2 = tid; e2 < 8192; e2 += 512) {
      const int d = e2 >> 12, ip = (e2 >> 6) & 63, jp = e2 & 63; const int i = d ? 63 - ip : ip, j = d ? 63 - jp : jp;
      const float dec = jp <= ip ? __expf(Gs[d * 64 + ip] - Gs[d * 64 + jp]) : 0.f;
      Ad[d * 4096 + ip * 64 + jp] = jp < ip ? Bs[d * 64 + ip] * KK[i * 65 + j] * dec : 0.f;
      const size_t cj = d ? cj1 : cj0;
      INTRA[(cj * 64 + ip) * 64 + jp] = f2bf(QKm[i * 65 + j] * dec);
    }
    if (tid < 128) { const int d = tid >> 6, ip = tid & 63; const size_t cj = d ? cj1 : cj0; const float gi = Gs[tid], gl = Gs[d * 64 + 63];
      SC[(cj * 64 + ip) * 2] = __expf(gi); SC[(cj * 64 + ip) * 2 + 1] = __expf(gl - gi); if (ip == 0) GLS[cj] = __expf(gl); }
    __syncthreads();
    {
      const int d = tid >> 8, cc = tid & 255; const size_t cj = d ? cj1 : cj0;
      int dofs = d * 64, aofs = d * 4096; asm volatile("" : "+v"(dofs), "+v"(aofs));
      float x[64];
      {
        int vofs = cc < 128 ? cc : 64 * 128 + (cc - 128); asm volatile("" : "+v"(vofs));
#pragma unroll
        for (int ip = 0; ip < 64; ++ip) x[ip] = bf2f(Vs[vofs + ip * 128]);
#pragma unroll
        for (int ip = 0; ip < 32; ++ip) { const float a_ = x[ip], b_ = x[63 - ip]; x[ip] = d ? b_ : a_; x[63 - ip] = d ? a_ : b_; }
        if (cc < 128) {
#pragma unroll
          for (int ip = 0; ip < 64; ++ip) x[ip] *= Bs[dofs + ip];
        } else {
#pragma unroll
          for (int ip = 0; ip < 64; ++ip) x[ip] *= Bs[dofs + ip] * __expf(Gs[dofs + ip]);
        }
      }
      const float* Arow = Ad + aofs;
#pragma unroll
      for (int ip = 1; ip < 64; ++ip) {
        float s = 0.f;
#pragma unroll
        for (int j4 = 0; j4 < (ip + 3) / 4; ++j4) { const f32x4 a = *(const f32x4*)(Arow + ip * 64 + 4 * j4);
          s += a[0] * x[4 * j4] + a[1] * x[4 * j4 + 1] + a[2] * x[4 * j4 + 2] + a[3] * x[4 * j4 + 3]; }
        x[ip] -= s;
      }
      bf16_t* dst = cc < 128 ? U_ + cj * 64 * 128 + cc : W_ + cj * 64 * 128 + (cc - 128);
#pragma unroll
      for (int ip = 0; ip < 64; ++ip) dst[ip * 128] = f2bf(x[ip]);
    }
    __syncthreads();
  }
}

typedef _Float16 h16x8 __attribute__((ext_vector_type(8)));
__device__ __forceinline__ void ph_gla_b(const P& p, char* lds, int e) {
  const int tid = TIDX(), wid = tid >> 6, lane = tid & 63;
  const float* SM = (const float*)(p.ws + OFF_SM);
  float* w2S = (float*)lds;
  float* b2S = w2S + 8192;
  for (int i = tid; i < 8192; i += 512) { const int d = i >> 12, hh = (i >> 10) & 3, r = (i >> 6) & 15, j = i & 63; w2S[i] = p.gla_w2[(((size_t)e * 2 + d) * 16 + r) * 256 + hh * 64 + j]; }
  if (tid < 512) b2S[tid] = p.gla_b2[(size_t)e * 512 + tid];
  __syncthreads();
  int jb = 8 * wid; asm volatile("" : "+v"(jb));
  for (int job = GDIM() - 1 - BIDX(); job < 16 * NCH; job += GDIM()) {
    const int n = job % NCH, sq = job / NCH; const int dir = sq >> 3, b = (sq >> 2) & 1, h = sq & 3;
    const int c = dir == 0 ? n : (n < 4 ? 3 - n : 135 - n);
    const size_t row = (size_t)b * TB + (size_t)c * 64 + (dir ? 63 - lane : lane);
    const float* gp = SM + row * 64 + 16 + dir * 16;
    const f32x4 g0 = *(const f32x4*)(gp), g1 = *(const f32x4*)(gp + 4), g2 = *(const f32x4*)(gp + 8), g3 = *(const f32x4*)(gp + 12);
    const float gg_[16] = {g0[0], g0[1], g0[2], g0[3], g1[0], g1[1], g1[2], g1[3], g2[0], g2[1], g2[2], g2[3], g3[0], g3[1], g3[2], g3[3]};
    const float* wb = w2S + (dir * 4 + h) * 1024 + jb; const float* bb2 = b2S + dir * 256 + h * 64 + jb;
    f32x4 sa = *(const f32x4*)(bb2), sb = *(const f32x4*)(bb2 + 4);
#pragma unroll
    for (int r = 0; r < 16; ++r) { const f32x4 wa = *(const f32x4*)(wb + r * 64), wq = *(const f32x4*)(wb + r * 64 + 4); sa += gg_[r] * wa; sb += gg_[r] * wq; }
    float la[8];
#pragma unroll
    for (int jj = 0; jj < 4; ++jj) { const float x0 = sa[jj], x1 = sb[jj];
      la[jj] = (fminf(x0, 0.f) - log1pf(expf(-fabsf(x0)))) * 0.0625f; la[4 + jj] = (fminf(x1, 0.f) - log1pf(expf(-fabsf(x1)))) * 0.0625f; }
#pragma unroll
    for (int o = 1; o < 64; o <<= 1) {
#pragma unroll
      for (int jj = 0; jj < 8; ++jj) { const float v = __shfl_up(la[jj], o); la[jj] += lane >= o ? v : 0.f; }
    }
    h16x8 hv;
#pragma unroll
    for (int jj = 0; jj < 8; ++jj) hv[jj] = (_Float16)la[jj];
    _Float16* dst = (_Float16*)(p.ws + (dir ? OFF_B16_1 : OFF_WC)) + ((((size_t)b * 4 + h) * NCH + n) * 64 + lane) * 64 + jb;
    *(h16x8*)dst = hv;
  }
}

struct DnSet { bf16x8 fa[8]; };
template <int ROLE>
__device__ __forceinline__ void dn_scan_t(const P& p, char* lds, int job) {
  const int tid = TIDX(), wid = tid >> 6, lane = tid & 63, r32 = lane & 31, hi = lane >> 5;
  const int dir = job >> 5, b = (job >> 4) & 1, h = (job >> 2) & 3, n0 = (job & 3) * 32;
  const bf16_t* QQ = (const bf16_t*)(p.ws + OFF_D + D_QQ); const bf16_t* KT = (const bf16_t*)(p.ws + OFF_D + D_KT);
  const bf16_t* W_ = (const bf16_t*)(p.ws + OFF_D + D_W); const bf16_t* U_ = (const bf16_t*)(p.ws + OFF_HBF); const bf16_t* INTRA = (const bf16_t*)(p.ws + OFF_D + D_INTRA);
  const float* SC = (const float*)(p.ws + OFF_SC); const float* GLS = (const float*)(p.ws + OFF_GL);
  bf16_t* DNO = (bf16_t*)(p.ws + OFF_D + D_DNO);
  bf16_t* ST = (bf16_t*)lds; bf16_t* vTa = ST + 32 * 136; bf16_t* vTb = vTa + 32 * 72;
  float* scS = (float*)(vTb + 32 * 72);
  bf16_t* uS = (bf16_t*)(scS + 256);
  bf16_t* inS = uS + 2 * 64 * 40;
  for (int i = tid; i < 32 * 136; i += 512) ST[i] = 0;
  f32x16 accS = {};
  const size_t seq = ((size_t)dir * 2 + b) * 4 + h;
  const int mi = wid & 1, di = wid - 4;
  constexpr int role = ROLE;
  const int tt = tid - 256;
  DnSet fs[3]; float gls[3] = {0.f, 0.f, 0.f};
  u32x4 stU[3], stI0[3]; float stS[3] = {0.f, 0.f, 0.f};
#define DN_CH(n_) const int n__ = (n_); const int c__ = dir == 0 ? n__ : (n__ < 4 ? 3 - n__ : 135 - n__); const size_t Rb__ = (size_t)b * TB + (size_t)c__ * 64; const size_t cj__ = seq * NCH + n__;
#define DN_LOAD(S, GL, n_) do { DN_CH(n_) \
    const int ipl__ = 32 * mi + r32, tl__ = dir ? 63 - ipl__ : ipl__; \
    const bf16_t* b0__ = W_ + cj__ * 8192 + (32 * mi + r32) * 128 + hi * 8; \
    const bf16_t* b1__ = QQ + (Rb__ + tl__) * 512 + h * 128 + hi * 8; \
    const bf16_t* b2__ = KT + ((((size_t)b * 4 + h) * NCH + c__) * 128 + 32 * (wid & 3) + r32) * 64 + hi * 8; \
    const bf16_t* bs__ = role == 0 ? b0__ : (role == 1 ? b1__ : b2__); \
    _Pragma("unroll") for (int ks = 0; ks < 8; ++ks) S.fa[ks] = *(const bf16x8*)(bs__ + ks * 16); \
    GL = GLS[cj__]; } while (0)
#define DN_STAGE_LD(q_, n_) do { DN_CH(n_) (void)Rb__; \
      stU[q_] = *(const u32x4*)(U_ + cj__ * 8192 + ((tid & 255) >> 2) * 128 + n0 + (tid & 3) * 8); \
      stI0[q_] = *(const u32x4*)(INTRA + cj__ * 4096 + (tid >> 3) * 64 + (tid & 7) * 8); \
      stS[q_] = SC[cj__ * 128 + (tid & 127)]; } while (0)
#define DN_STAGE_ST(q_, bf_) do { *(u32x4*)(inS + (bf_) * 4608 + (tid >> 3) * 72 + (tid & 7) * 8) = stI0[q_]; \
      if (ROLE < 2) *(u32x4*)(uS + (bf_) * 2560 + (tid >> 2) * 40 + (tid & 3) * 8) = stU[q_]; \
      if (ROLE == 0) scS[(bf_) * 128 + tid] = stS[q_]; } while (0)
#define DN_STEP(S, GL, n_, bf_) do { DN_CH(n_) (void)cj__; \
    const float* sc__ = scS + (bf_) * 128; \
    if (role < 2) { _Pragma("unroll") for (int r = 0; r < 16; ++r) accS[r] = 0.f; } \
    if (role < 2) { const bf16_t* sb__ = ST + r32 * 136 + hi * 8; \
      _Pragma("unroll") for (int ks = 0; ks < 8; ++ks) accS = MFMA32(S.fa[ks], *(const bf16x8*)(sb__ + ks * 16), accS); \
      if (role == 0) { const bf16_t* us__ = uS + (bf_) * 2560 + r32; \
        _Pragma("unroll") for (int r = 0; r < 16; ++r) { const int ip = 32 * mi + crow(r, hi); const float vn = bf2f(us__[ip * 40]) - accS[r]; \
          vTa[r32 * 72 + ip] = f2bf(vn); const int to = dir ? 63 - ip : ip; vTb[r32 * 72 + to] = f2bf(vn * sc__[ip * 2 + 1]); } } \
      else { _Pragma("unroll") for (int r = 0; r < 16; ++r) accS[r] *= sc__[(32 * mi + crow(r, hi)) * 2]; } } \
    LBAR(); \
    if (role == 1) { const bf16_t* vb__ = vTa + r32 * 72 + hi * 8; const bf16_t* ib__ = inS + (bf_) * 4608 + (32 * mi + r32) * 72 + hi * 8; \
      _Pragma("unroll") for (int ks = 0; ks < 4; ++ks) accS = MFMA32(*(const bf16x8*)(ib__ + ks * 16), *(const bf16x8*)(vb__ + ks * 16), accS); \
      _Pragma("unroll") for (int r = 0; r < 16; ++r) { const int ip = 32 * mi + crow(r, hi), t = dir ? 63 - ip : ip; \
        DNO[((size_t)dir * MROWS + Rb__ + t) * 512 + h * 128 + n0 + r32] = f2bf(accS[r]); } } \
    else if (role == 2) { const bf16_t* vb__ = vTb + r32 * 72 + hi * 8; \
      _Pragma("unroll") for (int r = 0; r < 16; ++r) accS[r] *= GL; \
      _Pragma("unroll") for (int ks = 0; ks < 4; ++ks) accS = MFMA32(S.fa[ks], *(const bf16x8*)(vb__ + ks * 16), accS); \
      _Pragma("unroll") for (int r = 0; r < 16; ++r) ST[r32 * 136 + 32 * di + crow(r, hi)] = f2bf(accS[r]); } \
    LBAR(); } while (0)
  DN_STAGE_LD(0, 0); DN_STAGE_ST(0, 0); DN_STAGE_LD(1, 1); DN_STAGE_LD(2, 2);
  DN_LOAD(fs[0], gls[0], 0); DN_LOAD(fs[1], gls[1], 1);
  __syncthreads();
  for (int nb6 = 0; nb6 < NCH; nb6 += 6) {
#pragma unroll
    for (int k = 0; k < 6; ++k) {
      const int n = nb6 + k; const int n2 = n + 2 < NCH ? n + 2 : NCH - 1; const int n3 = n + 3 < NCH ? n + 3 : NCH - 1;
      DN_STAGE_ST((k + 1) % 3, (k + 1) & 1);
      DN_STAGE_LD(k % 3, n3);
      DN_LOAD(fs[(k + 2) % 3], gls[(k + 2) % 3], n2);
      DN_STEP(fs[k % 3], gls[k % 3], n, k & 1);
    }
  }
#undef DN_CH
#undef DN_LOAD
#undef DN_STAGE_LD
#undef DN_STAGE_ST
#undef DN_STEP
}

__device__ __forceinline__ void dn_scan(const P& p, char* lds, int job) {
  const int wid = TIDX() >> 6;
  if (wid < 2) dn_scan_t<0>(p, lds, job); else if (wid < 4) dn_scan_t<1>(p, lds, job); else dn_scan_t<2>(p, lds, job);
}

DI float fast_logsig(float s) { return fminf(s, 0.f) - __logf(1.f + __expf(-fabsf(s))); }
struct GlaRegs { h16x8 ba, bb; bf16x8 qa, qb, ka, kb, v8; };
template <int ROLE>
__device__ __forceinline__ void gla_scan_t(const P& p, char* lds, int job, int e) {
  const int tid = TIDX(), wid = tid >> 6, lane = tid & 63, r32 = lane & 31, hi = lane >> 5;
  const int dir = job >> 5, b = (job >> 4) & 1, h = (job >> 2) & 3, n0 = (job & 3) * 32;
  const bf16_t* P2 = (const bf16_t*)(p.ws + OFF_D + D_P2); const float* SM = (const float*)(p.ws + OFF_SM);
  bf16_t* GLAO = (bf16_t*)(p.ws + OFF_D + D_GLAO);
  const _Float16* B16 = (const _Float16*)(p.ws + (dir ? OFF_B16_1 : OFF_WC));
  float* w2S = (float*)lds; float* b2S = w2S + 1024; float* aLb = b2S + 64;
  bf16_t* ops = (bf16_t*)(aLb + 128);
  constexpr int OPB = (4 * 64 + 32) * 72;
  bf16_t* attp = ops + 2 * OPB;
  bf16_t* STb = attp + 2 * 32 * 72;
  for (int i = tid; i < 2 * 32 * 72; i += 512) STb[i] = 0;
  f32x16 accS = {};
  __syncthreads();
  GlaRegs RG[3];
  int jb0 = 16 * (wid & 3); asm volatile("" : "+v"(jb0));
  int vtb0 = 8 * (wid & 3) * 72 + lane; asm volatile("" : "+v"(vtb0));
#define GLA_LOAD(R, n_) do { const int n__ = (n_) < NCH ? (n_) : NCH - 1; const int c__ = dir == 0 ? n__ : (n__ < 4 ? 3 - n__ : 135 - n__); const size_t row__ = (size_t)b * TB + (size_t)c__ * 64 + (dir ? 63 - lane : lane); \
    const _Float16* bp__ = B16 + ((((size_t)b * 4 + h) * NCH + n__) * 64 + lane) * 64 + 16 * (wid & 3); R.ba = *(const h16x8*)(bp__); R.bb = *(const h16x8*)(bp__ + 8); \
    const bf16_t* pr__ = P2 + row__ * 2048; R.qa = *(const bf16x8*)(pr__ + 512 + h * 64 + 16 * (wid & 3)); R.qb = *(const bf16x8*)(pr__ + 512 + h * 64 + 16 * (wid & 3) + 8); \
    R.ka = *(const bf16x8*)(pr__ + 768 + h * 64 + 16 * (wid & 3)); R.kb = *(const bf16x8*)(pr__ + 768 + h * 64 + 16 * (wid & 3) + 8); R.v8 = *(const bf16x8*)(pr__ + 1024 + h * 128 + n0 + 8 * (wid & 3)); } while (0)
#define GLA_HALF(R, BV, QV, KV, jb) do { \
    float eqe[8], eke[8], eqi[8]; \
    _Pragma("unroll") for (int jj = 0; jj < 8; ++jj) { const int j = (jb) + jj; const float bb = (float)BV[jj]; const float bm = __int_as_float(__builtin_amdgcn_readlane(__float_as_int(bb), 32)), bl = __int_as_float(__builtin_amdgcn_readlane(__float_as_int(bb), 63)); \
      const float q_ = bf2f((bf16_t)QV[jj]) * 0.125f, k_ = bf2f((bf16_t)KV[jj]); \
      eqe[jj] = q_ * __expf(bb - bm); eke[jj] = k_ * __expf(bm - bb); eqi[jj] = q_ * __expf(bb); ksT_[j * 72 + lane] = f2bf(k_ * __expf(bl - bb)); if (lane == 63) aL_[j] = __expf(bl); } \
    *(u32x4*)(qe_ + lane * 72 + (jb)) = (u32x4){cvtpk(eqe[0], eqe[1]), cvtpk(eqe[2], eqe[3]), cvtpk(eqe[4], eqe[5]), cvtpk(eqe[6], eqe[7])}; \
    *(u32x4*)(ke_ + lane * 72 + (jb)) = (u32x4){cvtpk(eke[0], eke[1]), cvtpk(eke[2], eke[3]), cvtpk(eke[4], eke[5]), cvtpk(eke[6], eke[7])}; \
    *(u32x4*)(qi_ + lane * 72 + (jb)) = (u32x4){cvtpk(eqi[0], eqi[1]), cvtpk(eqi[2], eqi[3]), cvtpk(eqi[4], eqi[5]), cvtpk(eqi[6], eqi[7])}; } while (0)
#define GLA_PREP(R, bf_) do { bf16_t* qe_ = ops + (bf_) * OPB; bf16_t* ke_ = qe_ + 64 * 72; bf16_t* qi_ = ke_ + 64 * 72; bf16_t* ksT_ = qi_ + 64 * 72; bf16_t* vT_ = ksT_ + 64 * 72; float* aL_ = aLb + (bf_) * 64; \
    GLA_HALF(R, R.ba, R.qa, R.ka, jb0); GLA_HALF(R, R.bb, R.qb, R.kb, jb0 + 8); \
    _Pragma("unroll") for (int q_ = 0; q_ < 8; ++q_) vT_[vtb0 + q_ * 72] = (bf16_t)R.v8[q_]; } while (0)
#define GLA_MMA(n_, bf_) do { const int nq__ = (n_); const int bf = (bf_); \
      const bf16_t* qe_ = ops + bf * OPB; const bf16_t* ke_ = qe_ + 64 * 72; const bf16_t* qi_ = ke_ + 64 * 72; const bf16_t* ksT_ = qi_ + 64 * 72; const bf16_t* vT_ = ksT_ + 64 * 72; const float* aL_ = aLb + bf * 64; \
      const bf16_t* STr = STb + bf * 32 * 72; bf16_t* STw = STb + (bf ^ 1) * 32 * 72; \
      if (ROLE == 1) { \
        const int mi = wid - 4; bf16_t* attw = attp + mi * 32 * 72; \
        const int c = dir == 0 ? nq__ : (nq__ < 4 ? 3 - nq__ : 135 - nq__); const size_t Rb = (size_t)b * TB + (size_t)c * 64; \
        f32x16 acc = {}; acc = mma_rows<4>(qi_ + (32 * mi + r32) * 72 + hi * 8, STr + r32 * 72 + hi * 8, acc); \
        { f32x16 a0 = {}; a0 = mma_rows<4>(qe_ + (32 * mi + r32) * 72 + hi * 8, ke_ + r32 * 72 + hi * 8, a0); \
          _Pragma("unroll") for (int r = 0; r < 16; ++r) { const int ipl = crow(r, hi); attw[ipl * 72 + r32] = f2bf((mi == 1 || r32 <= ipl) ? a0[r] : 0.f); } \
          f32x16 a1 = {}; if (mi == 1) a1 = mma_rows<4>(qe_ + (32 + r32) * 72 + hi * 8, ke_ + (32 + r32) * 72 + hi * 8, a1); \
          _Pragma("unroll") for (int r = 0; r < 16; ++r) { const int ipl = crow(r, hi); attw[ipl * 72 + 32 + r32] = f2bf((mi == 1 && r32 <= ipl) ? a1[r] : 0.f); } } \
        asm volatile("s_waitcnt lgkmcnt(0)" ::: "memory"); \
        acc = mma_rows<4>(attw + r32 * 72 + hi * 8, vT_ + r32 * 72 + hi * 8, acc); \
        _Pragma("unroll") for (int r = 0; r < 16; ++r) { const int ip = 32 * mi + crow(r, hi), t = dir ? 63 - ip : ip; \
          GLAO[((size_t)dir * MROWS + Rb + t) * 512 + h * 128 + n0 + r32] = f2bf(acc[r]); } \
      } else { \
        const int di = wid - 6; \
        _Pragma("unroll") for (int r = 0; r < 16; ++r) accS[r] *= aL_[32 * di + crow(r, hi)]; \
        accS = mma_rows<4>(ksT_ + (32 * di + r32) * 72 + hi * 8, vT_ + r32 * 72 + hi * 8, accS); \
        _Pragma("unroll") for (int r = 0; r < 16; ++r) STw[r32 * 72 + 32 * di + crow(r, hi)] = f2bf(accS[r]); \
      } } while (0)
  GLA_LOAD(RG[0], 0);
  if (ROLE == 0) { GLA_PREP(RG[0], 0); }
  GLA_LOAD(RG[1], 1); GLA_LOAD(RG[2], 2); GLA_LOAD(RG[0], 3);
  LBAR();
  for (int nb6 = 0; nb6 < NCH; nb6 += 6) {
#pragma unroll
    for (int k = 0; k < 6; ++k) {
      const int n = nb6 + k;
      if (ROLE == 0) { if (n + 1 < NCH) { GLA_PREP(RG[(k + 1) % 3], (k + 1) & 1); } } else { GLA_MMA(n, k & 1); }
      GLA_LOAD(RG[(k + 1) % 3], n + 4);
      LBAR();
    }
  }
#undef GLA_MMA
#undef GLA_LOAD
#undef GLA_HALF
#undef GLA_PREP
}

__device__ __forceinline__ void gla_scan(const P& p, char* lds, int job, int e) {
  const int wid = TIDX() >> 6;
  if (wid < 4) gla_scan_t<0>(p, lds, job, e); else if (wid < 6) gla_scan_t<1>(p, lds, job, e); else gla_scan_t<2>(p, lds, job, e);
}

__device__ __forceinline__ void ph_merge(const P& p, int e) {
  const int tid = TIDX(), wid = tid >> 6, lane = tid & 63, l16 = lane & 15, sub = lane >> 4;
  const bf16_t* DNO = (const bf16_t*)(p.ws + OFF_D + D_DNO); const bf16_t* GLAO = (const bf16_t*)(p.ws + OFF_D + D_GLAO);
  const bf16_t* P2 = (const bf16_t*)(p.ws + OFF_D + D_P2); bf16_t* hb = (bf16_t*)(p.ws + OFF_HBF);
  f32x8 nwd = *(const f32x8*)(p.dn_norm + e * 128 + l16 * 8), nwg = *(const f32x8*)(p.gla_norm + e * 128 + l16 * 8);
  for (int R4 = (BIDX() * 8 + wid) * 4; R4 < MROWS; R4 += GDIM() * 32) {
    const size_t R = R4 + sub;
    bf16x8 a[8], bq[8], zz[8];
#pragma unroll
    for (int g = 0; g < 8; ++g) { const bf16_t* src = g < 4 ? DNO : GLAO; const int hc = (g & 3) * 128 + l16 * 8;
      a[g] = *(const bf16x8*)(src + R * 512 + hc); bq[g] = *(const bf16x8*)(src + ((size_t)MROWS + R) * 512 + hc);
      zz[g] = *(const bf16x8*)(P2 + R * 2048 + (g < 4 ? 0 : 1536) + hc); }
#pragma unroll
    for (int g = 0; g < 8; ++g) {
      float v[8]; float ss = 0.f;
#pragma unroll
      for (int j = 0; j < 8; ++j) { v[j] = bf2f((bf16_t)a[g][j]) + bf2f((bf16_t)bq[g][j]); ss += v[j] * v[j]; }
      ss += __shfl_xor(ss, 1); ss += __shfl_xor(ss, 2); ss += __shfl_xor(ss, 4); ss += __shfl_xor(ss, 8);
      const float rs = rsqrtf(ss * (1.f / 128.f) + EPSF);
      float o[8];
#pragma unroll
      for (int j = 0; j < 8; ++j) o[j] = v[j] * rs * (g < 4 ? nwd[j] : nwg[j]) * siluf(bf2f((bf16_t)zz[g][j]));
      *(u32x4*)(hb + R * 1024 + g * 128 + l16 * 8) = (u32x4){cvtpk(o[0], o[1]), cvtpk(o[2], o[3]), cvtpk(o[4], o[5]), cvtpk(o[6], o[7])};
    }
  }
}

DI float silu_fast(float x) { return x / (1.f + __expf(-x)); }
__device__ __forceinline__ void ph_ffnact(const P& p, int L) {
  bf16_t* U = (bf16_t*)(p.ws + OFF_D);
  const float* cw = p.ffn_conv + (size_t)L * 3 * DFF;
  const size_t items = (size_t)MROWS * 352, stride = (size_t)GDIM() * 512;
  for (size_t it0 = (size_t)BIDX() * 512 + TIDX(); it0 < items; it0 += 2 * stride) {
    bf16x8 zc[2], zp[2], zn[2], vv[2]; int Rr[2], cc[2]; bool ok[2];
#pragma unroll
    for (int q = 0; q < 2; ++q) {
      size_t it = it0 + q * stride; ok[q] = it < items; if (!ok[q]) it = it0;
      const int R = (int)(it / 352), c0 = (int)(it % 352) * 8; const int b = R >= TB ? 1 : 0, pp = R - b * TB;
      const bool hasp = !(pp == 0 || pp == CTXL), hasn = !(pp == CTXL - 1 || pp == TB - 1);
      Rr[q] = R; cc[q] = c0;
      zc[q] = *(const bf16x8*)(U + (size_t)R * 5632 + c0);
      zp[q] = *(const bf16x8*)(U + (size_t)(hasp ? R - 1 : R) * 5632 + c0);
      zn[q] = *(const bf16x8*)(U + (size_t)(hasn ? R + 1 : R) * 5632 + c0);
      vv[q] = *(const bf16x8*)(U + (size_t)R * 5632 + DFF + c0);
      if (!hasp) zp[q] = (bf16x8){0, 0, 0, 0, 0, 0, 0, 0};
      if (!hasn) zn[q] = (bf16x8){0, 0, 0, 0, 0, 0, 0, 0};
    }
#pragma unroll
    for (int q = 0; q < 2; ++q) {
      const int c0 = cc[q];
      const f32x8 w0 = *(const f32x8*)(cw + c0), w1 = *(const f32x8*)(cw + DFF + c0), w2 = *(const f32x8*)(cw + 2 * DFF + c0);
      float o[8];
#pragma unroll
      for (int j = 0; j < 8; ++j) { const float a = bf2f((bf16_t)zp[q][j]) * w0[j] + bf2f((bf16_t)zc[q][j]) * w1[j] + bf2f((bf16_t)zn[q][j]) * w2[j];
        o[j] = silu_fast(a) * bf2f((bf16_t)vv[q][j]); }
      if (ok[q]) *(u32x4*)(U + (size_t)Rr[q] * 5632 + DFF + c0) = (u32x4){cvtpk(o[0], o[1]), cvtpk(o[2], o[3]), cvtpk(o[4], o[5]), cvtpk(o[6], o[7])};
    }
  }
}

__device__ __forceinline__ void ph_qknorm(const P& p, char* lds, int o) {
  const int tid = TIDX(), wid = tid >> 6, lane = tid & 63, l16 = lane & 15, sub = lane >> 4;
  bf16_t* QKV = (bf16_t*)(p.ws + OFF_D);
  float* tab = (float*)lds;
  for (int i = tid; i < 4096; i += 512) { const int pos = i >> 5, f = i & 31; const float ang = (float)pos * powf(10000.f, -(float)f / 32.f); tab[2 * i] = cosf(ang); tab[2 * i + 1] = sinf(ang); }
  __syncthreads();
  const f32x8 qn = *(const f32x8*)(p.att_q_norm + o * 128 + l16 * 8), kn = *(const f32x8*)(p.att_k_norm + o * 128 + l16 * 8);
  const int f0 = (l16 & 3) * 8;
  for (int R4 = (BIDX() * 8 + wid) * 4; R4 < MROWS; R4 += GDIM() * 32) {
    const int R = R4 + sub; const int b = R >= TB ? 1 : 0, pp = R - b * TB; const bool lat = pp >= CTXL; const int t = lat ? pp - CTXL : 0;
    const int pos = (l16 < 8) ? (t >> 6) : (t & 63);
    bf16_t* base = QKV + (size_t)R * 1536 + l16 * 8;
    bf16x8 x[10];
#pragma unroll
    for (int hd = 0; hd < 10; ++hd) x[hd] = *(const bf16x8*)(base + hd * 128);
    float cs[8], sn[8];
#pragma unroll
    for (int j = 0; j < 8; ++j) { const float2 t2 = *(const float2*)(tab + 2 * (pos * 32 + f0 + j)); cs[j] = lat ? t2.x : 1.f; sn[j] = lat ? t2.y : 0.f; }
#pragma unroll
    for (int hd = 0; hd < 10; ++hd) {
      float v[8]; float ss = 0.f;
#pragma unroll
      for (int j = 0; j < 8; ++j) { v[j] = bf2f((bf16_t)x[hd][j]); ss += v[j] * v[j]; }
      ss += __shfl_xor(ss, 1); ss += __shfl_xor(ss, 2); ss += __shfl_xor(ss, 4); ss += __shfl_xor(ss, 8);
      const float rs = rsqrtf(ss * (1.f / 128.f) + EPSF);
      float ov[8];
#pragma unroll
      for (int j = 0; j < 8; ++j) { v[j] = v[j] * rs * (hd < 8 ? qn[j] : kn[j]); const float pr = __shfl_xor(v[j], 4);
        ov[j] = (l16 & 4) ? (pr * sn[j] + v[j] * cs[j]) : (v[j] * cs[j] - pr * sn[j]); }
      *(u32x4*)(base + hd * 128) = (u32x4){cvtpk(ov[0], ov[1]), cvtpk(ov[2], ov[3]), cvtpk(ov[4], ov[5]), cvtpk(ov[6], ov[7])};
    }
  }
}

__device__ __forceinline__ void qk_fused(const P& p, char* lds, int o) {
  const int tid = TIDX(), l16 = tid & 15, grp = tid >> 4;
  bf16_t* QKV = (bf16_t*)(p.ws + OFF_D);
  float* tab = (float*)lds;
  for (int i = tid; i < 4096; i += 512) { const int pos = i >> 5, f = i & 31; const float ang = (float)pos * powf(10000.f, -(float)f / 32.f); tab[2 * i] = cosf(ang); tab[2 * i + 1] = sinf(ang); }
  asm volatile("s_waitcnt vmcnt(0)" ::: "memory");
  __syncthreads();
  const int f0 = (l16 & 3) * 8;
  pg8::SchedX S; S.so.init(MROWS, 1536, GDIM(), BIDX()); S.mode = 0;
  pg8::Unit u;
  for (int ui = 0; S.next(ui, u); ++ui) {
    if (u.pn >= 5) continue;
    const f32x8 nw = *(const f32x8*)((u.pn < 4 ? p.att_q_norm : p.att_k_norm) + o * 128 + l16 * 8);
    for (int it0 = grp; it0 < 512; it0 += 128) {
      bf16x8 x[4]; bf16_t* base[4]; int pos[4]; bool lat[4];
#pragma unroll
      for (int q = 0; q < 4; ++q) { const int it = it0 + q * 32;
        const int R = u.pm * 256 + (it >> 1); const int b = R >= TB ? 1 : 0, pp = R - b * TB; lat[q] = pp >= CTXL; const int t = lat[q] ? pp - CTXL : 0;
        pos[q] = (l16 < 8) ? (t >> 6) : (t & 63);
        base[q] = QKV + (size_t)R * 1536 + u.pn * 256 + (it & 1) * 128 + l16 * 8; x[q] = *(const bf16x8*)base[q]; }
#pragma unroll
      for (int q = 0; q < 4; ++q) {
        float v[8]; float ss = 0.f;
#pragma unroll
        for (int j = 0; j < 8; ++j) { v[j] = bf2f((bf16_t)x[q][j]); ss += v[j] * v[j]; }
        ss += __shfl_xor(ss, 1); ss += __shfl_xor(ss, 2); ss += __shfl_xor(ss, 4); ss += __shfl_xor(ss, 8);
        const float rs = rsqrtf(ss * (1.f / 128.f) + EPSF);
        float ov[8];
#pragma unroll
        for (int j = 0; j < 8; ++j) { const float2 t2 = *(const float2*)(tab + 2 * (pos[q] * 32 + f0 + j)); const float cs = lat[q] ? t2.x : 1.f, sn = lat[q] ? t2.y : 0.f;
          v[j] = v[j] * rs * nw[j]; const float pr = __shfl_xor(v[j], 4);
          ov[j] = (l16 & 4) ? (pr * sn + v[j] * cs) : (v[j] * cs - pr * sn); }
        *(u32x4*)base[q] = (u32x4){cvtpk(ov[0], ov[1]), cvtpk(ov[2], ov[3]), cvtpk(ov[4], ov[5]), cvtpk(ov[6], ov[7])};
      }
    }
  }
}

namespace at {
constexpr int D = 128, NW = 8, QBLK = 32, KVBLK = 64;
constexpr float SCALE = 0.088388347648318440f, THR = 8.f;
constexpr int LDQ = 1536, LDK = 1536, LDO = 1024;
constexpr size_t SHM_V = KVBLK * D * 2, SHM_K = KVBLK * D * 2;
#define KSWZ(row, colB) ((row) * 256 + ((colB) ^ (((row) & 7) << 4)))
#define SBAR() __builtin_amdgcn_sched_barrier(0)
DI void partialSM(f32x16& p0, f32x16& p1, float& m_reg, float& mn, float& alpha) {
  constexpr float C = SCALE * 1.4426950408889634f;
  float pmax = p0[0]; for (int r = 1; r < 16; ++r) pmax = fmaxf(pmax, p0[r]); for (int r = 0; r < 16; ++r) pmax = fmaxf(pmax, p1[r]);
  { auto rr = __builtin_amdgcn_permlane32_swap(__float_as_uint(pmax), __float_as_uint(pmax), false, false);
    pmax = fmaxf(__uint_as_float(rr[0]), __uint_as_float(rr[1])); }
  if (__builtin_expect(__all(pmax - m_reg <= THR / SCALE), 1)) { mn = m_reg; alpha = 1.f; }
  else { mn = fmaxf(m_reg, pmax); alpha = __builtin_amdgcn_exp2f((m_reg - mn) * C); m_reg = mn; }
  float mnC = -mn * C;
  for (int r = 0; r < 16; ++r) p0[r] = fmaf(p0[r], C, mnC); for (int r = 0; r < 16; ++r) p1[r] = fmaf(p1[r], C, mnC);
  for (int r = 0; r < 16; ++r) p0[r] = __builtin_amdgcn_exp2f(p0[r]);
}
DI void finishSM(f32x16& p0, f32x16& p1, float alpha, float& l_reg, bf16x8& pa0, bf16x8& pa1, bf16x8& pa2, bf16x8& pa3) {
  for (int r = 0; r < 16; ++r) p1[r] = __builtin_amdgcn_exp2f(p1[r]);
  float ps = 0; for (int r = 0; r < 16; ++r) ps += p0[r]; for (int r = 0; r < 16; ++r) ps += p1[r];
  { auto rr = __builtin_amdgcn_permlane32_swap(__float_as_uint(ps), __float_as_uint(ps), false, false);
    ps = __uint_as_float(rr[0]) + __uint_as_float(rr[1]); }
  l_reg = l_reg * alpha + ps;
#define PK4(PP, BASE, OUT) do { unsigned a0 = cvtpk(PP[BASE + 0], PP[BASE + 1]), a1 = cvtpk(PP[BASE + 2], PP[BASE + 3]);   \
    unsigned b0 = cvtpk(PP[BASE + 4], PP[BASE + 5]), b1 = cvtpk(PP[BASE + 6], PP[BASE + 7]);                              \
    auto r0 = __builtin_amdgcn_permlane32_swap(a0, b0, false, false); auto r1 = __builtin_amdgcn_permlane32_swap(a1, b1, false, false); \
    u32x4 w = {r0[0], r1[0], r0[1], r1[1]}; OUT = *reinterpret_cast<bf16x8*>(&w); } while (0)
  PK4(p0, 0, pa0); PK4(p0, 8, pa1); PK4(p1, 0, pa2); PK4(p1, 8, pa3);
#undef PK4
}
DI void qkt(f32x16& p0, f32x16& p1, const bf16_t* Ks, const bf16x8* qr, int r32, int hi) {
  p0 = f32x16{}; p1 = f32x16{};
  for (int d0 = 0; d0 < 8; ++d0) { int cb = (d0 * 16 + hi * 8) * 2;
    bf16x8 b0 = *reinterpret_cast<const bf16x8*>((const char*)Ks + KSWZ(r32, cb));
    bf16x8 b1 = *reinterpret_cast<const bf16x8*>((const char*)Ks + KSWZ(32 + r32, cb));
    p0 = MFMA32(b0, qr[d0], p0);
    p1 = MFMA32(b1, qr[d0], p1); }
}
DI int v_st(int k, int c) { const int kk = (k & ~0xC) | ((k & 4) << 1) | ((k & 8) >> 1); return ((kk >> 3) * 4 + (c >> 5)) * 512 + ((kk & 7) * 32 + (c & 31)) * 2; }
DI int v_rd_base(int lane) { return ((lane & 3) << 3) | (((lane >> 2) & 3) << 6) | (((lane >> 4) & 1) << 5) | (((lane >> 5) & 1) << 8); }
constexpr int v_rd_off(int d0, int ks, int half) { return d0 * 512 + ks * 4096 + half * 2048; }
template <int OFF> DI s16x4 tr_read(int vb) {
  s16x4 r; asm volatile("ds_read_b64_tr_b16 %0, %1 offset:%2" : "=&v"(r) : "v"(vb), "i"(OFF) : "memory"); return r;
}
template <int D0> DI void pv_one(f32x16& od, int vb, bf16x8 pa0, bf16x8 pa1, bf16x8 pa2, bf16x8 pa3) {
  const s16x4 l0 = tr_read<v_rd_off(D0, 0, 0)>(vb), h0 = tr_read<v_rd_off(D0, 0, 1)>(vb), l1 = tr_read<v_rd_off(D0, 1, 0)>(vb), h1 = tr_read<v_rd_off(D0, 1, 1)>(vb);
  const s16x4 l2 = tr_read<v_rd_off(D0, 2, 0)>(vb), h2 = tr_read<v_rd_off(D0, 2, 1)>(vb), l3 = tr_read<v_rd_off(D0, 3, 0)>(vb), h3 = tr_read<v_rd_off(D0, 3, 1)>(vb);
  asm volatile("s_waitcnt lgkmcnt(0)" ::: "memory"); SBAR();
#define PK(Lx, Hx) (bf16x8){Lx[0], Lx[1], Lx[2], Lx[3], Hx[0], Hx[1], Hx[2], Hx[3]}
  od = MFMA32(pa0, PK(l0, h0), od);
  od = MFMA32(pa1, PK(l1, h1), od);
  od = MFMA32(pa2, PK(l2, h2), od);
  od = MFMA32(pa3, PK(l3, h3), od);
#undef PK
}
DI void pv_d0(f32x16* o, int vb, bf16x8 pa0, bf16x8 pa1, bf16x8 pa2, bf16x8 pa3) {
  pv_one<0>(o[0], vb, pa0, pa1, pa2, pa3); pv_one<1>(o[1], vb, pa0, pa1, pa2, pa3); pv_one<2>(o[2], vb, pa0, pa1, pa2, pa3); pv_one<3>(o[3], vb, pa0, pa1, pa2, pa3);
}
DI void attn_dense_body(const bf16_t* __restrict__ Qb, const bf16_t* __restrict__ Kh, const bf16_t* __restrict__ Vh, bf16_t* __restrict__ Ob, int seq, char* lds) {
  const int tid = TIDX(), wid = tid >> 6, lane = tid & 63, r32 = lane & 31, hi = lane >> 5;
  bf16_t* V_lds = (bf16_t*)lds; bf16_t* K_lds = (bf16_t*)(lds + 2 * SHM_V);
  float* ws = (float*)(lds + 2 * SHM_V + 2 * SHM_K) + wid * 64; float* li_l = ws; float* al_l = ws + 32;
  float m_reg = -1e30f, l_reg = 0; f32x16 o[4] = {}; bf16x8 qr[8];
  const bf16_t* Qw = Qb + (long)(wid * QBLK + r32) * LDQ + hi * 8;
#pragma unroll
  for (int d0 = 0; d0 < 8; ++d0) qr[d0] = *reinterpret_cast<const bf16x8*>(Qw + d0 * 16);
  const int sr = tid >> 4, sc = (tid & 15) * 8, vst0 = v_st(sr, sc), vst1 = v_st(32 + sr, sc);
  const int vb0 = (int)(uintptr_t)V_lds + v_rd_base(lane);
  struct { bf16x8 vs0, vs1, ks0, ks1; } sr_[2];
#define SLOAD(i, k0) do { sr_[i].vs0 = *(const bf16x8*)(&Vh[(long)((k0) + sr) * LDK + sc]); sr_[i].vs1 = *(const bf16x8*)(&Vh[(long)((k0) + 32 + sr) * LDK + sc]); \
    sr_[i].ks0 = *(const bf16x8*)(&Kh[(long)((k0) + sr) * LDK + sc]); sr_[i].ks1 = *(const bf16x8*)(&Kh[(long)((k0) + 32 + sr) * LDK + sc]); } while (0)
#define SWRITE(bq, i) do { *(bf16x8*)((char*)V_lds + (bq) * SHM_V + vst0) = sr_[i].vs0;          \
    *(bf16x8*)((char*)V_lds + (bq) * SHM_V + vst1) = sr_[i].vs1; int kc = sc * 2;               \
    *(bf16x8*)((char*)K_lds + (bq) * SHM_K + KSWZ(sr, kc)) = sr_[i].ks0;                       \
    *(bf16x8*)((char*)K_lds + (bq) * SHM_K + KSWZ(32 + sr, kc)) = sr_[i].ks1; } while (0)
#define SWAIT() asm volatile("s_waitcnt vmcnt(4)" ::: "memory")
#define RESC(a) do { if (__any((a) < 1.f)) { if (hi == 0) al_l[r32] = (a); asm volatile("s_waitcnt lgkmcnt(0)" ::: "memory"); \
    for (int d = 0; d < 4; ++d) for (int r = 0; r < 16; ++r) o[d][r] *= al_l[crow(r, hi)]; } } while (0)
  f32x16 pA0, pA1, pB0, pB1; float mnA, mnB, alA, alB; bf16x8 pa0, pa1, pa2, pa3; const int NT = seq / KVBLK;
  constexpr int SE = 0, SO = 1;
  SLOAD(SE, 0); asm volatile("s_waitcnt vmcnt(0)" ::: "memory"); SWRITE(0, SE); __syncthreads();
  qkt(pA0, pA1, K_lds, qr, r32, hi); partialSM(pA0, pA1, m_reg, mnA, alA);
  SLOAD(SO, KVBLK); if (2 < NT) SLOAD(SE, 2 * KVBLK);
  SWAIT(); SWRITE(1, SO); __syncthreads();
  for (int j = 1; j + 1 < NT; j += 2) {
    SBAR(); qkt(pB0, pB1, (bf16_t*)((char*)K_lds + SHM_K), qr, r32, hi);
    finishSM(pA0, pA1, alA, l_reg, pa0, pa1, pa2, pa3); SBAR();
    SLOAD(SO, (j + 2) * KVBLK); SBAR();
    pv_d0(o, vb0, pa0, pa1, pa2, pa3); partialSM(pB0, pB1, m_reg, mnB, alB);
    __syncthreads(); SWAIT(); SWRITE(0, SE);
    RESC(alB); __syncthreads();
    SBAR(); qkt(pA0, pA1, K_lds, qr, r32, hi);
    finishSM(pB0, pB1, alB, l_reg, pa0, pa1, pa2, pa3); SBAR();
    if (j + 3 < NT) SLOAD(SE, (j + 3) * KVBLK); SBAR();
    pv_d0(o, vb0 + (int)SHM_V, pa0, pa1, pa2, pa3); partialSM(pA0, pA1, m_reg, mnA, alA);
    __syncthreads(); SWAIT(); SWRITE(1, SO);
    RESC(alA); __syncthreads();
  }
  SBAR(); qkt(pB0, pB1, (bf16_t*)((char*)K_lds + SHM_K), qr, r32, hi);
  finishSM(pA0, pA1, alA, l_reg, pa0, pa1, pa2, pa3); SBAR();
  pv_d0(o, vb0, pa0, pa1, pa2, pa3); partialSM(pB0, pB1, m_reg, mnB, alB);
  __syncthreads(); RESC(alB);
  finishSM(pB0, pB1, alB, l_reg, pa0, pa1, pa2, pa3); SBAR();
  pv_d0(o, vb0 + (int)SHM_V, pa0, pa1, pa2, pa3);
  if (hi == 0) li_l[r32] = l_reg; asm volatile("s_waitcnt lgkmcnt(0)" ::: "memory");
  float rli[16];
#pragma unroll
  for (int r = 0; r < 16; ++r) rli[r] = __builtin_amdgcn_rcpf(li_l[crow(r, hi)]);
  bf16_t* Ow = Ob + (long)(wid * QBLK) * LDO;
#pragma unroll
  for (int r = 0; r < 16; ++r) { int orow = crow(r, hi);
    for (int d0 = 0; d0 < 4; ++d0) Ow[(long)orow * LDO + d0 * 32 + r32] = f2bf(o[d0][r] * rli[r]); }
#undef SLOAD
#undef SWRITE
#undef SWAIT
#undef RESC
}
}

__device__ __forceinline__ void ph_attn(const P& p, char* lds, bool need_ctx) {
  const bf16_t* QKV = (const bf16_t*)(p.ws + OFF_D); bf16_t* hb = (bf16_t*)(p.ws + OFF_HBF);
  const int nunits = need_ctx ? 528 : 512;
  for (int u = BIDX(); u < nunits; u += GDIM()) {
    int b, h, seq; size_t qrow;
    if (u < 512) { b = u >> 8; const int rem = u & 255; h = rem >> 5; qrow = (size_t)b * TB + CTXL + (size_t)(rem & 31) * 256; seq = TB; }
    else { const int uu = u - 512; b = uu >> 3; h = uu & 7; qrow = (size_t)b * TB; seq = CTXL; }
    const int kvh = h >> 2;
    const bf16_t* Kh = QKV + (size_t)b * TB * 1536 + 1024 + kvh * 128;
    const bf16_t* Vh = QKV + (size_t)b * TB * 1536 + 1280 + kvh * 128;
    at::attn_dense_body(QKV + qrow * 1536 + h * 128, Kh, Vh, hb + qrow * 1024 + h * 128, seq, lds);
    __syncthreads();
  }
}

__device__ __forceinline__ void ph_final(const P& p) {
  const int tid = TIDX(), wid = tid >> 6, lane = tid & 63;
  const float* xr = (const float*)(p.ws + OFF_XRES);
  for (int q = BIDX() * 8 + wid; q < 2 * LAT; q += GDIM() * 8) {
    const int b = q >> 13, t = q & (LAT - 1); const float* row = xr + ((size_t)b * TB + CTXL + t) * 1024;
    f32x4 v[4]; float ss = 0.f;
#pragma unroll
    for (int i = 0; i < 4; ++i) { v[i] = *(const f32x4*)(row + i * 256 + lane * 4); ss += v[i][0] * v[i][0] + v[i][1] * v[i][1] + v[i][2] * v[i][2] + v[i][3] * v[i][3]; }
    ss = wave_sum(ss); const float rs = rsqrtf(ss * (1.f / 1024.f) + EPSF);
#pragma unroll
    for (int i = 0; i < 4; ++i) { const int c0 = i * 256 + lane * 4; const f32x4 g = *(const f32x4*)(p.final_norm + c0); f32x4 o = v[i] * rs * g; *(f32x4*)(p.out + (size_t)q * 1024 + c0) = o; }
  }
}

#ifndef ONLY_PH
#define ONLY_PH -1
#endif
#define EN(x) (ONLY_PH < 0 || ONLY_PH == (x))
#ifndef PROBE_REP
#define PROBE_REP -1
#endif
#define RUN(cls, ...) do { if (EN(cls)) { for (int rep_ = 0; rep_ < ((PROBE_REP == (cls)) ? 2 : 1); ++rep_) { if (rep_) xcd_barrier(*xbp); __VA_ARGS__; } } } while (0)
enum { OP_INIT, OP_N1FULL, OP_IN, OP_PREP, OP_D1, OP_SCAN, OP_MERGE, OP_OUTLAT, OP_OUTCTX_N2LAT, OP_N2CTX, OP_UP, OP_ACT, OP_DOWNLAT, OP_DOWNCTX_N1LAT, OP_N1CTX,
       OP_QKV, OP_QKNORM, OP_ATTN, OP_N2FULL, OP_FINAL };
constexpr int NPHASES = 46;
__device__ __forceinline__ void decode_phase(int ph, int& op, int& L) {
  if (ph == 0) { op = OP_INIT; L = 0; return; }
  if (ph == NPHASES - 1) { op = OP_FINAL; L = 3; return; }
  int q = ph - 1;
  if (q < 14) { L = 0; if (q == 0) { op = OP_N1FULL; return; } q -= 1; }
  else if (q < 24) { L = 1; q -= 14; }
  else if (q < 37) { L = 2; q -= 24; }
  else { L = 3; q -= 37; }
  if ((L & 1) == 0) {
    if (q < 5) { op = OP_IN + q; return; }
    q -= 5;
  } else {
    if (q < 2) { op = q == 0 ? OP_QKV : OP_ATTN; return; }
    q -= 2;
  }
  if (L < 3) { const int t[8] = {OP_OUTLAT, OP_OUTCTX_N2LAT, OP_N2CTX, OP_UP, OP_ACT, OP_DOWNLAT, OP_DOWNCTX_N1LAT, OP_N1CTX}; op = t[q]; }
  else { const int t[5] = {OP_OUTLAT, OP_N2FULL, OP_UP, OP_ACT, OP_DOWNLAT}; op = t[q]; }
}
__device__ __forceinline__ void run_phase(const P& p0, int ph, char* lds, const XcdBarrier* xbp) {
  P p = p0; { typedef __attribute__((address_space(1))) char gchar_t; size_t wi = (size_t)p0.ws; asm volatile("" : "+s"(wi)); p.ws = (char*)(gchar_t*)wi; }
  int op, L; decode_phase(ph, op, L);
  const int e = L >> 1, o = L >> 1;
  bf16_t* W1 = (bf16_t*)(p.ws + OFF_WC); bf16_t* W2 = (bf16_t*)(p.ws + OFF_WC + WC_W2); bf16_t* W3 = (bf16_t*)(p.ws + OFF_W3);
  bf16_t* hb = (bf16_t*)(p.ws + OFF_HBF); float* xr = (float*)(p.ws + OFF_XRES);
  const float* mods = (const float*)(p.ws + OFF_MODS) + (size_t)L * 3 * 6144;
  float* PART = (float*)(p.ws + OFF_D + D_END_F);
#define CVT_MIX(LL, skipb) do { const int L_ = (LL); if ((L_ & 1) == 0) { cvt_weight(p.rec_w_in + (size_t)(L_ >> 1) * 1024 * 3632, W1, 1024, 3632, NREC, true, skipb); cvt_weight(p.rec_w_out + (size_t)(L_ >> 1) * 1024 * 1024, W3, 1024, 1024, 1024, false, skipb); } \
    else { cvt_weight(p.att_w_qkv + (size_t)(L_ >> 1) * 1024 * 1536, W1, 1024, 1536, 1536, false, skipb); cvt_weight(p.att_w_out + (size_t)(L_ >> 1) * 1024 * 1024, W3, 1024, 1024, 1024, false, skipb); } } while (0)
#define CVT_FFN(LL, skipb) do { const int L_ = (LL); cvt_weight(p.ffn_w_up + (size_t)L_ * 1024 * 5632, W1, 1024, 5632, 5632, false, skipb); cvt_weight(p.ffn_w_down + (size_t)L_ * DFF * 1024, W2, DFF, 1024, 1024, false, skipb); } while (0)
  switch (op) {
    case OP_INIT: RUN(0, ph_init(p, lds); CVT_MIX(0, 0)); break;
    case OP_N1FULL: RUN(1, ph_norm(p, L, 0, 0, 0)); break;
    case OP_IN: RUN(2, gemm8(lds, hb, 1024, W1, 1024, NREC, 0, EpiRec8{(bf16_t*)(p.ws + OFF_D + D_P1), (bf16_t*)(p.ws + OFF_D + D_P2), (float*)(p.ws + OFF_SM)})); break;
    case OP_PREP: RUN(3, ph_dnprep(p, lds, e)); break;
    case OP_D1: RUN(4, ph_dn_d1(p, lds); ph_gla_b(p, lds, e)); break;
    case OP_SCAN: RUN(5, if (BIDX() < 64) { dn_scan(p, lds, BIDX()); } else if (BIDX() < 128) { gla_scan(p, lds, BIDX() - 64, e); });
        if (PROBE_REP == 55) { xcd_barrier(*xbp); if (BIDX() < 64) { dn_scan(p, lds, BIDX()); } }
        if (PROBE_REP == 56) { xcd_barrier(*xbp); if (BIDX() >= 64 && BIDX() < 128) { gla_scan(p, lds, BIDX() - 64, e); } }
        break;
    case OP_MERGE: RUN(7, ph_merge(p, e)); break;
    case OP_QKV: if (EN(2)) { gemm8(lds, hb, 1024, W1, 1024, 1536, 0, EpiBf8{(bf16_t*)(p.ws + OFF_D), 1536}); qk_fused(p, lds, o); } break;
    case OP_ATTN: RUN(10, ph_attn(p, lds, L != 3)); break;
    case OP_OUTLAT: if (EN(2)) { gemm8(lds, hb, 1024, W3, 1024, 1024, 1, EpiRes8{xr, mods + 2 * 1024}); if (L == 3) CVT_FFN(L, 0); } break;
    case OP_OUTCTX_N2LAT: if (EN(2)) { if (BIDX() < 128) gemm_ctx_split(lds, hb, 1024, W3, 1024, 128, PART); ph_norm(p, L, 1, 1, 0); CVT_FFN(L, 0); } break;
    case OP_N2CTX: if (EN(1)) ph_ctx_fold_norm(p, L, 1, PART, 8, mods + 2 * 1024); break;
    case OP_N2FULL: if (EN(1)) ph_norm(p, L, 1, 0, 0); break;
    case OP_UP: RUN(2, gemm8(lds, hb, 1024, W1, 1024, 5632, L == 3 ? 1 : 0, EpiBf8{(bf16_t*)(p.ws + OFF_D), 5632})); break;
    case OP_ACT: if (EN(8)) ph_ffnact(p, L); break;
    case OP_DOWNLAT: if (EN(2)) gemm8(lds, (const bf16_t*)(p.ws + OFF_D) + DFF, 5632, W2, DFF, 1024, 1, EpiRes8{xr, mods + 5 * 1024}); break;
    case OP_DOWNCTX_N1LAT: if (EN(2)) { if (BIDX() < 176) gemm_ctx_split(lds, (const bf16_t*)(p.ws + OFF_D) + DFF, 5632, W2, DFF, 256, PART); ph_norm(p, L + 1, 0, 1, 0); CVT_MIX(L + 1, 0); } break;
    case OP_N1CTX: if (EN(1)) ph_ctx_fold_norm(p, L + 1, 0, PART, 11, mods + 5 * 1024); break;
    case OP_FINAL: if (EN(11)) ph_final(p); break;
  }
#undef CVT_MIX
#undef CVT_FFN
}

template <bool COOP>
__global__ void __launch_bounds__(512, 1) mk_kernel(P p, int ph0, int ph1) {
  extern __shared__ __attribute__((aligned(16))) char smem[];
  if constexpr (COOP) {
    if (ph0 < 0) cg::this_grid().sync();
    volatile LAS unsigned* st = (volatile LAS unsigned*)(smem + LDS_BYTES);
    if (threadIdx.x < 4) st[threadIdx.x] = 0u;
    __syncthreads();
    XcdBarrier xb = xcd_barrier_post((unsigned*)(p.ws + OFF_BAR), st);
    for (int ph = ph0; ph < ph1; ++ph) {
      run_phase(p, ph, smem, &xb);
      if (ph + 1 < ph1) xcd_barrier(xb);
      if (PROBE_REP == 99 && ph == 0) { for (int q = 0; q < 20; ++q) xcd_barrier(xb); }
    }
  } else {
    for (int ph = ph0; ph < ph1; ++ph) run_phase(p, ph, smem, nullptr);
  }
}

extern "C" void kernel_launch(void* const* d_in, const int* in_sizes, int n_in, void* d_out, int out_size, void* d_ws, size_t ws_size, hipStream_t stream) {
  if (n_in != 23 || ws_size < WS_NEED) { fprintf(stderr, "kernel_launch: bad n_in %d or ws %zu < %zu\n", n_in, ws_size, (size_t)WS_NEED); return; }
  P p{};
  const float** f = (const float**)&p;
  for (int i = 0; i < 23; ++i) f[i] = (const float*)d_in[i];
  p.out = (float*)d_out; p.ws = (char*)d_ws;
  static int inited = 0, grid_blocks = 0;
  if (!inited) {
    hipFuncSetAttribute((const void*)mk_kernel<true>, hipFuncAttributeMaxDynamicSharedMemorySize, LDS_BYTES + 16);
#if !MK_COOP
    hipFuncSetAttribute((const void*)mk_kernel<false>, hipFuncAttributeMaxDynamicSharedMemorySize, LDS_BYTES);
#endif
    int dev = 0, cus = 0, per_cu = 0;
    hipGetDevice(&dev); hipDeviceGetAttribute(&cus, hipDeviceAttributeMultiprocessorCount, dev);
    hipOccupancyMaxActiveBlocksPerMultiprocessor(&per_cu, mk_kernel<true>, 512, LDS_BYTES + 16);
    if (per_cu > 1) per_cu = 1;
    grid_blocks = cus * per_cu; if (grid_blocks > 256) grid_blocks = 256; if (grid_blocks < 128) grid_blocks = 128;
    inited = 1;
  }
#if MK_COOP
  int ph0 = 0, ph1 = NPHASES;
  void* args[] = {&p, &ph0, &ph1};
  hipMemsetAsync((char*)d_ws + OFF_BAR, 0, 3456 * 4, stream);
  hipError_t er = hipLaunchCooperativeKernel((const void*)mk_kernel<true>, dim3(grid_blocks), dim3(512), args, LDS_BYTES + 16, stream);
  if (er != hipSuccess) fprintf(stderr, "cooperative launch failed: %s (grid %d)\n", hipGetErrorString(er), grid_blocks);
#else
  for (int ph = 0; ph < NPHASES; ++ph) hipLaunchKernelGGL(mk_kernel<false>, dim3(256), dim3(512), LDS_BYTES, stream, p, ph, ph + 1);
#endif
}
```

```cpp
#include <hip/hip_runtime.h>
#include <hip/hip_cooperative_groups.h>
#include <cstdio>
#include <cstdint>
namespace cg = cooperative_groups;

#ifndef MK_COOP
#define MK_COOP 1
#endif

typedef unsigned short bf16_t;
typedef short bf16x8 __attribute__((ext_vector_type(8)));
typedef short s16x4 __attribute__((ext_vector_type(4)));
typedef float f32x16 __attribute__((ext_vector_type(16)));
typedef float f32x8 __attribute__((ext_vector_type(8)));
typedef float f32x4 __attribute__((ext_vector_type(4)));
typedef unsigned u32x4 __attribute__((ext_vector_type(4)));
#define DI __device__ __forceinline__
#define LBAR() do { asm volatile("s_waitcnt lgkmcnt(0)" ::: "memory"); __builtin_amdgcn_s_barrier(); asm volatile("" ::: "memory"); } while (0)
#define MFMA32(a, b, c) __builtin_amdgcn_mfma_f32_32x32x16_bf16((a), (b), (c), 0, 0, 0)

constexpr int DM = 1024, TB = 8448, CTXL = 256, LAT = 8192, MROWS = 2 * TB;
constexpr int NCH = 132;
constexpr int DFF = 2816;
constexpr int NREC = 3840;
constexpr float EPSF = 1e-6f;

constexpr size_t AL(size_t x) { return (x + 255) / 256 * 256; }
constexpr size_t OFF_XRES = 0;
constexpr size_t OFF_HBF = OFF_XRES + AL((size_t)MROWS * DM * 4);
constexpr size_t OFF_WC = OFF_HBF + AL((size_t)MROWS * DM * 2);
constexpr size_t WC_W2 = (size_t)5632 * 1024 * 2;
constexpr size_t OFF_MODS = OFF_WC + AL(WC_W2 + (size_t)1024 * 2816 * 2);
constexpr size_t OFF_SM = OFF_MODS + AL((size_t)4 * 3 * 6144 * 4);
constexpr size_t OFF_GB = OFF_SM + AL((size_t)MROWS * 64 * 4);
constexpr size_t OFF_SC = OFF_GB + AL((size_t)MROWS * 16 * 4);
constexpr size_t OFF_GL = OFF_SC + AL((size_t)16 * NCH * 64 * 2 * 4);
constexpr size_t OFF_D = OFF_GL + AL((size_t)16 * NCH * 4);
constexpr size_t D_P1 = 0;
constexpr size_t D_W = 0;
constexpr size_t D_INTRA = D_W + (size_t)16 * NCH * 64 * 128 * 2;
constexpr size_t D_P2 = D_P1 + (size_t)MROWS * 1536 * 2;
constexpr size_t D_QQ = D_P2 + (size_t)MROWS * 2048 * 2;
constexpr size_t D_QK = D_QQ + (size_t)MROWS * 512 * 2;
constexpr size_t D_QV = D_QK + (size_t)MROWS * 512 * 2;
constexpr size_t D_DNO = D_QK;
constexpr size_t D_KT = D_QV + (size_t)MROWS * 512 * 2;
constexpr size_t D_GLAO = D_KT + (size_t)MROWS * 512 * 2;
constexpr size_t D_END_E = D_GLAO + (size_t)2 * MROWS * 512 * 2;
constexpr size_t D_END_F = (size_t)MROWS * 5632 * 2;
constexpr size_t OFF_B16_1 = OFF_D + (D_END_E > D_END_F ? D_END_E : D_END_F);
constexpr size_t B16_BYTES = (size_t)8 * NCH * 64 * 64 * 2;
constexpr size_t OFF_BAR = OFF_B16_1 + AL(B16_BYTES);
constexpr size_t OFF_W3 = OFF_BAR + AL(3456 * 4);
constexpr size_t WS_NEED = OFF_W3 + (size_t)1024 * 1024 * 2;
constexpr int LDS_BYTES = 132 * 1024;

struct P {
  const float *x, *c, *ctx, *c_ctx, *mod_w, *mod_b, *rec_w_in, *rec_conv, *dn_a_log, *dn_dt_bias, *dn_norm, *gla_w2, *gla_b2, *gla_norm,
      *rec_w_out, *att_w_qkv, *att_q_norm, *att_k_norm, *att_w_out, *ffn_w_up, *ffn_conv, *ffn_w_down, *final_norm;
  float* out;
  char* ws;
};

DI int TIDX() { int t = threadIdx.x; asm volatile("" : "+v"(t)); return t; }
DI int BIDX() { int t = blockIdx.x; asm volatile("" : "+s"(t)); return t; }
DI int GDIM() { int t = gridDim.x; asm volatile("" : "+s"(t)); return t; }
DI float bf2f(bf16_t v) { return __uint_as_float(((unsigned)v) << 16); }
DI bf16_t f2bf(float x) { unsigned u = __float_as_uint(x); u += 0x7fffu + ((u >> 16) & 1u); return (bf16_t)(u >> 16); }
typedef __bf16 bf16n2 __attribute__((ext_vector_type(2)));
DI unsigned cvtpk(float lo, float hi) { const bf16n2 v = {(__bf16)lo, (__bf16)hi}; return __builtin_bit_cast(unsigned, v); }
DI int crow(int r, int hi) { return (r & 3) + 8 * (r >> 2) + 4 * hi; }
DI float siluf(float x) { return x / (1.f + expf(-x)); }
DI float sigmf(float x) { return 1.f / (1.f + expf(-x)); }
DI float softplusf(float x) { return fmaxf(x, 0.f) + log1pf(expf(-fabsf(x))); }
DI float wave_sum(float v) {
#pragma unroll
  for (int o = 32; o > 0; o >>= 1) v += __shfl_xor(v, o);
  return v;
}
DI int modrow_of(int R) { const int b = R >= TB ? 1 : 0; const int pp = R - b * TB; return pp < CTXL ? 2 : b; }
template <int KS>
DI f32x16 mma_rows(const bf16_t* arow, const bf16_t* brow, f32x16 acc) {
#pragma unroll
  for (int ks = 0; ks < KS; ++ks) {
    const bf16x8 a = *reinterpret_cast<const bf16x8*>(arow + ks * 16);
    const bf16x8 b = *reinterpret_cast<const bf16x8*>(brow + ks * 16);
    acc = MFMA32(a, b, acc);
  }
  return acc;
}

#define XB_TMO      128
#define XB_XCNT(j)  (256  + 64 * (j))
#define XB_XSUB(j)  (1280 + 64 * (j))
#define XB_XGEN(j)  (2304 + 64 * (j))
#define XB_TOP      3328
#define XB_TOPGEN   3392
#define XCD_BAR_WORDS 3456
#define XB_SPIN_CAP (1u << 18)
#define LAS __attribute__((address_space(3)))
DI unsigned xb_ld(unsigned* p)              { return __hip_atomic_load(p, __ATOMIC_RELAXED, __HIP_MEMORY_SCOPE_AGENT); }
DI unsigned xb_add(unsigned* p, unsigned v) { return __hip_atomic_fetch_add(p, v, __ATOMIC_RELAXED, __HIP_MEMORY_SCOPE_AGENT); }
DI unsigned xb_xcc_id() { return (unsigned)__builtin_amdgcn_s_getreg((3 << 11) | 20) & 0xFu; }
#define XB_SPIN(cond, bar) do { unsigned _sp = 0; while (cond) { __builtin_amdgcn_s_sleep(1); \
    if ((++_sp & 255u) == 0u) { if (xb_ld(&(bar)[XB_TMO])) break; if (_sp > XB_SPIN_CAP) { atomicAdd(&(bar)[XB_TMO], 1u); break; } } } } while (0)
struct XcdBarrier { unsigned* bar; unsigned x; volatile LAS unsigned* st; };
DI XcdBarrier xcd_barrier_post(unsigned* bar, volatile LAS unsigned* st) {
    XcdBarrier b; b.bar = bar; b.x = xb_xcc_id(); b.st = st;
    if (threadIdx.x == 0) (void)xb_add(&bar[XB_XCNT(b.x)], 1u);
    return b;
}
DI void xcd_barrier_complete(unsigned* bar, unsigned x, unsigned& nloc, unsigned& nx) {
    const unsigned G = gridDim.x * gridDim.y * gridDim.z;
    unsigned sum, cnt, mine, sp = 0u;
    for (;;) {
        sum = 0u; cnt = 0u; mine = 0u;
#pragma unroll
        for (unsigned j = 0; j < 16; ++j) { const unsigned c = xb_ld(&bar[XB_XCNT(j)]); sum += c; cnt += (c > 0u) ? 1u : 0u; mine = (j == x) ? c : mine; }
        if (sum == G) break;
        __builtin_amdgcn_s_sleep(1);
        if ((++sp & 255u) == 0u) { if (xb_ld(&bar[XB_TMO])) break; if (sp > XB_SPIN_CAP) { atomicAdd(&bar[XB_TMO], 1u); break; } }
    }
    nloc = mine > 0u ? mine : 1u; nx = cnt > 0u ? cnt : 1u;
}
DI void xcd_barrier(const XcdBarrier& b) {
    asm volatile("s_waitcnt vmcnt(0)" ::: "memory");
    __syncthreads();
    if (threadIdx.x == 0) {
        unsigned* bar = b.bar;
        __builtin_amdgcn_s_waitcnt(0);
        unsigned nloc = b.st[0], nx = b.st[1];
        if (nloc == 0u) { xcd_barrier_complete(bar, b.x, nloc, nx); b.st[0] = nloc; b.st[1] = nx; }
        const unsigned old = xb_add(&bar[XB_XSUB(b.x)], 1u);
        const unsigned gen = old / nloc;
        if (old + 1u == (gen + 1u) * nloc) {
            __builtin_amdgcn_fence(__ATOMIC_RELEASE, "agent");
            asm volatile("s_waitcnt vmcnt(0)" ::: "memory");
            const unsigned og = xb_add(&bar[XB_TOP], 1u);
            const unsigned tg = og / nx;
            if (og + 1u == (tg + 1u) * nx) xb_add(&bar[XB_TOPGEN], 1u);
            else XB_SPIN(xb_ld(&bar[XB_TOPGEN]) == tg, bar);
            __builtin_amdgcn_fence(__ATOMIC_ACQUIRE, "agent");
            xb_add(&bar[XB_XGEN(b.x)], 1u);
            asm volatile("s_waitcnt vmcnt(0)" ::: "memory");
        } else {
            XB_SPIN(xb_ld(&bar[XB_XGEN(b.x)]) == gen, bar);
            __builtin_amdgcn_fence(__ATOMIC_ACQUIRE, "agent");
            asm volatile("s_waitcnt vmcnt(0)" ::: "memory");
        }
    }
    __syncthreads();
}

__device__ __forceinline__ void ph_init(const P& p, char* lds) {
  const int tid = TIDX();
  float* sc = (float*)lds;
  float* red = sc + 3072;
  for (int i = tid; i < 3072; i += 512) { const int r = i >> 10, k = i & 1023; const float v = r < 2 ? p.c[r * 1024 + k] : p.c_ctx[k]; sc[i] = siluf(v); }
  __syncthreads();
  float* mods = (float*)(p.ws + OFF_MODS);
  for (int job = BIDX(); job < 192; job += GDIM()) {
    const int col = job * 128 + (tid & 127), kq = tid >> 7;
    const int L = col / 6144, cl = col - L * 6144;
    const float* w = p.mod_w + ((size_t)L * 1024 + kq * 256) * 6144 + cl;
    float a0 = 0.f, a1 = 0.f, a2 = 0.f;
#pragma unroll 8
    for (int k = 0; k < 256; ++k) { const float wv = w[(size_t)k * 6144]; const int kk = kq * 256 + k; a0 += sc[kk] * wv; a1 += sc[1024 + kk] * wv; a2 += sc[2048 + kk] * wv; }
    red[(kq * 3 + 0) * 128 + (tid & 127)] = a0; red[(kq * 3 + 1) * 128 + (tid & 127)] = a1; red[(kq * 3 + 2) * 128 + (tid & 127)] = a2;
    __syncthreads();
    if (tid < 384) { const int r = tid >> 7, cc = tid & 127; const int c2 = job * 128 + cc; const int L2 = c2 / 6144, cl2 = c2 - L2 * 6144;
      const float s = red[(0 * 3 + r) * 128 + cc] + red[(1 * 3 + r) * 128 + cc] + red[(2 * 3 + r) * 128 + cc] + red[(3 * 3 + r) * 128 + cc] + p.mod_b[L2 * 6144 + cl2];
      mods[((size_t)L2 * 3 + r) * 6144 + cl2] = s; }
    __syncthreads();
  }
  f32x4* xr = (f32x4*)(p.ws + OFF_XRES);
  for (size_t i = (size_t)BIDX() * 512 + tid; i < (size_t)MROWS * 256; i += (size_t)GDIM() * 512) {
    const int R = (int)(i >> 8), c4 = (int)(i & 255); const int b = R >= TB ? 1 : 0, pp = R - b * TB;
    const float* src = pp < CTXL ? p.ctx + ((size_t)b * CTXL + pp) * 1024 : p.x + ((size_t)b * LAT + (pp - CTXL)) * 1024;
    xr[i] = *(const f32x4*)(src + c4 * 4);
  }
}

DI int rec_src_col(int n) { if (n < 2048) return n; if (n < 3584) return n + 16; if (n < 3600) return 2048 + (n - 3584); if (n < 3632) return n; return -1; }
__device__ __forceinline__ void cvt_weight(const float* __restrict__ W, bf16_t* __restrict__ Wt, int K, int Nsrc, int Npad, bool perm, int skipb) {
  const size_t items = (size_t)Npad * (K >> 3);
  const int bid = BIDX() - skipb, nb = GDIM() - skipb;
  if (bid < 0) return;
  for (size_t it = (size_t)bid * 512 + TIDX(); it < items; it += (size_t)nb * 512) {
    const int n = (int)(it % Npad), kb = (int)(it / Npad);
    const int s = perm ? rec_src_col(n) : n;
    float v[8];
#pragma unroll
    for (int j = 0; j < 8; ++j) v[j] = s >= 0 ? W[(size_t)(kb * 8 + j) * Nsrc + s] : 0.f;
    u32x4 w = {cvtpk(v[0], v[1]), cvtpk(v[2], v[3]), cvtpk(v[4], v[5]), cvtpk(v[6], v[7])};
    *(u32x4*)(Wt + (size_t)n * K + kb * 8) = w;
  }
}

__device__ __forceinline__ void gemm_ctx_split(char* lds, const bf16_t* __restrict__ A, int lda, const bf16_t* __restrict__ Bt, int ldb, int Ks, float* __restrict__ PART) {
  const int tid = TIDX(), wid = tid >> 6, lane = tid & 63, r32 = lane & 31, hi = lane >> 5;
  const int wm = wid >> 1, wn = wid & 1;
  const int nk = Ks >> 6;
  constexpr int RS = 144, ASZ = 256 * RS, BSZ = 128 * RS, STG = ASZ + BSZ;
  const int srow = tid >> 3, spc = tid & 7;
  const int w = BIDX(); const int ks = w >> 4, j = w & 15; const int pm = (j >> 3) ? 33 : 0, pn = j & 7;
  const bf16_t* Ab = A + (size_t)(pm * 256 + srow) * lda + (size_t)ks * Ks + spc * 8;
  const bf16_t* Bb = Bt + (size_t)(pn * 128 + srow) * ldb + (size_t)ks * Ks + spc * 8;
  f32x16 acc00 = {}, acc01 = {}, acc10 = {}, acc11 = {};
  bf16x8 ra0, ra1, ra2, ra3, rb0, rb1;
#define GLOAD(kt) do { const int ko = (kt) * 64; ra0 = *(const bf16x8*)(Ab + ko); ra1 = *(const bf16x8*)(Ab + (size_t)64 * lda + ko); ra2 = *(const bf16x8*)(Ab + (size_t)128 * lda + ko); \
    ra3 = *(const bf16x8*)(Ab + (size_t)192 * lda + ko); rb0 = *(const bf16x8*)(Bb + ko); rb1 = *(const bf16x8*)(Bb + (size_t)64 * ldb + ko); } while (0)
#define SWRITE(buf) do { char* sb = lds + (buf) * STG + srow * RS + spc * 16; *(bf16x8*)(sb) = ra0; *(bf16x8*)(sb + 64 * RS) = ra1; *(bf16x8*)(sb + 128 * RS) = ra2; *(bf16x8*)(sb + 192 * RS) = ra3; \
    *(bf16x8*)(sb + ASZ) = rb0; *(bf16x8*)(sb + ASZ + 64 * RS) = rb1; } while (0)
  GLOAD(0); SWRITE(0); __syncthreads();
  for (int kt = 0; kt < nk; ++kt) {
    const int cur = kt & 1;
    if (kt + 1 < nk) GLOAD(kt + 1);
    const char* ab = lds + cur * STG + (64 * wm + r32) * RS + hi * 16;
    const char* bb = lds + cur * STG + ASZ + (64 * wn + r32) * RS + hi * 16;
#pragma unroll
    for (int k4 = 0; k4 < 4; ++k4) {
      const bf16x8 a0 = *(const bf16x8*)(ab + k4 * 32), a1 = *(const bf16x8*)(ab + 32 * RS + k4 * 32);
      const bf16x8 b0 = *(const bf16x8*)(bb + k4 * 32), b1 = *(const bf16x8*)(bb + 32 * RS + k4 * 32);
      acc00 = MFMA32(a0, b0, acc00); acc01 = MFMA32(a0, b1, acc01); acc10 = MFMA32(a1, b0, acc10); acc11 = MFMA32(a1, b1, acc11);
    }
    if (kt + 1 < nk) SWRITE(cur ^ 1);
    __syncthreads();
  }
#undef GLOAD
#undef SWRITE
  float* pb = PART + ((size_t)ks * 512 + (pm ? 256 : 0) + 64 * wm) * 1024 + pn * 128 + 64 * wn + r32;
#pragma unroll
  for (int r = 0; r < 16; ++r) { float* q = pb + (size_t)crow(r, hi) * 1024;
    q[0] = acc00[r]; q[32] = acc01[r]; q[32 * 1024] = acc10[r]; q[32 * 1024 + 32] = acc11[r]; }
}

__device__ __forceinline__ void ph_ctx_fold_norm(const P& p, int L, int which, const float* __restrict__ part, int nsplit, const float* __restrict__ gate) {
  const int tid = TIDX(), wid = tid >> 6, lane = tid & 63;
  float* xr = (float*)(p.ws + OFF_XRES); bf16_t* hb = (bf16_t*)(p.ws + OFF_HBF);
  const float* mods = (const float*)(p.ws + OFF_MODS) + (size_t)L * 3 * 6144;
  for (int cr = BIDX() * 8 + wid; cr < 2 * CTXL; cr += GDIM() * 8) {
    const int R = cr < CTXL ? cr : TB + (cr - CTXL);
    float* row = xr + (size_t)R * 1024 + lane * 4;
    const float* pr = part + (size_t)cr * 1024 + lane * 4;
    f32x4 v[4], a[4];
#pragma unroll
    for (int i = 0; i < 4; ++i) { v[i] = *(const f32x4*)(row + i * 256); a[i] = *(const f32x4*)(pr + i * 256); }
    for (int sp = 1; sp < nsplit; ++sp) {
#pragma unroll
      for (int i = 0; i < 4; ++i) a[i] += *(const f32x4*)(pr + (size_t)sp * 512 * 1024 + i * 256);
    }
    float ss = 0.f;
#pragma unroll
    for (int i = 0; i < 4; ++i) { v[i] += *(const f32x4*)(gate + 2 * 6144 + i * 256 + lane * 4) * a[i]; *(f32x4*)(row + i * 256) = v[i];
      ss += v[i][0] * v[i][0] + v[i][1] * v[i][1] + v[i][2] * v[i][2] + v[i][3] * v[i][3]; }
    ss = wave_sum(ss);
    const float rs = rsqrtf(ss * (1.f / 1024.f) + EPSF);
    const float* mr = mods + (size_t)2 * 6144 + which * 3072 + lane * 4;
#pragma unroll
    for (int i = 0; i < 4; ++i) { const f32x4 sh = *(const f32x4*)(mr + i * 256), scl = *(const f32x4*)(mr + 1024 + i * 256);
      float o[4];
#pragma unroll
      for (int j = 0; j < 4; ++j) o[j] = v[i][j] * rs * (1.f + scl[j]) + sh[j];
      uint2 w; w.x = cvtpk(o[0], o[1]); w.y = cvtpk(o[2], o[3]);
      *(uint2*)(hb + (size_t)R * 1024 + i * 256 + lane * 4) = w; }
  }
}

__device__ __forceinline__ void ph_norm(const P& p, int L, int which, int mode, int skipb) {
  const int tid = TIDX(), wid = tid >> 6, lane = tid & 63, l16 = lane & 15, sub = lane >> 4;
  const float* xr = (const float*)(p.ws + OFF_XRES);
  bf16_t* hb = (bf16_t*)(p.ws + OFF_HBF);
  const float* mods = (const float*)(p.ws + OFF_MODS) + (size_t)L * 3 * 6144;
  const int bid = BIDX() - skipb, nb = GDIM() - skipb;
  if (bid < 0) return;
  const int nquads = mode == 0 ? MROWS / 4 : (mode == 1 ? 2 * LAT / 4 : 2 * CTXL / 4);
  for (int q = bid * 8 + wid; q < nquads; q += nb * 8) {
    int R4;
    if (mode == 0) R4 = q * 4; else if (mode == 1) R4 = q < LAT / 4 ? CTXL + q * 4 : TB + CTXL + (q - LAT / 4) * 4; else R4 = q < CTXL / 4 ? q * 4 : TB + (q - CTXL / 4) * 4;
    const int R = R4 + sub;
    const float* row = xr + (size_t)R * 1024 + l16 * 8;
    f32x4 v[16]; float ss = 0.f;
#pragma unroll
    for (int i = 0; i < 8; ++i) { v[2 * i] = *(const f32x4*)(row + i * 128); v[2 * i + 1] = *(const f32x4*)(row + i * 128 + 4); }
#pragma unroll
    for (int i = 0; i < 16; ++i) ss += v[i][0] * v[i][0] + v[i][1] * v[i][1] + v[i][2] * v[i][2] + v[i][3] * v[i][3];
    ss += __shfl_xor(ss, 1); ss += __shfl_xor(ss, 2); ss += __shfl_xor(ss, 4); ss += __shfl_xor(ss, 8);
    const float rs = rsqrtf(ss * (1.f / 1024.f) + EPSF);
    const float* mr = mods + (size_t)modrow_of(R) * 6144 + which * 3072 + l16 * 8;
    bf16_t* dst = hb + (size_t)R * 1024 + l16 * 8;
#pragma unroll
    for (int i = 0; i < 8; ++i) { unsigned w[4];
#pragma unroll
      for (int hlf = 0; hlf < 2; ++hlf) { const f32x4 sh = *(const f32x4*)(mr + i * 128 + hlf * 4), scl = *(const f32x4*)(mr + 1024 + i * 128 + hlf * 4); const f32x4 x = v[2 * i + hlf];
        float o[4];
#pragma unroll
        for (int j = 0; j < 4; ++j) o[j] = x[j] * rs * (1.f + scl[j]) + sh[j];
        w[2 * hlf] = cvtpk(o[0], o[1]); w[2 * hlf + 1] = cvtpk(o[2], o[3]); }
      *(u32x4*)(dst + i * 128) = (u32x4){w[0], w[1], w[2], w[3]}; }
  }
}

struct EpiRec { bf16_t* P1; bf16_t* P2; float* SM;
  DI void operator()(int row, int col, float v) const {
    if (col < 1536) P1[(size_t)row * 1536 + col] = f2bf(v);
    else if (col < 3584) P2[(size_t)row * 2048 + (col - 1536)] = f2bf(v);
    else { const int lc = col - 3584; if (lc < 48) SM[(size_t)row * 64 + lc] = v; } } };
struct EpiBf { bf16_t* O; int ldc;
  DI void operator()(int row, int col, float v) const { O[(size_t)row * ldc + col] = f2bf(v); } };
struct EpiRes { float* X; const float* gate;
  DI void operator()(int row, int col, float v) const { float* q = X + (size_t)row * 1024 + col; *q = *q + gate[(size_t)modrow_of(row) * 6144 + col] * v; } };

template <class Epi>
__device__ __forceinline__ void gemm_phase(char* lds, const bf16_t* __restrict__ A, int lda, const bf16_t* __restrict__ Bt, int K, int nN, const Epi epi, bool skipctx = false) {
  const int tid = TIDX(), wid = tid >> 6, lane = tid & 63, r32 = lane & 31, hi = lane >> 5;
  const int wm = wid >> 1, wn = wid & 1;
  const int nk = K >> 6;
  constexpr int RS = 144, ASZ = 256 * RS, BSZ = 128 * RS, STG = ASZ + BSZ;
  const int ntiles = (skipctx ? 64 : MROWS / 256) * nN;
  const int srow = tid >> 3, spc = tid & 7;
  for (int t = BIDX(); t < ntiles; t += GDIM()) {
    int pm = t / nN; const int pn = t - pm * nN; if (skipctx) pm = pm + 1 + (pm >= 32 ? 1 : 0);
    const bf16_t* Ab = A + (size_t)(pm * 256 + srow) * lda + spc * 8;
    const bf16_t* Bb = Bt + (size_t)(pn * 128 + srow) * K + spc * 8;
    f32x16 acc00 = {}, acc01 = {}, acc10 = {}, acc11 = {};
    bf16x8 ra0, ra1, ra2, ra3, rb0, rb1;
#define GLOAD(kt) do { const int ko = (kt) * 64; ra0 = *(const bf16x8*)(Ab + ko); ra1 = *(const bf16x8*)(Ab + (size_t)64 * lda + ko); ra2 = *(const bf16x8*)(Ab + (size_t)128 * lda + ko); \
    ra3 = *(const bf16x8*)(Ab + (size_t)192 * lda + ko); rb0 = *(const bf16x8*)(Bb + ko); rb1 = *(const bf16x8*)(Bb + (size_t)64 * K + ko); } while (0)
#define SWRITE(buf) do { char* sb = lds + (buf) * STG + srow * RS + spc * 16; *(bf16x8*)(sb) = ra0; *(bf16x8*)(sb + 64 * RS) = ra1; *(bf16x8*)(sb + 128 * RS) = ra2; *(bf16x8*)(sb + 192 * RS) = ra3; \
    *(bf16x8*)(sb + ASZ) = rb0; *(bf16x8*)(sb + ASZ + 64 * RS) = rb1; } while (0)
    GLOAD(0); SWRITE(0); __syncthreads();
    for (int kt = 0; kt < nk; ++kt) {
      const int cur = kt & 1;
      if (kt + 1 < nk) GLOAD(kt + 1);
      const char* ab = lds + cur * STG + (64 * wm + r32) * RS + hi * 16;
      const char* bb = lds + cur * STG + ASZ + (64 * wn + r32) * RS + hi * 16;
#pragma unroll
      for (int ks = 0; ks < 4; ++ks) {
        const bf16x8 a0 = *(const bf16x8*)(ab + ks * 32), a1 = *(const bf16x8*)(ab + 32 * RS + ks * 32);
        const bf16x8 b0 = *(const bf16x8*)(bb + ks * 32), b1 = *(const bf16x8*)(bb + 32 * RS + ks * 32);
        acc00 = MFMA32(a0, b0, acc00); acc01 = MFMA32(a0, b1, acc01); acc10 = MFMA32(a1, b0, acc10); acc11 = MFMA32(a1, b1, acc11);
      }
      if (kt + 1 < nk) SWRITE(cur ^ 1);
      __syncthreads();
    }
#undef GLOAD
#undef SWRITE
    const int row0 = pm * 256 + 64 * wm, col0 = pn * 128 + 64 * wn + r32;
#pragma unroll
    for (int r = 0; r < 16; ++r) { const int rr = row0 + crow(r, hi);
      epi(rr, col0, acc00[r]); epi(rr, col0 + 32, acc01[r]); epi(rr + 32, col0, acc10[r]); epi(rr + 32, col0 + 32, acc11[r]); }
  }
}

namespace pg8 {
#define PG8_LAS __attribute__((address_space(3)))
constexpr int BM = 256, BK = 64, HALF = 128, HTB = HALF * BK * 2  , STAGE_BYTES = 8 * HTB, NXCD = 8, WGM = 8;

__host__ __device__ __forceinline__ int lds_byte(int r, int c) { const int st = (r >> 4) * 2 + (c >> 5), rr = r & 15, cc = c & 31, ob = rr * 64 + cc * 2; return st * 1024 + (ob ^ (((ob >> 9) & 1) << 5)); }
__host__ __device__ __forceinline__ void stage_rc(int b, int& R, int& C) { const int st = b / 1024, sb = b % 1024, swz = sb ^ (((sb >> 9) & 1) << 5); R = (st >> 1) * 16 + swz / 64; C = (st & 1) * 32 + (swz % 64) / 2; }
__host__ __device__ __forceinline__ int perm32(int rho) { const int n = rho >> 4, i = rho & 15; return 8 * (i >> 2) + 4 * n + (i & 3); }
struct Unit { int pm, pn; };
struct Gemm { const bf16_t* A; const bf16_t* Bt; int M, N, K, lda; };

struct StaticOrder {
    int nM, nN, nwg, G, c;
    __host__ __device__ void init(int M, int N, int G_, int c_) { nM = M / BM; nN = N / BM; nwg = nM * nN; G = G_; c = c_; }
    __host__ __device__ bool next(int i, Unit& u) const {
        const long L = (long)i * G + c; if (L >= nwg) return false;
        int wgid = (int)L; { const int q = nwg / NXCD, r = nwg % NXCD, xcd = wgid % NXCD, off = wgid / NXCD; wgid = (xcd < r ? xcd * (q + 1) : r * (q + 1) + (xcd - r) * q) + off; }
        const int nig = WGM * nN, gid = wgid / nig, fm = gid * WGM, gsz = (nM - fm) < WGM ? (nM - fm) : WGM;
        u.pm = fm + ((wgid % nig) % gsz); u.pn = (wgid % nig) / gsz; return true;
    }
    __device__ __forceinline__ void a_ready(const Unit&) const {}
    __device__ __forceinline__ void done(const Unit&) const {}
};
template <class Epi, class Sched, bool ALIGN_EPI = false, bool SP2 = false>
__device__ __forceinline__ void gemm_phase(PG8_LAS unsigned char* lds, const Gemm g, const Sched& S, const Epi& E) {
    const int tid = TIDX(), wid = __builtin_amdgcn_readfirstlane(tid >> 6), lane = tid & 63, wr = wid >> 2, wc = wid & 3, fr = lane & 15, fq = lane >> 4;
    const int K = g.K, nt = K / BK;
    unsigned voffA[2], voffB[2];
#pragma unroll
    for (int i = 0; i < 2; ++i) { int R, C; stage_rc(tid * 16 + i * 8192, R, C); const int Rb = Epi::PERM ? ((R & ~31) + perm32(R & 31)) : R;
        voffA[i] = (unsigned)(R * g.lda + C) * 2u; voffB[i] = (unsigned)(Rb * K + C) * 2u; }
    const size_t kstep = (size_t)(BK * 2);
    const size_t hstep = (size_t)HALF * K * 2;
    const size_t tstep = 2 * hstep; const size_t hstepA = (size_t)HALF * g.lda * 2, tstepA = 2 * hstepA;
    const unsigned ldsw = (unsigned)wid * 1024u;
    const int aoff = lds_byte(wr * 64 + fr, fq * 8), boff = lds_byte(wc * 32 + fr, fq * 8);
#define PG8_SA(b, h) (((b) * 2 + (h)) * HTB)
#define PG8_SB(b, h) ((4 + (b) * 2 + (h)) * HTB)
#define PG8_STAGE(bufoff, gbase, voff) do { _Pragma("unroll") for (int _i = 0; _i < 2; ++_i) \
        __builtin_amdgcn_global_load_lds((const unsigned*)((const char*)(gbase) + (voff)[_i]), (PG8_LAS unsigned*)(lds + (bufoff) + ldsw + _i * 8192), 16, 0, 0); } while (0)
#define PG8_LDA(dst, b, h) do { _Pragma("unroll") for (int m = 0; m < 4; ++m) _Pragma("unroll") for (int k = 0; k < 2; ++k) dst[m][k] = *(const PG8_LAS bf16x8*)(lds + PG8_SA(b, h) + aoff + m * 2048 + k * 1024); } while (0)
#define PG8_LDB(dst, b, h) do { _Pragma("unroll") for (int n = 0; n < 2; ++n) _Pragma("unroll") for (int k = 0; k < 2; ++k) dst[n][k] = *(const PG8_LAS bf16x8*)(lds + PG8_SB(b, h) + boff + n * 2048 + k * 1024); } while (0)
#define PG8_MMA(ai, bj, At, Bt) do { __builtin_amdgcn_s_setprio(1); _Pragma("unroll") for (int m = 0; m < 4; ++m) _Pragma("unroll") for (int n = 0; n < 2; ++n) _Pragma("unroll") for (int k = 0; k < 2; ++k) \
        acc[ai][bj][m][n] = __builtin_amdgcn_mfma_f32_16x16x32_bf16(Bt[n][k], At[m][k], acc[ai][bj][m][n], 0, 0, 0); __builtin_amdgcn_s_setprio(0); } while (0)
#define PG8_WAIT_V(n) asm volatile("s_waitcnt vmcnt(" #n ")" ::: "memory")
#define PG8_WAIT_L(n) asm volatile("s_waitcnt lgkmcnt(" #n ")" ::: "memory")
#define PG8_BAR __builtin_amdgcn_s_barrier()
#define PG8_SCHED __builtin_amdgcn_sched_barrier(0)
    Unit cur, nxt; int ui = 0;
    if (!S.next(0, cur)) return;
    f32x4 acc[2][2][4][2];
#pragma unroll
    for (int a = 0; a < 2; ++a)
#pragma unroll
        for (int b = 0; b < 2; ++b)
#pragma unroll
            for (int m = 0; m < 4; ++m)
#pragma unroll
                for (int n = 0; n < 2; ++n) acc[a][b][m][n] = (f32x4){0.f, 0.f, 0.f, 0.f};
    bf16x8 At[4][2], B0[2][2], B1[2][2];
    const char* cA = (const char*)g.A + (size_t)cur.pm * tstepA; const char* cB = (const char*)g.Bt + (size_t)cur.pn * tstep;
    S.a_ready(cur);
    if constexpr (SP2) {
        PG8_STAGE(PG8_SB(0, 0), cB, voffB); PG8_STAGE(PG8_SB(0, 1), cB + hstep, voffB); PG8_STAGE(PG8_SA(0, 0), cA, voffA); PG8_STAGE(PG8_SA(0, 1), cA + hstepA, voffA);
        if (wr == 1) PG8_BAR;
        PG8_WAIT_V(2); PG8_BAR;
        PG8_STAGE(PG8_SB(1, 0), cB + kstep, voffB); PG8_STAGE(PG8_SA(1, 0), cA + kstep, voffA); PG8_STAGE(PG8_SB(1, 1), cB + hstep + kstep, voffB);
        PG8_WAIT_V(6); PG8_BAR;
    } else {
        PG8_STAGE(PG8_SB(0, 0), cB, voffB); PG8_STAGE(PG8_SA(0, 0), cA, voffA); PG8_STAGE(PG8_SB(0, 1), cB + hstep, voffB); PG8_STAGE(PG8_SA(0, 1), cA + hstepA, voffA);
        if (wr == 1) PG8_BAR;
        PG8_WAIT_V(4); PG8_BAR;
        PG8_STAGE(PG8_SB(1, 0), cB + kstep, voffB); PG8_STAGE(PG8_SA(1, 0), cA + kstep, voffA); PG8_STAGE(PG8_SB(1, 1), cB + hstep + kstep, voffB);
        PG8_WAIT_V(6); PG8_BAR;
    }
    for (;;) {
        const bool has_next = S.next(ui + 1, nxt);
        const char* nA = has_next ? (const char*)g.A + (size_t)nxt.pm * tstepA : cA; const char* nB = has_next ? (const char*)g.Bt + (size_t)nxt.pn * tstep : cB;
        for (int t = 0; t < nt; t += 2) {
            const bool last = (t == nt - 2);
            const char* a1 = cA + (size_t)(t + 1) * kstep;
            const char* a2 = last ? nA : cA + (size_t)(t + 2) * kstep; const char* b2 = last ? nB : cB + (size_t)(t + 2) * kstep;
            const char* a3 = a2 + kstep; const char* b3 = b2 + kstep;
            if (last && has_next) S.a_ready(nxt);
            if constexpr (SP2) {
            PG8_LDB(B0, 0, 0); PG8_LDB(B1, 0, 1); PG8_SCHED; PG8_LDA(At, 0, 0); PG8_STAGE(PG8_SA(1, 1), a1 + hstepA, voffA);
            PG8_WAIT_V(8); PG8_WAIT_L(0); PG8_BAR; PG8_MMA(0, 0, At, B0); PG8_MMA(0, 1, At, B1); PG8_BAR; PG8_SCHED;
            PG8_LDA(At, 0, 1); PG8_STAGE(PG8_SB(0, 0), b2, voffB); PG8_STAGE(PG8_SB(0, 1), b2 + hstep, voffB); PG8_STAGE(PG8_SA(0, 0), a2, voffA);
            PG8_WAIT_V(8); PG8_WAIT_L(0); PG8_BAR; PG8_MMA(1, 0, At, B0); PG8_MMA(1, 1, At, B1); PG8_BAR; PG8_SCHED;
            PG8_LDB(B0, 1, 0); PG8_LDB(B1, 1, 1); PG8_SCHED; PG8_LDA(At, 1, 0); PG8_STAGE(PG8_SA(0, 1), a2 + hstepA, voffA);
            PG8_WAIT_V(8); PG8_WAIT_L(0); PG8_BAR; PG8_MMA(0, 0, At, B0); PG8_MMA(0, 1, At, B1); PG8_BAR; PG8_SCHED;
            PG8_LDA(At, 1, 1); PG8_STAGE(PG8_SB(1, 0), b3, voffB); PG8_STAGE(PG8_SB(1, 1), b3 + hstep, voffB); PG8_STAGE(PG8_SA(1, 0), a3, voffA);
            PG8_WAIT_V(8); PG8_WAIT_L(0); PG8_BAR; PG8_MMA(1, 0, At, B0); PG8_MMA(1, 1, At, B1); PG8_BAR; PG8_SCHED;
            } else {
            PG8_LDB(B0, 0, 0); PG8_SCHED; PG8_LDA(At, 0, 0); PG8_STAGE(PG8_SA(1, 1), a1 + hstepA, voffA);
            PG8_WAIT_L(8); PG8_BAR; PG8_WAIT_L(0); PG8_MMA(0, 0, At, B0); PG8_BAR; PG8_SCHED;
            PG8_LDB(B1, 0, 1); PG8_STAGE(PG8_SB(0, 0), b2, voffB);
            PG8_BAR; PG8_WAIT_L(0); PG8_MMA(0, 1, At, B1); PG8_BAR;
            PG8_LDA(At, 0, 1); PG8_STAGE(PG8_SA(0, 0), a2, voffA);
            PG8_BAR; PG8_WAIT_L(0); PG8_MMA(1, 0, At, B0); PG8_BAR; PG8_SCHED;
            PG8_STAGE(PG8_SB(0, 1), b2 + hstep, voffB);
            PG8_WAIT_V(6); PG8_BAR; PG8_MMA(1, 1, At, B1); PG8_BAR;
            PG8_LDB(B0, 1, 0); PG8_SCHED; PG8_LDA(At, 1, 0); PG8_STAGE(PG8_SA(0, 1), a2 + hstepA, voffA);
            PG8_WAIT_L(8); PG8_BAR; PG8_WAIT_L(0); PG8_MMA(0, 0, At, B0); PG8_BAR; PG8_SCHED;
            PG8_LDB(B1, 1, 1); PG8_STAGE(PG8_SB(1, 0), b3, voffB);
            PG8_BAR; PG8_WAIT_L(0); PG8_MMA(0, 1, At, B1); PG8_BAR;
            PG8_LDA(At, 1, 1); PG8_STAGE(PG8_SA(1, 0), a3, voffA);
            PG8_BAR; PG8_WAIT_L(0); PG8_MMA(1, 0, At, B0); PG8_BAR; PG8_SCHED;
            PG8_STAGE(PG8_SB(1, 1), b3 + hstep, voffB);
            PG8_WAIT_V(6); PG8_BAR; PG8_MMA(1, 1, At, B1); PG8_BAR;
            }
        }
        if constexpr (ALIGN_EPI) { if (wr == 0) PG8_BAR; }
        if constexpr (!Epi::AFTER_DRAIN) { E(acc, cur, wr, wc, fr, fq); S.done(cur); }
        if (!has_next) break;
#pragma unroll
        for (int a = 0; a < 2; ++a)
#pragma unroll
            for (int b = 0; b < 2; ++b)
#pragma unroll
                for (int m = 0; m < 4; ++m)
#pragma unroll
                    for (int n = 0; n < 2; ++n) acc[a][b][m][n] = (f32x4){0.f, 0.f, 0.f, 0.f};
        cur = nxt; cA = nA; cB = nB; ++ui;
        if constexpr (ALIGN_EPI) { if (wr == 1) PG8_BAR; }
    }
    PG8_WAIT_V(0);
    if constexpr (!ALIGN_EPI) { if (wr == 0) PG8_BAR; }
    PG8_BAR;
    if constexpr (Epi::AFTER_DRAIN) { E.fused(acc, cur, wr, wc, fr, fq, lds, wid, lane); S.done(cur); }
#undef PG8_SA
#undef PG8_SB
#undef PG8_STAGE
#undef PG8_LDA
#undef PG8_LDB
#undef PG8_MMA
#undef PG8_WAIT_V
#undef PG8_WAIT_L
#undef PG8_BAR
#undef PG8_SCHED
}
struct SchedX { StaticOrder so; int mode;
  __device__ __forceinline__ bool next(int i, Unit& u) const {
    if (mode == 2) { if (i != 0 || so.c >= 8) return false; u.pm = (so.c >> 2) ? 33 : 0; u.pn = so.c & 3; return true; }
    if (!so.next(i, u)) return false; if (mode == 1) u.pm = u.pm + 1 + (u.pm >= 32 ? 1 : 0); return true; }
  __device__ __forceinline__ void a_ready(const Unit&) const {}
  __device__ __forceinline__ void done(const Unit&) const {} };
}
struct EpiRec8 { static constexpr bool PERM = true, AFTER_DRAIN = false; bf16_t* P1; bf16_t* P2; float* SM;
  DI void operator()(const f32x4 (&acc)[2][2][4][2], const pg8::Unit& u, int wr, int wc, int fr, int fq) const {
#pragma unroll
    for (int ai = 0; ai < 2; ++ai)
#pragma unroll
      for (int m = 0; m < 4; ++m) { const size_t row = (size_t)u.pm * 256 + ai * 128 + wr * 64 + m * 16 + fr;
#pragma unroll
        for (int bj = 0; bj < 2; ++bj) { const int col = u.pn * 256 + bj * 128 + wc * 32 + fq * 8; const f32x4 v0 = acc[ai][bj][m][0], v1 = acc[ai][bj][m][1];
          if (u.pn < 14) { const u32x4 w = {cvtpk(v0[0], v0[1]), cvtpk(v0[2], v0[3]), cvtpk(v1[0], v1[1]), cvtpk(v1[2], v1[3])};
            if (u.pn < 6) *(u32x4*)(P1 + row * 1536 + col) = w; else *(u32x4*)(P2 + row * 2048 + (col - 1536)) = w; }
          else { const int lc = col - 3584; if (lc < 48) { *(f32x4*)(SM + row * 64 + lc) = v0; *(f32x4*)(SM + row * 64 + lc + 4) = v1; } } } } } };
struct EpiBf8 { static constexpr bool PERM = true, AFTER_DRAIN = false; bf16_t* O; int ldc;
  DI void operator()(const f32x4 (&acc)[2][2][4][2], const pg8::Unit& u, int wr, int wc, int fr, int fq) const {
#pragma unroll
    for (int ai = 0; ai < 2; ++ai)
#pragma unroll
      for (int m = 0; m < 4; ++m) { const size_t row = (size_t)u.pm * 256 + ai * 128 + wr * 64 + m * 16 + fr;
#pragma unroll
        for (int bj = 0; bj < 2; ++bj) { const int col = u.pn * 256 + bj * 128 + wc * 32 + fq * 8; const f32x4 v0 = acc[ai][bj][m][0], v1 = acc[ai][bj][m][1];
          const u32x4 w = {cvtpk(v0[0], v0[1]), cvtpk(v0[2], v0[3]), cvtpk(v1[0], v1[1]), cvtpk(v1[2], v1[3])};
          *(u32x4*)(O + row * ldc + col) = w; } } } };
struct EpiRes8 { static constexpr bool PERM = false, AFTER_DRAIN = false; float* X; const float* gate;
  DI void operator()(const f32x4 (&acc)[2][2][4][2], const pg8::Unit& u, int wr, int wc, int fr, int fq) const {
    const float* gr = gate + (size_t)modrow_of(u.pm * 256) * 6144;
#pragma unroll
    for (int bj = 0; bj < 2; ++bj)
#pragma unroll
      for (int n = 0; n < 2; ++n) { const int col = u.pn * 256 + bj * 128 + wc * 32 + n * 16 + fq * 4; const f32x4 gv = *(const f32x4*)(gr + col);
#pragma unroll
        for (int ai = 0; ai < 2; ++ai)
#pragma unroll
          for (int m = 0; m < 4; ++m) { const size_t row = (size_t)u.pm * 256 + ai * 128 + wr * 64 + m * 16 + fr;
            f32x4* q = (f32x4*)(X + row * 1024 + col); *q = *q + gv * acc[ai][bj][m][n]; } } } };
template <class Epi>
__device__ __forceinline__ void gemm8(char* lds, const bf16_t* A, int lda, const bf16_t* Bt, int K, int N, int mode, const Epi& E) {
  pg8::Gemm g{A, Bt, mode == 1 ? 16384 : MROWS, N, K, lda};
  pg8::SchedX S; S.so.init(g.M, N, GDIM(), BIDX()); S.mode = mode;
  pg8::gemm_phase<Epi, pg8::SchedX, true, true>((PG8_LAS unsigned char*)lds, g, S, E);
}

__device__ __forceinline__ void ph_dnprep(const P& p, char* lds, int e) {
  const int tid = TIDX(), wid = tid >> 6, lane = tid & 63;
  const bf16_t* P1 = (const bf16_t*)(p.ws + OFF_D + D_P1);
  bf16_t* QQ = (bf16_t*)(p.ws + OFF_D + D_QQ); bf16_t* QK = (bf16_t*)(p.ws + OFF_D + D_QK); bf16_t* QV = (bf16_t*)(p.ws + OFF_D + D_QV);
  bf16_t* KT = (bf16_t*)(p.ws + OFF_D + D_KT);
  const float* SM = (const float*)(p.ws + OFF_SM); float* GB = (float*)(p.ws + OFF_GB);
  const float* cw = p.rec_conv + (size_t)e * 3 * 1536;
  bf16_t* kl = (bf16_t*)lds;
  for (int job = BIDX(); job < MROWS / 32; job += GDIM()) {
    const int R0 = job * 32;
    for (int tt = 0; tt < 4; ++tt) {
      const int tl = wid * 4 + tt, R = R0 + tl; const int b = R >= TB ? 1 : 0, pp = R - b * TB;
      const bool hasp = !(pp == 0 || pp == CTXL), hasn = !(pp == CTXL - 1 || pp == TB - 1);
#pragma unroll
      for (int part = 0; part < 3; ++part) {
        const int ch = part * 512 + lane * 8;
        const bf16x8 zc = *(const bf16x8*)(P1 + (size_t)R * 1536 + ch);
        bf16x8 zp = {}, zn = {};
        if (hasp) zp = *(const bf16x8*)(P1 + (size_t)(R - 1) * 1536 + ch);
        if (hasn) zn = *(const bf16x8*)(P1 + (size_t)(R + 1) * 1536 + ch);
        float o[8]; float ss = 0.f;
#pragma unroll
        for (int j = 0; j < 8; ++j) { const float a = bf2f((bf16_t)zp[j]) * cw[ch + j] + bf2f((bf16_t)zc[j]) * cw[1536 + ch + j] + bf2f((bf16_t)zn[j]) * cw[3072 + ch + j];
          o[j] = siluf(a); ss += o[j] * o[j]; }
        if (part < 2) {
          ss += __shfl_xor(ss, 1); ss += __shfl_xor(ss, 2); ss += __shfl_xor(ss, 4); ss += __shfl_xor(ss, 8);
          float sc = rsqrtf(ss + EPSF); if (part == 0) sc *= 0.08838834764831845f;
#pragma unroll
          for (int j = 0; j < 8; ++j) o[j] *= sc;
        }
        u32x4 w = {cvtpk(o[0], o[1]), cvtpk(o[2], o[3]), cvtpk(o[4], o[5]), cvtpk(o[6], o[7])};
        bf16_t* dst = part == 0 ? QQ : (part == 1 ? QK : QV);
        *(u32x4*)(dst + (size_t)R * 512 + lane * 8) = w;
        if (part == 1) *(u32x4*)(kl + tl * 512 + lane * 8) = w;
      }
      if (lane < 16) {
        const int q = lane & 7;
        if (lane < 8) { const float da = SM[(size_t)R * 64 + q]; GB[(size_t)R * 16 + q] = -expf(p.dn_a_log[e * 8 + q]) * softplusf(da + p.dn_dt_bias[e * 8 + q]); }
        else { const float db = SM[(size_t)R * 64 + 8 + q]; GB[(size_t)R * 16 + 8 + q] = sigmf(db); }
      }
    }
    __syncthreads();
    {
      const int b = R0 >= TB ? 1 : 0, c = (R0 - b * TB) / 64, half = ((R0 - b * TB) >> 5) & 1; const int h = tid >> 7, dk = tid & 127;
      bf16_t* dst = KT + ((((size_t)b * 4 + h) * NCH + c) * 128 + dk) * 64 + half * 32;
#pragma unroll
      for (int g8 = 0; g8 < 4; ++g8) { unsigned w[4];
#pragma unroll
        for (int j = 0; j < 4; ++j) { const unsigned lo = kl[(g8 * 8 + 2 * j) * 512 + tid], hi2 = kl[(g8 * 8 + 2 * j + 1) * 512 + tid]; w[j] = lo | (hi2 << 16); }
        *(u32x4*)(dst + g8 * 8) = (u32x4){w[0], w[1], w[2], w[3]}; }
    }
    __syncthreads();
  }
}

__device__ __forceinline__ void ph_dn_d1(const P& p, char* lds) {
  const int tid = TIDX(), wid = tid >> 6, lane = tid & 63, r32 = lane & 31, hi = lane >> 5;
  const bf16_t* QQ = (const bf16_t*)(p.ws + OFF_D + D_QQ); const bf16_t* QK = (const bf16_t*)(p.ws + OFF_D + D_QK); const bf16_t* QV = (const bf16_t*)(p.ws + OFF_D + D_QV);
  const float* GB = (const float*)(p.ws + OFF_GB);
  bf16_t* W_ = (bf16_t*)(p.ws + OFF_D + D_W); bf16_t* U_ = (bf16_t*)(p.ws + OFF_HBF); bf16_t* INTRA = (bf16_t*)(p.ws + OFF_D + D_INTRA);
  float* SC = (float*)(p.ws + OFF_SC); float* GLS = (float*)(p.ws + OFF_GL);
  float* KK = (float*)lds; float* QKm = KK + 64 * 65; float* Ad = QKm + 64 * 65; float* Gs = Ad + 2 * 4096; float* Bs = Gs + 128;
  bf16_t* Vs = (bf16_t*)(Bs + 128); bf16_t* Ks = Vs + 64 * 128;
  for (int job = BIDX(); job < 8 * NCH; job += GDIM()) {
    const int b = job / (4 * NCH), h = (job / NCH) & 3, c = job % NCH;
    const size_t Rb = (size_t)b * TB + (size_t)c * 64;
    {
      const int srow = tid >> 4, spc = (tid & 15) * 8;
      const u32x4 v0 = *(const u32x4*)(QV + (Rb + srow) * 512 + h * 128 + spc), v1 = *(const u32x4*)(QV + (Rb + 32 + srow) * 512 + h * 128 + spc);
      const u32x4 k0 = *(const u32x4*)(QK + (Rb + srow) * 512 + h * 128 + spc), k1 = *(const u32x4*)(QK + (Rb + 32 + srow) * 512 + h * 128 + spc);
      *(u32x4*)(Vs + srow * 128 + spc) = v0; *(u32x4*)(Vs + (32 + srow) * 128 + spc) = v1;
      *(u32x4*)(Ks + srow * 128 + spc) = k0; *(u32x4*)(Ks + (32 + srow) * 128 + spc) = k1;
    }
    {
      const int w4 = wid & 3, mi = w4 & 1, ni = w4 >> 1;
      const bf16_t* As = wid < 4 ? QK : QQ;
      const bf16_t* arow = As + (Rb + 32 * mi + r32) * 512 + h * 128 + hi * 8;
      const bf16_t* brow = QK + (Rb + 32 * ni + r32) * 512 + h * 128 + hi * 8;
      f32x16 acc = {}; acc = mma_rows<8>(arow, brow, acc);
      float* dst = wid < 4 ? KK : QKm;
#pragma unroll
      for (int r = 0; r < 16; ++r) dst[(32 * mi + crow(r, hi)) * 65 + 32 * ni + r32] = acc[r];
    }
    if (tid < 128) { const int d = tid >> 6, ip = tid & 63, t = d ? 63 - ip : ip; float g = GB[(Rb + t) * 16 + d * 4 + h]; Bs[tid] = GB[(Rb + t) * 16 + 8 + d * 4 + h];
#pragma unroll
      for (int o = 1; o < 64; o <<= 1) { const float v = __shfl_up(g, o); g += ip >= o ? v : 0.f; }
      Gs[tid] = g; }
    __syncthreads();
    const int n0 = c, n1 = c < 4 ? 3 - c : 135 - c;
    const size_t cj0 = ((size_t)(0 * 2 + b) * 4 + h) * NCH + n0, cj1 = ((size_t)(1 * 2 + b) * 4 + h) * NCH + n1;
    for (int e2 = tid; e2 < 8192; e2 += 512) {
      const int d = e2 >> 12, ip = (e2 >> 6) & 63, jp = e2 & 63; const int i = d ? 63 - ip : ip, j = d ? 63 - jp : jp;
      const float dec = jp <= ip ? __expf(Gs[d * 64 + ip] - Gs[d * 64 + jp]) : 0.f;
      Ad[d * 4096 + ip * 64 + jp] = jp < ip ? Bs[d * 64 + ip] * KK[i * 65 + j] * dec : 0.f;
      const size_t cj = d ? cj1 : cj0;
      INTRA[(cj * 64 + ip) * 64 + jp] = f2bf(QKm[i * 65 + j] * dec);
    }
    if (tid < 128) { const int d = tid >> 6, ip = tid & 63; const size_t cj = d ? cj1 : cj0; const float gi = Gs[tid], gl = Gs[d * 64 + 63];
      SC[(cj * 64 + ip) * 2] = __expf(gi); SC[(cj * 64 + ip) * 2 + 1] = __expf(gl - gi); if (ip == 0) GLS[cj] = __expf(gl); }
    __syncthreads();
    {
      const int d = tid >> 8, cc = tid & 255; const size_t cj = d ? cj1 : cj0;
      int dofs = d * 64, aofs = d * 4096; asm volatile("" : "+v"(dofs), "+v"(aofs));
      float x[64];
      {
        int vofs = cc < 128 ? cc : 64 * 128 + (cc - 128); asm volatile("" : "+v"(vofs));
#pragma unroll
        for (int ip = 0; ip < 64; ++ip) x[ip] = bf2f(Vs[vofs + ip * 128]);
#pragma unroll
        for (int ip = 0; ip < 32; ++ip) { const float a_ = x[ip], b_ = x[63 - ip]; x[ip] = d ? b_ : a_; x[63 - ip] = d ? a_ : b_; }
        if (cc < 128) {
#pragma unroll
          for (int ip = 0; ip < 64; ++ip) x[ip] *= Bs[dofs + ip];
        } else {
#pragma unroll
          for (int ip = 0; ip < 64; ++ip) x[ip] *= Bs[dofs + ip] * __expf(Gs[dofs + ip]);
        }
      }
      const float* Arow = Ad + aofs;
#pragma unroll
      for (int ip = 1; ip < 64; ++ip) {
        float s = 0.f;
#pragma unroll
        for (int j4 = 0; j4 < (ip + 3) / 4; ++j4) { const f32x4 a = *(const f32x4*)(Arow + ip * 64 + 4 * j4);
          s += a[0] * x[4 * j4] + a[1] * x[4 * j4 + 1] + a[2] * x[4 * j4 + 2] + a[3] * x[4 * j4 + 3]; }
        x[ip] -= s;
      }
      bf16_t* dst = cc < 128 ? U_ + cj * 64 * 128 + cc : W_ + cj * 64 * 128 + (cc - 128);
#pragma unroll
      for (int ip = 0; ip < 64; ++ip) dst[ip * 128] = f2bf(x[ip]);
    }
    __syncthreads();
  }
}

typedef _Float16 h16x8 __attribute__((ext_vector_type(8)));
__device__ __forceinline__ void ph_gla_b(const P& p, char* lds, int e) {
  const int tid = TIDX(), wid = tid >> 6, lane = tid & 63;
  const float* SM = (const float*)(p.ws + OFF_SM);
  float* w2S = (float*)lds;
  float* b2S = w2S + 8192;
  for (int i = tid; i < 8192; i += 512) { const int d = i >> 12, hh = (i >> 10) & 3, r = (i >> 6) & 15, j = i & 63; w2S[i] = p.gla_w2[(((size_t)e * 2 + d) * 16 + r) * 256 + hh * 64 + j]; }
  if (tid < 512) b2S[tid] = p.gla_b2[(size_t)e * 512 + tid];
  __syncthreads();
  int jb = 8 * wid; asm volatile("" : "+v"(jb));
  for (int job = GDIM() - 1 - BIDX(); job < 16 * NCH; job += GDIM()) {
    const int n = job % NCH, sq = job / NCH; const int dir = sq >> 3, b = (sq >> 2) & 1, h = sq & 3;
    const int c = dir == 0 ? n : (n < 4 ? 3 - n : 135 - n);
    const size_t row = (size_t)b * TB + (size_t)c * 64 + (dir ? 63 - lane : lane);
    const float* gp = SM + row * 64 + 16 + dir * 16;
    const f32x4 g0 = *(const f32x4*)(gp), g1 = *(const f32x4*)(gp + 4), g2 = *(const f32x4*)(gp + 8), g3 = *(const f32x4*)(gp + 12);
    const float gg_[16] = {g0[0], g0[1], g0[2], g0[3], g1[0], g1[1], g1[2], g1[3], g2[0], g2[1], g2[2], g2[3], g3[0], g3[1], g3[2], g3[3]};
    const float* wb = w2S + (dir * 4 + h) * 1024 + jb; const float* bb2 = b2S + dir * 256 + h * 64 + jb;
    f32x4 sa = *(const f32x4*)(bb2), sb = *(const f32x4*)(bb2 + 4);
#pragma unroll
    for (int r = 0; r < 16; ++r) { const f32x4 wa = *(const f32x4*)(wb + r * 64), wq = *(const f32x4*)(wb + r * 64 + 4); sa += gg_[r] * wa; sb += gg_[r] * wq; }
    float la[8];
#pragma unroll
    for (int jj = 0; jj < 4; ++jj) { const float x0 = sa[jj], x1 = sb[jj];
      la[jj] = (fminf(x0, 0.f) - log1pf(expf(-fabsf(x0)))) * 0.0625f; la[4 + jj] = (fminf(x1, 0.f) - log1pf(expf(-fabsf(x1)))) * 0.0625f; }
#pragma unroll
    for (int o = 1; o < 64; o <<= 1) {
#pragma unroll
      for (int jj = 0; jj < 8; ++jj) { const float v = __shfl_up(la[jj], o); la[jj] += lane >= o ? v : 0.f; }
    }
    h16x8 hv;
#pragma unroll
    for (int jj = 0; jj < 8; ++jj) hv[jj] = (_Float16)la[jj];
    _Float16* dst = (_Float16*)(p.ws + (dir ? OFF_B16_1 : OFF_WC)) + ((((size_t)b * 4 + h) * NCH + n) * 64 + lane) * 64 + jb;
    *(h16x8*)dst = hv;
  }
}

struct DnSet { bf16x8 fa[8]; };
template <int ROLE>
__device__ __forceinline__ void dn_scan_t(const P& p, char* lds, int job) {
  const int tid = TIDX(), wid = tid >> 6, lane = tid & 63, r32 = lane & 31, hi = lane >> 5;
  const int dir = job >> 5, b = (job >> 4) & 1, h = (job >> 2) & 3, n0 = (job & 3) * 32;
  const bf16_t* QQ = (const bf16_t*)(p.ws + OFF_D + D_QQ); const bf16_t* KT = (const bf16_t*)(p.ws + OFF_D + D_KT);
  const bf16_t* W_ = (const bf16_t*)(p.ws + OFF_D + D_W); const bf16_t* U_ = (const bf16_t*)(p.ws + OFF_HBF); const bf16_t* INTRA = (const bf16_t*)(p.ws + OFF_D + D_INTRA);
  const float* SC = (const float*)(p.ws + OFF_SC); const float* GLS = (const float*)(p.ws + OFF_GL);
  bf16_t* DNO = (bf16_t*)(p.ws + OFF_D + D_DNO);
  bf16_t* ST = (bf16_t*)lds; bf16_t* vTa = ST + 32 * 136; bf16_t* vTb = vTa + 32 * 72;
  float* scS = (float*)(vTb + 32 * 72);
  bf16_t* uS = (bf16_t*)(scS + 256);
  bf16_t* inS = uS + 2 * 64 * 40;
  for (int i = tid; i < 32 * 136; i += 512) ST[i] = 0;
  f32x16 accS = {};
  const size_t seq = ((size_t)dir * 2 + b) * 4 + h;
  const int mi = wid & 1, di = wid - 4;
  constexpr int role = ROLE;
  const int tt = tid - 256;
  DnSet fs[3]; float gls[3] = {0.f, 0.f, 0.f};
  u32x4 stU[3], stI0[3]; float stS[3] = {0.f, 0.f, 0.f};
#define DN_CH(n_) const int n__ = (n_); const int c__ = dir == 0 ? n__ : (n__ < 4 ? 3 - n__ : 135 - n__); const size_t Rb__ = (size_t)b * TB + (size_t)c__ * 64; const size_t cj__ = seq * NCH + n__;
#define DN_LOAD(S, GL, n_) do { DN_CH(n_) \
    const int ipl__ = 32 * mi + r32, tl__ = dir ? 63 - ipl__ : ipl__; \
    const bf16_t* b0__ = W_ + cj__ * 8192 + (32 * mi + r32) * 128 + hi * 8; \
    const bf16_t* b1__ = QQ + (Rb__ + tl__) * 512 + h * 128 + hi * 8; \
    const bf16_t* b2__ = KT + ((((size_t)b * 4 + h) * NCH + c__) * 128 + 32 * (wid & 3) + r32) * 64 + hi * 8; \
    const bf16_t* bs__ = role == 0 ? b0__ : (role == 1 ? b1__ : b2__); \
    _Pragma("unroll") for (int ks = 0; ks < 8; ++ks) S.fa[ks] = *(const bf16x8*)(bs__ + ks * 16); \
    GL = GLS[cj__]; } while (0)
#define DN_STAGE_LD(q_, n_) do { DN_CH(n_) (void)Rb__; \
      stU[q_] = *(const u32x4*)(U_ + cj__ * 8192 + ((tid & 255) >> 2) * 128 + n0 + (tid & 3) * 8); \
      stI0[q_] = *(const u32x4*)(INTRA + cj__ * 4096 + (tid >> 3) * 64 + (tid & 7) * 8); \
      stS[q_] = SC[cj__ * 128 + (tid & 127)]; } while (0)
#define DN_STAGE_ST(q_, bf_) do { *(u32x4*)(inS + (bf_) * 4608 + (tid >> 3) * 72 + (tid & 7) * 8) = stI0[q_]; \
      if (ROLE < 2) *(u32x4*)(uS + (bf_) * 2560 + (tid >> 2) * 40 + (tid & 3) * 8) = stU[q_]; \
      if (ROLE == 0) scS[(bf_) * 128 + tid] = stS[q_]; } while (0)
#define DN_STEP(S, GL, n_, bf_) do { DN_CH(n_) (void)cj__; \
    const float* sc__ = scS + (bf_) * 128; \
    if (role < 2) { _Pragma("unroll") for (int r = 0; r < 16; ++r) accS[r] = 0.f; } \
    if (role < 2) { const bf16_t* sb__ = ST + r32 * 136 + hi * 8; \
      _Pragma("unroll") for (int ks = 0; ks < 8; ++ks) accS = MFMA32(S.fa[ks], *(const bf16x8*)(sb__ + ks * 16), accS); \
      if (role == 0) { const bf16_t* us__ = uS + (bf_) * 2560 + r32; \
        _Pragma("unroll") for (int r = 0; r < 16; ++r) { const int ip = 32 * mi + crow(r, hi); const float vn = bf2f(us__[ip * 40]) - accS[r]; \
          vTa[r32 * 72 + ip] = f2bf(vn); const int to = dir ? 63 - ip : ip; vTb[r32 * 72 + to] = f2bf(vn * sc__[ip * 2 + 1]); } } \
      else { _Pragma("unroll") for (int r = 0; r < 16; ++r) accS[r] *= sc__[(32 * mi + crow(r, hi)) * 2]; } } \
    LBAR(); \
    if (role == 1) { const bf16_t* vb__ = vTa + r32 * 72 + hi * 8; const bf16_t* ib__ = inS + (bf_) * 4608 + (32 * mi + r32) * 72 + hi * 8; \
      _Pragma("unroll") for (int ks = 0; ks < 4; ++ks) accS = MFMA32(*(const bf16x8*)(ib__ + ks * 16), *(const bf16x8*)(vb__ + ks * 16), accS); \
      _Pragma("unroll") for (int r = 0; r < 16; ++r) { const int ip = 32 * mi + crow(r, hi), t = dir ? 63 - ip : ip; \
        DNO[((size_t)dir * MROWS + Rb__ + t) * 512 + h * 128 + n0 + r32] = f2bf(accS[r]); } } \
    else if (role == 2) { const bf16_t* vb__ = vTb + r32 * 72 + hi * 8; \
      _Pragma("unroll") for (int r = 0; r < 16; ++r) accS[r] *= GL; \
      _Pragma("unroll") for (int ks = 0; ks < 4; ++ks) accS = MFMA32(S.fa[ks], *(const bf16x8*)(vb__ + ks * 16), accS); \
      _Pragma("unroll") for (int r = 0; r < 16; ++r) ST[r32 * 136 + 32 * di + crow(r, hi)] = f2bf(accS[r]); } \
    LBAR(); } while (0)
  DN_STAGE_LD(0, 0); DN_STAGE_ST(0, 0); DN_STAGE_LD(1, 1); DN_STAGE_LD(2, 2);
  DN_LOAD(fs[0], gls[0], 0); DN_LOAD(fs[1], gls[1], 1);
  __syncthreads();
  for (int nb6 = 0; nb6 < NCH; nb6 += 6) {
#pragma unroll
    for (int k = 0; k < 6; ++k) {
      const int n = nb6 + k; const int n2 = n + 2 < NCH ? n + 2 : NCH - 1; const int n3 = n + 3 < NCH ? n + 3 : NCH - 1;
      DN_STAGE_ST((k + 1) % 3, (k + 1) & 1);
      DN_STAGE_LD(k % 3, n3);
      DN_LOAD(fs[(k + 2) % 3], gls[(k + 2) % 3], n2);
      DN_STEP(fs[k % 3], gls[k % 3], n, k & 1);
    }
  }
#undef DN_CH
#undef DN_LOAD
#undef DN_STAGE_LD
#undef DN_STAGE_ST
#undef DN_STEP
}

__device__ __forceinline__ void dn_scan(const P& p, char* lds, int job) {
  const int wid = TIDX() >> 6;
  if (wid < 2) dn_scan_t<0>(p, lds, job); else if (wid < 4) dn_scan_t<1>(p, lds, job); else dn_scan_t<2>(p, lds, job);
}

DI float fast_logsig(float s) { return fminf(s, 0.f) - __logf(1.f + __expf(-fabsf(s))); }
struct GlaRegs { h16x8 ba, bb; bf16x8 qa, qb, ka, kb, v8; };
template <int ROLE>
__device__ __forceinline__ void gla_scan_t(const P& p, char* lds, int job, int e) {
  const int tid = TIDX(), wid = tid >> 6, lane = tid & 63, r32 = lane & 31, hi = lane >> 5;
  const int dir = job >> 5, b = (job >> 4) & 1, h = (job >> 2) & 3, n0 = (job & 3) * 32;
  const bf16_t* P2 = (const bf16_t*)(p.ws + OFF_D + D_P2); const float* SM = (const float*)(p.ws + OFF_SM);
  bf16_t* GLAO = (bf16_t*)(p.ws + OFF_D + D_GLAO);
  const _Float16* B16 = (const _Float16*)(p.ws + (dir ? OFF_B16_1 : OFF_WC));
  float* w2S = (float*)lds; float* b2S = w2S + 1024; float* aLb = b2S + 64;
  bf16_t* ops = (bf16_t*)(aLb + 128);
  constexpr int OPB = (4 * 64 + 32) * 72;
  bf16_t* attp = ops + 2 * OPB;
  bf16_t* STb = attp + 2 * 32 * 72;
  for (int i = tid; i < 2 * 32 * 72; i += 512) STb[i] = 0;
  f32x16 accS = {};
  __syncthreads();
  GlaRegs RG[3];
  int jb0 = 16 * (wid & 3); asm volatile("" : "+v"(jb0));
  int vtb0 = 8 * (wid & 3) * 72 + lane; asm volatile("" : "+v"(vtb0));
#define GLA_LOAD(R, n_) do { const int n__ = (n_) < NCH ? (n_) : NCH - 1; const int c__ = dir == 0 ? n__ : (n__ < 4 ? 3 - n__ : 135 - n__); const size_t row__ = (size_t)b * TB + (size_t)c__ * 64 + (dir ? 63 - lane : lane); \
    const _Float16* bp__ = B16 + ((((size_t)b * 4 + h) * NCH + n__) * 64 + lane) * 64 + 16 * (wid & 3); R.ba = *(const h16x8*)(bp__); R.bb = *(const h16x8*)(bp__ + 8); \
    const bf16_t* pr__ = P2 + row__ * 2048; R.qa = *(const bf16x8*)(pr__ + 512 + h * 64 + 16 * (wid & 3)); R.qb = *(const bf16x8*)(pr__ + 512 + h * 64 + 16 * (wid & 3) + 8); \
    R.ka = *(const bf16x8*)(pr__ + 768 + h * 64 + 16 * (wid & 3)); R.kb = *(const bf16x8*)(pr__ + 768 + h * 64 + 16 * (wid & 3) + 8); R.v8 = *(const bf16x8*)(pr__ + 1024 + h * 128 + n0 + 8 * (wid & 3)); } while (0)
#define GLA_HALF(R, BV, QV, KV, jb) do { \
    float eqe[8], eke[8], eqi[8]; \
    _Pragma("unroll") for (int jj = 0; jj < 8; ++jj) { const int j = (jb) + jj; const float bb = (float)BV[jj]; const float bm = __int_as_float(__builtin_amdgcn_readlane(__float_as_int(bb), 32)), bl = __int_as_float(__builtin_amdgcn_readlane(__float_as_int(bb), 63)); \
      const float q_ = bf2f((bf16_t)QV[jj]) * 0.125f, k_ = bf2f((bf16_t)KV[jj]); \
      eqe[jj] = q_ * __expf(bb - bm); eke[jj] = k_ * __expf(bm - bb); eqi[jj] = q_ * __expf(bb); ksT_[j * 72 + lane] = f2bf(k_ * __expf(bl - bb)); if (lane == 63) aL_[j] = __expf(bl); } \
    *(u32x4*)(qe_ + lane * 72 + (jb)) = (u32x4){cvtpk(eqe[0], eqe[1]), cvtpk(eqe[2], eqe[3]), cvtpk(eqe[4], eqe[5]), cvtpk(eqe[6], eqe[7])}; \
    *(u32x4*)(ke_ + lane * 72 + (jb)) = (u32x4){cvtpk(eke[0], eke[1]), cvtpk(eke[2], eke[3]), cvtpk(eke[4], eke[5]), cvtpk(eke[6], eke[7])}; \
    *(u32x4*)(qi_ + lane * 72 + (jb)) = (u32x4){cvtpk(eqi[0], eqi[1]), cvtpk(eqi[2], eqi[3]), cvtpk(eqi[4], eqi[5]), cvtpk(eqi[6], eqi[7])}; } while (0)
#define GLA_PREP(R, bf_) do { bf16_t* qe_ = ops + (bf_) * OPB; bf16_t* ke_ = qe_ + 64 * 72; bf16_t* qi_ = ke_ + 64 * 72; bf16_t* ksT_ = qi_ + 64 * 72; bf16_t* vT_ = ksT_ + 64 * 72; float* aL_ = aLb + (bf_) * 64; \
    GLA_HALF(R, R.ba, R.qa, R.ka, jb0); GLA_HALF(R, R.bb, R.qb, R.kb, jb0 + 8); \
    _Pragma("unroll") for (int q_ = 0; q_ < 8; ++q_) vT_[vtb0 + q_ * 72] = (bf16_t)R.v8[q_]; } while (0)
#define GLA_MMA(n_, bf_) do { const int nq__ = (n_); const int bf = (bf_); \
      const bf16_t* qe_ = ops + bf * OPB; const bf16_t* ke_ = qe_ + 64 * 72; const bf16_t* qi_ = ke_ + 64 * 72; const bf16_t* ksT_ = qi_ + 64 * 72; const bf16_t* vT_ = ksT_ + 64 * 72; const float* aL_ = aLb + bf * 64; \
      const bf16_t* STr = STb + bf * 32 * 72; bf16_t* STw = STb + (bf ^ 1) * 32 * 72; \
      if (ROLE == 1) { \
        const int mi = wid - 4; bf16_t* attw = attp + mi * 32 * 72; \
        const int c = dir == 0 ? nq__ : (nq__ < 4 ? 3 - nq__ : 135 - nq__); const size_t Rb = (size_t)b * TB + (size_t)c * 64; \
        f32x16 acc = {}; acc = mma_rows<4>(qi_ + (32 * mi + r32) * 72 + hi * 8, STr + r32 * 72 + hi * 8, acc); \
        { f32x16 a0 = {}; a0 = mma_rows<4>(qe_ + (32 * mi + r32) * 72 + hi * 8, ke_ + r32 * 72 + hi * 8, a0); \
          _Pragma("unroll") for (int r = 0; r < 16; ++r) { const int ipl = crow(r, hi); attw[ipl * 72 + r32] = f2bf((mi == 1 || r32 <= ipl) ? a0[r] : 0.f); } \
          f32x16 a1 = {}; if (mi == 1) a1 = mma_rows<4>(qe_ + (32 + r32) * 72 + hi * 8, ke_ + (32 + r32) * 72 + hi * 8, a1); \
          _Pragma("unroll") for (int r = 0; r < 16; ++r) { const int ipl = crow(r, hi); attw[ipl * 72 + 32 + r32] = f2bf((mi == 1 && r32 <= ipl) ? a1[r] : 0.f); } } \
        asm volatile("s_waitcnt lgkmcnt(0)" ::: "memory"); \
        acc = mma_rows<4>(attw + r32 * 72 + hi * 8, vT_ + r32 * 72 + hi * 8, acc); \
        _Pragma("unroll") for (int r = 0; r < 16; ++r) { const int ip = 32 * mi + crow(r, hi), t = dir ? 63 - ip : ip; \
          GLAO[((size_t)dir * MROWS + Rb + t) * 512 + h * 128 + n0 + r32] = f2bf(acc[r]); } \
      } else { \
        const int di = wid - 6; \
        _Pragma("unroll") for (int r = 0; r < 16; ++r) accS[r] *= aL_[32 * di + crow(r, hi)]; \
        accS = mma_rows<4>(ksT_ + (32 * di + r32) * 72 + hi * 8, vT_ + r32 * 72 + hi * 8, accS); \
        _Pragma("unroll") for (int r = 0; r < 16; ++r) STw[r32 * 72 + 32 * di + crow(r, hi)] = f2bf(accS[r]); \
      } } while (0)
  GLA_LOAD(RG[0], 0);
  if (ROLE == 0) { GLA_PREP(RG[0], 0); }
  GLA_LOAD(RG[1], 1); GLA_LOAD(RG[2], 2); GLA_LOAD(RG[0], 3);
  LBAR();
  for (int nb6 = 0; nb6 < NCH; nb6 += 6) {
#pragma unroll
    for (int k = 0; k < 6; ++k) {
      const int n = nb6 + k;
      if (ROLE == 0) { if (n + 1 < NCH) { GLA_PREP(RG[(k + 1) % 3], (k + 1) & 1); } } else { GLA_MMA(n, k & 1); }
      GLA_LOAD(RG[(k + 1) % 3], n + 4);
      LBAR();
    }
  }
#undef GLA_MMA
#undef GLA_LOAD
#undef GLA_HALF
#undef GLA_PREP
}

__device__ __forceinline__ void gla_scan(const P& p, char* lds, int job, int e) {
  const int wid = TIDX() >> 6;
  if (wid < 4) gla_scan_t<0>(p, lds, job, e); else if (wid < 6) gla_scan_t<1>(p, lds, job, e); else gla_scan_t<2>(p, lds, job, e);
}

__device__ __forceinline__ void ph_merge(const P& p, int e) {
  const int tid = TIDX(), wid = tid >> 6, lane = tid & 63, l16 = lane & 15, sub = lane >> 4;
  const bf16_t* DNO = (const bf16_t*)(p.ws + OFF_D + D_DNO); const bf16_t* GLAO = (const bf16_t*)(p.ws + OFF_D + D_GLAO);
  const bf16_t* P2 = (const bf16_t*)(p.ws + OFF_D + D_P2); bf16_t* hb = (bf16_t*)(p.ws + OFF_HBF);
  f32x8 nwd = *(const f32x8*)(p.dn_norm + e * 128 + l16 * 8), nwg = *(const f32x8*)(p.gla_norm + e * 128 + l16 * 8);
  for (int R4 = (BIDX() * 8 + wid) * 4; R4 < MROWS; R4 += GDIM() * 32) {
    const size_t R = R4 + sub;
    bf16x8 a[8], bq[8], zz[8];
#pragma unroll
    for (int g = 0; g < 8; ++g) { const bf16_t* src = g < 4 ? DNO : GLAO; const int hc = (g & 3) * 128 + l16 * 8;
      a[g] = *(const bf16x8*)(src + R * 512 + hc); bq[g] = *(const bf16x8*)(src + ((size_t)MROWS + R) * 512 + hc);
      zz[g] = *(const bf16x8*)(P2 + R * 2048 + (g < 4 ? 0 : 1536) + hc); }
#pragma unroll
    for (int g = 0; g < 8; ++g) {
      float v[8]; float ss = 0.f;
#pragma unroll
      for (int j = 0; j < 8; ++j) { v[j] = bf2f((bf16_t)a[g][j]) + bf2f((bf16_t)bq[g][j]); ss += v[j] * v[j]; }
      ss += __shfl_xor(ss, 1); ss += __shfl_xor(ss, 2); ss += __shfl_xor(ss, 4); ss += __shfl_xor(ss, 8);
      const float rs = rsqrtf(ss * (1.f / 128.f) + EPSF);
      float o[8];
#pragma unroll
      for (int j = 0; j < 8; ++j) o[j] = v[j] * rs * (g < 4 ? nwd[j] : nwg[j]) * siluf(bf2f((bf16_t)zz[g][j]));
      *(u32x4*)(hb + R * 1024 + g * 128 + l16 * 8) = (u32x4){cvtpk(o[0], o[1]), cvtpk(o[2], o[3]), cvtpk(o[4], o[5]), cvtpk(o[6], o[7])};
    }
  }
}

DI float silu_fast(float x) { return x / (1.f + __expf(-x)); }
__device__ __forceinline__ void ph_ffnact(const P& p, int L) {
  bf16_t* U = (bf16_t*)(p.ws + OFF_D);
  const float* cw = p.ffn_conv + (size_t)L * 3 * DFF;
  const size_t items = (size_t)MROWS * 352, stride = (size_t)GDIM() * 512;
  for (size_t it0 = (size_t)BIDX() * 512 + TIDX(); it0 < items; it0 += 2 * stride) {
    bf16x8 zc[2], zp[2], zn[2], vv[2]; int Rr[2], cc[2]; bool ok[2];
#pragma unroll
    for (int q = 0; q < 2; ++q) {
      size_t it = it0 + q * stride; ok[q] = it < items; if (!ok[q]) it = it0;
      const int R = (int)(it / 352), c0 = (int)(it % 352) * 8; const int b = R >= TB ? 1 : 0, pp = R - b * TB;
      const bool hasp = !(pp == 0 || pp == CTXL), hasn = !(pp == CTXL - 1 || pp == TB - 1);
      Rr[q] = R; cc[q] = c0;
      zc[q] = *(const bf16x8*)(U + (size_t)R * 5632 + c0);
      zp[q] = *(const bf16x8*)(U + (size_t)(hasp ? R - 1 : R) * 5632 + c0);
      zn[q] = *(const bf16x8*)(U + (size_t)(hasn ? R + 1 : R) * 5632 + c0);
      vv[q] = *(const bf16x8*)(U + (size_t)R * 5632 + DFF + c0);
      if (!hasp) zp[q] = (bf16x8){0, 0, 0, 0, 0, 0, 0, 0};
      if (!hasn) zn[q] = (bf16x8){0, 0, 0, 0, 0, 0, 0, 0};
    }
#pragma unroll
    for (int q = 0; q < 2; ++q) {
      const int c0 = cc[q];
      const f32x8 w0 = *(const f32x8*)(cw + c0), w1 = *(const f32x8*)(cw + DFF + c0), w2 = *(const f32x8*)(cw + 2 * DFF + c0);
      float o[8];
#pragma unroll
      for (int j = 0; j < 8; ++j) { const float a = bf2f((bf16_t)zp[q][j]) * w0[j] + bf2f((bf16_t)zc[q][j]) * w1[j] + bf2f((bf16_t)zn[q][j]) * w2[j];
        o[j] = silu_fast(a) * bf2f((bf16_t)vv[q][j]); }
      if (ok[q]) *(u32x4*)(U + (size_t)Rr[q] * 5632 + DFF + c0) = (u32x4){cvtpk(o[0], o[1]), cvtpk(o[2], o[3]), cvtpk(o[4], o[5]), cvtpk(o[6], o[7])};
    }
  }
}

__device__ __forceinline__ void ph_qknorm(const P& p, char* lds, int o) {
  const int tid = TIDX(), wid = tid >> 6, lane = tid & 63, l16 = lane & 15, sub = lane >> 4;
  bf16_t* QKV = (bf16_t*)(p.ws + OFF_D);
  float* tab = (float*)lds;
  for (int i = tid; i < 4096; i += 512) { const int pos = i >> 5, f = i & 31; const float ang = (float)pos * powf(10000.f, -(float)f / 32.f); tab[2 * i] = cosf(ang); tab[2 * i + 1] = sinf(ang); }
  __syncthreads();
  const f32x8 qn = *(const f32x8*)(p.att_q_norm + o * 128 + l16 * 8), kn = *(const f32x8*)(p.att_k_norm + o * 128 + l16 * 8);
  const int f0 = (l16 & 3) * 8;
  for (int R4 = (BIDX() * 8 + wid) * 4; R4 < MROWS; R4 += GDIM() * 32) {
    const int R = R4 + sub; const int b = R >= TB ? 1 : 0, pp = R - b * TB; const bool lat = pp >= CTXL; const int t = lat ? pp - CTXL : 0;
    const int pos = (l16 < 8) ? (t >> 6) : (t & 63);
    bf16_t* base = QKV + (size_t)R * 1536 + l16 * 8;
    bf16x8 x[10];
#pragma unroll
    for (int hd = 0; hd < 10; ++hd) x[hd] = *(const bf16x8*)(base + hd * 128);
    float cs[8], sn[8];
#pragma unroll
    for (int j = 0; j < 8; ++j) { const float2 t2 = *(const float2*)(tab + 2 * (pos * 32 + f0 + j)); cs[j] = lat ? t2.x : 1.f; sn[j] = lat ? t2.y : 0.f; }
#pragma unroll
    for (int hd = 0; hd < 10; ++hd) {
      float v[8]; float ss = 0.f;
#pragma unroll
      for (int j = 0; j < 8; ++j) { v[j] = bf2f((bf16_t)x[hd][j]); ss += v[j] * v[j]; }
      ss += __shfl_xor(ss, 1); ss += __shfl_xor(ss, 2); ss += __shfl_xor(ss, 4); ss += __shfl_xor(ss, 8);
      const float rs = rsqrtf(ss * (1.f / 128.f) + EPSF);
      float ov[8];
#pragma unroll
      for (int j = 0; j < 8; ++j) { v[j] = v[j] * rs * (hd < 8 ? qn[j] : kn[j]); const float pr = __shfl_xor(v[j], 4);
        ov[j] = (l16 & 4) ? (pr * sn[j] + v[j] * cs[j]) : (v[j] * cs[j] - pr * sn[j]); }
      *(u32x4*)(base + hd * 128) = (u32x4){cvtpk(ov[0], ov[1]), cvtpk(ov[2], ov[3]), cvtpk(ov[4], ov[5]), cvtpk(ov[6], ov[7])};
    }
  }
}

__device__ __forceinline__ void qk_fused(const P& p, char* lds, int o) {
  const int tid = TIDX(), l16 = tid & 15, grp = tid >> 4;
  bf16_t* QKV = (bf16_t*)(p.ws + OFF_D);
  float* tab = (float*)lds;
  for (int i = tid; i < 4096; i += 512) { const int pos = i >> 5, f = i & 31; const float ang = (float)pos * powf(10000.f, -(float)f / 32.f); tab[2 * i] = cosf(ang); tab[2 * i + 1] = sinf(ang); }
  asm volatile("s_waitcnt vmcnt(0)" ::: "memory");
  __syncthreads();
  const int f0 = (l16 & 3) * 8;
  pg8::SchedX S; S.so.init(MROWS, 1536, GDIM(), BIDX()); S.mode = 0;
  pg8::Unit u;
  for (int ui = 0; S.next(ui, u); ++ui) {
    if (u.pn >= 5) continue;
    const f32x8 nw = *(const f32x8*)((u.pn < 4 ? p.att_q_norm : p.att_k_norm) + o * 128 + l16 * 8);
    for (int it0 = grp; it0 < 512; it0 += 128) {
      bf16x8 x[4]; bf16_t* base[4]; int pos[4]; bool lat[4];
#pragma unroll
      for (int q = 0; q < 4; ++q) { const int it = it0 + q * 32;
        const int R = u.pm * 256 + (it >> 1); const int b = R >= TB ? 1 : 0, pp = R - b * TB; lat[q] = pp >= CTXL; const int t = lat[q] ? pp - CTXL : 0;
        pos[q] = (l16 < 8) ? (t >> 6) : (t & 63);
        base[q] = QKV + (size_t)R * 1536 + u.pn * 256 + (it & 1) * 128 + l16 * 8; x[q] = *(const bf16x8*)base[q]; }
#pragma unroll
      for (int q = 0; q < 4; ++q) {
        float v[8]; float ss = 0.f;
#pragma unroll
        for (int j = 0; j < 8; ++j) { v[j] = bf2f((bf16_t)x[q][j]); ss += v[j] * v[j]; }
        ss += __shfl_xor(ss, 1); ss += __shfl_xor(ss, 2); ss += __shfl_xor(ss, 4); ss += __shfl_xor(ss, 8);
        const float rs = rsqrtf(ss * (1.f / 128.f) + EPSF);
        float ov[8];
#pragma unroll
        for (int j = 0; j < 8; ++j) { const float2 t2 = *(const float2*)(tab + 2 * (pos[q] * 32 + f0 + j)); const float cs = lat[q] ? t2.x : 1.f, sn = lat[q] ? t2.y : 0.f;
          v[j] = v[j] * rs * nw[j]; const float pr = __shfl_xor(v[j], 4);
          ov[j] = (l16 & 4) ? (pr * sn + v[j] * cs) : (v[j] * cs - pr * sn); }
        *(u32x4*)base[q] = (u32x4){cvtpk(ov[0], ov[1]), cvtpk(ov[2], ov[3]), cvtpk(ov[4], ov[5]), cvtpk(ov[6], ov[7])};
      }
    }
  }
}

namespace at {
constexpr int D = 128, NW = 8, QBLK = 32, KVBLK = 64;
constexpr float SCALE = 0.088388347648318440f, THR = 8.f;
constexpr int LDQ = 1536, LDK = 1536, LDO = 1024;
constexpr size_t SHM_V = KVBLK * D * 2, SHM_K = KVBLK * D * 2;
#define KSWZ(row, colB) ((row) * 256 + ((colB) ^ (((row) & 7) << 4)))
#define SBAR() __builtin_amdgcn_sched_barrier(0)
DI void partialSM(f32x16& p0, f32x16& p1, float& m_reg, float& mn, float& alpha) {
  constexpr float C = SCALE * 1.4426950408889634f;
  float pmax = p0[0]; for (int r = 1; r < 16; ++r) pmax = fmaxf(pmax, p0[r]); for (int r = 0; r < 16; ++r) pmax = fmaxf(pmax, p1[r]);
  { auto rr = __builtin_amdgcn_permlane32_swap(__float_as_uint(pmax), __float_as_uint(pmax), false, false);
    pmax = fmaxf(__uint_as_float(rr[0]), __uint_as_float(rr[1])); }
  if (__builtin_expect(__all(pmax - m_reg <= THR / SCALE), 1)) { mn = m_reg; alpha = 1.f; }
  else { mn = fmaxf(m_reg, pmax); alpha = __builtin_amdgcn_exp2f((m_reg - mn) * C); m_reg = mn; }
  float mnC = -mn * C;
  for (int r = 0; r < 16; ++r) p0[r] = fmaf(p0[r], C, mnC); for (int r = 0; r < 16; ++r) p1[r] = fmaf(p1[r], C, mnC);
  for (int r = 0; r < 16; ++r) p0[r] = __builtin_amdgcn_exp2f(p0[r]);
}
DI void finishSM(f32x16& p0, f32x16& p1, float alpha, float& l_reg, bf16x8& pa0, bf16x8& pa1, bf16x8& pa2, bf16x8& pa3) {
  for (int r = 0; r < 16; ++r) p1[r] = __builtin_amdgcn_exp2f(p1[r]);
  float ps = 0; for (int r = 0; r < 16; ++r) ps += p0[r]; for (int r = 0; r < 16; ++r) ps += p1[r];
  { auto rr = __builtin_amdgcn_permlane32_swap(__float_as_uint(ps), __float_as_uint(ps), false, false);
    ps = __uint_as_float(rr[0]) + __uint_as_float(rr[1]); }
  l_reg = l_reg * alpha + ps;
#define PK4(PP, BASE, OUT) do { unsigned a0 = cvtpk(PP[BASE + 0], PP[BASE + 1]), a1 = cvtpk(PP[BASE + 2], PP[BASE + 3]);   \
    unsigned b0 = cvtpk(PP[BASE + 4], PP[BASE + 5]), b1 = cvtpk(PP[BASE + 6], PP[BASE + 7]);                              \
    auto r0 = __builtin_amdgcn_permlane32_swap(a0, b0, false, false); auto r1 = __builtin_amdgcn_permlane32_swap(a1, b1, false, false); \
    u32x4 w = {r0[0], r1[0], r0[1], r1[1]}; OUT = *reinterpret_cast<bf16x8*>(&w); } while (0)
  PK4(p0, 0, pa0); PK4(p0, 8, pa1); PK4(p1, 0, pa2); PK4(p1, 8, pa3);
#undef PK4
}
DI void qkt(f32x16& p0, f32x16& p1, const bf16_t* Ks, const bf16x8* qr, int r32, int hi) {
  p0 = f32x16{}; p1 = f32x16{};
  for (int d0 = 0; d0 < 8; ++d0) { int cb = (d0 * 16 + hi * 8) * 2;
    bf16x8 b0 = *reinterpret_cast<const bf16x8*>((const char*)Ks + KSWZ(r32, cb));
    bf16x8 b1 = *reinterpret_cast<const bf16x8*>((const char*)Ks + KSWZ(32 + r32, cb));
    p0 = MFMA32(b0, qr[d0], p0);
    p1 = MFMA32(b1, qr[d0], p1); }
}
DI int v_st(int k, int c) { const int kk = (k & ~0xC) | ((k & 4) << 1) | ((k & 8) >> 1); return ((kk >> 3) * 4 + (c >> 5)) * 512 + ((kk & 7) * 32 + (c & 31)) * 2; }
DI int v_rd_base(int lane) { return ((lane & 3) << 3) | (((lane >> 2) & 3) << 6) | (((lane >> 4) & 1) << 5) | (((lane >> 5) & 1) << 8); }
constexpr int v_rd_off(int d0, int ks, int half) { return d0 * 512 + ks * 4096 + half * 2048; }
template <int OFF> DI s16x4 tr_read(int vb) {
  s16x4 r; asm volatile("ds_read_b64_tr_b16 %0, %1 offset:%2" : "=&v"(r) : "v"(vb), "i"(OFF) : "memory"); return r;
}
template <int D0> DI void pv_one(f32x16& od, int vb, bf16x8 pa0, bf16x8 pa1, bf16x8 pa2, bf16x8 pa3) {
  const s16x4 l0 = tr_read<v_rd_off(D0, 0, 0)>(vb), h0 = tr_read<v_rd_off(D0, 0, 1)>(vb), l1 = tr_read<v_rd_off(D0, 1, 0)>(vb), h1 = tr_read<v_rd_off(D0, 1, 1)>(vb);
  const s16x4 l2 = tr_read<v_rd_off(D0, 2, 0)>(vb), h2 = tr_read<v_rd_off(D0, 2, 1)>(vb), l3 = tr_read<v_rd_off(D0, 3, 0)>(vb), h3 = tr_read<v_rd_off(D0, 3, 1)>(vb);
  asm volatile("s_waitcnt lgkmcnt(0)" ::: "memory"); SBAR();
#define PK(Lx, Hx) (bf16x8){Lx[0], Lx[1], Lx[2], Lx[3], Hx[0], Hx[1], Hx[2], Hx[3]}
  od = MFMA32(pa0, PK(l0, h0), od);
  od = MFMA32(pa1, PK(l1, h1), od);
  od = MFMA32(pa2, PK(l2, h2), od);
  od = MFMA32(pa3, PK(l3, h3), od);
#undef PK
}
DI void pv_d0(f32x16* o, int vb, bf16x8 pa0, bf16x8 pa1, bf16x8 pa2, bf16x8 pa3) {
  pv_one<0>(o[0], vb, pa0, pa1, pa2, pa3); pv_one<1>(o[1], vb, pa0, pa1, pa2, pa3); pv_one<2>(o[2], vb, pa0, pa1, pa2, pa3); pv_one<3>(o[3], vb, pa0, pa1, pa2, pa3);
}
DI void attn_dense_body(const bf16_t* __restrict__ Qb, const bf16_t* __restrict__ Kh, const bf16_t* __restrict__ Vh, bf16_t* __restrict__ Ob, int seq, char* lds) {
  const int tid = TIDX(), wid = tid >> 6, lane = tid & 63, r32 = lane & 31, hi = lane >> 5;
  bf16_t* V_lds = (bf16_t*)lds; bf16_t* K_lds = (bf16_t*)(lds + 2 * SHM_V);
  float* ws = (float*)(lds + 2 * SHM_V + 2 * SHM_K) + wid * 64; float* li_l = ws; float* al_l = ws + 32;
  float m_reg = -1e30f, l_reg = 0; f32x16 o[4] = {}; bf16x8 qr[8];
  const bf16_t* Qw = Qb + (long)(wid * QBLK + r32) * LDQ + hi * 8;
#pragma unroll
  for (int d0 = 0; d0 < 8; ++d0) qr[d0] = *reinterpret_cast<const bf16x8*>(Qw + d0 * 16);
  const int sr = tid >> 4, sc = (tid & 15) * 8, vst0 = v_st(sr, sc), vst1 = v_st(32 + sr, sc);
  const int vb0 = (int)(uintptr_t)V_lds + v_rd_base(lane);
  struct { bf16x8 vs0, vs1, ks0, ks1; } sr_[2];
#define SLOAD(i, k0) do { sr_[i].vs0 = *(const bf16x8*)(&Vh[(long)((k0) + sr) * LDK + sc]); sr_[i].vs1 = *(const bf16x8*)(&Vh[(long)((k0) + 32 + sr) * LDK + sc]); \
    sr_[i].ks0 = *(const bf16x8*)(&Kh[(long)((k0) + sr) * LDK + sc]); sr_[i].ks1 = *(const bf16x8*)(&Kh[(long)((k0) + 32 + sr) * LDK + sc]); } while (0)
#define SWRITE(bq, i) do { *(bf16x8*)((char*)V_lds + (bq) * SHM_V + vst0) = sr_[i].vs0;          \
    *(bf16x8*)((char*)V_lds + (bq) * SHM_V + vst1) = sr_[i].vs1; int kc = sc * 2;               \
    *(bf16x8*)((char*)K_lds + (bq) * SHM_K + KSWZ(sr, kc)) = sr_[i].ks0;                       \
    *(bf16x8*)((char*)K_lds + (bq) * SHM_K + KSWZ(32 + sr, kc)) = sr_[i].ks1; } while (0)
#define SWAIT() asm volatile("s_waitcnt vmcnt(4)" ::: "memory")
#define RESC(a) do { if (__any((a) < 1.f)) { if (hi == 0) al_l[r32] = (a); asm volatile("s_waitcnt lgkmcnt(0)" ::: "memory"); \
    for (int d = 0; d < 4; ++d) for (int r = 0; r < 16; ++r) o[d][r] *= al_l[crow(r, hi)]; } } while (0)
  f32x16 pA0, pA1, pB0, pB1; float mnA, mnB, alA, alB; bf16x8 pa0, pa1, pa2, pa3; const int NT = seq / KVBLK;
  constexpr int SE = 0, SO = 1;
  SLOAD(SE, 0); asm volatile("s_waitcnt vmcnt(0)" ::: "memory"); SWRITE(0, SE); __syncthreads();
  qkt(pA0, pA1, K_lds, qr, r32, hi); partialSM(pA0, pA1, m_reg, mnA, alA);
  SLOAD(SO, KVBLK); if (2 < NT) SLOAD(SE, 2 * KVBLK);
  SWAIT(); SWRITE(1, SO); __syncthreads();
  for (int j = 1; j + 1 < NT; j += 2) {
    SBAR(); qkt(pB0, pB1, (bf16_t*)((char*)K_lds + SHM_K), qr, r32, hi);
    finishSM(pA0, pA1, alA, l_reg, pa0, pa1, pa2, pa3); SBAR();
    SLOAD(SO, (j + 2) * KVBLK); SBAR();
    pv_d0(o, vb0, pa0, pa1, pa2, pa3); partialSM(pB0, pB1, m_reg, mnB, alB);
    __syncthreads(); SWAIT(); SWRITE(0, SE);
    RESC(alB); __syncthreads();
    SBAR(); qkt(pA0, pA1, K_lds, qr, r32, hi);
    finishSM(pB0, pB1, alB, l_reg, pa0, pa1, pa2, pa3); SBAR();
    if (j + 3 < NT) SLOAD(SE, (j + 3) * KVBLK); SBAR();
    pv_d0(o, vb0 + (int)SHM_V, pa0, pa1, pa2, pa3); partialSM(pA0, pA1, m_reg, mnA, alA);
    __syncthreads(); SWAIT(); SWRITE(1, SO);
    RESC(alA); __syncthreads();
  }
  SBAR(); qkt(pB0, pB1, (bf16_t*)((char*)K_lds + SHM_K), qr, r32, hi);
  finishSM(pA0, pA1, alA, l_reg, pa0, pa1, pa2, pa3); SBAR();
  pv_d0(o, vb0, pa0, pa1, pa2, pa3); partialSM(pB0, pB1, m_reg, mnB, alB);
  __syncthreads(); RESC(alB);
  finishSM(pB0, pB1, alB, l_reg, pa0, pa1, pa2, pa3); SBAR();
  pv_d0(o, vb0 + (int)SHM_V, pa0, pa1, pa2, pa3);
  if (hi == 0) li_l[r32] = l_reg; asm volatile("s_waitcnt lgkmcnt(0)" ::: "memory");
  float rli[16];
#pragma unroll
  for (int r = 0; r < 16; ++r) rli[r] = __builtin_amdgcn_rcpf(li_l[crow(r, hi)]);
  bf16_t* Ow = Ob + (long)(wid * QBLK) * LDO;
#pragma unroll
  for (int r = 0; r < 16; ++r) { int orow = crow(r, hi);
    for (int d0 = 0; d0 < 4; ++d0) Ow[(long)orow * LDO + d0 * 32 + r32] = f2bf(o[d0][r] * rli[r]); }
#undef SLOAD
#undef SWRITE
#undef SWAIT
#undef RESC
}
}

__device__ __forceinline__ void ph_attn(const P& p, char* lds, bool need_ctx) {
  const bf16_t* QKV = (const bf16_t*)(p.ws + OFF_D); bf16_t* hb = (bf16_t*)(p.ws + OFF_HBF);
  const int nunits = need_ctx ? 528 : 512;
  for (int u = BIDX(); u < nunits; u += GDIM()) {
    int b, h, seq; size_t qrow;
    if (u < 512) { b = u >> 8; const int rem = u & 255; h = rem >> 5; qrow = (size_t)b * TB + CTXL + (size_t)(rem & 31) * 256; seq = TB; }
    else { const int uu = u - 512; b = uu >> 3; h = uu & 7; qrow = (size_t)b * TB; seq = CTXL; }
    const int kvh = h >> 2;
    const bf16_t* Kh = QKV + (size_t)b * TB * 1536 + 1024 + kvh * 128;
    const bf16_t* Vh = QKV + (size_t)b * TB * 1536 + 1280 + kvh * 128;
    at::attn_dense_body(QKV + qrow * 1536 + h * 128, Kh, Vh, hb + qrow * 1024 + h * 128, seq, lds);
    __syncthreads();
  }
}

__device__ __forceinline__ void ph_final(const P& p) {
  const int tid = TIDX(), wid = tid >> 6, lane = tid & 63;
  const float* xr = (const float*)(p.ws + OFF_XRES);
  for (int q = BIDX() * 8 + wid; q < 2 * LAT; q += GDIM() * 8) {
    const int b = q >> 13, t = q & (LAT - 1); const float* row = xr + ((size_t)b * TB + CTXL + t) * 1024;
    f32x4 v[4]; float ss = 0.f;
#pragma unroll
    for (int i = 0; i < 4; ++i) { v[i] = *(const f32x4*)(row + i * 256 + lane * 4); ss += v[i][0] * v[i][0] + v[i][1] * v[i][1] + v[i][2] * v[i][2] + v[i][3] * v[i][3]; }
    ss = wave_sum(ss); const float rs = rsqrtf(ss * (1.f / 1024.f) + EPSF);
#pragma unroll
    for (int i = 0; i < 4; ++i) { const int c0 = i * 256 + lane * 4; const f32x4 g = *(const f32x4*)(p.final_norm + c0); f32x4 o = v[i] * rs * g; *(f32x4*)(p.out + (size_t)q * 1024 + c0) = o; }
  }
}

#ifndef ONLY_PH
#define ONLY_PH -1
#endif
#define EN(x) (ONLY_PH < 0 || ONLY_PH == (x))
#ifndef PROBE_REP
#define PROBE_REP -1
#endif
#define RUN(cls, ...) do { if (EN(cls)) { for (int rep_ = 0; rep_ < ((PROBE_REP == (cls)) ? 2 : 1); ++rep_) { if (rep_) xcd_barrier(*xbp); __VA_ARGS__; } } } while (0)
enum { OP_INIT, OP_N1FULL, OP_IN, OP_PREP, OP_D1, OP_SCAN, OP_MERGE, OP_OUTLAT, OP_OUTCTX_N2LAT, OP_N2CTX, OP_UP, OP_ACT, OP_DOWNLAT, OP_DOWNCTX_N1LAT, OP_N1CTX,
       OP_QKV, OP_QKNORM, OP_ATTN, OP_N2FULL, OP_FINAL };
constexpr int NPHASES = 46;
__device__ __forceinline__ void decode_phase(int ph, int& op, int& L) {
  if (ph == 0) { op = OP_INIT; L = 0; return; }
  if (ph == NPHASES - 1) { op = OP_FINAL; L = 3; return; }
  int q = ph - 1;
  if (q < 14) { L = 0; if (q == 0) { op = OP_N1FULL; return; } q -= 1; }
  else if (q < 24) { L = 1; q -= 14; }
  else if (q < 37) { L = 2; q -= 24; }
  else { L = 3; q -= 37; }
  if ((L & 1) == 0) {
    if (q < 5) { op = OP_IN + q; return; }
    q -= 5;
  } else {
    if (q < 2) { op = q == 0 ? OP_QKV : OP_ATTN; return; }
    q -= 2;
  }
  if (L < 3) { const int t[8] = {OP_OUTLAT, OP_OUTCTX_N2LAT, OP_N2CTX, OP_UP, OP_ACT, OP_DOWNLAT, OP_DOWNCTX_N1LAT, OP_N1CTX}; op = t[q]; }
  else { const int t[5] = {OP_OUTLAT, OP_N2FULL, OP_UP, OP_ACT, OP_DOWNLAT}; op = t[q]; }
}
__device__ __forceinline__ void run_phase(const P& p0, int ph, char* lds, const XcdBarrier* xbp) {
  P p = p0; { typedef __attribute__((address_space(1))) char gchar_t; size_t wi = (size_t)p0.ws; asm volatile("" : "+s"(wi)); p.ws = (char*)(gchar_t*)wi; }
  int op, L; decode_phase(ph, op, L);
  const int e = L >> 1, o = L >> 1;
  bf16_t* W1 = (bf16_t*)(p.ws + OFF_WC); bf16_t* W2 = (bf16_t*)(p.ws + OFF_WC + WC_W2); bf16_t* W3 = (bf16_t*)(p.ws + OFF_W3);
  bf16_t* hb = (bf16_t*)(p.ws + OFF_HBF); float* xr = (float*)(p.ws + OFF_XRES);
  const float* mods = (const float*)(p.ws + OFF_MODS) + (size_t)L * 3 * 6144;
  float* PART = (float*)(p.ws + OFF_D + D_END_F);
#define CVT_MIX(LL, skipb) do { const int L_ = (LL); if ((L_ & 1) == 0) { cvt_weight(p.rec_w_in + (size_t)(L_ >> 1) * 1024 * 3632, W1, 1024, 3632, NREC, true, skipb); cvt_weight(p.rec_w_out + (size_t)(L_ >> 1) * 1024 * 1024, W3, 1024, 1024, 1024, false, skipb); } \
    else { cvt_weight(p.att_w_qkv + (size_t)(L_ >> 1) * 1024 * 1536, W1, 1024, 1536, 1536, false, skipb); cvt_weight(p.att_w_out + (size_t)(L_ >> 1) * 1024 * 1024, W3, 1024, 1024, 1024, false, skipb); } } while (0)
#define CVT_FFN(LL, skipb) do { const int L_ = (LL); cvt_weight(p.ffn_w_up + (size_t)L_ * 1024 * 5632, W1, 1024, 5632, 5632, false, skipb); cvt_weight(p.ffn_w_down + (size_t)L_ * DFF * 1024, W2, DFF, 1024, 1024, false, skipb); } while (0)
  switch (op) {
    case OP_INIT: RUN(0, ph_init(p, lds); CVT_MIX(0, 0)); break;
    case OP_N1FULL: RUN(1, ph_norm(p, L, 0, 0, 0)); break;
    case OP_IN: RUN(2, gemm8(lds, hb, 1024, W1, 1024, NREC, 0, EpiRec8{(bf16_t*)(p.ws + OFF_D + D_P1), (bf16_t*)(p.ws + OFF_D + D_P2), (float*)(p.ws + OFF_SM)})); break;
    case OP_PREP: RUN(3, ph_dnprep(p, lds, e)); break;
    case OP_D1: RUN(4, ph_dn_d1(p, lds); ph_gla_b(p, lds, e)); break;
    case OP_SCAN: RUN(5, if (BIDX() < 64) { dn_scan(p, lds, BIDX()); } else if (BIDX() < 128) { gla_scan(p, lds, BIDX() - 64, e); });
        if (PROBE_REP == 55) { xcd_barrier(*xbp); if (BIDX() < 64) { dn_scan(p, lds, BIDX()); } }
        if (PROBE_REP == 56) { xcd_barrier(*xbp); if (BIDX() >= 64 && BIDX() < 128) { gla_scan(p, lds, BIDX() - 64, e); } }
        break;
    case OP_MERGE: RUN(7, ph_merge(p, e)); break;
    case OP_QKV: if (EN(2)) { gemm8(lds, hb, 1024, W1, 1024, 1536, 0, EpiBf8{(bf16_t*)(p.ws + OFF_D), 1536}); qk_fused(p, lds, o); } break;
    case OP_ATTN: RUN(10, ph_attn(p, lds, L != 3)); break;
    case OP_OUTLAT: if (EN(2)) { gemm8(lds, hb, 1024, W3, 1024, 1024, 1, EpiRes8{xr, mods + 2 * 1024}); if (L == 3) CVT_FFN(L, 0); } break;
    case OP_OUTCTX_N2LAT: if (EN(2)) { if (BIDX() < 128) gemm_ctx_split(lds, hb, 1024, W3, 1024, 128, PART); ph_norm(p, L, 1, 1, 0); CVT_FFN(L, 0); } break;
    case OP_N2CTX: if (EN(1)) ph_ctx_fold_norm(p, L, 1, PART, 8, mods + 2 * 1024); break;
    case OP_N2FULL: if (EN(1)) ph_norm(p, L, 1, 0, 0); break;
    case OP_UP: RUN(2, gemm8(lds, hb, 1024, W1, 1024, 5632, L == 3 ? 1 : 0, EpiBf8{(bf16_t*)(p.ws + OFF_D), 5632})); break;
    case OP_ACT: if (EN(8)) ph_ffnact(p, L); break;
    case OP_DOWNLAT: if (EN(2)) gemm8(lds, (const bf16_t*)(p.ws + OFF_D) + DFF, 5632, W2, DFF, 1024, 1, EpiRes8{xr, mods + 5 * 1024}); break;
    case OP_DOWNCTX_N1LAT: if (EN(2)) { if (BIDX() < 176) gemm_ctx_split(lds, (const bf16_t*)(p.ws + OFF_D) + DFF, 5632, W2, DFF, 256, PART); ph_norm(p, L + 1, 0, 1, 0); CVT_MIX(L + 1, 0); } break;
    case OP_N1CTX: if (EN(1)) ph_ctx_fold_norm(p, L + 1, 0, PART, 11, mods + 5 * 1024); break;
    case OP_FINAL: if (EN(11)) ph_final(p); break;
  }
#undef CVT_MIX
#undef CVT_FFN
}

template <bool COOP>
__global__ void __launch_bounds__(512, 1) mk_kernel(P p, int ph0, int ph1) {
  extern __shared__ __attribute__((aligned(16))) char smem[];
  if constexpr (COOP) {
    if (ph0 < 0) cg::this_grid().sync();
    volatile LAS unsigned* st = (volatile LAS unsigned*)(smem + LDS_BYTES);
    if (threadIdx.x < 4) st[threadIdx.x] = 0u;
    __syncthreads();
    XcdBarrier xb = xcd_barrier_post((unsigned*)(p.ws + OFF_BAR), st);
    for (int ph = ph0; ph < ph1; ++ph) {
      run_phase(p, ph, smem, &xb);
      if (ph + 1 < ph1) xcd_barrier(xb);
      if (PROBE_REP == 99 && ph == 0) { for (int q = 0; q < 20; ++q) xcd_barrier(xb); }
    }
  } else {
    for (int ph = ph0; ph < ph1; ++ph) run_phase(p, ph, smem, nullptr);
  }
}

extern "C" void kernel_launch(void* const* d_in, const int* in_sizes, int n_in, void* d_out, int out_size, void* d_ws, size_t ws_size, hipStream_t stream) {
  if (n_in != 23 || ws_size < WS_NEED) { fprintf(stderr, "kernel_launch: bad n_in %d or ws %zu < %zu\n", n_in, ws_size, (size_t)WS_NEED); return; }
  P p{};
  const float** f = (const float**)&p;
  for (int i = 0; i < 23; ++i) f[i] = (const float*)d_in[i];
  p.out = (float*)d_out; p.ws = (char*)d_ws;
  static int inited = 0, grid_blocks = 0;
  if (!inited) {
    hipFuncSetAttribute((const void*)mk_kernel<true>, hipFuncAttributeMaxDynamicSharedMemorySize, LDS_BYTES + 16);
#if !MK_COOP
    hipFuncSetAttribute((const void*)mk_kernel<false>, hipFuncAttributeMaxDynamicSharedMemorySize, LDS_BYTES);
#endif
    int dev = 0, cus = 0, per_cu = 0;
    hipGetDevice(&dev); hipDeviceGetAttribute(&cus, hipDeviceAttributeMultiprocessorCount, dev);
    hipOccupancyMaxActiveBlocksPerMultiprocessor(&per_cu, mk_kernel<true>, 512, LDS_BYTES + 16);
    if (per_cu > 1) per_cu = 1;
    grid_blocks = cus * per_cu; if (grid_blocks > 256) grid_blocks = 256; if (grid_blocks < 128) grid_blocks = 128;
    inited = 1;
  }
#if MK_COOP
  int ph0 = 0, ph1 = NPHASES;
  void* args[] = {&p, &ph0, &ph1};
  hipMemsetAsync((char*)d_ws + OFF_BAR, 0, 3456 * 4, stream);
  hipError_t er = hipLaunchCooperativeKernel((const void*)mk_kernel<true>, dim3(grid_blocks), dim3(512), args, LDS_BYTES + 16, stream);
  if (er != hipSuccess) fprintf(stderr, "cooperative launch failed: %s (grid %d)\n", hipGetErrorString(er), grid_blocks);
#else
  for (int ph = 0; ph < NPHASES; ++ph) hipLaunchKernelGGL(mk_kernel<false>, dim3(256), dim3(512), LDS_BYTES, stream, p, ph, ph + 1);
#endif
}
```

```cpp
#include <hip/hip_runtime.h>
#include <hip/hip_cooperative_groups.h>
#include <cstdio>
#include <cstdint>
namespace cg = cooperative_groups;

#ifndef MK_COOP
#define MK_COOP 1
#endif

typedef unsigned short bf16_t;
typedef short bf16x8 __attribute__((ext_vector_type(8)));
typedef short s16x4 __attribute__((ext_vector_type(4)));
typedef float f32x16 __attribute__((ext_vector_type(16)));
typedef float f32x8 __attribute__((ext_vector_type(8)));
typedef float f32x4 __attribute__((ext_vector_type(4)));
typedef unsigned u32x4 __attribute__((ext_vector_type(4)));
#define DI __device__ __forceinline__
#define LBAR() do { asm volatile("s_waitcnt lgkmcnt(0)" ::: "memory"); __builtin_amdgcn_s_barrier(); asm volatile("" ::: "memory"); } while (0)
#define MFMA32(a, b, c) __builtin_amdgcn_mfma_f32_32x32x16_bf16((a), (b), (c), 0, 0, 0)

constexpr int DM = 1024, TB = 8448, CTXL = 256, LAT = 8192, MROWS = 2 * TB;
constexpr int NCH = 132;
constexpr int DFF = 2816;
constexpr int NREC = 3840;
constexpr float EPSF = 1e-6f;

constexpr size_t AL(size_t x) { return (x + 255) / 256 * 256; }
constexpr size_t OFF_XRES = 0;
constexpr size_t OFF_HBF = OFF_XRES + AL((size_t)MROWS * DM * 4);
constexpr size_t OFF_WC = OFF_HBF + AL((size_t)MROWS * DM * 2);
constexpr size_t WC_W2 = (size_t)5632 * 1024 * 2;
constexpr size_t OFF_MODS = OFF_WC + AL(WC_W2 + (size_t)1024 * 2816 * 2);
constexpr size_t OFF_SM = OFF_MODS + AL((size_t)4 * 3 * 6144 * 4);
constexpr size_t OFF_GB = OFF_SM + AL((size_t)MROWS * 64 * 4);
constexpr size_t OFF_SC = OFF_GB + AL((size_t)MROWS * 16 * 4);
constexpr size_t OFF_GL = OFF_SC + AL((size_t)16 * NCH * 64 * 2 * 4);
constexpr size_t OFF_D = OFF_GL + AL((size_t)16 * NCH * 4);
constexpr size_t D_P1 = 0;
constexpr size_t D_W = 0;
constexpr size_t D_INTRA = D_W + (size_t)16 * NCH * 64 * 128 * 2;
constexpr size_t D_P2 = D_P1 + (size_t)MROWS * 1536 * 2;
constexpr size_t D_QQ = D_P2 + (size_t)MROWS * 2048 * 2;
constexpr size_t D_QK = D_QQ + (size_t)MROWS * 512 * 2;
constexpr size_t D_QV = D_QK + (size_t)MROWS * 512 * 2;
constexpr size_t D_DNO = D_QK;
constexpr size_t D_KT = D_QV + (size_t)MROWS * 512 * 2;
constexpr size_t D_GLAO = D_KT + (size_t)MROWS * 512 * 2;
constexpr size_t D_END_E = D_GLAO + (size_t)2 * MROWS * 512 * 2;
constexpr size_t D_END_F = (size_t)MROWS * 5632 * 2;
constexpr size_t OFF_B16_1 = OFF_D + (D_END_E > D_END_F ? D_END_E : D_END_F);
constexpr size_t B16_BYTES = (size_t)8 * NCH * 64 * 64 * 2;
constexpr size_t OFF_BAR = OFF_B16_1 + AL(B16_BYTES);
constexpr size_t OFF_W3 = OFF_BAR + AL(3456 * 4);
constexpr size_t WS_NEED = OFF_W3 + (size_t)1024 * 1024 * 2;
constexpr int LDS_BYTES = 132 * 1024;

struct P {
  const float *x, *c, *ctx, *c_ctx, *mod_w, *mod_b, *rec_w_in, *rec_conv, *dn_a_log, *dn_dt_bias, *dn_norm, *gla_w2, *gla_b2, *gla_norm,
      *rec_w_out, *att_w_qkv, *att_q_norm, *att_k_norm, *att_w_out, *ffn_w_up, *ffn_conv, *ffn_w_down, *final_norm;
  float* out;
  char* ws;
};

DI int TIDX() { int t = threadIdx.x; asm volatile("" : "+v"(t)); return t; }
DI int BIDX() { int t = blockIdx.x; asm volatile("" : "+s"(t)); return t; }
DI int GDIM() { int t = gridDim.x; asm volatile("" : "+s"(t)); return t; }
DI float bf2f(bf16_t v) { return __uint_as_float(((unsigned)v) << 16); }
DI bf16_t f2bf(float x) { unsigned u = __float_as_uint(x); u += 0x7fffu + ((u >> 16) & 1u); return (bf16_t)(u >> 16); }
typedef __bf16 bf16n2 __attribute__((ext_vector_type(2)));
DI unsigned cvtpk(float lo, float hi) { const bf16n2 v = {(__bf16)lo, (__bf16)hi}; return __builtin_bit_cast(unsigned, v); }
DI int crow(int r, int hi) { return (r & 3) + 8 * (r >> 2) + 4 * hi; }
DI float siluf(float x) { return x / (1.f + expf(-x)); }
DI float sigmf(float x) { return 1.f / (1.f + expf(-x)); }
DI float softplusf(float x) { return fmaxf(x, 0.f) + log1pf(expf(-fabsf(x))); }
DI float wave_sum(float v) {
#pragma unroll
  for (int o = 32; o > 0; o >>= 1) v += __shfl_xor(v, o);
  return v;
}
DI int modrow_of(int R) { const int b = R >= TB ? 1 : 0; const int pp = R - b * TB; return pp < CTXL ? 2 : b; }
template <int KS>
DI f32x16 mma_rows(const bf16_t* arow, const bf16_t* brow, f32x16 acc) {
#pragma unroll
  for (int ks = 0; ks < KS; ++ks) {
    const bf16x8 a = *reinterpret_cast<const bf16x8*>(arow + ks * 16);
    const bf16x8 b = *reinterpret_cast<const bf16x8*>(brow + ks * 16);
    acc = MFMA32(a, b, acc);
  }
  return acc;
}

#define XB_TMO      128
#define XB_XCNT(j)  (256  + 64 * (j))
#define XB_XSUB(j)  (1280 + 64 * (j))
#define XB_XGEN(j)  (2304 + 64 * (j))
#define XB_TOP      3328
#define XB_TOPGEN   3392
#define XCD_BAR_WORDS 3456
#define XB_SPIN_CAP (1u << 18)
#define LAS __attribute__((address_space(3)))
DI unsigned xb_ld(unsigned* p)              { return __hip_atomic_load(p, __ATOMIC_RELAXED, __HIP_MEMORY_SCOPE_AGENT); }
DI unsigned xb_add(unsigned* p, unsigned v) { return __hip_atomic_fetch_add(p, v, __ATOMIC_RELAXED, __HIP_MEMORY_SCOPE_AGENT); }
DI unsigned xb_xcc_id() { return (unsigned)__builtin_amdgcn_s_getreg((3 << 11) | 20) & 0xFu; }
#define XB_SPIN(cond, bar) do { unsigned _sp = 0; while (cond) { __builtin_amdgcn_s_sleep(1); \
    if ((++_sp & 255u) == 0u) { if (xb_ld(&(bar)[XB_TMO])) break; if (_sp > XB_SPIN_CAP) { atomicAdd(&(bar)[XB_TMO], 1u); break; } } } } while (0)
struct XcdBarrier { unsigned* bar; unsigned x; volatile LAS unsigned* st; };
DI XcdBarrier xcd_barrier_post(unsigned* bar, volatile LAS unsigned* st) {
    XcdBarrier b; b.bar = bar; b.x = xb_xcc_id(); b.st = st;
    if (threadIdx.x == 0) (void)xb_add(&bar[XB_XCNT(b.x)], 1u);
    return b;
}
DI void xcd_barrier_complete(unsigned* bar, unsigned x, unsigned& nloc, unsigned& nx) {
    const unsigned G = gridDim.x * gridDim.y * gridDim.z;
    unsigned sum, cnt, mine, sp = 0u;
    for (;;) {
        sum = 0u; cnt = 0u; mine = 0u;
#pragma unroll
        for (unsigned j = 0; j < 16; ++j) { const unsigned c = xb_ld(&bar[XB_XCNT(j)]); sum += c; cnt += (c > 0u) ? 1u : 0u; mine = (j == x) ? c : mine; }
        if (sum == G) break;
        __builtin_amdgcn_s_sleep(1);
        if ((++sp & 255u) == 0u) { if (xb_ld(&bar[XB_TMO])) break; if (sp > XB_SPIN_CAP) { atomicAdd(&bar[XB_TMO], 1u); break; } }
    }
    nloc = mine > 0u ? mine : 1u; nx = cnt > 0u ? cnt : 1u;
}
DI void xcd_barrier(const XcdBarrier& b) {
    asm volatile("s_waitcnt vmcnt(0)" ::: "memory");
    __syncthreads();
    if (threadIdx.x == 0) {
        unsigned* bar = b.bar;
        __builtin_amdgcn_s_waitcnt(0);
        unsigned nloc = b.st[0], nx = b.st[1];
        if (nloc == 0u) { xcd_barrier_complete(bar, b.x, nloc, nx); b.st[0] = nloc; b.st[1] = nx; }
        const unsigned old = xb_add(&bar[XB_XSUB(b.x)], 1u);
        const unsigned gen = old / nloc;
        if (old + 1u == (gen + 1u) * nloc) {
            __builtin_amdgcn_fence(__ATOMIC_RELEASE, "agent");
            asm volatile("s_waitcnt vmcnt(0)" ::: "memory");
            const unsigned og = xb_add(&bar[XB_TOP], 1u);
            const unsigned tg = og / nx;
            if (og + 1u == (tg + 1u) * nx) xb_add(&bar[XB_TOPGEN], 1u);
            else XB_SPIN(xb_ld(&bar[XB_TOPGEN]) == tg, bar);
            __builtin_amdgcn_fence(__ATOMIC_ACQUIRE, "agent");
            xb_add(&bar[XB_XGEN(b.x)], 1u);
            asm volatile("s_waitcnt vmcnt(0)" ::: "memory");
        } else {
            XB_SPIN(xb_ld(&bar[XB_XGEN(b.x)]) == gen, bar);
            __builtin_amdgcn_fence(__ATOMIC_ACQUIRE, "agent");
            asm volatile("s_waitcnt vmcnt(0)" ::: "memory");
        }
    }
    __syncthreads();
}

__device__ __forceinline__ void ph_init(const P& p, char* lds) {
  const int tid = TIDX();
  float* sc = (float*)lds;
  for (int i = tid; i < 3072; i += 512) { const int r = i >> 10, k = i & 1023; const float v = r < 2 ? p.c[r * 1024 + k] : p.c_ctx[k]; sc[i] = siluf(v); }
  __syncthreads();
  float* mods = (float*)(p.ws + OFF_MODS);
  float* red = sc + 3072;
  for (int job = BIDX(); job < 192; job += GDIM()) {
    const int ct = tid & 31, ks = tid >> 5;
    const int col = job * 128 + ct * 4; const int L = col / 6144, cl = col - L * 6144;
    const float* w = p.mod_w + ((size_t)L * 1024 + ks * 64) * 6144 + cl;
    f32x4 a0 = {0.f, 0.f, 0.f, 0.f}, a1 = a0, a2 = a0;
#pragma unroll 16
    for (int k = 0; k < 64; ++k) { const f32x4 wv = *(const f32x4*)(w + (size_t)k * 6144); const int kk = ks * 64 + k; a0 += sc[kk] * wv; a1 += sc[1024 + kk] * wv; a2 += sc[2048 + kk] * wv; }
    *(f32x4*)(red + (ks * 3 + 0) * 128 + ct * 4) = a0; *(f32x4*)(red + (ks * 3 + 1) * 128 + ct * 4) = a1; *(f32x4*)(red + (ks * 3 + 2) * 128 + ct * 4) = a2;
    __syncthreads();
    if (tid < 384) { const int r = tid >> 7, cc = tid & 127; const int c2 = job * 128 + cc; const int L2 = c2 / 6144, cl2 = c2 - L2 * 6144;
      float sm = p.mod_b[L2 * 6144 + cl2];
#pragma unroll
      for (int q = 0; q < 16; ++q) sm += red[(q * 3 + r) * 128 + cc];
      mods[((size_t)L2 * 3 + r) * 6144 + cl2] = sm; }
    __syncthreads();
  }
  f32x4* xr = (f32x4*)(p.ws + OFF_XRES);
  for (size_t i = (size_t)BIDX() * 512 + tid; i < (size_t)MROWS * 256; i += (size_t)GDIM() * 512) {
    const int R = (int)(i >> 8), c4 = (int)(i & 255); const int b = R >= TB ? 1 : 0, pp = R - b * TB;
    const float* src = pp < CTXL ? p.ctx + ((size_t)b * CTXL + pp) * 1024 : p.x + ((size_t)b * LAT + (pp - CTXL)) * 1024;
    xr[i] = *(const f32x4*)(src + c4 * 4);
  }
}

DI int rec_src_col(int n) { if (n < 2048) return n; if (n < 3584) return n + 16; if (n < 3600) return 2048 + (n - 3584); if (n < 3632) return n; return -1; }
__device__ __forceinline__ void cvt_weight(const float* __restrict__ W, bf16_t* __restrict__ Wt, int K, int Nsrc, int Npad, bool perm, int skipb) {
  const size_t items = (size_t)Npad * (K >> 3);
  const int bid = BIDX() - skipb, nb = GDIM() - skipb;
  if (bid < 0) return;
  for (size_t it = (size_t)bid * 512 + TIDX(); it < items; it += (size_t)nb * 512) {
    const int n = (int)(it % Npad), kb = (int)(it / Npad);
    const int s = perm ? rec_src_col(n) : n;
    float v[8];
#pragma unroll
    for (int j = 0; j < 8; ++j) v[j] = s >= 0 ? W[(size_t)(kb * 8 + j) * Nsrc + s] : 0.f;
    u32x4 w = {cvtpk(v[0], v[1]), cvtpk(v[2], v[3]), cvtpk(v[4], v[5]), cvtpk(v[6], v[7])};
    *(u32x4*)(Wt + (size_t)n * K + kb * 8) = w;
  }
}

__device__ __forceinline__ void gemm_ctx_split(char* lds, const bf16_t* __restrict__ A, int lda, const bf16_t* __restrict__ Bt, int ldb, int Ks, float* __restrict__ PART) {
  const int tid = TIDX(), wid = tid >> 6, lane = tid & 63, r32 = lane & 31, hi = lane >> 5;
  const int wm = wid >> 1, wn = wid & 1;
  const int nk = Ks >> 6;
  constexpr int RS = 144, ASZ = 256 * RS, BSZ = 128 * RS, STG = ASZ + BSZ;
  const int srow = tid >> 3, spc = tid & 7;
  const int w = BIDX(); const int ks = w >> 4, j = w & 15; const int pm = (j >> 3) ? 33 : 0, pn = j & 7;
  const bf16_t* Ab = A + (size_t)(pm * 256 + srow) * lda + (size_t)ks * Ks + spc * 8;
  const bf16_t* Bb = Bt + (size_t)(pn * 128 + srow) * ldb + (size_t)ks * Ks + spc * 8;
  f32x16 acc00 = {}, acc01 = {}, acc10 = {}, acc11 = {};
  bf16x8 ra0, ra1, ra2, ra3, rb0, rb1;
#define GLOAD(kt) do { const int ko = (kt) * 64; ra0 = *(const bf16x8*)(Ab + ko); ra1 = *(const bf16x8*)(Ab + (size_t)64 * lda + ko); ra2 = *(const bf16x8*)(Ab + (size_t)128 * lda + ko); \
    ra3 = *(const bf16x8*)(Ab + (size_t)192 * lda + ko); rb0 = *(const bf16x8*)(Bb + ko); rb1 = *(const bf16x8*)(Bb + (size_t)64 * ldb + ko); } while (0)
#define SWRITE(buf) do { char* sb = lds + (buf) * STG + srow * RS + spc * 16; *(bf16x8*)(sb) = ra0; *(bf16x8*)(sb + 64 * RS) = ra1; *(bf16x8*)(sb + 128 * RS) = ra2; *(bf16x8*)(sb + 192 * RS) = ra3; \
    *(bf16x8*)(sb + ASZ) = rb0; *(bf16x8*)(sb + ASZ + 64 * RS) = rb1; } while (0)
  GLOAD(0); SWRITE(0); __syncthreads();
  for (int kt = 0; kt < nk; ++kt) {
    const int cur = kt & 1;
    if (kt + 1 < nk) GLOAD(kt + 1);
    const char* ab = lds + cur * STG + (64 * wm + r32) * RS + hi * 16;
    const char* bb = lds + cur * STG + ASZ + (64 * wn + r32) * RS + hi * 16;
#pragma unroll
    for (int k4 = 0; k4 < 4; ++k4) {
      const bf16x8 a0 = *(const bf16x8*)(ab + k4 * 32), a1 = *(const bf16x8*)(ab + 32 * RS + k4 * 32);
      const bf16x8 b0 = *(const bf16x8*)(bb + k4 * 32), b1 = *(const bf16x8*)(bb + 32 * RS + k4 * 32);
      acc00 = MFMA32(a0, b0, acc00); acc01 = MFMA32(a0, b1, acc01); acc10 = MFMA32(a1, b0, acc10); acc11 = MFMA32(a1, b1, acc11);
    }
    if (kt + 1 < nk) SWRITE(cur ^ 1);
    __syncthreads();
  }
#undef GLOAD
#undef SWRITE
  float* pb = PART + ((size_t)ks * 512 + (pm ? 256 : 0) + 64 * wm) * 1024 + pn * 128 + 64 * wn + r32;
#pragma unroll
  for (int r = 0; r < 16; ++r) { float* q = pb + (size_t)crow(r, hi) * 1024;
    q[0] = acc00[r]; q[32] = acc01[r]; q[32 * 1024] = acc10[r]; q[32 * 1024 + 32] = acc11[r]; }
}

__device__ __forceinline__ void ph_ctx_fold_norm(const P& p, int L, int which, const float* __restrict__ part, int nsplit, const float* __restrict__ gate) {
  const int tid = TIDX(), wid = tid >> 6, lane = tid & 63;
  float* xr = (float*)(p.ws + OFF_XRES); bf16_t* hb = (bf16_t*)(p.ws + OFF_HBF);
  const float* mods = (const float*)(p.ws + OFF_MODS) + (size_t)L * 3 * 6144;
  for (int cr = BIDX() * 8 + wid; cr < 2 * CTXL; cr += GDIM() * 8) {
    const int R = cr < CTXL ? cr : TB + (cr - CTXL);
    float* row = xr + (size_t)R * 1024 + lane * 4;
    const float* pr = part + (size_t)cr * 1024 + lane * 4;
    f32x4 v[4], a[4];
#pragma unroll
    for (int i = 0; i < 4; ++i) { v[i] = *(const f32x4*)(row + i * 256); a[i] = *(const f32x4*)(pr + i * 256); }
    for (int sp = 1; sp < nsplit; ++sp) {
#pragma unroll
      for (int i = 0; i < 4; ++i) a[i] += *(const f32x4*)(pr + (size_t)sp * 512 * 1024 + i * 256);
    }
    float ss = 0.f;
#pragma unroll
    for (int i = 0; i < 4; ++i) { v[i] += *(const f32x4*)(gate + 2 * 6144 + i * 256 + lane * 4) * a[i]; *(f32x4*)(row + i * 256) = v[i];
      ss += v[i][0] * v[i][0] + v[i][1] * v[i][1] + v[i][2] * v[i][2] + v[i][3] * v[i][3]; }
    ss = wave_sum(ss);
    const float rs = rsqrtf(ss * (1.f / 1024.f) + EPSF);
    const float* mr = mods + (size_t)2 * 6144 + which * 3072 + lane * 4;
#pragma unroll
    for (int i = 0; i < 4; ++i) { const f32x4 sh = *(const f32x4*)(mr + i * 256), scl = *(const f32x4*)(mr + 1024 + i * 256);
      float o[4];
#pragma unroll
      for (int j = 0; j < 4; ++j) o[j] = v[i][j] * rs * (1.f + scl[j]) + sh[j];
      uint2 w; w.x = cvtpk(o[0], o[1]); w.y = cvtpk(o[2], o[3]);
      *(uint2*)(hb + (size_t)R * 1024 + i * 256 + lane * 4) = w; }
  }
}

__device__ __forceinline__ void ph_norm(const P& p, int L, int which, int mode, int skipb) {
  const int tid = TIDX(), wid = tid >> 6, lane = tid & 63, l16 = lane & 15, sub = lane >> 4;
  const float* xr = (const float*)(p.ws + OFF_XRES);
  bf16_t* hb = (bf16_t*)(p.ws + OFF_HBF);
  const float* mods = (const float*)(p.ws + OFF_MODS) + (size_t)L * 3 * 6144;
  const int bid = BIDX() - skipb, nb = GDIM() - skipb;
  if (bid < 0) return;
  const int nquads = mode == 0 ? MROWS / 4 : (mode == 1 ? 2 * LAT / 4 : 2 * CTXL / 4);
  for (int q = bid * 8 + wid; q < nquads; q += nb * 8) {
    int R4;
    if (mode == 0) R4 = q * 4; else if (mode == 1) R4 = q < LAT / 4 ? CTXL + q * 4 : TB + CTXL + (q - LAT / 4) * 4; else R4 = q < CTXL / 4 ? q * 4 : TB + (q - CTXL / 4) * 4;
    const int R = R4 + sub;
    const float* row = xr + (size_t)R * 1024 + l16 * 8;
    f32x4 v[16]; float ss = 0.f;
#pragma unroll
    for (int i = 0; i < 8; ++i) { v[2 * i] = *(const f32x4*)(row + i * 128); v[2 * i + 1] = *(const f32x4*)(row + i * 128 + 4); }
#pragma unroll
    for (int i = 0; i < 16; ++i) ss += v[i][0] * v[i][0] + v[i][1] * v[i][1] + v[i][2] * v[i][2] + v[i][3] * v[i][3];
    ss += __shfl_xor(ss, 1); ss += __shfl_xor(ss, 2); ss += __shfl_xor(ss, 4); ss += __shfl_xor(ss, 8);
    const float rs = rsqrtf(ss * (1.f / 1024.f) + EPSF);
    const float* mr = mods + (size_t)modrow_of(R) * 6144 + which * 3072 + l16 * 8;
    bf16_t* dst = hb + (size_t)R * 1024 + l16 * 8;
#pragma unroll
    for (int i = 0; i < 8; ++i) { unsigned w[4];
#pragma unroll
      for (int hlf = 0; hlf < 2; ++hlf) { const f32x4 sh = *(const f32x4*)(mr + i * 128 + hlf * 4), scl = *(const f32x4*)(mr + 1024 + i * 128 + hlf * 4); const f32x4 x = v[2 * i + hlf];
        float o[4];
#pragma unroll
        for (int j = 0; j < 4; ++j) o[j] = x[j] * rs * (1.f + scl[j]) + sh[j];
        w[2 * hlf] = cvtpk(o[0], o[1]); w[2 * hlf + 1] = cvtpk(o[2], o[3]); }
      *(u32x4*)(dst + i * 128) = (u32x4){w[0], w[1], w[2], w[3]}; }
  }
}

struct EpiRec { bf16_t* P1; bf16_t* P2; float* SM;
  DI void operator()(int row, int col, float v) const {
    if (col < 1536) P1[(size_t)row * 1536 + col] = f2bf(v);
    else if (col < 3584) P2[(size_t)row * 2048 + (col - 1536)] = f2bf(v);
    else { const int lc = col - 3584; if (lc < 48) SM[(size_t)row * 64 + lc] = v; } } };
struct EpiBf { bf16_t* O; int ldc;
  DI void operator()(int row, int col, float v) const { O[(size_t)row * ldc + col] = f2bf(v); } };
struct EpiRes { float* X; const float* gate;
  DI void operator()(int row, int col, float v) const { float* q = X + (size_t)row * 1024 + col; *q = *q + gate[(size_t)modrow_of(row) * 6144 + col] * v; } };

template <class Epi>
__device__ __forceinline__ void gemm_phase(char* lds, const bf16_t* __restrict__ A, int lda, const bf16_t* __restrict__ Bt, int K, int nN, const Epi epi, bool skipctx = false) {
  const int tid = TIDX(), wid = tid >> 6, lane = tid & 63, r32 = lane & 31, hi = lane >> 5;
  const int wm = wid >> 1, wn = wid & 1;
  const int nk = K >> 6;
  constexpr int RS = 144, ASZ = 256 * RS, BSZ = 128 * RS, STG = ASZ + BSZ;
  const int ntiles = (skipctx ? 64 : MROWS / 256) * nN;
  const int srow = tid >> 3, spc = tid & 7;
  for (int t = BIDX(); t < ntiles; t += GDIM()) {
    int pm = t / nN; const int pn = t - pm * nN; if (skipctx) pm = pm + 1 + (pm >= 32 ? 1 : 0);
    const bf16_t* Ab = A + (size_t)(pm * 256 + srow) * lda + spc * 8;
    const bf16_t* Bb = Bt + (size_t)(pn * 128 + srow) * K + spc * 8;
    f32x16 acc00 = {}, acc01 = {}, acc10 = {}, acc11 = {};
    bf16x8 ra0, ra1, ra2, ra3, rb0, rb1;
#define GLOAD(kt) do { const int ko = (kt) * 64; ra0 = *(const bf16x8*)(Ab + ko); ra1 = *(const bf16x8*)(Ab + (size_t)64 * lda + ko); ra2 = *(const bf16x8*)(Ab + (size_t)128 * lda + ko); \
    ra3 = *(const bf16x8*)(Ab + (size_t)192 * lda + ko); rb0 = *(const bf16x8*)(Bb + ko); rb1 = *(const bf16x8*)(Bb + (size_t)64 * K + ko); } while (0)
#define SWRITE(buf) do { char* sb = lds + (buf) * STG + srow * RS + spc * 16; *(bf16x8*)(sb) = ra0; *(bf16x8*)(sb + 64 * RS) = ra1; *(bf16x8*)(sb + 128 * RS) = ra2; *(bf16x8*)(sb + 192 * RS) = ra3; \
    *(bf16x8*)(sb + ASZ) = rb0; *(bf16x8*)(sb + ASZ + 64 * RS) = rb1; } while (0)
    GLOAD(0); SWRITE(0); __syncthreads();
    for (int kt = 0; kt < nk; ++kt) {
      const int cur = kt & 1;
      if (kt + 1 < nk) GLOAD(kt + 1);
      const char* ab = lds + cur * STG + (64 * wm + r32) * RS + hi * 16;
      const char* bb = lds + cur * STG + ASZ + (64 * wn + r32) * RS + hi * 16;
#pragma unroll
      for (int ks = 0; ks < 4; ++ks) {
        const bf16x8 a0 = *(const bf16x8*)(ab + ks * 32), a1 = *(const bf16x8*)(ab + 32 * RS + ks * 32);
        const bf16x8 b0 = *(const bf16x8*)(bb + ks * 32), b1 = *(const bf16x8*)(bb + 32 * RS + ks * 32);
        acc00 = MFMA32(a0, b0, acc00); acc01 = MFMA32(a0, b1, acc01); acc10 = MFMA32(a1, b0, acc10); acc11 = MFMA32(a1, b1, acc11);
      }
      if (kt + 1 < nk) SWRITE(cur ^ 1);
      __syncthreads();
    }
#undef GLOAD
#undef SWRITE
    const int row0 = pm * 256 + 64 * wm, col0 = pn * 128 + 64 * wn + r32;
#pragma unroll
    for (int r = 0; r < 16; ++r) { const int rr = row0 + crow(r, hi);
      epi(rr, col0, acc00[r]); epi(rr, col0 + 32, acc01[r]); epi(rr + 32, col0, acc10[r]); epi(rr + 32, col0 + 32, acc11[r]); }
  }
}

namespace pg8 {
#define PG8_LAS __attribute__((address_space(3)))
constexpr int BM = 256, BK = 64, HALF = 128, HTB = HALF * BK * 2  , STAGE_BYTES = 8 * HTB, NXCD = 8, WGM = 8;

__host__ __device__ __forceinline__ int lds_byte(int r, int c) { const int st = (r >> 4) * 2 + (c >> 5), rr = r & 15, cc = c & 31, ob = rr * 64 + cc * 2; return st * 1024 + (ob ^ (((ob >> 9) & 1) << 5)); }
__host__ __device__ __forceinline__ void stage_rc(int b, int& R, int& C) { const int st = b / 1024, sb = b % 1024, swz = sb ^ (((sb >> 9) & 1) << 5); R = (st >> 1) * 16 + swz / 64; C = (st & 1) * 32 + (swz % 64) / 2; }
__host__ __device__ __forceinline__ int perm32(int rho) { const int n = rho >> 4, i = rho & 15; return 8 * (i >> 2) + 4 * n + (i & 3); }
struct Unit { int pm, pn; };
struct Gemm { const bf16_t* A; const bf16_t* Bt; int M, N, K, lda; };

struct StaticOrder {
    int nM, nN, nwg, G, c;
    __host__ __device__ void init(int M, int N, int G_, int c_) { nM = M / BM; nN = N / BM; nwg = nM * nN; G = G_; c = c_; }
    __host__ __device__ bool next(int i, Unit& u) const {
        const long L = (long)i * G + c; if (L >= nwg) return false;
        int wgid = (int)L; { const int q = nwg / NXCD, r = nwg % NXCD, xcd = wgid % NXCD, off = wgid / NXCD; wgid = (xcd < r ? xcd * (q + 1) : r * (q + 1) + (xcd - r) * q) + off; }
        const int nig = WGM * nN, gid = wgid / nig, fm = gid * WGM, gsz = (nM - fm) < WGM ? (nM - fm) : WGM;
        u.pm = fm + ((wgid % nig) % gsz); u.pn = (wgid % nig) / gsz; return true;
    }
    __device__ __forceinline__ void a_ready(const Unit&) const {}
    __device__ __forceinline__ void done(const Unit&) const {}
};
template <class Epi, class Sched, bool ALIGN_EPI = false, bool SP2 = false>
__device__ __forceinline__ void gemm_phase(PG8_LAS unsigned char* lds, const Gemm g, const Sched& S, const Epi& E) {
    const int tid = TIDX(), wid = __builtin_amdgcn_readfirstlane(tid >> 6), lane = tid & 63, wr = wid >> 2, wc = wid & 3, fr = lane & 15, fq = lane >> 4;
    const int K = g.K, nt = K / BK;
    unsigned voffA[2], voffB[2];
#pragma unroll
    for (int i = 0; i < 2; ++i) { int R, C; stage_rc(tid * 16 + i * 8192, R, C); const int Rb = Epi::PERM ? ((R & ~31) + perm32(R & 31)) : R;
        voffA[i] = (unsigned)(R * g.lda + C) * 2u; voffB[i] = (unsigned)(Rb * K + C) * 2u; }
    const size_t kstep = (size_t)(BK * 2);
    const size_t hstep = (size_t)HALF * K * 2;
    const size_t tstep = 2 * hstep; const size_t hstepA = (size_t)HALF * g.lda * 2, tstepA = 2 * hstepA;
    const unsigned ldsw = (unsigned)wid * 1024u;
    const int aoff = lds_byte(wr * 64 + fr, fq * 8), boff = lds_byte(wc * 32 + fr, fq * 8);
#define PG8_SA(b, h) (((b) * 2 + (h)) * HTB)
#define PG8_SB(b, h) ((4 + (b) * 2 + (h)) * HTB)
#define PG8_STAGE(bufoff, gbase, voff) do { _Pragma("unroll") for (int _i = 0; _i < 2; ++_i) \
        __builtin_amdgcn_global_load_lds((const unsigned*)((const char*)(gbase) + (voff)[_i]), (PG8_LAS unsigned*)(lds + (bufoff) + ldsw + _i * 8192), 16, 0, 0); } while (0)
#define PG8_LDA(dst, b, h) do { _Pragma("unroll") for (int m = 0; m < 4; ++m) _Pragma("unroll") for (int k = 0; k < 2; ++k) dst[m][k] = *(const PG8_LAS bf16x8*)(lds + PG8_SA(b, h) + aoff + m * 2048 + k * 1024); } while (0)
#define PG8_LDB(dst, b, h) do { _Pragma("unroll") for (int n = 0; n < 2; ++n) _Pragma("unroll") for (int k = 0; k < 2; ++k) dst[n][k] = *(const PG8_LAS bf16x8*)(lds + PG8_SB(b, h) + boff + n * 2048 + k * 1024); } while (0)
#define PG8_MMA(ai, bj, At, Bt) do { __builtin_amdgcn_s_setprio(1); _Pragma("unroll") for (int m = 0; m < 4; ++m) _Pragma("unroll") for (int n = 0; n < 2; ++n) _Pragma("unroll") for (int k = 0; k < 2; ++k) \
        acc[ai][bj][m][n] = __builtin_amdgcn_mfma_f32_16x16x32_bf16(Bt[n][k], At[m][k], acc[ai][bj][m][n], 0, 0, 0); __builtin_amdgcn_s_setprio(0); } while (0)
#define PG8_WAIT_V(n) asm volatile("s_waitcnt vmcnt(" #n ")" ::: "memory")
#define PG8_WAIT_L(n) asm volatile("s_waitcnt lgkmcnt(" #n ")" ::: "memory")
#define PG8_BAR __builtin_amdgcn_s_barrier()
#define PG8_SCHED __builtin_amdgcn_sched_barrier(0)
    Unit cur, nxt; int ui = 0;
    if (!S.next(0, cur)) return;
    f32x4 acc[2][2][4][2];
#pragma unroll
    for (int a = 0; a < 2; ++a)
#pragma unroll
        for (int b = 0; b < 2; ++b)
#pragma unroll
            for (int m = 0; m < 4; ++m)
#pragma unroll
                for (int n = 0; n < 2; ++n) acc[a][b][m][n] = (f32x4){0.f, 0.f, 0.f, 0.f};
    bf16x8 At[4][2], B0[2][2], B1[2][2];
    const char* cA = (const char*)g.A + (size_t)cur.pm * tstepA; const char* cB = (const char*)g.Bt + (size_t)cur.pn * tstep;
    S.a_ready(cur);
    if constexpr (SP2) {
        PG8_STAGE(PG8_SB(0, 0), cB, voffB); PG8_STAGE(PG8_SB(0, 1), cB + hstep, voffB); PG8_STAGE(PG8_SA(0, 0), cA, voffA); PG8_STAGE(PG8_SA(0, 1), cA + hstepA, voffA);
        if (wr == 1) PG8_BAR;
        PG8_WAIT_V(2); PG8_BAR;
        PG8_STAGE(PG8_SB(1, 0), cB + kstep, voffB); PG8_STAGE(PG8_SA(1, 0), cA + kstep, voffA); PG8_STAGE(PG8_SB(1, 1), cB + hstep + kstep, voffB);
        PG8_WAIT_V(6); PG8_BAR;
    } else {
        PG8_STAGE(PG8_SB(0, 0), cB, voffB); PG8_STAGE(PG8_SA(0, 0), cA, voffA); PG8_STAGE(PG8_SB(0, 1), cB + hstep, voffB); PG8_STAGE(PG8_SA(0, 1), cA + hstepA, voffA);
        if (wr == 1) PG8_BAR;
        PG8_WAIT_V(4); PG8_BAR;
        PG8_STAGE(PG8_SB(1, 0), cB + kstep, voffB); PG8_STAGE(PG8_SA(1, 0), cA + kstep, voffA); PG8_STAGE(PG8_SB(1, 1), cB + hstep + kstep, voffB);
        PG8_WAIT_V(6); PG8_BAR;
    }
    for (;;) {
        const bool has_next = S.next(ui + 1, nxt);
        const char* nA = has_next ? (const char*)g.A + (size_t)nxt.pm * tstepA : cA; const char* nB = has_next ? (const char*)g.Bt + (size_t)nxt.pn * tstep : cB;
        for (int t = 0; t < nt; t += 2) {
            const bool last = (t == nt - 2);
            const char* a1 = cA + (size_t)(t + 1) * kstep;
            const char* a2 = last ? nA : cA + (size_t)(t + 2) * kstep; const char* b2 = last ? nB : cB + (size_t)(t + 2) * kstep;
            const char* a3 = a2 + kstep; const char* b3 = b2 + kstep;
            if (last && has_next) S.a_ready(nxt);
            if constexpr (SP2) {
            PG8_LDB(B0, 0, 0); PG8_LDB(B1, 0, 1); PG8_SCHED; PG8_LDA(At, 0, 0); PG8_STAGE(PG8_SA(1, 1), a1 + hstepA, voffA);
            PG8_WAIT_V(8); PG8_WAIT_L(0); PG8_BAR; PG8_MMA(0, 0, At, B0); PG8_MMA(0, 1, At, B1); PG8_BAR; PG8_SCHED;
            PG8_LDA(At, 0, 1); PG8_STAGE(PG8_SB(0, 0), b2, voffB); PG8_STAGE(PG8_SB(0, 1), b2 + hstep, voffB); PG8_STAGE(PG8_SA(0, 0), a2, voffA);
            PG8_WAIT_V(8); PG8_WAIT_L(0); PG8_BAR; PG8_MMA(1, 0, At, B0); PG8_MMA(1, 1, At, B1); PG8_BAR; PG8_SCHED;
            PG8_LDB(B0, 1, 0); PG8_LDB(B1, 1, 1); PG8_SCHED; PG8_LDA(At, 1, 0); PG8_STAGE(PG8_SA(0, 1), a2 + hstepA, voffA);
            PG8_WAIT_V(8); PG8_WAIT_L(0); PG8_BAR; PG8_MMA(0, 0, At, B0); PG8_MMA(0, 1, At, B1); PG8_BAR; PG8_SCHED;
            PG8_LDA(At, 1, 1); PG8_STAGE(PG8_SB(1, 0), b3, voffB); PG8_STAGE(PG8_SB(1, 1), b3 + hstep, voffB); PG8_STAGE(PG8_SA(1, 0), a3, voffA);
            PG8_WAIT_V(8); PG8_WAIT_L(0); PG8_BAR; PG8_MMA(1, 0, At, B0); PG8_MMA(1, 1, At, B1); PG8_BAR; PG8_SCHED;
            } else {
            PG8_LDB(B0, 0, 0); PG8_SCHED; PG8_LDA(At, 0, 0); PG8_STAGE(PG8_SA(1, 1), a1 + hstepA, voffA);
            PG8_WAIT_L(8); PG8_BAR; PG8_WAIT_L(0); PG8_MMA(0, 0, At, B0); PG8_BAR; PG8_SCHED;
            PG8_LDB(B1, 0, 1); PG8_STAGE(PG8_SB(0, 0), b2, voffB);
            PG8_BAR; PG8_WAIT_L(0); PG8_MMA(0, 1, At, B1); PG8_BAR;
            PG8_LDA(At, 0, 1); PG8_STAGE(PG8_SA(0, 0), a2, voffA);
            PG8_BAR; PG8_WAIT_L(0); PG8_MMA(1, 0, At, B0); PG8_BAR; PG8_SCHED;
            PG8_STAGE(PG8_SB(0, 1), b2 + hstep, voffB);
            PG8_WAIT_V(6); PG8_BAR; PG8_MMA(1, 1, At, B1); PG8_BAR;
            PG8_LDB(B0, 1, 0); PG8_SCHED; PG8_LDA(At, 1, 0); PG8_STAGE(PG8_SA(0, 1), a2 + hstepA, voffA);
            PG8_WAIT_L(8); PG8_BAR; PG8_WAIT_L(0); PG8_MMA(0, 0, At, B0); PG8_BAR; PG8_SCHED;
            PG8_LDB(B1, 1, 1); PG8_STAGE(PG8_SB(1, 0), b3, voffB);
            PG8_BAR; PG8_WAIT_L(0); PG8_MMA(0, 1, At, B1); PG8_BAR;
            PG8_LDA(At, 1, 1); PG8_STAGE(PG8_SA(1, 0), a3, voffA);
            PG8_BAR; PG8_WAIT_L(0); PG8_MMA(1, 0, At, B0); PG8_BAR; PG8_SCHED;
            PG8_STAGE(PG8_SB(1, 1), b3 + hstep, voffB);
            PG8_WAIT_V(6); PG8_BAR; PG8_MMA(1, 1, At, B1); PG8_BAR;
            }
        }
        if constexpr (ALIGN_EPI) { if (wr == 0) PG8_BAR; }
        if constexpr (!Epi::AFTER_DRAIN) { E(acc, cur, wr, wc, fr, fq); S.done(cur); }
        if (!has_next) break;
#pragma unroll
        for (int a = 0; a < 2; ++a)
#pragma unroll
            for (int b = 0; b < 2; ++b)
#pragma unroll
                for (int m = 0; m < 4; ++m)
#pragma unroll
                    for (int n = 0; n < 2; ++n) acc[a][b][m][n] = (f32x4){0.f, 0.f, 0.f, 0.f};
        cur = nxt; cA = nA; cB = nB; ++ui;
        if constexpr (ALIGN_EPI) { if (wr == 1) PG8_BAR; }
    }
    PG8_WAIT_V(0);
    if constexpr (!ALIGN_EPI) { if (wr == 0) PG8_BAR; }
    PG8_BAR;
    if constexpr (Epi::AFTER_DRAIN) { E.fused(acc, cur, wr, wc, fr, fq, lds, wid, lane); S.done(cur); }
#undef PG8_SA
#undef PG8_SB
#undef PG8_STAGE
#undef PG8_LDA
#undef PG8_LDB
#undef PG8_MMA
#undef PG8_WAIT_V
#undef PG8_WAIT_L
#undef PG8_BAR
#undef PG8_SCHED
}
struct SchedX { StaticOrder so; int mode;
  __device__ __forceinline__ bool next(int i, Unit& u) const {
    if (mode == 2) { if (i != 0 || so.c >= 8) return false; u.pm = (so.c >> 2) ? 33 : 0; u.pn = so.c & 3; return true; }
    if (!so.next(i, u)) return false; if (mode == 1) u.pm = u.pm + 1 + (u.pm >= 32 ? 1 : 0); return true; }
  __device__ __forceinline__ void a_ready(const Unit&) const {}
  __device__ __forceinline__ void done(const Unit&) const {} };
}
struct EpiRec8 { static constexpr bool PERM = true, AFTER_DRAIN = false; bf16_t* P1; bf16_t* P2; float* SM;
  DI void operator()(const f32x4 (&acc)[2][2][4][2], const pg8::Unit& u, int wr, int wc, int fr, int fq) const {
#pragma unroll
    for (int ai = 0; ai < 2; ++ai)
#pragma unroll
      for (int m = 0; m < 4; ++m) { const size_t row = (size_t)u.pm * 256 + ai * 128 + wr * 64 + m * 16 + fr;
#pragma unroll
        for (int bj = 0; bj < 2; ++bj) { const int col = u.pn * 256 + bj * 128 + wc * 32 + fq * 8; const f32x4 v0 = acc[ai][bj][m][0], v1 = acc[ai][bj][m][1];
          if (u.pn < 14) { const u32x4 w = {cvtpk(v0[0], v0[1]), cvtpk(v0[2], v0[3]), cvtpk(v1[0], v1[1]), cvtpk(v1[2], v1[3])};
            if (u.pn < 6) *(u32x4*)(P1 + row * 1536 + col) = w; else *(u32x4*)(P2 + row * 2048 + (col - 1536)) = w; }
          else { const int lc = col - 3584; if (lc < 48) { *(f32x4*)(SM + row * 64 + lc) = v0; *(f32x4*)(SM + row * 64 + lc + 4) = v1; } } } } } };
struct EpiBf8 { static constexpr bool PERM = true, AFTER_DRAIN = false; bf16_t* O; int ldc;
  DI void operator()(const f32x4 (&acc)[2][2][4][2], const pg8::Unit& u, int wr, int wc, int fr, int fq) const {
#pragma unroll
    for (int ai = 0; ai < 2; ++ai)
#pragma unroll
      for (int m = 0; m < 4; ++m) { const size_t row = (size_t)u.pm * 256 + ai * 128 + wr * 64 + m * 16 + fr;
#pragma unroll
        for (int bj = 0; bj < 2; ++bj) { const int col = u.pn * 256 + bj * 128 + wc * 32 + fq * 8; const f32x4 v0 = acc[ai][bj][m][0], v1 = acc[ai][bj][m][1];
          const u32x4 w = {cvtpk(v0[0], v0[1]), cvtpk(v0[2], v0[3]), cvtpk(v1[0], v1[1]), cvtpk(v1[2], v1[3])};
          *(u32x4*)(O + row * ldc + col) = w; } } } };
struct EpiRes8 { static constexpr bool PERM = false, AFTER_DRAIN = false; float* X; const float* gate;
  DI void operator()(const f32x4 (&acc)[2][2][4][2], const pg8::Unit& u, int wr, int wc, int fr, int fq) const {
    const float* gr = gate + (size_t)modrow_of(u.pm * 256) * 6144;
#pragma unroll
    for (int bj = 0; bj < 2; ++bj)
#pragma unroll
      for (int n = 0; n < 2; ++n) { const int col = u.pn * 256 + bj * 128 + wc * 32 + n * 16 + fq * 4; const f32x4 gv = *(const f32x4*)(gr + col);
#pragma unroll
        for (int ai = 0; ai < 2; ++ai)
#pragma unroll
          for (int m = 0; m < 4; ++m) { const size_t row = (size_t)u.pm * 256 + ai * 128 + wr * 64 + m * 16 + fr;
            f32x4* q = (f32x4*)(X + row * 1024 + col); *q = *q + gv * acc[ai][bj][m][n]; } } } };
template <class Epi>
__device__ __forceinline__ void gemm8(char* lds, const bf16_t* A, int lda, const bf16_t* Bt, int K, int N, int mode, const Epi& E) {
  pg8::Gemm g{A, Bt, mode == 1 ? 16384 : MROWS, N, K, lda};
  pg8::SchedX S; S.so.init(g.M, N, GDIM(), BIDX()); S.mode = mode;
  pg8::gemm_phase<Epi, pg8::SchedX, true, true>((PG8_LAS unsigned char*)lds, g, S, E);
}

__device__ __forceinline__ void ph_dnprep(const P& p, char* lds, int e) {
  const int tid = TIDX(), wid = tid >> 6, lane = tid & 63;
  const bf16_t* P1 = (const bf16_t*)(p.ws + OFF_D + D_P1);
  bf16_t* QQ = (bf16_t*)(p.ws + OFF_D + D_QQ); bf16_t* QK = (bf16_t*)(p.ws + OFF_D + D_QK); bf16_t* QV = (bf16_t*)(p.ws + OFF_D + D_QV);
  bf16_t* KT = (bf16_t*)(p.ws + OFF_D + D_KT);
  const float* SM = (const float*)(p.ws + OFF_SM); float* GB = (float*)(p.ws + OFF_GB);
  const float* cw = p.rec_conv + (size_t)e * 3 * 1536;
  bf16_t* kl = (bf16_t*)lds;
  for (int job = BIDX(); job < MROWS / 32; job += GDIM()) {
    const int R0 = job * 32;
    for (int tt = 0; tt < 4; ++tt) {
      const int tl = wid * 4 + tt, R = R0 + tl; const int b = R >= TB ? 1 : 0, pp = R - b * TB;
      const bool hasp = !(pp == 0 || pp == CTXL), hasn = !(pp == CTXL - 1 || pp == TB - 1);
#pragma unroll
      for (int part = 0; part < 3; ++part) {
        const int ch = part * 512 + lane * 8;
        const bf16x8 zc = *(const bf16x8*)(P1 + (size_t)R * 1536 + ch);
        bf16x8 zp = {}, zn = {};
        if (hasp) zp = *(const bf16x8*)(P1 + (size_t)(R - 1) * 1536 + ch);
        if (hasn) zn = *(const bf16x8*)(P1 + (size_t)(R + 1) * 1536 + ch);
        float o[8]; float ss = 0.f;
#pragma unroll
        for (int j = 0; j < 8; ++j) { const float a = bf2f((bf16_t)zp[j]) * cw[ch + j] + bf2f((bf16_t)zc[j]) * cw[1536 + ch + j] + bf2f((bf16_t)zn[j]) * cw[3072 + ch + j];
          o[j] = siluf(a); ss += o[j] * o[j]; }
        if (part < 2) {
          ss += __shfl_xor(ss, 1); ss += __shfl_xor(ss, 2); ss += __shfl_xor(ss, 4); ss += __shfl_xor(ss, 8);
          float sc = rsqrtf(ss + EPSF); if (part == 0) sc *= 0.08838834764831845f;
#pragma unroll
          for (int j = 0; j < 8; ++j) o[j] *= sc;
        }
        u32x4 w = {cvtpk(o[0], o[1]), cvtpk(o[2], o[3]), cvtpk(o[4], o[5]), cvtpk(o[6], o[7])};
        bf16_t* dst = part == 0 ? QQ : (part == 1 ? QK : QV);
        *(u32x4*)(dst + (size_t)R * 512 + lane * 8) = w;
        if (part == 1) *(u32x4*)(kl + tl * 512 + lane * 8) = w;
      }
      if (lane < 16) {
        const int q = lane & 7;
        if (lane < 8) { const float da = SM[(size_t)R * 64 + q]; GB[(size_t)R * 16 + q] = -expf(p.dn_a_log[e * 8 + q]) * softplusf(da + p.dn_dt_bias[e * 8 + q]); }
        else { const float db = SM[(size_t)R * 64 + 8 + q]; GB[(size_t)R * 16 + 8 + q] = sigmf(db); }
      }
    }
    __syncthreads();
    {
      const int b = R0 >= TB ? 1 : 0, c = (R0 - b * TB) / 64, half = ((R0 - b * TB) >> 5) & 1; const int h = tid >> 7, dk = tid & 127;
      bf16_t* dst = KT + ((((size_t)b * 4 + h) * NCH + c) * 128 + dk) * 64 + half * 32;
#pragma unroll
      for (int g8 = 0; g8 < 4; ++g8) { unsigned w[4];
#pragma unroll
        for (int j = 0; j < 4; ++j) { const unsigned lo = kl[(g8 * 8 + 2 * j) * 512 + tid], hi2 = kl[(g8 * 8 + 2 * j + 1) * 512 + tid]; w[j] = lo | (hi2 << 16); }
        *(u32x4*)(dst + g8 * 8) = (u32x4){w[0], w[1], w[2], w[3]}; }
    }
    __syncthreads();
  }
}

__device__ __forceinline__ void ph_dn_d1(const P& p, char* lds) {
  const int tid = TIDX(), wid = tid >> 6, lane = tid & 63, r32 = lane & 31, hi = lane >> 5;
  const bf16_t* QQ = (const bf16_t*)(p.ws + OFF_D + D_QQ); const bf16_t* QK = (const bf16_t*)(p.ws + OFF_D + D_QK); const bf16_t* QV = (const bf16_t*)(p.ws + OFF_D + D_QV);
  const float* GB = (const float*)(p.ws + OFF_GB);
  bf16_t* W_ = (bf16_t*)(p.ws + OFF_D + D_W); bf16_t* U_ = (bf16_t*)(p.ws + OFF_HBF); bf16_t* INTRA = (bf16_t*)(p.ws + OFF_D + D_INTRA);
  float* SC = (float*)(p.ws + OFF_SC); float* GLS = (float*)(p.ws + OFF_GL);
  float* KK = (float*)lds; float* QKm = KK + 64 * 65; float* Ad = QKm + 64 * 65; float* Gs = Ad + 2 * 4096; float* Bs = Gs + 128;
  bf16_t* Vs = (bf16_t*)(Bs + 128); bf16_t* Ks = Vs + 64 * 128;
  for (int job = BIDX(); job < 8 * NCH; job += GDIM()) {
    const int b = job / (4 * NCH), h = (job / NCH) & 3, c = job % NCH;
    const size_t Rb = (size_t)b * TB + (size_t)c * 64;
    {
      const int srow = tid >> 4, spc = (tid & 15) * 8;
      const u32x4 v0 = *(const u32x4*)(QV + (Rb + srow) * 512 + h * 128 + spc), v1 = *(const u32x4*)(QV + (Rb + 32 + srow) * 512 + h * 128 + spc);
      const u32x4 k0 = *(const u32x4*)(QK + (Rb + srow) * 512 + h * 128 + spc), k1 = *(const u32x4*)(QK + (Rb + 32 + srow) * 512 + h * 128 + spc);
      *(u32x4*)(Vs + srow * 128 + spc) = v0; *(u32x4*)(Vs + (32 + srow) * 128 + spc) = v1;
      *(u32x4*)(Ks + srow * 128 + spc) = k0; *(u32x4*)(Ks + (32 + srow) * 128 + spc) = k1;
    }
    {
      const int w4 = wid & 3, mi = w4 & 1, ni = w4 >> 1;
      const bf16_t* As = wid < 4 ? QK : QQ;
      const bf16_t* arow = As + (Rb + 32 * mi + r32) * 512 + h * 128 + hi * 8;
      const bf16_t* brow = QK + (Rb + 32 * ni + r32) * 512 + h * 128 + hi * 8;
      f32x16 acc = {}; acc = mma_rows<8>(arow, brow, acc);
      float* dst = wid < 4 ? KK : QKm;
#pragma unroll
      for (int r = 0; r < 16; ++r) dst[(32 * mi + crow(r, hi)) * 65 + 32 * ni + r32] = acc[r];
    }
    if (tid < 128) { const int d = tid >> 6, ip = tid & 63, t = d ? 63 - ip : ip; float g = GB[(Rb + t) * 16 + d * 4 + h]; Bs[tid] = GB[(Rb + t) * 16 + 8 + d * 4 + h];
#pragma unroll
      for (int o = 1; o < 64; o <<= 1) { const float v = __shfl_up(g, o); g += ip >= o ? v : 0.f; }
      Gs[tid] = g; }
    __syncthreads();
    const int n0 = c, n1 = c < 4 ? 3 - c : 135 - c;
    const size_t cj0 = ((size_t)(0 * 2 + b) * 4 + h) * NCH + n0, cj1 = ((size_t)(1 * 2 + b) * 4 + h) * NCH + n1;
    for (int e2 = tid; e2 < 8192; e2 += 512) {
      const int d = e2 >> 12, ip = (e2 >> 6) & 63, jp = e2 & 63; const int i = d ? 63 - ip : ip, j = d ? 63 - jp : jp;
      const float dec = jp <= ip ? __expf(Gs[d * 64 + ip] - Gs[d * 64 + jp]) : 0.f;
      Ad[d * 4096 + ip * 64 + jp] = jp < ip ? Bs[d * 64 + ip] * KK[i * 65 + j] * dec : 0.f;
      const size_t cj = d ? cj1 : cj0;
      INTRA[(cj * 64 + ip) * 64 + jp] = f2bf(QKm[i * 65 + j] * dec);
    }
    if (tid < 128) { const int d = tid >> 6, ip = tid & 63; const size_t cj = d ? cj1 : cj0; const float gi = Gs[tid], gl = Gs[d * 64 + 63];
      SC[(cj * 64 + ip) * 2] = __expf(gi); SC[(cj * 64 + ip) * 2 + 1] = __expf(gl - gi); if (ip == 0) GLS[cj] = __expf(gl); }
    __syncthreads();
    {
      const int d = tid >> 8, cc = tid & 255; const size_t cj = d ? cj1 : cj0;
      int dofs = d * 64, aofs = d * 4096; asm volatile("" : "+v"(dofs), "+v"(aofs));
      float x[64];
      {
        int vofs = cc < 128 ? cc : 64 * 128 + (cc - 128); asm volatile("" : "+v"(vofs));
#pragma unroll
        for (int ip = 0; ip < 64; ++ip) x[ip] = bf2f(Vs[vofs + ip * 128]);
#pragma unroll
        for (int ip = 0; ip < 32; ++ip) { const float a_ = x[ip], b_ = x[63 - ip]; x[ip] = d ? b_ : a_; x[63 - ip] = d ? a_ : b_; }
        if (cc < 128) {
#pragma unroll
          for (int ip = 0; ip < 64; ++ip) x[ip] *= Bs[dofs + ip];
        } else {
#pragma unroll
          for (int ip = 0; ip < 64; ++ip) x[ip] *= Bs[dofs + ip] * __expf(Gs[dofs + ip]);
        }
      }
      const float* Arow = Ad + aofs;
#pragma unroll
      for (int ip = 1; ip < 64; ++ip) {
        float s = 0.f;
#pragma unroll
        for (int j4 = 0; j4 < (ip + 3) / 4; ++j4) { const f32x4 a = *(const f32x4*)(Arow + ip * 64 + 4 * j4);
          s += a[0] * x[4 * j4] + a[1] * x[4 * j4 + 1] + a[2] * x[4 * j4 + 2] + a[3] * x[4 * j4 + 3]; }
        x[ip] -= s;
      }
      bf16_t* dst = cc < 128 ? U_ + cj * 64 * 128 + cc : W_ + cj * 64 * 128 + (cc - 128);
#pragma unroll
      for (int ip = 0; ip < 64; ++ip) dst[ip * 128] = f2bf(x[ip]);
    }
    __syncthreads();
  }
}

typedef _Float16 h16x8 __attribute__((ext_vector_type(8)));
__device__ __forceinline__ void ph_gla_b(const P& p, char* lds, int e) {
  const int tid = TIDX(), wid = tid >> 6, lane = tid & 63;
  const float* SM = (const float*)(p.ws + OFF_SM);
  float* w2S = (float*)lds;
  float* b2S = w2S + 8192;
  for (int i = tid; i < 8192; i += 512) { const int d = i >> 12, hh = (i >> 10) & 3, r = (i >> 6) & 15, j = i & 63; w2S[i] = p.gla_w2[(((size_t)e * 2 + d) * 16 + r) * 256 + hh * 64 + j]; }
  if (tid < 512) b2S[tid] = p.gla_b2[(size_t)e * 512 + tid];
  __syncthreads();
  int jb = 8 * wid; asm volatile("" : "+v"(jb));
  for (int job = GDIM() - 1 - BIDX(); job < 16 * NCH; job += GDIM()) {
    const int n = job % NCH, sq = job / NCH; const int dir = sq >> 3, b = (sq >> 2) & 1, h = sq & 3;
    const int c = dir == 0 ? n : (n < 4 ? 3 - n : 135 - n);
    const size_t row = (size_t)b * TB + (size_t)c * 64 + (dir ? 63 - lane : lane);
    const float* gp = SM + row * 64 + 16 + dir * 16;
    const f32x4 g0 = *(const f32x4*)(gp), g1 = *(const f32x4*)(gp + 4), g2 = *(const f32x4*)(gp + 8), g3 = *(const f32x4*)(gp + 12);
    const float gg_[16] = {g0[0], g0[1], g0[2], g0[3], g1[0], g1[1], g1[2], g1[3], g2[0], g2[1], g2[2], g2[3], g3[0], g3[1], g3[2], g3[3]};
    const float* wb = w2S + (dir * 4 + h) * 1024 + jb; const float* bb2 = b2S + dir * 256 + h * 64 + jb;
    f32x4 sa = *(const f32x4*)(bb2), sb = *(const f32x4*)(bb2 + 4);
#pragma unroll
    for (int r = 0; r < 16; ++r) { const f32x4 wa = *(const f32x4*)(wb + r * 64), wq = *(const f32x4*)(wb + r * 64 + 4); sa += gg_[r] * wa; sb += gg_[r] * wq; }
    float la[8];
#pragma unroll
    for (int jj = 0; jj < 4; ++jj) { const float x0 = sa[jj], x1 = sb[jj];
      la[jj] = (fminf(x0, 0.f) - log1pf(expf(-fabsf(x0)))) * 0.0625f; la[4 + jj] = (fminf(x1, 0.f) - log1pf(expf(-fabsf(x1)))) * 0.0625f; }
#pragma unroll
    for (int o = 1; o < 64; o <<= 1) {
#pragma unroll
      for (int jj = 0; jj < 8; ++jj) { const float v = __shfl_up(la[jj], o); la[jj] += lane >= o ? v : 0.f; }
    }
    h16x8 hv;
#pragma unroll
    for (int jj = 0; jj < 8; ++jj) hv[jj] = (_Float16)la[jj];
    _Float16* dst = (_Float16*)(p.ws + (dir ? OFF_B16_1 : OFF_WC)) + ((((size_t)b * 4 + h) * NCH + n) * 64 + lane) * 64 + jb;
    *(h16x8*)dst = hv;
  }
}

struct DnSet { bf16x8 fa[8]; };
template <int ROLE>
__device__ __forceinline__ void dn_scan_t(const P& p, char* lds, int job) {
  const int tid = TIDX(), wid = tid >> 6, lane = tid & 63, r32 = lane & 31, hi = lane >> 5;
  const int dir = job >> 5, b = (job >> 4) & 1, h = (job >> 2) & 3, n0 = (job & 3) * 32;
  const bf16_t* QQ = (const bf16_t*)(p.ws + OFF_D + D_QQ); const bf16_t* KT = (const bf16_t*)(p.ws + OFF_D + D_KT);
  const bf16_t* W_ = (const bf16_t*)(p.ws + OFF_D + D_W); const bf16_t* U_ = (const bf16_t*)(p.ws + OFF_HBF); const bf16_t* INTRA = (const bf16_t*)(p.ws + OFF_D + D_INTRA);
  const float* SC = (const float*)(p.ws + OFF_SC); const float* GLS = (const float*)(p.ws + OFF_GL);
  bf16_t* DNO = (bf16_t*)(p.ws + OFF_D + D_DNO);
  bf16_t* ST = (bf16_t*)lds; bf16_t* vTa = ST + 32 * 136; bf16_t* vTb = vTa + 32 * 72;
  float* scS = (float*)(vTb + 32 * 72);
  bf16_t* uS = (bf16_t*)(scS + 256);
  bf16_t* inS = uS + 2 * 64 * 40;
  for (int i = tid; i < 32 * 136; i += 512) ST[i] = 0;
  f32x16 accS = {};
  const size_t seq = ((size_t)dir * 2 + b) * 4 + h;
  const int mi = wid & 1, di = wid - 4;
  constexpr int role = ROLE;
  const int tt = tid - 256;
  DnSet fs[3]; float gls[3] = {0.f, 0.f, 0.f};
  u32x4 stU[3], stI0[3]; float stS[3] = {0.f, 0.f, 0.f};
#define DN_CH(n_) const int n__ = (n_); const int c__ = dir == 0 ? n__ : (n__ < 4 ? 3 - n__ : 135 - n__); const size_t Rb__ = (size_t)b * TB + (size_t)c__ * 64; const size_t cj__ = seq * NCH + n__;
#define DN_LOAD(S, GL, n_) do { DN_CH(n_) \
    const int ipl__ = 32 * mi + r32, tl__ = dir ? 63 - ipl__ : ipl__; \
    const bf16_t* b0__ = W_ + cj__ * 8192 + (32 * mi + r32) * 128 + hi * 8; \
    const bf16_t* b1__ = QQ + (Rb__ + tl__) * 512 + h * 128 + hi * 8; \
    const bf16_t* b2__ = KT + ((((size_t)b * 4 + h) * NCH + c__) * 128 + 32 * (wid & 3) + r32) * 64 + hi * 8; \
    const bf16_t* bs__ = role == 0 ? b0__ : (role == 1 ? b1__ : b2__); \
    _Pragma("unroll") for (int ks = 0; ks < 8; ++ks) S.fa[ks] = *(const bf16x8*)(bs__ + ks * 16); \
    GL = GLS[cj__]; } while (0)
#define DN_STAGE_LD(q_, n_) do { DN_CH(n_) (void)Rb__; \
      stU[q_] = *(const u32x4*)(U_ + cj__ * 8192 + ((tid & 255) >> 2) * 128 + n0 + (tid & 3) * 8); \
      stI0[q_] = *(const u32x4*)(INTRA + cj__ * 4096 + (tid >> 3) * 64 + (tid & 7) * 8); \
      stS[q_] = SC[cj__ * 128 + (tid & 127)]; } while (0)
#define DN_STAGE_ST(q_, bf_) do { *(u32x4*)(inS + (bf_) * 4608 + (tid >> 3) * 72 + (tid & 7) * 8) = stI0[q_]; \
      if (ROLE < 2) *(u32x4*)(uS + (bf_) * 2560 + (tid >> 2) * 40 + (tid & 3) * 8) = stU[q_]; \
      if (ROLE == 0) scS[(bf_) * 128 + tid] = stS[q_]; } while (0)
#define DN_STEP(S, GL, n_, bf_) do { DN_CH(n_) (void)cj__; \
    const float* sc__ = scS + (bf_) * 128; \
    if (role < 2) { _Pragma("unroll") for (int r = 0; r < 16; ++r) accS[r] = 0.f; } \
    if (role < 2) { const bf16_t* sb__ = ST + r32 * 136 + hi * 8; \
      _Pragma("unroll") for (int ks = 0; ks < 8; ++ks) accS = MFMA32(S.fa[ks], *(const bf16x8*)(sb__ + ks * 16), accS); \
      if (role == 0) { const bf16_t* us__ = uS + (bf_) * 2560 + r32; \
        _Pragma("unroll") for (int r = 0; r < 16; ++r) { const int ip = 32 * mi + crow(r, hi); const float vn = bf2f(us__[ip * 40]) - accS[r]; \
          vTa[r32 * 72 + ip] = f2bf(vn); const int to = dir ? 63 - ip : ip; vTb[r32 * 72 + to] = f2bf(vn * sc__[ip * 2 + 1]); } } \
      else { _Pragma("unroll") for (int r = 0; r < 16; ++r) accS[r] *= sc__[(32 * mi + crow(r, hi)) * 2]; } } \
    LBAR(); \
    if (role == 1) { const bf16_t* vb__ = vTa + r32 * 72 + hi * 8; const bf16_t* ib__ = inS + (bf_) * 4608 + (32 * mi + r32) * 72 + hi * 8; \
      _Pragma("unroll") for (int ks = 0; ks < 4; ++ks) accS = MFMA32(*(const bf16x8*)(ib__ + ks * 16), *(const bf16x8*)(vb__ + ks * 16), accS); \
      _Pragma("unroll") for (int r = 0; r < 16; ++r) { const int ip = 32 * mi + crow(r, hi), t = dir ? 63 - ip : ip; \
        DNO[((size_t)dir * MROWS + Rb__ + t) * 512 + h * 128 + n0 + r32] = f2bf(accS[r]); } } \
    else if (role == 2) { const bf16_t* vb__ = vTb + r32 * 72 + hi * 8; \
      _Pragma("unroll") for (int r = 0; r < 16; ++r) accS[r] *= GL; \
      _Pragma("unroll") for (int ks = 0; ks < 4; ++ks) accS = MFMA32(S.fa[ks], *(const bf16x8*)(vb__ + ks * 16), accS); \
      _Pragma("unroll") for (int r = 0; r < 16; ++r) ST[r32 * 136 + 32 * di + crow(r, hi)] = f2bf(accS[r]); } \
    LBAR(); } while (0)
  DN_STAGE_LD(0, 0); DN_STAGE_ST(0, 0); DN_STAGE_LD(1, 1); DN_STAGE_LD(2, 2);
  DN_LOAD(fs[0], gls[0], 0); DN_LOAD(fs[1], gls[1], 1);
  __syncthreads();
  for (int nb6 = 0; nb6 < NCH; nb6 += 6) {
#pragma unroll
    for (int k = 0; k < 6; ++k) {
      const int n = nb6 + k; const int n2 = n + 2 < NCH ? n + 2 : NCH - 1; const int n3 = n + 3 < NCH ? n + 3 : NCH - 1;
      DN_STAGE_ST((k + 1) % 3, (k + 1) & 1);
      DN_STAGE_LD(k % 3, n3);
      DN_LOAD(fs[(k + 2) % 3], gls[(k + 2) % 3], n2);
      DN_STEP(fs[k % 3], gls[k % 3], n, k & 1);
    }
  }
#undef DN_CH
#undef DN_LOAD
#undef DN_STAGE_LD
#undef DN_STAGE_ST
#undef DN_STEP
}

__device__ __forceinline__ void dn_scan(const P& p, char* lds, int job) {
  const int wid = TIDX() >> 6;
  if (wid < 2) dn_scan_t<0>(p, lds, job); else if (wid < 4) dn_scan_t<1>(p, lds, job); else dn_scan_t<2>(p, lds, job);
}

DI float fast_logsig(float s) { return fminf(s, 0.f) - __logf(1.f + __expf(-fabsf(s))); }
struct GlaRegs { h16x8 ba, bb; bf16x8 qa, qb, ka, kb, v8; };
template <int ROLE>
__device__ __forceinline__ void gla_scan_t(const P& p, char* lds, int job, int e) {
  const int tid = TIDX(), wid = tid >> 6, lane = tid & 63, r32 = lane & 31, hi = lane >> 5;
  const int dir = job >> 5, b = (job >> 4) & 1, h = (job >> 2) & 3, n0 = (job & 3) * 32;
  const bf16_t* P2 = (const bf16_t*)(p.ws + OFF_D + D_P2); const float* SM = (const float*)(p.ws + OFF_SM);
  bf16_t* GLAO = (bf16_t*)(p.ws + OFF_D + D_GLAO);
  const _Float16* B16 = (const _Float16*)(p.ws + (dir ? OFF_B16_1 : OFF_WC));
  float* w2S = (float*)lds; float* b2S = w2S + 1024; float* aLb = b2S + 64;
  bf16_t* ops = (bf16_t*)(aLb + 128);
  constexpr int OPB = (4 * 64 + 32) * 72;
  bf16_t* attp = ops + 2 * OPB;
  bf16_t* STb = attp + 2 * 32 * 72;
  for (int i = tid; i < 2 * 32 * 72; i += 512) STb[i] = 0;
  f32x16 accS = {};
  __syncthreads();
  GlaRegs RG[3];
  int jb0 = 16 * (wid & 3); asm volatile("" : "+v"(jb0));
  int vtb0 = 8 * (wid & 3) * 72 + lane; asm volatile("" : "+v"(vtb0));
#define GLA_LOAD(R, n_) do { const int n__ = (n_) < NCH ? (n_) : NCH - 1; const int c__ = dir == 0 ? n__ : (n__ < 4 ? 3 - n__ : 135 - n__); const size_t row__ = (size_t)b * TB + (size_t)c__ * 64 + (dir ? 63 - lane : lane); \
    const _Float16* bp__ = B16 + ((((size_t)b * 4 + h) * NCH + n__) * 64 + lane) * 64 + 16 * (wid & 3); R.ba = *(const h16x8*)(bp__); R.bb = *(const h16x8*)(bp__ + 8); \
    const bf16_t* pr__ = P2 + row__ * 2048; R.qa = *(const bf16x8*)(pr__ + 512 + h * 64 + 16 * (wid & 3)); R.qb = *(const bf16x8*)(pr__ + 512 + h * 64 + 16 * (wid & 3) + 8); \
    R.ka = *(const bf16x8*)(pr__ + 768 + h * 64 + 16 * (wid & 3)); R.kb = *(const bf16x8*)(pr__ + 768 + h * 64 + 16 * (wid & 3) + 8); R.v8 = *(const bf16x8*)(pr__ + 1024 + h * 128 + n0 + 8 * (wid & 3)); } while (0)
#define GLA_HALF(R, BV, QV, KV, jb) do { \
    float eqe[8], eke[8], eqi[8]; \
    _Pragma("unroll") for (int jj = 0; jj < 8; ++jj) { const int j = (jb) + jj; const float bb = (float)BV[jj]; const float bm = __int_as_float(__builtin_amdgcn_readlane(__float_as_int(bb), 32)), bl = __int_as_float(__builtin_amdgcn_readlane(__float_as_int(bb), 63)); \
      const float q_ = bf2f((bf16_t)QV[jj]) * 0.125f, k_ = bf2f((bf16_t)KV[jj]); \
      eqe[jj] = q_ * __expf(bb - bm); eke[jj] = k_ * __expf(bm - bb); eqi[jj] = q_ * __expf(bb); ksT_[j * 72 + lane] = f2bf(k_ * __expf(bl - bb)); if (lane == 63) aL_[j] = __expf(bl); } \
    *(u32x4*)(qe_ + lane * 72 + (jb)) = (u32x4){cvtpk(eqe[0], eqe[1]), cvtpk(eqe[2], eqe[3]), cvtpk(eqe[4], eqe[5]), cvtpk(eqe[6], eqe[7])}; \
    *(u32x4*)(ke_ + lane * 72 + (jb)) = (u32x4){cvtpk(eke[0], eke[1]), cvtpk(eke[2], eke[3]), cvtpk(eke[4], eke[5]), cvtpk(eke[6], eke[7])}; \
    *(u32x4*)(qi_ + lane * 72 + (jb)) = (u32x4){cvtpk(eqi[0], eqi[1]), cvtpk(eqi[2], eqi[3]), cvtpk(eqi[4], eqi[5]), cvtpk(eqi[6], eqi[7])}; } while (0)
#define GLA_PREP(R, bf_) do { bf16_t* qe_ = ops + (bf_) * OPB; bf16_t* ke_ = qe_ + 64 * 72; bf16_t* qi_ = ke_ + 64 * 72; bf16_t* ksT_ = qi_ + 64 * 72; bf16_t* vT_ = ksT_ + 64 * 72; float* aL_ = aLb + (bf_) * 64; \
    GLA_HALF(R, R.ba, R.qa, R.ka, jb0); GLA_HALF(R, R.bb, R.qb, R.kb, jb0 + 8); \
    _Pragma("unroll") for (int q_ = 0; q_ < 8; ++q_) vT_[vtb0 + q_ * 72] = (bf16_t)R.v8[q_]; } while (0)
#define GLA_MMA(n_, bf_) do { const int nq__ = (n_); const int bf = (bf_); \
      const bf16_t* qe_ = ops + bf * OPB; const bf16_t* ke_ = qe_ + 64 * 72; const bf16_t* qi_ = ke_ + 64 * 72; const bf16_t* ksT_ = qi_ + 64 * 72; const bf16_t* vT_ = ksT_ + 64 * 72; const float* aL_ = aLb + bf * 64; \
      const bf16_t* STr = STb + bf * 32 * 72; bf16_t* STw = STb + (bf ^ 1) * 32 * 72; \
      if (ROLE == 1) { \
        const int mi = wid - 4; bf16_t* attw = attp + mi * 32 * 72; \
        const int c = dir == 0 ? nq__ : (nq__ < 4 ? 3 - nq__ : 135 - nq__); const size_t Rb = (size_t)b * TB + (size_t)c * 64; \
        f32x16 acc = {}; acc = mma_rows<4>(qi_ + (32 * mi + r32) * 72 + hi * 8, STr + r32 * 72 + hi * 8, acc); \
        { f32x16 a0 = {}; a0 = mma_rows<4>(qe_ + (32 * mi + r32) * 72 + hi * 8, ke_ + r32 * 72 + hi * 8, a0); \
          _Pragma("unroll") for (int r = 0; r < 16; ++r) { const int ipl = crow(r, hi); attw[ipl * 72 + r32] = f2bf((mi == 1 || r32 <= ipl) ? a0[r] : 0.f); } \
          f32x16 a1 = {}; if (mi == 1) a1 = mma_rows<4>(qe_ + (32 + r32) * 72 + hi * 8, ke_ + (32 + r32) * 72 + hi * 8, a1); \
          _Pragma("unroll") for (int r = 0; r < 16; ++r) { const int ipl = crow(r, hi); attw[ipl * 72 + 32 + r32] = f2bf((mi == 1 && r32 <= ipl) ? a1[r] : 0.f); } } \
        asm volatile("s_waitcnt lgkmcnt(0)" ::: "memory"); \
        acc = mma_rows<4>(attw + r32 * 72 + hi * 8, vT_ + r32 * 72 + hi * 8, acc); \
        _Pragma("unroll") for (int r = 0; r < 16; ++r) { const int ip = 32 * mi + crow(r, hi), t = dir ? 63 - ip : ip; \
          GLAO[((size_t)dir * MROWS + Rb + t) * 512 + h * 128 + n0 + r32] = f2bf(acc[r]); } \
      } else { \
        const int di = wid - 6; \
        _Pragma("unroll") for (int r = 0; r < 16; ++r) accS[r] *= aL_[32 * di + crow(r, hi)]; \
        accS = mma_rows<4>(ksT_ + (32 * di + r32) * 72 + hi * 8, vT_ + r32 * 72 + hi * 8, accS); \
        _Pragma("unroll") for (int r = 0; r < 16; ++r) STw[r32 * 72 + 32 * di + crow(r, hi)] = f2bf(accS[r]); \
      } } while (0)
  GLA_LOAD(RG[0], 0);
  if (ROLE == 0) { GLA_PREP(RG[0], 0); }
  GLA_LOAD(RG[1], 1); GLA_LOAD(RG[2], 2); GLA_LOAD(RG[0], 3);
  LBAR();
  for (int nb6 = 0; nb6 < NCH; nb6 += 6) {
#pragma unroll
    for (int k = 0; k < 6; ++k) {
      const int n = nb6 + k;
      if (ROLE == 0) { if (n + 1 < NCH) { GLA_PREP(RG[(k + 1) % 3], (k + 1) & 1); } } else { GLA_MMA(n, k & 1); }
      GLA_LOAD(RG[(k + 1) % 3], n + 4);
      LBAR();
    }
  }
#undef GLA_MMA
#undef GLA_LOAD
#undef GLA_HALF
#undef GLA_PREP
}

__device__ __forceinline__ void gla_scan(const P& p, char* lds, int job, int e) {
  const int wid = TIDX() >> 6;
  if (wid < 4) gla_scan_t<0>(p, lds, job, e); else if (wid < 6) gla_scan_t<1>(p, lds, job, e); else gla_scan_t<2>(p, lds, job, e);
}

__device__ __forceinline__ void ph_merge(const P& p, int e) {
  const int tid = TIDX(), wid = tid >> 6, lane = tid & 63, l16 = lane & 15, sub = lane >> 4;
  const bf16_t* DNO = (const bf16_t*)(p.ws + OFF_D + D_DNO); const bf16_t* GLAO = (const bf16_t*)(p.ws + OFF_D + D_GLAO);
  const bf16_t* P2 = (const bf16_t*)(p.ws + OFF_D + D_P2); bf16_t* hb = (bf16_t*)(p.ws + OFF_HBF);
  f32x8 nwd = *(const f32x8*)(p.dn_norm + e * 128 + l16 * 8), nwg = *(const f32x8*)(p.gla_norm + e * 128 + l16 * 8);
  for (int R4 = (BIDX() * 8 + wid) * 4; R4 < MROWS; R4 += GDIM() * 32) {
    const size_t R = R4 + sub;
    bf16x8 a[8], bq[8], zz[8];
#pragma unroll
    for (int g = 0; g < 8; ++g) { const bf16_t* src = g < 4 ? DNO : GLAO; const int hc = (g & 3) * 128 + l16 * 8;
      a[g] = *(const bf16x8*)(src + R * 512 + hc); bq[g] = *(const bf16x8*)(src + ((size_t)MROWS + R) * 512 + hc);
      zz[g] = *(const bf16x8*)(P2 + R * 2048 + (g < 4 ? 0 : 1536) + hc); }
#pragma unroll
    for (int g = 0; g < 8; ++g) {
      float v[8]; float ss = 0.f;
#pragma unroll
      for (int j = 0; j < 8; ++j) { v[j] = bf2f((bf16_t)a[g][j]) + bf2f((bf16_t)bq[g][j]); ss += v[j] * v[j]; }
      ss += __shfl_xor(ss, 1); ss += __shfl_xor(ss, 2); ss += __shfl_xor(ss, 4); ss += __shfl_xor(ss, 8);
      const float rs = rsqrtf(ss * (1.f / 128.f) + EPSF);
      float o[8];
#pragma unroll
      for (int j = 0; j < 8; ++j) o[j] = v[j] * rs * (g < 4 ? nwd[j] : nwg[j]) * siluf(bf2f((bf16_t)zz[g][j]));
      *(u32x4*)(hb + R * 1024 + g * 128 + l16 * 8) = (u32x4){cvtpk(o[0], o[1]), cvtpk(o[2], o[3]), cvtpk(o[4], o[5]), cvtpk(o[6], o[7])};
    }
  }
}

DI float silu_fast(float x) { return x / (1.f + __expf(-x)); }
__device__ __forceinline__ void ph_ffnact(const P& p, int L) {
  bf16_t* U = (bf16_t*)(p.ws + OFF_D);
  const float* cw = p.ffn_conv + (size_t)L * 3 * DFF;
  const size_t items = (size_t)MROWS * 352, stride = (size_t)GDIM() * 512;
  for (size_t it0 = (size_t)BIDX() * 512 + TIDX(); it0 < items; it0 += 2 * stride) {
    bf16x8 zc[2], zp[2], zn[2], vv[2]; int Rr[2], cc[2]; bool ok[2];
#pragma unroll
    for (int q = 0; q < 2; ++q) {
      size_t it = it0 + q * stride; ok[q] = it < items; if (!ok[q]) it = it0;
      const int R = (int)(it / 352), c0 = (int)(it % 352) * 8; const int b = R >= TB ? 1 : 0, pp = R - b * TB;
      const bool hasp = !(pp == 0 || pp == CTXL), hasn = !(pp == CTXL - 1 || pp == TB - 1);
      Rr[q] = R; cc[q] = c0;
      zc[q] = *(const bf16x8*)(U + (size_t)R * 5632 + c0);
      zp[q] = *(const bf16x8*)(U + (size_t)(hasp ? R - 1 : R) * 5632 + c0);
      zn[q] = *(const bf16x8*)(U + (size_t)(hasn ? R + 1 : R) * 5632 + c0);
      vv[q] = *(const bf16x8*)(U + (size_t)R * 5632 + DFF + c0);
      if (!hasp) zp[q] = (bf16x8){0, 0, 0, 0, 0, 0, 0, 0};
      if (!hasn) zn[q] = (bf16x8){0, 0, 0, 0, 0, 0, 0, 0};
    }
#pragma unroll
    for (int q = 0; q < 2; ++q) {
      const int c0 = cc[q];
      const f32x8 w0 = *(const f32x8*)(cw + c0), w1 = *(const f32x8*)(cw + DFF + c0), w2 = *(const f32x8*)(cw + 2 * DFF + c0);
      float o[8];
#pragma unroll
      for (int j = 0; j < 8; ++j) { const float a = bf2f((bf16_t)zp[q][j]) * w0[j] + bf2f((bf16_t)zc[q][j]) * w1[j] + bf2f((bf16_t)zn[q][j]) * w2[j];
        o[j] = silu_fast(a) * bf2f((bf16_t)vv[q][j]); }
      if (ok[q]) *(u32x4*)(U + (size_t)Rr[q] * 5632 + DFF + c0) = (u32x4){cvtpk(o[0], o[1]), cvtpk(o[2], o[3]), cvtpk(o[4], o[5]), cvtpk(o[6], o[7])};
    }
  }
}

__device__ __forceinline__ void ph_qknorm(const P& p, char* lds, int o) {
  const int tid = TIDX(), wid = tid >> 6, lane = tid & 63, l16 = lane & 15, sub = lane >> 4;
  bf16_t* QKV = (bf16_t*)(p.ws + OFF_D);
  float* tab = (float*)lds;
  for (int i = tid; i < 4096; i += 512) { const int pos = i >> 5, f = i & 31; const float ang = (float)pos * powf(10000.f, -(float)f / 32.f); tab[2 * i] = cosf(ang); tab[2 * i + 1] = sinf(ang); }
  __syncthreads();
  const f32x8 qn = *(const f32x8*)(p.att_q_norm + o * 128 + l16 * 8), kn = *(const f32x8*)(p.att_k_norm + o * 128 + l16 * 8);
  const int f0 = (l16 & 3) * 8;
  for (int R4 = (BIDX() * 8 + wid) * 4; R4 < MROWS; R4 += GDIM() * 32) {
    const int R = R4 + sub; const int b = R >= TB ? 1 : 0, pp = R - b * TB; const bool lat = pp >= CTXL; const int t = lat ? pp - CTXL : 0;
    const int pos = (l16 < 8) ? (t >> 6) : (t & 63);
    bf16_t* base = QKV + (size_t)R * 1536 + l16 * 8;
    bf16x8 x[10];
#pragma unroll
    for (int hd = 0; hd < 10; ++hd) x[hd] = *(const bf16x8*)(base + hd * 128);
    float cs[8], sn[8];
#pragma unroll
    for (int j = 0; j < 8; ++j) { const float2 t2 = *(const float2*)(tab + 2 * (pos * 32 + f0 + j)); cs[j] = lat ? t2.x : 1.f; sn[j] = lat ? t2.y : 0.f; }
#pragma unroll
    for (int hd = 0; hd < 10; ++hd) {
      float v[8]; float ss = 0.f;
#pragma unroll
      for (int j = 0; j < 8; ++j) { v[j] = bf2f((bf16_t)x[hd][j]); ss += v[j] * v[j]; }
      ss += __shfl_xor(ss, 1); ss += __shfl_xor(ss, 2); ss += __shfl_xor(ss, 4); ss += __shfl_xor(ss, 8);
      const float rs = rsqrtf(ss * (1.f / 128.f) + EPSF);
      float ov[8];
#pragma unroll
      for (int j = 0; j < 8; ++j) { v[j] = v[j] * rs * (hd < 8 ? qn[j] : kn[j]); const float pr = __shfl_xor(v[j], 4);
        ov[j] = (l16 & 4) ? (pr * sn[j] + v[j] * cs[j]) : (v[j] * cs[j] - pr * sn[j]); }
      *(u32x4*)(base + hd * 128) = (u32x4){cvtpk(ov[0], ov[1]), cvtpk(ov[2], ov[3]), cvtpk(ov[4], ov[5]), cvtpk(ov[6], ov[7])};
    }
  }
}

__device__ __forceinline__ void qk_fused(const P& p, char* lds, int o) {
  const int tid = TIDX(), l16 = tid & 15, grp = tid >> 4;
  bf16_t* QKV = (bf16_t*)(p.ws + OFF_D);
  float* tab = (float*)lds;
  for (int i = tid; i < 4096; i += 512) { const int pos = i >> 5, f = i & 31; const float ang = (float)pos * powf(10000.f, -(float)f / 32.f); tab[2 * i] = cosf(ang); tab[2 * i + 1] = sinf(ang); }
  asm volatile("s_waitcnt vmcnt(0)" ::: "memory");
  __syncthreads();
  const int f0 = (l16 & 3) * 8;
  pg8::SchedX S; S.so.init(MROWS, 1536, GDIM(), BIDX()); S.mode = 0;
  pg8::Unit u;
  for (int ui = 0; S.next(ui, u); ++ui) {
    if (u.pn >= 5) continue;
    const f32x8 nw = *(const f32x8*)((u.pn < 4 ? p.att_q_norm : p.att_k_norm) + o * 128 + l16 * 8);
    for (int it0 = grp; it0 < 512; it0 += 128) {
      bf16x8 x[4]; bf16_t* base[4]; int pos[4]; bool lat[4];
#pragma unroll
      for (int q = 0; q < 4; ++q) { const int it = it0 + q * 32;
        const int R = u.pm * 256 + (it >> 1); const int b = R >= TB ? 1 : 0, pp = R - b * TB; lat[q] = pp >= CTXL; const int t = lat[q] ? pp - CTXL : 0;
        pos[q] = (l16 < 8) ? (t >> 6) : (t & 63);
        base[q] = QKV + (size_t)R * 1536 + u.pn * 256 + (it & 1) * 128 + l16 * 8; x[q] = *(const bf16x8*)base[q]; }
#pragma unroll
      for (int q = 0; q < 4; ++q) {
        float v[8]; float ss = 0.f;
#pragma unroll
        for (int j = 0; j < 8; ++j) { v[j] = bf2f((bf16_t)x[q][j]); ss += v[j] * v[j]; }
        ss += __shfl_xor(ss, 1); ss += __shfl_xor(ss, 2); ss += __shfl_xor(ss, 4); ss += __shfl_xor(ss, 8);
        const float rs = rsqrtf(ss * (1.f / 128.f) + EPSF);
        float ov[8];
#pragma unroll
        for (int j = 0; j < 8; ++j) { const float2 t2 = *(const float2*)(tab + 2 * (pos[q] * 32 + f0 + j)); const float cs = lat[q] ? t2.x : 1.f, sn = lat[q] ? t2.y : 0.f;
          v[j] = v[j] * rs * nw[j]; const float pr = __shfl_xor(v[j], 4);
          ov[j] = (l16 & 4) ? (pr * sn + v[j] * cs) : (v[j] * cs - pr * sn); }
        *(u32x4*)base[q] = (u32x4){cvtpk(ov[0], ov[1]), cvtpk(ov[2], ov[3]), cvtpk(ov[4], ov[5]), cvtpk(ov[6], ov[7])};
      }
    }
  }
}

namespace at {
constexpr int D = 128, NW = 8, QBLK = 32, KVBLK = 64;
constexpr float SCALE = 0.088388347648318440f, THR = 8.f;
constexpr int LDQ = 1536, LDK = 1536, LDO = 1024;
constexpr size_t SHM_V = KVBLK * D * 2, SHM_K = KVBLK * D * 2;
#define KSWZ(row, colB) ((row) * 256 + ((colB) ^ (((row) & 7) << 4)))
#define SBAR() __builtin_amdgcn_sched_barrier(0)
DI void partialSM(f32x16& p0, f32x16& p1, float& m_reg, float& mn, float& alpha) {
  constexpr float C = SCALE * 1.4426950408889634f;
  float pmax = p0[0]; for (int r = 1; r < 16; ++r) pmax = fmaxf(pmax, p0[r]); for (int r = 0; r < 16; ++r) pmax = fmaxf(pmax, p1[r]);
  { auto rr = __builtin_amdgcn_permlane32_swap(__float_as_uint(pmax), __float_as_uint(pmax), false, false);
    pmax = fmaxf(__uint_as_float(rr[0]), __uint_as_float(rr[1])); }
  if (__builtin_expect(__all(pmax - m_reg <= THR / SCALE), 1)) { mn = m_reg; alpha = 1.f; }
  else { mn = fmaxf(m_reg, pmax); alpha = __builtin_amdgcn_exp2f((m_reg - mn) * C); m_reg = mn; }
  float mnC = -mn * C;
  for (int r = 0; r < 16; ++r) p0[r] = fmaf(p0[r], C, mnC); for (int r = 0; r < 16; ++r) p1[r] = fmaf(p1[r], C, mnC);
  for (int r = 0; r < 16; ++r) p0[r] = __builtin_amdgcn_exp2f(p0[r]);
}
DI void finishSM(f32x16& p0, f32x16& p1, float alpha, float& l_reg, bf16x8& pa0, bf16x8& pa1, bf16x8& pa2, bf16x8& pa3) {
  for (int r = 0; r < 16; ++r) p1[r] = __builtin_amdgcn_exp2f(p1[r]);
  float ps = 0; for (int r = 0; r < 16; ++r) ps += p0[r]; for (int r = 0; r < 16; ++r) ps += p1[r];
  { auto rr = __builtin_amdgcn_permlane32_swap(__float_as_uint(ps), __float_as_uint(ps), false, false);
    ps = __uint_as_float(rr[0]) + __uint_as_float(rr[1]); }
  l_reg = l_reg * alpha + ps;
#define PK4(PP, BASE, OUT) do { unsigned a0 = cvtpk(PP[BASE + 0], PP[BASE + 1]), a1 = cvtpk(PP[BASE + 2], PP[BASE + 3]);   \
    unsigned b0 = cvtpk(PP[BASE + 4], PP[BASE + 5]), b1 = cvtpk(PP[BASE + 6], PP[BASE + 7]);                              \
    auto r0 = __builtin_amdgcn_permlane32_swap(a0, b0, false, false); auto r1 = __builtin_amdgcn_permlane32_swap(a1, b1, false, false); \
    u32x4 w = {r0[0], r1[0], r0[1], r1[1]}; OUT = *reinterpret_cast<bf16x8*>(&w); } while (0)
  PK4(p0, 0, pa0); PK4(p0, 8, pa1); PK4(p1, 0, pa2); PK4(p1, 8, pa3);
#undef PK4
}
DI void qkt(f32x16& p0, f32x16& p1, const bf16_t* Ks, const bf16x8* qr, int r32, int hi) {
  p0 = f32x16{}; p1 = f32x16{};
  for (int d0 = 0; d0 < 8; ++d0) { int cb = (d0 * 16 + hi * 8) * 2;
    bf16x8 b0 = *reinterpret_cast<const bf16x8*>((const char*)Ks + KSWZ(r32, cb));
    bf16x8 b1 = *reinterpret_cast<const bf16x8*>((const char*)Ks + KSWZ(32 + r32, cb));
    p0 = MFMA32(b0, qr[d0], p0);
    p1 = MFMA32(b1, qr[d0], p1); }
}
DI int v_st(int k, int c) { const int kk = (k & ~0xC) | ((k & 4) << 1) | ((k & 8) >> 1); return ((kk >> 3) * 4 + (c >> 5)) * 512 + ((kk & 7) * 32 + (c & 31)) * 2; }
DI int v_rd_base(int lane) { return ((lane & 3) << 3) | (((lane >> 2) & 3) << 6) | (((lane >> 4) & 1) << 5) | (((lane >> 5) & 1) << 8); }
constexpr int v_rd_off(int d0, int ks, int half) { return d0 * 512 + ks * 4096 + half * 2048; }
template <int OFF> DI s16x4 tr_read(int vb) {
  s16x4 r; asm volatile("ds_read_b64_tr_b16 %0, %1 offset:%2" : "=&v"(r) : "v"(vb), "i"(OFF) : "memory"); return r;
}
template <int D0> DI void pv_one(f32x16& od, int vb, bf16x8 pa0, bf16x8 pa1, bf16x8 pa2, bf16x8 pa3) {
  const s16x4 l0 = tr_read<v_rd_off(D0, 0, 0)>(vb), h0 = tr_read<v_rd_off(D0, 0, 1)>(vb), l1 = tr_read<v_rd_off(D0, 1, 0)>(vb), h1 = tr_read<v_rd_off(D0, 1, 1)>(vb);
  const s16x4 l2 = tr_read<v_rd_off(D0, 2, 0)>(vb), h2 = tr_read<v_rd_off(D0, 2, 1)>(vb), l3 = tr_read<v_rd_off(D0, 3, 0)>(vb), h3 = tr_read<v_rd_off(D0, 3, 1)>(vb);
  asm volatile("s_waitcnt lgkmcnt(0)" ::: "memory"); SBAR();
#define PK(Lx, Hx) (bf16x8){Lx[0], Lx[1], Lx[2], Lx[3], Hx[0], Hx[1], Hx[2], Hx[3]}
  od = MFMA32(pa0, PK(l0, h0), od);
  od = MFMA32(pa1, PK(l1, h1), od);
  od = MFMA32(pa2, PK(l2, h2), od);
  od = MFMA32(pa3, PK(l3, h3), od);
#undef PK
}
DI void pv_d0(f32x16* o, int vb, bf16x8 pa0, bf16x8 pa1, bf16x8 pa2, bf16x8 pa3) {
  pv_one<0>(o[0], vb, pa0, pa1, pa2, pa3); pv_one<1>(o[1], vb, pa0, pa1, pa2, pa3); pv_one<2>(o[2], vb, pa0, pa1, pa2, pa3); pv_one<3>(o[3], vb, pa0, pa1, pa2, pa3);
}
DI void attn_dense_body(const bf16_t* __restrict__ Qb, const bf16_t* __restrict__ Kh, const bf16_t* __restrict__ Vh, bf16_t* __restrict__ Ob, int seq, char* lds) {
  const int tid = TIDX(), wid = tid >> 6, lane = tid & 63, r32 = lane & 31, hi = lane >> 5;
  bf16_t* V_lds = (bf16_t*)lds; bf16_t* K_lds = (bf16_t*)(lds + 2 * SHM_V);
  float* ws = (float*)(lds + 2 * SHM_V + 2 * SHM_K) + wid * 64; float* li_l = ws; float* al_l = ws + 32;
  float m_reg = -1e30f, l_reg = 0; f32x16 o[4] = {}; bf16x8 qr[8];
  const bf16_t* Qw = Qb + (long)(wid * QBLK + r32) * LDQ + hi * 8;
#pragma unroll
  for (int d0 = 0; d0 < 8; ++d0) qr[d0] = *reinterpret_cast<const bf16x8*>(Qw + d0 * 16);
  const int sr = tid >> 4, sc = (tid & 15) * 8, vst0 = v_st(sr, sc), vst1 = v_st(32 + sr, sc);
  const int vb0 = (int)(uintptr_t)V_lds + v_rd_base(lane);
  struct { bf16x8 vs0, vs1, ks0, ks1; } sr_[2];
#define SLOAD(i, k0) do { sr_[i].vs0 = *(const bf16x8*)(&Vh[(long)((k0) + sr) * LDK + sc]); sr_[i].vs1 = *(const bf16x8*)(&Vh[(long)((k0) + 32 + sr) * LDK + sc]); \
    sr_[i].ks0 = *(const bf16x8*)(&Kh[(long)((k0) + sr) * LDK + sc]); sr_[i].ks1 = *(const bf16x8*)(&Kh[(long)((k0) + 32 + sr) * LDK + sc]); } while (0)
#define SWRITE(bq, i) do { *(bf16x8*)((char*)V_lds + (bq) * SHM_V + vst0) = sr_[i].vs0;          \
    *(bf16x8*)((char*)V_lds + (bq) * SHM_V + vst1) = sr_[i].vs1; int kc = sc * 2;               \
    *(bf16x8*)((char*)K_lds + (bq) * SHM_K + KSWZ(sr, kc)) = sr_[i].ks0;                       \
    *(bf16x8*)((char*)K_lds + (bq) * SHM_K + KSWZ(32 + sr, kc)) = sr_[i].ks1; } while (0)
#define SWAIT() asm volatile("s_waitcnt vmcnt(4)" ::: "memory")
#define RESC(a) do { if (__any((a) < 1.f)) { if (hi == 0) al_l[r32] = (a); asm volatile("s_waitcnt lgkmcnt(0)" ::: "memory"); \
    for (int d = 0; d < 4; ++d) for (int r = 0; r < 16; ++r) o[d][r] *= al_l[crow(r, hi)]; } } while (0)
  f32x16 pA0, pA1, pB0, pB1; float mnA, mnB, alA, alB; bf16x8 pa0, pa1, pa2, pa3; const int NT = seq / KVBLK;
  constexpr int SE = 0, SO = 1;
  SLOAD(SE, 0); asm volatile("s_waitcnt vmcnt(0)" ::: "memory"); SWRITE(0, SE); __syncthreads();
  qkt(pA0, pA1, K_lds, qr, r32, hi); partialSM(pA0, pA1, m_reg, mnA, alA);
  SLOAD(SO, KVBLK); if (2 < NT) SLOAD(SE, 2 * KVBLK);
  SWAIT(); SWRITE(1, SO); __syncthreads();
  for (int j = 1; j + 1 < NT; j += 2) {
    SBAR(); qkt(pB0, pB1, (bf16_t*)((char*)K_lds + SHM_K), qr, r32, hi);
    finishSM(pA0, pA1, alA, l_reg, pa0, pa1, pa2, pa3); SBAR();
    SLOAD(SO, (j + 2) * KVBLK); SBAR();
    pv_d0(o, vb0, pa0, pa1, pa2, pa3); partialSM(pB0, pB1, m_reg, mnB, alB);
    __syncthreads(); SWAIT(); SWRITE(0, SE);
    RESC(alB); __syncthreads();
    SBAR(); qkt(pA0, pA1, K_lds, qr, r32, hi);
    finishSM(pB0, pB1, alB, l_reg, pa0, pa1, pa2, pa3); SBAR();
    if (j + 3 < NT) SLOAD(SE, (j + 3) * KVBLK); SBAR();
    pv_d0(o, vb0 + (int)SHM_V, pa0, pa1, pa2, pa3); partialSM(pA0, pA1, m_reg, mnA, alA);
    __syncthreads(); SWAIT(); SWRITE(1, SO);
    RESC(alA); __syncthreads();
  }
  SBAR(); qkt(pB0, pB1, (bf16_t*)((char*)K_lds + SHM_K), qr, r32, hi);
  finishSM(pA0, pA1, alA, l_reg, pa0, pa1, pa2, pa3); SBAR();
  pv_d0(o, vb0, pa0, pa1, pa2, pa3); partialSM(pB0, pB1, m_reg, mnB, alB);
  __syncthreads(); RESC(alB);
  finishSM(pB0, pB1, alB, l_reg, pa0, pa1, pa2, pa3); SBAR();
  pv_d0(o, vb0 + (int)SHM_V, pa0, pa1, pa2, pa3);
  if (hi == 0) li_l[r32] = l_reg; asm volatile("s_waitcnt lgkmcnt(0)" ::: "memory");
  float rli[16];
#pragma unroll
  for (int r = 0; r < 16; ++r) rli[r] = __builtin_amdgcn_rcpf(li_l[crow(r, hi)]);
  bf16_t* Ow = Ob + (long)(wid * QBLK) * LDO;
#pragma unroll
  for (int r = 0; r < 16; ++r) { int orow = crow(r, hi);
    for (int d0 = 0; d0 < 4; ++d0) Ow[(long)orow * LDO + d0 * 32 + r32] = f2bf(o[d0][r] * rli[r]); }
#undef SLOAD
#undef SWRITE
#undef SWAIT
#undef RESC
}
}

__device__ __forceinline__ void ph_attn(const P& p, char* lds, bool need_ctx) {
  const bf16_t* QKV = (const bf16_t*)(p.ws + OFF_D); bf16_t* hb = (bf16_t*)(p.ws + OFF_HBF);
  const int nunits = need_ctx ? 528 : 512;
  for (int u = BIDX(); u < nunits; u += GDIM()) {
    int b, h, seq; size_t qrow;
    if (u < 512) { b = u >> 8; const int rem = u & 255; h = rem >> 5; qrow = (size_t)b * TB + CTXL + (size_t)(rem & 31) * 256; seq = TB; }
    else { const int uu = u - 512; b = uu >> 3; h = uu & 7; qrow = (size_t)b * TB; seq = CTXL; }
    const int kvh = h >> 2;
    const bf16_t* Kh = QKV + (size_t)b * TB * 1536 + 1024 + kvh * 128;
    const bf16_t* Vh = QKV + (size_t)b * TB * 1536 + 1280 + kvh * 128;
    at::attn_dense_body(QKV + qrow * 1536 + h * 128, Kh, Vh, hb + qrow * 1024 + h * 128, seq, lds);
    __syncthreads();
  }
}

__device__ __forceinline__ void ph_final(const P& p) {
  const int tid = TIDX(), wid = tid >> 6, lane = tid & 63;
  const float* xr = (const float*)(p.ws + OFF_XRES);
  for (int q = BIDX() * 8 + wid; q < 2 * LAT; q += GDIM() * 8) {
    const int b = q >> 13, t = q & (LAT - 1); const float* row = xr + ((size_t)b * TB + CTXL + t) * 1024;
    f32x4 v[4]; float ss = 0.f;
#pragma unroll
    for (int i = 0; i < 4; ++i) { v[i] = *(const f32x4*)(row + i * 256 + lane * 4); ss += v[i][0] * v[i][0] + v[i][1] * v[i][1] + v[i][2] * v[i][2] + v[i][3] * v[i][3]; }
    ss = wave_sum(ss); const float rs = rsqrtf(ss * (1.f / 1024.f) + EPSF);
#pragma unroll
    for (int i = 0; i < 4; ++i) { const int c0 = i * 256 + lane * 4; const f32x4 g = *(const f32x4*)(p.final_norm + c0); f32x4 o = v[i] * rs * g; *(f32x4*)(p.out + (size_t)q * 1024 + c0) = o; }
  }
}

#ifndef ONLY_PH
#define ONLY_PH -1
#endif
#define EN(x) (ONLY_PH < 0 || ONLY_PH == (x))
#ifndef PROBE_REP
#define PROBE_REP -1
#endif
#define RUN(cls, ...) do { if (EN(cls)) { for (int rep_ = 0; rep_ < ((PROBE_REP == (cls)) ? 2 : 1); ++rep_) { if (rep_) xcd_barrier(*xbp); __VA_ARGS__; } } } while (0)
enum { OP_INIT, OP_N1FULL, OP_IN, OP_PREP, OP_D1, OP_SCAN, OP_MERGE, OP_OUTLAT, OP_OUTCTX_N2LAT, OP_N2CTX, OP_UP, OP_ACT, OP_DOWNLAT, OP_DOWNCTX_N1LAT, OP_N1CTX,
       OP_QKV, OP_QKNORM, OP_ATTN, OP_N2FULL, OP_FINAL };
constexpr int NPHASES = 46;
__device__ __forceinline__ void decode_phase(int ph, int& op, int& L) {
  if (ph == 0) { op = OP_INIT; L = 0; return; }
  if (ph == NPHASES - 1) { op = OP_FINAL; L = 3; return; }
  int q = ph - 1;
  if (q < 14) { L = 0; if (q == 0) { op = OP_N1FULL; return; } q -= 1; }
  else if (q < 24) { L = 1; q -= 14; }
  else if (q < 37) { L = 2; q -= 24; }
  else { L = 3; q -= 37; }
  if ((L & 1) == 0) {
    if (q < 5) { op = OP_IN + q; return; }
    q -= 5;
  } else {
    if (q < 2) { op = q == 0 ? OP_QKV : OP_ATTN; return; }
    q -= 2;
  }
  if (L < 3) { const int t[8] = {OP_OUTLAT, OP_OUTCTX_N2LAT, OP_N2CTX, OP_UP, OP_ACT, OP_DOWNLAT, OP_DOWNCTX_N1LAT, OP_N1CTX}; op = t[q]; }
  else { const int t[5] = {OP_OUTLAT, OP_N2FULL, OP_UP, OP_ACT, OP_DOWNLAT}; op = t[q]; }
}
__device__ __forceinline__ void run_phase(const P& p0, int ph, char* lds, const XcdBarrier* xbp) {
  P p = p0; { typedef __attribute__((address_space(1))) char gchar_t; size_t wi = (size_t)p0.ws; asm volatile("" : "+s"(wi)); p.ws = (char*)(gchar_t*)wi; }
  int op, L; decode_phase(ph, op, L);
  const int e = L >> 1, o = L >> 1;
  bf16_t* W1 = (bf16_t*)(p.ws + OFF_WC); bf16_t* W2 = (bf16_t*)(p.ws + OFF_WC + WC_W2); bf16_t* W3 = (bf16_t*)(p.ws + OFF_W3);
  bf16_t* hb = (bf16_t*)(p.ws + OFF_HBF); float* xr = (float*)(p.ws + OFF_XRES);
  const float* mods = (const float*)(p.ws + OFF_MODS) + (size_t)L * 3 * 6144;
  float* PART = (float*)(p.ws + OFF_D + D_END_F);
#define CVT_MIX(LL, skipb) do { const int L_ = (LL); if ((L_ & 1) == 0) { cvt_weight(p.rec_w_in + (size_t)(L_ >> 1) * 1024 * 3632, W1, 1024, 3632, NREC, true, skipb); cvt_weight(p.rec_w_out + (size_t)(L_ >> 1) * 1024 * 1024, W3, 1024, 1024, 1024, false, skipb); } \
    else { cvt_weight(p.att_w_qkv + (size_t)(L_ >> 1) * 1024 * 1536, W1, 1024, 1536, 1536, false, skipb); cvt_weight(p.att_w_out + (size_t)(L_ >> 1) * 1024 * 1024, W3, 1024, 1024, 1024, false, skipb); } } while (0)
#define CVT_FFN(LL, skipb) do { const int L_ = (LL); cvt_weight(p.ffn_w_up + (size_t)L_ * 1024 * 5632, W1, 1024, 5632, 5632, false, skipb); cvt_weight(p.ffn_w_down + (size_t)L_ * DFF * 1024, W2, DFF, 1024, 1024, false, skipb); } while (0)
  switch (op) {
    case OP_INIT: RUN(0, ph_init(p, lds); CVT_MIX(0, 0)); break;
    case OP_N1FULL: RUN(1, ph_norm(p, L, 0, 0, 0)); break;
    case OP_IN: RUN(2, gemm8(lds, hb, 1024, W1, 1024, NREC, 0, EpiRec8{(bf16_t*)(p.ws + OFF_D + D_P1), (bf16_t*)(p.ws + OFF_D + D_P2), (float*)(p.ws + OFF_SM)})); break;
    case OP_PREP: RUN(3, ph_dnprep(p, lds, e)); break;
    case OP_D1: RUN(4, ph_dn_d1(p, lds); ph_gla_b(p, lds, e)); break;
    case OP_SCAN: RUN(5, if (BIDX() < 64) { dn_scan(p, lds, BIDX()); } else if (BIDX() < 128) { gla_scan(p, lds, BIDX() - 64, e); });
        if (PROBE_REP == 55) { xcd_barrier(*xbp); if (BIDX() < 64) { dn_scan(p, lds, BIDX()); } }
        if (PROBE_REP == 56) { xcd_barrier(*xbp); if (BIDX() >= 64 && BIDX() < 128) { gla_scan(p, lds, BIDX() - 64, e); } }
        break;
    case OP_MERGE: RUN(7, ph_merge(p, e)); break;
    case OP_QKV: if (EN(2)) { gemm8(lds, hb, 1024, W1, 1024, 1536, 0, EpiBf8{(bf16_t*)(p.ws + OFF_D), 1536}); qk_fused(p, lds, o); } break;
    case OP_ATTN: RUN(10, ph_attn(p, lds, L != 3)); break;
    case OP_OUTLAT: if (EN(2)) { gemm8(lds, hb, 1024, W3, 1024, 1024, 1, EpiRes8{xr, mods + 2 * 1024}); if (L == 3) CVT_FFN(L, 0); } break;
    case OP_OUTCTX_N2LAT: if (EN(2)) { if (BIDX() < 128) gemm_ctx_split(lds, hb, 1024, W3, 1024, 128, PART); ph_norm(p, L, 1, 1, 0); CVT_FFN(L, 0); } break;
    case OP_N2CTX: if (EN(1)) ph_ctx_fold_norm(p, L, 1, PART, 8, mods + 2 * 1024); break;
    case OP_N2FULL: if (EN(1)) ph_norm(p, L, 1, 0, 0); break;
    case OP_UP: RUN(2, gemm8(lds, hb, 1024, W1, 1024, 5632, L == 3 ? 1 : 0, EpiBf8{(bf16_t*)(p.ws + OFF_D), 5632})); break;
    case OP_ACT: if (EN(8)) ph_ffnact(p, L); break;
    case OP_DOWNLAT: if (EN(2)) gemm8(lds, (const bf16_t*)(p.ws + OFF_D) + DFF, 5632, W2, DFF, 1024, 1, EpiRes8{xr, mods + 5 * 1024}); break;
    case OP_DOWNCTX_N1LAT: if (EN(2)) { if (BIDX() < 176) gemm_ctx_split(lds, (const bf16_t*)(p.ws + OFF_D) + DFF, 5632, W2, DFF, 256, PART); ph_norm(p, L + 1, 0, 1, 0); CVT_MIX(L + 1, 0); } break;
    case OP_N1CTX: if (EN(1)) ph_ctx_fold_norm(p, L + 1, 0, PART, 11, mods + 5 * 1024); break;
    case OP_FINAL: if (EN(11)) ph_final(p); break;
  }
#undef CVT_MIX
#undef CVT_FFN
}

template <bool COOP>
__global__ void __launch_bounds__(512, 1) mk_kernel(P p, int ph0, int ph1) {
  extern __shared__ __attribute__((aligned(16))) char smem[];
  if constexpr (COOP) {
    if (ph0 < 0) cg::this_grid().sync();
    volatile LAS unsigned* st = (volatile LAS unsigned*)(smem + LDS_BYTES);
    if (threadIdx.x < 4) st[threadIdx.x] = 0u;
    __syncthreads();
    XcdBarrier xb = xcd_barrier_post((unsigned*)(p.ws + OFF_BAR), st);
    for (int ph = ph0; ph < ph1; ++ph) {
      run_phase(p, ph, smem, &xb);
      if (ph + 1 < ph1) xcd_barrier(xb);
      if (PROBE_REP == 99 && ph == 0) { for (int q = 0; q < 20; ++q) xcd_barrier(xb); }
    }
  } else {
    for (int ph = ph0; ph < ph1; ++ph) run_phase(p, ph, smem, nullptr);
  }
}

extern "C" void kernel_launch(void* const* d_in, const int* in_sizes, int n_in, void* d_out, int out_size, void* d_ws, size_t ws_size, hipStream_t stream) {
  if (n_in != 23 || ws_size < WS_NEED) { fprintf(stderr, "kernel_launch: bad n_in %d or ws %zu < %zu\n", n_in, ws_size, (size_t)WS_NEED); return; }
  P p{};
  const float** f = (const float**)&p;
  for (int i = 0; i < 23; ++i) f[i] = (const float*)d_in[i];
  p.out = (float*)d_out; p.ws = (char*)d_ws;
  static int inited = 0, grid_blocks = 0;
  if (!inited) {
    hipFuncSetAttribute((const void*)mk_kernel<true>, hipFuncAttributeMaxDynamicSharedMemorySize, LDS_BYTES + 16);
#if !MK_COOP
    hipFuncSetAttribute((const void*)mk_kernel<false>, hipFuncAttributeMaxDynamicSharedMemorySize, LDS_BYTES);
#endif
    int dev = 0, cus = 0, per_cu = 0;
    hipGetDevice(&dev); hipDeviceGetAttribute(&cus, hipDeviceAttributeMultiprocessorCount, dev);
    hipOccupancyMaxActiveBlocksPerMultiprocessor(&per_cu, mk_kernel<true>, 512, LDS_BYTES + 16);
    if (per_cu > 1) per_cu = 1;
    grid_blocks = cus * per_cu; if (grid_blocks > 256) grid_blocks = 256; if (grid_blocks < 128) grid_blocks = 128;
    inited = 1;
  }
#if MK_COOP
  int ph0 = 0, ph1 = NPHASES;
  void* args[] = {&p, &ph0, &ph1};
  hipMemsetAsync((char*)d_ws + OFF_BAR, 0, 3456 * 4, stream);
  hipError_t er = hipLaunchCooperativeKernel((const void*)mk_kernel<true>, dim3(grid_blocks), dim3(512), args, LDS_BYTES + 16, stream);
  if (er != hipSuccess) fprintf(stderr, "cooperative launch failed: %s (grid %d)\n", hipGetErrorString(er), grid_blocks);
#else
  for (int ph = 0; ph < NPHASES; ++ph) hipLaunchKernelGGL(mk_kernel<false>, dim3(256), dim3(512), LDS_BYTES, stream, p, ph, ph + 1);
#endif
}
```

```cpp
#include <hip/hip_runtime.h>
#include <hip/hip_cooperative_groups.h>
#include <cstdio>
#include <cstdint>
namespace cg = cooperative_groups;

#ifndef MK_COOP
#define MK_COOP 1
#endif

typedef unsigned short bf16_t;
typedef short bf16x8 __attribute__((ext_vector_type(8)));
typedef short s16x4 __attribute__((ext_vector_type(4)));
typedef float f32x16 __attribute__((ext_vector_type(16)));
typedef float f32x8 __attribute__((ext_vector_type(8)));
typedef float f32x4 __attribute__((ext_vector_type(4)));
typedef unsigned u32x4 __attribute__((ext_vector_type(4)));
#define DI __device__ __forceinline__
#define LBAR() do { asm volatile("s_waitcnt lgkmcnt(0)" ::: "memory"); __builtin_amdgcn_s_barrier(); asm volatile("" ::: "memory"); } while (0)
#define MFMA32(a, b, c) __builtin_amdgcn_mfma_f32_32x32x16_bf16((a), (b), (c), 0, 0, 0)

constexpr int DM = 1024, TB = 8448, CTXL = 256, LAT = 8192, MROWS = 2 * TB;
constexpr int NCH = 132;
constexpr int DFF = 2816;
constexpr int NREC = 3840;
constexpr float EPSF = 1e-6f;

constexpr size_t AL(size_t x) { return (x + 255) / 256 * 256; }
constexpr size_t OFF_XRES = 0;
constexpr size_t OFF_HBF = OFF_XRES + AL((size_t)MROWS * DM * 4);
constexpr size_t OFF_WC = OFF_HBF + AL((size_t)MROWS * DM * 2);
constexpr size_t WC_W2 = (size_t)5632 * 1024 * 2;
constexpr size_t OFF_MODS = OFF_WC + AL(WC_W2 + (size_t)1024 * 2816 * 2);
constexpr size_t OFF_SM = OFF_MODS + AL((size_t)4 * 3 * 6144 * 4);
constexpr size_t OFF_GB = OFF_SM + AL((size_t)MROWS * 64 * 4);
constexpr size_t OFF_SC = OFF_GB + AL((size_t)MROWS * 16 * 4);
constexpr size_t OFF_GL = OFF_SC + AL((size_t)16 * NCH * 64 * 2 * 4);
constexpr size_t OFF_D = OFF_GL + AL((size_t)16 * NCH * 4);
constexpr size_t D_P1 = 0;
constexpr size_t D_W = 0;
constexpr size_t D_INTRA = D_W + (size_t)16 * NCH * 64 * 128 * 2;
constexpr size_t D_P2 = D_P1 + (size_t)MROWS * 1536 * 2;
constexpr size_t D_QQ = D_P2 + (size_t)MROWS * 2048 * 2;
constexpr size_t D_QK = D_QQ + (size_t)MROWS * 512 * 2;
constexpr size_t D_QV = D_QK + (size_t)MROWS * 512 * 2;
constexpr size_t D_DNO = D_QK;
constexpr size_t D_KT = D_QV + (size_t)MROWS * 512 * 2;
constexpr size_t D_GLAO = D_KT + (size_t)MROWS * 512 * 2;
constexpr size_t D_END_E = D_GLAO + (size_t)2 * MROWS * 512 * 2;
constexpr size_t D_END_F = (size_t)MROWS * 5632 * 2;
constexpr size_t OFF_B16_1 = OFF_D + (D_END_E > D_END_F ? D_END_E : D_END_F);
constexpr size_t B16_BYTES = (size_t)8 * NCH * 64 * 64 * 2;
constexpr size_t OFF_BAR = OFF_B16_1 + AL(B16_BYTES);
constexpr size_t OFF_W3 = OFF_BAR + AL(3456 * 4);
constexpr size_t WS_NEED = OFF_W3 + (size_t)1024 * 1024 * 2;
constexpr int LDS_BYTES = 132 * 1024;

struct P {
  const float *x, *c, *ctx, *c_ctx, *mod_w, *mod_b, *rec_w_in, *rec_conv, *dn_a_log, *dn_dt_bias, *dn_norm, *gla_w2, *gla_b2, *gla_norm,
      *rec_w_out, *att_w_qkv, *att_q_norm, *att_k_norm, *att_w_out, *ffn_w_up, *ffn_conv, *ffn_w_down, *final_norm;
  float* out;
  char* ws;
};

DI int TIDX() { int t = threadIdx.x; asm volatile("" : "+v"(t)); return t; }
DI int BIDX() { int t = blockIdx.x; asm volatile("" : "+s"(t)); return t; }
DI int GDIM() { int t = gridDim.x; asm volatile("" : "+s"(t)); return t; }
DI float bf2f(bf16_t v) { return __uint_as_float(((unsigned)v) << 16); }
DI bf16_t f2bf(float x) { unsigned u = __float_as_uint(x); u += 0x7fffu + ((u >> 16) & 1u); return (bf16_t)(u >> 16); }
typedef __bf16 bf16n2 __attribute__((ext_vector_type(2)));
DI unsigned cvtpk(float lo, float hi) { const bf16n2 v = {(__bf16)lo, (__bf16)hi}; return __builtin_bit_cast(unsigned, v); }
DI int crow(int r, int hi) { return (r & 3) + 8 * (r >> 2) + 4 * hi; }
DI float siluf(float x) { return x / (1.f + expf(-x)); }
DI float sigmf(float x) { return 1.f / (1.f + expf(-x)); }
DI float softplusf(float x) { return fmaxf(x, 0.f) + log1pf(expf(-fabsf(x))); }
DI float wave_sum(float v) {
#pragma unroll
  for (int o = 32; o > 0; o >>= 1) v += __shfl_xor(v, o);
  return v;
}
DI int modrow_of(int R) { const int b = R >= TB ? 1 : 0; const int pp = R - b * TB; return pp < CTXL ? 2 : b; }
template <int KS>
DI f32x16 mma_rows(const bf16_t* arow, const bf16_t* brow, f32x16 acc) {
#pragma unroll
  for (int ks = 0; ks < KS; ++ks) {
    const bf16x8 a = *reinterpret_cast<const bf16x8*>(arow + ks * 16);
    const bf16x8 b = *reinterpret_cast<const bf16x8*>(brow + ks * 16);
    acc = MFMA32(a, b, acc);
  }
  return acc;
}

#define XB_TMO      128
#define XB_XCNT(j)  (256  + 64 * (j))
#define XB_XSUB(j)  (1280 + 64 * (j))
#define XB_XGEN(j)  (2304 + 64 * (j))
#define XB_TOP      3328
#define XB_TOPGEN   3392
#define XCD_BAR_WORDS 3456
#define XB_SPIN_CAP (1u << 18)
#define LAS __attribute__((address_space(3)))
DI unsigned xb_ld(unsigned* p)              { return __hip_atomic_load(p, __ATOMIC_RELAXED, __HIP_MEMORY_SCOPE_AGENT); }
DI unsigned xb_add(unsigned* p, unsigned v) { return __hip_atomic_fetch_add(p, v, __ATOMIC_RELAXED, __HIP_MEMORY_SCOPE_AGENT); }
DI unsigned xb_xcc_id() { return (unsigned)__builtin_amdgcn_s_getreg((3 << 11) | 20) & 0xFu; }
#define XB_SPIN(cond, bar) do { unsigned _sp = 0; while (cond) { __builtin_amdgcn_s_sleep(1); \
    if ((++_sp & 255u) == 0u) { if (xb_ld(&(bar)[XB_TMO])) break; if (_sp > XB_SPIN_CAP) { atomicAdd(&(bar)[XB_TMO], 1u); break; } } } } while (0)
struct XcdBarrier { unsigned* bar; unsigned x; volatile LAS unsigned* st; };
DI XcdBarrier xcd_barrier_post(unsigned* bar, volatile LAS unsigned* st) {
    XcdBarrier b; b.bar = bar; b.x = xb_xcc_id(); b.st = st;
    if (threadIdx.x == 0) (void)xb_add(&bar[XB_XCNT(b.x)], 1u);
    return b;
}
DI void xcd_barrier_complete(unsigned* bar, unsigned x, unsigned& nloc, unsigned& nx) {
    const unsigned G = gridDim.x * gridDim.y * gridDim.z;
    unsigned sum, cnt, mine, sp = 0u;
    for (;;) {
        sum = 0u; cnt = 0u; mine = 0u;
#pragma unroll
        for (unsigned j = 0; j < 16; ++j) { const unsigned c = xb_ld(&bar[XB_XCNT(j)]); sum += c; cnt += (c > 0u) ? 1u : 0u; mine = (j == x) ? c : mine; }
        if (sum == G) break;
        __builtin_amdgcn_s_sleep(1);
        if ((++sp & 255u) == 0u) { if (xb_ld(&bar[XB_TMO])) break; if (sp > XB_SPIN_CAP) { atomicAdd(&bar[XB_TMO], 1u); break; } }
    }
    nloc = mine > 0u ? mine : 1u; nx = cnt > 0u ? cnt : 1u;
}
DI void xcd_barrier(const XcdBarrier& b) {
    asm volatile("s_waitcnt vmcnt(0)" ::: "memory");
    __syncthreads();
    if (threadIdx.x == 0) {
        unsigned* bar = b.bar;
        __builtin_amdgcn_s_waitcnt(0);
        unsigned nloc = b.st[0], nx = b.st[1];
        if (nloc == 0u) { xcd_barrier_complete(bar, b.x, nloc, nx); b.st[0] = nloc; b.st[1] = nx; }
        const unsigned old = xb_add(&bar[XB_XSUB(b.x)], 1u);
        const unsigned gen = old / nloc;
        if (old + 1u == (gen + 1u) * nloc) {
            __builtin_amdgcn_fence(__ATOMIC_RELEASE, "agent");
            asm volatile("s_waitcnt vmcnt(0)" ::: "memory");
            const unsigned og = xb_add(&bar[XB_TOP], 1u);
            const unsigned tg = og / nx;
            if (og + 1u == (tg + 1u) * nx) xb_add(&bar[XB_TOPGEN], 1u);
            else XB_SPIN(xb_ld(&bar[XB_TOPGEN]) == tg, bar);
            __builtin_amdgcn_fence(__ATOMIC_ACQUIRE, "agent");
            xb_add(&bar[XB_XGEN(b.x)], 1u);
            asm volatile("s_waitcnt vmcnt(0)" ::: "memory");
        } else {
            XB_SPIN(xb_ld(&bar[XB_XGEN(b.x)]) == gen, bar);
            __builtin_amdgcn_fence(__ATOMIC_ACQUIRE, "agent");
            asm volatile("s_waitcnt vmcnt(0)" ::: "memory");
        }
    }
    __syncthreads();
}

__device__ __forceinline__ void ph_init(const P& p, char* lds) {
  const int tid = TIDX();
  float* sc = (float*)lds;
  for (int i = tid; i < 3072; i += 512) { const int r = i >> 10, k = i & 1023; const float v = r < 2 ? p.c[r * 1024 + k] : p.c_ctx[k]; sc[i] = siluf(v); }
  __syncthreads();
  float* mods = (float*)(p.ws + OFF_MODS);
  float* red = sc + 3072;
  for (int job = BIDX(); job < 192; job += GDIM()) {
    const int ct = tid & 31, ks = tid >> 5;
    const int col = job * 128 + ct * 4; const int L = col / 6144, cl = col - L * 6144;
    const float* w = p.mod_w + ((size_t)L * 1024 + ks * 64) * 6144 + cl;
    f32x4 a0 = {0.f, 0.f, 0.f, 0.f}, a1 = a0, a2 = a0;
#pragma unroll 16
    for (int k = 0; k < 64; ++k) { const f32x4 wv = *(const f32x4*)(w + (size_t)k * 6144); const int kk = ks * 64 + k; a0 += sc[kk] * wv; a1 += sc[1024 + kk] * wv; a2 += sc[2048 + kk] * wv; }
    *(f32x4*)(red + (ks * 3 + 0) * 128 + ct * 4) = a0; *(f32x4*)(red + (ks * 3 + 1) * 128 + ct * 4) = a1; *(f32x4*)(red + (ks * 3 + 2) * 128 + ct * 4) = a2;
    __syncthreads();
    if (tid < 384) { const int r = tid >> 7, cc = tid & 127; const int c2 = job * 128 + cc; const int L2 = c2 / 6144, cl2 = c2 - L2 * 6144;
      float sm = p.mod_b[L2 * 6144 + cl2];
#pragma unroll
      for (int q = 0; q < 16; ++q) sm += red[(q * 3 + r) * 128 + cc];
      mods[((size_t)L2 * 3 + r) * 6144 + cl2] = sm; }
    __syncthreads();
  }
  f32x4* xr = (f32x4*)(p.ws + OFF_XRES);
  for (size_t i = (size_t)BIDX() * 512 + tid; i < (size_t)MROWS * 256; i += (size_t)GDIM() * 512) {
    const int R = (int)(i >> 8), c4 = (int)(i & 255); const int b = R >= TB ? 1 : 0, pp = R - b * TB;
    const float* src = pp < CTXL ? p.ctx + ((size_t)b * CTXL + pp) * 1024 : p.x + ((size_t)b * LAT + (pp - CTXL)) * 1024;
    xr[i] = *(const f32x4*)(src + c4 * 4);
  }
}

DI int rec_src_col(int n) { if (n < 2048) return n; if (n < 3584) return n + 16; if (n < 3600) return 2048 + (n - 3584); if (n < 3632) return n; return -1; }
__device__ __forceinline__ void cvt_weight(const float* __restrict__ W, bf16_t* __restrict__ Wt, int K, int Nsrc, int Npad, bool perm, int skipb) {
  const size_t items = (size_t)Npad * (K >> 3);
  const int bid = BIDX() - skipb, nb = GDIM() - skipb;
  if (bid < 0) return;
  for (size_t it = (size_t)bid * 512 + TIDX(); it < items; it += (size_t)nb * 512) {
    const int n = (int)(it % Npad), kb = (int)(it / Npad);
    const int s = perm ? rec_src_col(n) : n;
    float v[8];
#pragma unroll
    for (int j = 0; j < 8; ++j) v[j] = s >= 0 ? W[(size_t)(kb * 8 + j) * Nsrc + s] : 0.f;
    u32x4 w = {cvtpk(v[0], v[1]), cvtpk(v[2], v[3]), cvtpk(v[4], v[5]), cvtpk(v[6], v[7])};
    *(u32x4*)(Wt + (size_t)n * K + kb * 8) = w;
  }
}

__device__ __forceinline__ void gemm_ctx_split(char* lds, const bf16_t* __restrict__ A, int lda, const bf16_t* __restrict__ Bt, int ldb, int Ks, float* __restrict__ PART) {
  const int tid = TIDX(), wid = tid >> 6, lane = tid & 63, r32 = lane & 31, hi = lane >> 5;
  const int wm = wid >> 1, wn = wid & 1;
  const int nk = Ks >> 6;
  constexpr int RS = 144, ASZ = 256 * RS, BSZ = 128 * RS, STG = ASZ + BSZ;
  const int srow = tid >> 3, spc = tid & 7;
  const int w = BIDX(); const int ks = w >> 4, j = w & 15; const int pm = (j >> 3) ? 33 : 0, pn = j & 7;
  const bf16_t* Ab = A + (size_t)(pm * 256 + srow) * lda + (size_t)ks * Ks + spc * 8;
  const bf16_t* Bb = Bt + (size_t)(pn * 128 + srow) * ldb + (size_t)ks * Ks + spc * 8;
  f32x16 acc00 = {}, acc01 = {}, acc10 = {}, acc11 = {};
  bf16x8 ra0, ra1, ra2, ra3, rb0, rb1;
#define GLOAD(kt) do { const int ko = (kt) * 64; ra0 = *(const bf16x8*)(Ab + ko); ra1 = *(const bf16x8*)(Ab + (size_t)64 * lda + ko); ra2 = *(const bf16x8*)(Ab + (size_t)128 * lda + ko); \
    ra3 = *(const bf16x8*)(Ab + (size_t)192 * lda + ko); rb0 = *(const bf16x8*)(Bb + ko); rb1 = *(const bf16x8*)(Bb + (size_t)64 * ldb + ko); } while (0)
#define SWRITE(buf) do { char* sb = lds + (buf) * STG + srow * RS + spc * 16; *(bf16x8*)(sb) = ra0; *(bf16x8*)(sb + 64 * RS) = ra1; *(bf16x8*)(sb + 128 * RS) = ra2; *(bf16x8*)(sb + 192 * RS) = ra3; \
    *(bf16x8*)(sb + ASZ) = rb0; *(bf16x8*)(sb + ASZ + 64 * RS) = rb1; } while (0)
  GLOAD(0); SWRITE(0); __syncthreads();
  for (int kt = 0; kt < nk; ++kt) {
    const int cur = kt & 1;
    if (kt + 1 < nk) GLOAD(kt + 1);
    const char* ab = lds + cur * STG + (64 * wm + r32) * RS + hi * 16;
    const char* bb = lds + cur * STG + ASZ + (64 * wn + r32) * RS + hi * 16;
#pragma unroll
    for (int k4 = 0; k4 < 4; ++k4) {
      const bf16x8 a0 = *(const bf16x8*)(ab + k4 * 32), a1 = *(const bf16x8*)(ab + 32 * RS + k4 * 32);
      const bf16x8 b0 = *(const bf16x8*)(bb + k4 * 32), b1 = *(const bf16x8*)(bb + 32 * RS + k4 * 32);
      acc00 = MFMA32(a0, b0, acc00); acc01 = MFMA32(a0, b1, acc01); acc10 = MFMA32(a1, b0, acc10); acc11 = MFMA32(a1, b1, acc11);
    }
    if (kt + 1 < nk) SWRITE(cur ^ 1);
    __syncthreads();
  }
#undef GLOAD
#undef SWRITE
  float* pb = PART + ((size_t)ks * 512 + (pm ? 256 : 0) + 64 * wm) * 1024 + pn * 128 + 64 * wn + r32;
#pragma unroll
  for (int r = 0; r < 16; ++r) { float* q = pb + (size_t)crow(r, hi) * 1024;
    q[0] = acc00[r]; q[32] = acc01[r]; q[32 * 1024] = acc10[r]; q[32 * 1024 + 32] = acc11[r]; }
}

__device__ __forceinline__ void ph_ctx_fold_norm(const P& p, int L, int which, const float* __restrict__ part, int nsplit, const float* __restrict__ gate) {
  const int tid = TIDX(), wid = tid >> 6, lane = tid & 63;
  float* xr = (float*)(p.ws + OFF_XRES); bf16_t* hb = (bf16_t*)(p.ws + OFF_HBF);
  const float* mods = (const float*)(p.ws + OFF_MODS) + (size_t)L * 3 * 6144;
  for (int cr = BIDX() * 8 + wid; cr < 2 * CTXL; cr += GDIM() * 8) {
    const int R = cr < CTXL ? cr : TB + (cr - CTXL);
    float* row = xr + (size_t)R * 1024 + lane * 4;
    const float* pr = part + (size_t)cr * 1024 + lane * 4;
    f32x4 v[4], a[4];
#pragma unroll
    for (int i = 0; i < 4; ++i) { v[i] = *(const f32x4*)(row + i * 256); a[i] = *(const f32x4*)(pr + i * 256); }
    for (int sp = 1; sp < nsplit; ++sp) {
#pragma unroll
      for (int i = 0; i < 4; ++i) a[i] += *(const f32x4*)(pr + (size_t)sp * 512 * 1024 + i * 256);
    }
    float ss = 0.f;
#pragma unroll
    for (int i = 0; i < 4; ++i) { v[i] += *(const f32x4*)(gate + 2 * 6144 + i * 256 + lane * 4) * a[i]; *(f32x4*)(row + i * 256) = v[i];
      ss += v[i][0] * v[i][0] + v[i][1] * v[i][1] + v[i][2] * v[i][2] + v[i][3] * v[i][3]; }
    ss = wave_sum(ss);
    const float rs = rsqrtf(ss * (1.f / 1024.f) + EPSF);
    const float* mr = mods + (size_t)2 * 6144 + which * 3072 + lane * 4;
#pragma unroll
    for (int i = 0; i < 4; ++i) { const f32x4 sh = *(const f32x4*)(mr + i * 256), scl = *(const f32x4*)(mr + 1024 + i * 256);
      float o[4];
#pragma unroll
      for (int j = 0; j < 4; ++j) o[j] = v[i][j] * rs * (1.f + scl[j]) + sh[j];
      uint2 w; w.x = cvtpk(o[0], o[1]); w.y = cvtpk(o[2], o[3]);
      *(uint2*)(hb + (size_t)R * 1024 + i * 256 + lane * 4) = w; }
  }
}

__device__ __forceinline__ void ph_norm(const P& p, int L, int which, int mode, int skipb) {
  const int tid = TIDX(), wid = tid >> 6, lane = tid & 63, l16 = lane & 15, sub = lane >> 4;
  const float* xr = (const float*)(p.ws + OFF_XRES);
  bf16_t* hb = (bf16_t*)(p.ws + OFF_HBF);
  const float* mods = (const float*)(p.ws + OFF_MODS) + (size_t)L * 3 * 6144;
  const int bid = BIDX() - skipb, nb = GDIM() - skipb;
  if (bid < 0) return;
  const int nquads = mode == 0 ? MROWS / 4 : (mode == 1 ? 2 * LAT / 4 : 2 * CTXL / 4);
  for (int q = bid * 8 + wid; q < nquads; q += nb * 8) {
    int R4;
    if (mode == 0) R4 = q * 4; else if (mode == 1) R4 = q < LAT / 4 ? CTXL + q * 4 : TB + CTXL + (q - LAT / 4) * 4; else R4 = q < CTXL / 4 ? q * 4 : TB + (q - CTXL / 4) * 4;
    const int R = R4 + sub;
    const float* row = xr + (size_t)R * 1024 + l16 * 8;
    f32x4 v[16]; float ss = 0.f;
#pragma unroll
    for (int i = 0; i < 8; ++i) { v[2 * i] = *(const f32x4*)(row + i * 128); v[2 * i + 1] = *(const f32x4*)(row + i * 128 + 4); }
#pragma unroll
    for (int i = 0; i < 16; ++i) ss += v[i][0] * v[i][0] + v[i][1] * v[i][1] + v[i][2] * v[i][2] + v[i][3] * v[i][3];
    ss += __shfl_xor(ss, 1); ss += __shfl_xor(ss, 2); ss += __shfl_xor(ss, 4); ss += __shfl_xor(ss, 8);
    const float rs = rsqrtf(ss * (1.f / 1024.f) + EPSF);
    const float* mr = mods + (size_t)modrow_of(R) * 6144 + which * 3072 + l16 * 8;
    bf16_t* dst = hb + (size_t)R * 1024 + l16 * 8;
#pragma unroll
    for (int i = 0; i < 8; ++i) { unsigned w[4];
#pragma unroll
      for (int hlf = 0; hlf < 2; ++hlf) { const f32x4 sh = *(const f32x4*)(mr + i * 128 + hlf * 4), scl = *(const f32x4*)(mr + 1024 + i * 128 + hlf * 4); const f32x4 x = v[2 * i + hlf];
        float o[4];
#pragma unroll
        for (int j = 0; j < 4; ++j) o[j] = x[j] * rs * (1.f + scl[j]) + sh[j];
        w[2 * hlf] = cvtpk(o[0], o[1]); w[2 * hlf + 1] = cvtpk(o[2], o[3]); }
      *(u32x4*)(dst + i * 128) = (u32x4){w[0], w[1], w[2], w[3]}; }
  }
}

struct EpiRec { bf16_t* P1; bf16_t* P2; float* SM;
  DI void operator()(int row, int col, float v) const {
    if (col < 1536) P1[(size_t)row * 1536 + col] = f2bf(v);
    else if (col < 3584) P2[(size_t)row * 2048 + (col - 1536)] = f2bf(v);
    else { const int lc = col - 3584; if (lc < 48) SM[(size_t)row * 64 + lc] = v; } } };
struct EpiBf { bf16_t* O; int ldc;
  DI void operator()(int row, int col, float v) const { O[(size_t)row * ldc + col] = f2bf(v); } };
struct EpiRes { float* X; const float* gate;
  DI void operator()(int row, int col, float v) const { float* q = X + (size_t)row * 1024 + col; *q = *q + gate[(size_t)modrow_of(row) * 6144 + col] * v; } };

template <class Epi>
__device__ __forceinline__ void gemm_phase(char* lds, const bf16_t* __restrict__ A, int lda, const bf16_t* __restrict__ Bt, int K, int nN, const Epi epi, bool skipctx = false) {
  const int tid = TIDX(), wid = tid >> 6, lane = tid & 63, r32 = lane & 31, hi = lane >> 5;
  const int wm = wid >> 1, wn = wid & 1;
  const int nk = K >> 6;
  constexpr int RS = 144, ASZ = 256 * RS, BSZ = 128 * RS, STG = ASZ + BSZ;
  const int ntiles = (skipctx ? 64 : MROWS / 256) * nN;
  const int srow = tid >> 3, spc = tid & 7;
  for (int t = BIDX(); t < ntiles; t += GDIM()) {
    int pm = t / nN; const int pn = t - pm * nN; if (skipctx) pm = pm + 1 + (pm >= 32 ? 1 : 0);
    const bf16_t* Ab = A + (size_t)(pm * 256 + srow) * lda + spc * 8;
    const bf16_t* Bb = Bt + (size_t)(pn * 128 + srow) * K + spc * 8;
    f32x16 acc00 = {}, acc01 = {}, acc10 = {}, acc11 = {};
    bf16x8 ra0, ra1, ra2, ra3, rb0, rb1;
#define GLOAD(kt) do { const int ko = (kt) * 64; ra0 = *(const bf16x8*)(Ab + ko); ra1 = *(const bf16x8*)(Ab + (size_t)64 * lda + ko); ra2 = *(const bf16x8*)(Ab + (size_t)128 * lda + ko); \
    ra3 = *(const bf16x8*)(Ab + (size_t)192 * lda + ko); rb0 = *(const bf16x8*)(Bb + ko); rb1 = *(const bf16x8*)(Bb + (size_t)64 * K + ko); } while (0)
#define SWRITE(buf) do { char* sb = lds + (buf) * STG + srow * RS + spc * 16; *(bf16x8*)(sb) = ra0; *(bf16x8*)(sb + 64 * RS) = ra1; *(bf16x8*)(sb + 128 * RS) = ra2; *(bf16x8*)(sb + 192 * RS) = ra3; \
    *(bf16x8*)(sb + ASZ) = rb0; *(bf16x8*)(sb + ASZ + 64 * RS) = rb1; } while (0)
    GLOAD(0); SWRITE(0); __syncthreads();
    for (int kt = 0; kt < nk; ++kt) {
      const int cur = kt & 1;
      if (kt + 1 < nk) GLOAD(kt + 1);
      const char* ab = lds + cur * STG + (64 * wm + r32) * RS + hi * 16;
      const char* bb = lds + cur * STG + ASZ + (64 * wn + r32) * RS + hi * 16;
#pragma unroll
      for (int ks = 0; ks < 4; ++ks) {
        const bf16x8 a0 = *(const bf16x8*)(ab + ks * 32), a1 = *(const bf16x8*)(ab + 32 * RS + ks * 32);
        const bf16x8 b0 = *(const bf16x8*)(bb + ks * 32), b1 = *(const bf16x8*)(bb + 32 * RS + ks * 32);
        acc00 = MFMA32(a0, b0, acc00); acc01 = MFMA32(a0, b1, acc01); acc10 = MFMA32(a1, b0, acc10); acc11 = MFMA32(a1, b1, acc11);
      }
      if (kt + 1 < nk) SWRITE(cur ^ 1);
      __syncthreads();
    }
#undef GLOAD
#undef SWRITE
    const int row0 = pm * 256 + 64 * wm, col0 = pn * 128 + 64 * wn + r32;
#pragma unroll
    for (int r = 0; r < 16; ++r) { const int rr = row0 + crow(r, hi);
      epi(rr, col0, acc00[r]); epi(rr, col0 + 32, acc01[r]); epi(rr + 32, col0, acc10[r]); epi(rr + 32, col0 + 32, acc11[r]); }
  }
}

namespace pg8 {
#define PG8_LAS __attribute__((address_space(3)))
constexpr int BM = 256, BK = 64, HALF = 128, HTB = HALF * BK * 2  , STAGE_BYTES = 8 * HTB, NXCD = 8, WGM = 8;

__host__ __device__ __forceinline__ int lds_byte(int r, int c) { const int st = (r >> 4) * 2 + (c >> 5), rr = r & 15, cc = c & 31, ob = rr * 64 + cc * 2; return st * 1024 + (ob ^ (((ob >> 9) & 1) << 5)); }
__host__ __device__ __forceinline__ void stage_rc(int b, int& R, int& C) { const int st = b / 1024, sb = b % 1024, swz = sb ^ (((sb >> 9) & 1) << 5); R = (st >> 1) * 16 + swz / 64; C = (st & 1) * 32 + (swz % 64) / 2; }
__host__ __device__ __forceinline__ int perm32(int rho) { const int n = rho >> 4, i = rho & 15; return 8 * (i >> 2) + 4 * n + (i & 3); }
struct Unit { int pm, pn; };
struct Gemm { const bf16_t* A; const bf16_t* Bt; int M, N, K, lda; };

struct StaticOrder {
    int nM, nN, nwg, G, c;
    __host__ __device__ void init(int M, int N, int G_, int c_) { nM = M / BM; nN = N / BM; nwg = nM * nN; G = G_; c = c_; }
    __host__ __device__ bool next(int i, Unit& u) const {
        const long L = (long)i * G + c; if (L >= nwg) return false;
        int wgid = (int)L; { const int q = nwg / NXCD, r = nwg % NXCD, xcd = wgid % NXCD, off = wgid / NXCD; wgid = (xcd < r ? xcd * (q + 1) : r * (q + 1) + (xcd - r) * q) + off; }
        const int nig = WGM * nN, gid = wgid / nig, fm = gid * WGM, gsz = (nM - fm) < WGM ? (nM - fm) : WGM;
        u.pm = fm + ((wgid % nig) % gsz); u.pn = (wgid % nig) / gsz; return true;
    }
    __device__ __forceinline__ void a_ready(const Unit&) const {}
    __device__ __forceinline__ void done(const Unit&) const {}
};
template <class Epi, class Sched, bool ALIGN_EPI = false, bool SP2 = false>
__device__ __forceinline__ void gemm_phase(PG8_LAS unsigned char* lds, const Gemm g, const Sched& S, const Epi& E) {
    const int tid = TIDX(), wid = __builtin_amdgcn_readfirstlane(tid >> 6), lane = tid & 63, wr = wid >> 2, wc = wid & 3, fr = lane & 15, fq = lane >> 4;
    const int K = g.K, nt = K / BK;
    unsigned voffA[2], voffB[2];
#pragma unroll
    for (int i = 0; i < 2; ++i) { int R, C; stage_rc(tid * 16 + i * 8192, R, C); const int Rb = Epi::PERM ? ((R & ~31) + perm32(R & 31)) : R;
        voffA[i] = (unsigned)(R * g.lda + C) * 2u; voffB[i] = (unsigned)(Rb * K + C) * 2u; }
    const size_t kstep = (size_t)(BK * 2);
    const size_t hstep = (size_t)HALF * K * 2;
    const size_t tstep = 2 * hstep; const size_t hstepA = (size_t)HALF * g.lda * 2, tstepA = 2 * hstepA;
    const unsigned ldsw = (unsigned)wid * 1024u;
    const int aoff = lds_byte(wr * 64 + fr, fq * 8), boff = lds_byte(wc * 32 + fr, fq * 8);
#define PG8_SA(b, h) (((b) * 2 + (h)) * HTB)
#define PG8_SB(b, h) ((4 + (b) * 2 + (h)) * HTB)
#define PG8_STAGE(bufoff, gbase, voff) do { _Pragma("unroll") for (int _i = 0; _i < 2; ++_i) \
        __builtin_amdgcn_global_load_lds((const unsigned*)((const char*)(gbase) + (voff)[_i]), (PG8_LAS unsigned*)(lds + (bufoff) + ldsw + _i * 8192), 16, 0, 0); } while (0)
#define PG8_LDA(dst, b, h) do { _Pragma("unroll") for (int m = 0; m < 4; ++m) _Pragma("unroll") for (int k = 0; k < 2; ++k) dst[m][k] = *(const PG8_LAS bf16x8*)(lds + PG8_SA(b, h) + aoff + m * 2048 + k * 1024); } while (0)
#define PG8_LDB(dst, b, h) do { _Pragma("unroll") for (int n = 0; n < 2; ++n) _Pragma("unroll") for (int k = 0; k < 2; ++k) dst[n][k] = *(const PG8_LAS bf16x8*)(lds + PG8_SB(b, h) + boff + n * 2048 + k * 1024); } while (0)
#define PG8_MMA(ai, bj, At, Bt) do { __builtin_amdgcn_s_setprio(1); _Pragma("unroll") for (int m = 0; m < 4; ++m) _Pragma("unroll") for (int n = 0; n < 2; ++n) _Pragma("unroll") for (int k = 0; k < 2; ++k) \
        acc[ai][bj][m][n] = __builtin_amdgcn_mfma_f32_16x16x32_bf16(Bt[n][k], At[m][k], acc[ai][bj][m][n], 0, 0, 0); __builtin_amdgcn_s_setprio(0); } while (0)
#define PG8_WAIT_V(n) asm volatile("s_waitcnt vmcnt(" #n ")" ::: "memory")
#define PG8_WAIT_L(n) asm volatile("s_waitcnt lgkmcnt(" #n ")" ::: "memory")
#define PG8_BAR __builtin_amdgcn_s_barrier()
#define PG8_SCHED __builtin_amdgcn_sched_barrier(0)
    Unit cur, nxt; int ui = 0;
    if (!S.next(0, cur)) return;
    f32x4 acc[2][2][4][2];
#pragma unroll
    for (int a = 0; a < 2; ++a)
#pragma unroll
        for (int b = 0; b < 2; ++b)
#pragma unroll
            for (int m = 0; m < 4; ++m)
#pragma unroll
                for (int n = 0; n < 2; ++n) acc[a][b][m][n] = (f32x4){0.f, 0.f, 0.f, 0.f};
    bf16x8 At[4][2], B0[2][2], B1[2][2];
    const char* cA = (const char*)g.A + (size_t)cur.pm * tstepA; const char* cB = (const char*)g.Bt + (size_t)cur.pn * tstep;
    S.a_ready(cur);
    if constexpr (SP2) {
        PG8_STAGE(PG8_SB(0, 0), cB, voffB); PG8_STAGE(PG8_SB(0, 1), cB + hstep, voffB); PG8_STAGE(PG8_SA(0, 0), cA, voffA); PG8_STAGE(PG8_SA(0, 1), cA + hstepA, voffA);
        if (wr == 1) PG8_BAR;
        PG8_WAIT_V(2); PG8_BAR;
        PG8_STAGE(PG8_SB(1, 0), cB + kstep, voffB); PG8_STAGE(PG8_SA(1, 0), cA + kstep, voffA); PG8_STAGE(PG8_SB(1, 1), cB + hstep + kstep, voffB);
        PG8_WAIT_V(6); PG8_BAR;
    } else {
        PG8_STAGE(PG8_SB(0, 0), cB, voffB); PG8_STAGE(PG8_SA(0, 0), cA, voffA); PG8_STAGE(PG8_SB(0, 1), cB + hstep, voffB); PG8_STAGE(PG8_SA(0, 1), cA + hstepA, voffA);
        if (wr == 1) PG8_BAR;
        PG8_WAIT_V(4); PG8_BAR;
        PG8_STAGE(PG8_SB(1, 0), cB + kstep, voffB); PG8_STAGE(PG8_SA(1, 0), cA + kstep, voffA); PG8_STAGE(PG8_SB(1, 1), cB + hstep + kstep, voffB);
        PG8_WAIT_V(6); PG8_BAR;
    }
    for (;;) {
        const bool has_next = S.next(ui + 1, nxt);
        const char* nA = has_next ? (const char*)g.A + (size_t)nxt.pm * tstepA : cA; const char* nB = has_next ? (const char*)g.Bt + (size_t)nxt.pn * tstep : cB;
        for (int t = 0; t < nt; t += 2) {
            const bool last = (t == nt - 2);
            const char* a1 = cA + (size_t)(t + 1) * kstep;
            const char* a2 = last ? nA : cA + (size_t)(t + 2) * kstep; const char* b2 = last ? nB : cB + (size_t)(t + 2) * kstep;
            const char* a3 = a2 + kstep; const char* b3 = b2 + kstep;
            if (last && has_next) S.a_ready(nxt);
            if constexpr (SP2) {
            PG8_LDB(B0, 0, 0); PG8_LDB(B1, 0, 1); PG8_SCHED; PG8_LDA(At, 0, 0); PG8_STAGE(PG8_SA(1, 1), a1 + hstepA, voffA);
            PG8_WAIT_V(8); PG8_WAIT_L(0); PG8_BAR; PG8_MMA(0, 0, At, B0); PG8_MMA(0, 1, At, B1); PG8_BAR; PG8_SCHED;
            PG8_LDA(At, 0, 1); PG8_STAGE(PG8_SB(0, 0), b2, voffB); PG8_STAGE(PG8_SB(0, 1), b2 + hstep, voffB); PG8_STAGE(PG8_SA(0, 0), a2, voffA);
            PG8_WAIT_V(8); PG8_WAIT_L(0); PG8_BAR; PG8_MMA(1, 0, At, B0); PG8_MMA(1, 1, At, B1); PG8_BAR; PG8_SCHED;
            PG8_LDB(B0, 1, 0); PG8_LDB(B1, 1, 1); PG8_SCHED; PG8_LDA(At, 1, 0); PG8_STAGE(PG8_SA(0, 1), a2 + hstepA, voffA);
            PG8_WAIT_V(8); PG8_WAIT_L(0); PG8_BAR; PG8_MMA(0, 0, At, B0); PG8_MMA(0, 1, At, B1); PG8_BAR; PG8_SCHED;
            PG8_LDA(At, 1, 1); PG8_STAGE(PG8_SB(1, 0), b3, voffB); PG8_STAGE(PG8_SB(1, 1), b3 + hstep, voffB); PG8_STAGE(PG8_SA(1, 0), a3, voffA);
            PG8_WAIT_V(8); PG8_WAIT_L(0); PG8_BAR; PG8_MMA(1, 0, At, B0); PG8_MMA(1, 1, At, B1); PG8_BAR; PG8_SCHED;
            } else {
            PG8_LDB(B0, 0, 0); PG8_SCHED; PG8_LDA(At, 0, 0); PG8_STAGE(PG8_SA(1, 1), a1 + hstepA, voffA);
            PG8_WAIT_L(8); PG8_BAR; PG8_WAIT_L(0); PG8_MMA(0, 0, At, B0); PG8_BAR; PG8_SCHED;
            PG8_LDB(B1, 0, 1); PG8_STAGE(PG8_SB(0, 0), b2, voffB);
            PG8_BAR; PG8_WAIT_L(0); PG8_MMA(0, 1, At, B1); PG8_BAR;
            PG8_LDA(At, 0, 1); PG8_STAGE(PG8_SA(0, 0), a2, voffA);
            PG8_BAR; PG8_WAIT_L(0); PG8_MMA(1, 0, At, B0); PG8_BAR; PG8_SCHED;
            PG8_STAGE(PG8_SB(0, 1), b2 + hstep, voffB);
            PG8_WAIT_V(6); PG8_BAR; PG8_MMA(1, 1, At, B1); PG8_BAR;
            PG8_LDB(B0, 1, 0); PG8_SCHED; PG8_LDA(At, 1, 0); PG8_STAGE(PG8_SA(0, 1), a2 + hstepA, voffA);
            PG8_WAIT_L(8); PG8_BAR; PG8_WAIT_L(0); PG8_MMA(0, 0, At, B0); PG8_BAR; PG8_SCHED;
            PG8_LDB(B1, 1, 1); PG8_STAGE(PG8_SB(1, 0), b3, voffB);
            PG8_BAR; PG8_WAIT_L(0); PG8_MMA(0, 1, At, B1); PG8_BAR;
            PG8_LDA(At, 1, 1); PG8_STAGE(PG8_SA(1, 0), a3, voffA);
            PG8_BAR; PG8_WAIT_L(0); PG8_MMA(1, 0, At, B0); PG8_BAR; PG8_SCHED;
            PG8_STAGE(PG8_SB(1, 1), b3 + hstep, voffB);
            PG8_WAIT_V(6); PG8_BAR; PG8_MMA(1, 1, At, B1); PG8_BAR;
            }
        }
        if constexpr (ALIGN_EPI) { if (wr == 0) PG8_BAR; }
        if constexpr (!Epi::AFTER_DRAIN) { E(acc, cur, wr, wc, fr, fq); S.done(cur); }
        if (!has_next) break;
#pragma unroll
        for (int a = 0; a < 2; ++a)
#pragma unroll
            for (int b = 0; b < 2; ++b)
#pragma unroll
                for (int m = 0; m < 4; ++m)
#pragma unroll
                    for (int n = 0; n < 2; ++n) acc[a][b][m][n] = (f32x4){0.f, 0.f, 0.f, 0.f};
        cur = nxt; cA = nA; cB = nB; ++ui;
        if constexpr (ALIGN_EPI) { if (wr == 1) PG8_BAR; }
    }
    PG8_WAIT_V(0);
    if constexpr (!ALIGN_EPI) { if (wr == 0) PG8_BAR; }
    PG8_BAR;
    if constexpr (Epi::AFTER_DRAIN) { E.fused(acc, cur, wr, wc, fr, fq, lds, wid, lane); S.done(cur); }
#undef PG8_SA
#undef PG8_SB
#undef PG8_STAGE
#undef PG8_LDA
#undef PG8_LDB
#undef PG8_MMA
#undef PG8_WAIT_V
#undef PG8_WAIT_L
#undef PG8_BAR
#undef PG8_SCHED
}
struct SchedX { StaticOrder so; int mode;
  __device__ __forceinline__ bool next(int i, Unit& u) const {
    if (mode == 2) { if (i != 0 || so.c >= 8) return false; u.pm = (so.c >> 2) ? 33 : 0; u.pn = so.c & 3; return true; }
    if (!so.next(i, u)) return false; if (mode == 1) u.pm = u.pm + 1 + (u.pm >= 32 ? 1 : 0); return true; }
  __device__ __forceinline__ void a_ready(const Unit&) const {}
  __device__ __forceinline__ void done(const Unit&) const {} };
}
struct EpiRec8 { static constexpr bool PERM = true, AFTER_DRAIN = false; bf16_t* P1; bf16_t* P2; float* SM;
  DI void operator()(const f32x4 (&acc)[2][2][4][2], const pg8::Unit& u, int wr, int wc, int fr, int fq) const {
#pragma unroll
    for (int ai = 0; ai < 2; ++ai)
#pragma unroll
      for (int m = 0; m < 4; ++m) { const size_t row = (size_t)u.pm * 256 + ai * 128 + wr * 64 + m * 16 + fr;
#pragma unroll
        for (int bj = 0; bj < 2; ++bj) { const int col = u.pn * 256 + bj * 128 + wc * 32 + fq * 8; const f32x4 v0 = acc[ai][bj][m][0], v1 = acc[ai][bj][m][1];
          if (u.pn < 14) { const u32x4 w = {cvtpk(v0[0], v0[1]), cvtpk(v0[2], v0[3]), cvtpk(v1[0], v1[1]), cvtpk(v1[2], v1[3])};
            if (u.pn < 6) *(u32x4*)(P1 + row * 1536 + col) = w; else *(u32x4*)(P2 + row * 2048 + (col - 1536)) = w; }
          else { const int lc = col - 3584; if (lc < 48) { *(f32x4*)(SM + row * 64 + lc) = v0; *(f32x4*)(SM + row * 64 + lc + 4) = v1; } } } } } };
struct EpiBf8 { static constexpr bool PERM = true, AFTER_DRAIN = false; bf16_t* O; int ldc;
  DI void operator()(const f32x4 (&acc)[2][2][4][2], const pg8::Unit& u, int wr, int wc, int fr, int fq) const {
#pragma unroll
    for (int ai = 0; ai < 2; ++ai)
#pragma unroll
      for (int m = 0; m < 4; ++m) { const size_t row = (size_t)u.pm * 256 + ai * 128 + wr * 64 + m * 16 + fr;
#pragma unroll
        for (int bj = 0; bj < 2; ++bj) { const int col = u.pn * 256 + bj * 128 + wc * 32 + fq * 8; const f32x4 v0 = acc[ai][bj][m][0], v1 = acc[ai][bj][m][1];
          const u32x4 w = {cvtpk(v0[0], v0[1]), cvtpk(v0[2], v0[3]), cvtpk(v1[0], v1[1]), cvtpk(v1[2], v1[3])};
          *(u32x4*)(O + row * ldc + col) = w; } } } };
struct EpiRes8 { static constexpr bool PERM = true, AFTER_DRAIN = false; float* X; const float* gate;
  DI void operator()(const f32x4 (&acc)[2][2][4][2], const pg8::Unit& u, int wr, int wc, int fr, int fq) const {
    const float* gr = gate + (size_t)modrow_of(u.pm * 256) * 6144;
#pragma unroll
    for (int bj = 0; bj < 2; ++bj) { const int col = u.pn * 256 + bj * 128 + wc * 32 + fq * 8; const f32x4 g0 = *(const f32x4*)(gr + col), g1 = *(const f32x4*)(gr + col + 4);
#pragma unroll
      for (int ai = 0; ai < 2; ++ai)
#pragma unroll
        for (int m = 0; m < 4; ++m) { const size_t row = (size_t)u.pm * 256 + ai * 128 + wr * 64 + m * 16 + fr;
          f32x4* q = (f32x4*)(X + row * 1024 + col); const f32x4 x0 = q[0], x1 = q[1]; q[0] = x0 + g0 * acc[ai][bj][m][0]; q[1] = x1 + g1 * acc[ai][bj][m][1]; } } } };
template <class Epi>
__device__ __forceinline__ void gemm8(char* lds, const bf16_t* A, int lda, const bf16_t* Bt, int K, int N, int mode, const Epi& E) {
  pg8::Gemm g{A, Bt, mode == 1 ? 16384 : MROWS, N, K, lda};
  pg8::SchedX S; S.so.init(g.M, N, GDIM(), BIDX()); S.mode = mode;
  pg8::gemm_phase<Epi, pg8::SchedX, true, true>((PG8_LAS unsigned char*)lds, g, S, E);
}

__device__ __forceinline__ void ph_dnprep(const P& p, char* lds, int e) {
  const int tid = TIDX(), wid = tid >> 6, lane = tid & 63;
  const bf16_t* P1 = (const bf16_t*)(p.ws + OFF_D + D_P1);
  bf16_t* QQ = (bf16_t*)(p.ws + OFF_D + D_QQ); bf16_t* QK = (bf16_t*)(p.ws + OFF_D + D_QK); bf16_t* QV = (bf16_t*)(p.ws + OFF_D + D_QV);
  bf16_t* KT = (bf16_t*)(p.ws + OFF_D + D_KT);
  const float* SM = (const float*)(p.ws + OFF_SM); float* GB = (float*)(p.ws + OFF_GB);
  const float* cw = p.rec_conv + (size_t)e * 3 * 1536;
  bf16_t* kl = (bf16_t*)lds;
  for (int job = BIDX(); job < MROWS / 32; job += GDIM()) {
    const int R0 = job * 32;
    for (int tt = 0; tt < 4; ++tt) {
      const int tl = wid * 4 + tt, R = R0 + tl; const int b = R >= TB ? 1 : 0, pp = R - b * TB;
      const bool hasp = !(pp == 0 || pp == CTXL), hasn = !(pp == CTXL - 1 || pp == TB - 1);
#pragma unroll
      for (int part = 0; part < 3; ++part) {
        const int ch = part * 512 + lane * 8;
        const bf16x8 zc = *(const bf16x8*)(P1 + (size_t)R * 1536 + ch);
        bf16x8 zp = {}, zn = {};
        if (hasp) zp = *(const bf16x8*)(P1 + (size_t)(R - 1) * 1536 + ch);
        if (hasn) zn = *(const bf16x8*)(P1 + (size_t)(R + 1) * 1536 + ch);
        float o[8]; float ss = 0.f;
#pragma unroll
        for (int j = 0; j < 8; ++j) { const float a = bf2f((bf16_t)zp[j]) * cw[ch + j] + bf2f((bf16_t)zc[j]) * cw[1536 + ch + j] + bf2f((bf16_t)zn[j]) * cw[3072 + ch + j];
          o[j] = siluf(a); ss += o[j] * o[j]; }
        if (part < 2) {
          ss += __shfl_xor(ss, 1); ss += __shfl_xor(ss, 2); ss += __shfl_xor(ss, 4); ss += __shfl_xor(ss, 8);
          float sc = rsqrtf(ss + EPSF); if (part == 0) sc *= 0.08838834764831845f;
#pragma unroll
          for (int j = 0; j < 8; ++j) o[j] *= sc;
        }
        u32x4 w = {cvtpk(o[0], o[1]), cvtpk(o[2], o[3]), cvtpk(o[4], o[5]), cvtpk(o[6], o[7])};
        bf16_t* dst = part == 0 ? QQ : (part == 1 ? QK : QV);
        *(u32x4*)(dst + (size_t)R * 512 + lane * 8) = w;
        if (part == 1) *(u32x4*)(kl + tl * 512 + lane * 8) = w;
      }
      if (lane < 16) {
        const int q = lane & 7;
        if (lane < 8) { const float da = SM[(size_t)R * 64 + q]; GB[(size_t)R * 16 + q] = -expf(p.dn_a_log[e * 8 + q]) * softplusf(da + p.dn_dt_bias[e * 8 + q]); }
        else { const float db = SM[(size_t)R * 64 + 8 + q]; GB[(size_t)R * 16 + 8 + q] = sigmf(db); }
      }
    }
    __syncthreads();
    {
      const int b = R0 >= TB ? 1 : 0, c = (R0 - b * TB) / 64, half = ((R0 - b * TB) >> 5) & 1; const int h = tid >> 7, dk = tid & 127;
      bf16_t* dst = KT + ((((size_t)b * 4 + h) * NCH + c) * 128 + dk) * 64 + half * 32;
#pragma unroll
      for (int g8 = 0; g8 < 4; ++g8) { unsigned w[4];
#pragma unroll
        for (int j = 0; j < 4; ++j) { const unsigned lo = kl[(g8 * 8 + 2 * j) * 512 + tid], hi2 = kl[(g8 * 8 + 2 * j + 1) * 512 + tid]; w[j] = lo | (hi2 << 16); }
        *(u32x4*)(dst + g8 * 8) = (u32x4){w[0], w[1], w[2], w[3]}; }
    }
    __syncthreads();
  }
}

__device__ __forceinline__ void ph_dn_d1(const P& p, char* lds) {
  const int tid = TIDX(), wid = tid >> 6, lane = tid & 63, r32 = lane & 31, hi = lane >> 5;
  const bf16_t* QQ = (const bf16_t*)(p.ws + OFF_D + D_QQ); const bf16_t* QK = (const bf16_t*)(p.ws + OFF_D + D_QK); const bf16_t* QV = (const bf16_t*)(p.ws + OFF_D + D_QV);
  const float* GB = (const float*)(p.ws + OFF_GB);
  bf16_t* W_ = (bf16_t*)(p.ws + OFF_D + D_W); bf16_t* U_ = (bf16_t*)(p.ws + OFF_HBF); bf16_t* INTRA = (bf16_t*)(p.ws + OFF_D + D_INTRA);
  float* SC = (float*)(p.ws + OFF_SC); float* GLS = (float*)(p.ws + OFF_GL);
  float* KK = (float*)lds; float* QKm = KK + 64 * 65; float* Ad = QKm + 64 * 65; float* Gs = Ad + 2 * 4096; float* Bs = Gs + 128;
  bf16_t* Vs = (bf16_t*)(Bs + 128); bf16_t* Ks = Vs + 64 * 128;
  for (int job = BIDX(); job < 8 * NCH; job += GDIM()) {
    const int b = job / (4 * NCH), h = (job / NCH) & 3, c = job % NCH;
    const size_t Rb = (size_t)b * TB + (size_t)c * 64;
    {
      const int srow = tid >> 4, spc = (tid & 15) * 8;
      const u32x4 v0 = *(const u32x4*)(QV + (Rb + srow) * 512 + h * 128 + spc), v1 = *(const u32x4*)(QV + (Rb + 32 + srow) * 512 + h * 128 + spc);
      const u32x4 k0 = *(const u32x4*)(QK + (Rb + srow) * 512 + h * 128 + spc), k1 = *(const u32x4*)(QK + (Rb + 32 + srow) * 512 + h * 128 + spc);
      *(u32x4*)(Vs + srow * 128 + spc) = v0; *(u32x4*)(Vs + (32 + srow) * 128 + spc) = v1;
      *(u32x4*)(Ks + srow * 128 + spc) = k0; *(u32x4*)(Ks + (32 + srow) * 128 + spc) = k1;
    }
    {
      const int w4 = wid & 3, mi = w4 & 1, ni = w4 >> 1;
      const bf16_t* As = wid < 4 ? QK : QQ;
      const bf16_t* arow = As + (Rb + 32 * mi + r32) * 512 + h * 128 + hi * 8;
      const bf16_t* brow = QK + (Rb + 32 * ni + r32) * 512 + h * 128 + hi * 8;
      f32x16 acc = {}; acc = mma_rows<8>(arow, brow, acc);
      float* dst = wid < 4 ? KK : QKm;
#pragma unroll
      for (int r = 0; r < 16; ++r) dst[(32 * mi + crow(r, hi)) * 65 + 32 * ni + r32] = acc[r];
    }
    if (tid < 128) { const int d = tid >> 6, ip = tid & 63, t = d ? 63 - ip : ip; float g = GB[(Rb + t) * 16 + d * 4 + h]; Bs[tid] = GB[(Rb + t) * 16 + 8 + d * 4 + h];
#pragma unroll
      for (int o = 1; o < 64; o <<= 1) { const float v = __shfl_up(g, o); g += ip >= o ? v : 0.f; }
      Gs[tid] = g; }
    __syncthreads();
    const int n0 = c, n1 = c < 4 ? 3 - c : 135 - c;
    const size_t cj0 = ((size_t)(0 * 2 + b) * 4 + h) * NCH + n0, cj1 = ((size_t)(1 * 2 + b) * 4 + h) * NCH + n1;
    for (int e2 = tid; e2 < 8192; e2 += 512) {
      const int d = e2 >> 12, ip = (e2 >> 6) & 63, jp = e2 & 63; const int i = d ? 63 - ip : ip, j = d ? 63 - jp : jp;
      const float dec = jp <= ip ? __expf(Gs[d * 64 + ip] - Gs[d * 64 + jp]) : 0.f;
      Ad[d * 4096 + ip * 64 + jp] = jp < ip ? Bs[d * 64 + ip] * KK[i * 65 + j] * dec : 0.f;
      const size_t cj = d ? cj1 : cj0;
      INTRA[(cj * 64 + ip) * 64 + jp] = f2bf(QKm[i * 65 + j] * dec);
    }
    if (tid < 128) { const int d = tid >> 6, ip = tid & 63; const size_t cj = d ? cj1 : cj0; const float gi = Gs[tid], gl = Gs[d * 64 + 63];
      SC[(cj * 64 + ip) * 2] = __expf(gi); SC[(cj * 64 + ip) * 2 + 1] = __expf(gl - gi); if (ip == 0) GLS[cj] = __expf(gl); }
    __syncthreads();
    {
      const int d = tid >> 8, cc = tid & 255; const size_t cj = d ? cj1 : cj0;
      int dofs = d * 64, aofs = d * 4096; asm volatile("" : "+v"(dofs), "+v"(aofs));
      float x[64];
      {
        int vofs = cc < 128 ? cc : 64 * 128 + (cc - 128); asm volatile("" : "+v"(vofs));
#pragma unroll
        for (int ip = 0; ip < 64; ++ip) x[ip] = bf2f(Vs[vofs + ip * 128]);
#pragma unroll
        for (int ip = 0; ip < 32; ++ip) { const float a_ = x[ip], b_ = x[63 - ip]; x[ip] = d ? b_ : a_; x[63 - ip] = d ? a_ : b_; }
        if (cc < 128) {
#pragma unroll
          for (int ip = 0; ip < 64; ++ip) x[ip] *= Bs[dofs + ip];
        } else {
#pragma unroll
          for (int ip = 0; ip < 64; ++ip) x[ip] *= Bs[dofs + ip] * __expf(Gs[dofs + ip]);
        }
      }
      const float* Arow = Ad + aofs;
#pragma unroll
      for (int ip = 1; ip < 64; ++ip) {
        float s = 0.f;
#pragma unroll
        for (int j4 = 0; j4 < (ip + 3) / 4; ++j4) { const f32x4 a = *(const f32x4*)(Arow + ip * 64 + 4 * j4);
          s += a[0] * x[4 * j4] + a[1] * x[4 * j4 + 1] + a[2] * x[4 * j4 + 2] + a[3] * x[4 * j4 + 3]; }
        x[ip] -= s;
      }
      bf16_t* dst = cc < 128 ? U_ + cj * 64 * 128 + cc : W_ + cj * 64 * 128 + (cc - 128);
#pragma unroll
      for (int ip = 0; ip < 64; ++ip) dst[ip * 128] = f2bf(x[ip]);
    }
    __syncthreads();
  }
}

typedef _Float16 h16x8 __attribute__((ext_vector_type(8)));
__device__ __forceinline__ void ph_gla_b(const P& p, char* lds, int e) {
  const int tid = TIDX(), wid = tid >> 6, lane = tid & 63;
  const float* SM = (const float*)(p.ws + OFF_SM);
  float* w2S = (float*)lds;
  float* b2S = w2S + 8192;
  for (int i = tid; i < 8192; i += 512) { const int d = i >> 12, hh = (i >> 10) & 3, r = (i >> 6) & 15, j = i & 63; w2S[i] = p.gla_w2[(((size_t)e * 2 + d) * 16 + r) * 256 + hh * 64 + j]; }
  if (tid < 512) b2S[tid] = p.gla_b2[(size_t)e * 512 + tid];
  __syncthreads();
  int jb = 8 * wid; asm volatile("" : "+v"(jb));
  for (int job = GDIM() - 1 - BIDX(); job < 16 * NCH; job += GDIM()) {
    const int n = job % NCH, sq = job / NCH; const int dir = sq >> 3, b = (sq >> 2) & 1, h = sq & 3;
    const int c = dir == 0 ? n : (n < 4 ? 3 - n : 135 - n);
    const size_t row = (size_t)b * TB + (size_t)c * 64 + (dir ? 63 - lane : lane);
    const float* gp = SM + row * 64 + 16 + dir * 16;
    const f32x4 g0 = *(const f32x4*)(gp), g1 = *(const f32x4*)(gp + 4), g2 = *(const f32x4*)(gp + 8), g3 = *(const f32x4*)(gp + 12);
    const float gg_[16] = {g0[0], g0[1], g0[2], g0[3], g1[0], g1[1], g1[2], g1[3], g2[0], g2[1], g2[2], g2[3], g3[0], g3[1], g3[2], g3[3]};
    const float* wb = w2S + (dir * 4 + h) * 1024 + jb; const float* bb2 = b2S + dir * 256 + h * 64 + jb;
    f32x4 sa = *(const f32x4*)(bb2), sb = *(const f32x4*)(bb2 + 4);
#pragma unroll
    for (int r = 0; r < 16; ++r) { const f32x4 wa = *(const f32x4*)(wb + r * 64), wq = *(const f32x4*)(wb + r * 64 + 4); sa += gg_[r] * wa; sb += gg_[r] * wq; }
    float la[8];
#pragma unroll
    for (int jj = 0; jj < 4; ++jj) { const float x0 = sa[jj], x1 = sb[jj];
      la[jj] = (fminf(x0, 0.f) - log1pf(expf(-fabsf(x0)))) * 0.0625f; la[4 + jj] = (fminf(x1, 0.f) - log1pf(expf(-fabsf(x1)))) * 0.0625f; }
#pragma unroll
    for (int o = 1; o < 64; o <<= 1) {
#pragma unroll
      for (int jj = 0; jj < 8; ++jj) { const float v = __shfl_up(la[jj], o); la[jj] += lane >= o ? v : 0.f; }
    }
    h16x8 hv;
#pragma unroll
    for (int jj = 0; jj < 8; ++jj) hv[jj] = (_Float16)la[jj];
    _Float16* dst = (_Float16*)(p.ws + (dir ? OFF_B16_1 : OFF_WC)) + ((((size_t)b * 4 + h) * NCH + n) * 64 + lane) * 64 + jb;
    *(h16x8*)dst = hv;
  }
}

struct DnSet { bf16x8 fa[8]; };
template <int ROLE>
__device__ __forceinline__ void dn_scan_t(const P& p, char* lds, int job) {
  const int tid = TIDX(), wid = tid >> 6, lane = tid & 63, r32 = lane & 31, hi = lane >> 5;
  const int dir = job >> 5, b = (job >> 4) & 1, h = (job >> 2) & 3, n0 = (job & 3) * 32;
  const bf16_t* QQ = (const bf16_t*)(p.ws + OFF_D + D_QQ); const bf16_t* KT = (const bf16_t*)(p.ws + OFF_D + D_KT);
  const bf16_t* W_ = (const bf16_t*)(p.ws + OFF_D + D_W); const bf16_t* U_ = (const bf16_t*)(p.ws + OFF_HBF); const bf16_t* INTRA = (const bf16_t*)(p.ws + OFF_D + D_INTRA);
  const float* SC = (const float*)(p.ws + OFF_SC); const float* GLS = (const float*)(p.ws + OFF_GL);
  bf16_t* DNO = (bf16_t*)(p.ws + OFF_D + D_DNO);
  bf16_t* ST = (bf16_t*)lds; bf16_t* vTa = ST + 32 * 136; bf16_t* vTb = vTa + 32 * 72;
  float* scS = (float*)(vTb + 32 * 72);
  bf16_t* uS = (bf16_t*)(scS + 256);
  bf16_t* inS = uS + 2 * 64 * 40;
  for (int i = tid; i < 32 * 136; i += 512) ST[i] = 0;
  f32x16 accS = {};
  const size_t seq = ((size_t)dir * 2 + b) * 4 + h;
  const int mi = wid & 1, di = wid - 4;
  constexpr int role = ROLE;
  const int tt = tid - 256;
  DnSet fs[3]; float gls[3] = {0.f, 0.f, 0.f};
  u32x4 stU[3], stI0[3]; float stS[3] = {0.f, 0.f, 0.f};
#define DN_CH(n_) const int n__ = (n_); const int c__ = dir == 0 ? n__ : (n__ < 4 ? 3 - n__ : 135 - n__); const size_t Rb__ = (size_t)b * TB + (size_t)c__ * 64; const size_t cj__ = seq * NCH + n__;
#define DN_LOAD(S, GL, n_) do { DN_CH(n_) \
    const int ipl__ = 32 * mi + r32, tl__ = dir ? 63 - ipl__ : ipl__; \
    const bf16_t* b0__ = W_ + cj__ * 8192 + (32 * mi + r32) * 128 + hi * 8; \
    const bf16_t* b1__ = QQ + (Rb__ + tl__) * 512 + h * 128 + hi * 8; \
    const bf16_t* b2__ = KT + ((((size_t)b * 4 + h) * NCH + c__) * 128 + 32 * (wid & 3) + r32) * 64 + hi * 8; \
    const bf16_t* bs__ = role == 0 ? b0__ : (role == 1 ? b1__ : b2__); \
    _Pragma("unroll") for (int ks = 0; ks < 8; ++ks) S.fa[ks] = *(const bf16x8*)(bs__ + ks * 16); \
    GL = GLS[cj__]; } while (0)
#define DN_STAGE_LD(q_, n_) do { DN_CH(n_) (void)Rb__; \
      stU[q_] = *(const u32x4*)(U_ + cj__ * 8192 + ((tid & 255) >> 2) * 128 + n0 + (tid & 3) * 8); \
      stI0[q_] = *(const u32x4*)(INTRA + cj__ * 4096 + (tid >> 3) * 64 + (tid & 7) * 8); \
      stS[q_] = SC[cj__ * 128 + (tid & 127)]; } while (0)
#define DN_STAGE_ST(q_, bf_) do { *(u32x4*)(inS + (bf_) * 4608 + (tid >> 3) * 72 + (tid & 7) * 8) = stI0[q_]; \
      if (ROLE < 2) *(u32x4*)(uS + (bf_) * 2560 + (tid >> 2) * 40 + (tid & 3) * 8) = stU[q_]; \
      if (ROLE == 0) scS[(bf_) * 128 + tid] = stS[q_]; } while (0)
#define DN_STEP(S, GL, n_, bf_) do { DN_CH(n_) (void)cj__; \
    const float* sc__ = scS + (bf_) * 128; \
    if (role < 2) { _Pragma("unroll") for (int r = 0; r < 16; ++r) accS[r] = 0.f; } \
    if (role < 2) { const bf16_t* sb__ = ST + r32 * 136 + hi * 8; \
      _Pragma("unroll") for (int ks = 0; ks < 8; ++ks) accS = MFMA32(S.fa[ks], *(const bf16x8*)(sb__ + ks * 16), accS); \
      if (role == 0) { const bf16_t* us__ = uS + (bf_) * 2560 + r32; \
        _Pragma("unroll") for (int r = 0; r < 16; ++r) { const int ip = 32 * mi + crow(r, hi); const float vn = bf2f(us__[ip * 40]) - accS[r]; \
          vTa[r32 * 72 + ip] = f2bf(vn); const int to = dir ? 63 - ip : ip; vTb[r32 * 72 + to] = f2bf(vn * sc__[ip * 2 + 1]); } } \
      else { _Pragma("unroll") for (int r = 0; r < 16; ++r) accS[r] *= sc__[(32 * mi + crow(r, hi)) * 2]; } } \
    LBAR(); \
    if (role == 1) { const bf16_t* vb__ = vTa + r32 * 72 + hi * 8; const bf16_t* ib__ = inS + (bf_) * 4608 + (32 * mi + r32) * 72 + hi * 8; \
      _Pragma("unroll") for (int ks = 0; ks < 4; ++ks) accS = MFMA32(*(const bf16x8*)(ib__ + ks * 16), *(const bf16x8*)(vb__ + ks * 16), accS); \
      _Pragma("unroll") for (int r = 0; r < 16; ++r) { const int ip = 32 * mi + crow(r, hi), t = dir ? 63 - ip : ip; \
        DNO[((size_t)dir * MROWS + Rb__ + t) * 512 + h * 128 + n0 + r32] = f2bf(accS[r]); } } \
    else if (role == 2) { const bf16_t* vb__ = vTb + r32 * 72 + hi * 8; \
      _Pragma("unroll") for (int r = 0; r < 16; ++r) accS[r] *= GL; \
      _Pragma("unroll") for (int ks = 0; ks < 4; ++ks) accS = MFMA32(S.fa[ks], *(const bf16x8*)(vb__ + ks * 16), accS); \
      _Pragma("unroll") for (int r = 0; r < 16; ++r) ST[r32 * 136 + 32 * di + crow(r, hi)] = f2bf(accS[r]); } \
    LBAR(); } while (0)
  DN_STAGE_LD(0, 0); DN_STAGE_ST(0, 0); DN_STAGE_LD(1, 1); DN_STAGE_LD(2, 2);
  DN_LOAD(fs[0], gls[0], 0); DN_LOAD(fs[1], gls[1], 1);
  __syncthreads();
  for (int nb6 = 0; nb6 < NCH; nb6 += 6) {
#pragma unroll
    for (int k = 0; k < 6; ++k) {
      const int n = nb6 + k; const int n2 = n + 2 < NCH ? n + 2 : NCH - 1; const int n3 = n + 3 < NCH ? n + 3 : NCH - 1;
      DN_STAGE_ST((k + 1) % 3, (k + 1) & 1);
      DN_STAGE_LD(k % 3, n3);
      DN_LOAD(fs[(k + 2) % 3], gls[(k + 2) % 3], n2);
      DN_STEP(fs[k % 3], gls[k % 3], n, k & 1);
    }
  }
#undef DN_CH
#undef DN_LOAD
#undef DN_STAGE_LD
#undef DN_STAGE_ST
#undef DN_STEP
}

__device__ __forceinline__ void dn_scan(const P& p, char* lds, int job) {
  const int wid = TIDX() >> 6;
  if (wid < 2) dn_scan_t<0>(p, lds, job); else if (wid < 4) dn_scan_t<1>(p, lds, job); else dn_scan_t<2>(p, lds, job);
}

DI float fast_logsig(float s) { return fminf(s, 0.f) - __logf(1.f + __expf(-fabsf(s))); }
struct GlaRegs { h16x8 ba, bb; bf16x8 qa, qb, ka, kb, v8; };
template <int ROLE>
__device__ __forceinline__ void gla_scan_t(const P& p, char* lds, int job, int e) {
  const int tid = TIDX(), wid = tid >> 6, lane = tid & 63, r32 = lane & 31, hi = lane >> 5;
  const int dir = job >> 5, b = (job >> 4) & 1, h = (job >> 2) & 3, n0 = (job & 3) * 32;
  const bf16_t* P2 = (const bf16_t*)(p.ws + OFF_D + D_P2); const float* SM = (const float*)(p.ws + OFF_SM);
  bf16_t* GLAO = (bf16_t*)(p.ws + OFF_D + D_GLAO);
  const _Float16* B16 = (const _Float16*)(p.ws + (dir ? OFF_B16_1 : OFF_WC));
  float* w2S = (float*)lds; float* b2S = w2S + 1024; float* aLb = b2S + 64;
  bf16_t* ops = (bf16_t*)(aLb + 128);
  constexpr int OPB = (4 * 64 + 32) * 72;
  bf16_t* attp = ops + 2 * OPB;
  bf16_t* STb = attp + 2 * 32 * 72;
  for (int i = tid; i < 2 * 32 * 72; i += 512) STb[i] = 0;
  f32x16 accS = {};
  __syncthreads();
  GlaRegs RG[3];
  int jb0 = 16 * (wid & 3); asm volatile("" : "+v"(jb0));
  int vtb0 = 8 * (wid & 3) * 72 + lane; asm volatile("" : "+v"(vtb0));
#define GLA_LOAD(R, n_) do { const int n__ = (n_) < NCH ? (n_) : NCH - 1; const int c__ = dir == 0 ? n__ : (n__ < 4 ? 3 - n__ : 135 - n__); const size_t row__ = (size_t)b * TB + (size_t)c__ * 64 + (dir ? 63 - lane : lane); \
    const _Float16* bp__ = B16 + ((((size_t)b * 4 + h) * NCH + n__) * 64 + lane) * 64 + 16 * (wid & 3); R.ba = *(const h16x8*)(bp__); R.bb = *(const h16x8*)(bp__ + 8); \
    const bf16_t* pr__ = P2 + row__ * 2048; R.qa = *(const bf16x8*)(pr__ + 512 + h * 64 + 16 * (wid & 3)); R.qb = *(const bf16x8*)(pr__ + 512 + h * 64 + 16 * (wid & 3) + 8); \
    R.ka = *(const bf16x8*)(pr__ + 768 + h * 64 + 16 * (wid & 3)); R.kb = *(const bf16x8*)(pr__ + 768 + h * 64 + 16 * (wid & 3) + 8); R.v8 = *(const bf16x8*)(pr__ + 1024 + h * 128 + n0 + 8 * (wid & 3)); } while (0)
#define GLA_HALF(R, BV, QV, KV, jb) do { \
    float eqe[8], eke[8], eqi[8]; \
    _Pragma("unroll") for (int jj = 0; jj < 8; ++jj) { const int j = (jb) + jj; const float bb = (float)BV[jj]; const float bm = __int_as_float(__builtin_amdgcn_readlane(__float_as_int(bb), 32)), bl = __int_as_float(__builtin_amdgcn_readlane(__float_as_int(bb), 63)); \
      const float q_ = bf2f((bf16_t)QV[jj]) * 0.125f, k_ = bf2f((bf16_t)KV[jj]); \
      eqe[jj] = q_ * __expf(bb - bm); eke[jj] = k_ * __expf(bm - bb); eqi[jj] = q_ * __expf(bb); ksT_[j * 72 + lane] = f2bf(k_ * __expf(bl - bb)); if (lane == 63) aL_[j] = __expf(bl); } \
    *(u32x4*)(qe_ + lane * 72 + (jb)) = (u32x4){cvtpk(eqe[0], eqe[1]), cvtpk(eqe[2], eqe[3]), cvtpk(eqe[4], eqe[5]), cvtpk(eqe[6], eqe[7])}; \
    *(u32x4*)(ke_ + lane * 72 + (jb)) = (u32x4){cvtpk(eke[0], eke[1]), cvtpk(eke[2], eke[3]), cvtpk(eke[4], eke[5]), cvtpk(eke[6], eke[7])}; \
    *(u32x4*)(qi_ + lane * 72 + (jb)) = (u32x4){cvtpk(eqi[0], eqi[1]), cvtpk(eqi[2], eqi[3]), cvtpk(eqi[4], eqi[5]), cvtpk(eqi[6], eqi[7])}; } while (0)
#define GLA_PREP(R, bf_) do { bf16_t* qe_ = ops + (bf_) * OPB; bf16_t* ke_ = qe_ + 64 * 72; bf16_t* qi_ = ke_ + 64 * 72; bf16_t* ksT_ = qi_ + 64 * 72; bf16_t* vT_ = ksT_ + 64 * 72; float* aL_ = aLb + (bf_) * 64; \
    GLA_HALF(R, R.ba, R.qa, R.ka, jb0); GLA_HALF(R, R.bb, R.qb, R.kb, jb0 + 8); \
    _Pragma("unroll") for (int q_ = 0; q_ < 8; ++q_) vT_[vtb0 + q_ * 72] = (bf16_t)R.v8[q_]; } while (0)
#define GLA_MMA(n_, bf_) do { const int nq__ = (n_); const int bf = (bf_); \
      const bf16_t* qe_ = ops + bf * OPB; const bf16_t* ke_ = qe_ + 64 * 72; const bf16_t* qi_ = ke_ + 64 * 72; const bf16_t* ksT_ = qi_ + 64 * 72; const bf16_t* vT_ = ksT_ + 64 * 72; const float* aL_ = aLb + bf * 64; \
      const bf16_t* STr = STb + bf * 32 * 72; bf16_t* STw = STb + (bf ^ 1) * 32 * 72; \
      if (ROLE == 1) { \
        const int mi = wid - 4; bf16_t* attw = attp + mi * 32 * 72; \
        const int c = dir == 0 ? nq__ : (nq__ < 4 ? 3 - nq__ : 135 - nq__); const size_t Rb = (size_t)b * TB + (size_t)c * 64; \
        f32x16 acc = {}; acc = mma_rows<4>(qi_ + (32 * mi + r32) * 72 + hi * 8, STr + r32 * 72 + hi * 8, acc); \
        { f32x16 a0 = {}; a0 = mma_rows<4>(qe_ + (32 * mi + r32) * 72 + hi * 8, ke_ + r32 * 72 + hi * 8, a0); \
          _Pragma("unroll") for (int r = 0; r < 16; ++r) { const int ipl = crow(r, hi); attw[ipl * 72 + r32] = f2bf((mi == 1 || r32 <= ipl) ? a0[r] : 0.f); } \
          f32x16 a1 = {}; if (mi == 1) a1 = mma_rows<4>(qe_ + (32 + r32) * 72 + hi * 8, ke_ + (32 + r32) * 72 + hi * 8, a1); \
          _Pragma("unroll") for (int r = 0; r < 16; ++r) { const int ipl = crow(r, hi); attw[ipl * 72 + 32 + r32] = f2bf((mi == 1 && r32 <= ipl) ? a1[r] : 0.f); } } \
        asm volatile("s_waitcnt lgkmcnt(0)" ::: "memory"); \
        acc = mma_rows<4>(attw + r32 * 72 + hi * 8, vT_ + r32 * 72 + hi * 8, acc); \
        _Pragma("unroll") for (int r = 0; r < 16; ++r) { const int ip = 32 * mi + crow(r, hi), t = dir ? 63 - ip : ip; \
          GLAO[((size_t)dir * MROWS + Rb + t) * 512 + h * 128 + n0 + r32] = f2bf(acc[r]); } \
      } else { \
        const int di = wid - 6; \
        _Pragma("unroll") for (int r = 0; r < 16; ++r) accS[r] *= aL_[32 * di + crow(r, hi)]; \
        accS = mma_rows<4>(ksT_ + (32 * di + r32) * 72 + hi * 8, vT_ + r32 * 72 + hi * 8, accS); \
        _Pragma("unroll") for (int r = 0; r < 16; ++r) STw[r32 * 72 + 32 * di + crow(r, hi)] = f2bf(accS[r]); \
      } } while (0)
  GLA_LOAD(RG[0], 0);
  if (ROLE == 0) { GLA_PREP(RG[0], 0); }
  GLA_LOAD(RG[1], 1); GLA_LOAD(RG[2], 2); GLA_LOAD(RG[0], 3);
  LBAR();
  for (int nb6 = 0; nb6 < NCH; nb6 += 6) {
#pragma unroll
    for (int k = 0; k < 6; ++k) {
      const int n = nb6 + k;
      if (ROLE == 0) { if (n + 1 < NCH) { GLA_PREP(RG[(k + 1) % 3], (k + 1) & 1); } } else { GLA_MMA(n, k & 1); }
      GLA_LOAD(RG[(k + 1) % 3], n + 4);
      LBAR();
    }
  }
#undef GLA_MMA
#undef GLA_LOAD
#undef GLA_HALF
#undef GLA_PREP
}

__device__ __forceinline__ void gla_scan(const P& p, char* lds, int job, int e) {
  const int wid = TIDX() >> 6;
  if (wid < 4) gla_scan_t<0>(p, lds, job, e); else if (wid < 6) gla_scan_t<1>(p, lds, job, e); else gla_scan_t<2>(p, lds, job, e);
}

__device__ __forceinline__ void ph_merge(const P& p, int e) {
  const int tid = TIDX(), wid = tid >> 6, lane = tid & 63, l16 = lane & 15, sub = lane >> 4;
  const bf16_t* DNO = (const bf16_t*)(p.ws + OFF_D + D_DNO); const bf16_t* GLAO = (const bf16_t*)(p.ws + OFF_D + D_GLAO);
  const bf16_t* P2 = (const bf16_t*)(p.ws + OFF_D + D_P2); bf16_t* hb = (bf16_t*)(p.ws + OFF_HBF);
  f32x8 nwd = *(const f32x8*)(p.dn_norm + e * 128 + l16 * 8), nwg = *(const f32x8*)(p.gla_norm + e * 128 + l16 * 8);
  for (int R4 = (BIDX() * 8 + wid) * 4; R4 < MROWS; R4 += GDIM() * 32) {
    const size_t R = R4 + sub;
    bf16x8 a[8], bq[8], zz[8];
#pragma unroll
    for (int g = 0; g < 8; ++g) { const bf16_t* src = g < 4 ? DNO : GLAO; const int hc = (g & 3) * 128 + l16 * 8;
      a[g] = *(const bf16x8*)(src + R * 512 + hc); bq[g] = *(const bf16x8*)(src + ((size_t)MROWS + R) * 512 + hc);
      zz[g] = *(const bf16x8*)(P2 + R * 2048 + (g < 4 ? 0 : 1536) + hc); }
#pragma unroll
    for (int g = 0; g < 8; ++g) {
      float v[8]; float ss = 0.f;
#pragma unroll
      for (int j = 0; j < 8; ++j) { v[j] = bf2f((bf16_t)a[g][j]) + bf2f((bf16_t)bq[g][j]); ss += v[j] * v[j]; }
      ss += __shfl_xor(ss, 1); ss += __shfl_xor(ss, 2); ss += __shfl_xor(ss, 4); ss += __shfl_xor(ss, 8);
      const float rs = rsqrtf(ss * (1.f / 128.f) + EPSF);
      float o[8];
#pragma unroll
      for (int j = 0; j < 8; ++j) o[j] = v[j] * rs * (g < 4 ? nwd[j] : nwg[j]) * siluf(bf2f((bf16_t)zz[g][j]));
      *(u32x4*)(hb + R * 1024 + g * 128 + l16 * 8) = (u32x4){cvtpk(o[0], o[1]), cvtpk(o[2], o[3]), cvtpk(o[4], o[5]), cvtpk(o[6], o[7])};
    }
  }
}

DI float silu_fast(float x) { return x / (1.f + __expf(-x)); }
__device__ __forceinline__ void ph_ffnact(const P& p, int L) {
  bf16_t* U = (bf16_t*)(p.ws + OFF_D);
  const float* cw = p.ffn_conv + (size_t)L * 3 * DFF;
  const size_t items = (size_t)MROWS * 352, stride = (size_t)GDIM() * 512;
  for (size_t it0 = (size_t)BIDX() * 512 + TIDX(); it0 < items; it0 += 2 * stride) {
    bf16x8 zc[2], zp[2], zn[2], vv[2]; int Rr[2], cc[2]; bool ok[2];
#pragma unroll
    for (int q = 0; q < 2; ++q) {
      size_t it = it0 + q * stride; ok[q] = it < items; if (!ok[q]) it = it0;
      const int R = (int)(it / 352), c0 = (int)(it % 352) * 8; const int b = R >= TB ? 1 : 0, pp = R - b * TB;
      const bool hasp = !(pp == 0 || pp == CTXL), hasn = !(pp == CTXL - 1 || pp == TB - 1);
      Rr[q] = R; cc[q] = c0;
      zc[q] = *(const bf16x8*)(U + (size_t)R * 5632 + c0);
      zp[q] = *(const bf16x8*)(U + (size_t)(hasp ? R - 1 : R) * 5632 + c0);
      zn[q] = *(const bf16x8*)(U + (size_t)(hasn ? R + 1 : R) * 5632 + c0);
      vv[q] = *(const bf16x8*)(U + (size_t)R * 5632 + DFF + c0);
      if (!hasp) zp[q] = (bf16x8){0, 0, 0, 0, 0, 0, 0, 0};
      if (!hasn) zn[q] = (bf16x8){0, 0, 0, 0, 0, 0, 0, 0};
    }
#pragma unroll
    for (int q = 0; q < 2; ++q) {
      const int c0 = cc[q];
      const f32x8 w0 = *(const f32x8*)(cw + c0), w1 = *(const f32x8*)(cw + DFF + c0), w2 = *(const f32x8*)(cw + 2 * DFF + c0);
      float o[8];
#pragma unroll
      for (int j = 0; j < 8; ++j) { const float a = bf2f((bf16_t)zp[q][j]) * w0[j] + bf2f((bf16_t)zc[q][j]) * w1[j] + bf2f((bf16_t)zn[q][j]) * w2[j];
        o[j] = silu_fast(a) * bf2f((bf16_t)vv[q][j]); }
      if (ok[q]) *(u32x4*)(U + (size_t)Rr[q] * 5632 + DFF + c0) = (u32x4){cvtpk(o[0], o[1]), cvtpk(o[2], o[3]), cvtpk(o[4], o[5]), cvtpk(o[6], o[7])};
    }
  }
}

__device__ __forceinline__ void ph_qknorm(const P& p, char* lds, int o) {
  const int tid = TIDX(), wid = tid >> 6, lane = tid & 63, l16 = lane & 15, sub = lane >> 4;
  bf16_t* QKV = (bf16_t*)(p.ws + OFF_D);
  float* tab = (float*)lds;
  for (int i = tid; i < 4096; i += 512) { const int pos = i >> 5, f = i & 31; const float ang = (float)pos * powf(10000.f, -(float)f / 32.f); tab[2 * i] = cosf(ang); tab[2 * i + 1] = sinf(ang); }
  __syncthreads();
  const f32x8 qn = *(const f32x8*)(p.att_q_norm + o * 128 + l16 * 8), kn = *(const f32x8*)(p.att_k_norm + o * 128 + l16 * 8);
  const int f0 = (l16 & 3) * 8;
  for (int R4 = (BIDX() * 8 + wid) * 4; R4 < MROWS; R4 += GDIM() * 32) {
    const int R = R4 + sub; const int b = R >= TB ? 1 : 0, pp = R - b * TB; const bool lat = pp >= CTXL; const int t = lat ? pp - CTXL : 0;
    const int pos = (l16 < 8) ? (t >> 6) : (t & 63);
    bf16_t* base = QKV + (size_t)R * 1536 + l16 * 8;
    bf16x8 x[10];
#pragma unroll
    for (int hd = 0; hd < 10; ++hd) x[hd] = *(const bf16x8*)(base + hd * 128);
    float cs[8], sn[8];
#pragma unroll
    for (int j = 0; j < 8; ++j) { const float2 t2 = *(const float2*)(tab + 2 * (pos * 32 + f0 + j)); cs[j] = lat ? t2.x : 1.f; sn[j] = lat ? t2.y : 0.f; }
#pragma unroll
    for (int hd = 0; hd < 10; ++hd) {
      float v[8]; float ss = 0.f;
#pragma unroll
      for (int j = 0; j < 8; ++j) { v[j] = bf2f((bf16_t)x[hd][j]); ss += v[j] * v[j]; }
      ss += __shfl_xor(ss, 1); ss += __shfl_xor(ss, 2); ss += __shfl_xor(ss, 4); ss += __shfl_xor(ss, 8);
      const float rs = rsqrtf(ss * (1.f / 128.f) + EPSF);
      float ov[8];
#pragma unroll
      for (int j = 0; j < 8; ++j) { v[j] = v[j] * rs * (hd < 8 ? qn[j] : kn[j]); const float pr = __shfl_xor(v[j], 4);
        ov[j] = (l16 & 4) ? (pr * sn[j] + v[j] * cs[j]) : (v[j] * cs[j] - pr * sn[j]); }
      *(u32x4*)(base + hd * 128) = (u32x4){cvtpk(ov[0], ov[1]), cvtpk(ov[2], ov[3]), cvtpk(ov[4], ov[5]), cvtpk(ov[6], ov[7])};
    }
  }
}

__device__ __forceinline__ void qk_fused(const P& p, char* lds, int o) {
  const int tid = TIDX(), l16 = tid & 15, grp = tid >> 4;
  bf16_t* QKV = (bf16_t*)(p.ws + OFF_D);
  float* tab = (float*)lds;
  for (int i = tid; i < 4096; i += 512) { const int pos = i >> 5, f = i & 31; const float ang = (float)pos * powf(10000.f, -(float)f / 32.f); tab[2 * i] = cosf(ang); tab[2 * i + 1] = sinf(ang); }
  asm volatile("s_waitcnt vmcnt(0)" ::: "memory");
  __syncthreads();
  const int f0 = (l16 & 3) * 8;
  pg8::SchedX S; S.so.init(MROWS, 1536, GDIM(), BIDX()); S.mode = 0;
  pg8::Unit u;
  for (int ui = 0; S.next(ui, u); ++ui) {
    if (u.pn >= 5) continue;
    const f32x8 nw = *(const f32x8*)((u.pn < 4 ? p.att_q_norm : p.att_k_norm) + o * 128 + l16 * 8);
    for (int it0 = grp; it0 < 512; it0 += 128) {
      bf16x8 x[4]; bf16_t* base[4]; int pos[4]; bool lat[4];
#pragma unroll
      for (int q = 0; q < 4; ++q) { const int it = it0 + q * 32;
        const int R = u.pm * 256 + (it >> 1); const int b = R >= TB ? 1 : 0, pp = R - b * TB; lat[q] = pp >= CTXL; const int t = lat[q] ? pp - CTXL : 0;
        pos[q] = (l16 < 8) ? (t >> 6) : (t & 63);
        base[q] = QKV + (size_t)R * 1536 + u.pn * 256 + (it & 1) * 128 + l16 * 8; x[q] = *(const bf16x8*)base[q]; }
#pragma unroll
      for (int q = 0; q < 4; ++q) {
        float v[8]; float ss = 0.f;
#pragma unroll
        for (int j = 0; j < 8; ++j) { v[j] = bf2f((bf16_t)x[q][j]); ss += v[j] * v[j]; }
        ss += __shfl_xor(ss, 1); ss += __shfl_xor(ss, 2); ss += __shfl_xor(ss, 4); ss += __shfl_xor(ss, 8);
        const float rs = rsqrtf(ss * (1.f / 128.f) + EPSF);
        float ov[8];
#pragma unroll
        for (int j = 0; j < 8; ++j) { const float2 t2 = *(const float2*)(tab + 2 * (pos[q] * 32 + f0 + j)); const float cs = lat[q] ? t2.x : 1.f, sn = lat[q] ? t2.y : 0.f;
          v[j] = v[j] * rs * nw[j]; const float pr = __shfl_xor(v[j], 4);
          ov[j] = (l16 & 4) ? (pr * sn + v[j] * cs) : (v[j] * cs - pr * sn); }
        *(u32x4*)base[q] = (u32x4){cvtpk(ov[0], ov[1]), cvtpk(ov[2], ov[3]), cvtpk(ov[4], ov[5]), cvtpk(ov[6], ov[7])};
      }
    }
  }
}

namespace at {
constexpr int D = 128, NW = 8, QBLK = 32, KVBLK = 64;
constexpr float SCALE = 0.088388347648318440f, THR = 8.f;
constexpr int LDQ = 1536, LDK = 1536, LDO = 1024;
constexpr size_t SHM_V = KVBLK * D * 2, SHM_K = KVBLK * D * 2;
#define KSWZ(row, colB) ((row) * 256 + ((colB) ^ (((row) & 7) << 4)))
#define SBAR() __builtin_amdgcn_sched_barrier(0)
DI void partialSM(f32x16& p0, f32x16& p1, float& m_reg, float& mn, float& alpha) {
  constexpr float C = SCALE * 1.4426950408889634f;
  float pmax = p0[0]; for (int r = 1; r < 16; ++r) pmax = fmaxf(pmax, p0[r]); for (int r = 0; r < 16; ++r) pmax = fmaxf(pmax, p1[r]);
  { auto rr = __builtin_amdgcn_permlane32_swap(__float_as_uint(pmax), __float_as_uint(pmax), false, false);
    pmax = fmaxf(__uint_as_float(rr[0]), __uint_as_float(rr[1])); }
  if (__builtin_expect(__all(pmax - m_reg <= THR / SCALE), 1)) { mn = m_reg; alpha = 1.f; }
  else { mn = fmaxf(m_reg, pmax); alpha = __builtin_amdgcn_exp2f((m_reg - mn) * C); m_reg = mn; }
  float mnC = -mn * C;
  for (int r = 0; r < 16; ++r) p0[r] = fmaf(p0[r], C, mnC); for (int r = 0; r < 16; ++r) p1[r] = fmaf(p1[r], C, mnC);
  for (int r = 0; r < 16; ++r) p0[r] = __builtin_amdgcn_exp2f(p0[r]);
}
DI void finishSM(f32x16& p0, f32x16& p1, float alpha, float& l_reg, bf16x8& pa0, bf16x8& pa1, bf16x8& pa2, bf16x8& pa3) {
  for (int r = 0; r < 16; ++r) p1[r] = __builtin_amdgcn_exp2f(p1[r]);
  float ps = 0; for (int r = 0; r < 16; ++r) ps += p0[r]; for (int r = 0; r < 16; ++r) ps += p1[r];
  { auto rr = __builtin_amdgcn_permlane32_swap(__float_as_uint(ps), __float_as_uint(ps), false, false);
    ps = __uint_as_float(rr[0]) + __uint_as_float(rr[1]); }
  l_reg = l_reg * alpha + ps;
#define PK4(PP, BASE, OUT) do { unsigned a0 = cvtpk(PP[BASE + 0], PP[BASE + 1]), a1 = cvtpk(PP[BASE + 2], PP[BASE + 3]);   \
    unsigned b0 = cvtpk(PP[BASE + 4], PP[BASE + 5]), b1 = cvtpk(PP[BASE + 6], PP[BASE + 7]);                              \
    auto r0 = __builtin_amdgcn_permlane32_swap(a0, b0, false, false); auto r1 = __builtin_amdgcn_permlane32_swap(a1, b1, false, false); \
    u32x4 w = {r0[0], r1[0], r0[1], r1[1]}; OUT = *reinterpret_cast<bf16x8*>(&w); } while (0)
  PK4(p0, 0, pa0); PK4(p0, 8, pa1); PK4(p1, 0, pa2); PK4(p1, 8, pa3);
#undef PK4
}
DI void qkt(f32x16& p0, f32x16& p1, const bf16_t* Ks, const bf16x8* qr, int r32, int hi) {
  p0 = f32x16{}; p1 = f32x16{};
  for (int d0 = 0; d0 < 8; ++d0) { int cb = (d0 * 16 + hi * 8) * 2;
    bf16x8 b0 = *reinterpret_cast<const bf16x8*>((const char*)Ks + KSWZ(r32, cb));
    bf16x8 b1 = *reinterpret_cast<const bf16x8*>((const char*)Ks + KSWZ(32 + r32, cb));
    p0 = MFMA32(b0, qr[d0], p0);
    p1 = MFMA32(b1, qr[d0], p1); }
}
DI int v_st(int k, int c) { const int kk = (k & ~0xC) | ((k & 4) << 1) | ((k & 8) >> 1); return ((kk >> 3) * 4 + (c >> 5)) * 512 + ((kk & 7) * 32 + (c & 31)) * 2; }
DI int v_rd_base(int lane) { return ((lane & 3) << 3) | (((lane >> 2) & 3) << 6) | (((lane >> 4) & 1) << 5) | (((lane >> 5) & 1) << 8); }
constexpr int v_rd_off(int d0, int ks, int half) { return d0 * 512 + ks * 4096 + half * 2048; }
template <int OFF> DI s16x4 tr_read(int vb) {
  s16x4 r; asm volatile("ds_read_b64_tr_b16 %0, %1 offset:%2" : "=&v"(r) : "v"(vb), "i"(OFF) : "memory"); return r;
}
template <int D0> DI void pv_one(f32x16& od, int vb, bf16x8 pa0, bf16x8 pa1, bf16x8 pa2, bf16x8 pa3) {
  const s16x4 l0 = tr_read<v_rd_off(D0, 0, 0)>(vb), h0 = tr_read<v_rd_off(D0, 0, 1)>(vb), l1 = tr_read<v_rd_off(D0, 1, 0)>(vb), h1 = tr_read<v_rd_off(D0, 1, 1)>(vb);
  const s16x4 l2 = tr_read<v_rd_off(D0, 2, 0)>(vb), h2 = tr_read<v_rd_off(D0, 2, 1)>(vb), l3 = tr_read<v_rd_off(D0, 3, 0)>(vb), h3 = tr_read<v_rd_off(D0, 3, 1)>(vb);
  asm volatile("s_waitcnt lgkmcnt(0)" ::: "memory"); SBAR();
#define PK(Lx, Hx) (bf16x8){Lx[0], Lx[1], Lx[2], Lx[3], Hx[0], Hx[1], Hx[2], Hx[3]}
  od = MFMA32(pa0, PK(l0, h0), od);
  od = MFMA32(pa1, PK(l1, h1), od);
  od = MFMA32(pa2, PK(l2, h2), od);
  od = MFMA32(pa3, PK(l3, h3), od);
#undef PK
}
DI void pv_d0(f32x16* o, int vb, bf16x8 pa0, bf16x8 pa1, bf16x8 pa2, bf16x8 pa3) {
  pv_one<0>(o[0], vb, pa0, pa1, pa2, pa3); pv_one<1>(o[1], vb, pa0, pa1, pa2, pa3); pv_one<2>(o[2], vb, pa0, pa1, pa2, pa3); pv_one<3>(o[3], vb, pa0, pa1, pa2, pa3);
}
DI void attn_dense_body(const bf16_t* __restrict__ Qb, const bf16_t* __restrict__ Kh, const bf16_t* __restrict__ Vh, bf16_t* __restrict__ Ob, int seq, char* lds) {
  const int tid = TIDX(), wid = tid >> 6, lane = tid & 63, r32 = lane & 31, hi = lane >> 5;
  bf16_t* V_lds = (bf16_t*)lds; bf16_t* K_lds = (bf16_t*)(lds + 2 * SHM_V);
  float* ws = (float*)(lds + 2 * SHM_V + 2 * SHM_K) + wid * 64; float* li_l = ws; float* al_l = ws + 32;
  float m_reg = -1e30f, l_reg = 0; f32x16 o[4] = {}; bf16x8 qr[8];
  const bf16_t* Qw = Qb + (long)(wid * QBLK + r32) * LDQ + hi * 8;
#pragma unroll
  for (int d0 = 0; d0 < 8; ++d0) qr[d0] = *reinterpret_cast<const bf16x8*>(Qw + d0 * 16);
  const int sr = tid >> 4, sc = (tid & 15) * 8, vst0 = v_st(sr, sc), vst1 = v_st(32 + sr, sc);
  const int vb0 = (int)(uintptr_t)V_lds + v_rd_base(lane);
  struct { bf16x8 vs0, vs1, ks0, ks1; } sr_[2];
#define SLOAD(i, k0) do { sr_[i].vs0 = *(const bf16x8*)(&Vh[(long)((k0) + sr) * LDK + sc]); sr_[i].vs1 = *(const bf16x8*)(&Vh[(long)((k0) + 32 + sr) * LDK + sc]); \
    sr_[i].ks0 = *(const bf16x8*)(&Kh[(long)((k0) + sr) * LDK + sc]); sr_[i].ks1 = *(const bf16x8*)(&Kh[(long)((k0) + 32 + sr) * LDK + sc]); } while (0)
#define SWRITE(bq, i) do { *(bf16x8*)((char*)V_lds + (bq) * SHM_V + vst0) = sr_[i].vs0;          \
    *(bf16x8*)((char*)V_lds + (bq) * SHM_V + vst1) = sr_[i].vs1; int kc = sc * 2;               \
    *(bf16x8*)((char*)K_lds + (bq) * SHM_K + KSWZ(sr, kc)) = sr_[i].ks0;                       \
    *(bf16x8*)((char*)K_lds + (bq) * SHM_K + KSWZ(32 + sr, kc)) = sr_[i].ks1; } while (0)
#define SWAIT() asm volatile("s_waitcnt vmcnt(4)" ::: "memory")
#define RESC(a) do { if (__any((a) < 1.f)) { if (hi == 0) al_l[r32] = (a); asm volatile("s_waitcnt lgkmcnt(0)" ::: "memory"); \
    for (int d = 0; d < 4; ++d) for (int r = 0; r < 16; ++r) o[d][r] *= al_l[crow(r, hi)]; } } while (0)
  f32x16 pA0, pA1, pB0, pB1; float mnA, mnB, alA, alB; bf16x8 pa0, pa1, pa2, pa3; const int NT = seq / KVBLK;
  constexpr int SE = 0, SO = 1;
  SLOAD(SE, 0); asm volatile("s_waitcnt vmcnt(0)" ::: "memory"); SWRITE(0, SE); __syncthreads();
  qkt(pA0, pA1, K_lds, qr, r32, hi); partialSM(pA0, pA1, m_reg, mnA, alA);
  SLOAD(SO, KVBLK); if (2 < NT) SLOAD(SE, 2 * KVBLK);
  SWAIT(); SWRITE(1, SO); __syncthreads();
  for (int j = 1; j + 1 < NT; j += 2) {
    SBAR(); qkt(pB0, pB1, (bf16_t*)((char*)K_lds + SHM_K), qr, r32, hi);
    finishSM(pA0, pA1, alA, l_reg, pa0, pa1, pa2, pa3); SBAR();
    SLOAD(SO, (j + 2) * KVBLK); SBAR();
    pv_d0(o, vb0, pa0, pa1, pa2, pa3); partialSM(pB0, pB1, m_reg, mnB, alB);
    __syncthreads(); SWAIT(); SWRITE(0, SE);
    RESC(alB); __syncthreads();
    SBAR(); qkt(pA0, pA1, K_lds, qr, r32, hi);
    finishSM(pB0, pB1, alB, l_reg, pa0, pa1, pa2, pa3); SBAR();
    if (j + 3 < NT) SLOAD(SE, (j + 3) * KVBLK); SBAR();
    pv_d0(o, vb0 + (int)SHM_V, pa0, pa1, pa2, pa3); partialSM(pA0, pA1, m_reg, mnA, alA);
    __syncthreads(); SWAIT(); SWRITE(1, SO);
    RESC(alA); __syncthreads();
  }
  SBAR(); qkt(pB0, pB1, (bf16_t*)((char*)K_lds + SHM_K), qr, r32, hi);
  finishSM(pA0, pA1, alA, l_reg, pa0, pa1, pa2, pa3); SBAR();
  pv_d0(o, vb0, pa0, pa1, pa2, pa3); partialSM(pB0, pB1, m_reg, mnB, alB);
  __syncthreads(); RESC(alB);
  finishSM(pB0, pB1, alB, l_reg, pa0, pa1, pa2, pa3); SBAR();
  pv_d0(o, vb0 + (int)SHM_V, pa0, pa1, pa2, pa3);
  if (hi == 0) li_l[r32] = l_reg; asm volatile("s_waitcnt lgkmcnt(0)" ::: "memory");
  float rli[16];
#pragma unroll
  for (int r = 0; r < 16; ++r) rli[r] = __builtin_amdgcn_rcpf(li_l[crow(r, hi)]);
  bf16_t* Ow = Ob + (long)(wid * QBLK) * LDO;
#pragma unroll
  for (int r = 0; r < 16; ++r) { int orow = crow(r, hi);
    for (int d0 = 0; d0 < 4; ++d0) Ow[(long)orow * LDO + d0 * 32 + r32] = f2bf(o[d0][r] * rli[r]); }
#undef SLOAD
#undef SWRITE
#undef SWAIT
#undef RESC
}
}

__device__ __forceinline__ void ph_attn(const P& p, char* lds, bool need_ctx) {
  const bf16_t* QKV = (const bf16_t*)(p.ws + OFF_D); bf16_t* hb = (bf16_t*)(p.ws + OFF_HBF);
  const int nunits = need_ctx ? 528 : 512;
  for (int u = BIDX(); u < nunits; u += GDIM()) {
    int b, h, seq; size_t qrow;
    if (u < 512) { b = u >> 8; const int rem = u & 255; h = rem >> 5; qrow = (size_t)b * TB + CTXL + (size_t)(rem & 31) * 256; seq = TB; }
    else { const int uu = u - 512; b = uu >> 3; h = uu & 7; qrow = (size_t)b * TB; seq = CTXL; }
    const int kvh = h >> 2;
    const bf16_t* Kh = QKV + (size_t)b * TB * 1536 + 1024 + kvh * 128;
    const bf16_t* Vh = QKV + (size_t)b * TB * 1536 + 1280 + kvh * 128;
    at::attn_dense_body(QKV + qrow * 1536 + h * 128, Kh, Vh, hb + qrow * 1024 + h * 128, seq, lds);
    __syncthreads();
  }
}

__device__ __forceinline__ void ph_final(const P& p) {
  const int tid = TIDX(), wid = tid >> 6, lane = tid & 63;
  const float* xr = (const float*)(p.ws + OFF_XRES);
  for (int q = BIDX() * 8 + wid; q < 2 * LAT; q += GDIM() * 8) {
    const int b = q >> 13, t = q & (LAT - 1); const float* row = xr + ((size_t)b * TB + CTXL + t) * 1024;
    f32x4 v[4]; float ss = 0.f;
#pragma unroll
    for (int i = 0; i < 4; ++i) { v[i] = *(const f32x4*)(row + i * 256 + lane * 4); ss += v[i][0] * v[i][0] + v[i][1] * v[i][1] + v[i][2] * v[i][2] + v[i][3] * v[i][3]; }
    ss = wave_sum(ss); const float rs = rsqrtf(ss * (1.f / 1024.f) + EPSF);
#pragma unroll
    for (int i = 0; i < 4; ++i) { const int c0 = i * 256 + lane * 4; const f32x4 g = *(const f32x4*)(p.final_norm + c0); f32x4 o = v[i] * rs * g; *(f32x4*)(p.out + (size_t)q * 1024 + c0) = o; }
  }
}

#ifndef ONLY_PH
#define ONLY_PH -1
#endif
#define EN(x) (ONLY_PH < 0 || ONLY_PH == (x))
#ifndef PROBE_REP
#define PROBE_REP -1
#endif
#define RUN(cls, ...) do { if (EN(cls)) { for (int rep_ = 0; rep_ < ((PROBE_REP == (cls)) ? 2 : 1); ++rep_) { if (rep_) xcd_barrier(*xbp); __VA_ARGS__; } } } while (0)
enum { OP_INIT, OP_N1FULL, OP_IN, OP_PREP, OP_D1, OP_SCAN, OP_MERGE, OP_OUTLAT, OP_OUTCTX_N2LAT, OP_N2CTX, OP_UP, OP_ACT, OP_DOWNLAT, OP_DOWNCTX_N1LAT, OP_N1CTX,
       OP_QKV, OP_QKNORM, OP_ATTN, OP_N2FULL, OP_FINAL };
constexpr int NPHASES = 46;
__device__ __forceinline__ void decode_phase(int ph, int& op, int& L) {
  if (ph == 0) { op = OP_INIT; L = 0; return; }
  if (ph == NPHASES - 1) { op = OP_FINAL; L = 3; return; }
  int q = ph - 1;
  if (q < 14) { L = 0; if (q == 0) { op = OP_N1FULL; return; } q -= 1; }
  else if (q < 24) { L = 1; q -= 14; }
  else if (q < 37) { L = 2; q -= 24; }
  else { L = 3; q -= 37; }
  if ((L & 1) == 0) {
    if (q < 5) { op = OP_IN + q; return; }
    q -= 5;
  } else {
    if (q < 2) { op = q == 0 ? OP_QKV : OP_ATTN; return; }
    q -= 2;
  }
  if (L < 3) { const int t[8] = {OP_OUTLAT, OP_OUTCTX_N2LAT, OP_N2CTX, OP_UP, OP_ACT, OP_DOWNLAT, OP_DOWNCTX_N1LAT, OP_N1CTX}; op = t[q]; }
  else { const int t[5] = {OP_OUTLAT, OP_N2FULL, OP_UP, OP_ACT, OP_DOWNLAT}; op = t[q]; }
}
__device__ __forceinline__ void run_phase(const P& p0, int ph, char* lds, const XcdBarrier* xbp) {
  P p = p0; { typedef __attribute__((address_space(1))) char gchar_t; size_t wi = (size_t)p0.ws; asm volatile("" : "+s"(wi)); p.ws = (char*)(gchar_t*)wi; }
  int op, L; decode_phase(ph, op, L);
  const int e = L >> 1, o = L >> 1;
  bf16_t* W1 = (bf16_t*)(p.ws + OFF_WC); bf16_t* W2 = (bf16_t*)(p.ws + OFF_WC + WC_W2); bf16_t* W3 = (bf16_t*)(p.ws + OFF_W3);
  bf16_t* hb = (bf16_t*)(p.ws + OFF_HBF); float* xr = (float*)(p.ws + OFF_XRES);
  const float* mods = (const float*)(p.ws + OFF_MODS) + (size_t)L * 3 * 6144;
  float* PART = (float*)(p.ws + OFF_D + D_END_F);
#define CVT_MIX(LL, skipb) do { const int L_ = (LL); if ((L_ & 1) == 0) { cvt_weight(p.rec_w_in + (size_t)(L_ >> 1) * 1024 * 3632, W1, 1024, 3632, NREC, true, skipb); cvt_weight(p.rec_w_out + (size_t)(L_ >> 1) * 1024 * 1024, W3, 1024, 1024, 1024, false, skipb); } \
    else { cvt_weight(p.att_w_qkv + (size_t)(L_ >> 1) * 1024 * 1536, W1, 1024, 1536, 1536, false, skipb); cvt_weight(p.att_w_out + (size_t)(L_ >> 1) * 1024 * 1024, W3, 1024, 1024, 1024, false, skipb); } } while (0)
#define CVT_FFN(LL, skipb) do { const int L_ = (LL); cvt_weight(p.ffn_w_up + (size_t)L_ * 1024 * 5632, W1, 1024, 5632, 5632, false, skipb); cvt_weight(p.ffn_w_down + (size_t)L_ * DFF * 1024, W2, DFF, 1024, 1024, false, skipb); } while (0)
  switch (op) {
    case OP_INIT: RUN(0, ph_init(p, lds); CVT_MIX(0, 0)); break;
    case OP_N1FULL: RUN(1, ph_norm(p, L, 0, 0, 0)); break;
    case OP_IN: RUN(2, gemm8(lds, hb, 1024, W1, 1024, NREC, 0, EpiRec8{(bf16_t*)(p.ws + OFF_D + D_P1), (bf16_t*)(p.ws + OFF_D + D_P2), (float*)(p.ws + OFF_SM)})); break;
    case OP_PREP: RUN(3, ph_dnprep(p, lds, e)); break;
    case OP_D1: RUN(4, ph_dn_d1(p, lds); ph_gla_b(p, lds, e)); break;
    case OP_SCAN: RUN(5, if (BIDX() < 64) { dn_scan(p, lds, BIDX()); } else if (BIDX() < 128) { gla_scan(p, lds, BIDX() - 64, e); });
        if (PROBE_REP == 55) { xcd_barrier(*xbp); if (BIDX() < 64) { dn_scan(p, lds, BIDX()); } }
        if (PROBE_REP == 56) { xcd_barrier(*xbp); if (BIDX() >= 64 && BIDX() < 128) { gla_scan(p, lds, BIDX() - 64, e); } }
        break;
    case OP_MERGE: RUN(7, ph_merge(p, e)); break;
    case OP_QKV: if (EN(2)) { gemm8(lds, hb, 1024, W1, 1024, 1536, 0, EpiBf8{(bf16_t*)(p.ws + OFF_D), 1536}); qk_fused(p, lds, o); } break;
    case OP_ATTN: RUN(10, ph_attn(p, lds, L != 3)); break;
    case OP_OUTLAT: if (EN(2)) { gemm8(lds, hb, 1024, W3, 1024, 1024, 1, EpiRes8{xr, mods + 2 * 1024}); if (L == 3) CVT_FFN(L, 0); } break;
    case OP_OUTCTX_N2LAT: if (EN(2)) { if (BIDX() < 128) gemm_ctx_split(lds, hb, 1024, W3, 1024, 128, PART); ph_norm(p, L, 1, 1, 0); CVT_FFN(L, 0); } break;
    case OP_N2CTX: if (EN(1)) ph_ctx_fold_norm(p, L, 1, PART, 8, mods + 2 * 1024); break;
    case OP_N2FULL: if (EN(1)) ph_norm(p, L, 1, 0, 0); break;
    case OP_UP: RUN(2, gemm8(lds, hb, 1024, W1, 1024, 5632, L == 3 ? 1 : 0, EpiBf8{(bf16_t*)(p.ws + OFF_D), 5632})); break;
    case OP_ACT: if (EN(8)) ph_ffnact(p, L); break;
    case OP_DOWNLAT: if (EN(2)) gemm8(lds, (const bf16_t*)(p.ws + OFF_D) + DFF, 5632, W2, DFF, 1024, 1, EpiRes8{xr, mods + 5 * 1024}); break;
    case OP_DOWNCTX_N1LAT: if (EN(2)) { if (BIDX() < 176) gemm_ctx_split(lds, (const bf16_t*)(p.ws + OFF_D) + DFF, 5632, W2, DFF, 256, PART); ph_norm(p, L + 1, 0, 1, 0); CVT_MIX(L + 1, 0); } break;
    case OP_N1CTX: if (EN(1)) ph_ctx_fold_norm(p, L + 1, 0, PART, 11, mods + 5 * 1024); break;
    case OP_FINAL: if (EN(11)) ph_final(p); break;
  }
#undef CVT_MIX
#undef CVT_FFN
}

template <bool COOP>
__global__ void __launch_bounds__(512, 1) mk_kernel(P p, int ph0, int ph1) {
  extern __shared__ __attribute__((aligned(16))) char smem[];
  if constexpr (COOP) {
    if (ph0 < 0) cg::this_grid().sync();
    volatile LAS unsigned* st = (volatile LAS unsigned*)(smem + LDS_BYTES);
    if (threadIdx.x < 4) st[threadIdx.x] = 0u;
    __syncthreads();
    XcdBarrier xb = xcd_barrier_post((unsigned*)(p.ws + OFF_BAR), st);
    for (int ph = ph0; ph < ph1; ++ph) {
      run_phase(p, ph, smem, &xb);
      if (ph + 1 < ph1) xcd_barrier(xb);
      if (PROBE_REP == 99 && ph == 0) { for (int q = 0; q < 20; ++q) xcd_barrier(xb); }
    }
  } else {
    for (int ph = ph0; ph < ph1; ++ph) run_phase(p, ph, smem, nullptr);
  }
}

extern "C" void kernel_launch(void* const* d_in, const int* in_sizes, int n_in, void* d_out, int out_size, void* d_ws, size_t ws_size, hipStream_t stream) {
  if (n_in != 23 || ws_size < WS_NEED) { fprintf(stderr, "kernel_launch: bad n_in %d or ws %zu < %zu\n", n_in, ws_size, (size_t)WS_NEED); return; }
  P p{};
  const float** f = (const float**)&p;
  for (int i = 0; i < 23; ++i) f[i] = (const float*)d_in[i];
  p.out = (float*)d_out; p.ws = (char*)d_ws;
  static int inited = 0, grid_blocks = 0;
  if (!inited) {
    hipFuncSetAttribute((const void*)mk_kernel<true>, hipFuncAttributeMaxDynamicSharedMemorySize, LDS_BYTES + 16);
#if !MK_COOP
    hipFuncSetAttribute((const void*)mk_kernel<false>, hipFuncAttributeMaxDynamicSharedMemorySize, LDS_BYTES);
#endif
    int dev = 0, cus = 0, per_cu = 0;
    hipGetDevice(&dev); hipDeviceGetAttribute(&cus, hipDeviceAttributeMultiprocessorCount, dev);
    hipOccupancyMaxActiveBlocksPerMultiprocessor(&per_cu, mk_kernel<true>, 512, LDS_BYTES + 16);
    if (per_cu > 1) per_cu = 1;
    grid_blocks = cus * per_cu; if (grid_blocks > 256) grid_blocks = 256; if (grid_blocks < 128) grid_blocks = 128;
    inited = 1;
  }
#if MK_COOP
  int ph0 = 0, ph1 = NPHASES;
  void* args[] = {&p, &ph0, &ph1};
  hipMemsetAsync((char*)d_ws + OFF_BAR, 0, 3456 * 4, stream);
  hipError_t er = hipLaunchCooperativeKernel((const void*)mk_kernel<true>, dim3(grid_blocks), dim3(512), args, LDS_BYTES + 16, stream);
  if (er != hipSuccess) fprintf(stderr, "cooperative launch failed: %s (grid %d)\n", hipGetErrorString(er), grid_blocks);
#else
  for (int ph = 0; ph < NPHASES; ++ph) hipLaunchKernelGGL(mk_kernel<false>, dim3(256), dim3(512), LDS_BYTES, stream, p, ph, ph + 1);
#endif
}
```

```cpp
#include <hip/hip_runtime.h>
#include <hip/hip_cooperative_groups.h>
#include <cstdio>
#include <cstdint>
namespace cg = cooperative_groups;

#ifndef MK_COOP
#define MK_COOP 1
#endif

typedef unsigned short bf16_t;
typedef short bf16x8 __attribute__((ext_vector_type(8)));
typedef short s16x4 __attribute__((ext_vector_type(4)));
typedef float f32x16 __attribute__((ext_vector_type(16)));
typedef float f32x8 __attribute__((ext_vector_type(8)));
typedef float f32x4 __attribute__((ext_vector_type(4)));
typedef unsigned u32x4 __attribute__((ext_vector_type(4)));
#define DI __device__ __forceinline__
#define LBAR() do { asm volatile("s_waitcnt lgkmcnt(0)" ::: "memory"); __builtin_amdgcn_s_barrier(); asm volatile("" ::: "memory"); } while (0)
#define MFMA32(a, b, c) __builtin_amdgcn_mfma_f32_32x32x16_bf16((a), (b), (c), 0, 0, 0)

constexpr int DM = 1024, TB = 8448, CTXL = 256, LAT = 8192, MROWS = 2 * TB;
constexpr int NCH = 132;
constexpr int DFF = 2816;
constexpr int NREC = 3840;
constexpr float EPSF = 1e-6f;

constexpr size_t AL(size_t x) { return (x + 255) / 256 * 256; }
constexpr size_t OFF_XRES = 0;
constexpr size_t OFF_HBF = OFF_XRES + AL((size_t)MROWS * DM * 4);
constexpr size_t OFF_WC = OFF_HBF + AL((size_t)MROWS * DM * 2);
constexpr size_t WC_W2 = (size_t)5632 * 1024 * 2;
constexpr size_t OFF_MODS = OFF_WC + AL(WC_W2 + (size_t)1024 * 2816 * 2);
constexpr size_t OFF_SM = OFF_MODS + AL((size_t)4 * 3 * 6144 * 4);
constexpr size_t OFF_GB = OFF_SM + AL((size_t)MROWS * 64 * 4);
constexpr size_t OFF_SC = OFF_GB + AL((size_t)MROWS * 16 * 4);
constexpr size_t OFF_GL = OFF_SC + AL((size_t)16 * NCH * 64 * 2 * 4);
constexpr size_t OFF_D = OFF_GL + AL((size_t)16 * NCH * 4);
constexpr size_t D_P1 = 0;
constexpr size_t D_W = 0;
constexpr size_t D_INTRA = D_W + (size_t)16 * NCH * 64 * 128 * 2;
constexpr size_t D_P2 = D_P1 + (size_t)MROWS * 1536 * 2;
constexpr size_t D_QQ = D_P2 + (size_t)MROWS * 2048 * 2;
constexpr size_t D_QK = D_QQ + (size_t)MROWS * 512 * 2;
constexpr size_t D_QV = D_QK + (size_t)MROWS * 512 * 2;
constexpr size_t D_DNO = D_QK;
constexpr size_t D_KT = D_QV + (size_t)MROWS * 512 * 2;
constexpr size_t D_GLAO = D_KT + (size_t)MROWS * 512 * 2;
constexpr size_t D_END_E = D_GLAO + (size_t)2 * MROWS * 512 * 2;
constexpr size_t D_END_F = (size_t)MROWS * 5632 * 2;
constexpr size_t OFF_B16_1 = OFF_D + (D_END_E > D_END_F ? D_END_E : D_END_F);
constexpr size_t B16_BYTES = (size_t)8 * NCH * 64 * 64 * 2;
constexpr size_t OFF_BAR = OFF_B16_1 + AL(B16_BYTES);
constexpr size_t OFF_W3 = OFF_BAR + AL(3456 * 4);
constexpr size_t WS_NEED = OFF_W3 + (size_t)1024 * 1024 * 2;
constexpr int LDS_BYTES = 132 * 1024;

struct P {
  const float *x, *c, *ctx, *c_ctx, *mod_w, *mod_b, *rec_w_in, *rec_conv, *dn_a_log, *dn_dt_bias, *dn_norm, *gla_w2, *gla_b2, *gla_norm,
      *rec_w_out, *att_w_qkv, *att_q_norm, *att_k_norm, *att_w_out, *ffn_w_up, *ffn_conv, *ffn_w_down, *final_norm;
  float* out;
  char* ws;
};

DI int TIDX() { int t = threadIdx.x; asm volatile("" : "+v"(t)); return t; }
DI int BIDX() { int t = blockIdx.x; asm volatile("" : "+s"(t)); return t; }
DI int GDIM() { int t = gridDim.x; asm volatile("" : "+s"(t)); return t; }
DI float bf2f(bf16_t v) { return __uint_as_float(((unsigned)v) << 16); }
DI bf16_t f2bf(float x) { unsigned u = __float_as_uint(x); u += 0x7fffu + ((u >> 16) & 1u); return (bf16_t)(u >> 16); }
typedef __bf16 bf16n2 __attribute__((ext_vector_type(2)));
DI unsigned cvtpk(float lo, float hi) { const bf16n2 v = {(__bf16)lo, (__bf16)hi}; return __builtin_bit_cast(unsigned, v); }
DI int crow(int r, int hi) { return (r & 3) + 8 * (r >> 2) + 4 * hi; }
DI float siluf(float x) { return x / (1.f + expf(-x)); }
DI float sigmf(float x) { return 1.f / (1.f + expf(-x)); }
DI float softplusf(float x) { return fmaxf(x, 0.f) + log1pf(expf(-fabsf(x))); }
DI float wave_sum(float v) {
#pragma unroll
  for (int o = 32; o > 0; o >>= 1) v += __shfl_xor(v, o);
  return v;
}
DI int modrow_of(int R) { const int b = R >= TB ? 1 : 0; const int pp = R - b * TB; return pp < CTXL ? 2 : b; }
template <int KS>
DI f32x16 mma_rows(const bf16_t* arow, const bf16_t* brow, f32x16 acc) {
#pragma unroll
  for (int ks = 0; ks < KS; ++ks) {
    const bf16x8 a = *reinterpret_cast<const bf16x8*>(arow + ks * 16);
    const bf16x8 b = *reinterpret_cast<const bf16x8*>(brow + ks * 16);
    acc = MFMA32(a, b, acc);
  }
  return acc;
}

#define XB_TMO      128
#define XB_XCNT(j)  (256  + 64 * (j))
#define XB_XSUB(j)  (1280 + 64 * (j))
#define XB_XGEN(j)  (2304 + 64 * (j))
#define XB_TOP      3328
#define XB_TOPGEN   3392
#define XCD_BAR_WORDS 3456
#define XB_SPIN_CAP (1u << 18)
#define LAS __attribute__((address_space(3)))
DI unsigned xb_ld(unsigned* p)              { return __hip_atomic_load(p, __ATOMIC_RELAXED, __HIP_MEMORY_SCOPE_AGENT); }
DI unsigned xb_add(unsigned* p, unsigned v) { return __hip_atomic_fetch_add(p, v, __ATOMIC_RELAXED, __HIP_MEMORY_SCOPE_AGENT); }
DI unsigned xb_xcc_id() { return (unsigned)__builtin_amdgcn_s_getreg((3 << 11) | 20) & 0xFu; }
#define XB_SPIN(cond, bar) do { unsigned _sp = 0; while (cond) { __builtin_amdgcn_s_sleep(1); \
    if ((++_sp & 255u) == 0u) { if (xb_ld(&(bar)[XB_TMO])) break; if (_sp > XB_SPIN_CAP) { atomicAdd(&(bar)[XB_TMO], 1u); break; } } } } while (0)
struct XcdBarrier { unsigned* bar; unsigned x; volatile LAS unsigned* st; };
DI XcdBarrier xcd_barrier_post(unsigned* bar, volatile LAS unsigned* st) {
    XcdBarrier b; b.bar = bar; b.x = xb_xcc_id(); b.st = st;
    if (threadIdx.x == 0) (void)xb_add(&bar[XB_XCNT(b.x)], 1u);
    return b;
}
DI void xcd_barrier_complete(unsigned* bar, unsigned x, unsigned& nloc, unsigned& nx) {
    const unsigned G = gridDim.x * gridDim.y * gridDim.z;
    unsigned sum, cnt, mine, sp = 0u;
    for (;;) {
        sum = 0u; cnt = 0u; mine = 0u;
#pragma unroll
        for (unsigned j = 0; j < 16; ++j) { const unsigned c = xb_ld(&bar[XB_XCNT(j)]); sum += c; cnt += (c > 0u) ? 1u : 0u; mine = (j == x) ? c : mine; }
        if (sum == G) break;
        __builtin_amdgcn_s_sleep(1);
        if ((++sp & 255u) == 0u) { if (xb_ld(&bar[XB_TMO])) break; if (sp > XB_SPIN_CAP) { atomicAdd(&bar[XB_TMO], 1u); break; } }
    }
    nloc = mine > 0u ? mine : 1u; nx = cnt > 0u ? cnt : 1u;
}
DI void xcd_barrier(const XcdBarrier& b) {
    asm volatile("s_waitcnt vmcnt(0)" ::: "memory");
    __syncthreads();
    if (threadIdx.x == 0) {
        unsigned* bar = b.bar;
        __builtin_amdgcn_s_waitcnt(0);
        unsigned nloc = b.st[0], nx = b.st[1];
        if (nloc == 0u) { xcd_barrier_complete(bar, b.x, nloc, nx); b.st[0] = nloc; b.st[1] = nx; }
        const unsigned old = xb_add(&bar[XB_XSUB(b.x)], 1u);
        const unsigned gen = old / nloc;
        if (old + 1u == (gen + 1u) * nloc) {
            __builtin_amdgcn_fence(__ATOMIC_RELEASE, "agent");
            asm volatile("s_waitcnt vmcnt(0)" ::: "memory");
            const unsigned og = xb_add(&bar[XB_TOP], 1u);
            const unsigned tg = og / nx;
            if (og + 1u == (tg + 1u) * nx) xb_add(&bar[XB_TOPGEN], 1u);
            else XB_SPIN(xb_ld(&bar[XB_TOPGEN]) == tg, bar);
            __builtin_amdgcn_fence(__ATOMIC_ACQUIRE, "agent");
            xb_add(&bar[XB_XGEN(b.x)], 1u);
            asm volatile("s_waitcnt vmcnt(0)" ::: "memory");
        } else {
            XB_SPIN(xb_ld(&bar[XB_XGEN(b.x)]) == gen, bar);
            __builtin_amdgcn_fence(__ATOMIC_ACQUIRE, "agent");
            asm volatile("s_waitcnt vmcnt(0)" ::: "memory");
        }
    }
    __syncthreads();
}

__device__ __forceinline__ void ph_init(const P& p, char* lds) {
  const int tid = TIDX();
  float* sc = (float*)lds;
  for (int i = tid; i < 3072; i += 512) { const int r = i >> 10, k = i & 1023; const float v = r < 2 ? p.c[r * 1024 + k] : p.c_ctx[k]; sc[i] = siluf(v); }
  __syncthreads();
  float* mods = (float*)(p.ws + OFF_MODS);
  float* red = sc + 3072;
  for (int job = BIDX(); job < 192; job += GDIM()) {
    const int ct = tid & 31, ks = tid >> 5;
    const int col = job * 128 + ct * 4; const int L = col / 6144, cl = col - L * 6144;
    const float* w = p.mod_w + ((size_t)L * 1024 + ks * 64) * 6144 + cl;
    f32x4 a0 = {0.f, 0.f, 0.f, 0.f}, a1 = a0, a2 = a0;
#pragma unroll 16
    for (int k = 0; k < 64; ++k) { const f32x4 wv = *(const f32x4*)(w + (size_t)k * 6144); const int kk = ks * 64 + k; a0 += sc[kk] * wv; a1 += sc[1024 + kk] * wv; a2 += sc[2048 + kk] * wv; }
    *(f32x4*)(red + (ks * 3 + 0) * 128 + ct * 4) = a0; *(f32x4*)(red + (ks * 3 + 1) * 128 + ct * 4) = a1; *(f32x4*)(red + (ks * 3 + 2) * 128 + ct * 4) = a2;
    __syncthreads();
    if (tid < 384) { const int r = tid >> 7, cc = tid & 127; const int c2 = job * 128 + cc; const int L2 = c2 / 6144, cl2 = c2 - L2 * 6144;
      float sm = p.mod_b[L2 * 6144 + cl2];
#pragma unroll
      for (int q = 0; q < 16; ++q) sm += red[(q * 3 + r) * 128 + cc];
      mods[((size_t)L2 * 3 + r) * 6144 + cl2] = sm; }
    __syncthreads();
  }
  f32x4* xr = (f32x4*)(p.ws + OFF_XRES);
  for (size_t i = (size_t)BIDX() * 512 + tid; i < (size_t)MROWS * 256; i += (size_t)GDIM() * 512) {
    const int R = (int)(i >> 8), c4 = (int)(i & 255); const int b = R >= TB ? 1 : 0, pp = R - b * TB;
    const float* src = pp < CTXL ? p.ctx + ((size_t)b * CTXL + pp) * 1024 : p.x + ((size_t)b * LAT + (pp - CTXL)) * 1024;
    xr[i] = *(const f32x4*)(src + c4 * 4);
  }
}

DI int rec_src_col(int n) { if (n < 2048) return n; if (n < 3584) return n + 16; if (n < 3600) return 2048 + (n - 3584); if (n < 3632) return n; return -1; }
__device__ __forceinline__ void cvt_weight(const float* __restrict__ W, bf16_t* __restrict__ Wt, int K, int Nsrc, int Npad, bool perm, int skipb) {
  const size_t items = (size_t)Npad * (K >> 3);
  const int bid = BIDX() - skipb, nb = GDIM() - skipb;
  if (bid < 0) return;
  for (size_t it = (size_t)bid * 512 + TIDX(); it < items; it += (size_t)nb * 512) {
    const int n = (int)(it % Npad), kb = (int)(it / Npad);
    const int s = perm ? rec_src_col(n) : n;
    float v[8];
#pragma unroll
    for (int j = 0; j < 8; ++j) v[j] = s >= 0 ? W[(size_t)(kb * 8 + j) * Nsrc + s] : 0.f;
    u32x4 w = {cvtpk(v[0], v[1]), cvtpk(v[2], v[3]), cvtpk(v[4], v[5]), cvtpk(v[6], v[7])};
    *(u32x4*)(Wt + (size_t)n * K + kb * 8) = w;
  }
}

__device__ __forceinline__ void gemm_ctx_split(char* lds, const bf16_t* __restrict__ A, int lda, const bf16_t* __restrict__ Bt, int ldb, int Ks, float* __restrict__ PART) {
  const int tid = TIDX(), wid = tid >> 6, lane = tid & 63, r32 = lane & 31, hi = lane >> 5;
  const int wm = wid >> 1, wn = wid & 1;
  const int nk = Ks >> 6;
  constexpr int RS = 144, ASZ = 256 * RS, BSZ = 128 * RS, STG = ASZ + BSZ;
  const int srow = tid >> 3, spc = tid & 7;
  const int w = BIDX(); const int ks = w >> 4, j = w & 15; const int pm = (j >> 3) ? 33 : 0, pn = j & 7;
  const bf16_t* Ab = A + (size_t)(pm * 256 + srow) * lda + (size_t)ks * Ks + spc * 8;
  const bf16_t* Bb = Bt + (size_t)(pn * 128 + srow) * ldb + (size_t)ks * Ks + spc * 8;
  f32x16 acc00 = {}, acc01 = {}, acc10 = {}, acc11 = {};
  bf16x8 ra0, ra1, ra2, ra3, rb0, rb1;
#define GLOAD(kt) do { const int ko = (kt) * 64; ra0 = *(const bf16x8*)(Ab + ko); ra1 = *(const bf16x8*)(Ab + (size_t)64 * lda + ko); ra2 = *(const bf16x8*)(Ab + (size_t)128 * lda + ko); \
    ra3 = *(const bf16x8*)(Ab + (size_t)192 * lda + ko); rb0 = *(const bf16x8*)(Bb + ko); rb1 = *(const bf16x8*)(Bb + (size_t)64 * ldb + ko); } while (0)
#define SWRITE(buf) do { char* sb = lds + (buf) * STG + srow * RS + spc * 16; *(bf16x8*)(sb) = ra0; *(bf16x8*)(sb + 64 * RS) = ra1; *(bf16x8*)(sb + 128 * RS) = ra2; *(bf16x8*)(sb + 192 * RS) = ra3; \
    *(bf16x8*)(sb + ASZ) = rb0; *(bf16x8*)(sb + ASZ + 64 * RS) = rb1; } while (0)
  GLOAD(0); SWRITE(0); __syncthreads();
  for (int kt = 0; kt < nk; ++kt) {
    const int cur = kt & 1;
    if (kt + 1 < nk) GLOAD(kt + 1);
    const char* ab = lds + cur * STG + (64 * wm + r32) * RS + hi * 16;
    const char* bb = lds + cur * STG + ASZ + (64 * wn + r32) * RS + hi * 16;
#pragma unroll
    for (int k4 = 0; k4 < 4; ++k4) {
      const bf16x8 a0 = *(const bf16x8*)(ab + k4 * 32), a1 = *(const bf16x8*)(ab + 32 * RS + k4 * 32);
      const bf16x8 b0 = *(const bf16x8*)(bb + k4 * 32), b1 = *(const bf16x8*)(bb + 32 * RS + k4 * 32);
      acc00 = MFMA32(a0, b0, acc00); acc01 = MFMA32(a0, b1, acc01); acc10 = MFMA32(a1, b0, acc10); acc11 = MFMA32(a1, b1, acc11);
    }
    if (kt + 1 < nk) SWRITE(cur ^ 1);
    __syncthreads();
  }
#undef GLOAD
#undef SWRITE
  float* pb = PART + ((size_t)ks * 512 + (pm ? 256 : 0) + 64 * wm) * 1024 + pn * 128 + 64 * wn + r32;
#pragma unroll
  for (int r = 0; r < 16; ++r) { float* q = pb + (size_t)crow(r, hi) * 1024;
    q[0] = acc00[r]; q[32] = acc01[r]; q[32 * 1024] = acc10[r]; q[32 * 1024 + 32] = acc11[r]; }
}

__device__ __forceinline__ void ph_ctx_fold_norm(const P& p, int L, int which, const float* __restrict__ part, int nsplit, const float* __restrict__ gate) {
  const int tid = TIDX(), wid = tid >> 6, lane = tid & 63;
  float* xr = (float*)(p.ws + OFF_XRES); bf16_t* hb = (bf16_t*)(p.ws + OFF_HBF);
  const float* mods = (const float*)(p.ws + OFF_MODS) + (size_t)L * 3 * 6144;
  for (int cr = BIDX() * 8 + wid; cr < 2 * CTXL; cr += GDIM() * 8) {
    const int R = cr < CTXL ? cr : TB + (cr - CTXL);
    float* row = xr + (size_t)R * 1024 + lane * 4;
    const float* pr = part + (size_t)cr * 1024 + lane * 4;
    f32x4 v[4], a[4];
#pragma unroll
    for (int i = 0; i < 4; ++i) { v[i] = *(const f32x4*)(row + i * 256); a[i] = *(const f32x4*)(pr + i * 256); }
    for (int sp = 1; sp < nsplit; ++sp) {
#pragma unroll
      for (int i = 0; i < 4; ++i) a[i] += *(const f32x4*)(pr + (size_t)sp * 512 * 1024 + i * 256);
    }
    float ss = 0.f;
#pragma unroll
    for (int i = 0; i < 4; ++i) { v[i] += *(const f32x4*)(gate + 2 * 6144 + i * 256 + lane * 4) * a[i]; *(f32x4*)(row + i * 256) = v[i];
      ss += v[i][0] * v[i][0] + v[i][1] * v[i][1] + v[i][2] * v[i][2] + v[i][3] * v[i][3]; }
    ss = wave_sum(ss);
    const float rs = rsqrtf(ss * (1.f / 1024.f) + EPSF);
    const float* mr = mods + (size_t)2 * 6144 + which * 3072 + lane * 4;
#pragma unroll
    for (int i = 0; i < 4; ++i) { const f32x4 sh = *(const f32x4*)(mr + i * 256), scl = *(const f32x4*)(mr + 1024 + i * 256);
      float o[4];
#pragma unroll
      for (int j = 0; j < 4; ++j) o[j] = v[i][j] * rs * (1.f + scl[j]) + sh[j];
      uint2 w; w.x = cvtpk(o[0], o[1]); w.y = cvtpk(o[2], o[3]);
      *(uint2*)(hb + (size_t)R * 1024 + i * 256 + lane * 4) = w; }
  }
}

__device__ __forceinline__ void ph_norm(const P& p, int L, int which, int mode, int skipb) {
  const int tid = TIDX(), wid = tid >> 6, lane = tid & 63, l16 = lane & 15, sub = lane >> 4;
  const float* xr = (const float*)(p.ws + OFF_XRES);
  bf16_t* hb = (bf16_t*)(p.ws + OFF_HBF);
  const float* mods = (const float*)(p.ws + OFF_MODS) + (size_t)L * 3 * 6144;
  const int bid = BIDX() - skipb, nb = GDIM() - skipb;
  if (bid < 0) return;
  const int nquads = mode == 0 ? MROWS / 4 : (mode == 1 ? 2 * LAT / 4 : 2 * CTXL / 4);
  for (int q = bid * 8 + wid; q < nquads; q += nb * 8) {
    int R4;
    if (mode == 0) R4 = q * 4; else if (mode == 1) R4 = q < LAT / 4 ? CTXL + q * 4 : TB + CTXL + (q - LAT / 4) * 4; else R4 = q < CTXL / 4 ? q * 4 : TB + (q - CTXL / 4) * 4;
    const int R = R4 + sub;
    const float* row = xr + (size_t)R * 1024 + l16 * 8;
    f32x4 v[16]; float ss = 0.f;
#pragma unroll
    for (int i = 0; i < 8; ++i) { v[2 * i] = *(const f32x4*)(row + i * 128); v[2 * i + 1] = *(const f32x4*)(row + i * 128 + 4); }
#pragma unroll
    for (int i = 0; i < 16; ++i) ss += v[i][0] * v[i][0] + v[i][1] * v[i][1] + v[i][2] * v[i][2] + v[i][3] * v[i][3];
    ss += __shfl_xor(ss, 1); ss += __shfl_xor(ss, 2); ss += __shfl_xor(ss, 4); ss += __shfl_xor(ss, 8);
    const float rs = rsqrtf(ss * (1.f / 1024.f) + EPSF);
    const float* mr = mods + (size_t)modrow_of(R) * 6144 + which * 3072 + l16 * 8;
    bf16_t* dst = hb + (size_t)R * 1024 + l16 * 8;
#pragma unroll
    for (int i = 0; i < 8; ++i) { unsigned w[4];
#pragma unroll
      for (int hlf = 0; hlf < 2; ++hlf) { const f32x4 sh = *(const f32x4*)(mr + i * 128 + hlf * 4), scl = *(const f32x4*)(mr + 1024 + i * 128 + hlf * 4); const f32x4 x = v[2 * i + hlf];
        float o[4];
#pragma unroll
        for (int j = 0; j < 4; ++j) o[j] = x[j] * rs * (1.f + scl[j]) + sh[j];
        w[2 * hlf] = cvtpk(o[0], o[1]); w[2 * hlf + 1] = cvtpk(o[2], o[3]); }
      *(u32x4*)(dst + i * 128) = (u32x4){w[0], w[1], w[2], w[3]}; }
  }
}

struct EpiRec { bf16_t* P1; bf16_t* P2; float* SM;
  DI void operator()(int row, int col, float v) const {
    if (col < 1536) P1[(size_t)row * 1536 + col] = f2bf(v);
    else if (col < 3584) P2[(size_t)row * 2048 + (col - 1536)] = f2bf(v);
    else { const int lc = col - 3584; if (lc < 48) SM[(size_t)row * 64 + lc] = v; } } };
struct EpiBf { bf16_t* O; int ldc;
  DI void operator()(int row, int col, float v) const { O[(size_t)row * ldc + col] = f2bf(v); } };
struct EpiRes { float* X; const float* gate;
  DI void operator()(int row, int col, float v) const { float* q = X + (size_t)row * 1024 + col; *q = *q + gate[(size_t)modrow_of(row) * 6144 + col] * v; } };

template <class Epi>
__device__ __forceinline__ void gemm_phase(char* lds, const bf16_t* __restrict__ A, int lda, const bf16_t* __restrict__ Bt, int K, int nN, const Epi epi, bool skipctx = false) {
  const int tid = TIDX(), wid = tid >> 6, lane = tid & 63, r32 = lane & 31, hi = lane >> 5;
  const int wm = wid >> 1, wn = wid & 1;
  const int nk = K >> 6;
  constexpr int RS = 144, ASZ = 256 * RS, BSZ = 128 * RS, STG = ASZ + BSZ;
  const int ntiles = (skipctx ? 64 : MROWS / 256) * nN;
  const int srow = tid >> 3, spc = tid & 7;
  for (int t = BIDX(); t < ntiles; t += GDIM()) {
    int pm = t / nN; const int pn = t - pm * nN; if (skipctx) pm = pm + 1 + (pm >= 32 ? 1 : 0);
    const bf16_t* Ab = A + (size_t)(pm * 256 + srow) * lda + spc * 8;
    const bf16_t* Bb = Bt + (size_t)(pn * 128 + srow) * K + spc * 8;
    f32x16 acc00 = {}, acc01 = {}, acc10 = {}, acc11 = {};
    bf16x8 ra0, ra1, ra2, ra3, rb0, rb1;
#define GLOAD(kt) do { const int ko = (kt) * 64; ra0 = *(const bf16x8*)(Ab + ko); ra1 = *(const bf16x8*)(Ab + (size_t)64 * lda + ko); ra2 = *(const bf16x8*)(Ab + (size_t)128 * lda + ko); \
    ra3 = *(const bf16x8*)(Ab + (size_t)192 * lda + ko); rb0 = *(const bf16x8*)(Bb + ko); rb1 = *(const bf16x8*)(Bb + (size_t)64 * K + ko); } while (0)
#define SWRITE(buf) do { char* sb = lds + (buf) * STG + srow * RS + spc * 16; *(bf16x8*)(sb) = ra0; *(bf16x8*)(sb + 64 * RS) = ra1; *(bf16x8*)(sb + 128 * RS) = ra2; *(bf16x8*)(sb + 192 * RS) = ra3; \
    *(bf16x8*)(sb + ASZ) = rb0; *(bf16x8*)(sb + ASZ + 64 * RS) = rb1; } while (0)
    GLOAD(0); SWRITE(0); __syncthreads();
    for (int kt = 0; kt < nk; ++kt) {
      const int cur = kt & 1;
      if (kt + 1 < nk) GLOAD(kt + 1);
      const char* ab = lds + cur * STG + (64 * wm + r32) * RS + hi * 16;
      const char* bb = lds + cur * STG + ASZ + (64 * wn + r32) * RS + hi * 16;
#pragma unroll
      for (int ks = 0; ks < 4; ++ks) {
        const bf16x8 a0 = *(const bf16x8*)(ab + ks * 32), a1 = *(const bf16x8*)(ab + 32 * RS + ks * 32);
        const bf16x8 b0 = *(const bf16x8*)(bb + ks * 32), b1 = *(const bf16x8*)(bb + 32 * RS + ks * 32);
        acc00 = MFMA32(a0, b0, acc00); acc01 = MFMA32(a0, b1, acc01); acc10 = MFMA32(a1, b0, acc10); acc11 = MFMA32(a1, b1, acc11);
      }
      if (kt + 1 < nk) SWRITE(cur ^ 1);
      __syncthreads();
    }
#undef GLOAD
#undef SWRITE
    const int row0 = pm * 256 + 64 * wm, col0 = pn * 128 + 64 * wn + r32;
#pragma unroll
    for (int r = 0; r < 16; ++r) { const int rr = row0 + crow(r, hi);
      epi(rr, col0, acc00[r]); epi(rr, col0 + 32, acc01[r]); epi(rr + 32, col0, acc10[r]); epi(rr + 32, col0 + 32, acc11[r]); }
  }
}

namespace pg8 {
#define PG8_LAS __attribute__((address_space(3)))
constexpr int BM = 256, BK = 64, HALF = 128, HTB = HALF * BK * 2  , STAGE_BYTES = 8 * HTB, NXCD = 8, WGM = 8;

__host__ __device__ __forceinline__ int lds_byte(int r, int c) { const int st = (r >> 4) * 2 + (c >> 5), rr = r & 15, cc = c & 31, ob = rr * 64 + cc * 2; return st * 1024 + (ob ^ (((ob >> 9) & 1) << 5)); }
__host__ __device__ __forceinline__ void stage_rc(int b, int& R, int& C) { const int st = b / 1024, sb = b % 1024, swz = sb ^ (((sb >> 9) & 1) << 5); R = (st >> 1) * 16 + swz / 64; C = (st & 1) * 32 + (swz % 64) / 2; }
__host__ __device__ __forceinline__ int perm32(int rho) { const int n = rho >> 4, i = rho & 15; return 8 * (i >> 2) + 4 * n + (i & 3); }
struct Unit { int pm, pn; };
struct Gemm { const bf16_t* A; const bf16_t* Bt; int M, N, K, lda; };

struct StaticOrder {
    int nM, nN, nwg, G, c;
    __host__ __device__ void init(int M, int N, int G_, int c_) { nM = M / BM; nN = N / BM; nwg = nM * nN; G = G_; c = c_; }
    __host__ __device__ bool next(int i, Unit& u) const {
        const long L = (long)i * G + c; if (L >= nwg) return false;
        int wgid = (int)L; { const int q = nwg / NXCD, r = nwg % NXCD, xcd = wgid % NXCD, off = wgid / NXCD; wgid = (xcd < r ? xcd * (q + 1) : r * (q + 1) + (xcd - r) * q) + off; }
        const int nig = WGM * nN, gid = wgid / nig, fm = gid * WGM, gsz = (nM - fm) < WGM ? (nM - fm) : WGM;
        u.pm = fm + ((wgid % nig) % gsz); u.pn = (wgid % nig) / gsz; return true;
    }
    __device__ __forceinline__ void a_ready(const Unit&) const {}
    __device__ __forceinline__ void done(const Unit&) const {}
};
template <class Epi, class Sched, bool ALIGN_EPI = false, bool SP2 = false>
__device__ __forceinline__ void gemm_phase(PG8_LAS unsigned char* lds, const Gemm g, const Sched& S, const Epi& E) {
    const int tid = TIDX(), wid = __builtin_amdgcn_readfirstlane(tid >> 6), lane = tid & 63, wr = wid >> 2, wc = wid & 3, fr = lane & 15, fq = lane >> 4;
    const int K = g.K, nt = K / BK;
    unsigned voffA[2], voffB[2];
#pragma unroll
    for (int i = 0; i < 2; ++i) { int R, C; stage_rc(tid * 16 + i * 8192, R, C); const int Rb = Epi::PERM ? ((R & ~31) + perm32(R & 31)) : R;
        voffA[i] = (unsigned)(R * g.lda + C) * 2u; voffB[i] = (unsigned)(Rb * K + C) * 2u; }
    const size_t kstep = (size_t)(BK * 2);
    const size_t hstep = (size_t)HALF * K * 2;
    const size_t tstep = 2 * hstep; const size_t hstepA = (size_t)HALF * g.lda * 2, tstepA = 2 * hstepA;
    const unsigned ldsw = (unsigned)wid * 1024u;
    const int aoff = lds_byte(wr * 64 + fr, fq * 8), boff = lds_byte(wc * 32 + fr, fq * 8);
#define PG8_SA(b, h) (((b) * 2 + (h)) * HTB)
#define PG8_SB(b, h) ((4 + (b) * 2 + (h)) * HTB)
#define PG8_STAGE(bufoff, gbase, voff) do { _Pragma("unroll") for (int _i = 0; _i < 2; ++_i) \
        __builtin_amdgcn_global_load_lds((const unsigned*)((const char*)(gbase) + (voff)[_i]), (PG8_LAS unsigned*)(lds + (bufoff) + ldsw + _i * 8192), 16, 0, 0); } while (0)
#define PG8_LDA(dst, b, h) do { _Pragma("unroll") for (int m = 0; m < 4; ++m) _Pragma("unroll") for (int k = 0; k < 2; ++k) dst[m][k] = *(const PG8_LAS bf16x8*)(lds + PG8_SA(b, h) + aoff + m * 2048 + k * 1024); } while (0)
#define PG8_LDB(dst, b, h) do { _Pragma("unroll") for (int n = 0; n < 2; ++n) _Pragma("unroll") for (int k = 0; k < 2; ++k) dst[n][k] = *(const PG8_LAS bf16x8*)(lds + PG8_SB(b, h) + boff + n * 2048 + k * 1024); } while (0)
#define PG8_MMA(ai, bj, At, Bt) do { __builtin_amdgcn_s_setprio(1); _Pragma("unroll") for (int m = 0; m < 4; ++m) _Pragma("unroll") for (int n = 0; n < 2; ++n) _Pragma("unroll") for (int k = 0; k < 2; ++k) \
        acc[ai][bj][m][n] = __builtin_amdgcn_mfma_f32_16x16x32_bf16(Bt[n][k], At[m][k], acc[ai][bj][m][n], 0, 0, 0); __builtin_amdgcn_s_setprio(0); } while (0)
#define PG8_WAIT_V(n) asm volatile("s_waitcnt vmcnt(" #n ")" ::: "memory")
#define PG8_WAIT_L(n) asm volatile("s_waitcnt lgkmcnt(" #n ")" ::: "memory")
#define PG8_BAR __builtin_amdgcn_s_barrier()
#define PG8_SCHED __builtin_amdgcn_sched_barrier(0)
    Unit cur, nxt; int ui = 0;
    if (!S.next(0, cur)) return;
    f32x4 acc[2][2][4][2];
#pragma unroll
    for (int a = 0; a < 2; ++a)
#pragma unroll
        for (int b = 0; b < 2; ++b)
#pragma unroll
            for (int m = 0; m < 4; ++m)
#pragma unroll
                for (int n = 0; n < 2; ++n) acc[a][b][m][n] = (f32x4){0.f, 0.f, 0.f, 0.f};
    bf16x8 At[4][2], B0[2][2], B1[2][2];
    const char* cA = (const char*)g.A + (size_t)cur.pm * tstepA; const char* cB = (const char*)g.Bt + (size_t)cur.pn * tstep;
    S.a_ready(cur);
    if constexpr (SP2) {
        PG8_STAGE(PG8_SB(0, 0), cB, voffB); PG8_STAGE(PG8_SB(0, 1), cB + hstep, voffB); PG8_STAGE(PG8_SA(0, 0), cA, voffA); PG8_STAGE(PG8_SA(0, 1), cA + hstepA, voffA);
        if (wr == 1) PG8_BAR;
        PG8_WAIT_V(2); PG8_BAR;
        PG8_STAGE(PG8_SB(1, 0), cB + kstep, voffB); PG8_STAGE(PG8_SA(1, 0), cA + kstep, voffA); PG8_STAGE(PG8_SB(1, 1), cB + hstep + kstep, voffB);
        PG8_WAIT_V(6); PG8_BAR;
    } else {
        PG8_STAGE(PG8_SB(0, 0), cB, voffB); PG8_STAGE(PG8_SA(0, 0), cA, voffA); PG8_STAGE(PG8_SB(0, 1), cB + hstep, voffB); PG8_STAGE(PG8_SA(0, 1), cA + hstepA, voffA);
        if (wr == 1) PG8_BAR;
        PG8_WAIT_V(4); PG8_BAR;
        PG8_STAGE(PG8_SB(1, 0), cB + kstep, voffB); PG8_STAGE(PG8_SA(1, 0), cA + kstep, voffA); PG8_STAGE(PG8_SB(1, 1), cB + hstep + kstep, voffB);
        PG8_WAIT_V(6); PG8_BAR;
    }
    for (;;) {
        const bool has_next = S.next(ui + 1, nxt);
        const char* nA = has_next ? (const char*)g.A + (size_t)nxt.pm * tstepA : cA; const char* nB = has_next ? (const char*)g.Bt + (size_t)nxt.pn * tstep : cB;
        for (int t = 0; t < nt; t += 2) {
            const bool last = (t == nt - 2);
            const char* a1 = cA + (size_t)(t + 1) * kstep;
            const char* a2 = last ? nA : cA + (size_t)(t + 2) * kstep; const char* b2 = last ? nB : cB + (size_t)(t + 2) * kstep;
            const char* a3 = a2 + kstep; const char* b3 = b2 + kstep;
            if (last && has_next) S.a_ready(nxt);
            if constexpr (SP2) {
            PG8_LDB(B0, 0, 0); PG8_LDB(B1, 0, 1); PG8_SCHED; PG8_LDA(At, 0, 0); PG8_STAGE(PG8_SA(1, 1), a1 + hstepA, voffA);
            PG8_WAIT_V(8); PG8_WAIT_L(0); PG8_BAR; PG8_MMA(0, 0, At, B0); PG8_MMA(0, 1, At, B1); PG8_BAR; PG8_SCHED;
            PG8_LDA(At, 0, 1); PG8_STAGE(PG8_SB(0, 0), b2, voffB); PG8_STAGE(PG8_SB(0, 1), b2 + hstep, voffB); PG8_STAGE(PG8_SA(0, 0), a2, voffA);
            PG8_WAIT_V(8); PG8_WAIT_L(0); PG8_BAR; PG8_MMA(1, 0, At, B0); PG8_MMA(1, 1, At, B1); PG8_BAR; PG8_SCHED;
            PG8_LDB(B0, 1, 0); PG8_LDB(B1, 1, 1); PG8_SCHED; PG8_LDA(At, 1, 0); PG8_STAGE(PG8_SA(0, 1), a2 + hstepA, voffA);
            PG8_WAIT_V(8); PG8_WAIT_L(0); PG8_BAR; PG8_MMA(0, 0, At, B0); PG8_MMA(0, 1, At, B1); PG8_BAR; PG8_SCHED;
            PG8_LDA(At, 1, 1); PG8_STAGE(PG8_SB(1, 0), b3, voffB); PG8_STAGE(PG8_SB(1, 1), b3 + hstep, voffB); PG8_STAGE(PG8_SA(1, 0), a3, voffA);
            PG8_WAIT_V(8); PG8_WAIT_L(0); PG8_BAR; PG8_MMA(1, 0, At, B0); PG8_MMA(1, 1, At, B1); PG8_BAR; PG8_SCHED;
            } else {
            PG8_LDB(B0, 0, 0); PG8_SCHED; PG8_LDA(At, 0, 0); PG8_STAGE(PG8_SA(1, 1), a1 + hstepA, voffA);
            PG8_WAIT_L(8); PG8_BAR; PG8_WAIT_L(0); PG8_MMA(0, 0, At, B0); PG8_BAR; PG8_SCHED;
            PG8_LDB(B1, 0, 1); PG8_STAGE(PG8_SB(0, 0), b2, voffB);
            PG8_BAR; PG8_WAIT_L(0); PG8_MMA(0, 1, At, B1); PG8_BAR;
            PG8_LDA(At, 0, 1); PG8_STAGE(PG8_SA(0, 0), a2, voffA);
            PG8_BAR; PG8_WAIT_L(0); PG8_MMA(1, 0, At, B0); PG8_BAR; PG8_SCHED;
            PG8_STAGE(PG8_SB(0, 1), b2 + hstep, voffB);
            PG8_WAIT_V(6); PG8_BAR; PG8_MMA(1, 1, At, B1); PG8_BAR;
            PG8_LDB(B0, 1, 0); PG8_SCHED; PG8_LDA(At, 1, 0); PG8_STAGE(PG8_SA(0, 1), a2 + hstepA, voffA);
            PG8_WAIT_L(8); PG8_BAR; PG8_WAIT_L(0); PG8_MMA(0, 0, At, B0); PG8_BAR; PG8_SCHED;
            PG8_LDB(B1, 1, 1); PG8_STAGE(PG8_SB(1, 0), b3, voffB);
            PG8_BAR; PG8_WAIT_L(0); PG8_MMA(0, 1, At, B1); PG8_BAR;
            PG8_LDA(At, 1, 1); PG8_STAGE(PG8_SA(1, 0), a3, voffA);
            PG8_BAR; PG8_WAIT_L(0); PG8_MMA(1, 0, At, B0); PG8_BAR; PG8_SCHED;
            PG8_STAGE(PG8_SB(1, 1), b3 + hstep, voffB);
            PG8_WAIT_V(6); PG8_BAR; PG8_MMA(1, 1, At, B1); PG8_BAR;
            }
        }
        if constexpr (ALIGN_EPI) { if (wr == 0) PG8_BAR; }
        if constexpr (!Epi::AFTER_DRAIN) { E(acc, cur, wr, wc, fr, fq); S.done(cur); }
        if (!has_next) break;
#pragma unroll
        for (int a = 0; a < 2; ++a)
#pragma unroll
            for (int b = 0; b < 2; ++b)
#pragma unroll
                for (int m = 0; m < 4; ++m)
#pragma unroll
                    for (int n = 0; n < 2; ++n) acc[a][b][m][n] = (f32x4){0.f, 0.f, 0.f, 0.f};
        cur = nxt; cA = nA; cB = nB; ++ui;
        if constexpr (ALIGN_EPI) { if (wr == 1) PG8_BAR; }
    }
    PG8_WAIT_V(0);
    if constexpr (!ALIGN_EPI) { if (wr == 0) PG8_BAR; }
    PG8_BAR;
    if constexpr (Epi::AFTER_DRAIN) { E.fused(acc, cur, wr, wc, fr, fq, lds, wid, lane); S.done(cur); }
#undef PG8_SA
#undef PG8_SB
#undef PG8_STAGE
#undef PG8_LDA
#undef PG8_LDB
#undef PG8_MMA
#undef PG8_WAIT_V
#undef PG8_WAIT_L
#undef PG8_BAR
#undef PG8_SCHED
}
struct SchedX { StaticOrder so; int mode;
  __device__ __forceinline__ bool next(int i, Unit& u) const {
    if (mode == 2) { if (i != 0 || so.c >= 8) return false; u.pm = (so.c >> 2) ? 33 : 0; u.pn = so.c & 3; return true; }
    if (!so.next(i, u)) return false; if (mode == 1) u.pm = u.pm + 1 + (u.pm >= 32 ? 1 : 0); return true; }
  __device__ __forceinline__ void a_ready(const Unit&) const {}
  __device__ __forceinline__ void done(const Unit&) const {} };
}
struct EpiRec8 { static constexpr bool PERM = true, AFTER_DRAIN = false; bf16_t* P1; bf16_t* P2; float* SM;
  DI void operator()(const f32x4 (&acc)[2][2][4][2], const pg8::Unit& u, int wr, int wc, int fr, int fq) const {
#pragma unroll
    for (int ai = 0; ai < 2; ++ai)
#pragma unroll
      for (int m = 0; m < 4; ++m) { const size_t row = (size_t)u.pm * 256 + ai * 128 + wr * 64 + m * 16 + fr;
#pragma unroll
        for (int bj = 0; bj < 2; ++bj) { const int col = u.pn * 256 + bj * 128 + wc * 32 + fq * 8; const f32x4 v0 = acc[ai][bj][m][0], v1 = acc[ai][bj][m][1];
          if (u.pn < 14) { const u32x4 w = {cvtpk(v0[0], v0[1]), cvtpk(v0[2], v0[3]), cvtpk(v1[0], v1[1]), cvtpk(v1[2], v1[3])};
            if (u.pn < 6) *(u32x4*)(P1 + row * 1536 + col) = w; else *(u32x4*)(P2 + row * 2048 + (col - 1536)) = w; }
          else { const int lc = col - 3584; if (lc < 48) { *(f32x4*)(SM + row * 64 + lc) = v0; *(f32x4*)(SM + row * 64 + lc + 4) = v1; } } } } } };
struct EpiBf8 { static constexpr bool PERM = true, AFTER_DRAIN = false; bf16_t* O; int ldc;
  DI void operator()(const f32x4 (&acc)[2][2][4][2], const pg8::Unit& u, int wr, int wc, int fr, int fq) const {
#pragma unroll
    for (int ai = 0; ai < 2; ++ai)
#pragma unroll
      for (int m = 0; m < 4; ++m) { const size_t row = (size_t)u.pm * 256 + ai * 128 + wr * 64 + m * 16 + fr;
#pragma unroll
        for (int bj = 0; bj < 2; ++bj) { const int col = u.pn * 256 + bj * 128 + wc * 32 + fq * 8; const f32x4 v0 = acc[ai][bj][m][0], v1 = acc[ai][bj][m][1];
          const u32x4 w = {cvtpk(v0[0], v0[1]), cvtpk(v0[2], v0[3]), cvtpk(v1[0], v1[1]), cvtpk(v1[2], v1[3])};
          *(u32x4*)(O + row * ldc + col) = w; } } } };
struct EpiRes8 { static constexpr bool PERM = true, AFTER_DRAIN = false; float* X; const float* gate;
  DI void operator()(const f32x4 (&acc)[2][2][4][2], const pg8::Unit& u, int wr, int wc, int fr, int fq) const {
    const float* gr = gate + (size_t)modrow_of(u.pm * 256) * 6144;
#pragma unroll
    for (int bj = 0; bj < 2; ++bj) { const int col = u.pn * 256 + bj * 128 + wc * 32 + fq * 8; const f32x4 g0 = *(const f32x4*)(gr + col), g1 = *(const f32x4*)(gr + col + 4);
#pragma unroll
      for (int ai = 0; ai < 2; ++ai)
#pragma unroll
        for (int m = 0; m < 4; ++m) { const size_t row = (size_t)u.pm * 256 + ai * 128 + wr * 64 + m * 16 + fr;
          f32x4* q = (f32x4*)(X + row * 1024 + col); const f32x4 x0 = q[0], x1 = q[1]; q[0] = x0 + g0 * acc[ai][bj][m][0]; q[1] = x1 + g1 * acc[ai][bj][m][1]; } } } };
template <class Epi>
__device__ __forceinline__ void gemm8(char* lds, const bf16_t* A, int lda, const bf16_t* Bt, int K, int N, int mode, const Epi& E) {
  pg8::Gemm g{A, Bt, mode == 1 ? 16384 : MROWS, N, K, lda};
  pg8::SchedX S; S.so.init(g.M, N, GDIM(), BIDX()); S.mode = mode;
  pg8::gemm_phase<Epi, pg8::SchedX, true, true>((PG8_LAS unsigned char*)lds, g, S, E);
}

__device__ __forceinline__ void ph_dnprep(const P& p, char* lds, int e) {
  const int tid = TIDX(), wid = tid >> 6, lane = tid & 63;
  const bf16_t* P1 = (const bf16_t*)(p.ws + OFF_D + D_P1);
  bf16_t* QQ = (bf16_t*)(p.ws + OFF_D + D_QQ); bf16_t* QK = (bf16_t*)(p.ws + OFF_D + D_QK); bf16_t* QV = (bf16_t*)(p.ws + OFF_D + D_QV);
  bf16_t* KT = (bf16_t*)(p.ws + OFF_D + D_KT);
  const float* SM = (const float*)(p.ws + OFF_SM); float* GB = (float*)(p.ws + OFF_GB);
  const float* cw = p.rec_conv + (size_t)e * 3 * 1536;
  bf16_t* kl = (bf16_t*)lds;
  for (int job = BIDX(); job < MROWS / 32; job += GDIM()) {
    const int R0 = job * 32;
    for (int tt = 0; tt < 4; ++tt) {
      const int tl = wid * 4 + tt, R = R0 + tl; const int b = R >= TB ? 1 : 0, pp = R - b * TB;
      const bool hasp = !(pp == 0 || pp == CTXL), hasn = !(pp == CTXL - 1 || pp == TB - 1);
#pragma unroll
      for (int part = 0; part < 3; ++part) {
        const int ch = part * 512 + lane * 8;
        const bf16x8 zc = *(const bf16x8*)(P1 + (size_t)R * 1536 + ch);
        bf16x8 zp = {}, zn = {};
        if (hasp) zp = *(const bf16x8*)(P1 + (size_t)(R - 1) * 1536 + ch);
        if (hasn) zn = *(const bf16x8*)(P1 + (size_t)(R + 1) * 1536 + ch);
        float o[8]; float ss = 0.f;
#pragma unroll
        for (int j = 0; j < 8; ++j) { const float a = bf2f((bf16_t)zp[j]) * cw[ch + j] + bf2f((bf16_t)zc[j]) * cw[1536 + ch + j] + bf2f((bf16_t)zn[j]) * cw[3072 + ch + j];
          o[j] = siluf(a); ss += o[j] * o[j]; }
        if (part < 2) {
          ss += __shfl_xor(ss, 1); ss += __shfl_xor(ss, 2); ss += __shfl_xor(ss, 4); ss += __shfl_xor(ss, 8);
          float sc = rsqrtf(ss + EPSF); if (part == 0) sc *= 0.08838834764831845f;
#pragma unroll
          for (int j = 0; j < 8; ++j) o[j] *= sc;
        }
        u32x4 w = {cvtpk(o[0], o[1]), cvtpk(o[2], o[3]), cvtpk(o[4], o[5]), cvtpk(o[6], o[7])};
        bf16_t* dst = part == 0 ? QQ : (part == 1 ? QK : QV);
        *(u32x4*)(dst + (size_t)R * 512 + lane * 8) = w;
        if (part == 1) *(u32x4*)(kl + tl * 512 + lane * 8) = w;
      }
      if (lane < 16) {
        const int q = lane & 7;
        if (lane < 8) { const float da = SM[(size_t)R * 64 + q]; GB[(size_t)R * 16 + q] = -expf(p.dn_a_log[e * 8 + q]) * softplusf(da + p.dn_dt_bias[e * 8 + q]); }
        else { const float db = SM[(size_t)R * 64 + 8 + q]; GB[(size_t)R * 16 + 8 + q] = sigmf(db); }
      }
    }
    __syncthreads();
    {
      const int b = R0 >= TB ? 1 : 0, c = (R0 - b * TB) / 64, half = ((R0 - b * TB) >> 5) & 1; const int h = tid >> 7, dk = tid & 127;
      bf16_t* dst = KT + ((((size_t)b * 4 + h) * NCH + c) * 128 + dk) * 64 + half * 32;
#pragma unroll
      for (int g8 = 0; g8 < 4; ++g8) { unsigned w[4];
#pragma unroll
        for (int j = 0; j < 4; ++j) { const unsigned lo = kl[(g8 * 8 + 2 * j) * 512 + tid], hi2 = kl[(g8 * 8 + 2 * j + 1) * 512 + tid]; w[j] = lo | (hi2 << 16); }
        *(u32x4*)(dst + g8 * 8) = (u32x4){w[0], w[1], w[2], w[3]}; }
    }
    __syncthreads();
  }
}

__device__ __forceinline__ void ph_dn_d1(const P& p, char* lds) {
  const int tid = TIDX(), wid = tid >> 6, lane = tid & 63, r32 = lane & 31, hi = lane >> 5;
  const bf16_t* QQ = (const bf16_t*)(p.ws + OFF_D + D_QQ); const bf16_t* QK = (const bf16_t*)(p.ws + OFF_D + D_QK); const bf16_t* QV = (const bf16_t*)(p.ws + OFF_D + D_QV);
  const float* GB = (const float*)(p.ws + OFF_GB);
  bf16_t* W_ = (bf16_t*)(p.ws + OFF_D + D_W); bf16_t* U_ = (bf16_t*)(p.ws + OFF_HBF); bf16_t* INTRA = (bf16_t*)(p.ws + OFF_D + D_INTRA);
  float* SC = (float*)(p.ws + OFF_SC); float* GLS = (float*)(p.ws + OFF_GL);
  float* KK = (float*)lds; float* QKm = KK + 64 * 65; float* Ad = QKm + 64 * 65; float* Gs = Ad + 2 * 4096; float* Bs = Gs + 128;
  bf16_t* Vs = (bf16_t*)(Bs + 128); bf16_t* Ks = Vs + 64 * 128;
  for (int job = BIDX(); job < 8 * NCH; job += GDIM()) {
    const int b = job / (4 * NCH), h = (job / NCH) & 3, c = job % NCH;
    const size_t Rb = (size_t)b * TB + (size_t)c * 64;
    {
      const int srow = tid >> 4, spc = (tid & 15) * 8;
      const u32x4 v0 = *(const u32x4*)(QV + (Rb + srow) * 512 + h * 128 + spc), v1 = *(const u32x4*)(QV + (Rb + 32 + srow) * 512 + h * 128 + spc);
      const u32x4 k0 = *(const u32x4*)(QK + (Rb + srow) * 512 + h * 128 + spc), k1 = *(const u32x4*)(QK + (Rb + 32 + srow) * 512 + h * 128 + spc);
      *(u32x4*)(Vs + srow * 128 + spc) = v0; *(u32x4*)(Vs + (32 + srow) * 128 + spc) = v1;
      *(u32x4*)(Ks + srow * 128 + spc) = k0; *(u32x4*)(Ks + (32 + srow) * 128 + spc) = k1;
    }
    {
      const int w4 = wid & 3, mi = w4 & 1, ni = w4 >> 1;
      const bf16_t* As = wid < 4 ? QK : QQ;
      const bf16_t* arow = As + (Rb + 32 * mi + r32) * 512 + h * 128 + hi * 8;
      const bf16_t* brow = QK + (Rb + 32 * ni + r32) * 512 + h * 128 + hi * 8;
      f32x16 acc = {}; acc = mma_rows<8>(arow, brow, acc);
      float* dst = wid < 4 ? KK : QKm;
#pragma unroll
      for (int r = 0; r < 16; ++r) dst[(32 * mi + crow(r, hi)) * 65 + 32 * ni + r32] = acc[r];
    }
    if (tid < 128) { const int d = tid >> 6, ip = tid & 63, t = d ? 63 - ip : ip; float g = GB[(Rb + t) * 16 + d * 4 + h]; Bs[tid] = GB[(Rb + t) * 16 + 8 + d * 4 + h];
#pragma unroll
      for (int o = 1; o < 64; o <<= 1) { const float v = __shfl_up(g, o); g += ip >= o ? v : 0.f; }
      Gs[tid] = g; }
    __syncthreads();
    const int n0 = c, n1 = c < 4 ? 3 - c : 135 - c;
    const size_t cj0 = ((size_t)(0 * 2 + b) * 4 + h) * NCH + n0, cj1 = ((size_t)(1 * 2 + b) * 4 + h) * NCH + n1;
    for (int e2 = tid; e2 < 8192; e2 += 512) {
      const int d = e2 >> 12, ip = (e2 >> 6) & 63, jp = e2 & 63; const int i = d ? 63 - ip : ip, j = d ? 63 - jp : jp;
      const float dec = jp <= ip ? __expf(Gs[d * 64 + ip] - Gs[d * 64 + jp]) : 0.f;
      Ad[d * 4096 + ip * 64 + jp] = jp < ip ? Bs[d * 64 + ip] * KK[i * 65 + j] * dec : 0.f;
      const size_t cj = d ? cj1 : cj0;
      INTRA[(cj * 64 + ip) * 64 + jp] = f2bf(QKm[i * 65 + j] * dec);
    }
    if (tid < 128) { const int d = tid >> 6, ip = tid & 63; const size_t cj = d ? cj1 : cj0; const float gi = Gs[tid], gl = Gs[d * 64 + 63];
      SC[(cj * 64 + ip) * 2] = __expf(gi); SC[(cj * 64 + ip) * 2 + 1] = __expf(gl - gi); if (ip == 0) GLS[cj] = __expf(gl); }
    __syncthreads();
    {
      const int d = tid >> 8, cc = tid & 255; const size_t cj = d ? cj1 : cj0;
      int dofs = d * 64, aofs = d * 4096; asm volatile("" : "+v"(dofs), "+v"(aofs));
      float x[64];
      {
        int vofs = cc < 128 ? cc : 64 * 128 + (cc - 128); asm volatile("" : "+v"(vofs));
#pragma unroll
        for (int ip = 0; ip < 64; ++ip) x[ip] = bf2f(Vs[vofs + ip * 128]);
#pragma unroll
        for (int ip = 0; ip < 32; ++ip) { const float a_ = x[ip], b_ = x[63 - ip]; x[ip] = d ? b_ : a_; x[63 - ip] = d ? a_ : b_; }
        if (cc < 128) {
#pragma unroll
          for (int ip = 0; ip < 64; ++ip) x[ip] *= Bs[dofs + ip];
        } else {
#pragma unroll
          for (int ip = 0; ip < 64; ++ip) x[ip] *= Bs[dofs + ip] * __expf(Gs[dofs + ip]);
        }
      }
      const float* Arow = Ad + aofs;
#pragma unroll
      for (int ip = 1; ip < 64; ++ip) {
        float s = 0.f;
#pragma unroll
        for (int j4 = 0; j4 < (ip + 3) / 4; ++j4) { const f32x4 a = *(const f32x4*)(Arow + ip * 64 + 4 * j4);
          s += a[0] * x[4 * j4] + a[1] * x[4 * j4 + 1] + a[2] * x[4 * j4 + 2] + a[3] * x[4 * j4 + 3]; }
        x[ip] -= s;
      }
      bf16_t* dst = cc < 128 ? U_ + cj * 64 * 128 + cc : W_ + cj * 64 * 128 + (cc - 128);
#pragma unroll
      for (int ip = 0; ip < 64; ++ip) dst[ip * 128] = f2bf(x[ip]);
    }
    __syncthreads();
  }
}

typedef _Float16 h16x8 __attribute__((ext_vector_type(8)));
__device__ __forceinline__ void ph_gla_b(const P& p, char* lds, int e) {
  const int tid = TIDX(), wid = tid >> 6, lane = tid & 63;
  const float* SM = (const float*)(p.ws + OFF_SM);
  float* w2S = (float*)lds;
  float* b2S = w2S + 8192;
  for (int i = tid; i < 8192; i += 512) { const int d = i >> 12, hh = (i >> 10) & 3, r = (i >> 6) & 15, j = i & 63; w2S[i] = p.gla_w2[(((size_t)e * 2 + d) * 16 + r) * 256 + hh * 64 + j]; }
  if (tid < 512) b2S[tid] = p.gla_b2[(size_t)e * 512 + tid];
  __syncthreads();
  int jb = 8 * wid; asm volatile("" : "+v"(jb));
  for (int job = GDIM() - 1 - BIDX(); job < 16 * NCH; job += GDIM()) {
    const int n = job % NCH, sq = job / NCH; const int dir = sq >> 3, b = (sq >> 2) & 1, h = sq & 3;
    const int c = dir == 0 ? n : (n < 4 ? 3 - n : 135 - n);
    const size_t row = (size_t)b * TB + (size_t)c * 64 + (dir ? 63 - lane : lane);
    const float* gp = SM + row * 64 + 16 + dir * 16;
    const f32x4 g0 = *(const f32x4*)(gp), g1 = *(const f32x4*)(gp + 4), g2 = *(const f32x4*)(gp + 8), g3 = *(const f32x4*)(gp + 12);
    const float gg_[16] = {g0[0], g0[1], g0[2], g0[3], g1[0], g1[1], g1[2], g1[3], g2[0], g2[1], g2[2], g2[3], g3[0], g3[1], g3[2], g3[3]};
    const float* wb = w2S + (dir * 4 + h) * 1024 + jb; const float* bb2 = b2S + dir * 256 + h * 64 + jb;
    f32x4 sa = *(const f32x4*)(bb2), sb = *(const f32x4*)(bb2 + 4);
#pragma unroll
    for (int r = 0; r < 16; ++r) { const f32x4 wa = *(const f32x4*)(wb + r * 64), wq = *(const f32x4*)(wb + r * 64 + 4); sa += gg_[r] * wa; sb += gg_[r] * wq; }
    float la[8];
#pragma unroll
    for (int jj = 0; jj < 4; ++jj) { const float x0 = sa[jj], x1 = sb[jj];
      la[jj] = (fminf(x0, 0.f) - log1pf(expf(-fabsf(x0)))) * 0.0625f; la[4 + jj] = (fminf(x1, 0.f) - log1pf(expf(-fabsf(x1)))) * 0.0625f; }
#pragma unroll
    for (int o = 1; o < 64; o <<= 1) {
#pragma unroll
      for (int jj = 0; jj < 8; ++jj) { const float v = __shfl_up(la[jj], o); la[jj] += lane >= o ? v : 0.f; }
    }
    h16x8 hv;
#pragma unroll
    for (int jj = 0; jj < 8; ++jj) hv[jj] = (_Float16)la[jj];
    _Float16* dst = (_Float16*)(p.ws + (dir ? OFF_B16_1 : OFF_WC)) + ((((size_t)b * 4 + h) * NCH + n) * 64 + lane) * 64 + jb;
    *(h16x8*)dst = hv;
  }
}

struct DnSet { bf16x8 fa[8]; };
template <int ROLE>
__device__ __forceinline__ void dn_scan_t(const P& p, char* lds, int job) {
  const int tid = TIDX(), wid = tid >> 6, lane = tid & 63, r32 = lane & 31, hi = lane >> 5;
  const int dir = job >> 5, b = (job >> 4) & 1, h = (job >> 2) & 3, n0 = (job & 3) * 32;
  const bf16_t* QQ = (const bf16_t*)(p.ws + OFF_D + D_QQ); const bf16_t* KT = (const bf16_t*)(p.ws + OFF_D + D_KT);
  const bf16_t* W_ = (const bf16_t*)(p.ws + OFF_D + D_W); const bf16_t* U_ = (const bf16_t*)(p.ws + OFF_HBF); const bf16_t* INTRA = (const bf16_t*)(p.ws + OFF_D + D_INTRA);
  const float* SC = (const float*)(p.ws + OFF_SC); const float* GLS = (const float*)(p.ws + OFF_GL);
  bf16_t* DNO = (bf16_t*)(p.ws + OFF_D + D_DNO);
  bf16_t* ST = (bf16_t*)lds; bf16_t* vTa = ST + 32 * 136; bf16_t* vTb = vTa + 32 * 72;
  float* scS = (float*)(vTb + 32 * 72);
  bf16_t* uS = (bf16_t*)(scS + 256);
  bf16_t* inS = uS + 2 * 64 * 40;
  for (int i = tid; i < 32 * 136; i += 512) ST[i] = 0;
  f32x16 accS = {};
  const size_t seq = ((size_t)dir * 2 + b) * 4 + h;
  const int mi = wid & 1, di = wid - 4;
  constexpr int role = ROLE;
  const int tt = tid - 256;
  DnSet fs[3]; float gls[3] = {0.f, 0.f, 0.f};
  u32x4 stU[3], stI0[3]; float stS[3] = {0.f, 0.f, 0.f};
#define DN_CH(n_) const int n__ = (n_); const int c__ = dir == 0 ? n__ : (n__ < 4 ? 3 - n__ : 135 - n__); const size_t Rb__ = (size_t)b * TB + (size_t)c__ * 64; const size_t cj__ = seq * NCH + n__;
#define DN_LOAD(S, GL, n_) do { DN_CH(n_) \
    const int ipl__ = 32 * mi + r32, tl__ = dir ? 63 - ipl__ : ipl__; \
    const bf16_t* b0__ = W_ + cj__ * 8192 + (32 * mi + r32) * 128 + hi * 8; \
    const bf16_t* b1__ = QQ + (Rb__ + tl__) * 512 + h * 128 + hi * 8; \
    const bf16_t* b2__ = KT + ((((size_t)b * 4 + h) * NCH + c__) * 128 + 32 * (wid & 3) + r32) * 64 + hi * 8; \
    const bf16_t* bs__ = role == 0 ? b0__ : (role == 1 ? b1__ : b2__); \
    _Pragma("unroll") for (int ks = 0; ks < 8; ++ks) S.fa[ks] = *(const bf16x8*)(bs__ + ks * 16); \
    GL = GLS[cj__]; } while (0)
#define DN_STAGE_LD(q_, n_) do { DN_CH(n_) (void)Rb__; \
      stU[q_] = *(const u32x4*)(U_ + cj__ * 8192 + ((tid & 255) >> 2) * 128 + n0 + (tid & 3) * 8); \
      stI0[q_] = *(const u32x4*)(INTRA + cj__ * 4096 + (tid >> 3) * 64 + (tid & 7) * 8); \
      stS[q_] = SC[cj__ * 128 + (tid & 127)]; } while (0)
#define DN_STAGE_ST(q_, bf_) do { *(u32x4*)(inS + (bf_) * 4608 + (tid >> 3) * 72 + (tid & 7) * 8) = stI0[q_]; \
      if (ROLE < 2) *(u32x4*)(uS + (bf_) * 2560 + (tid >> 2) * 40 + (tid & 3) * 8) = stU[q_]; \
      if (ROLE == 0) scS[(bf_) * 128 + tid] = stS[q_]; } while (0)
#define DN_STEP(S, GL, n_, bf_) do { DN_CH(n_) (void)cj__; \
    const float* sc__ = scS + (bf_) * 128; \
    if (role < 2) { _Pragma("unroll") for (int r = 0; r < 16; ++r) accS[r] = 0.f; } \
    if (role < 2) { const bf16_t* sb__ = ST + r32 * 136 + hi * 8; \
      _Pragma("unroll") for (int ks = 0; ks < 8; ++ks) accS = MFMA32(S.fa[ks], *(const bf16x8*)(sb__ + ks * 16), accS); \
      if (role == 0) { const bf16_t* us__ = uS + (bf_) * 2560 + r32; \
        _Pragma("unroll") for (int r = 0; r < 16; ++r) { const int ip = 32 * mi + crow(r, hi); const float vn = bf2f(us__[ip * 40]) - accS[r]; \
          vTa[r32 * 72 + ip] = f2bf(vn); const int to = dir ? 63 - ip : ip; vTb[r32 * 72 + to] = f2bf(vn * sc__[ip * 2 + 1]); } } \
      else { _Pragma("unroll") for (int r = 0; r < 16; ++r) accS[r] *= sc__[(32 * mi + crow(r, hi)) * 2]; } } \
    LBAR(); \
    if (role == 1) { const bf16_t* vb__ = vTa + r32 * 72 + hi * 8; const bf16_t* ib__ = inS + (bf_) * 4608 + (32 * mi + r32) * 72 + hi * 8; \
      _Pragma("unroll") for (int ks = 0; ks < 4; ++ks) accS = MFMA32(*(const bf16x8*)(ib__ + ks * 16), *(const bf16x8*)(vb__ + ks * 16), accS); \
      _Pragma("unroll") for (int r = 0; r < 16; ++r) { const int ip = 32 * mi + crow(r, hi), t = dir ? 63 - ip : ip; \
        DNO[((size_t)dir * MROWS + Rb__ + t) * 512 + h * 128 + n0 + r32] = f2bf(accS[r]); } } \
    else if (role == 2) { const bf16_t* vb__ = vTb + r32 * 72 + hi * 8; \
      _Pragma("unroll") for (int r = 0; r < 16; ++r) accS[r] *= GL; \
      _Pragma("unroll") for (int ks = 0; ks < 4; ++ks) accS = MFMA32(S.fa[ks], *(const bf16x8*)(vb__ + ks * 16), accS); \
      _Pragma("unroll") for (int r = 0; r < 16; ++r) ST[r32 * 136 + 32 * di + crow(r, hi)] = f2bf(accS[r]); } \
    LBAR(); } while (0)
  DN_STAGE_LD(0, 0); DN_STAGE_ST(0, 0); DN_STAGE_LD(1, 1); DN_STAGE_LD(2, 2);
  DN_LOAD(fs[0], gls[0], 0); DN_LOAD(fs[1], gls[1], 1);
  __syncthreads();
  for (int nb6 = 0; nb6 < NCH; nb6 += 6) {
#pragma unroll
    for (int k = 0; k < 6; ++k) {
      const int n = nb6 + k; const int n2 = n + 2 < NCH ? n + 2 : NCH - 1; const int n3 = n + 3 < NCH ? n + 3 : NCH - 1;
      DN_STAGE_ST((k + 1) % 3, (k + 1) & 1);
      DN_STAGE_LD(k % 3, n3);
      DN_LOAD(fs[(k + 2) % 3], gls[(k + 2) % 3], n2);
      DN_STEP(fs[k % 3], gls[k % 3], n, k & 1);
    }
  }
#undef DN_CH
#undef DN_LOAD
#undef DN_STAGE_LD
#undef DN_STAGE_ST
#undef DN_STEP
}

__device__ __forceinline__ void dn_scan(const P& p, char* lds, int job) {
  const int wid = TIDX() >> 6;
  if (wid < 2) dn_scan_t<0>(p, lds, job); else if (wid < 4) dn_scan_t<1>(p, lds, job); else dn_scan_t<2>(p, lds, job);
}

DI float fast_logsig(float s) { return fminf(s, 0.f) - __logf(1.f + __expf(-fabsf(s))); }
struct GlaRegs { h16x8 ba, bb; bf16x8 qa, qb, ka, kb, v8; };
template <int ROLE>
__device__ __forceinline__ void gla_scan_t(const P& p, char* lds, int job, int e) {
  const int tid = TIDX(), wid = tid >> 6, lane = tid & 63, r32 = lane & 31, hi = lane >> 5;
  const int dir = job >> 5, b = (job >> 4) & 1, h = (job >> 2) & 3, n0 = (job & 3) * 32;
  const bf16_t* P2 = (const bf16_t*)(p.ws + OFF_D + D_P2); const float* SM = (const float*)(p.ws + OFF_SM);
  bf16_t* GLAO = (bf16_t*)(p.ws + OFF_D + D_GLAO);
  const _Float16* B16 = (const _Float16*)(p.ws + (dir ? OFF_B16_1 : OFF_WC));
  float* w2S = (float*)lds; float* b2S = w2S + 1024; float* aLb = b2S + 64;
  bf16_t* ops = (bf16_t*)(aLb + 128);
  constexpr int OPB = (4 * 64 + 32) * 72;
  bf16_t* attp = ops + 2 * OPB;
  bf16_t* STb = attp + 2 * 32 * 72;
  for (int i = tid; i < 2 * 32 * 72; i += 512) STb[i] = 0;
  f32x16 accS = {};
  __syncthreads();
  GlaRegs RG[3];
  int jb0 = 16 * (wid & 3); asm volatile("" : "+v"(jb0));
  int vtb0 = 8 * (wid & 3) * 72 + lane; asm volatile("" : "+v"(vtb0));
#define GLA_LOAD(R, n_) do { const int n__ = (n_) < NCH ? (n_) : NCH - 1; const int c__ = dir == 0 ? n__ : (n__ < 4 ? 3 - n__ : 135 - n__); const size_t row__ = (size_t)b * TB + (size_t)c__ * 64 + (dir ? 63 - lane : lane); \
    const _Float16* bp__ = B16 + ((((size_t)b * 4 + h) * NCH + n__) * 64 + lane) * 64 + 16 * (wid & 3); R.ba = *(const h16x8*)(bp__); R.bb = *(const h16x8*)(bp__ + 8); \
    const bf16_t* pr__ = P2 + row__ * 2048; R.qa = *(const bf16x8*)(pr__ + 512 + h * 64 + 16 * (wid & 3)); R.qb = *(const bf16x8*)(pr__ + 512 + h * 64 + 16 * (wid & 3) + 8); \
    R.ka = *(const bf16x8*)(pr__ + 768 + h * 64 + 16 * (wid & 3)); R.kb = *(const bf16x8*)(pr__ + 768 + h * 64 + 16 * (wid & 3) + 8); R.v8 = *(const bf16x8*)(pr__ + 1024 + h * 128 + n0 + 8 * (wid & 3)); } while (0)
#define GLA_HALF(R, BV, QV, KV, jb) do { \
    float eqe[8], eke[8], eqi[8]; \
    _Pragma("unroll") for (int jj = 0; jj < 8; ++jj) { const int j = (jb) + jj; const float bb = (float)BV[jj]; const float bm = __int_as_float(__builtin_amdgcn_readlane(__float_as_int(bb), 32)), bl = __int_as_float(__builtin_amdgcn_readlane(__float_as_int(bb), 63)); \
      const float q_ = bf2f((bf16_t)QV[jj]) * 0.125f, k_ = bf2f((bf16_t)KV[jj]); \
      eqe[jj] = q_ * __expf(bb - bm); eke[jj] = k_ * __expf(bm - bb); eqi[jj] = q_ * __expf(bb); ksT_[j * 72 + lane] = f2bf(k_ * __expf(bl - bb)); if (lane == 63) aL_[j] = __expf(bl); } \
    *(u32x4*)(qe_ + lane * 72 + (jb)) = (u32x4){cvtpk(eqe[0], eqe[1]), cvtpk(eqe[2], eqe[3]), cvtpk(eqe[4], eqe[5]), cvtpk(eqe[6], eqe[7])}; \
    *(u32x4*)(ke_ + lane * 72 + (jb)) = (u32x4){cvtpk(eke[0], eke[1]), cvtpk(eke[2], eke[3]), cvtpk(eke[4], eke[5]), cvtpk(eke[6], eke[7])}; \
    *(u32x4*)(qi_ + lane * 72 + (jb)) = (u32x4){cvtpk(eqi[0], eqi[1]), cvtpk(eqi[2], eqi[3]), cvtpk(eqi[4], eqi[5]), cvtpk(eqi[6], eqi[7])}; } while (0)
#define GLA_PREP(R, bf_) do { bf16_t* qe_ = ops + (bf_) * OPB; bf16_t* ke_ = qe_ + 64 * 72; bf16_t* qi_ = ke_ + 64 * 72; bf16_t* ksT_ = qi_ + 64 * 72; bf16_t* vT_ = ksT_ + 64 * 72; float* aL_ = aLb + (bf_) * 64; \
    GLA_HALF(R, R.ba, R.qa, R.ka, jb0); GLA_HALF(R, R.bb, R.qb, R.kb, jb0 + 8); \
    _Pragma("unroll") for (int q_ = 0; q_ < 8; ++q_) vT_[vtb0 + q_ * 72] = (bf16_t)R.v8[q_]; } while (0)
#define GLA_MMA(n_, bf_) do { const int nq__ = (n_); const int bf = (bf_); \
      const bf16_t* qe_ = ops + bf * OPB; const bf16_t* ke_ = qe_ + 64 * 72; const bf16_t* qi_ = ke_ + 64 * 72; const bf16_t* ksT_ = qi_ + 64 * 72; const bf16_t* vT_ = ksT_ + 64 * 72; const float* aL_ = aLb + bf * 64; \
      const bf16_t* STr = STb + bf * 32 * 72; bf16_t* STw = STb + (bf ^ 1) * 32 * 72; \
      if (ROLE == 1) { \
        const int mi = wid - 4; bf16_t* attw = attp + mi * 32 * 72; \
        const int c = dir == 0 ? nq__ : (nq__ < 4 ? 3 - nq__ : 135 - nq__); const size_t Rb = (size_t)b * TB + (size_t)c * 64; \
        f32x16 acc = {}; acc = mma_rows<4>(qi_ + (32 * mi + r32) * 72 + hi * 8, STr + r32 * 72 + hi * 8, acc); \
        { f32x16 a0 = {}; a0 = mma_rows<4>(qe_ + (32 * mi + r32) * 72 + hi * 8, ke_ + r32 * 72 + hi * 8, a0); \
          _Pragma("unroll") for (int r = 0; r < 16; ++r) { const int ipl = crow(r, hi); attw[ipl * 72 + r32] = f2bf((mi == 1 || r32 <= ipl) ? a0[r] : 0.f); } \
          f32x16 a1 = {}; if (mi == 1) a1 = mma_rows<4>(qe_ + (32 + r32) * 72 + hi * 8, ke_ + (32 + r32) * 72 + hi * 8, a1); \
          _Pragma("unroll") for (int r = 0; r < 16; ++r) { const int ipl = crow(r, hi); attw[ipl * 72 + 32 + r32] = f2bf((mi == 1 && r32 <= ipl) ? a1[r] : 0.f); } } \
        asm volatile("s_waitcnt lgkmcnt(0)" ::: "memory"); \
        acc = mma_rows<4>(attw + r32 * 72 + hi * 8, vT_ + r32 * 72 + hi * 8, acc); \
        _Pragma("unroll") for (int r = 0; r < 16; ++r) { const int ip = 32 * mi + crow(r, hi), t = dir ? 63 - ip : ip; \
          GLAO[((size_t)dir * MROWS + Rb + t) * 512 + h * 128 + n0 + r32] = f2bf(acc[r]); } \
      } else { \
        const int di = wid - 6; \
        _Pragma("unroll") for (int r = 0; r < 16; ++r) accS[r] *= aL_[32 * di + crow(r, hi)]; \
        accS = mma_rows<4>(ksT_ + (32 * di + r32) * 72 + hi * 8, vT_ + r32 * 72 + hi * 8, accS); \
        _Pragma("unroll") for (int r = 0; r < 16; ++r) STw[r32 * 72 + 32 * di + crow(r, hi)] = f2bf(accS[r]); \
      } } while (0)
  GLA_LOAD(RG[0], 0);
  if (ROLE == 0) { GLA_PREP(RG[0], 0); }
  GLA_LOAD(RG[1], 1); GLA_LOAD(RG[2], 2); GLA_LOAD(RG[0], 3);
  LBAR();
  for (int nb6 = 0; nb6 < NCH; nb6 += 6) {
#pragma unroll
    for (int k = 0; k < 6; ++k) {
      const int n = nb6 + k;
      if (ROLE == 0) { if (n + 1 < NCH) { GLA_PREP(RG[(k + 1) % 3], (k + 1) & 1); } } else { GLA_MMA(n, k & 1); }
      GLA_LOAD(RG[(k + 1) % 3], n + 4);
      LBAR();
    }
  }
#undef GLA_MMA
#undef GLA_LOAD
#undef GLA_HALF
#undef GLA_PREP
}

__device__ __forceinline__ void gla_scan(const P& p, char* lds, int job, int e) {
  const int wid = TIDX() >> 6;
  if (wid < 4) gla_scan_t<0>(p, lds, job, e); else if (wid < 6) gla_scan_t<1>(p, lds, job, e); else gla_scan_t<2>(p, lds, job, e);
}

__device__ __forceinline__ void ph_merge(const P& p, int e) {
  const int tid = TIDX(), wid = tid >> 6, lane = tid & 63, l16 = lane & 15, sub = lane >> 4;
  const bf16_t* DNO = (const bf16_t*)(p.ws + OFF_D + D_DNO); const bf16_t* GLAO = (const bf16_t*)(p.ws + OFF_D + D_GLAO);
  const bf16_t* P2 = (const bf16_t*)(p.ws + OFF_D + D_P2); bf16_t* hb = (bf16_t*)(p.ws + OFF_HBF);
  f32x8 nwd = *(const f32x8*)(p.dn_norm + e * 128 + l16 * 8), nwg = *(const f32x8*)(p.gla_norm + e * 128 + l16 * 8);
  for (int R4 = (BIDX() * 8 + wid) * 4; R4 < MROWS; R4 += GDIM() * 32) {
    const size_t R = R4 + sub;
    bf16x8 a[8], bq[8], zz[8];
#pragma unroll
    for (int g = 0; g < 8; ++g) { const bf16_t* src = g < 4 ? DNO : GLAO; const int hc = (g & 3) * 128 + l16 * 8;
      a[g] = *(const bf16x8*)(src + R * 512 + hc); bq[g] = *(const bf16x8*)(src + ((size_t)MROWS + R) * 512 + hc);
      zz[g] = *(const bf16x8*)(P2 + R * 2048 + (g < 4 ? 0 : 1536) + hc); }
#pragma unroll
    for (int g = 0; g < 8; ++g) {
      float v[8]; float ss = 0.f;
#pragma unroll
      for (int j = 0; j < 8; ++j) { v[j] = bf2f((bf16_t)a[g][j]) + bf2f((bf16_t)bq[g][j]); ss += v[j] * v[j]; }
      ss += __shfl_xor(ss, 1); ss += __shfl_xor(ss, 2); ss += __shfl_xor(ss, 4); ss += __shfl_xor(ss, 8);
      const float rs = rsqrtf(ss * (1.f / 128.f) + EPSF);
      float o[8];
#pragma unroll
      for (int j = 0; j < 8; ++j) o[j] = v[j] * rs * (g < 4 ? nwd[j] : nwg[j]) * siluf(bf2f((bf16_t)zz[g][j]));
      *(u32x4*)(hb + R * 1024 + g * 128 + l16 * 8) = (u32x4){cvtpk(o[0], o[1]), cvtpk(o[2], o[3]), cvtpk(o[4], o[5]), cvtpk(o[6], o[7])};
    }
  }
}

DI float silu_fast(float x) { return x / (1.f + __expf(-x)); }
__device__ __forceinline__ void ph_ffnact(const P& p, int L) {
  bf16_t* U = (bf16_t*)(p.ws + OFF_D);
  const float* cw = p.ffn_conv + (size_t)L * 3 * DFF;
  const size_t items = (size_t)MROWS * 352, stride = (size_t)GDIM() * 512;
  for (size_t it0 = (size_t)BIDX() * 512 + TIDX(); it0 < items; it0 += 2 * stride) {
    bf16x8 zc[2], zp[2], zn[2], vv[2]; int Rr[2], cc[2]; bool ok[2];
#pragma unroll
    for (int q = 0; q < 2; ++q) {
      size_t it = it0 + q * stride; ok[q] = it < items; if (!ok[q]) it = it0;
      const int R = (int)(it / 352), c0 = (int)(it % 352) * 8; const int b = R >= TB ? 1 : 0, pp = R - b * TB;
      const bool hasp = !(pp == 0 || pp == CTXL), hasn = !(pp == CTXL - 1 || pp == TB - 1);
      Rr[q] = R; cc[q] = c0;
      zc[q] = *(const bf16x8*)(U + (size_t)R * 5632 + c0);
      zp[q] = *(const bf16x8*)(U + (size_t)(hasp ? R - 1 : R) * 5632 + c0);
      zn[q] = *(const bf16x8*)(U + (size_t)(hasn ? R + 1 : R) * 5632 + c0);
      vv[q] = *(const bf16x8*)(U + (size_t)R * 5632 + DFF + c0);
      if (!hasp) zp[q] = (bf16x8){0, 0, 0, 0, 0, 0, 0, 0};
      if (!hasn) zn[q] = (bf16x8){0, 0, 0, 0, 0, 0, 0, 0};
    }
#pragma unroll
    for (int q = 0; q < 2; ++q) {
      const int c0 = cc[q];
      const f32x8 w0 = *(const f32x8*)(cw + c0), w1 = *(const f32x8*)(cw + DFF + c0), w2 = *(const f32x8*)(cw + 2 * DFF + c0);
      float o[8];
#pragma unroll
      for (int j = 0; j < 8; ++j) { const float a = bf2f((bf16_t)zp[q][j]) * w0[j] + bf2f((bf16_t)zc[q][j]) * w1[j] + bf2f((bf16_t)zn[q][j]) * w2[j];
        o[j] = silu_fast(a) * bf2f((bf16_t)vv[q][j]); }
      if (ok[q]) *(u32x4*)(U + (size_t)Rr[q] * 5632 + DFF + c0) = (u32x4){cvtpk(o[0], o[1]), cvtpk(o[2], o[3]), cvtpk(o[4], o[5]), cvtpk(o[6], o[7])};
    }
  }
}

__device__ __forceinline__ void ph_qknorm(const P& p, char* lds, int o) {
  const int tid = TIDX(), wid = tid >> 6, lane = tid & 63, l16 = lane & 15, sub = lane >> 4;
  bf16_t* QKV = (bf16_t*)(p.ws + OFF_D);
  float* tab = (float*)lds;
  for (int i = tid; i < 4096; i += 512) { const int pos = i >> 5, f = i & 31; const float ang = (float)pos * powf(10000.f, -(float)f / 32.f); tab[2 * i] = cosf(ang); tab[2 * i + 1] = sinf(ang); }
  __syncthreads();
  const f32x8 qn = *(const f32x8*)(p.att_q_norm + o * 128 + l16 * 8), kn = *(const f32x8*)(p.att_k_norm + o * 128 + l16 * 8);
  const int f0 = (l16 & 3) * 8;
  for (int R4 = (BIDX() * 8 + wid) * 4; R4 < MROWS; R4 += GDIM() * 32) {
    const int R = R4 + sub; const int b = R >= TB ? 1 : 0, pp = R - b * TB; const bool lat = pp >= CTXL; const int t = lat ? pp - CTXL : 0;
    const int pos = (l16 < 8) ? (t >> 6) : (t & 63);
    bf16_t* base = QKV + (size_t)R * 1536 + l16 * 8;
    bf16x8 x[10];
#pragma unroll
    for (int hd = 0; hd < 10; ++hd) x[hd] = *(const bf16x8*)(base + hd * 128);
    float cs[8], sn[8];
#pragma unroll
    for (int j = 0; j < 8; ++j) { const float2 t2 = *(const float2*)(tab + 2 * (pos * 32 + f0 + j)); cs[j] = lat ? t2.x : 1.f; sn[j] = lat ? t2.y : 0.f; }
#pragma unroll
    for (int hd = 0; hd < 10; ++hd) {
      float v[8]; float ss = 0.f;
#pragma unroll
      for (int j = 0; j < 8; ++j) { v[j] = bf2f((bf16_t)x[hd][j]); ss += v[j] * v[j]; }
      ss += __shfl_xor(ss, 1); ss += __shfl_xor(ss, 2); ss += __shfl_xor(ss, 4); ss += __shfl_xor(ss, 8);
      const float rs = rsqrtf(ss * (1.f / 128.f) + EPSF);
      float ov[8];
#pragma unroll
      for (int j = 0; j < 8; ++j) { v[j] = v[j] * rs * (hd < 8 ? qn[j] : kn[j]); const float pr = __shfl_xor(v[j], 4);
        ov[j] = (l16 & 4) ? (pr * sn[j] + v[j] * cs[j]) : (v[j] * cs[j] - pr * sn[j]); }
      *(u32x4*)(base + hd * 128) = (u32x4){cvtpk(ov[0], ov[1]), cvtpk(ov[2], ov[3]), cvtpk(ov[4], ov[5]), cvtpk(ov[6], ov[7])};
    }
  }
}

__device__ __forceinline__ void qk_fused(const P& p, char* lds, int o) {
  const int tid = TIDX(), l16 = tid & 15, grp = tid >> 4;
  bf16_t* QKV = (bf16_t*)(p.ws + OFF_D);
  float* tab = (float*)lds;
  for (int i = tid; i < 4096; i += 512) { const int pos = i >> 5, f = i & 31; const float ang = (float)pos * powf(10000.f, -(float)f / 32.f); tab[2 * i] = cosf(ang); tab[2 * i + 1] = sinf(ang); }
  asm volatile("s_waitcnt vmcnt(0)" ::: "memory");
  __syncthreads();
  const int f0 = (l16 & 3) * 8;
  pg8::SchedX S; S.so.init(MROWS, 1536, GDIM(), BIDX()); S.mode = 0;
  pg8::Unit u;
  for (int ui = 0; S.next(ui, u); ++ui) {
    if (u.pn >= 5) continue;
    const f32x8 nw = *(const f32x8*)((u.pn < 4 ? p.att_q_norm : p.att_k_norm) + o * 128 + l16 * 8);
    for (int it0 = grp; it0 < 512; it0 += 128) {
      bf16x8 x[4]; bf16_t* base[4]; int pos[4]; bool lat[4];
#pragma unroll
      for (int q = 0; q < 4; ++q) { const int it = it0 + q * 32;
        const int R = u.pm * 256 + (it >> 1); const int b = R >= TB ? 1 : 0, pp = R - b * TB; lat[q] = pp >= CTXL; const int t = lat[q] ? pp - CTXL : 0;
        pos[q] = (l16 < 8) ? (t >> 6) : (t & 63);
        base[q] = QKV + (size_t)R * 1536 + u.pn * 256 + (it & 1) * 128 + l16 * 8; x[q] = *(const bf16x8*)base[q]; }
#pragma unroll
      for (int q = 0; q < 4; ++q) {
        float v[8]; float ss = 0.f;
#pragma unroll
        for (int j = 0; j < 8; ++j) { v[j] = bf2f((bf16_t)x[q][j]); ss += v[j] * v[j]; }
        ss += __shfl_xor(ss, 1); ss += __shfl_xor(ss, 2); ss += __shfl_xor(ss, 4); ss += __shfl_xor(ss, 8);
        const float rs = rsqrtf(ss * (1.f / 128.f) + EPSF);
        float ov[8];
#pragma unroll
        for (int j = 0; j < 8; ++j) { const float2 t2 = *(const float2*)(tab + 2 * (pos[q] * 32 + f0 + j)); const float cs = lat[q] ? t2.x : 1.f, sn = lat[q] ? t2.y : 0.f;
          v[j] = v[j] * rs * nw[j]; const float pr = __shfl_xor(v[j], 4);
          ov[j] = (l16 & 4) ? (pr * sn + v[j] * cs) : (v[j] * cs - pr * sn); }
        *(u32x4*)base[q] = (u32x4){cvtpk(ov[0], ov[1]), cvtpk(ov[2], ov[3]), cvtpk(ov[4], ov[5]), cvtpk(ov[6], ov[7])};
      }
    }
  }
}

namespace at {
constexpr int D = 128, NW = 8, QBLK = 32, KVBLK = 64;
constexpr float SCALE = 0.088388347648318440f, THR = 8.f;
constexpr int LDQ = 1536, LDK = 1536, LDO = 1024;
constexpr size_t SHM_V = KVBLK * D * 2, SHM_K = KVBLK * D * 2;
#define KSWZ(row, colB) ((row) * 256 + ((colB) ^ (((row) & 7) << 4)))
#define SBAR() __builtin_amdgcn_sched_barrier(0)
DI void partialSM(f32x16& p0, f32x16& p1, float& m_reg, float& mn, float& alpha) {
  constexpr float C = SCALE * 1.4426950408889634f;
  float pmax = p0[0]; for (int r = 1; r < 16; ++r) pmax = fmaxf(pmax, p0[r]); for (int r = 0; r < 16; ++r) pmax = fmaxf(pmax, p1[r]);
  { auto rr = __builtin_amdgcn_permlane32_swap(__float_as_uint(pmax), __float_as_uint(pmax), false, false);
    pmax = fmaxf(__uint_as_float(rr[0]), __uint_as_float(rr[1])); }
  if (__builtin_expect(__all(pmax - m_reg <= THR / SCALE), 1)) { mn = m_reg; alpha = 1.f; }
  else { mn = fmaxf(m_reg, pmax); alpha = __builtin_amdgcn_exp2f((m_reg - mn) * C); m_reg = mn; }
  float mnC = -mn * C;
  for (int r = 0; r < 16; ++r) p0[r] = fmaf(p0[r], C, mnC); for (int r = 0; r < 16; ++r) p1[r] = fmaf(p1[r], C, mnC);
  for (int r = 0; r < 16; ++r) p0[r] = __builtin_amdgcn_exp2f(p0[r]);
}
DI void finishSM(f32x16& p0, f32x16& p1, float alpha, float& l_reg, bf16x8& pa0, bf16x8& pa1, bf16x8& pa2, bf16x8& pa3) {
  for (int r = 0; r < 16; ++r) p1[r] = __builtin_amdgcn_exp2f(p1[r]);
  float ps = 0; for (int r = 0; r < 16; ++r) ps += p0[r]; for (int r = 0; r < 16; ++r) ps += p1[r];
  { auto rr = __builtin_amdgcn_permlane32_swap(__float_as_uint(ps), __float_as_uint(ps), false, false);
    ps = __uint_as_float(rr[0]) + __uint_as_float(rr[1]); }
  l_reg = l_reg * alpha + ps;
#define PK4(PP, BASE, OUT) do { unsigned a0 = cvtpk(PP[BASE + 0], PP[BASE + 1]), a1 = cvtpk(PP[BASE + 2], PP[BASE + 3]);   \
    unsigned b0 = cvtpk(PP[BASE + 4], PP[BASE + 5]), b1 = cvtpk(PP[BASE + 6], PP[BASE + 7]);                              \
    auto r0 = __builtin_amdgcn_permlane32_swap(a0, b0, false, false); auto r1 = __builtin_amdgcn_permlane32_swap(a1, b1, false, false); \
    u32x4 w = {r0[0], r1[0], r0[1], r1[1]}; OUT = *reinterpret_cast<bf16x8*>(&w); } while (0)
  PK4(p0, 0, pa0); PK4(p0, 8, pa1); PK4(p1, 0, pa2); PK4(p1, 8, pa3);
#undef PK4
}
DI void qkt(f32x16& p0, f32x16& p1, const bf16_t* Ks, const bf16x8* qr, int r32, int hi) {
  p0 = f32x16{}; p1 = f32x16{};
  for (int d0 = 0; d0 < 8; ++d0) { int cb = (d0 * 16 + hi * 8) * 2;
    bf16x8 b0 = *reinterpret_cast<const bf16x8*>((const char*)Ks + KSWZ(r32, cb));
    bf16x8 b1 = *reinterpret_cast<const bf16x8*>((const char*)Ks + KSWZ(32 + r32, cb));
    p0 = MFMA32(b0, qr[d0], p0);
    p1 = MFMA32(b1, qr[d0], p1); }
}
DI int v_st(int k, int c) { const int kk = (k & ~0xC) | ((k & 4) << 1) | ((k & 8) >> 1); return ((kk >> 3) * 4 + (c >> 5)) * 512 + ((kk & 7) * 32 + (c & 31)) * 2; }
DI int v_rd_base(int lane) { return ((lane & 3) << 3) | (((lane >> 2) & 3) << 6) | (((lane >> 4) & 1) << 5) | (((lane >> 5) & 1) << 8); }
constexpr int v_rd_off(int d0, int ks, int half) { return d0 * 512 + ks * 4096 + half * 2048; }
template <int OFF> DI s16x4 tr_read(int vb) {
  s16x4 r; asm volatile("ds_read_b64_tr_b16 %0, %1 offset:%2" : "=&v"(r) : "v"(vb), "i"(OFF) : "memory"); return r;
}
template <int D0> DI void pv_one(f32x16& od, int vb, bf16x8 pa0, bf16x8 pa1, bf16x8 pa2, bf16x8 pa3) {
  const s16x4 l0 = tr_read<v_rd_off(D0, 0, 0)>(vb), h0 = tr_read<v_rd_off(D0, 0, 1)>(vb), l1 = tr_read<v_rd_off(D0, 1, 0)>(vb), h1 = tr_read<v_rd_off(D0, 1, 1)>(vb);
  const s16x4 l2 = tr_read<v_rd_off(D0, 2, 0)>(vb), h2 = tr_read<v_rd_off(D0, 2, 1)>(vb), l3 = tr_read<v_rd_off(D0, 3, 0)>(vb), h3 = tr_read<v_rd_off(D0, 3, 1)>(vb);
  asm volatile("s_waitcnt lgkmcnt(0)" ::: "memory"); SBAR();
#define PK(Lx, Hx) (bf16x8){Lx[0], Lx[1], Lx[2], Lx[3], Hx[0], Hx[1], Hx[2], Hx[3]}
  od = MFMA32(pa0, PK(l0, h0), od);
  od = MFMA32(pa1, PK(l1, h1), od);
  od = MFMA32(pa2, PK(l2, h2), od);
  od = MFMA32(pa3, PK(l3, h3), od);
#undef PK
}
DI void pv_d0(f32x16* o, int vb, bf16x8 pa0, bf16x8 pa1, bf16x8 pa2, bf16x8 pa3) {
  pv_one<0>(o[0], vb, pa0, pa1, pa2, pa3); pv_one<1>(o[1], vb, pa0, pa1, pa2, pa3); pv_one<2>(o[2], vb, pa0, pa1, pa2, pa3); pv_one<3>(o[3], vb, pa0, pa1, pa2, pa3);
}
DI void attn_dense_body(const bf16_t* __restrict__ Qb, const bf16_t* __restrict__ Kh, const bf16_t* __restrict__ Vh, bf16_t* __restrict__ Ob, int seq, char* lds) {
  const int tid = TIDX(), wid = tid >> 6, lane = tid & 63, r32 = lane & 31, hi = lane >> 5;
  bf16_t* V_lds = (bf16_t*)lds; bf16_t* K_lds = (bf16_t*)(lds + 2 * SHM_V);
  float* ws = (float*)(lds + 2 * SHM_V + 2 * SHM_K) + wid * 64; float* li_l = ws; float* al_l = ws + 32;
  float m_reg = -1e30f, l_reg = 0; f32x16 o[4] = {}; bf16x8 qr[8];
  const bf16_t* Qw = Qb + (long)(wid * QBLK + r32) * LDQ + hi * 8;
#pragma unroll
  for (int d0 = 0; d0 < 8; ++d0) qr[d0] = *reinterpret_cast<const bf16x8*>(Qw + d0 * 16);
  const int sr = tid >> 4, sc = (tid & 15) * 8, vst0 = v_st(sr, sc), vst1 = v_st(32 + sr, sc);
  const int vb0 = (int)(uintptr_t)V_lds + v_rd_base(lane);
  struct { bf16x8 vs0, vs1, ks0, ks1; } sr_[2];
#define SLOAD(i, k0) do { sr_[i].vs0 = *(const bf16x8*)(&Vh[(long)((k0) + sr) * LDK + sc]); sr_[i].vs1 = *(const bf16x8*)(&Vh[(long)((k0) + 32 + sr) * LDK + sc]); \
    sr_[i].ks0 = *(const bf16x8*)(&Kh[(long)((k0) + sr) * LDK + sc]); sr_[i].ks1 = *(const bf16x8*)(&Kh[(long)((k0) + 32 + sr) * LDK + sc]); } while (0)
#define SWRITE(bq, i) do { *(bf16x8*)((char*)V_lds + (bq) * SHM_V + vst0) = sr_[i].vs0;          \
    *(bf16x8*)((char*)V_lds + (bq) * SHM_V + vst1) = sr_[i].vs1; int kc = sc * 2;               \
    *(bf16x8*)((char*)K_lds + (bq) * SHM_K + KSWZ(sr, kc)) = sr_[i].ks0;                       \
    *(bf16x8*)((char*)K_lds + (bq) * SHM_K + KSWZ(32 + sr, kc)) = sr_[i].ks1; } while (0)
#define SWAIT() asm volatile("s_waitcnt vmcnt(4)" ::: "memory")
#define RESC(a) do { if (__any((a) < 1.f)) { if (hi == 0) al_l[r32] = (a); asm volatile("s_waitcnt lgkmcnt(0)" ::: "memory"); \
    for (int d = 0; d < 4; ++d) for (int r = 0; r < 16; ++r) o[d][r] *= al_l[crow(r, hi)]; } } while (0)
  f32x16 pA0, pA1, pB0, pB1; float mnA, mnB, alA, alB; bf16x8 pa0, pa1, pa2, pa3; const int NT = seq / KVBLK;
  constexpr int SE = 0, SO = 1;
  SLOAD(SE, 0); asm volatile("s_waitcnt vmcnt(0)" ::: "memory"); SWRITE(0, SE); __syncthreads();
  qkt(pA0, pA1, K_lds, qr, r32, hi); partialSM(pA0, pA1, m_reg, mnA, alA);
  SLOAD(SO, KVBLK); if (2 < NT) SLOAD(SE, 2 * KVBLK);
  SWAIT(); SWRITE(1, SO); __syncthreads();
  for (int j = 1; j + 1 < NT; j += 2) {
    SBAR(); qkt(pB0, pB1, (bf16_t*)((char*)K_lds + SHM_K), qr, r32, hi);
    finishSM(pA0, pA1, alA, l_reg, pa0, pa1, pa2, pa3); SBAR();
    SLOAD(SO, (j + 2) * KVBLK); SBAR();
    pv_d0(o, vb0, pa0, pa1, pa2, pa3); partialSM(pB0, pB1, m_reg, mnB, alB);
    __syncthreads(); SWAIT(); SWRITE(0, SE);
    RESC(alB); __syncthreads();
    SBAR(); qkt(pA0, pA1, K_lds, qr, r32, hi);
    finishSM(pB0, pB1, alB, l_reg, pa0, pa1, pa2, pa3); SBAR();
    if (j + 3 < NT) SLOAD(SE, (j + 3) * KVBLK); SBAR();
    pv_d0(o, vb0 + (int)SHM_V, pa0, pa1, pa2, pa3); partialSM(pA0, pA1, m_reg, mnA, alA);
    __syncthreads(); SWAIT(); SWRITE(1, SO);
    RESC(alA); __syncthreads();
  }
  SBAR(); qkt(pB0, pB1, (bf16_t*)((char*)K_lds + SHM_K), qr, r32, hi);
  finishSM(pA0, pA1, alA, l_reg, pa0, pa1, pa2, pa3); SBAR();
  pv_d0(o, vb0, pa0, pa1, pa2, pa3); partialSM(pB0, pB1, m_reg, mnB, alB);
  __syncthreads(); RESC(alB);
  finishSM(pB0, pB1, alB, l_reg, pa0, pa1, pa2, pa3); SBAR();
  pv_d0(o, vb0 + (int)SHM_V, pa0, pa1, pa2, pa3);
  if (hi == 0) li_l[r32] = l_reg; asm volatile("s_waitcnt lgkmcnt(0)" ::: "memory");
  float rli[16];
#pragma unroll
  for (int r = 0; r < 16; ++r) rli[r] = __builtin_amdgcn_rcpf(li_l[crow(r, hi)]);
  bf16_t* Ow = Ob + (long)(wid * QBLK) * LDO;
#pragma unroll
  for (int r = 0; r < 16; ++r) { int orow = crow(r, hi);
    for (int d0 = 0; d0 < 4; ++d0) Ow[(long)orow * LDO + d0 * 32 + r32] = f2bf(o[d0][r] * rli[r]); }
#undef SLOAD
#undef SWRITE
#undef SWAIT
#undef RESC
}
}

__device__ __forceinline__ void ph_attn(const P& p, char* lds, bool need_ctx) {
  const bf16_t* QKV = (const bf16_t*)(p.ws + OFF_D); bf16_t* hb = (bf16_t*)(p.ws + OFF_HBF);
  const int nunits = need_ctx ? 528 : 512;
  for (int u = BIDX(); u < nunits; u += GDIM()) {
    int b, h, seq; size_t qrow;
    if (u < 512) { b = u >> 8; const int rem = u & 255; h = rem >> 5; qrow = (size_t)b * TB + CTXL + (size_t)(rem & 31) * 256; seq = TB; }
    else { const int uu = u - 512; b = uu >> 3; h = uu & 7; qrow = (size_t)b * TB; seq = CTXL; }
    const int kvh = h >> 2;
    const bf16_t* Kh = QKV + (size_t)b * TB * 1536 + 1024 + kvh * 128;
    const bf16_t* Vh = QKV + (size_t)b * TB * 1536 + 1280 + kvh * 128;
    at::attn_dense_body(QKV + qrow * 1536 + h * 128, Kh, Vh, hb + qrow * 1024 + h * 128, seq, lds);
    __syncthreads();
  }
}

__device__ __forceinline__ void ph_final(const P& p) {
  const int tid = TIDX(), wid = tid >> 6, lane = tid & 63;
  const float* xr = (const float*)(p.ws + OFF_XRES);
  for (int q = BIDX() * 8 + wid; q < 2 * LAT; q += GDIM() * 8) {
    const int b = q >> 13, t = q & (LAT - 1); const float* row = xr + ((size_t)b * TB + CTXL + t) * 1024;
    f32x4 v[4]; float ss = 0.f;
#pragma unroll
    for (int i = 0; i < 4; ++i) { v[i] = *(const f32x4*)(row + i * 256 + lane * 4); ss += v[i][0] * v[i][0] + v[i][1] * v[i][1] + v[i][2] * v[i][2] + v[i][3] * v[i][3]; }
    ss = wave_sum(ss); const float rs = rsqrtf(ss * (1.f / 1024.f) + EPSF);
#pragma unroll
    for (int i = 0; i < 4; ++i) { const int c0 = i * 256 + lane * 4; const f32x4 g = *(const f32x4*)(p.final_norm + c0); f32x4 o = v[i] * rs * g; *(f32x4*)(p.out + (size_t)q * 1024 + c0) = o; }
  }
}

#ifndef ONLY_PH
#define ONLY_PH -1
#endif
#define EN(x) (ONLY_PH < 0 || ONLY_PH == (x))
#ifndef PROBE_REP
#define PROBE_REP -1
#endif
#define RUN(cls, ...) do { if (EN(cls)) { for (int rep_ = 0; rep_ < ((PROBE_REP == (cls)) ? 2 : 1); ++rep_) { if (rep_) xcd_barrier(*xbp); __VA_ARGS__; } } } while (0)
enum { OP_INIT, OP_N1FULL, OP_IN, OP_PREP, OP_D1, OP_SCAN, OP_MERGE, OP_OUTLAT, OP_OUTCTX_N2LAT, OP_N2CTX, OP_UP, OP_ACT, OP_DOWNLAT, OP_DOWNCTX_N1LAT, OP_N1CTX,
       OP_QKV, OP_QKNORM, OP_ATTN, OP_N2FULL, OP_FINAL };
constexpr int NPHASES = 46;
__device__ __forceinline__ void decode_phase(int ph, int& op, int& L) {
  if (ph == 0) { op = OP_INIT; L = 0; return; }
  if (ph == NPHASES - 1) { op = OP_FINAL; L = 3; return; }
  int q = ph - 1;
  if (q < 14) { L = 0; if (q == 0) { op = OP_N1FULL; return; } q -= 1; }
  else if (q < 24) { L = 1; q -= 14; }
  else if (q < 37) { L = 2; q -= 24; }
  else { L = 3; q -= 37; }
  if ((L & 1) == 0) {
    if (q < 5) { op = OP_IN + q; return; }
    q -= 5;
  } else {
    if (q < 2) { op = q == 0 ? OP_QKV : OP_ATTN; return; }
    q -= 2;
  }
  if (L < 3) { const int t[8] = {OP_OUTLAT, OP_OUTCTX_N2LAT, OP_N2CTX, OP_UP, OP_ACT, OP_DOWNLAT, OP_DOWNCTX_N1LAT, OP_N1CTX}; op = t[q]; }
  else { const int t[5] = {OP_OUTLAT, OP_N2FULL, OP_UP, OP_ACT, OP_DOWNLAT}; op = t[q]; }
}
__device__ __forceinline__ void run_phase(const P& p0, int ph, char* lds, const XcdBarrier* xbp) {
  P p = p0; { typedef __attribute__((address_space(1))) char gchar_t; size_t wi = (size_t)p0.ws; asm volatile("" : "+s"(wi)); p.ws = (char*)(gchar_t*)wi; }
  int op, L; decode_phase(ph, op, L);
  const int e = L >> 1, o = L >> 1;
  bf16_t* W1 = (bf16_t*)(p.ws + OFF_WC); bf16_t* W2 = (bf16_t*)(p.ws + OFF_WC + WC_W2); bf16_t* W3 = (bf16_t*)(p.ws + OFF_W3);
  bf16_t* hb = (bf16_t*)(p.ws + OFF_HBF); float* xr = (float*)(p.ws + OFF_XRES);
  const float* mods = (const float*)(p.ws + OFF_MODS) + (size_t)L * 3 * 6144;
  float* PART = (float*)(p.ws + OFF_D + D_END_F);
#define CVT_MIX(LL, skipb) do { const int L_ = (LL); if ((L_ & 1) == 0) { cvt_weight(p.rec_w_in + (size_t)(L_ >> 1) * 1024 * 3632, W1, 1024, 3632, NREC, true, skipb); cvt_weight(p.rec_w_out + (size_t)(L_ >> 1) * 1024 * 1024, W3, 1024, 1024, 1024, false, skipb); } \
    else { cvt_weight(p.att_w_qkv + (size_t)(L_ >> 1) * 1024 * 1536, W1, 1024, 1536, 1536, false, skipb); cvt_weight(p.att_w_out + (size_t)(L_ >> 1) * 1024 * 1024, W3, 1024, 1024, 1024, false, skipb); } } while (0)
#define CVT_FFN(LL, skipb) do { const int L_ = (LL); cvt_weight(p.ffn_w_up + (size_t)L_ * 1024 * 5632, W1, 1024, 5632, 5632, false, skipb); cvt_weight(p.ffn_w_down + (size_t)L_ * DFF * 1024, W2, DFF, 1024, 1024, false, skipb); } while (0)
  switch (op) {
    case OP_INIT: RUN(0, ph_init(p, lds); CVT_MIX(0, 0)); break;
    case OP_N1FULL: RUN(1, ph_norm(p, L, 0, 0, 0)); break;
    case OP_IN: RUN(2, gemm8(lds, hb, 1024, W1, 1024, NREC, 0, EpiRec8{(bf16_t*)(p.ws + OFF_D + D_P1), (bf16_t*)(p.ws + OFF_D + D_P2), (float*)(p.ws + OFF_SM)})); break;
    case OP_PREP: RUN(3, ph_dnprep(p, lds, e)); break;
    case OP_D1: RUN(4, ph_dn_d1(p, lds); ph_gla_b(p, lds, e)); break;
#define SCAN_JOB(j) ((((j) & 7) + 8 * ((j) >> 5)) * 4 + (((j) >> 3) & 3))
    case OP_SCAN: RUN(5, if (BIDX() < 64) { dn_scan(p, lds, SCAN_JOB(BIDX())); } else if (BIDX() < 128) { gla_scan(p, lds, SCAN_JOB(BIDX() - 64), e); });
        if (PROBE_REP == 55) { xcd_barrier(*xbp); if (BIDX() < 64) { dn_scan(p, lds, BIDX()); } }
        if (PROBE_REP == 56) { xcd_barrier(*xbp); if (BIDX() >= 64 && BIDX() < 128) { gla_scan(p, lds, BIDX() - 64, e); } }
        break;
    case OP_MERGE: RUN(7, ph_merge(p, e)); break;
    case OP_QKV: if (EN(2)) { gemm8(lds, hb, 1024, W1, 1024, 1536, 0, EpiBf8{(bf16_t*)(p.ws + OFF_D), 1536}); qk_fused(p, lds, o); } break;
    case OP_ATTN: RUN(10, ph_attn(p, lds, L != 3)); break;
    case OP_OUTLAT: if (EN(2)) { gemm8(lds, hb, 1024, W3, 1024, 1024, 1, EpiRes8{xr, mods + 2 * 1024}); if (L == 3) CVT_FFN(L, 0); } break;
    case OP_OUTCTX_N2LAT: if (EN(2)) { if (BIDX() < 128) gemm_ctx_split(lds, hb, 1024, W3, 1024, 128, PART); ph_norm(p, L, 1, 1, 0); CVT_FFN(L, 0); } break;
    case OP_N2CTX: if (EN(1)) ph_ctx_fold_norm(p, L, 1, PART, 8, mods + 2 * 1024); break;
    case OP_N2FULL: if (EN(1)) ph_norm(p, L, 1, 0, 0); break;
    case OP_UP: RUN(2, gemm8(lds, hb, 1024, W1, 1024, 5632, L == 3 ? 1 : 0, EpiBf8{(bf16_t*)(p.ws + OFF_D), 5632})); break;
    case OP_ACT: if (EN(8)) ph_ffnact(p, L); break;
    case OP_DOWNLAT: if (EN(2)) gemm8(lds, (const bf16_t*)(p.ws + OFF_D) + DFF, 5632, W2, DFF, 1024, 1, EpiRes8{xr, mods + 5 * 1024}); break;
    case OP_DOWNCTX_N1LAT: if (EN(2)) { if (BIDX() < 176) gemm_ctx_split(lds, (const bf16_t*)(p.ws + OFF_D) + DFF, 5632, W2, DFF, 256, PART); ph_norm(p, L + 1, 0, 1, 0); CVT_MIX(L + 1, 0); } break;
    case OP_N1CTX: if (EN(1)) ph_ctx_fold_norm(p, L + 1, 0, PART, 11, mods + 5 * 1024); break;
    case OP_FINAL: if (EN(11)) ph_final(p); break;
  }
#undef CVT_MIX
#undef CVT_FFN
}

template <bool COOP>
__global__ void __launch_bounds__(512, 1) mk_kernel(P p, int ph0, int ph1) {
  extern __shared__ __attribute__((aligned(16))) char smem[];
  if constexpr (COOP) {
    if (ph0 < 0) cg::this_grid().sync();
    volatile LAS unsigned* st = (volatile LAS unsigned*)(smem + LDS_BYTES);
    if (threadIdx.x < 4) st[threadIdx.x] = 0u;
    __syncthreads();
    XcdBarrier xb = xcd_barrier_post((unsigned*)(p.ws + OFF_BAR), st);
    for (int ph = ph0; ph < ph1; ++ph) {
      run_phase(p, ph, smem, &xb);
      if (ph + 1 < ph1) xcd_barrier(xb);
      if (PROBE_REP == 99 && ph == 0) { for (int q = 0; q < 20; ++q) xcd_barrier(xb); }
    }
  } else {
    for (int ph = ph0; ph < ph1; ++ph) run_phase(p, ph, smem, nullptr);
  }
}

extern "C" void kernel_launch(void* const* d_in, const int* in_sizes, int n_in, void* d_out, int out_size, void* d_ws, size_t ws_size, hipStream_t stream) {
  if (n_in != 23 || ws_size < WS_NEED) { fprintf(stderr, "kernel_launch: bad n_in %d or ws %zu < %zu\n", n_in, ws_size, (size_t)WS_NEED); return; }
  P p{};
  const float** f = (const float**)&p;
  for (int i = 0; i < 23; ++i) f[i] = (const float*)d_in[i];
  p.out = (float*)d_out; p.ws = (char*)d_ws;
  static int inited = 0, grid_blocks = 0;
  if (!inited) {
    hipFuncSetAttribute((const void*)mk_kernel<true>, hipFuncAttributeMaxDynamicSharedMemorySize, LDS_BYTES + 16);
#if !MK_COOP
    hipFuncSetAttribute((const void*)mk_kernel<false>, hipFuncAttributeMaxDynamicSharedMemorySize, LDS_BYTES);
#endif
    int dev = 0, cus = 0, per_cu = 0;
    hipGetDevice(&dev); hipDeviceGetAttribute(&cus, hipDeviceAttributeMultiprocessorCount, dev);
    hipOccupancyMaxActiveBlocksPerMultiprocessor(&per_cu, mk_kernel<true>, 512, LDS_BYTES + 16);
    if (per_cu > 1) per_cu = 1;
    grid_blocks = cus * per_cu; if (grid_blocks > 256) grid_blocks = 256; if (grid_blocks < 128) grid_blocks = 128;
    inited = 1;
  }
#if MK_COOP
  int ph0 = 0, ph1 = NPHASES;
  void* args[] = {&p, &ph0, &ph1};
  hipMemsetAsync((char*)d_ws + OFF_BAR, 0, 3456 * 4, stream);
  hipError_t er = hipLaunchCooperativeKernel((const void*)mk_kernel<true>, dim3(grid_blocks), dim3(512), args, LDS_BYTES + 16, stream);
  if (er != hipSuccess) fprintf(stderr, "cooperative launch failed: %s (grid %d)\n", hipGetErrorString(er), grid_blocks);
#else
  for (int ph = 0; ph < NPHASES; ++ph) hipLaunchKernelGGL(mk_kernel<false>, dim3(256), dim3(512), LDS_BYTES, stream, p, ph, ph + 1);
#endif
}
```
